# Optimizing an MI355X kernel written in HIP

```python
import math
import jax
import jax.numpy as jnp
from jax import lax
import numpy as np

D_MODEL = 1024
BATCH = 2
SEQ = 8192
DEPTH = 2

GRID_W = 64
CTX_LEN = 256
HEAD_DIM = 64
BLOCK = 128
WINDOW = 128
ROPE_THETA = 10000.0
EPS = 1e-6
NEG_INF = -1e30
N_MOD = 6

MIX_WIDTH = D_MODEL
GROUP_WIDTH = MIX_WIDTH // 4
N_OUT_HEADS = MIX_WIDTH // HEAD_DIM
DIFF_HEADS = GROUP_WIDTH // HEAD_DIM
DIFF_QK_DIM = HEAD_DIM // 2
WIN_HEADS = GROUP_WIDTH // HEAD_DIM
WIN_KV_HEADS = WIN_HEADS // 2
GLOB_HEADS = GROUP_WIDTH // HEAD_DIM
GLOB_KV_HEADS = GLOB_HEADS // 2
HY_CH = GROUP_WIDTH
HY_ORDER = 2
HY_SHORT = 3
HY_BANDS = 16
HY_EMB = 1 + 2 * HY_BANDS
HY_HIDDEN = 64
HY_TARGET = 1e-2
HY_FAST = 0.3
HY_SLOW = 1.5

W_DIFF = 3 * DIFF_HEADS * HEAD_DIM
W_WIN = (WIN_HEADS + 2 * WIN_KV_HEADS) * HEAD_DIM
W_GLOB = (GLOB_HEADS + 2 * GLOB_KV_HEADS) * HEAD_DIM
W_HY = (HY_ORDER + 1) * HY_CH
D_IN = W_DIFF + W_WIN + W_GLOB + W_HY
SPLITS = (W_DIFF, W_DIFF + W_WIN, W_DIFF + W_WIN + W_GLOB)

PEER_HEADS = 8
N_KEYS = 128
N_EXPERTS = N_KEYS * N_KEYS
PEER_TOPK = 16
PEER_DK = 256
PEER_CHUNK = 128

kernel_name = 'hybrid_flow_backbone_peer'


def rmsnorm(x, g):
    xf = x.astype(jnp.float32)
    y = xf * lax.rsqrt(jnp.mean(xf * xf, axis=-1, keepdims=True) + EPS)
    return (y * g).astype(x.dtype)


def modulate(h, shift, scale):
    return h * (1.0 + scale) + shift


def axial_rope(n_tok, dim):
    rows = n_tok // GRID_W
    row = jnp.repeat(jnp.arange(rows, dtype=jnp.float32), GRID_W)
    col = jnp.tile(jnp.arange(GRID_W, dtype=jnp.float32), rows)
    axis_dim = dim // 2
    inv_freq = ROPE_THETA ** (-jnp.arange(0, axis_dim, 2, dtype=jnp.float32) / axis_dim)
    ang = jnp.concatenate([row[:, None] * inv_freq, col[:, None] * inv_freq], axis=-1)
    return jnp.cos(ang), jnp.sin(ang)


def apply_rope(x, cos, sin):
    shape = (1, x.shape[1]) + (1,) * (x.ndim - 3) + (cos.shape[-1],)
    c, s = cos.reshape(shape), sin.reshape(shape)
    x1, x2 = jnp.split(x.astype(jnp.float32), 2, axis=-1)
    return jnp.concatenate([x1 * c - x2 * s, x1 * s + x2 * c], axis=-1).astype(x.dtype)


def sink_softmax(s, sink):
    sink = sink.astype(jnp.float32)
    m = jnp.maximum(jnp.max(s, axis=-1, keepdims=True), sink)
    e = jnp.exp(s - m)
    return e / (jnp.sum(e, axis=-1, keepdims=True) + jnp.exp(sink - m))


def dense_attention(qs, ks, coefs, v, sink=None):
    B_, Lq, H, d = qs[0].shape
    G = v.shape[2]
    R = H // G
    dv = v.shape[-1]
    nb = Lq // BLOCK
    scale = d ** -0.5
    qb = tuple(q.reshape(B_, nb, BLOCK, G, R, d).swapaxes(0, 1) for q in qs)
    sink_b = None if sink is None else sink.reshape(1, G, R, 1, 1)

    def one_block(qblk):
        acc = None
        for q_, k_, coef in zip(qblk, ks, coefs):
            s = jnp.einsum('bqgrd,bkgd->bgrqk', q_, k_, preferred_element_type=jnp.float32) * scale
            p = jax.nn.softmax(s, axis=-1) if sink_b is None else sink_softmax(s, sink_b)
            acc = coef * p if acc is None else acc + coef * p
        return jnp.einsum('bgrqk,bkgd->bqgrd', acc.astype(v.dtype), v)

    o = lax.map(one_block, qb)
    return o.swapaxes(0, 1).reshape(B_, Lq, H, dv)


def window_attention(q, k, v, kc, vc, sink):
    B_, L_, H, d = q.shape
    G = k.shape[2]
    R = H // G
    nb = L_ // BLOCK
    scale = d ** -0.5

    def band(t):
        tb = t.reshape(B_, nb, BLOCK, G, t.shape[-1])
        pad = jnp.zeros_like(tb[:, :1])
        prev = jnp.concatenate([pad, tb[:, :-1]], axis=1)
        nxt = jnp.concatenate([tb[:, 1:], pad], axis=1)
        return jnp.concatenate([prev, tb, nxt], axis=2)

    kb, vb = band(k), band(v)
    qb = q.reshape(B_, nb, BLOCK, G, R, d)
    s_loc = jnp.einsum('bnqgrd,bnkgd->bgrnqk', qb, kb, preferred_element_type=jnp.float32) * scale
    qi = jnp.arange(BLOCK)[:, None]
    kj = jnp.arange(3 * BLOCK)[None, :]
    kpos = (jnp.arange(nb)[:, None, None] - 1) * BLOCK + kj
    valid = (jnp.abs(kj - BLOCK - qi) <= WINDOW) & (kpos >= 0) & (kpos < L_)
    s_loc = jnp.where(valid, s_loc, NEG_INF)
    s_ctx = jnp.einsum('bnqgrd,bkgd->bgrnqk', qb, kc, preferred_element_type=jnp.float32) * scale
    p = sink_softmax(jnp.concatenate([s_ctx, s_loc], axis=-1), sink.reshape(1, G, R, 1, 1, 1))
    p = p.astype(v.dtype)
    n_ctx = kc.shape[1]
    o = (jnp.einsum('bgrnqk,bkgd->bnqgrd', p[..., :n_ctx], vc)
         + jnp.einsum('bgrnqk,bnkgd->bnqgrd', p[..., n_ctx:], vb))
    return o.reshape(B_, L_, H, d)


def gqa_heads(t, n_q, n_kv, g_qk):
    B_, L_, _ = t.shape
    q, k, v = jnp.split(t, [n_q * HEAD_DIM, (n_q + n_kv) * HEAD_DIM], axis=-1)
    q = rmsnorm(q.reshape(B_, L_, n_q, HEAD_DIM), g_qk[0])
    k = rmsnorm(k.reshape(B_, L_, n_kv, HEAD_DIM), g_qk[1])
    return q, k, v.reshape(B_, L_, n_kv, HEAD_DIM)


def diff_attention(p, pc, g_qk, lam_vec, lambda_init, rope, want_ctx):
    def heads(t):
        B_, L_, _ = t.shape
        q, k, v = jnp.split(t, 3, axis=-1)
        q = rmsnorm(q.reshape(B_, L_, DIFF_HEADS, 2, DIFF_QK_DIM), g_qk[0])
        k = rmsnorm(k.reshape(B_, L_, DIFF_HEADS, 2, DIFF_QK_DIM), g_qk[1])
        return q, k, v.reshape(B_, L_, DIFF_HEADS, HEAD_DIM)

    q, k, v = heads(p)
    qc, kc, vc = heads(pc)
    q, k = apply_rope(q, *rope), apply_rope(k, *rope)
    lam_vec = lam_vec.astype(jnp.float32)
    lam = jnp.exp(jnp.sum(lam_vec[0] * lam_vec[1])) - jnp.exp(jnp.sum(lam_vec[2] * lam_vec[3])) + lambda_init
    coefs = (1.0, -lam)
    kk = jnp.concatenate([kc, k], axis=1)
    vv = jnp.concatenate([vc, v], axis=1)
    o = dense_attention((q[..., 0, :], q[..., 1, :]), (kk[..., 0, :], kk[..., 1, :]), coefs, vv)
    if not want_ctx:
        return o, None
    oc = dense_attention((qc[..., 0, :], qc[..., 1, :]), (kc[..., 0, :], kc[..., 1, :]), coefs, vc)
    return o, oc


def short_conv(u, w, b):
    up = jnp.pad(u, ((0, 0), (1, 1), (0, 0)))
    return up[:, :-2] * w[0] + up[:, 1:-1] * w[1] + up[:, 2:] * w[2] + b


def hyena_filters(n_tok, w1, b1, w2, b2, w3, b3, freq):
    t = jnp.linspace(0.0, 1.0, n_tok, dtype=jnp.float32)[:, None]
    w = (2.0 * math.pi / n_tok) * jnp.arange(n_tok, dtype=jnp.float32)[:, None]
    f = jnp.linspace(1e-4, HY_BANDS - 1, HY_BANDS, dtype=jnp.float32)[None, :]
    feat = jnp.concatenate([t, jnp.cos(f * w), -jnp.sin(f * w)], axis=-1)
    hdn = jnp.sin(freq * (feat @ w1 + b1))
    hdn = jnp.sin(freq * (hdn @ w2 + b2))
    filt = (hdn @ w3 + b3).astype(jnp.float32).reshape(n_tok, HY_ORDER, 2, HY_CH)
    deltas = jnp.abs(jnp.linspace(math.log(HY_TARGET) / HY_SLOW, math.log(HY_TARGET) / HY_FAST, HY_CH,
                                  dtype=jnp.float32))
    filt = filt * jnp.exp(-t[:, :, None, None] * deltas)
    fwd, bwd = filt[:, :, 0], filt[:, :, 1]
    kfull = jnp.concatenate([fwd, jnp.zeros_like(fwd[:1]), bwd[1:][::-1]], axis=0)
    return kfull / jnp.sum(jnp.abs(kfull), axis=0, keepdims=True)


def long_conv(z, kf):
    n = z.shape[1]
    zf = jnp.fft.rfft(z.astype(jnp.float32), n=2 * n, axis=1)
    hf = jnp.fft.rfft(kf, n=2 * n, axis=0)
    return jnp.fft.irfft(zf * hf[None], n=2 * n, axis=1)[:, :n].astype(z.dtype)


def hyena(u, conv_w, conv_b, filter_params, bias):
    n = u.shape[1]
    u = short_conv(u, conv_w, conv_b)
    v, x1, x2 = jnp.split(u, 3, axis=-1)
    kfull = hyena_filters(n, *filter_params)
    z = x1 * (long_conv(v, kfull[:, 0]) + bias[0] * v)
    return x2 * (long_conv(z, kfull[:, 1]) + bias[1] * z)


def merge_heads(o, g, w_out, lambda_init):
    B_, L_, _ = o.shape
    oh = rmsnorm(o.reshape(B_, L_, N_OUT_HEADS, HEAD_DIM), g.reshape(N_OUT_HEADS, HEAD_DIM))
    head_scale = jnp.where(jnp.arange(N_OUT_HEADS) < DIFF_HEADS, 1.0 - lambda_init, 1.0)[:, None]
    return (oh * head_scale.astype(oh.dtype)).reshape(B_, L_, MIX_WIDTH) @ w_out


def flat_heads(o):
    return o.reshape(o.shape[0], o.shape[1], -1)


def token_mixing(h, hc, rope_half, rope_full, lambda_init, want_ctx, w_in, g_qk_diff, lambda_diff,
                 g_qk_win, sink_win, g_qk_glob, hy_conv_w, hy_conv_b, hy_filter_params, hy_bias,
                 g_mix_out, w_out):
    pa, pw, pg, ph = jnp.split(h @ w_in, SPLITS, axis=-1)
    pac, pwc, pgc, phc = jnp.split(hc @ w_in, SPLITS, axis=-1)
    oa, oac = diff_attention(pa, pac, g_qk_diff, lambda_diff, lambda_init, rope_half, want_ctx)
    qw, kw, vw = gqa_heads(pw, WIN_HEADS, WIN_KV_HEADS, g_qk_win)
    qwc, kwc, vwc = gqa_heads(pwc, WIN_HEADS, WIN_KV_HEADS, g_qk_win)
    qw, kw = apply_rope(qw, *rope_full), apply_rope(kw, *rope_full)
    ob = window_attention(qw, kw, vw, kwc, vwc, sink_win)
    qg, kg, vg = gqa_heads(pg, GLOB_HEADS, GLOB_KV_HEADS, g_qk_glob)
    qgc, kgc, vgc = gqa_heads(pgc, GLOB_HEADS, GLOB_KV_HEADS, g_qk_glob)
    qg, kg = apply_rope(qg, *rope_full), apply_rope(kg, *rope_full)
    og = dense_attention((qg,), (jnp.concatenate([kgc, kg], axis=1),), (1.0,),
                         jnp.concatenate([vgc, vg], axis=1))
    oh = hyena(ph, hy_conv_w, hy_conv_b, hy_filter_params, hy_bias)
    lat = merge_heads(jnp.concatenate([flat_heads(oa), flat_heads(ob), flat_heads(og), oh], axis=-1),
                      g_mix_out, w_out, lambda_init)
    if not want_ctx:
        return lat, None
    obc = dense_attention((qwc,), (kwc,), (1.0,), vwc, sink=sink_win)
    ogc = dense_attention((qgc,), (kgc,), (1.0,), vgc)
    ohc = hyena(phc, hy_conv_w, hy_conv_b, hy_filter_params, hy_bias)
    ctx_out = merge_heads(jnp.concatenate([flat_heads(oac), flat_heads(obc), flat_heads(ogc), ohc], axis=-1),
                          g_mix_out, w_out, lambda_init)
    return lat, ctx_out


def peer(h, wq, keys, u_tab, v_tab):
    B_, L_, D_ = h.shape
    T = B_ * L_
    xt = h.reshape(T, D_)
    q = (xt @ wq).reshape(T, PEER_HEADS, 2, PEER_DK // 2)
    s = jnp.einsum('thpd,hpkd->thpk', q, keys, preferred_element_type=jnp.float32)
    s_top, i_top = lax.top_k(s, PEER_TOPK)
    cand = (s_top[..., 0, :, None] + s_top[..., 1, None, :]).reshape(T, PEER_HEADS, PEER_TOPK * PEER_TOPK)
    cidx = (i_top[..., 0, :, None] * N_KEYS + i_top[..., 1, None, :]).reshape(T, PEER_HEADS, PEER_TOPK * PEER_TOPK)
    best, pos = lax.top_k(cand, PEER_TOPK)
    experts = jnp.take_along_axis(cidx, pos, axis=-1)
    gate = jax.nn.softmax(best, axis=-1).astype(h.dtype)
    nc = T // PEER_CHUNK

    def one_chunk(args):
        xch, ech, gch = args
        act = jax.nn.gelu(jnp.einsum('chkd,cd->chk', u_tab[ech], xch))
        return jnp.einsum('chk,chkd->cd', gch * act, v_tab[ech])

    out = lax.map(one_chunk, (xt.reshape(nc, PEER_CHUNK, D_),
                              experts.reshape(nc, PEER_CHUNK, PEER_HEADS, PEER_TOPK),
                              gate.reshape(nc, PEER_CHUNK, PEER_HEADS, PEER_TOPK)))
    return out.reshape(B_, L_, D_)


def setup_inputs(seed: int = 0) -> dict:
    key = jax.random.key(seed)
    ks = iter(jax.random.split(key, 40))

    def nrm(shape, s):
        return jax.random.normal(next(ks), shape, jnp.float32) * s

    def gain(shape):
        return 1.0 + nrm(shape, 0.02)

    Ld = DEPTH
    return {
        'x': nrm((BATCH, SEQ, D_MODEL), 1.0),
        'c': nrm((BATCH, D_MODEL), 1.0),
        'ctx': nrm((BATCH, CTX_LEN, D_MODEL), 1.0),
        'c_ctx': nrm((D_MODEL,), 1.0),
        'w_mod': nrm((Ld, D_MODEL, N_MOD * D_MODEL), 0.5 * D_MODEL ** -0.5),
        'b_mod': nrm((Ld, N_MOD * D_MODEL), 0.01),
        'g_norm_mix': gain((Ld, D_MODEL)),
        'w_in': nrm((Ld, D_MODEL, D_IN), D_MODEL ** -0.5),
        'g_qk_diff': gain((Ld, 2, DIFF_QK_DIM)),
        'lambda_diff': nrm((Ld, 4, DIFF_QK_DIM), 0.1),
        'g_qk_win': gain((Ld, 2, HEAD_DIM)),
        'sink_win': nrm((Ld, WIN_HEADS), 0.5),
        'g_qk_glob': gain((Ld, 2, HEAD_DIM)),
        'hy_conv_w': nrm((Ld, HY_SHORT, W_HY), 0.5),
        'hy_conv_b': nrm((Ld, W_HY), 0.02),
        'hy_w1': nrm((Ld, HY_EMB, HY_HIDDEN), HY_EMB ** -0.5),
        'hy_b1': nrm((Ld, HY_HIDDEN), 0.1),
        'hy_w2': nrm((Ld, HY_HIDDEN, HY_HIDDEN), HY_HIDDEN ** -0.5),
        'hy_b2': nrm((Ld, HY_HIDDEN), 0.1),
        'hy_w3': nrm((Ld, HY_HIDDEN, 2 * HY_ORDER * HY_CH), HY_HIDDEN ** -0.5),
        'hy_b3': nrm((Ld, 2 * HY_ORDER * HY_CH), 0.02),
        'hy_freq': 1.0 + nrm((Ld, HY_HIDDEN), 0.1),
        'hy_bias': nrm((Ld, HY_ORDER, HY_CH), 0.5),
        'g_mix_out': gain((Ld, MIX_WIDTH)),
        'w_out': nrm((Ld, MIX_WIDTH, D_MODEL), MIX_WIDTH ** -0.5),
        'g_norm_ffn': gain((Ld, D_MODEL)),
        'peer_wq': nrm((Ld, D_MODEL, PEER_HEADS * PEER_DK), D_MODEL ** -0.5),
        'peer_keys': nrm((Ld, PEER_HEADS, 2, N_KEYS, PEER_DK // 2), (PEER_DK // 2) ** -0.5),
        'peer_u': nrm((Ld, N_EXPERTS, D_MODEL), D_MODEL ** -0.5),
        'peer_v': nrm((Ld, N_EXPERTS, D_MODEL), PEER_HEADS ** -0.5),
    }


def reference(x, c, ctx, c_ctx, w_mod, b_mod, g_norm_mix, w_in, g_qk_diff, lambda_diff, g_qk_win,
              sink_win, g_qk_glob, hy_conv_w, hy_conv_b, hy_w1, hy_b1, hy_w2, hy_b2, hy_w3, hy_b3,
              hy_freq, hy_bias, g_mix_out, w_out, g_norm_ffn, peer_wq, peer_keys, peer_u, peer_v):
    n_tok = x.shape[1]
    rope_half = axial_rope(n_tok, DIFF_QK_DIM)
    rope_full = axial_rope(n_tok, HEAD_DIM)
    xc = ctx
    sc = jax.nn.silu(c)
    scc = jax.nn.silu(c_ctx)
    for i in range(DEPTH):
        want_ctx = i < DEPTH - 1
        lambda_init = 0.8 - 0.6 * math.exp(-0.3 * i)
        m = (sc @ w_mod[i] + b_mod[i])[:, None, :]
        mc = scc @ w_mod[i] + b_mod[i]
        sh1, s1, g1, sh2, s2, g2 = jnp.split(m, N_MOD, axis=-1)
        sh1c, s1c, g1c, sh2c, s2c, g2c = jnp.split(mc, N_MOD, axis=-1)
        h = modulate(rmsnorm(x, g_norm_mix[i]), sh1, s1)
        hc = modulate(rmsnorm(xc, g_norm_mix[i]), sh1c, s1c)
        filt = (hy_w1[i], hy_b1[i], hy_w2[i], hy_b2[i], hy_w3[i], hy_b3[i], hy_freq[i])
        o, oc = token_mixing(h, hc, rope_half, rope_full, lambda_init, want_ctx, w_in[i], g_qk_diff[i],
                             lambda_diff[i], g_qk_win[i], sink_win[i], g_qk_glob[i], hy_conv_w[i],
                             hy_conv_b[i], filt, hy_bias[i], g_mix_out[i], w_out[i])
        x = x + g1 * o
        h2 = modulate(rmsnorm(x, g_norm_ffn[i]), sh2, s2)
        x = x + g2 * peer(h2, peer_wq[i], peer_keys[i], peer_u[i], peer_v[i])
        if want_ctx:
            xc = xc + g1c * oc
            h2c = modulate(rmsnorm(xc, g_norm_ffn[i]), sh2c, s2c)
            xc = xc + g2c * peer(h2c, peer_wq[i], peer_keys[i], peer_u[i], peer_v[i])
    return x
```

```cpp
#include <hip/hip_runtime.h>
#include <stdint.h>

#define DI __device__ __forceinline__
typedef unsigned short bf16_t;

constexpr int D = 1024;
constexpr int NB = 2;
constexpr int SEQ = 8192;
constexpr int CTX = 256;
constexpr int NT = SEQ + CTX;
constexpr int R = NB * NT;
constexpr int DIN = 2560;
constexpr int NMOD = 6 * D;
constexpr float EPS = 1e-6f;
constexpr float LOG2E = 1.4426950408889634f;

DI bf16_t f2bf(float x) { unsigned u = __float_as_uint(x); u += 0x7fffu + ((u >> 16) & 1u); return (bf16_t)(u >> 16); }
DI float bf2f(bf16_t h) { return __uint_as_float(((unsigned)h) << 16); }
DI float bflo(unsigned w) { return __uint_as_float(w << 16); }
DI float bfhi(unsigned w) { return __uint_as_float(w & 0xffff0000u); }

DI float block_sum_256(float v, float* red) {
  for (int o = 32; o > 0; o >>= 1) v += __shfl_xor(v, o);
  int w = threadIdx.x >> 6;
  __syncthreads();
  if ((threadIdx.x & 63) == 0) red[w] = v;
  __syncthreads();
  float s = red[0] + red[1] + red[2] + red[3];
  return s;
}

__global__ __launch_bounds__(256) void k_mod(const float* __restrict__ c, const float* __restrict__ c_ctx,
                                             const float* __restrict__ w_mod, const float* __restrict__ b_mod,
                                             float* __restrict__ modv) {
  __shared__ float sc[3][D];
  int l = blockIdx.y;
  for (int i = threadIdx.x; i < 3 * D; i += 256) {
    int row = i / D, k = i % D;
    float v = row < 2 ? c[row * D + k] : c_ctx[k];
    sc[row][k] = v / (1.f + __expf(-v));
  }
  __syncthreads();
  int col = blockIdx.x * 256 + threadIdx.x;
  const float* w = w_mod + (size_t)l * D * NMOD + col;
  float a0 = 0, a1 = 0, a2 = 0;
  for (int k = 0; k < D; ++k) {
    float wv = w[(size_t)k * NMOD];
    a0 += sc[0][k] * wv; a1 += sc[1][k] * wv; a2 += sc[2][k] * wv;
  }
  float bb = b_mod[l * NMOD + col];
  modv[(l * 3 + 0) * NMOD + col] = a0 + bb;
  modv[(l * 3 + 1) * NMOD + col] = a1 + bb;
  modv[(l * 3 + 2) * NMOD + col] = a2 + bb;
}

__global__ __launch_bounds__(256) void k_init_xs(const float* __restrict__ x, const float* __restrict__ ctx, float* __restrict__ xs) {
  int r = blockIdx.x; int b = r / NT, p = r % NT;
  const float4* src = (const float4*)(p < CTX ? ctx + ((size_t)b * CTX + p) * D : x + ((size_t)b * SEQ + (p - CTX)) * D);
  ((float4*)(xs + (size_t)r * D))[threadIdx.x] = src[threadIdx.x];
}
__global__ __launch_bounds__(256) void k_final(const float* __restrict__ xs, float* __restrict__ out) {
  int i = blockIdx.x; int b = i / SEQ, t = i % SEQ;
  ((float4*)(out + (size_t)i * D))[threadIdx.x] = ((const float4*)(xs + ((size_t)b * NT + CTX + t) * D))[threadIdx.x];
}

__global__ __launch_bounds__(256) void k_norm_mod(const float* __restrict__ xs, const float* __restrict__ g,
                                                  const float* __restrict__ modv_l, int sh_chunk, bf16_t* __restrict__ hbuf) {
  __shared__ float red[8];
  int r = blockIdx.x; int b = r / NT, p = r % NT; int mrow = p < CTX ? 2 : b;
  float4 v = ((const float4*)(xs + (size_t)r * D))[threadIdx.x];
  float ss = v.x * v.x + v.y * v.y + v.z * v.z + v.w * v.w;
  ss = block_sum_256(ss, red);
  float rs = rsqrtf(ss * (1.f / D) + EPS);
  int c0 = threadIdx.x * 4;
  const float* sh = modv_l + mrow * NMOD + sh_chunk * D;
  const float* sc = sh + D;
  float o[4] = {v.x, v.y, v.z, v.w};
  bf16_t ob[4];
  for (int j = 0; j < 4; ++j) ob[j] = f2bf(o[j] * rs * g[c0 + j] * (1.f + sc[c0 + j]) + sh[c0 + j]);
  uint2 pk; pk.x = ob[0] | ((unsigned)ob[1] << 16); pk.y = ob[2] | ((unsigned)ob[3] << 16);
  ((uint2*)(hbuf + (size_t)r * D))[threadIdx.x] = pk;
}

template <int MODE>
__global__ __launch_bounds__(256) void k_gemm_naive(const bf16_t* __restrict__ A, const float* __restrict__ B, float* __restrict__ C,
                                                    int M, int N, int K, const float* __restrict__ gate_base) {
  __shared__ float As[16][68];
  __shared__ float Bs[16][68];
  int bm = blockIdx.y * 64, bn = blockIdx.x * 64;
  int tx = threadIdx.x & 15, ty = threadIdx.x >> 4;
  float acc[4][4];
  for (int i = 0; i < 4; ++i) for (int j = 0; j < 4; ++j) acc[i][j] = 0.f;
  int arow = threadIdx.x >> 2, akq = (threadIdx.x & 3) * 4;
  int brow = threadIdx.x >> 4, bcol = (threadIdx.x & 15) * 4;
  for (int k0 = 0; k0 < K; k0 += 16) {
    uint2 av = *(const uint2*)(A + (size_t)(bm + arow) * K + k0 + akq);
    float4 bv = *(const float4*)(B + (size_t)(k0 + brow) * N + bn + bcol);
    __syncthreads();
    As[akq + 0][arow] = bflo(av.x); As[akq + 1][arow] = bfhi(av.x);
    As[akq + 2][arow] = bflo(av.y); As[akq + 3][arow] = bfhi(av.y);
    *(float4*)&Bs[brow][bcol] = bv;
    __syncthreads();
#pragma unroll
    for (int kk = 0; kk < 16; ++kk) {
      float4 a = *(const float4*)&As[kk][ty * 4];
      float4 bq = *(const float4*)&Bs[kk][tx * 4];
      float aa[4] = {a.x, a.y, a.z, a.w}, bb[4] = {bq.x, bq.y, bq.z, bq.w};
#pragma unroll
      for (int i = 0; i < 4; ++i)
#pragma unroll
        for (int j = 0; j < 4; ++j) acc[i][j] += aa[i] * bb[j];
    }
  }
#pragma unroll
  for (int i = 0; i < 4; ++i) {
    int r = bm + ty * 4 + i;
    int n = bn + tx * 4;
    if (MODE == 0) {
      *(float4*)(C + (size_t)r * N + n) = make_float4(acc[i][0], acc[i][1], acc[i][2], acc[i][3]);
    } else {
      int b = r / NT, p = r % NT; int mrow = p < CTX ? 2 : b;
      const float* gt = gate_base + mrow * NMOD + n;
      float4 xv = *(float4*)(C + (size_t)r * N + n);
      xv.x += gt[0] * acc[i][0]; xv.y += gt[1] * acc[i][1]; xv.z += gt[2] * acc[i][2]; xv.w += gt[3] * acc[i][3];
      *(float4*)(C + (size_t)r * N + n) = xv;
    }
  }
}

struct PrepOut {
  bf16_t *QA, *KA, *VAt, *QW, *KW, *VWt, *QG, *KG, *VGt;
  float* uT;
};
DI int perm16(int o) { return (o & 3) | ((o & 4) << 1) | ((o & 8) >> 1); }

template <int DQK>
DI void prep_unit(const float* src, const float* gain, const float* cs, const float* sn, bool lat, float scale, bf16_t* dst) {
  float ss = 0.f;
  for (int d = 0; d < DQK; ++d) ss += src[d] * src[d];
  float rs = rsqrtf(ss * (1.f / DQK) + EPS);
  constexpr int H = DQK / 2;
  for (int d = 0; d < H; ++d) {
    float x1 = src[d] * rs * gain[d], x2 = src[d + H] * rs * gain[d + H];
    float y1 = x1, y2 = x2;
    if (lat) { y1 = x1 * cs[d] - x2 * sn[d]; y2 = x1 * sn[d] + x2 * cs[d]; }
    dst[d] = f2bf(y1 * scale); dst[d + H] = f2bf(y2 * scale);
  }
}

__global__ __launch_bounds__(256) void k_prep(const float* __restrict__ P, const float* __restrict__ g_qk_diff, const float* __restrict__ g_qk_win,
                                              const float* __restrict__ g_qk_glob, const float* __restrict__ conv_w, const float* __restrict__ conv_b,
                                              PrepOut o) {
  __shared__ float row[1792];
  __shared__ float csh[16], snh[16], csf[32], snf[32];
  int r = blockIdx.x; int b = r / NT, p = r % NT; bool lat = p >= CTX; int t = p - CTX;
  const float* Pr = P + (size_t)r * DIN;
  for (int i = threadIdx.x; i < 1792; i += 256) row[i] = Pr[i];
  if (threadIdx.x < 48 && lat) {
    float trow = (float)(t / 64), tcol = (float)(t % 64);
    int i = threadIdx.x;
    if (i < 16) {
      int j = i & 7; float f = exp2f(-(float)j * (13.287712379549449f / 8.f));
      float a = (i < 8 ? trow : tcol) * f;
      csh[i] = cosf(a); snh[i] = sinf(a);
    } else {
      int ii = i - 16; int j = ii & 15; float f = exp2f(-(float)j * (13.287712379549449f / 16.f));
      float a = (ii < 16 ? trow : tcol) * f;
      csf[ii] = cosf(a); snf[ii] = sinf(a);
    }
  }
  __syncthreads();
  int u = threadIdx.x;
  if (u < 8) {
    prep_unit<32>(row + u * 32, g_qk_diff, csh, snh, lat, 0.17677669529663687f * LOG2E, o.QA + (((size_t)b * 8 + u) * NT + p) * 32);
  } else if (u < 16) {
    int vh = u - 8;
    prep_unit<32>(row + 256 + vh * 32, g_qk_diff + 32, csh, snh, lat, 1.f, o.KA + (((size_t)b * 8 + vh) * NT + p) * 32);
  } else if (u < 20) {
    int h = u - 16;
    prep_unit<64>(row + 768 + h * 64, g_qk_win, csf, snf, lat, 0.125f * LOG2E, o.QW + (((size_t)b * 4 + h) * NT + p) * 64);
  } else if (u < 22) {
    int h = u - 20;
    prep_unit<64>(row + 768 + 256 + h * 64, g_qk_win + 64, csf, snf, lat, 1.f, o.KW + (((size_t)b * 2 + h) * NT + p) * 64);
  } else if (u < 26) {
    int h = u - 22;
    prep_unit<64>(row + 1280 + h * 64, g_qk_glob, csf, snf, lat, 0.125f * LOG2E, o.QG + (((size_t)b * 4 + h) * NT + p) * 64);
  } else if (u < 28) {
    int h = u - 26;
    prep_unit<64>(row + 1280 + 256 + h * 64, g_qk_glob + 64, csf, snf, lat, 1.f, o.KG + (((size_t)b * 2 + h) * NT + p) * 64);
  }
  int pp = (p & ~15) + perm16(p & 15);
  {
    int c = threadIdx.x;
    o.VAt[(((size_t)b * 4 + c / 64) * 64 + (c % 64)) * NT + pp] = f2bf(row[512 + c]);
    if (c < 128) {
      o.VWt[(((size_t)b * 2 + c / 64) * 64 + (c % 64)) * NT + pp] = f2bf(row[768 + 384 + c]);
    } else {
      int c2 = c - 128;
      o.VGt[(((size_t)b * 2 + c2 / 64) * 64 + (c2 % 64)) * NT + pp] = f2bf(row[1280 + 384 + c2]);
    }
  }
  bool hasp = lat ? (t > 0) : (p > 0);
  bool hasn = lat ? (t < SEQ - 1) : (p < CTX - 1);
  for (int c = threadIdx.x; c < 768; c += 256) {
    float v = Pr[1792 + c] * conv_w[768 + c] + conv_b[c];
    if (hasp) v += Pr[1792 + c - DIN] * conv_w[c];
    if (hasn) v += Pr[1792 + c + DIN] * conv_w[2 * 768 + c];
    o.uT[((size_t)b * 768 + c) * NT + p] = v;
  }
}

template <int DQK>
DI void attn_accum(const float* q, const bf16_t* __restrict__ Kb, const bf16_t* __restrict__ Vt, int g0, int g1, int lo, int hi,
                   float M2, float& l, float* o) {
  for (int kg = g0; kg < g1; kg += 16) {
    float pw[16];
#pragma unroll
    for (int pos = 0; pos < 16; ++pos) {
      int k = kg + perm16(pos);
      const uint4* kr = (const uint4*)(Kb + (size_t)k * DQK);
      float s = 0.f;
#pragma unroll
      for (int c = 0; c < DQK / 8; ++c) {
        uint4 w = kr[c];
        s += q[c * 8 + 0] * bflo(w.x) + q[c * 8 + 1] * bfhi(w.x) + q[c * 8 + 2] * bflo(w.y) + q[c * 8 + 3] * bfhi(w.y) +
             q[c * 8 + 4] * bflo(w.z) + q[c * 8 + 5] * bfhi(w.z) + q[c * 8 + 6] * bflo(w.w) + q[c * 8 + 7] * bfhi(w.w);
      }
      float e = exp2f(s - M2);
      pw[pos] = (k >= lo && k <= hi) ? e : 0.f;
      l += pw[pos];
      if ((pos & 3) == 3) asm volatile("" ::: "memory");
    }
#pragma unroll
    for (int dv = 0; dv < 64; ++dv) {
      const uint4* vr = (const uint4*)(Vt + (size_t)dv * NT + kg);
      uint4 w0 = vr[0], w1 = vr[1];
      o[dv] += pw[0] * bflo(w0.x) + pw[1] * bfhi(w0.x) + pw[2] * bflo(w0.y) + pw[3] * bfhi(w0.y) + pw[4] * bflo(w0.z) +
               pw[5] * bfhi(w0.z) + pw[6] * bflo(w0.w) + pw[7] * bfhi(w0.w) + pw[8] * bflo(w1.x) + pw[9] * bfhi(w1.x) +
               pw[10] * bflo(w1.y) + pw[11] * bfhi(w1.y) + pw[12] * bflo(w1.z) + pw[13] * bfhi(w1.z) + pw[14] * bflo(w1.w) +
               pw[15] * bfhi(w1.w);
      if ((dv & 3) == 3) asm volatile("" ::: "memory");
    }
  }
}

template <int TYPE>
__global__ __launch_bounds__(256) void k_attn_naive(const bf16_t* __restrict__ Q, const bf16_t* __restrict__ K, const bf16_t* __restrict__ Vt,
                                                    const float* __restrict__ gqk, const float* __restrict__ sink, float* __restrict__ Otmp,
                                                    int want_ctx) {
  constexpr int DQK = TYPE == 0 ? 32 : 64;
  constexpr int HQ = TYPE == 0 ? 8 : 4;
  constexpr int HK = TYPE == 0 ? 8 : 2;
  constexpr int HV = TYPE == 0 ? 4 : 2;
  constexpr int SLOT0 = TYPE == 0 ? 0 : (TYPE == 1 ? 8 : 12);
  int idx = blockIdx.x * 256 + threadIdx.x;
  int p = idx % NT; int h = (idx / NT) % HQ; int b = idx / (NT * HQ);
  if (p < CTX && !want_ctx) return;
  float gq = 0.f, gk = 0.f;
  for (int d = 0; d < DQK; ++d) { gq = fmaxf(gq, fabsf(gqk[d])); gk = fmaxf(gk, fabsf(gqk[DQK + d])); }
  float M2 = sqrtf((float)DQK) * gq * gk * LOG2E;
  int kh = TYPE == 0 ? h : h / 2, vh = h / 2;
  const bf16_t* Kb = K + ((size_t)b * HK + kh) * NT * DQK;
  const bf16_t* Vb = Vt + ((size_t)b * HV + vh) * 64 * NT;
  float q[DQK];
  {
    const uint4* qr = (const uint4*)(Q + (((size_t)b * HQ + h) * NT + p) * DQK);
#pragma unroll
    for (int c = 0; c < DQK / 8; ++c) {
      uint4 w = qr[c];
      q[c * 8 + 0] = bflo(w.x); q[c * 8 + 1] = bfhi(w.x); q[c * 8 + 2] = bflo(w.y); q[c * 8 + 3] = bfhi(w.y);
      q[c * 8 + 4] = bflo(w.z); q[c * 8 + 5] = bfhi(w.z); q[c * 8 + 6] = bflo(w.w); q[c * 8 + 7] = bfhi(w.w);
    }
  }
  float o[64];
#pragma unroll
  for (int i = 0; i < 64; ++i) o[i] = 0.f;
  float l = 0.f;
#pragma unroll 1
  for (int seg = 0; seg < 2; ++seg) {
    int g0 = 0, g1 = CTX, lo = 0, hi = CTX - 1;
    if (seg == 1) {
      if (p < CTX) break;
      if (TYPE == 1) { lo = max(CTX, p - 128); hi = min(NT - 1, p + 128); g0 = lo & ~15; g1 = (hi & ~15) + 16; }
      else { lo = CTX; hi = NT - 1; g0 = CTX; g1 = NT; }
    }
    attn_accum<DQK>(q, Kb, Vb, g0, g1, lo, hi, M2, l, o);
  }
  if (TYPE == 1) l += exp2f(sink[h] * LOG2E - M2);
  float inv = 1.f / l;
  float4* dst = (float4*)(Otmp + ((((size_t)b * 16 + SLOT0 + h) * NT) + p) * 64);
#pragma unroll
  for (int i = 0; i < 16; ++i) dst[i] = make_float4(o[4 * i] * inv, o[4 * i + 1] * inv, o[4 * i + 2] * inv, o[4 * i + 3] * inv);
}

__global__ __launch_bounds__(256) void k_attn_finish(const float* __restrict__ Otmp, const float* __restrict__ lambda_diff, float lambda_init,
                                                     const float* __restrict__ g_mix_out, bf16_t* __restrict__ A2, int want_ctx) {
  int idx = blockIdx.x * 256 + threadIdx.x;
  int p = idx % NT; int oh = (idx / NT) % 12; int b = idx / (NT * 12);
  if (p < CTX && !want_ctx) return;
  float o[64];
  float hs = 1.f;
  if (oh < 4) {
    float s0 = 0.f, s1 = 0.f;
    for (int d = 0; d < 32; ++d) { s0 += lambda_diff[d] * lambda_diff[32 + d]; s1 += lambda_diff[64 + d] * lambda_diff[96 + d]; }
    float lam = __expf(s0) - __expf(s1) + lambda_init;
    const float4* a = (const float4*)(Otmp + ((((size_t)b * 16 + 2 * oh) * NT) + p) * 64);
    const float4* c = (const float4*)(Otmp + ((((size_t)b * 16 + 2 * oh + 1) * NT) + p) * 64);
#pragma unroll
    for (int i = 0; i < 16; ++i) {
      float4 x = a[i], y = c[i];
      o[4 * i] = x.x - lam * y.x; o[4 * i + 1] = x.y - lam * y.y; o[4 * i + 2] = x.z - lam * y.z; o[4 * i + 3] = x.w - lam * y.w;
    }
    hs = 1.f - lambda_init;
  } else {
    const float4* a = (const float4*)(Otmp + ((((size_t)b * 16 + 4 + oh) * NT) + p) * 64);
#pragma unroll
    for (int i = 0; i < 16; ++i) { float4 x = a[i]; o[4 * i] = x.x; o[4 * i + 1] = x.y; o[4 * i + 2] = x.z; o[4 * i + 3] = x.w; }
  }
  float ss = 0.f;
#pragma unroll
  for (int i = 0; i < 64; ++i) ss += o[i] * o[i];
  float rs = rsqrtf(ss * (1.f / 64) + EPS) * hs;
  const float* g = g_mix_out + oh * 64;
  uint4* dst = (uint4*)(A2 + ((size_t)b * NT + p) * D + oh * 64);
#pragma unroll
  for (int i = 0; i < 8; ++i) {
    unsigned w[4];
#pragma unroll
    for (int j = 0; j < 4; ++j) {
      int e = i * 8 + j * 2;
      w[j] = (unsigned)f2bf(o[e] * rs * g[e]) | ((unsigned)f2bf(o[e + 1] * rs * g[e + 1]) << 16);
    }
    dst[i] = make_uint4(w[0], w[1], w[2], w[3]);
  }
}

__global__ __launch_bounds__(64) void k_hy_mlp(const float* __restrict__ w1, const float* __restrict__ b1, const float* __restrict__ w2,
                                               const float* __restrict__ b2, const float* __restrict__ freq, float* __restrict__ hdn2) {
  __shared__ float feat[33];
  __shared__ float h1[64];
  int which = blockIdx.x >= SEQ ? 1 : 0;
  int j = which ? blockIdx.x - SEQ : blockIdx.x;
  int n = which ? CTX : SEQ;
  int u = threadIdx.x;
  float tt = (float)j / (float)(n - 1);
  float w = (6.283185307179586f / (float)n) * (float)j;
  if (u == 0) feat[0] = tt;
  if (u < 16) {
    float f = 1e-4f + (float)u * ((15.f - 1e-4f) / 15.f);
    feat[1 + u] = cosf(f * w);
    feat[17 + u] = -sinf(f * w);
  }
  __syncthreads();
  float a = b1[u];
  for (int i = 0; i < 33; ++i) a += feat[i] * w1[i * 64 + u];
  h1[u] = sinf(freq[u] * a);
  __syncthreads();
  float a2 = b2[u];
  for (int i = 0; i < 64; ++i) a2 += h1[i] * w2[i * 64 + u];
  hdn2[((size_t)which * SEQ + j) * 64 + u] = sinf(freq[u] * a2);
}

constexpr size_t KC_W0 = (size_t)2 * 256 * 2 * SEQ;
DI size_t kc_off(int which, int order, int c) {
  return which ? KC_W0 + ((size_t)order * 256 + c) * 2 * CTX : ((size_t)order * 256 + c) * 2 * SEQ;
}
__global__ __launch_bounds__(256) void k_hy_filt(const float* __restrict__ hdn2, const float* __restrict__ w3, const float* __restrict__ b3,
                                                 float* __restrict__ kc, int want_ctx) {
  __shared__ float wc[2][64];
  __shared__ float red[8];
  int c = blockIdx.x, order = blockIdx.y, which = blockIdx.z;
  if (which && !want_ctx) return;
  int n = which ? CTX : SEQ;
  int col0 = order * 512 + c, col1 = col0 + 256;
  if (threadIdx.x < 64) wc[0][threadIdx.x] = w3[threadIdx.x * 1024 + col0];
  else if (threadIdx.x < 128) wc[1][threadIdx.x - 64] = w3[(threadIdx.x - 64) * 1024 + col1];
  __syncthreads();
  float delta = fabsf(-3.0701134573253944f + (float)c * ((-15.350567286626972f + 3.0701134573253944f) / 255.f));
  float* out = kc + kc_off(which, order, c);
  float asum = 0.f;
  float bb0 = b3[col0], bb1 = b3[col1];
  for (int j = threadIdx.x; j < n; j += 256) {
    const float4* hr = (const float4*)(hdn2 + ((size_t)which * SEQ + j) * 64);
    float f0 = bb0, f1 = bb1;
#pragma unroll
    for (int i = 0; i < 16; ++i) {
      float4 hv = hr[i];
      f0 += hv.x * wc[0][4 * i] + hv.y * wc[0][4 * i + 1] + hv.z * wc[0][4 * i + 2] + hv.w * wc[0][4 * i + 3];
      f1 += hv.x * wc[1][4 * i] + hv.y * wc[1][4 * i + 1] + hv.z * wc[1][4 * i + 2] + hv.w * wc[1][4 * i + 3];
    }
    float tt = (float)j / (float)(n - 1);
    float dec = __expf(-tt * delta);
    f0 *= dec; f1 *= dec;
    out[n + j] = f0;
    asum += fabsf(f0);
    if (j > 0) { out[n - j] = f1; asum += fabsf(f1); }
    else out[0] = 0.f;
  }
  asum = block_sum_256(asum, red);
  float inv = 1.f / asum;
  __syncthreads();
  for (int j = threadIdx.x; j < 2 * n; j += 256) out[j] *= inv;
}

template <int ORDER>
__global__ __launch_bounds__(256) void k_hy_conv(const float* __restrict__ uT, const float* __restrict__ zin, float* __restrict__ zout,
                                                 const float* __restrict__ kc, const float* __restrict__ hy_bias, int which) {
  __shared__ float zs[256];
  int n = which ? CTX : SEQ;
  int off = which ? 0 : CTX;
  int chunk = blockIdx.x, c = blockIdx.y, b = blockIdx.z;
  int t = chunk * 256 + threadIdx.x;
  const float* in = (ORDER == 0 ? uT + ((size_t)b * 768 + c) * NT : zin + ((size_t)b * 256 + c) * NT) + off;
  const float* kk = kc + kc_off(which, ORDER, c) + n + t;
  float acc = 0.f;
  for (int s0 = 0; s0 < n; s0 += 256) {
    __syncthreads();
    zs[threadIdx.x] = in[s0 + threadIdx.x];
    __syncthreads();
    const float* kp = kk - s0;
#pragma unroll 8
    for (int ss = 0; ss < 256; ++ss) acc += zs[ss] * kp[-ss];
  }
  float self = in[t];
  float gatev = uT[((size_t)b * 768 + (ORDER == 0 ? 256 : 512) + c) * NT + off + t];
  float res = gatev * (acc + hy_bias[ORDER * 256 + c] * self);
  zout[((size_t)b * 256 + c) * NT + off + t] = res;
}

__global__ __launch_bounds__(256) void k_hy_fin(const float* __restrict__ yT, const float* __restrict__ g_mix_out, bf16_t* __restrict__ A2,
                                                int want_ctx) {
  int idx = blockIdx.x * 256 + threadIdx.x;
  int p = idx % NT; int g = (idx / NT) % 4; int b = idx / (NT * 4);
  if (p < CTX && !want_ctx) return;
  float v[64];
  float ss = 0.f;
#pragma unroll
  for (int i = 0; i < 64; ++i) { v[i] = yT[((size_t)b * 256 + g * 64 + i) * NT + p]; ss += v[i] * v[i]; }
  float rs = rsqrtf(ss * (1.f / 64) + EPS);
  const float* gm = g_mix_out + 768 + g * 64;
  uint4* dst = (uint4*)(A2 + ((size_t)b * NT + p) * D + 768 + g * 64);
#pragma unroll
  for (int i = 0; i < 8; ++i) {
    unsigned w[4];
#pragma unroll
    for (int j = 0; j < 4; ++j) {
      int e = i * 8 + j * 2;
      w[j] = (unsigned)f2bf(v[e] * rs * gm[e]) | ((unsigned)f2bf(v[e + 1] * rs * gm[e + 1]) << 16);
    }
    dst[i] = make_uint4(w[0], w[1], w[2], w[3]);
  }
}

__global__ __launch_bounds__(256) void k_peer_naive(const float* __restrict__ qbuf, const bf16_t* __restrict__ hbuf, const float* __restrict__ keys,
                                                    const float* __restrict__ ut, const float* __restrict__ vt, const float* __restrict__ modv_l,
                                                    float* __restrict__ xs, int want_ctx) {
  __shared__ float qs[2048];
  __shared__ float sc[16 * 128];
  __shared__ float topv[16][16];
  __shared__ int topi[16][16];
  __shared__ float cand[8][256];
  __shared__ int elist[128];
  __shared__ float glist[128];
  __shared__ float wl[128];
  int r = blockIdx.x; int b = r / NT, p = r % NT;
  if (p < CTX && !want_ctx) return;
  int tid = threadIdx.x;
  for (int i = tid; i < 512; i += 256) ((float4*)qs)[i] = ((const float4*)(qbuf + (size_t)r * 2048))[i];
  __syncthreads();
  for (int i = 0; i < 8; ++i) {
    int sidx = tid + 256 * i;
    int hp = sidx >> 7;
    const float4* kr = (const float4*)(keys + (size_t)sidx * 128);
    const float4* qq = (const float4*)(qs + hp * 128);
    float s = 0.f;
    for (int d = 0; d < 32; ++d) { float4 a = kr[d], q4 = qq[d]; s += a.x * q4.x + a.y * q4.y + a.z * q4.z + a.w * q4.w; }
    sc[sidx] = s;
  }
  __syncthreads();
  if (tid < 16) {
    float* row = sc + tid * 128;
    for (int k = 0; k < 16; ++k) {
      float best = -3.0e38f; int bi = 0;
      for (int j = 0; j < 128; ++j) { float v = row[j]; if (v > best) { best = v; bi = j; } }
      topv[tid][k] = best; topi[tid][k] = bi; row[bi] = -3.0e38f;
    }
  }
  __syncthreads();
  for (int i = tid; i < 8 * 256; i += 256) {
    int h = i >> 8, ab = i & 255;
    cand[h][ab] = topv[2 * h][ab >> 4] + topv[2 * h + 1][ab & 15];
  }
  __syncthreads();
  if (tid < 8) {
    float* row = cand[tid];
    float mx = -3.0e38f;
    for (int k = 0; k < 16; ++k) {
      float best = -3.0e38f; int bi = 0;
      for (int j = 0; j < 256; ++j) { float v = row[j]; if (v > best) { best = v; bi = j; } }
      row[bi] = -3.0e38f;
      elist[tid * 16 + k] = topi[2 * tid][bi >> 4] * 128 + topi[2 * tid + 1][bi & 15];
      glist[tid * 16 + k] = best;
      if (k == 0) mx = best;
    }
    float sum = 0.f;
    for (int k = 0; k < 16; ++k) { float e = __expf(glist[tid * 16 + k] - mx); glist[tid * 16 + k] = e; sum += e; }
    float inv = 1.f / sum;
    for (int k = 0; k < 16; ++k) glist[tid * 16 + k] *= inv;
  }
  __syncthreads();
  {
    int lane = tid & 63, w = tid >> 6;
    float xv[16];
    const uint4* hr = (const uint4*)(hbuf + (size_t)r * D + lane * 16);
    uint4 a = hr[0], c = hr[1];
    xv[0] = bflo(a.x); xv[1] = bfhi(a.x); xv[2] = bflo(a.y); xv[3] = bfhi(a.y); xv[4] = bflo(a.z); xv[5] = bfhi(a.z); xv[6] = bflo(a.w); xv[7] = bfhi(a.w);
    xv[8] = bflo(c.x); xv[9] = bfhi(c.x); xv[10] = bflo(c.y); xv[11] = bfhi(c.y); xv[12] = bflo(c.z); xv[13] = bfhi(c.z); xv[14] = bflo(c.w); xv[15] = bfhi(c.w);
    for (int e = 0; e < 32; ++e) {
      int ei = w * 32 + e;
      const float4* ur = (const float4*)(ut + (size_t)elist[ei] * D + lane * 16);
      float s = 0.f;
#pragma unroll
      for (int j = 0; j < 4; ++j) { float4 uu = ur[j]; s += uu.x * xv[4 * j] + uu.y * xv[4 * j + 1] + uu.z * xv[4 * j + 2] + uu.w * xv[4 * j + 3]; }
      for (int o = 32; o > 0; o >>= 1) s += __shfl_xor(s, o);
      if (lane == 0) {
        float g = 0.5f * s * (1.f + tanhf(0.7978845608028654f * (s + 0.044715f * s * s * s)));
        wl[ei] = glist[ei] * g;
      }
    }
  }
  __syncthreads();
  float4 acc = make_float4(0.f, 0.f, 0.f, 0.f);
  for (int e = 0; e < 128; ++e) {
    float wv = wl[e];
    float4 vv = ((const float4*)(vt + (size_t)elist[e] * D))[tid];
    acc.x += wv * vv.x; acc.y += wv * vv.y; acc.z += wv * vv.z; acc.w += wv * vv.w;
  }
  int mrow = p < CTX ? 2 : b;
  const float* g2 = modv_l + mrow * NMOD + 5 * D + tid * 4;
  float4 xv = ((float4*)(xs + (size_t)r * D))[tid];
  xv.x += g2[0] * acc.x; xv.y += g2[1] * acc.y; xv.z += g2[2] * acc.z; xv.w += g2[3] * acc.w;
  ((float4*)(xs + (size_t)r * D))[tid] = xv;
}

static inline size_t align_up(size_t x) { return (x + 255) & ~(size_t)255; }

extern "C" void kernel_launch(void* const* d_in, const int* in_sizes, int n_in, void* d_out, int out_size, void* d_ws, size_t ws_size,
                              hipStream_t stream) {
  const float* x = (const float*)d_in[0];
  const float* c = (const float*)d_in[1];
  const float* ctx = (const float*)d_in[2];
  const float* c_ctx = (const float*)d_in[3];
  const float* w_mod = (const float*)d_in[4];
  const float* b_mod = (const float*)d_in[5];
  const float* g_norm_mix = (const float*)d_in[6];
  const float* w_in = (const float*)d_in[7];
  const float* g_qk_diff = (const float*)d_in[8];
  const float* lambda_diff = (const float*)d_in[9];
  const float* g_qk_win = (const float*)d_in[10];
  const float* sink_win = (const float*)d_in[11];
  const float* g_qk_glob = (const float*)d_in[12];
  const float* hy_conv_w = (const float*)d_in[13];
  const float* hy_conv_b = (const float*)d_in[14];
  const float* hy_w1 = (const float*)d_in[15];
  const float* hy_b1 = (const float*)d_in[16];
  const float* hy_w2 = (const float*)d_in[17];
  const float* hy_b2 = (const float*)d_in[18];
  const float* hy_w3 = (const float*)d_in[19];
  const float* hy_b3 = (const float*)d_in[20];
  const float* hy_freq = (const float*)d_in[21];
  const float* hy_bias = (const float*)d_in[22];
  const float* g_mix_out = (const float*)d_in[23];
  const float* w_out = (const float*)d_in[24];
  const float* g_norm_ffn = (const float*)d_in[25];
  const float* peer_wq = (const float*)d_in[26];
  const float* peer_keys = (const float*)d_in[27];
  const float* peer_u = (const float*)d_in[28];
  const float* peer_v = (const float*)d_in[29];
  float* out = (float*)d_out;

  char* ws = (char*)d_ws;
  size_t off = 0;
  auto carve = [&](size_t bytes) { char* p = ws + off; off = align_up(off + bytes); return p; };
  float* modv = (float*)carve((size_t)2 * 3 * NMOD * 4);
  float* xs = (float*)carve((size_t)R * D * 4);
  bf16_t* hbuf = (bf16_t*)carve((size_t)R * D * 2);
  float* P = (float*)carve((size_t)R * DIN * 4);
  float* qbuf = P;
  PrepOut po;
  po.QA = (bf16_t*)carve((size_t)NB * 8 * NT * 32 * 2);
  po.KA = (bf16_t*)carve((size_t)NB * 8 * NT * 32 * 2);
  po.VAt = (bf16_t*)carve((size_t)NB * 4 * 64 * NT * 2);
  po.QW = (bf16_t*)carve((size_t)NB * 4 * NT * 64 * 2);
  po.KW = (bf16_t*)carve((size_t)NB * 2 * NT * 64 * 2);
  po.VWt = (bf16_t*)carve((size_t)NB * 2 * 64 * NT * 2);
  po.QG = (bf16_t*)carve((size_t)NB * 4 * NT * 64 * 2);
  po.KG = (bf16_t*)carve((size_t)NB * 2 * NT * 64 * 2);
  po.VGt = (bf16_t*)carve((size_t)NB * 2 * 64 * NT * 2);
  po.uT = (float*)carve((size_t)NB * 768 * NT * 4);
  float* zT = (float*)carve((size_t)NB * 256 * NT * 4);
  float* yT = (float*)carve((size_t)NB * 256 * NT * 4);
  float* hdn2 = (float*)carve((size_t)2 * SEQ * 64 * 4);
  float* kc = (float*)carve((KC_W0 + (size_t)2 * 256 * 2 * CTX) * 4);
  bf16_t* A2 = (bf16_t*)carve((size_t)R * D * 2);
  float* Otmp = P;
  if (off > ws_size) return; (void)in_sizes; (void)n_in; (void)out_size;

  k_mod<<<dim3(NMOD / 256, 2), 256, 0, stream>>>(c, c_ctx, w_mod, b_mod, modv);
  k_init_xs<<<R, 256, 0, stream>>>(x, ctx, xs);

  for (int l = 0; l < 2; ++l) {
    int want_ctx = l < 1 ? 1 : 0;
    float lambda_init = 0.8f - 0.6f * expf(-0.3f * (float)l);
    const float* modv_l = modv + (size_t)l * 3 * NMOD;
    k_norm_mod<<<R, 256, 0, stream>>>(xs, g_norm_mix + l * D, modv_l, 0, hbuf);
    k_gemm_naive<0><<<dim3(DIN / 64, R / 64), 256, 0, stream>>>(hbuf, w_in + (size_t)l * D * DIN, P, R, DIN, D, nullptr);
    k_prep<<<R, 256, 0, stream>>>(P, g_qk_diff + l * 64, g_qk_win + l * 128, g_qk_glob + l * 128, hy_conv_w + l * 3 * 768,
                                  hy_conv_b + l * 768, po);
    k_attn_naive<0><<<NB * 8 * NT / 256, 256, 0, stream>>>(po.QA, po.KA, po.VAt, g_qk_diff + l * 64, nullptr, Otmp, want_ctx);
    k_attn_naive<1><<<NB * 4 * NT / 256, 256, 0, stream>>>(po.QW, po.KW, po.VWt, g_qk_win + l * 128, sink_win + l * 4, Otmp, want_ctx);
    k_attn_naive<2><<<NB * 4 * NT / 256, 256, 0, stream>>>(po.QG, po.KG, po.VGt, g_qk_glob + l * 128, nullptr, Otmp, want_ctx);
    k_attn_finish<<<NB * 12 * NT / 256, 256, 0, stream>>>(Otmp, lambda_diff + l * 128, lambda_init, g_mix_out + l * D, A2, want_ctx);
    k_hy_mlp<<<SEQ + CTX, 64, 0, stream>>>(hy_w1 + l * 33 * 64, hy_b1 + l * 64, hy_w2 + l * 64 * 64, hy_b2 + l * 64, hy_freq + l * 64, hdn2);
    k_hy_filt<<<dim3(256, 2, 2), 256, 0, stream>>>(hdn2, hy_w3 + (size_t)l * 64 * 1024, hy_b3 + l * 1024, kc, want_ctx);
    k_hy_conv<0><<<dim3(SEQ / 256, 256, NB), 256, 0, stream>>>(po.uT, nullptr, zT, kc, hy_bias + l * 512, 0);
    k_hy_conv<1><<<dim3(SEQ / 256, 256, NB), 256, 0, stream>>>(po.uT, zT, yT, kc, hy_bias + l * 512, 0);
    if (want_ctx) {
      k_hy_conv<0><<<dim3(CTX / 256, 256, NB), 256, 0, stream>>>(po.uT, nullptr, zT, kc, hy_bias + l * 512, 1);
      k_hy_conv<1><<<dim3(CTX / 256, 256, NB), 256, 0, stream>>>(po.uT, zT, yT, kc, hy_bias + l * 512, 1);
    }
    k_hy_fin<<<NB * 4 * NT / 256, 256, 0, stream>>>(yT, g_mix_out + l * D, A2, want_ctx);
    k_gemm_naive<1><<<dim3(D / 64, R / 64), 256, 0, stream>>>(A2, w_out + (size_t)l * D * D, xs, R, D, D, modv_l + 2 * D);
    k_norm_mod<<<R, 256, 0, stream>>>(xs, g_norm_ffn + l * D, modv_l, 3, hbuf);
    k_gemm_naive<0><<<dim3(2048 / 64, R / 64), 256, 0, stream>>>(hbuf, peer_wq + (size_t)l * D * 2048, qbuf, R, 2048, D, nullptr);
    k_peer_naive<<<R, 256, 0, stream>>>(qbuf, hbuf, peer_keys + (size_t)l * 16 * 128 * 128, peer_u + (size_t)l * 16384 * D,
                                        peer_v + (size_t)l * 16384 * D, modv_l, xs, want_ctx);
  }
  k_final<<<NB * SEQ, 256, 0, stream>>>(xs, out);
}
```

```cpp
#include <hip/hip_runtime.h>
#include <stdint.h>

#define DI __device__ __forceinline__
typedef unsigned short bf16_t;

constexpr int D = 1024;
constexpr int NB = 2;
constexpr int SEQ = 8192;
constexpr int CTX = 256;
constexpr int NT = SEQ + CTX;
constexpr int R = NB * NT;
constexpr int DIN = 2560;
constexpr int NMOD = 6 * D;
constexpr float EPS = 1e-6f;
constexpr float LOG2E = 1.4426950408889634f;

DI bf16_t f2bf(float x) { unsigned u = __float_as_uint(x); u += 0x7fffu + ((u >> 16) & 1u); return (bf16_t)(u >> 16); }
DI float bf2f(bf16_t h) { return __uint_as_float(((unsigned)h) << 16); }
DI float bflo(unsigned w) { return __uint_as_float(w << 16); }
DI float bfhi(unsigned w) { return __uint_as_float(w & 0xffff0000u); }

DI float block_sum_256(float v, float* red) {
  for (int o = 32; o > 0; o >>= 1) v += __shfl_xor(v, o);
  int w = threadIdx.x >> 6;
  __syncthreads();
  if ((threadIdx.x & 63) == 0) red[w] = v;
  __syncthreads();
  float s = red[0] + red[1] + red[2] + red[3];
  return s;
}

__global__ __launch_bounds__(256) void k_mod(const float* __restrict__ c, const float* __restrict__ c_ctx,
                                             const float* __restrict__ w_mod, const float* __restrict__ b_mod,
                                             float* __restrict__ modv) {
  __shared__ float sc[3][D];
  int l = blockIdx.y;
  for (int i = threadIdx.x; i < 3 * D; i += 256) {
    int row = i / D, k = i % D;
    float v = row < 2 ? c[row * D + k] : c_ctx[k];
    sc[row][k] = v / (1.f + __expf(-v));
  }
  __syncthreads();
  int col = blockIdx.x * 256 + threadIdx.x;
  const float* w = w_mod + (size_t)l * D * NMOD + col;
  float a0 = 0, a1 = 0, a2 = 0;
  for (int k = 0; k < D; ++k) {
    float wv = w[(size_t)k * NMOD];
    a0 += sc[0][k] * wv; a1 += sc[1][k] * wv; a2 += sc[2][k] * wv;
  }
  float bb = b_mod[l * NMOD + col];
  modv[(l * 3 + 0) * NMOD + col] = a0 + bb;
  modv[(l * 3 + 1) * NMOD + col] = a1 + bb;
  modv[(l * 3 + 2) * NMOD + col] = a2 + bb;
}

__global__ __launch_bounds__(256) void k_init_xs(const float* __restrict__ x, const float* __restrict__ ctx, float* __restrict__ xs) {
  int r = blockIdx.x; int b = r / NT, p = r % NT;
  const float4* src = (const float4*)(p < CTX ? ctx + ((size_t)b * CTX + p) * D : x + ((size_t)b * SEQ + (p - CTX)) * D);
  ((float4*)(xs + (size_t)r * D))[threadIdx.x] = src[threadIdx.x];
}
__global__ __launch_bounds__(256) void k_final(const float* __restrict__ xs, float* __restrict__ out) {
  int i = blockIdx.x; int b = i / SEQ, t = i % SEQ;
  ((float4*)(out + (size_t)i * D))[threadIdx.x] = ((const float4*)(xs + ((size_t)b * NT + CTX + t) * D))[threadIdx.x];
}

__global__ __launch_bounds__(256) void k_norm_mod(const float* __restrict__ xs, const float* __restrict__ g,
                                                  const float* __restrict__ modv_l, int sh_chunk, bf16_t* __restrict__ hbuf) {
  __shared__ float red[8];
  int r = blockIdx.x; int b = r / NT, p = r % NT; int mrow = p < CTX ? 2 : b;
  float4 v = ((const float4*)(xs + (size_t)r * D))[threadIdx.x];
  float ss = v.x * v.x + v.y * v.y + v.z * v.z + v.w * v.w;
  ss = block_sum_256(ss, red);
  float rs = rsqrtf(ss * (1.f / D) + EPS);
  int c0 = threadIdx.x * 4;
  const float* sh = modv_l + mrow * NMOD + sh_chunk * D;
  const float* sc = sh + D;
  float o[4] = {v.x, v.y, v.z, v.w};
  bf16_t ob[4];
  for (int j = 0; j < 4; ++j) ob[j] = f2bf(o[j] * rs * g[c0 + j] * (1.f + sc[c0 + j]) + sh[c0 + j]);
  uint2 pk; pk.x = ob[0] | ((unsigned)ob[1] << 16); pk.y = ob[2] | ((unsigned)ob[3] << 16);
  ((uint2*)(hbuf + (size_t)r * D))[threadIdx.x] = pk;
}

template <int MODE>
__global__ __launch_bounds__(256) void k_gemm_naive(const bf16_t* __restrict__ A, const float* __restrict__ B, float* __restrict__ C,
                                                    int M, int N, int K, const float* __restrict__ gate_base) {
  __shared__ float As[16][68];
  __shared__ float Bs[16][68];
  int bm = blockIdx.y * 64, bn = blockIdx.x * 64;
  int tx = threadIdx.x & 15, ty = threadIdx.x >> 4;
  float acc[4][4];
  for (int i = 0; i < 4; ++i) for (int j = 0; j < 4; ++j) acc[i][j] = 0.f;
  int arow = threadIdx.x >> 2, akq = (threadIdx.x & 3) * 4;
  int brow = threadIdx.x >> 4, bcol = (threadIdx.x & 15) * 4;
  for (int k0 = 0; k0 < K; k0 += 16) {
    uint2 av = *(const uint2*)(A + (size_t)(bm + arow) * K + k0 + akq);
    float4 bv = *(const float4*)(B + (size_t)(k0 + brow) * N + bn + bcol);
    __syncthreads();
    As[akq + 0][arow] = bflo(av.x); As[akq + 1][arow] = bfhi(av.x);
    As[akq + 2][arow] = bflo(av.y); As[akq + 3][arow] = bfhi(av.y);
    *(float4*)&Bs[brow][bcol] = bv;
    __syncthreads();
#pragma unroll
    for (int kk = 0; kk < 16; ++kk) {
      float4 a = *(const float4*)&As[kk][ty * 4];
      float4 bq = *(const float4*)&Bs[kk][tx * 4];
      float aa[4] = {a.x, a.y, a.z, a.w}, bb[4] = {bq.x, bq.y, bq.z, bq.w};
#pragma unroll
      for (int i = 0; i < 4; ++i)
#pragma unroll
        for (int j = 0; j < 4; ++j) acc[i][j] += aa[i] * bb[j];
    }
  }
#pragma unroll
  for (int i = 0; i < 4; ++i) {
    int r = bm + ty * 4 + i;
    int n = bn + tx * 4;
    if (MODE == 0) {
      *(float4*)(C + (size_t)r * N + n) = make_float4(acc[i][0], acc[i][1], acc[i][2], acc[i][3]);
    } else {
      int b = r / NT, p = r % NT; int mrow = p < CTX ? 2 : b;
      const float* gt = gate_base + mrow * NMOD + n;
      float4 xv = *(float4*)(C + (size_t)r * N + n);
      xv.x += gt[0] * acc[i][0]; xv.y += gt[1] * acc[i][1]; xv.z += gt[2] * acc[i][2]; xv.w += gt[3] * acc[i][3];
      *(float4*)(C + (size_t)r * N + n) = xv;
    }
  }
}

struct PrepOut {
  bf16_t *QA, *KA, *VAt, *QW, *KW, *VWt, *QG, *KG, *VGt;
  float* uT;
};
DI int perm16(int o) { return (o & 3) | ((o & 4) << 1) | ((o & 8) >> 1); }

template <int DQK>
DI void prep_unit(const float* src, const float* gain, const float* cs, const float* sn, bool lat, float scale, bf16_t* dst) {
  float ss = 0.f;
  for (int d = 0; d < DQK; ++d) ss += src[d] * src[d];
  float rs = rsqrtf(ss * (1.f / DQK) + EPS);
  constexpr int H = DQK / 2;
  for (int d = 0; d < H; ++d) {
    float x1 = src[d] * rs * gain[d], x2 = src[d + H] * rs * gain[d + H];
    float y1 = x1, y2 = x2;
    if (lat) { y1 = x1 * cs[d] - x2 * sn[d]; y2 = x1 * sn[d] + x2 * cs[d]; }
    dst[d] = f2bf(y1 * scale); dst[d + H] = f2bf(y2 * scale);
  }
}

__global__ __launch_bounds__(256) void k_prep(const bf16_t* __restrict__ P, const float* __restrict__ g_qk_diff, const float* __restrict__ g_qk_win,
                                              const float* __restrict__ g_qk_glob, const float* __restrict__ conv_w, const float* __restrict__ conv_b,
                                              PrepOut o) {
  __shared__ float row[1792];
  __shared__ float csh[16], snh[16], csf[32], snf[32];
  int r = blockIdx.x; int b = r / NT, p = r % NT; bool lat = p >= CTX; int t = p - CTX;
  const bf16_t* Pr = P + (size_t)r * DIN;
  for (int i = threadIdx.x; i < 1792; i += 256) row[i] = bf2f(Pr[i]);
  if (threadIdx.x < 48 && lat) {
    float trow = (float)(t / 64), tcol = (float)(t % 64);
    int i = threadIdx.x;
    if (i < 16) {
      int j = i & 7; float f = exp2f(-(float)j * (13.287712379549449f / 8.f));
      float a = (i < 8 ? trow : tcol) * f;
      csh[i] = cosf(a); snh[i] = sinf(a);
    } else {
      int ii = i - 16; int j = ii & 15; float f = exp2f(-(float)j * (13.287712379549449f / 16.f));
      float a = (ii < 16 ? trow : tcol) * f;
      csf[ii] = cosf(a); snf[ii] = sinf(a);
    }
  }
  __syncthreads();
  int u = threadIdx.x;
  if (u < 8) {
    prep_unit<32>(row + u * 32, g_qk_diff, csh, snh, lat, 0.17677669529663687f * LOG2E, o.QA + (((size_t)b * 8 + u) * NT + p) * 32);
  } else if (u < 16) {
    int vh = u - 8;
    prep_unit<32>(row + 256 + vh * 32, g_qk_diff + 32, csh, snh, lat, 1.f, o.KA + (((size_t)b * 8 + vh) * NT + p) * 32);
  } else if (u < 20) {
    int h = u - 16;
    prep_unit<64>(row + 768 + h * 64, g_qk_win, csf, snf, lat, 0.125f * LOG2E, o.QW + (((size_t)b * 4 + h) * NT + p) * 64);
  } else if (u < 22) {
    int h = u - 20;
    prep_unit<64>(row + 768 + 256 + h * 64, g_qk_win + 64, csf, snf, lat, 1.f, o.KW + (((size_t)b * 2 + h) * NT + p) * 64);
  } else if (u < 26) {
    int h = u - 22;
    prep_unit<64>(row + 1280 + h * 64, g_qk_glob, csf, snf, lat, 0.125f * LOG2E, o.QG + (((size_t)b * 4 + h) * NT + p) * 64);
  } else if (u < 28) {
    int h = u - 26;
    prep_unit<64>(row + 1280 + 256 + h * 64, g_qk_glob + 64, csf, snf, lat, 1.f, o.KG + (((size_t)b * 2 + h) * NT + p) * 64);
  }
  int pp = (p & ~15) + perm16(p & 15);
  {
    int c = threadIdx.x;
    o.VAt[(((size_t)b * 4 + c / 64) * 64 + (c % 64)) * NT + pp] = f2bf(row[512 + c]);
    if (c < 128) {
      o.VWt[(((size_t)b * 2 + c / 64) * 64 + (c % 64)) * NT + pp] = f2bf(row[768 + 384 + c]);
    } else {
      int c2 = c - 128;
      o.VGt[(((size_t)b * 2 + c2 / 64) * 64 + (c2 % 64)) * NT + pp] = f2bf(row[1280 + 384 + c2]);
    }
  }
  bool hasp = lat ? (t > 0) : (p > 0);
  bool hasn = lat ? (t < SEQ - 1) : (p < CTX - 1);
  for (int c = threadIdx.x; c < 768; c += 256) {
    float v = bf2f(Pr[1792 + c]) * conv_w[768 + c] + conv_b[c];
    if (hasp) v += bf2f(Pr[1792 + c - DIN]) * conv_w[c];
    if (hasn) v += bf2f(Pr[1792 + c + DIN]) * conv_w[2 * 768 + c];
    o.uT[((size_t)b * 768 + c) * NT + p] = v;
  }
}

template <int DQK>
DI void attn_accum(const float* q, const bf16_t* __restrict__ Kb, const bf16_t* __restrict__ Vt, int g0, int g1, int lo, int hi,
                   float M2, float& l, float* o) {
  for (int kg = g0; kg < g1; kg += 16) {
    float pw[16];
#pragma unroll
    for (int pos = 0; pos < 16; ++pos) {
      int k = kg + perm16(pos);
      const uint4* kr = (const uint4*)(Kb + (size_t)k * DQK);
      float s = 0.f;
#pragma unroll
      for (int c = 0; c < DQK / 8; ++c) {
        uint4 w = kr[c];
        s += q[c * 8 + 0] * bflo(w.x) + q[c * 8 + 1] * bfhi(w.x) + q[c * 8 + 2] * bflo(w.y) + q[c * 8 + 3] * bfhi(w.y) +
             q[c * 8 + 4] * bflo(w.z) + q[c * 8 + 5] * bfhi(w.z) + q[c * 8 + 6] * bflo(w.w) + q[c * 8 + 7] * bfhi(w.w);
      }
      float e = exp2f(s - M2);
      pw[pos] = (k >= lo && k <= hi) ? e : 0.f;
      l += pw[pos];
      if ((pos & 3) == 3) asm volatile("" ::: "memory");
    }
#pragma unroll
    for (int dv = 0; dv < 64; ++dv) {
      const uint4* vr = (const uint4*)(Vt + (size_t)dv * NT + kg);
      uint4 w0 = vr[0], w1 = vr[1];
      o[dv] += pw[0] * bflo(w0.x) + pw[1] * bfhi(w0.x) + pw[2] * bflo(w0.y) + pw[3] * bfhi(w0.y) + pw[4] * bflo(w0.z) +
               pw[5] * bfhi(w0.z) + pw[6] * bflo(w0.w) + pw[7] * bfhi(w0.w) + pw[8] * bflo(w1.x) + pw[9] * bfhi(w1.x) +
               pw[10] * bflo(w1.y) + pw[11] * bfhi(w1.y) + pw[12] * bflo(w1.z) + pw[13] * bfhi(w1.z) + pw[14] * bflo(w1.w) +
               pw[15] * bfhi(w1.w);
      if ((dv & 3) == 3) asm volatile("" ::: "memory");
    }
  }
}

template <int TYPE>
__global__ __launch_bounds__(256) void k_attn_naive(const bf16_t* __restrict__ Q, const bf16_t* __restrict__ K, const bf16_t* __restrict__ Vt,
                                                    const float* __restrict__ gqk, const float* __restrict__ sink, float* __restrict__ Otmp,
                                                    int want_ctx) {
  constexpr int DQK = TYPE == 0 ? 32 : 64;
  constexpr int HQ = TYPE == 0 ? 8 : 4;
  constexpr int HK = TYPE == 0 ? 8 : 2;
  constexpr int HV = TYPE == 0 ? 4 : 2;
  constexpr int SLOT0 = TYPE == 0 ? 0 : (TYPE == 1 ? 8 : 12);
  int idx = blockIdx.x * 256 + threadIdx.x;
  int p = idx % NT; int h = (idx / NT) % HQ; int b = idx / (NT * HQ);
  if (p < CTX && !want_ctx) return;
  float gq = 0.f, gk = 0.f;
  for (int d = 0; d < DQK; ++d) { gq = fmaxf(gq, fabsf(gqk[d])); gk = fmaxf(gk, fabsf(gqk[DQK + d])); }
  float M2 = sqrtf((float)DQK) * gq * gk * LOG2E;
  int kh = TYPE == 0 ? h : h / 2, vh = h / 2;
  const bf16_t* Kb = K + ((size_t)b * HK + kh) * NT * DQK;
  const bf16_t* Vb = Vt + ((size_t)b * HV + vh) * 64 * NT;
  float q[DQK];
  {
    const uint4* qr = (const uint4*)(Q + (((size_t)b * HQ + h) * NT + p) * DQK);
#pragma unroll
    for (int c = 0; c < DQK / 8; ++c) {
      uint4 w = qr[c];
      q[c * 8 + 0] = bflo(w.x); q[c * 8 + 1] = bfhi(w.x); q[c * 8 + 2] = bflo(w.y); q[c * 8 + 3] = bfhi(w.y);
      q[c * 8 + 4] = bflo(w.z); q[c * 8 + 5] = bfhi(w.z); q[c * 8 + 6] = bflo(w.w); q[c * 8 + 7] = bfhi(w.w);
    }
  }
  float o[64];
#pragma unroll
  for (int i = 0; i < 64; ++i) o[i] = 0.f;
  float l = 0.f;
#pragma unroll 1
  for (int seg = 0; seg < 2; ++seg) {
    int g0 = 0, g1 = CTX, lo = 0, hi = CTX - 1;
    if (seg == 1) {
      if (p < CTX) break;
      if (TYPE == 1) { lo = max(CTX, p - 128); hi = min(NT - 1, p + 128); g0 = lo & ~15; g1 = (hi & ~15) + 16; }
      else { lo = CTX; hi = NT - 1; g0 = CTX; g1 = NT; }
    }
    attn_accum<DQK>(q, Kb, Vb, g0, g1, lo, hi, M2, l, o);
  }
  if (TYPE == 1) l += exp2f(sink[h] * LOG2E - M2);
  float inv = 1.f / l;
  float4* dst = (float4*)(Otmp + ((((size_t)b * 16 + SLOT0 + h) * NT) + p) * 64);
#pragma unroll
  for (int i = 0; i < 16; ++i) dst[i] = make_float4(o[4 * i] * inv, o[4 * i + 1] * inv, o[4 * i + 2] * inv, o[4 * i + 3] * inv);
}

__global__ __launch_bounds__(256) void k_attn_finish(const float* __restrict__ Otmp, const float* __restrict__ lambda_diff, float lambda_init,
                                                     const float* __restrict__ g_mix_out, bf16_t* __restrict__ A2, int want_ctx) {
  int idx = blockIdx.x * 256 + threadIdx.x;
  int p = idx % NT; int oh = (idx / NT) % 12; int b = idx / (NT * 12);
  if (p < CTX && !want_ctx) return;
  float o[64];
  float hs = 1.f;
  if (oh < 4) {
    float s0 = 0.f, s1 = 0.f;
    for (int d = 0; d < 32; ++d) { s0 += lambda_diff[d] * lambda_diff[32 + d]; s1 += lambda_diff[64 + d] * lambda_diff[96 + d]; }
    float lam = __expf(s0) - __expf(s1) + lambda_init;
    const float4* a = (const float4*)(Otmp + ((((size_t)b * 16 + 2 * oh) * NT) + p) * 64);
    const float4* c = (const float4*)(Otmp + ((((size_t)b * 16 + 2 * oh + 1) * NT) + p) * 64);
#pragma unroll
    for (int i = 0; i < 16; ++i) {
      float4 x = a[i], y = c[i];
      o[4 * i] = x.x - lam * y.x; o[4 * i + 1] = x.y - lam * y.y; o[4 * i + 2] = x.z - lam * y.z; o[4 * i + 3] = x.w - lam * y.w;
    }
    hs = 1.f - lambda_init;
  } else {
    const float4* a = (const float4*)(Otmp + ((((size_t)b * 16 + 4 + oh) * NT) + p) * 64);
#pragma unroll
    for (int i = 0; i < 16; ++i) { float4 x = a[i]; o[4 * i] = x.x; o[4 * i + 1] = x.y; o[4 * i + 2] = x.z; o[4 * i + 3] = x.w; }
  }
  float ss = 0.f;
#pragma unroll
  for (int i = 0; i < 64; ++i) ss += o[i] * o[i];
  float rs = rsqrtf(ss * (1.f / 64) + EPS) * hs;
  const float* g = g_mix_out + oh * 64;
  uint4* dst = (uint4*)(A2 + ((size_t)b * NT + p) * D + oh * 64);
#pragma unroll
  for (int i = 0; i < 8; ++i) {
    unsigned w[4];
#pragma unroll
    for (int j = 0; j < 4; ++j) {
      int e = i * 8 + j * 2;
      w[j] = (unsigned)f2bf(o[e] * rs * g[e]) | ((unsigned)f2bf(o[e + 1] * rs * g[e + 1]) << 16);
    }
    dst[i] = make_uint4(w[0], w[1], w[2], w[3]);
  }
}

__global__ __launch_bounds__(64) void k_hy_mlp(const float* __restrict__ w1, const float* __restrict__ b1, const float* __restrict__ w2,
                                               const float* __restrict__ b2, const float* __restrict__ freq, float* __restrict__ hdn2) {
  __shared__ float feat[33];
  __shared__ float h1[64];
  int which = blockIdx.x >= SEQ ? 1 : 0;
  int j = which ? blockIdx.x - SEQ : blockIdx.x;
  int n = which ? CTX : SEQ;
  int u = threadIdx.x;
  float tt = (float)j / (float)(n - 1);
  float w = (6.283185307179586f / (float)n) * (float)j;
  if (u == 0) feat[0] = tt;
  if (u < 16) {
    float f = 1e-4f + (float)u * ((15.f - 1e-4f) / 15.f);
    feat[1 + u] = cosf(f * w);
    feat[17 + u] = -sinf(f * w);
  }
  __syncthreads();
  float a = b1[u];
  for (int i = 0; i < 33; ++i) a += feat[i] * w1[i * 64 + u];
  h1[u] = sinf(freq[u] * a);
  __syncthreads();
  float a2 = b2[u];
  for (int i = 0; i < 64; ++i) a2 += h1[i] * w2[i * 64 + u];
  hdn2[((size_t)which * SEQ + j) * 64 + u] = sinf(freq[u] * a2);
}

constexpr size_t KC_W0 = (size_t)2 * 256 * 2 * SEQ;
DI size_t kc_off(int which, int order, int c) {
  return which ? KC_W0 + ((size_t)order * 256 + c) * 2 * CTX : ((size_t)order * 256 + c) * 2 * SEQ;
}
__global__ __launch_bounds__(256) void k_hy_filt(const float* __restrict__ hdn2, const float* __restrict__ w3, const float* __restrict__ b3,
                                                 float* __restrict__ kc, int want_ctx) {
  __shared__ float wc[2][64];
  __shared__ float red[8];
  int c = blockIdx.x, order = blockIdx.y, which = blockIdx.z;
  if (which && !want_ctx) return;
  int n = which ? CTX : SEQ;
  int col0 = order * 512 + c, col1 = col0 + 256;
  if (threadIdx.x < 64) wc[0][threadIdx.x] = w3[threadIdx.x * 1024 + col0];
  else if (threadIdx.x < 128) wc[1][threadIdx.x - 64] = w3[(threadIdx.x - 64) * 1024 + col1];
  __syncthreads();
  float delta = fabsf(-3.0701134573253944f + (float)c * ((-15.350567286626972f + 3.0701134573253944f) / 255.f));
  float* out = kc + kc_off(which, order, c);
  float asum = 0.f;
  float bb0 = b3[col0], bb1 = b3[col1];
  for (int j = threadIdx.x; j < n; j += 256) {
    const float4* hr = (const float4*)(hdn2 + ((size_t)which * SEQ + j) * 64);
    float f0 = bb0, f1 = bb1;
#pragma unroll
    for (int i = 0; i < 16; ++i) {
      float4 hv = hr[i];
      f0 += hv.x * wc[0][4 * i] + hv.y * wc[0][4 * i + 1] + hv.z * wc[0][4 * i + 2] + hv.w * wc[0][4 * i + 3];
      f1 += hv.x * wc[1][4 * i] + hv.y * wc[1][4 * i + 1] + hv.z * wc[1][4 * i + 2] + hv.w * wc[1][4 * i + 3];
    }
    float tt = (float)j / (float)(n - 1);
    float dec = __expf(-tt * delta);
    f0 *= dec; f1 *= dec;
    out[n + j] = f0;
    asum += fabsf(f0);
    if (j > 0) { out[n - j] = f1; asum += fabsf(f1); }
    else out[0] = 0.f;
  }
  asum = block_sum_256(asum, red);
  float inv = 1.f / asum;
  __syncthreads();
  for (int j = threadIdx.x; j < 2 * n; j += 256) out[j] *= inv;
}

template <int ORDER>
__global__ __launch_bounds__(256) void k_hy_conv(const float* __restrict__ uT, const float* __restrict__ zin, float* __restrict__ zout,
                                                 const float* __restrict__ kc, const float* __restrict__ hy_bias, int which) {
  __shared__ float zs[256];
  int n = which ? CTX : SEQ;
  int off = which ? 0 : CTX;
  int chunk = blockIdx.x, c = blockIdx.y, b = blockIdx.z;
  int t = chunk * 256 + threadIdx.x;
  const float* in = (ORDER == 0 ? uT + ((size_t)b * 768 + c) * NT : zin + ((size_t)b * 256 + c) * NT) + off;
  const float* kk = kc + kc_off(which, ORDER, c) + n + t;
  float acc = 0.f;
  for (int s0 = 0; s0 < n; s0 += 256) {
    __syncthreads();
    zs[threadIdx.x] = in[s0 + threadIdx.x];
    __syncthreads();
    const float* kp = kk - s0;
#pragma unroll 8
    for (int ss = 0; ss < 256; ++ss) acc += zs[ss] * kp[-ss];
  }
  float self = in[t];
  float gatev = uT[((size_t)b * 768 + (ORDER == 0 ? 256 : 512) + c) * NT + off + t];
  float res = gatev * (acc + hy_bias[ORDER * 256 + c] * self);
  zout[((size_t)b * 256 + c) * NT + off + t] = res;
}

__global__ __launch_bounds__(256) void k_hy_fin(const float* __restrict__ yT, const float* __restrict__ g_mix_out, bf16_t* __restrict__ A2,
                                                int want_ctx) {
  int idx = blockIdx.x * 256 + threadIdx.x;
  int p = idx % NT; int g = (idx / NT) % 4; int b = idx / (NT * 4);
  if (p < CTX && !want_ctx) return;
  float v[64];
  float ss = 0.f;
#pragma unroll
  for (int i = 0; i < 64; ++i) { v[i] = yT[((size_t)b * 256 + g * 64 + i) * NT + p]; ss += v[i] * v[i]; }
  float rs = rsqrtf(ss * (1.f / 64) + EPS);
  const float* gm = g_mix_out + 768 + g * 64;
  uint4* dst = (uint4*)(A2 + ((size_t)b * NT + p) * D + 768 + g * 64);
#pragma unroll
  for (int i = 0; i < 8; ++i) {
    unsigned w[4];
#pragma unroll
    for (int j = 0; j < 4; ++j) {
      int e = i * 8 + j * 2;
      w[j] = (unsigned)f2bf(v[e] * rs * gm[e]) | ((unsigned)f2bf(v[e + 1] * rs * gm[e + 1]) << 16);
    }
    dst[i] = make_uint4(w[0], w[1], w[2], w[3]);
  }
}

__global__ __launch_bounds__(256) void k_peer_naive(const bf16_t* __restrict__ qbuf, const bf16_t* __restrict__ hbuf, const float* __restrict__ keys,
                                                    const float* __restrict__ ut, const float* __restrict__ vt, const float* __restrict__ modv_l,
                                                    float* __restrict__ xs, int want_ctx) {
  __shared__ float qs[2048];
  __shared__ float sc[16 * 128];
  __shared__ float topv[16][16];
  __shared__ int topi[16][16];
  __shared__ float cand[8][256];
  __shared__ int elist[128];
  __shared__ float glist[128];
  __shared__ float wl[128];
  int r = blockIdx.x; int b = r / NT, p = r % NT;
  if (p < CTX && !want_ctx) return;
  int tid = threadIdx.x;
  {
    uint4 w = ((const uint4*)(qbuf + (size_t)r * 2048))[tid];
    float* qd = qs + tid * 8;
    qd[0] = bflo(w.x); qd[1] = bfhi(w.x); qd[2] = bflo(w.y); qd[3] = bfhi(w.y); qd[4] = bflo(w.z); qd[5] = bfhi(w.z); qd[6] = bflo(w.w); qd[7] = bfhi(w.w);
  }
  __syncthreads();
  for (int i = 0; i < 8; ++i) {
    int sidx = tid + 256 * i;
    int hp = sidx >> 7;
    const float4* kr = (const float4*)(keys + (size_t)sidx * 128);
    const float4* qq = (const float4*)(qs + hp * 128);
    float s = 0.f;
    for (int d = 0; d < 32; ++d) { float4 a = kr[d], q4 = qq[d]; s += a.x * q4.x + a.y * q4.y + a.z * q4.z + a.w * q4.w; }
    sc[sidx] = s;
  }
  __syncthreads();
  if (tid < 16) {
    float* row = sc + tid * 128;
    for (int k = 0; k < 16; ++k) {
      float best = -3.0e38f; int bi = 0;
      for (int j = 0; j < 128; ++j) { float v = row[j]; if (v > best) { best = v; bi = j; } }
      topv[tid][k] = best; topi[tid][k] = bi; row[bi] = -3.0e38f;
    }
  }
  __syncthreads();
  for (int i = tid; i < 8 * 256; i += 256) {
    int h = i >> 8, ab = i & 255;
    cand[h][ab] = topv[2 * h][ab >> 4] + topv[2 * h + 1][ab & 15];
  }
  __syncthreads();
  if (tid < 8) {
    float* row = cand[tid];
    float mx = -3.0e38f;
    for (int k = 0; k < 16; ++k) {
      float best = -3.0e38f; int bi = 0;
      for (int j = 0; j < 256; ++j) { float v = row[j]; if (v > best) { best = v; bi = j; } }
      row[bi] = -3.0e38f;
      elist[tid * 16 + k] = topi[2 * tid][bi >> 4] * 128 + topi[2 * tid + 1][bi & 15];
      glist[tid * 16 + k] = best;
      if (k == 0) mx = best;
    }
    float sum = 0.f;
    for (int k = 0; k < 16; ++k) { float e = __expf(glist[tid * 16 + k] - mx); glist[tid * 16 + k] = e; sum += e; }
    float inv = 1.f / sum;
    for (int k = 0; k < 16; ++k) glist[tid * 16 + k] *= inv;
  }
  __syncthreads();
  {
    int lane = tid & 63, w = tid >> 6;
    float xv[16];
    const uint4* hr = (const uint4*)(hbuf + (size_t)r * D + lane * 16);
    uint4 a = hr[0], c = hr[1];
    xv[0] = bflo(a.x); xv[1] = bfhi(a.x); xv[2] = bflo(a.y); xv[3] = bfhi(a.y); xv[4] = bflo(a.z); xv[5] = bfhi(a.z); xv[6] = bflo(a.w); xv[7] = bfhi(a.w);
    xv[8] = bflo(c.x); xv[9] = bfhi(c.x); xv[10] = bflo(c.y); xv[11] = bfhi(c.y); xv[12] = bflo(c.z); xv[13] = bfhi(c.z); xv[14] = bflo(c.w); xv[15] = bfhi(c.w);
    for (int e = 0; e < 32; ++e) {
      int ei = w * 32 + e;
      const float4* ur = (const float4*)(ut + (size_t)elist[ei] * D + lane * 16);
      float s = 0.f;
#pragma unroll
      for (int j = 0; j < 4; ++j) { float4 uu = ur[j]; s += uu.x * xv[4 * j] + uu.y * xv[4 * j + 1] + uu.z * xv[4 * j + 2] + uu.w * xv[4 * j + 3]; }
      for (int o = 32; o > 0; o >>= 1) s += __shfl_xor(s, o);
      if (lane == 0) {
        float g = 0.5f * s * (1.f + tanhf(0.7978845608028654f * (s + 0.044715f * s * s * s)));
        wl[ei] = glist[ei] * g;
      }
    }
  }
  __syncthreads();
  float4 acc = make_float4(0.f, 0.f, 0.f, 0.f);
  for (int e = 0; e < 128; ++e) {
    float wv = wl[e];
    float4 vv = ((const float4*)(vt + (size_t)elist[e] * D))[tid];
    acc.x += wv * vv.x; acc.y += wv * vv.y; acc.z += wv * vv.z; acc.w += wv * vv.w;
  }
  int mrow = p < CTX ? 2 : b;
  const float* g2 = modv_l + mrow * NMOD + 5 * D + tid * 4;
  float4 xv = ((float4*)(xs + (size_t)r * D))[tid];
  xv.x += g2[0] * acc.x; xv.y += g2[1] * acc.y; xv.z += g2[2] * acc.z; xv.w += g2[3] * acc.w;
  ((float4*)(xs + (size_t)r * D))[tid] = xv;
}

typedef __attribute__((ext_vector_type(8))) short bf16x8;
typedef __attribute__((ext_vector_type(16))) float f32x16;
typedef __attribute__((ext_vector_type(2))) __bf16 bf16x2_t;
typedef __attribute__((ext_vector_type(2))) float f32x2_t;
#define MFMA32(a, b, c) __builtin_amdgcn_mfma_f32_32x32x16_bf16((a), (b), (c), 0, 0, 0)
DI unsigned pk2bf(float a, float b) { f32x2_t v = {a, b}; return __builtin_bit_cast(unsigned, __builtin_convertvector(v, bf16x2_t)); }
constexpr int NTHR = 512;

DI void wconv_tile(const float* __restrict__ W, bf16_t* __restrict__ Wt, int N, int tile, float* sm  ) {
  int tn = tile % (N / 64), tk = tile / (N / 64);
  int tid = threadIdx.x;
  __syncthreads();
  for (int i = tid; i < 64 * 16; i += NTHR) {
    int kr = i >> 4, c4 = (i & 15) * 4;
    float4 v = *(const float4*)(W + (size_t)(tk * 64 + kr) * N + tn * 64 + c4);
    sm[kr * 65 + c4] = v.x; sm[kr * 65 + c4 + 1] = v.y; sm[kr * 65 + c4 + 2] = v.z; sm[kr * 65 + c4 + 3] = v.w;
  }
  __syncthreads();
  for (int i = tid; i < 64 * 8; i += NTHR) {
    int n = i >> 3, k8 = (i & 7) * 8;
    unsigned w[4];
    for (int j = 0; j < 4; ++j) w[j] = pk2bf(sm[(k8 + 2 * j) * 65 + n], sm[(k8 + 2 * j + 1) * 65 + n]);
    *(uint4*)(Wt + (size_t)(tn * 64 + n) * D + tk * 64 + k8) = make_uint4(w[0], w[1], w[2], w[3]);
  }
}

template <int EPI>
DI void gemm_tile(const bf16_t* __restrict__ A, const bf16_t* __restrict__ Wt, int N, int m0, int n0, char* smem, bf16_t* __restrict__ Cb,
                  float* __restrict__ xs, const float* __restrict__ gate_base) {
  constexpr int K = D;
  const int tid = threadIdx.x, lane = tid & 63, wid = tid >> 6;
  const int wm = wid & 1, wn = wid >> 1;
  const int r = lane & 31, h = lane >> 5;
  f32x16 acc0, acc1;
  for (int i = 0; i < 16; ++i) { acc0[i] = 0.f; acc1[i] = 0.f; }
  const int lrow = tid >> 3, lch = tid & 7;
  const bf16_t* Ag = A + (size_t)(m0 + lrow) * K + lch * 8;
  const bf16_t* Bg = Wt + (size_t)(n0 + lrow) * K + lch * 8;
  const int woff = lrow * 128 + ((lch ^ ((lrow >> 1) & 7)) << 4);
  uint4 ra0, ra1, rb0, rb1;
  ra0 = *(const uint4*)(Ag); ra1 = *(const uint4*)(Ag + (size_t)64 * K);
  rb0 = *(const uint4*)(Bg); rb1 = *(const uint4*)(Bg + (size_t)64 * K);
  __syncthreads();
  *(uint4*)(smem + woff) = ra0; *(uint4*)(smem + woff + 8192) = ra1;
  *(uint4*)(smem + 16384 + woff) = rb0; *(uint4*)(smem + 16384 + woff + 8192) = rb1;
  __syncthreads();
  const int sw = (r >> 1) & 7;
  const int aoff0 = (wm * 64 + r) * 128, aoff1 = aoff0 + 32 * 128;
  const int boff = 16384 + (wn * 32 + r) * 128;
#pragma unroll 1
  for (int kt = 0; kt < K / 64; ++kt) {
    const char* st = smem + (kt & 1) * 32768;
    if (kt + 1 < K / 64) {
      ra0 = *(const uint4*)(Ag + (kt + 1) * 64); ra1 = *(const uint4*)(Ag + (size_t)64 * K + (kt + 1) * 64);
      rb0 = *(const uint4*)(Bg + (kt + 1) * 64); rb1 = *(const uint4*)(Bg + (size_t)64 * K + (kt + 1) * 64);
    }
#pragma unroll
    for (int s = 0; s < 4; ++s) {
      int co = ((2 * s + h) ^ sw) << 4;
      bf16x8 a0 = *(const bf16x8*)(st + aoff0 + co);
      bf16x8 a1 = *(const bf16x8*)(st + aoff1 + co);
      bf16x8 b = *(const bf16x8*)(st + boff + co);
      acc0 = MFMA32(a0, b, acc0);
      acc1 = MFMA32(a1, b, acc1);
    }
    if (kt + 1 < K / 64) {
      char* sn = smem + ((kt + 1) & 1) * 32768;
      *(uint4*)(sn + woff) = ra0; *(uint4*)(sn + woff + 8192) = ra1;
      *(uint4*)(sn + 16384 + woff) = rb0; *(uint4*)(sn + 16384 + woff + 8192) = rb1;
    }
    __syncthreads();
  }
  float* Cs = (float*)smem;
  constexpr int CS = 132;
#pragma unroll
  for (int i = 0; i < 16; ++i) {
    int row = (i & 3) + 8 * (i >> 2) + 4 * h;
    Cs[(wm * 64 + row) * CS + wn * 32 + r] = acc0[i];
    Cs[(wm * 64 + 32 + row) * CS + wn * 32 + r] = acc1[i];
  }
  __syncthreads();
  if (EPI == 0) {
    for (int i = tid; i < 128 * 16; i += NTHR) {
      int row = i >> 4, c8 = (i & 15) * 8;
      const float* cr = Cs + row * CS + c8;
      float4 v0 = *(const float4*)cr, v1 = *(const float4*)(cr + 4);
      *(uint4*)(Cb + (size_t)(m0 + row) * N + n0 + c8) = make_uint4(pk2bf(v0.x, v0.y), pk2bf(v0.z, v0.w), pk2bf(v1.x, v1.y), pk2bf(v1.z, v1.w));
    }
  } else {
    for (int i = tid; i < 128 * 32; i += NTHR) {
      int row = i >> 5, c4 = (i & 31) * 4;
      int rr = m0 + row; int b = rr / NT, p = rr % NT; int mrow = p < CTX ? 2 : b;
      const float* gt = gate_base + mrow * NMOD + n0 + c4;
      float4 v = *(const float4*)(Cs + row * CS + c4);
      float4 xv = *(float4*)(xs + (size_t)rr * D + n0 + c4);
      xv.x += gt[0] * v.x; xv.y += gt[1] * v.y; xv.z += gt[2] * v.z; xv.w += gt[3] * v.w;
      *(float4*)(xs + (size_t)rr * D + n0 + c4) = xv;
    }
  }
}

__global__ __launch_bounds__(NTHR) void k_wconv(const float* __restrict__ W, bf16_t* __restrict__ Wt, int N) {
  __shared__ float sm[64 * 65];
  int ntiles = (N / 64) * (D / 64);
  for (int t = blockIdx.x; t < ntiles; t += gridDim.x) wconv_tile(W, Wt, N, t, sm);
}
template <int EPI>
__global__ __launch_bounds__(NTHR) void k_gemm(const bf16_t* __restrict__ A, const bf16_t* __restrict__ Wt, int N, bf16_t* __restrict__ Cb,
                                               float* __restrict__ xs, const float* __restrict__ gate_base) {
  extern __shared__ __attribute__((aligned(16))) char smem[];
  int nt_n = N / 128, ntiles = (R / 128) * nt_n;
  for (int t = blockIdx.x; t < ntiles; t += gridDim.x) {
    int tm = t / nt_n, tn = t % nt_n;
    gemm_tile<EPI>(A, Wt, N, tm * 128, tn * 128, smem, Cb, xs, gate_base);
  }
}

static inline size_t align_up(size_t x) { return (x + 255) & ~(size_t)255; }

extern "C" void kernel_launch(void* const* d_in, const int* in_sizes, int n_in, void* d_out, int out_size, void* d_ws, size_t ws_size,
                              hipStream_t stream) {
  const float* x = (const float*)d_in[0];
  const float* c = (const float*)d_in[1];
  const float* ctx = (const float*)d_in[2];
  const float* c_ctx = (const float*)d_in[3];
  const float* w_mod = (const float*)d_in[4];
  const float* b_mod = (const float*)d_in[5];
  const float* g_norm_mix = (const float*)d_in[6];
  const float* w_in = (const float*)d_in[7];
  const float* g_qk_diff = (const float*)d_in[8];
  const float* lambda_diff = (const float*)d_in[9];
  const float* g_qk_win = (const float*)d_in[10];
  const float* sink_win = (const float*)d_in[11];
  const float* g_qk_glob = (const float*)d_in[12];
  const float* hy_conv_w = (const float*)d_in[13];
  const float* hy_conv_b = (const float*)d_in[14];
  const float* hy_w1 = (const float*)d_in[15];
  const float* hy_b1 = (const float*)d_in[16];
  const float* hy_w2 = (const float*)d_in[17];
  const float* hy_b2 = (const float*)d_in[18];
  const float* hy_w3 = (const float*)d_in[19];
  const float* hy_b3 = (const float*)d_in[20];
  const float* hy_freq = (const float*)d_in[21];
  const float* hy_bias = (const float*)d_in[22];
  const float* g_mix_out = (const float*)d_in[23];
  const float* w_out = (const float*)d_in[24];
  const float* g_norm_ffn = (const float*)d_in[25];
  const float* peer_wq = (const float*)d_in[26];
  const float* peer_keys = (const float*)d_in[27];
  const float* peer_u = (const float*)d_in[28];
  const float* peer_v = (const float*)d_in[29];
  float* out = (float*)d_out;

  char* ws = (char*)d_ws;
  size_t off = 0;
  auto carve = [&](size_t bytes) { char* p = ws + off; off = align_up(off + bytes); return p; };
  float* modv = (float*)carve((size_t)2 * 3 * NMOD * 4);
  float* xs = (float*)carve((size_t)R * D * 4);
  bf16_t* hbuf = (bf16_t*)carve((size_t)R * D * 2);
  bf16_t* P = (bf16_t*)carve((size_t)R * DIN * 2);
  bf16_t* qbuf = P;
  bf16_t* Wt_in = (bf16_t*)carve((size_t)2 * DIN * D * 2);
  bf16_t* Wt_out = (bf16_t*)carve((size_t)2 * D * D * 2);
  bf16_t* Wt_q = (bf16_t*)carve((size_t)2 * 2048 * D * 2);
  PrepOut po;
  po.QA = (bf16_t*)carve((size_t)NB * 8 * NT * 32 * 2);
  po.KA = (bf16_t*)carve((size_t)NB * 8 * NT * 32 * 2);
  po.VAt = (bf16_t*)carve((size_t)NB * 4 * 64 * NT * 2);
  po.QW = (bf16_t*)carve((size_t)NB * 4 * NT * 64 * 2);
  po.KW = (bf16_t*)carve((size_t)NB * 2 * NT * 64 * 2);
  po.VWt = (bf16_t*)carve((size_t)NB * 2 * 64 * NT * 2);
  po.QG = (bf16_t*)carve((size_t)NB * 4 * NT * 64 * 2);
  po.KG = (bf16_t*)carve((size_t)NB * 2 * NT * 64 * 2);
  po.VGt = (bf16_t*)carve((size_t)NB * 2 * 64 * NT * 2);
  po.uT = (float*)carve((size_t)NB * 768 * NT * 4);
  float* zT = (float*)carve((size_t)NB * 256 * NT * 4);
  float* yT = (float*)carve((size_t)NB * 256 * NT * 4);
  float* hdn2 = (float*)carve((size_t)2 * SEQ * 64 * 4);
  float* kc = (float*)carve((KC_W0 + (size_t)2 * 256 * 2 * CTX) * 4);
  bf16_t* A2 = (bf16_t*)carve((size_t)R * D * 2);
  float* Otmp = (float*)P;
  if (off > ws_size) return; (void)in_sizes; (void)n_in; (void)out_size;

  k_mod<<<dim3(NMOD / 256, 2), 256, 0, stream>>>(c, c_ctx, w_mod, b_mod, modv);
  constexpr int GEMM_LDS = 128 * 132 * 4;
  hipFuncSetAttribute((const void*)k_gemm<0>, hipFuncAttributeMaxDynamicSharedMemorySize, GEMM_LDS);
  hipFuncSetAttribute((const void*)k_gemm<1>, hipFuncAttributeMaxDynamicSharedMemorySize, GEMM_LDS);
  for (int l = 0; l < 2; ++l) {
    k_wconv<<<256, NTHR, 0, stream>>>(w_in + (size_t)l * D * DIN, Wt_in + (size_t)l * DIN * D, DIN);
    k_wconv<<<256, NTHR, 0, stream>>>(w_out + (size_t)l * D * D, Wt_out + (size_t)l * D * D, D);
    k_wconv<<<256, NTHR, 0, stream>>>(peer_wq + (size_t)l * D * 2048, Wt_q + (size_t)l * 2048 * D, 2048);
  }
  k_init_xs<<<R, 256, 0, stream>>>(x, ctx, xs);

  for (int l = 0; l < 2; ++l) {
    int want_ctx = l < 1 ? 1 : 0;
    float lambda_init = 0.8f - 0.6f * expf(-0.3f * (float)l);
    const float* modv_l = modv + (size_t)l * 3 * NMOD;
    k_norm_mod<<<R, 256, 0, stream>>>(xs, g_norm_mix + l * D, modv_l, 0, hbuf);
    k_gemm<0><<<256, NTHR, GEMM_LDS, stream>>>(hbuf, Wt_in + (size_t)l * DIN * D, DIN, P, nullptr, nullptr);
    k_prep<<<R, 256, 0, stream>>>(P, g_qk_diff + l * 64, g_qk_win + l * 128, g_qk_glob + l * 128, hy_conv_w + l * 3 * 768,
                                  hy_conv_b + l * 768, po);
    k_attn_naive<0><<<NB * 8 * NT / 256, 256, 0, stream>>>(po.QA, po.KA, po.VAt, g_qk_diff + l * 64, nullptr, Otmp, want_ctx);
    k_attn_naive<1><<<NB * 4 * NT / 256, 256, 0, stream>>>(po.QW, po.KW, po.VWt, g_qk_win + l * 128, sink_win + l * 4, Otmp, want_ctx);
    k_attn_naive<2><<<NB * 4 * NT / 256, 256, 0, stream>>>(po.QG, po.KG, po.VGt, g_qk_glob + l * 128, nullptr, Otmp, want_ctx);
    k_attn_finish<<<NB * 12 * NT / 256, 256, 0, stream>>>(Otmp, lambda_diff + l * 128, lambda_init, g_mix_out + l * D, A2, want_ctx);
    k_hy_mlp<<<SEQ + CTX, 64, 0, stream>>>(hy_w1 + l * 33 * 64, hy_b1 + l * 64, hy_w2 + l * 64 * 64, hy_b2 + l * 64, hy_freq + l * 64, hdn2);
    k_hy_filt<<<dim3(256, 2, 2), 256, 0, stream>>>(hdn2, hy_w3 + (size_t)l * 64 * 1024, hy_b3 + l * 1024, kc, want_ctx);
    k_hy_conv<0><<<dim3(SEQ / 256, 256, NB), 256, 0, stream>>>(po.uT, nullptr, zT, kc, hy_bias + l * 512, 0);
    k_hy_conv<1><<<dim3(SEQ / 256, 256, NB), 256, 0, stream>>>(po.uT, zT, yT, kc, hy_bias + l * 512, 0);
    if (want_ctx) {
      k_hy_conv<0><<<dim3(CTX / 256, 256, NB), 256, 0, stream>>>(po.uT, nullptr, zT, kc, hy_bias + l * 512, 1);
      k_hy_conv<1><<<dim3(CTX / 256, 256, NB), 256, 0, stream>>>(po.uT, zT, yT, kc, hy_bias + l * 512, 1);
    }
    k_hy_fin<<<NB * 4 * NT / 256, 256, 0, stream>>>(yT, g_mix_out + l * D, A2, want_ctx);
    k_gemm<1><<<256, NTHR, GEMM_LDS, stream>>>(A2, Wt_out + (size_t)l * D * D, D, nullptr, xs, modv_l + 2 * D);
    k_norm_mod<<<R, 256, 0, stream>>>(xs, g_norm_ffn + l * D, modv_l, 3, hbuf);
    k_gemm<0><<<256, NTHR, GEMM_LDS, stream>>>(hbuf, Wt_q + (size_t)l * 2048 * D, 2048, qbuf, nullptr, nullptr);
    k_peer_naive<<<R, 256, 0, stream>>>(qbuf, hbuf, peer_keys + (size_t)l * 16 * 128 * 128, peer_u + (size_t)l * 16384 * D,
                                        peer_v + (size_t)l * 16384 * D, modv_l, xs, want_ctx);
  }
  k_final<<<NB * SEQ, 256, 0, stream>>>(xs, out);
}
```

```cpp
#include <hip/hip_runtime.h>
#include <stdint.h>
#include <string.h>

#define DI __device__ __forceinline__
typedef unsigned short bf16_t;

constexpr int D = 1024;
constexpr int NB = 2;
constexpr int SEQ = 8192;
constexpr int CTX = 256;
constexpr int NT = SEQ + CTX;
constexpr int R = NB * NT;
constexpr int DIN = 2560;
constexpr int NMOD = 6 * D;
constexpr float EPS = 1e-6f;
constexpr float LOG2E = 1.4426950408889634f;

DI bf16_t f2bf(float x) { unsigned u = __float_as_uint(x); u += 0x7fffu + ((u >> 16) & 1u); return (bf16_t)(u >> 16); }
DI float bf2f(bf16_t h) { return __uint_as_float(((unsigned)h) << 16); }
DI float bflo(unsigned w) { return __uint_as_float(w << 16); }
DI float bfhi(unsigned w) { return __uint_as_float(w & 0xffff0000u); }

DI float block_sum_256(float v, float* red) {
  for (int o = 32; o > 0; o >>= 1) v += __shfl_xor(v, o);
  int w = threadIdx.x >> 6;
  __syncthreads();
  if ((threadIdx.x & 63) == 0) red[w] = v;
  __syncthreads();
  float s = red[0] + red[1] + red[2] + red[3];
  return s;
}

__global__ __launch_bounds__(256) void k_mod(const float* __restrict__ c, const float* __restrict__ c_ctx,
                                             const float* __restrict__ w_mod, const float* __restrict__ b_mod,
                                             float* __restrict__ modv) {
  __shared__ float sc[3][D];
  int l = blockIdx.y;
  for (int i = threadIdx.x; i < 3 * D; i += 256) {
    int row = i / D, k = i % D;
    float v = row < 2 ? c[row * D + k] : c_ctx[k];
    sc[row][k] = v / (1.f + __expf(-v));
  }
  __syncthreads();
  int col = blockIdx.x * 256 + threadIdx.x;
  const float* w = w_mod + (size_t)l * D * NMOD + col;
  float a0 = 0, a1 = 0, a2 = 0;
  for (int k = 0; k < D; ++k) {
    float wv = w[(size_t)k * NMOD];
    a0 += sc[0][k] * wv; a1 += sc[1][k] * wv; a2 += sc[2][k] * wv;
  }
  float bb = b_mod[l * NMOD + col];
  modv[(l * 3 + 0) * NMOD + col] = a0 + bb;
  modv[(l * 3 + 1) * NMOD + col] = a1 + bb;
  modv[(l * 3 + 2) * NMOD + col] = a2 + bb;
}

__global__ __launch_bounds__(256) void k_init_xs(const float* __restrict__ x, const float* __restrict__ ctx, float* __restrict__ xs) {
  int r = blockIdx.x; int b = r / NT, p = r % NT;
  const float4* src = (const float4*)(p < CTX ? ctx + ((size_t)b * CTX + p) * D : x + ((size_t)b * SEQ + (p - CTX)) * D);
  ((float4*)(xs + (size_t)r * D))[threadIdx.x] = src[threadIdx.x];
}
__global__ __launch_bounds__(256) void k_final(const float* __restrict__ xs, float* __restrict__ out) {
  int i = blockIdx.x; int b = i / SEQ, t = i % SEQ;
  ((float4*)(out + (size_t)i * D))[threadIdx.x] = ((const float4*)(xs + ((size_t)b * NT + CTX + t) * D))[threadIdx.x];
}

__global__ __launch_bounds__(256) void k_norm_mod(const float* __restrict__ xs, const float* __restrict__ g,
                                                  const float* __restrict__ modv_l, int sh_chunk, bf16_t* __restrict__ hbuf) {
  __shared__ float red[8];
  int r = blockIdx.x; int b = r / NT, p = r % NT; int mrow = p < CTX ? 2 : b;
  float4 v = ((const float4*)(xs + (size_t)r * D))[threadIdx.x];
  float ss = v.x * v.x + v.y * v.y + v.z * v.z + v.w * v.w;
  ss = block_sum_256(ss, red);
  float rs = rsqrtf(ss * (1.f / D) + EPS);
  int c0 = threadIdx.x * 4;
  const float* sh = modv_l + mrow * NMOD + sh_chunk * D;
  const float* sc = sh + D;
  float o[4] = {v.x, v.y, v.z, v.w};
  bf16_t ob[4];
  for (int j = 0; j < 4; ++j) ob[j] = f2bf(o[j] * rs * g[c0 + j] * (1.f + sc[c0 + j]) + sh[c0 + j]);
  uint2 pk; pk.x = ob[0] | ((unsigned)ob[1] << 16); pk.y = ob[2] | ((unsigned)ob[3] << 16);
  ((uint2*)(hbuf + (size_t)r * D))[threadIdx.x] = pk;
}

template <int MODE>
__global__ __launch_bounds__(256) void k_gemm_naive(const bf16_t* __restrict__ A, const float* __restrict__ B, float* __restrict__ C,
                                                    int M, int N, int K, const float* __restrict__ gate_base) {
  __shared__ float As[16][68];
  __shared__ float Bs[16][68];
  int bm = blockIdx.y * 64, bn = blockIdx.x * 64;
  int tx = threadIdx.x & 15, ty = threadIdx.x >> 4;
  float acc[4][4];
  for (int i = 0; i < 4; ++i) for (int j = 0; j < 4; ++j) acc[i][j] = 0.f;
  int arow = threadIdx.x >> 2, akq = (threadIdx.x & 3) * 4;
  int brow = threadIdx.x >> 4, bcol = (threadIdx.x & 15) * 4;
  for (int k0 = 0; k0 < K; k0 += 16) {
    uint2 av = *(const uint2*)(A + (size_t)(bm + arow) * K + k0 + akq);
    float4 bv = *(const float4*)(B + (size_t)(k0 + brow) * N + bn + bcol);
    __syncthreads();
    As[akq + 0][arow] = bflo(av.x); As[akq + 1][arow] = bfhi(av.x);
    As[akq + 2][arow] = bflo(av.y); As[akq + 3][arow] = bfhi(av.y);
    *(float4*)&Bs[brow][bcol] = bv;
    __syncthreads();
#pragma unroll
    for (int kk = 0; kk < 16; ++kk) {
      float4 a = *(const float4*)&As[kk][ty * 4];
      float4 bq = *(const float4*)&Bs[kk][tx * 4];
      float aa[4] = {a.x, a.y, a.z, a.w}, bb[4] = {bq.x, bq.y, bq.z, bq.w};
#pragma unroll
      for (int i = 0; i < 4; ++i)
#pragma unroll
        for (int j = 0; j < 4; ++j) acc[i][j] += aa[i] * bb[j];
    }
  }
#pragma unroll
  for (int i = 0; i < 4; ++i) {
    int r = bm + ty * 4 + i;
    int n = bn + tx * 4;
    if (MODE == 0) {
      *(float4*)(C + (size_t)r * N + n) = make_float4(acc[i][0], acc[i][1], acc[i][2], acc[i][3]);
    } else {
      int b = r / NT, p = r % NT; int mrow = p < CTX ? 2 : b;
      const float* gt = gate_base + mrow * NMOD + n;
      float4 xv = *(float4*)(C + (size_t)r * N + n);
      xv.x += gt[0] * acc[i][0]; xv.y += gt[1] * acc[i][1]; xv.z += gt[2] * acc[i][2]; xv.w += gt[3] * acc[i][3];
      *(float4*)(C + (size_t)r * N + n) = xv;
    }
  }
}

struct PrepOut {
  bf16_t *QA, *KA, *VAt, *QW, *KW, *VWt, *QG, *KG, *VGt;
  float* uT;
};
DI int perm16(int o) { return (o & 3) | ((o & 4) << 1) | ((o & 8) >> 1); }

template <int DQK>
DI void prep_unit(const float* src, const float* gain, const float* cs, const float* sn, bool lat, float scale, bf16_t* dst) {
  float ss = 0.f;
  for (int d = 0; d < DQK; ++d) ss += src[d] * src[d];
  float rs = rsqrtf(ss * (1.f / DQK) + EPS);
  constexpr int H = DQK / 2;
  for (int d = 0; d < H; ++d) {
    float x1 = src[d] * rs * gain[d], x2 = src[d + H] * rs * gain[d + H];
    float y1 = x1, y2 = x2;
    if (lat) { y1 = x1 * cs[d] - x2 * sn[d]; y2 = x1 * sn[d] + x2 * cs[d]; }
    dst[d] = f2bf(y1 * scale); dst[d + H] = f2bf(y2 * scale);
  }
}

__global__ __launch_bounds__(256) void k_prep(const bf16_t* __restrict__ P, const float* __restrict__ g_qk_diff, const float* __restrict__ g_qk_win,
                                              const float* __restrict__ g_qk_glob, const float* __restrict__ conv_w, const float* __restrict__ conv_b,
                                              PrepOut o) {
  __shared__ float row[1792];
  __shared__ float csh[16], snh[16], csf[32], snf[32];
  int r = blockIdx.x; int b = r / NT, p = r % NT; bool lat = p >= CTX; int t = p - CTX;
  const bf16_t* Pr = P + (size_t)r * DIN;
  for (int i = threadIdx.x; i < 1792; i += 256) row[i] = bf2f(Pr[i]);
  if (threadIdx.x < 48 && lat) {
    float trow = (float)(t / 64), tcol = (float)(t % 64);
    int i = threadIdx.x;
    if (i < 16) {
      int j = i & 7; float f = exp2f(-(float)j * (13.287712379549449f / 8.f));
      float a = (i < 8 ? trow : tcol) * f;
      csh[i] = cosf(a); snh[i] = sinf(a);
    } else {
      int ii = i - 16; int j = ii & 15; float f = exp2f(-(float)j * (13.287712379549449f / 16.f));
      float a = (ii < 16 ? trow : tcol) * f;
      csf[ii] = cosf(a); snf[ii] = sinf(a);
    }
  }
  __syncthreads();
  int u = threadIdx.x;
  if (u < 8) {
    prep_unit<32>(row + u * 32, g_qk_diff, csh, snh, lat, 0.17677669529663687f * LOG2E, o.QA + (((size_t)b * 8 + u) * NT + p) * 32);
  } else if (u < 16) {
    int vh = u - 8;
    prep_unit<32>(row + 256 + vh * 32, g_qk_diff + 32, csh, snh, lat, 1.f, o.KA + (((size_t)b * 8 + vh) * NT + p) * 32);
  } else if (u < 20) {
    int h = u - 16;
    prep_unit<64>(row + 768 + h * 64, g_qk_win, csf, snf, lat, 0.125f * LOG2E, o.QW + (((size_t)b * 4 + h) * NT + p) * 64);
  } else if (u < 22) {
    int h = u - 20;
    prep_unit<64>(row + 768 + 256 + h * 64, g_qk_win + 64, csf, snf, lat, 1.f, o.KW + (((size_t)b * 2 + h) * NT + p) * 64);
  } else if (u < 26) {
    int h = u - 22;
    prep_unit<64>(row + 1280 + h * 64, g_qk_glob, csf, snf, lat, 0.125f * LOG2E, o.QG + (((size_t)b * 4 + h) * NT + p) * 64);
  } else if (u < 28) {
    int h = u - 26;
    prep_unit<64>(row + 1280 + 256 + h * 64, g_qk_glob + 64, csf, snf, lat, 1.f, o.KG + (((size_t)b * 2 + h) * NT + p) * 64);
  }
  int pp = (p & ~15) + perm16(p & 15);
  {
    int c = threadIdx.x;
    o.VAt[(((size_t)b * 4 + c / 64) * 64 + (c % 64)) * NT + pp] = f2bf(row[512 + c]);
    if (c < 128) {
      o.VWt[(((size_t)b * 2 + c / 64) * 64 + (c % 64)) * NT + pp] = f2bf(row[768 + 384 + c]);
    } else {
      int c2 = c - 128;
      o.VGt[(((size_t)b * 2 + c2 / 64) * 64 + (c2 % 64)) * NT + pp] = f2bf(row[1280 + 384 + c2]);
    }
  }
  bool hasp = lat ? (t > 0) : (p > 0);
  bool hasn = lat ? (t < SEQ - 1) : (p < CTX - 1);
  for (int c = threadIdx.x; c < 768; c += 256) {
    float v = bf2f(Pr[1792 + c]) * conv_w[768 + c] + conv_b[c];
    if (hasp) v += bf2f(Pr[1792 + c - DIN]) * conv_w[c];
    if (hasn) v += bf2f(Pr[1792 + c + DIN]) * conv_w[2 * 768 + c];
    o.uT[((size_t)b * 768 + c) * NT + p] = v;
  }
}

template <int DQK>
DI void attn_accum(const float* q, const bf16_t* __restrict__ Kb, const bf16_t* __restrict__ Vt, int g0, int g1, int lo, int hi,
                   float M2, float& l, float* o) {
  for (int kg = g0; kg < g1; kg += 16) {
    float pw[16];
#pragma unroll
    for (int pos = 0; pos < 16; ++pos) {
      int k = kg + perm16(pos);
      const uint4* kr = (const uint4*)(Kb + (size_t)k * DQK);
      float s = 0.f;
#pragma unroll
      for (int c = 0; c < DQK / 8; ++c) {
        uint4 w = kr[c];
        s += q[c * 8 + 0] * bflo(w.x) + q[c * 8 + 1] * bfhi(w.x) + q[c * 8 + 2] * bflo(w.y) + q[c * 8 + 3] * bfhi(w.y) +
             q[c * 8 + 4] * bflo(w.z) + q[c * 8 + 5] * bfhi(w.z) + q[c * 8 + 6] * bflo(w.w) + q[c * 8 + 7] * bfhi(w.w);
      }
      float e = exp2f(s - M2);
      pw[pos] = (k >= lo && k <= hi) ? e : 0.f;
      l += pw[pos];
      if ((pos & 3) == 3) asm volatile("" ::: "memory");
    }
#pragma unroll
    for (int dv = 0; dv < 64; ++dv) {
      const uint4* vr = (const uint4*)(Vt + (size_t)dv * NT + kg);
      uint4 w0 = vr[0], w1 = vr[1];
      o[dv] += pw[0] * bflo(w0.x) + pw[1] * bfhi(w0.x) + pw[2] * bflo(w0.y) + pw[3] * bfhi(w0.y) + pw[4] * bflo(w0.z) +
               pw[5] * bfhi(w0.z) + pw[6] * bflo(w0.w) + pw[7] * bfhi(w0.w) + pw[8] * bflo(w1.x) + pw[9] * bfhi(w1.x) +
               pw[10] * bflo(w1.y) + pw[11] * bfhi(w1.y) + pw[12] * bflo(w1.z) + pw[13] * bfhi(w1.z) + pw[14] * bflo(w1.w) +
               pw[15] * bfhi(w1.w);
      if ((dv & 3) == 3) asm volatile("" ::: "memory");
    }
  }
}

template <int TYPE>
__global__ __launch_bounds__(256) void k_attn_naive(const bf16_t* __restrict__ Q, const bf16_t* __restrict__ K, const bf16_t* __restrict__ Vt,
                                                    const float* __restrict__ gqk, const float* __restrict__ sink, float* __restrict__ Otmp,
                                                    int want_ctx) {
  constexpr int DQK = TYPE == 0 ? 32 : 64;
  constexpr int HQ = TYPE == 0 ? 8 : 4;
  constexpr int HK = TYPE == 0 ? 8 : 2;
  constexpr int HV = TYPE == 0 ? 4 : 2;
  constexpr int SLOT0 = TYPE == 0 ? 0 : (TYPE == 1 ? 8 : 12);
  int idx = blockIdx.x * 256 + threadIdx.x;
  int p = idx % NT; int h = (idx / NT) % HQ; int b = idx / (NT * HQ);
  if (p < CTX && !want_ctx) return;
  float gq = 0.f, gk = 0.f;
  for (int d = 0; d < DQK; ++d) { gq = fmaxf(gq, fabsf(gqk[d])); gk = fmaxf(gk, fabsf(gqk[DQK + d])); }
  float M2 = sqrtf((float)DQK) * gq * gk * LOG2E;
  int kh = TYPE == 0 ? h : h / 2, vh = h / 2;
  const bf16_t* Kb = K + ((size_t)b * HK + kh) * NT * DQK;
  const bf16_t* Vb = Vt + ((size_t)b * HV + vh) * 64 * NT;
  float q[DQK];
  {
    const uint4* qr = (const uint4*)(Q + (((size_t)b * HQ + h) * NT + p) * DQK);
#pragma unroll
    for (int c = 0; c < DQK / 8; ++c) {
      uint4 w = qr[c];
      q[c * 8 + 0] = bflo(w.x); q[c * 8 + 1] = bfhi(w.x); q[c * 8 + 2] = bflo(w.y); q[c * 8 + 3] = bfhi(w.y);
      q[c * 8 + 4] = bflo(w.z); q[c * 8 + 5] = bfhi(w.z); q[c * 8 + 6] = bflo(w.w); q[c * 8 + 7] = bfhi(w.w);
    }
  }
  float o[64];
#pragma unroll
  for (int i = 0; i < 64; ++i) o[i] = 0.f;
  float l = 0.f;
#pragma unroll 1
  for (int seg = 0; seg < 2; ++seg) {
    int g0 = 0, g1 = CTX, lo = 0, hi = CTX - 1;
    if (seg == 1) {
      if (p < CTX) break;
      if (TYPE == 1) { lo = max(CTX, p - 128); hi = min(NT - 1, p + 128); g0 = lo & ~15; g1 = (hi & ~15) + 16; }
      else { lo = CTX; hi = NT - 1; g0 = CTX; g1 = NT; }
    }
    attn_accum<DQK>(q, Kb, Vb, g0, g1, lo, hi, M2, l, o);
  }
  if (TYPE == 1) l += exp2f(sink[h] * LOG2E - M2);
  float inv = 1.f / l;
  float4* dst = (float4*)(Otmp + ((((size_t)b * 16 + SLOT0 + h) * NT) + p) * 64);
#pragma unroll
  for (int i = 0; i < 16; ++i) dst[i] = make_float4(o[4 * i] * inv, o[4 * i + 1] * inv, o[4 * i + 2] * inv, o[4 * i + 3] * inv);
}

__global__ __launch_bounds__(256) void k_attn_finish(const float* __restrict__ Otmp, const float* __restrict__ lambda_diff, float lambda_init,
                                                     const float* __restrict__ g_mix_out, bf16_t* __restrict__ A2, int want_ctx) {
  int idx = blockIdx.x * 256 + threadIdx.x;
  int p = idx % NT; int oh = (idx / NT) % 12; int b = idx / (NT * 12);
  if (p < CTX && !want_ctx) return;
  float o[64];
  float hs = 1.f;
  if (oh < 4) {
    float s0 = 0.f, s1 = 0.f;
    for (int d = 0; d < 32; ++d) { s0 += lambda_diff[d] * lambda_diff[32 + d]; s1 += lambda_diff[64 + d] * lambda_diff[96 + d]; }
    float lam = __expf(s0) - __expf(s1) + lambda_init;
    const float4* a = (const float4*)(Otmp + ((((size_t)b * 16 + 2 * oh) * NT) + p) * 64);
    const float4* c = (const float4*)(Otmp + ((((size_t)b * 16 + 2 * oh + 1) * NT) + p) * 64);
#pragma unroll
    for (int i = 0; i < 16; ++i) {
      float4 x = a[i], y = c[i];
      o[4 * i] = x.x - lam * y.x; o[4 * i + 1] = x.y - lam * y.y; o[4 * i + 2] = x.z - lam * y.z; o[4 * i + 3] = x.w - lam * y.w;
    }
    hs = 1.f - lambda_init;
  } else {
    const float4* a = (const float4*)(Otmp + ((((size_t)b * 16 + 4 + oh) * NT) + p) * 64);
#pragma unroll
    for (int i = 0; i < 16; ++i) { float4 x = a[i]; o[4 * i] = x.x; o[4 * i + 1] = x.y; o[4 * i + 2] = x.z; o[4 * i + 3] = x.w; }
  }
  float ss = 0.f;
#pragma unroll
  for (int i = 0; i < 64; ++i) ss += o[i] * o[i];
  float rs = rsqrtf(ss * (1.f / 64) + EPS) * hs;
  const float* g = g_mix_out + oh * 64;
  uint4* dst = (uint4*)(A2 + ((size_t)b * NT + p) * D + oh * 64);
#pragma unroll
  for (int i = 0; i < 8; ++i) {
    unsigned w[4];
#pragma unroll
    for (int j = 0; j < 4; ++j) {
      int e = i * 8 + j * 2;
      w[j] = (unsigned)f2bf(o[e] * rs * g[e]) | ((unsigned)f2bf(o[e + 1] * rs * g[e + 1]) << 16);
    }
    dst[i] = make_uint4(w[0], w[1], w[2], w[3]);
  }
}

__global__ __launch_bounds__(64) void k_hy_mlp(const float* __restrict__ w1, const float* __restrict__ b1, const float* __restrict__ w2,
                                               const float* __restrict__ b2, const float* __restrict__ freq, float* __restrict__ hdn2) {
  __shared__ float feat[33];
  __shared__ float h1[64];
  int which = blockIdx.x >= SEQ ? 1 : 0;
  int j = which ? blockIdx.x - SEQ : blockIdx.x;
  int n = which ? CTX : SEQ;
  int u = threadIdx.x;
  float tt = (float)j / (float)(n - 1);
  float w = (6.283185307179586f / (float)n) * (float)j;
  if (u == 0) feat[0] = tt;
  if (u < 16) {
    float f = 1e-4f + (float)u * ((15.f - 1e-4f) / 15.f);
    feat[1 + u] = cosf(f * w);
    feat[17 + u] = -sinf(f * w);
  }
  __syncthreads();
  float a = b1[u];
  for (int i = 0; i < 33; ++i) a += feat[i] * w1[i * 64 + u];
  h1[u] = sinf(freq[u] * a);
  __syncthreads();
  float a2 = b2[u];
  for (int i = 0; i < 64; ++i) a2 += h1[i] * w2[i * 64 + u];
  hdn2[((size_t)which * SEQ + j) * 64 + u] = sinf(freq[u] * a2);
}

constexpr size_t KC_W0 = (size_t)2 * 256 * 2 * SEQ;
DI size_t kc_off(int which, int order, int c) {
  return which ? KC_W0 + ((size_t)order * 256 + c) * 2 * CTX : ((size_t)order * 256 + c) * 2 * SEQ;
}
__global__ __launch_bounds__(256) void k_hy_filt(const float* __restrict__ hdn2, const float* __restrict__ w3, const float* __restrict__ b3,
                                                 float* __restrict__ kc, int want_ctx) {
  __shared__ float wc[2][64];
  __shared__ float red[8];
  int c = blockIdx.x, order = blockIdx.y, which = blockIdx.z;
  if (which && !want_ctx) return;
  int n = which ? CTX : SEQ;
  int col0 = order * 512 + c, col1 = col0 + 256;
  if (threadIdx.x < 64) wc[0][threadIdx.x] = w3[threadIdx.x * 1024 + col0];
  else if (threadIdx.x < 128) wc[1][threadIdx.x - 64] = w3[(threadIdx.x - 64) * 1024 + col1];
  __syncthreads();
  float delta = fabsf(-3.0701134573253944f + (float)c * ((-15.350567286626972f + 3.0701134573253944f) / 255.f));
  float* out = kc + kc_off(which, order, c);
  float asum = 0.f;
  float bb0 = b3[col0], bb1 = b3[col1];
  for (int j = threadIdx.x; j < n; j += 256) {
    const float4* hr = (const float4*)(hdn2 + ((size_t)which * SEQ + j) * 64);
    float f0 = bb0, f1 = bb1;
#pragma unroll
    for (int i = 0; i < 16; ++i) {
      float4 hv = hr[i];
      f0 += hv.x * wc[0][4 * i] + hv.y * wc[0][4 * i + 1] + hv.z * wc[0][4 * i + 2] + hv.w * wc[0][4 * i + 3];
      f1 += hv.x * wc[1][4 * i] + hv.y * wc[1][4 * i + 1] + hv.z * wc[1][4 * i + 2] + hv.w * wc[1][4 * i + 3];
    }
    float tt = (float)j / (float)(n - 1);
    float dec = __expf(-tt * delta);
    f0 *= dec; f1 *= dec;
    out[n + j] = f0;
    asum += fabsf(f0);
    if (j > 0) { out[n - j] = f1; asum += fabsf(f1); }
    else out[0] = 0.f;
  }
  asum = block_sum_256(asum, red);
  float inv = 1.f / asum;
  __syncthreads();
  for (int j = threadIdx.x; j < 2 * n; j += 256) out[j] *= inv;
}

template <int ORDER>
__global__ __launch_bounds__(256) void k_hy_conv(const float* __restrict__ uT, const float* __restrict__ zin, float* __restrict__ zout,
                                                 const float* __restrict__ kc, const float* __restrict__ hy_bias, int which) {
  __shared__ float zs[256];
  int n = which ? CTX : SEQ;
  int off = which ? 0 : CTX;
  int chunk = blockIdx.x, c = blockIdx.y, b = blockIdx.z;
  int t = chunk * 256 + threadIdx.x;
  const float* in = (ORDER == 0 ? uT + ((size_t)b * 768 + c) * NT : zin + ((size_t)b * 256 + c) * NT) + off;
  const float* kk = kc + kc_off(which, ORDER, c) + n + t;
  float acc = 0.f;
  for (int s0 = 0; s0 < n; s0 += 256) {
    __syncthreads();
    zs[threadIdx.x] = in[s0 + threadIdx.x];
    __syncthreads();
    const float* kp = kk - s0;
#pragma unroll 8
    for (int ss = 0; ss < 256; ++ss) acc += zs[ss] * kp[-ss];
  }
  float self = in[t];
  float gatev = uT[((size_t)b * 768 + (ORDER == 0 ? 256 : 512) + c) * NT + off + t];
  float res = gatev * (acc + hy_bias[ORDER * 256 + c] * self);
  zout[((size_t)b * 256 + c) * NT + off + t] = res;
}

__global__ __launch_bounds__(256) void k_hy_fin(const float* __restrict__ yT, const float* __restrict__ g_mix_out, bf16_t* __restrict__ A2,
                                                int want_ctx) {
  int idx = blockIdx.x * 256 + threadIdx.x;
  int p = idx % NT; int g = (idx / NT) % 4; int b = idx / (NT * 4);
  if (p < CTX && !want_ctx) return;
  float v[64];
  float ss = 0.f;
#pragma unroll
  for (int i = 0; i < 64; ++i) { v[i] = yT[((size_t)b * 256 + g * 64 + i) * NT + p]; ss += v[i] * v[i]; }
  float rs = rsqrtf(ss * (1.f / 64) + EPS);
  const float* gm = g_mix_out + 768 + g * 64;
  uint4* dst = (uint4*)(A2 + ((size_t)b * NT + p) * D + 768 + g * 64);
#pragma unroll
  for (int i = 0; i < 8; ++i) {
    unsigned w[4];
#pragma unroll
    for (int j = 0; j < 4; ++j) {
      int e = i * 8 + j * 2;
      w[j] = (unsigned)f2bf(v[e] * rs * gm[e]) | ((unsigned)f2bf(v[e + 1] * rs * gm[e + 1]) << 16);
    }
    dst[i] = make_uint4(w[0], w[1], w[2], w[3]);
  }
}

__global__ __launch_bounds__(256) void k_peer_naive(const bf16_t* __restrict__ qbuf, const bf16_t* __restrict__ hbuf, const float* __restrict__ keys,
                                                    const float* __restrict__ ut, const float* __restrict__ vt, const float* __restrict__ modv_l,
                                                    float* __restrict__ xs, int want_ctx) {
  __shared__ float qs[2048];
  __shared__ float sc[16 * 128];
  __shared__ float topv[16][16];
  __shared__ int topi[16][16];
  __shared__ float cand[8][256];
  __shared__ int elist[128];
  __shared__ float glist[128];
  __shared__ float wl[128];
  int r = blockIdx.x; int b = r / NT, p = r % NT;
  if (p < CTX && !want_ctx) return;
  int tid = threadIdx.x;
  {
    uint4 w = ((const uint4*)(qbuf + (size_t)r * 2048))[tid];
    float* qd = qs + tid * 8;
    qd[0] = bflo(w.x); qd[1] = bfhi(w.x); qd[2] = bflo(w.y); qd[3] = bfhi(w.y); qd[4] = bflo(w.z); qd[5] = bfhi(w.z); qd[6] = bflo(w.w); qd[7] = bfhi(w.w);
  }
  __syncthreads();
  for (int i = 0; i < 8; ++i) {
    int sidx = tid + 256 * i;
    int hp = sidx >> 7;
    const float4* kr = (const float4*)(keys + (size_t)sidx * 128);
    const float4* qq = (const float4*)(qs + hp * 128);
    float s = 0.f;
    for (int d = 0; d < 32; ++d) { float4 a = kr[d], q4 = qq[d]; s += a.x * q4.x + a.y * q4.y + a.z * q4.z + a.w * q4.w; }
    sc[sidx] = s;
  }
  __syncthreads();
  if (tid < 16) {
    float* row = sc + tid * 128;
    for (int k = 0; k < 16; ++k) {
      float best = -3.0e38f; int bi = 0;
      for (int j = 0; j < 128; ++j) { float v = row[j]; if (v > best) { best = v; bi = j; } }
      topv[tid][k] = best; topi[tid][k] = bi; row[bi] = -3.0e38f;
    }
  }
  __syncthreads();
  for (int i = tid; i < 8 * 256; i += 256) {
    int h = i >> 8, ab = i & 255;
    cand[h][ab] = topv[2 * h][ab >> 4] + topv[2 * h + 1][ab & 15];
  }
  __syncthreads();
  if (tid < 8) {
    float* row = cand[tid];
    float mx = -3.0e38f;
    for (int k = 0; k < 16; ++k) {
      float best = -3.0e38f; int bi = 0;
      for (int j = 0; j < 256; ++j) { float v = row[j]; if (v > best) { best = v; bi = j; } }
      row[bi] = -3.0e38f;
      elist[tid * 16 + k] = topi[2 * tid][bi >> 4] * 128 + topi[2 * tid + 1][bi & 15];
      glist[tid * 16 + k] = best;
      if (k == 0) mx = best;
    }
    float sum = 0.f;
    for (int k = 0; k < 16; ++k) { float e = __expf(glist[tid * 16 + k] - mx); glist[tid * 16 + k] = e; sum += e; }
    float inv = 1.f / sum;
    for (int k = 0; k < 16; ++k) glist[tid * 16 + k] *= inv;
  }
  __syncthreads();
  {
    int lane = tid & 63, w = tid >> 6;
    float xv[16];
    const uint4* hr = (const uint4*)(hbuf + (size_t)r * D + lane * 16);
    uint4 a = hr[0], c = hr[1];
    xv[0] = bflo(a.x); xv[1] = bfhi(a.x); xv[2] = bflo(a.y); xv[3] = bfhi(a.y); xv[4] = bflo(a.z); xv[5] = bfhi(a.z); xv[6] = bflo(a.w); xv[7] = bfhi(a.w);
    xv[8] = bflo(c.x); xv[9] = bfhi(c.x); xv[10] = bflo(c.y); xv[11] = bfhi(c.y); xv[12] = bflo(c.z); xv[13] = bfhi(c.z); xv[14] = bflo(c.w); xv[15] = bfhi(c.w);
    for (int e = 0; e < 32; ++e) {
      int ei = w * 32 + e;
      const float4* ur = (const float4*)(ut + (size_t)elist[ei] * D + lane * 16);
      float s = 0.f;
#pragma unroll
      for (int j = 0; j < 4; ++j) { float4 uu = ur[j]; s += uu.x * xv[4 * j] + uu.y * xv[4 * j + 1] + uu.z * xv[4 * j + 2] + uu.w * xv[4 * j + 3]; }
      for (int o = 32; o > 0; o >>= 1) s += __shfl_xor(s, o);
      if (lane == 0) {
        float g = 0.5f * s * (1.f + tanhf(0.7978845608028654f * (s + 0.044715f * s * s * s)));
        wl[ei] = glist[ei] * g;
      }
    }
  }
  __syncthreads();
  float4 acc = make_float4(0.f, 0.f, 0.f, 0.f);
  for (int e = 0; e < 128; ++e) {
    float wv = wl[e];
    float4 vv = ((const float4*)(vt + (size_t)elist[e] * D))[tid];
    acc.x += wv * vv.x; acc.y += wv * vv.y; acc.z += wv * vv.z; acc.w += wv * vv.w;
  }
  int mrow = p < CTX ? 2 : b;
  const float* g2 = modv_l + mrow * NMOD + 5 * D + tid * 4;
  float4 xv = ((float4*)(xs + (size_t)r * D))[tid];
  xv.x += g2[0] * acc.x; xv.y += g2[1] * acc.y; xv.z += g2[2] * acc.z; xv.w += g2[3] * acc.w;
  ((float4*)(xs + (size_t)r * D))[tid] = xv;
}

typedef __attribute__((ext_vector_type(8))) short bf16x8;
typedef __attribute__((ext_vector_type(16))) float f32x16;
typedef __attribute__((ext_vector_type(2))) __bf16 bf16x2_t;
typedef __attribute__((ext_vector_type(2))) float f32x2_t;
#define MFMA32(a, b, c) __builtin_amdgcn_mfma_f32_32x32x16_bf16((a), (b), (c), 0, 0, 0)
DI unsigned pk2bf(float a, float b) { f32x2_t v = {a, b}; return __builtin_bit_cast(unsigned, __builtin_convertvector(v, bf16x2_t)); }
constexpr int NTHR = 512;

DI void wconv_tile(const float* __restrict__ W, bf16_t* __restrict__ Wt, int N, int tile, float* sm  ) {
  int tn = tile % (N / 64), tk = tile / (N / 64);
  int tid = threadIdx.x;
  __syncthreads();
  for (int i = tid; i < 64 * 16; i += NTHR) {
    int kr = i >> 4, c4 = (i & 15) * 4;
    float4 v = *(const float4*)(W + (size_t)(tk * 64 + kr) * N + tn * 64 + c4);
    sm[kr * 65 + c4] = v.x; sm[kr * 65 + c4 + 1] = v.y; sm[kr * 65 + c4 + 2] = v.z; sm[kr * 65 + c4 + 3] = v.w;
  }
  __syncthreads();
  for (int i = tid; i < 64 * 8; i += NTHR) {
    int n = i >> 3, k8 = (i & 7) * 8;
    unsigned w[4];
    for (int j = 0; j < 4; ++j) w[j] = pk2bf(sm[(k8 + 2 * j) * 65 + n], sm[(k8 + 2 * j + 1) * 65 + n]);
    *(uint4*)(Wt + (size_t)(tn * 64 + n) * D + tk * 64 + k8) = make_uint4(w[0], w[1], w[2], w[3]);
  }
}

template <int EPI>
DI void gemm_tile(const bf16_t* __restrict__ A, const bf16_t* __restrict__ Wt, int N, int m0, int n0, char* smem, bf16_t* __restrict__ Cb,
                  float* __restrict__ xs, const float* __restrict__ gate_base) {
  constexpr int K = D;
  const int tid = threadIdx.x, lane = tid & 63, wid = tid >> 6;
  const int wm = wid & 1, wn = wid >> 1;
  const int r = lane & 31, h = lane >> 5;
  f32x16 acc0, acc1;
  for (int i = 0; i < 16; ++i) { acc0[i] = 0.f; acc1[i] = 0.f; }
  const int lrow = tid >> 3, lch = tid & 7;
  const bf16_t* Ag = A + (size_t)(m0 + lrow) * K + lch * 8;
  const bf16_t* Bg = Wt + (size_t)(n0 + lrow) * K + lch * 8;
  const int woff = lrow * 128 + ((lch ^ ((lrow >> 1) & 7)) << 4);
  uint4 ra0, ra1, rb0, rb1;
  ra0 = *(const uint4*)(Ag); ra1 = *(const uint4*)(Ag + (size_t)64 * K);
  rb0 = *(const uint4*)(Bg); rb1 = *(const uint4*)(Bg + (size_t)64 * K);
  __syncthreads();
  *(uint4*)(smem + woff) = ra0; *(uint4*)(smem + woff + 8192) = ra1;
  *(uint4*)(smem + 16384 + woff) = rb0; *(uint4*)(smem + 16384 + woff + 8192) = rb1;
  __syncthreads();
  const int sw = (r >> 1) & 7;
  const int aoff0 = (wm * 64 + r) * 128, aoff1 = aoff0 + 32 * 128;
  const int boff = 16384 + (wn * 32 + r) * 128;
#pragma unroll 1
  for (int kt = 0; kt < K / 64; ++kt) {
    const char* st = smem + (kt & 1) * 32768;
    if (kt + 1 < K / 64) {
      ra0 = *(const uint4*)(Ag + (kt + 1) * 64); ra1 = *(const uint4*)(Ag + (size_t)64 * K + (kt + 1) * 64);
      rb0 = *(const uint4*)(Bg + (kt + 1) * 64); rb1 = *(const uint4*)(Bg + (size_t)64 * K + (kt + 1) * 64);
    }
#pragma unroll
    for (int s = 0; s < 4; ++s) {
      int co = ((2 * s + h) ^ sw) << 4;
      bf16x8 a0 = *(const bf16x8*)(st + aoff0 + co);
      bf16x8 a1 = *(const bf16x8*)(st + aoff1 + co);
      bf16x8 b = *(const bf16x8*)(st + boff + co);
      acc0 = MFMA32(a0, b, acc0);
      acc1 = MFMA32(a1, b, acc1);
    }
    if (kt + 1 < K / 64) {
      char* sn = smem + ((kt + 1) & 1) * 32768;
      *(uint4*)(sn + woff) = ra0; *(uint4*)(sn + woff + 8192) = ra1;
      *(uint4*)(sn + 16384 + woff) = rb0; *(uint4*)(sn + 16384 + woff + 8192) = rb1;
    }
    __syncthreads();
  }
  float* Cs = (float*)smem;
  constexpr int CS = 132;
#pragma unroll
  for (int i = 0; i < 16; ++i) {
    int row = (i & 3) + 8 * (i >> 2) + 4 * h;
    Cs[(wm * 64 + row) * CS + wn * 32 + r] = acc0[i];
    Cs[(wm * 64 + 32 + row) * CS + wn * 32 + r] = acc1[i];
  }
  __syncthreads();
  if (EPI == 0) {
    for (int i = tid; i < 128 * 16; i += NTHR) {
      int row = i >> 4, c8 = (i & 15) * 8;
      const float* cr = Cs + row * CS + c8;
      float4 v0 = *(const float4*)cr, v1 = *(const float4*)(cr + 4);
      *(uint4*)(Cb + (size_t)(m0 + row) * N + n0 + c8) = make_uint4(pk2bf(v0.x, v0.y), pk2bf(v0.z, v0.w), pk2bf(v1.x, v1.y), pk2bf(v1.z, v1.w));
    }
  } else {
    for (int i = tid; i < 128 * 32; i += NTHR) {
      int row = i >> 5, c4 = (i & 31) * 4;
      int rr = m0 + row; int b = rr / NT, p = rr % NT; int mrow = p < CTX ? 2 : b;
      const float* gt = gate_base + mrow * NMOD + n0 + c4;
      float4 v = *(const float4*)(Cs + row * CS + c4);
      float4 xv = *(float4*)(xs + (size_t)rr * D + n0 + c4);
      xv.x += gt[0] * v.x; xv.y += gt[1] * v.y; xv.z += gt[2] * v.z; xv.w += gt[3] * v.w;
      *(float4*)(xs + (size_t)rr * D + n0 + c4) = xv;
    }
  }
}

__global__ __launch_bounds__(NTHR) void k_wconv(const float* __restrict__ W, bf16_t* __restrict__ Wt, int N) {
  __shared__ float sm[64 * 65];
  int ntiles = (N / 64) * (D / 64);
  for (int t = blockIdx.x; t < ntiles; t += gridDim.x) wconv_tile(W, Wt, N, t, sm);
}
template <int EPI>
__global__ __launch_bounds__(NTHR) void k_gemm(const bf16_t* __restrict__ A, const bf16_t* __restrict__ Wt, int N, bf16_t* __restrict__ Cb,
                                               float* __restrict__ xs, const float* __restrict__ gate_base) {
  extern __shared__ __attribute__((aligned(16))) char smem[];
  int nt_n = N / 128, ntiles = (R / 128) * nt_n;
  for (int t = blockIdx.x; t < ntiles; t += gridDim.x) {
    int tm = t / nt_n, tn = t % nt_n;
    gemm_tile<EPI>(A, Wt, N, tm * 128, tn * 128, smem, Cb, xs, gate_base);
  }
}

struct AttnArgs {
  const bf16_t *QA, *KA, *VAt, *QW, *KW, *VWt, *QG, *KG, *VGt;
  const float *g_qk_diff, *g_qk_win, *g_qk_glob, *sink, *lambda_diff, *g_mix_out;
  float lambda_init;
  int pad0;
  bf16_t* A2;
  float* Oslab;
  float* Lslab;
};

template <int TYPE>
DI void attn_item(const AttnArgs& a, int b, int g, int p0, int ctx0, int nctx, int lat0, int nkt, int half, char* smem) {
  constexpr int DQK = TYPE == 0 ? 32 : 64;
  constexpr int KS = DQK / 16;
  const int tid = threadIdx.x, lane = tid & 63, wid = tid >> 6;
  const int r = lane & 31, h = lane >> 5;
  const bf16_t *Q0, *Q1, *K0, *K1, *Vt;
  const float* gqk;
  if (TYPE == 0) {
    Q0 = a.QA + ((size_t)b * 8 + 2 * g) * NT * 32; Q1 = Q0 + (size_t)NT * 32;
    K0 = a.KA + ((size_t)b * 8 + 2 * g) * NT * 32; K1 = K0 + (size_t)NT * 32;
    Vt = a.VAt + ((size_t)b * 4 + g) * 64 * NT; gqk = a.g_qk_diff;
  } else if (TYPE == 1) {
    Q0 = a.QW + ((size_t)b * 4 + 2 * g) * NT * 64; Q1 = Q0 + (size_t)NT * 64;
    K0 = a.KW + ((size_t)b * 2 + g) * NT * 64; K1 = K0;
    Vt = a.VWt + ((size_t)b * 2 + g) * 64 * NT; gqk = a.g_qk_win;
  } else {
    Q0 = a.QG + ((size_t)b * 4 + 2 * g) * NT * 64; Q1 = Q0 + (size_t)NT * 64;
    K0 = a.KG + ((size_t)b * 2 + g) * NT * 64; K1 = K0;
    Vt = a.VGt + ((size_t)b * 2 + g) * 64 * NT; gqk = a.g_qk_glob;
  }
  (void)gqk;
  const int qpos = p0 + wid * 32 + r;
  bf16x8 qf0[KS], qf1[KS];
#pragma unroll
  for (int s = 0; s < KS; ++s) {
    qf0[s] = *(const bf16x8*)(Q0 + (size_t)qpos * DQK + 16 * s + 8 * h);
    qf1[s] = *(const bf16x8*)(Q1 + (size_t)qpos * DQK + 16 * s + 8 * h);
  }
  f32x16 O00, O01, O10, O11, Zero;
#pragma unroll
  for (int i = 0; i < 16; ++i) { O00[i] = 0.f; O01[i] = 0.f; O10[i] = 0.f; O11[i] = 0.f; Zero[i] = 0.f; }
  float l0 = 0.f, l1 = 0.f;

  uint4 st0, st1, st2, st3;
  auto tile_of = [&](int it) { return it < nctx ? ctx0 + it : lat0 + it - nctx; };
  const int vrow0 = tid >> 4, vch = tid & 15;
#define ATT_GLOAD(kt_)                                                                                   \
  {                                                                                                      \
    const int kt__ = (kt_);                                                                              \
    if (TYPE == 0) {                                                                                     \
      st0 = *(const uint4*)(K0 + (size_t)kt__ * 128 * 32 + tid * 8);                                     \
      st1 = *(const uint4*)(K1 + (size_t)kt__ * 128 * 32 + tid * 8);                                     \
    } else {                                                                                             \
      st0 = *(const uint4*)(K0 + (size_t)kt__ * 128 * 64 + tid * 8);                                     \
      st1 = *(const uint4*)(K0 + (size_t)kt__ * 128 * 64 + (tid + 512) * 8);                             \
    }                                                                                                    \
    st2 = *(const uint4*)(Vt + (size_t)vrow0 * NT + kt__ * 128 + vch * 8);                               \
    st3 = *(const uint4*)(Vt + (size_t)(vrow0 + 32) * NT + kt__ * 128 + vch * 8);                        \
  }
#define ATT_SSTORE(sb_)                                                                                  \
  {                                                                                                      \
    char* sb__ = (sb_);                                                                                  \
    if (TYPE == 0) {                                                                                     \
      int row = tid >> 2, ch = tid & 3;                                                                  \
      int off = row * 64 + ((ch ^ ((row >> 2) & 3)) << 4);                                               \
      *(uint4*)(sb__ + off) = st0;                                                                       \
      *(uint4*)(sb__ + 8192 + off) = st1;                                                                \
    } else {                                                                                             \
      int row = tid >> 3, ch = tid & 7;                                                                  \
      int off = row * 128 + ((ch ^ ((row >> 1) & 7)) << 4);                                              \
      *(uint4*)(sb__ + off) = st0;                                                                       \
      *(uint4*)(sb__ + off + 8192) = st1;                                                                \
    }                                                                                                    \
    int voff = 16384 + vrow0 * 256 + ((vch ^ (vrow0 & 15)) << 4);                                        \
    *(uint4*)(sb__ + voff) = st2;                                                                        \
    *(uint4*)(sb__ + voff + 8192) = st3;                                                                 \
  }
  ATT_GLOAD(tile_of(0));
  __syncthreads();
  ATT_SSTORE(smem);
  __syncthreads();
  const int qwave = p0 + wid * 32;
#pragma unroll 1
  for (int it = 0; it < nkt; ++it) {
    const int kt = tile_of(it);
    const char* sb = smem + (it & 1) * 32768;
    if (it + 1 < nkt) ATT_GLOAD(tile_of(it + 1));
#pragma unroll 1
    for (int j = 0; j < 4; ++j) {
      const int kbase = kt * 128 + 32 * j;
      bool masked = false;
      if (TYPE == 1) {
        if (kbase >= CTX && p0 >= CTX) {
          if (kbase > qwave + 31 + 128 || kbase + 31 < qwave - 128) continue;
          masked = true;
        }
      }
      f32x16 S0 = Zero, S1 = Zero;
#pragma unroll
      for (int s = 0; s < KS; ++s) {
        if (TYPE == 0) {
          int row = 32 * j + r;
          int off = row * 64 + (((2 * s + h) ^ ((row >> 2) & 3)) << 4);
          bf16x8 k0 = *(const bf16x8*)(sb + off);
          bf16x8 k1 = *(const bf16x8*)(sb + 8192 + off);
          S0 = MFMA32(k0, qf0[s], S0);
          S1 = MFMA32(k1, qf1[s], S1);
        } else {
          int row = 32 * j + r;
          int off = row * 128 + (((2 * s + h) ^ ((row >> 1) & 7)) << 4);
          bf16x8 k0 = *(const bf16x8*)(sb + off);
          S0 = MFMA32(k0, qf0[s], S0);
          S1 = MFMA32(k0, qf1[s], S1);
        }
      }
      float pa[16], pb[16];
#pragma unroll
      for (int i = 0; i < 16; ++i) {
        float e0 = __builtin_amdgcn_exp2f(S0[i]);
        float e1 = __builtin_amdgcn_exp2f(S1[i]);
        if (TYPE == 1) {
          if (masked) {
            int kp = kbase + (i & 3) + 8 * (i >> 2) + 4 * h;
            int dd = kp - qpos;
            bool ok = (dd <= 128) && (dd >= -128);
            e0 = ok ? e0 : 0.f; e1 = ok ? e1 : 0.f;
          }
        }
        pa[i] = e0; pb[i] = e1;
      }
      l0 += ((pa[0] + pa[1]) + (pa[2] + pa[3])) + ((pa[4] + pa[5]) + (pa[6] + pa[7])) + ((pa[8] + pa[9]) + (pa[10] + pa[11])) + ((pa[12] + pa[13]) + (pa[14] + pa[15]));
      l1 += ((pb[0] + pb[1]) + (pb[2] + pb[3])) + ((pb[4] + pb[5]) + (pb[6] + pb[7])) + ((pb[8] + pb[9]) + (pb[10] + pb[11])) + ((pb[12] + pb[13]) + (pb[14] + pb[15]));
      bf16x8 pf0[2], pf1[2];
#pragma unroll
      for (int s2 = 0; s2 < 2; ++s2) {
        unsigned w0[4], w1[4];
#pragma unroll
        for (int e = 0; e < 4; ++e) {
          w0[e] = pk2bf(pa[8 * s2 + 2 * e], pa[8 * s2 + 2 * e + 1]);
          w1[e] = pk2bf(pb[8 * s2 + 2 * e], pb[8 * s2 + 2 * e + 1]);
        }
        pf0[s2] = __builtin_bit_cast(bf16x8, make_uint4(w0[0], w0[1], w0[2], w0[3]));
        pf1[s2] = __builtin_bit_cast(bf16x8, make_uint4(w1[0], w1[1], w1[2], w1[3]));
      }
#pragma unroll
      for (int s2 = 0; s2 < 2; ++s2) {
        int ch = 4 * j + 2 * s2 + h;
        bf16x8 v0 = *(const bf16x8*)(sb + 16384 + r * 256 + ((ch ^ (r & 15)) << 4));
        bf16x8 v1 = *(const bf16x8*)(sb + 16384 + (32 + r) * 256 + ((ch ^ (r & 15)) << 4));
        O00 = MFMA32(v0, pf0[s2], O00);
        O01 = MFMA32(v1, pf0[s2], O01);
        O10 = MFMA32(v0, pf1[s2], O10);
        O11 = MFMA32(v1, pf1[s2], O11);
      }
    }
    if (it + 1 < nkt) ATT_SSTORE(smem + ((it + 1) & 1) * 32768);
    __syncthreads();
  }
  l0 += __shfl_xor(l0, 32);
  l1 += __shfl_xor(l1, 32);
  if (TYPE == 1) {
    l0 += __builtin_amdgcn_exp2f(a.sink[2 * g] * LOG2E);
    l1 += __builtin_amdgcn_exp2f(a.sink[2 * g + 1] * LOG2E);
  }
  const size_t orow = (size_t)b * NT + qpos;
  if (TYPE == 2) {
#pragma unroll
    for (int x = 0; x < 2; ++x) {
      int head = 2 * g + x;
      float* dst = a.Oslab + ((((size_t)half * NB + b) * 4 + head) * NT + qpos) * 64;
#pragma unroll
      for (int dt = 0; dt < 2; ++dt) {
        const f32x16& O = x == 0 ? (dt == 0 ? O00 : O01) : (dt == 0 ? O10 : O11);
#pragma unroll
        for (int q4 = 0; q4 < 4; ++q4)
          *(float4*)(dst + 32 * dt + 8 * q4 + 4 * h) = make_float4(O[4 * q4], O[4 * q4 + 1], O[4 * q4 + 2], O[4 * q4 + 3]);
      }
      if (h == 0) a.Lslab[(((size_t)half * NB + b) * 4 + head) * NT + qpos] = x == 0 ? l0 : l1;
    }
  } else if (TYPE == 0) {
    float s0 = 0.f, s1 = 0.f;
    for (int d = 0; d < 32; ++d) { s0 += a.lambda_diff[d] * a.lambda_diff[32 + d]; s1 += a.lambda_diff[64 + d] * a.lambda_diff[96 + d]; }
    const float lam = __expf(s0) - __expf(s1) + a.lambda_init;
    const float i0 = 1.f / l0, i1 = lam / l1;
    float o[32];
    float ss = 0.f;
#pragma unroll
    for (int i = 0; i < 16; ++i) {
      o[i] = O00[i] * i0 - O10[i] * i1;
      o[16 + i] = O01[i] * i0 - O11[i] * i1;
      ss += o[i] * o[i] + o[16 + i] * o[16 + i];
    }
    ss += __shfl_xor(ss, 32);
    const float rs = rsqrtf(ss * (1.f / 64) + EPS) * (1.f - a.lambda_init);
    const float* gm = a.g_mix_out + g * 64;
    bf16_t* dst = a.A2 + orow * D + g * 64;
#pragma unroll
    for (int dt = 0; dt < 2; ++dt)
#pragma unroll
      for (int q4 = 0; q4 < 4; ++q4) {
        int dv = 32 * dt + 8 * q4 + 4 * h;
        const float* ov = o + 16 * dt + 4 * q4;
        uint2 w;
        w.x = pk2bf(ov[0] * rs * gm[dv], ov[1] * rs * gm[dv + 1]);
        w.y = pk2bf(ov[2] * rs * gm[dv + 2], ov[3] * rs * gm[dv + 3]);
        *(uint2*)(dst + dv) = w;
      }
  } else {
#pragma unroll
    for (int x = 0; x < 2; ++x) {
      const float inv = 1.f / (x == 0 ? l0 : l1);
      float o[32];
      float ss = 0.f;
#pragma unroll
      for (int i = 0; i < 16; ++i) {
        o[i] = (x == 0 ? O00[i] : O10[i]) * inv;
        o[16 + i] = (x == 0 ? O01[i] : O11[i]) * inv;
        ss += o[i] * o[i] + o[16 + i] * o[16 + i];
      }
      ss += __shfl_xor(ss, 32);
      const float rs = rsqrtf(ss * (1.f / 64) + EPS);
      const int col0 = 256 + (2 * g + x) * 64;
      const float* gm = a.g_mix_out + col0;
      bf16_t* dst = a.A2 + orow * D + col0;
#pragma unroll
      for (int dt = 0; dt < 2; ++dt)
#pragma unroll
        for (int q4 = 0; q4 < 4; ++q4) {
          int dv = 32 * dt + 8 * q4 + 4 * h;
          const float* ov = o + 16 * dt + 4 * q4;
          uint2 w;
          w.x = pk2bf(ov[0] * rs * gm[dv], ov[1] * rs * gm[dv + 1]);
          w.y = pk2bf(ov[2] * rs * gm[dv + 2], ov[3] * rs * gm[dv + 3]);
          *(uint2*)(dst + dv) = w;
        }
    }
  }
}

DI void attn_dispatch(const AttnArgs& a, int idx, int want_ctx, char* smem) {
  if (idx < 256) {
    int b = idx >> 7, g = (idx >> 5) & 3, qt = 1 + (idx & 31);
    attn_item<0>(a, b, g, qt * 256, 0, 2, 2, 66, 0, smem);
  } else if (idx < 512) {
    int i = idx - 256; int half = i >> 7, b = (i >> 6) & 1, g = (i >> 5) & 1, qt = 1 + (i & 31);
    if (half == 0) attn_item<2>(a, b, g, qt * 256, 0, 2, 2, 33, 0, smem);
    else attn_item<2>(a, b, g, qt * 256, 0, 0, 33, 33, 1, smem);
  } else if (idx < 640) {
    int i = idx - 512; int b = i >> 6, g = (i >> 5) & 1, qt = 1 + (i & 31);
    int lo = max(2, 2 * qt - 1), hi = min(65, 2 * qt + 2);
    attn_item<1>(a, b, g, qt * 256, 0, 2, lo, 2 + (hi - lo + 1), 0, smem);
  } else if (want_ctx) {
    int i = idx - 640;
    if (i < 8) attn_item<0>(a, i >> 2, i & 3, 0, 0, 2, 0, 2, 0, smem);
    else if (i < 16) { int k = i - 8; int half = k >> 2, b = (k >> 1) & 1, g = k & 1; attn_item<2>(a, b, g, 0, half, 1, 0, 1, half, smem); }
    else if (i < 20) { int k = i - 16; attn_item<1>(a, k >> 1, k & 1, 0, 0, 2, 0, 2, 0, smem); }
  }
}
__global__ __launch_bounds__(NTHR) void k_attn(AttnArgs a, int want_ctx) {
  extern __shared__ __attribute__((aligned(16))) char smem[];
  int nitems = 640 + (want_ctx ? 20 : 0);
  for (int idx = blockIdx.x; idx < nitems; idx += gridDim.x) attn_dispatch(a, idx, want_ctx, smem);
}
__global__ __launch_bounds__(256) void k_glob_fin(const float* __restrict__ Oslab, const float* __restrict__ Lslab, const float* __restrict__ g_mix_out,
                                                  bf16_t* __restrict__ A2, int want_ctx) {
  int idx = blockIdx.x * 256 + threadIdx.x;
  int p = idx % NT; int hd = (idx / NT) % 4; int b = idx / (NT * 4);
  if (p < CTX && !want_ctx) return;
  size_t i0 = (((size_t)0 * NB + b) * 4 + hd) * NT + p, i1 = (((size_t)1 * NB + b) * 4 + hd) * NT + p;
  float inv = 1.f / (Lslab[i0] + Lslab[i1]);
  float o[64]; float ss = 0.f;
  const float4* a0 = (const float4*)(Oslab + i0 * 64); const float4* a1 = (const float4*)(Oslab + i1 * 64);
#pragma unroll
  for (int i = 0; i < 16; ++i) {
    float4 x = a0[i], y = a1[i];
    o[4 * i] = (x.x + y.x) * inv; o[4 * i + 1] = (x.y + y.y) * inv; o[4 * i + 2] = (x.z + y.z) * inv; o[4 * i + 3] = (x.w + y.w) * inv;
    ss += o[4 * i] * o[4 * i] + o[4 * i + 1] * o[4 * i + 1] + o[4 * i + 2] * o[4 * i + 2] + o[4 * i + 3] * o[4 * i + 3];
  }
  float rs = rsqrtf(ss * (1.f / 64) + EPS);
  const float* gm = g_mix_out + 512 + hd * 64;
  uint4* dst = (uint4*)(A2 + ((size_t)b * NT + p) * D + 512 + hd * 64);
#pragma unroll
  for (int i = 0; i < 8; ++i)
    dst[i] = make_uint4(pk2bf(o[8 * i] * rs * gm[8 * i], o[8 * i + 1] * rs * gm[8 * i + 1]), pk2bf(o[8 * i + 2] * rs * gm[8 * i + 2], o[8 * i + 3] * rs * gm[8 * i + 3]),
                        pk2bf(o[8 * i + 4] * rs * gm[8 * i + 4], o[8 * i + 5] * rs * gm[8 * i + 5]), pk2bf(o[8 * i + 6] * rs * gm[8 * i + 6], o[8 * i + 7] * rs * gm[8 * i + 7]));
}

static inline size_t align_up(size_t x) { return (x + 255) & ~(size_t)255; }

extern "C" void kernel_launch(void* const* d_in, const int* in_sizes, int n_in, void* d_out, int out_size, void* d_ws, size_t ws_size,
                              hipStream_t stream) {
  const float* x = (const float*)d_in[0];
  const float* c = (const float*)d_in[1];
  const float* ctx = (const float*)d_in[2];
  const float* c_ctx = (const float*)d_in[3];
  const float* w_mod = (const float*)d_in[4];
  const float* b_mod = (const float*)d_in[5];
  const float* g_norm_mix = (const float*)d_in[6];
  const float* w_in = (const float*)d_in[7];
  const float* g_qk_diff = (const float*)d_in[8];
  const float* lambda_diff = (const float*)d_in[9];
  const float* g_qk_win = (const float*)d_in[10];
  const float* sink_win = (const float*)d_in[11];
  const float* g_qk_glob = (const float*)d_in[12];
  const float* hy_conv_w = (const float*)d_in[13];
  const float* hy_conv_b = (const float*)d_in[14];
  const float* hy_w1 = (const float*)d_in[15];
  const float* hy_b1 = (const float*)d_in[16];
  const float* hy_w2 = (const float*)d_in[17];
  const float* hy_b2 = (const float*)d_in[18];
  const float* hy_w3 = (const float*)d_in[19];
  const float* hy_b3 = (const float*)d_in[20];
  const float* hy_freq = (const float*)d_in[21];
  const float* hy_bias = (const float*)d_in[22];
  const float* g_mix_out = (const float*)d_in[23];
  const float* w_out = (const float*)d_in[24];
  const float* g_norm_ffn = (const float*)d_in[25];
  const float* peer_wq = (const float*)d_in[26];
  const float* peer_keys = (const float*)d_in[27];
  const float* peer_u = (const float*)d_in[28];
  const float* peer_v = (const float*)d_in[29];
  float* out = (float*)d_out;

  char* ws = (char*)d_ws;
  size_t off = 0;
  auto carve = [&](size_t bytes) { char* p = ws + off; off = align_up(off + bytes); return p; };
  float* modv = (float*)carve((size_t)2 * 3 * NMOD * 4);
  float* xs = (float*)carve((size_t)R * D * 4);
  bf16_t* hbuf = (bf16_t*)carve((size_t)R * D * 2);
  bf16_t* P = (bf16_t*)carve((size_t)R * DIN * 2);
  bf16_t* qbuf = P;
  bf16_t* Wt_in = (bf16_t*)carve((size_t)2 * DIN * D * 2);
  bf16_t* Wt_out = (bf16_t*)carve((size_t)2 * D * D * 2);
  bf16_t* Wt_q = (bf16_t*)carve((size_t)2 * 2048 * D * 2);
  PrepOut po;
  po.QA = (bf16_t*)carve((size_t)NB * 8 * NT * 32 * 2);
  po.KA = (bf16_t*)carve((size_t)NB * 8 * NT * 32 * 2);
  po.VAt = (bf16_t*)carve((size_t)NB * 4 * 64 * NT * 2);
  po.QW = (bf16_t*)carve((size_t)NB * 4 * NT * 64 * 2);
  po.KW = (bf16_t*)carve((size_t)NB * 2 * NT * 64 * 2);
  po.VWt = (bf16_t*)carve((size_t)NB * 2 * 64 * NT * 2);
  po.QG = (bf16_t*)carve((size_t)NB * 4 * NT * 64 * 2);
  po.KG = (bf16_t*)carve((size_t)NB * 2 * NT * 64 * 2);
  po.VGt = (bf16_t*)carve((size_t)NB * 2 * 64 * NT * 2);
  po.uT = (float*)carve((size_t)NB * 768 * NT * 4);
  float* zT = (float*)carve((size_t)NB * 256 * NT * 4);
  float* yT = (float*)carve((size_t)NB * 256 * NT * 4);
  float* hdn2 = (float*)carve((size_t)2 * SEQ * 64 * 4);
  float* kc = (float*)carve((KC_W0 + (size_t)2 * 256 * 2 * CTX) * 4);
  bf16_t* A2 = (bf16_t*)carve((size_t)R * D * 2);
  float* Otmp = (float*)P;
  if (off > ws_size) return; (void)in_sizes; (void)n_in; (void)out_size;

  k_mod<<<dim3(NMOD / 256, 2), 256, 0, stream>>>(c, c_ctx, w_mod, b_mod, modv);
  constexpr int GEMM_LDS = 128 * 132 * 4;
  hipFuncSetAttribute((const void*)k_gemm<0>, hipFuncAttributeMaxDynamicSharedMemorySize, GEMM_LDS);
  hipFuncSetAttribute((const void*)k_gemm<1>, hipFuncAttributeMaxDynamicSharedMemorySize, GEMM_LDS);
  hipFuncSetAttribute((const void*)k_attn, hipFuncAttributeMaxDynamicSharedMemorySize, 65536);
  for (int l = 0; l < 2; ++l) {
    k_wconv<<<256, NTHR, 0, stream>>>(w_in + (size_t)l * D * DIN, Wt_in + (size_t)l * DIN * D, DIN);
    k_wconv<<<256, NTHR, 0, stream>>>(w_out + (size_t)l * D * D, Wt_out + (size_t)l * D * D, D);
    k_wconv<<<256, NTHR, 0, stream>>>(peer_wq + (size_t)l * D * 2048, Wt_q + (size_t)l * 2048 * D, 2048);
  }
  k_init_xs<<<R, 256, 0, stream>>>(x, ctx, xs);

  for (int l = 0; l < 2; ++l) {
    int want_ctx = l < 1 ? 1 : 0;
    float lambda_init = 0.8f - 0.6f * expf(-0.3f * (float)l);
    const float* modv_l = modv + (size_t)l * 3 * NMOD;
    k_norm_mod<<<R, 256, 0, stream>>>(xs, g_norm_mix + l * D, modv_l, 0, hbuf);
    k_gemm<0><<<256, NTHR, GEMM_LDS, stream>>>(hbuf, Wt_in + (size_t)l * DIN * D, DIN, P, nullptr, nullptr);
    k_prep<<<R, 256, 0, stream>>>(P, g_qk_diff + l * 64, g_qk_win + l * 128, g_qk_glob + l * 128, hy_conv_w + l * 3 * 768,
                                  hy_conv_b + l * 768, po);
    {
      AttnArgs aa;
      memset(&aa, 0, sizeof(aa));
      aa.QA = po.QA; aa.KA = po.KA; aa.VAt = po.VAt; aa.QW = po.QW; aa.KW = po.KW; aa.VWt = po.VWt; aa.QG = po.QG; aa.KG = po.KG; aa.VGt = po.VGt;
      aa.g_qk_diff = g_qk_diff + l * 64; aa.g_qk_win = g_qk_win + l * 128; aa.g_qk_glob = g_qk_glob + l * 128; aa.sink = sink_win + l * 4;
      aa.lambda_diff = lambda_diff + l * 128; aa.g_mix_out = g_mix_out + l * D; aa.lambda_init = lambda_init; aa.A2 = A2;
      aa.Oslab = Otmp; aa.Lslab = Otmp + (size_t)2 * NB * 4 * NT * 64;
      k_attn<<<256, NTHR, 65536, stream>>>(aa, want_ctx);
      k_glob_fin<<<NB * 4 * NT / 256, 256, 0, stream>>>(aa.Oslab, aa.Lslab, g_mix_out + l * D, A2, want_ctx);
    }
    k_hy_mlp<<<SEQ + CTX, 64, 0, stream>>>(hy_w1 + l * 33 * 64, hy_b1 + l * 64, hy_w2 + l * 64 * 64, hy_b2 + l * 64, hy_freq + l * 64, hdn2);
    k_hy_filt<<<dim3(256, 2, 2), 256, 0, stream>>>(hdn2, hy_w3 + (size_t)l * 64 * 1024, hy_b3 + l * 1024, kc, want_ctx);
    k_hy_conv<0><<<dim3(SEQ / 256, 256, NB), 256, 0, stream>>>(po.uT, nullptr, zT, kc, hy_bias + l * 512, 0);
    k_hy_conv<1><<<dim3(SEQ / 256, 256, NB), 256, 0, stream>>>(po.uT, zT, yT, kc, hy_bias + l * 512, 0);
    if (want_ctx) {
      k_hy_conv<0><<<dim3(CTX / 256, 256, NB), 256, 0, stream>>>(po.uT, nullptr, zT, kc, hy_bias + l * 512, 1);
      k_hy_conv<1><<<dim3(CTX / 256, 256, NB), 256, 0, stream>>>(po.uT, zT, yT, kc, hy_bias + l * 512, 1);
    }
    k_hy_fin<<<NB * 4 * NT / 256, 256, 0, stream>>>(yT, g_mix_out + l * D, A2, want_ctx);
    k_gemm<1><<<256, NTHR, GEMM_LDS, stream>>>(A2, Wt_out + (size_t)l * D * D, D, nullptr, xs, modv_l + 2 * D);
    k_norm_mod<<<R, 256, 0, stream>>>(xs, g_norm_ffn + l * D, modv_l, 3, hbuf);
    k_gemm<0><<<256, NTHR, GEMM_LDS, stream>>>(hbuf, Wt_q + (size_t)l * 2048 * D, 2048, qbuf, nullptr, nullptr);
    k_peer_naive<<<R, 256, 0, stream>>>(qbuf, hbuf, peer_keys + (size_t)l * 16 * 128 * 128, peer_u + (size_t)l * 16384 * D,
                                        peer_v + (size_t)l * 16384 * D, modv_l, xs, want_ctx);
  }
  k_final<<<NB * SEQ, 256, 0, stream>>>(xs, out);
}
```

```cpp
#include <hip/hip_runtime.h>
#include <stdint.h>
#include <string.h>

#define DI __device__ __forceinline__
typedef unsigned short bf16_t;

constexpr int D = 1024;
constexpr int NB = 2;
constexpr int SEQ = 8192;
constexpr int CTX = 256;
constexpr int NT = SEQ + CTX;
constexpr int R = NB * NT;
constexpr int DIN = 2560;
constexpr int NMOD = 6 * D;
constexpr float EPS = 1e-6f;
constexpr float LOG2E = 1.4426950408889634f;

DI bf16_t f2bf(float x) { unsigned u = __float_as_uint(x); u += 0x7fffu + ((u >> 16) & 1u); return (bf16_t)(u >> 16); }
DI float bf2f(bf16_t h) { return __uint_as_float(((unsigned)h) << 16); }
DI float bflo(unsigned w) { return __uint_as_float(w << 16); }
DI float bfhi(unsigned w) { return __uint_as_float(w & 0xffff0000u); }

DI float block_sum_256(float v, float* red) {
  for (int o = 32; o > 0; o >>= 1) v += __shfl_xor(v, o);
  int w = threadIdx.x >> 6;
  __syncthreads();
  if ((threadIdx.x & 63) == 0) red[w] = v;
  __syncthreads();
  float s = red[0] + red[1] + red[2] + red[3];
  return s;
}

__global__ __launch_bounds__(256) void k_mod(const float* __restrict__ c, const float* __restrict__ c_ctx,
                                             const float* __restrict__ w_mod, const float* __restrict__ b_mod,
                                             float* __restrict__ modv) {
  __shared__ float sc[3][D];
  int l = blockIdx.y;
  for (int i = threadIdx.x; i < 3 * D; i += 256) {
    int row = i / D, k = i % D;
    float v = row < 2 ? c[row * D + k] : c_ctx[k];
    sc[row][k] = v / (1.f + __expf(-v));
  }
  __syncthreads();
  int col = blockIdx.x * 256 + threadIdx.x;
  const float* w = w_mod + (size_t)l * D * NMOD + col;
  float a0 = 0, a1 = 0, a2 = 0;
  for (int k = 0; k < D; ++k) {
    float wv = w[(size_t)k * NMOD];
    a0 += sc[0][k] * wv; a1 += sc[1][k] * wv; a2 += sc[2][k] * wv;
  }
  float bb = b_mod[l * NMOD + col];
  modv[(l * 3 + 0) * NMOD + col] = a0 + bb;
  modv[(l * 3 + 1) * NMOD + col] = a1 + bb;
  modv[(l * 3 + 2) * NMOD + col] = a2 + bb;
}

__global__ __launch_bounds__(256) void k_init_xs(const float* __restrict__ x, const float* __restrict__ ctx, float* __restrict__ xs) {
  int r = blockIdx.x; int b = r / NT, p = r % NT;
  const float4* src = (const float4*)(p < CTX ? ctx + ((size_t)b * CTX + p) * D : x + ((size_t)b * SEQ + (p - CTX)) * D);
  ((float4*)(xs + (size_t)r * D))[threadIdx.x] = src[threadIdx.x];
}
__global__ __launch_bounds__(256) void k_final(const float* __restrict__ xs, float* __restrict__ out) {
  int i = blockIdx.x; int b = i / SEQ, t = i % SEQ;
  ((float4*)(out + (size_t)i * D))[threadIdx.x] = ((const float4*)(xs + ((size_t)b * NT + CTX + t) * D))[threadIdx.x];
}

__global__ __launch_bounds__(256) void k_norm_mod(const float* __restrict__ xs, const float* __restrict__ g,
                                                  const float* __restrict__ modv_l, int sh_chunk, bf16_t* __restrict__ hbuf) {
  __shared__ float red[8];
  int r = blockIdx.x; int b = r / NT, p = r % NT; int mrow = p < CTX ? 2 : b;
  float4 v = ((const float4*)(xs + (size_t)r * D))[threadIdx.x];
  float ss = v.x * v.x + v.y * v.y + v.z * v.z + v.w * v.w;
  ss = block_sum_256(ss, red);
  float rs = rsqrtf(ss * (1.f / D) + EPS);
  int c0 = threadIdx.x * 4;
  const float* sh = modv_l + mrow * NMOD + sh_chunk * D;
  const float* sc = sh + D;
  float o[4] = {v.x, v.y, v.z, v.w};
  bf16_t ob[4];
  for (int j = 0; j < 4; ++j) ob[j] = f2bf(o[j] * rs * g[c0 + j] * (1.f + sc[c0 + j]) + sh[c0 + j]);
  uint2 pk; pk.x = ob[0] | ((unsigned)ob[1] << 16); pk.y = ob[2] | ((unsigned)ob[3] << 16);
  ((uint2*)(hbuf + (size_t)r * D))[threadIdx.x] = pk;
}

template <int MODE>
__global__ __launch_bounds__(256) void k_gemm_naive(const bf16_t* __restrict__ A, const float* __restrict__ B, float* __restrict__ C,
                                                    int M, int N, int K, const float* __restrict__ gate_base) {
  __shared__ float As[16][68];
  __shared__ float Bs[16][68];
  int bm = blockIdx.y * 64, bn = blockIdx.x * 64;
  int tx = threadIdx.x & 15, ty = threadIdx.x >> 4;
  float acc[4][4];
  for (int i = 0; i < 4; ++i) for (int j = 0; j < 4; ++j) acc[i][j] = 0.f;
  int arow = threadIdx.x >> 2, akq = (threadIdx.x & 3) * 4;
  int brow = threadIdx.x >> 4, bcol = (threadIdx.x & 15) * 4;
  for (int k0 = 0; k0 < K; k0 += 16) {
    uint2 av = *(const uint2*)(A + (size_t)(bm + arow) * K + k0 + akq);
    float4 bv = *(const float4*)(B + (size_t)(k0 + brow) * N + bn + bcol);
    __syncthreads();
    As[akq + 0][arow] = bflo(av.x); As[akq + 1][arow] = bfhi(av.x);
    As[akq + 2][arow] = bflo(av.y); As[akq + 3][arow] = bfhi(av.y);
    *(float4*)&Bs[brow][bcol] = bv;
    __syncthreads();
#pragma unroll
    for (int kk = 0; kk < 16; ++kk) {
      float4 a = *(const float4*)&As[kk][ty * 4];
      float4 bq = *(const float4*)&Bs[kk][tx * 4];
      float aa[4] = {a.x, a.y, a.z, a.w}, bb[4] = {bq.x, bq.y, bq.z, bq.w};
#pragma unroll
      for (int i = 0; i < 4; ++i)
#pragma unroll
        for (int j = 0; j < 4; ++j) acc[i][j] += aa[i] * bb[j];
    }
  }
#pragma unroll
  for (int i = 0; i < 4; ++i) {
    int r = bm + ty * 4 + i;
    int n = bn + tx * 4;
    if (MODE == 0) {
      *(float4*)(C + (size_t)r * N + n) = make_float4(acc[i][0], acc[i][1], acc[i][2], acc[i][3]);
    } else {
      int b = r / NT, p = r % NT; int mrow = p < CTX ? 2 : b;
      const float* gt = gate_base + mrow * NMOD + n;
      float4 xv = *(float4*)(C + (size_t)r * N + n);
      xv.x += gt[0] * acc[i][0]; xv.y += gt[1] * acc[i][1]; xv.z += gt[2] * acc[i][2]; xv.w += gt[3] * acc[i][3];
      *(float4*)(C + (size_t)r * N + n) = xv;
    }
  }
}

struct PrepOut {
  bf16_t *QA, *KA, *VAt, *QW, *KW, *VWt, *QG, *KG, *VGt;
  float* uT;
};
DI int perm16(int o) { return (o & 3) | ((o & 4) << 1) | ((o & 8) >> 1); }

template <int DQK>
DI void prep_unit(const float* src, const float* gain, const float* cs, const float* sn, bool lat, float scale, bf16_t* dst) {
  float ss = 0.f;
  for (int d = 0; d < DQK; ++d) ss += src[d] * src[d];
  float rs = rsqrtf(ss * (1.f / DQK) + EPS);
  constexpr int H = DQK / 2;
  for (int d = 0; d < H; ++d) {
    float x1 = src[d] * rs * gain[d], x2 = src[d + H] * rs * gain[d + H];
    float y1 = x1, y2 = x2;
    if (lat) { y1 = x1 * cs[d] - x2 * sn[d]; y2 = x1 * sn[d] + x2 * cs[d]; }
    dst[d] = f2bf(y1 * scale); dst[d + H] = f2bf(y2 * scale);
  }
}

__global__ __launch_bounds__(256) void k_prep(const bf16_t* __restrict__ P, const float* __restrict__ g_qk_diff, const float* __restrict__ g_qk_win,
                                              const float* __restrict__ g_qk_glob, const float* __restrict__ conv_w, const float* __restrict__ conv_b,
                                              PrepOut o) {
  __shared__ float row[1792];
  __shared__ float csh[16], snh[16], csf[32], snf[32];
  int r = blockIdx.x; int b = r / NT, p = r % NT; bool lat = p >= CTX; int t = p - CTX;
  const bf16_t* Pr = P + (size_t)r * DIN;
  for (int i = threadIdx.x; i < 1792; i += 256) row[i] = bf2f(Pr[i]);
  if (threadIdx.x < 48 && lat) {
    float trow = (float)(t / 64), tcol = (float)(t % 64);
    int i = threadIdx.x;
    if (i < 16) {
      int j = i & 7; float f = exp2f(-(float)j * (13.287712379549449f / 8.f));
      float a = (i < 8 ? trow : tcol) * f;
      csh[i] = cosf(a); snh[i] = sinf(a);
    } else {
      int ii = i - 16; int j = ii & 15; float f = exp2f(-(float)j * (13.287712379549449f / 16.f));
      float a = (ii < 16 ? trow : tcol) * f;
      csf[ii] = cosf(a); snf[ii] = sinf(a);
    }
  }
  __syncthreads();
  int u = threadIdx.x;
  if (u < 8) {
    prep_unit<32>(row + u * 32, g_qk_diff, csh, snh, lat, 0.17677669529663687f * LOG2E, o.QA + (((size_t)b * 8 + u) * NT + p) * 32);
  } else if (u < 16) {
    int vh = u - 8;
    prep_unit<32>(row + 256 + vh * 32, g_qk_diff + 32, csh, snh, lat, 1.f, o.KA + (((size_t)b * 8 + vh) * NT + p) * 32);
  } else if (u < 20) {
    int h = u - 16;
    prep_unit<64>(row + 768 + h * 64, g_qk_win, csf, snf, lat, 0.125f * LOG2E, o.QW + (((size_t)b * 4 + h) * NT + p) * 64);
  } else if (u < 22) {
    int h = u - 20;
    prep_unit<64>(row + 768 + 256 + h * 64, g_qk_win + 64, csf, snf, lat, 1.f, o.KW + (((size_t)b * 2 + h) * NT + p) * 64);
  } else if (u < 26) {
    int h = u - 22;
    prep_unit<64>(row + 1280 + h * 64, g_qk_glob, csf, snf, lat, 0.125f * LOG2E, o.QG + (((size_t)b * 4 + h) * NT + p) * 64);
  } else if (u < 28) {
    int h = u - 26;
    prep_unit<64>(row + 1280 + 256 + h * 64, g_qk_glob + 64, csf, snf, lat, 1.f, o.KG + (((size_t)b * 2 + h) * NT + p) * 64);
  }
  int pp = (p & ~15) + perm16(p & 15);
  {
    int c = threadIdx.x;
    o.VAt[(((size_t)b * 4 + c / 64) * 64 + (c % 64)) * NT + pp] = f2bf(row[512 + c]);
    if (c < 128) {
      o.VWt[(((size_t)b * 2 + c / 64) * 64 + (c % 64)) * NT + pp] = f2bf(row[768 + 384 + c]);
    } else {
      int c2 = c - 128;
      o.VGt[(((size_t)b * 2 + c2 / 64) * 64 + (c2 % 64)) * NT + pp] = f2bf(row[1280 + 384 + c2]);
    }
  }
  bool hasp = lat ? (t > 0) : (p > 0);
  bool hasn = lat ? (t < SEQ - 1) : (p < CTX - 1);
  for (int c = threadIdx.x; c < 768; c += 256) {
    float v = bf2f(Pr[1792 + c]) * conv_w[768 + c] + conv_b[c];
    if (hasp) v += bf2f(Pr[1792 + c - DIN]) * conv_w[c];
    if (hasn) v += bf2f(Pr[1792 + c + DIN]) * conv_w[2 * 768 + c];
    o.uT[((size_t)b * 768 + c) * NT + p] = v;
  }
}

template <int DQK>
DI void attn_accum(const float* q, const bf16_t* __restrict__ Kb, const bf16_t* __restrict__ Vt, int g0, int g1, int lo, int hi,
                   float M2, float& l, float* o) {
  for (int kg = g0; kg < g1; kg += 16) {
    float pw[16];
#pragma unroll
    for (int pos = 0; pos < 16; ++pos) {
      int k = kg + perm16(pos);
      const uint4* kr = (const uint4*)(Kb + (size_t)k * DQK);
      float s = 0.f;
#pragma unroll
      for (int c = 0; c < DQK / 8; ++c) {
        uint4 w = kr[c];
        s += q[c * 8 + 0] * bflo(w.x) + q[c * 8 + 1] * bfhi(w.x) + q[c * 8 + 2] * bflo(w.y) + q[c * 8 + 3] * bfhi(w.y) +
             q[c * 8 + 4] * bflo(w.z) + q[c * 8 + 5] * bfhi(w.z) + q[c * 8 + 6] * bflo(w.w) + q[c * 8 + 7] * bfhi(w.w);
      }
      float e = exp2f(s - M2);
      pw[pos] = (k >= lo && k <= hi) ? e : 0.f;
      l += pw[pos];
      if ((pos & 3) == 3) asm volatile("" ::: "memory");
    }
#pragma unroll
    for (int dv = 0; dv < 64; ++dv) {
      const uint4* vr = (const uint4*)(Vt + (size_t)dv * NT + kg);
      uint4 w0 = vr[0], w1 = vr[1];
      o[dv] += pw[0] * bflo(w0.x) + pw[1] * bfhi(w0.x) + pw[2] * bflo(w0.y) + pw[3] * bfhi(w0.y) + pw[4] * bflo(w0.z) +
               pw[5] * bfhi(w0.z) + pw[6] * bflo(w0.w) + pw[7] * bfhi(w0.w) + pw[8] * bflo(w1.x) + pw[9] * bfhi(w1.x) +
               pw[10] * bflo(w1.y) + pw[11] * bfhi(w1.y) + pw[12] * bflo(w1.z) + pw[13] * bfhi(w1.z) + pw[14] * bflo(w1.w) +
               pw[15] * bfhi(w1.w);
      if ((dv & 3) == 3) asm volatile("" ::: "memory");
    }
  }
}

template <int TYPE>
__global__ __launch_bounds__(256) void k_attn_naive(const bf16_t* __restrict__ Q, const bf16_t* __restrict__ K, const bf16_t* __restrict__ Vt,
                                                    const float* __restrict__ gqk, const float* __restrict__ sink, float* __restrict__ Otmp,
                                                    int want_ctx) {
  constexpr int DQK = TYPE == 0 ? 32 : 64;
  constexpr int HQ = TYPE == 0 ? 8 : 4;
  constexpr int HK = TYPE == 0 ? 8 : 2;
  constexpr int HV = TYPE == 0 ? 4 : 2;
  constexpr int SLOT0 = TYPE == 0 ? 0 : (TYPE == 1 ? 8 : 12);
  int idx = blockIdx.x * 256 + threadIdx.x;
  int p = idx % NT; int h = (idx / NT) % HQ; int b = idx / (NT * HQ);
  if (p < CTX && !want_ctx) return;
  float gq = 0.f, gk = 0.f;
  for (int d = 0; d < DQK; ++d) { gq = fmaxf(gq, fabsf(gqk[d])); gk = fmaxf(gk, fabsf(gqk[DQK + d])); }
  float M2 = sqrtf((float)DQK) * gq * gk * LOG2E;
  int kh = TYPE == 0 ? h : h / 2, vh = h / 2;
  const bf16_t* Kb = K + ((size_t)b * HK + kh) * NT * DQK;
  const bf16_t* Vb = Vt + ((size_t)b * HV + vh) * 64 * NT;
  float q[DQK];
  {
    const uint4* qr = (const uint4*)(Q + (((size_t)b * HQ + h) * NT + p) * DQK);
#pragma unroll
    for (int c = 0; c < DQK / 8; ++c) {
      uint4 w = qr[c];
      q[c * 8 + 0] = bflo(w.x); q[c * 8 + 1] = bfhi(w.x); q[c * 8 + 2] = bflo(w.y); q[c * 8 + 3] = bfhi(w.y);
      q[c * 8 + 4] = bflo(w.z); q[c * 8 + 5] = bfhi(w.z); q[c * 8 + 6] = bflo(w.w); q[c * 8 + 7] = bfhi(w.w);
    }
  }
  float o[64];
#pragma unroll
  for (int i = 0; i < 64; ++i) o[i] = 0.f;
  float l = 0.f;
#pragma unroll 1
  for (int seg = 0; seg < 2; ++seg) {
    int g0 = 0, g1 = CTX, lo = 0, hi = CTX - 1;
    if (seg == 1) {
      if (p < CTX) break;
      if (TYPE == 1) { lo = max(CTX, p - 128); hi = min(NT - 1, p + 128); g0 = lo & ~15; g1 = (hi & ~15) + 16; }
      else { lo = CTX; hi = NT - 1; g0 = CTX; g1 = NT; }
    }
    attn_accum<DQK>(q, Kb, Vb, g0, g1, lo, hi, M2, l, o);
  }
  if (TYPE == 1) l += exp2f(sink[h] * LOG2E - M2);
  float inv = 1.f / l;
  float4* dst = (float4*)(Otmp + ((((size_t)b * 16 + SLOT0 + h) * NT) + p) * 64);
#pragma unroll
  for (int i = 0; i < 16; ++i) dst[i] = make_float4(o[4 * i] * inv, o[4 * i + 1] * inv, o[4 * i + 2] * inv, o[4 * i + 3] * inv);
}

__global__ __launch_bounds__(256) void k_attn_finish(const float* __restrict__ Otmp, const float* __restrict__ lambda_diff, float lambda_init,
                                                     const float* __restrict__ g_mix_out, bf16_t* __restrict__ A2, int want_ctx) {
  int idx = blockIdx.x * 256 + threadIdx.x;
  int p = idx % NT; int oh = (idx / NT) % 12; int b = idx / (NT * 12);
  if (p < CTX && !want_ctx) return;
  float o[64];
  float hs = 1.f;
  if (oh < 4) {
    float s0 = 0.f, s1 = 0.f;
    for (int d = 0; d < 32; ++d) { s0 += lambda_diff[d] * lambda_diff[32 + d]; s1 += lambda_diff[64 + d] * lambda_diff[96 + d]; }
    float lam = __expf(s0) - __expf(s1) + lambda_init;
    const float4* a = (const float4*)(Otmp + ((((size_t)b * 16 + 2 * oh) * NT) + p) * 64);
    const float4* c = (const float4*)(Otmp + ((((size_t)b * 16 + 2 * oh + 1) * NT) + p) * 64);
#pragma unroll
    for (int i = 0; i < 16; ++i) {
      float4 x = a[i], y = c[i];
      o[4 * i] = x.x - lam * y.x; o[4 * i + 1] = x.y - lam * y.y; o[4 * i + 2] = x.z - lam * y.z; o[4 * i + 3] = x.w - lam * y.w;
    }
    hs = 1.f - lambda_init;
  } else {
    const float4* a = (const float4*)(Otmp + ((((size_t)b * 16 + 4 + oh) * NT) + p) * 64);
#pragma unroll
    for (int i = 0; i < 16; ++i) { float4 x = a[i]; o[4 * i] = x.x; o[4 * i + 1] = x.y; o[4 * i + 2] = x.z; o[4 * i + 3] = x.w; }
  }
  float ss = 0.f;
#pragma unroll
  for (int i = 0; i < 64; ++i) ss += o[i] * o[i];
  float rs = rsqrtf(ss * (1.f / 64) + EPS) * hs;
  const float* g = g_mix_out + oh * 64;
  uint4* dst = (uint4*)(A2 + ((size_t)b * NT + p) * D + oh * 64);
#pragma unroll
  for (int i = 0; i < 8; ++i) {
    unsigned w[4];
#pragma unroll
    for (int j = 0; j < 4; ++j) {
      int e = i * 8 + j * 2;
      w[j] = (unsigned)f2bf(o[e] * rs * g[e]) | ((unsigned)f2bf(o[e + 1] * rs * g[e + 1]) << 16);
    }
    dst[i] = make_uint4(w[0], w[1], w[2], w[3]);
  }
}

__global__ __launch_bounds__(64) void k_hy_mlp(const float* __restrict__ w1, const float* __restrict__ b1, const float* __restrict__ w2,
                                               const float* __restrict__ b2, const float* __restrict__ freq, float* __restrict__ hdn2) {
  __shared__ float feat[33];
  __shared__ float h1[64];
  int which = blockIdx.x >= SEQ ? 1 : 0;
  int j = which ? blockIdx.x - SEQ : blockIdx.x;
  int n = which ? CTX : SEQ;
  int u = threadIdx.x;
  float tt = (float)j / (float)(n - 1);
  float w = (6.283185307179586f / (float)n) * (float)j;
  if (u == 0) feat[0] = tt;
  if (u < 16) {
    float f = 1e-4f + (float)u * ((15.f - 1e-4f) / 15.f);
    feat[1 + u] = cosf(f * w);
    feat[17 + u] = -sinf(f * w);
  }
  __syncthreads();
  float a = b1[u];
  for (int i = 0; i < 33; ++i) a += feat[i] * w1[i * 64 + u];
  h1[u] = sinf(freq[u] * a);
  __syncthreads();
  float a2 = b2[u];
  for (int i = 0; i < 64; ++i) a2 += h1[i] * w2[i * 64 + u];
  hdn2[((size_t)which * SEQ + j) * 64 + u] = sinf(freq[u] * a2);
}

constexpr size_t KC_W0 = (size_t)2 * 256 * 2 * SEQ;
DI size_t kc_off(int which, int order, int c) {
  return which ? KC_W0 + ((size_t)order * 256 + c) * 2 * CTX : ((size_t)order * 256 + c) * 2 * SEQ;
}
__global__ __launch_bounds__(256) void k_hy_filt(const float* __restrict__ hdn2, const float* __restrict__ w3, const float* __restrict__ b3,
                                                 float* __restrict__ kc, int want_ctx) {
  __shared__ float wc[2][64];
  __shared__ float red[8];
  int c = blockIdx.x, order = blockIdx.y, which = blockIdx.z;
  if (which && !want_ctx) return;
  int n = which ? CTX : SEQ;
  int col0 = order * 512 + c, col1 = col0 + 256;
  if (threadIdx.x < 64) wc[0][threadIdx.x] = w3[threadIdx.x * 1024 + col0];
  else if (threadIdx.x < 128) wc[1][threadIdx.x - 64] = w3[(threadIdx.x - 64) * 1024 + col1];
  __syncthreads();
  float delta = fabsf(-3.0701134573253944f + (float)c * ((-15.350567286626972f + 3.0701134573253944f) / 255.f));
  float* out = kc + kc_off(which, order, c);
  float asum = 0.f;
  float bb0 = b3[col0], bb1 = b3[col1];
  for (int j = threadIdx.x; j < n; j += 256) {
    const float4* hr = (const float4*)(hdn2 + ((size_t)which * SEQ + j) * 64);
    float f0 = bb0, f1 = bb1;
#pragma unroll
    for (int i = 0; i < 16; ++i) {
      float4 hv = hr[i];
      f0 += hv.x * wc[0][4 * i] + hv.y * wc[0][4 * i + 1] + hv.z * wc[0][4 * i + 2] + hv.w * wc[0][4 * i + 3];
      f1 += hv.x * wc[1][4 * i] + hv.y * wc[1][4 * i + 1] + hv.z * wc[1][4 * i + 2] + hv.w * wc[1][4 * i + 3];
    }
    float tt = (float)j / (float)(n - 1);
    float dec = __expf(-tt * delta);
    f0 *= dec; f1 *= dec;
    out[n + j] = f0;
    asum += fabsf(f0);
    if (j > 0) { out[n - j] = f1; asum += fabsf(f1); }
    else out[0] = 0.f;
  }
  asum = block_sum_256(asum, red);
  float inv = 1.f / asum;
  __syncthreads();
  for (int j = threadIdx.x; j < 2 * n; j += 256) out[j] *= inv;
}

template <int ORDER>
__global__ __launch_bounds__(256) void k_hy_conv(const float* __restrict__ uT, const float* __restrict__ zin, float* __restrict__ zout,
                                                 const float* __restrict__ kc, const float* __restrict__ hy_bias, int which) {
  __shared__ float zs[256];
  int n = which ? CTX : SEQ;
  int off = which ? 0 : CTX;
  int chunk = blockIdx.x, c = blockIdx.y, b = blockIdx.z;
  int t = chunk * 256 + threadIdx.x;
  const float* in = (ORDER == 0 ? uT + ((size_t)b * 768 + c) * NT : zin + ((size_t)b * 256 + c) * NT) + off;
  const float* kk = kc + kc_off(which, ORDER, c) + n + t;
  float acc = 0.f;
  for (int s0 = 0; s0 < n; s0 += 256) {
    __syncthreads();
    zs[threadIdx.x] = in[s0 + threadIdx.x];
    __syncthreads();
    const float* kp = kk - s0;
#pragma unroll 8
    for (int ss = 0; ss < 256; ++ss) acc += zs[ss] * kp[-ss];
  }
  float self = in[t];
  float gatev = uT[((size_t)b * 768 + (ORDER == 0 ? 256 : 512) + c) * NT + off + t];
  float res = gatev * (acc + hy_bias[ORDER * 256 + c] * self);
  zout[((size_t)b * 256 + c) * NT + off + t] = res;
}

__global__ __launch_bounds__(256) void k_hy_fin(const float* __restrict__ yT, const float* __restrict__ g_mix_out, bf16_t* __restrict__ A2,
                                                int want_ctx) {
  int idx = blockIdx.x * 256 + threadIdx.x;
  int p = idx % NT; int g = (idx / NT) % 4; int b = idx / (NT * 4);
  if (p < CTX && !want_ctx) return;
  float v[64];
  float ss = 0.f;
#pragma unroll
  for (int i = 0; i < 64; ++i) { v[i] = yT[((size_t)b * 256 + g * 64 + i) * NT + p]; ss += v[i] * v[i]; }
  float rs = rsqrtf(ss * (1.f / 64) + EPS);
  const float* gm = g_mix_out + 768 + g * 64;
  uint4* dst = (uint4*)(A2 + ((size_t)b * NT + p) * D + 768 + g * 64);
#pragma unroll
  for (int i = 0; i < 8; ++i) {
    unsigned w[4];
#pragma unroll
    for (int j = 0; j < 4; ++j) {
      int e = i * 8 + j * 2;
      w[j] = (unsigned)f2bf(v[e] * rs * gm[e]) | ((unsigned)f2bf(v[e + 1] * rs * gm[e + 1]) << 16);
    }
    dst[i] = make_uint4(w[0], w[1], w[2], w[3]);
  }
}

__global__ __launch_bounds__(256) void k_peer_naive(const bf16_t* __restrict__ qbuf, const bf16_t* __restrict__ hbuf, const float* __restrict__ keys,
                                                    const float* __restrict__ ut, const float* __restrict__ vt, const float* __restrict__ modv_l,
                                                    float* __restrict__ xs, int want_ctx) {
  __shared__ float qs[2048];
  __shared__ float sc[16 * 128];
  __shared__ float topv[16][16];
  __shared__ int topi[16][16];
  __shared__ float cand[8][256];
  __shared__ int elist[128];
  __shared__ float glist[128];
  __shared__ float wl[128];
  int r = blockIdx.x; int b = r / NT, p = r % NT;
  if (p < CTX && !want_ctx) return;
  int tid = threadIdx.x;
  {
    uint4 w = ((const uint4*)(qbuf + (size_t)r * 2048))[tid];
    float* qd = qs + tid * 8;
    qd[0] = bflo(w.x); qd[1] = bfhi(w.x); qd[2] = bflo(w.y); qd[3] = bfhi(w.y); qd[4] = bflo(w.z); qd[5] = bfhi(w.z); qd[6] = bflo(w.w); qd[7] = bfhi(w.w);
  }
  __syncthreads();
  for (int i = 0; i < 8; ++i) {
    int sidx = tid + 256 * i;
    int hp = sidx >> 7;
    const float4* kr = (const float4*)(keys + (size_t)sidx * 128);
    const float4* qq = (const float4*)(qs + hp * 128);
    float s = 0.f;
    for (int d = 0; d < 32; ++d) { float4 a = kr[d], q4 = qq[d]; s += a.x * q4.x + a.y * q4.y + a.z * q4.z + a.w * q4.w; }
    sc[sidx] = s;
  }
  __syncthreads();
  if (tid < 16) {
    float* row = sc + tid * 128;
    for (int k = 0; k < 16; ++k) {
      float best = -3.0e38f; int bi = 0;
      for (int j = 0; j < 128; ++j) { float v = row[j]; if (v > best) { best = v; bi = j; } }
      topv[tid][k] = best; topi[tid][k] = bi; row[bi] = -3.0e38f;
    }
  }
  __syncthreads();
  for (int i = tid; i < 8 * 256; i += 256) {
    int h = i >> 8, ab = i & 255;
    cand[h][ab] = topv[2 * h][ab >> 4] + topv[2 * h + 1][ab & 15];
  }
  __syncthreads();
  if (tid < 8) {
    float* row = cand[tid];
    float mx = -3.0e38f;
    for (int k = 0; k < 16; ++k) {
      float best = -3.0e38f; int bi = 0;
      for (int j = 0; j < 256; ++j) { float v = row[j]; if (v > best) { best = v; bi = j; } }
      row[bi] = -3.0e38f;
      elist[tid * 16 + k] = topi[2 * tid][bi >> 4] * 128 + topi[2 * tid + 1][bi & 15];
      glist[tid * 16 + k] = best;
      if (k == 0) mx = best;
    }
    float sum = 0.f;
    for (int k = 0; k < 16; ++k) { float e = __expf(glist[tid * 16 + k] - mx); glist[tid * 16 + k] = e; sum += e; }
    float inv = 1.f / sum;
    for (int k = 0; k < 16; ++k) glist[tid * 16 + k] *= inv;
  }
  __syncthreads();
  {
    int lane = tid & 63, w = tid >> 6;
    float xv[16];
    const uint4* hr = (const uint4*)(hbuf + (size_t)r * D + lane * 16);
    uint4 a = hr[0], c = hr[1];
    xv[0] = bflo(a.x); xv[1] = bfhi(a.x); xv[2] = bflo(a.y); xv[3] = bfhi(a.y); xv[4] = bflo(a.z); xv[5] = bfhi(a.z); xv[6] = bflo(a.w); xv[7] = bfhi(a.w);
    xv[8] = bflo(c.x); xv[9] = bfhi(c.x); xv[10] = bflo(c.y); xv[11] = bfhi(c.y); xv[12] = bflo(c.z); xv[13] = bfhi(c.z); xv[14] = bflo(c.w); xv[15] = bfhi(c.w);
    for (int e = 0; e < 32; ++e) {
      int ei = w * 32 + e;
      const float4* ur = (const float4*)(ut + (size_t)elist[ei] * D + lane * 16);
      float s = 0.f;
#pragma unroll
      for (int j = 0; j < 4; ++j) { float4 uu = ur[j]; s += uu.x * xv[4 * j] + uu.y * xv[4 * j + 1] + uu.z * xv[4 * j + 2] + uu.w * xv[4 * j + 3]; }
      for (int o = 32; o > 0; o >>= 1) s += __shfl_xor(s, o);
      if (lane == 0) {
        float g = 0.5f * s * (1.f + tanhf(0.7978845608028654f * (s + 0.044715f * s * s * s)));
        wl[ei] = glist[ei] * g;
      }
    }
  }
  __syncthreads();
  float4 acc = make_float4(0.f, 0.f, 0.f, 0.f);
  for (int e = 0; e < 128; ++e) {
    float wv = wl[e];
    float4 vv = ((const float4*)(vt + (size_t)elist[e] * D))[tid];
    acc.x += wv * vv.x; acc.y += wv * vv.y; acc.z += wv * vv.z; acc.w += wv * vv.w;
  }
  int mrow = p < CTX ? 2 : b;
  const float* g2 = modv_l + mrow * NMOD + 5 * D + tid * 4;
  float4 xv = ((float4*)(xs + (size_t)r * D))[tid];
  xv.x += g2[0] * acc.x; xv.y += g2[1] * acc.y; xv.z += g2[2] * acc.z; xv.w += g2[3] * acc.w;
  ((float4*)(xs + (size_t)r * D))[tid] = xv;
}

typedef __attribute__((ext_vector_type(8))) short bf16x8;
typedef __attribute__((ext_vector_type(16))) float f32x16;
typedef __attribute__((ext_vector_type(2))) __bf16 bf16x2_t;
typedef __attribute__((ext_vector_type(2))) float f32x2_t;
#define MFMA32(a, b, c) __builtin_amdgcn_mfma_f32_32x32x16_bf16((a), (b), (c), 0, 0, 0)
DI unsigned pk2bf(float a, float b) { f32x2_t v = {a, b}; return __builtin_bit_cast(unsigned, __builtin_convertvector(v, bf16x2_t)); }
constexpr int NTHR = 512;

DI void wconv_tile(const float* __restrict__ W, bf16_t* __restrict__ Wt, int N, int tile, float* sm  ) {
  int tn = tile % (N / 64), tk = tile / (N / 64);
  int tid = threadIdx.x;
  __syncthreads();
  for (int i = tid; i < 64 * 16; i += NTHR) {
    int kr = i >> 4, c4 = (i & 15) * 4;
    float4 v = *(const float4*)(W + (size_t)(tk * 64 + kr) * N + tn * 64 + c4);
    sm[kr * 65 + c4] = v.x; sm[kr * 65 + c4 + 1] = v.y; sm[kr * 65 + c4 + 2] = v.z; sm[kr * 65 + c4 + 3] = v.w;
  }
  __syncthreads();
  for (int i = tid; i < 64 * 8; i += NTHR) {
    int n = i >> 3, k8 = (i & 7) * 8;
    unsigned w[4];
    for (int j = 0; j < 4; ++j) w[j] = pk2bf(sm[(k8 + 2 * j) * 65 + n], sm[(k8 + 2 * j + 1) * 65 + n]);
    *(uint4*)(Wt + (size_t)(tn * 64 + n) * D + tk * 64 + k8) = make_uint4(w[0], w[1], w[2], w[3]);
  }
}

template <int EPI>
DI void gemm_tile(const bf16_t* __restrict__ A, const bf16_t* __restrict__ Wt, int N, int m0, int n0, char* smem, bf16_t* __restrict__ Cb,
                  float* __restrict__ xs, const float* __restrict__ gate_base) {
  constexpr int K = D;
  const int tid = threadIdx.x, lane = tid & 63, wid = tid >> 6;
  const int wm = wid & 1, wn = wid >> 1;
  const int r = lane & 31, h = lane >> 5;
  f32x16 acc0, acc1;
  for (int i = 0; i < 16; ++i) { acc0[i] = 0.f; acc1[i] = 0.f; }
  const int lrow = tid >> 3, lch = tid & 7;
  const bf16_t* Ag = A + (size_t)(m0 + lrow) * K + lch * 8;
  const bf16_t* Bg = Wt + (size_t)(n0 + lrow) * K + lch * 8;
  const int woff = lrow * 128 + ((lch ^ ((lrow >> 1) & 7)) << 4);
  uint4 ra0, ra1, rb0, rb1;
  ra0 = *(const uint4*)(Ag); ra1 = *(const uint4*)(Ag + (size_t)64 * K);
  rb0 = *(const uint4*)(Bg); rb1 = *(const uint4*)(Bg + (size_t)64 * K);
  __syncthreads();
  *(uint4*)(smem + woff) = ra0; *(uint4*)(smem + woff + 8192) = ra1;
  *(uint4*)(smem + 16384 + woff) = rb0; *(uint4*)(smem + 16384 + woff + 8192) = rb1;
  __syncthreads();
  const int sw = (r >> 1) & 7;
  const int aoff0 = (wm * 64 + r) * 128, aoff1 = aoff0 + 32 * 128;
  const int boff = 16384 + (wn * 32 + r) * 128;
#pragma unroll 1
  for (int kt = 0; kt < K / 64; ++kt) {
    const char* st = smem + (kt & 1) * 32768;
    if (kt + 1 < K / 64) {
      ra0 = *(const uint4*)(Ag + (kt + 1) * 64); ra1 = *(const uint4*)(Ag + (size_t)64 * K + (kt + 1) * 64);
      rb0 = *(const uint4*)(Bg + (kt + 1) * 64); rb1 = *(const uint4*)(Bg + (size_t)64 * K + (kt + 1) * 64);
    }
#pragma unroll
    for (int s = 0; s < 4; ++s) {
      int co = ((2 * s + h) ^ sw) << 4;
      bf16x8 a0 = *(const bf16x8*)(st + aoff0 + co);
      bf16x8 a1 = *(const bf16x8*)(st + aoff1 + co);
      bf16x8 b = *(const bf16x8*)(st + boff + co);
      acc0 = MFMA32(a0, b, acc0);
      acc1 = MFMA32(a1, b, acc1);
    }
    if (kt + 1 < K / 64) {
      char* sn = smem + ((kt + 1) & 1) * 32768;
      *(uint4*)(sn + woff) = ra0; *(uint4*)(sn + woff + 8192) = ra1;
      *(uint4*)(sn + 16384 + woff) = rb0; *(uint4*)(sn + 16384 + woff + 8192) = rb1;
    }
    __syncthreads();
  }
  float* Cs = (float*)smem;
  constexpr int CS = 132;
#pragma unroll
  for (int i = 0; i < 16; ++i) {
    int row = (i & 3) + 8 * (i >> 2) + 4 * h;
    Cs[(wm * 64 + row) * CS + wn * 32 + r] = acc0[i];
    Cs[(wm * 64 + 32 + row) * CS + wn * 32 + r] = acc1[i];
  }
  __syncthreads();
  if (EPI == 0) {
    for (int i = tid; i < 128 * 16; i += NTHR) {
      int row = i >> 4, c8 = (i & 15) * 8;
      const float* cr = Cs + row * CS + c8;
      float4 v0 = *(const float4*)cr, v1 = *(const float4*)(cr + 4);
      *(uint4*)(Cb + (size_t)(m0 + row) * N + n0 + c8) = make_uint4(pk2bf(v0.x, v0.y), pk2bf(v0.z, v0.w), pk2bf(v1.x, v1.y), pk2bf(v1.z, v1.w));
    }
  } else {
    for (int i = tid; i < 128 * 32; i += NTHR) {
      int row = i >> 5, c4 = (i & 31) * 4;
      int rr = m0 + row; int b = rr / NT, p = rr % NT; int mrow = p < CTX ? 2 : b;
      const float* gt = gate_base + mrow * NMOD + n0 + c4;
      float4 v = *(const float4*)(Cs + row * CS + c4);
      float4 xv = *(float4*)(xs + (size_t)rr * D + n0 + c4);
      xv.x += gt[0] * v.x; xv.y += gt[1] * v.y; xv.z += gt[2] * v.z; xv.w += gt[3] * v.w;
      *(float4*)(xs + (size_t)rr * D + n0 + c4) = xv;
    }
  }
}

__global__ __launch_bounds__(NTHR) void k_wconv(const float* __restrict__ W, bf16_t* __restrict__ Wt, int N) {
  __shared__ float sm[64 * 65];
  int ntiles = (N / 64) * (D / 64);
  for (int t = blockIdx.x; t < ntiles; t += gridDim.x) wconv_tile(W, Wt, N, t, sm);
}
template <int EPI>
__global__ __launch_bounds__(NTHR) void k_gemm(const bf16_t* __restrict__ A, const bf16_t* __restrict__ Wt, int N, bf16_t* __restrict__ Cb,
                                               float* __restrict__ xs, const float* __restrict__ gate_base) {
  extern __shared__ __attribute__((aligned(16))) char smem[];
  int nt_n = N / 128, ntiles = (R / 128) * nt_n;
  for (int t = blockIdx.x; t < ntiles; t += gridDim.x) {
    int tm = t / nt_n, tn = t % nt_n;
    gemm_tile<EPI>(A, Wt, N, tm * 128, tn * 128, smem, Cb, xs, gate_base);
  }
}

struct AttnArgs {
  const bf16_t *QA, *KA, *VAt, *QW, *KW, *VWt, *QG, *KG, *VGt;
  const float *g_qk_diff, *g_qk_win, *g_qk_glob, *sink, *lambda_diff, *g_mix_out;
  float lambda_init;
  int pad0;
  bf16_t* A2;
  float* Oslab;
  float* Lslab;
};

template <int TYPE>
DI void attn_item(const AttnArgs& a, int b, int g, int p0, int ctx0, int nctx, int lat0, int nkt, int half, char* smem) {
  constexpr int DQK = TYPE == 0 ? 32 : 64;
  constexpr int KS = DQK / 16;
  const int tid = threadIdx.x, lane = tid & 63, wid = tid >> 6;
  const int r = lane & 31, h = lane >> 5;
  const bf16_t *Q0, *Q1, *K0, *K1, *Vt;
  const float* gqk;
  if (TYPE == 0) {
    Q0 = a.QA + ((size_t)b * 8 + 2 * g) * NT * 32; Q1 = Q0 + (size_t)NT * 32;
    K0 = a.KA + ((size_t)b * 8 + 2 * g) * NT * 32; K1 = K0 + (size_t)NT * 32;
    Vt = a.VAt + ((size_t)b * 4 + g) * 64 * NT; gqk = a.g_qk_diff;
  } else if (TYPE == 1) {
    Q0 = a.QW + ((size_t)b * 4 + 2 * g) * NT * 64; Q1 = Q0 + (size_t)NT * 64;
    K0 = a.KW + ((size_t)b * 2 + g) * NT * 64; K1 = K0;
    Vt = a.VWt + ((size_t)b * 2 + g) * 64 * NT; gqk = a.g_qk_win;
  } else {
    Q0 = a.QG + ((size_t)b * 4 + 2 * g) * NT * 64; Q1 = Q0 + (size_t)NT * 64;
    K0 = a.KG + ((size_t)b * 2 + g) * NT * 64; K1 = K0;
    Vt = a.VGt + ((size_t)b * 2 + g) * 64 * NT; gqk = a.g_qk_glob;
  }
  (void)gqk;
  const int qpos = p0 + wid * 32 + r;
  bf16x8 qf0[KS], qf1[KS];
#pragma unroll
  for (int s = 0; s < KS; ++s) {
    qf0[s] = *(const bf16x8*)(Q0 + (size_t)qpos * DQK + 16 * s + 8 * h);
    qf1[s] = *(const bf16x8*)(Q1 + (size_t)qpos * DQK + 16 * s + 8 * h);
  }
  f32x16 O00, O01, O10, O11, Zero;
#pragma unroll
  for (int i = 0; i < 16; ++i) { O00[i] = 0.f; O01[i] = 0.f; O10[i] = 0.f; O11[i] = 0.f; Zero[i] = 0.f; }
  float l0 = 0.f, l1 = 0.f;

  uint4 st0, st1, st2, st3;
  auto tile_of = [&](int it) { return it < nctx ? ctx0 + it : lat0 + it - nctx; };
  const int vrow0 = tid >> 4, vch = tid & 15;
#define ATT_GLOAD(kt_)                                                                                   \
  {                                                                                                      \
    const int kt__ = (kt_);                                                                              \
    if (TYPE == 0) {                                                                                     \
      st0 = *(const uint4*)(K0 + (size_t)kt__ * 128 * 32 + tid * 8);                                     \
      st1 = *(const uint4*)(K1 + (size_t)kt__ * 128 * 32 + tid * 8);                                     \
    } else {                                                                                             \
      st0 = *(const uint4*)(K0 + (size_t)kt__ * 128 * 64 + tid * 8);                                     \
      st1 = *(const uint4*)(K0 + (size_t)kt__ * 128 * 64 + (tid + 512) * 8);                             \
    }                                                                                                    \
    st2 = *(const uint4*)(Vt + (size_t)vrow0 * NT + kt__ * 128 + vch * 8);                               \
    st3 = *(const uint4*)(Vt + (size_t)(vrow0 + 32) * NT + kt__ * 128 + vch * 8);                        \
  }
#define ATT_SSTORE(sb_)                                                                                  \
  {                                                                                                      \
    char* sb__ = (sb_);                                                                                  \
    if (TYPE == 0) {                                                                                     \
      int row = tid >> 2, ch = tid & 3;                                                                  \
      int off = row * 64 + ((ch ^ ((row >> 2) & 3)) << 4);                                               \
      *(uint4*)(sb__ + off) = st0;                                                                       \
      *(uint4*)(sb__ + 8192 + off) = st1;                                                                \
    } else {                                                                                             \
      int row = tid >> 3, ch = tid & 7;                                                                  \
      int off = row * 128 + ((ch ^ ((row >> 1) & 7)) << 4);                                              \
      *(uint4*)(sb__ + off) = st0;                                                                       \
      *(uint4*)(sb__ + off + 8192) = st1;                                                                \
    }                                                                                                    \
    int voff = 16384 + vrow0 * 256 + ((vch ^ (vrow0 & 15)) << 4);                                        \
    *(uint4*)(sb__ + voff) = st2;                                                                        \
    *(uint4*)(sb__ + voff + 8192) = st3;                                                                 \
  }
  ATT_GLOAD(tile_of(0));
  __syncthreads();
  ATT_SSTORE(smem);
  __syncthreads();
  const int qwave = p0 + wid * 32;
#pragma unroll 1
  for (int it = 0; it < nkt; ++it) {
    const int kt = tile_of(it);
    const char* sb = smem + (it & 1) * 32768;
    if (it + 1 < nkt) ATT_GLOAD(tile_of(it + 1));
#pragma unroll 1
    for (int j = 0; j < 4; ++j) {
      const int kbase = kt * 128 + 32 * j;
      bool masked = false;
      if (TYPE == 1) {
        if (kbase >= CTX && p0 >= CTX) {
          if (kbase > qwave + 31 + 128 || kbase + 31 < qwave - 128) continue;
          masked = true;
        }
      }
      f32x16 S0 = Zero, S1 = Zero;
#pragma unroll
      for (int s = 0; s < KS; ++s) {
        if (TYPE == 0) {
          int row = 32 * j + r;
          int off = row * 64 + (((2 * s + h) ^ ((row >> 2) & 3)) << 4);
          bf16x8 k0 = *(const bf16x8*)(sb + off);
          bf16x8 k1 = *(const bf16x8*)(sb + 8192 + off);
          S0 = MFMA32(k0, qf0[s], S0);
          S1 = MFMA32(k1, qf1[s], S1);
        } else {
          int row = 32 * j + r;
          int off = row * 128 + (((2 * s + h) ^ ((row >> 1) & 7)) << 4);
          bf16x8 k0 = *(const bf16x8*)(sb + off);
          S0 = MFMA32(k0, qf0[s], S0);
          S1 = MFMA32(k0, qf1[s], S1);
        }
      }
      float pa[16], pb[16];
#pragma unroll
      for (int i = 0; i < 16; ++i) {
        float e0 = __builtin_amdgcn_exp2f(S0[i]);
        float e1 = __builtin_amdgcn_exp2f(S1[i]);
        if (TYPE == 1) {
          if (masked) {
            int kp = kbase + (i & 3) + 8 * (i >> 2) + 4 * h;
            int dd = kp - qpos;
            bool ok = (dd <= 128) && (dd >= -128);
            e0 = ok ? e0 : 0.f; e1 = ok ? e1 : 0.f;
          }
        }
        pa[i] = e0; pb[i] = e1;
      }
      l0 += ((pa[0] + pa[1]) + (pa[2] + pa[3])) + ((pa[4] + pa[5]) + (pa[6] + pa[7])) + ((pa[8] + pa[9]) + (pa[10] + pa[11])) + ((pa[12] + pa[13]) + (pa[14] + pa[15]));
      l1 += ((pb[0] + pb[1]) + (pb[2] + pb[3])) + ((pb[4] + pb[5]) + (pb[6] + pb[7])) + ((pb[8] + pb[9]) + (pb[10] + pb[11])) + ((pb[12] + pb[13]) + (pb[14] + pb[15]));
      bf16x8 pf0[2], pf1[2];
#pragma unroll
      for (int s2 = 0; s2 < 2; ++s2) {
        unsigned w0[4], w1[4];
#pragma unroll
        for (int e = 0; e < 4; ++e) {
          w0[e] = pk2bf(pa[8 * s2 + 2 * e], pa[8 * s2 + 2 * e + 1]);
          w1[e] = pk2bf(pb[8 * s2 + 2 * e], pb[8 * s2 + 2 * e + 1]);
        }
        pf0[s2] = __builtin_bit_cast(bf16x8, make_uint4(w0[0], w0[1], w0[2], w0[3]));
        pf1[s2] = __builtin_bit_cast(bf16x8, make_uint4(w1[0], w1[1], w1[2], w1[3]));
      }
#pragma unroll
      for (int s2 = 0; s2 < 2; ++s2) {
        int ch = 4 * j + 2 * s2 + h;
        bf16x8 v0 = *(const bf16x8*)(sb + 16384 + r * 256 + ((ch ^ (r & 15)) << 4));
        bf16x8 v1 = *(const bf16x8*)(sb + 16384 + (32 + r) * 256 + ((ch ^ (r & 15)) << 4));
        O00 = MFMA32(v0, pf0[s2], O00);
        O01 = MFMA32(v1, pf0[s2], O01);
        O10 = MFMA32(v0, pf1[s2], O10);
        O11 = MFMA32(v1, pf1[s2], O11);
      }
    }
    if (it + 1 < nkt) ATT_SSTORE(smem + ((it + 1) & 1) * 32768);
    __syncthreads();
  }
  l0 += __shfl_xor(l0, 32);
  l1 += __shfl_xor(l1, 32);
  if (TYPE == 1) {
    l0 += __builtin_amdgcn_exp2f(a.sink[2 * g] * LOG2E);
    l1 += __builtin_amdgcn_exp2f(a.sink[2 * g + 1] * LOG2E);
  }
  const size_t orow = (size_t)b * NT + qpos;
  if (TYPE == 2) {
#pragma unroll
    for (int x = 0; x < 2; ++x) {
      int head = 2 * g + x;
      float* dst = a.Oslab + ((((size_t)half * NB + b) * 4 + head) * NT + qpos) * 64;
#pragma unroll
      for (int dt = 0; dt < 2; ++dt) {
        const f32x16& O = x == 0 ? (dt == 0 ? O00 : O01) : (dt == 0 ? O10 : O11);
#pragma unroll
        for (int q4 = 0; q4 < 4; ++q4)
          *(float4*)(dst + 32 * dt + 8 * q4 + 4 * h) = make_float4(O[4 * q4], O[4 * q4 + 1], O[4 * q4 + 2], O[4 * q4 + 3]);
      }
      if (h == 0) a.Lslab[(((size_t)half * NB + b) * 4 + head) * NT + qpos] = x == 0 ? l0 : l1;
    }
  } else if (TYPE == 0) {
    float s0 = 0.f, s1 = 0.f;
    for (int d = 0; d < 32; ++d) { s0 += a.lambda_diff[d] * a.lambda_diff[32 + d]; s1 += a.lambda_diff[64 + d] * a.lambda_diff[96 + d]; }
    const float lam = __expf(s0) - __expf(s1) + a.lambda_init;
    const float i0 = 1.f / l0, i1 = lam / l1;
    float o[32];
    float ss = 0.f;
#pragma unroll
    for (int i = 0; i < 16; ++i) {
      o[i] = O00[i] * i0 - O10[i] * i1;
      o[16 + i] = O01[i] * i0 - O11[i] * i1;
      ss += o[i] * o[i] + o[16 + i] * o[16 + i];
    }
    ss += __shfl_xor(ss, 32);
    const float rs = rsqrtf(ss * (1.f / 64) + EPS) * (1.f - a.lambda_init);
    const float* gm = a.g_mix_out + g * 64;
    bf16_t* dst = a.A2 + orow * D + g * 64;
#pragma unroll
    for (int dt = 0; dt < 2; ++dt)
#pragma unroll
      for (int q4 = 0; q4 < 4; ++q4) {
        int dv = 32 * dt + 8 * q4 + 4 * h;
        const float* ov = o + 16 * dt + 4 * q4;
        uint2 w;
        w.x = pk2bf(ov[0] * rs * gm[dv], ov[1] * rs * gm[dv + 1]);
        w.y = pk2bf(ov[2] * rs * gm[dv + 2], ov[3] * rs * gm[dv + 3]);
        *(uint2*)(dst + dv) = w;
      }
  } else {
#pragma unroll
    for (int x = 0; x < 2; ++x) {
      const float inv = 1.f / (x == 0 ? l0 : l1);
      float o[32];
      float ss = 0.f;
#pragma unroll
      for (int i = 0; i < 16; ++i) {
        o[i] = (x == 0 ? O00[i] : O10[i]) * inv;
        o[16 + i] = (x == 0 ? O01[i] : O11[i]) * inv;
        ss += o[i] * o[i] + o[16 + i] * o[16 + i];
      }
      ss += __shfl_xor(ss, 32);
      const float rs = rsqrtf(ss * (1.f / 64) + EPS);
      const int col0 = 256 + (2 * g + x) * 64;
      const float* gm = a.g_mix_out + col0;
      bf16_t* dst = a.A2 + orow * D + col0;
#pragma unroll
      for (int dt = 0; dt < 2; ++dt)
#pragma unroll
        for (int q4 = 0; q4 < 4; ++q4) {
          int dv = 32 * dt + 8 * q4 + 4 * h;
          const float* ov = o + 16 * dt + 4 * q4;
          uint2 w;
          w.x = pk2bf(ov[0] * rs * gm[dv], ov[1] * rs * gm[dv + 1]);
          w.y = pk2bf(ov[2] * rs * gm[dv + 2], ov[3] * rs * gm[dv + 3]);
          *(uint2*)(dst + dv) = w;
        }
    }
  }
}

DI void attn_dispatch(const AttnArgs& a, int idx, int want_ctx, char* smem) {
  if (idx < 256) {
    int b = idx >> 7, g = (idx >> 5) & 3, qt = 1 + (idx & 31);
    attn_item<0>(a, b, g, qt * 256, 0, 2, 2, 66, 0, smem);
  } else if (idx < 512) {
    int i = idx - 256; int half = i >> 7, b = (i >> 6) & 1, g = (i >> 5) & 1, qt = 1 + (i & 31);
    if (half == 0) attn_item<2>(a, b, g, qt * 256, 0, 2, 2, 33, 0, smem);
    else attn_item<2>(a, b, g, qt * 256, 0, 0, 33, 33, 1, smem);
  } else if (idx < 640) {
    int i = idx - 512; int b = i >> 6, g = (i >> 5) & 1, qt = 1 + (i & 31);
    int lo = max(2, 2 * qt - 1), hi = min(65, 2 * qt + 2);
    attn_item<1>(a, b, g, qt * 256, 0, 2, lo, 2 + (hi - lo + 1), 0, smem);
  } else if (want_ctx) {
    int i = idx - 640;
    if (i < 8) attn_item<0>(a, i >> 2, i & 3, 0, 0, 2, 0, 2, 0, smem);
    else if (i < 16) { int k = i - 8; int half = k >> 2, b = (k >> 1) & 1, g = k & 1; attn_item<2>(a, b, g, 0, half, 1, 0, 1, half, smem); }
    else if (i < 20) { int k = i - 16; attn_item<1>(a, k >> 1, k & 1, 0, 0, 2, 0, 2, 0, smem); }
  }
}
__global__ __launch_bounds__(NTHR) void k_attn(AttnArgs a, int want_ctx) {
  extern __shared__ __attribute__((aligned(16))) char smem[];
  int nitems = 640 + (want_ctx ? 20 : 0);
  for (int idx = blockIdx.x; idx < nitems; idx += gridDim.x) attn_dispatch(a, idx, want_ctx, smem);
}
__global__ __launch_bounds__(256) void k_glob_fin(const float* __restrict__ Oslab, const float* __restrict__ Lslab, const float* __restrict__ g_mix_out,
                                                  bf16_t* __restrict__ A2, int want_ctx) {
  int idx = blockIdx.x * 256 + threadIdx.x;
  int p = idx % NT; int hd = (idx / NT) % 4; int b = idx / (NT * 4);
  if (p < CTX && !want_ctx) return;
  size_t i0 = (((size_t)0 * NB + b) * 4 + hd) * NT + p, i1 = (((size_t)1 * NB + b) * 4 + hd) * NT + p;
  float inv = 1.f / (Lslab[i0] + Lslab[i1]);
  float o[64]; float ss = 0.f;
  const float4* a0 = (const float4*)(Oslab + i0 * 64); const float4* a1 = (const float4*)(Oslab + i1 * 64);
#pragma unroll
  for (int i = 0; i < 16; ++i) {
    float4 x = a0[i], y = a1[i];
    o[4 * i] = (x.x + y.x) * inv; o[4 * i + 1] = (x.y + y.y) * inv; o[4 * i + 2] = (x.z + y.z) * inv; o[4 * i + 3] = (x.w + y.w) * inv;
    ss += o[4 * i] * o[4 * i] + o[4 * i + 1] * o[4 * i + 1] + o[4 * i + 2] * o[4 * i + 2] + o[4 * i + 3] * o[4 * i + 3];
  }
  float rs = rsqrtf(ss * (1.f / 64) + EPS);
  const float* gm = g_mix_out + 512 + hd * 64;
  uint4* dst = (uint4*)(A2 + ((size_t)b * NT + p) * D + 512 + hd * 64);
#pragma unroll
  for (int i = 0; i < 8; ++i)
    dst[i] = make_uint4(pk2bf(o[8 * i] * rs * gm[8 * i], o[8 * i + 1] * rs * gm[8 * i + 1]), pk2bf(o[8 * i + 2] * rs * gm[8 * i + 2], o[8 * i + 3] * rs * gm[8 * i + 3]),
                        pk2bf(o[8 * i + 4] * rs * gm[8 * i + 4], o[8 * i + 5] * rs * gm[8 * i + 5]), pk2bf(o[8 * i + 6] * rs * gm[8 * i + 6], o[8 * i + 7] * rs * gm[8 * i + 7]));
}

typedef __attribute__((ext_vector_type(4))) float f32x4v;
DI void tabconv_row(const float* __restrict__ src, unsigned char* __restrict__ dst, float* __restrict__ scale, size_t row) {
  const int lane = threadIdx.x & 63;
  const float4* sp = (const float4*)(src + row * D + lane * 16);
  float4 v0 = sp[0], v1 = sp[1], v2 = sp[2], v3 = sp[3];
  float m = fmaxf(fmaxf(fmaxf(fabsf(v0.x), fabsf(v0.y)), fmaxf(fabsf(v0.z), fabsf(v0.w))), fmaxf(fmaxf(fabsf(v1.x), fabsf(v1.y)), fmaxf(fabsf(v1.z), fabsf(v1.w))));
  m = fmaxf(m, fmaxf(fmaxf(fmaxf(fabsf(v2.x), fabsf(v2.y)), fmaxf(fabsf(v2.z), fabsf(v2.w))), fmaxf(fmaxf(fabsf(v3.x), fabsf(v3.y)), fmaxf(fabsf(v3.z), fabsf(v3.w)))));
  for (int o = 32; o > 0; o >>= 1) m = fmaxf(m, __shfl_xor(m, o));
  m = fmaxf(m, 1e-30f);
  const float sc = m * (1.f / 448.f), inv = 448.f / m;
  int w0 = __builtin_amdgcn_cvt_pk_fp8_f32(v0.x * inv, v0.y * inv, 0, false); w0 = __builtin_amdgcn_cvt_pk_fp8_f32(v0.z * inv, v0.w * inv, w0, true);
  int w1 = __builtin_amdgcn_cvt_pk_fp8_f32(v1.x * inv, v1.y * inv, 0, false); w1 = __builtin_amdgcn_cvt_pk_fp8_f32(v1.z * inv, v1.w * inv, w1, true);
  int w2 = __builtin_amdgcn_cvt_pk_fp8_f32(v2.x * inv, v2.y * inv, 0, false); w2 = __builtin_amdgcn_cvt_pk_fp8_f32(v2.z * inv, v2.w * inv, w2, true);
  int w3 = __builtin_amdgcn_cvt_pk_fp8_f32(v3.x * inv, v3.y * inv, 0, false); w3 = __builtin_amdgcn_cvt_pk_fp8_f32(v3.z * inv, v3.w * inv, w3, true);
  *(uint4*)(dst + row * D + lane * 16) = make_uint4((unsigned)w0, (unsigned)w1, (unsigned)w2, (unsigned)w3);
  if (lane == 0) scale[row] = sc;
}
__global__ __launch_bounds__(NTHR) void k_tabconv(const float* __restrict__ src, unsigned char* __restrict__ dst, float* __restrict__ scale, int nrows) {
  int gw = blockIdx.x * 8 + (threadIdx.x >> 6);
  for (int row = gw; row < nrows; row += gridDim.x * 8) tabconv_row(src, dst, scale, (size_t)row);
}
__global__ __launch_bounds__(256) void k_f2bf(const float* __restrict__ src, bf16_t* __restrict__ dst, int n4) {
  for (int i = blockIdx.x * 256 + threadIdx.x; i < n4; i += gridDim.x * 256) {
    float4 v = ((const float4*)src)[i];
    ((uint2*)dst)[i] = make_uint2(pk2bf(v.x, v.y), pk2bf(v.z, v.w));
  }
}

DI void score_tile(const bf16_t* __restrict__ qbuf, const bf16_t* __restrict__ keysb, int m0, int hp, char* smem, float* __restrict__ topv,
                   unsigned char* __restrict__ topi) {
  const int tid = threadIdx.x, lane = tid & 63, wid = tid >> 6;
  const int wm = wid & 1, wn = wid >> 1;
  const int r = lane & 31, h = lane >> 5;
  f32x16 acc0, acc1;
  for (int i = 0; i < 16; ++i) { acc0[i] = 0.f; acc1[i] = 0.f; }
  const int lrow = tid >> 3, lch = tid & 7;
  const bf16_t* Ag = qbuf + (size_t)(m0 + lrow) * 2048 + hp * 128 + lch * 8;
  const bf16_t* Bg = keysb + ((size_t)hp * 128 + lrow) * 128 + lch * 8;
  const int woff = lrow * 128 + ((lch ^ ((lrow >> 1) & 7)) << 4);
  __syncthreads();
#pragma unroll
  for (int kt = 0; kt < 2; ++kt) {
    char* sn = smem + kt * 32768;
    *(uint4*)(sn + woff) = *(const uint4*)(Ag + kt * 64);
    *(uint4*)(sn + woff + 8192) = *(const uint4*)(Ag + (size_t)64 * 2048 + kt * 64);
    *(uint4*)(sn + 16384 + woff) = *(const uint4*)(Bg + kt * 64);
    *(uint4*)(sn + 16384 + woff + 8192) = *(const uint4*)(Bg + 64 * 128 + kt * 64);
  }
  __syncthreads();
  const int sw = (r >> 1) & 7;
  const int aoff0 = (wm * 64 + r) * 128, aoff1 = aoff0 + 32 * 128;
  const int boff = 16384 + (wn * 32 + r) * 128;
#pragma unroll
  for (int kt = 0; kt < 2; ++kt) {
    const char* st = smem + kt * 32768;
#pragma unroll
    for (int s = 0; s < 4; ++s) {
      int co = ((2 * s + h) ^ sw) << 4;
      bf16x8 a0 = *(const bf16x8*)(st + aoff0 + co);
      bf16x8 a1 = *(const bf16x8*)(st + aoff1 + co);
      bf16x8 b = *(const bf16x8*)(st + boff + co);
      acc0 = MFMA32(a0, b, acc0);
      acc1 = MFMA32(a1, b, acc1);
    }
  }
  __syncthreads();
  float* Cs = (float*)smem;
  constexpr int CS = 132;
#pragma unroll
  for (int i = 0; i < 16; ++i) {
    int row = (i & 3) + 8 * (i >> 2) + 4 * h;
    Cs[(wm * 64 + row) * CS + wn * 32 + r] = acc0[i];
    Cs[(wm * 64 + 32 + row) * CS + wn * 32 + r] = acc1[i];
  }
  __syncthreads();
  const int row = tid >> 2, q = tid & 3;
  float v[32];
#pragma unroll
  for (int i = 0; i < 32; ++i) v[i] = Cs[row * CS + 4 * i + q];
#pragma unroll 1
  for (int k = 0; k < 16; ++k) {
    float m = v[0]; int li = 0;
#pragma unroll
    for (int i = 1; i < 32; ++i) { bool gt = v[i] > m; m = gt ? v[i] : m; li = gt ? i : li; }
    int col = 4 * li + q;
    float m1 = __shfl_xor(m, 1); int c1 = __shfl_xor(col, 1);
    bool t1 = (m1 > m) || (m1 == m && c1 < col); m = t1 ? m1 : m; col = t1 ? c1 : col;
    float m2 = __shfl_xor(m, 2); int c2 = __shfl_xor(col, 2);
    bool t2 = (m2 > m) || (m2 == m && c2 < col); m = t2 ? m2 : m; col = t2 ? c2 : col;
    const bool own = (col & 3) == q; const int wi = col >> 2;
#pragma unroll
    for (int i = 0; i < 32; ++i) v[i] = (own && i == wi) ? -3.0e38f : v[i];
    if ((k & 3) == q) {
      size_t o = ((size_t)(m0 + row) * 16 + hp) * 16 + k;
      topv[o] = m; topi[o] = (unsigned char)col;
    }
  }
}
__global__ __launch_bounds__(NTHR) void k_scores(const bf16_t* __restrict__ qbuf, const bf16_t* __restrict__ keysb, float* __restrict__ topv,
                                                 unsigned char* __restrict__ topi) {
  extern __shared__ __attribute__((aligned(16))) char smem[];
  int ntiles = (R / 128) * 16;
  for (int t = blockIdx.x; t < ntiles; t += gridDim.x) score_tile(qbuf, keysb, (t >> 4) * 128, t & 15, smem, topv, topi);
}

DI void merge_one(const float* __restrict__ topv, const unsigned char* __restrict__ topi, int r, int hd, int* __restrict__ experts,
                  float* __restrict__ gates) {
  const float* va = topv + ((size_t)r * 16 + 2 * hd) * 16;
  const float* vb = va + 16;
  const unsigned char* ia = topi + ((size_t)r * 16 + 2 * hd) * 16;
  const unsigned char* ib = ia + 16;
  float a[16], bq[16];
#pragma unroll
  for (int i = 0; i < 4; ++i) {
    float4 x = ((const float4*)va)[i], y = ((const float4*)vb)[i];
    a[4 * i] = x.x; a[4 * i + 1] = x.y; a[4 * i + 2] = x.z; a[4 * i + 3] = x.w;
    bq[4 * i] = y.x; bq[4 * i + 1] = y.y; bq[4 * i + 2] = y.z; bq[4 * i + 3] = y.w;
  }
  float cv[50];
  {
    int n = 0;
#pragma unroll
    for (int i = 0; i < 16; ++i)
#pragma unroll
      for (int j = 0; j < 16; ++j)
        if ((i + 1) * (j + 1) <= 16) { cv[n] = a[i] + bq[j]; ++n; }
  }
  float best[16]; int bidx[16];
#pragma unroll
  for (int k = 0; k < 16; ++k) {
    float m = cv[0]; int mi = 0;
#pragma unroll
    for (int n = 1; n < 50; ++n) { bool gt = cv[n] > m; m = gt ? cv[n] : m; mi = gt ? n : mi; }
#pragma unroll
    for (int n = 0; n < 50; ++n) cv[n] = (n == mi) ? -3.0e38f : cv[n];
    best[k] = m; bidx[k] = mi;
  }
  float mx = best[0], sum = 0.f;
#pragma unroll
  for (int k = 0; k < 16; ++k) { best[k] = __expf(best[k] - mx); sum += best[k]; }
  const float inv = 1.f / sum;
#pragma unroll
  for (int k = 0; k < 16; ++k) {
    int mi = bidx[k];
    int ci = 0, cj = 0;
    {
      int n = 0;
#pragma unroll
      for (int i = 0; i < 16; ++i)
#pragma unroll
        for (int j = 0; j < 16; ++j)
          if ((i + 1) * (j + 1) <= 16) { if (n == mi) { ci = i; cj = j; } ++n; }
    }
    experts[(size_t)r * 128 + hd * 16 + k] = (int)ia[ci] * 128 + (int)ib[cj];
    gates[(size_t)r * 128 + hd * 16 + k] = best[k] * inv;
  }
}
__global__ __launch_bounds__(256) void k_merge(const float* __restrict__ topv, const unsigned char* __restrict__ topi, int* __restrict__ experts,
                                               float* __restrict__ gates, int want_ctx) {
  int idx = blockIdx.x * 256 + threadIdx.x;
  if (idx >= R * 8) return;
  int r = idx >> 3, hd = idx & 7;
  if ((r % NT) < CTX && !want_ctx) return;
  merge_one(topv, topi, r, hd, experts, gates);
}

DI void peer_token(int r, const bf16_t* __restrict__ hbuf, const int* __restrict__ experts, const float* __restrict__ gates,
                   const unsigned char* __restrict__ u8, const float* __restrict__ us, const unsigned char* __restrict__ v8,
                   const float* __restrict__ vs, const float* __restrict__ modv_l, float* __restrict__ xs, float* wdots  ) {
  const int lane = threadIdx.x & 63;
  float x[16];
  {
    const uint4* hr = (const uint4*)(hbuf + (size_t)r * D + lane * 16);
    uint4 a = hr[0], c = hr[1];
    x[0] = bflo(a.x); x[1] = bfhi(a.x); x[2] = bflo(a.y); x[3] = bfhi(a.y); x[4] = bflo(a.z); x[5] = bfhi(a.z); x[6] = bflo(a.w); x[7] = bfhi(a.w);
    x[8] = bflo(c.x); x[9] = bfhi(c.x); x[10] = bflo(c.y); x[11] = bfhi(c.y); x[12] = bflo(c.z); x[13] = bfhi(c.z); x[14] = bflo(c.w); x[15] = bfhi(c.w);
  }
  const int e0 = experts[(size_t)r * 128 + lane], e1 = experts[(size_t)r * 128 + 64 + lane];
  const float g0 = gates[(size_t)r * 128 + lane], g1 = gates[(size_t)r * 128 + 64 + lane];
  const float us0 = us[e0], us1 = us[e1], vs0 = vs[e0], vs1 = vs[e1];
#pragma unroll 1
  for (int k0 = 0; k0 < 128; k0 += 8) {
    uint4 rw[8];
#pragma unroll
    for (int j = 0; j < 8; ++j) {
      int k = k0 + j;
      int e = __builtin_amdgcn_readlane(k0 < 64 ? e0 : e1, k & 63);
      rw[j] = *(const uint4*)(u8 + (size_t)e * D + lane * 16);
    }
    float p[8];
#pragma unroll
    for (int j = 0; j < 8; ++j) {
      f32x2_t a0 = __builtin_amdgcn_cvt_pk_f32_fp8((int)rw[j].x, false), a1 = __builtin_amdgcn_cvt_pk_f32_fp8((int)rw[j].x, true);
      f32x2_t b0 = __builtin_amdgcn_cvt_pk_f32_fp8((int)rw[j].y, false), b1 = __builtin_amdgcn_cvt_pk_f32_fp8((int)rw[j].y, true);
      f32x2_t c0 = __builtin_amdgcn_cvt_pk_f32_fp8((int)rw[j].z, false), c1 = __builtin_amdgcn_cvt_pk_f32_fp8((int)rw[j].z, true);
      f32x2_t d0 = __builtin_amdgcn_cvt_pk_f32_fp8((int)rw[j].w, false), d1 = __builtin_amdgcn_cvt_pk_f32_fp8((int)rw[j].w, true);
      float s = a0[0] * x[0] + a0[1] * x[1] + a1[0] * x[2] + a1[1] * x[3];
      s += b0[0] * x[4] + b0[1] * x[5] + b1[0] * x[6] + b1[1] * x[7];
      s += c0[0] * x[8] + c0[1] * x[9] + c1[0] * x[10] + c1[1] * x[11];
      s += d0[0] * x[12] + d0[1] * x[13] + d1[0] * x[14] + d1[1] * x[15];
      p[j] = s;
    }
    const bool hi32 = lane & 32, hi16 = lane & 16, hi8 = lane & 8;
    float q4[4];
#pragma unroll
    for (int i = 0; i < 4; ++i) { float send = hi32 ? p[i] : p[4 + i]; float keep = hi32 ? p[4 + i] : p[i]; q4[i] = keep + __shfl_xor(send, 32); }
    float q2[2];
#pragma unroll
    for (int i = 0; i < 2; ++i) { float send = hi16 ? q4[i] : q4[2 + i]; float keep = hi16 ? q4[2 + i] : q4[i]; q2[i] = keep + __shfl_xor(send, 16); }
    float q1;
    { float send = hi8 ? q2[0] : q2[1]; float keep = hi8 ? q2[1] : q2[0]; q1 = keep + __shfl_xor(send, 8); }
    q1 += __shfl_xor(q1, 4); q1 += __shfl_xor(q1, 2); q1 += __shfl_xor(q1, 1);
    if ((lane & 7) == 0) wdots[k0 + (lane >> 3)] = q1;
  }
  float w0, w1;
  {
    float d0 = wdots[lane] * us0, d1 = wdots[64 + lane] * us1;
    float t0 = 0.5f * d0 * (1.f + tanhf(0.7978845608028654f * (d0 + 0.044715f * d0 * d0 * d0)));
    float t1 = 0.5f * d1 * (1.f + tanhf(0.7978845608028654f * (d1 + 0.044715f * d1 * d1 * d1)));
    w0 = g0 * t0 * vs0; w1 = g1 * t1 * vs1;
  }
  float acc[16];
#pragma unroll
  for (int i = 0; i < 16; ++i) acc[i] = 0.f;
#pragma unroll 1
  for (int k0 = 0; k0 < 128; k0 += 8) {
    uint4 rw[8];
#pragma unroll
    for (int j = 0; j < 8; ++j) {
      int k = k0 + j;
      int e = __builtin_amdgcn_readlane(k0 < 64 ? e0 : e1, k & 63);
      rw[j] = *(const uint4*)(v8 + (size_t)e * D + lane * 16);
    }
#pragma unroll
    for (int j = 0; j < 8; ++j) {
      int k = k0 + j;
      float w = __builtin_bit_cast(float, __builtin_amdgcn_readlane(__builtin_bit_cast(int, k0 < 64 ? w0 : w1), k & 63));
      f32x2_t a0 = __builtin_amdgcn_cvt_pk_f32_fp8((int)rw[j].x, false), a1 = __builtin_amdgcn_cvt_pk_f32_fp8((int)rw[j].x, true);
      f32x2_t b0 = __builtin_amdgcn_cvt_pk_f32_fp8((int)rw[j].y, false), b1 = __builtin_amdgcn_cvt_pk_f32_fp8((int)rw[j].y, true);
      f32x2_t c0 = __builtin_amdgcn_cvt_pk_f32_fp8((int)rw[j].z, false), c1 = __builtin_amdgcn_cvt_pk_f32_fp8((int)rw[j].z, true);
      f32x2_t d0 = __builtin_amdgcn_cvt_pk_f32_fp8((int)rw[j].w, false), d1 = __builtin_amdgcn_cvt_pk_f32_fp8((int)rw[j].w, true);
      acc[0] += w * a0[0]; acc[1] += w * a0[1]; acc[2] += w * a1[0]; acc[3] += w * a1[1];
      acc[4] += w * b0[0]; acc[5] += w * b0[1]; acc[6] += w * b1[0]; acc[7] += w * b1[1];
      acc[8] += w * c0[0]; acc[9] += w * c0[1]; acc[10] += w * c1[0]; acc[11] += w * c1[1];
      acc[12] += w * d0[0]; acc[13] += w * d0[1]; acc[14] += w * d1[0]; acc[15] += w * d1[1];
    }
  }
  const int b = r / NT, p = r % NT; const int mrow = p < CTX ? 2 : b;
  const float* g2 = modv_l + mrow * NMOD + 5 * D + lane * 16;
  float4* xp = (float4*)(xs + (size_t)r * D + lane * 16);
#pragma unroll
  for (int i = 0; i < 4; ++i) {
    float4 xv = xp[i]; float4 gg = ((const float4*)g2)[i];
    xv.x += gg.x * acc[4 * i]; xv.y += gg.y * acc[4 * i + 1]; xv.z += gg.z * acc[4 * i + 2]; xv.w += gg.w * acc[4 * i + 3];
    xp[i] = xv;
  }
}
__global__ __launch_bounds__(NTHR) void k_peer(const bf16_t* __restrict__ hbuf, const int* __restrict__ experts, const float* __restrict__ gates,
                                               const unsigned char* __restrict__ u8, const float* __restrict__ us, const unsigned char* __restrict__ v8,
                                               const float* __restrict__ vs, const float* __restrict__ modv_l, float* __restrict__ xs, int want_ctx) {
  __shared__ float wd[8][128];
  const int wid = threadIdx.x >> 6;
  for (int r = blockIdx.x * 8 + wid; r < R; r += gridDim.x * 8) {
    if ((r % NT) < CTX && !want_ctx) continue;
    peer_token(r, hbuf, experts, gates, u8, us, v8, vs, modv_l, xs, wd[wid]);
  }
}

static inline size_t align_up(size_t x) { return (x + 255) & ~(size_t)255; }

extern "C" void kernel_launch(void* const* d_in, const int* in_sizes, int n_in, void* d_out, int out_size, void* d_ws, size_t ws_size,
                              hipStream_t stream) {
  const float* x = (const float*)d_in[0];
  const float* c = (const float*)d_in[1];
  const float* ctx = (const float*)d_in[2];
  const float* c_ctx = (const float*)d_in[3];
  const float* w_mod = (const float*)d_in[4];
  const float* b_mod = (const float*)d_in[5];
  const float* g_norm_mix = (const float*)d_in[6];
  const float* w_in = (const float*)d_in[7];
  const float* g_qk_diff = (const float*)d_in[8];
  const float* lambda_diff = (const float*)d_in[9];
  const float* g_qk_win = (const float*)d_in[10];
  const float* sink_win = (const float*)d_in[11];
  const float* g_qk_glob = (const float*)d_in[12];
  const float* hy_conv_w = (const float*)d_in[13];
  const float* hy_conv_b = (const float*)d_in[14];
  const float* hy_w1 = (const float*)d_in[15];
  const float* hy_b1 = (const float*)d_in[16];
  const float* hy_w2 = (const float*)d_in[17];
  const float* hy_b2 = (const float*)d_in[18];
  const float* hy_w3 = (const float*)d_in[19];
  const float* hy_b3 = (const float*)d_in[20];
  const float* hy_freq = (const float*)d_in[21];
  const float* hy_bias = (const float*)d_in[22];
  const float* g_mix_out = (const float*)d_in[23];
  const float* w_out = (const float*)d_in[24];
  const float* g_norm_ffn = (const float*)d_in[25];
  const float* peer_wq = (const float*)d_in[26];
  const float* peer_keys = (const float*)d_in[27];
  const float* peer_u = (const float*)d_in[28];
  const float* peer_v = (const float*)d_in[29];
  float* out = (float*)d_out;

  char* ws = (char*)d_ws;
  size_t off = 0;
  auto carve = [&](size_t bytes) { char* p = ws + off; off = align_up(off + bytes); return p; };
  float* modv = (float*)carve((size_t)2 * 3 * NMOD * 4);
  float* xs = (float*)carve((size_t)R * D * 4);
  bf16_t* hbuf = (bf16_t*)carve((size_t)R * D * 2);
  bf16_t* P = (bf16_t*)carve((size_t)R * DIN * 2);
  bf16_t* qbuf = P;
  bf16_t* Wt_in = (bf16_t*)carve((size_t)2 * DIN * D * 2);
  bf16_t* Wt_out = (bf16_t*)carve((size_t)2 * D * D * 2);
  bf16_t* Wt_q = (bf16_t*)carve((size_t)2 * 2048 * D * 2);
  PrepOut po;
  po.QA = (bf16_t*)carve((size_t)NB * 8 * NT * 32 * 2);
  po.KA = (bf16_t*)carve((size_t)NB * 8 * NT * 32 * 2);
  po.VAt = (bf16_t*)carve((size_t)NB * 4 * 64 * NT * 2);
  po.QW = (bf16_t*)carve((size_t)NB * 4 * NT * 64 * 2);
  po.KW = (bf16_t*)carve((size_t)NB * 2 * NT * 64 * 2);
  po.VWt = (bf16_t*)carve((size_t)NB * 2 * 64 * NT * 2);
  po.QG = (bf16_t*)carve((size_t)NB * 4 * NT * 64 * 2);
  po.KG = (bf16_t*)carve((size_t)NB * 2 * NT * 64 * 2);
  po.VGt = (bf16_t*)carve((size_t)NB * 2 * 64 * NT * 2);
  po.uT = (float*)carve((size_t)NB * 768 * NT * 4);
  float* zT = (float*)carve((size_t)NB * 256 * NT * 4);
  float* yT = (float*)carve((size_t)NB * 256 * NT * 4);
  float* hdn2 = (float*)carve((size_t)2 * SEQ * 64 * 4);
  float* kc = (float*)carve((KC_W0 + (size_t)2 * 256 * 2 * CTX) * 4);
  bf16_t* A2 = (bf16_t*)carve((size_t)R * D * 2);
  unsigned char* u8 = (unsigned char*)carve((size_t)2 * 16384 * D);
  unsigned char* v8 = (unsigned char*)carve((size_t)2 * 16384 * D);
  float* us = (float*)carve((size_t)2 * 16384 * 4);
  float* vs = (float*)carve((size_t)2 * 16384 * 4);
  bf16_t* keysb = (bf16_t*)carve((size_t)2 * 16 * 128 * 128 * 2);
  float* topv = (float*)po.uT;
  unsigned char* topi = (unsigned char*)(topv + (size_t)R * 256);
  int* experts = (int*)(topi + (size_t)R * 256);
  float* gates = (float*)(experts + (size_t)R * 128);
  float* Otmp = (float*)P;
  if (off > ws_size) return; (void)in_sizes; (void)n_in; (void)out_size;

  k_mod<<<dim3(NMOD / 256, 2), 256, 0, stream>>>(c, c_ctx, w_mod, b_mod, modv);
  constexpr int GEMM_LDS = 128 * 132 * 4;
  hipFuncSetAttribute((const void*)k_gemm<0>, hipFuncAttributeMaxDynamicSharedMemorySize, GEMM_LDS);
  hipFuncSetAttribute((const void*)k_gemm<1>, hipFuncAttributeMaxDynamicSharedMemorySize, GEMM_LDS);
  hipFuncSetAttribute((const void*)k_attn, hipFuncAttributeMaxDynamicSharedMemorySize, 65536);
  hipFuncSetAttribute((const void*)k_scores, hipFuncAttributeMaxDynamicSharedMemorySize, GEMM_LDS);
  for (int l = 0; l < 2; ++l) {
    k_wconv<<<256, NTHR, 0, stream>>>(w_in + (size_t)l * D * DIN, Wt_in + (size_t)l * DIN * D, DIN);
    k_wconv<<<256, NTHR, 0, stream>>>(w_out + (size_t)l * D * D, Wt_out + (size_t)l * D * D, D);
    k_wconv<<<256, NTHR, 0, stream>>>(peer_wq + (size_t)l * D * 2048, Wt_q + (size_t)l * 2048 * D, 2048);
    k_tabconv<<<1024, NTHR, 0, stream>>>(peer_u + (size_t)l * 16384 * D, u8 + (size_t)l * 16384 * D, us + l * 16384, 16384);
    k_tabconv<<<1024, NTHR, 0, stream>>>(peer_v + (size_t)l * 16384 * D, v8 + (size_t)l * 16384 * D, vs + l * 16384, 16384);
    k_f2bf<<<256, 256, 0, stream>>>(peer_keys + (size_t)l * 16 * 128 * 128, keysb + (size_t)l * 16 * 128 * 128, 16 * 128 * 128 / 4);
  }
  k_init_xs<<<R, 256, 0, stream>>>(x, ctx, xs);

  for (int l = 0; l < 2; ++l) {
    int want_ctx = l < 1 ? 1 : 0;
    float lambda_init = 0.8f - 0.6f * expf(-0.3f * (float)l);
    const float* modv_l = modv + (size_t)l * 3 * NMOD;
    k_norm_mod<<<R, 256, 0, stream>>>(xs, g_norm_mix + l * D, modv_l, 0, hbuf);
    k_gemm<0><<<256, NTHR, GEMM_LDS, stream>>>(hbuf, Wt_in + (size_t)l * DIN * D, DIN, P, nullptr, nullptr);
    k_prep<<<R, 256, 0, stream>>>(P, g_qk_diff + l * 64, g_qk_win + l * 128, g_qk_glob + l * 128, hy_conv_w + l * 3 * 768,
                                  hy_conv_b + l * 768, po);
    {
      AttnArgs aa;
      memset(&aa, 0, sizeof(aa));
      aa.QA = po.QA; aa.KA = po.KA; aa.VAt = po.VAt; aa.QW = po.QW; aa.KW = po.KW; aa.VWt = po.VWt; aa.QG = po.QG; aa.KG = po.KG; aa.VGt = po.VGt;
      aa.g_qk_diff = g_qk_diff + l * 64; aa.g_qk_win = g_qk_win + l * 128; aa.g_qk_glob = g_qk_glob + l * 128; aa.sink = sink_win + l * 4;
      aa.lambda_diff = lambda_diff + l * 128; aa.g_mix_out = g_mix_out + l * D; aa.lambda_init = lambda_init; aa.A2 = A2;
      aa.Oslab = Otmp; aa.Lslab = Otmp + (size_t)2 * NB * 4 * NT * 64;
      k_attn<<<256, NTHR, 65536, stream>>>(aa, want_ctx);
      k_glob_fin<<<NB * 4 * NT / 256, 256, 0, stream>>>(aa.Oslab, aa.Lslab, g_mix_out + l * D, A2, want_ctx);
    }
    k_hy_mlp<<<SEQ + CTX, 64, 0, stream>>>(hy_w1 + l * 33 * 64, hy_b1 + l * 64, hy_w2 + l * 64 * 64, hy_b2 + l * 64, hy_freq + l * 64, hdn2);
    k_hy_filt<<<dim3(256, 2, 2), 256, 0, stream>>>(hdn2, hy_w3 + (size_t)l * 64 * 1024, hy_b3 + l * 1024, kc, want_ctx);
    k_hy_conv<0><<<dim3(SEQ / 256, 256, NB), 256, 0, stream>>>(po.uT, nullptr, zT, kc, hy_bias + l * 512, 0);
    k_hy_conv<1><<<dim3(SEQ / 256, 256, NB), 256, 0, stream>>>(po.uT, zT, yT, kc, hy_bias + l * 512, 0);
    if (want_ctx) {
      k_hy_conv<0><<<dim3(CTX / 256, 256, NB), 256, 0, stream>>>(po.uT, nullptr, zT, kc, hy_bias + l * 512, 1);
      k_hy_conv<1><<<dim3(CTX / 256, 256, NB), 256, 0, stream>>>(po.uT, zT, yT, kc, hy_bias + l * 512, 1);
    }
    k_hy_fin<<<NB * 4 * NT / 256, 256, 0, stream>>>(yT, g_mix_out + l * D, A2, want_ctx);
    k_gemm<1><<<256, NTHR, GEMM_LDS, stream>>>(A2, Wt_out + (size_t)l * D * D, D, nullptr, xs, modv_l + 2 * D);
    k_norm_mod<<<R, 256, 0, stream>>>(xs, g_norm_ffn + l * D, modv_l, 3, hbuf);
    k_gemm<0><<<256, NTHR, GEMM_LDS, stream>>>(hbuf, Wt_q + (size_t)l * 2048 * D, 2048, qbuf, nullptr, nullptr);
    k_scores<<<256, NTHR, GEMM_LDS, stream>>>(qbuf, keysb + (size_t)l * 16 * 128 * 128, topv, topi);
    k_merge<<<R * 8 / 256, 256, 0, stream>>>(topv, topi, experts, gates, want_ctx);
    k_peer<<<256, NTHR, 0, stream>>>(hbuf, experts, gates, u8 + (size_t)l * 16384 * D, us + l * 16384, v8 + (size_t)l * 16384 * D, vs + l * 16384,
                                    modv_l, xs, want_ctx);
  }
  k_final<<<NB * SEQ, 256, 0, stream>>>(xs, out);
}
```

```cpp
#include <hip/hip_runtime.h>
#include <stdint.h>
#include <string.h>

#define DI __device__ __forceinline__
typedef unsigned short bf16_t;

constexpr int D = 1024;
constexpr int NB = 2;
constexpr int SEQ = 8192;
constexpr int CTX = 256;
constexpr int NT = SEQ + CTX;
constexpr int R = NB * NT;
constexpr int DIN = 2560;
constexpr int NMOD = 6 * D;
constexpr float EPS = 1e-6f;
constexpr float LOG2E = 1.4426950408889634f;

DI bf16_t f2bf(float x) { unsigned u = __float_as_uint(x); u += 0x7fffu + ((u >> 16) & 1u); return (bf16_t)(u >> 16); }
DI float bf2f(bf16_t h) { return __uint_as_float(((unsigned)h) << 16); }
DI float bflo(unsigned w) { return __uint_as_float(w << 16); }
DI float bfhi(unsigned w) { return __uint_as_float(w & 0xffff0000u); }

DI float block_sum_256(float v, float* red) {
  for (int o = 32; o > 0; o >>= 1) v += __shfl_xor(v, o);
  int w = threadIdx.x >> 6;
  __syncthreads();
  if ((threadIdx.x & 63) == 0) red[w] = v;
  __syncthreads();
  float s = red[0] + red[1] + red[2] + red[3];
  return s;
}

__global__ __launch_bounds__(256) void k_mod(const float* __restrict__ c, const float* __restrict__ c_ctx,
                                             const float* __restrict__ w_mod, const float* __restrict__ b_mod,
                                             float* __restrict__ modv) {
  __shared__ float sc[3][D];
  int l = blockIdx.y;
  for (int i = threadIdx.x; i < 3 * D; i += 256) {
    int row = i / D, k = i % D;
    float v = row < 2 ? c[row * D + k] : c_ctx[k];
    sc[row][k] = v / (1.f + __expf(-v));
  }
  __syncthreads();
  int col = blockIdx.x * 256 + threadIdx.x;
  const float* w = w_mod + (size_t)l * D * NMOD + col;
  float a0 = 0, a1 = 0, a2 = 0;
  for (int k = 0; k < D; ++k) {
    float wv = w[(size_t)k * NMOD];
    a0 += sc[0][k] * wv; a1 += sc[1][k] * wv; a2 += sc[2][k] * wv;
  }
  float bb = b_mod[l * NMOD + col];
  modv[(l * 3 + 0) * NMOD + col] = a0 + bb;
  modv[(l * 3 + 1) * NMOD + col] = a1 + bb;
  modv[(l * 3 + 2) * NMOD + col] = a2 + bb;
}

__global__ __launch_bounds__(256) void k_init_xs(const float* __restrict__ x, const float* __restrict__ ctx, float* __restrict__ xs) {
  int r = blockIdx.x; int b = r / NT, p = r % NT;
  const float4* src = (const float4*)(p < CTX ? ctx + ((size_t)b * CTX + p) * D : x + ((size_t)b * SEQ + (p - CTX)) * D);
  ((float4*)(xs + (size_t)r * D))[threadIdx.x] = src[threadIdx.x];
}
__global__ __launch_bounds__(256) void k_final(const float* __restrict__ xs, float* __restrict__ out) {
  int i = blockIdx.x; int b = i / SEQ, t = i % SEQ;
  ((float4*)(out + (size_t)i * D))[threadIdx.x] = ((const float4*)(xs + ((size_t)b * NT + CTX + t) * D))[threadIdx.x];
}

__global__ __launch_bounds__(256) void k_norm_mod(const float* __restrict__ xs, const float* __restrict__ g,
                                                  const float* __restrict__ modv_l, int sh_chunk, bf16_t* __restrict__ hbuf) {
  __shared__ float red[8];
  int r = blockIdx.x; int b = r / NT, p = r % NT; int mrow = p < CTX ? 2 : b;
  float4 v = ((const float4*)(xs + (size_t)r * D))[threadIdx.x];
  float ss = v.x * v.x + v.y * v.y + v.z * v.z + v.w * v.w;
  ss = block_sum_256(ss, red);
  float rs = rsqrtf(ss * (1.f / D) + EPS);
  int c0 = threadIdx.x * 4;
  const float* sh = modv_l + mrow * NMOD + sh_chunk * D;
  const float* sc = sh + D;
  float o[4] = {v.x, v.y, v.z, v.w};
  bf16_t ob[4];
  for (int j = 0; j < 4; ++j) ob[j] = f2bf(o[j] * rs * g[c0 + j] * (1.f + sc[c0 + j]) + sh[c0 + j]);
  uint2 pk; pk.x = ob[0] | ((unsigned)ob[1] << 16); pk.y = ob[2] | ((unsigned)ob[3] << 16);
  ((uint2*)(hbuf + (size_t)r * D))[threadIdx.x] = pk;
}

template <int MODE>
__global__ __launch_bounds__(256) void k_gemm_naive(const bf16_t* __restrict__ A, const float* __restrict__ B, float* __restrict__ C,
                                                    int M, int N, int K, const float* __restrict__ gate_base) {
  __shared__ float As[16][68];
  __shared__ float Bs[16][68];
  int bm = blockIdx.y * 64, bn = blockIdx.x * 64;
  int tx = threadIdx.x & 15, ty = threadIdx.x >> 4;
  float acc[4][4];
  for (int i = 0; i < 4; ++i) for (int j = 0; j < 4; ++j) acc[i][j] = 0.f;
  int arow = threadIdx.x >> 2, akq = (threadIdx.x & 3) * 4;
  int brow = threadIdx.x >> 4, bcol = (threadIdx.x & 15) * 4;
  for (int k0 = 0; k0 < K; k0 += 16) {
    uint2 av = *(const uint2*)(A + (size_t)(bm + arow) * K + k0 + akq);
    float4 bv = *(const float4*)(B + (size_t)(k0 + brow) * N + bn + bcol);
    __syncthreads();
    As[akq + 0][arow] = bflo(av.x); As[akq + 1][arow] = bfhi(av.x);
    As[akq + 2][arow] = bflo(av.y); As[akq + 3][arow] = bfhi(av.y);
    *(float4*)&Bs[brow][bcol] = bv;
    __syncthreads();
#pragma unroll
    for (int kk = 0; kk < 16; ++kk) {
      float4 a = *(const float4*)&As[kk][ty * 4];
      float4 bq = *(const float4*)&Bs[kk][tx * 4];
      float aa[4] = {a.x, a.y, a.z, a.w}, bb[4] = {bq.x, bq.y, bq.z, bq.w};
#pragma unroll
      for (int i = 0; i < 4; ++i)
#pragma unroll
        for (int j = 0; j < 4; ++j) acc[i][j] += aa[i] * bb[j];
    }
  }
#pragma unroll
  for (int i = 0; i < 4; ++i) {
    int r = bm + ty * 4 + i;
    int n = bn + tx * 4;
    if (MODE == 0) {
      *(float4*)(C + (size_t)r * N + n) = make_float4(acc[i][0], acc[i][1], acc[i][2], acc[i][3]);
    } else {
      int b = r / NT, p = r % NT; int mrow = p < CTX ? 2 : b;
      const float* gt = gate_base + mrow * NMOD + n;
      float4 xv = *(float4*)(C + (size_t)r * N + n);
      xv.x += gt[0] * acc[i][0]; xv.y += gt[1] * acc[i][1]; xv.z += gt[2] * acc[i][2]; xv.w += gt[3] * acc[i][3];
      *(float4*)(C + (size_t)r * N + n) = xv;
    }
  }
}

struct PrepOut {
  bf16_t *QA, *KA, *VAt, *QW, *KW, *VWt, *QG, *KG, *VGt;
  float* uT;
};
DI int perm16(int o) { return (o & 3) | ((o & 4) << 1) | ((o & 8) >> 1); }

template <int DQK>
DI void prep_unit(const float* src, const float* gain, const float* cs, const float* sn, bool lat, float scale, bf16_t* dst) {
  float ss = 0.f;
  for (int d = 0; d < DQK; ++d) ss += src[d] * src[d];
  float rs = rsqrtf(ss * (1.f / DQK) + EPS);
  constexpr int H = DQK / 2;
  for (int d = 0; d < H; ++d) {
    float x1 = src[d] * rs * gain[d], x2 = src[d + H] * rs * gain[d + H];
    float y1 = x1, y2 = x2;
    if (lat) { y1 = x1 * cs[d] - x2 * sn[d]; y2 = x1 * sn[d] + x2 * cs[d]; }
    dst[d] = f2bf(y1 * scale); dst[d + H] = f2bf(y2 * scale);
  }
}

__global__ __launch_bounds__(256) void k_prep(const bf16_t* __restrict__ P, const float* __restrict__ g_qk_diff, const float* __restrict__ g_qk_win,
                                              const float* __restrict__ g_qk_glob, const float* __restrict__ conv_w, const float* __restrict__ conv_b,
                                              PrepOut o) {
  __shared__ float row[1792];
  __shared__ float csh[16], snh[16], csf[32], snf[32];
  int r = blockIdx.x; int b = r / NT, p = r % NT; bool lat = p >= CTX; int t = p - CTX;
  const bf16_t* Pr = P + (size_t)r * DIN;
  for (int i = threadIdx.x; i < 1792; i += 256) row[i] = bf2f(Pr[i]);
  if (threadIdx.x < 48 && lat) {
    float trow = (float)(t / 64), tcol = (float)(t % 64);
    int i = threadIdx.x;
    if (i < 16) {
      int j = i & 7; float f = exp2f(-(float)j * (13.287712379549449f / 8.f));
      float a = (i < 8 ? trow : tcol) * f;
      csh[i] = cosf(a); snh[i] = sinf(a);
    } else {
      int ii = i - 16; int j = ii & 15; float f = exp2f(-(float)j * (13.287712379549449f / 16.f));
      float a = (ii < 16 ? trow : tcol) * f;
      csf[ii] = cosf(a); snf[ii] = sinf(a);
    }
  }
  __syncthreads();
  int u = threadIdx.x;
  if (u < 8) {
    prep_unit<32>(row + u * 32, g_qk_diff, csh, snh, lat, 0.17677669529663687f * LOG2E, o.QA + (((size_t)b * 8 + u) * NT + p) * 32);
  } else if (u < 16) {
    int vh = u - 8;
    prep_unit<32>(row + 256 + vh * 32, g_qk_diff + 32, csh, snh, lat, 1.f, o.KA + (((size_t)b * 8 + vh) * NT + p) * 32);
  } else if (u < 20) {
    int h = u - 16;
    prep_unit<64>(row + 768 + h * 64, g_qk_win, csf, snf, lat, 0.125f * LOG2E, o.QW + (((size_t)b * 4 + h) * NT + p) * 64);
  } else if (u < 22) {
    int h = u - 20;
    prep_unit<64>(row + 768 + 256 + h * 64, g_qk_win + 64, csf, snf, lat, 1.f, o.KW + (((size_t)b * 2 + h) * NT + p) * 64);
  } else if (u < 26) {
    int h = u - 22;
    prep_unit<64>(row + 1280 + h * 64, g_qk_glob, csf, snf, lat, 0.125f * LOG2E, o.QG + (((size_t)b * 4 + h) * NT + p) * 64);
  } else if (u < 28) {
    int h = u - 26;
    prep_unit<64>(row + 1280 + 256 + h * 64, g_qk_glob + 64, csf, snf, lat, 1.f, o.KG + (((size_t)b * 2 + h) * NT + p) * 64);
  }
  int pp = (p & ~15) + perm16(p & 15);
  {
    int c = threadIdx.x;
    o.VAt[(((size_t)b * 4 + c / 64) * 64 + (c % 64)) * NT + pp] = f2bf(row[512 + c]);
    if (c < 128) {
      o.VWt[(((size_t)b * 2 + c / 64) * 64 + (c % 64)) * NT + pp] = f2bf(row[768 + 384 + c]);
    } else {
      int c2 = c - 128;
      o.VGt[(((size_t)b * 2 + c2 / 64) * 64 + (c2 % 64)) * NT + pp] = f2bf(row[1280 + 384 + c2]);
    }
  }
  bool hasp = lat ? (t > 0) : (p > 0);
  bool hasn = lat ? (t < SEQ - 1) : (p < CTX - 1);
  for (int c = threadIdx.x; c < 768; c += 256) {
    float v = bf2f(Pr[1792 + c]) * conv_w[768 + c] + conv_b[c];
    if (hasp) v += bf2f(Pr[1792 + c - DIN]) * conv_w[c];
    if (hasn) v += bf2f(Pr[1792 + c + DIN]) * conv_w[2 * 768 + c];
    o.uT[((size_t)b * 768 + c) * NT + p] = v;
  }
}

template <int DQK>
DI void attn_accum(const float* q, const bf16_t* __restrict__ Kb, const bf16_t* __restrict__ Vt, int g0, int g1, int lo, int hi,
                   float M2, float& l, float* o) {
  for (int kg = g0; kg < g1; kg += 16) {
    float pw[16];
#pragma unroll
    for (int pos = 0; pos < 16; ++pos) {
      int k = kg + perm16(pos);
      const uint4* kr = (const uint4*)(Kb + (size_t)k * DQK);
      float s = 0.f;
#pragma unroll
      for (int c = 0; c < DQK / 8; ++c) {
        uint4 w = kr[c];
        s += q[c * 8 + 0] * bflo(w.x) + q[c * 8 + 1] * bfhi(w.x) + q[c * 8 + 2] * bflo(w.y) + q[c * 8 + 3] * bfhi(w.y) +
             q[c * 8 + 4] * bflo(w.z) + q[c * 8 + 5] * bfhi(w.z) + q[c * 8 + 6] * bflo(w.w) + q[c * 8 + 7] * bfhi(w.w);
      }
      float e = exp2f(s - M2);
      pw[pos] = (k >= lo && k <= hi) ? e : 0.f;
      l += pw[pos];
      if ((pos & 3) == 3) asm volatile("" ::: "memory");
    }
#pragma unroll
    for (int dv = 0; dv < 64; ++dv) {
      const uint4* vr = (const uint4*)(Vt + (size_t)dv * NT + kg);
      uint4 w0 = vr[0], w1 = vr[1];
      o[dv] += pw[0] * bflo(w0.x) + pw[1] * bfhi(w0.x) + pw[2] * bflo(w0.y) + pw[3] * bfhi(w0.y) + pw[4] * bflo(w0.z) +
               pw[5] * bfhi(w0.z) + pw[6] * bflo(w0.w) + pw[7] * bfhi(w0.w) + pw[8] * bflo(w1.x) + pw[9] * bfhi(w1.x) +
               pw[10] * bflo(w1.y) + pw[11] * bfhi(w1.y) + pw[12] * bflo(w1.z) + pw[13] * bfhi(w1.z) + pw[14] * bflo(w1.w) +
               pw[15] * bfhi(w1.w);
      if ((dv & 3) == 3) asm volatile("" ::: "memory");
    }
  }
}

template <int TYPE>
__global__ __launch_bounds__(256) void k_attn_naive(const bf16_t* __restrict__ Q, const bf16_t* __restrict__ K, const bf16_t* __restrict__ Vt,
                                                    const float* __restrict__ gqk, const float* __restrict__ sink, float* __restrict__ Otmp,
                                                    int want_ctx) {
  constexpr int DQK = TYPE == 0 ? 32 : 64;
  constexpr int HQ = TYPE == 0 ? 8 : 4;
  constexpr int HK = TYPE == 0 ? 8 : 2;
  constexpr int HV = TYPE == 0 ? 4 : 2;
  constexpr int SLOT0 = TYPE == 0 ? 0 : (TYPE == 1 ? 8 : 12);
  int idx = blockIdx.x * 256 + threadIdx.x;
  int p = idx % NT; int h = (idx / NT) % HQ; int b = idx / (NT * HQ);
  if (p < CTX && !want_ctx) return;
  float gq = 0.f, gk = 0.f;
  for (int d = 0; d < DQK; ++d) { gq = fmaxf(gq, fabsf(gqk[d])); gk = fmaxf(gk, fabsf(gqk[DQK + d])); }
  float M2 = sqrtf((float)DQK) * gq * gk * LOG2E;
  int kh = TYPE == 0 ? h : h / 2, vh = h / 2;
  const bf16_t* Kb = K + ((size_t)b * HK + kh) * NT * DQK;
  const bf16_t* Vb = Vt + ((size_t)b * HV + vh) * 64 * NT;
  float q[DQK];
  {
    const uint4* qr = (const uint4*)(Q + (((size_t)b * HQ + h) * NT + p) * DQK);
#pragma unroll
    for (int c = 0; c < DQK / 8; ++c) {
      uint4 w = qr[c];
      q[c * 8 + 0] = bflo(w.x); q[c * 8 + 1] = bfhi(w.x); q[c * 8 + 2] = bflo(w.y); q[c * 8 + 3] = bfhi(w.y);
      q[c * 8 + 4] = bflo(w.z); q[c * 8 + 5] = bfhi(w.z); q[c * 8 + 6] = bflo(w.w); q[c * 8 + 7] = bfhi(w.w);
    }
  }
  float o[64];
#pragma unroll
  for (int i = 0; i < 64; ++i) o[i] = 0.f;
  float l = 0.f;
#pragma unroll 1
  for (int seg = 0; seg < 2; ++seg) {
    int g0 = 0, g1 = CTX, lo = 0, hi = CTX - 1;
    if (seg == 1) {
      if (p < CTX) break;
      if (TYPE == 1) { lo = max(CTX, p - 128); hi = min(NT - 1, p + 128); g0 = lo & ~15; g1 = (hi & ~15) + 16; }
      else { lo = CTX; hi = NT - 1; g0 = CTX; g1 = NT; }
    }
    attn_accum<DQK>(q, Kb, Vb, g0, g1, lo, hi, M2, l, o);
  }
  if (TYPE == 1) l += exp2f(sink[h] * LOG2E - M2);
  float inv = 1.f / l;
  float4* dst = (float4*)(Otmp + ((((size_t)b * 16 + SLOT0 + h) * NT) + p) * 64);
#pragma unroll
  for (int i = 0; i < 16; ++i) dst[i] = make_float4(o[4 * i] * inv, o[4 * i + 1] * inv, o[4 * i + 2] * inv, o[4 * i + 3] * inv);
}

__global__ __launch_bounds__(256) void k_attn_finish(const float* __restrict__ Otmp, const float* __restrict__ lambda_diff, float lambda_init,
                                                     const float* __restrict__ g_mix_out, bf16_t* __restrict__ A2, int want_ctx) {
  int idx = blockIdx.x * 256 + threadIdx.x;
  int p = idx % NT; int oh = (idx / NT) % 12; int b = idx / (NT * 12);
  if (p < CTX && !want_ctx) return;
  float o[64];
  float hs = 1.f;
  if (oh < 4) {
    float s0 = 0.f, s1 = 0.f;
    for (int d = 0; d < 32; ++d) { s0 += lambda_diff[d] * lambda_diff[32 + d]; s1 += lambda_diff[64 + d] * lambda_diff[96 + d]; }
    float lam = __expf(s0) - __expf(s1) + lambda_init;
    const float4* a = (const float4*)(Otmp + ((((size_t)b * 16 + 2 * oh) * NT) + p) * 64);
    const float4* c = (const float4*)(Otmp + ((((size_t)b * 16 + 2 * oh + 1) * NT) + p) * 64);
#pragma unroll
    for (int i = 0; i < 16; ++i) {
      float4 x = a[i], y = c[i];
      o[4 * i] = x.x - lam * y.x; o[4 * i + 1] = x.y - lam * y.y; o[4 * i + 2] = x.z - lam * y.z; o[4 * i + 3] = x.w - lam * y.w;
    }
    hs = 1.f - lambda_init;
  } else {
    const float4* a = (const float4*)(Otmp + ((((size_t)b * 16 + 4 + oh) * NT) + p) * 64);
#pragma unroll
    for (int i = 0; i < 16; ++i) { float4 x = a[i]; o[4 * i] = x.x; o[4 * i + 1] = x.y; o[4 * i + 2] = x.z; o[4 * i + 3] = x.w; }
  }
  float ss = 0.f;
#pragma unroll
  for (int i = 0; i < 64; ++i) ss += o[i] * o[i];
  float rs = rsqrtf(ss * (1.f / 64) + EPS) * hs;
  const float* g = g_mix_out + oh * 64;
  uint4* dst = (uint4*)(A2 + ((size_t)b * NT + p) * D + oh * 64);
#pragma unroll
  for (int i = 0; i < 8; ++i) {
    unsigned w[4];
#pragma unroll
    for (int j = 0; j < 4; ++j) {
      int e = i * 8 + j * 2;
      w[j] = (unsigned)f2bf(o[e] * rs * g[e]) | ((unsigned)f2bf(o[e + 1] * rs * g[e + 1]) << 16);
    }
    dst[i] = make_uint4(w[0], w[1], w[2], w[3]);
  }
}

__global__ __launch_bounds__(64) void k_hy_mlp(const float* __restrict__ w1, const float* __restrict__ b1, const float* __restrict__ w2,
                                               const float* __restrict__ b2, const float* __restrict__ freq, float* __restrict__ hdn2) {
  __shared__ float feat[33];
  __shared__ float h1[64];
  int which = blockIdx.x >= SEQ ? 1 : 0;
  int j = which ? blockIdx.x - SEQ : blockIdx.x;
  int n = which ? CTX : SEQ;
  int u = threadIdx.x;
  float tt = (float)j / (float)(n - 1);
  float w = (6.283185307179586f / (float)n) * (float)j;
  if (u == 0) feat[0] = tt;
  if (u < 16) {
    float f = 1e-4f + (float)u * ((15.f - 1e-4f) / 15.f);
    feat[1 + u] = cosf(f * w);
    feat[17 + u] = -sinf(f * w);
  }
  __syncthreads();
  float a = b1[u];
  for (int i = 0; i < 33; ++i) a += feat[i] * w1[i * 64 + u];
  h1[u] = sinf(freq[u] * a);
  __syncthreads();
  float a2 = b2[u];
  for (int i = 0; i < 64; ++i) a2 += h1[i] * w2[i * 64 + u];
  hdn2[((size_t)which * SEQ + j) * 64 + u] = sinf(freq[u] * a2);
}

constexpr size_t KC_W0 = 0;
DI size_t kc_off(int which, int order, int c) {
  return which ? KC_W0 + ((size_t)order * 256 + c) * 2 * CTX : ((size_t)order * 256 + c) * 2 * SEQ;
}
__global__ __launch_bounds__(256) void k_hy_filt(const float* __restrict__ hdn2, const float* __restrict__ w3, const float* __restrict__ b3,
                                                 float* __restrict__ kc, int want_ctx) {
  __shared__ float wc[2][64];
  __shared__ float red[8];
  int c = blockIdx.x, order = blockIdx.y, which = blockIdx.z;
  if (!which) return;
  int n = which ? CTX : SEQ;
  int col0 = order * 512 + c, col1 = col0 + 256;
  if (threadIdx.x < 64) wc[0][threadIdx.x] = w3[threadIdx.x * 1024 + col0];
  else if (threadIdx.x < 128) wc[1][threadIdx.x - 64] = w3[(threadIdx.x - 64) * 1024 + col1];
  __syncthreads();
  float delta = fabsf(-3.0701134573253944f + (float)c * ((-15.350567286626972f + 3.0701134573253944f) / 255.f));
  float* out = kc + kc_off(which, order, c);
  float asum = 0.f;
  float bb0 = b3[col0], bb1 = b3[col1];
  for (int j = threadIdx.x; j < n; j += 256) {
    const float4* hr = (const float4*)(hdn2 + ((size_t)which * SEQ + j) * 64);
    float f0 = bb0, f1 = bb1;
#pragma unroll
    for (int i = 0; i < 16; ++i) {
      float4 hv = hr[i];
      f0 += hv.x * wc[0][4 * i] + hv.y * wc[0][4 * i + 1] + hv.z * wc[0][4 * i + 2] + hv.w * wc[0][4 * i + 3];
      f1 += hv.x * wc[1][4 * i] + hv.y * wc[1][4 * i + 1] + hv.z * wc[1][4 * i + 2] + hv.w * wc[1][4 * i + 3];
    }
    float tt = (float)j / (float)(n - 1);
    float dec = __expf(-tt * delta);
    f0 *= dec; f1 *= dec;
    out[n + j] = f0;
    asum += fabsf(f0);
    if (j > 0) { out[n - j] = f1; asum += fabsf(f1); }
    else out[0] = 0.f;
  }
  asum = block_sum_256(asum, red);
  float inv = 1.f / asum;
  __syncthreads();
  for (int j = threadIdx.x; j < 2 * n; j += 256) out[j] *= inv;
}

template <int ORDER>
__global__ __launch_bounds__(256) void k_hy_conv(const float* __restrict__ uT, const float* __restrict__ zin, float* __restrict__ zout,
                                                 const float* __restrict__ kc, const float* __restrict__ hy_bias, int which) {
  __shared__ float zs[256];
  int n = which ? CTX : SEQ;
  int off = which ? 0 : CTX;
  int chunk = blockIdx.x, c = blockIdx.y, b = blockIdx.z;
  int t = chunk * 256 + threadIdx.x;
  const float* in = (ORDER == 0 ? uT + ((size_t)b * 768 + c) * NT : zin + ((size_t)b * 256 + c) * NT) + off;
  const float* kk = kc + kc_off(which, ORDER, c) + n + t;
  float acc = 0.f;
  for (int s0 = 0; s0 < n; s0 += 256) {
    __syncthreads();
    zs[threadIdx.x] = in[s0 + threadIdx.x];
    __syncthreads();
    const float* kp = kk - s0;
#pragma unroll 8
    for (int ss = 0; ss < 256; ++ss) acc += zs[ss] * kp[-ss];
  }
  float self = in[t];
  float gatev = uT[((size_t)b * 768 + (ORDER == 0 ? 256 : 512) + c) * NT + off + t];
  float res = gatev * (acc + hy_bias[ORDER * 256 + c] * self);
  zout[((size_t)b * 256 + c) * NT + off + t] = res;
}

__global__ __launch_bounds__(256) void k_hy_fin(const float* __restrict__ yT, const float* __restrict__ g_mix_out, bf16_t* __restrict__ A2,
                                                int want_ctx) {
  int idx = blockIdx.x * 256 + threadIdx.x;
  int p = idx % NT; int g = (idx / NT) % 4; int b = idx / (NT * 4);
  if (p < CTX && !want_ctx) return;
  float v[64];
  float ss = 0.f;
#pragma unroll
  for (int i = 0; i < 64; ++i) { v[i] = yT[((size_t)b * 256 + g * 64 + i) * NT + p]; ss += v[i] * v[i]; }
  float rs = rsqrtf(ss * (1.f / 64) + EPS);
  const float* gm = g_mix_out + 768 + g * 64;
  uint4* dst = (uint4*)(A2 + ((size_t)b * NT + p) * D + 768 + g * 64);
#pragma unroll
  for (int i = 0; i < 8; ++i) {
    unsigned w[4];
#pragma unroll
    for (int j = 0; j < 4; ++j) {
      int e = i * 8 + j * 2;
      w[j] = (unsigned)f2bf(v[e] * rs * gm[e]) | ((unsigned)f2bf(v[e + 1] * rs * gm[e + 1]) << 16);
    }
    dst[i] = make_uint4(w[0], w[1], w[2], w[3]);
  }
}

__global__ __launch_bounds__(256) void k_peer_naive(const bf16_t* __restrict__ qbuf, const bf16_t* __restrict__ hbuf, const float* __restrict__ keys,
                                                    const float* __restrict__ ut, const float* __restrict__ vt, const float* __restrict__ modv_l,
                                                    float* __restrict__ xs, int want_ctx) {
  __shared__ float qs[2048];
  __shared__ float sc[16 * 128];
  __shared__ float topv[16][16];
  __shared__ int topi[16][16];
  __shared__ float cand[8][256];
  __shared__ int elist[128];
  __shared__ float glist[128];
  __shared__ float wl[128];
  int r = blockIdx.x; int b = r / NT, p = r % NT;
  if (p < CTX && !want_ctx) return;
  int tid = threadIdx.x;
  {
    uint4 w = ((const uint4*)(qbuf + (size_t)r * 2048))[tid];
    float* qd = qs + tid * 8;
    qd[0] = bflo(w.x); qd[1] = bfhi(w.x); qd[2] = bflo(w.y); qd[3] = bfhi(w.y); qd[4] = bflo(w.z); qd[5] = bfhi(w.z); qd[6] = bflo(w.w); qd[7] = bfhi(w.w);
  }
  __syncthreads();
  for (int i = 0; i < 8; ++i) {
    int sidx = tid + 256 * i;
    int hp = sidx >> 7;
    const float4* kr = (const float4*)(keys + (size_t)sidx * 128);
    const float4* qq = (const float4*)(qs + hp * 128);
    float s = 0.f;
    for (int d = 0; d < 32; ++d) { float4 a = kr[d], q4 = qq[d]; s += a.x * q4.x + a.y * q4.y + a.z * q4.z + a.w * q4.w; }
    sc[sidx] = s;
  }
  __syncthreads();
  if (tid < 16) {
    float* row = sc + tid * 128;
    for (int k = 0; k < 16; ++k) {
      float best = -3.0e38f; int bi = 0;
      for (int j = 0; j < 128; ++j) { float v = row[j]; if (v > best) { best = v; bi = j; } }
      topv[tid][k] = best; topi[tid][k] = bi; row[bi] = -3.0e38f;
    }
  }
  __syncthreads();
  for (int i = tid; i < 8 * 256; i += 256) {
    int h = i >> 8, ab = i & 255;
    cand[h][ab] = topv[2 * h][ab >> 4] + topv[2 * h + 1][ab & 15];
  }
  __syncthreads();
  if (tid < 8) {
    float* row = cand[tid];
    float mx = -3.0e38f;
    for (int k = 0; k < 16; ++k) {
      float best = -3.0e38f; int bi = 0;
      for (int j = 0; j < 256; ++j) { float v = row[j]; if (v > best) { best = v; bi = j; } }
      row[bi] = -3.0e38f;
      elist[tid * 16 + k] = topi[2 * tid][bi >> 4] * 128 + topi[2 * tid + 1][bi & 15];
      glist[tid * 16 + k] = best;
      if (k == 0) mx = best;
    }
    float sum = 0.f;
    for (int k = 0; k < 16; ++k) { float e = __expf(glist[tid * 16 + k] - mx); glist[tid * 16 + k] = e; sum += e; }
    float inv = 1.f / sum;
    for (int k = 0; k < 16; ++k) glist[tid * 16 + k] *= inv;
  }
  __syncthreads();
  {
    int lane = tid & 63, w = tid >> 6;
    float xv[16];
    const uint4* hr = (const uint4*)(hbuf + (size_t)r * D + lane * 16);
    uint4 a = hr[0], c = hr[1];
    xv[0] = bflo(a.x); xv[1] = bfhi(a.x); xv[2] = bflo(a.y); xv[3] = bfhi(a.y); xv[4] = bflo(a.z); xv[5] = bfhi(a.z); xv[6] = bflo(a.w); xv[7] = bfhi(a.w);
    xv[8] = bflo(c.x); xv[9] = bfhi(c.x); xv[10] = bflo(c.y); xv[11] = bfhi(c.y); xv[12] = bflo(c.z); xv[13] = bfhi(c.z); xv[14] = bflo(c.w); xv[15] = bfhi(c.w);
    for (int e = 0; e < 32; ++e) {
      int ei = w * 32 + e;
      const float4* ur = (const float4*)(ut + (size_t)elist[ei] * D + lane * 16);
      float s = 0.f;
#pragma unroll
      for (int j = 0; j < 4; ++j) { float4 uu = ur[j]; s += uu.x * xv[4 * j] + uu.y * xv[4 * j + 1] + uu.z * xv[4 * j + 2] + uu.w * xv[4 * j + 3]; }
      for (int o = 32; o > 0; o >>= 1) s += __shfl_xor(s, o);
      if (lane == 0) {
        float g = 0.5f * s * (1.f + tanhf(0.7978845608028654f * (s + 0.044715f * s * s * s)));
        wl[ei] = glist[ei] * g;
      }
    }
  }
  __syncthreads();
  float4 acc = make_float4(0.f, 0.f, 0.f, 0.f);
  for (int e = 0; e < 128; ++e) {
    float wv = wl[e];
    float4 vv = ((const float4*)(vt + (size_t)elist[e] * D))[tid];
    acc.x += wv * vv.x; acc.y += wv * vv.y; acc.z += wv * vv.z; acc.w += wv * vv.w;
  }
  int mrow = p < CTX ? 2 : b;
  const float* g2 = modv_l + mrow * NMOD + 5 * D + tid * 4;
  float4 xv = ((float4*)(xs + (size_t)r * D))[tid];
  xv.x += g2[0] * acc.x; xv.y += g2[1] * acc.y; xv.z += g2[2] * acc.z; xv.w += g2[3] * acc.w;
  ((float4*)(xs + (size_t)r * D))[tid] = xv;
}

typedef __attribute__((ext_vector_type(8))) short bf16x8;
typedef __attribute__((ext_vector_type(16))) float f32x16;
typedef __attribute__((ext_vector_type(2))) __bf16 bf16x2_t;
typedef __attribute__((ext_vector_type(2))) float f32x2_t;
#define MFMA32(a, b, c) __builtin_amdgcn_mfma_f32_32x32x16_bf16((a), (b), (c), 0, 0, 0)
DI unsigned pk2bf(float a, float b) { f32x2_t v = {a, b}; return __builtin_bit_cast(unsigned, __builtin_convertvector(v, bf16x2_t)); }
constexpr int NTHR = 512;

DI void wconv_tile(const float* __restrict__ W, bf16_t* __restrict__ Wt, int N, int tile, float* sm  ) {
  int tn = tile % (N / 64), tk = tile / (N / 64);
  int tid = threadIdx.x;
  __syncthreads();
  for (int i = tid; i < 64 * 16; i += NTHR) {
    int kr = i >> 4, c4 = (i & 15) * 4;
    float4 v = *(const float4*)(W + (size_t)(tk * 64 + kr) * N + tn * 64 + c4);
    sm[kr * 65 + c4] = v.x; sm[kr * 65 + c4 + 1] = v.y; sm[kr * 65 + c4 + 2] = v.z; sm[kr * 65 + c4 + 3] = v.w;
  }
  __syncthreads();
  for (int i = tid; i < 64 * 8; i += NTHR) {
    int n = i >> 3, k8 = (i & 7) * 8;
    unsigned w[4];
    for (int j = 0; j < 4; ++j) w[j] = pk2bf(sm[(k8 + 2 * j) * 65 + n], sm[(k8 + 2 * j + 1) * 65 + n]);
    *(uint4*)(Wt + (size_t)(tn * 64 + n) * D + tk * 64 + k8) = make_uint4(w[0], w[1], w[2], w[3]);
  }
}

template <int EPI>
DI void gemm_tile(const bf16_t* __restrict__ A, const bf16_t* __restrict__ Wt, int N, int m0, int n0, char* smem, bf16_t* __restrict__ Cb,
                  float* __restrict__ xs, const float* __restrict__ gate_base) {
  constexpr int K = D;
  const int tid = threadIdx.x, lane = tid & 63, wid = tid >> 6;
  const int wm = wid & 1, wn = wid >> 1;
  const int r = lane & 31, h = lane >> 5;
  f32x16 acc0, acc1;
  for (int i = 0; i < 16; ++i) { acc0[i] = 0.f; acc1[i] = 0.f; }
  const int lrow = tid >> 3, lch = tid & 7;
  const bf16_t* Ag = A + (size_t)(m0 + lrow) * K + lch * 8;
  const bf16_t* Bg = Wt + (size_t)(n0 + lrow) * K + lch * 8;
  const int woff = lrow * 128 + ((lch ^ ((lrow >> 1) & 7)) << 4);
  uint4 ra0, ra1, rb0, rb1;
  ra0 = *(const uint4*)(Ag); ra1 = *(const uint4*)(Ag + (size_t)64 * K);
  rb0 = *(const uint4*)(Bg); rb1 = *(const uint4*)(Bg + (size_t)64 * K);
  __syncthreads();
  *(uint4*)(smem + woff) = ra0; *(uint4*)(smem + woff + 8192) = ra1;
  *(uint4*)(smem + 16384 + woff) = rb0; *(uint4*)(smem + 16384 + woff + 8192) = rb1;
  __syncthreads();
  const int sw = (r >> 1) & 7;
  const int aoff0 = (wm * 64 + r) * 128, aoff1 = aoff0 + 32 * 128;
  const int boff = 16384 + (wn * 32 + r) * 128;
#pragma unroll 1
  for (int kt = 0; kt < K / 64; ++kt) {
    const char* st = smem + (kt & 1) * 32768;
    if (kt + 1 < K / 64) {
      ra0 = *(const uint4*)(Ag + (kt + 1) * 64); ra1 = *(const uint4*)(Ag + (size_t)64 * K + (kt + 1) * 64);
      rb0 = *(const uint4*)(Bg + (kt + 1) * 64); rb1 = *(const uint4*)(Bg + (size_t)64 * K + (kt + 1) * 64);
    }
#pragma unroll
    for (int s = 0; s < 4; ++s) {
      int co = ((2 * s + h) ^ sw) << 4;
      bf16x8 a0 = *(const bf16x8*)(st + aoff0 + co);
      bf16x8 a1 = *(const bf16x8*)(st + aoff1 + co);
      bf16x8 b = *(const bf16x8*)(st + boff + co);
      acc0 = MFMA32(a0, b, acc0);
      acc1 = MFMA32(a1, b, acc1);
    }
    if (kt + 1 < K / 64) {
      char* sn = smem + ((kt + 1) & 1) * 32768;
      *(uint4*)(sn + woff) = ra0; *(uint4*)(sn + woff + 8192) = ra1;
      *(uint4*)(sn + 16384 + woff) = rb0; *(uint4*)(sn + 16384 + woff + 8192) = rb1;
    }
    __syncthreads();
  }
  float* Cs = (float*)smem;
  constexpr int CS = 132;
#pragma unroll
  for (int i = 0; i < 16; ++i) {
    int row = (i & 3) + 8 * (i >> 2) + 4 * h;
    Cs[(wm * 64 + row) * CS + wn * 32 + r] = acc0[i];
    Cs[(wm * 64 + 32 + row) * CS + wn * 32 + r] = acc1[i];
  }
  __syncthreads();
  if (EPI == 0) {
    for (int i = tid; i < 128 * 16; i += NTHR) {
      int row = i >> 4, c8 = (i & 15) * 8;
      const float* cr = Cs + row * CS + c8;
      float4 v0 = *(const float4*)cr, v1 = *(const float4*)(cr + 4);
      *(uint4*)(Cb + (size_t)(m0 + row) * N + n0 + c8) = make_uint4(pk2bf(v0.x, v0.y), pk2bf(v0.z, v0.w), pk2bf(v1.x, v1.y), pk2bf(v1.z, v1.w));
    }
  } else {
    for (int i = tid; i < 128 * 32; i += NTHR) {
      int row = i >> 5, c4 = (i & 31) * 4;
      int rr = m0 + row; int b = rr / NT, p = rr % NT; int mrow = p < CTX ? 2 : b;
      const float* gt = gate_base + mrow * NMOD + n0 + c4;
      float4 v = *(const float4*)(Cs + row * CS + c4);
      float4 xv = *(float4*)(xs + (size_t)rr * D + n0 + c4);
      xv.x += gt[0] * v.x; xv.y += gt[1] * v.y; xv.z += gt[2] * v.z; xv.w += gt[3] * v.w;
      *(float4*)(xs + (size_t)rr * D + n0 + c4) = xv;
    }
  }
}

__global__ __launch_bounds__(NTHR) void k_wconv(const float* __restrict__ W, bf16_t* __restrict__ Wt, int N) {
  __shared__ float sm[64 * 65];
  int ntiles = (N / 64) * (D / 64);
  for (int t = blockIdx.x; t < ntiles; t += gridDim.x) wconv_tile(W, Wt, N, t, sm);
}
template <int EPI>
__global__ __launch_bounds__(NTHR) void k_gemm(const bf16_t* __restrict__ A, const bf16_t* __restrict__ Wt, int N, bf16_t* __restrict__ Cb,
                                               float* __restrict__ xs, const float* __restrict__ gate_base) {
  extern __shared__ __attribute__((aligned(16))) char smem[];
  int nt_n = N / 128, ntiles = (R / 128) * nt_n;
  for (int t = blockIdx.x; t < ntiles; t += gridDim.x) {
    int tm = t / nt_n, tn = t % nt_n;
    gemm_tile<EPI>(A, Wt, N, tm * 128, tn * 128, smem, Cb, xs, gate_base);
  }
}

struct AttnArgs {
  const bf16_t *QA, *KA, *VAt, *QW, *KW, *VWt, *QG, *KG, *VGt;
  const float *g_qk_diff, *g_qk_win, *g_qk_glob, *sink, *lambda_diff, *g_mix_out;
  float lambda_init;
  int pad0;
  bf16_t* A2;
  float* Oslab;
  float* Lslab;
};

template <int TYPE>
DI void attn_item(const AttnArgs& a, int b, int g, int p0, int ctx0, int nctx, int lat0, int nkt, int half, char* smem) {
  constexpr int DQK = TYPE == 0 ? 32 : 64;
  constexpr int KS = DQK / 16;
  const int tid = threadIdx.x, lane = tid & 63, wid = tid >> 6;
  const int r = lane & 31, h = lane >> 5;
  const bf16_t *Q0, *Q1, *K0, *K1, *Vt;
  const float* gqk;
  if (TYPE == 0) {
    Q0 = a.QA + ((size_t)b * 8 + 2 * g) * NT * 32; Q1 = Q0 + (size_t)NT * 32;
    K0 = a.KA + ((size_t)b * 8 + 2 * g) * NT * 32; K1 = K0 + (size_t)NT * 32;
    Vt = a.VAt + ((size_t)b * 4 + g) * 64 * NT; gqk = a.g_qk_diff;
  } else if (TYPE == 1) {
    Q0 = a.QW + ((size_t)b * 4 + 2 * g) * NT * 64; Q1 = Q0 + (size_t)NT * 64;
    K0 = a.KW + ((size_t)b * 2 + g) * NT * 64; K1 = K0;
    Vt = a.VWt + ((size_t)b * 2 + g) * 64 * NT; gqk = a.g_qk_win;
  } else {
    Q0 = a.QG + ((size_t)b * 4 + 2 * g) * NT * 64; Q1 = Q0 + (size_t)NT * 64;
    K0 = a.KG + ((size_t)b * 2 + g) * NT * 64; K1 = K0;
    Vt = a.VGt + ((size_t)b * 2 + g) * 64 * NT; gqk = a.g_qk_glob;
  }
  (void)gqk;
  const int qpos = p0 + wid * 32 + r;
  bf16x8 qf0[KS], qf1[KS];
#pragma unroll
  for (int s = 0; s < KS; ++s) {
    qf0[s] = *(const bf16x8*)(Q0 + (size_t)qpos * DQK + 16 * s + 8 * h);
    qf1[s] = *(const bf16x8*)(Q1 + (size_t)qpos * DQK + 16 * s + 8 * h);
  }
  f32x16 O00, O01, O10, O11, Zero;
#pragma unroll
  for (int i = 0; i < 16; ++i) { O00[i] = 0.f; O01[i] = 0.f; O10[i] = 0.f; O11[i] = 0.f; Zero[i] = 0.f; }
  float l0 = 0.f, l1 = 0.f;

  uint4 st0, st1, st2, st3;
  auto tile_of = [&](int it) { return it < nctx ? ctx0 + it : lat0 + it - nctx; };
  const int vrow0 = tid >> 4, vch = tid & 15;
#define ATT_GLOAD(kt_)                                                                                   \
  {                                                                                                      \
    const int kt__ = (kt_);                                                                              \
    if (TYPE == 0) {                                                                                     \
      st0 = *(const uint4*)(K0 + (size_t)kt__ * 128 * 32 + tid * 8);                                     \
      st1 = *(const uint4*)(K1 + (size_t)kt__ * 128 * 32 + tid * 8);                                     \
    } else {                                                                                             \
      st0 = *(const uint4*)(K0 + (size_t)kt__ * 128 * 64 + tid * 8);                                     \
      st1 = *(const uint4*)(K0 + (size_t)kt__ * 128 * 64 + (tid + 512) * 8);                             \
    }                                                                                                    \
    st2 = *(const uint4*)(Vt + (size_t)vrow0 * NT + kt__ * 128 + vch * 8);                               \
    st3 = *(const uint4*)(Vt + (size_t)(vrow0 + 32) * NT + kt__ * 128 + vch * 8);                        \
  }
#define ATT_SSTORE(sb_)                                                                                  \
  {                                                                                                      \
    char* sb__ = (sb_);                                                                                  \
    if (TYPE == 0) {                                                                                     \
      int row = tid >> 2, ch = tid & 3;                                                                  \
      int off = row * 64 + ((ch ^ ((row >> 2) & 3)) << 4);                                               \
      *(uint4*)(sb__ + off) = st0;                                                                       \
      *(uint4*)(sb__ + 8192 + off) = st1;                                                                \
    } else {                                                                                             \
      int row = tid >> 3, ch = tid & 7;                                                                  \
      int off = row * 128 + ((ch ^ ((row >> 1) & 7)) << 4);                                              \
      *(uint4*)(sb__ + off) = st0;                                                                       \
      *(uint4*)(sb__ + off + 8192) = st1;                                                                \
    }                                                                                                    \
    int voff = 16384 + vrow0 * 256 + ((vch ^ (vrow0 & 15)) << 4);                                        \
    *(uint4*)(sb__ + voff) = st2;                                                                        \
    *(uint4*)(sb__ + voff + 8192) = st3;                                                                 \
  }
  ATT_GLOAD(tile_of(0));
  __syncthreads();
  ATT_SSTORE(smem);
  __syncthreads();
  const int qwave = p0 + wid * 32;
#pragma unroll 1
  for (int it = 0; it < nkt; ++it) {
    const int kt = tile_of(it);
    const char* sb = smem + (it & 1) * 32768;
    if (it + 1 < nkt) ATT_GLOAD(tile_of(it + 1));
#pragma unroll 1
    for (int j = 0; j < 4; ++j) {
      const int kbase = kt * 128 + 32 * j;
      bool masked = false;
      if (TYPE == 1) {
        if (kbase >= CTX && p0 >= CTX) {
          if (kbase > qwave + 31 + 128 || kbase + 31 < qwave - 128) continue;
          masked = true;
        }
      }
      f32x16 S0 = Zero, S1 = Zero;
#pragma unroll
      for (int s = 0; s < KS; ++s) {
        if (TYPE == 0) {
          int row = 32 * j + r;
          int off = row * 64 + (((2 * s + h) ^ ((row >> 2) & 3)) << 4);
          bf16x8 k0 = *(const bf16x8*)(sb + off);
          bf16x8 k1 = *(const bf16x8*)(sb + 8192 + off);
          S0 = MFMA32(k0, qf0[s], S0);
          S1 = MFMA32(k1, qf1[s], S1);
        } else {
          int row = 32 * j + r;
          int off = row * 128 + (((2 * s + h) ^ ((row >> 1) & 7)) << 4);
          bf16x8 k0 = *(const bf16x8*)(sb + off);
          S0 = MFMA32(k0, qf0[s], S0);
          S1 = MFMA32(k0, qf1[s], S1);
        }
      }
      float pa[16], pb[16];
#pragma unroll
      for (int i = 0; i < 16; ++i) {
        float e0 = __builtin_amdgcn_exp2f(S0[i]);
        float e1 = __builtin_amdgcn_exp2f(S1[i]);
        if (TYPE == 1) {
          if (masked) {
            int kp = kbase + (i & 3) + 8 * (i >> 2) + 4 * h;
            int dd = kp - qpos;
            bool ok = (dd <= 128) && (dd >= -128);
            e0 = ok ? e0 : 0.f; e1 = ok ? e1 : 0.f;
          }
        }
        pa[i] = e0; pb[i] = e1;
      }
      l0 += ((pa[0] + pa[1]) + (pa[2] + pa[3])) + ((pa[4] + pa[5]) + (pa[6] + pa[7])) + ((pa[8] + pa[9]) + (pa[10] + pa[11])) + ((pa[12] + pa[13]) + (pa[14] + pa[15]));
      l1 += ((pb[0] + pb[1]) + (pb[2] + pb[3])) + ((pb[4] + pb[5]) + (pb[6] + pb[7])) + ((pb[8] + pb[9]) + (pb[10] + pb[11])) + ((pb[12] + pb[13]) + (pb[14] + pb[15]));
      bf16x8 pf0[2], pf1[2];
#pragma unroll
      for (int s2 = 0; s2 < 2; ++s2) {
        unsigned w0[4], w1[4];
#pragma unroll
        for (int e = 0; e < 4; ++e) {
          w0[e] = pk2bf(pa[8 * s2 + 2 * e], pa[8 * s2 + 2 * e + 1]);
          w1[e] = pk2bf(pb[8 * s2 + 2 * e], pb[8 * s2 + 2 * e + 1]);
        }
        pf0[s2] = __builtin_bit_cast(bf16x8, make_uint4(w0[0], w0[1], w0[2], w0[3]));
        pf1[s2] = __builtin_bit_cast(bf16x8, make_uint4(w1[0], w1[1], w1[2], w1[3]));
      }
#pragma unroll
      for (int s2 = 0; s2 < 2; ++s2) {
        int ch = 4 * j + 2 * s2 + h;
        bf16x8 v0 = *(const bf16x8*)(sb + 16384 + r * 256 + ((ch ^ (r & 15)) << 4));
        bf16x8 v1 = *(const bf16x8*)(sb + 16384 + (32 + r) * 256 + ((ch ^ (r & 15)) << 4));
        O00 = MFMA32(v0, pf0[s2], O00);
        O01 = MFMA32(v1, pf0[s2], O01);
        O10 = MFMA32(v0, pf1[s2], O10);
        O11 = MFMA32(v1, pf1[s2], O11);
      }
    }
    if (it + 1 < nkt) ATT_SSTORE(smem + ((it + 1) & 1) * 32768);
    __syncthreads();
  }
  l0 += __shfl_xor(l0, 32);
  l1 += __shfl_xor(l1, 32);
  if (TYPE == 1) {
    l0 += __builtin_amdgcn_exp2f(a.sink[2 * g] * LOG2E);
    l1 += __builtin_amdgcn_exp2f(a.sink[2 * g + 1] * LOG2E);
  }
  const size_t orow = (size_t)b * NT + qpos;
  if (TYPE == 2) {
#pragma unroll
    for (int x = 0; x < 2; ++x) {
      int head = 2 * g + x;
      float* dst = a.Oslab + ((((size_t)half * NB + b) * 4 + head) * NT + qpos) * 64;
#pragma unroll
      for (int dt = 0; dt < 2; ++dt) {
        const f32x16& O = x == 0 ? (dt == 0 ? O00 : O01) : (dt == 0 ? O10 : O11);
#pragma unroll
        for (int q4 = 0; q4 < 4; ++q4)
          *(float4*)(dst + 32 * dt + 8 * q4 + 4 * h) = make_float4(O[4 * q4], O[4 * q4 + 1], O[4 * q4 + 2], O[4 * q4 + 3]);
      }
      if (h == 0) a.Lslab[(((size_t)half * NB + b) * 4 + head) * NT + qpos] = x == 0 ? l0 : l1;
    }
  } else if (TYPE == 0) {
    float s0 = 0.f, s1 = 0.f;
    for (int d = 0; d < 32; ++d) { s0 += a.lambda_diff[d] * a.lambda_diff[32 + d]; s1 += a.lambda_diff[64 + d] * a.lambda_diff[96 + d]; }
    const float lam = __expf(s0) - __expf(s1) + a.lambda_init;
    const float i0 = 1.f / l0, i1 = lam / l1;
    float o[32];
    float ss = 0.f;
#pragma unroll
    for (int i = 0; i < 16; ++i) {
      o[i] = O00[i] * i0 - O10[i] * i1;
      o[16 + i] = O01[i] * i0 - O11[i] * i1;
      ss += o[i] * o[i] + o[16 + i] * o[16 + i];
    }
    ss += __shfl_xor(ss, 32);
    const float rs = rsqrtf(ss * (1.f / 64) + EPS) * (1.f - a.lambda_init);
    const float* gm = a.g_mix_out + g * 64;
    bf16_t* dst = a.A2 + orow * D + g * 64;
#pragma unroll
    for (int dt = 0; dt < 2; ++dt)
#pragma unroll
      for (int q4 = 0; q4 < 4; ++q4) {
        int dv = 32 * dt + 8 * q4 + 4 * h;
        const float* ov = o + 16 * dt + 4 * q4;
        uint2 w;
        w.x = pk2bf(ov[0] * rs * gm[dv], ov[1] * rs * gm[dv + 1]);
        w.y = pk2bf(ov[2] * rs * gm[dv + 2], ov[3] * rs * gm[dv + 3]);
        *(uint2*)(dst + dv) = w;
      }
  } else {
#pragma unroll
    for (int x = 0; x < 2; ++x) {
      const float inv = 1.f / (x == 0 ? l0 : l1);
      float o[32];
      float ss = 0.f;
#pragma unroll
      for (int i = 0; i < 16; ++i) {
        o[i] = (x == 0 ? O00[i] : O10[i]) * inv;
        o[16 + i] = (x == 0 ? O01[i] : O11[i]) * inv;
        ss += o[i] * o[i] + o[16 + i] * o[16 + i];
      }
      ss += __shfl_xor(ss, 32);
      const float rs = rsqrtf(ss * (1.f / 64) + EPS);
      const int col0 = 256 + (2 * g + x) * 64;
      const float* gm = a.g_mix_out + col0;
      bf16_t* dst = a.A2 + orow * D + col0;
#pragma unroll
      for (int dt = 0; dt < 2; ++dt)
#pragma unroll
        for (int q4 = 0; q4 < 4; ++q4) {
          int dv = 32 * dt + 8 * q4 + 4 * h;
          const float* ov = o + 16 * dt + 4 * q4;
          uint2 w;
          w.x = pk2bf(ov[0] * rs * gm[dv], ov[1] * rs * gm[dv + 1]);
          w.y = pk2bf(ov[2] * rs * gm[dv + 2], ov[3] * rs * gm[dv + 3]);
          *(uint2*)(dst + dv) = w;
        }
    }
  }
}

DI void attn_dispatch(const AttnArgs& a, int idx, int want_ctx, char* smem) {
  if (idx < 256) {
    int b = idx >> 7, g = (idx >> 5) & 3, qt = 1 + (idx & 31);
    attn_item<0>(a, b, g, qt * 256, 0, 2, 2, 66, 0, smem);
  } else if (idx < 512) {
    int i = idx - 256; int half = i >> 7, b = (i >> 6) & 1, g = (i >> 5) & 1, qt = 1 + (i & 31);
    if (half == 0) attn_item<2>(a, b, g, qt * 256, 0, 2, 2, 33, 0, smem);
    else attn_item<2>(a, b, g, qt * 256, 0, 0, 33, 33, 1, smem);
  } else if (idx < 640) {
    int i = idx - 512; int b = i >> 6, g = (i >> 5) & 1, qt = 1 + (i & 31);
    int lo = max(2, 2 * qt - 1), hi = min(65, 2 * qt + 2);
    attn_item<1>(a, b, g, qt * 256, 0, 2, lo, 2 + (hi - lo + 1), 0, smem);
  } else if (want_ctx) {
    int i = idx - 640;
    if (i < 8) attn_item<0>(a, i >> 2, i & 3, 0, 0, 2, 0, 2, 0, smem);
    else if (i < 16) { int k = i - 8; int half = k >> 2, b = (k >> 1) & 1, g = k & 1; attn_item<2>(a, b, g, 0, half, 1, 0, 1, half, smem); }
    else if (i < 20) { int k = i - 16; attn_item<1>(a, k >> 1, k & 1, 0, 0, 2, 0, 2, 0, smem); }
  }
}
__global__ __launch_bounds__(NTHR) void k_attn(AttnArgs a, int want_ctx) {
  extern __shared__ __attribute__((aligned(16))) char smem[];
  int nitems = 640 + (want_ctx ? 20 : 0);
  for (int idx = blockIdx.x; idx < nitems; idx += gridDim.x) attn_dispatch(a, idx, want_ctx, smem);
}
__global__ __launch_bounds__(256) void k_glob_fin(const float* __restrict__ Oslab, const float* __restrict__ Lslab, const float* __restrict__ g_mix_out,
                                                  bf16_t* __restrict__ A2, int want_ctx) {
  int idx = blockIdx.x * 256 + threadIdx.x;
  int p = idx % NT; int hd = (idx / NT) % 4; int b = idx / (NT * 4);
  if (p < CTX && !want_ctx) return;
  size_t i0 = (((size_t)0 * NB + b) * 4 + hd) * NT + p, i1 = (((size_t)1 * NB + b) * 4 + hd) * NT + p;
  float inv = 1.f / (Lslab[i0] + Lslab[i1]);
  float o[64]; float ss = 0.f;
  const float4* a0 = (const float4*)(Oslab + i0 * 64); const float4* a1 = (const float4*)(Oslab + i1 * 64);
#pragma unroll
  for (int i = 0; i < 16; ++i) {
    float4 x = a0[i], y = a1[i];
    o[4 * i] = (x.x + y.x) * inv; o[4 * i + 1] = (x.y + y.y) * inv; o[4 * i + 2] = (x.z + y.z) * inv; o[4 * i + 3] = (x.w + y.w) * inv;
    ss += o[4 * i] * o[4 * i] + o[4 * i + 1] * o[4 * i + 1] + o[4 * i + 2] * o[4 * i + 2] + o[4 * i + 3] * o[4 * i + 3];
  }
  float rs = rsqrtf(ss * (1.f / 64) + EPS);
  const float* gm = g_mix_out + 512 + hd * 64;
  uint4* dst = (uint4*)(A2 + ((size_t)b * NT + p) * D + 512 + hd * 64);
#pragma unroll
  for (int i = 0; i < 8; ++i)
    dst[i] = make_uint4(pk2bf(o[8 * i] * rs * gm[8 * i], o[8 * i + 1] * rs * gm[8 * i + 1]), pk2bf(o[8 * i + 2] * rs * gm[8 * i + 2], o[8 * i + 3] * rs * gm[8 * i + 3]),
                        pk2bf(o[8 * i + 4] * rs * gm[8 * i + 4], o[8 * i + 5] * rs * gm[8 * i + 5]), pk2bf(o[8 * i + 6] * rs * gm[8 * i + 6], o[8 * i + 7] * rs * gm[8 * i + 7]));
}

typedef __attribute__((ext_vector_type(4))) float f32x4v;
DI void tabconv_row(const float* __restrict__ src, unsigned char* __restrict__ dst, float* __restrict__ scale, size_t row) {
  const int lane = threadIdx.x & 63;
  const float4* sp = (const float4*)(src + row * D + lane * 16);
  float4 v0 = sp[0], v1 = sp[1], v2 = sp[2], v3 = sp[3];
  float m = fmaxf(fmaxf(fmaxf(fabsf(v0.x), fabsf(v0.y)), fmaxf(fabsf(v0.z), fabsf(v0.w))), fmaxf(fmaxf(fabsf(v1.x), fabsf(v1.y)), fmaxf(fabsf(v1.z), fabsf(v1.w))));
  m = fmaxf(m, fmaxf(fmaxf(fmaxf(fabsf(v2.x), fabsf(v2.y)), fmaxf(fabsf(v2.z), fabsf(v2.w))), fmaxf(fmaxf(fabsf(v3.x), fabsf(v3.y)), fmaxf(fabsf(v3.z), fabsf(v3.w)))));
  for (int o = 32; o > 0; o >>= 1) m = fmaxf(m, __shfl_xor(m, o));
  m = fmaxf(m, 1e-30f);
  const float sc = m * (1.f / 448.f), inv = 448.f / m;
  int w0 = __builtin_amdgcn_cvt_pk_fp8_f32(v0.x * inv, v0.y * inv, 0, false); w0 = __builtin_amdgcn_cvt_pk_fp8_f32(v0.z * inv, v0.w * inv, w0, true);
  int w1 = __builtin_amdgcn_cvt_pk_fp8_f32(v1.x * inv, v1.y * inv, 0, false); w1 = __builtin_amdgcn_cvt_pk_fp8_f32(v1.z * inv, v1.w * inv, w1, true);
  int w2 = __builtin_amdgcn_cvt_pk_fp8_f32(v2.x * inv, v2.y * inv, 0, false); w2 = __builtin_amdgcn_cvt_pk_fp8_f32(v2.z * inv, v2.w * inv, w2, true);
  int w3 = __builtin_amdgcn_cvt_pk_fp8_f32(v3.x * inv, v3.y * inv, 0, false); w3 = __builtin_amdgcn_cvt_pk_fp8_f32(v3.z * inv, v3.w * inv, w3, true);
  *(uint4*)(dst + row * D + lane * 16) = make_uint4((unsigned)w0, (unsigned)w1, (unsigned)w2, (unsigned)w3);
  if (lane == 0) scale[row] = sc;
}
__global__ __launch_bounds__(NTHR) void k_tabconv(const float* __restrict__ src, unsigned char* __restrict__ dst, float* __restrict__ scale, int nrows) {
  int gw = blockIdx.x * 8 + (threadIdx.x >> 6);
  for (int row = gw; row < nrows; row += gridDim.x * 8) tabconv_row(src, dst, scale, (size_t)row);
}
__global__ __launch_bounds__(256) void k_f2bf(const float* __restrict__ src, bf16_t* __restrict__ dst, int n4) {
  for (int i = blockIdx.x * 256 + threadIdx.x; i < n4; i += gridDim.x * 256) {
    float4 v = ((const float4*)src)[i];
    ((uint2*)dst)[i] = make_uint2(pk2bf(v.x, v.y), pk2bf(v.z, v.w));
  }
}

DI void score_tile(const bf16_t* __restrict__ qbuf, const bf16_t* __restrict__ keysb, int m0, int hp, char* smem, float* __restrict__ topv,
                   unsigned char* __restrict__ topi) {
  const int tid = threadIdx.x, lane = tid & 63, wid = tid >> 6;
  const int wm = wid & 1, wn = wid >> 1;
  const int r = lane & 31, h = lane >> 5;
  f32x16 acc0, acc1;
  for (int i = 0; i < 16; ++i) { acc0[i] = 0.f; acc1[i] = 0.f; }
  const int lrow = tid >> 3, lch = tid & 7;
  const bf16_t* Ag = qbuf + (size_t)(m0 + lrow) * 2048 + hp * 128 + lch * 8;
  const bf16_t* Bg = keysb + ((size_t)hp * 128 + lrow) * 128 + lch * 8;
  const int woff = lrow * 128 + ((lch ^ ((lrow >> 1) & 7)) << 4);
  __syncthreads();
#pragma unroll
  for (int kt = 0; kt < 2; ++kt) {
    char* sn = smem + kt * 32768;
    *(uint4*)(sn + woff) = *(const uint4*)(Ag + kt * 64);
    *(uint4*)(sn + woff + 8192) = *(const uint4*)(Ag + (size_t)64 * 2048 + kt * 64);
    *(uint4*)(sn + 16384 + woff) = *(const uint4*)(Bg + kt * 64);
    *(uint4*)(sn + 16384 + woff + 8192) = *(const uint4*)(Bg + 64 * 128 + kt * 64);
  }
  __syncthreads();
  const int sw = (r >> 1) & 7;
  const int aoff0 = (wm * 64 + r) * 128, aoff1 = aoff0 + 32 * 128;
  const int boff = 16384 + (wn * 32 + r) * 128;
#pragma unroll
  for (int kt = 0; kt < 2; ++kt) {
    const char* st = smem + kt * 32768;
#pragma unroll
    for (int s = 0; s < 4; ++s) {
      int co = ((2 * s + h) ^ sw) << 4;
      bf16x8 a0 = *(const bf16x8*)(st + aoff0 + co);
      bf16x8 a1 = *(const bf16x8*)(st + aoff1 + co);
      bf16x8 b = *(const bf16x8*)(st + boff + co);
      acc0 = MFMA32(a0, b, acc0);
      acc1 = MFMA32(a1, b, acc1);
    }
  }
  __syncthreads();
  float* Cs = (float*)smem;
  constexpr int CS = 132;
#pragma unroll
  for (int i = 0; i < 16; ++i) {
    int row = (i & 3) + 8 * (i >> 2) + 4 * h;
    Cs[(wm * 64 + row) * CS + wn * 32 + r] = acc0[i];
    Cs[(wm * 64 + 32 + row) * CS + wn * 32 + r] = acc1[i];
  }
  __syncthreads();
  const int row = tid >> 2, q = tid & 3;
  float v[32];
#pragma unroll
  for (int i = 0; i < 32; ++i) v[i] = Cs[row * CS + 4 * i + q];
#pragma unroll 1
  for (int k = 0; k < 16; ++k) {
    float m = v[0]; int li = 0;
#pragma unroll
    for (int i = 1; i < 32; ++i) { bool gt = v[i] > m; m = gt ? v[i] : m; li = gt ? i : li; }
    int col = 4 * li + q;
    float m1 = __shfl_xor(m, 1); int c1 = __shfl_xor(col, 1);
    bool t1 = (m1 > m) || (m1 == m && c1 < col); m = t1 ? m1 : m; col = t1 ? c1 : col;
    float m2 = __shfl_xor(m, 2); int c2 = __shfl_xor(col, 2);
    bool t2 = (m2 > m) || (m2 == m && c2 < col); m = t2 ? m2 : m; col = t2 ? c2 : col;
    const bool own = (col & 3) == q; const int wi = col >> 2;
#pragma unroll
    for (int i = 0; i < 32; ++i) v[i] = (own && i == wi) ? -3.0e38f : v[i];
    if ((k & 3) == q) {
      size_t o = ((size_t)(m0 + row) * 16 + hp) * 16 + k;
      topv[o] = m; topi[o] = (unsigned char)col;
    }
  }
}
__global__ __launch_bounds__(NTHR) void k_scores(const bf16_t* __restrict__ qbuf, const bf16_t* __restrict__ keysb, float* __restrict__ topv,
                                                 unsigned char* __restrict__ topi) {
  extern __shared__ __attribute__((aligned(16))) char smem[];
  int ntiles = (R / 128) * 16;
  for (int t = blockIdx.x; t < ntiles; t += gridDim.x) score_tile(qbuf, keysb, (t >> 4) * 128, t & 15, smem, topv, topi);
}

DI void merge_one(const float* __restrict__ topv, const unsigned char* __restrict__ topi, int r, int hd, int* __restrict__ experts,
                  float* __restrict__ gates) {
  const float* va = topv + ((size_t)r * 16 + 2 * hd) * 16;
  const float* vb = va + 16;
  const unsigned char* ia = topi + ((size_t)r * 16 + 2 * hd) * 16;
  const unsigned char* ib = ia + 16;
  float a[16], bq[16];
#pragma unroll
  for (int i = 0; i < 4; ++i) {
    float4 x = ((const float4*)va)[i], y = ((const float4*)vb)[i];
    a[4 * i] = x.x; a[4 * i + 1] = x.y; a[4 * i + 2] = x.z; a[4 * i + 3] = x.w;
    bq[4 * i] = y.x; bq[4 * i + 1] = y.y; bq[4 * i + 2] = y.z; bq[4 * i + 3] = y.w;
  }
  float cv[50];
  {
    int n = 0;
#pragma unroll
    for (int i = 0; i < 16; ++i)
#pragma unroll
      for (int j = 0; j < 16; ++j)
        if ((i + 1) * (j + 1) <= 16) { cv[n] = a[i] + bq[j]; ++n; }
  }
  float best[16]; int bidx[16];
#pragma unroll
  for (int k = 0; k < 16; ++k) {
    float m = cv[0]; int mi = 0;
#pragma unroll
    for (int n = 1; n < 50; ++n) { bool gt = cv[n] > m; m = gt ? cv[n] : m; mi = gt ? n : mi; }
#pragma unroll
    for (int n = 0; n < 50; ++n) cv[n] = (n == mi) ? -3.0e38f : cv[n];
    best[k] = m; bidx[k] = mi;
  }
  float mx = best[0], sum = 0.f;
#pragma unroll
  for (int k = 0; k < 16; ++k) { best[k] = __expf(best[k] - mx); sum += best[k]; }
  const float inv = 1.f / sum;
#pragma unroll
  for (int k = 0; k < 16; ++k) {
    int mi = bidx[k];
    int ci = 0, cj = 0;
    {
      int n = 0;
#pragma unroll
      for (int i = 0; i < 16; ++i)
#pragma unroll
        for (int j = 0; j < 16; ++j)
          if ((i + 1) * (j + 1) <= 16) { if (n == mi) { ci = i; cj = j; } ++n; }
    }
    experts[(size_t)r * 128 + hd * 16 + k] = (int)ia[ci] * 128 + (int)ib[cj];
    gates[(size_t)r * 128 + hd * 16 + k] = best[k] * inv;
  }
}
__global__ __launch_bounds__(256) void k_merge(const float* __restrict__ topv, const unsigned char* __restrict__ topi, int* __restrict__ experts,
                                               float* __restrict__ gates, int want_ctx) {
  int idx = blockIdx.x * 256 + threadIdx.x;
  if (idx >= R * 8) return;
  int r = idx >> 3, hd = idx & 7;
  if ((r % NT) < CTX && !want_ctx) return;
  merge_one(topv, topi, r, hd, experts, gates);
}

DI void peer_token(int r, const bf16_t* __restrict__ hbuf, const int* __restrict__ experts, const float* __restrict__ gates,
                   const unsigned char* __restrict__ u8, const float* __restrict__ us, const unsigned char* __restrict__ v8,
                   const float* __restrict__ vs, const float* __restrict__ modv_l, float* __restrict__ xs, float* wdots  ) {
  const int lane = threadIdx.x & 63;
  float x[16];
  {
    const uint4* hr = (const uint4*)(hbuf + (size_t)r * D + lane * 16);
    uint4 a = hr[0], c = hr[1];
    x[0] = bflo(a.x); x[1] = bfhi(a.x); x[2] = bflo(a.y); x[3] = bfhi(a.y); x[4] = bflo(a.z); x[5] = bfhi(a.z); x[6] = bflo(a.w); x[7] = bfhi(a.w);
    x[8] = bflo(c.x); x[9] = bfhi(c.x); x[10] = bflo(c.y); x[11] = bfhi(c.y); x[12] = bflo(c.z); x[13] = bfhi(c.z); x[14] = bflo(c.w); x[15] = bfhi(c.w);
  }
  const int e0 = experts[(size_t)r * 128 + lane], e1 = experts[(size_t)r * 128 + 64 + lane];
  const float g0 = gates[(size_t)r * 128 + lane], g1 = gates[(size_t)r * 128 + 64 + lane];
  const float us0 = us[e0], us1 = us[e1], vs0 = vs[e0], vs1 = vs[e1];
#pragma unroll 1
  for (int k0 = 0; k0 < 128; k0 += 8) {
    uint4 rw[8];
#pragma unroll
    for (int j = 0; j < 8; ++j) {
      int k = k0 + j;
      int e = __builtin_amdgcn_readlane(k0 < 64 ? e0 : e1, k & 63);
      rw[j] = *(const uint4*)(u8 + (size_t)e * D + lane * 16);
    }
    float p[8];
#pragma unroll
    for (int j = 0; j < 8; ++j) {
      f32x2_t a0 = __builtin_amdgcn_cvt_pk_f32_fp8((int)rw[j].x, false), a1 = __builtin_amdgcn_cvt_pk_f32_fp8((int)rw[j].x, true);
      f32x2_t b0 = __builtin_amdgcn_cvt_pk_f32_fp8((int)rw[j].y, false), b1 = __builtin_amdgcn_cvt_pk_f32_fp8((int)rw[j].y, true);
      f32x2_t c0 = __builtin_amdgcn_cvt_pk_f32_fp8((int)rw[j].z, false), c1 = __builtin_amdgcn_cvt_pk_f32_fp8((int)rw[j].z, true);
      f32x2_t d0 = __builtin_amdgcn_cvt_pk_f32_fp8((int)rw[j].w, false), d1 = __builtin_amdgcn_cvt_pk_f32_fp8((int)rw[j].w, true);
      float s = a0[0] * x[0] + a0[1] * x[1] + a1[0] * x[2] + a1[1] * x[3];
      s += b0[0] * x[4] + b0[1] * x[5] + b1[0] * x[6] + b1[1] * x[7];
      s += c0[0] * x[8] + c0[1] * x[9] + c1[0] * x[10] + c1[1] * x[11];
      s += d0[0] * x[12] + d0[1] * x[13] + d1[0] * x[14] + d1[1] * x[15];
      p[j] = s;
    }
    const bool hi32 = lane & 32, hi16 = lane & 16, hi8 = lane & 8;
    float q4[4];
#pragma unroll
    for (int i = 0; i < 4; ++i) { float send = hi32 ? p[i] : p[4 + i]; float keep = hi32 ? p[4 + i] : p[i]; q4[i] = keep + __shfl_xor(send, 32); }
    float q2[2];
#pragma unroll
    for (int i = 0; i < 2; ++i) { float send = hi16 ? q4[i] : q4[2 + i]; float keep = hi16 ? q4[2 + i] : q4[i]; q2[i] = keep + __shfl_xor(send, 16); }
    float q1;
    { float send = hi8 ? q2[0] : q2[1]; float keep = hi8 ? q2[1] : q2[0]; q1 = keep + __shfl_xor(send, 8); }
    q1 += __shfl_xor(q1, 4); q1 += __shfl_xor(q1, 2); q1 += __shfl_xor(q1, 1);
    if ((lane & 7) == 0) wdots[k0 + (lane >> 3)] = q1;
  }
  float w0, w1;
  {
    float d0 = wdots[lane] * us0, d1 = wdots[64 + lane] * us1;
    float t0 = 0.5f * d0 * (1.f + tanhf(0.7978845608028654f * (d0 + 0.044715f * d0 * d0 * d0)));
    float t1 = 0.5f * d1 * (1.f + tanhf(0.7978845608028654f * (d1 + 0.044715f * d1 * d1 * d1)));
    w0 = g0 * t0 * vs0; w1 = g1 * t1 * vs1;
  }
  float acc[16];
#pragma unroll
  for (int i = 0; i < 16; ++i) acc[i] = 0.f;
#pragma unroll 1
  for (int k0 = 0; k0 < 128; k0 += 8) {
    uint4 rw[8];
#pragma unroll
    for (int j = 0; j < 8; ++j) {
      int k = k0 + j;
      int e = __builtin_amdgcn_readlane(k0 < 64 ? e0 : e1, k & 63);
      rw[j] = *(const uint4*)(v8 + (size_t)e * D + lane * 16);
    }
#pragma unroll
    for (int j = 0; j < 8; ++j) {
      int k = k0 + j;
      float w = __builtin_bit_cast(float, __builtin_amdgcn_readlane(__builtin_bit_cast(int, k0 < 64 ? w0 : w1), k & 63));
      f32x2_t a0 = __builtin_amdgcn_cvt_pk_f32_fp8((int)rw[j].x, false), a1 = __builtin_amdgcn_cvt_pk_f32_fp8((int)rw[j].x, true);
      f32x2_t b0 = __builtin_amdgcn_cvt_pk_f32_fp8((int)rw[j].y, false), b1 = __builtin_amdgcn_cvt_pk_f32_fp8((int)rw[j].y, true);
      f32x2_t c0 = __builtin_amdgcn_cvt_pk_f32_fp8((int)rw[j].z, false), c1 = __builtin_amdgcn_cvt_pk_f32_fp8((int)rw[j].z, true);
      f32x2_t d0 = __builtin_amdgcn_cvt_pk_f32_fp8((int)rw[j].w, false), d1 = __builtin_amdgcn_cvt_pk_f32_fp8((int)rw[j].w, true);
      acc[0] += w * a0[0]; acc[1] += w * a0[1]; acc[2] += w * a1[0]; acc[3] += w * a1[1];
      acc[4] += w * b0[0]; acc[5] += w * b0[1]; acc[6] += w * b1[0]; acc[7] += w * b1[1];
      acc[8] += w * c0[0]; acc[9] += w * c0[1]; acc[10] += w * c1[0]; acc[11] += w * c1[1];
      acc[12] += w * d0[0]; acc[13] += w * d0[1]; acc[14] += w * d1[0]; acc[15] += w * d1[1];
    }
  }
  const int b = r / NT, p = r % NT; const int mrow = p < CTX ? 2 : b;
  const float* g2 = modv_l + mrow * NMOD + 5 * D + lane * 16;
  float4* xp = (float4*)(xs + (size_t)r * D + lane * 16);
#pragma unroll
  for (int i = 0; i < 4; ++i) {
    float4 xv = xp[i]; float4 gg = ((const float4*)g2)[i];
    xv.x += gg.x * acc[4 * i]; xv.y += gg.y * acc[4 * i + 1]; xv.z += gg.z * acc[4 * i + 2]; xv.w += gg.w * acc[4 * i + 3];
    xp[i] = xv;
  }
}
__global__ __launch_bounds__(NTHR) void k_peer(const bf16_t* __restrict__ hbuf, const int* __restrict__ experts, const float* __restrict__ gates,
                                               const unsigned char* __restrict__ u8, const float* __restrict__ us, const unsigned char* __restrict__ v8,
                                               const float* __restrict__ vs, const float* __restrict__ modv_l, float* __restrict__ xs, int want_ctx) {
  __shared__ float wd[8][128];
  const int wid = threadIdx.x >> 6;
  for (int r = blockIdx.x * 8 + wid; r < R; r += gridDim.x * 8) {
    if ((r % NT) < CTX && !want_ctx) continue;
    peer_token(r, hbuf, experts, gates, u8, us, v8, vs, modv_l, xs, wd[wid]);
  }
}

constexpr int FN = 2 * SEQ;
DI float2 cmul(float2 a, float2 b) { return make_float2(a.x * b.x - a.y * b.y, a.x * b.y + a.y * b.x); }
DI float2 cmulc(float2 a, float2 b) { return make_float2(a.x * b.x + a.y * b.y, a.y * b.x - a.x * b.y); }
DI int rev4_7(int x) {
  return ((x & 3) << 12) | ((x >> 12) & 3) | ((x & 0xC) << 8) | ((x >> 8) & 0xC) | ((x & 0x30) << 4) | ((x >> 4) & 0x30) | (x & 0xC0);
}
DI void fft_fwd(float2* X) {
  const int tid = threadIdx.x;
#pragma unroll 1
  for (int p = 0; p < 7; ++p) {
    const int lq = 12 - 2 * p; const int q = 1 << lq;
    const float invL = 1.f / (float)(4 << lq);
    __syncthreads();
#pragma unroll 2
    for (int m = 0; m < 8; ++m) {
      const int i = tid + 512 * m;
      const int j = i & (q - 1); const int base = ((i >> lq) << (lq + 2)) + j;
      float2 a = X[base], b = X[base + q], c = X[base + 2 * q], d = X[base + 3 * q];
      float2 t0 = make_float2(a.x + c.x, a.y + c.y), t1 = make_float2(a.x - c.x, a.y - c.y);
      float2 t2 = make_float2(b.x + d.x, b.y + d.y), t3 = make_float2(b.y - d.y, d.x - b.x);
      float2 y0 = make_float2(t0.x + t2.x, t0.y + t2.y), y1 = make_float2(t1.x + t3.x, t1.y + t3.y);
      float2 y2 = make_float2(t0.x - t2.x, t0.y - t2.y), y3 = make_float2(t1.x - t3.x, t1.y - t3.y);
      const float fr = (float)j * invL;
      float2 w1 = make_float2(__builtin_amdgcn_cosf(fr), -__builtin_amdgcn_sinf(fr));
      float2 w2 = cmul(w1, w1), w3 = cmul(w2, w1);
      X[base] = y0; X[base + q] = cmul(y1, w1); X[base + 2 * q] = cmul(y2, w2); X[base + 3 * q] = cmul(y3, w3);
    }
  }
  __syncthreads();
}
DI void fft_inv(float2* X) {
  const int tid = threadIdx.x;
#pragma unroll 1
  for (int p = 6; p >= 0; --p) {
    const int lq = 12 - 2 * p; const int q = 1 << lq;
    const float invL = 1.f / (float)(4 << lq);
    __syncthreads();
#pragma unroll 2
    for (int m = 0; m < 8; ++m) {
      const int i = tid + 512 * m;
      const int j = i & (q - 1); const int base = ((i >> lq) << (lq + 2)) + j;
      const float fr = (float)j * invL;
      float2 w1 = make_float2(__builtin_amdgcn_cosf(fr), -__builtin_amdgcn_sinf(fr));
      float2 w2 = cmul(w1, w1), w3 = cmul(w2, w1);
      float2 y0 = X[base], y1 = cmulc(X[base + q], w1), y2 = cmulc(X[base + 2 * q], w2), y3 = cmulc(X[base + 3 * q], w3);
      float2 t0 = make_float2(y0.x + y2.x, y0.y + y2.y), t1 = make_float2(y0.x - y2.x, y0.y - y2.y);
      float2 t2 = make_float2(y1.x + y3.x, y1.y + y3.y), t3 = make_float2(y3.y - y1.y, y1.x - y3.x);
      X[base] = make_float2(t0.x + t2.x, t0.y + t2.y);
      X[base + q] = make_float2(t1.x + t3.x, t1.y + t3.y);
      X[base + 2 * q] = make_float2(t0.x - t2.x, t0.y - t2.y);
      X[base + 3 * q] = make_float2(t1.x - t3.x, t1.y - t3.y);
    }
  }
  __syncthreads();
}
DI float block_sum_512(float v, float* red) {
  for (int o = 32; o > 0; o >>= 1) v += __shfl_xor(v, o);
  __syncthreads();
  if ((threadIdx.x & 63) == 0) red[threadIdx.x >> 6] = v;
  __syncthreads();
  float s = 0.f;
  for (int i = 0; i < 8; ++i) s += red[i];
  return s;
}
DI void hyena_channel(int c, const float* __restrict__ hdn2, const float* __restrict__ w3, const float* __restrict__ b3,
                      const float* __restrict__ hy_bias, const float* __restrict__ uT, float* __restrict__ zT, float* __restrict__ yT,
                      float2* __restrict__ Hc_all, char* smem) {
  float2* X = (float2*)smem;
  float* red = (float*)(smem + 131072);
  float* wcol = red + 16;
  float2* Hc = Hc_all + (size_t)c * FN;
  const int tid = threadIdx.x;
  __syncthreads();
  if (tid < 256) {
    int od = tid >> 6, i = tid & 63;
    wcol[od * 64 + i] = w3[i * 1024 + (od >> 1) * 512 + (od & 1) * 256 + c];
  }
  __syncthreads();
  const float delta = fabsf(-3.0701134573253944f + (float)c * ((-15.350567286626972f + 3.0701134573253944f) / 255.f));
  const float bb00 = b3[c], bb01 = b3[256 + c], bb10 = b3[512 + c], bb11 = b3[768 + c];
  float n0 = 0.f, n1 = 0.f;
#pragma unroll 1
  for (int j = tid; j < SEQ; j += 512) {
    asm volatile("" ::: "memory");
    const float4* hr = (const float4*)(hdn2 + (size_t)j * 64);
    float f00 = bb00, f01 = bb01, f10 = bb10, f11 = bb11;
#pragma unroll 4
    for (int i = 0; i < 16; ++i) {
      float4 hv = hr[i];
      const float* w0 = wcol + 4 * i;
      f00 += hv.x * w0[0] + hv.y * w0[1] + hv.z * w0[2] + hv.w * w0[3];
      f01 += hv.x * w0[64] + hv.y * w0[65] + hv.z * w0[66] + hv.w * w0[67];
      f10 += hv.x * w0[128] + hv.y * w0[129] + hv.z * w0[130] + hv.w * w0[131];
      f11 += hv.x * w0[192] + hv.y * w0[193] + hv.z * w0[194] + hv.w * w0[195];
    }
    const float dec = __expf(-((float)j / (float)(SEQ - 1)) * delta);
    f00 *= dec; f01 *= dec; f10 *= dec; f11 *= dec;
    X[j] = make_float2(f00, f10);
    n0 += fabsf(f00); n1 += fabsf(f10);
    if (j > 0) { X[FN - j] = make_float2(f01, f11); n0 += fabsf(f01); n1 += fabsf(f11); }
    else X[SEQ] = make_float2(0.f, 0.f);
  }
  n0 = block_sum_512(n0, red);
  n1 = block_sum_512(n1, red);
  const float s0 = 1.f / (n0 * (float)FN), s1 = 1.f / (n1 * (float)FN);
  fft_fwd(X);
  for (int i = tid; i < FN; i += 512) Hc[i] = X[i];
  const float* v0p = uT + ((size_t)0 * 768 + c) * NT + CTX;
  const float* v1p = uT + ((size_t)1 * 768 + c) * NT + CTX;
  __syncthreads();
  for (int t = tid; t < SEQ; t += 512) { X[t] = make_float2(v0p[t], v1p[t]); X[SEQ + t] = make_float2(0.f, 0.f); }
  fft_fwd(X);
  for (int pos = tid; pos < FN; pos += 512) {
    int f = rev4_7(pos); int pm = rev4_7((FN - f) & (FN - 1));
    float2 A = Hc[pos], Bm = Hc[pm];
    float2 K0 = make_float2((A.x + Bm.x) * 0.5f * s0, (A.y - Bm.y) * 0.5f * s0);
    X[pos] = cmul(X[pos], K0);
  }
  fft_inv(X);
  {
    const float bias0 = hy_bias[c];
    const float* x10 = v0p + (size_t)256 * NT; const float* x11 = v1p + (size_t)256 * NT;
    float* z0 = zT + ((size_t)0 * 256 + c) * NT + CTX; float* z1 = zT + ((size_t)1 * 256 + c) * NT + CTX;
    for (int t = tid; t < SEQ; t += 512) {
      float2 y = X[t];
      float za = x10[t] * (y.x + bias0 * v0p[t]);
      float zb = x11[t] * (y.y + bias0 * v1p[t]);
      z0[t] = za; z1[t] = zb;
      X[t] = make_float2(za, zb);
    }
    __syncthreads();
    for (int t = tid; t < SEQ; t += 512) X[SEQ + t] = make_float2(0.f, 0.f);
  }
  fft_fwd(X);
  for (int pos = tid; pos < FN; pos += 512) {
    int f = rev4_7(pos); int pm = rev4_7((FN - f) & (FN - 1));
    float2 A = Hc[pos], Bm = Hc[pm];
    float2 K1 = make_float2((A.y + Bm.y) * 0.5f * s1, -(A.x - Bm.x) * 0.5f * s1);
    X[pos] = cmul(X[pos], K1);
  }
  fft_inv(X);
  {
    const float bias1 = hy_bias[256 + c];
    const float* x20 = v0p + (size_t)512 * NT; const float* x21 = v1p + (size_t)512 * NT;
    const float* z0 = zT + ((size_t)0 * 256 + c) * NT + CTX; const float* z1 = zT + ((size_t)1 * 256 + c) * NT + CTX;
    float* y0 = yT + ((size_t)0 * 256 + c) * NT + CTX; float* y1 = yT + ((size_t)1 * 256 + c) * NT + CTX;
    for (int t = tid; t < SEQ; t += 512) {
      float2 y = X[t];
      y0[t] = x20[t] * (y.x + bias1 * z0[t]);
      y1[t] = x21[t] * (y.y + bias1 * z1[t]);
    }
  }
}
__global__ __launch_bounds__(NTHR) void k_hyena_fft(const float* __restrict__ hdn2, const float* __restrict__ w3, const float* __restrict__ b3,
                                                    const float* __restrict__ hy_bias, const float* __restrict__ uT, float* __restrict__ zT,
                                                    float* __restrict__ yT, float2* __restrict__ Hc_all) {
  extern __shared__ __attribute__((aligned(16))) char smem[];
  for (int c = blockIdx.x; c < 256; c += gridDim.x) hyena_channel(c, hdn2, w3, b3, hy_bias, uT, zT, yT, Hc_all, smem);
}

static inline size_t align_up(size_t x) { return (x + 255) & ~(size_t)255; }

extern "C" void kernel_launch(void* const* d_in, const int* in_sizes, int n_in, void* d_out, int out_size, void* d_ws, size_t ws_size,
                              hipStream_t stream) {
  const float* x = (const float*)d_in[0];
  const float* c = (const float*)d_in[1];
  const float* ctx = (const float*)d_in[2];
  const float* c_ctx = (const float*)d_in[3];
  const float* w_mod = (const float*)d_in[4];
  const float* b_mod = (const float*)d_in[5];
  const float* g_norm_mix = (const float*)d_in[6];
  const float* w_in = (const float*)d_in[7];
  const float* g_qk_diff = (const float*)d_in[8];
  const float* lambda_diff = (const float*)d_in[9];
  const float* g_qk_win = (const float*)d_in[10];
  const float* sink_win = (const float*)d_in[11];
  const float* g_qk_glob = (const float*)d_in[12];
  const float* hy_conv_w = (const float*)d_in[13];
  const float* hy_conv_b = (const float*)d_in[14];
  const float* hy_w1 = (const float*)d_in[15];
  const float* hy_b1 = (const float*)d_in[16];
  const float* hy_w2 = (const float*)d_in[17];
  const float* hy_b2 = (const float*)d_in[18];
  const float* hy_w3 = (const float*)d_in[19];
  const float* hy_b3 = (const float*)d_in[20];
  const float* hy_freq = (const float*)d_in[21];
  const float* hy_bias = (const float*)d_in[22];
  const float* g_mix_out = (const float*)d_in[23];
  const float* w_out = (const float*)d_in[24];
  const float* g_norm_ffn = (const float*)d_in[25];
  const float* peer_wq = (const float*)d_in[26];
  const float* peer_keys = (const float*)d_in[27];
  const float* peer_u = (const float*)d_in[28];
  const float* peer_v = (const float*)d_in[29];
  float* out = (float*)d_out;

  char* ws = (char*)d_ws;
  size_t off = 0;
  auto carve = [&](size_t bytes) { char* p = ws + off; off = align_up(off + bytes); return p; };
  float* modv = (float*)carve((size_t)2 * 3 * NMOD * 4);
  float* xs = (float*)carve((size_t)R * D * 4);
  bf16_t* hbuf = (bf16_t*)carve((size_t)R * D * 2);
  bf16_t* P = (bf16_t*)carve((size_t)R * DIN * 2);
  bf16_t* qbuf = P;
  bf16_t* Wt_in = (bf16_t*)carve((size_t)2 * DIN * D * 2);
  bf16_t* Wt_out = (bf16_t*)carve((size_t)2 * D * D * 2);
  bf16_t* Wt_q = (bf16_t*)carve((size_t)2 * 2048 * D * 2);
  PrepOut po;
  po.QA = (bf16_t*)carve((size_t)NB * 8 * NT * 32 * 2);
  po.KA = (bf16_t*)carve((size_t)NB * 8 * NT * 32 * 2);
  po.VAt = (bf16_t*)carve((size_t)NB * 4 * 64 * NT * 2);
  po.QW = (bf16_t*)carve((size_t)NB * 4 * NT * 64 * 2);
  po.KW = (bf16_t*)carve((size_t)NB * 2 * NT * 64 * 2);
  po.VWt = (bf16_t*)carve((size_t)NB * 2 * 64 * NT * 2);
  po.QG = (bf16_t*)carve((size_t)NB * 4 * NT * 64 * 2);
  po.KG = (bf16_t*)carve((size_t)NB * 2 * NT * 64 * 2);
  po.VGt = (bf16_t*)carve((size_t)NB * 2 * 64 * NT * 2);
  po.uT = (float*)carve((size_t)NB * 768 * NT * 4);
  float* zT = (float*)carve((size_t)NB * 256 * NT * 4);
  float* yT = (float*)carve((size_t)NB * 256 * NT * 4);
  float* hdn2 = (float*)carve((size_t)2 * SEQ * 64 * 4);
  float* kc = (float*)carve((KC_W0 + (size_t)2 * 256 * 2 * CTX) * 4);
  float2* Hc_all = (float2*)carve((size_t)256 * FN * 8);
  bf16_t* A2 = (bf16_t*)carve((size_t)R * D * 2);
  unsigned char* u8 = (unsigned char*)carve((size_t)2 * 16384 * D);
  unsigned char* v8 = (unsigned char*)carve((size_t)2 * 16384 * D);
  float* us = (float*)carve((size_t)2 * 16384 * 4);
  float* vs = (float*)carve((size_t)2 * 16384 * 4);
  bf16_t* keysb = (bf16_t*)carve((size_t)2 * 16 * 128 * 128 * 2);
  float* topv = (float*)po.uT;
  unsigned char* topi = (unsigned char*)(topv + (size_t)R * 256);
  int* experts = (int*)(topi + (size_t)R * 256);
  float* gates = (float*)(experts + (size_t)R * 128);
  float* Otmp = (float*)P;
  if (off > ws_size) return; (void)in_sizes; (void)n_in; (void)out_size;

  k_mod<<<dim3(NMOD / 256, 2), 256, 0, stream>>>(c, c_ctx, w_mod, b_mod, modv);
  constexpr int GEMM_LDS = 128 * 132 * 4;
  constexpr int HY_LDS = 131072 + 2048;
  hipFuncSetAttribute((const void*)k_hyena_fft, hipFuncAttributeMaxDynamicSharedMemorySize, HY_LDS);
  hipFuncSetAttribute((const void*)k_gemm<0>, hipFuncAttributeMaxDynamicSharedMemorySize, GEMM_LDS);
  hipFuncSetAttribute((const void*)k_gemm<1>, hipFuncAttributeMaxDynamicSharedMemorySize, GEMM_LDS);
  hipFuncSetAttribute((const void*)k_attn, hipFuncAttributeMaxDynamicSharedMemorySize, 65536);
  hipFuncSetAttribute((const void*)k_scores, hipFuncAttributeMaxDynamicSharedMemorySize, GEMM_LDS);
  for (int l = 0; l < 2; ++l) {
    k_wconv<<<256, NTHR, 0, stream>>>(w_in + (size_t)l * D * DIN, Wt_in + (size_t)l * DIN * D, DIN);
    k_wconv<<<256, NTHR, 0, stream>>>(w_out + (size_t)l * D * D, Wt_out + (size_t)l * D * D, D);
    k_wconv<<<256, NTHR, 0, stream>>>(peer_wq + (size_t)l * D * 2048, Wt_q + (size_t)l * 2048 * D, 2048);
    k_tabconv<<<1024, NTHR, 0, stream>>>(peer_u + (size_t)l * 16384 * D, u8 + (size_t)l * 16384 * D, us + l * 16384, 16384);
    k_tabconv<<<1024, NTHR, 0, stream>>>(peer_v + (size_t)l * 16384 * D, v8 + (size_t)l * 16384 * D, vs + l * 16384, 16384);
    k_f2bf<<<256, 256, 0, stream>>>(peer_keys + (size_t)l * 16 * 128 * 128, keysb + (size_t)l * 16 * 128 * 128, 16 * 128 * 128 / 4);
  }
  k_init_xs<<<R, 256, 0, stream>>>(x, ctx, xs);

  for (int l = 0; l < 2; ++l) {
    int want_ctx = l < 1 ? 1 : 0;
    float lambda_init = 0.8f - 0.6f * expf(-0.3f * (float)l);
    const float* modv_l = modv + (size_t)l * 3 * NMOD;
    k_norm_mod<<<R, 256, 0, stream>>>(xs, g_norm_mix + l * D, modv_l, 0, hbuf);
    k_gemm<0><<<256, NTHR, GEMM_LDS, stream>>>(hbuf, Wt_in + (size_t)l * DIN * D, DIN, P, nullptr, nullptr);
    k_prep<<<R, 256, 0, stream>>>(P, g_qk_diff + l * 64, g_qk_win + l * 128, g_qk_glob + l * 128, hy_conv_w + l * 3 * 768,
                                  hy_conv_b + l * 768, po);
    {
      AttnArgs aa;
      memset(&aa, 0, sizeof(aa));
      aa.QA = po.QA; aa.KA = po.KA; aa.VAt = po.VAt; aa.QW = po.QW; aa.KW = po.KW; aa.VWt = po.VWt; aa.QG = po.QG; aa.KG = po.KG; aa.VGt = po.VGt;
      aa.g_qk_diff = g_qk_diff + l * 64; aa.g_qk_win = g_qk_win + l * 128; aa.g_qk_glob = g_qk_glob + l * 128; aa.sink = sink_win + l * 4;
      aa.lambda_diff = lambda_diff + l * 128; aa.g_mix_out = g_mix_out + l * D; aa.lambda_init = lambda_init; aa.A2 = A2;
      aa.Oslab = Otmp; aa.Lslab = Otmp + (size_t)2 * NB * 4 * NT * 64;
      k_attn<<<256, NTHR, 65536, stream>>>(aa, want_ctx);
      k_glob_fin<<<NB * 4 * NT / 256, 256, 0, stream>>>(aa.Oslab, aa.Lslab, g_mix_out + l * D, A2, want_ctx);
    }
    k_hy_mlp<<<SEQ + CTX, 64, 0, stream>>>(hy_w1 + l * 33 * 64, hy_b1 + l * 64, hy_w2 + l * 64 * 64, hy_b2 + l * 64, hy_freq + l * 64, hdn2);
    k_hyena_fft<<<256, NTHR, HY_LDS, stream>>>(hdn2, hy_w3 + (size_t)l * 64 * 1024, hy_b3 + l * 1024, hy_bias + l * 512, po.uT, zT, yT, Hc_all);
    if (want_ctx) k_hy_filt<<<dim3(256, 2, 2), 256, 0, stream>>>(hdn2, hy_w3 + (size_t)l * 64 * 1024, hy_b3 + l * 1024, kc, want_ctx);
    if (want_ctx) {
      k_hy_conv<0><<<dim3(CTX / 256, 256, NB), 256, 0, stream>>>(po.uT, nullptr, zT, kc, hy_bias + l * 512, 1);
      k_hy_conv<1><<<dim3(CTX / 256, 256, NB), 256, 0, stream>>>(po.uT, zT, yT, kc, hy_bias + l * 512, 1);
    }
    k_hy_fin<<<NB * 4 * NT / 256, 256, 0, stream>>>(yT, g_mix_out + l * D, A2, want_ctx);
    k_gemm<1><<<256, NTHR, GEMM_LDS, stream>>>(A2, Wt_out + (size_t)l * D * D, D, nullptr, xs, modv_l + 2 * D);
    k_norm_mod<<<R, 256, 0, stream>>>(xs, g_norm_ffn + l * D, modv_l, 3, hbuf);
    k_gemm<0><<<256, NTHR, GEMM_LDS, stream>>>(hbuf, Wt_q + (size_t)l * 2048 * D, 2048, qbuf, nullptr, nullptr);
    k_scores<<<256, NTHR, GEMM_LDS, stream>>>(qbuf, keysb + (size_t)l * 16 * 128 * 128, topv, topi);
    k_merge<<<R * 8 / 256, 256, 0, stream>>>(topv, topi, experts, gates, want_ctx);
    k_peer<<<256, NTHR, 0, stream>>>(hbuf, experts, gates, u8 + (size_t)l * 16384 * D, us + l * 16384, v8 + (size_t)l * 16384 * D, vs + l * 16384,
                                    modv_l, xs, want_ctx);
  }
  k_final<<<NB * SEQ, 256, 0, stream>>>(xs, out);
}
```

```cpp
#include <hip/hip_runtime.h>
#include <hip/hip_cooperative_groups.h>
namespace cg = cooperative_groups;
#include <stdint.h>
#include <string.h>

#define DI __device__ __forceinline__
typedef unsigned short bf16_t;

constexpr int D = 1024;
constexpr int NB = 2;
constexpr int SEQ = 8192;
constexpr int CTX = 256;
constexpr int NT = SEQ + CTX;
constexpr int R = NB * NT;
constexpr int DIN = 2560;
constexpr int NMOD = 6 * D;
constexpr float EPS = 1e-6f;
constexpr float LOG2E = 1.4426950408889634f;

DI int opq_v(int x) { asm volatile("" : "+v"(x)); return x; }
DI int opq_s(int x) { asm volatile("" : "+s"(x)); return x; }
template <class T> DI T* opq_p(T* p) { asm volatile("" : "+s"(p)); return p; }
#define TID opq_v((int)threadIdx.x)
#define BID opq_s((int)blockIdx.x)
#define NBLK opq_s((int)gridDim.x)
DI float shxl(float v, int lane, int mask) { return __builtin_bit_cast(float, __builtin_amdgcn_ds_bpermute((lane ^ mask) << 2, __builtin_bit_cast(int, v))); }
DI int shxl(int v, int lane, int mask) { return __builtin_amdgcn_ds_bpermute((lane ^ mask) << 2, v); }
DI float shx(float v, int mask) { return shxl(v, opq_v((int)threadIdx.x) & 63, mask); }
DI bf16_t f2bf(float x) { unsigned u = __float_as_uint(x); u += 0x7fffu + ((u >> 16) & 1u); return (bf16_t)(u >> 16); }
DI float bf2f(bf16_t h) { return __uint_as_float(((unsigned)h) << 16); }
DI float bflo(unsigned w) { return __uint_as_float(w << 16); }
DI float bfhi(unsigned w) { return __uint_as_float(w & 0xffff0000u); }

DI float block_sum_256(float v, float* red) {
  for (int o = 32; o > 0; o >>= 1) v += shx(v, o);
  int w = TID >> 6;
  __syncthreads();
  if ((TID & 63) == 0) red[w] = v;
  __syncthreads();
  float s = red[0] + red[1] + red[2] + red[3];
  return s;
}

DI int perm16(int o) { return (o & 3) | ((o & 4) << 1) | ((o & 8) >> 1); }

typedef __attribute__((ext_vector_type(8))) short bf16x8;
typedef __attribute__((ext_vector_type(16))) float f32x16;
typedef __attribute__((ext_vector_type(2))) __bf16 bf16x2_t;
typedef __attribute__((ext_vector_type(2))) float f32x2_t;
#define MFMA32(a, b, c) __builtin_amdgcn_mfma_f32_32x32x16_bf16((a), (b), (c), 0, 0, 0)
DI unsigned pk2bf(float a, float b) { f32x2_t v = {a, b}; return __builtin_bit_cast(unsigned, __builtin_convertvector(v, bf16x2_t)); }
constexpr int NTHR = 512;

DI void wconv_tile(const float* __restrict__ W, bf16_t* __restrict__ Wt, int N, int tile, float* sm  ) {
  int tn = tile % (N / 64), tk = tile / (N / 64);
  int tid = TID;
  __syncthreads();
  for (int i = tid; i < 64 * 16; i += NTHR) {
    int kr = i >> 4, c4 = (i & 15) * 4;
    float4 v = *(const float4*)(W + (size_t)(tk * 64 + kr) * N + tn * 64 + c4);
    sm[kr * 65 + c4] = v.x; sm[kr * 65 + c4 + 1] = v.y; sm[kr * 65 + c4 + 2] = v.z; sm[kr * 65 + c4 + 3] = v.w;
  }
  __syncthreads();
  for (int i = tid; i < 64 * 8; i += NTHR) {
    int n = i >> 3, k8 = (i & 7) * 8;
    unsigned w[4];
    for (int j = 0; j < 4; ++j) w[j] = pk2bf(sm[(k8 + 2 * j) * 65 + n], sm[(k8 + 2 * j + 1) * 65 + n]);
    *(uint4*)(Wt + (size_t)(tn * 64 + n) * D + tk * 64 + k8) = make_uint4(w[0], w[1], w[2], w[3]);
  }
}

template <int EPI>
DI void gemm_tile(const bf16_t* __restrict__ A, const bf16_t* __restrict__ Wt, int N, int m0, int n0, char* smem, bf16_t* __restrict__ Cb,
                  float* __restrict__ xs, const float* __restrict__ gate_base) {
  constexpr int K = D;
  const int tid = TID, lane = tid & 63, wid = tid >> 6;
  const int wm = wid & 1, wn = wid >> 1;
  const int r = lane & 31, h = lane >> 5;
  f32x16 acc0, acc1;
  for (int i = 0; i < 16; ++i) { acc0[i] = 0.f; acc1[i] = 0.f; }
  const int lrow = tid >> 3, lch = tid & 7;
  const bf16_t* Ag = A + (size_t)(m0 + lrow) * K + lch * 8;
  const bf16_t* Bg = Wt + (size_t)(n0 + lrow) * K + lch * 8;
  const int woff = lrow * 128 + ((lch ^ ((lrow >> 1) & 7)) << 4);
  uint4 ra0, ra1, rb0, rb1;
  ra0 = *(const uint4*)(Ag); ra1 = *(const uint4*)(Ag + (size_t)64 * K);
  rb0 = *(const uint4*)(Bg); rb1 = *(const uint4*)(Bg + (size_t)64 * K);
  __syncthreads();
  *(uint4*)(smem + woff) = ra0; *(uint4*)(smem + woff + 8192) = ra1;
  *(uint4*)(smem + 16384 + woff) = rb0; *(uint4*)(smem + 16384 + woff + 8192) = rb1;
  __syncthreads();
  const int sw = (r >> 1) & 7;
  const int aoff0 = (wm * 64 + r) * 128, aoff1 = aoff0 + 32 * 128;
  const int boff = 16384 + (wn * 32 + r) * 128;
#pragma unroll 1
  for (int kt = 0; kt < K / 64; ++kt) {
    const char* st = smem + (kt & 1) * 32768;
    if (kt + 1 < K / 64) {
      ra0 = *(const uint4*)(Ag + (kt + 1) * 64); ra1 = *(const uint4*)(Ag + (size_t)64 * K + (kt + 1) * 64);
      rb0 = *(const uint4*)(Bg + (kt + 1) * 64); rb1 = *(const uint4*)(Bg + (size_t)64 * K + (kt + 1) * 64);
    }
#pragma unroll
    for (int s = 0; s < 4; ++s) {
      int co = ((2 * s + h) ^ sw) << 4;
      bf16x8 a0 = *(const bf16x8*)(st + aoff0 + co);
      bf16x8 a1 = *(const bf16x8*)(st + aoff1 + co);
      bf16x8 b = *(const bf16x8*)(st + boff + co);
      acc0 = MFMA32(a0, b, acc0);
      acc1 = MFMA32(a1, b, acc1);
    }
    if (kt + 1 < K / 64) {
      char* sn = smem + ((kt + 1) & 1) * 32768;
      *(uint4*)(sn + woff) = ra0; *(uint4*)(sn + woff + 8192) = ra1;
      *(uint4*)(sn + 16384 + woff) = rb0; *(uint4*)(sn + 16384 + woff + 8192) = rb1;
    }
    __syncthreads();
  }
  float* Cs = (float*)smem;
  constexpr int CS = 132;
#pragma unroll
  for (int i = 0; i < 16; ++i) {
    int row = (i & 3) + 8 * (i >> 2) + 4 * h;
    Cs[(wm * 64 + row) * CS + wn * 32 + r] = acc0[i];
    Cs[(wm * 64 + 32 + row) * CS + wn * 32 + r] = acc1[i];
  }
  __syncthreads();
  if (EPI == 0) {
    for (int i = tid; i < 128 * 16; i += NTHR) {
      int row = i >> 4, c8 = (i & 15) * 8;
      const float* cr = Cs + row * CS + c8;
      float4 v0 = *(const float4*)cr, v1 = *(const float4*)(cr + 4);
      *(uint4*)(Cb + (size_t)(m0 + row) * N + n0 + c8) = make_uint4(pk2bf(v0.x, v0.y), pk2bf(v0.z, v0.w), pk2bf(v1.x, v1.y), pk2bf(v1.z, v1.w));
    }
  } else {
    for (int i = tid; i < 128 * 32; i += NTHR) {
      int row = i >> 5, c4 = (i & 31) * 4;
      int rr = m0 + row; int b = rr / NT, p = rr % NT; int mrow = p < CTX ? 2 : b;
      const float* gt = gate_base + mrow * NMOD + n0 + c4;
      float4 v = *(const float4*)(Cs + row * CS + c4);
      float4 xv = *(float4*)(xs + (size_t)rr * D + n0 + c4);
      xv.x += gt[0] * v.x; xv.y += gt[1] * v.y; xv.z += gt[2] * v.z; xv.w += gt[3] * v.w;
      *(float4*)(xs + (size_t)rr * D + n0 + c4) = xv;
    }
  }
}


struct AttnArgs {
  const bf16_t *QA, *KA, *VAt, *QW, *KW, *VWt, *QG, *KG, *VGt;
  const float *g_qk_diff, *g_qk_win, *g_qk_glob, *sink, *lambda_diff, *g_mix_out;
  float lambda_init;
  int pad0;
  bf16_t* A2;
  float* Oslab;
  float* Lslab;
};

template <int TYPE>
DI void attn_item(const AttnArgs& a, int b, int g, int p0, int ctx0, int nctx, int lat0, int nkt, int half, char* smem) {
  constexpr int DQK = TYPE == 0 ? 32 : 64;
  constexpr int KS = DQK / 16;
  const int tid = TID, lane = tid & 63, wid = tid >> 6;
  const int r = lane & 31, h = lane >> 5;
  const bf16_t *Q0, *Q1, *K0, *K1, *Vt;
  const float* gqk;
  if (TYPE == 0) {
    Q0 = a.QA + ((size_t)b * 8 + 2 * g) * NT * 32; Q1 = Q0 + (size_t)NT * 32;
    K0 = a.KA + ((size_t)b * 8 + 2 * g) * NT * 32; K1 = K0 + (size_t)NT * 32;
    Vt = a.VAt + ((size_t)b * 4 + g) * 64 * NT; gqk = a.g_qk_diff;
  } else if (TYPE == 1) {
    Q0 = a.QW + ((size_t)b * 4 + 2 * g) * NT * 64; Q1 = Q0 + (size_t)NT * 64;
    K0 = a.KW + ((size_t)b * 2 + g) * NT * 64; K1 = K0;
    Vt = a.VWt + ((size_t)b * 2 + g) * 64 * NT; gqk = a.g_qk_win;
  } else {
    Q0 = a.QG + ((size_t)b * 4 + 2 * g) * NT * 64; Q1 = Q0 + (size_t)NT * 64;
    K0 = a.KG + ((size_t)b * 2 + g) * NT * 64; K1 = K0;
    Vt = a.VGt + ((size_t)b * 2 + g) * 64 * NT; gqk = a.g_qk_glob;
  }
  (void)gqk;
  const int qpos = p0 + wid * 32 + r;
  bf16x8 qf0[KS], qf1[KS];
#pragma unroll
  for (int s = 0; s < KS; ++s) {
    qf0[s] = *(const bf16x8*)(Q0 + (size_t)qpos * DQK + 16 * s + 8 * h);
    qf1[s] = *(const bf16x8*)(Q1 + (size_t)qpos * DQK + 16 * s + 8 * h);
  }
  f32x16 O00, O01, O10, O11, Zero;
#pragma unroll
  for (int i = 0; i < 16; ++i) { O00[i] = 0.f; O01[i] = 0.f; O10[i] = 0.f; O11[i] = 0.f; Zero[i] = 0.f; }
  float l0 = 0.f, l1 = 0.f;

  uint4 st0, st1, st2, st3;
  auto tile_of = [&](int it) { return it < nctx ? ctx0 + it : lat0 + it - nctx; };
  const int vrow0 = tid >> 4, vch = tid & 15;
#define ATT_GLOAD(kt_)                                                                                   \
  {                                                                                                      \
    const int kt__ = (kt_);                                                                              \
    if (TYPE == 0) {                                                                                     \
      st0 = *(const uint4*)(K0 + (size_t)kt__ * 128 * 32 + tid * 8);                                     \
      st1 = *(const uint4*)(K1 + (size_t)kt__ * 128 * 32 + tid * 8);                                     \
    } else {                                                                                             \
      st0 = *(const uint4*)(K0 + (size_t)kt__ * 128 * 64 + tid * 8);                                     \
      st1 = *(const uint4*)(K0 + (size_t)kt__ * 128 * 64 + (tid + 512) * 8);                             \
    }                                                                                                    \
    st2 = *(const uint4*)(Vt + (size_t)vrow0 * NT + kt__ * 128 + vch * 8);                               \
    st3 = *(const uint4*)(Vt + (size_t)(vrow0 + 32) * NT + kt__ * 128 + vch * 8);                        \
  }
#define ATT_SSTORE(sb_)                                                                                  \
  {                                                                                                      \
    char* sb__ = (sb_);                                                                                  \
    if (TYPE == 0) {                                                                                     \
      int row = tid >> 2, ch = tid & 3;                                                                  \
      int off = row * 64 + ((ch ^ ((row >> 2) & 3)) << 4);                                               \
      *(uint4*)(sb__ + off) = st0;                                                                       \
      *(uint4*)(sb__ + 8192 + off) = st1;                                                                \
    } else {                                                                                             \
      int row = tid >> 3, ch = tid & 7;                                                                  \
      int off = row * 128 + ((ch ^ ((row >> 1) & 7)) << 4);                                              \
      *(uint4*)(sb__ + off) = st0;                                                                       \
      *(uint4*)(sb__ + off + 8192) = st1;                                                                \
    }                                                                                                    \
    int voff = 16384 + vrow0 * 256 + ((vch ^ (vrow0 & 15)) << 4);                                        \
    *(uint4*)(sb__ + voff) = st2;                                                                        \
    *(uint4*)(sb__ + voff + 8192) = st3;                                                                 \
  }
  ATT_GLOAD(tile_of(0));
  __syncthreads();
  ATT_SSTORE(smem);
  __syncthreads();
  const int qwave = p0 + wid * 32;
#pragma unroll 1
  for (int it = 0; it < nkt; ++it) {
    const int kt = tile_of(it);
    const char* sb = smem + (it & 1) * 32768;
    if (it + 1 < nkt) ATT_GLOAD(tile_of(it + 1));
#pragma unroll 1
    for (int j = 0; j < 4; ++j) {
      const int kbase = kt * 128 + 32 * j;
      bool masked = false;
      if (TYPE == 1) {
        if (kbase >= CTX && p0 >= CTX) {
          if (kbase > qwave + 31 + 128 || kbase + 31 < qwave - 128) continue;
          masked = true;
        }
      }
      f32x16 S0 = Zero, S1 = Zero;
#pragma unroll
      for (int s = 0; s < KS; ++s) {
        if (TYPE == 0) {
          int row = 32 * j + r;
          int off = row * 64 + (((2 * s + h) ^ ((row >> 2) & 3)) << 4);
          bf16x8 k0 = *(const bf16x8*)(sb + off);
          bf16x8 k1 = *(const bf16x8*)(sb + 8192 + off);
          S0 = MFMA32(k0, qf0[s], S0);
          S1 = MFMA32(k1, qf1[s], S1);
        } else {
          int row = 32 * j + r;
          int off = row * 128 + (((2 * s + h) ^ ((row >> 1) & 7)) << 4);
          bf16x8 k0 = *(const bf16x8*)(sb + off);
          S0 = MFMA32(k0, qf0[s], S0);
          S1 = MFMA32(k0, qf1[s], S1);
        }
      }
      float pa[16], pb[16];
#pragma unroll
      for (int i = 0; i < 16; ++i) {
        float e0 = __builtin_amdgcn_exp2f(S0[i]);
        float e1 = __builtin_amdgcn_exp2f(S1[i]);
        if (TYPE == 1) {
          if (masked) {
            int kp = kbase + (i & 3) + 8 * (i >> 2) + 4 * h;
            int dd = kp - qpos;
            bool ok = (dd <= 128) && (dd >= -128);
            e0 = ok ? e0 : 0.f; e1 = ok ? e1 : 0.f;
          }
        }
        pa[i] = e0; pb[i] = e1;
      }
      l0 += ((pa[0] + pa[1]) + (pa[2] + pa[3])) + ((pa[4] + pa[5]) + (pa[6] + pa[7])) + ((pa[8] + pa[9]) + (pa[10] + pa[11])) + ((pa[12] + pa[13]) + (pa[14] + pa[15]));
      l1 += ((pb[0] + pb[1]) + (pb[2] + pb[3])) + ((pb[4] + pb[5]) + (pb[6] + pb[7])) + ((pb[8] + pb[9]) + (pb[10] + pb[11])) + ((pb[12] + pb[13]) + (pb[14] + pb[15]));
      bf16x8 pf0[2], pf1[2];
#pragma unroll
      for (int s2 = 0; s2 < 2; ++s2) {
        unsigned w0[4], w1[4];
#pragma unroll
        for (int e = 0; e < 4; ++e) {
          w0[e] = pk2bf(pa[8 * s2 + 2 * e], pa[8 * s2 + 2 * e + 1]);
          w1[e] = pk2bf(pb[8 * s2 + 2 * e], pb[8 * s2 + 2 * e + 1]);
        }
        pf0[s2] = __builtin_bit_cast(bf16x8, make_uint4(w0[0], w0[1], w0[2], w0[3]));
        pf1[s2] = __builtin_bit_cast(bf16x8, make_uint4(w1[0], w1[1], w1[2], w1[3]));
      }
#pragma unroll
      for (int s2 = 0; s2 < 2; ++s2) {
        int ch = 4 * j + 2 * s2 + h;
        bf16x8 v0 = *(const bf16x8*)(sb + 16384 + r * 256 + ((ch ^ (r & 15)) << 4));
        bf16x8 v1 = *(const bf16x8*)(sb + 16384 + (32 + r) * 256 + ((ch ^ (r & 15)) << 4));
        O00 = MFMA32(v0, pf0[s2], O00);
        O01 = MFMA32(v1, pf0[s2], O01);
        O10 = MFMA32(v0, pf1[s2], O10);
        O11 = MFMA32(v1, pf1[s2], O11);
      }
    }
    if (it + 1 < nkt) ATT_SSTORE(smem + ((it + 1) & 1) * 32768);
    __syncthreads();
  }
  l0 += shxl(l0, lane, 32);
  l1 += shxl(l1, lane, 32);
  if (TYPE == 1) {
    l0 += __builtin_amdgcn_exp2f(a.sink[2 * g] * LOG2E);
    l1 += __builtin_amdgcn_exp2f(a.sink[2 * g + 1] * LOG2E);
  }
  const size_t orow = (size_t)b * NT + qpos;
  if (TYPE == 2) {
#pragma unroll
    for (int x = 0; x < 2; ++x) {
      int head = 2 * g + x;
      float* dst = a.Oslab + ((((size_t)half * NB + b) * 4 + head) * NT + qpos) * 64;
#pragma unroll
      for (int dt = 0; dt < 2; ++dt) {
        const f32x16& O = x == 0 ? (dt == 0 ? O00 : O01) : (dt == 0 ? O10 : O11);
#pragma unroll
        for (int q4 = 0; q4 < 4; ++q4)
          *(float4*)(dst + 32 * dt + 8 * q4 + 4 * h) = make_float4(O[4 * q4], O[4 * q4 + 1], O[4 * q4 + 2], O[4 * q4 + 3]);
      }
      if (h == 0) a.Lslab[(((size_t)half * NB + b) * 4 + head) * NT + qpos] = x == 0 ? l0 : l1;
    }
  } else if (TYPE == 0) {
    float s0 = 0.f, s1 = 0.f;
    for (int d = 0; d < 32; ++d) { s0 += a.lambda_diff[d] * a.lambda_diff[32 + d]; s1 += a.lambda_diff[64 + d] * a.lambda_diff[96 + d]; }
    const float lam = __expf(s0) - __expf(s1) + a.lambda_init;
    const float i0 = 1.f / l0, i1 = lam / l1;
    float o[32];
    float ss = 0.f;
#pragma unroll
    for (int i = 0; i < 16; ++i) {
      o[i] = O00[i] * i0 - O10[i] * i1;
      o[16 + i] = O01[i] * i0 - O11[i] * i1;
      ss += o[i] * o[i] + o[16 + i] * o[16 + i];
    }
    ss += shxl(ss, lane, 32);
    const float rs = rsqrtf(ss * (1.f / 64) + EPS) * (1.f - a.lambda_init);
    const float* gm = a.g_mix_out + g * 64;
    bf16_t* dst = a.A2 + orow * D + g * 64;
#pragma unroll
    for (int dt = 0; dt < 2; ++dt)
#pragma unroll
      for (int q4 = 0; q4 < 4; ++q4) {
        int dv = 32 * dt + 8 * q4 + 4 * h;
        const float* ov = o + 16 * dt + 4 * q4;
        uint2 w;
        w.x = pk2bf(ov[0] * rs * gm[dv], ov[1] * rs * gm[dv + 1]);
        w.y = pk2bf(ov[2] * rs * gm[dv + 2], ov[3] * rs * gm[dv + 3]);
        *(uint2*)(dst + dv) = w;
      }
  } else {
#pragma unroll
    for (int x = 0; x < 2; ++x) {
      const float inv = 1.f / (x == 0 ? l0 : l1);
      float o[32];
      float ss = 0.f;
#pragma unroll
      for (int i = 0; i < 16; ++i) {
        o[i] = (x == 0 ? O00[i] : O10[i]) * inv;
        o[16 + i] = (x == 0 ? O01[i] : O11[i]) * inv;
        ss += o[i] * o[i] + o[16 + i] * o[16 + i];
      }
      ss += shxl(ss, lane, 32);
      const float rs = rsqrtf(ss * (1.f / 64) + EPS);
      const int col0 = 256 + (2 * g + x) * 64;
      const float* gm = a.g_mix_out + col0;
      bf16_t* dst = a.A2 + orow * D + col0;
#pragma unroll
      for (int dt = 0; dt < 2; ++dt)
#pragma unroll
        for (int q4 = 0; q4 < 4; ++q4) {
          int dv = 32 * dt + 8 * q4 + 4 * h;
          const float* ov = o + 16 * dt + 4 * q4;
          uint2 w;
          w.x = pk2bf(ov[0] * rs * gm[dv], ov[1] * rs * gm[dv + 1]);
          w.y = pk2bf(ov[2] * rs * gm[dv + 2], ov[3] * rs * gm[dv + 3]);
          *(uint2*)(dst + dv) = w;
        }
    }
  }
}

DI void attn_dispatch(const AttnArgs& a, int idx, int want_ctx, char* smem) {
  if (idx < 256) {
    int b = idx >> 7, g = (idx >> 5) & 3, qt = 1 + (idx & 31);
    attn_item<0>(a, b, g, qt * 256, 0, 2, 2, 66, 0, smem);
  } else if (idx < 512) {
    int i = idx - 256; int half = i >> 7, b = (i >> 6) & 1, g = (i >> 5) & 1, qt = 1 + (i & 31);
    if (half == 0) attn_item<2>(a, b, g, qt * 256, 0, 2, 2, 33, 0, smem);
    else attn_item<2>(a, b, g, qt * 256, 0, 0, 33, 33, 1, smem);
  } else if (idx < 640) {
    int i = idx - 512; int b = i >> 6, g = (i >> 5) & 1, qt = 1 + (i & 31);
    int lo = max(2, 2 * qt - 1), hi = min(65, 2 * qt + 2);
    attn_item<1>(a, b, g, qt * 256, 0, 2, lo, 2 + (hi - lo + 1), 0, smem);
  } else if (want_ctx) {
    int i = idx - 640;
    if (i < 8) attn_item<0>(a, i >> 2, i & 3, 0, 0, 2, 0, 2, 0, smem);
    else if (i < 16) { int k = i - 8; int half = k >> 2, b = (k >> 1) & 1, g = k & 1; attn_item<2>(a, b, g, 0, half, 1, 0, 1, half, smem); }
    else if (i < 20) { int k = i - 16; attn_item<1>(a, k >> 1, k & 1, 0, 0, 2, 0, 2, 0, smem); }
  }
}

typedef __attribute__((ext_vector_type(4))) float f32x4v;
DI void tabconv_row(const float* __restrict__ src, unsigned char* __restrict__ dst, float* __restrict__ scale, size_t row) {
  const int lane = TID & 63;
  const float4* sp = (const float4*)(src + row * D + lane * 16);
  float4 v0 = sp[0], v1 = sp[1], v2 = sp[2], v3 = sp[3];
  float m = fmaxf(fmaxf(fmaxf(fabsf(v0.x), fabsf(v0.y)), fmaxf(fabsf(v0.z), fabsf(v0.w))), fmaxf(fmaxf(fabsf(v1.x), fabsf(v1.y)), fmaxf(fabsf(v1.z), fabsf(v1.w))));
  m = fmaxf(m, fmaxf(fmaxf(fmaxf(fabsf(v2.x), fabsf(v2.y)), fmaxf(fabsf(v2.z), fabsf(v2.w))), fmaxf(fmaxf(fabsf(v3.x), fabsf(v3.y)), fmaxf(fabsf(v3.z), fabsf(v3.w)))));
  for (int o = 32; o > 0; o >>= 1) m = fmaxf(m, shxl(m, lane, o));
  m = fmaxf(m, 1e-30f);
  const float sc = m * (1.f / 448.f), inv = 448.f / m;
  int w0 = __builtin_amdgcn_cvt_pk_fp8_f32(v0.x * inv, v0.y * inv, 0, false); w0 = __builtin_amdgcn_cvt_pk_fp8_f32(v0.z * inv, v0.w * inv, w0, true);
  int w1 = __builtin_amdgcn_cvt_pk_fp8_f32(v1.x * inv, v1.y * inv, 0, false); w1 = __builtin_amdgcn_cvt_pk_fp8_f32(v1.z * inv, v1.w * inv, w1, true);
  int w2 = __builtin_amdgcn_cvt_pk_fp8_f32(v2.x * inv, v2.y * inv, 0, false); w2 = __builtin_amdgcn_cvt_pk_fp8_f32(v2.z * inv, v2.w * inv, w2, true);
  int w3 = __builtin_amdgcn_cvt_pk_fp8_f32(v3.x * inv, v3.y * inv, 0, false); w3 = __builtin_amdgcn_cvt_pk_fp8_f32(v3.z * inv, v3.w * inv, w3, true);
  *(uint4*)(dst + row * D + lane * 16) = make_uint4((unsigned)w0, (unsigned)w1, (unsigned)w2, (unsigned)w3);
  if (lane == 0) scale[row] = sc;
}

DI void score_tile(const bf16_t* __restrict__ qbuf, const bf16_t* __restrict__ keysb, int m0, int hp, char* smem, float* __restrict__ topv,
                   unsigned char* __restrict__ topi) {
  const int tid = TID, lane = tid & 63, wid = tid >> 6;
  const int wm = wid & 1, wn = wid >> 1;
  const int r = lane & 31, h = lane >> 5;
  f32x16 acc0, acc1;
  for (int i = 0; i < 16; ++i) { acc0[i] = 0.f; acc1[i] = 0.f; }
  const int lrow = tid >> 3, lch = tid & 7;
  const bf16_t* Ag = qbuf + (size_t)(m0 + lrow) * 2048 + hp * 128 + lch * 8;
  const bf16_t* Bg = keysb + ((size_t)hp * 128 + lrow) * 128 + lch * 8;
  const int woff = lrow * 128 + ((lch ^ ((lrow >> 1) & 7)) << 4);
  __syncthreads();
#pragma unroll
  for (int kt = 0; kt < 2; ++kt) {
    char* sn = smem + kt * 32768;
    *(uint4*)(sn + woff) = *(const uint4*)(Ag + kt * 64);
    *(uint4*)(sn + woff + 8192) = *(const uint4*)(Ag + (size_t)64 * 2048 + kt * 64);
    *(uint4*)(sn + 16384 + woff) = *(const uint4*)(Bg + kt * 64);
    *(uint4*)(sn + 16384 + woff + 8192) = *(const uint4*)(Bg + 64 * 128 + kt * 64);
  }
  __syncthreads();
  const int sw = (r >> 1) & 7;
  const int aoff0 = (wm * 64 + r) * 128, aoff1 = aoff0 + 32 * 128;
  const int boff = 16384 + (wn * 32 + r) * 128;
#pragma unroll
  for (int kt = 0; kt < 2; ++kt) {
    const char* st = smem + kt * 32768;
#pragma unroll
    for (int s = 0; s < 4; ++s) {
      int co = ((2 * s + h) ^ sw) << 4;
      bf16x8 a0 = *(const bf16x8*)(st + aoff0 + co);
      bf16x8 a1 = *(const bf16x8*)(st + aoff1 + co);
      bf16x8 b = *(const bf16x8*)(st + boff + co);
      acc0 = MFMA32(a0, b, acc0);
      acc1 = MFMA32(a1, b, acc1);
    }
  }
  __syncthreads();
  float* Cs = (float*)smem;
  constexpr int CS = 132;
#pragma unroll
  for (int i = 0; i < 16; ++i) {
    int row = (i & 3) + 8 * (i >> 2) + 4 * h;
    Cs[(wm * 64 + row) * CS + wn * 32 + r] = acc0[i];
    Cs[(wm * 64 + 32 + row) * CS + wn * 32 + r] = acc1[i];
  }
  __syncthreads();
  const int row = tid >> 2, q = tid & 3;
  float v[32];
#pragma unroll
  for (int i = 0; i < 32; ++i) v[i] = Cs[row * CS + 4 * i + q];
#pragma unroll 1
  for (int k = 0; k < 16; ++k) {
    float m = v[0]; int li = 0;
#pragma unroll
    for (int i = 1; i < 32; ++i) { bool gt = v[i] > m; m = gt ? v[i] : m; li = gt ? i : li; }
    int col = 4 * li + q;
    float m1 = shxl(m, lane, 1); int c1 = shxl(col, lane, 1);
    bool t1 = (m1 > m) || (m1 == m && c1 < col); m = t1 ? m1 : m; col = t1 ? c1 : col;
    float m2 = shxl(m, lane, 2); int c2 = shxl(col, lane, 2);
    bool t2 = (m2 > m) || (m2 == m && c2 < col); m = t2 ? m2 : m; col = t2 ? c2 : col;
    const bool own = (col & 3) == q; const int wi = col >> 2;
#pragma unroll
    for (int i = 0; i < 32; ++i) v[i] = (own && i == wi) ? -3.0e38f : v[i];
    if ((k & 3) == q) {
      size_t o = ((size_t)(m0 + row) * 16 + hp) * 16 + k;
      topv[o] = m; topi[o] = (unsigned char)col;
    }
  }
}

DI void merge_one(const float* __restrict__ topv, const unsigned char* __restrict__ topi, int r, int hd, int* __restrict__ experts,
                  float* __restrict__ gates) {
  const float* va = topv + ((size_t)r * 16 + 2 * hd) * 16;
  const float* vb = va + 16;
  const unsigned char* ia = topi + ((size_t)r * 16 + 2 * hd) * 16;
  const unsigned char* ib = ia + 16;
  float a[16], bq[16];
#pragma unroll
  for (int i = 0; i < 4; ++i) {
    float4 x = ((const float4*)va)[i], y = ((const float4*)vb)[i];
    a[4 * i] = x.x; a[4 * i + 1] = x.y; a[4 * i + 2] = x.z; a[4 * i + 3] = x.w;
    bq[4 * i] = y.x; bq[4 * i + 1] = y.y; bq[4 * i + 2] = y.z; bq[4 * i + 3] = y.w;
  }
  float cv[50];
  {
    int n = 0;
#pragma unroll
    for (int i = 0; i < 16; ++i)
#pragma unroll
      for (int j = 0; j < 16; ++j)
        if ((i + 1) * (j + 1) <= 16) { cv[n] = a[i] + bq[j]; ++n; }
  }
  int* eo = experts + (size_t)r * 128 + hd * 16;
  float* go = gates + (size_t)r * 128 + hd * 16;
  float mx = 0.f, sum = 0.f;
#pragma unroll 1
  for (int k = 0; k < 16; ++k) {
    float mval = cv[0]; int code = 0;
    {
      int n = 0;
#pragma unroll
      for (int i = 0; i < 16; ++i)
#pragma unroll
        for (int j = 0; j < 16; ++j)
          if ((i + 1) * (j + 1) <= 16) {
            if (n > 0) { bool gt = cv[n] > mval; mval = gt ? cv[n] : mval; code = gt ? (i * 16 + j) : code; }
            ++n;
          }
    }
    {
      int n = 0;
#pragma unroll
      for (int i = 0; i < 16; ++i)
#pragma unroll
        for (int j = 0; j < 16; ++j)
          if ((i + 1) * (j + 1) <= 16) { cv[n] = (code == i * 16 + j) ? -3.0e38f : cv[n]; ++n; }
    }
    if (k == 0) mx = mval;
    const float e = __expf(mval - mx);
    sum += e;
    eo[k] = (int)ia[code >> 4] * 128 + (int)ib[code & 15];
    go[k] = e;
  }
  const float inv = 1.f / sum;
#pragma unroll
  for (int i = 0; i < 4; ++i) {
    float4 g4 = ((float4*)go)[i];
    g4.x *= inv; g4.y *= inv; g4.z *= inv; g4.w *= inv;
    ((float4*)go)[i] = g4;
  }
}

DI void peer_token(int r, const bf16_t* __restrict__ hbuf, const int* __restrict__ experts, const float* __restrict__ gates,
                   const unsigned char* __restrict__ u8, const float* __restrict__ us, const unsigned char* __restrict__ v8,
                   const float* __restrict__ vs, const float* __restrict__ modv_l, float* __restrict__ xs, float* wdots  ,
                   float* __restrict__ outp = nullptr) {
  const int lane = TID & 63;
  float x[16];
  {
    const uint4* hr = (const uint4*)(hbuf + (size_t)r * D + lane * 16);
    uint4 a = hr[0], c = hr[1];
    x[0] = bflo(a.x); x[1] = bfhi(a.x); x[2] = bflo(a.y); x[3] = bfhi(a.y); x[4] = bflo(a.z); x[5] = bfhi(a.z); x[6] = bflo(a.w); x[7] = bfhi(a.w);
    x[8] = bflo(c.x); x[9] = bfhi(c.x); x[10] = bflo(c.y); x[11] = bfhi(c.y); x[12] = bflo(c.z); x[13] = bfhi(c.z); x[14] = bflo(c.w); x[15] = bfhi(c.w);
  }
  const int e0 = experts[(size_t)r * 128 + lane], e1 = experts[(size_t)r * 128 + 64 + lane];
  const float g0 = gates[(size_t)r * 128 + lane], g1 = gates[(size_t)r * 128 + 64 + lane];
  const float us0 = us[e0], us1 = us[e1], vs0 = vs[e0], vs1 = vs[e1];
#pragma unroll 1
  for (int k0 = 0; k0 < 128; k0 += 8) {
    uint4 rw[8];
#pragma unroll
    for (int j = 0; j < 8; ++j) {
      int k = k0 + j;
      int e = __builtin_amdgcn_readlane(k0 < 64 ? e0 : e1, k & 63);
      rw[j] = *(const uint4*)(u8 + (size_t)e * D + lane * 16);
    }
    float p[8];
#pragma unroll
    for (int j = 0; j < 8; ++j) {
      f32x2_t a0 = __builtin_amdgcn_cvt_pk_f32_fp8((int)rw[j].x, false), a1 = __builtin_amdgcn_cvt_pk_f32_fp8((int)rw[j].x, true);
      f32x2_t b0 = __builtin_amdgcn_cvt_pk_f32_fp8((int)rw[j].y, false), b1 = __builtin_amdgcn_cvt_pk_f32_fp8((int)rw[j].y, true);
      f32x2_t c0 = __builtin_amdgcn_cvt_pk_f32_fp8((int)rw[j].z, false), c1 = __builtin_amdgcn_cvt_pk_f32_fp8((int)rw[j].z, true);
      f32x2_t d0 = __builtin_amdgcn_cvt_pk_f32_fp8((int)rw[j].w, false), d1 = __builtin_amdgcn_cvt_pk_f32_fp8((int)rw[j].w, true);
      float s = a0[0] * x[0] + a0[1] * x[1] + a1[0] * x[2] + a1[1] * x[3];
      s += b0[0] * x[4] + b0[1] * x[5] + b1[0] * x[6] + b1[1] * x[7];
      s += c0[0] * x[8] + c0[1] * x[9] + c1[0] * x[10] + c1[1] * x[11];
      s += d0[0] * x[12] + d0[1] * x[13] + d1[0] * x[14] + d1[1] * x[15];
      p[j] = s;
    }
    const bool hi32 = lane & 32, hi16 = lane & 16, hi8 = lane & 8;
    float q4[4];
#pragma unroll
    for (int i = 0; i < 4; ++i) { float send = hi32 ? p[i] : p[4 + i]; float keep = hi32 ? p[4 + i] : p[i]; q4[i] = keep + shxl(send, lane, 32); }
    float q2[2];
#pragma unroll
    for (int i = 0; i < 2; ++i) { float send = hi16 ? q4[i] : q4[2 + i]; float keep = hi16 ? q4[2 + i] : q4[i]; q2[i] = keep + shxl(send, lane, 16); }
    float q1;
    { float send = hi8 ? q2[0] : q2[1]; float keep = hi8 ? q2[1] : q2[0]; q1 = keep + shxl(send, lane, 8); }
    q1 += shxl(q1, lane, 4); q1 += shxl(q1, lane, 2); q1 += shxl(q1, lane, 1);
    if ((lane & 7) == 0) wdots[k0 + (lane >> 3)] = q1;
  }
  float w0, w1;
  {
    float d0 = wdots[lane] * us0, d1 = wdots[64 + lane] * us1;
    float t0 = 0.5f * d0 * (1.f + tanhf(0.7978845608028654f * (d0 + 0.044715f * d0 * d0 * d0)));
    float t1 = 0.5f * d1 * (1.f + tanhf(0.7978845608028654f * (d1 + 0.044715f * d1 * d1 * d1)));
    w0 = g0 * t0 * vs0; w1 = g1 * t1 * vs1;
  }
  float acc[16];
#pragma unroll
  for (int i = 0; i < 16; ++i) acc[i] = 0.f;
#pragma unroll 1
  for (int k0 = 0; k0 < 128; k0 += 8) {
    uint4 rw[8];
#pragma unroll
    for (int j = 0; j < 8; ++j) {
      int k = k0 + j;
      int e = __builtin_amdgcn_readlane(k0 < 64 ? e0 : e1, k & 63);
      rw[j] = *(const uint4*)(v8 + (size_t)e * D + lane * 16);
    }
#pragma unroll
    for (int j = 0; j < 8; ++j) {
      int k = k0 + j;
      float w = __builtin_bit_cast(float, __builtin_amdgcn_readlane(__builtin_bit_cast(int, k0 < 64 ? w0 : w1), k & 63));
      f32x2_t a0 = __builtin_amdgcn_cvt_pk_f32_fp8((int)rw[j].x, false), a1 = __builtin_amdgcn_cvt_pk_f32_fp8((int)rw[j].x, true);
      f32x2_t b0 = __builtin_amdgcn_cvt_pk_f32_fp8((int)rw[j].y, false), b1 = __builtin_amdgcn_cvt_pk_f32_fp8((int)rw[j].y, true);
      f32x2_t c0 = __builtin_amdgcn_cvt_pk_f32_fp8((int)rw[j].z, false), c1 = __builtin_amdgcn_cvt_pk_f32_fp8((int)rw[j].z, true);
      f32x2_t d0 = __builtin_amdgcn_cvt_pk_f32_fp8((int)rw[j].w, false), d1 = __builtin_amdgcn_cvt_pk_f32_fp8((int)rw[j].w, true);
      acc[0] += w * a0[0]; acc[1] += w * a0[1]; acc[2] += w * a1[0]; acc[3] += w * a1[1];
      acc[4] += w * b0[0]; acc[5] += w * b0[1]; acc[6] += w * b1[0]; acc[7] += w * b1[1];
      acc[8] += w * c0[0]; acc[9] += w * c0[1]; acc[10] += w * c1[0]; acc[11] += w * c1[1];
      acc[12] += w * d0[0]; acc[13] += w * d0[1]; acc[14] += w * d1[0]; acc[15] += w * d1[1];
    }
  }
  const int b = r / NT, p = r % NT; const int mrow = p < CTX ? 2 : b;
  const float* g2 = modv_l + mrow * NMOD + 5 * D + lane * 16;
  float4* xp = (float4*)(xs + (size_t)r * D + lane * 16);
  float4* op = outp ? (float4*)(outp + ((size_t)b * SEQ + (p - CTX)) * D + lane * 16) : xp;
#pragma unroll
  for (int i = 0; i < 4; ++i) {
    float4 xv = xp[i]; float4 gg = ((const float4*)g2)[i];
    xv.x += gg.x * acc[4 * i]; xv.y += gg.y * acc[4 * i + 1]; xv.z += gg.z * acc[4 * i + 2]; xv.w += gg.w * acc[4 * i + 3];
    op[i] = xv;
  }
}

constexpr int FN = 2 * SEQ;
DI float2 cmul(float2 a, float2 b) { return make_float2(a.x * b.x - a.y * b.y, a.x * b.y + a.y * b.x); }
DI float2 cmulc(float2 a, float2 b) { return make_float2(a.x * b.x + a.y * b.y, a.y * b.x - a.x * b.y); }
DI int rev4_7(int x) {
  return ((x & 3) << 12) | ((x >> 12) & 3) | ((x & 0xC) << 8) | ((x >> 8) & 0xC) | ((x & 0x30) << 4) | ((x >> 4) & 0x30) | (x & 0xC0);
}
DI void fft_fwd(float2* X) {
  const int tid = TID;
#pragma unroll 1
  for (int p = 0; p < 7; ++p) {
    const int lq = 12 - 2 * p; const int q = 1 << lq;
    const float invL = 1.f / (float)(4 << lq);
    __syncthreads();
#pragma unroll 2
    for (int m = 0; m < 8; ++m) {
      const int i = tid + 512 * m;
      const int j = i & (q - 1); const int base = ((i >> lq) << (lq + 2)) + j;
      float2 a = X[base], b = X[base + q], c = X[base + 2 * q], d = X[base + 3 * q];
      float2 t0 = make_float2(a.x + c.x, a.y + c.y), t1 = make_float2(a.x - c.x, a.y - c.y);
      float2 t2 = make_float2(b.x + d.x, b.y + d.y), t3 = make_float2(b.y - d.y, d.x - b.x);
      float2 y0 = make_float2(t0.x + t2.x, t0.y + t2.y), y1 = make_float2(t1.x + t3.x, t1.y + t3.y);
      float2 y2 = make_float2(t0.x - t2.x, t0.y - t2.y), y3 = make_float2(t1.x - t3.x, t1.y - t3.y);
      const float fr = (float)j * invL;
      float2 w1 = make_float2(__builtin_amdgcn_cosf(fr), -__builtin_amdgcn_sinf(fr));
      float2 w2 = cmul(w1, w1), w3 = cmul(w2, w1);
      X[base] = y0; X[base + q] = cmul(y1, w1); X[base + 2 * q] = cmul(y2, w2); X[base + 3 * q] = cmul(y3, w3);
    }
  }
  __syncthreads();
}
DI void fft_inv(float2* X) {
  const int tid = TID;
#pragma unroll 1
  for (int p = 6; p >= 0; --p) {
    const int lq = 12 - 2 * p; const int q = 1 << lq;
    const float invL = 1.f / (float)(4 << lq);
    __syncthreads();
#pragma unroll 2
    for (int m = 0; m < 8; ++m) {
      const int i = tid + 512 * m;
      const int j = i & (q - 1); const int base = ((i >> lq) << (lq + 2)) + j;
      const float fr = (float)j * invL;
      float2 w1 = make_float2(__builtin_amdgcn_cosf(fr), -__builtin_amdgcn_sinf(fr));
      float2 w2 = cmul(w1, w1), w3 = cmul(w2, w1);
      float2 y0 = X[base], y1 = cmulc(X[base + q], w1), y2 = cmulc(X[base + 2 * q], w2), y3 = cmulc(X[base + 3 * q], w3);
      float2 t0 = make_float2(y0.x + y2.x, y0.y + y2.y), t1 = make_float2(y0.x - y2.x, y0.y - y2.y);
      float2 t2 = make_float2(y1.x + y3.x, y1.y + y3.y), t3 = make_float2(y3.y - y1.y, y1.x - y3.x);
      X[base] = make_float2(t0.x + t2.x, t0.y + t2.y);
      X[base + q] = make_float2(t1.x + t3.x, t1.y + t3.y);
      X[base + 2 * q] = make_float2(t0.x - t2.x, t0.y - t2.y);
      X[base + 3 * q] = make_float2(t1.x - t3.x, t1.y - t3.y);
    }
  }
  __syncthreads();
}
DI float block_sum_512(float v, float* red) {
  for (int o = 32; o > 0; o >>= 1) v += shx(v, o);
  __syncthreads();
  if ((TID & 63) == 0) red[TID >> 6] = v;
  __syncthreads();
  float s = 0.f;
  for (int i = 0; i < 8; ++i) s += red[i];
  return s;
}
DI void hyena_channel(int c, const float* __restrict__ hdn2, const float* __restrict__ w3, const float* __restrict__ b3,
                      const float* __restrict__ hy_bias, const float* __restrict__ uT, float* __restrict__ zT, float* __restrict__ yT,
                      float2* __restrict__ Hc_all, char* smem) {
  float2* X = (float2*)smem;
  float* red = (float*)(smem + 131072);
  float* wcol = red + 16;
  float2* Hc = Hc_all + (size_t)c * FN;
  const int tid = TID;
  __syncthreads();
  if (tid < 256) {
    int od = tid >> 6, i = tid & 63;
    wcol[od * 64 + i] = w3[i * 1024 + (od >> 1) * 512 + (od & 1) * 256 + c];
  }
  __syncthreads();
  const float delta = fabsf(-3.0701134573253944f + (float)c * ((-15.350567286626972f + 3.0701134573253944f) / 255.f));
  const float bb00 = b3[c], bb01 = b3[256 + c], bb10 = b3[512 + c], bb11 = b3[768 + c];
  float n0 = 0.f, n1 = 0.f;
#pragma unroll 1
  for (int j = tid; j < SEQ; j += 512) {
    asm volatile("" ::: "memory");
    const float4* hr = (const float4*)(hdn2 + (size_t)j * 64);
    float f00 = bb00, f01 = bb01, f10 = bb10, f11 = bb11;
#pragma unroll 4
    for (int i = 0; i < 16; ++i) {
      float4 hv = hr[i];
      const float* w0 = wcol + 4 * i;
      f00 += hv.x * w0[0] + hv.y * w0[1] + hv.z * w0[2] + hv.w * w0[3];
      f01 += hv.x * w0[64] + hv.y * w0[65] + hv.z * w0[66] + hv.w * w0[67];
      f10 += hv.x * w0[128] + hv.y * w0[129] + hv.z * w0[130] + hv.w * w0[131];
      f11 += hv.x * w0[192] + hv.y * w0[193] + hv.z * w0[194] + hv.w * w0[195];
    }
    const float dec = __expf(-((float)j / (float)(SEQ - 1)) * delta);
    f00 *= dec; f01 *= dec; f10 *= dec; f11 *= dec;
    X[j] = make_float2(f00, f10);
    n0 += fabsf(f00); n1 += fabsf(f10);
    if (j > 0) { X[FN - j] = make_float2(f01, f11); n0 += fabsf(f01); n1 += fabsf(f11); }
    else X[SEQ] = make_float2(0.f, 0.f);
  }
  n0 = block_sum_512(n0, red);
  n1 = block_sum_512(n1, red);
  const float s0 = 1.f / (n0 * (float)FN), s1 = 1.f / (n1 * (float)FN);
  fft_fwd(X);
  for (int i = tid; i < FN; i += 512) Hc[i] = X[i];
  const float* v0p = uT + ((size_t)0 * 768 + c) * NT + CTX;
  const float* v1p = uT + ((size_t)1 * 768 + c) * NT + CTX;
  __syncthreads();
  for (int t = tid; t < SEQ; t += 512) { X[t] = make_float2(v0p[t], v1p[t]); X[SEQ + t] = make_float2(0.f, 0.f); }
  fft_fwd(X);
  for (int pos = tid; pos < FN; pos += 512) {
    int f = rev4_7(pos); int pm = rev4_7((FN - f) & (FN - 1));
    float2 A = Hc[pos], Bm = Hc[pm];
    float2 K0 = make_float2((A.x + Bm.x) * 0.5f * s0, (A.y - Bm.y) * 0.5f * s0);
    X[pos] = cmul(X[pos], K0);
  }
  fft_inv(X);
  {
    const float bias0 = hy_bias[c];
    const float* x10 = v0p + (size_t)256 * NT; const float* x11 = v1p + (size_t)256 * NT;
    float* z0 = zT + ((size_t)0 * 256 + c) * NT + CTX; float* z1 = zT + ((size_t)1 * 256 + c) * NT + CTX;
    for (int t = tid; t < SEQ; t += 512) {
      float2 y = X[t];
      float za = x10[t] * (y.x + bias0 * v0p[t]);
      float zb = x11[t] * (y.y + bias0 * v1p[t]);
      z0[t] = za; z1[t] = zb;
      X[t] = make_float2(za, zb);
    }
    __syncthreads();
    for (int t = tid; t < SEQ; t += 512) X[SEQ + t] = make_float2(0.f, 0.f);
  }
  fft_fwd(X);
  for (int pos = tid; pos < FN; pos += 512) {
    int f = rev4_7(pos); int pm = rev4_7((FN - f) & (FN - 1));
    float2 A = Hc[pos], Bm = Hc[pm];
    float2 K1 = make_float2((A.y + Bm.y) * 0.5f * s1, -(A.x - Bm.x) * 0.5f * s1);
    X[pos] = cmul(X[pos], K1);
  }
  fft_inv(X);
  {
    const float bias1 = hy_bias[256 + c];
    const float* x20 = v0p + (size_t)512 * NT; const float* x21 = v1p + (size_t)512 * NT;
    const float* z0 = zT + ((size_t)0 * 256 + c) * NT + CTX; const float* z1 = zT + ((size_t)1 * 256 + c) * NT + CTX;
    float* y0 = yT + ((size_t)0 * 256 + c) * NT + CTX; float* y1 = yT + ((size_t)1 * 256 + c) * NT + CTX;
    for (int t = tid; t < SEQ; t += 512) {
      float2 y = X[t];
      y0[t] = x20[t] * (y.x + bias1 * z0[t]);
      y1[t] = x21[t] * (y.y + bias1 * z1[t]);
    }
  }
}

constexpr size_t al256(size_t x) { return (x + 255) & ~(size_t)255; }
constexpr size_t OFF_modv = 0;
constexpr size_t OFF_xs = al256(OFF_modv + (size_t)2 * 3 * NMOD * 4);
constexpr size_t OFF_hbuf = al256(OFF_xs + (size_t)R * D * 4);
constexpr size_t OFF_P = al256(OFF_hbuf + (size_t)R * D * 2);
constexpr size_t OFF_Wt_in = al256(OFF_P + (size_t)R * DIN * 2);
constexpr size_t OFF_Wt_out = al256(OFF_Wt_in + (size_t)2 * DIN * D * 2);
constexpr size_t OFF_Wt_q = al256(OFF_Wt_out + (size_t)2 * D * D * 2);
constexpr size_t OFF_QA = al256(OFF_Wt_q + (size_t)2 * 2048 * D * 2);
constexpr size_t OFF_KA = al256(OFF_QA + (size_t)NB * 8 * NT * 32 * 2);
constexpr size_t OFF_VAt = al256(OFF_KA + (size_t)NB * 8 * NT * 32 * 2);
constexpr size_t OFF_QW = al256(OFF_VAt + (size_t)NB * 4 * 64 * NT * 2);
constexpr size_t OFF_KW = al256(OFF_QW + (size_t)NB * 4 * NT * 64 * 2);
constexpr size_t OFF_VWt = al256(OFF_KW + (size_t)NB * 2 * NT * 64 * 2);
constexpr size_t OFF_QG = al256(OFF_VWt + (size_t)NB * 2 * 64 * NT * 2);
constexpr size_t OFF_KG = al256(OFF_QG + (size_t)NB * 4 * NT * 64 * 2);
constexpr size_t OFF_VGt = al256(OFF_KG + (size_t)NB * 2 * NT * 64 * 2);
constexpr size_t OFF_uT = al256(OFF_VGt + (size_t)NB * 2 * 64 * NT * 2);
constexpr size_t OFF_zT = al256(OFF_uT + (size_t)NB * 768 * NT * 4);
constexpr size_t OFF_yT = al256(OFF_zT + (size_t)NB * 256 * NT * 4);
constexpr size_t OFF_hdn2 = al256(OFF_yT + (size_t)NB * 256 * NT * 4);
constexpr size_t OFF_Hc = al256(OFF_hdn2 + (size_t)2 * NT * 64 * 4);
constexpr size_t OFF_A2 = al256(OFF_Hc + (size_t)256 * 2 * SEQ * 8);
constexpr size_t OFF_u8 = al256(OFF_A2 + (size_t)R * D * 2);
constexpr size_t OFF_v8 = al256(OFF_u8 + (size_t)2 * 16384 * D);
constexpr size_t OFF_us = al256(OFF_v8 + (size_t)2 * 16384 * D);
constexpr size_t OFF_vs = al256(OFF_us + (size_t)2 * 16384 * 4);
constexpr size_t OFF_keysb = al256(OFF_vs + (size_t)2 * 16384 * 4);
constexpr size_t WS_TOTAL = al256(OFF_keysb + (size_t)2 * 16 * 128 * 128 * 2);
constexpr size_t OFF_topv = OFF_uT;
constexpr size_t OFF_topi = OFF_topv + (size_t)R * 256 * 4;
constexpr size_t OFF_experts = OFF_topi + (size_t)R * 256;
constexpr size_t OFF_gates = OFF_experts + (size_t)R * 128 * 4;
constexpr size_t OFF_Oslab = OFF_P;
constexpr size_t OFF_Lslab = OFF_Oslab + (size_t)2 * NB * 4 * NT * 64 * 4;
static_assert(OFF_gates + (size_t)R * 128 * 4 <= OFF_zT, "routing buffers overflow uT");
static_assert(OFF_Lslab + (size_t)2 * NB * 4 * NT * 4 <= OFF_Wt_in, "slabs overflow P");

struct MKView;
struct MK {
  const float *x, *c, *ctx, *c_ctx, *w_mod, *b_mod, *g_norm_mix, *w_in, *g_qk_diff, *lambda_diff, *g_qk_win, *sink_win, *g_qk_glob, *hy_conv_w,
      *hy_conv_b, *hy_w1, *hy_b1, *hy_w2, *hy_b2, *hy_w3, *hy_b3, *hy_freq, *hy_bias, *g_mix_out, *w_out, *g_norm_ffn, *peer_wq, *peer_keys,
      *peer_u, *peer_v;
  float* out;
  char* ws;
};
constexpr int SMEM_BYTES = 131072 + 2048;
typedef const MK __attribute__((address_space(4))) * MKP;
DI MK launder_mk(MKP a) {
  asm volatile("" : "+s"(a));
  MK r;
  r.x = a->x; r.c = a->c; r.ctx = a->ctx; r.c_ctx = a->c_ctx; r.w_mod = a->w_mod; r.b_mod = a->b_mod;
  r.g_norm_mix = a->g_norm_mix; r.w_in = a->w_in; r.g_qk_diff = a->g_qk_diff; r.lambda_diff = a->lambda_diff;
  r.g_qk_win = a->g_qk_win; r.sink_win = a->sink_win; r.g_qk_glob = a->g_qk_glob; r.hy_conv_w = a->hy_conv_w;
  r.hy_conv_b = a->hy_conv_b; r.hy_w1 = a->hy_w1; r.hy_b1 = a->hy_b1; r.hy_w2 = a->hy_w2; r.hy_b2 = a->hy_b2;
  r.hy_w3 = a->hy_w3; r.hy_b3 = a->hy_b3; r.hy_freq = a->hy_freq; r.hy_bias = a->hy_bias; r.g_mix_out = a->g_mix_out;
  r.w_out = a->w_out; r.g_norm_ffn = a->g_norm_ffn; r.peer_wq = a->peer_wq; r.peer_keys = a->peer_keys;
  r.peer_u = a->peer_u; r.peer_v = a->peer_v; r.out = a->out; r.ws = a->ws;
  return r;
}

DI void ph_mod_item(const MK& m, int item, char* smem) {
  float* sc = (float*)smem;
  float* part = sc + 3 * D;
  const int tid = TID;
  const int l = item / 24, chunk = item % 24;
  __syncthreads();
  for (int i = tid; i < 3 * D; i += NTHR) {
    int row = i / D, k = i % D;
    float v = row < 2 ? m.c[row * D + k] : m.c_ctx[k];
    sc[i] = v / (1.f + __expf(-v));
  }
  __syncthreads();
  const int cl = tid & 255, kh = tid >> 8;
  const int col = chunk * 256 + cl;
  const float* w = m.w_mod + (size_t)l * D * NMOD + (size_t)(kh * 512) * NMOD + col;
  float a0 = 0, a1 = 0, a2 = 0;
  for (int k = 0; k < 512; ++k) {
    float wv = w[(size_t)k * NMOD];
    a0 += sc[kh * 512 + k] * wv; a1 += sc[D + kh * 512 + k] * wv; a2 += sc[2 * D + kh * 512 + k] * wv;
  }
  if (kh == 1) { part[cl] = a0; part[256 + cl] = a1; part[512 + cl] = a2; }
  __syncthreads();
  if (kh == 0) {
    float bb = m.b_mod[l * NMOD + col];
    ((float*)(m.ws + OFF_modv))[(l * 3 + 0) * NMOD + col] = a0 + part[cl] + bb;
    ((float*)(m.ws + OFF_modv))[(l * 3 + 1) * NMOD + col] = a1 + part[256 + cl] + bb;
    ((float*)(m.ws + OFF_modv))[(l * 3 + 2) * NMOD + col] = a2 + part[512 + cl] + bb;
  }
}
DI void ph_hymlp_group(const MK& m, int g, char* smem) {
  const int tid = TID, wv = tid >> 6, u = tid & 63;
  float* feat = (float*)smem + wv * 128;
  float* h1 = feat + 64;
  const int gi = g * 8 + wv;
  const int l = gi / NT, pos = gi % NT;
  const int which = pos >= SEQ ? 1 : 0;
  const int j = which ? pos - SEQ : pos;
  const int n = which ? CTX : SEQ;
  const float tt = (float)j / (float)(n - 1);
  const float w = (6.283185307179586f / (float)n) * (float)j;
  __syncthreads();
  if (u == 0) feat[0] = tt;
  if (u < 16) {
    float f = 1e-4f + (float)u * ((15.f - 1e-4f) / 15.f);
    feat[1 + u] = cosf(f * w);
    feat[17 + u] = -sinf(f * w);
  }
  __syncthreads();
  const float* w1 = m.hy_w1 + l * 33 * 64; const float* w2 = m.hy_w2 + l * 64 * 64;
  const float fq = m.hy_freq[l * 64 + u];
  float a = m.hy_b1[l * 64 + u];
  for (int i = 0; i < 33; ++i) a += feat[i] * w1[i * 64 + u];
  h1[u] = sinf(fq * a);
  __syncthreads();
  float a2 = m.hy_b2[l * 64 + u];
  for (int i = 0; i < 64; ++i) a2 += h1[i] * w2[i * 64 + u];
  ((float*)(m.ws + OFF_hdn2))[((size_t)l * NT + pos) * 64 + u] = sinf(fq * a2);
}
DI void phase0(MKP m_in, char* smem) {
  const MK m = launder_mk(m_in);
  const int bid = BID, nb = NBLK, tid = TID;
  {
    const int gw = bid * 8 + (tid >> 6), nw = nb * 8;
    for (int row = gw; row < 4 * 16384; row += nw) {
      int tbl = row >> 14, rr = row & 16383;
      int l = tbl >> 1;
      if (tbl & 1) tabconv_row(m.peer_v + (size_t)l * 16384 * D, ((unsigned char*)(m.ws + OFF_v8)) + (size_t)l * 16384 * D, ((float*)(m.ws + OFF_vs)) + l * 16384, (size_t)rr);
      else tabconv_row(m.peer_u + (size_t)l * 16384 * D, ((unsigned char*)(m.ws + OFF_u8)) + (size_t)l * 16384 * D, ((float*)(m.ws + OFF_us)) + l * 16384, (size_t)rr);
    }
  }
  for (int it = bid; it < 48; it += nb) ph_mod_item(m, it, smem);
  for (int g = bid; g < 2 * NT / 8; g += nb) ph_hymlp_group(m, g, smem);
  for (int t = bid; t < 2 * 1408; t += nb) {
    int l = t / 1408, tt = t % 1408;
    if (tt < 640) wconv_tile(m.w_in + (size_t)l * D * DIN, ((bf16_t*)(m.ws + OFF_Wt_in)) + (size_t)l * DIN * D, DIN, tt, (float*)smem);
    else if (tt < 896) wconv_tile(m.w_out + (size_t)l * D * D, ((bf16_t*)(m.ws + OFF_Wt_out)) + (size_t)l * D * D, D, tt - 640, (float*)smem);
    else wconv_tile(m.peer_wq + (size_t)l * D * 2048, ((bf16_t*)(m.ws + OFF_Wt_q)) + (size_t)l * 2048 * D, 2048, tt - 896, (float*)smem);
  }
  for (int i = bid * NTHR + tid; i < 2 * 16 * 128 * 128 / 4; i += nb * NTHR) {
    float4 v = ((const float4*)m.peer_keys)[i];
    ((uint2*)((bf16_t*)(m.ws + OFF_keysb)))[i] = make_uint2(pk2bf(v.x, v.y), pk2bf(v.z, v.w));
  }
}

DI void phase_norm(MKP m_in, int l, int which  , bool first, bool skip_ctx) {
  const MK m = launder_mk(m_in);
  const int tid = TID, lane = tid & 63;
  const int gw = BID * 8 + (tid >> 6), nw = NBLK * 8;
  const float* g = (which ? m.g_norm_ffn : m.g_norm_mix) + l * D;
  const float* modv_l = ((float*)(m.ws + OFF_modv)) + (size_t)l * 3 * NMOD;
  for (int r = gw; r < R; r += nw) {
    const int b = r / NT, p = r % NT;
    if (skip_ctx && p < CTX) continue;
    const int mrow = p < CTX ? 2 : b;
    const float4* src = (const float4*)(first ? (p < CTX ? m.ctx + ((size_t)b * CTX + p) * D : m.x + ((size_t)b * SEQ + (p - CTX)) * D)
                                              : ((float*)(m.ws + OFF_xs)) + (size_t)r * D);
    float4 v[4];
    float ss = 0.f;
#pragma unroll
    for (int i = 0; i < 4; ++i) { v[i] = src[lane + 64 * i]; ss += v[i].x * v[i].x + v[i].y * v[i].y + v[i].z * v[i].z + v[i].w * v[i].w; }
    for (int o = 32; o > 0; o >>= 1) ss += shxl(ss, lane, o);
    const float rs = rsqrtf(ss * (1.f / D) + EPS);
    const float* sh = modv_l + mrow * NMOD + (which ? 3 : 0) * D;
    const float* sc = sh + D;
#pragma unroll
    for (int i = 0; i < 4; ++i) {
      const int c0 = (lane + 64 * i) * 4;
      float4 gg = *(const float4*)(g + c0), s4 = *(const float4*)(sc + c0), h4 = *(const float4*)(sh + c0);
      float o0 = v[i].x * rs * gg.x * (1.f + s4.x) + h4.x, o1 = v[i].y * rs * gg.y * (1.f + s4.y) + h4.y;
      float o2 = v[i].z * rs * gg.z * (1.f + s4.z) + h4.z, o3 = v[i].w * rs * gg.w * (1.f + s4.w) + h4.w;
      *(uint2*)(((bf16_t*)(m.ws + OFF_hbuf)) + (size_t)r * D + c0) = make_uint2(pk2bf(o0, o1), pk2bf(o2, o3));
      if (first) ((float4*)(((float*)(m.ws + OFF_xs)) + (size_t)r * D))[lane + 64 * i] = v[i];
    }
  }
}

DI int rowtile_of(int i, bool latent_only) { return latent_only ? (i / 64) * 66 + 2 + (i % 64) : i; }
template <int EPI>
DI void phase_gemm(const bf16_t* A, const bf16_t* Wt, int N, bf16_t* Cb, float* xs, const float* gate_base, bool latent_only, char* smem) {
  const int nt_n = N / 128, nrt = latent_only ? 128 : 132, ntiles = nrt * nt_n;
  for (int t = BID; t < ntiles; t += NBLK) {
    int tm = rowtile_of(t / nt_n, latent_only), tn = t % nt_n;
    gemm_tile<EPI>(A, Wt, N, tm * 128, tn * 128, smem, Cb, xs, gate_base);
  }
}

DI void rope_pair8(float (&y)[8], const float (&part)[8], bool upper, const float* cs, const float* sn, int dd0) {
#pragma unroll
  for (int e = 0; e < 8; ++e) {
    float c = cs[dd0 + e], s = sn[dd0 + e];
    float x1 = upper ? part[e] : y[e], x2 = upper ? y[e] : part[e];
    y[e] = upper ? (x1 * s + x2 * c) : (x1 * c - x2 * s);
  }
}
DI void unpack8(uint4 w, float (&v)[8]) {
  v[0] = bflo(w.x); v[1] = bfhi(w.x); v[2] = bflo(w.y); v[3] = bfhi(w.y); v[4] = bflo(w.z); v[5] = bfhi(w.z); v[6] = bflo(w.w); v[7] = bfhi(w.w);
}
DI uint4 pack8(const float (&v)[8], float sc) {
  return make_uint4(pk2bf(v[0] * sc, v[1] * sc), pk2bf(v[2] * sc, v[3] * sc), pk2bf(v[4] * sc, v[5] * sc), pk2bf(v[6] * sc, v[7] * sc));
}
constexpr int VS_STRIDE = 1032;
constexpr int HS_STRIDE = 1536;
DI void prep_tile(MKP m_in, int l, int tile, char* smem) {
  const MK m = launder_mk(m_in);
  const int tid = TID, lane = tid & 63, wid = tid >> 6;
  const int r0 = tile * 32; const int b = r0 / NT, p0 = r0 % NT;
  const bool lat = p0 >= CTX;
  char* Vs = smem;
  char* Hs = smem + 33280;
  float* csh = (float*)(smem + 33280 + 52224);
  const bf16_t* Pb = ((bf16_t*)(m.ws + OFF_P)) + (size_t)(b * NT) * DIN;
  __syncthreads();
  if (lat) {
    for (int i = tid; i < 32 * 48; i += NTHR) {
      int rr = i / 48, a = i % 48;
      int t = p0 + rr - CTX;
      float trow = (float)(t / 64), tcol = (float)(t % 64);
      float* rowp = csh + rr * 96;
      if (a < 16) {
        int j = a & 7; float f = exp2f(-(float)j * (13.287712379549449f / 8.f));
        float ang = (a < 8 ? trow : tcol) * f;
        rowp[a] = cosf(ang); rowp[16 + a] = sinf(ang);
      } else {
        int aa = a - 16; int j = aa & 15; float f = exp2f(-(float)j * (13.287712379549449f / 16.f));
        float ang = (aa < 16 ? trow : tcol) * f;
        rowp[32 + aa] = cosf(ang); rowp[64 + aa] = sinf(ang);
      }
    }
  }
  {
    const int seg_lo = lat ? CTX : 0, seg_hi = lat ? NT : CTX;
    for (int ch = tid; ch < 34 * 96; ch += NTHR) {
      int rr = ch / 96, c8 = ch % 96;
      int p = p0 - 1 + rr;
      uint4 v = make_uint4(0, 0, 0, 0);
      if (p >= seg_lo && p < seg_hi) v = *(const uint4*)(Pb + (size_t)p * DIN + 1792 + c8 * 8);
      *(uint4*)(Hs + rr * HS_STRIDE + c8 * 16) = v;
    }
  }
  __syncthreads();
  const float* gd = m.g_qk_diff + l * 64; const float* gwn = m.g_qk_win + l * 128; const float* gg = m.g_qk_glob + l * 128;
#pragma unroll 1
  for (int k = 0; k < 4; ++k) {
    const int rr = wid + 8 * k; const int p = p0 + rr;
    const bf16_t* Pr = Pb + (size_t)p * DIN;
    const float* rowp = csh + rr * 96;
    {
      float y[8], part[8];
      unpack8(*(const uint4*)(Pr + 8 * lane), y);
      float ss = 0.f;
#pragma unroll
      for (int e = 0; e < 8; ++e) ss += y[e] * y[e];
      ss += shxl(ss, lane, 1); ss += shxl(ss, lane, 2);
      const float rs = rsqrtf(ss * (1.f / 32) + EPS);
      const int unit = lane >> 2; const bool isk = unit >= 8; const int vh = unit & 7;
      const int d0 = (lane & 3) * 8;
      const float* gn = gd + (isk ? 32 : 0) + d0;
#pragma unroll
      for (int e = 0; e < 8; ++e) y[e] = y[e] * rs * gn[e];
      if (lat) {
#pragma unroll
        for (int e = 0; e < 8; ++e) part[e] = shxl(y[e], lane, 2);
        rope_pair8(y, part, (lane & 2) != 0, rowp, rowp + 16, (lane & 1) * 8);
      }
      bf16_t* dst = (isk ? ((bf16_t*)(m.ws + OFF_KA)) : ((bf16_t*)(m.ws + OFF_QA))) + (((size_t)b * 8 + vh) * NT + p) * 32 + d0;
      *(uint4*)dst = pack8(y, isk ? 1.f : 0.17677669529663687f * LOG2E);
    }
#pragma unroll
    for (int grp = 0; grp < 2; ++grp) {
      float y[8], part[8];
      const int cbase = grp == 0 ? 768 : 1280;
      uint4 w = make_uint4(0, 0, 0, 0);
      if (lane < 48) w = *(const uint4*)(Pr + cbase + 8 * lane);
      unpack8(w, y);
      float ss = 0.f;
#pragma unroll
      for (int e = 0; e < 8; ++e) ss += y[e] * y[e];
      ss += shxl(ss, lane, 1); ss += shxl(ss, lane, 2); ss += shxl(ss, lane, 4);
      const float rs = rsqrtf(ss * (1.f / 64) + EPS);
      const int unit = lane >> 3; const bool isk = unit >= 4; const int hh = isk ? unit - 4 : unit;
      const int d0 = (lane & 7) * 8;
      const float* gn = (grp == 0 ? gwn : gg) + (isk ? 64 : 0) + d0;
      if (lane < 48) {
#pragma unroll
        for (int e = 0; e < 8; ++e) y[e] = y[e] * rs * gn[e];
      }
      if (lat) {
#pragma unroll
        for (int e = 0; e < 8; ++e) part[e] = shxl(y[e], lane, 4);
        rope_pair8(y, part, (lane & 4) != 0, rowp + 32, rowp + 64, (lane & 3) * 8);
      }
      if (lane < 48) {
        bf16_t* base = grp == 0 ? (isk ? ((bf16_t*)(m.ws + OFF_KW)) : ((bf16_t*)(m.ws + OFF_QW))) : (isk ? ((bf16_t*)(m.ws + OFF_KG)) : ((bf16_t*)(m.ws + OFF_QG)));
        bf16_t* dst = base + (((size_t)b * (isk ? 2 : 4) + hh) * NT + p) * 64 + d0;
        *(uint4*)dst = pack8(y, isk ? 1.f : 0.125f * LOG2E);
      }
    }
    {
      const int vsrc = lane < 32 ? 512 + 8 * lane : (lane < 48 ? 1152 + 8 * (lane - 32) : 1664 + 8 * (lane - 48));
      uint4 w = *(const uint4*)(Pr + vsrc);
      *(uint2*)(Vs + rr * VS_STRIDE + lane * 16) = make_uint2(w.x, w.y);
      *(uint2*)(Vs + rr * VS_STRIDE + lane * 16 + 8) = make_uint2(w.z, w.w);
    }
  }
  __syncthreads();
  for (int tk = tid; tk < 2048; tk += NTHR) {
    const int pg = tk & 3; const int vch = (tk >> 2) & 15 | ((tk >> 6) << 4);
    unsigned short e[8];
#pragma unroll
    for (int i = 0; i < 8; ++i) {
      int sidx = 8 * pg + i;
      int pl = (sidx & 16) | perm16(sidx & 15);
      e[i] = *(const unsigned short*)(Vs + pl * VS_STRIDE + vch * 2);
    }
    uint4 w = make_uint4(e[0] | ((unsigned)e[1] << 16), e[2] | ((unsigned)e[3] << 16), e[4] | ((unsigned)e[5] << 16), e[6] | ((unsigned)e[7] << 16));
    bf16_t* dst;
    if (vch < 256) dst = ((bf16_t*)(m.ws + OFF_VAt)) + (((size_t)b * 4 + (vch >> 6)) * 64 + (vch & 63)) * NT;
    else if (vch < 384) dst = ((bf16_t*)(m.ws + OFF_VWt)) + (((size_t)b * 2 + ((vch - 256) >> 6)) * 64 + (vch & 63)) * NT;
    else dst = ((bf16_t*)(m.ws + OFF_VGt)) + (((size_t)b * 2 + ((vch - 384) >> 6)) * 64 + (vch & 63)) * NT;
    *(uint4*)(dst + p0 + 8 * pg) = w;
  }
  {
    const float* cw = m.hy_conv_w + l * 3 * 768; const float* cb = m.hy_conv_b + l * 768;
    for (int c = tid; c < 768; c += NTHR) {
      const float w0 = cw[c], w1 = cw[768 + c], w2 = cw[1536 + c], bb = cb[c];
      float* dst = ((float*)(m.ws + OFF_uT)) + ((size_t)b * 768 + c) * NT + p0;
      float prev = bf2f(*(const bf16_t*)(Hs + 0 * HS_STRIDE + c * 2));
      float cur = bf2f(*(const bf16_t*)(Hs + 1 * HS_STRIDE + c * 2));
#pragma unroll 1
      for (int pg = 0; pg < 8; ++pg) {
        float o[4];
#pragma unroll
        for (int i = 0; i < 4; ++i) {
          float nxt = bf2f(*(const bf16_t*)(Hs + (4 * pg + i + 2) * HS_STRIDE + c * 2));
          o[i] = prev * w0 + cur * w1 + nxt * w2 + bb;
          prev = cur; cur = nxt;
        }
        *(float4*)(dst + 4 * pg) = make_float4(o[0], o[1], o[2], o[3]);
      }
    }
  }
}

DI void hyena_ctx_channel(MKP m_in, int l, int c, char* smem) {
  const MK m = launder_mk(m_in);
  float* kf = (float*)smem;
  float* vz = kf + 1024;
  float* red = vz + 512;
  float* wcol = red + 16;
  const int tid = TID;
  const float* hd = ((float*)(m.ws + OFF_hdn2)) + ((size_t)l * NT + SEQ) * 64;
  const float* w3 = m.hy_w3 + (size_t)l * 64 * 1024; const float* b3 = m.hy_b3 + l * 1024;
  __syncthreads();
  if (tid < 256) { int od = tid >> 6, i = tid & 63; wcol[od * 64 + i] = w3[i * 1024 + (od >> 1) * 512 + (od & 1) * 256 + c]; }
  __syncthreads();
  const float delta = fabsf(-3.0701134573253944f + (float)c * ((-15.350567286626972f + 3.0701134573253944f) / 255.f));
  float n0 = 0.f, n1 = 0.f;
  if (tid < 256) {
    const int j = tid;
    float f00 = b3[c], f01 = b3[256 + c], f10 = b3[512 + c], f11 = b3[768 + c];
    for (int i = 0; i < 64; ++i) {
      float hv = hd[j * 64 + i];
      f00 += hv * wcol[i]; f01 += hv * wcol[64 + i]; f10 += hv * wcol[128 + i]; f11 += hv * wcol[192 + i];
    }
    const float dec = __expf(-((float)j / (float)(CTX - 1)) * delta);
    f00 *= dec; f01 *= dec; f10 *= dec; f11 *= dec;
    kf[256 + j] = f00; kf[512 + 256 + j] = f10; n0 += fabsf(f00); n1 += fabsf(f10);
    if (j > 0) { kf[256 - j] = f01; kf[512 + 256 - j] = f11; n0 += fabsf(f01); n1 += fabsf(f11); }
    else { kf[0] = 0.f; kf[512] = 0.f; }
  }
  n0 = block_sum_512(n0, red);
  n1 = block_sum_512(n1, red);
  const float i0 = 1.f / n0, i1 = 1.f / n1;
  const int bb = tid >> 8, t = tid & 255;
  const float* ub = ((float*)(m.ws + OFF_uT)) + ((size_t)bb * 768 + c) * NT;
  const float vself = ub[t];
  vz[bb * 256 + t] = vself;
  __syncthreads();
  float acc = 0.f;
  for (int s2 = 0; s2 < 256; ++s2) acc += vz[bb * 256 + s2] * kf[256 + t - s2];
  const float z = ub[(size_t)256 * NT + t] * (acc * i0 + m.hy_bias[l * 512 + c] * vself);
  __syncthreads();
  vz[bb * 256 + t] = z;
  __syncthreads();
  float acc2 = 0.f;
  for (int s2 = 0; s2 < 256; ++s2) acc2 += vz[bb * 256 + s2] * kf[512 + 256 + t - s2];
  ((float*)(m.ws + OFF_yT))[((size_t)bb * 256 + c) * NT + t] = ub[(size_t)512 * NT + t] * (acc2 * i1 + m.hy_bias[l * 512 + 256 + c] * z);
}

DI void phase_mix(MKP m_in, int l, bool want_ctx, char* smem) {
  const MK m = launder_mk(m_in);
  AttnArgs a;
  a.QA = ((bf16_t*)(m.ws + OFF_QA)); a.KA = ((bf16_t*)(m.ws + OFF_KA)); a.VAt = ((bf16_t*)(m.ws + OFF_VAt)); a.QW = ((bf16_t*)(m.ws + OFF_QW)); a.KW = ((bf16_t*)(m.ws + OFF_KW)); a.VWt = ((bf16_t*)(m.ws + OFF_VWt)); a.QG = ((bf16_t*)(m.ws + OFF_QG)); a.KG = ((bf16_t*)(m.ws + OFF_KG)); a.VGt = ((bf16_t*)(m.ws + OFF_VGt));
  a.g_qk_diff = m.g_qk_diff + l * 64; a.g_qk_win = m.g_qk_win + l * 128; a.g_qk_glob = m.g_qk_glob + l * 128; a.sink = m.sink_win + l * 4;
  a.lambda_diff = m.lambda_diff + l * 128; a.g_mix_out = m.g_mix_out + l * D; a.lambda_init = 0.8f - 0.6f * __expf(-0.3f * (float)l); a.pad0 = 0;
  a.A2 = ((bf16_t*)(m.ws + OFF_A2)); a.Oslab = ((float*)(m.ws + OFF_Oslab)); a.Lslab = ((float*)(m.ws + OFF_Lslab));
  const int nitems = 640 + (want_ctx ? 20 : 0);
  for (int idx = BID; idx < 512; idx += NBLK) attn_dispatch(a, idx, want_ctx, smem);
  for (int c = BID; c < 256; c += NBLK) {
    hyena_channel(c, ((float*)(m.ws + OFF_hdn2)) + (size_t)l * NT * 64, m.hy_w3 + (size_t)l * 64 * 1024, m.hy_b3 + l * 1024, m.hy_bias + l * 512, ((float*)(m.ws + OFF_uT)), ((float*)(m.ws + OFF_zT)), ((float*)(m.ws + OFF_yT)),
                  ((float2*)(m.ws + OFF_Hc)), smem);
    if (want_ctx) hyena_ctx_channel(m_in, l, c, smem);
  }
  for (int idx = 512 + BID; idx < nitems; idx += NBLK) attn_dispatch(a, idx, want_ctx, smem);
}

DI void phase_fin(MKP m_in, int l, bool want_ctx) {
  const MK m = launder_mk(m_in);
  const float* gmo = m.g_mix_out + l * D;
  for (int idx = BID * NTHR + TID; idx < NB * 8 * NT; idx += NBLK * NTHR) {
    const int p = idx % NT; const int hd = (idx / NT) % 8; const int b = idx / (NT * 8);
    if (p < CTX && !want_ctx) continue;
    float o[64]; float ss = 0.f;
    if (hd < 4) {
      size_t i0 = (((size_t)0 * NB + b) * 4 + hd) * NT + p, i1 = (((size_t)1 * NB + b) * 4 + hd) * NT + p;
      const float inv = 1.f / (((float*)(m.ws + OFF_Lslab))[i0] + ((float*)(m.ws + OFF_Lslab))[i1]);
      const float4* a0 = (const float4*)(((float*)(m.ws + OFF_Oslab)) + i0 * 64); const float4* a1 = (const float4*)(((float*)(m.ws + OFF_Oslab)) + i1 * 64);
#pragma unroll
      for (int i = 0; i < 16; ++i) {
        float4 x = a0[i], y = a1[i];
        o[4 * i] = (x.x + y.x) * inv; o[4 * i + 1] = (x.y + y.y) * inv; o[4 * i + 2] = (x.z + y.z) * inv; o[4 * i + 3] = (x.w + y.w) * inv;
      }
    } else {
      const int g = hd - 4;
#pragma unroll
      for (int i = 0; i < 64; ++i) o[i] = ((float*)(m.ws + OFF_yT))[((size_t)b * 256 + g * 64 + i) * NT + p];
    }
#pragma unroll
    for (int i = 0; i < 64; ++i) ss += o[i] * o[i];
    const float rs = rsqrtf(ss * (1.f / 64) + EPS);
    const float* gm = gmo + 512 + hd * 64;
    uint4* dst = (uint4*)(((bf16_t*)(m.ws + OFF_A2)) + ((size_t)b * NT + p) * D + 512 + hd * 64);
#pragma unroll
    for (int i = 0; i < 8; ++i)
      dst[i] = make_uint4(pk2bf(o[8 * i] * rs * gm[8 * i], o[8 * i + 1] * rs * gm[8 * i + 1]), pk2bf(o[8 * i + 2] * rs * gm[8 * i + 2], o[8 * i + 3] * rs * gm[8 * i + 3]),
                          pk2bf(o[8 * i + 4] * rs * gm[8 * i + 4], o[8 * i + 5] * rs * gm[8 * i + 5]), pk2bf(o[8 * i + 6] * rs * gm[8 * i + 6], o[8 * i + 7] * rs * gm[8 * i + 7]));
  }
}

DI void phase_peer(MKP m_in, int l, bool want_ctx, bool last, char* smem) {
  const MK m = launder_mk(m_in);
  float* wd = (float*)smem + (TID >> 6) * 128;
  const float* modv_l = ((float*)(m.ws + OFF_modv)) + (size_t)l * 3 * NMOD;
  for (int r = BID * 8 + (TID >> 6); r < R; r += NBLK * 8) {
    if ((r % NT) < CTX && !want_ctx) continue;
    peer_token(r, ((bf16_t*)(m.ws + OFF_hbuf)), ((int*)(m.ws + OFF_experts)), ((float*)(m.ws + OFF_gates)), ((unsigned char*)(m.ws + OFF_u8)) + (size_t)l * 16384 * D, ((float*)(m.ws + OFF_us)) + l * 16384, ((unsigned char*)(m.ws + OFF_v8)) + (size_t)l * 16384 * D, ((float*)(m.ws + OFF_vs)) + l * 16384,
               modv_l, ((float*)(m.ws + OFF_xs)), wd, last ? m.out : nullptr);
  }
}

DI void phase_scores(MKP m_in, int l, bool last, char* smem) {
  const MK m = launder_mk(m_in);
  const int nrt = last ? 128 : 132;
  for (int t = BID; t < nrt * 16; t += NBLK)
    score_tile(((bf16_t*)(m.ws + OFF_P)), ((bf16_t*)(m.ws + OFF_keysb)) + (size_t)l * 16 * 128 * 128, rowtile_of(t >> 4, last) * 128, t & 15, smem,
               ((float*)(m.ws + OFF_topv)), ((unsigned char*)(m.ws + OFF_topi)));
}
DI void phase_merge(MKP m_in, bool want_ctx) {
  const MK m = launder_mk(m_in);
  for (int idx = BID * NTHR + TID; idx < R * 8; idx += NBLK * NTHR) {
    int r = idx >> 3;
    if ((r % NT) < CTX && !want_ctx) continue;
    merge_one(((float*)(m.ws + OFF_topv)), ((unsigned char*)(m.ws + OFF_topi)), r, idx & 7, ((int*)(m.ws + OFF_experts)), ((float*)(m.ws + OFF_gates)));
  }
}
DI void phase_gemm1(MKP m_in, int l, char* smem) {
  const MK m = launder_mk(m_in);
  phase_gemm<0>((bf16_t*)(m.ws + OFF_hbuf), (bf16_t*)(m.ws + OFF_Wt_in) + (size_t)l * DIN * D, DIN, (bf16_t*)(m.ws + OFF_P), nullptr, nullptr, false, smem);
}
DI void phase_gemm2(MKP m_in, int l, bool last, char* smem) {
  const MK m = launder_mk(m_in);
  phase_gemm<1>((bf16_t*)(m.ws + OFF_A2), (bf16_t*)(m.ws + OFF_Wt_out) + (size_t)l * D * D, D, nullptr, (float*)(m.ws + OFF_xs),
                (float*)(m.ws + OFF_modv) + (size_t)l * 3 * NMOD + 2 * D, last, smem);
}
DI void phase_gemm3(MKP m_in, int l, bool last, char* smem) {
  const MK m = launder_mk(m_in);
  phase_gemm<0>((bf16_t*)(m.ws + OFF_hbuf), (bf16_t*)(m.ws + OFF_Wt_q) + (size_t)l * 2048 * D, 2048, (bf16_t*)(m.ws + OFF_P), nullptr, nullptr, last, smem);
}
template <int L>
DI void layer_body(MKP m, cg::grid_group& grid, char* smem) {
  constexpr bool want_ctx = L == 0, last = L == 1;
  phase_norm(m, L, 0, L == 0, false);
  grid.sync();
  phase_gemm1(m, L, smem);
  grid.sync();
  for (int t = BID; t < R / 32; t += NBLK) prep_tile(m, L, t, smem);
  grid.sync();
  phase_mix(m, L, want_ctx, smem);
  grid.sync();
  phase_fin(m, L, want_ctx);
  grid.sync();
  phase_gemm2(m, L, last, smem);
  grid.sync();
  phase_norm(m, L, 1, false, last);
  grid.sync();
  phase_gemm3(m, L, last, smem);
  grid.sync();
  phase_scores(m, L, last, smem);
  grid.sync();
  phase_merge(m, want_ctx);
  grid.sync();
  phase_peer(m, L, want_ctx, last, smem);
  if (!last) grid.sync();
}
__global__ __launch_bounds__(NTHR) void k_mega(MK m_unused) {
  extern __shared__ __attribute__((aligned(16))) char smem[];
  cg::grid_group grid = cg::this_grid();
  (void)m_unused;
  MKP m = (MKP)__builtin_amdgcn_kernarg_segment_ptr();
  phase0(m, smem);
  grid.sync();
  layer_body<0>(m, grid, smem);
  layer_body<1>(m, grid, smem);
}

extern "C" void kernel_launch(void* const* d_in, const int* in_sizes, int n_in, void* d_out, int out_size, void* d_ws, size_t ws_size,
                              hipStream_t stream) {
  (void)in_sizes; (void)n_in; (void)out_size;
  MK m;
  memset(&m, 0, sizeof(m));
  const float** ip = (const float**)&m.x;
  for (int i = 0; i < 30; ++i) ip[i] = (const float*)d_in[i];
  m.out = (float*)d_out;
  m.ws = (char*)d_ws;
  if (WS_TOTAL > ws_size) return;

  static int grid_blocks = 0;
  if (!grid_blocks) {
    hipFuncSetAttribute((const void*)k_mega, hipFuncAttributeMaxDynamicSharedMemorySize, SMEM_BYTES);
    int dev = 0, cus = 0, per_cu = 0;
    hipGetDevice(&dev);
    hipDeviceGetAttribute(&cus, hipDeviceAttributeMultiprocessorCount, dev);
    hipOccupancyMaxActiveBlocksPerMultiprocessor(&per_cu, k_mega, NTHR, SMEM_BYTES);
    if (per_cu > 1) per_cu = 1;
    grid_blocks = cus * per_cu;
  }
  void* args[] = {&m};
  hipLaunchCooperativeKernel((void*)k_mega, dim3(grid_blocks), dim3(NTHR), args, SMEM_BYTES, stream);
}
```

```cpp
#include <hip/hip_runtime.h>
#include <hip/hip_cooperative_groups.h>
namespace cg = cooperative_groups;
#include <stdint.h>
#include <string.h>

#define DI __device__ __forceinline__
typedef unsigned short bf16_t;

constexpr int D = 1024;
constexpr int NB = 2;
constexpr int SEQ = 8192;
constexpr int CTX = 256;
constexpr int NT = SEQ + CTX;
constexpr int R = NB * NT;
constexpr int DIN = 2560;
constexpr int NMOD = 6 * D;
constexpr float EPS = 1e-6f;
constexpr float LOG2E = 1.4426950408889634f;

DI int opq_v(int x) { asm volatile("" : "+v"(x)); return x; }
DI int opq_s(int x) { asm volatile("" : "+s"(x)); return x; }
template <class T> DI T* opq_p(T* p) { asm volatile("" : "+s"(p)); return p; }
#define TID opq_v((int)threadIdx.x)
#define BID opq_s((int)blockIdx.x)
#define NBLK opq_s((int)gridDim.x)
DI float shxl(float v, int lane, int mask) { return __builtin_bit_cast(float, __builtin_amdgcn_ds_bpermute((lane ^ mask) << 2, __builtin_bit_cast(int, v))); }
DI int shxl(int v, int lane, int mask) { return __builtin_amdgcn_ds_bpermute((lane ^ mask) << 2, v); }
DI float shx(float v, int mask) { return shxl(v, opq_v((int)threadIdx.x) & 63, mask); }
DI bf16_t f2bf(float x) { unsigned u = __float_as_uint(x); u += 0x7fffu + ((u >> 16) & 1u); return (bf16_t)(u >> 16); }
DI float bf2f(bf16_t h) { return __uint_as_float(((unsigned)h) << 16); }
DI float bflo(unsigned w) { return __uint_as_float(w << 16); }
DI float bfhi(unsigned w) { return __uint_as_float(w & 0xffff0000u); }

DI float block_sum_256(float v, float* red) {
  for (int o = 32; o > 0; o >>= 1) v += shx(v, o);
  int w = TID >> 6;
  __syncthreads();
  if ((TID & 63) == 0) red[w] = v;
  __syncthreads();
  float s = red[0] + red[1] + red[2] + red[3];
  return s;
}

DI int perm16(int o) { return (o & 3) | ((o & 4) << 1) | ((o & 8) >> 1); }

typedef __attribute__((ext_vector_type(8))) short bf16x8;
typedef __attribute__((ext_vector_type(16))) float f32x16;
typedef __attribute__((ext_vector_type(2))) __bf16 bf16x2_t;
typedef __attribute__((ext_vector_type(2))) float f32x2_t;
#define MFMA32(a, b, c) __builtin_amdgcn_mfma_f32_32x32x16_bf16((a), (b), (c), 0, 0, 0)
DI unsigned pk2bf(float a, float b) { f32x2_t v = {a, b}; return __builtin_bit_cast(unsigned, __builtin_convertvector(v, bf16x2_t)); }
constexpr int NTHR = 512;

DI void wconv_tile(const float* __restrict__ W, bf16_t* __restrict__ Wt, int N, int tile, float* sm  ) {
  int tn = tile % (N / 64), tk = tile / (N / 64);
  int tid = TID;
  __syncthreads();
  for (int i = tid; i < 64 * 16; i += NTHR) {
    int kr = i >> 4, c4 = (i & 15) * 4;
    float4 v = *(const float4*)(W + (size_t)(tk * 64 + kr) * N + tn * 64 + c4);
    sm[kr * 65 + c4] = v.x; sm[kr * 65 + c4 + 1] = v.y; sm[kr * 65 + c4 + 2] = v.z; sm[kr * 65 + c4 + 3] = v.w;
  }
  __syncthreads();
  for (int i = tid; i < 64 * 8; i += NTHR) {
    int n = i >> 3, k8 = (i & 7) * 8;
    unsigned w[4];
    for (int j = 0; j < 4; ++j) w[j] = pk2bf(sm[(k8 + 2 * j) * 65 + n], sm[(k8 + 2 * j + 1) * 65 + n]);
    *(uint4*)(Wt + (size_t)(tn * 64 + n) * D + tk * 64 + k8) = make_uint4(w[0], w[1], w[2], w[3]);
  }
}

template <int EPI>
DI void gemm_tile(const bf16_t* __restrict__ A, const bf16_t* __restrict__ Wt, int N, int m0, int n0, char* smem, bf16_t* __restrict__ Cb,
                  float* __restrict__ xs, const float* __restrict__ gate_base) {
  constexpr int K = D;
  const int tid = TID, lane = tid & 63, wid = tid >> 6;
  const int wm = wid & 1, wn = wid >> 1;
  const int r = lane & 31, h = lane >> 5;
  f32x16 acc0, acc1;
  for (int i = 0; i < 16; ++i) { acc0[i] = 0.f; acc1[i] = 0.f; }
  const int lrow = tid >> 3, lch = tid & 7;
  const bf16_t* Ag = A + (size_t)(m0 + lrow) * K + lch * 8;
  const bf16_t* Bg = Wt + (size_t)(n0 + lrow) * K + lch * 8;
  const int woff = lrow * 128 + ((lch ^ ((lrow >> 1) & 7)) << 4);
  uint4 ra0, ra1, rb0, rb1;
  ra0 = *(const uint4*)(Ag); ra1 = *(const uint4*)(Ag + (size_t)64 * K);
  rb0 = *(const uint4*)(Bg); rb1 = *(const uint4*)(Bg + (size_t)64 * K);
  __syncthreads();
  *(uint4*)(smem + woff) = ra0; *(uint4*)(smem + woff + 8192) = ra1;
  *(uint4*)(smem + 16384 + woff) = rb0; *(uint4*)(smem + 16384 + woff + 8192) = rb1;
  __syncthreads();
  const int sw = (r >> 1) & 7;
  const int aoff0 = (wm * 64 + r) * 128, aoff1 = aoff0 + 32 * 128;
  const int boff = 16384 + (wn * 32 + r) * 128;
#pragma unroll 1
  for (int kt = 0; kt < K / 64; ++kt) {
    const char* st = smem + (kt & 1) * 32768;
    if (kt + 1 < K / 64) {
      ra0 = *(const uint4*)(Ag + (kt + 1) * 64); ra1 = *(const uint4*)(Ag + (size_t)64 * K + (kt + 1) * 64);
      rb0 = *(const uint4*)(Bg + (kt + 1) * 64); rb1 = *(const uint4*)(Bg + (size_t)64 * K + (kt + 1) * 64);
    }
#pragma unroll
    for (int s = 0; s < 4; ++s) {
      int co = ((2 * s + h) ^ sw) << 4;
      bf16x8 a0 = *(const bf16x8*)(st + aoff0 + co);
      bf16x8 a1 = *(const bf16x8*)(st + aoff1 + co);
      bf16x8 b = *(const bf16x8*)(st + boff + co);
      acc0 = MFMA32(a0, b, acc0);
      acc1 = MFMA32(a1, b, acc1);
    }
    if (kt + 1 < K / 64) {
      char* sn = smem + ((kt + 1) & 1) * 32768;
      *(uint4*)(sn + woff) = ra0; *(uint4*)(sn + woff + 8192) = ra1;
      *(uint4*)(sn + 16384 + woff) = rb0; *(uint4*)(sn + 16384 + woff + 8192) = rb1;
    }
    __syncthreads();
  }
  float* Cs = (float*)smem;
  constexpr int CS = 132;
#pragma unroll
  for (int i = 0; i < 16; ++i) {
    int row = (i & 3) + 8 * (i >> 2) + 4 * h;
    Cs[(wm * 64 + row) * CS + wn * 32 + r] = acc0[i];
    Cs[(wm * 64 + 32 + row) * CS + wn * 32 + r] = acc1[i];
  }
  __syncthreads();
  if (EPI == 0) {
    for (int i = tid; i < 128 * 16; i += NTHR) {
      int row = i >> 4, c8 = (i & 15) * 8;
      const float* cr = Cs + row * CS + c8;
      float4 v0 = *(const float4*)cr, v1 = *(const float4*)(cr + 4);
      *(uint4*)(Cb + (size_t)(m0 + row) * N + n0 + c8) = make_uint4(pk2bf(v0.x, v0.y), pk2bf(v0.z, v0.w), pk2bf(v1.x, v1.y), pk2bf(v1.z, v1.w));
    }
  } else {
    for (int i = tid; i < 128 * 32; i += NTHR) {
      int row = i >> 5, c4 = (i & 31) * 4;
      int rr = m0 + row; int b = rr / NT, p = rr % NT; int mrow = p < CTX ? 2 : b;
      const float* gt = gate_base + mrow * NMOD + n0 + c4;
      float4 v = *(const float4*)(Cs + row * CS + c4);
      float4 xv = *(float4*)(xs + (size_t)rr * D + n0 + c4);
      xv.x += gt[0] * v.x; xv.y += gt[1] * v.y; xv.z += gt[2] * v.z; xv.w += gt[3] * v.w;
      *(float4*)(xs + (size_t)rr * D + n0 + c4) = xv;
    }
  }
}


struct AttnArgs {
  const bf16_t *QA, *KA, *VAt, *QW, *KW, *VWt, *QG, *KG, *VGt;
  const float *g_qk_diff, *g_qk_win, *g_qk_glob, *sink, *lambda_diff, *g_mix_out;
  float lambda_init;
  int pad0;
  bf16_t* A2;
  float* Oslab;
  float* Lslab;
};

template <int TYPE>
DI void attn_item(const AttnArgs& a, int b, int g, int p0, int ctx0, int nctx, int lat0, int nkt, int half, char* smem) {
  constexpr int DQK = TYPE == 0 ? 32 : 64;
  constexpr int KS = DQK / 16;
  const int tid = TID, lane = tid & 63, wid = tid >> 6;
  const int r = lane & 31, h = lane >> 5;
  const bf16_t *Q0, *Q1, *K0, *K1, *Vt;
  const float* gqk;
  if (TYPE == 0) {
    Q0 = a.QA + ((size_t)b * 8 + 2 * g) * NT * 32; Q1 = Q0 + (size_t)NT * 32;
    K0 = a.KA + ((size_t)b * 8 + 2 * g) * NT * 32; K1 = K0 + (size_t)NT * 32;
    Vt = a.VAt + ((size_t)b * 4 + g) * 64 * NT; gqk = a.g_qk_diff;
  } else if (TYPE == 1) {
    Q0 = a.QW + ((size_t)b * 4 + 2 * g) * NT * 64; Q1 = Q0 + (size_t)NT * 64;
    K0 = a.KW + ((size_t)b * 2 + g) * NT * 64; K1 = K0;
    Vt = a.VWt + ((size_t)b * 2 + g) * 64 * NT; gqk = a.g_qk_win;
  } else {
    Q0 = a.QG + ((size_t)b * 4 + 2 * g) * NT * 64; Q1 = Q0 + (size_t)NT * 64;
    K0 = a.KG + ((size_t)b * 2 + g) * NT * 64; K1 = K0;
    Vt = a.VGt + ((size_t)b * 2 + g) * 64 * NT; gqk = a.g_qk_glob;
  }
  (void)gqk;
  const int qpos = p0 + wid * 32 + r;
  bf16x8 qf0[KS], qf1[KS];
#pragma unroll
  for (int s = 0; s < KS; ++s) {
    qf0[s] = *(const bf16x8*)(Q0 + (size_t)qpos * DQK + 16 * s + 8 * h);
    qf1[s] = *(const bf16x8*)(Q1 + (size_t)qpos * DQK + 16 * s + 8 * h);
  }
  f32x16 O00, O01, O10, O11, Zero;
#pragma unroll
  for (int i = 0; i < 16; ++i) { O00[i] = 0.f; O01[i] = 0.f; O10[i] = 0.f; O11[i] = 0.f; Zero[i] = 0.f; }
  float l0 = 0.f, l1 = 0.f;

  uint4 st0, st1, st2, st3;
  auto tile_of = [&](int it) { return it < nctx ? ctx0 + it : lat0 + it - nctx; };
  const int vrow0 = tid >> 4, vch = tid & 15;
#define ATT_GLOAD(kt_)                                                                                   \
  {                                                                                                      \
    const int kt__ = (kt_);                                                                              \
    if (TYPE == 0) {                                                                                     \
      st0 = *(const uint4*)(K0 + (size_t)kt__ * 128 * 32 + tid * 8);                                     \
      st1 = *(const uint4*)(K1 + (size_t)kt__ * 128 * 32 + tid * 8);                                     \
    } else {                                                                                             \
      st0 = *(const uint4*)(K0 + (size_t)kt__ * 128 * 64 + tid * 8);                                     \
      st1 = *(const uint4*)(K0 + (size_t)kt__ * 128 * 64 + (tid + 512) * 8);                             \
    }                                                                                                    \
    st2 = *(const uint4*)(Vt + (size_t)vrow0 * NT + kt__ * 128 + vch * 8);                               \
    st3 = *(const uint4*)(Vt + (size_t)(vrow0 + 32) * NT + kt__ * 128 + vch * 8);                        \
  }
#define ATT_SSTORE(sb_)                                                                                  \
  {                                                                                                      \
    char* sb__ = (sb_);                                                                                  \
    if (TYPE == 0) {                                                                                     \
      int row = tid >> 2, ch = tid & 3;                                                                  \
      int off = row * 64 + ((ch ^ ((row >> 2) & 3)) << 4);                                               \
      *(uint4*)(sb__ + off) = st0;                                                                       \
      *(uint4*)(sb__ + 8192 + off) = st1;                                                                \
    } else {                                                                                             \
      int row = tid >> 3, ch = tid & 7;                                                                  \
      int off = row * 128 + ((ch ^ ((row >> 1) & 7)) << 4);                                              \
      *(uint4*)(sb__ + off) = st0;                                                                       \
      *(uint4*)(sb__ + off + 8192) = st1;                                                                \
    }                                                                                                    \
    int voff = 16384 + vrow0 * 256 + ((vch ^ (vrow0 & 15)) << 4);                                        \
    *(uint4*)(sb__ + voff) = st2;                                                                        \
    *(uint4*)(sb__ + voff + 8192) = st3;                                                                 \
  }
  ATT_GLOAD(tile_of(0));
  __syncthreads();
  ATT_SSTORE(smem);
  __syncthreads();
  const int qwave = p0 + wid * 32;
#pragma unroll 1
  for (int it = 0; it < nkt; ++it) {
    const int kt = tile_of(it);
    const char* sb = smem + (it & 1) * 32768;
    if (it + 1 < nkt) ATT_GLOAD(tile_of(it + 1));
#pragma unroll 1
    for (int j = 0; j < 4; ++j) {
      const int kbase = kt * 128 + 32 * j;
      bool masked = false;
      if (TYPE == 1) {
        if (kbase >= CTX && p0 >= CTX) {
          if (kbase > qwave + 31 + 128 || kbase + 31 < qwave - 128) continue;
          masked = true;
        }
      }
      f32x16 S0 = Zero, S1 = Zero;
#pragma unroll
      for (int s = 0; s < KS; ++s) {
        if (TYPE == 0) {
          int row = 32 * j + r;
          int off = row * 64 + (((2 * s + h) ^ ((row >> 2) & 3)) << 4);
          bf16x8 k0 = *(const bf16x8*)(sb + off);
          bf16x8 k1 = *(const bf16x8*)(sb + 8192 + off);
          S0 = MFMA32(k0, qf0[s], S0);
          S1 = MFMA32(k1, qf1[s], S1);
        } else {
          int row = 32 * j + r;
          int off = row * 128 + (((2 * s + h) ^ ((row >> 1) & 7)) << 4);
          bf16x8 k0 = *(const bf16x8*)(sb + off);
          S0 = MFMA32(k0, qf0[s], S0);
          S1 = MFMA32(k0, qf1[s], S1);
        }
      }
      float pa[16], pb[16];
#pragma unroll
      for (int i = 0; i < 16; ++i) {
        float e0 = __builtin_amdgcn_exp2f(S0[i]);
        float e1 = __builtin_amdgcn_exp2f(S1[i]);
        if (TYPE == 1) {
          if (masked) {
            int kp = kbase + (i & 3) + 8 * (i >> 2) + 4 * h;
            int dd = kp - qpos;
            bool ok = (dd <= 128) && (dd >= -128);
            e0 = ok ? e0 : 0.f; e1 = ok ? e1 : 0.f;
          }
        }
        pa[i] = e0; pb[i] = e1;
      }
      l0 += ((pa[0] + pa[1]) + (pa[2] + pa[3])) + ((pa[4] + pa[5]) + (pa[6] + pa[7])) + ((pa[8] + pa[9]) + (pa[10] + pa[11])) + ((pa[12] + pa[13]) + (pa[14] + pa[15]));
      l1 += ((pb[0] + pb[1]) + (pb[2] + pb[3])) + ((pb[4] + pb[5]) + (pb[6] + pb[7])) + ((pb[8] + pb[9]) + (pb[10] + pb[11])) + ((pb[12] + pb[13]) + (pb[14] + pb[15]));
      bf16x8 pf0[2], pf1[2];
#pragma unroll
      for (int s2 = 0; s2 < 2; ++s2) {
        unsigned w0[4], w1[4];
#pragma unroll
        for (int e = 0; e < 4; ++e) {
          w0[e] = pk2bf(pa[8 * s2 + 2 * e], pa[8 * s2 + 2 * e + 1]);
          w1[e] = pk2bf(pb[8 * s2 + 2 * e], pb[8 * s2 + 2 * e + 1]);
        }
        pf0[s2] = __builtin_bit_cast(bf16x8, make_uint4(w0[0], w0[1], w0[2], w0[3]));
        pf1[s2] = __builtin_bit_cast(bf16x8, make_uint4(w1[0], w1[1], w1[2], w1[3]));
      }
#pragma unroll
      for (int s2 = 0; s2 < 2; ++s2) {
        int ch = 4 * j + 2 * s2 + h;
        bf16x8 v0 = *(const bf16x8*)(sb + 16384 + r * 256 + ((ch ^ (r & 15)) << 4));
        bf16x8 v1 = *(const bf16x8*)(sb + 16384 + (32 + r) * 256 + ((ch ^ (r & 15)) << 4));
        O00 = MFMA32(v0, pf0[s2], O00);
        O01 = MFMA32(v1, pf0[s2], O01);
        O10 = MFMA32(v0, pf1[s2], O10);
        O11 = MFMA32(v1, pf1[s2], O11);
      }
    }
    if (it + 1 < nkt) ATT_SSTORE(smem + ((it + 1) & 1) * 32768);
    __syncthreads();
  }
  l0 += shxl(l0, lane, 32);
  l1 += shxl(l1, lane, 32);
  if (TYPE == 1) {
    l0 += __builtin_amdgcn_exp2f(a.sink[2 * g] * LOG2E);
    l1 += __builtin_amdgcn_exp2f(a.sink[2 * g + 1] * LOG2E);
  }
  const size_t orow = (size_t)b * NT + qpos;
  if (TYPE == 2) {
#pragma unroll
    for (int x = 0; x < 2; ++x) {
      int head = 2 * g + x;
      float* dst = a.Oslab + ((((size_t)half * NB + b) * 4 + head) * NT + qpos) * 64;
#pragma unroll
      for (int dt = 0; dt < 2; ++dt) {
        const f32x16& O = x == 0 ? (dt == 0 ? O00 : O01) : (dt == 0 ? O10 : O11);
#pragma unroll
        for (int q4 = 0; q4 < 4; ++q4)
          *(float4*)(dst + 32 * dt + 8 * q4 + 4 * h) = make_float4(O[4 * q4], O[4 * q4 + 1], O[4 * q4 + 2], O[4 * q4 + 3]);
      }
      if (h == 0) a.Lslab[(((size_t)half * NB + b) * 4 + head) * NT + qpos] = x == 0 ? l0 : l1;
    }
  } else if (TYPE == 0) {
    float s0 = 0.f, s1 = 0.f;
    for (int d = 0; d < 32; ++d) { s0 += a.lambda_diff[d] * a.lambda_diff[32 + d]; s1 += a.lambda_diff[64 + d] * a.lambda_diff[96 + d]; }
    const float lam = __expf(s0) - __expf(s1) + a.lambda_init;
    const float i0 = 1.f / l0, i1 = lam / l1;
    float o[32];
    float ss = 0.f;
#pragma unroll
    for (int i = 0; i < 16; ++i) {
      o[i] = O00[i] * i0 - O10[i] * i1;
      o[16 + i] = O01[i] * i0 - O11[i] * i1;
      ss += o[i] * o[i] + o[16 + i] * o[16 + i];
    }
    ss += shxl(ss, lane, 32);
    const float rs = rsqrtf(ss * (1.f / 64) + EPS) * (1.f - a.lambda_init);
    const float* gm = a.g_mix_out + g * 64;
    bf16_t* dst = a.A2 + orow * D + g * 64;
#pragma unroll
    for (int dt = 0; dt < 2; ++dt)
#pragma unroll
      for (int q4 = 0; q4 < 4; ++q4) {
        int dv = 32 * dt + 8 * q4 + 4 * h;
        const float* ov = o + 16 * dt + 4 * q4;
        uint2 w;
        w.x = pk2bf(ov[0] * rs * gm[dv], ov[1] * rs * gm[dv + 1]);
        w.y = pk2bf(ov[2] * rs * gm[dv + 2], ov[3] * rs * gm[dv + 3]);
        *(uint2*)(dst + dv) = w;
      }
  } else {
#pragma unroll
    for (int x = 0; x < 2; ++x) {
      const float inv = 1.f / (x == 0 ? l0 : l1);
      float o[32];
      float ss = 0.f;
#pragma unroll
      for (int i = 0; i < 16; ++i) {
        o[i] = (x == 0 ? O00[i] : O10[i]) * inv;
        o[16 + i] = (x == 0 ? O01[i] : O11[i]) * inv;
        ss += o[i] * o[i] + o[16 + i] * o[16 + i];
      }
      ss += shxl(ss, lane, 32);
      const float rs = rsqrtf(ss * (1.f / 64) + EPS);
      const int col0 = 256 + (2 * g + x) * 64;
      const float* gm = a.g_mix_out + col0;
      bf16_t* dst = a.A2 + orow * D + col0;
#pragma unroll
      for (int dt = 0; dt < 2; ++dt)
#pragma unroll
        for (int q4 = 0; q4 < 4; ++q4) {
          int dv = 32 * dt + 8 * q4 + 4 * h;
          const float* ov = o + 16 * dt + 4 * q4;
          uint2 w;
          w.x = pk2bf(ov[0] * rs * gm[dv], ov[1] * rs * gm[dv + 1]);
          w.y = pk2bf(ov[2] * rs * gm[dv + 2], ov[3] * rs * gm[dv + 3]);
          *(uint2*)(dst + dv) = w;
        }
    }
  }
}

DI void attn_dispatch(const AttnArgs& a, int idx, int want_ctx, char* smem) {
  if (idx < 256) {
    int b = idx >> 7, g = (idx >> 5) & 3, qt = 1 + (idx & 31);
    attn_item<0>(a, b, g, qt * 256, 0, 2, 2, 66, 0, smem);
  } else if (idx < 512) {
    int i = idx - 256; int half = i >> 7, b = (i >> 6) & 1, g = (i >> 5) & 1, qt = 1 + (i & 31);
    if (half == 0) attn_item<2>(a, b, g, qt * 256, 0, 2, 2, 33, 0, smem);
    else attn_item<2>(a, b, g, qt * 256, 0, 0, 33, 33, 1, smem);
  } else if (idx < 640) {
    int i = idx - 512; int b = i >> 6, g = (i >> 5) & 1, qt = 1 + (i & 31);
    int lo = max(2, 2 * qt - 1), hi = min(65, 2 * qt + 2);
    attn_item<1>(a, b, g, qt * 256, 0, 2, lo, 2 + (hi - lo + 1), 0, smem);
  } else if (want_ctx) {
    int i = idx - 640;
    if (i < 8) attn_item<0>(a, i >> 2, i & 3, 0, 0, 2, 0, 2, 0, smem);
    else if (i < 16) { int k = i - 8; int half = k >> 2, b = (k >> 1) & 1, g = k & 1; attn_item<2>(a, b, g, 0, half, 1, 0, 1, half, smem); }
    else if (i < 20) { int k = i - 16; attn_item<1>(a, k >> 1, k & 1, 0, 0, 2, 0, 2, 0, smem); }
  }
}

typedef __attribute__((ext_vector_type(4))) float f32x4v;
DI void tabconv_row(const float* __restrict__ src, unsigned char* __restrict__ dst, float* __restrict__ scale, size_t row) {
  const int lane = TID & 63;
  const float4* sp = (const float4*)(src + row * D + lane * 16);
  float4 v0 = sp[0], v1 = sp[1], v2 = sp[2], v3 = sp[3];
  float m = fmaxf(fmaxf(fmaxf(fabsf(v0.x), fabsf(v0.y)), fmaxf(fabsf(v0.z), fabsf(v0.w))), fmaxf(fmaxf(fabsf(v1.x), fabsf(v1.y)), fmaxf(fabsf(v1.z), fabsf(v1.w))));
  m = fmaxf(m, fmaxf(fmaxf(fmaxf(fabsf(v2.x), fabsf(v2.y)), fmaxf(fabsf(v2.z), fabsf(v2.w))), fmaxf(fmaxf(fabsf(v3.x), fabsf(v3.y)), fmaxf(fabsf(v3.z), fabsf(v3.w)))));
  for (int o = 32; o > 0; o >>= 1) m = fmaxf(m, shxl(m, lane, o));
  m = fmaxf(m, 1e-30f);
  const float sc = m * (1.f / 448.f), inv = 448.f / m;
  int w0 = __builtin_amdgcn_cvt_pk_fp8_f32(v0.x * inv, v0.y * inv, 0, false); w0 = __builtin_amdgcn_cvt_pk_fp8_f32(v0.z * inv, v0.w * inv, w0, true);
  int w1 = __builtin_amdgcn_cvt_pk_fp8_f32(v1.x * inv, v1.y * inv, 0, false); w1 = __builtin_amdgcn_cvt_pk_fp8_f32(v1.z * inv, v1.w * inv, w1, true);
  int w2 = __builtin_amdgcn_cvt_pk_fp8_f32(v2.x * inv, v2.y * inv, 0, false); w2 = __builtin_amdgcn_cvt_pk_fp8_f32(v2.z * inv, v2.w * inv, w2, true);
  int w3 = __builtin_amdgcn_cvt_pk_fp8_f32(v3.x * inv, v3.y * inv, 0, false); w3 = __builtin_amdgcn_cvt_pk_fp8_f32(v3.z * inv, v3.w * inv, w3, true);
  *(uint4*)(dst + row * D + lane * 16) = make_uint4((unsigned)w0, (unsigned)w1, (unsigned)w2, (unsigned)w3);
  if (lane == 0) scale[row] = sc;
}

DI void score_tile(const bf16_t* __restrict__ qbuf, const bf16_t* __restrict__ keysb, int m0, int hp, char* smem, float* __restrict__ topv,
                   unsigned char* __restrict__ topi) {
  const int tid = TID, lane = tid & 63, wid = tid >> 6;
  const int wm = wid & 1, wn = wid >> 1;
  const int r = lane & 31, h = lane >> 5;
  f32x16 acc0, acc1;
  for (int i = 0; i < 16; ++i) { acc0[i] = 0.f; acc1[i] = 0.f; }
  const int lrow = tid >> 3, lch = tid & 7;
  const bf16_t* Ag = qbuf + (size_t)(m0 + lrow) * 2048 + hp * 128 + lch * 8;
  const bf16_t* Bg = keysb + ((size_t)hp * 128 + lrow) * 128 + lch * 8;
  const int woff = lrow * 128 + ((lch ^ ((lrow >> 1) & 7)) << 4);
  __syncthreads();
#pragma unroll
  for (int kt = 0; kt < 2; ++kt) {
    char* sn = smem + kt * 32768;
    *(uint4*)(sn + woff) = *(const uint4*)(Ag + kt * 64);
    *(uint4*)(sn + woff + 8192) = *(const uint4*)(Ag + (size_t)64 * 2048 + kt * 64);
    *(uint4*)(sn + 16384 + woff) = *(const uint4*)(Bg + kt * 64);
    *(uint4*)(sn + 16384 + woff + 8192) = *(const uint4*)(Bg + 64 * 128 + kt * 64);
  }
  __syncthreads();
  const int sw = (r >> 1) & 7;
  const int aoff0 = (wm * 64 + r) * 128, aoff1 = aoff0 + 32 * 128;
  const int boff = 16384 + (wn * 32 + r) * 128;
#pragma unroll
  for (int kt = 0; kt < 2; ++kt) {
    const char* st = smem + kt * 32768;
#pragma unroll
    for (int s = 0; s < 4; ++s) {
      int co = ((2 * s + h) ^ sw) << 4;
      bf16x8 a0 = *(const bf16x8*)(st + aoff0 + co);
      bf16x8 a1 = *(const bf16x8*)(st + aoff1 + co);
      bf16x8 b = *(const bf16x8*)(st + boff + co);
      acc0 = MFMA32(a0, b, acc0);
      acc1 = MFMA32(a1, b, acc1);
    }
  }
  __syncthreads();
  float* Cs = (float*)smem;
  constexpr int CS = 132;
#pragma unroll
  for (int i = 0; i < 16; ++i) {
    int row = (i & 3) + 8 * (i >> 2) + 4 * h;
    Cs[(wm * 64 + row) * CS + wn * 32 + r] = acc0[i];
    Cs[(wm * 64 + 32 + row) * CS + wn * 32 + r] = acc1[i];
  }
  __syncthreads();
  const int row = tid >> 2, q = tid & 3;
  float v[32];
#pragma unroll
  for (int i = 0; i < 32; ++i) v[i] = Cs[row * CS + 4 * i + q];
#pragma unroll 1
  for (int k = 0; k < 16; ++k) {
    float m = v[0]; int li = 0;
#pragma unroll
    for (int i = 1; i < 32; ++i) { bool gt = v[i] > m; m = gt ? v[i] : m; li = gt ? i : li; }
    int col = 4 * li + q;
    float m1 = shxl(m, lane, 1); int c1 = shxl(col, lane, 1);
    bool t1 = (m1 > m) || (m1 == m && c1 < col); m = t1 ? m1 : m; col = t1 ? c1 : col;
    float m2 = shxl(m, lane, 2); int c2 = shxl(col, lane, 2);
    bool t2 = (m2 > m) || (m2 == m && c2 < col); m = t2 ? m2 : m; col = t2 ? c2 : col;
    const bool own = (col & 3) == q; const int wi = col >> 2;
#pragma unroll
    for (int i = 0; i < 32; ++i) v[i] = (own && i == wi) ? -3.0e38f : v[i];
    if ((k & 3) == q) {
      size_t o = ((size_t)(m0 + row) * 16 + hp) * 16 + k;
      topv[o] = m; topi[o] = (unsigned char)col;
    }
  }
}

DI void merge_one(const float* __restrict__ topv, const unsigned char* __restrict__ topi, int r, int hd, int* __restrict__ experts,
                  float* __restrict__ gates) {
  const float* va = topv + ((size_t)r * 16 + 2 * hd) * 16;
  const float* vb = va + 16;
  const unsigned char* ia = topi + ((size_t)r * 16 + 2 * hd) * 16;
  const unsigned char* ib = ia + 16;
  float a[16], bq[16];
#pragma unroll
  for (int i = 0; i < 4; ++i) {
    float4 x = ((const float4*)va)[i], y = ((const float4*)vb)[i];
    a[4 * i] = x.x; a[4 * i + 1] = x.y; a[4 * i + 2] = x.z; a[4 * i + 3] = x.w;
    bq[4 * i] = y.x; bq[4 * i + 1] = y.y; bq[4 * i + 2] = y.z; bq[4 * i + 3] = y.w;
  }
  float cv[50];
  {
    int n = 0;
#pragma unroll
    for (int i = 0; i < 16; ++i)
#pragma unroll
      for (int j = 0; j < 16; ++j)
        if ((i + 1) * (j + 1) <= 16) { cv[n] = a[i] + bq[j]; ++n; }
  }
  int* eo = experts + (size_t)r * 128 + hd * 16;
  float* go = gates + (size_t)r * 128 + hd * 16;
  float mx = 0.f, sum = 0.f;
#pragma unroll 1
  for (int k = 0; k < 16; ++k) {
    float mval = cv[0]; int code = 0;
    {
      int n = 0;
#pragma unroll
      for (int i = 0; i < 16; ++i)
#pragma unroll
        for (int j = 0; j < 16; ++j)
          if ((i + 1) * (j + 1) <= 16) {
            if (n > 0) { bool gt = cv[n] > mval; mval = gt ? cv[n] : mval; code = gt ? (i * 16 + j) : code; }
            ++n;
          }
    }
    {
      int n = 0;
#pragma unroll
      for (int i = 0; i < 16; ++i)
#pragma unroll
        for (int j = 0; j < 16; ++j)
          if ((i + 1) * (j + 1) <= 16) { cv[n] = (code == i * 16 + j) ? -3.0e38f : cv[n]; ++n; }
    }
    if (k == 0) mx = mval;
    const float e = __expf(mval - mx);
    sum += e;
    eo[k] = (int)ia[code >> 4] * 128 + (int)ib[code & 15];
    go[k] = e;
  }
  const float inv = 1.f / sum;
#pragma unroll
  for (int i = 0; i < 4; ++i) {
    float4 g4 = ((float4*)go)[i];
    g4.x *= inv; g4.y *= inv; g4.z *= inv; g4.w *= inv;
    ((float4*)go)[i] = g4;
  }
}

DI void peer_token(int r, const bf16_t* __restrict__ hbuf, const int* __restrict__ experts, const float* __restrict__ gates,
                   const unsigned char* __restrict__ u8, const float* __restrict__ us, const unsigned char* __restrict__ v8,
                   const float* __restrict__ vs, const float* __restrict__ modv_l, float* __restrict__ xs, float* wdots  ,
                   float* __restrict__ outp = nullptr) {
  const int lane = TID & 63;
  float x[16];
  {
    const uint4* hr = (const uint4*)(hbuf + (size_t)r * D + lane * 16);
    uint4 a = hr[0], c = hr[1];
    x[0] = bflo(a.x); x[1] = bfhi(a.x); x[2] = bflo(a.y); x[3] = bfhi(a.y); x[4] = bflo(a.z); x[5] = bfhi(a.z); x[6] = bflo(a.w); x[7] = bfhi(a.w);
    x[8] = bflo(c.x); x[9] = bfhi(c.x); x[10] = bflo(c.y); x[11] = bfhi(c.y); x[12] = bflo(c.z); x[13] = bfhi(c.z); x[14] = bflo(c.w); x[15] = bfhi(c.w);
  }
  const int e0 = experts[(size_t)r * 128 + lane], e1 = experts[(size_t)r * 128 + 64 + lane];
  const float g0 = gates[(size_t)r * 128 + lane], g1 = gates[(size_t)r * 128 + 64 + lane];
  const float us0 = us[e0], us1 = us[e1], vs0 = vs[e0], vs1 = vs[e1];
#pragma unroll 1
  for (int k0 = 0; k0 < 128; k0 += 8) {
    uint4 rw[8];
#pragma unroll
    for (int j = 0; j < 8; ++j) {
      int k = k0 + j;
      int e = __builtin_amdgcn_readlane(k0 < 64 ? e0 : e1, k & 63);
      rw[j] = *(const uint4*)(u8 + (size_t)e * D + lane * 16);
    }
    float p[8];
#pragma unroll
    for (int j = 0; j < 8; ++j) {
      f32x2_t a0 = __builtin_amdgcn_cvt_pk_f32_fp8((int)rw[j].x, false), a1 = __builtin_amdgcn_cvt_pk_f32_fp8((int)rw[j].x, true);
      f32x2_t b0 = __builtin_amdgcn_cvt_pk_f32_fp8((int)rw[j].y, false), b1 = __builtin_amdgcn_cvt_pk_f32_fp8((int)rw[j].y, true);
      f32x2_t c0 = __builtin_amdgcn_cvt_pk_f32_fp8((int)rw[j].z, false), c1 = __builtin_amdgcn_cvt_pk_f32_fp8((int)rw[j].z, true);
      f32x2_t d0 = __builtin_amdgcn_cvt_pk_f32_fp8((int)rw[j].w, false), d1 = __builtin_amdgcn_cvt_pk_f32_fp8((int)rw[j].w, true);
      float s = a0[0] * x[0] + a0[1] * x[1] + a1[0] * x[2] + a1[1] * x[3];
      s += b0[0] * x[4] + b0[1] * x[5] + b1[0] * x[6] + b1[1] * x[7];
      s += c0[0] * x[8] + c0[1] * x[9] + c1[0] * x[10] + c1[1] * x[11];
      s += d0[0] * x[12] + d0[1] * x[13] + d1[0] * x[14] + d1[1] * x[15];
      p[j] = s;
    }
    const bool hi32 = lane & 32, hi16 = lane & 16, hi8 = lane & 8;
    float q4[4];
#pragma unroll
    for (int i = 0; i < 4; ++i) { float send = hi32 ? p[i] : p[4 + i]; float keep = hi32 ? p[4 + i] : p[i]; q4[i] = keep + shxl(send, lane, 32); }
    float q2[2];
#pragma unroll
    for (int i = 0; i < 2; ++i) { float send = hi16 ? q4[i] : q4[2 + i]; float keep = hi16 ? q4[2 + i] : q4[i]; q2[i] = keep + shxl(send, lane, 16); }
    float q1;
    { float send = hi8 ? q2[0] : q2[1]; float keep = hi8 ? q2[1] : q2[0]; q1 = keep + shxl(send, lane, 8); }
    q1 += shxl(q1, lane, 4); q1 += shxl(q1, lane, 2); q1 += shxl(q1, lane, 1);
    if ((lane & 7) == 0) wdots[k0 + (lane >> 3)] = q1;
  }
  float w0, w1;
  {
    float d0 = wdots[lane] * us0, d1 = wdots[64 + lane] * us1;
    float t0 = 0.5f * d0 * (1.f + tanhf(0.7978845608028654f * (d0 + 0.044715f * d0 * d0 * d0)));
    float t1 = 0.5f * d1 * (1.f + tanhf(0.7978845608028654f * (d1 + 0.044715f * d1 * d1 * d1)));
    w0 = g0 * t0 * vs0; w1 = g1 * t1 * vs1;
  }
  float acc[16];
#pragma unroll
  for (int i = 0; i < 16; ++i) acc[i] = 0.f;
#pragma unroll 1
  for (int k0 = 0; k0 < 128; k0 += 8) {
    uint4 rw[8];
#pragma unroll
    for (int j = 0; j < 8; ++j) {
      int k = k0 + j;
      int e = __builtin_amdgcn_readlane(k0 < 64 ? e0 : e1, k & 63);
      rw[j] = *(const uint4*)(v8 + (size_t)e * D + lane * 16);
    }
#pragma unroll
    for (int j = 0; j < 8; ++j) {
      int k = k0 + j;
      float w = __builtin_bit_cast(float, __builtin_amdgcn_readlane(__builtin_bit_cast(int, k0 < 64 ? w0 : w1), k & 63));
      f32x2_t a0 = __builtin_amdgcn_cvt_pk_f32_fp8((int)rw[j].x, false), a1 = __builtin_amdgcn_cvt_pk_f32_fp8((int)rw[j].x, true);
      f32x2_t b0 = __builtin_amdgcn_cvt_pk_f32_fp8((int)rw[j].y, false), b1 = __builtin_amdgcn_cvt_pk_f32_fp8((int)rw[j].y, true);
      f32x2_t c0 = __builtin_amdgcn_cvt_pk_f32_fp8((int)rw[j].z, false), c1 = __builtin_amdgcn_cvt_pk_f32_fp8((int)rw[j].z, true);
      f32x2_t d0 = __builtin_amdgcn_cvt_pk_f32_fp8((int)rw[j].w, false), d1 = __builtin_amdgcn_cvt_pk_f32_fp8((int)rw[j].w, true);
      acc[0] += w * a0[0]; acc[1] += w * a0[1]; acc[2] += w * a1[0]; acc[3] += w * a1[1];
      acc[4] += w * b0[0]; acc[5] += w * b0[1]; acc[6] += w * b1[0]; acc[7] += w * b1[1];
      acc[8] += w * c0[0]; acc[9] += w * c0[1]; acc[10] += w * c1[0]; acc[11] += w * c1[1];
      acc[12] += w * d0[0]; acc[13] += w * d0[1]; acc[14] += w * d1[0]; acc[15] += w * d1[1];
    }
  }
  const int b = r / NT, p = r % NT; const int mrow = p < CTX ? 2 : b;
  const float* g2 = modv_l + mrow * NMOD + 5 * D + lane * 16;
  float4* xp = (float4*)(xs + (size_t)r * D + lane * 16);
  float4* op = outp ? (float4*)(outp + ((size_t)b * SEQ + (p - CTX)) * D + lane * 16) : xp;
#pragma unroll
  for (int i = 0; i < 4; ++i) {
    float4 xv = xp[i]; float4 gg = ((const float4*)g2)[i];
    xv.x += gg.x * acc[4 * i]; xv.y += gg.y * acc[4 * i + 1]; xv.z += gg.z * acc[4 * i + 2]; xv.w += gg.w * acc[4 * i + 3];
    op[i] = xv;
  }
}

constexpr int FN = 2 * SEQ;
DI float2 cmul(float2 a, float2 b) { return make_float2(a.x * b.x - a.y * b.y, a.x * b.y + a.y * b.x); }
DI float2 cmulc(float2 a, float2 b) { return make_float2(a.x * b.x + a.y * b.y, a.y * b.x - a.x * b.y); }
DI int rev4_7(int x) {
  return ((x & 3) << 12) | ((x >> 12) & 3) | ((x & 0xC) << 8) | ((x >> 8) & 0xC) | ((x & 0x30) << 4) | ((x >> 4) & 0x30) | (x & 0xC0);
}
DI void fft_fwd(float2* X) {
  const int tid = TID;
#pragma unroll 1
  for (int p = 0; p < 7; ++p) {
    const int lq = 12 - 2 * p; const int q = 1 << lq;
    const float invL = 1.f / (float)(4 << lq);
    __syncthreads();
#pragma unroll 2
    for (int m = 0; m < 8; ++m) {
      const int i = tid + 512 * m;
      const int j = i & (q - 1); const int base = ((i >> lq) << (lq + 2)) + j;
      float2 a = X[base], b = X[base + q], c = X[base + 2 * q], d = X[base + 3 * q];
      float2 t0 = make_float2(a.x + c.x, a.y + c.y), t1 = make_float2(a.x - c.x, a.y - c.y);
      float2 t2 = make_float2(b.x + d.x, b.y + d.y), t3 = make_float2(b.y - d.y, d.x - b.x);
      float2 y0 = make_float2(t0.x + t2.x, t0.y + t2.y), y1 = make_float2(t1.x + t3.x, t1.y + t3.y);
      float2 y2 = make_float2(t0.x - t2.x, t0.y - t2.y), y3 = make_float2(t1.x - t3.x, t1.y - t3.y);
      const float fr = (float)j * invL;
      float2 w1 = make_float2(__builtin_amdgcn_cosf(fr), -__builtin_amdgcn_sinf(fr));
      float2 w2 = cmul(w1, w1), w3 = cmul(w2, w1);
      X[base] = y0; X[base + q] = cmul(y1, w1); X[base + 2 * q] = cmul(y2, w2); X[base + 3 * q] = cmul(y3, w3);
    }
  }
  __syncthreads();
}
DI void fft_inv(float2* X) {
  const int tid = TID;
#pragma unroll 1
  for (int p = 6; p >= 0; --p) {
    const int lq = 12 - 2 * p; const int q = 1 << lq;
    const float invL = 1.f / (float)(4 << lq);
    __syncthreads();
#pragma unroll 2
    for (int m = 0; m < 8; ++m) {
      const int i = tid + 512 * m;
      const int j = i & (q - 1); const int base = ((i >> lq) << (lq + 2)) + j;
      const float fr = (float)j * invL;
      float2 w1 = make_float2(__builtin_amdgcn_cosf(fr), -__builtin_amdgcn_sinf(fr));
      float2 w2 = cmul(w1, w1), w3 = cmul(w2, w1);
      float2 y0 = X[base], y1 = cmulc(X[base + q], w1), y2 = cmulc(X[base + 2 * q], w2), y3 = cmulc(X[base + 3 * q], w3);
      float2 t0 = make_float2(y0.x + y2.x, y0.y + y2.y), t1 = make_float2(y0.x - y2.x, y0.y - y2.y);
      float2 t2 = make_float2(y1.x + y3.x, y1.y + y3.y), t3 = make_float2(y3.y - y1.y, y1.x - y3.x);
      X[base] = make_float2(t0.x + t2.x, t0.y + t2.y);
      X[base + q] = make_float2(t1.x + t3.x, t1.y + t3.y);
      X[base + 2 * q] = make_float2(t0.x - t2.x, t0.y - t2.y);
      X[base + 3 * q] = make_float2(t1.x - t3.x, t1.y - t3.y);
    }
  }
  __syncthreads();
}
DI float block_sum_512(float v, float* red) {
  for (int o = 32; o > 0; o >>= 1) v += shx(v, o);
  __syncthreads();
  if ((TID & 63) == 0) red[TID >> 6] = v;
  __syncthreads();
  float s = 0.f;
  for (int i = 0; i < 8; ++i) s += red[i];
  return s;
}
DI void hyena_channel(int c, const float* __restrict__ hdn2, const float* __restrict__ w3, const float* __restrict__ b3,
                      const float* __restrict__ hy_bias, const float* __restrict__ uT, float* __restrict__ zT, float* __restrict__ yT,
                      float2* __restrict__ Hc_all, char* smem) {
  float2* X = (float2*)smem;
  float* red = (float*)(smem + 131072);
  float* wcol = red + 16;
  float2* Hc = Hc_all + (size_t)c * FN;
  const int tid = TID;
  __syncthreads();
  if (tid < 256) {
    int od = tid >> 6, i = tid & 63;
    wcol[od * 64 + i] = w3[i * 1024 + (od >> 1) * 512 + (od & 1) * 256 + c];
  }
  __syncthreads();
  const float delta = fabsf(-3.0701134573253944f + (float)c * ((-15.350567286626972f + 3.0701134573253944f) / 255.f));
  const float bb00 = b3[c], bb01 = b3[256 + c], bb10 = b3[512 + c], bb11 = b3[768 + c];
  float n0 = 0.f, n1 = 0.f;
#pragma unroll 1
  for (int j = tid; j < SEQ; j += 512) {
    asm volatile("" ::: "memory");
    const float4* hr = (const float4*)(hdn2 + (size_t)j * 64);
    float f00 = bb00, f01 = bb01, f10 = bb10, f11 = bb11;
#pragma unroll 4
    for (int i = 0; i < 16; ++i) {
      float4 hv = hr[i];
      const float* w0 = wcol + 4 * i;
      f00 += hv.x * w0[0] + hv.y * w0[1] + hv.z * w0[2] + hv.w * w0[3];
      f01 += hv.x * w0[64] + hv.y * w0[65] + hv.z * w0[66] + hv.w * w0[67];
      f10 += hv.x * w0[128] + hv.y * w0[129] + hv.z * w0[130] + hv.w * w0[131];
      f11 += hv.x * w0[192] + hv.y * w0[193] + hv.z * w0[194] + hv.w * w0[195];
    }
    const float dec = __expf(-((float)j / (float)(SEQ - 1)) * delta);
    f00 *= dec; f01 *= dec; f10 *= dec; f11 *= dec;
    X[j] = make_float2(f00, f10);
    n0 += fabsf(f00); n1 += fabsf(f10);
    if (j > 0) { X[FN - j] = make_float2(f01, f11); n0 += fabsf(f01); n1 += fabsf(f11); }
    else X[SEQ] = make_float2(0.f, 0.f);
  }
  n0 = block_sum_512(n0, red);
  n1 = block_sum_512(n1, red);
  const float s0 = 1.f / (n0 * (float)FN), s1 = 1.f / (n1 * (float)FN);
  fft_fwd(X);
  for (int i = tid; i < FN; i += 512) Hc[i] = X[i];
  const float* v0p = uT + ((size_t)0 * 768 + c) * NT + CTX;
  const float* v1p = uT + ((size_t)1 * 768 + c) * NT + CTX;
  __syncthreads();
  for (int t = tid; t < SEQ; t += 512) { X[t] = make_float2(v0p[t], v1p[t]); X[SEQ + t] = make_float2(0.f, 0.f); }
  fft_fwd(X);
  for (int pos = tid; pos < FN; pos += 512) {
    int f = rev4_7(pos); int pm = rev4_7((FN - f) & (FN - 1));
    float2 A = Hc[pos], Bm = Hc[pm];
    float2 K0 = make_float2((A.x + Bm.x) * 0.5f * s0, (A.y - Bm.y) * 0.5f * s0);
    X[pos] = cmul(X[pos], K0);
  }
  fft_inv(X);
  {
    const float bias0 = hy_bias[c];
    const float* x10 = v0p + (size_t)256 * NT; const float* x11 = v1p + (size_t)256 * NT;
    float* z0 = zT + ((size_t)0 * 256 + c) * NT + CTX; float* z1 = zT + ((size_t)1 * 256 + c) * NT + CTX;
    for (int t = tid; t < SEQ; t += 512) {
      float2 y = X[t];
      float za = x10[t] * (y.x + bias0 * v0p[t]);
      float zb = x11[t] * (y.y + bias0 * v1p[t]);
      z0[t] = za; z1[t] = zb;
      X[t] = make_float2(za, zb);
    }
    __syncthreads();
    for (int t = tid; t < SEQ; t += 512) X[SEQ + t] = make_float2(0.f, 0.f);
  }
  fft_fwd(X);
  for (int pos = tid; pos < FN; pos += 512) {
    int f = rev4_7(pos); int pm = rev4_7((FN - f) & (FN - 1));
    float2 A = Hc[pos], Bm = Hc[pm];
    float2 K1 = make_float2((A.y + Bm.y) * 0.5f * s1, -(A.x - Bm.x) * 0.5f * s1);
    X[pos] = cmul(X[pos], K1);
  }
  fft_inv(X);
  {
    const float bias1 = hy_bias[256 + c];
    const float* x20 = v0p + (size_t)512 * NT; const float* x21 = v1p + (size_t)512 * NT;
    const float* z0 = zT + ((size_t)0 * 256 + c) * NT + CTX; const float* z1 = zT + ((size_t)1 * 256 + c) * NT + CTX;
    float* y0 = yT + ((size_t)0 * 256 + c) * NT + CTX; float* y1 = yT + ((size_t)1 * 256 + c) * NT + CTX;
    for (int t = tid; t < SEQ; t += 512) {
      float2 y = X[t];
      y0[t] = x20[t] * (y.x + bias1 * z0[t]);
      y1[t] = x21[t] * (y.y + bias1 * z1[t]);
    }
  }
}

#define XB_TMO      128
#define XB_XCNT(j)  (256  + 64 * (j))
#define XB_XSUB(j)  (1280 + 64 * (j))
#define XB_XGEN(j)  (2304 + 64 * (j))
#define XB_TOP      3328
#define XB_TOPGEN   3392
#define XB_SPIN_CAP (1u << 22)
#define LAS __attribute__((address_space(3)))
DI unsigned xb_ld(unsigned* p) { return __hip_atomic_load(p, __ATOMIC_RELAXED, __HIP_MEMORY_SCOPE_AGENT); }
DI unsigned xb_add(unsigned* p, unsigned v) { return __hip_atomic_fetch_add(p, v, __ATOMIC_RELAXED, __HIP_MEMORY_SCOPE_AGENT); }
DI unsigned xb_xcc_id() { return (unsigned)__builtin_amdgcn_s_getreg((3 << 11) | 20) & 0xFu; }
#define XB_SPIN(cond, bar) do { unsigned _sp = 0; while (cond) { __builtin_amdgcn_s_sleep(1); \
    if ((++_sp & 255u) == 0u) { if (xb_ld(&(bar)[XB_TMO])) break; if (_sp > XB_SPIN_CAP) { atomicAdd(&(bar)[XB_TMO], 1u); break; } } } } while (0)
DI void xcd_barrier_post(unsigned* bar) {
  if (threadIdx.x == 0) (void)xb_add(&bar[XB_XCNT(xb_xcc_id())], 1u);
}
DI void xcd_barrier_complete(unsigned* bar, unsigned x, unsigned& nloc, unsigned& nx) {
  const unsigned G = gridDim.x;
  unsigned sum, cnt, mine, sp = 0u;
  for (;;) {
    sum = 0u; cnt = 0u; mine = 0u;
#pragma unroll
    for (unsigned j = 0; j < 16; ++j) { const unsigned c = xb_ld(&bar[XB_XCNT(j)]); sum += c; cnt += (c > 0u) ? 1u : 0u; mine = (j == x) ? c : mine; }
    if (sum == G) break;
    __builtin_amdgcn_s_sleep(1);
    if ((++sp & 255u) == 0u) { if (xb_ld(&bar[XB_TMO])) break; if (sp > XB_SPIN_CAP) { atomicAdd(&bar[XB_TMO], 1u); break; } }
  }
  nloc = mine > 0u ? mine : 1u; nx = cnt > 0u ? cnt : 1u;
}
DI void xcd_barrier(unsigned* bar, volatile LAS unsigned* st) {
  asm volatile("s_waitcnt vmcnt(0)" ::: "memory");
  __syncthreads();
  if (threadIdx.x == 0) {
    const unsigned x = xb_xcc_id();
    __builtin_amdgcn_s_waitcnt(0);
    unsigned nloc = st[0], nx = st[1];
    if (nloc == 0u) { xcd_barrier_complete(bar, x, nloc, nx); st[0] = nloc; st[1] = nx; }
    const unsigned old = xb_add(&bar[XB_XSUB(x)], 1u);
    const unsigned gen = old / nloc;
    if (old + 1u == (gen + 1u) * nloc) {
      __builtin_amdgcn_fence(__ATOMIC_RELEASE, "agent");
      asm volatile("s_waitcnt vmcnt(0)" ::: "memory");
      const unsigned og = xb_add(&bar[XB_TOP], 1u);
      const unsigned tg = og / nx;
      if (og + 1u == (tg + 1u) * nx) xb_add(&bar[XB_TOPGEN], 1u);
      else XB_SPIN(xb_ld(&bar[XB_TOPGEN]) == tg, bar);
      __builtin_amdgcn_fence(__ATOMIC_ACQUIRE, "agent");
      xb_add(&bar[XB_XGEN(x)], 1u);
      asm volatile("s_waitcnt vmcnt(0)" ::: "memory");
    } else {
      XB_SPIN(xb_ld(&bar[XB_XGEN(x)]) == gen, bar);
      __builtin_amdgcn_fence(__ATOMIC_ACQUIRE, "agent");
      asm volatile("s_waitcnt vmcnt(0)" ::: "memory");
    }
  }
  __syncthreads();
}

#define XCD_BAR_WORDS 3456
constexpr size_t al256(size_t x) { return (x + 255) & ~(size_t)255; }
constexpr size_t OFF_modv = 0;
constexpr size_t OFF_xs = al256(OFF_modv + (size_t)2 * 3 * NMOD * 4);
constexpr size_t OFF_hbuf = al256(OFF_xs + (size_t)R * D * 4);
constexpr size_t OFF_P = al256(OFF_hbuf + (size_t)R * D * 2);
constexpr size_t OFF_Wt_in = al256(OFF_P + (size_t)R * DIN * 2);
constexpr size_t OFF_Wt_out = al256(OFF_Wt_in + (size_t)2 * DIN * D * 2);
constexpr size_t OFF_Wt_q = al256(OFF_Wt_out + (size_t)2 * D * D * 2);
constexpr size_t OFF_QA = al256(OFF_Wt_q + (size_t)2 * 2048 * D * 2);
constexpr size_t OFF_KA = al256(OFF_QA + (size_t)NB * 8 * NT * 32 * 2);
constexpr size_t OFF_VAt = al256(OFF_KA + (size_t)NB * 8 * NT * 32 * 2);
constexpr size_t OFF_QW = al256(OFF_VAt + (size_t)NB * 4 * 64 * NT * 2);
constexpr size_t OFF_KW = al256(OFF_QW + (size_t)NB * 4 * NT * 64 * 2);
constexpr size_t OFF_VWt = al256(OFF_KW + (size_t)NB * 2 * NT * 64 * 2);
constexpr size_t OFF_QG = al256(OFF_VWt + (size_t)NB * 2 * 64 * NT * 2);
constexpr size_t OFF_KG = al256(OFF_QG + (size_t)NB * 4 * NT * 64 * 2);
constexpr size_t OFF_VGt = al256(OFF_KG + (size_t)NB * 2 * NT * 64 * 2);
constexpr size_t OFF_uT = al256(OFF_VGt + (size_t)NB * 2 * 64 * NT * 2);
constexpr size_t OFF_zT = al256(OFF_uT + (size_t)NB * 768 * NT * 4);
constexpr size_t OFF_yT = al256(OFF_zT + (size_t)NB * 256 * NT * 4);
constexpr size_t OFF_hdn2 = al256(OFF_yT + (size_t)NB * 256 * NT * 4);
constexpr size_t OFF_Hc = al256(OFF_hdn2 + (size_t)2 * NT * 64 * 4);
constexpr size_t OFF_A2 = al256(OFF_Hc + (size_t)256 * 2 * SEQ * 8);
constexpr size_t OFF_u8 = al256(OFF_A2 + (size_t)R * D * 2);
constexpr size_t OFF_v8 = al256(OFF_u8 + (size_t)2 * 16384 * D);
constexpr size_t OFF_us = al256(OFF_v8 + (size_t)2 * 16384 * D);
constexpr size_t OFF_vs = al256(OFF_us + (size_t)2 * 16384 * 4);
constexpr size_t OFF_keysb = al256(OFF_vs + (size_t)2 * 16384 * 4);
constexpr size_t OFF_bar = al256(OFF_keysb + (size_t)2 * 16 * 128 * 128 * 2);
constexpr size_t WS_TOTAL = al256(OFF_bar + (size_t)XCD_BAR_WORDS * 4);
constexpr size_t OFF_topv = OFF_uT;
constexpr size_t OFF_topi = OFF_topv + (size_t)R * 256 * 4;
constexpr size_t OFF_experts = OFF_topi + (size_t)R * 256;
constexpr size_t OFF_gates = OFF_experts + (size_t)R * 128 * 4;
constexpr size_t OFF_Oslab = OFF_P;
constexpr size_t OFF_Lslab = OFF_Oslab + (size_t)2 * NB * 4 * NT * 64 * 4;
static_assert(OFF_gates + (size_t)R * 128 * 4 <= OFF_zT, "routing buffers overflow uT");
static_assert(OFF_Lslab + (size_t)2 * NB * 4 * NT * 4 <= OFF_Wt_in, "slabs overflow P");

struct MKView;
struct MK {
  const float *x, *c, *ctx, *c_ctx, *w_mod, *b_mod, *g_norm_mix, *w_in, *g_qk_diff, *lambda_diff, *g_qk_win, *sink_win, *g_qk_glob, *hy_conv_w,
      *hy_conv_b, *hy_w1, *hy_b1, *hy_w2, *hy_b2, *hy_w3, *hy_b3, *hy_freq, *hy_bias, *g_mix_out, *w_out, *g_norm_ffn, *peer_wq, *peer_keys,
      *peer_u, *peer_v;
  float* out;
  char* ws;
};
constexpr int SMEM_BYTES = 131072 + 2048;
typedef const MK __attribute__((address_space(4))) * MKP;
DI MK launder_mk(MKP a) {
  asm volatile("" : "+s"(a));
  MK r;
  r.x = a->x; r.c = a->c; r.ctx = a->ctx; r.c_ctx = a->c_ctx; r.w_mod = a->w_mod; r.b_mod = a->b_mod;
  r.g_norm_mix = a->g_norm_mix; r.w_in = a->w_in; r.g_qk_diff = a->g_qk_diff; r.lambda_diff = a->lambda_diff;
  r.g_qk_win = a->g_qk_win; r.sink_win = a->sink_win; r.g_qk_glob = a->g_qk_glob; r.hy_conv_w = a->hy_conv_w;
  r.hy_conv_b = a->hy_conv_b; r.hy_w1 = a->hy_w1; r.hy_b1 = a->hy_b1; r.hy_w2 = a->hy_w2; r.hy_b2 = a->hy_b2;
  r.hy_w3 = a->hy_w3; r.hy_b3 = a->hy_b3; r.hy_freq = a->hy_freq; r.hy_bias = a->hy_bias; r.g_mix_out = a->g_mix_out;
  r.w_out = a->w_out; r.g_norm_ffn = a->g_norm_ffn; r.peer_wq = a->peer_wq; r.peer_keys = a->peer_keys;
  r.peer_u = a->peer_u; r.peer_v = a->peer_v; r.out = a->out; r.ws = a->ws;
  return r;
}

DI void ph_mod_item(const MK& m, int item, char* smem) {
  float* sc = (float*)smem;
  float* part = sc + 3 * D;
  const int tid = TID;
  const int l = item / 24, chunk = item % 24;
  __syncthreads();
  for (int i = tid; i < 3 * D; i += NTHR) {
    int row = i / D, k = i % D;
    float v = row < 2 ? m.c[row * D + k] : m.c_ctx[k];
    sc[i] = v / (1.f + __expf(-v));
  }
  __syncthreads();
  const int cl = tid & 255, kh = tid >> 8;
  const int col = chunk * 256 + cl;
  const float* w = m.w_mod + (size_t)l * D * NMOD + (size_t)(kh * 512) * NMOD + col;
  float a0 = 0, a1 = 0, a2 = 0;
  for (int k = 0; k < 512; ++k) {
    float wv = w[(size_t)k * NMOD];
    a0 += sc[kh * 512 + k] * wv; a1 += sc[D + kh * 512 + k] * wv; a2 += sc[2 * D + kh * 512 + k] * wv;
  }
  if (kh == 1) { part[cl] = a0; part[256 + cl] = a1; part[512 + cl] = a2; }
  __syncthreads();
  if (kh == 0) {
    float bb = m.b_mod[l * NMOD + col];
    ((float*)(m.ws + OFF_modv))[(l * 3 + 0) * NMOD + col] = a0 + part[cl] + bb;
    ((float*)(m.ws + OFF_modv))[(l * 3 + 1) * NMOD + col] = a1 + part[256 + cl] + bb;
    ((float*)(m.ws + OFF_modv))[(l * 3 + 2) * NMOD + col] = a2 + part[512 + cl] + bb;
  }
}
DI void ph_hymlp_group(const MK& m, int g, char* smem) {
  const int tid = TID, wv = tid >> 6, u = tid & 63;
  float* feat = (float*)smem + wv * 128;
  float* h1 = feat + 64;
  const int gi = g * 8 + wv;
  const int l = gi / NT, pos = gi % NT;
  const int which = pos >= SEQ ? 1 : 0;
  const int j = which ? pos - SEQ : pos;
  const int n = which ? CTX : SEQ;
  const float tt = (float)j / (float)(n - 1);
  const float w = (6.283185307179586f / (float)n) * (float)j;
  __syncthreads();
  if (u == 0) feat[0] = tt;
  if (u < 16) {
    float f = 1e-4f + (float)u * ((15.f - 1e-4f) / 15.f);
    feat[1 + u] = cosf(f * w);
    feat[17 + u] = -sinf(f * w);
  }
  __syncthreads();
  const float* w1 = m.hy_w1 + l * 33 * 64; const float* w2 = m.hy_w2 + l * 64 * 64;
  const float fq = m.hy_freq[l * 64 + u];
  float a = m.hy_b1[l * 64 + u];
  for (int i = 0; i < 33; ++i) a += feat[i] * w1[i * 64 + u];
  h1[u] = sinf(fq * a);
  __syncthreads();
  float a2 = m.hy_b2[l * 64 + u];
  for (int i = 0; i < 64; ++i) a2 += h1[i] * w2[i * 64 + u];
  ((float*)(m.ws + OFF_hdn2))[((size_t)l * NT + pos) * 64 + u] = sinf(fq * a2);
}
DI void phase0(MKP m_in, char* smem) {
  const MK m = launder_mk(m_in);
  const int bid = BID, nb = NBLK, tid = TID;
  {
    const int gw = bid * 8 + (tid >> 6), nw = nb * 8;
    for (int row = gw; row < 4 * 16384; row += nw) {
      int tbl = row >> 14, rr = row & 16383;
      int l = tbl >> 1;
      if (tbl & 1) tabconv_row(m.peer_v + (size_t)l * 16384 * D, ((unsigned char*)(m.ws + OFF_v8)) + (size_t)l * 16384 * D, ((float*)(m.ws + OFF_vs)) + l * 16384, (size_t)rr);
      else tabconv_row(m.peer_u + (size_t)l * 16384 * D, ((unsigned char*)(m.ws + OFF_u8)) + (size_t)l * 16384 * D, ((float*)(m.ws + OFF_us)) + l * 16384, (size_t)rr);
    }
  }
  for (int it = bid; it < 48; it += nb) ph_mod_item(m, it, smem);
  for (int g = bid; g < 2 * NT / 8; g += nb) ph_hymlp_group(m, g, smem);
  for (int t = bid; t < 2 * 1408; t += nb) {
    int l = t / 1408, tt = t % 1408;
    if (tt < 640) wconv_tile(m.w_in + (size_t)l * D * DIN, ((bf16_t*)(m.ws + OFF_Wt_in)) + (size_t)l * DIN * D, DIN, tt, (float*)smem);
    else if (tt < 896) wconv_tile(m.w_out + (size_t)l * D * D, ((bf16_t*)(m.ws + OFF_Wt_out)) + (size_t)l * D * D, D, tt - 640, (float*)smem);
    else wconv_tile(m.peer_wq + (size_t)l * D * 2048, ((bf16_t*)(m.ws + OFF_Wt_q)) + (size_t)l * 2048 * D, 2048, tt - 896, (float*)smem);
  }
  for (int i = bid * NTHR + tid; i < 2 * 16 * 128 * 128 / 4; i += nb * NTHR) {
    float4 v = ((const float4*)m.peer_keys)[i];
    ((uint2*)((bf16_t*)(m.ws + OFF_keysb)))[i] = make_uint2(pk2bf(v.x, v.y), pk2bf(v.z, v.w));
  }
}

DI void phase_norm(MKP m_in, int l, int which  , bool first, bool skip_ctx) {
  const MK m = launder_mk(m_in);
  const int tid = TID, lane = tid & 63;
  const int gw = BID * 8 + (tid >> 6), nw = NBLK * 8;
  const float* g = (which ? m.g_norm_ffn : m.g_norm_mix) + l * D;
  const float* modv_l = ((float*)(m.ws + OFF_modv)) + (size_t)l * 3 * NMOD;
  for (int r = gw; r < R; r += nw) {
    const int b = r / NT, p = r % NT;
    if (skip_ctx && p < CTX) continue;
    const int mrow = p < CTX ? 2 : b;
    const float4* src = (const float4*)(first ? (p < CTX ? m.ctx + ((size_t)b * CTX + p) * D : m.x + ((size_t)b * SEQ + (p - CTX)) * D)
                                              : ((float*)(m.ws + OFF_xs)) + (size_t)r * D);
    float4 v[4];
    float ss = 0.f;
#pragma unroll
    for (int i = 0; i < 4; ++i) { v[i] = src[lane + 64 * i]; ss += v[i].x * v[i].x + v[i].y * v[i].y + v[i].z * v[i].z + v[i].w * v[i].w; }
    for (int o = 32; o > 0; o >>= 1) ss += shxl(ss, lane, o);
    const float rs = rsqrtf(ss * (1.f / D) + EPS);
    const float* sh = modv_l + mrow * NMOD + (which ? 3 : 0) * D;
    const float* sc = sh + D;
#pragma unroll
    for (int i = 0; i < 4; ++i) {
      const int c0 = (lane + 64 * i) * 4;
      float4 gg = *(const float4*)(g + c0), s4 = *(const float4*)(sc + c0), h4 = *(const float4*)(sh + c0);
      float o0 = v[i].x * rs * gg.x * (1.f + s4.x) + h4.x, o1 = v[i].y * rs * gg.y * (1.f + s4.y) + h4.y;
      float o2 = v[i].z * rs * gg.z * (1.f + s4.z) + h4.z, o3 = v[i].w * rs * gg.w * (1.f + s4.w) + h4.w;
      *(uint2*)(((bf16_t*)(m.ws + OFF_hbuf)) + (size_t)r * D + c0) = make_uint2(pk2bf(o0, o1), pk2bf(o2, o3));
      if (first) ((float4*)(((float*)(m.ws + OFF_xs)) + (size_t)r * D))[lane + 64 * i] = v[i];
    }
  }
}

DI int rowtile_of(int i, bool latent_only) { return latent_only ? (i / 64) * 66 + 2 + (i % 64) : i; }
template <int EPI>
DI void phase_gemm(const bf16_t* A, const bf16_t* Wt, int N, bf16_t* Cb, float* xs, const float* gate_base, bool latent_only, char* smem) {
  const int nt_n = N / 128, nrt = latent_only ? 128 : 132, ntiles = nrt * nt_n;
  for (int t = BID; t < ntiles; t += NBLK) {
    int tm = rowtile_of(t / nt_n, latent_only), tn = t % nt_n;
    gemm_tile<EPI>(A, Wt, N, tm * 128, tn * 128, smem, Cb, xs, gate_base);
  }
}

DI void rope_pair8(float (&y)[8], const float (&part)[8], bool upper, const float* cs, const float* sn, int dd0) {
#pragma unroll
  for (int e = 0; e < 8; ++e) {
    float c = cs[dd0 + e], s = sn[dd0 + e];
    float x1 = upper ? part[e] : y[e], x2 = upper ? y[e] : part[e];
    y[e] = upper ? (x1 * s + x2 * c) : (x1 * c - x2 * s);
  }
}
DI void unpack8(uint4 w, float (&v)[8]) {
  v[0] = bflo(w.x); v[1] = bfhi(w.x); v[2] = bflo(w.y); v[3] = bfhi(w.y); v[4] = bflo(w.z); v[5] = bfhi(w.z); v[6] = bflo(w.w); v[7] = bfhi(w.w);
}
DI uint4 pack8(const float (&v)[8], float sc) {
  return make_uint4(pk2bf(v[0] * sc, v[1] * sc), pk2bf(v[2] * sc, v[3] * sc), pk2bf(v[4] * sc, v[5] * sc), pk2bf(v[6] * sc, v[7] * sc));
}
constexpr int VS_STRIDE = 1032;
constexpr int HS_STRIDE = 1536;
DI void prep_tile(MKP m_in, int l, int tile, char* smem) {
  const MK m = launder_mk(m_in);
  const int tid = TID, lane = tid & 63, wid = tid >> 6;
  const int r0 = tile * 32; const int b = r0 / NT, p0 = r0 % NT;
  const bool lat = p0 >= CTX;
  char* Vs = smem;
  char* Hs = smem + 33280;
  float* csh = (float*)(smem + 33280 + 52224);
  const bf16_t* Pb = ((bf16_t*)(m.ws + OFF_P)) + (size_t)(b * NT) * DIN;
  __syncthreads();
  if (lat) {
    for (int i = tid; i < 32 * 48; i += NTHR) {
      int rr = i / 48, a = i % 48;
      int t = p0 + rr - CTX;
      float trow = (float)(t / 64), tcol = (float)(t % 64);
      float* rowp = csh + rr * 96;
      if (a < 16) {
        int j = a & 7; float f = exp2f(-(float)j * (13.287712379549449f / 8.f));
        float ang = (a < 8 ? trow : tcol) * f;
        rowp[a] = cosf(ang); rowp[16 + a] = sinf(ang);
      } else {
        int aa = a - 16; int j = aa & 15; float f = exp2f(-(float)j * (13.287712379549449f / 16.f));
        float ang = (aa < 16 ? trow : tcol) * f;
        rowp[32 + aa] = cosf(ang); rowp[64 + aa] = sinf(ang);
      }
    }
  }
  {
    const int seg_lo = lat ? CTX : 0, seg_hi = lat ? NT : CTX;
    for (int ch = tid; ch < 34 * 96; ch += NTHR) {
      int rr = ch / 96, c8 = ch % 96;
      int p = p0 - 1 + rr;
      uint4 v = make_uint4(0, 0, 0, 0);
      if (p >= seg_lo && p < seg_hi) v = *(const uint4*)(Pb + (size_t)p * DIN + 1792 + c8 * 8);
      *(uint4*)(Hs + rr * HS_STRIDE + c8 * 16) = v;
    }
  }
  __syncthreads();
  const float* gd = m.g_qk_diff + l * 64; const float* gwn = m.g_qk_win + l * 128; const float* gg = m.g_qk_glob + l * 128;
#pragma unroll 1
  for (int k = 0; k < 4; ++k) {
    const int rr = wid + 8 * k; const int p = p0 + rr;
    const bf16_t* Pr = Pb + (size_t)p * DIN;
    const float* rowp = csh + rr * 96;
    {
      float y[8], part[8];
      unpack8(*(const uint4*)(Pr + 8 * lane), y);
      float ss = 0.f;
#pragma unroll
      for (int e = 0; e < 8; ++e) ss += y[e] * y[e];
      ss += shxl(ss, lane, 1); ss += shxl(ss, lane, 2);
      const float rs = rsqrtf(ss * (1.f / 32) + EPS);
      const int unit = lane >> 2; const bool isk = unit >= 8; const int vh = unit & 7;
      const int d0 = (lane & 3) * 8;
      const float* gn = gd + (isk ? 32 : 0) + d0;
#pragma unroll
      for (int e = 0; e < 8; ++e) y[e] = y[e] * rs * gn[e];
      if (lat) {
#pragma unroll
        for (int e = 0; e < 8; ++e) part[e] = shxl(y[e], lane, 2);
        rope_pair8(y, part, (lane & 2) != 0, rowp, rowp + 16, (lane & 1) * 8);
      }
      bf16_t* dst = (isk ? ((bf16_t*)(m.ws + OFF_KA)) : ((bf16_t*)(m.ws + OFF_QA))) + (((size_t)b * 8 + vh) * NT + p) * 32 + d0;
      *(uint4*)dst = pack8(y, isk ? 1.f : 0.17677669529663687f * LOG2E);
    }
#pragma unroll
    for (int grp = 0; grp < 2; ++grp) {
      float y[8], part[8];
      const int cbase = grp == 0 ? 768 : 1280;
      uint4 w = make_uint4(0, 0, 0, 0);
      if (lane < 48) w = *(const uint4*)(Pr + cbase + 8 * lane);
      unpack8(w, y);
      float ss = 0.f;
#pragma unroll
      for (int e = 0; e < 8; ++e) ss += y[e] * y[e];
      ss += shxl(ss, lane, 1); ss += shxl(ss, lane, 2); ss += shxl(ss, lane, 4);
      const float rs = rsqrtf(ss * (1.f / 64) + EPS);
      const int unit = lane >> 3; const bool isk = unit >= 4; const int hh = isk ? unit - 4 : unit;
      const int d0 = (lane & 7) * 8;
      const float* gn = (grp == 0 ? gwn : gg) + (isk ? 64 : 0) + d0;
      if (lane < 48) {
#pragma unroll
        for (int e = 0; e < 8; ++e) y[e] = y[e] * rs * gn[e];
      }
      if (lat) {
#pragma unroll
        for (int e = 0; e < 8; ++e) part[e] = shxl(y[e], lane, 4);
        rope_pair8(y, part, (lane & 4) != 0, rowp + 32, rowp + 64, (lane & 3) * 8);
      }
      if (lane < 48) {
        bf16_t* base = grp == 0 ? (isk ? ((bf16_t*)(m.ws + OFF_KW)) : ((bf16_t*)(m.ws + OFF_QW))) : (isk ? ((bf16_t*)(m.ws + OFF_KG)) : ((bf16_t*)(m.ws + OFF_QG)));
        bf16_t* dst = base + (((size_t)b * (isk ? 2 : 4) + hh) * NT + p) * 64 + d0;
        *(uint4*)dst = pack8(y, isk ? 1.f : 0.125f * LOG2E);
      }
    }
    {
      const int vsrc = lane < 32 ? 512 + 8 * lane : (lane < 48 ? 1152 + 8 * (lane - 32) : 1664 + 8 * (lane - 48));
      uint4 w = *(const uint4*)(Pr + vsrc);
      *(uint2*)(Vs + rr * VS_STRIDE + lane * 16) = make_uint2(w.x, w.y);
      *(uint2*)(Vs + rr * VS_STRIDE + lane * 16 + 8) = make_uint2(w.z, w.w);
    }
  }
  __syncthreads();
  for (int tk = tid; tk < 2048; tk += NTHR) {
    const int pg = tk & 3; const int vch = (tk >> 2) & 15 | ((tk >> 6) << 4);
    unsigned short e[8];
#pragma unroll
    for (int i = 0; i < 8; ++i) {
      int sidx = 8 * pg + i;
      int pl = (sidx & 16) | perm16(sidx & 15);
      e[i] = *(const unsigned short*)(Vs + pl * VS_STRIDE + vch * 2);
    }
    uint4 w = make_uint4(e[0] | ((unsigned)e[1] << 16), e[2] | ((unsigned)e[3] << 16), e[4] | ((unsigned)e[5] << 16), e[6] | ((unsigned)e[7] << 16));
    bf16_t* dst;
    if (vch < 256) dst = ((bf16_t*)(m.ws + OFF_VAt)) + (((size_t)b * 4 + (vch >> 6)) * 64 + (vch & 63)) * NT;
    else if (vch < 384) dst = ((bf16_t*)(m.ws + OFF_VWt)) + (((size_t)b * 2 + ((vch - 256) >> 6)) * 64 + (vch & 63)) * NT;
    else dst = ((bf16_t*)(m.ws + OFF_VGt)) + (((size_t)b * 2 + ((vch - 384) >> 6)) * 64 + (vch & 63)) * NT;
    *(uint4*)(dst + p0 + 8 * pg) = w;
  }
  {
    const float* cw = m.hy_conv_w + l * 3 * 768; const float* cb = m.hy_conv_b + l * 768;
    for (int c = tid; c < 768; c += NTHR) {
      const float w0 = cw[c], w1 = cw[768 + c], w2 = cw[1536 + c], bb = cb[c];
      float* dst = ((float*)(m.ws + OFF_uT)) + ((size_t)b * 768 + c) * NT + p0;
      float prev = bf2f(*(const bf16_t*)(Hs + 0 * HS_STRIDE + c * 2));
      float cur = bf2f(*(const bf16_t*)(Hs + 1 * HS_STRIDE + c * 2));
#pragma unroll 1
      for (int pg = 0; pg < 8; ++pg) {
        float o[4];
#pragma unroll
        for (int i = 0; i < 4; ++i) {
          float nxt = bf2f(*(const bf16_t*)(Hs + (4 * pg + i + 2) * HS_STRIDE + c * 2));
          o[i] = prev * w0 + cur * w1 + nxt * w2 + bb;
          prev = cur; cur = nxt;
        }
        *(float4*)(dst + 4 * pg) = make_float4(o[0], o[1], o[2], o[3]);
      }
    }
  }
}

DI void hyena_ctx_channel(MKP m_in, int l, int c, char* smem) {
  const MK m = launder_mk(m_in);
  float* kf = (float*)smem;
  float* vz = kf + 1024;
  float* red = vz + 512;
  float* wcol = red + 16;
  const int tid = TID;
  const float* hd = ((float*)(m.ws + OFF_hdn2)) + ((size_t)l * NT + SEQ) * 64;
  const float* w3 = m.hy_w3 + (size_t)l * 64 * 1024; const float* b3 = m.hy_b3 + l * 1024;
  __syncthreads();
  if (tid < 256) { int od = tid >> 6, i = tid & 63; wcol[od * 64 + i] = w3[i * 1024 + (od >> 1) * 512 + (od & 1) * 256 + c]; }
  __syncthreads();
  const float delta = fabsf(-3.0701134573253944f + (float)c * ((-15.350567286626972f + 3.0701134573253944f) / 255.f));
  float n0 = 0.f, n1 = 0.f;
  if (tid < 256) {
    const int j = tid;
    float f00 = b3[c], f01 = b3[256 + c], f10 = b3[512 + c], f11 = b3[768 + c];
    for (int i = 0; i < 64; ++i) {
      float hv = hd[j * 64 + i];
      f00 += hv * wcol[i]; f01 += hv * wcol[64 + i]; f10 += hv * wcol[128 + i]; f11 += hv * wcol[192 + i];
    }
    const float dec = __expf(-((float)j / (float)(CTX - 1)) * delta);
    f00 *= dec; f01 *= dec; f10 *= dec; f11 *= dec;
    kf[256 + j] = f00; kf[512 + 256 + j] = f10; n0 += fabsf(f00); n1 += fabsf(f10);
    if (j > 0) { kf[256 - j] = f01; kf[512 + 256 - j] = f11; n0 += fabsf(f01); n1 += fabsf(f11); }
    else { kf[0] = 0.f; kf[512] = 0.f; }
  }
  n0 = block_sum_512(n0, red);
  n1 = block_sum_512(n1, red);
  const float i0 = 1.f / n0, i1 = 1.f / n1;
  const int bb = tid >> 8, t = tid & 255;
  const float* ub = ((float*)(m.ws + OFF_uT)) + ((size_t)bb * 768 + c) * NT;
  const float vself = ub[t];
  vz[bb * 256 + t] = vself;
  __syncthreads();
  float acc = 0.f;
  for (int s2 = 0; s2 < 256; ++s2) acc += vz[bb * 256 + s2] * kf[256 + t - s2];
  const float z = ub[(size_t)256 * NT + t] * (acc * i0 + m.hy_bias[l * 512 + c] * vself);
  __syncthreads();
  vz[bb * 256 + t] = z;
  __syncthreads();
  float acc2 = 0.f;
  for (int s2 = 0; s2 < 256; ++s2) acc2 += vz[bb * 256 + s2] * kf[512 + 256 + t - s2];
  ((float*)(m.ws + OFF_yT))[((size_t)bb * 256 + c) * NT + t] = ub[(size_t)512 * NT + t] * (acc2 * i1 + m.hy_bias[l * 512 + 256 + c] * z);
}

DI void phase_mix(MKP m_in, int l, bool want_ctx, char* smem) {
  const MK m = launder_mk(m_in);
  AttnArgs a;
  a.QA = ((bf16_t*)(m.ws + OFF_QA)); a.KA = ((bf16_t*)(m.ws + OFF_KA)); a.VAt = ((bf16_t*)(m.ws + OFF_VAt)); a.QW = ((bf16_t*)(m.ws + OFF_QW)); a.KW = ((bf16_t*)(m.ws + OFF_KW)); a.VWt = ((bf16_t*)(m.ws + OFF_VWt)); a.QG = ((bf16_t*)(m.ws + OFF_QG)); a.KG = ((bf16_t*)(m.ws + OFF_KG)); a.VGt = ((bf16_t*)(m.ws + OFF_VGt));
  a.g_qk_diff = m.g_qk_diff + l * 64; a.g_qk_win = m.g_qk_win + l * 128; a.g_qk_glob = m.g_qk_glob + l * 128; a.sink = m.sink_win + l * 4;
  a.lambda_diff = m.lambda_diff + l * 128; a.g_mix_out = m.g_mix_out + l * D; a.lambda_init = 0.8f - 0.6f * __expf(-0.3f * (float)l); a.pad0 = 0;
  a.A2 = ((bf16_t*)(m.ws + OFF_A2)); a.Oslab = ((float*)(m.ws + OFF_Oslab)); a.Lslab = ((float*)(m.ws + OFF_Lslab));
  const int nitems = 640 + (want_ctx ? 20 : 0);
  for (int idx = BID; idx < 512; idx += NBLK) attn_dispatch(a, idx, want_ctx, smem);
  for (int c = BID; c < 256; c += NBLK) {
    hyena_channel(c, ((float*)(m.ws + OFF_hdn2)) + (size_t)l * NT * 64, m.hy_w3 + (size_t)l * 64 * 1024, m.hy_b3 + l * 1024, m.hy_bias + l * 512, ((float*)(m.ws + OFF_uT)), ((float*)(m.ws + OFF_zT)), ((float*)(m.ws + OFF_yT)),
                  ((float2*)(m.ws + OFF_Hc)), smem);
    if (want_ctx) hyena_ctx_channel(m_in, l, c, smem);
  }
  for (int idx = 512 + BID; idx < nitems; idx += NBLK) attn_dispatch(a, idx, want_ctx, smem);
}

DI void phase_fin(MKP m_in, int l, bool want_ctx) {
  const MK m = launder_mk(m_in);
  const float* gmo = m.g_mix_out + l * D;
  for (int idx = BID * NTHR + TID; idx < NB * 8 * NT; idx += NBLK * NTHR) {
    const int p = idx % NT; const int hd = (idx / NT) % 8; const int b = idx / (NT * 8);
    if (p < CTX && !want_ctx) continue;
    float o[64]; float ss = 0.f;
    if (hd < 4) {
      size_t i0 = (((size_t)0 * NB + b) * 4 + hd) * NT + p, i1 = (((size_t)1 * NB + b) * 4 + hd) * NT + p;
      const float inv = 1.f / (((float*)(m.ws + OFF_Lslab))[i0] + ((float*)(m.ws + OFF_Lslab))[i1]);
      const float4* a0 = (const float4*)(((float*)(m.ws + OFF_Oslab)) + i0 * 64); const float4* a1 = (const float4*)(((float*)(m.ws + OFF_Oslab)) + i1 * 64);
#pragma unroll
      for (int i = 0; i < 16; ++i) {
        float4 x = a0[i], y = a1[i];
        o[4 * i] = (x.x + y.x) * inv; o[4 * i + 1] = (x.y + y.y) * inv; o[4 * i + 2] = (x.z + y.z) * inv; o[4 * i + 3] = (x.w + y.w) * inv;
      }
    } else {
      const int g = hd - 4;
#pragma unroll
      for (int i = 0; i < 64; ++i) o[i] = ((float*)(m.ws + OFF_yT))[((size_t)b * 256 + g * 64 + i) * NT + p];
    }
#pragma unroll
    for (int i = 0; i < 64; ++i) ss += o[i] * o[i];
    const float rs = rsqrtf(ss * (1.f / 64) + EPS);
    const float* gm = gmo + 512 + hd * 64;
    uint4* dst = (uint4*)(((bf16_t*)(m.ws + OFF_A2)) + ((size_t)b * NT + p) * D + 512 + hd * 64);
#pragma unroll
    for (int i = 0; i < 8; ++i)
      dst[i] = make_uint4(pk2bf(o[8 * i] * rs * gm[8 * i], o[8 * i + 1] * rs * gm[8 * i + 1]), pk2bf(o[8 * i + 2] * rs * gm[8 * i + 2], o[8 * i + 3] * rs * gm[8 * i + 3]),
                          pk2bf(o[8 * i + 4] * rs * gm[8 * i + 4], o[8 * i + 5] * rs * gm[8 * i + 5]), pk2bf(o[8 * i + 6] * rs * gm[8 * i + 6], o[8 * i + 7] * rs * gm[8 * i + 7]));
  }
}

DI void phase_peer(MKP m_in, int l, bool want_ctx, bool last, char* smem) {
  const MK m = launder_mk(m_in);
  float* wd = (float*)smem + (TID >> 6) * 128;
  const float* modv_l = ((float*)(m.ws + OFF_modv)) + (size_t)l * 3 * NMOD;
  for (int r = BID * 8 + (TID >> 6); r < R; r += NBLK * 8) {
    if ((r % NT) < CTX && !want_ctx) continue;
    peer_token(r, ((bf16_t*)(m.ws + OFF_hbuf)), ((int*)(m.ws + OFF_experts)), ((float*)(m.ws + OFF_gates)), ((unsigned char*)(m.ws + OFF_u8)) + (size_t)l * 16384 * D, ((float*)(m.ws + OFF_us)) + l * 16384, ((unsigned char*)(m.ws + OFF_v8)) + (size_t)l * 16384 * D, ((float*)(m.ws + OFF_vs)) + l * 16384,
               modv_l, ((float*)(m.ws + OFF_xs)), wd, last ? m.out : nullptr);
  }
}

DI void phase_scores(MKP m_in, int l, bool last, char* smem) {
  const MK m = launder_mk(m_in);
  const int nrt = last ? 128 : 132;
  for (int t = BID; t < nrt * 16; t += NBLK)
    score_tile(((bf16_t*)(m.ws + OFF_P)), ((bf16_t*)(m.ws + OFF_keysb)) + (size_t)l * 16 * 128 * 128, rowtile_of(t >> 4, last) * 128, t & 15, smem,
               ((float*)(m.ws + OFF_topv)), ((unsigned char*)(m.ws + OFF_topi)));
}
DI void phase_merge(MKP m_in, bool want_ctx) {
  const MK m = launder_mk(m_in);
  for (int idx = BID * NTHR + TID; idx < R * 8; idx += NBLK * NTHR) {
    int r = idx >> 3;
    if ((r % NT) < CTX && !want_ctx) continue;
    merge_one(((float*)(m.ws + OFF_topv)), ((unsigned char*)(m.ws + OFF_topi)), r, idx & 7, ((int*)(m.ws + OFF_experts)), ((float*)(m.ws + OFF_gates)));
  }
}
DI void phase_gemm1(MKP m_in, int l, char* smem) {
  const MK m = launder_mk(m_in);
  phase_gemm<0>((bf16_t*)(m.ws + OFF_hbuf), (bf16_t*)(m.ws + OFF_Wt_in) + (size_t)l * DIN * D, DIN, (bf16_t*)(m.ws + OFF_P), nullptr, nullptr, false, smem);
}
DI void phase_gemm2(MKP m_in, int l, bool last, char* smem) {
  const MK m = launder_mk(m_in);
  phase_gemm<1>((bf16_t*)(m.ws + OFF_A2), (bf16_t*)(m.ws + OFF_Wt_out) + (size_t)l * D * D, D, nullptr, (float*)(m.ws + OFF_xs),
                (float*)(m.ws + OFF_modv) + (size_t)l * 3 * NMOD + 2 * D, last, smem);
}
DI void phase_gemm3(MKP m_in, int l, bool last, char* smem) {
  const MK m = launder_mk(m_in);
  phase_gemm<0>((bf16_t*)(m.ws + OFF_hbuf), (bf16_t*)(m.ws + OFF_Wt_q) + (size_t)l * 2048 * D, 2048, (bf16_t*)(m.ws + OFF_P), nullptr, nullptr, last, smem);
}
#define GSYNC() xcd_barrier((unsigned*)(launder_mk(m).ws + OFF_bar), (volatile LAS unsigned*)(smem + SMEM_BYTES))
template <int L>
DI void layer_body(MKP m, char* smem) {
  constexpr bool want_ctx = L == 0, last = L == 1;
  phase_norm(m, L, 0, L == 0, false);
  GSYNC();
  phase_gemm1(m, L, smem);
  GSYNC();
  for (int t = BID; t < R / 32; t += NBLK) prep_tile(m, L, t, smem);
  GSYNC();
  phase_mix(m, L, want_ctx, smem);
  GSYNC();
  phase_fin(m, L, want_ctx);
  GSYNC();
  phase_gemm2(m, L, last, smem);
  GSYNC();
  phase_norm(m, L, 1, false, last);
  GSYNC();
  phase_gemm3(m, L, last, smem);
  GSYNC();
  phase_scores(m, L, last, smem);
  GSYNC();
  phase_merge(m, want_ctx);
  GSYNC();
  phase_peer(m, L, want_ctx, last, smem);
  if (!last) GSYNC();
}
__global__ __launch_bounds__(NTHR) void k_mega(MK m_unused) {
  extern __shared__ __attribute__((aligned(16))) char smem[];
  (void)m_unused;
  MKP m = (MKP)__builtin_amdgcn_kernarg_segment_ptr();
  {
    volatile LAS unsigned* st = (volatile LAS unsigned*)(smem + SMEM_BYTES);
    if (threadIdx.x == 0) { st[0] = 0u; st[1] = 0u; st[2] = 0u; st[3] = 0u; }
    __syncthreads();
    xcd_barrier_post((unsigned*)(launder_mk(m).ws + OFF_bar));
  }
  phase0(m, smem);
  GSYNC();
  layer_body<0>(m, smem);
  layer_body<1>(m, smem);
}

extern "C" void kernel_launch(void* const* d_in, const int* in_sizes, int n_in, void* d_out, int out_size, void* d_ws, size_t ws_size,
                              hipStream_t stream) {
  (void)in_sizes; (void)n_in; (void)out_size;
  MK m;
  memset(&m, 0, sizeof(m));
  const float** ip = (const float**)&m.x;
  for (int i = 0; i < 30; ++i) ip[i] = (const float*)d_in[i];
  m.out = (float*)d_out;
  m.ws = (char*)d_ws;
  if (WS_TOTAL > ws_size) return;

  static int grid_blocks = 0;
  if (!grid_blocks) {
    (void)hipFuncSetAttribute((const void*)k_mega, hipFuncAttributeMaxDynamicSharedMemorySize, SMEM_BYTES + 16);
    int dev = 0, cus = 0, per_cu = 0;
    (void)hipGetDevice(&dev);
    (void)hipDeviceGetAttribute(&cus, hipDeviceAttributeMultiprocessorCount, dev);
    (void)hipOccupancyMaxActiveBlocksPerMultiprocessor(&per_cu, k_mega, NTHR, SMEM_BYTES + 16);
    if (per_cu > 1) per_cu = 1;
    grid_blocks = cus * per_cu;
  }
  (void)hipMemsetAsync(m.ws + OFF_bar, 0, (size_t)XCD_BAR_WORDS * 4, stream);
  void* args[] = {&m};
  (void)hipLaunchCooperativeKernel((void*)k_mega, dim3(grid_blocks), dim3(NTHR), args, SMEM_BYTES + 16, stream);
}
```

```cpp
#include <hip/hip_runtime.h>
#ifndef REP_DIFF
#define REP_DIFF 1
#endif
#ifndef REP_GLOB
#define REP_GLOB 1
#endif
#ifndef REP_HY
#define REP_HY 1
#endif
#ifndef REP_NORM1
#define REP_NORM1 1
#endif
#ifndef REP_GEMM1
#define REP_GEMM1 1
#endif
#ifndef REP_PREP
#define REP_PREP 1
#endif
#ifndef REP_MIX
#define REP_MIX 1
#endif
#ifndef REP_FIN
#define REP_FIN 1
#endif
#ifndef REP_NORM2
#define REP_NORM2 1
#endif
#ifndef REP_GEMM3
#define REP_GEMM3 1
#endif
#ifndef REP_SCORES
#define REP_SCORES 1
#endif
#ifndef REP_MERGE
#define REP_MERGE 1
#endif
#ifndef REP_PEER_LAST
#define REP_PEER_LAST 1
#endif
#ifndef REP_P0
#define REP_P0 1
#endif
#include <hip/hip_cooperative_groups.h>
namespace cg = cooperative_groups;
#include <stdint.h>
#include <string.h>

#define DI __device__ __forceinline__
typedef unsigned short bf16_t;

constexpr int D = 1024;
constexpr int NB = 2;
constexpr int SEQ = 8192;
constexpr int CTX = 256;
constexpr int NT = SEQ + CTX;
constexpr int R = NB * NT;
constexpr int DIN = 2560;
constexpr int NMOD = 6 * D;
constexpr float EPS = 1e-6f;
constexpr float LOG2E = 1.4426950408889634f;

DI int opq_v(int x) { asm volatile("" : "+v"(x)); return x; }
DI int opq_s(int x) { asm volatile("" : "+s"(x)); return x; }
template <class T> DI T* opq_p(T* p) { asm volatile("" : "+s"(p)); return p; }
#define TID opq_v((int)threadIdx.x)
#define BID opq_s((int)blockIdx.x)
#define NBLK opq_s((int)gridDim.x)
DI float shxl(float v, int lane, int mask) { return __builtin_bit_cast(float, __builtin_amdgcn_ds_bpermute((lane ^ mask) << 2, __builtin_bit_cast(int, v))); }
DI int shxl(int v, int lane, int mask) { return __builtin_amdgcn_ds_bpermute((lane ^ mask) << 2, v); }
DI float shx(float v, int mask) { return shxl(v, opq_v((int)threadIdx.x) & 63, mask); }
DI bf16_t f2bf(float x) { unsigned u = __float_as_uint(x); u += 0x7fffu + ((u >> 16) & 1u); return (bf16_t)(u >> 16); }
DI float bf2f(bf16_t h) { return __uint_as_float(((unsigned)h) << 16); }
DI float bflo(unsigned w) { return __uint_as_float(w << 16); }
DI float bfhi(unsigned w) { return __uint_as_float(w & 0xffff0000u); }

DI float block_sum_256(float v, float* red) {
  for (int o = 32; o > 0; o >>= 1) v += shx(v, o);
  int w = TID >> 6;
  __syncthreads();
  if ((TID & 63) == 0) red[w] = v;
  __syncthreads();
  float s = red[0] + red[1] + red[2] + red[3];
  return s;
}

DI int perm16(int o) { return (o & 3) | ((o & 4) << 1) | ((o & 8) >> 1); }

typedef __attribute__((ext_vector_type(8))) short bf16x8;
typedef __attribute__((ext_vector_type(16))) float f32x16;
typedef __attribute__((ext_vector_type(2))) __bf16 bf16x2_t;
typedef __attribute__((ext_vector_type(2))) float f32x2_t;
#define MFMA32(a, b, c) __builtin_amdgcn_mfma_f32_32x32x16_bf16((a), (b), (c), 0, 0, 0)
DI unsigned pk2bf(float a, float b) { f32x2_t v = {a, b}; return __builtin_bit_cast(unsigned, __builtin_convertvector(v, bf16x2_t)); }
constexpr int NTHR = 512;

DI void wconv_tile(const float* __restrict__ W, bf16_t* __restrict__ Wt, int N, int tile, float* sm  ) {
  int tn = tile % (N / 64), tk = tile / (N / 64);
  int tid = TID;
  __syncthreads();
  for (int i = tid; i < 64 * 16; i += NTHR) {
    int kr = i >> 4, c4 = (i & 15) * 4;
    float4 v = *(const float4*)(W + (size_t)(tk * 64 + kr) * N + tn * 64 + c4);
    sm[kr * 65 + c4] = v.x; sm[kr * 65 + c4 + 1] = v.y; sm[kr * 65 + c4 + 2] = v.z; sm[kr * 65 + c4 + 3] = v.w;
  }
  __syncthreads();
  for (int i = tid; i < 64 * 8; i += NTHR) {
    int n = i >> 3, k8 = (i & 7) * 8;
    unsigned w[4];
    for (int j = 0; j < 4; ++j) w[j] = pk2bf(sm[(k8 + 2 * j) * 65 + n], sm[(k8 + 2 * j + 1) * 65 + n]);
    *(uint4*)(Wt + (size_t)(tn * 64 + n) * D + tk * 64 + k8) = make_uint4(w[0], w[1], w[2], w[3]);
  }
}

template <int EPI>
DI void gemm_tile(const bf16_t* __restrict__ A, const bf16_t* __restrict__ Wt, int N, int m0, int n0, char* smem, bf16_t* __restrict__ Cb,
                  float* __restrict__ xs, const float* __restrict__ gate_base) {
  constexpr int K = D;
  const int tid = TID, lane = tid & 63, wid = tid >> 6;
  const int wm = wid & 1, wn = wid >> 1;
  const int r = lane & 31, h = lane >> 5;
  f32x16 acc0, acc1;
  for (int i = 0; i < 16; ++i) { acc0[i] = 0.f; acc1[i] = 0.f; }
  const int lrow = tid >> 3, lch = tid & 7;
  const bf16_t* Ag = A + (size_t)(m0 + lrow) * K + lch * 8;
  const bf16_t* Bg = Wt + (size_t)(n0 + lrow) * K + lch * 8;
  const int woff = lrow * 128 + ((lch ^ ((lrow >> 1) & 7)) << 4);
  uint4 ra0, ra1, rb0, rb1;
  ra0 = *(const uint4*)(Ag); ra1 = *(const uint4*)(Ag + (size_t)64 * K);
  rb0 = *(const uint4*)(Bg); rb1 = *(const uint4*)(Bg + (size_t)64 * K);
  __syncthreads();
  *(uint4*)(smem + woff) = ra0; *(uint4*)(smem + woff + 8192) = ra1;
  *(uint4*)(smem + 16384 + woff) = rb0; *(uint4*)(smem + 16384 + woff + 8192) = rb1;
  __syncthreads();
  const int sw = (r >> 1) & 7;
  const int aoff0 = (wm * 64 + r) * 128, aoff1 = aoff0 + 32 * 128;
  const int boff = 16384 + (wn * 32 + r) * 128;
#pragma unroll 1
  for (int kt = 0; kt < K / 64; ++kt) {
    const char* st = smem + (kt & 1) * 32768;
    if (kt + 1 < K / 64) {
      ra0 = *(const uint4*)(Ag + (kt + 1) * 64); ra1 = *(const uint4*)(Ag + (size_t)64 * K + (kt + 1) * 64);
      rb0 = *(const uint4*)(Bg + (kt + 1) * 64); rb1 = *(const uint4*)(Bg + (size_t)64 * K + (kt + 1) * 64);
    }
#pragma unroll
    for (int s = 0; s < 4; ++s) {
      int co = ((2 * s + h) ^ sw) << 4;
      bf16x8 a0 = *(const bf16x8*)(st + aoff0 + co);
      bf16x8 a1 = *(const bf16x8*)(st + aoff1 + co);
      bf16x8 b = *(const bf16x8*)(st + boff + co);
      acc0 = MFMA32(a0, b, acc0);
      acc1 = MFMA32(a1, b, acc1);
    }
    if (kt + 1 < K / 64) {
      char* sn = smem + ((kt + 1) & 1) * 32768;
      *(uint4*)(sn + woff) = ra0; *(uint4*)(sn + woff + 8192) = ra1;
      *(uint4*)(sn + 16384 + woff) = rb0; *(uint4*)(sn + 16384 + woff + 8192) = rb1;
    }
    __syncthreads();
  }
  float* Cs = (float*)smem;
  constexpr int CS = 132;
#pragma unroll
  for (int i = 0; i < 16; ++i) {
    int row = (i & 3) + 8 * (i >> 2) + 4 * h;
    Cs[(wm * 64 + row) * CS + wn * 32 + r] = acc0[i];
    Cs[(wm * 64 + 32 + row) * CS + wn * 32 + r] = acc1[i];
  }
  __syncthreads();
  if (EPI == 0) {
    for (int i = tid; i < 128 * 16; i += NTHR) {
      int row = i >> 4, c8 = (i & 15) * 8;
      const float* cr = Cs + row * CS + c8;
      float4 v0 = *(const float4*)cr, v1 = *(const float4*)(cr + 4);
      *(uint4*)(Cb + (size_t)(m0 + row) * N + n0 + c8) = make_uint4(pk2bf(v0.x, v0.y), pk2bf(v0.z, v0.w), pk2bf(v1.x, v1.y), pk2bf(v1.z, v1.w));
    }
  } else {
    for (int i = tid; i < 128 * 32; i += NTHR) {
      int row = i >> 5, c4 = (i & 31) * 4;
      int rr = m0 + row; int b = rr / NT, p = rr % NT; int mrow = p < CTX ? 2 : b;
      const float* gt = gate_base + mrow * NMOD + n0 + c4;
      float4 v = *(const float4*)(Cs + row * CS + c4);
      float4 xv = *(float4*)(xs + (size_t)rr * D + n0 + c4);
      xv.x += gt[0] * v.x; xv.y += gt[1] * v.y; xv.z += gt[2] * v.z; xv.w += gt[3] * v.w;
      *(float4*)(xs + (size_t)rr * D + n0 + c4) = xv;
    }
  }
}


struct AttnArgs {
  const bf16_t *QA, *KA, *VAt, *QW, *KW, *VWt, *QG, *KG, *VGt;
  const float *g_qk_diff, *g_qk_win, *g_qk_glob, *sink, *lambda_diff, *g_mix_out;
  float lambda_init;
  int pad0;
  bf16_t* A2;
  float* Oslab;
  float* Lslab;
};

template <int TYPE>
DI void attn_item(const AttnArgs& a, int b, int g, int p0, int ctx0, int nctx, int lat0, int nkt, int half, char* smem) {
  constexpr int DQK = TYPE == 0 ? 32 : 64;
  constexpr int KS = DQK / 16;
  const int tid = TID, lane = tid & 63, wid = tid >> 6;
  const int r = lane & 31, h = lane >> 5;
  const bf16_t *Q0, *Q1, *K0, *K1, *Vt;
  const float* gqk;
  if (TYPE == 0) {
    Q0 = a.QA + ((size_t)b * 8 + 2 * g) * NT * 32; Q1 = Q0 + (size_t)NT * 32;
    K0 = a.KA + ((size_t)b * 8 + 2 * g) * NT * 32; K1 = K0 + (size_t)NT * 32;
    Vt = a.VAt + ((size_t)b * 4 + g) * 64 * NT; gqk = a.g_qk_diff;
  } else if (TYPE == 1) {
    Q0 = a.QW + ((size_t)b * 4 + 2 * g) * NT * 64; Q1 = Q0 + (size_t)NT * 64;
    K0 = a.KW + ((size_t)b * 2 + g) * NT * 64; K1 = K0;
    Vt = a.VWt + ((size_t)b * 2 + g) * 64 * NT; gqk = a.g_qk_win;
  } else {
    Q0 = a.QG + ((size_t)b * 4 + 2 * g) * NT * 64; Q1 = Q0 + (size_t)NT * 64;
    K0 = a.KG + ((size_t)b * 2 + g) * NT * 64; K1 = K0;
    Vt = a.VGt + ((size_t)b * 2 + g) * 64 * NT; gqk = a.g_qk_glob;
  }
  (void)gqk;
  const int qpos = p0 + wid * 32 + r;
  bf16x8 qf0[KS], qf1[KS];
#pragma unroll
  for (int s = 0; s < KS; ++s) {
    qf0[s] = *(const bf16x8*)(Q0 + (size_t)qpos * DQK + 16 * s + 8 * h);
    qf1[s] = *(const bf16x8*)(Q1 + (size_t)qpos * DQK + 16 * s + 8 * h);
  }
  f32x16 O00, O01, O10, O11, Zero;
#pragma unroll
  for (int i = 0; i < 16; ++i) { O00[i] = 0.f; O01[i] = 0.f; O10[i] = 0.f; O11[i] = 0.f; Zero[i] = 0.f; }
  float l0 = 0.f, l1 = 0.f;

  uint4 st0, st1, st2, st3;
  auto tile_of = [&](int it) { return it < nctx ? ctx0 + it : lat0 + it - nctx; };
  const int vrow0 = tid >> 4, vch = tid & 15;
#define ATT_GLOAD(kt_)                                                                                   \
  {                                                                                                      \
    const int kt__ = (kt_);                                                                              \
    if (TYPE == 0) {                                                                                     \
      st0 = *(const uint4*)(K0 + (size_t)kt__ * 128 * 32 + tid * 8);                                     \
      st1 = *(const uint4*)(K1 + (size_t)kt__ * 128 * 32 + tid * 8);                                     \
    } else {                                                                                             \
      st0 = *(const uint4*)(K0 + (size_t)kt__ * 128 * 64 + tid * 8);                                     \
      st1 = *(const uint4*)(K0 + (size_t)kt__ * 128 * 64 + (tid + 512) * 8);                             \
    }                                                                                                    \
    st2 = *(const uint4*)(Vt + (size_t)vrow0 * NT + kt__ * 128 + vch * 8);                               \
    st3 = *(const uint4*)(Vt + (size_t)(vrow0 + 32) * NT + kt__ * 128 + vch * 8);                        \
  }
#define ATT_SSTORE(sb_)                                                                                  \
  {                                                                                                      \
    char* sb__ = (sb_);                                                                                  \
    if (TYPE == 0) {                                                                                     \
      int row = tid >> 2, ch = tid & 3;                                                                  \
      int off = row * 64 + ((ch ^ ((row >> 2) & 3)) << 4);                                               \
      *(uint4*)(sb__ + off) = st0;                                                                       \
      *(uint4*)(sb__ + 8192 + off) = st1;                                                                \
    } else {                                                                                             \
      int row = tid >> 3, ch = tid & 7;                                                                  \
      int off = row * 128 + ((ch ^ ((row >> 1) & 7)) << 4);                                              \
      *(uint4*)(sb__ + off) = st0;                                                                       \
      *(uint4*)(sb__ + off + 8192) = st1;                                                                \
    }                                                                                                    \
    int voff = 16384 + vrow0 * 256 + ((vch ^ (vrow0 & 15)) << 4);                                        \
    *(uint4*)(sb__ + voff) = st2;                                                                        \
    *(uint4*)(sb__ + voff + 8192) = st3;                                                                 \
  }
  ATT_GLOAD(tile_of(0));
  __syncthreads();
  ATT_SSTORE(smem);
  __syncthreads();
  const int qwave = p0 + wid * 32;
#pragma unroll 1
  for (int it = 0; it < nkt; ++it) {
    const int kt = tile_of(it);
    const char* sb = smem + (it & 1) * 32768;
    if (it + 1 < nkt) ATT_GLOAD(tile_of(it + 1));
#pragma unroll 1
    for (int j = 0; j < 4; ++j) {
      const int kbase = kt * 128 + 32 * j;
      bool masked = false;
      if (TYPE == 1) {
        if (kbase >= CTX && p0 >= CTX) {
          if (kbase > qwave + 31 + 128 || kbase + 31 < qwave - 128) continue;
          masked = true;
        }
      }
      f32x16 S0 = Zero, S1 = Zero;
#pragma unroll
      for (int s = 0; s < KS; ++s) {
        if (TYPE == 0) {
          int row = 32 * j + r;
          int off = row * 64 + (((2 * s + h) ^ ((row >> 2) & 3)) << 4);
          bf16x8 k0 = *(const bf16x8*)(sb + off);
          bf16x8 k1 = *(const bf16x8*)(sb + 8192 + off);
          S0 = MFMA32(k0, qf0[s], S0);
          S1 = MFMA32(k1, qf1[s], S1);
        } else {
          int row = 32 * j + r;
          int off = row * 128 + (((2 * s + h) ^ ((row >> 1) & 7)) << 4);
          bf16x8 k0 = *(const bf16x8*)(sb + off);
          S0 = MFMA32(k0, qf0[s], S0);
          S1 = MFMA32(k0, qf1[s], S1);
        }
      }
      float pa[16], pb[16];
#pragma unroll
      for (int i = 0; i < 16; ++i) {
        float e0 = __builtin_amdgcn_exp2f(S0[i]);
        float e1 = __builtin_amdgcn_exp2f(S1[i]);
        if (TYPE == 1) {
          if (masked) {
            int kp = kbase + (i & 3) + 8 * (i >> 2) + 4 * h;
            int dd = kp - qpos;
            bool ok = (dd <= 128) && (dd >= -128);
            e0 = ok ? e0 : 0.f; e1 = ok ? e1 : 0.f;
          }
        }
        pa[i] = e0; pb[i] = e1;
      }
      l0 += ((pa[0] + pa[1]) + (pa[2] + pa[3])) + ((pa[4] + pa[5]) + (pa[6] + pa[7])) + ((pa[8] + pa[9]) + (pa[10] + pa[11])) + ((pa[12] + pa[13]) + (pa[14] + pa[15]));
      l1 += ((pb[0] + pb[1]) + (pb[2] + pb[3])) + ((pb[4] + pb[5]) + (pb[6] + pb[7])) + ((pb[8] + pb[9]) + (pb[10] + pb[11])) + ((pb[12] + pb[13]) + (pb[14] + pb[15]));
      bf16x8 pf0[2], pf1[2];
#pragma unroll
      for (int s2 = 0; s2 < 2; ++s2) {
        unsigned w0[4], w1[4];
#pragma unroll
        for (int e = 0; e < 4; ++e) {
          w0[e] = pk2bf(pa[8 * s2 + 2 * e], pa[8 * s2 + 2 * e + 1]);
          w1[e] = pk2bf(pb[8 * s2 + 2 * e], pb[8 * s2 + 2 * e + 1]);
        }
        pf0[s2] = __builtin_bit_cast(bf16x8, make_uint4(w0[0], w0[1], w0[2], w0[3]));
        pf1[s2] = __builtin_bit_cast(bf16x8, make_uint4(w1[0], w1[1], w1[2], w1[3]));
      }
#pragma unroll
      for (int s2 = 0; s2 < 2; ++s2) {
        int ch = 4 * j + 2 * s2 + h;
        bf16x8 v0 = *(const bf16x8*)(sb + 16384 + r * 256 + ((ch ^ (r & 15)) << 4));
        bf16x8 v1 = *(const bf16x8*)(sb + 16384 + (32 + r) * 256 + ((ch ^ (r & 15)) << 4));
        O00 = MFMA32(v0, pf0[s2], O00);
        O01 = MFMA32(v1, pf0[s2], O01);
        O10 = MFMA32(v0, pf1[s2], O10);
        O11 = MFMA32(v1, pf1[s2], O11);
      }
    }
    if (it + 1 < nkt) ATT_SSTORE(smem + ((it + 1) & 1) * 32768);
    __syncthreads();
  }
  l0 += shxl(l0, lane, 32);
  l1 += shxl(l1, lane, 32);
  if (TYPE == 1) {
    l0 += __builtin_amdgcn_exp2f(a.sink[2 * g] * LOG2E);
    l1 += __builtin_amdgcn_exp2f(a.sink[2 * g + 1] * LOG2E);
  }
  const size_t orow = (size_t)b * NT + qpos;
  if (TYPE == 2) {
#pragma unroll
    for (int x = 0; x < 2; ++x) {
      int head = 2 * g + x;
      float* dst = a.Oslab + ((((size_t)half * NB + b) * 4 + head) * NT + qpos) * 64;
#pragma unroll
      for (int dt = 0; dt < 2; ++dt) {
        const f32x16& O = x == 0 ? (dt == 0 ? O00 : O01) : (dt == 0 ? O10 : O11);
#pragma unroll
        for (int q4 = 0; q4 < 4; ++q4)
          *(float4*)(dst + 32 * dt + 8 * q4 + 4 * h) = make_float4(O[4 * q4], O[4 * q4 + 1], O[4 * q4 + 2], O[4 * q4 + 3]);
      }
      if (h == 0) a.Lslab[(((size_t)half * NB + b) * 4 + head) * NT + qpos] = x == 0 ? l0 : l1;
    }
  } else if (TYPE == 0) {
    float s0 = 0.f, s1 = 0.f;
    for (int d = 0; d < 32; ++d) { s0 += a.lambda_diff[d] * a.lambda_diff[32 + d]; s1 += a.lambda_diff[64 + d] * a.lambda_diff[96 + d]; }
    const float lam = __expf(s0) - __expf(s1) + a.lambda_init;
    const float i0 = 1.f / l0, i1 = lam / l1;
    float o[32];
    float ss = 0.f;
#pragma unroll
    for (int i = 0; i < 16; ++i) {
      o[i] = O00[i] * i0 - O10[i] * i1;
      o[16 + i] = O01[i] * i0 - O11[i] * i1;
      ss += o[i] * o[i] + o[16 + i] * o[16 + i];
    }
    ss += shxl(ss, lane, 32);
    const float rs = rsqrtf(ss * (1.f / 64) + EPS) * (1.f - a.lambda_init);
    const float* gm = a.g_mix_out + g * 64;
    bf16_t* dst = a.A2 + orow * D + g * 64;
#pragma unroll
    for (int dt = 0; dt < 2; ++dt)
#pragma unroll
      for (int q4 = 0; q4 < 4; ++q4) {
        int dv = 32 * dt + 8 * q4 + 4 * h;
        const float* ov = o + 16 * dt + 4 * q4;
        uint2 w;
        w.x = pk2bf(ov[0] * rs * gm[dv], ov[1] * rs * gm[dv + 1]);
        w.y = pk2bf(ov[2] * rs * gm[dv + 2], ov[3] * rs * gm[dv + 3]);
        *(uint2*)(dst + dv) = w;
      }
  } else {
#pragma unroll
    for (int x = 0; x < 2; ++x) {
      const float inv = 1.f / (x == 0 ? l0 : l1);
      float o[32];
      float ss = 0.f;
#pragma unroll
      for (int i = 0; i < 16; ++i) {
        o[i] = (x == 0 ? O00[i] : O10[i]) * inv;
        o[16 + i] = (x == 0 ? O01[i] : O11[i]) * inv;
        ss += o[i] * o[i] + o[16 + i] * o[16 + i];
      }
      ss += shxl(ss, lane, 32);
      const float rs = rsqrtf(ss * (1.f / 64) + EPS);
      const int col0 = 256 + (2 * g + x) * 64;
      const float* gm = a.g_mix_out + col0;
      bf16_t* dst = a.A2 + orow * D + col0;
#pragma unroll
      for (int dt = 0; dt < 2; ++dt)
#pragma unroll
        for (int q4 = 0; q4 < 4; ++q4) {
          int dv = 32 * dt + 8 * q4 + 4 * h;
          const float* ov = o + 16 * dt + 4 * q4;
          uint2 w;
          w.x = pk2bf(ov[0] * rs * gm[dv], ov[1] * rs * gm[dv + 1]);
          w.y = pk2bf(ov[2] * rs * gm[dv + 2], ov[3] * rs * gm[dv + 3]);
          *(uint2*)(dst + dv) = w;
        }
    }
  }
}

DI void attn_dispatch(const AttnArgs& a, int idx, int want_ctx, char* smem) {
  if (idx < 256) {
    int b = idx >> 7, g = (idx >> 5) & 3, qt = 1 + (idx & 31);
    attn_item<0>(a, b, g, qt * 256, 0, 2, 2, 66, 0, smem);
  } else if (idx < 512) {
    int i = idx - 256; int half = i >> 7, b = (i >> 6) & 1, g = (i >> 5) & 1, qt = 1 + (i & 31);
    if (half == 0) attn_item<2>(a, b, g, qt * 256, 0, 2, 2, 33, 0, smem);
    else attn_item<2>(a, b, g, qt * 256, 0, 0, 33, 33, 1, smem);
  } else if (idx < 640) {
    int i = idx - 512; int b = i >> 6, g = (i >> 5) & 1, qt = 1 + (i & 31);
    int lo = max(2, 2 * qt - 1), hi = min(65, 2 * qt + 2);
    attn_item<1>(a, b, g, qt * 256, 0, 2, lo, 2 + (hi - lo + 1), 0, smem);
  } else if (want_ctx) {
    int i = idx - 640;
    if (i < 8) attn_item<0>(a, i >> 2, i & 3, 0, 0, 2, 0, 2, 0, smem);
    else if (i < 16) { int k = i - 8; int half = k >> 2, b = (k >> 1) & 1, g = k & 1; attn_item<2>(a, b, g, 0, half, 1, 0, 1, half, smem); }
    else if (i < 20) { int k = i - 16; attn_item<1>(a, k >> 1, k & 1, 0, 0, 2, 0, 2, 0, smem); }
  }
}

typedef __attribute__((ext_vector_type(4))) float f32x4v;
DI void tabconv_row(const float* __restrict__ src, unsigned char* __restrict__ dst, float* __restrict__ scale, size_t row) {
  const int lane = TID & 63;
  const float4* sp = (const float4*)(src + row * D + lane * 16);
  float4 v0 = sp[0], v1 = sp[1], v2 = sp[2], v3 = sp[3];
  float m = fmaxf(fmaxf(fmaxf(fabsf(v0.x), fabsf(v0.y)), fmaxf(fabsf(v0.z), fabsf(v0.w))), fmaxf(fmaxf(fabsf(v1.x), fabsf(v1.y)), fmaxf(fabsf(v1.z), fabsf(v1.w))));
  m = fmaxf(m, fmaxf(fmaxf(fmaxf(fabsf(v2.x), fabsf(v2.y)), fmaxf(fabsf(v2.z), fabsf(v2.w))), fmaxf(fmaxf(fabsf(v3.x), fabsf(v3.y)), fmaxf(fabsf(v3.z), fabsf(v3.w)))));
  for (int o = 32; o > 0; o >>= 1) m = fmaxf(m, shxl(m, lane, o));
  m = fmaxf(m, 1e-30f);
  const float sc = m * (1.f / 448.f), inv = 448.f / m;
  int w0 = __builtin_amdgcn_cvt_pk_fp8_f32(v0.x * inv, v0.y * inv, 0, false); w0 = __builtin_amdgcn_cvt_pk_fp8_f32(v0.z * inv, v0.w * inv, w0, true);
  int w1 = __builtin_amdgcn_cvt_pk_fp8_f32(v1.x * inv, v1.y * inv, 0, false); w1 = __builtin_amdgcn_cvt_pk_fp8_f32(v1.z * inv, v1.w * inv, w1, true);
  int w2 = __builtin_amdgcn_cvt_pk_fp8_f32(v2.x * inv, v2.y * inv, 0, false); w2 = __builtin_amdgcn_cvt_pk_fp8_f32(v2.z * inv, v2.w * inv, w2, true);
  int w3 = __builtin_amdgcn_cvt_pk_fp8_f32(v3.x * inv, v3.y * inv, 0, false); w3 = __builtin_amdgcn_cvt_pk_fp8_f32(v3.z * inv, v3.w * inv, w3, true);
  *(uint4*)(dst + row * D + lane * 16) = make_uint4((unsigned)w0, (unsigned)w1, (unsigned)w2, (unsigned)w3);
  if (lane == 0) scale[row] = sc;
}

DI void score_tile(const bf16_t* __restrict__ qbuf, const bf16_t* __restrict__ keysb, int m0, int hp, char* smem, unsigned* __restrict__ topk) {
  const int tid = TID, lane = tid & 63, wid = tid >> 6;
  const int wm = wid & 1, wn = wid >> 1;
  const int r = lane & 31, h = lane >> 5;
  f32x16 acc0, acc1;
  for (int i = 0; i < 16; ++i) { acc0[i] = 0.f; acc1[i] = 0.f; }
  const int lrow = tid >> 3, lch = tid & 7;
  const bf16_t* Ag = qbuf + (size_t)(m0 + lrow) * 2048 + hp * 128 + lch * 8;
  const bf16_t* Bg = keysb + ((size_t)hp * 128 + lrow) * 128 + lch * 8;
  const int woff = lrow * 128 + ((lch ^ ((lrow >> 1) & 7)) << 4);
  __syncthreads();
#pragma unroll
  for (int kt = 0; kt < 2; ++kt) {
    char* sn = smem + kt * 32768;
    *(uint4*)(sn + woff) = *(const uint4*)(Ag + kt * 64);
    *(uint4*)(sn + woff + 8192) = *(const uint4*)(Ag + (size_t)64 * 2048 + kt * 64);
    *(uint4*)(sn + 16384 + woff) = *(const uint4*)(Bg + kt * 64);
    *(uint4*)(sn + 16384 + woff + 8192) = *(const uint4*)(Bg + 64 * 128 + kt * 64);
  }
  __syncthreads();
  const int sw = (r >> 1) & 7;
  const int aoff0 = (wm * 64 + r) * 128, aoff1 = aoff0 + 32 * 128;
  const int boff = 16384 + (wn * 32 + r) * 128;
#pragma unroll
  for (int kt = 0; kt < 2; ++kt) {
    const char* st = smem + kt * 32768;
#pragma unroll
    for (int s = 0; s < 4; ++s) {
      int co = ((2 * s + h) ^ sw) << 4;
      bf16x8 a0 = *(const bf16x8*)(st + aoff0 + co);
      bf16x8 a1 = *(const bf16x8*)(st + aoff1 + co);
      bf16x8 b = *(const bf16x8*)(st + boff + co);
      acc0 = MFMA32(a0, b, acc0);
      acc1 = MFMA32(a1, b, acc1);
    }
  }
  __syncthreads();
  float* Cs = (float*)smem;
  constexpr int CS = 132;
#pragma unroll
  for (int i = 0; i < 16; ++i) {
    int row = (i & 3) + 8 * (i >> 2) + 4 * h;
    Cs[(wm * 64 + row) * CS + wn * 32 + r] = acc0[i];
    Cs[(wm * 64 + 32 + row) * CS + wn * 32 + r] = acc1[i];
  }
  __syncthreads();
  const int row = tid >> 2, q = tid & 3;
  unsigned v[32];
#pragma unroll
  for (int i = 0; i < 32; ++i) {
    unsigned u = __float_as_uint(Cs[row * CS + 4 * i + q]);
    u ^= (u & 0x80000000u) ? 0xffffffffu : 0x80000000u;
    v[i] = (u & ~127u) | (unsigned)(127 - (4 * i + q));
  }
#pragma unroll
  for (int k = 2; k <= 32; k <<= 1)
#pragma unroll
    for (int j = k >> 1; j > 0; j >>= 1)
#pragma unroll
      for (int i = 0; i < 32; ++i) {
        const int l = i ^ j;
        if (l > i) {
          const unsigned lo = min(v[i], v[l]), hi = max(v[i], v[l]);
          if ((i & k) == 0) { v[i] = hi; v[l] = lo; } else { v[i] = lo; v[l] = hi; }
        }
      }
#pragma unroll
  for (int step = 0; step < 2; ++step) {
    unsigned c[16];
#pragma unroll
    for (int i = 0; i < 16; ++i) {
      const unsigned o = step == 0 ? (unsigned)__builtin_amdgcn_mov_dpp((int)v[15 - i], 0xB1, 0xf, 0xf, false)
                                   : (unsigned)__builtin_amdgcn_mov_dpp((int)v[15 - i], 0x4E, 0xf, 0xf, false);
      c[i] = max(v[i], o);
    }
#pragma unroll
    for (int j = 8; j > 0; j >>= 1)
#pragma unroll
      for (int i = 0; i < 16; ++i) {
        const int l = i ^ j;
        if (l > i) { const unsigned lo = min(c[i], c[l]), hi = max(c[i], c[l]); c[i] = hi; c[l] = lo; }
      }
#pragma unroll
    for (int i = 0; i < 16; ++i) v[i] = c[i];
  }
  {
    unsigned* dst = topk + ((size_t)(m0 + row) * 16 + hp) * 16 + 4 * q;
    uint4 w = q == 0 ? make_uint4(v[0], v[1], v[2], v[3]) : q == 1 ? make_uint4(v[4], v[5], v[6], v[7]) : q == 2 ? make_uint4(v[8], v[9], v[10], v[11]) : make_uint4(v[12], v[13], v[14], v[15]);
    *(uint4*)dst = w;
  }
}

DI float key2f(unsigned k) { k &= ~127u; k ^= (k & 0x80000000u) ? 0x80000000u : 0xffffffffu; return __uint_as_float(k); }
DI void merge_one(const unsigned* __restrict__ topk, int r, int hd, int* __restrict__ experts, float* __restrict__ gates) {
  const unsigned* ka = topk + ((size_t)r * 16 + 2 * hd) * 16;
  const unsigned* kb = ka + 16;
  float a[16], bq[16];
#pragma unroll
  for (int i = 0; i < 4; ++i) {
    uint4 x = ((const uint4*)ka)[i], y = ((const uint4*)kb)[i];
    a[4 * i] = key2f(x.x); a[4 * i + 1] = key2f(x.y); a[4 * i + 2] = key2f(x.z); a[4 * i + 3] = key2f(x.w);
    bq[4 * i] = key2f(y.x); bq[4 * i + 1] = key2f(y.y); bq[4 * i + 2] = key2f(y.z); bq[4 * i + 3] = key2f(y.w);
  }
  float cv[50];
  {
    int n = 0;
#pragma unroll
    for (int i = 0; i < 16; ++i)
#pragma unroll
      for (int j = 0; j < 16; ++j)
        if ((i + 1) * (j + 1) <= 16) { cv[n] = a[i] + bq[j]; ++n; }
  }
  int* eo = experts + (size_t)r * 128 + hd * 16;
  float* go = gates + (size_t)r * 128 + hd * 16;
  float mx = 0.f, sum = 0.f;
#pragma unroll 1
  for (int k = 0; k < 16; ++k) {
    float mval = cv[0]; int code = 0;
    {
      int n = 0;
#pragma unroll
      for (int i = 0; i < 16; ++i)
#pragma unroll
        for (int j = 0; j < 16; ++j)
          if ((i + 1) * (j + 1) <= 16) {
            if (n > 0) { bool gt = cv[n] > mval; mval = gt ? cv[n] : mval; code = gt ? (i * 16 + j) : code; }
            ++n;
          }
    }
    {
      int n = 0;
#pragma unroll
      for (int i = 0; i < 16; ++i)
#pragma unroll
        for (int j = 0; j < 16; ++j)
          if ((i + 1) * (j + 1) <= 16) { cv[n] = (code == i * 16 + j) ? -3.0e38f : cv[n]; ++n; }
    }
    if (k == 0) mx = mval;
    const float e = __expf(mval - mx);
    sum += e;
    eo[k] = (int)(127u - (ka[code >> 4] & 127u)) * 128 + (int)(127u - (kb[code & 15] & 127u));
    go[k] = e;
  }
  const float inv = 1.f / sum;
#pragma unroll
  for (int i = 0; i < 4; ++i) {
    float4 g4 = ((float4*)go)[i];
    g4.x *= inv; g4.y *= inv; g4.z *= inv; g4.w *= inv;
    ((float4*)go)[i] = g4;
  }
}

DI void peer_token(int r, const bf16_t* __restrict__ hbuf, const int* __restrict__ experts, const float* __restrict__ gates,
                   const unsigned char* __restrict__ u8, const float* __restrict__ us, const unsigned char* __restrict__ v8,
                   const float* __restrict__ vs, const float* __restrict__ modv_l, float* __restrict__ xs, float* wdots  ,
                   float* __restrict__ outp = nullptr) {
  const int lane = TID & 63;
  float x[16];
  {
    const uint4* hr = (const uint4*)(hbuf + (size_t)r * D + lane * 16);
    uint4 a = hr[0], c = hr[1];
    x[0] = bflo(a.x); x[1] = bfhi(a.x); x[2] = bflo(a.y); x[3] = bfhi(a.y); x[4] = bflo(a.z); x[5] = bfhi(a.z); x[6] = bflo(a.w); x[7] = bfhi(a.w);
    x[8] = bflo(c.x); x[9] = bfhi(c.x); x[10] = bflo(c.y); x[11] = bfhi(c.y); x[12] = bflo(c.z); x[13] = bfhi(c.z); x[14] = bflo(c.w); x[15] = bfhi(c.w);
  }
  const int e0 = experts[(size_t)r * 128 + lane], e1 = experts[(size_t)r * 128 + 64 + lane];
  const float g0 = gates[(size_t)r * 128 + lane], g1 = gates[(size_t)r * 128 + 64 + lane];
  const float us0 = us[e0], us1 = us[e1], vs0 = vs[e0], vs1 = vs[e1];
#define PEER_LOAD8(rw_, tab_, k0_)                                                          \
  {                                                                                         \
    _Pragma("unroll") for (int j = 0; j < 8; ++j) {                                         \
      int e = __builtin_amdgcn_readlane((k0_) < 64 ? e0 : e1, ((k0_) + j) & 63);            \
      rw_[j] = *(const uint4*)((tab_) + (size_t)e * D + lane * 16);                         \
    }                                                                                       \
  }
#define PEER_UDOT8(rw_, k0_)                                                                \
  {                                                                                         \
    float p[8];                                                                             \
    _Pragma("unroll") for (int j = 0; j < 8; ++j) {                                         \
      f32x2_t a0 = __builtin_amdgcn_cvt_pk_f32_fp8((int)rw_[j].x, false), a1 = __builtin_amdgcn_cvt_pk_f32_fp8((int)rw_[j].x, true); \
      f32x2_t b0 = __builtin_amdgcn_cvt_pk_f32_fp8((int)rw_[j].y, false), b1 = __builtin_amdgcn_cvt_pk_f32_fp8((int)rw_[j].y, true); \
      f32x2_t c0 = __builtin_amdgcn_cvt_pk_f32_fp8((int)rw_[j].z, false), c1 = __builtin_amdgcn_cvt_pk_f32_fp8((int)rw_[j].z, true); \
      f32x2_t d0 = __builtin_amdgcn_cvt_pk_f32_fp8((int)rw_[j].w, false), d1 = __builtin_amdgcn_cvt_pk_f32_fp8((int)rw_[j].w, true); \
      float s = a0[0] * x[0] + a0[1] * x[1] + a1[0] * x[2] + a1[1] * x[3];                  \
      s += b0[0] * x[4] + b0[1] * x[5] + b1[0] * x[6] + b1[1] * x[7];                       \
      s += c0[0] * x[8] + c0[1] * x[9] + c1[0] * x[10] + c1[1] * x[11];                     \
      s += d0[0] * x[12] + d0[1] * x[13] + d1[0] * x[14] + d1[1] * x[15];                   \
      p[j] = s;                                                                             \
    }                                                                                       \
    float q4[4];                                                                            \
    _Pragma("unroll") for (int i = 0; i < 4; ++i) { float send = hi32 ? p[i] : p[4 + i]; float keep = hi32 ? p[4 + i] : p[i]; q4[i] = keep + shxl(send, lane, 32); } \
    float q2[2];                                                                            \
    _Pragma("unroll") for (int i = 0; i < 2; ++i) { float send = hi16 ? q4[i] : q4[2 + i]; float keep = hi16 ? q4[2 + i] : q4[i]; q2[i] = keep + shxl(send, lane, 16); } \
    float q1;                                                                               \
    { float send = hi8 ? q2[0] : q2[1]; float keep = hi8 ? q2[1] : q2[0]; q1 = keep + shxl(send, lane, 8); } \
    q1 += shxl(q1, lane, 4); q1 += shxl(q1, lane, 2); q1 += shxl(q1, lane, 1);              \
    if ((lane & 7) == 0) wdots[(k0_) + (lane >> 3)] = q1;                                   \
  }
#define PEER_VACC8(rw_, k0_)                                                                \
  {                                                                                         \
    _Pragma("unroll") for (int j = 0; j < 8; ++j) {                                         \
      float w = __builtin_bit_cast(float, __builtin_amdgcn_readlane(__builtin_bit_cast(int, (k0_) < 64 ? w0 : w1), ((k0_) + j) & 63)); \
      f32x2_t a0 = __builtin_amdgcn_cvt_pk_f32_fp8((int)rw_[j].x, false), a1 = __builtin_amdgcn_cvt_pk_f32_fp8((int)rw_[j].x, true); \
      f32x2_t b0 = __builtin_amdgcn_cvt_pk_f32_fp8((int)rw_[j].y, false), b1 = __builtin_amdgcn_cvt_pk_f32_fp8((int)rw_[j].y, true); \
      f32x2_t c0 = __builtin_amdgcn_cvt_pk_f32_fp8((int)rw_[j].z, false), c1 = __builtin_amdgcn_cvt_pk_f32_fp8((int)rw_[j].z, true); \
      f32x2_t d0 = __builtin_amdgcn_cvt_pk_f32_fp8((int)rw_[j].w, false), d1 = __builtin_amdgcn_cvt_pk_f32_fp8((int)rw_[j].w, true); \
      acc[0] += w * a0[0]; acc[1] += w * a0[1]; acc[2] += w * a1[0]; acc[3] += w * a1[1];   \
      acc[4] += w * b0[0]; acc[5] += w * b0[1]; acc[6] += w * b1[0]; acc[7] += w * b1[1];   \
      acc[8] += w * c0[0]; acc[9] += w * c0[1]; acc[10] += w * c1[0]; acc[11] += w * c1[1]; \
      acc[12] += w * d0[0]; acc[13] += w * d0[1]; acc[14] += w * d1[0]; acc[15] += w * d1[1]; \
    }                                                                                       \
  }
  const bool hi32 = lane & 32, hi16 = lane & 16, hi8 = lane & 8;
  uint4 rwA[8], rwB[8];
  PEER_LOAD8(rwA, u8, 0);
#pragma unroll 1
  for (int k0 = 0; k0 < 128; k0 += 16) {
    PEER_LOAD8(rwB, u8, k0 + 8);
    PEER_UDOT8(rwA, k0);
    if (k0 + 16 < 128) { PEER_LOAD8(rwA, u8, k0 + 16); } else { PEER_LOAD8(rwA, v8, 0); }
    PEER_UDOT8(rwB, k0 + 8);
  }
  float w0, w1;
  {
    float d0 = wdots[lane] * us0, d1 = wdots[64 + lane] * us1;
    float t0 = 0.5f * d0 * (1.f + tanhf(0.7978845608028654f * (d0 + 0.044715f * d0 * d0 * d0)));
    float t1 = 0.5f * d1 * (1.f + tanhf(0.7978845608028654f * (d1 + 0.044715f * d1 * d1 * d1)));
    w0 = g0 * t0 * vs0; w1 = g1 * t1 * vs1;
  }
  float acc[16];
#pragma unroll
  for (int i = 0; i < 16; ++i) acc[i] = 0.f;
#pragma unroll 1
  for (int k0 = 0; k0 < 128; k0 += 16) {
    PEER_LOAD8(rwB, v8, k0 + 8);
    PEER_VACC8(rwA, k0);
    if (k0 + 16 < 128) PEER_LOAD8(rwA, v8, k0 + 16);
    PEER_VACC8(rwB, k0 + 8);
  }
  const int b = r / NT, p = r % NT; const int mrow = p < CTX ? 2 : b;
  const float* g2 = modv_l + mrow * NMOD + 5 * D + lane * 16;
  float4* xp = (float4*)(xs + (size_t)r * D + lane * 16);
  float4* op = outp ? (float4*)(outp + ((size_t)b * SEQ + (p - CTX)) * D + lane * 16) : xp;
#pragma unroll
  for (int i = 0; i < 4; ++i) {
    float4 xv = xp[i]; float4 gg = ((const float4*)g2)[i];
    xv.x += gg.x * acc[4 * i]; xv.y += gg.y * acc[4 * i + 1]; xv.z += gg.z * acc[4 * i + 2]; xv.w += gg.w * acc[4 * i + 3];
    op[i] = xv;
  }
}

constexpr int FN = 2 * SEQ;
DI float2 cmul(float2 a, float2 b) { return make_float2(a.x * b.x - a.y * b.y, a.x * b.y + a.y * b.x); }
DI float2 cmulc(float2 a, float2 b) { return make_float2(a.x * b.x + a.y * b.y, a.y * b.x - a.x * b.y); }
DI int rev4_7(int x) {
  return ((x & 3) << 12) | ((x >> 12) & 3) | ((x & 0xC) << 8) | ((x >> 8) & 0xC) | ((x & 0x30) << 4) | ((x >> 4) & 0x30) | (x & 0xC0);
}
DI void fft_fwd(float2* X) {
  const int tid = TID;
#pragma unroll 1
  for (int p = 0; p < 7; ++p) {
    const int lq = 12 - 2 * p; const int q = 1 << lq;
    const float invL = 1.f / (float)(4 << lq);
    __syncthreads();
#pragma unroll 2
    for (int m = 0; m < 8; ++m) {
      const int i = tid + 512 * m;
      const int j = i & (q - 1); const int base = ((i >> lq) << (lq + 2)) + j;
      float2 a = X[base], b = X[base + q], c = X[base + 2 * q], d = X[base + 3 * q];
      float2 t0 = make_float2(a.x + c.x, a.y + c.y), t1 = make_float2(a.x - c.x, a.y - c.y);
      float2 t2 = make_float2(b.x + d.x, b.y + d.y), t3 = make_float2(b.y - d.y, d.x - b.x);
      float2 y0 = make_float2(t0.x + t2.x, t0.y + t2.y), y1 = make_float2(t1.x + t3.x, t1.y + t3.y);
      float2 y2 = make_float2(t0.x - t2.x, t0.y - t2.y), y3 = make_float2(t1.x - t3.x, t1.y - t3.y);
      const float fr = (float)j * invL;
      float2 w1 = make_float2(__builtin_amdgcn_cosf(fr), -__builtin_amdgcn_sinf(fr));
      float2 w2 = cmul(w1, w1), w3 = cmul(w2, w1);
      X[base] = y0; X[base + q] = cmul(y1, w1); X[base + 2 * q] = cmul(y2, w2); X[base + 3 * q] = cmul(y3, w3);
    }
  }
  __syncthreads();
}
DI void fft_inv(float2* X) {
  const int tid = TID;
#pragma unroll 1
  for (int p = 6; p >= 0; --p) {
    const int lq = 12 - 2 * p; const int q = 1 << lq;
    const float invL = 1.f / (float)(4 << lq);
    __syncthreads();
#pragma unroll 2
    for (int m = 0; m < 8; ++m) {
      const int i = tid + 512 * m;
      const int j = i & (q - 1); const int base = ((i >> lq) << (lq + 2)) + j;
      const float fr = (float)j * invL;
      float2 w1 = make_float2(__builtin_amdgcn_cosf(fr), -__builtin_amdgcn_sinf(fr));
      float2 w2 = cmul(w1, w1), w3 = cmul(w2, w1);
      float2 y0 = X[base], y1 = cmulc(X[base + q], w1), y2 = cmulc(X[base + 2 * q], w2), y3 = cmulc(X[base + 3 * q], w3);
      float2 t0 = make_float2(y0.x + y2.x, y0.y + y2.y), t1 = make_float2(y0.x - y2.x, y0.y - y2.y);
      float2 t2 = make_float2(y1.x + y3.x, y1.y + y3.y), t3 = make_float2(y3.y - y1.y, y1.x - y3.x);
      X[base] = make_float2(t0.x + t2.x, t0.y + t2.y);
      X[base + q] = make_float2(t1.x + t3.x, t1.y + t3.y);
      X[base + 2 * q] = make_float2(t0.x - t2.x, t0.y - t2.y);
      X[base + 3 * q] = make_float2(t1.x - t3.x, t1.y - t3.y);
    }
  }
  __syncthreads();
}
DI float block_sum_512(float v, float* red) {
  for (int o = 32; o > 0; o >>= 1) v += shx(v, o);
  __syncthreads();
  if ((TID & 63) == 0) red[TID >> 6] = v;
  __syncthreads();
  float s = 0.f;
  for (int i = 0; i < 8; ++i) s += red[i];
  return s;
}
DI void hyena_channel(int c, const float* __restrict__ hdn2, const float* __restrict__ w3, const float* __restrict__ b3,
                      const float* __restrict__ hy_bias, const float* __restrict__ uT, float* __restrict__ zT, float* __restrict__ yT,
                      float2* __restrict__ Hc_all, char* smem) {
  float2* X = (float2*)smem;
  float* red = (float*)(smem + 131072);
  float* wcol = red + 16;
  float2* Hc = Hc_all + (size_t)c * FN;
  const int tid = TID;
  __syncthreads();
  if (tid < 256) {
    int od = tid >> 6, i = tid & 63;
    wcol[od * 64 + i] = w3[i * 1024 + (od >> 1) * 512 + (od & 1) * 256 + c];
  }
  __syncthreads();
  const float delta = fabsf(-3.0701134573253944f + (float)c * ((-15.350567286626972f + 3.0701134573253944f) / 255.f));
  const float bb00 = b3[c], bb01 = b3[256 + c], bb10 = b3[512 + c], bb11 = b3[768 + c];
  float n0 = 0.f, n1 = 0.f;
#pragma unroll 1
  for (int j = tid; j < SEQ; j += 512) {
    asm volatile("" ::: "memory");
    const float4* hr = (const float4*)(hdn2 + (size_t)j * 64);
    float f00 = bb00, f01 = bb01, f10 = bb10, f11 = bb11;
#pragma unroll 4
    for (int i = 0; i < 16; ++i) {
      float4 hv = hr[i];
      const float* w0 = wcol + 4 * i;
      f00 += hv.x * w0[0] + hv.y * w0[1] + hv.z * w0[2] + hv.w * w0[3];
      f01 += hv.x * w0[64] + hv.y * w0[65] + hv.z * w0[66] + hv.w * w0[67];
      f10 += hv.x * w0[128] + hv.y * w0[129] + hv.z * w0[130] + hv.w * w0[131];
      f11 += hv.x * w0[192] + hv.y * w0[193] + hv.z * w0[194] + hv.w * w0[195];
    }
    const float dec = __expf(-((float)j / (float)(SEQ - 1)) * delta);
    f00 *= dec; f01 *= dec; f10 *= dec; f11 *= dec;
    X[j] = make_float2(f00, f10);
    n0 += fabsf(f00); n1 += fabsf(f10);
    if (j > 0) { X[FN - j] = make_float2(f01, f11); n0 += fabsf(f01); n1 += fabsf(f11); }
    else X[SEQ] = make_float2(0.f, 0.f);
  }
  n0 = block_sum_512(n0, red);
  n1 = block_sum_512(n1, red);
  const float s0 = 1.f / (n0 * (float)FN), s1 = 1.f / (n1 * (float)FN);
  fft_fwd(X);
  for (int i = tid; i < FN; i += 512) Hc[i] = X[i];
  const float* v0p = uT + ((size_t)0 * 768 + c) * NT + CTX;
  const float* v1p = uT + ((size_t)1 * 768 + c) * NT + CTX;
  __syncthreads();
  for (int t = tid; t < SEQ; t += 512) { X[t] = make_float2(v0p[t], v1p[t]); X[SEQ + t] = make_float2(0.f, 0.f); }
  fft_fwd(X);
  for (int pos = tid; pos < FN; pos += 512) {
    int f = rev4_7(pos); int pm = rev4_7((FN - f) & (FN - 1));
    float2 A = Hc[pos], Bm = Hc[pm];
    float2 K0 = make_float2((A.x + Bm.x) * 0.5f * s0, (A.y - Bm.y) * 0.5f * s0);
    X[pos] = cmul(X[pos], K0);
  }
  fft_inv(X);
  {
    const float bias0 = hy_bias[c];
    const float* x10 = v0p + (size_t)256 * NT; const float* x11 = v1p + (size_t)256 * NT;
    float* z0 = zT + ((size_t)0 * 256 + c) * NT + CTX; float* z1 = zT + ((size_t)1 * 256 + c) * NT + CTX;
    for (int t = tid; t < SEQ; t += 512) {
      float2 y = X[t];
      float za = x10[t] * (y.x + bias0 * v0p[t]);
      float zb = x11[t] * (y.y + bias0 * v1p[t]);
      z0[t] = za; z1[t] = zb;
      X[t] = make_float2(za, zb);
    }
    __syncthreads();
    for (int t = tid; t < SEQ; t += 512) X[SEQ + t] = make_float2(0.f, 0.f);
  }
  fft_fwd(X);
  for (int pos = tid; pos < FN; pos += 512) {
    int f = rev4_7(pos); int pm = rev4_7((FN - f) & (FN - 1));
    float2 A = Hc[pos], Bm = Hc[pm];
    float2 K1 = make_float2((A.y + Bm.y) * 0.5f * s1, -(A.x - Bm.x) * 0.5f * s1);
    X[pos] = cmul(X[pos], K1);
  }
  fft_inv(X);
  {
    const float bias1 = hy_bias[256 + c];
    const float* x20 = v0p + (size_t)512 * NT; const float* x21 = v1p + (size_t)512 * NT;
    const float* z0 = zT + ((size_t)0 * 256 + c) * NT + CTX; const float* z1 = zT + ((size_t)1 * 256 + c) * NT + CTX;
    float* y0 = yT + ((size_t)0 * 256 + c) * NT + CTX; float* y1 = yT + ((size_t)1 * 256 + c) * NT + CTX;
    for (int t = tid; t < SEQ; t += 512) {
      float2 y = X[t];
      y0[t] = x20[t] * (y.x + bias1 * z0[t]);
      y1[t] = x21[t] * (y.y + bias1 * z1[t]);
    }
  }
}

#define XB_TMO      128
#define XB_XCNT(j)  (256  + 64 * (j))
#define XB_XSUB(j)  (1280 + 64 * (j))
#define XB_XGEN(j)  (2304 + 64 * (j))
#define XB_TOP      3328
#define XB_TOPGEN   3392
#define XB_SPIN_CAP (1u << 22)
#define LAS __attribute__((address_space(3)))
DI unsigned xb_ld(unsigned* p) { return __hip_atomic_load(p, __ATOMIC_RELAXED, __HIP_MEMORY_SCOPE_AGENT); }
DI unsigned xb_add(unsigned* p, unsigned v) { return __hip_atomic_fetch_add(p, v, __ATOMIC_RELAXED, __HIP_MEMORY_SCOPE_AGENT); }
DI unsigned xb_xcc_id() { return (unsigned)__builtin_amdgcn_s_getreg((3 << 11) | 20) & 0xFu; }
#define XB_SPIN(cond, bar) do { unsigned _sp = 0; while (cond) { __builtin_amdgcn_s_sleep(1); \
    if ((++_sp & 255u) == 0u) { if (xb_ld(&(bar)[XB_TMO])) break; if (_sp > XB_SPIN_CAP) { atomicAdd(&(bar)[XB_TMO], 1u); break; } } } } while (0)
DI void xcd_barrier_post(unsigned* bar) {
  if (threadIdx.x == 0) (void)xb_add(&bar[XB_XCNT(xb_xcc_id())], 1u);
}
DI void xcd_barrier_complete(unsigned* bar, unsigned x, unsigned& nloc, unsigned& nx) {
  const unsigned G = gridDim.x;
  unsigned sum, cnt, mine, sp = 0u;
  for (;;) {
    sum = 0u; cnt = 0u; mine = 0u;
#pragma unroll
    for (unsigned j = 0; j < 16; ++j) { const unsigned c = xb_ld(&bar[XB_XCNT(j)]); sum += c; cnt += (c > 0u) ? 1u : 0u; mine = (j == x) ? c : mine; }
    if (sum == G) break;
    __builtin_amdgcn_s_sleep(1);
    if ((++sp & 255u) == 0u) { if (xb_ld(&bar[XB_TMO])) break; if (sp > XB_SPIN_CAP) { atomicAdd(&bar[XB_TMO], 1u); break; } }
  }
  nloc = mine > 0u ? mine : 1u; nx = cnt > 0u ? cnt : 1u;
}
DI void xcd_barrier(unsigned* bar, volatile LAS unsigned* st) {
  asm volatile("s_waitcnt vmcnt(0)" ::: "memory");
  __syncthreads();
  if (threadIdx.x == 0) {
    const unsigned x = xb_xcc_id();
    __builtin_amdgcn_s_waitcnt(0);
    unsigned nloc = st[0], nx = st[1];
    if (nloc == 0u) { xcd_barrier_complete(bar, x, nloc, nx); st[0] = nloc; st[1] = nx; }
    const unsigned old = xb_add(&bar[XB_XSUB(x)], 1u);
    const unsigned gen = old / nloc;
    if (old + 1u == (gen + 1u) * nloc) {
      __builtin_amdgcn_fence(__ATOMIC_RELEASE, "agent");
      asm volatile("s_waitcnt vmcnt(0)" ::: "memory");
      const unsigned og = xb_add(&bar[XB_TOP], 1u);
      const unsigned tg = og / nx;
      if (og + 1u == (tg + 1u) * nx) xb_add(&bar[XB_TOPGEN], 1u);
      else XB_SPIN(xb_ld(&bar[XB_TOPGEN]) == tg, bar);
      __builtin_amdgcn_fence(__ATOMIC_ACQUIRE, "agent");
      xb_add(&bar[XB_XGEN(x)], 1u);
      asm volatile("s_waitcnt vmcnt(0)" ::: "memory");
    } else {
      XB_SPIN(xb_ld(&bar[XB_XGEN(x)]) == gen, bar);
      __builtin_amdgcn_fence(__ATOMIC_ACQUIRE, "agent");
      asm volatile("s_waitcnt vmcnt(0)" ::: "memory");
    }
  }
  __syncthreads();
}

#define XCD_BAR_WORDS 3456
constexpr size_t al256(size_t x) { return (x + 255) & ~(size_t)255; }
constexpr size_t OFF_modv = 0;
constexpr size_t OFF_xs = al256(OFF_modv + (size_t)2 * 3 * NMOD * 4);
constexpr size_t OFF_hbuf = al256(OFF_xs + (size_t)R * D * 4);
constexpr size_t OFF_P = al256(OFF_hbuf + (size_t)R * D * 2);
constexpr size_t OFF_Wt_in = al256(OFF_P + (size_t)R * DIN * 2);
constexpr size_t OFF_Wt_out = al256(OFF_Wt_in + (size_t)2 * DIN * D * 2);
constexpr size_t OFF_Wt_q = al256(OFF_Wt_out + (size_t)2 * D * D * 2);
constexpr size_t OFF_QA = al256(OFF_Wt_q + (size_t)2 * 2048 * D * 2);
constexpr size_t OFF_KA = al256(OFF_QA + (size_t)NB * 8 * NT * 32 * 2);
constexpr size_t OFF_VAt = al256(OFF_KA + (size_t)NB * 8 * NT * 32 * 2);
constexpr size_t OFF_QW = al256(OFF_VAt + (size_t)NB * 4 * 64 * NT * 2);
constexpr size_t OFF_KW = al256(OFF_QW + (size_t)NB * 4 * NT * 64 * 2);
constexpr size_t OFF_VWt = al256(OFF_KW + (size_t)NB * 2 * NT * 64 * 2);
constexpr size_t OFF_QG = al256(OFF_VWt + (size_t)NB * 2 * 64 * NT * 2);
constexpr size_t OFF_KG = al256(OFF_QG + (size_t)NB * 4 * NT * 64 * 2);
constexpr size_t OFF_VGt = al256(OFF_KG + (size_t)NB * 2 * NT * 64 * 2);
constexpr size_t OFF_uT = al256(OFF_VGt + (size_t)NB * 2 * 64 * NT * 2);
constexpr size_t OFF_zT = al256(OFF_uT + (size_t)NB * 768 * NT * 4);
constexpr size_t OFF_yT = al256(OFF_zT + (size_t)NB * 256 * NT * 4);
constexpr size_t OFF_hdn2 = al256(OFF_yT + (size_t)NB * 256 * NT * 4);
constexpr size_t OFF_Hc = al256(OFF_hdn2 + (size_t)2 * NT * 64 * 4);
constexpr size_t OFF_A2 = al256(OFF_Hc + (size_t)256 * 2 * SEQ * 8);
constexpr size_t OFF_u8 = al256(OFF_A2 + (size_t)R * D * 2);
constexpr size_t OFF_v8 = al256(OFF_u8 + (size_t)2 * 16384 * D);
constexpr size_t OFF_us = al256(OFF_v8 + (size_t)2 * 16384 * D);
constexpr size_t OFF_vs = al256(OFF_us + (size_t)2 * 16384 * 4);
constexpr size_t OFF_keysb = al256(OFF_vs + (size_t)2 * 16384 * 4);
constexpr size_t OFF_bar = al256(OFF_keysb + (size_t)2 * 16 * 128 * 128 * 2);
constexpr size_t WS_TOTAL = al256(OFF_bar + (size_t)XCD_BAR_WORDS * 4);
constexpr size_t OFF_topv = OFF_uT;
constexpr size_t OFF_topi = OFF_topv + (size_t)R * 256 * 4;
constexpr size_t OFF_experts = OFF_topi + (size_t)R * 256;
constexpr size_t OFF_gates = OFF_experts + (size_t)R * 128 * 4;
constexpr size_t OFF_Oslab = OFF_P;
constexpr size_t OFF_Lslab = OFF_Oslab + (size_t)2 * NB * 4 * NT * 64 * 4;
static_assert(OFF_gates + (size_t)R * 128 * 4 <= OFF_zT, "routing buffers overflow uT");
static_assert(OFF_Lslab + (size_t)2 * NB * 4 * NT * 4 <= OFF_Wt_in, "slabs overflow P");

struct MKView;
struct MK {
  const float *x, *c, *ctx, *c_ctx, *w_mod, *b_mod, *g_norm_mix, *w_in, *g_qk_diff, *lambda_diff, *g_qk_win, *sink_win, *g_qk_glob, *hy_conv_w,
      *hy_conv_b, *hy_w1, *hy_b1, *hy_w2, *hy_b2, *hy_w3, *hy_b3, *hy_freq, *hy_bias, *g_mix_out, *w_out, *g_norm_ffn, *peer_wq, *peer_keys,
      *peer_u, *peer_v;
  float* out;
  char* ws;
};
constexpr int SMEM_BYTES = 131072 + 2048;
typedef const MK __attribute__((address_space(4))) * MKP;
DI MK launder_mk(MKP a) {
  asm volatile("" : "+s"(a));
  MK r;
  r.x = a->x; r.c = a->c; r.ctx = a->ctx; r.c_ctx = a->c_ctx; r.w_mod = a->w_mod; r.b_mod = a->b_mod;
  r.g_norm_mix = a->g_norm_mix; r.w_in = a->w_in; r.g_qk_diff = a->g_qk_diff; r.lambda_diff = a->lambda_diff;
  r.g_qk_win = a->g_qk_win; r.sink_win = a->sink_win; r.g_qk_glob = a->g_qk_glob; r.hy_conv_w = a->hy_conv_w;
  r.hy_conv_b = a->hy_conv_b; r.hy_w1 = a->hy_w1; r.hy_b1 = a->hy_b1; r.hy_w2 = a->hy_w2; r.hy_b2 = a->hy_b2;
  r.hy_w3 = a->hy_w3; r.hy_b3 = a->hy_b3; r.hy_freq = a->hy_freq; r.hy_bias = a->hy_bias; r.g_mix_out = a->g_mix_out;
  r.w_out = a->w_out; r.g_norm_ffn = a->g_norm_ffn; r.peer_wq = a->peer_wq; r.peer_keys = a->peer_keys;
  r.peer_u = a->peer_u; r.peer_v = a->peer_v; r.out = a->out; r.ws = a->ws;
  return r;
}

DI void ph_mod_item(const MK& m, int item, char* smem) {
  float* sc = (float*)smem;
  float* part = sc + 3 * D;
  const int tid = TID;
  const int l = item / 24, chunk = item % 24;
  __syncthreads();
  for (int i = tid; i < 3 * D; i += NTHR) {
    int row = i / D, k = i % D;
    float v = row < 2 ? m.c[row * D + k] : m.c_ctx[k];
    sc[i] = v / (1.f + __expf(-v));
  }
  __syncthreads();
  const int cl = tid & 255, kh = tid >> 8;
  const int col = chunk * 256 + cl;
  const float* w = m.w_mod + (size_t)l * D * NMOD + (size_t)(kh * 512) * NMOD + col;
  float a0 = 0, a1 = 0, a2 = 0;
  for (int k = 0; k < 512; ++k) {
    float wv = w[(size_t)k * NMOD];
    a0 += sc[kh * 512 + k] * wv; a1 += sc[D + kh * 512 + k] * wv; a2 += sc[2 * D + kh * 512 + k] * wv;
  }
  if (kh == 1) { part[cl] = a0; part[256 + cl] = a1; part[512 + cl] = a2; }
  __syncthreads();
  if (kh == 0) {
    float bb = m.b_mod[l * NMOD + col];
    ((float*)(m.ws + OFF_modv))[(l * 3 + 0) * NMOD + col] = a0 + part[cl] + bb;
    ((float*)(m.ws + OFF_modv))[(l * 3 + 1) * NMOD + col] = a1 + part[256 + cl] + bb;
    ((float*)(m.ws + OFF_modv))[(l * 3 + 2) * NMOD + col] = a2 + part[512 + cl] + bb;
  }
}
DI void ph_hymlp_group(const MK& m, int g, char* smem) {
  const int tid = TID, wv = tid >> 6, u = tid & 63;
  float* feat = (float*)smem + wv * 128;
  float* h1 = feat + 64;
  const int gi = g * 8 + wv;
  const int l = gi / NT, pos = gi % NT;
  const int which = pos >= SEQ ? 1 : 0;
  const int j = which ? pos - SEQ : pos;
  const int n = which ? CTX : SEQ;
  const float tt = (float)j / (float)(n - 1);
  const float w = (6.283185307179586f / (float)n) * (float)j;
  __syncthreads();
  if (u == 0) feat[0] = tt;
  if (u < 16) {
    float f = 1e-4f + (float)u * ((15.f - 1e-4f) / 15.f);
    feat[1 + u] = cosf(f * w);
    feat[17 + u] = -sinf(f * w);
  }
  __syncthreads();
  const float* w1 = m.hy_w1 + l * 33 * 64; const float* w2 = m.hy_w2 + l * 64 * 64;
  const float fq = m.hy_freq[l * 64 + u];
  float a = m.hy_b1[l * 64 + u];
  for (int i = 0; i < 33; ++i) a += feat[i] * w1[i * 64 + u];
  h1[u] = sinf(fq * a);
  __syncthreads();
  float a2 = m.hy_b2[l * 64 + u];
  for (int i = 0; i < 64; ++i) a2 += h1[i] * w2[i * 64 + u];
  ((float*)(m.ws + OFF_hdn2))[((size_t)l * NT + pos) * 64 + u] = sinf(fq * a2);
}
DI void phase0(MKP m_in, char* smem) {
  const MK m = launder_mk(m_in);
  const int bid = BID, nb = NBLK, tid = TID;
  {
    const int gw = bid * 8 + (tid >> 6), nw = nb * 8;
    for (int row = gw; row < 4 * 16384; row += nw) {
      int tbl = row >> 14, rr = row & 16383;
      int l = tbl >> 1;
      if (tbl & 1) tabconv_row(m.peer_v + (size_t)l * 16384 * D, ((unsigned char*)(m.ws + OFF_v8)) + (size_t)l * 16384 * D, ((float*)(m.ws + OFF_vs)) + l * 16384, (size_t)rr);
      else tabconv_row(m.peer_u + (size_t)l * 16384 * D, ((unsigned char*)(m.ws + OFF_u8)) + (size_t)l * 16384 * D, ((float*)(m.ws + OFF_us)) + l * 16384, (size_t)rr);
    }
  }
  for (int it = bid; it < 48; it += nb) ph_mod_item(m, it, smem);
  for (int g = bid; g < 2 * NT / 8; g += nb) ph_hymlp_group(m, g, smem);
  for (int t = bid; t < 2 * 1408; t += nb) {
    int l = t / 1408, tt = t % 1408;
    if (tt < 640) wconv_tile(m.w_in + (size_t)l * D * DIN, ((bf16_t*)(m.ws + OFF_Wt_in)) + (size_t)l * DIN * D, DIN, tt, (float*)smem);
    else if (tt < 896) wconv_tile(m.w_out + (size_t)l * D * D, ((bf16_t*)(m.ws + OFF_Wt_out)) + (size_t)l * D * D, D, tt - 640, (float*)smem);
    else wconv_tile(m.peer_wq + (size_t)l * D * 2048, ((bf16_t*)(m.ws + OFF_Wt_q)) + (size_t)l * 2048 * D, 2048, tt - 896, (float*)smem);
  }
  for (int i = bid * NTHR + tid; i < 2 * 16 * 128 * 128 / 4; i += nb * NTHR) {
    float4 v = ((const float4*)m.peer_keys)[i];
    ((uint2*)((bf16_t*)(m.ws + OFF_keysb)))[i] = make_uint2(pk2bf(v.x, v.y), pk2bf(v.z, v.w));
  }
}

DI void phase_norm(MKP m_in, int l, int which  , bool first, bool skip_ctx) {
  const MK m = launder_mk(m_in);
  const int tid = TID, lane = tid & 63;
  const int gw = BID * 8 + (tid >> 6), nw = NBLK * 8;
  const float* g = (which ? m.g_norm_ffn : m.g_norm_mix) + l * D;
  const float* modv_l = ((float*)(m.ws + OFF_modv)) + (size_t)l * 3 * NMOD;
  for (int r = gw; r < R; r += nw) {
    const int b = r / NT, p = r % NT;
    if (skip_ctx && p < CTX) continue;
    const int mrow = p < CTX ? 2 : b;
    const float4* src = (const float4*)(first ? (p < CTX ? m.ctx + ((size_t)b * CTX + p) * D : m.x + ((size_t)b * SEQ + (p - CTX)) * D)
                                              : ((float*)(m.ws + OFF_xs)) + (size_t)r * D);
    float4 v[4];
    float ss = 0.f;
#pragma unroll
    for (int i = 0; i < 4; ++i) { v[i] = src[lane + 64 * i]; ss += v[i].x * v[i].x + v[i].y * v[i].y + v[i].z * v[i].z + v[i].w * v[i].w; }
    for (int o = 32; o > 0; o >>= 1) ss += shxl(ss, lane, o);
    const float rs = rsqrtf(ss * (1.f / D) + EPS);
    const float* sh = modv_l + mrow * NMOD + (which ? 3 : 0) * D;
    const float* sc = sh + D;
#pragma unroll
    for (int i = 0; i < 4; ++i) {
      const int c0 = (lane + 64 * i) * 4;
      float4 gg = *(const float4*)(g + c0), s4 = *(const float4*)(sc + c0), h4 = *(const float4*)(sh + c0);
      float o0 = v[i].x * rs * gg.x * (1.f + s4.x) + h4.x, o1 = v[i].y * rs * gg.y * (1.f + s4.y) + h4.y;
      float o2 = v[i].z * rs * gg.z * (1.f + s4.z) + h4.z, o3 = v[i].w * rs * gg.w * (1.f + s4.w) + h4.w;
      *(uint2*)(((bf16_t*)(m.ws + OFF_hbuf)) + (size_t)r * D + c0) = make_uint2(pk2bf(o0, o1), pk2bf(o2, o3));
      if (first) ((float4*)(((float*)(m.ws + OFF_xs)) + (size_t)r * D))[lane + 64 * i] = v[i];
    }
  }
}

DI int rowtile_of(int i, bool latent_only) { return latent_only ? (i / 64) * 66 + 2 + (i % 64) : i; }
template <int EPI>
DI void phase_gemm(const bf16_t* A, const bf16_t* Wt, int N, bf16_t* Cb, float* xs, const float* gate_base, bool latent_only, char* smem) {
  const int nt_n = N / 128, nrt = latent_only ? 128 : 132, ntiles = nrt * nt_n;
  for (int t = BID; t < ntiles; t += NBLK) {
    int tm = rowtile_of(t / nt_n, latent_only), tn = t % nt_n;
    gemm_tile<EPI>(A, Wt, N, tm * 128, tn * 128, smem, Cb, xs, gate_base);
  }
}

DI void rope_pair8(float (&y)[8], const float (&part)[8], bool upper, const float* cs, const float* sn, int dd0) {
#pragma unroll
  for (int e = 0; e < 8; ++e) {
    float c = cs[dd0 + e], s = sn[dd0 + e];
    float x1 = upper ? part[e] : y[e], x2 = upper ? y[e] : part[e];
    y[e] = upper ? (x1 * s + x2 * c) : (x1 * c - x2 * s);
  }
}
DI void unpack8(uint4 w, float (&v)[8]) {
  v[0] = bflo(w.x); v[1] = bfhi(w.x); v[2] = bflo(w.y); v[3] = bfhi(w.y); v[4] = bflo(w.z); v[5] = bfhi(w.z); v[6] = bflo(w.w); v[7] = bfhi(w.w);
}
DI uint4 pack8(const float (&v)[8], float sc) {
  return make_uint4(pk2bf(v[0] * sc, v[1] * sc), pk2bf(v[2] * sc, v[3] * sc), pk2bf(v[4] * sc, v[5] * sc), pk2bf(v[6] * sc, v[7] * sc));
}
constexpr int VS_STRIDE = 1032;
constexpr int HS_STRIDE = 1536;
DI void prep_tile(MKP m_in, int l, int tile, char* smem) {
  const MK m = launder_mk(m_in);
  const int tid = TID, lane = tid & 63, wid = tid >> 6;
  const int r0 = tile * 32; const int b = r0 / NT, p0 = r0 % NT;
  const bool lat = p0 >= CTX;
  char* Vs = smem;
  char* Hs = smem + 33280;
  float* csh = (float*)(smem + 33280 + 52224);
  const bf16_t* Pb = ((bf16_t*)(m.ws + OFF_P)) + (size_t)(b * NT) * DIN;
  __syncthreads();
  if (lat) {
    for (int i = tid; i < 32 * 48; i += NTHR) {
      int rr = i / 48, a = i % 48;
      int t = p0 + rr - CTX;
      float trow = (float)(t / 64), tcol = (float)(t % 64);
      float* rowp = csh + rr * 96;
      if (a < 16) {
        int j = a & 7; float f = exp2f(-(float)j * (13.287712379549449f / 8.f));
        float ang = (a < 8 ? trow : tcol) * f;
        rowp[a] = cosf(ang); rowp[16 + a] = sinf(ang);
      } else {
        int aa = a - 16; int j = aa & 15; float f = exp2f(-(float)j * (13.287712379549449f / 16.f));
        float ang = (aa < 16 ? trow : tcol) * f;
        rowp[32 + aa] = cosf(ang); rowp[64 + aa] = sinf(ang);
      }
    }
  }
  {
    const int seg_lo = lat ? CTX : 0, seg_hi = lat ? NT : CTX;
    for (int ch = tid; ch < 34 * 96; ch += NTHR) {
      int rr = ch / 96, c8 = ch % 96;
      int p = p0 - 1 + rr;
      uint4 v = make_uint4(0, 0, 0, 0);
      if (p >= seg_lo && p < seg_hi) v = *(const uint4*)(Pb + (size_t)p * DIN + 1792 + c8 * 8);
      *(uint4*)(Hs + rr * HS_STRIDE + c8 * 16) = v;
    }
  }
  __syncthreads();
  const float* gd = m.g_qk_diff + l * 64; const float* gwn = m.g_qk_win + l * 128; const float* gg = m.g_qk_glob + l * 128;
#pragma unroll 1
  for (int k = 0; k < 4; ++k) {
    const int rr = wid + 8 * k; const int p = p0 + rr;
    const bf16_t* Pr = Pb + (size_t)p * DIN;
    const float* rowp = csh + rr * 96;
    {
      float y[8], part[8];
      unpack8(*(const uint4*)(Pr + 8 * lane), y);
      float ss = 0.f;
#pragma unroll
      for (int e = 0; e < 8; ++e) ss += y[e] * y[e];
      ss += shxl(ss, lane, 1); ss += shxl(ss, lane, 2);
      const float rs = rsqrtf(ss * (1.f / 32) + EPS);
      const int unit = lane >> 2; const bool isk = unit >= 8; const int vh = unit & 7;
      const int d0 = (lane & 3) * 8;
      const float* gn = gd + (isk ? 32 : 0) + d0;
#pragma unroll
      for (int e = 0; e < 8; ++e) y[e] = y[e] * rs * gn[e];
      if (lat) {
#pragma unroll
        for (int e = 0; e < 8; ++e) part[e] = shxl(y[e], lane, 2);
        rope_pair8(y, part, (lane & 2) != 0, rowp, rowp + 16, (lane & 1) * 8);
      }
      bf16_t* dst = (isk ? ((bf16_t*)(m.ws + OFF_KA)) : ((bf16_t*)(m.ws + OFF_QA))) + (((size_t)b * 8 + vh) * NT + p) * 32 + d0;
      *(uint4*)dst = pack8(y, isk ? 1.f : 0.17677669529663687f * LOG2E);
    }
#pragma unroll
    for (int grp = 0; grp < 2; ++grp) {
      float y[8], part[8];
      const int cbase = grp == 0 ? 768 : 1280;
      uint4 w = make_uint4(0, 0, 0, 0);
      if (lane < 48) w = *(const uint4*)(Pr + cbase + 8 * lane);
      unpack8(w, y);
      float ss = 0.f;
#pragma unroll
      for (int e = 0; e < 8; ++e) ss += y[e] * y[e];
      ss += shxl(ss, lane, 1); ss += shxl(ss, lane, 2); ss += shxl(ss, lane, 4);
      const float rs = rsqrtf(ss * (1.f / 64) + EPS);
      const int unit = lane >> 3; const bool isk = unit >= 4; const int hh = isk ? unit - 4 : unit;
      const int d0 = (lane & 7) * 8;
      const float* gn = (grp == 0 ? gwn : gg) + (isk ? 64 : 0) + d0;
      if (lane < 48) {
#pragma unroll
        for (int e = 0; e < 8; ++e) y[e] = y[e] * rs * gn[e];
      }
      if (lat) {
#pragma unroll
        for (int e = 0; e < 8; ++e) part[e] = shxl(y[e], lane, 4);
        rope_pair8(y, part, (lane & 4) != 0, rowp + 32, rowp + 64, (lane & 3) * 8);
      }
      if (lane < 48) {
        bf16_t* base = grp == 0 ? (isk ? ((bf16_t*)(m.ws + OFF_KW)) : ((bf16_t*)(m.ws + OFF_QW))) : (isk ? ((bf16_t*)(m.ws + OFF_KG)) : ((bf16_t*)(m.ws + OFF_QG)));
        bf16_t* dst = base + (((size_t)b * (isk ? 2 : 4) + hh) * NT + p) * 64 + d0;
        *(uint4*)dst = pack8(y, isk ? 1.f : 0.125f * LOG2E);
      }
    }
    {
      const int vsrc = lane < 32 ? 512 + 8 * lane : (lane < 48 ? 1152 + 8 * (lane - 32) : 1664 + 8 * (lane - 48));
      uint4 w = *(const uint4*)(Pr + vsrc);
      *(uint2*)(Vs + rr * VS_STRIDE + lane * 16) = make_uint2(w.x, w.y);
      *(uint2*)(Vs + rr * VS_STRIDE + lane * 16 + 8) = make_uint2(w.z, w.w);
    }
  }
  __syncthreads();
  for (int tk = tid; tk < 2048; tk += NTHR) {
    const int pg = tk & 3; const int vch = (tk >> 2) & 15 | ((tk >> 6) << 4);
    unsigned short e[8];
#pragma unroll
    for (int i = 0; i < 8; ++i) {
      int sidx = 8 * pg + i;
      int pl = (sidx & 16) | perm16(sidx & 15);
      e[i] = *(const unsigned short*)(Vs + pl * VS_STRIDE + vch * 2);
    }
    uint4 w = make_uint4(e[0] | ((unsigned)e[1] << 16), e[2] | ((unsigned)e[3] << 16), e[4] | ((unsigned)e[5] << 16), e[6] | ((unsigned)e[7] << 16));
    bf16_t* dst;
    if (vch < 256) dst = ((bf16_t*)(m.ws + OFF_VAt)) + (((size_t)b * 4 + (vch >> 6)) * 64 + (vch & 63)) * NT;
    else if (vch < 384) dst = ((bf16_t*)(m.ws + OFF_VWt)) + (((size_t)b * 2 + ((vch - 256) >> 6)) * 64 + (vch & 63)) * NT;
    else dst = ((bf16_t*)(m.ws + OFF_VGt)) + (((size_t)b * 2 + ((vch - 384) >> 6)) * 64 + (vch & 63)) * NT;
    *(uint4*)(dst + p0 + 8 * pg) = w;
  }
  {
    const float* cw = m.hy_conv_w + l * 3 * 768; const float* cb = m.hy_conv_b + l * 768;
    for (int c = tid; c < 768; c += NTHR) {
      const float w0 = cw[c], w1 = cw[768 + c], w2 = cw[1536 + c], bb = cb[c];
      float* dst = ((float*)(m.ws + OFF_uT)) + ((size_t)b * 768 + c) * NT + p0;
      float prev = bf2f(*(const bf16_t*)(Hs + 0 * HS_STRIDE + c * 2));
      float cur = bf2f(*(const bf16_t*)(Hs + 1 * HS_STRIDE + c * 2));
#pragma unroll 1
      for (int pg = 0; pg < 8; ++pg) {
        float o[4];
#pragma unroll
        for (int i = 0; i < 4; ++i) {
          float nxt = bf2f(*(const bf16_t*)(Hs + (4 * pg + i + 2) * HS_STRIDE + c * 2));
          o[i] = prev * w0 + cur * w1 + nxt * w2 + bb;
          prev = cur; cur = nxt;
        }
        *(float4*)(dst + 4 * pg) = make_float4(o[0], o[1], o[2], o[3]);
      }
    }
  }
}

DI void hyena_ctx_channel(MKP m_in, int l, int c, char* smem) {
  const MK m = launder_mk(m_in);
  float* kf = (float*)smem;
  float* vz = kf + 1024;
  float* red = vz + 512;
  float* wcol = red + 16;
  const int tid = TID;
  const float* hd = ((float*)(m.ws + OFF_hdn2)) + ((size_t)l * NT + SEQ) * 64;
  const float* w3 = m.hy_w3 + (size_t)l * 64 * 1024; const float* b3 = m.hy_b3 + l * 1024;
  __syncthreads();
  if (tid < 256) { int od = tid >> 6, i = tid & 63; wcol[od * 64 + i] = w3[i * 1024 + (od >> 1) * 512 + (od & 1) * 256 + c]; }
  __syncthreads();
  const float delta = fabsf(-3.0701134573253944f + (float)c * ((-15.350567286626972f + 3.0701134573253944f) / 255.f));
  float n0 = 0.f, n1 = 0.f;
  if (tid < 256) {
    const int j = tid;
    float f00 = b3[c], f01 = b3[256 + c], f10 = b3[512 + c], f11 = b3[768 + c];
    for (int i = 0; i < 64; ++i) {
      float hv = hd[j * 64 + i];
      f00 += hv * wcol[i]; f01 += hv * wcol[64 + i]; f10 += hv * wcol[128 + i]; f11 += hv * wcol[192 + i];
    }
    const float dec = __expf(-((float)j / (float)(CTX - 1)) * delta);
    f00 *= dec; f01 *= dec; f10 *= dec; f11 *= dec;
    kf[256 + j] = f00; kf[512 + 256 + j] = f10; n0 += fabsf(f00); n1 += fabsf(f10);
    if (j > 0) { kf[256 - j] = f01; kf[512 + 256 - j] = f11; n0 += fabsf(f01); n1 += fabsf(f11); }
    else { kf[0] = 0.f; kf[512] = 0.f; }
  }
  n0 = block_sum_512(n0, red);
  n1 = block_sum_512(n1, red);
  const float i0 = 1.f / n0, i1 = 1.f / n1;
  const int bb = tid >> 8, t = tid & 255;
  const float* ub = ((float*)(m.ws + OFF_uT)) + ((size_t)bb * 768 + c) * NT;
  const float vself = ub[t];
  vz[bb * 256 + t] = vself;
  __syncthreads();
  float acc = 0.f;
  for (int s2 = 0; s2 < 256; ++s2) acc += vz[bb * 256 + s2] * kf[256 + t - s2];
  const float z = ub[(size_t)256 * NT + t] * (acc * i0 + m.hy_bias[l * 512 + c] * vself);
  __syncthreads();
  vz[bb * 256 + t] = z;
  __syncthreads();
  float acc2 = 0.f;
  for (int s2 = 0; s2 < 256; ++s2) acc2 += vz[bb * 256 + s2] * kf[512 + 256 + t - s2];
  ((float*)(m.ws + OFF_yT))[((size_t)bb * 256 + c) * NT + t] = ub[(size_t)512 * NT + t] * (acc2 * i1 + m.hy_bias[l * 512 + 256 + c] * z);
}

DI void phase_mix(MKP m_in, int l, bool want_ctx, char* smem) {
  const MK m = launder_mk(m_in);
  AttnArgs a;
  a.QA = ((bf16_t*)(m.ws + OFF_QA)); a.KA = ((bf16_t*)(m.ws + OFF_KA)); a.VAt = ((bf16_t*)(m.ws + OFF_VAt)); a.QW = ((bf16_t*)(m.ws + OFF_QW)); a.KW = ((bf16_t*)(m.ws + OFF_KW)); a.VWt = ((bf16_t*)(m.ws + OFF_VWt)); a.QG = ((bf16_t*)(m.ws + OFF_QG)); a.KG = ((bf16_t*)(m.ws + OFF_KG)); a.VGt = ((bf16_t*)(m.ws + OFF_VGt));
  a.g_qk_diff = m.g_qk_diff + l * 64; a.g_qk_win = m.g_qk_win + l * 128; a.g_qk_glob = m.g_qk_glob + l * 128; a.sink = m.sink_win + l * 4;
  a.lambda_diff = m.lambda_diff + l * 128; a.g_mix_out = m.g_mix_out + l * D; a.lambda_init = 0.8f - 0.6f * __expf(-0.3f * (float)l); a.pad0 = 0;
  a.A2 = ((bf16_t*)(m.ws + OFF_A2)); a.Oslab = ((float*)(m.ws + OFF_Oslab)); a.Lslab = ((float*)(m.ws + OFF_Lslab));
  const int nitems = 640 + (want_ctx ? 20 : 0);
  for (int rep = 0; rep < REP_DIFF; ++rep) for (int idx = BID; idx < 256; idx += NBLK) attn_dispatch(a, idx, want_ctx, smem);
  for (int rep = 0; rep < REP_GLOB; ++rep) for (int idx = 256 + BID; idx < 512; idx += NBLK) attn_dispatch(a, idx, want_ctx, smem);
  for (int rep = 0; rep < REP_HY; ++rep) for (int c = BID; c < 256; c += NBLK) {
    hyena_channel(c, ((float*)(m.ws + OFF_hdn2)) + (size_t)l * NT * 64, m.hy_w3 + (size_t)l * 64 * 1024, m.hy_b3 + l * 1024, m.hy_bias + l * 512, ((float*)(m.ws + OFF_uT)), ((float*)(m.ws + OFF_zT)), ((float*)(m.ws + OFF_yT)),
                  ((float2*)(m.ws + OFF_Hc)), smem);
    if (want_ctx) hyena_ctx_channel(m_in, l, c, smem);
  }
  for (int idx = 512 + BID; idx < nitems; idx += NBLK) attn_dispatch(a, idx, want_ctx, smem);
}

DI void phase_fin(MKP m_in, int l, bool want_ctx) {
  const MK m = launder_mk(m_in);
  const float* gmo = m.g_mix_out + l * D;
  for (int idx = BID * NTHR + TID; idx < NB * 8 * NT; idx += NBLK * NTHR) {
    const int p = idx % NT; const int hd = (idx / NT) % 8; const int b = idx / (NT * 8);
    if (p < CTX && !want_ctx) continue;
    float o[64]; float ss = 0.f;
    if (hd < 4) {
      size_t i0 = (((size_t)0 * NB + b) * 4 + hd) * NT + p, i1 = (((size_t)1 * NB + b) * 4 + hd) * NT + p;
      const float inv = 1.f / (((float*)(m.ws + OFF_Lslab))[i0] + ((float*)(m.ws + OFF_Lslab))[i1]);
      const float4* a0 = (const float4*)(((float*)(m.ws + OFF_Oslab)) + i0 * 64); const float4* a1 = (const float4*)(((float*)(m.ws + OFF_Oslab)) + i1 * 64);
#pragma unroll
      for (int i = 0; i < 16; ++i) {
        float4 x = a0[i], y = a1[i];
        o[4 * i] = (x.x + y.x) * inv; o[4 * i + 1] = (x.y + y.y) * inv; o[4 * i + 2] = (x.z + y.z) * inv; o[4 * i + 3] = (x.w + y.w) * inv;
      }
    } else {
      const int g = hd - 4;
#pragma unroll
      for (int i = 0; i < 64; ++i) o[i] = ((float*)(m.ws + OFF_yT))[((size_t)b * 256 + g * 64 + i) * NT + p];
    }
#pragma unroll
    for (int i = 0; i < 64; ++i) ss += o[i] * o[i];
    const float rs = rsqrtf(ss * (1.f / 64) + EPS);
    const float* gm = gmo + 512 + hd * 64;
    uint4* dst = (uint4*)(((bf16_t*)(m.ws + OFF_A2)) + ((size_t)b * NT + p) * D + 512 + hd * 64);
#pragma unroll
    for (int i = 0; i < 8; ++i)
      dst[i] = make_uint4(pk2bf(o[8 * i] * rs * gm[8 * i], o[8 * i + 1] * rs * gm[8 * i + 1]), pk2bf(o[8 * i + 2] * rs * gm[8 * i + 2], o[8 * i + 3] * rs * gm[8 * i + 3]),
                          pk2bf(o[8 * i + 4] * rs * gm[8 * i + 4], o[8 * i + 5] * rs * gm[8 * i + 5]), pk2bf(o[8 * i + 6] * rs * gm[8 * i + 6], o[8 * i + 7] * rs * gm[8 * i + 7]));
  }
}

DI void phase_peer(MKP m_in, int l, bool want_ctx, bool last, char* smem) {
  const MK m = launder_mk(m_in);
  float* wd = (float*)smem + (TID >> 6) * 128;
  const float* modv_l = ((float*)(m.ws + OFF_modv)) + (size_t)l * 3 * NMOD;
  for (int r = BID * 8 + (TID >> 6); r < R; r += NBLK * 8) {
    if ((r % NT) < CTX && !want_ctx) continue;
    peer_token(r, ((bf16_t*)(m.ws + OFF_hbuf)), ((int*)(m.ws + OFF_experts)), ((float*)(m.ws + OFF_gates)), ((unsigned char*)(m.ws + OFF_u8)) + (size_t)l * 16384 * D, ((float*)(m.ws + OFF_us)) + l * 16384, ((unsigned char*)(m.ws + OFF_v8)) + (size_t)l * 16384 * D, ((float*)(m.ws + OFF_vs)) + l * 16384,
               modv_l, ((float*)(m.ws + OFF_xs)), wd, last ? m.out : nullptr);
  }
}

DI void phase_scores(MKP m_in, int l, bool last, char* smem) {
  const MK m = launder_mk(m_in);
  const int nrt = last ? 128 : 132;
  for (int t = BID; t < nrt * 16; t += NBLK)
    score_tile(((bf16_t*)(m.ws + OFF_P)), ((bf16_t*)(m.ws + OFF_keysb)) + (size_t)l * 16 * 128 * 128, rowtile_of(t >> 4, last) * 128, t & 15, smem,
               ((unsigned*)(m.ws + OFF_topv)));
}
DI void phase_merge(MKP m_in, bool want_ctx) {
  const MK m = launder_mk(m_in);
  for (int idx = BID * NTHR + TID; idx < R * 8; idx += NBLK * NTHR) {
    int r = idx >> 3;
    if ((r % NT) < CTX && !want_ctx) continue;
    merge_one(((unsigned*)(m.ws + OFF_topv)), r, idx & 7, ((int*)(m.ws + OFF_experts)), ((float*)(m.ws + OFF_gates)));
  }
}
DI void phase_gemm1(MKP m_in, int l, char* smem) {
  const MK m = launder_mk(m_in);
  phase_gemm<0>((bf16_t*)(m.ws + OFF_hbuf), (bf16_t*)(m.ws + OFF_Wt_in) + (size_t)l * DIN * D, DIN, (bf16_t*)(m.ws + OFF_P), nullptr, nullptr, false, smem);
}
DI void phase_gemm2(MKP m_in, int l, bool last, char* smem) {
  const MK m = launder_mk(m_in);
  phase_gemm<1>((bf16_t*)(m.ws + OFF_A2), (bf16_t*)(m.ws + OFF_Wt_out) + (size_t)l * D * D, D, nullptr, (float*)(m.ws + OFF_xs),
                (float*)(m.ws + OFF_modv) + (size_t)l * 3 * NMOD + 2 * D, last, smem);
}
DI void phase_gemm3(MKP m_in, int l, bool last, char* smem) {
  const MK m = launder_mk(m_in);
  phase_gemm<0>((bf16_t*)(m.ws + OFF_hbuf), (bf16_t*)(m.ws + OFF_Wt_q) + (size_t)l * 2048 * D, 2048, (bf16_t*)(m.ws + OFF_P), nullptr, nullptr, last, smem);
}
#define GSYNC() xcd_barrier((unsigned*)(launder_mk(m).ws + OFF_bar), (volatile LAS unsigned*)(smem + SMEM_BYTES))
template <int L>
DI void layer_body(MKP m, char* smem) {
  constexpr bool want_ctx = L == 0, last = L == 1;
  for (int rep = 0; rep < REP_NORM1; ++rep) { phase_norm(m, L, 0, L == 0, false); GSYNC(); }
  for (int rep = 0; rep < REP_GEMM1; ++rep) { phase_gemm1(m, L, smem); GSYNC(); }
  for (int rep = 0; rep < REP_PREP; ++rep) { for (int t = BID; t < R / 32; t += NBLK) prep_tile(m, L, t, smem); GSYNC(); }
  for (int rep = 0; rep < REP_MIX; ++rep) { phase_mix(m, L, want_ctx, smem); GSYNC(); }
  for (int rep = 0; rep < REP_FIN; ++rep) { phase_fin(m, L, want_ctx); GSYNC(); }
  phase_gemm2(m, L, last, smem);
  GSYNC();
  for (int rep = 0; rep < REP_NORM2; ++rep) { phase_norm(m, L, 1, false, last); GSYNC(); }
  for (int rep = 0; rep < REP_GEMM3; ++rep) { phase_gemm3(m, L, last, smem); GSYNC(); }
  for (int rep = 0; rep < REP_SCORES; ++rep) { phase_scores(m, L, last, smem); GSYNC(); }
  for (int rep = 0; rep < REP_MERGE; ++rep) { phase_merge(m, want_ctx); GSYNC(); }
  for (int rep = 0; rep < (last ? REP_PEER_LAST : 1); ++rep) {
    phase_peer(m, L, want_ctx, last, smem);
    if (!last || rep + 1 < REP_PEER_LAST) GSYNC();
  }
}
__global__ __launch_bounds__(NTHR) void k_mega(MK m_unused) {
  extern __shared__ __attribute__((aligned(16))) char smem[];
  (void)m_unused;
  MKP m = (MKP)__builtin_amdgcn_kernarg_segment_ptr();
  {
    volatile LAS unsigned* st = (volatile LAS unsigned*)(smem + SMEM_BYTES);
    if (threadIdx.x == 0) { st[0] = 0u; st[1] = 0u; st[2] = 0u; st[3] = 0u; }
    __syncthreads();
    xcd_barrier_post((unsigned*)(launder_mk(m).ws + OFF_bar));
  }
  for (int rep = 0; rep < REP_P0; ++rep) { phase0(m, smem); GSYNC(); }
  layer_body<0>(m, smem);
  layer_body<1>(m, smem);
}

extern "C" void kernel_launch(void* const* d_in, const int* in_sizes, int n_in, void* d_out, int out_size, void* d_ws, size_t ws_size,
                              hipStream_t stream) {
  (void)in_sizes; (void)n_in; (void)out_size;
  MK m;
  memset(&m, 0, sizeof(m));
  const float** ip = (const float**)&m.x;
  for (int i = 0; i < 30; ++i) ip[i] = (const float*)d_in[i];
  m.out = (float*)d_out;
  m.ws = (char*)d_ws;
  if (WS_TOTAL > ws_size) return;

  static int grid_blocks = 0;
  if (!grid_blocks) {
    (void)hipFuncSetAttribute((const void*)k_mega, hipFuncAttributeMaxDynamicSharedMemorySize, SMEM_BYTES + 16);
    int dev = 0, cus = 0, per_cu = 0;
    (void)hipGetDevice(&dev);
    (void)hipDeviceGetAttribute(&cus, hipDeviceAttributeMultiprocessorCount, dev);
    (void)hipOccupancyMaxActiveBlocksPerMultiprocessor(&per_cu, k_mega, NTHR, SMEM_BYTES + 16);
    if (per_cu > 1) per_cu = 1;
    grid_blocks = cus * per_cu;
  }
  (void)hipMemsetAsync(m.ws + OFF_bar, 0, (size_t)XCD_BAR_WORDS * 4, stream);
  void* args[] = {&m};
  (void)hipLaunchCooperativeKernel((void*)k_mega, dim3(grid_blocks), dim3(NTHR), args, SMEM_BYTES + 16, stream);
}
```

```cpp
#include <hip/hip_runtime.h>
#ifndef REP_DIFF
#define REP_DIFF 1
#endif
#ifndef REP_GLOB
#define REP_GLOB 1
#endif
#ifndef REP_HY
#define REP_HY 1
#endif
#ifndef REP_NORM1
#define REP_NORM1 1
#endif
#ifndef REP_GEMM1
#define REP_GEMM1 1
#endif
#ifndef REP_PREP
#define REP_PREP 1
#endif
#ifndef REP_MIX
#define REP_MIX 1
#endif
#ifndef REP_FIN
#define REP_FIN 1
#endif
#ifndef REP_NORM2
#define REP_NORM2 1
#endif
#ifndef REP_GEMM3
#define REP_GEMM3 1
#endif
#ifndef REP_SCORES
#define REP_SCORES 1
#endif
#ifndef REP_MERGE
#define REP_MERGE 1
#endif
#ifndef REP_PEER_LAST
#define REP_PEER_LAST 1
#endif
#ifndef REP_P0
#define REP_P0 1
#endif
#include <hip/hip_cooperative_groups.h>
namespace cg = cooperative_groups;
#include <stdint.h>
#include <string.h>

#define DI __device__ __forceinline__
typedef unsigned short bf16_t;

constexpr int D = 1024;
constexpr int NB = 2;
constexpr int SEQ = 8192;
constexpr int CTX = 256;
constexpr int NT = SEQ + CTX;
constexpr int R = NB * NT;
constexpr int DIN = 2560;
constexpr int NMOD = 6 * D;
constexpr float EPS = 1e-6f;
constexpr float LOG2E = 1.4426950408889634f;

DI int opq_v(int x) { asm volatile("" : "+v"(x)); return x; }
DI int opq_s(int x) { asm volatile("" : "+s"(x)); return x; }
template <class T> DI T* opq_p(T* p) { asm volatile("" : "+s"(p)); return p; }
#define TID opq_v((int)threadIdx.x)
#define BID opq_s((int)blockIdx.x)
#define NBLK opq_s((int)gridDim.x)
DI float shxl(float v, int lane, int mask) { return __builtin_bit_cast(float, __builtin_amdgcn_ds_bpermute((lane ^ mask) << 2, __builtin_bit_cast(int, v))); }
DI int shxl(int v, int lane, int mask) { return __builtin_amdgcn_ds_bpermute((lane ^ mask) << 2, v); }
DI float shx(float v, int mask) { return shxl(v, opq_v((int)threadIdx.x) & 63, mask); }
DI bf16_t f2bf(float x) { unsigned u = __float_as_uint(x); u += 0x7fffu + ((u >> 16) & 1u); return (bf16_t)(u >> 16); }
DI float bf2f(bf16_t h) { return __uint_as_float(((unsigned)h) << 16); }
DI float bflo(unsigned w) { return __uint_as_float(w << 16); }
DI float bfhi(unsigned w) { return __uint_as_float(w & 0xffff0000u); }

DI float block_sum_256(float v, float* red) {
  for (int o = 32; o > 0; o >>= 1) v += shx(v, o);
  int w = TID >> 6;
  __syncthreads();
  if ((TID & 63) == 0) red[w] = v;
  __syncthreads();
  float s = red[0] + red[1] + red[2] + red[3];
  return s;
}

DI int perm16(int o) { return (o & 3) | ((o & 4) << 1) | ((o & 8) >> 1); }

typedef __attribute__((ext_vector_type(8))) short bf16x8;
typedef __attribute__((ext_vector_type(16))) float f32x16;
typedef __attribute__((ext_vector_type(2))) __bf16 bf16x2_t;
typedef __attribute__((ext_vector_type(2))) float f32x2_t;
#define MFMA32(a, b, c) __builtin_amdgcn_mfma_f32_32x32x16_bf16((a), (b), (c), 0, 0, 0)
DI unsigned pk2bf(float a, float b) { f32x2_t v = {a, b}; return __builtin_bit_cast(unsigned, __builtin_convertvector(v, bf16x2_t)); }
constexpr int NTHR = 512;

DI void wconv_tile(const float* __restrict__ W, bf16_t* __restrict__ Wt, int N, int tile, float* sm  ) {
  int tn = tile % (N / 64), tk = tile / (N / 64);
  int tid = TID;
  __syncthreads();
  for (int i = tid; i < 64 * 16; i += NTHR) {
    int kr = i >> 4, c4 = (i & 15) * 4;
    float4 v = *(const float4*)(W + (size_t)(tk * 64 + kr) * N + tn * 64 + c4);
    sm[kr * 65 + c4] = v.x; sm[kr * 65 + c4 + 1] = v.y; sm[kr * 65 + c4 + 2] = v.z; sm[kr * 65 + c4 + 3] = v.w;
  }
  __syncthreads();
  for (int i = tid; i < 64 * 8; i += NTHR) {
    int n = i >> 3, k8 = (i & 7) * 8;
    unsigned w[4];
    for (int j = 0; j < 4; ++j) w[j] = pk2bf(sm[(k8 + 2 * j) * 65 + n], sm[(k8 + 2 * j + 1) * 65 + n]);
    *(uint4*)(Wt + (size_t)(tn * 64 + n) * D + tk * 64 + k8) = make_uint4(w[0], w[1], w[2], w[3]);
  }
}

template <int EPI>
DI void gemm_tile(const bf16_t* __restrict__ A, const bf16_t* __restrict__ Wt, int N, int m0, int n0, char* smem, bf16_t* __restrict__ Cb,
                  float* __restrict__ xs, const float* __restrict__ gate_base) {
  constexpr int K = D;
  const int tid = TID, lane = tid & 63, wid = tid >> 6;
  const int wm = wid & 1, wn = wid >> 1;
  const int r = lane & 31, h = lane >> 5;
  f32x16 acc0, acc1;
  for (int i = 0; i < 16; ++i) { acc0[i] = 0.f; acc1[i] = 0.f; }
  const int lrow = tid >> 3, lch = tid & 7;
  const bf16_t* Ag = A + (size_t)(m0 + lrow) * K + lch * 8;
  const bf16_t* Bg = Wt + (size_t)(n0 + lrow) * K + lch * 8;
  const int woff = lrow * 128 + ((lch ^ ((lrow >> 1) & 7)) << 4);
  uint4 ra0, ra1, rb0, rb1;
  ra0 = *(const uint4*)(Ag); ra1 = *(const uint4*)(Ag + (size_t)64 * K);
  rb0 = *(const uint4*)(Bg); rb1 = *(const uint4*)(Bg + (size_t)64 * K);
  __syncthreads();
  *(uint4*)(smem + woff) = ra0; *(uint4*)(smem + woff + 8192) = ra1;
  *(uint4*)(smem + 16384 + woff) = rb0; *(uint4*)(smem + 16384 + woff + 8192) = rb1;
  __syncthreads();
  const int sw = (r >> 1) & 7;
  const int aoff0 = (wm * 64 + r) * 128, aoff1 = aoff0 + 32 * 128;
  const int boff = 16384 + (wn * 32 + r) * 128;
#pragma unroll 1
  for (int kt = 0; kt < K / 64; ++kt) {
    const char* st = smem + (kt & 1) * 32768;
    if (kt + 1 < K / 64) {
      ra0 = *(const uint4*)(Ag + (kt + 1) * 64); ra1 = *(const uint4*)(Ag + (size_t)64 * K + (kt + 1) * 64);
      rb0 = *(const uint4*)(Bg + (kt + 1) * 64); rb1 = *(const uint4*)(Bg + (size_t)64 * K + (kt + 1) * 64);
    }
#pragma unroll
    for (int s = 0; s < 4; ++s) {
      int co = ((2 * s + h) ^ sw) << 4;
      bf16x8 a0 = *(const bf16x8*)(st + aoff0 + co);
      bf16x8 a1 = *(const bf16x8*)(st + aoff1 + co);
      bf16x8 b = *(const bf16x8*)(st + boff + co);
      acc0 = MFMA32(a0, b, acc0);
      acc1 = MFMA32(a1, b, acc1);
    }
    if (kt + 1 < K / 64) {
      char* sn = smem + ((kt + 1) & 1) * 32768;
      *(uint4*)(sn + woff) = ra0; *(uint4*)(sn + woff + 8192) = ra1;
      *(uint4*)(sn + 16384 + woff) = rb0; *(uint4*)(sn + 16384 + woff + 8192) = rb1;
    }
    __syncthreads();
  }
  float* Cs = (float*)smem;
  constexpr int CS = 132;
#pragma unroll
  for (int i = 0; i < 16; ++i) {
    int row = (i & 3) + 8 * (i >> 2) + 4 * h;
    Cs[(wm * 64 + row) * CS + wn * 32 + r] = acc0[i];
    Cs[(wm * 64 + 32 + row) * CS + wn * 32 + r] = acc1[i];
  }
  __syncthreads();
  if (EPI == 0) {
    for (int i = tid; i < 128 * 16; i += NTHR) {
      int row = i >> 4, c8 = (i & 15) * 8;
      const float* cr = Cs + row * CS + c8;
      float4 v0 = *(const float4*)cr, v1 = *(const float4*)(cr + 4);
      *(uint4*)(Cb + (size_t)(m0 + row) * N + n0 + c8) = make_uint4(pk2bf(v0.x, v0.y), pk2bf(v0.z, v0.w), pk2bf(v1.x, v1.y), pk2bf(v1.z, v1.w));
    }
  } else {
    for (int i = tid; i < 128 * 32; i += NTHR) {
      int row = i >> 5, c4 = (i & 31) * 4;
      int rr = m0 + row; int b = rr / NT, p = rr % NT; int mrow = p < CTX ? 2 : b;
      const float* gt = gate_base + mrow * NMOD + n0 + c4;
      float4 v = *(const float4*)(Cs + row * CS + c4);
      float4 xv = *(float4*)(xs + (size_t)rr * D + n0 + c4);
      xv.x += gt[0] * v.x; xv.y += gt[1] * v.y; xv.z += gt[2] * v.z; xv.w += gt[3] * v.w;
      *(float4*)(xs + (size_t)rr * D + n0 + c4) = xv;
    }
  }
}


struct AttnArgs {
  const bf16_t *QA, *KA, *VAt, *QW, *KW, *VWt, *QG, *KG, *VGt;
  const float *g_qk_diff, *g_qk_win, *g_qk_glob, *sink, *lambda_diff, *g_mix_out;
  float lambda_init;
  int pad0;
  bf16_t* A2;
  float* Oslab;
  float* Lslab;
};

template <int TYPE>
DI void attn_item(const AttnArgs& a, int b, int g, int p0, int ctx0, int nctx, int lat0, int nkt, int half, char* smem) {
  constexpr int DQK = TYPE == 0 ? 32 : 64;
  constexpr int KS = DQK / 16;
  const int tid = TID, lane = tid & 63, wid = tid >> 6;
  const int r = lane & 31, h = lane >> 5;
  const bf16_t *Q0, *Q1, *K0, *K1, *Vt;
  const float* gqk;
  if (TYPE == 0) {
    Q0 = a.QA + ((size_t)b * 8 + 2 * g) * NT * 32; Q1 = Q0 + (size_t)NT * 32;
    K0 = a.KA + ((size_t)b * 8 + 2 * g) * NT * 32; K1 = K0 + (size_t)NT * 32;
    Vt = a.VAt + ((size_t)b * 4 + g) * 64 * NT; gqk = a.g_qk_diff;
  } else if (TYPE == 1) {
    Q0 = a.QW + ((size_t)b * 4 + 2 * g) * NT * 64; Q1 = Q0 + (size_t)NT * 64;
    K0 = a.KW + ((size_t)b * 2 + g) * NT * 64; K1 = K0;
    Vt = a.VWt + ((size_t)b * 2 + g) * 64 * NT; gqk = a.g_qk_win;
  } else {
    Q0 = a.QG + ((size_t)b * 4 + 2 * g) * NT * 64; Q1 = Q0 + (size_t)NT * 64;
    K0 = a.KG + ((size_t)b * 2 + g) * NT * 64; K1 = K0;
    Vt = a.VGt + ((size_t)b * 2 + g) * 64 * NT; gqk = a.g_qk_glob;
  }
  (void)gqk;
  const int qpos = p0 + wid * 32 + r;
  bf16x8 qf0[KS], qf1[KS];
#pragma unroll
  for (int s = 0; s < KS; ++s) {
    qf0[s] = *(const bf16x8*)(Q0 + (size_t)qpos * DQK + 16 * s + 8 * h);
    qf1[s] = *(const bf16x8*)(Q1 + (size_t)qpos * DQK + 16 * s + 8 * h);
  }
  f32x16 O00, O01, O10, O11, Zero;
#pragma unroll
  for (int i = 0; i < 16; ++i) { O00[i] = 0.f; O01[i] = 0.f; O10[i] = 0.f; O11[i] = 0.f; Zero[i] = 0.f; }
  float l0 = 0.f, l1 = 0.f;

  uint4 st0, st1, st2, st3;
  auto tile_of = [&](int it) { return it < nctx ? ctx0 + it : lat0 + it - nctx; };
  const int vrow0 = tid >> 4, vch = tid & 15;
#define ATT_GLOAD(kt_)                                                                                   \
  {                                                                                                      \
    const int kt__ = (kt_);                                                                              \
    if (TYPE == 0) {                                                                                     \
      st0 = *(const uint4*)(K0 + (size_t)kt__ * 128 * 32 + tid * 8);                                     \
      st1 = *(const uint4*)(K1 + (size_t)kt__ * 128 * 32 + tid * 8);                                     \
    } else {                                                                                             \
      st0 = *(const uint4*)(K0 + (size_t)kt__ * 128 * 64 + tid * 8);                                     \
      st1 = *(const uint4*)(K0 + (size_t)kt__ * 128 * 64 + (tid + 512) * 8);                             \
    }                                                                                                    \
    st2 = *(const uint4*)(Vt + (size_t)vrow0 * NT + kt__ * 128 + vch * 8);                               \
    st3 = *(const uint4*)(Vt + (size_t)(vrow0 + 32) * NT + kt__ * 128 + vch * 8);                        \
  }
#define ATT_SSTORE(sb_)                                                                                  \
  {                                                                                                      \
    char* sb__ = (sb_);                                                                                  \
    if (TYPE == 0) {                                                                                     \
      int row = tid >> 2, ch = tid & 3;                                                                  \
      int off = row * 64 + ((ch ^ ((row >> 2) & 3)) << 4);                                               \
      *(uint4*)(sb__ + off) = st0;                                                                       \
      *(uint4*)(sb__ + 8192 + off) = st1;                                                                \
    } else {                                                                                             \
      int row = tid >> 3, ch = tid & 7;                                                                  \
      int off = row * 128 + ((ch ^ ((row >> 1) & 7)) << 4);                                              \
      *(uint4*)(sb__ + off) = st0;                                                                       \
      *(uint4*)(sb__ + off + 8192) = st1;                                                                \
    }                                                                                                    \
    int voff = 16384 + vrow0 * 256 + ((vch ^ (vrow0 & 15)) << 4);                                        \
    *(uint4*)(sb__ + voff) = st2;                                                                        \
    *(uint4*)(sb__ + voff + 8192) = st3;                                                                 \
  }
  ATT_GLOAD(tile_of(0));
  __syncthreads();
  ATT_SSTORE(smem);
  __syncthreads();
  const int qwave = p0 + wid * 32;
#pragma unroll 1
  for (int it = 0; it < nkt; ++it) {
    const int kt = tile_of(it);
    const char* sb = smem + (it & 1) * 32768;
    if (it + 1 < nkt) ATT_GLOAD(tile_of(it + 1));
#pragma unroll 1
    for (int j = 0; j < 4; ++j) {
      const int kbase = kt * 128 + 32 * j;
      bool masked = false;
      if (TYPE == 1) {
        if (kbase >= CTX && p0 >= CTX) {
          if (kbase > qwave + 31 + 128 || kbase + 31 < qwave - 128) continue;
          masked = true;
        }
      }
      f32x16 S0 = Zero, S1 = Zero;
#pragma unroll
      for (int s = 0; s < KS; ++s) {
        if (TYPE == 0) {
          int row = 32 * j + r;
          int off = row * 64 + (((2 * s + h) ^ ((row >> 2) & 3)) << 4);
          bf16x8 k0 = *(const bf16x8*)(sb + off);
          bf16x8 k1 = *(const bf16x8*)(sb + 8192 + off);
          S0 = MFMA32(k0, qf0[s], S0);
          S1 = MFMA32(k1, qf1[s], S1);
        } else {
          int row = 32 * j + r;
          int off = row * 128 + (((2 * s + h) ^ ((row >> 1) & 7)) << 4);
          bf16x8 k0 = *(const bf16x8*)(sb + off);
          S0 = MFMA32(k0, qf0[s], S0);
          S1 = MFMA32(k0, qf1[s], S1);
        }
      }
      float pa[16], pb[16];
#pragma unroll
      for (int i = 0; i < 16; ++i) {
        float e0 = __builtin_amdgcn_exp2f(S0[i]);
        float e1 = __builtin_amdgcn_exp2f(S1[i]);
        if (TYPE == 1) {
          if (masked) {
            int kp = kbase + (i & 3) + 8 * (i >> 2) + 4 * h;
            int dd = kp - qpos;
            bool ok = (dd <= 128) && (dd >= -128);
            e0 = ok ? e0 : 0.f; e1 = ok ? e1 : 0.f;
          }
        }
        pa[i] = e0; pb[i] = e1;
      }
      l0 += ((pa[0] + pa[1]) + (pa[2] + pa[3])) + ((pa[4] + pa[5]) + (pa[6] + pa[7])) + ((pa[8] + pa[9]) + (pa[10] + pa[11])) + ((pa[12] + pa[13]) + (pa[14] + pa[15]));
      l1 += ((pb[0] + pb[1]) + (pb[2] + pb[3])) + ((pb[4] + pb[5]) + (pb[6] + pb[7])) + ((pb[8] + pb[9]) + (pb[10] + pb[11])) + ((pb[12] + pb[13]) + (pb[14] + pb[15]));
      bf16x8 pf0[2], pf1[2];
#pragma unroll
      for (int s2 = 0; s2 < 2; ++s2) {
        unsigned w0[4], w1[4];
#pragma unroll
        for (int e = 0; e < 4; ++e) {
          w0[e] = pk2bf(pa[8 * s2 + 2 * e], pa[8 * s2 + 2 * e + 1]);
          w1[e] = pk2bf(pb[8 * s2 + 2 * e], pb[8 * s2 + 2 * e + 1]);
        }
        pf0[s2] = __builtin_bit_cast(bf16x8, make_uint4(w0[0], w0[1], w0[2], w0[3]));
        pf1[s2] = __builtin_bit_cast(bf16x8, make_uint4(w1[0], w1[1], w1[2], w1[3]));
      }
#pragma unroll
      for (int s2 = 0; s2 < 2; ++s2) {
        int ch = 4 * j + 2 * s2 + h;
        bf16x8 v0 = *(const bf16x8*)(sb + 16384 + r * 256 + ((ch ^ (r & 15)) << 4));
        bf16x8 v1 = *(const bf16x8*)(sb + 16384 + (32 + r) * 256 + ((ch ^ (r & 15)) << 4));
        O00 = MFMA32(v0, pf0[s2], O00);
        O01 = MFMA32(v1, pf0[s2], O01);
        O10 = MFMA32(v0, pf1[s2], O10);
        O11 = MFMA32(v1, pf1[s2], O11);
      }
    }
    if (it + 1 < nkt) ATT_SSTORE(smem + ((it + 1) & 1) * 32768);
    __syncthreads();
  }
  l0 += shxl(l0, lane, 32);
  l1 += shxl(l1, lane, 32);
  if (TYPE == 1) {
    l0 += __builtin_amdgcn_exp2f(a.sink[2 * g] * LOG2E);
    l1 += __builtin_amdgcn_exp2f(a.sink[2 * g + 1] * LOG2E);
  }
  const size_t orow = (size_t)b * NT + qpos;
  if (TYPE == 2) {
#pragma unroll
    for (int x = 0; x < 2; ++x) {
      int head = 2 * g + x;
      float* dst = a.Oslab + ((((size_t)half * NB + b) * 4 + head) * NT + qpos) * 64;
#pragma unroll
      for (int dt = 0; dt < 2; ++dt) {
        const f32x16& O = x == 0 ? (dt == 0 ? O00 : O01) : (dt == 0 ? O10 : O11);
#pragma unroll
        for (int q4 = 0; q4 < 4; ++q4)
          *(float4*)(dst + 32 * dt + 8 * q4 + 4 * h) = make_float4(O[4 * q4], O[4 * q4 + 1], O[4 * q4 + 2], O[4 * q4 + 3]);
      }
      if (h == 0) a.Lslab[(((size_t)half * NB + b) * 4 + head) * NT + qpos] = x == 0 ? l0 : l1;
    }
  } else if (TYPE == 0) {
    float s0 = 0.f, s1 = 0.f;
    for (int d = 0; d < 32; ++d) { s0 += a.lambda_diff[d] * a.lambda_diff[32 + d]; s1 += a.lambda_diff[64 + d] * a.lambda_diff[96 + d]; }
    const float lam = __expf(s0) - __expf(s1) + a.lambda_init;
    const float i0 = 1.f / l0, i1 = lam / l1;
    float o[32];
    float ss = 0.f;
#pragma unroll
    for (int i = 0; i < 16; ++i) {
      o[i] = O00[i] * i0 - O10[i] * i1;
      o[16 + i] = O01[i] * i0 - O11[i] * i1;
      ss += o[i] * o[i] + o[16 + i] * o[16 + i];
    }
    ss += shxl(ss, lane, 32);
    const float rs = rsqrtf(ss * (1.f / 64) + EPS) * (1.f - a.lambda_init);
    const float* gm = a.g_mix_out + g * 64;
    bf16_t* dst = a.A2 + orow * D + g * 64;
#pragma unroll
    for (int dt = 0; dt < 2; ++dt)
#pragma unroll
      for (int q4 = 0; q4 < 4; ++q4) {
        int dv = 32 * dt + 8 * q4 + 4 * h;
        const float* ov = o + 16 * dt + 4 * q4;
        uint2 w;
        w.x = pk2bf(ov[0] * rs * gm[dv], ov[1] * rs * gm[dv + 1]);
        w.y = pk2bf(ov[2] * rs * gm[dv + 2], ov[3] * rs * gm[dv + 3]);
        *(uint2*)(dst + dv) = w;
      }
  } else {
#pragma unroll
    for (int x = 0; x < 2; ++x) {
      const float inv = 1.f / (x == 0 ? l0 : l1);
      float o[32];
      float ss = 0.f;
#pragma unroll
      for (int i = 0; i < 16; ++i) {
        o[i] = (x == 0 ? O00[i] : O10[i]) * inv;
        o[16 + i] = (x == 0 ? O01[i] : O11[i]) * inv;
        ss += o[i] * o[i] + o[16 + i] * o[16 + i];
      }
      ss += shxl(ss, lane, 32);
      const float rs = rsqrtf(ss * (1.f / 64) + EPS);
      const int col0 = 256 + (2 * g + x) * 64;
      const float* gm = a.g_mix_out + col0;
      bf16_t* dst = a.A2 + orow * D + col0;
#pragma unroll
      for (int dt = 0; dt < 2; ++dt)
#pragma unroll
        for (int q4 = 0; q4 < 4; ++q4) {
          int dv = 32 * dt + 8 * q4 + 4 * h;
          const float* ov = o + 16 * dt + 4 * q4;
          uint2 w;
          w.x = pk2bf(ov[0] * rs * gm[dv], ov[1] * rs * gm[dv + 1]);
          w.y = pk2bf(ov[2] * rs * gm[dv + 2], ov[3] * rs * gm[dv + 3]);
          *(uint2*)(dst + dv) = w;
        }
    }
  }
}

DI void attn_dispatch(const AttnArgs& a, int idx, int want_ctx, char* smem) {
  if (idx < 256) {
    int b = idx >> 7, g = (idx >> 5) & 3, qt = 1 + (idx & 31);
    attn_item<0>(a, b, g, qt * 256, 0, 2, 2, 66, 0, smem);
  } else if (idx < 512) {
    int i = idx - 256; int half = i >> 7, b = (i >> 6) & 1, g = (i >> 5) & 1, qt = 1 + (i & 31);
    if (half == 0) attn_item<2>(a, b, g, qt * 256, 0, 2, 2, 33, 0, smem);
    else attn_item<2>(a, b, g, qt * 256, 0, 0, 33, 33, 1, smem);
  } else if (idx < 640) {
    int i = idx - 512; int b = i >> 6, g = (i >> 5) & 1, qt = 1 + (i & 31);
    int lo = max(2, 2 * qt - 1), hi = min(65, 2 * qt + 2);
    attn_item<1>(a, b, g, qt * 256, 0, 2, lo, 2 + (hi - lo + 1), 0, smem);
  } else if (want_ctx) {
    int i = idx - 640;
    if (i < 8) attn_item<0>(a, i >> 2, i & 3, 0, 0, 2, 0, 2, 0, smem);
    else if (i < 16) { int k = i - 8; int half = k >> 2, b = (k >> 1) & 1, g = k & 1; attn_item<2>(a, b, g, 0, half, 1, 0, 1, half, smem); }
    else if (i < 20) { int k = i - 16; attn_item<1>(a, k >> 1, k & 1, 0, 0, 2, 0, 2, 0, smem); }
  }
}

typedef __attribute__((ext_vector_type(4))) float f32x4v;
DI void tabconv_row(const float* __restrict__ src, unsigned char* __restrict__ dst, float* __restrict__ scale, size_t row) {
  const int lane = TID & 63;
  const float4* sp = (const float4*)(src + row * D + lane * 16);
  float4 v0 = sp[0], v1 = sp[1], v2 = sp[2], v3 = sp[3];
  float m = fmaxf(fmaxf(fmaxf(fabsf(v0.x), fabsf(v0.y)), fmaxf(fabsf(v0.z), fabsf(v0.w))), fmaxf(fmaxf(fabsf(v1.x), fabsf(v1.y)), fmaxf(fabsf(v1.z), fabsf(v1.w))));
  m = fmaxf(m, fmaxf(fmaxf(fmaxf(fabsf(v2.x), fabsf(v2.y)), fmaxf(fabsf(v2.z), fabsf(v2.w))), fmaxf(fmaxf(fabsf(v3.x), fabsf(v3.y)), fmaxf(fabsf(v3.z), fabsf(v3.w)))));
  for (int o = 32; o > 0; o >>= 1) m = fmaxf(m, shxl(m, lane, o));
  m = fmaxf(m, 1e-30f);
  const float sc = m * (1.f / 448.f), inv = 448.f / m;
  int w0 = __builtin_amdgcn_cvt_pk_fp8_f32(v0.x * inv, v0.y * inv, 0, false); w0 = __builtin_amdgcn_cvt_pk_fp8_f32(v0.z * inv, v0.w * inv, w0, true);
  int w1 = __builtin_amdgcn_cvt_pk_fp8_f32(v1.x * inv, v1.y * inv, 0, false); w1 = __builtin_amdgcn_cvt_pk_fp8_f32(v1.z * inv, v1.w * inv, w1, true);
  int w2 = __builtin_amdgcn_cvt_pk_fp8_f32(v2.x * inv, v2.y * inv, 0, false); w2 = __builtin_amdgcn_cvt_pk_fp8_f32(v2.z * inv, v2.w * inv, w2, true);
  int w3 = __builtin_amdgcn_cvt_pk_fp8_f32(v3.x * inv, v3.y * inv, 0, false); w3 = __builtin_amdgcn_cvt_pk_fp8_f32(v3.z * inv, v3.w * inv, w3, true);
  *(uint4*)(dst + row * D + lane * 16) = make_uint4((unsigned)w0, (unsigned)w1, (unsigned)w2, (unsigned)w3);
  if (lane == 0) scale[row] = sc;
}

DI void score_tile(const bf16_t* __restrict__ qbuf, const bf16_t* __restrict__ keysb, int m0, int hp, char* smem, unsigned* __restrict__ topk) {
  const int tid = TID, lane = tid & 63, wid = tid >> 6;
  const int wm = wid & 1, wn = wid >> 1;
  const int r = lane & 31, h = lane >> 5;
  f32x16 acc0, acc1;
  for (int i = 0; i < 16; ++i) { acc0[i] = 0.f; acc1[i] = 0.f; }
  const int lrow = tid >> 3, lch = tid & 7;
  const bf16_t* Ag = qbuf + (size_t)(m0 + lrow) * 2048 + hp * 128 + lch * 8;
  const bf16_t* Bg = keysb + ((size_t)hp * 128 + lrow) * 128 + lch * 8;
  const int woff = lrow * 128 + ((lch ^ ((lrow >> 1) & 7)) << 4);
  __syncthreads();
#pragma unroll
  for (int kt = 0; kt < 2; ++kt) {
    char* sn = smem + kt * 32768;
    *(uint4*)(sn + woff) = *(const uint4*)(Ag + kt * 64);
    *(uint4*)(sn + woff + 8192) = *(const uint4*)(Ag + (size_t)64 * 2048 + kt * 64);
    *(uint4*)(sn + 16384 + woff) = *(const uint4*)(Bg + kt * 64);
    *(uint4*)(sn + 16384 + woff + 8192) = *(const uint4*)(Bg + 64 * 128 + kt * 64);
  }
  __syncthreads();
  const int sw = (r >> 1) & 7;
  const int aoff0 = (wm * 64 + r) * 128, aoff1 = aoff0 + 32 * 128;
  const int boff = 16384 + (wn * 32 + r) * 128;
#pragma unroll
  for (int kt = 0; kt < 2; ++kt) {
    const char* st = smem + kt * 32768;
#pragma unroll
    for (int s = 0; s < 4; ++s) {
      int co = ((2 * s + h) ^ sw) << 4;
      bf16x8 a0 = *(const bf16x8*)(st + aoff0 + co);
      bf16x8 a1 = *(const bf16x8*)(st + aoff1 + co);
      bf16x8 b = *(const bf16x8*)(st + boff + co);
      acc0 = MFMA32(a0, b, acc0);
      acc1 = MFMA32(a1, b, acc1);
    }
  }
  __syncthreads();
  float* Cs = (float*)smem;
  constexpr int CS = 132;
#pragma unroll
  for (int i = 0; i < 16; ++i) {
    int row = (i & 3) + 8 * (i >> 2) + 4 * h;
    Cs[(wm * 64 + row) * CS + wn * 32 + r] = acc0[i];
    Cs[(wm * 64 + 32 + row) * CS + wn * 32 + r] = acc1[i];
  }
  __syncthreads();
  const int row = tid >> 2, q = tid & 3;
  unsigned v[32];
#pragma unroll
  for (int i = 0; i < 32; ++i) {
    unsigned u = __float_as_uint(Cs[row * CS + 4 * i + q]);
    u ^= (u & 0x80000000u) ? 0xffffffffu : 0x80000000u;
    v[i] = (u & ~127u) | (unsigned)(127 - (4 * i + q));
  }
#pragma unroll
  for (int k = 2; k <= 32; k <<= 1)
#pragma unroll
    for (int j = k >> 1; j > 0; j >>= 1)
#pragma unroll
      for (int i = 0; i < 32; ++i) {
        const int l = i ^ j;
        if (l > i) {
          const unsigned lo = min(v[i], v[l]), hi = max(v[i], v[l]);
          if ((i & k) == 0) { v[i] = hi; v[l] = lo; } else { v[i] = lo; v[l] = hi; }
        }
      }
#pragma unroll
  for (int step = 0; step < 2; ++step) {
    unsigned c[16];
#pragma unroll
    for (int i = 0; i < 16; ++i) {
      const unsigned o = step == 0 ? (unsigned)__builtin_amdgcn_mov_dpp((int)v[15 - i], 0xB1, 0xf, 0xf, false)
                                   : (unsigned)__builtin_amdgcn_mov_dpp((int)v[15 - i], 0x4E, 0xf, 0xf, false);
      c[i] = max(v[i], o);
    }
#pragma unroll
    for (int j = 8; j > 0; j >>= 1)
#pragma unroll
      for (int i = 0; i < 16; ++i) {
        const int l = i ^ j;
        if (l > i) { const unsigned lo = min(c[i], c[l]), hi = max(c[i], c[l]); c[i] = hi; c[l] = lo; }
      }
#pragma unroll
    for (int i = 0; i < 16; ++i) v[i] = c[i];
  }
  {
    unsigned* dst = topk + ((size_t)(m0 + row) * 16 + hp) * 16 + 4 * q;
    uint4 w = q == 0 ? make_uint4(v[0], v[1], v[2], v[3]) : q == 1 ? make_uint4(v[4], v[5], v[6], v[7]) : q == 2 ? make_uint4(v[8], v[9], v[10], v[11]) : make_uint4(v[12], v[13], v[14], v[15]);
    *(uint4*)dst = w;
  }
}

DI float key2f(unsigned k) { k &= ~127u; k ^= (k & 0x80000000u) ? 0x80000000u : 0xffffffffu; return __uint_as_float(k); }
DI void merge_one(const unsigned* __restrict__ topk, int r, int hd, int* __restrict__ experts, float* __restrict__ gates) {
  const unsigned* ka = topk + ((size_t)r * 16 + 2 * hd) * 16;
  const unsigned* kb = ka + 16;
  float a[16], bq[16];
#pragma unroll
  for (int i = 0; i < 4; ++i) {
    uint4 x = ((const uint4*)ka)[i], y = ((const uint4*)kb)[i];
    a[4 * i] = key2f(x.x); a[4 * i + 1] = key2f(x.y); a[4 * i + 2] = key2f(x.z); a[4 * i + 3] = key2f(x.w);
    bq[4 * i] = key2f(y.x); bq[4 * i + 1] = key2f(y.y); bq[4 * i + 2] = key2f(y.z); bq[4 * i + 3] = key2f(y.w);
  }
  float cv[50];
  {
    int n = 0;
#pragma unroll
    for (int i = 0; i < 16; ++i)
#pragma unroll
      for (int j = 0; j < 16; ++j)
        if ((i + 1) * (j + 1) <= 16) { cv[n] = a[i] + bq[j]; ++n; }
  }
  int* eo = experts + (size_t)r * 128 + hd * 16;
  float* go = gates + (size_t)r * 128 + hd * 16;
  float mx = 0.f, sum = 0.f;
#pragma unroll 1
  for (int k = 0; k < 16; ++k) {
    float mval = cv[0]; int code = 0;
    {
      int n = 0;
#pragma unroll
      for (int i = 0; i < 16; ++i)
#pragma unroll
        for (int j = 0; j < 16; ++j)
          if ((i + 1) * (j + 1) <= 16) {
            if (n > 0) { bool gt = cv[n] > mval; mval = gt ? cv[n] : mval; code = gt ? (i * 16 + j) : code; }
            ++n;
          }
    }
    {
      int n = 0;
#pragma unroll
      for (int i = 0; i < 16; ++i)
#pragma unroll
        for (int j = 0; j < 16; ++j)
          if ((i + 1) * (j + 1) <= 16) { cv[n] = (code == i * 16 + j) ? -3.0e38f : cv[n]; ++n; }
    }
    if (k == 0) mx = mval;
    const float e = __expf(mval - mx);
    sum += e;
    eo[k] = (int)(127u - (ka[code >> 4] & 127u)) * 128 + (int)(127u - (kb[code & 15] & 127u));
    go[k] = e;
  }
  const float inv = 1.f / sum;
#pragma unroll
  for (int i = 0; i < 4; ++i) {
    float4 g4 = ((float4*)go)[i];
    g4.x *= inv; g4.y *= inv; g4.z *= inv; g4.w *= inv;
    ((float4*)go)[i] = g4;
  }
}

DI void peer_token(int r, const bf16_t* __restrict__ hbuf, const int* __restrict__ experts, const float* __restrict__ gates,
                   const unsigned char* __restrict__ u8, const float* __restrict__ us, const unsigned char* __restrict__ v8,
                   const float* __restrict__ vs, const float* __restrict__ modv_l, float* __restrict__ xs, float* wdots  ,
                   float* __restrict__ outp = nullptr) {
  const int lane = TID & 63;
  float x[16];
  {
    const uint4* hr = (const uint4*)(hbuf + (size_t)r * D + lane * 16);
    uint4 a = hr[0], c = hr[1];
    x[0] = bflo(a.x); x[1] = bfhi(a.x); x[2] = bflo(a.y); x[3] = bfhi(a.y); x[4] = bflo(a.z); x[5] = bfhi(a.z); x[6] = bflo(a.w); x[7] = bfhi(a.w);
    x[8] = bflo(c.x); x[9] = bfhi(c.x); x[10] = bflo(c.y); x[11] = bfhi(c.y); x[12] = bflo(c.z); x[13] = bfhi(c.z); x[14] = bflo(c.w); x[15] = bfhi(c.w);
  }
  const int e0 = experts[(size_t)r * 128 + lane], e1 = experts[(size_t)r * 128 + 64 + lane];
  const float g0 = gates[(size_t)r * 128 + lane], g1 = gates[(size_t)r * 128 + 64 + lane];
  const float us0 = us[e0], us1 = us[e1], vs0 = vs[e0], vs1 = vs[e1];
#define PEER_LOAD8(rw_, tab_, k0_)                                                          \
  {                                                                                         \
    _Pragma("unroll") for (int j = 0; j < 8; ++j) {                                         \
      int e = __builtin_amdgcn_readlane((k0_) < 64 ? e0 : e1, ((k0_) + j) & 63);            \
      rw_[j] = *(const uint4*)((tab_) + (size_t)e * D + lane * 16);                         \
    }                                                                                       \
  }
#define PEER_UDOT8(rw_, k0_)                                                                \
  {                                                                                         \
    float p[8];                                                                             \
    _Pragma("unroll") for (int j = 0; j < 8; ++j) {                                         \
      f32x2_t a0 = __builtin_amdgcn_cvt_pk_f32_fp8((int)rw_[j].x, false), a1 = __builtin_amdgcn_cvt_pk_f32_fp8((int)rw_[j].x, true); \
      f32x2_t b0 = __builtin_amdgcn_cvt_pk_f32_fp8((int)rw_[j].y, false), b1 = __builtin_amdgcn_cvt_pk_f32_fp8((int)rw_[j].y, true); \
      f32x2_t c0 = __builtin_amdgcn_cvt_pk_f32_fp8((int)rw_[j].z, false), c1 = __builtin_amdgcn_cvt_pk_f32_fp8((int)rw_[j].z, true); \
      f32x2_t d0 = __builtin_amdgcn_cvt_pk_f32_fp8((int)rw_[j].w, false), d1 = __builtin_amdgcn_cvt_pk_f32_fp8((int)rw_[j].w, true); \
      float s = a0[0] * x[0] + a0[1] * x[1] + a1[0] * x[2] + a1[1] * x[3];                  \
      s += b0[0] * x[4] + b0[1] * x[5] + b1[0] * x[6] + b1[1] * x[7];                       \
      s += c0[0] * x[8] + c0[1] * x[9] + c1[0] * x[10] + c1[1] * x[11];                     \
      s += d0[0] * x[12] + d0[1] * x[13] + d1[0] * x[14] + d1[1] * x[15];                   \
      p[j] = s;                                                                             \
    }                                                                                       \
    float q4[4];                                                                            \
    _Pragma("unroll") for (int i = 0; i < 4; ++i) { float send = hi32 ? p[i] : p[4 + i]; float keep = hi32 ? p[4 + i] : p[i]; q4[i] = keep + shxl(send, lane, 32); } \
    float q2[2];                                                                            \
    _Pragma("unroll") for (int i = 0; i < 2; ++i) { float send = hi16 ? q4[i] : q4[2 + i]; float keep = hi16 ? q4[2 + i] : q4[i]; q2[i] = keep + shxl(send, lane, 16); } \
    float q1;                                                                               \
    { float send = hi8 ? q2[0] : q2[1]; float keep = hi8 ? q2[1] : q2[0]; q1 = keep + shxl(send, lane, 8); } \
    q1 += shxl(q1, lane, 4); q1 += shxl(q1, lane, 2); q1 += shxl(q1, lane, 1);              \
    if ((lane & 7) == 0) wdots[(k0_) + (lane >> 3)] = q1;                                   \
  }
#define PEER_VACC8(rw_, k0_)                                                                \
  {                                                                                         \
    _Pragma("unroll") for (int j = 0; j < 8; ++j) {                                         \
      float w = __builtin_bit_cast(float, __builtin_amdgcn_readlane(__builtin_bit_cast(int, (k0_) < 64 ? w0 : w1), ((k0_) + j) & 63)); \
      f32x2_t a0 = __builtin_amdgcn_cvt_pk_f32_fp8((int)rw_[j].x, false), a1 = __builtin_amdgcn_cvt_pk_f32_fp8((int)rw_[j].x, true); \
      f32x2_t b0 = __builtin_amdgcn_cvt_pk_f32_fp8((int)rw_[j].y, false), b1 = __builtin_amdgcn_cvt_pk_f32_fp8((int)rw_[j].y, true); \
      f32x2_t c0 = __builtin_amdgcn_cvt_pk_f32_fp8((int)rw_[j].z, false), c1 = __builtin_amdgcn_cvt_pk_f32_fp8((int)rw_[j].z, true); \
      f32x2_t d0 = __builtin_amdgcn_cvt_pk_f32_fp8((int)rw_[j].w, false), d1 = __builtin_amdgcn_cvt_pk_f32_fp8((int)rw_[j].w, true); \
      acc[0] += w * a0[0]; acc[1] += w * a0[1]; acc[2] += w * a1[0]; acc[3] += w * a1[1];   \
      acc[4] += w * b0[0]; acc[5] += w * b0[1]; acc[6] += w * b1[0]; acc[7] += w * b1[1];   \
      acc[8] += w * c0[0]; acc[9] += w * c0[1]; acc[10] += w * c1[0]; acc[11] += w * c1[1]; \
      acc[12] += w * d0[0]; acc[13] += w * d0[1]; acc[14] += w * d1[0]; acc[15] += w * d1[1]; \
    }                                                                                       \
  }
  const bool hi32 = lane & 32, hi16 = lane & 16, hi8 = lane & 8;
  uint4 rwA[8], rwB[8];
  PEER_LOAD8(rwA, u8, 0);
#pragma unroll 1
  for (int k0 = 0; k0 < 128; k0 += 16) {
    PEER_LOAD8(rwB, u8, k0 + 8);
    PEER_UDOT8(rwA, k0);
    if (k0 + 16 < 128) { PEER_LOAD8(rwA, u8, k0 + 16); } else { PEER_LOAD8(rwA, v8, 0); }
    PEER_UDOT8(rwB, k0 + 8);
  }
  float w0, w1;
  {
    float d0 = wdots[lane] * us0, d1 = wdots[64 + lane] * us1;
    float t0 = 0.5f * d0 * (1.f + tanhf(0.7978845608028654f * (d0 + 0.044715f * d0 * d0 * d0)));
    float t1 = 0.5f * d1 * (1.f + tanhf(0.7978845608028654f * (d1 + 0.044715f * d1 * d1 * d1)));
    w0 = g0 * t0 * vs0; w1 = g1 * t1 * vs1;
  }
  float acc[16];
#pragma unroll
  for (int i = 0; i < 16; ++i) acc[i] = 0.f;
#pragma unroll 1
  for (int k0 = 0; k0 < 128; k0 += 16) {
    PEER_LOAD8(rwB, v8, k0 + 8);
    PEER_VACC8(rwA, k0);
    if (k0 + 16 < 128) PEER_LOAD8(rwA, v8, k0 + 16);
    PEER_VACC8(rwB, k0 + 8);
  }
  const int b = r / NT, p = r % NT; const int mrow = p < CTX ? 2 : b;
  const float* g2 = modv_l + mrow * NMOD + 5 * D + lane * 16;
  float4* xp = (float4*)(xs + (size_t)r * D + lane * 16);
  float4* op = outp ? (float4*)(outp + ((size_t)b * SEQ + (p - CTX)) * D + lane * 16) : xp;
#pragma unroll
  for (int i = 0; i < 4; ++i) {
    float4 xv = xp[i]; float4 gg = ((const float4*)g2)[i];
    xv.x += gg.x * acc[4 * i]; xv.y += gg.y * acc[4 * i + 1]; xv.z += gg.z * acc[4 * i + 2]; xv.w += gg.w * acc[4 * i + 3];
    op[i] = xv;
  }
}

constexpr int FN = 2 * SEQ;
DI float2 cmul(float2 a, float2 b) { return make_float2(a.x * b.x - a.y * b.y, a.x * b.y + a.y * b.x); }
DI float2 cmulc(float2 a, float2 b) { return make_float2(a.x * b.x + a.y * b.y, a.y * b.x - a.x * b.y); }
DI int rev4_7(int x) {
  return ((x & 3) << 12) | ((x >> 12) & 3) | ((x & 0xC) << 8) | ((x >> 8) & 0xC) | ((x & 0x30) << 4) | ((x >> 4) & 0x30) | (x & 0xC0);
}
DI void fft_fwd(float2* X) {
  const int tid = TID;
#pragma unroll 1
  for (int p = 0; p < 7; ++p) {
    const int lq = 12 - 2 * p; const int q = 1 << lq;
    const float invL = 1.f / (float)(4 << lq);
    __syncthreads();
#pragma unroll 2
    for (int m = 0; m < 8; ++m) {
      const int i = tid + 512 * m;
      const int j = i & (q - 1); const int base = ((i >> lq) << (lq + 2)) + j;
      float2 a = X[base], b = X[base + q], c = X[base + 2 * q], d = X[base + 3 * q];
      float2 t0 = make_float2(a.x + c.x, a.y + c.y), t1 = make_float2(a.x - c.x, a.y - c.y);
      float2 t2 = make_float2(b.x + d.x, b.y + d.y), t3 = make_float2(b.y - d.y, d.x - b.x);
      float2 y0 = make_float2(t0.x + t2.x, t0.y + t2.y), y1 = make_float2(t1.x + t3.x, t1.y + t3.y);
      float2 y2 = make_float2(t0.x - t2.x, t0.y - t2.y), y3 = make_float2(t1.x - t3.x, t1.y - t3.y);
      const float fr = (float)j * invL;
      float2 w1 = make_float2(__builtin_amdgcn_cosf(fr), -__builtin_amdgcn_sinf(fr));
      float2 w2 = cmul(w1, w1), w3 = cmul(w2, w1);
      X[base] = y0; X[base + q] = cmul(y1, w1); X[base + 2 * q] = cmul(y2, w2); X[base + 3 * q] = cmul(y3, w3);
    }
  }
  __syncthreads();
}
DI void fft_inv(float2* X) {
  const int tid = TID;
#pragma unroll 1
  for (int p = 6; p >= 0; --p) {
    const int lq = 12 - 2 * p; const int q = 1 << lq;
    const float invL = 1.f / (float)(4 << lq);
    __syncthreads();
#pragma unroll 2
    for (int m = 0; m < 8; ++m) {
      const int i = tid + 512 * m;
      const int j = i & (q - 1); const int base = ((i >> lq) << (lq + 2)) + j;
      const float fr = (float)j * invL;
      float2 w1 = make_float2(__builtin_amdgcn_cosf(fr), -__builtin_amdgcn_sinf(fr));
      float2 w2 = cmul(w1, w1), w3 = cmul(w2, w1);
      float2 y0 = X[base], y1 = cmulc(X[base + q], w1), y2 = cmulc(X[base + 2 * q], w2), y3 = cmulc(X[base + 3 * q], w3);
      float2 t0 = make_float2(y0.x + y2.x, y0.y + y2.y), t1 = make_float2(y0.x - y2.x, y0.y - y2.y);
      float2 t2 = make_float2(y1.x + y3.x, y1.y + y3.y), t3 = make_float2(y3.y - y1.y, y1.x - y3.x);
      X[base] = make_float2(t0.x + t2.x, t0.y + t2.y);
      X[base + q] = make_float2(t1.x + t3.x, t1.y + t3.y);
      X[base + 2 * q] = make_float2(t0.x - t2.x, t0.y - t2.y);
      X[base + 3 * q] = make_float2(t1.x - t3.x, t1.y - t3.y);
    }
  }
  __syncthreads();
}
DI float block_sum_512(float v, float* red) {
  for (int o = 32; o > 0; o >>= 1) v += shx(v, o);
  __syncthreads();
  if ((TID & 63) == 0) red[TID >> 6] = v;
  __syncthreads();
  float s = 0.f;
  for (int i = 0; i < 8; ++i) s += red[i];
  return s;
}
DI unsigned pkc(float2 v) { return pk2bf(v.x, v.y); }
DI float2 upkc(unsigned w) { return make_float2(bflo(w), bfhi(w)); }
DI void hyena_filter_task(int c, const float* __restrict__ hT, const float* __restrict__ w3, const float* __restrict__ b3, uint2* __restrict__ H01_all,
                          char* smem) {
  float2* X = (float2*)smem;
  float* red = (float*)(smem + 131072);
  float* wcol = red + 16;
  uint2* H01 = H01_all + (size_t)c * FN;
  const int tid = TID;
  __syncthreads();
  if (tid < 256) {
    int od = tid >> 6, i = tid & 63;
    wcol[i * 4 + od] = w3[i * 1024 + (od >> 1) * 512 + (od & 1) * 256 + c];
  }
  __syncthreads();
  const float delta = fabsf(-3.0701134573253944f + (float)c * ((-15.350567286626972f + 3.0701134573253944f) / 255.f));
  const float bb00 = b3[c], bb01 = b3[256 + c], bb10 = b3[512 + c], bb11 = b3[768 + c];
  float n0 = 0.f, n1 = 0.f;
#pragma unroll 1
  for (int j = tid; j < SEQ; j += 512) {
    float f00 = bb00, f01 = bb01, f10 = bb10, f11 = bb11;
#pragma unroll 8
    for (int i = 0; i < 64; ++i) {
      const float hv = hT[(size_t)i * NT + j];
      const float4 w = *(const float4*)(wcol + 4 * i);
      f00 += hv * w.x; f01 += hv * w.y; f10 += hv * w.z; f11 += hv * w.w;
    }
    const float dec = __expf(-((float)j / (float)(SEQ - 1)) * delta);
    f00 *= dec; f01 *= dec; f10 *= dec; f11 *= dec;
    X[j] = make_float2(f00, f10);
    n0 += fabsf(f00); n1 += fabsf(f10);
    if (j > 0) { X[FN - j] = make_float2(f01, f11); n0 += fabsf(f01); n1 += fabsf(f11); }
    else X[SEQ] = make_float2(0.f, 0.f);
  }
  n0 = block_sum_512(n0, red);
  n1 = block_sum_512(n1, red);
  const float s0 = 0.5f / (n0 * (float)FN), s1 = 0.5f / (n1 * (float)FN);
  fft_fwd(X);
  for (int pos = tid; pos < FN; pos += 512) {
    const int f = rev4_7(pos); const int pm = rev4_7((FN - f) & (FN - 1));
    const float2 A = X[pos], Bm = X[pm];
    const float2 K0 = make_float2((A.x + Bm.x) * s0, (A.y - Bm.y) * s0);
    const float2 K1 = make_float2((A.y + Bm.y) * s1, -(A.x - Bm.x) * s1);
    H01[pos] = make_uint2(pkc(K0), pkc(K1));
  }
}
DI void hyena_channel(int c, const float* __restrict__ hy_bias, const float* __restrict__ uT, float* __restrict__ zT, float* __restrict__ yT,
                      const uint2* __restrict__ H01_all, char* smem) {
  float2* X = (float2*)smem;
  const uint2* H01 = H01_all + (size_t)c * FN;
  const int tid = TID;
  const float* v0p = uT + ((size_t)0 * 768 + c) * NT + CTX;
  const float* v1p = uT + ((size_t)1 * 768 + c) * NT + CTX;
  __syncthreads();
  for (int t = tid; t < SEQ; t += 512) { X[t] = make_float2(v0p[t], v1p[t]); X[SEQ + t] = make_float2(0.f, 0.f); }
  fft_fwd(X);
  for (int pos = tid; pos < FN; pos += 512) X[pos] = cmul(X[pos], upkc(H01[pos].x));
  fft_inv(X);
  {
    const float bias0 = hy_bias[c];
    const float* x10 = v0p + (size_t)256 * NT; const float* x11 = v1p + (size_t)256 * NT;
    float* z0 = zT + ((size_t)0 * 256 + c) * NT + CTX; float* z1 = zT + ((size_t)1 * 256 + c) * NT + CTX;
    for (int t = tid; t < SEQ; t += 512) {
      float2 y = X[t];
      float za = x10[t] * (y.x + bias0 * v0p[t]);
      float zb = x11[t] * (y.y + bias0 * v1p[t]);
      z0[t] = za; z1[t] = zb;
      X[t] = make_float2(za, zb);
    }
    __syncthreads();
    for (int t = tid; t < SEQ; t += 512) X[SEQ + t] = make_float2(0.f, 0.f);
  }
  fft_fwd(X);
  for (int pos = tid; pos < FN; pos += 512) X[pos] = cmul(X[pos], upkc(H01[pos].y));
  fft_inv(X);
  {
    const float bias1 = hy_bias[256 + c];
    const float* x20 = v0p + (size_t)512 * NT; const float* x21 = v1p + (size_t)512 * NT;
    const float* z0 = zT + ((size_t)0 * 256 + c) * NT + CTX; const float* z1 = zT + ((size_t)1 * 256 + c) * NT + CTX;
    float* y0 = yT + ((size_t)0 * 256 + c) * NT + CTX; float* y1 = yT + ((size_t)1 * 256 + c) * NT + CTX;
    for (int t = tid; t < SEQ; t += 512) {
      float2 y = X[t];
      y0[t] = x20[t] * (y.x + bias1 * z0[t]);
      y1[t] = x21[t] * (y.y + bias1 * z1[t]);
    }
  }
}

#define XB_TMO      128
#define XB_XCNT(j)  (256  + 64 * (j))
#define XB_XSUB(j)  (1280 + 64 * (j))
#define XB_XGEN(j)  (2304 + 64 * (j))
#define XB_TOP      3328
#define XB_TOPGEN   3392
#define XB_SPIN_CAP (1u << 22)
#define LAS __attribute__((address_space(3)))
DI unsigned xb_ld(unsigned* p) { return __hip_atomic_load(p, __ATOMIC_RELAXED, __HIP_MEMORY_SCOPE_AGENT); }
DI unsigned xb_add(unsigned* p, unsigned v) { return __hip_atomic_fetch_add(p, v, __ATOMIC_RELAXED, __HIP_MEMORY_SCOPE_AGENT); }
DI unsigned xb_xcc_id() { return (unsigned)__builtin_amdgcn_s_getreg((3 << 11) | 20) & 0xFu; }
#define XB_SPIN(cond, bar) do { unsigned _sp = 0; while (cond) { __builtin_amdgcn_s_sleep(1); \
    if ((++_sp & 255u) == 0u) { if (xb_ld(&(bar)[XB_TMO])) break; if (_sp > XB_SPIN_CAP) { atomicAdd(&(bar)[XB_TMO], 1u); break; } } } } while (0)
DI void xcd_barrier_post(unsigned* bar) {
  if (threadIdx.x == 0) (void)xb_add(&bar[XB_XCNT(xb_xcc_id())], 1u);
}
DI void xcd_barrier_complete(unsigned* bar, unsigned x, unsigned& nloc, unsigned& nx) {
  const unsigned G = gridDim.x;
  unsigned sum, cnt, mine, sp = 0u;
  for (;;) {
    sum = 0u; cnt = 0u; mine = 0u;
#pragma unroll
    for (unsigned j = 0; j < 16; ++j) { const unsigned c = xb_ld(&bar[XB_XCNT(j)]); sum += c; cnt += (c > 0u) ? 1u : 0u; mine = (j == x) ? c : mine; }
    if (sum == G) break;
    __builtin_amdgcn_s_sleep(1);
    if ((++sp & 255u) == 0u) { if (xb_ld(&bar[XB_TMO])) break; if (sp > XB_SPIN_CAP) { atomicAdd(&bar[XB_TMO], 1u); break; } }
  }
  nloc = mine > 0u ? mine : 1u; nx = cnt > 0u ? cnt : 1u;
}
DI void xcd_barrier(unsigned* bar, volatile LAS unsigned* st) {
  asm volatile("s_waitcnt vmcnt(0)" ::: "memory");
  __syncthreads();
  if (threadIdx.x == 0) {
    const unsigned x = xb_xcc_id();
    __builtin_amdgcn_s_waitcnt(0);
    unsigned nloc = st[0], nx = st[1];
    if (nloc == 0u) { xcd_barrier_complete(bar, x, nloc, nx); st[0] = nloc; st[1] = nx; }
    const unsigned old = xb_add(&bar[XB_XSUB(x)], 1u);
    const unsigned gen = old / nloc;
    if (old + 1u == (gen + 1u) * nloc) {
      __builtin_amdgcn_fence(__ATOMIC_RELEASE, "agent");
      asm volatile("s_waitcnt vmcnt(0)" ::: "memory");
      const unsigned og = xb_add(&bar[XB_TOP], 1u);
      const unsigned tg = og / nx;
      if (og + 1u == (tg + 1u) * nx) xb_add(&bar[XB_TOPGEN], 1u);
      else XB_SPIN(xb_ld(&bar[XB_TOPGEN]) == tg, bar);
      __builtin_amdgcn_fence(__ATOMIC_ACQUIRE, "agent");
      xb_add(&bar[XB_XGEN(x)], 1u);
      asm volatile("s_waitcnt vmcnt(0)" ::: "memory");
    } else {
      XB_SPIN(xb_ld(&bar[XB_XGEN(x)]) == gen, bar);
      __builtin_amdgcn_fence(__ATOMIC_ACQUIRE, "agent");
      asm volatile("s_waitcnt vmcnt(0)" ::: "memory");
    }
  }
  __syncthreads();
}

#define XCD_BAR_WORDS 3456
constexpr size_t al256(size_t x) { return (x + 255) & ~(size_t)255; }
constexpr size_t OFF_modv = 0;
constexpr size_t OFF_xs = al256(OFF_modv + (size_t)2 * 3 * NMOD * 4);
constexpr size_t OFF_hbuf = al256(OFF_xs + (size_t)R * D * 4);
constexpr size_t OFF_P = al256(OFF_hbuf + (size_t)R * D * 2);
constexpr size_t OFF_Wt_in = al256(OFF_P + (size_t)R * DIN * 2);
constexpr size_t OFF_Wt_out = al256(OFF_Wt_in + (size_t)2 * DIN * D * 2);
constexpr size_t OFF_Wt_q = al256(OFF_Wt_out + (size_t)2 * D * D * 2);
constexpr size_t OFF_QA = al256(OFF_Wt_q + (size_t)2 * 2048 * D * 2);
constexpr size_t OFF_KA = al256(OFF_QA + (size_t)NB * 8 * NT * 32 * 2);
constexpr size_t OFF_VAt = al256(OFF_KA + (size_t)NB * 8 * NT * 32 * 2);
constexpr size_t OFF_QW = al256(OFF_VAt + (size_t)NB * 4 * 64 * NT * 2);
constexpr size_t OFF_KW = al256(OFF_QW + (size_t)NB * 4 * NT * 64 * 2);
constexpr size_t OFF_VWt = al256(OFF_KW + (size_t)NB * 2 * NT * 64 * 2);
constexpr size_t OFF_QG = al256(OFF_VWt + (size_t)NB * 2 * 64 * NT * 2);
constexpr size_t OFF_KG = al256(OFF_QG + (size_t)NB * 4 * NT * 64 * 2);
constexpr size_t OFF_VGt = al256(OFF_KG + (size_t)NB * 2 * NT * 64 * 2);
constexpr size_t OFF_uT = al256(OFF_VGt + (size_t)NB * 2 * 64 * NT * 2);
constexpr size_t OFF_zT = al256(OFF_uT + (size_t)NB * 768 * NT * 4);
constexpr size_t OFF_yT = al256(OFF_zT + (size_t)NB * 256 * NT * 4);
constexpr size_t OFF_hdn2 = al256(OFF_yT + (size_t)NB * 256 * NT * 4);
constexpr size_t OFF_Hc = al256(OFF_hdn2 + (size_t)2 * NT * 64 * 4);
constexpr size_t OFF_A2 = al256(OFF_Hc + (size_t)256 * 2 * SEQ * 8);
constexpr size_t OFF_u8 = al256(OFF_A2 + (size_t)R * D * 2);
constexpr size_t OFF_v8 = al256(OFF_u8 + (size_t)2 * 16384 * D);
constexpr size_t OFF_us = al256(OFF_v8 + (size_t)2 * 16384 * D);
constexpr size_t OFF_vs = al256(OFF_us + (size_t)2 * 16384 * 4);
constexpr size_t OFF_keysb = al256(OFF_vs + (size_t)2 * 16384 * 4);
constexpr size_t OFF_bar = al256(OFF_keysb + (size_t)2 * 16 * 128 * 128 * 2);
constexpr size_t WS_TOTAL = al256(OFF_bar + (size_t)XCD_BAR_WORDS * 4);
constexpr size_t OFF_topv = OFF_uT;
constexpr size_t OFF_topi = OFF_topv + (size_t)R * 256 * 4;
constexpr size_t OFF_experts = OFF_topi + (size_t)R * 256;
constexpr size_t OFF_gates = OFF_experts + (size_t)R * 128 * 4;
constexpr size_t OFF_Oslab = OFF_P;
constexpr size_t OFF_Lslab = OFF_Oslab + (size_t)2 * NB * 4 * NT * 64 * 4;
static_assert(OFF_gates + (size_t)R * 128 * 4 <= OFF_zT, "routing buffers overflow uT");
static_assert(OFF_Lslab + (size_t)2 * NB * 4 * NT * 4 <= OFF_Wt_in, "slabs overflow P");

struct MKView;
struct MK {
  const float *x, *c, *ctx, *c_ctx, *w_mod, *b_mod, *g_norm_mix, *w_in, *g_qk_diff, *lambda_diff, *g_qk_win, *sink_win, *g_qk_glob, *hy_conv_w,
      *hy_conv_b, *hy_w1, *hy_b1, *hy_w2, *hy_b2, *hy_w3, *hy_b3, *hy_freq, *hy_bias, *g_mix_out, *w_out, *g_norm_ffn, *peer_wq, *peer_keys,
      *peer_u, *peer_v;
  float* out;
  char* ws;
};
constexpr int SMEM_BYTES = 131072 + 2048;
typedef const MK __attribute__((address_space(4))) * MKP;
DI MK launder_mk(MKP a) {
  asm volatile("" : "+s"(a));
  MK r;
  r.x = a->x; r.c = a->c; r.ctx = a->ctx; r.c_ctx = a->c_ctx; r.w_mod = a->w_mod; r.b_mod = a->b_mod;
  r.g_norm_mix = a->g_norm_mix; r.w_in = a->w_in; r.g_qk_diff = a->g_qk_diff; r.lambda_diff = a->lambda_diff;
  r.g_qk_win = a->g_qk_win; r.sink_win = a->sink_win; r.g_qk_glob = a->g_qk_glob; r.hy_conv_w = a->hy_conv_w;
  r.hy_conv_b = a->hy_conv_b; r.hy_w1 = a->hy_w1; r.hy_b1 = a->hy_b1; r.hy_w2 = a->hy_w2; r.hy_b2 = a->hy_b2;
  r.hy_w3 = a->hy_w3; r.hy_b3 = a->hy_b3; r.hy_freq = a->hy_freq; r.hy_bias = a->hy_bias; r.g_mix_out = a->g_mix_out;
  r.w_out = a->w_out; r.g_norm_ffn = a->g_norm_ffn; r.peer_wq = a->peer_wq; r.peer_keys = a->peer_keys;
  r.peer_u = a->peer_u; r.peer_v = a->peer_v; r.out = a->out; r.ws = a->ws;
  return r;
}

DI void ph_mod_item(const MK& m, int item, char* smem) {
  float* sc = (float*)smem;
  float* part = sc + 3 * D;
  const int tid = TID;
  const int l = item / 24, chunk = item % 24;
  __syncthreads();
  for (int i = tid; i < 3 * D; i += NTHR) {
    int row = i / D, k = i % D;
    float v = row < 2 ? m.c[row * D + k] : m.c_ctx[k];
    sc[i] = v / (1.f + __expf(-v));
  }
  __syncthreads();
  const int cl = tid & 255, kh = tid >> 8;
  const int col = chunk * 256 + cl;
  const float* w = m.w_mod + (size_t)l * D * NMOD + (size_t)(kh * 512) * NMOD + col;
  float a0 = 0, a1 = 0, a2 = 0;
  for (int k = 0; k < 512; ++k) {
    float wv = w[(size_t)k * NMOD];
    a0 += sc[kh * 512 + k] * wv; a1 += sc[D + kh * 512 + k] * wv; a2 += sc[2 * D + kh * 512 + k] * wv;
  }
  if (kh == 1) { part[cl] = a0; part[256 + cl] = a1; part[512 + cl] = a2; }
  __syncthreads();
  if (kh == 0) {
    float bb = m.b_mod[l * NMOD + col];
    ((float*)(m.ws + OFF_modv))[(l * 3 + 0) * NMOD + col] = a0 + part[cl] + bb;
    ((float*)(m.ws + OFF_modv))[(l * 3 + 1) * NMOD + col] = a1 + part[256 + cl] + bb;
    ((float*)(m.ws + OFF_modv))[(l * 3 + 2) * NMOD + col] = a2 + part[512 + cl] + bb;
  }
}
DI void ph_hymlp_group(const MK& m, int g, char* smem) {
  const int tid = TID, wv = tid >> 6, u = tid & 63;
  float* feat = (float*)smem + wv * 128;
  float* h1 = feat + 64;
  const int gi = g * 8 + wv;
  const int l = gi / NT, pos = gi % NT;
  const int which = pos >= SEQ ? 1 : 0;
  const int j = which ? pos - SEQ : pos;
  const int n = which ? CTX : SEQ;
  const float tt = (float)j / (float)(n - 1);
  const float w = (6.283185307179586f / (float)n) * (float)j;
  __syncthreads();
  if (u == 0) feat[0] = tt;
  if (u < 16) {
    float f = 1e-4f + (float)u * ((15.f - 1e-4f) / 15.f);
    feat[1 + u] = cosf(f * w);
    feat[17 + u] = -sinf(f * w);
  }
  __syncthreads();
  const float* w1 = m.hy_w1 + l * 33 * 64; const float* w2 = m.hy_w2 + l * 64 * 64;
  const float fq = m.hy_freq[l * 64 + u];
  float a = m.hy_b1[l * 64 + u];
  for (int i = 0; i < 33; ++i) a += feat[i] * w1[i * 64 + u];
  h1[u] = sinf(fq * a);
  __syncthreads();
  float a2 = m.hy_b2[l * 64 + u];
  for (int i = 0; i < 64; ++i) a2 += h1[i] * w2[i * 64 + u];
  ((float*)(m.ws + OFF_hdn2))[((size_t)l * 64 + u) * NT + pos] = sinf(fq * a2);
}
DI void phase0(MKP m_in, char* smem) {
  const MK m = launder_mk(m_in);
  const int bid = BID, nb = NBLK, tid = TID;
  {
    const int gw = bid * 8 + (tid >> 6), nw = nb * 8;
    for (int row = gw; row < 4 * 16384; row += nw) {
      int tbl = row >> 14, rr = row & 16383;
      int l = tbl >> 1;
      if (tbl & 1) tabconv_row(m.peer_v + (size_t)l * 16384 * D, ((unsigned char*)(m.ws + OFF_v8)) + (size_t)l * 16384 * D, ((float*)(m.ws + OFF_vs)) + l * 16384, (size_t)rr);
      else tabconv_row(m.peer_u + (size_t)l * 16384 * D, ((unsigned char*)(m.ws + OFF_u8)) + (size_t)l * 16384 * D, ((float*)(m.ws + OFF_us)) + l * 16384, (size_t)rr);
    }
  }
  for (int it = bid; it < 48; it += nb) ph_mod_item(m, it, smem);
  for (int g = bid; g < 2 * NT / 8; g += nb) ph_hymlp_group(m, g, smem);
  for (int t = bid; t < 2 * 1408; t += nb) {
    int l = t / 1408, tt = t % 1408;
    if (tt < 640) wconv_tile(m.w_in + (size_t)l * D * DIN, ((bf16_t*)(m.ws + OFF_Wt_in)) + (size_t)l * DIN * D, DIN, tt, (float*)smem);
    else if (tt < 896) wconv_tile(m.w_out + (size_t)l * D * D, ((bf16_t*)(m.ws + OFF_Wt_out)) + (size_t)l * D * D, D, tt - 640, (float*)smem);
    else wconv_tile(m.peer_wq + (size_t)l * D * 2048, ((bf16_t*)(m.ws + OFF_Wt_q)) + (size_t)l * 2048 * D, 2048, tt - 896, (float*)smem);
  }
  for (int i = bid * NTHR + tid; i < 2 * 16 * 128 * 128 / 4; i += nb * NTHR) {
    float4 v = ((const float4*)m.peer_keys)[i];
    ((uint2*)((bf16_t*)(m.ws + OFF_keysb)))[i] = make_uint2(pk2bf(v.x, v.y), pk2bf(v.z, v.w));
  }
}

DI void phase_norm(MKP m_in, int l, int which  , bool first, bool skip_ctx) {
  const MK m = launder_mk(m_in);
  const int tid = TID, lane = tid & 63;
  const int gw = BID * 8 + (tid >> 6), nw = NBLK * 8;
  const float* g = (which ? m.g_norm_ffn : m.g_norm_mix) + l * D;
  const float* modv_l = ((float*)(m.ws + OFF_modv)) + (size_t)l * 3 * NMOD;
  for (int r = gw; r < R; r += nw) {
    const int b = r / NT, p = r % NT;
    if (skip_ctx && p < CTX) continue;
    const int mrow = p < CTX ? 2 : b;
    const float4* src = (const float4*)(first ? (p < CTX ? m.ctx + ((size_t)b * CTX + p) * D : m.x + ((size_t)b * SEQ + (p - CTX)) * D)
                                              : ((float*)(m.ws + OFF_xs)) + (size_t)r * D);
    float4 v[4];
    float ss = 0.f;
#pragma unroll
    for (int i = 0; i < 4; ++i) { v[i] = src[lane + 64 * i]; ss += v[i].x * v[i].x + v[i].y * v[i].y + v[i].z * v[i].z + v[i].w * v[i].w; }
    for (int o = 32; o > 0; o >>= 1) ss += shxl(ss, lane, o);
    const float rs = rsqrtf(ss * (1.f / D) + EPS);
    const float* sh = modv_l + mrow * NMOD + (which ? 3 : 0) * D;
    const float* sc = sh + D;
#pragma unroll
    for (int i = 0; i < 4; ++i) {
      const int c0 = (lane + 64 * i) * 4;
      float4 gg = *(const float4*)(g + c0), s4 = *(const float4*)(sc + c0), h4 = *(const float4*)(sh + c0);
      float o0 = v[i].x * rs * gg.x * (1.f + s4.x) + h4.x, o1 = v[i].y * rs * gg.y * (1.f + s4.y) + h4.y;
      float o2 = v[i].z * rs * gg.z * (1.f + s4.z) + h4.z, o3 = v[i].w * rs * gg.w * (1.f + s4.w) + h4.w;
      *(uint2*)(((bf16_t*)(m.ws + OFF_hbuf)) + (size_t)r * D + c0) = make_uint2(pk2bf(o0, o1), pk2bf(o2, o3));
      if (first) ((float4*)(((float*)(m.ws + OFF_xs)) + (size_t)r * D))[lane + 64 * i] = v[i];
    }
  }
}

DI int rowtile_of(int i, bool latent_only) { return latent_only ? (i / 64) * 66 + 2 + (i % 64) : i; }
template <int EPI>
DI void phase_gemm(const bf16_t* A, const bf16_t* Wt, int N, bf16_t* Cb, float* xs, const float* gate_base, bool latent_only, char* smem) {
  const int nt_n = N / 128, nrt = latent_only ? 128 : 132, ntiles = nrt * nt_n;
  for (int t = BID; t < ntiles; t += NBLK) {
    int tm = rowtile_of(t / nt_n, latent_only), tn = t % nt_n;
    gemm_tile<EPI>(A, Wt, N, tm * 128, tn * 128, smem, Cb, xs, gate_base);
  }
}

DI void rope_pair8(float (&y)[8], const float (&part)[8], bool upper, const float* cs, const float* sn, int dd0) {
#pragma unroll
  for (int e = 0; e < 8; ++e) {
    float c = cs[dd0 + e], s = sn[dd0 + e];
    float x1 = upper ? part[e] : y[e], x2 = upper ? y[e] : part[e];
    y[e] = upper ? (x1 * s + x2 * c) : (x1 * c - x2 * s);
  }
}
DI void unpack8(uint4 w, float (&v)[8]) {
  v[0] = bflo(w.x); v[1] = bfhi(w.x); v[2] = bflo(w.y); v[3] = bfhi(w.y); v[4] = bflo(w.z); v[5] = bfhi(w.z); v[6] = bflo(w.w); v[7] = bfhi(w.w);
}
DI uint4 pack8(const float (&v)[8], float sc) {
  return make_uint4(pk2bf(v[0] * sc, v[1] * sc), pk2bf(v[2] * sc, v[3] * sc), pk2bf(v[4] * sc, v[5] * sc), pk2bf(v[6] * sc, v[7] * sc));
}
constexpr int VS_STRIDE = 1032;
constexpr int HS_STRIDE = 1536;
DI void prep_tile(MKP m_in, int l, int tile, char* smem) {
  const MK m = launder_mk(m_in);
  const int tid = TID, lane = tid & 63, wid = tid >> 6;
  const int r0 = tile * 32; const int b = r0 / NT, p0 = r0 % NT;
  const bool lat = p0 >= CTX;
  char* Vs = smem;
  char* Hs = smem + 33280;
  float* csh = (float*)(smem + 33280 + 52224);
  const bf16_t* Pb = ((bf16_t*)(m.ws + OFF_P)) + (size_t)(b * NT) * DIN;
  __syncthreads();
  if (lat) {
    for (int i = tid; i < 32 * 48; i += NTHR) {
      int rr = i / 48, a = i % 48;
      int t = p0 + rr - CTX;
      float trow = (float)(t / 64), tcol = (float)(t % 64);
      float* rowp = csh + rr * 96;
      if (a < 16) {
        int j = a & 7; float f = exp2f(-(float)j * (13.287712379549449f / 8.f));
        float ang = (a < 8 ? trow : tcol) * f;
        rowp[a] = cosf(ang); rowp[16 + a] = sinf(ang);
      } else {
        int aa = a - 16; int j = aa & 15; float f = exp2f(-(float)j * (13.287712379549449f / 16.f));
        float ang = (aa < 16 ? trow : tcol) * f;
        rowp[32 + aa] = cosf(ang); rowp[64 + aa] = sinf(ang);
      }
    }
  }
  {
    const int seg_lo = lat ? CTX : 0, seg_hi = lat ? NT : CTX;
    for (int ch = tid; ch < 34 * 96; ch += NTHR) {
      int rr = ch / 96, c8 = ch % 96;
      int p = p0 - 1 + rr;
      uint4 v = make_uint4(0, 0, 0, 0);
      if (p >= seg_lo && p < seg_hi) v = *(const uint4*)(Pb + (size_t)p * DIN + 1792 + c8 * 8);
      *(uint4*)(Hs + rr * HS_STRIDE + c8 * 16) = v;
    }
  }
  __syncthreads();
  const float* gd = m.g_qk_diff + l * 64; const float* gwn = m.g_qk_win + l * 128; const float* gg = m.g_qk_glob + l * 128;
#pragma unroll 1
  for (int k = 0; k < 4; ++k) {
    const int rr = wid + 8 * k; const int p = p0 + rr;
    const bf16_t* Pr = Pb + (size_t)p * DIN;
    const float* rowp = csh + rr * 96;
    {
      float y[8], part[8];
      unpack8(*(const uint4*)(Pr + 8 * lane), y);
      float ss = 0.f;
#pragma unroll
      for (int e = 0; e < 8; ++e) ss += y[e] * y[e];
      ss += shxl(ss, lane, 1); ss += shxl(ss, lane, 2);
      const float rs = rsqrtf(ss * (1.f / 32) + EPS);
      const int unit = lane >> 2; const bool isk = unit >= 8; const int vh = unit & 7;
      const int d0 = (lane & 3) * 8;
      const float* gn = gd + (isk ? 32 : 0) + d0;
#pragma unroll
      for (int e = 0; e < 8; ++e) y[e] = y[e] * rs * gn[e];
      if (lat) {
#pragma unroll
        for (int e = 0; e < 8; ++e) part[e] = shxl(y[e], lane, 2);
        rope_pair8(y, part, (lane & 2) != 0, rowp, rowp + 16, (lane & 1) * 8);
      }
      bf16_t* dst = (isk ? ((bf16_t*)(m.ws + OFF_KA)) : ((bf16_t*)(m.ws + OFF_QA))) + (((size_t)b * 8 + vh) * NT + p) * 32 + d0;
      *(uint4*)dst = pack8(y, isk ? 1.f : 0.17677669529663687f * LOG2E);
    }
#pragma unroll
    for (int grp = 0; grp < 2; ++grp) {
      float y[8], part[8];
      const int cbase = grp == 0 ? 768 : 1280;
      uint4 w = make_uint4(0, 0, 0, 0);
      if (lane < 48) w = *(const uint4*)(Pr + cbase + 8 * lane);
      unpack8(w, y);
      float ss = 0.f;
#pragma unroll
      for (int e = 0; e < 8; ++e) ss += y[e] * y[e];
      ss += shxl(ss, lane, 1); ss += shxl(ss, lane, 2); ss += shxl(ss, lane, 4);
      const float rs = rsqrtf(ss * (1.f / 64) + EPS);
      const int unit = lane >> 3; const bool isk = unit >= 4; const int hh = isk ? unit - 4 : unit;
      const int d0 = (lane & 7) * 8;
      const float* gn = (grp == 0 ? gwn : gg) + (isk ? 64 : 0) + d0;
      if (lane < 48) {
#pragma unroll
        for (int e = 0; e < 8; ++e) y[e] = y[e] * rs * gn[e];
      }
      if (lat) {
#pragma unroll
        for (int e = 0; e < 8; ++e) part[e] = shxl(y[e], lane, 4);
        rope_pair8(y, part, (lane & 4) != 0, rowp + 32, rowp + 64, (lane & 3) * 8);
      }
      if (lane < 48) {
        bf16_t* base = grp == 0 ? (isk ? ((bf16_t*)(m.ws + OFF_KW)) : ((bf16_t*)(m.ws + OFF_QW))) : (isk ? ((bf16_t*)(m.ws + OFF_KG)) : ((bf16_t*)(m.ws + OFF_QG)));
        bf16_t* dst = base + (((size_t)b * (isk ? 2 : 4) + hh) * NT + p) * 64 + d0;
        *(uint4*)dst = pack8(y, isk ? 1.f : 0.125f * LOG2E);
      }
    }
    {
      const int vsrc = lane < 32 ? 512 + 8 * lane : (lane < 48 ? 1152 + 8 * (lane - 32) : 1664 + 8 * (lane - 48));
      uint4 w = *(const uint4*)(Pr + vsrc);
      *(uint2*)(Vs + rr * VS_STRIDE + lane * 16) = make_uint2(w.x, w.y);
      *(uint2*)(Vs + rr * VS_STRIDE + lane * 16 + 8) = make_uint2(w.z, w.w);
    }
  }
  __syncthreads();
  for (int tk = tid; tk < 2048; tk += NTHR) {
    const int pg = tk & 3; const int vch = (tk >> 2) & 15 | ((tk >> 6) << 4);
    unsigned short e[8];
#pragma unroll
    for (int i = 0; i < 8; ++i) {
      int sidx = 8 * pg + i;
      int pl = (sidx & 16) | perm16(sidx & 15);
      e[i] = *(const unsigned short*)(Vs + pl * VS_STRIDE + vch * 2);
    }
    uint4 w = make_uint4(e[0] | ((unsigned)e[1] << 16), e[2] | ((unsigned)e[3] << 16), e[4] | ((unsigned)e[5] << 16), e[6] | ((unsigned)e[7] << 16));
    bf16_t* dst;
    if (vch < 256) dst = ((bf16_t*)(m.ws + OFF_VAt)) + (((size_t)b * 4 + (vch >> 6)) * 64 + (vch & 63)) * NT;
    else if (vch < 384) dst = ((bf16_t*)(m.ws + OFF_VWt)) + (((size_t)b * 2 + ((vch - 256) >> 6)) * 64 + (vch & 63)) * NT;
    else dst = ((bf16_t*)(m.ws + OFF_VGt)) + (((size_t)b * 2 + ((vch - 384) >> 6)) * 64 + (vch & 63)) * NT;
    *(uint4*)(dst + p0 + 8 * pg) = w;
  }
  {
    const float* cw = m.hy_conv_w + l * 3 * 768; const float* cb = m.hy_conv_b + l * 768;
    for (int c = tid; c < 768; c += NTHR) {
      const float w0 = cw[c], w1 = cw[768 + c], w2 = cw[1536 + c], bb = cb[c];
      float* dst = ((float*)(m.ws + OFF_uT)) + ((size_t)b * 768 + c) * NT + p0;
      float prev = bf2f(*(const bf16_t*)(Hs + 0 * HS_STRIDE + c * 2));
      float cur = bf2f(*(const bf16_t*)(Hs + 1 * HS_STRIDE + c * 2));
#pragma unroll 1
      for (int pg = 0; pg < 8; ++pg) {
        float o[4];
#pragma unroll
        for (int i = 0; i < 4; ++i) {
          float nxt = bf2f(*(const bf16_t*)(Hs + (4 * pg + i + 2) * HS_STRIDE + c * 2));
          o[i] = prev * w0 + cur * w1 + nxt * w2 + bb;
          prev = cur; cur = nxt;
        }
        *(float4*)(dst + 4 * pg) = make_float4(o[0], o[1], o[2], o[3]);
      }
    }
  }
}

DI void hyena_ctx_channel(MKP m_in, int l, int c, char* smem) {
  const MK m = launder_mk(m_in);
  float* kf = (float*)smem;
  float* vz = kf + 1024;
  float* red = vz + 512;
  float* wcol = red + 16;
  const int tid = TID;
  const float* hd = ((float*)(m.ws + OFF_hdn2)) + (size_t)l * 64 * NT + SEQ;
  const float* w3 = m.hy_w3 + (size_t)l * 64 * 1024; const float* b3 = m.hy_b3 + l * 1024;
  __syncthreads();
  if (tid < 256) { int od = tid >> 6, i = tid & 63; wcol[od * 64 + i] = w3[i * 1024 + (od >> 1) * 512 + (od & 1) * 256 + c]; }
  __syncthreads();
  const float delta = fabsf(-3.0701134573253944f + (float)c * ((-15.350567286626972f + 3.0701134573253944f) / 255.f));
  float n0 = 0.f, n1 = 0.f;
  if (tid < 256) {
    const int j = tid;
    float f00 = b3[c], f01 = b3[256 + c], f10 = b3[512 + c], f11 = b3[768 + c];
#pragma unroll 4
    for (int i = 0; i < 64; ++i) {
      float hv = hd[(size_t)i * NT + j];
      f00 += hv * wcol[i]; f01 += hv * wcol[64 + i]; f10 += hv * wcol[128 + i]; f11 += hv * wcol[192 + i];
    }
    const float dec = __expf(-((float)j / (float)(CTX - 1)) * delta);
    f00 *= dec; f01 *= dec; f10 *= dec; f11 *= dec;
    kf[256 + j] = f00; kf[512 + 256 + j] = f10; n0 += fabsf(f00); n1 += fabsf(f10);
    if (j > 0) { kf[256 - j] = f01; kf[512 + 256 - j] = f11; n0 += fabsf(f01); n1 += fabsf(f11); }
    else { kf[0] = 0.f; kf[512] = 0.f; }
  }
  n0 = block_sum_512(n0, red);
  n1 = block_sum_512(n1, red);
  const float i0 = 1.f / n0, i1 = 1.f / n1;
  const int bb = tid >> 8, t = tid & 255;
  const float* ub = ((float*)(m.ws + OFF_uT)) + ((size_t)bb * 768 + c) * NT;
  const float vself = ub[t];
  vz[bb * 256 + t] = vself;
  __syncthreads();
  float acc = 0.f;
  for (int s2 = 0; s2 < 256; ++s2) acc += vz[bb * 256 + s2] * kf[256 + t - s2];
  const float z = ub[(size_t)256 * NT + t] * (acc * i0 + m.hy_bias[l * 512 + c] * vself);
  __syncthreads();
  vz[bb * 256 + t] = z;
  __syncthreads();
  float acc2 = 0.f;
  for (int s2 = 0; s2 < 256; ++s2) acc2 += vz[bb * 256 + s2] * kf[512 + 256 + t - s2];
  ((float*)(m.ws + OFF_yT))[((size_t)bb * 256 + c) * NT + t] = ub[(size_t)512 * NT + t] * (acc2 * i1 + m.hy_bias[l * 512 + 256 + c] * z);
}

DI void phase_mix(MKP m_in, int l, bool want_ctx, char* smem) {
  const MK m = launder_mk(m_in);
  AttnArgs a;
  a.QA = ((bf16_t*)(m.ws + OFF_QA)); a.KA = ((bf16_t*)(m.ws + OFF_KA)); a.VAt = ((bf16_t*)(m.ws + OFF_VAt)); a.QW = ((bf16_t*)(m.ws + OFF_QW)); a.KW = ((bf16_t*)(m.ws + OFF_KW)); a.VWt = ((bf16_t*)(m.ws + OFF_VWt)); a.QG = ((bf16_t*)(m.ws + OFF_QG)); a.KG = ((bf16_t*)(m.ws + OFF_KG)); a.VGt = ((bf16_t*)(m.ws + OFF_VGt));
  a.g_qk_diff = m.g_qk_diff + l * 64; a.g_qk_win = m.g_qk_win + l * 128; a.g_qk_glob = m.g_qk_glob + l * 128; a.sink = m.sink_win + l * 4;
  a.lambda_diff = m.lambda_diff + l * 128; a.g_mix_out = m.g_mix_out + l * D; a.lambda_init = 0.8f - 0.6f * __expf(-0.3f * (float)l); a.pad0 = 0;
  a.A2 = ((bf16_t*)(m.ws + OFF_A2)); a.Oslab = ((float*)(m.ws + OFF_Oslab)); a.Lslab = ((float*)(m.ws + OFF_Lslab));
  const int nitems = 640 + (want_ctx ? 20 : 0);
  for (int rep = 0; rep < REP_DIFF; ++rep) for (int idx = BID; idx < 256; idx += NBLK) attn_dispatch(a, idx, want_ctx, smem);
  for (int rep = 0; rep < REP_GLOB; ++rep) for (int idx = 256 + BID; idx < 512; idx += NBLK) attn_dispatch(a, idx, want_ctx, smem);
  for (int rep = 0; rep < REP_HY; ++rep) for (int c = BID; c < 256; c += NBLK) {
    hyena_channel(c, m.hy_bias + l * 512, ((float*)(m.ws + OFF_uT)), ((float*)(m.ws + OFF_zT)), ((float*)(m.ws + OFF_yT)), (const uint2*)(m.ws + OFF_Hc), smem);
    if (want_ctx) hyena_ctx_channel(m_in, l, c, smem);
  }
  for (int idx = 512 + BID; idx < nitems; idx += NBLK) attn_dispatch(a, idx, want_ctx, smem);
}

DI void phase_fin(MKP m_in, int l, bool want_ctx) {
  const MK m = launder_mk(m_in);
  const float* gmo = m.g_mix_out + l * D;
  for (int idx = BID * NTHR + TID; idx < NB * 8 * NT; idx += NBLK * NTHR) {
    const int p = idx % NT; const int hd = (idx / NT) % 8; const int b = idx / (NT * 8);
    if (p < CTX && !want_ctx) continue;
    float o[64]; float ss = 0.f;
    if (hd < 4) {
      size_t i0 = (((size_t)0 * NB + b) * 4 + hd) * NT + p, i1 = (((size_t)1 * NB + b) * 4 + hd) * NT + p;
      const float inv = 1.f / (((float*)(m.ws + OFF_Lslab))[i0] + ((float*)(m.ws + OFF_Lslab))[i1]);
      const float4* a0 = (const float4*)(((float*)(m.ws + OFF_Oslab)) + i0 * 64); const float4* a1 = (const float4*)(((float*)(m.ws + OFF_Oslab)) + i1 * 64);
#pragma unroll
      for (int i = 0; i < 16; ++i) {
        float4 x = a0[i], y = a1[i];
        o[4 * i] = (x.x + y.x) * inv; o[4 * i + 1] = (x.y + y.y) * inv; o[4 * i + 2] = (x.z + y.z) * inv; o[4 * i + 3] = (x.w + y.w) * inv;
      }
    } else {
      const int g = hd - 4;
#pragma unroll
      for (int i = 0; i < 64; ++i) o[i] = ((float*)(m.ws + OFF_yT))[((size_t)b * 256 + g * 64 + i) * NT + p];
    }
#pragma unroll
    for (int i = 0; i < 64; ++i) ss += o[i] * o[i];
    const float rs = rsqrtf(ss * (1.f / 64) + EPS);
    const float* gm = gmo + 512 + hd * 64;
    uint4* dst = (uint4*)(((bf16_t*)(m.ws + OFF_A2)) + ((size_t)b * NT + p) * D + 512 + hd * 64);
#pragma unroll
    for (int i = 0; i < 8; ++i)
      dst[i] = make_uint4(pk2bf(o[8 * i] * rs * gm[8 * i], o[8 * i + 1] * rs * gm[8 * i + 1]), pk2bf(o[8 * i + 2] * rs * gm[8 * i + 2], o[8 * i + 3] * rs * gm[8 * i + 3]),
                          pk2bf(o[8 * i + 4] * rs * gm[8 * i + 4], o[8 * i + 5] * rs * gm[8 * i + 5]), pk2bf(o[8 * i + 6] * rs * gm[8 * i + 6], o[8 * i + 7] * rs * gm[8 * i + 7]));
  }
}

DI void phase_peer(MKP m_in, int l, bool want_ctx, bool last, char* smem) {
  const MK m = launder_mk(m_in);
  float* wd = (float*)smem + (TID >> 6) * 128;
  const float* modv_l = ((float*)(m.ws + OFF_modv)) + (size_t)l * 3 * NMOD;
  for (int r = BID * 8 + (TID >> 6); r < R; r += NBLK * 8) {
    if ((r % NT) < CTX && !want_ctx) continue;
    peer_token(r, ((bf16_t*)(m.ws + OFF_hbuf)), ((int*)(m.ws + OFF_experts)), ((float*)(m.ws + OFF_gates)), ((unsigned char*)(m.ws + OFF_u8)) + (size_t)l * 16384 * D, ((float*)(m.ws + OFF_us)) + l * 16384, ((unsigned char*)(m.ws + OFF_v8)) + (size_t)l * 16384 * D, ((float*)(m.ws + OFF_vs)) + l * 16384,
               modv_l, ((float*)(m.ws + OFF_xs)), wd, last ? m.out : nullptr);
  }
}

DI void phase_scores(MKP m_in, int l, bool last, char* smem) {
  const MK m = launder_mk(m_in);
  const int nrt = last ? 128 : 132;
  for (int t = BID; t < nrt * 16; t += NBLK)
    score_tile(((bf16_t*)(m.ws + OFF_P)), ((bf16_t*)(m.ws + OFF_keysb)) + (size_t)l * 16 * 128 * 128, rowtile_of(t >> 4, last) * 128, t & 15, smem,
               ((unsigned*)(m.ws + OFF_topv)));
}
DI void phase_merge(MKP m_in, bool want_ctx) {
  const MK m = launder_mk(m_in);
  for (int idx = BID * NTHR + TID; idx < R * 8; idx += NBLK * NTHR) {
    int r = idx >> 3;
    if ((r % NT) < CTX && !want_ctx) continue;
    merge_one(((unsigned*)(m.ws + OFF_topv)), r, idx & 7, ((int*)(m.ws + OFF_experts)), ((float*)(m.ws + OFF_gates)));
  }
}
DI void phase_gemm1(MKP m_in, int l, char* smem) {
  const MK m = launder_mk(m_in);
  phase_gemm<0>((bf16_t*)(m.ws + OFF_hbuf), (bf16_t*)(m.ws + OFF_Wt_in) + (size_t)l * DIN * D, DIN, (bf16_t*)(m.ws + OFF_P), nullptr, nullptr, false, smem);
}
DI void phase_gemm2(MKP m_in, int l, bool last, char* smem) {
  const MK m = launder_mk(m_in);
  phase_gemm<1>((bf16_t*)(m.ws + OFF_A2), (bf16_t*)(m.ws + OFF_Wt_out) + (size_t)l * D * D, D, nullptr, (float*)(m.ws + OFF_xs),
                (float*)(m.ws + OFF_modv) + (size_t)l * 3 * NMOD + 2 * D, last, smem);
}
DI void phase_gemm3(MKP m_in, int l, bool last, char* smem) {
  const MK m = launder_mk(m_in);
  phase_gemm<0>((bf16_t*)(m.ws + OFF_hbuf), (bf16_t*)(m.ws + OFF_Wt_q) + (size_t)l * 2048 * D, 2048, (bf16_t*)(m.ws + OFF_P), nullptr, nullptr, last, smem);
}
#define GSYNC() xcd_barrier((unsigned*)(launder_mk(m).ws + OFF_bar), (volatile LAS unsigned*)(smem + SMEM_BYTES))
DI void phase_filters(MKP m_in, int l, char* smem) {
  const MK m = launder_mk(m_in);
  for (int c = BID; c < 256; c += NBLK)
    hyena_filter_task(c, ((float*)(m.ws + OFF_hdn2)) + (size_t)l * 64 * NT, m.hy_w3 + (size_t)l * 64 * 1024, m.hy_b3 + l * 1024, (uint2*)(m.ws + OFF_Hc), smem);
}
template <int L>
DI void layer_body(MKP m, char* smem) {
  constexpr bool want_ctx = L == 0, last = L == 1;
  for (int rep = 0; rep < REP_NORM1; ++rep) { phase_norm(m, L, 0, L == 0, false); GSYNC(); }
  for (int rep = 0; rep < REP_GEMM1; ++rep) { phase_gemm1(m, L, smem); GSYNC(); }
  for (int rep = 0; rep < REP_PREP; ++rep) { for (int t = BID; t < R / 32; t += NBLK) prep_tile(m, L, t, smem); phase_filters(m, L, smem); GSYNC(); }
  for (int rep = 0; rep < REP_MIX; ++rep) { phase_mix(m, L, want_ctx, smem); GSYNC(); }
  for (int rep = 0; rep < REP_FIN; ++rep) { phase_fin(m, L, want_ctx); GSYNC(); }
  phase_gemm2(m, L, last, smem);
  GSYNC();
  for (int rep = 0; rep < REP_NORM2; ++rep) { phase_norm(m, L, 1, false, last); GSYNC(); }
  for (int rep = 0; rep < REP_GEMM3; ++rep) { phase_gemm3(m, L, last, smem); GSYNC(); }
  for (int rep = 0; rep < REP_SCORES; ++rep) { phase_scores(m, L, last, smem); GSYNC(); }
  for (int rep = 0; rep < REP_MERGE; ++rep) { phase_merge(m, want_ctx); GSYNC(); }
  for (int rep = 0; rep < (last ? REP_PEER_LAST : 1); ++rep) {
    phase_peer(m, L, want_ctx, last, smem);
    if (!last || rep + 1 < REP_PEER_LAST) GSYNC();
  }
}
__global__ __launch_bounds__(NTHR) void k_mega(MK m_unused) {
  extern __shared__ __attribute__((aligned(16))) char smem[];
  (void)m_unused;
  MKP m = (MKP)__builtin_amdgcn_kernarg_segment_ptr();
  {
    volatile LAS unsigned* st = (volatile LAS unsigned*)(smem + SMEM_BYTES);
    if (threadIdx.x == 0) { st[0] = 0u; st[1] = 0u; st[2] = 0u; st[3] = 0u; }
    __syncthreads();
    xcd_barrier_post((unsigned*)(launder_mk(m).ws + OFF_bar));
  }
  for (int rep = 0; rep < REP_P0; ++rep) { phase0(m, smem); GSYNC(); }
  layer_body<0>(m, smem);
  layer_body<1>(m, smem);
}

extern "C" void kernel_launch(void* const* d_in, const int* in_sizes, int n_in, void* d_out, int out_size, void* d_ws, size_t ws_size,
                              hipStream_t stream) {
  (void)in_sizes; (void)n_in; (void)out_size;
  MK m;
  memset(&m, 0, sizeof(m));
  const float** ip = (const float**)&m.x;
  for (int i = 0; i < 30; ++i) ip[i] = (const float*)d_in[i];
  m.out = (float*)d_out;
  m.ws = (char*)d_ws;
  if (WS_TOTAL > ws_size) return;

  static int grid_blocks = 0;
  if (!grid_blocks) {
    (void)hipFuncSetAttribute((const void*)k_mega, hipFuncAttributeMaxDynamicSharedMemorySize, SMEM_BYTES + 16);
    int dev = 0, cus = 0, per_cu = 0;
    (void)hipGetDevice(&dev);
    (void)hipDeviceGetAttribute(&cus, hipDeviceAttributeMultiprocessorCount, dev);
    (void)hipOccupancyMaxActiveBlocksPerMultiprocessor(&per_cu, k_mega, NTHR, SMEM_BYTES + 16);
    if (per_cu > 1) per_cu = 1;
    grid_blocks = cus * per_cu;
  }
  (void)hipMemsetAsync(m.ws + OFF_bar, 0, (size_t)XCD_BAR_WORDS * 4, stream);
  void* args[] = {&m};
  (void)hipLaunchCooperativeKernel((void*)k_mega, dim3(grid_blocks), dim3(NTHR), args, SMEM_BYTES + 16, stream);
}
```

```cpp
#include <hip/hip_runtime.h>
#ifndef REP_DIFF
#define REP_DIFF 1
#endif
#ifndef REP_GLOB
#define REP_GLOB 1
#endif
#ifndef REP_HY
#define REP_HY 1
#endif
#ifndef REP_FILT
#define REP_FILT 1
#endif
#ifndef REP_PEER_U
#define REP_PEER_U 1
#endif
#ifndef REP_PEER_V
#define REP_PEER_V 1
#endif
#ifndef REP_NORM1
#define REP_NORM1 1
#endif
#ifndef REP_GEMM1
#define REP_GEMM1 1
#endif
#ifndef REP_PREP
#define REP_PREP 1
#endif
#ifndef REP_MIX
#define REP_MIX 1
#endif
#ifndef REP_FIN
#define REP_FIN 1
#endif
#ifndef REP_NORM2
#define REP_NORM2 1
#endif
#ifndef REP_GEMM3
#define REP_GEMM3 1
#endif
#ifndef REP_SCORES
#define REP_SCORES 1
#endif
#ifndef REP_MERGE
#define REP_MERGE 1
#endif
#ifndef REP_PEER_LAST
#define REP_PEER_LAST 1
#endif
#ifndef REP_P0
#define REP_P0 1
#endif
#include <hip/hip_cooperative_groups.h>
namespace cg = cooperative_groups;
#include <stdint.h>
#include <string.h>

#define DI __device__ __forceinline__
#define LAS __attribute__((address_space(3)))
typedef unsigned short bf16_t;

constexpr int D = 1024;
constexpr int NB = 2;
constexpr int SEQ = 8192;
constexpr int CTX = 256;
constexpr int NT = SEQ + CTX;
constexpr int R = NB * NT;
constexpr int DIN = 2560;
constexpr int NMOD = 6 * D;
constexpr float EPS = 1e-6f;
constexpr float LOG2E = 1.4426950408889634f;

DI int opq_v(int x) { asm volatile("" : "+v"(x)); return x; }
DI int opq_s(int x) { asm volatile("" : "+s"(x)); return x; }
template <class T> DI T* opq_p(T* p) { asm volatile("" : "+s"(p)); return p; }
#define TID opq_v((int)threadIdx.x)
#define BID opq_s((int)blockIdx.x)
#define NBLK opq_s((int)gridDim.x)
DI float shxl(float v, int lane, int mask) { return __builtin_bit_cast(float, __builtin_amdgcn_ds_bpermute((lane ^ mask) << 2, __builtin_bit_cast(int, v))); }
DI int shxl(int v, int lane, int mask) { return __builtin_amdgcn_ds_bpermute((lane ^ mask) << 2, v); }
DI float shx(float v, int mask) { return shxl(v, opq_v((int)threadIdx.x) & 63, mask); }
DI bf16_t f2bf(float x) { unsigned u = __float_as_uint(x); u += 0x7fffu + ((u >> 16) & 1u); return (bf16_t)(u >> 16); }
DI float bf2f(bf16_t h) { return __uint_as_float(((unsigned)h) << 16); }
DI float bflo(unsigned w) { return __uint_as_float(w << 16); }
DI float bfhi(unsigned w) { return __uint_as_float(w & 0xffff0000u); }

DI float block_sum_256(float v, float* red) {
  for (int o = 32; o > 0; o >>= 1) v += shx(v, o);
  int w = TID >> 6;
  __syncthreads();
  if ((TID & 63) == 0) red[w] = v;
  __syncthreads();
  float s = red[0] + red[1] + red[2] + red[3];
  return s;
}

DI int perm16(int o) { return (o & 3) | ((o & 4) << 1) | ((o & 8) >> 1); }

typedef __attribute__((ext_vector_type(8))) short bf16x8;
typedef __attribute__((ext_vector_type(16))) float f32x16;
typedef __attribute__((ext_vector_type(2))) __bf16 bf16x2_t;
typedef __attribute__((ext_vector_type(2))) float f32x2_t;
#define MFMA32(a, b, c) __builtin_amdgcn_mfma_f32_32x32x16_bf16((a), (b), (c), 0, 0, 0)
DI unsigned pk2bf(float a, float b) { f32x2_t v = {a, b}; return __builtin_bit_cast(unsigned, __builtin_convertvector(v, bf16x2_t)); }
constexpr int NTHR = 512;

DI void wconv_tile(const float* __restrict__ W, bf16_t* __restrict__ Wt, int N, int tile, float* sm  ) {
  int tn = tile % (N / 64), tk = tile / (N / 64);
  int tid = TID;
  __syncthreads();
  for (int i = tid; i < 64 * 16; i += NTHR) {
    int kr = i >> 4, c4 = (i & 15) * 4;
    float4 v = *(const float4*)(W + (size_t)(tk * 64 + kr) * N + tn * 64 + c4);
    sm[kr * 65 + c4] = v.x; sm[kr * 65 + c4 + 1] = v.y; sm[kr * 65 + c4 + 2] = v.z; sm[kr * 65 + c4 + 3] = v.w;
  }
  __syncthreads();
  for (int i = tid; i < 64 * 8; i += NTHR) {
    int n = i >> 3, k8 = (i & 7) * 8;
    unsigned w[4];
    for (int j = 0; j < 4; ++j) w[j] = pk2bf(sm[(k8 + 2 * j) * 65 + n], sm[(k8 + 2 * j + 1) * 65 + n]);
    *(uint4*)(Wt + (size_t)(tn * 64 + n) * D + tk * 64 + k8) = make_uint4(w[0], w[1], w[2], w[3]);
  }
}

template <int EPI, int K = D>
DI void gemm_tile(const bf16_t* __restrict__ A, const bf16_t* __restrict__ Wt, int N, int m0, int n0, char* smem, bf16_t* __restrict__ Cb,
                  float* __restrict__ xs, const float* __restrict__ gate_base, const float* __restrict__ xin = nullptr, const float* __restrict__ ctxin = nullptr) {
  const int tid = TID, lane = tid & 63, wid = tid >> 6;
  const int wm = wid & 1, wn = wid >> 1;
  const int r = lane & 31, h = lane >> 5;
  f32x16 acc0, acc1;
  for (int i = 0; i < 16; ++i) { acc0[i] = 0.f; acc1[i] = 0.f; }
  const int lrow = tid >> 3, lch = tid & 7;
  const bf16_t* Ag = A + (size_t)(m0 + lrow) * K + lch * 8;
  const bf16_t* Bg = Wt + (size_t)(n0 + lrow) * K + lch * 8;
  const int woff = lrow * 128 + ((lch ^ ((lrow >> 1) & 7)) << 4);
  uint4 ra0, ra1, rb0, rb1;
  ra0 = *(const uint4*)(Ag); ra1 = *(const uint4*)(Ag + (size_t)64 * K);
  rb0 = *(const uint4*)(Bg); rb1 = *(const uint4*)(Bg + (size_t)64 * K);
  __syncthreads();
  *(uint4*)(smem + woff) = ra0; *(uint4*)(smem + woff + 8192) = ra1;
  *(uint4*)(smem + 16384 + woff) = rb0; *(uint4*)(smem + 16384 + woff + 8192) = rb1;
  __syncthreads();
  const int sw = (r >> 1) & 7;
  const int aoff0 = (wm * 64 + r) * 128, aoff1 = aoff0 + 32 * 128;
  const int boff = 16384 + (wn * 32 + r) * 128;
#pragma unroll 1
  for (int kt = 0; kt < K / 64; ++kt) {
    const char* st = smem + (kt & 1) * 32768;
    if (kt + 1 < K / 64) {
      ra0 = *(const uint4*)(Ag + (kt + 1) * 64); ra1 = *(const uint4*)(Ag + (size_t)64 * K + (kt + 1) * 64);
      rb0 = *(const uint4*)(Bg + (kt + 1) * 64); rb1 = *(const uint4*)(Bg + (size_t)64 * K + (kt + 1) * 64);
    }
#pragma unroll
    for (int s = 0; s < 4; ++s) {
      int co = ((2 * s + h) ^ sw) << 4;
      bf16x8 a0 = *(const bf16x8*)(st + aoff0 + co);
      bf16x8 a1 = *(const bf16x8*)(st + aoff1 + co);
      bf16x8 b = *(const bf16x8*)(st + boff + co);
      acc0 = MFMA32(a0, b, acc0);
      acc1 = MFMA32(a1, b, acc1);
    }
    if (kt + 1 < K / 64) {
      char* sn = smem + ((kt + 1) & 1) * 32768;
      *(uint4*)(sn + woff) = ra0; *(uint4*)(sn + woff + 8192) = ra1;
      *(uint4*)(sn + 16384 + woff) = rb0; *(uint4*)(sn + 16384 + woff + 8192) = rb1;
    }
    __syncthreads();
  }
  float* Cs = (float*)smem;
  constexpr int CS = 132;
#pragma unroll
  for (int i = 0; i < 16; ++i) {
    int row = (i & 3) + 8 * (i >> 2) + 4 * h;
    Cs[(wm * 64 + row) * CS + wn * 32 + r] = acc0[i];
    Cs[(wm * 64 + 32 + row) * CS + wn * 32 + r] = acc1[i];
  }
  __syncthreads();
  if (EPI == 0) {
    for (int i = tid; i < 128 * 16; i += NTHR) {
      int row = i >> 4, c8 = (i & 15) * 8;
      const float* cr = Cs + row * CS + c8;
      float4 v0 = *(const float4*)cr, v1 = *(const float4*)(cr + 4);
      *(uint4*)(Cb + (size_t)(m0 + row) * N + n0 + c8) = make_uint4(pk2bf(v0.x, v0.y), pk2bf(v0.z, v0.w), pk2bf(v1.x, v1.y), pk2bf(v1.z, v1.w));
    }
  } else if (EPI == 2) {
    for (int i = tid; i < 128 * 32; i += NTHR) {
      const int col = i >> 5, r4 = (i & 31) * 4;
      const float4 v = make_float4(Cs[r4 * CS + col], Cs[(r4 + 1) * CS + col], Cs[(r4 + 2) * CS + col], Cs[(r4 + 3) * CS + col]);
      *(float4*)(xs + (size_t)(n0 + col) * N + m0 + r4) = v;
    }
  } else {
    for (int i = tid; i < 128 * 32; i += NTHR) {
      int row = i >> 5, c4 = (i & 31) * 4;
      int rr = m0 + row; int b = rr / NT, p = rr % NT; int mrow = p < CTX ? 2 : b;
      const float* gt = gate_base + mrow * NMOD + n0 + c4;
      float4 v = *(const float4*)(Cs + row * CS + c4);
      const float* rsrc = xin ? (p < CTX ? ctxin + ((size_t)b * CTX + p) * D : xin + ((size_t)b * SEQ + (p - CTX)) * D) : xs + (size_t)rr * D;
      float4 xv = *(const float4*)(rsrc + n0 + c4);
      xv.x += gt[0] * v.x; xv.y += gt[1] * v.y; xv.z += gt[2] * v.z; xv.w += gt[3] * v.w;
      *(float4*)(xs + (size_t)rr * D + n0 + c4) = xv;
    }
  }
}


struct AttnArgs {
  const bf16_t *QA, *KA, *VAt, *QW, *KW, *VWt, *QG, *KG, *VGt;
  const float *g_qk_diff, *g_qk_win, *g_qk_glob, *sink, *lambda_diff, *g_mix_out;
  float lambda_init;
  int pad0;
  bf16_t* A2;
  float* Oslab;
  float* Lslab;
};

DI void store_head_bf16(char* wl, const float (&o)[32], float rs, const float* __restrict__ gm, bf16_t* __restrict__ dst_row0  ,
                        int lane) {
  const int r = lane & 31, h = lane >> 5;
#pragma unroll
  for (int dt = 0; dt < 2; ++dt)
#pragma unroll
    for (int q4 = 0; q4 < 4; ++q4) {
      const int dv = 32 * dt + 8 * q4 + 4 * h;
      const float* ov = o + 16 * dt + 4 * q4;
      *(uint2*)(wl + r * 136 + dv * 2) = make_uint2(pk2bf(ov[0] * rs * gm[dv], ov[1] * rs * gm[dv + 1]), pk2bf(ov[2] * rs * gm[dv + 2], ov[3] * rs * gm[dv + 3]));
    }
  asm volatile("s_waitcnt lgkmcnt(0)" ::: "memory");
#pragma unroll
  for (int ps = 0; ps < 4; ++ps) {
    const int row = ps * 8 + (lane >> 3), ch = lane & 7;
    const uint2 a = *(const uint2*)(wl + row * 136 + ch * 16), c = *(const uint2*)(wl + row * 136 + ch * 16 + 8);
    *(uint4*)(dst_row0 + (size_t)row * D + ch * 8) = make_uint4(a.x, a.y, c.x, c.y);
  }
  asm volatile("s_waitcnt lgkmcnt(0)" ::: "memory");
}
DI void store_head_f32(char* wl, const f32x16& Oa, const f32x16& Ob, float* __restrict__ dst_row0, int lane) {
  const int r = lane & 31, h = lane >> 5;
#pragma unroll
  for (int dt = 0; dt < 2; ++dt)
#pragma unroll
    for (int q4 = 0; q4 < 4; ++q4) {
      const f32x16& O = dt == 0 ? Oa : Ob;
      *(float4*)(wl + r * 272 + (32 * dt + 8 * q4 + 4 * h) * 4) = make_float4(O[4 * q4], O[4 * q4 + 1], O[4 * q4 + 2], O[4 * q4 + 3]);
    }
  asm volatile("s_waitcnt lgkmcnt(0)" ::: "memory");
#pragma unroll
  for (int ps = 0; ps < 8; ++ps) {
    const int row = ps * 4 + (lane >> 4), ch = lane & 15;
    *(float4*)(dst_row0 + (size_t)row * 64 + ch * 4) = *(const float4*)(wl + row * 272 + ch * 16);
  }
  asm volatile("s_waitcnt lgkmcnt(0)" ::: "memory");
}

template <int TYPE>
DI void attn_item(const AttnArgs& a, int b, int g, int p0, int ctx0, int nctx, int lat0, int nkt, int half, char* smem) {
  constexpr int DQK = TYPE == 0 ? 32 : 64;
  constexpr int KS = DQK / 16;
  const int tid = TID, lane = tid & 63, wid = tid >> 6;
  const int r = lane & 31, h = lane >> 5;
  const bf16_t *Q0, *Q1, *K0, *K1, *Vt;
  const float* gqk;
  if (TYPE == 0) {
    Q0 = a.QA + ((size_t)b * 8 + 2 * g) * NT * 32; Q1 = Q0 + (size_t)NT * 32;
    K0 = a.KA + ((size_t)b * 8 + 2 * g) * NT * 32; K1 = K0 + (size_t)NT * 32;
    Vt = a.VAt + ((size_t)b * 4 + g) * 64 * NT; gqk = a.g_qk_diff;
  } else if (TYPE == 1) {
    Q0 = a.QW + ((size_t)b * 4 + 2 * g) * NT * 64; Q1 = Q0 + (size_t)NT * 64;
    K0 = a.KW + ((size_t)b * 2 + g) * NT * 64; K1 = K0;
    Vt = a.VWt + ((size_t)b * 2 + g) * 64 * NT; gqk = a.g_qk_win;
  } else {
    Q0 = a.QG + ((size_t)b * 4 + 2 * g) * NT * 64; Q1 = Q0 + (size_t)NT * 64;
    K0 = a.KG + ((size_t)b * 2 + g) * NT * 64; K1 = K0;
    Vt = a.VGt + ((size_t)b * 2 + g) * 64 * NT; gqk = a.g_qk_glob;
  }
  (void)gqk;
  const int qpos = p0 + wid * 32 + r;
  bf16x8 qf0[KS], qf1[KS];
#pragma unroll
  for (int s = 0; s < KS; ++s) {
    qf0[s] = *(const bf16x8*)(Q0 + (size_t)qpos * DQK + 16 * s + 8 * h);
    qf1[s] = *(const bf16x8*)(Q1 + (size_t)qpos * DQK + 16 * s + 8 * h);
  }
  f32x16 O00, O01, O10, O11, Zero;
#pragma unroll
  for (int i = 0; i < 16; ++i) { O00[i] = 0.f; O01[i] = 0.f; O10[i] = 0.f; O11[i] = 0.f; Zero[i] = 0.f; }
  float l0 = 0.f, l1 = 0.f;

  auto tile_of = [&](int it) { return it < nctx ? ctx0 + it : lat0 + it - nctx; };
  const int wvu = __builtin_amdgcn_readfirstlane(tid >> 6);
#define ATT_GLDS(kt_, sb_)                                                                               \
  {                                                                                                      \
    const int kt__ = (kt_);                                                                              \
    LAS char* sl__ = (LAS char*)(sb_);                                                                   \
    if (TYPE == 0) {                                                                                     \
      const int row = tid >> 2, ch = (tid & 3) ^ ((row >> 2) & 3);                                       \
      __builtin_amdgcn_global_load_lds((const unsigned*)(K0 + (size_t)(kt__ * 128 + row) * 32 + ch * 8), (LAS unsigned*)(sl__ + wvu * 1024), 16, 0, 0);          \
      __builtin_amdgcn_global_load_lds((const unsigned*)(K1 + (size_t)(kt__ * 128 + row) * 32 + ch * 8), (LAS unsigned*)(sl__ + 8192 + wvu * 1024), 16, 0, 0);   \
    } else {                                                                                             \
      _Pragma("unroll") for (int i2 = 0; i2 < 2; ++i2) {                                                 \
        const int lc = tid + 512 * i2; const int row = lc >> 3, ch = (lc & 7) ^ ((row >> 1) & 7);        \
        __builtin_amdgcn_global_load_lds((const unsigned*)(K0 + (size_t)(kt__ * 128 + row) * 64 + ch * 8), (LAS unsigned*)(sl__ + i2 * 8192 + wvu * 1024), 16, 0, 0); \
      }                                                                                                  \
    }                                                                                                    \
    _Pragma("unroll") for (int i2 = 0; i2 < 2; ++i2) {                                                   \
      const int lc = tid + 512 * i2; const int row = lc >> 4, ch = (lc & 15) ^ (row & 15);               \
      __builtin_amdgcn_global_load_lds((const unsigned*)(Vt + (size_t)row * NT + kt__ * 128 + ch * 8), (LAS unsigned*)(sl__ + 16384 + i2 * 8192 + wvu * 1024), 16, 0, 0); \
    }                                                                                                    \
  }
  __syncthreads();
  ATT_GLDS(tile_of(0), smem);
  asm volatile("s_waitcnt vmcnt(0)" ::: "memory");
  __syncthreads();
  const int qwave = p0 + wid * 32;
  const int vbase = r * 256 + ((h ^ (r & 15)) << 4);
#pragma unroll 1
  for (int it = 0; it < nkt; ++it) {
    const int kt = tile_of(it);
    const char* sb = smem + (it & 1) * 32768;
    if (it + 1 < nkt) ATT_GLDS(tile_of(it + 1), smem + ((it + 1) & 1) * 32768);
#pragma unroll 2
    for (int j = 0; j < 4; ++j) {
      const int kbase = kt * 128 + 32 * j;
      bool masked = false;
      if (TYPE == 1) {
        if (kbase >= CTX && p0 >= CTX) {
          if (kbase > qwave + 31 + 128 || kbase + 31 < qwave - 128) continue;
          masked = true;
        }
      }
      f32x16 S0 = Zero, S1 = Zero;
#pragma unroll
      for (int s = 0; s < KS; ++s) {
        if (TYPE == 0) {
          int row = 32 * j + r;
          int off = row * 64 + (((2 * s + h) ^ ((row >> 2) & 3)) << 4);
          bf16x8 k0 = *(const bf16x8*)(sb + off);
          bf16x8 k1 = *(const bf16x8*)(sb + 8192 + off);
          S0 = MFMA32(k0, qf0[s], S0);
          S1 = MFMA32(k1, qf1[s], S1);
        } else {
          int row = 32 * j + r;
          int off = row * 128 + (((2 * s + h) ^ ((row >> 1) & 7)) << 4);
          bf16x8 k0 = *(const bf16x8*)(sb + off);
          S0 = MFMA32(k0, qf0[s], S0);
          S1 = MFMA32(k0, qf1[s], S1);
        }
      }
      float pa[16], pb[16];
#pragma unroll
      for (int i = 0; i < 16; ++i) {
        float e0 = __builtin_amdgcn_exp2f(S0[i]);
        float e1 = __builtin_amdgcn_exp2f(S1[i]);
        if (TYPE == 1) {
          if (masked) {
            int kp = kbase + (i & 3) + 8 * (i >> 2) + 4 * h;
            int dd = kp - qpos;
            bool ok = (dd <= 128) && (dd >= -128);
            e0 = ok ? e0 : 0.f; e1 = ok ? e1 : 0.f;
          }
        }
        pa[i] = e0; pb[i] = e1;
      }
      l0 += ((pa[0] + pa[1]) + (pa[2] + pa[3])) + ((pa[4] + pa[5]) + (pa[6] + pa[7])) + ((pa[8] + pa[9]) + (pa[10] + pa[11])) + ((pa[12] + pa[13]) + (pa[14] + pa[15]));
      l1 += ((pb[0] + pb[1]) + (pb[2] + pb[3])) + ((pb[4] + pb[5]) + (pb[6] + pb[7])) + ((pb[8] + pb[9]) + (pb[10] + pb[11])) + ((pb[12] + pb[13]) + (pb[14] + pb[15]));
      bf16x8 pf0[2], pf1[2];
#pragma unroll
      for (int s2 = 0; s2 < 2; ++s2) {
        unsigned w0[4], w1[4];
#pragma unroll
        for (int e = 0; e < 4; ++e) {
          w0[e] = pk2bf(pa[8 * s2 + 2 * e], pa[8 * s2 + 2 * e + 1]);
          w1[e] = pk2bf(pb[8 * s2 + 2 * e], pb[8 * s2 + 2 * e + 1]);
        }
        pf0[s2] = __builtin_bit_cast(bf16x8, make_uint4(w0[0], w0[1], w0[2], w0[3]));
        pf1[s2] = __builtin_bit_cast(bf16x8, make_uint4(w1[0], w1[1], w1[2], w1[3]));
      }
#pragma unroll
      for (int s2 = 0; s2 < 2; ++s2) {
        const int vo = vbase ^ ((4 * j + 2 * s2) << 4);
        bf16x8 v0 = *(const bf16x8*)(sb + 16384 + vo);
        bf16x8 v1 = *(const bf16x8*)(sb + 16384 + 8192 + vo);
        O00 = MFMA32(v0, pf0[s2], O00);
        O01 = MFMA32(v1, pf0[s2], O01);
        O10 = MFMA32(v0, pf1[s2], O10);
        O11 = MFMA32(v1, pf1[s2], O11);
      }
    }
    asm volatile("s_waitcnt vmcnt(0)" ::: "memory");
    __syncthreads();
  }
  l0 += shxl(l0, lane, 32);
  l1 += shxl(l1, lane, 32);
  if (TYPE == 1) {
    l0 += __builtin_amdgcn_exp2f(a.sink[2 * g] * LOG2E);
    l1 += __builtin_amdgcn_exp2f(a.sink[2 * g + 1] * LOG2E);
  }
  const size_t orow0 = (size_t)b * NT + p0 + wid * 32;
  char* wl = smem + wid * 8704;
  if (TYPE == 2) {
#pragma unroll
    for (int x = 0; x < 2; ++x) {
      int head = 2 * g + x;
      float* dst0 = a.Oslab + ((((size_t)half * NB + b) * 4 + head) * NT + (p0 + wid * 32)) * 64;
      if (x == 0) store_head_f32(wl, O00, O01, dst0, lane); else store_head_f32(wl, O10, O11, dst0, lane);
      if (h == 0) a.Lslab[(((size_t)half * NB + b) * 4 + head) * NT + qpos] = x == 0 ? l0 : l1;
    }
  } else if (TYPE == 0) {
    float s0 = 0.f, s1 = 0.f;
    for (int d = 0; d < 32; ++d) { s0 += a.lambda_diff[d] * a.lambda_diff[32 + d]; s1 += a.lambda_diff[64 + d] * a.lambda_diff[96 + d]; }
    const float lam = __expf(s0) - __expf(s1) + a.lambda_init;
    const float i0 = 1.f / l0, i1 = lam / l1;
    float o[32];
    float ss = 0.f;
#pragma unroll
    for (int i = 0; i < 16; ++i) {
      o[i] = O00[i] * i0 - O10[i] * i1;
      o[16 + i] = O01[i] * i0 - O11[i] * i1;
      ss += o[i] * o[i] + o[16 + i] * o[16 + i];
    }
    ss += shxl(ss, lane, 32);
    const float rs = rsqrtf(ss * (1.f / 64) + EPS) * (1.f - a.lambda_init);
    const float* gm = a.g_mix_out + g * 64;
    store_head_bf16(wl, o, rs, gm, a.A2 + orow0 * D + g * 64, lane);
  } else {
#pragma unroll
    for (int x = 0; x < 2; ++x) {
      const float inv = 1.f / (x == 0 ? l0 : l1);
      float o[32];
      float ss = 0.f;
#pragma unroll
      for (int i = 0; i < 16; ++i) {
        o[i] = (x == 0 ? O00[i] : O10[i]) * inv;
        o[16 + i] = (x == 0 ? O01[i] : O11[i]) * inv;
        ss += o[i] * o[i] + o[16 + i] * o[16 + i];
      }
      ss += shxl(ss, lane, 32);
      const float rs = rsqrtf(ss * (1.f / 64) + EPS);
      const int col0 = 256 + (2 * g + x) * 64;
      const float* gm = a.g_mix_out + col0;
      store_head_bf16(wl, o, rs, gm, a.A2 + orow0 * D + col0, lane);
    }
  }
}

DI void attn_dispatch(const AttnArgs& a, int idx, int want_ctx, char* smem) {
  if (idx < 256) {
    int b = idx >> 7, g = (idx >> 5) & 3, qt = 1 + (idx & 31);
    attn_item<0>(a, b, g, qt * 256, 0, 2, 2, 66, 0, smem);
  } else if (idx < 512) {
    int i = idx - 256; int half = i >> 7, b = (i >> 6) & 1, g = (i >> 5) & 1, qt = 1 + (i & 31);
    if (half == 0) attn_item<2>(a, b, g, qt * 256, 0, 2, 2, 33, 0, smem);
    else attn_item<2>(a, b, g, qt * 256, 0, 0, 33, 33, 1, smem);
  } else if (idx < 640) {
    int i = idx - 512; int b = i >> 6, g = (i >> 5) & 1, qt = 1 + (i & 31);
    int lo = max(2, 2 * qt - 1), hi = min(65, 2 * qt + 2);
    attn_item<1>(a, b, g, qt * 256, 0, 2, lo, 2 + (hi - lo + 1), 0, smem);
  } else if (want_ctx) {
    int i = idx - 640;
    if (i < 8) attn_item<0>(a, i >> 2, i & 3, 0, 0, 2, 0, 2, 0, smem);
    else if (i < 16) { int k = i - 8; int half = k >> 2, b = (k >> 1) & 1, g = k & 1; attn_item<2>(a, b, g, 0, half, 1, 0, 1, half, smem); }
    else if (i < 20) { int k = i - 16; attn_item<1>(a, k >> 1, k & 1, 0, 0, 2, 0, 2, 0, smem); }
  }
}

typedef __attribute__((ext_vector_type(4))) float f32x4v;
typedef __attribute__((ext_vector_type(2))) _Float16 h2_t;
DI unsigned pack_i8x4(float a, float b, float c, float d) {
  const int ia = (int)__builtin_rintf(a), ib = (int)__builtin_rintf(b), ic = (int)__builtin_rintf(c), id = (int)__builtin_rintf(d);
  return (unsigned)(ia & 255) | ((unsigned)(ib & 255) << 8) | ((unsigned)(ic & 255) << 16) | ((unsigned)id << 24);
}
constexpr size_t TSLICE = (size_t)16384 * 128;
DI void tabconv_fin_i8(float4 v0, float4 v1, float4 v2, float4 v3, unsigned char* __restrict__ dst, float* __restrict__ scale, size_t row, int lane) {
  float m = fmaxf(fmaxf(fmaxf(fabsf(v0.x), fabsf(v0.y)), fmaxf(fabsf(v0.z), fabsf(v0.w))), fmaxf(fmaxf(fabsf(v1.x), fabsf(v1.y)), fmaxf(fabsf(v1.z), fabsf(v1.w))));
  m = fmaxf(m, fmaxf(fmaxf(fmaxf(fabsf(v2.x), fabsf(v2.y)), fmaxf(fabsf(v2.z), fabsf(v2.w))), fmaxf(fmaxf(fabsf(v3.x), fabsf(v3.y)), fmaxf(fabsf(v3.z), fabsf(v3.w)))));
  for (int o = 32; o > 0; o >>= 1) m = fmaxf(m, shxl(m, lane, o));
  m = fmaxf(m, 1e-30f);
  const float sc = m * (1.f / 127.f), inv = 127.f / m;
  *(uint4*)(dst + (size_t)(lane >> 3) * TSLICE + row * 128 + (lane & 7) * 16) = make_uint4(pack_i8x4(v0.x * inv, v0.y * inv, v0.z * inv, v0.w * inv), pack_i8x4(v1.x * inv, v1.y * inv, v1.z * inv, v1.w * inv),
                                                    pack_i8x4(v2.x * inv, v2.y * inv, v2.z * inv, v2.w * inv), pack_i8x4(v3.x * inv, v3.y * inv, v3.z * inv, v3.w * inv));
  if (lane == 0) scale[row] = sc;
}
DI void tabconv_fin(float4 v0, float4 v1, float4 v2, float4 v3, unsigned char* __restrict__ dst, float* __restrict__ scale, size_t row, int lane) {
  float m = fmaxf(fmaxf(fmaxf(fabsf(v0.x), fabsf(v0.y)), fmaxf(fabsf(v0.z), fabsf(v0.w))), fmaxf(fmaxf(fabsf(v1.x), fabsf(v1.y)), fmaxf(fabsf(v1.z), fabsf(v1.w))));
  m = fmaxf(m, fmaxf(fmaxf(fmaxf(fabsf(v2.x), fabsf(v2.y)), fmaxf(fabsf(v2.z), fabsf(v2.w))), fmaxf(fmaxf(fabsf(v3.x), fabsf(v3.y)), fmaxf(fabsf(v3.z), fabsf(v3.w)))));
  for (int o = 32; o > 0; o >>= 1) m = fmaxf(m, shxl(m, lane, o));
  m = fmaxf(m, 1e-30f);
  const float sc = m * (1.f / 448.f), inv = 448.f / m;
  int w0 = __builtin_amdgcn_cvt_pk_fp8_f32(v0.x * inv, v0.y * inv, 0, false); w0 = __builtin_amdgcn_cvt_pk_fp8_f32(v0.z * inv, v0.w * inv, w0, true);
  int w1 = __builtin_amdgcn_cvt_pk_fp8_f32(v1.x * inv, v1.y * inv, 0, false); w1 = __builtin_amdgcn_cvt_pk_fp8_f32(v1.z * inv, v1.w * inv, w1, true);
  int w2 = __builtin_amdgcn_cvt_pk_fp8_f32(v2.x * inv, v2.y * inv, 0, false); w2 = __builtin_amdgcn_cvt_pk_fp8_f32(v2.z * inv, v2.w * inv, w2, true);
  int w3 = __builtin_amdgcn_cvt_pk_fp8_f32(v3.x * inv, v3.y * inv, 0, false); w3 = __builtin_amdgcn_cvt_pk_fp8_f32(v3.z * inv, v3.w * inv, w3, true);
  *(uint4*)(dst + (size_t)(lane >> 3) * TSLICE + row * 128 + (lane & 7) * 16) = make_uint4((unsigned)w0, (unsigned)w1, (unsigned)w2, (unsigned)w3);
  if (lane == 0) scale[row] = sc;
}
DI void score_sort(const bf16_t* __restrict__ qbuf, const bf16_t* __restrict__ keysb, int m0, int hp, char* smem, unsigned (&v16)[16]) {
  const int tid = TID, lane = tid & 63, wid = tid >> 6;
  const int wm = wid & 1, wn = wid >> 1;
  const int r = lane & 31, h = lane >> 5;
  f32x16 acc0, acc1;
  for (int i = 0; i < 16; ++i) { acc0[i] = 0.f; acc1[i] = 0.f; }
  const int lrow = tid >> 3, lch = tid & 7;
  const bf16_t* Ag = qbuf + (size_t)(m0 + lrow) * 2048 + hp * 128 + lch * 8;
  const bf16_t* Bg = keysb + ((size_t)hp * 128 + lrow) * 128 + lch * 8;
  const int woff = lrow * 128 + ((lch ^ ((lrow >> 1) & 7)) << 4);
  __syncthreads();
#pragma unroll
  for (int kt = 0; kt < 2; ++kt) {
    char* sn = smem + kt * 32768;
    *(uint4*)(sn + woff) = *(const uint4*)(Ag + kt * 64);
    *(uint4*)(sn + woff + 8192) = *(const uint4*)(Ag + (size_t)64 * 2048 + kt * 64);
    *(uint4*)(sn + 16384 + woff) = *(const uint4*)(Bg + kt * 64);
    *(uint4*)(sn + 16384 + woff + 8192) = *(const uint4*)(Bg + 64 * 128 + kt * 64);
  }
  __syncthreads();
  const int sw = (r >> 1) & 7;
  const int aoff0 = (wm * 64 + r) * 128, aoff1 = aoff0 + 32 * 128;
  const int boff = 16384 + (wn * 32 + r) * 128;
#pragma unroll
  for (int kt = 0; kt < 2; ++kt) {
    const char* st = smem + kt * 32768;
#pragma unroll
    for (int s = 0; s < 4; ++s) {
      int co = ((2 * s + h) ^ sw) << 4;
      bf16x8 a0 = *(const bf16x8*)(st + aoff0 + co);
      bf16x8 a1 = *(const bf16x8*)(st + aoff1 + co);
      bf16x8 b = *(const bf16x8*)(st + boff + co);
      acc0 = MFMA32(a0, b, acc0);
      acc1 = MFMA32(a1, b, acc1);
    }
  }
  __syncthreads();
  float* Cs = (float*)smem;
  constexpr int CS = 132;
#pragma unroll
  for (int i = 0; i < 16; ++i) {
    int row = (i & 3) + 8 * (i >> 2) + 4 * h;
    Cs[(wm * 64 + row) * CS + wn * 32 + r] = acc0[i];
    Cs[(wm * 64 + 32 + row) * CS + wn * 32 + r] = acc1[i];
  }
  __syncthreads();
  const int row = tid >> 2, q = tid & 3;
  unsigned v[32];
#pragma unroll
  for (int i = 0; i < 32; ++i) {
    unsigned u = __float_as_uint(Cs[row * CS + 4 * i + q]);
    u ^= (u & 0x80000000u) ? 0xffffffffu : 0x80000000u;
    v[i] = (u & ~127u) | (unsigned)(127 - (4 * i + q));
  }
#pragma unroll
  for (int k = 2; k <= 32; k <<= 1)
#pragma unroll
    for (int j = k >> 1; j > 0; j >>= 1)
#pragma unroll
      for (int i = 0; i < 32; ++i) {
        const int l = i ^ j;
        if (l > i) {
          const unsigned lo = min(v[i], v[l]), hi = max(v[i], v[l]);
          if ((i & k) == 0) { v[i] = hi; v[l] = lo; } else { v[i] = lo; v[l] = hi; }
        }
      }
#pragma unroll
  for (int step = 0; step < 2; ++step) {
    unsigned c[16];
#pragma unroll
    for (int i = 0; i < 16; ++i) {
      const unsigned o = step == 0 ? (unsigned)__builtin_amdgcn_mov_dpp((int)v[15 - i], 0xB1, 0xf, 0xf, false)
                                   : (unsigned)__builtin_amdgcn_mov_dpp((int)v[15 - i], 0x4E, 0xf, 0xf, false);
      c[i] = max(v[i], o);
    }
#pragma unroll
    for (int j = 8; j > 0; j >>= 1)
#pragma unroll
      for (int i = 0; i < 16; ++i) {
        const int l = i ^ j;
        if (l > i) { const unsigned lo = min(c[i], c[l]), hi = max(c[i], c[l]); c[i] = hi; c[l] = lo; }
      }
#pragma unroll
    for (int i = 0; i < 16; ++i) v[i] = c[i];
  }
#pragma unroll
  for (int i = 0; i < 16; ++i) v16[i] = v[i];
}
constexpr int CAND_I[52] = {0, 0, 0, 0, 0, 0, 0, 0, 0, 0, 0, 0, 0, 0, 0, 0, 1, 1, 1, 1, 1, 1, 1, 1, 2, 2, 2, 2, 2, 3, 3, 3, 3, 4, 4, 4, 5, 5, 6, 6, 7, 7, 8, 9, 10, 11, 12, 13, 14, 15, 0, 0};
constexpr int CAND_J[52] = {0, 1, 2, 3, 4, 5, 6, 7, 8, 9, 10, 11, 12, 13, 14, 15, 0, 1, 2, 3, 4, 5, 6, 7, 0, 1, 2, 3, 4, 0, 1, 2, 3, 0, 1, 2, 0, 1, 0, 1, 0, 1, 0, 0, 0, 0, 0, 0, 0, 0, 0, 0};
DI float sel4(int q, float a, float b, float c, float d) { return q == 0 ? a : q == 1 ? b : q == 2 ? c : d; }
DI unsigned sel4u(int q, unsigned a, unsigned b, unsigned c, unsigned d) { return q == 0 ? a : q == 1 ? b : q == 2 ? c : d; }
DI float key7f(unsigned k) { k &= ~127u; k ^= (k & 0x80000000u) ? 0x80000000u : 0xffffffffu; return __uint_as_float(k); }
DI float key8f(unsigned k) { k &= ~255u; k ^= (k & 0x80000000u) ? 0x80000000u : 0xffffffffu; return __uint_as_float(k); }
DI void score_head_item(const bf16_t* __restrict__ qbuf, const bf16_t* __restrict__ keysb, int m0, int hd, char* smem, int* __restrict__ experts,
                        float* __restrict__ gates) {
  unsigned ka[16], kb[16];
  score_sort(qbuf, keysb, m0, 2 * hd, smem, ka);
  score_sort(qbuf, keysb, m0, 2 * hd + 1, smem, kb);
  const int tid = TID, row = tid >> 2, q = tid & 3;
  unsigned char* ix = (unsigned char*)(smem + 69632) + row * 32;
  *(unsigned*)(ix + 4 * q) = (sel4u(q, ka[0], ka[4], ka[8], ka[12]) & 127u) | ((sel4u(q, ka[1], ka[5], ka[9], ka[13]) & 127u) << 8) |
                             ((sel4u(q, ka[2], ka[6], ka[10], ka[14]) & 127u) << 16) | ((sel4u(q, ka[3], ka[7], ka[11], ka[15]) & 127u) << 24);
  *(unsigned*)(ix + 16 + 4 * q) = (sel4u(q, kb[0], kb[4], kb[8], kb[12]) & 127u) | ((sel4u(q, kb[1], kb[5], kb[9], kb[13]) & 127u) << 8) |
                                  ((sel4u(q, kb[2], kb[6], kb[10], kb[14]) & 127u) << 16) | ((sel4u(q, kb[3], kb[7], kb[11], kb[15]) & 127u) << 24);
  float a[16], b[16];
#pragma unroll
  for (int i = 0; i < 16; ++i) { a[i] = key7f(ka[i]); b[i] = key7f(kb[i]); }
  unsigned c[16];
#pragma unroll
  for (int t = 0; t < 16; ++t) {
    if (4 * t >= 52) { c[t] = 0u; continue; }
    const float sv = sel4(q, a[CAND_I[4 * t]], a[CAND_I[4 * t + 1]], a[CAND_I[4 * t + 2]], a[CAND_I[4 * t + 3]]) +
                     sel4(q, b[CAND_J[4 * t]], b[CAND_J[4 * t + 1]], b[CAND_J[4 * t + 2]], b[CAND_J[4 * t + 3]]);
    const unsigned code = sel4u(q, CAND_I[4 * t] * 16 + CAND_J[4 * t], CAND_I[4 * t + 1] * 16 + CAND_J[4 * t + 1], CAND_I[4 * t + 2] * 16 + CAND_J[4 * t + 2],
                                CAND_I[4 * t + 3] * 16 + CAND_J[4 * t + 3]);
    unsigned u = __float_as_uint(sv);
    u ^= (u & 0x80000000u) ? 0xffffffffu : 0x80000000u;
    const bool valid = (4 * t + q) < 50;
    c[t] = valid ? ((u & ~255u) | code) : 0u;
  }
#pragma unroll
  for (int k = 2; k <= 16; k <<= 1)
#pragma unroll
    for (int j = k >> 1; j > 0; j >>= 1)
#pragma unroll
      for (int i = 0; i < 16; ++i) {
        const int l = i ^ j;
        if (l > i) {
          const unsigned lo = min(c[i], c[l]), hi = max(c[i], c[l]);
          if ((i & k) == 0) { c[i] = hi; c[l] = lo; } else { c[i] = lo; c[l] = hi; }
        }
      }
#pragma unroll
  for (int step = 0; step < 2; ++step) {
    unsigned d[16];
#pragma unroll
    for (int i = 0; i < 16; ++i) {
      const unsigned o = step == 0 ? (unsigned)__builtin_amdgcn_mov_dpp((int)c[15 - i], 0xB1, 0xf, 0xf, false)
                                   : (unsigned)__builtin_amdgcn_mov_dpp((int)c[15 - i], 0x4E, 0xf, 0xf, false);
      d[i] = max(c[i], o);
    }
#pragma unroll
    for (int j = 8; j > 0; j >>= 1)
#pragma unroll
      for (int i = 0; i < 16; ++i) {
        const int l = i ^ j;
        if (l > i) { const unsigned lo = min(d[i], d[l]), hi = max(d[i], d[l]); d[i] = hi; d[l] = lo; }
      }
#pragma unroll
    for (int i = 0; i < 16; ++i) c[i] = d[i];
  }
  const float mx = key8f(c[0]);
  float e[16]; float sum = 0.f;
#pragma unroll
  for (int i = 0; i < 16; ++i) { e[i] = __expf(key8f(c[i]) - mx); sum += e[i]; }
  const float inv = 1.f / sum;
  asm volatile("s_waitcnt lgkmcnt(0)" ::: "memory");
  int eo[4]; float go[4];
#pragma unroll
  for (int k = 0; k < 4; ++k) {
    const unsigned code = sel4u(q, c[k], c[4 + k], c[8 + k], c[12 + k]) & 255u;
    go[k] = sel4(q, e[k], e[4 + k], e[8 + k], e[12 + k]) * inv;
    eo[k] = (127 - (int)ix[code >> 4]) * 128 + (127 - (int)ix[16 + (code & 15)]);
  }
  const size_t o = (size_t)(m0 + row) * 128 + hd * 16 + 4 * q;
  *(uint2*)((unsigned short*)experts + o) = make_uint2((unsigned)eo[0] | ((unsigned)eo[1] << 16), (unsigned)eo[2] | ((unsigned)eo[3] << 16));
  *(float4*)(gates + o) = make_float4(go[0], go[1], go[2], go[3]);
}

DI float key2f(unsigned k) { k &= ~127u; k ^= (k & 0x80000000u) ? 0x80000000u : 0xffffffffu; return __uint_as_float(k); }
DI void merge_one(const unsigned* __restrict__ topk, int r, int hd, int* experts, float* gates) {
  const unsigned* ka = topk + ((size_t)r * 16 + 2 * hd) * 16;
  const unsigned* kb = ka + 16;
  float a[16], bq[16];
#pragma unroll
  for (int i = 0; i < 4; ++i) {
    uint4 x = ((const uint4*)ka)[i], y = ((const uint4*)kb)[i];
    a[4 * i] = key2f(x.x); a[4 * i + 1] = key2f(x.y); a[4 * i + 2] = key2f(x.z); a[4 * i + 3] = key2f(x.w);
    bq[4 * i] = key2f(y.x); bq[4 * i + 1] = key2f(y.y); bq[4 * i + 2] = key2f(y.z); bq[4 * i + 3] = key2f(y.w);
  }
  float cv[50];
  {
    int n = 0;
#pragma unroll
    for (int i = 0; i < 16; ++i)
#pragma unroll
      for (int j = 0; j < 16; ++j)
        if ((i + 1) * (j + 1) <= 16) { cv[n] = a[i] + bq[j]; ++n; }
  }
  int* eo = experts + hd * 16;
  float* go = gates + hd * 16;
  float mx = 0.f, sum = 0.f;
#pragma unroll 1
  for (int k = 0; k < 16; ++k) {
    float mval = cv[0]; int code = 0;
    {
      int n = 0;
#pragma unroll
      for (int i = 0; i < 16; ++i)
#pragma unroll
        for (int j = 0; j < 16; ++j)
          if ((i + 1) * (j + 1) <= 16) {
            if (n > 0) { bool gt = cv[n] > mval; mval = gt ? cv[n] : mval; code = gt ? (i * 16 + j) : code; }
            ++n;
          }
    }
    {
      int n = 0;
#pragma unroll
      for (int i = 0; i < 16; ++i)
#pragma unroll
        for (int j = 0; j < 16; ++j)
          if ((i + 1) * (j + 1) <= 16) { cv[n] = (code == i * 16 + j) ? -3.0e38f : cv[n]; ++n; }
    }
    if (k == 0) mx = mval;
    const float e = __expf(mval - mx);
    sum += e;
    eo[k] = (int)(127u - (ka[code >> 4] & 127u)) * 128 + (int)(127u - (kb[code & 15] & 127u));
    go[k] = e;
  }
  const float inv = 1.f / sum;
#pragma unroll
  for (int i = 0; i < 4; ++i) {
    float4 g4 = ((float4*)go)[i];
    g4.x *= inv; g4.y *= inv; g4.z *= inv; g4.w *= inv;
    ((float4*)go)[i] = g4;
  }
}

template <int MODE>
DI void peer_token(int r, const bf16_t* __restrict__ hbuf, const int* ex_row, const float* g_row,
                   const unsigned char* __restrict__ u8, const float* __restrict__ us, const unsigned char* __restrict__ v8,
                   const float* __restrict__ vs, const float* __restrict__ modv_l, float* __restrict__ xs, float* wdots  ,
                   float* __restrict__ outp, int* __restrict__ ex_out, float* __restrict__ w_out) {
  const int lane = TID & 63;
  float x[16];
  {
    const uint2* hr = (const uint2*)(hbuf + (size_t)r * D + lane * 4);
#pragma unroll
    for (int c = 0; c < 4; ++c) { const uint2 a = hr[64 * c]; x[4 * c] = bflo(a.x); x[4 * c + 1] = bfhi(a.x); x[4 * c + 2] = bflo(a.y); x[4 * c + 3] = bfhi(a.y); }
  }
  const int e0 = ex_row[lane], e1 = ex_row[64 + lane];
  const float g0 = g_row[lane], g1 = g_row[64 + lane];
  const float us0 = us[e0], us1 = us[e1], vs0 = vs[e0], vs1 = vs[e1];
#define PEER_LOAD8(rw_, tab_, k0_)                                                          \
  {                                                                                         \
    _Pragma("unroll") for (int j = 0; j < 8; ++j) {                                         \
      int e = __builtin_amdgcn_readlane((k0_) < 64 ? e0 : e1, ((k0_) + j) & 63);            \
      rw_[j] = *(const uint4*)((tab_) + (size_t)e * D + lane * 16);                         \
    }                                                                                       \
  }
#define PEER_UDOT8(rw_, k0_)                                                                \
  {                                                                                         \
    float p[8];                                                                             \
    _Pragma("unroll") for (int j = 0; j < 8; ++j) {                                         \
      f32x2_t a0 = __builtin_amdgcn_cvt_pk_f32_fp8((int)rw_[j].x, false), a1 = __builtin_amdgcn_cvt_pk_f32_fp8((int)rw_[j].x, true); \
      f32x2_t b0 = __builtin_amdgcn_cvt_pk_f32_fp8((int)rw_[j].y, false), b1 = __builtin_amdgcn_cvt_pk_f32_fp8((int)rw_[j].y, true); \
      f32x2_t c0 = __builtin_amdgcn_cvt_pk_f32_fp8((int)rw_[j].z, false), c1 = __builtin_amdgcn_cvt_pk_f32_fp8((int)rw_[j].z, true); \
      f32x2_t d0 = __builtin_amdgcn_cvt_pk_f32_fp8((int)rw_[j].w, false), d1 = __builtin_amdgcn_cvt_pk_f32_fp8((int)rw_[j].w, true); \
      float s = a0[0] * x[0] + a0[1] * x[1] + a1[0] * x[2] + a1[1] * x[3];                  \
      s += b0[0] * x[4] + b0[1] * x[5] + b1[0] * x[6] + b1[1] * x[7];                       \
      s += c0[0] * x[8] + c0[1] * x[9] + c1[0] * x[10] + c1[1] * x[11];                     \
      s += d0[0] * x[12] + d0[1] * x[13] + d1[0] * x[14] + d1[1] * x[15];                   \
      p[j] = s;                                                                             \
    }                                                                                       \
    float q4[4];                                                                            \
    _Pragma("unroll") for (int i = 0; i < 4; ++i) { float send = hi32 ? p[i] : p[4 + i]; float keep = hi32 ? p[4 + i] : p[i]; q4[i] = keep + shxl(send, lane, 32); } \
    float q2[2];                                                                            \
    _Pragma("unroll") for (int i = 0; i < 2; ++i) { float send = hi16 ? q4[i] : q4[2 + i]; float keep = hi16 ? q4[2 + i] : q4[i]; q2[i] = keep + shxl(send, lane, 16); } \
    float q1;                                                                               \
    { float send = hi8 ? q2[0] : q2[1]; float keep = hi8 ? q2[1] : q2[0]; q1 = keep + shxl(send, lane, 8); } \
    q1 += shxl(q1, lane, 4); q1 += shxl(q1, lane, 2); q1 += shxl(q1, lane, 1);              \
    if ((lane & 7) == 0) wdots[(k0_) + (lane >> 3)] = q1;                                   \
  }
#define PEER_VACC8(rw_, k0_)                                                                \
  {                                                                                         \
    _Pragma("unroll") for (int j = 0; j < 8; ++j) {                                         \
      float w = __builtin_bit_cast(float, __builtin_amdgcn_readlane(__builtin_bit_cast(int, (k0_) < 64 ? w0 : w1), ((k0_) + j) & 63)); \
      f32x2_t a0 = __builtin_amdgcn_cvt_pk_f32_fp8((int)rw_[j].x, false), a1 = __builtin_amdgcn_cvt_pk_f32_fp8((int)rw_[j].x, true); \
      f32x2_t b0 = __builtin_amdgcn_cvt_pk_f32_fp8((int)rw_[j].y, false), b1 = __builtin_amdgcn_cvt_pk_f32_fp8((int)rw_[j].y, true); \
      f32x2_t c0 = __builtin_amdgcn_cvt_pk_f32_fp8((int)rw_[j].z, false), c1 = __builtin_amdgcn_cvt_pk_f32_fp8((int)rw_[j].z, true); \
      f32x2_t d0 = __builtin_amdgcn_cvt_pk_f32_fp8((int)rw_[j].w, false), d1 = __builtin_amdgcn_cvt_pk_f32_fp8((int)rw_[j].w, true); \
      acc[0] += w * a0[0]; acc[1] += w * a0[1]; acc[2] += w * a1[0]; acc[3] += w * a1[1];   \
      acc[4] += w * b0[0]; acc[5] += w * b0[1]; acc[6] += w * b1[0]; acc[7] += w * b1[1];   \
      acc[8] += w * c0[0]; acc[9] += w * c0[1]; acc[10] += w * c1[0]; acc[11] += w * c1[1]; \
      acc[12] += w * d0[0]; acc[13] += w * d0[1]; acc[14] += w * d1[0]; acc[15] += w * d1[1]; \
    }                                                                                       \
  }
  const bool hi32 = lane & 32, hi16 = lane & 16, hi8 = lane & 8;
  uint4 rwA[8], rwB[8];
  PEER_LOAD8(rwA, u8, 0);
#pragma unroll 1
  for (int k0 = 0; k0 < 128; k0 += 16) {
    PEER_LOAD8(rwB, u8, k0 + 8);
    PEER_UDOT8(rwA, k0);
    if (k0 + 16 < 128) { PEER_LOAD8(rwA, u8, k0 + 16); } else if (MODE == 0) { PEER_LOAD8(rwA, v8, 0); }
    PEER_UDOT8(rwB, k0 + 8);
  }
  float w0, w1;
  {
    float d0 = wdots[lane] * us0, d1 = wdots[64 + lane] * us1;
    float t0 = 0.5f * d0 * (1.f + tanhf(0.7978845608028654f * (d0 + 0.044715f * d0 * d0 * d0)));
    float t1 = 0.5f * d1 * (1.f + tanhf(0.7978845608028654f * (d1 + 0.044715f * d1 * d1 * d1)));
    w0 = g0 * t0 * vs0; w1 = g1 * t1 * vs1;
  }
  if (MODE == 1) {
    ex_out[(size_t)r * 128 + lane] = e0; ex_out[(size_t)r * 128 + 64 + lane] = e1;
    w_out[(size_t)r * 128 + lane] = w0; w_out[(size_t)r * 128 + 64 + lane] = w1;
    return;
  }
  float acc[16];
#pragma unroll
  for (int i = 0; i < 16; ++i) acc[i] = 0.f;
#pragma unroll 1
  for (int k0 = 0; k0 < 128; k0 += 16) {
    PEER_LOAD8(rwB, v8, k0 + 8);
    PEER_VACC8(rwA, k0);
    if (k0 + 16 < 128) PEER_LOAD8(rwA, v8, k0 + 16);
    PEER_VACC8(rwB, k0 + 8);
  }
  const int b = r / NT, p = r % NT; const int mrow = p < CTX ? 2 : b;
  const float* g2 = modv_l + mrow * NMOD + 5 * D + lane * 4;
  float4* xp = (float4*)(xs + (size_t)r * D + lane * 4);
  float4* op = outp ? (float4*)(outp + ((size_t)b * SEQ + (p - CTX)) * D + lane * 4) : xp;
#pragma unroll
  for (int i = 0; i < 4; ++i) {
    float4 xv = xp[64 * i]; float4 gg = ((const float4*)g2)[64 * i];
    xv.x += gg.x * acc[4 * i]; xv.y += gg.y * acc[4 * i + 1]; xv.z += gg.z * acc[4 * i + 2]; xv.w += gg.w * acc[4 * i + 3];
    op[64 * i] = xv;
  }
}

constexpr int FN = 2 * SEQ;
DI float2 cmul(float2 a, float2 b) { return make_float2(a.x * b.x - a.y * b.y, a.x * b.y + a.y * b.x); }
DI float2 cmulc(float2 a, float2 b) { return make_float2(a.x * b.x + a.y * b.y, a.y * b.x - a.x * b.y); }
DI int PX(int i) { return i + ((i >> 6) << 2); }
constexpr int FNP = FN + (FN >> 6) * 4;
DI int freq_of_pos(int pos) { return ((pos >> 10) & 15) | (((pos >> 6) & 15) << 4) | (((pos >> 2) & 15) << 8) | ((pos & 3) << 12); }
DI int pos_of_freq(int f) { return ((f & 15) << 10) | (((f >> 4) & 15) << 6) | (((f >> 8) & 15) << 2) | (f >> 12); }
DI float2 cadd(float2 a, float2 b) { return make_float2(a.x + b.x, a.y + b.y); }
DI float2 csub(float2 a, float2 b) { return make_float2(a.x - b.x, a.y - b.y); }
DI float2 cmni(float2 a) { return make_float2(a.y, -a.x); }
DI float2 cconj(float2 a) { return make_float2(a.x, -a.y); }
DI void dft16(float2 (&x)[16]) {
  constexpr float C1 = 0.9238795325112867f, S1 = 0.3826834323650898f, C2 = 0.7071067811865476f;
  float2 u[16];
#pragma unroll
  for (int r = 0; r < 4; ++r) {
    const float2 a = x[r], b = x[r + 4], c = x[r + 8], d = x[r + 12];
    const float2 t0 = cadd(a, c), t1 = csub(a, c), t2 = cadd(b, d), t3 = cmni(csub(b, d));
    const float2 y0 = cadd(t0, t2), y1 = cadd(t1, t3), y2 = csub(t0, t2), y3 = csub(t1, t3);
    u[4 * r] = y0;
    if (r == 0) { u[1] = y1; u[2] = y2; u[3] = y3; }
    else if (r == 1) { u[5] = cmul(y1, make_float2(C1, -S1)); u[6] = cmul(y2, make_float2(C2, -C2)); u[7] = cmul(y3, make_float2(S1, -C1)); }
    else if (r == 2) { u[9] = cmul(y1, make_float2(C2, -C2)); u[10] = cmni(y2); u[11] = cmul(y3, make_float2(-C2, -C2)); }
    else { u[13] = cmul(y1, make_float2(S1, -C1)); u[14] = cmul(y2, make_float2(-C2, -C2)); u[15] = cmul(y3, make_float2(-C1, S1)); }
  }
#pragma unroll
  for (int sdx = 0; sdx < 4; ++sdx) {
    const float2 a = u[sdx], b = u[4 + sdx], c = u[8 + sdx], d = u[12 + sdx];
    const float2 t0 = cadd(a, c), t1 = csub(a, c), t2 = cadd(b, d), t3 = cmni(csub(b, d));
    x[4 * sdx] = cadd(t0, t2); x[4 * sdx + 1] = cadd(t1, t3); x[4 * sdx + 2] = csub(t0, t2); x[4 * sdx + 3] = csub(t1, t3);
  }
}
template <int LQ, bool INV>
DI void fft_pass16(float2* X, int tid) {
  constexpr int q = 1 << LQ;
  constexpr float invL = 1.f / (float)(16 << LQ);
#pragma unroll 1
  for (int bf = 0; bf < 2; ++bf) {
    const int i = tid + 512 * bf;
    const int j = i & (q - 1); const int base = ((i >> LQ) << (LQ + 4)) + j;
    const float fr = (float)j * invL;
    const float2 w1 = make_float2(__builtin_amdgcn_cosf(fr), -__builtin_amdgcn_sinf(fr));
    float2 x[16];
    if (!INV) {
#pragma unroll
      for (int mm = 0; mm < 16; ++mm) x[mm] = X[PX(base + mm * q)];
      dft16(x);
      float2 w = w1;
      X[PX(base)] = x[0];
#pragma unroll
      for (int k = 1; k < 16; ++k) {
        const int p = 4 * (k & 3) + (k >> 2);
        X[PX(base + k * q)] = cmul(x[p], w);
        w = cmul(w, w1);
      }
    } else {
      float2 w = w1;
      x[0] = cconj(X[PX(base)]);
#pragma unroll
      for (int k = 1; k < 16; ++k) {
        x[k] = cmul(cconj(X[PX(base + k * q)]), w);
        w = cmul(w, w1);
      }
      dft16(x);
#pragma unroll
      for (int p = 0; p < 16; ++p) {
        const int mm = (p >> 2) + 4 * (p & 3);
        X[PX(base + mm * q)] = cconj(x[p]);
      }
    }
  }
}
template <bool INV>
DI void fft_pass4(float2* X, int tid) {
#pragma unroll 2
  for (int bf = 0; bf < 8; ++bf) {
    const int base = PX(4 * (tid + 512 * bf));
    float2 a = X[base], b = X[base + 1], c = X[base + 2], d = X[base + 3];
    if (INV) { a = cconj(a); b = cconj(b); c = cconj(c); d = cconj(d); }
    const float2 t0 = cadd(a, c), t1 = csub(a, c), t2 = cadd(b, d), t3 = cmni(csub(b, d));
    float2 y0 = cadd(t0, t2), y1 = cadd(t1, t3), y2 = csub(t0, t2), y3 = csub(t1, t3);
    if (INV) { y0 = cconj(y0); y1 = cconj(y1); y2 = cconj(y2); y3 = cconj(y3); }
    X[base] = y0; X[base + 1] = y1; X[base + 2] = y2; X[base + 3] = y3;
  }
}
DI void fft_fwd(float2* X) {
  const int tid = TID;
  __syncthreads(); fft_pass16<10, false>(X, tid);
  __syncthreads(); fft_pass16<6, false>(X, tid);
  __syncthreads(); fft_pass16<2, false>(X, tid);
  __syncthreads(); fft_pass4<false>(X, tid);
  __syncthreads();
}
DI void fft_inv(float2* X) {
  const int tid = TID;
  __syncthreads(); fft_pass4<true>(X, tid);
  __syncthreads(); fft_pass16<2, true>(X, tid);
  __syncthreads(); fft_pass16<6, true>(X, tid);
  __syncthreads(); fft_pass16<10, true>(X, tid);
  __syncthreads();
}
DI float block_sum_512(float v, float* red) {
  for (int o = 32; o > 0; o >>= 1) v += shx(v, o);
  __syncthreads();
  if ((TID & 63) == 0) red[TID >> 6] = v;
  __syncthreads();
  float s = 0.f;
  for (int i = 0; i < 8; ++i) s += red[i];
  return s;
}
DI unsigned pkc(float2 v) { return pk2bf(v.x, v.y); }
DI float2 upkc(unsigned w) { return make_float2(bflo(w), bfhi(w)); }
DI void hyena_filter_task(int c, const bf16_t* __restrict__ hdnB, const bf16_t* __restrict__ W3t, const float* __restrict__ b3, uint2* __restrict__ H01_all,
                          char* smem) {
  float2* X = (float2*)smem;
  float* red = (float*)(smem + FNP * 8);
  uint2* H01 = H01_all + (size_t)c * FN;
  const int tid = TID;
  __syncthreads();
  const float delta = fabsf(-3.0701134573253944f + (float)c * ((-15.350567286626972f + 3.0701134573253944f) / 255.f));
  const float bb00 = b3[c], bb01 = b3[256 + c], bb10 = b3[512 + c], bb11 = b3[768 + c];
  float n0 = 0.f, n1 = 0.f;
  {
    const int lane = tid & 63, wid = tid >> 6, r = lane & 31, h = lane >> 5;
    bf16x8 wa[4];
#pragma unroll
    for (int s4 = 0; s4 < 4; ++s4) {
      uint4 w = make_uint4(0u, 0u, 0u, 0u);
      if (r < 4) w = *(const uint4*)(W3t + ((size_t)((r >> 1) * 512 + (r & 1) * 256 + c)) * 64 + 16 * s4 + 8 * h);
      wa[s4] = __builtin_bit_cast(bf16x8, w);
    }
#pragma unroll 8
    for (int blk = wid; blk < SEQ / 32; blk += 8) {
      const int j = blk * 32 + r;
      const bf16_t* hp = hdnB + (size_t)j * 64 + 8 * h;
      f32x16 acc;
#pragma unroll
      for (int i = 0; i < 16; ++i) acc[i] = 0.f;
#pragma unroll
      for (int s4 = 0; s4 < 4; ++s4) acc = MFMA32(wa[s4], *(const bf16x8*)(hp + 16 * s4), acc);
      if (h == 0) {
        const float dec = __expf(-((float)j / (float)(SEQ - 1)) * delta);
        const float f00 = (acc[0] + bb00) * dec, f01 = (acc[1] + bb01) * dec, f10 = (acc[2] + bb10) * dec, f11 = (acc[3] + bb11) * dec;
        X[PX(j)] = make_float2(f00, f10);
        n0 += fabsf(f00); n1 += fabsf(f10);
        if (j > 0) { X[PX(FN - j)] = make_float2(f01, f11); n0 += fabsf(f01); n1 += fabsf(f11); }
        else X[PX(SEQ)] = make_float2(0.f, 0.f);
      }
    }
  }
  n0 = block_sum_512(n0, red);
  n1 = block_sum_512(n1, red);
  const float s0 = 0.5f / (n0 * (float)FN), s1 = 0.5f / (n1 * (float)FN);
  fft_fwd(X);
  for (int pos = tid; pos < FN; pos += 512) {
    const int f = freq_of_pos(pos); const int pm = pos_of_freq((FN - f) & (FN - 1));
    const float2 A = X[PX(pos)], Bm = X[PX(pm)];
    const float2 K0 = make_float2((A.x + Bm.x) * s0, (A.y - Bm.y) * s0);
    const float2 K1 = make_float2((A.y + Bm.y) * s1, -(A.x - Bm.x) * s1);
    H01[pos] = make_uint2(pkc(K0), pkc(K1));
  }
}
DI void hyena_channel(int c, const float* __restrict__ hy_bias, const float* __restrict__ uT, float* __restrict__ zT, float* __restrict__ yT,
                      const uint2* __restrict__ H01_all, char* smem) {
  float2* X = (float2*)smem;
  const uint2* H01 = H01_all + (size_t)c * FN;
  const int tid = TID;
  const float* v0p = uT + ((size_t)0 * 768 + c) * NT + CTX;
  const float* v1p = uT + ((size_t)1 * 768 + c) * NT + CTX;
  __syncthreads();
  for (int t = tid; t < SEQ; t += 512) { X[PX(t)] = make_float2(v0p[t], v1p[t]); X[PX(SEQ + t)] = make_float2(0.f, 0.f); }
  fft_fwd(X);
  for (int pos = tid; pos < FN; pos += 512) X[PX(pos)] = cmul(X[PX(pos)], upkc(H01[pos].x));
  fft_inv(X);
  {
    const float bias0 = hy_bias[c];
    const float* x10 = v0p + (size_t)256 * NT; const float* x11 = v1p + (size_t)256 * NT;
    float* z0 = zT + ((size_t)0 * 256 + c) * NT + CTX; float* z1 = zT + ((size_t)1 * 256 + c) * NT + CTX;
    for (int t = tid; t < SEQ; t += 512) {
      float2 y = X[PX(t)];
      float za = x10[t] * (y.x + bias0 * v0p[t]);
      float zb = x11[t] * (y.y + bias0 * v1p[t]);
      z0[t] = za; z1[t] = zb;
      X[PX(t)] = make_float2(za, zb);
    }
    __syncthreads();
    for (int t = tid; t < SEQ; t += 512) X[PX(SEQ + t)] = make_float2(0.f, 0.f);
  }
  fft_fwd(X);
  for (int pos = tid; pos < FN; pos += 512) X[PX(pos)] = cmul(X[PX(pos)], upkc(H01[pos].y));
  fft_inv(X);
  {
    const float bias1 = hy_bias[256 + c];
    const float* x20 = v0p + (size_t)512 * NT; const float* x21 = v1p + (size_t)512 * NT;
    const float* z0 = zT + ((size_t)0 * 256 + c) * NT + CTX; const float* z1 = zT + ((size_t)1 * 256 + c) * NT + CTX;
    float* y0 = yT + ((size_t)0 * 256 + c) * NT + CTX; float* y1 = yT + ((size_t)1 * 256 + c) * NT + CTX;
    for (int t = tid; t < SEQ; t += 512) {
      float2 y = X[PX(t)];
      y0[t] = x20[t] * (y.x + bias1 * z0[t]);
      y1[t] = x21[t] * (y.y + bias1 * z1[t]);
    }
  }
}

namespace pg8 {
#define PG8_LAS __attribute__((address_space(3)))
typedef ::bf16x8 bf16x8;
typedef float f32x4 __attribute__((ext_vector_type(4)));
typedef unsigned u32x4 __attribute__((ext_vector_type(4)));
constexpr int BM = 256, BK = 64, HALF = 128, HTB = HALF * BK * 2  , STAGE_BYTES = 8 * HTB, NXCD = 8, WGM = 8;

__host__ __device__ __forceinline__ int lds_byte(int r, int c) { const int st = (r >> 4) * 2 + (c >> 5), rr = r & 15, cc = c & 31, ob = rr * 64 + cc * 2; return st * 1024 + (ob ^ (((ob >> 9) & 1) << 5)); }
__host__ __device__ __forceinline__ void stage_rc(int b, int& R, int& C) { const int st = b / 1024, sb = b % 1024, swz = sb ^ (((sb >> 9) & 1) << 5); R = (st >> 1) * 16 + swz / 64; C = (st & 1) * 32 + (swz % 64) / 2; }
__host__ __device__ __forceinline__ int perm32(int rho) { const int n = rho >> 4, i = rho & 15; return 8 * (i >> 2) + 4 * n + (i & 3); }
struct Unit { int pm, pn; };
struct Gemm { const bf16_t* A; const bf16_t* Bt; int M, N, K; };
template <class Epi, class Sched, bool STAMP = false>
__device__ __forceinline__ void gemm_phase(PG8_LAS unsigned char* lds, const Gemm g, const Sched& S, const Epi& E, unsigned long long* stamps) {
    const int tid = TID, wid = __builtin_amdgcn_readfirstlane(tid >> 6), lane = tid & 63, wr = wid >> 2, wc = wid & 3, fr = lane & 15, fq = lane >> 4;
    const int K = g.K, nt = K / BK;
    int ts_lo = 0, ts_hi = 0, nts = 0; const unsigned long long rt_entry = STAMP ? (unsigned long long)wall_clock64() : 0ull;
#define PG8_STAMP() do { if (STAMP && wid == 0 && nts < 64) { const unsigned long long _c = (unsigned long long)clock64(); \
        ts_lo = (lane == nts) ? (int)(unsigned)_c : ts_lo; ts_hi = (lane == nts) ? (int)(unsigned)(_c >> 32) : ts_hi; ++nts; } } while (0)
    PG8_STAMP();
    unsigned voffA[2], voffB[2];
#pragma unroll
    for (int i = 0; i < 2; ++i) { int R, C; stage_rc(tid * 16 + i * 8192, R, C); const int Rb = Epi::PERM ? ((R & ~31) + perm32(R & 31)) : R;
        voffA[i] = (unsigned)(R * K + C) * 2u; voffB[i] = (unsigned)(Rb * K + C) * 2u; }
    const size_t kstep = (size_t)(BK * 2);
    const size_t hstep = (size_t)HALF * K * 2;
    const size_t tstep = 2 * hstep;
    const unsigned ldsw = (unsigned)wid * 1024u;
    const int aoff = lds_byte(wr * 64 + fr, fq * 8), boff = lds_byte(wc * 32 + fr, fq * 8);
#define PG8_SA(b, h) (((b) * 2 + (h)) * HTB)
#define PG8_SB(b, h) ((4 + (b) * 2 + (h)) * HTB)
#define PG8_STAGE(bufoff, gbase, voff) do { _Pragma("unroll") for (int _i = 0; _i < 2; ++_i) \
        __builtin_amdgcn_global_load_lds((const unsigned*)((const char*)(gbase) + (voff)[_i]), (PG8_LAS unsigned*)(lds + (bufoff) + ldsw + _i * 8192), 16, 0, 0); } while (0)
#define PG8_LDA(dst, b, h) do { _Pragma("unroll") for (int m = 0; m < 4; ++m) _Pragma("unroll") for (int k = 0; k < 2; ++k) dst[m][k] = *(const PG8_LAS bf16x8*)(lds + PG8_SA(b, h) + aoff + m * 2048 + k * 1024); } while (0)
#define PG8_LDB(dst, b, h) do { _Pragma("unroll") for (int n = 0; n < 2; ++n) _Pragma("unroll") for (int k = 0; k < 2; ++k) dst[n][k] = *(const PG8_LAS bf16x8*)(lds + PG8_SB(b, h) + boff + n * 2048 + k * 1024); } while (0)
#define PG8_MMA(ai, bj, At, Bt) do { __builtin_amdgcn_s_setprio(1); _Pragma("unroll") for (int m = 0; m < 4; ++m) _Pragma("unroll") for (int n = 0; n < 2; ++n) _Pragma("unroll") for (int k = 0; k < 2; ++k) \
        acc[ai][bj][m][n] = __builtin_amdgcn_mfma_f32_16x16x32_bf16(Bt[n][k], At[m][k], acc[ai][bj][m][n], 0, 0, 0); __builtin_amdgcn_s_setprio(0); } while (0)
#define PG8_WAIT_V(n) asm volatile("s_waitcnt vmcnt(" #n ")" ::: "memory")
#define PG8_WAIT_L(n) asm volatile("s_waitcnt lgkmcnt(" #n ")" ::: "memory")
#define PG8_BAR __builtin_amdgcn_s_barrier()
#define PG8_SCHED __builtin_amdgcn_sched_barrier(0)
    Unit cur, nxt; int ui = 0;
    if (!S.next(0, cur)) return;
    f32x4 acc[2][2][4][2];
#pragma unroll
    for (int a = 0; a < 2; ++a)
#pragma unroll
        for (int b = 0; b < 2; ++b)
#pragma unroll
            for (int m = 0; m < 4; ++m)
#pragma unroll
                for (int n = 0; n < 2; ++n) acc[a][b][m][n] = (f32x4){0.f, 0.f, 0.f, 0.f};
    bf16x8 At[4][2], B0[2][2], B1[2][2];
    const char* cA = (const char*)g.A + (size_t)cur.pm * tstep; const char* cB = (const char*)g.Bt + (size_t)cur.pn * tstep;
    S.a_ready(cur);
    PG8_STAGE(PG8_SB(0, 0), cB, voffB); PG8_STAGE(PG8_SA(0, 0), cA, voffA); PG8_STAGE(PG8_SB(0, 1), cB + hstep, voffB); PG8_STAGE(PG8_SA(0, 1), cA + hstep, voffA);
    if (wr == 1) PG8_BAR;
    PG8_WAIT_V(4); PG8_BAR;
    PG8_STAGE(PG8_SB(1, 0), cB + kstep, voffB); PG8_STAGE(PG8_SA(1, 0), cA + kstep, voffA); PG8_STAGE(PG8_SB(1, 1), cB + hstep + kstep, voffB);
    PG8_WAIT_V(6); PG8_BAR;
    PG8_STAMP();
    for (;;) {
        const bool has_next = S.next(ui + 1, nxt);
        const char* nA = has_next ? (const char*)g.A + (size_t)nxt.pm * tstep : cA; const char* nB = has_next ? (const char*)g.Bt + (size_t)nxt.pn * tstep : cB;
        for (int t = 0; t < nt; t += 2) {
            const bool last = (t == nt - 2);
            const char* a1 = cA + (size_t)(t + 1) * kstep;
            const char* a2 = last ? nA : cA + (size_t)(t + 2) * kstep; const char* b2 = last ? nB : cB + (size_t)(t + 2) * kstep;
            const char* a3 = a2 + kstep; const char* b3 = b2 + kstep;
            if (last && has_next) S.a_ready(nxt);
            PG8_LDB(B0, 0, 0); PG8_SCHED; PG8_LDA(At, 0, 0); PG8_STAGE(PG8_SA(1, 1), a1 + hstep, voffA);
            PG8_WAIT_L(8); PG8_BAR; PG8_WAIT_L(0); PG8_MMA(0, 0, At, B0); PG8_BAR; PG8_SCHED;
            PG8_LDB(B1, 0, 1); PG8_STAGE(PG8_SB(0, 0), b2, voffB);
            PG8_BAR; PG8_WAIT_L(0); PG8_MMA(0, 1, At, B1); PG8_BAR;
            PG8_LDA(At, 0, 1); PG8_STAGE(PG8_SA(0, 0), a2, voffA);
            PG8_BAR; PG8_WAIT_L(0); PG8_MMA(1, 0, At, B0); PG8_BAR; PG8_SCHED;
            PG8_STAGE(PG8_SB(0, 1), b2 + hstep, voffB);
            PG8_WAIT_V(6); PG8_BAR; PG8_MMA(1, 1, At, B1); PG8_BAR;
            PG8_LDB(B0, 1, 0); PG8_SCHED; PG8_LDA(At, 1, 0); PG8_STAGE(PG8_SA(0, 1), a2 + hstep, voffA);
            PG8_WAIT_L(8); PG8_BAR; PG8_WAIT_L(0); PG8_MMA(0, 0, At, B0); PG8_BAR; PG8_SCHED;
            PG8_LDB(B1, 1, 1); PG8_STAGE(PG8_SB(1, 0), b3, voffB);
            PG8_BAR; PG8_WAIT_L(0); PG8_MMA(0, 1, At, B1); PG8_BAR;
            PG8_LDA(At, 1, 1); PG8_STAGE(PG8_SA(1, 0), a3, voffA);
            PG8_BAR; PG8_WAIT_L(0); PG8_MMA(1, 0, At, B0); PG8_BAR; PG8_SCHED;
            PG8_STAGE(PG8_SB(1, 1), b3 + hstep, voffB);
            PG8_WAIT_V(6); PG8_BAR; PG8_MMA(1, 1, At, B1); PG8_BAR;
        }
        PG8_STAMP();
        if constexpr (!Epi::AFTER_DRAIN) { E(acc, cur, wr, wc, fr, fq); S.done(cur); }
        PG8_STAMP();
        if (!has_next) break;
#pragma unroll
        for (int a = 0; a < 2; ++a)
#pragma unroll
            for (int b = 0; b < 2; ++b)
#pragma unroll
                for (int m = 0; m < 4; ++m)
#pragma unroll
                    for (int n = 0; n < 2; ++n) acc[a][b][m][n] = (f32x4){0.f, 0.f, 0.f, 0.f};
        cur = nxt; cA = nA; cB = nB; ++ui;
    }
    PG8_WAIT_V(0);
    if (wr == 0) PG8_BAR;
    PG8_BAR;
    if constexpr (Epi::AFTER_DRAIN) { E.fused(acc, cur, wr, wc, fr, fq, lds, wid, lane); S.done(cur); }
    PG8_STAMP();
    if (STAMP && wid == 0) { stamps[lane] = lane < nts ? (((unsigned long long)(unsigned)ts_hi << 32) | (unsigned)ts_lo) : 0ull;
        if (lane == 62) stamps[62] = rt_entry; if (lane == 63) stamps[63] = (unsigned long long)wall_clock64(); }
#undef PG8_STAMP
#undef PG8_SA
#undef PG8_SB
#undef PG8_STAGE
#undef PG8_LDA
#undef PG8_LDB
#undef PG8_MMA
#undef PG8_WAIT_V
#undef PG8_WAIT_L
#undef PG8_BAR
#undef PG8_SCHED
}
}

#ifndef GEMM_WGM
#define GEMM_WGM 4
#endif
struct MySched {
  int nN, nunits, G, c; bool latent_only;
  DI void init(int N, bool lat_only, int G_, int c_) { nN = N / 256; latent_only = lat_only; nunits = (lat_only ? 64 : 66) * nN; G = G_; c = c_; }
  DI bool next(int i, pg8::Unit& u) const {
    const int L = i * G + c; if (L >= nunits) return false;
    const int nM = latent_only ? 64 : 66;
    int wgid = L;
    { const int q = nunits / 8, r = nunits % 8, xcd = wgid % 8, off = wgid / 8; wgid = (xcd < r ? xcd * (q + 1) : r * (q + 1) + (xcd - r) * q) + off; }
    const int nig = GEMM_WGM * nN, gid = wgid / nig, fm = gid * GEMM_WGM, gsz = (nM - fm) < GEMM_WGM ? (nM - fm) : GEMM_WGM;
    const int ri = fm + ((wgid % nig) % gsz);
    u.pn = (wgid % nig) / gsz;
    u.pm = latent_only ? (ri / 32) * 33 + 1 + (ri % 32) : ri;
    return true;
  }
  DI void a_ready(const pg8::Unit&) const {}
  DI void done(const pg8::Unit&) const {}
};
struct EpiStoreBf16 {
  static constexpr bool PERM = true, AFTER_DRAIN = false;
  bf16_t* Cb; int ldc;
  DI void operator()(const pg8::f32x4 (&acc)[2][2][4][2], const pg8::Unit& u, int wr, int wc, int fr, int fq) const {
    const int row0 = u.pm * 256 + wr * 64 + fr, col0 = u.pn * 256 + wc * 32 + 8 * fq;
#pragma unroll
    for (int ai = 0; ai < 2; ++ai)
#pragma unroll
      for (int m = 0; m < 4; ++m) {
        bf16_t* rowp = Cb + (size_t)(row0 + ai * 128 + m * 16) * ldc + col0;
#pragma unroll
        for (int bj = 0; bj < 2; ++bj) {
          const pg8::f32x4 v0 = acc[ai][bj][m][0], v1 = acc[ai][bj][m][1];
          *(uint4*)(rowp + bj * 128) = make_uint4(pk2bf(v0[0], v0[1]), pk2bf(v0[2], v0[3]), pk2bf(v1[0], v1[1]), pk2bf(v1[2], v1[3]));
        }
      }
  }
};
struct EpiResidual {
  static constexpr bool PERM = true, AFTER_DRAIN = false;
  float* xs; const float* gate_base; const float* xin; const float* ctxin;
  DI void operator()(const pg8::f32x4 (&acc)[2][2][4][2], const pg8::Unit& u, int wr, int wc, int fr, int fq) const {
    const int row0 = u.pm * 256 + wr * 64 + fr, col0 = u.pn * 256 + wc * 32 + 8 * fq;
    const int b = u.pm / 33; const int mrow = (u.pm % 33) == 0 ? 2 : b;
    const int pt = (u.pm % 33) * 256 + wr * 64 + fr;
    const float* gt = gate_base + mrow * NMOD + col0;
#pragma unroll
    for (int ai = 0; ai < 2; ++ai)
#pragma unroll
      for (int m = 0; m < 4; ++m) {
        float* rowp = xs + (size_t)(row0 + ai * 128 + m * 16) * D + col0;
        const int pp = pt + ai * 128 + m * 16;
        const float* srcp = xin ? (pp < CTX ? ctxin + ((size_t)b * CTX + pp) * D + col0 : xin + ((size_t)b * SEQ + (pp - CTX)) * D + col0) : rowp;
#pragma unroll
        for (int bj = 0; bj < 2; ++bj)
#pragma unroll
          for (int n = 0; n < 2; ++n) {
            const pg8::f32x4 v = acc[ai][bj][m][n];
            const float4 g4 = *(const float4*)(gt + bj * 128 + n * 4);
            float4 xv = *(const float4*)(srcp + bj * 128 + n * 4);
            xv.x += g4.x * v[0]; xv.y += g4.y * v[1]; xv.z += g4.z * v[2]; xv.w += g4.w * v[3];
            *(float4*)(rowp + bj * 128 + n * 4) = xv;
          }
      }
  }
};

#define XB_TMO      128
#define XB_XCNT(j)  (256  + 64 * (j))
#define XB_XSUB(j)  (1280 + 64 * (j))
#define XB_XGEN(j)  (2304 + 64 * (j))
#define XB_TOP      3328
#define XB_TOPGEN   3392
#define XB_SPIN_CAP (1u << 22)
DI unsigned xb_ld(unsigned* p) { return __hip_atomic_load(p, __ATOMIC_RELAXED, __HIP_MEMORY_SCOPE_AGENT); }
DI unsigned xb_add(unsigned* p, unsigned v) { return __hip_atomic_fetch_add(p, v, __ATOMIC_RELAXED, __HIP_MEMORY_SCOPE_AGENT); }
DI unsigned xb_xcc_id() { return (unsigned)__builtin_amdgcn_s_getreg((3 << 11) | 20) & 0xFu; }
#define XB_SPIN(cond, bar) do { unsigned _sp = 0; while (cond) { __builtin_amdgcn_s_sleep(1); \
    if ((++_sp & 255u) == 0u) { if (xb_ld(&(bar)[XB_TMO])) break; if (_sp > XB_SPIN_CAP) { atomicAdd(&(bar)[XB_TMO], 1u); break; } } } } while (0)
DI void xcd_barrier_post(unsigned* bar, volatile LAS unsigned* st) {
  if (threadIdx.x == 0) { const unsigned x = xb_xcc_id(); st[3] = x; st[2] = xb_add(&bar[XB_XCNT(x)], 1u); }
}
DI void xcd_barrier_complete(unsigned* bar, unsigned x, unsigned& nloc, unsigned& nx) {
  const unsigned G = gridDim.x;
  unsigned sum, cnt, mine, sp = 0u;
  for (;;) {
    sum = 0u; cnt = 0u; mine = 0u;
#pragma unroll
    for (unsigned j = 0; j < 16; ++j) { const unsigned c = xb_ld(&bar[XB_XCNT(j)]); sum += c; cnt += (c > 0u) ? 1u : 0u; mine = (j == x) ? c : mine; }
    if (sum == G) break;
    __builtin_amdgcn_s_sleep(1);
    if ((++sp & 255u) == 0u) { if (xb_ld(&bar[XB_TMO])) break; if (sp > XB_SPIN_CAP) { atomicAdd(&bar[XB_TMO], 1u); break; } }
  }
  nloc = mine > 0u ? mine : 1u; nx = cnt > 0u ? cnt : 1u;
}
DI void xcd_barrier(unsigned* bar, volatile LAS unsigned* st) {
  asm volatile("s_waitcnt vmcnt(0)" ::: "memory");
  __syncthreads();
  if (threadIdx.x == 0) {
    const unsigned x = xb_xcc_id();
    __builtin_amdgcn_s_waitcnt(0);
    unsigned nloc = st[0], nx = st[1];
    if (nloc == 0u) { xcd_barrier_complete(bar, x, nloc, nx); st[0] = nloc; st[1] = nx; }
    const unsigned old = xb_add(&bar[XB_XSUB(x)], 1u);
    const unsigned gen = old / nloc;
    if (old + 1u == (gen + 1u) * nloc) {
      __builtin_amdgcn_fence(__ATOMIC_RELEASE, "agent");
      asm volatile("s_waitcnt vmcnt(0)" ::: "memory");
      const unsigned og = xb_add(&bar[XB_TOP], 1u);
      const unsigned tg = og / nx;
      if (og + 1u == (tg + 1u) * nx) xb_add(&bar[XB_TOPGEN], 1u);
      else XB_SPIN(xb_ld(&bar[XB_TOPGEN]) == tg, bar);
      __builtin_amdgcn_fence(__ATOMIC_ACQUIRE, "agent");
      xb_add(&bar[XB_XGEN(x)], 1u);
      asm volatile("s_waitcnt vmcnt(0)" ::: "memory");
    } else {
      XB_SPIN(xb_ld(&bar[XB_XGEN(x)]) == gen, bar);
      __builtin_amdgcn_fence(__ATOMIC_ACQUIRE, "agent");
      asm volatile("s_waitcnt vmcnt(0)" ::: "memory");
    }
  }
  __syncthreads();
}

#define XCD_BAR_WORDS 3456
constexpr size_t al256(size_t x) { return (x + 255) & ~(size_t)255; }
constexpr size_t OFF_modv = 0;
constexpr size_t OFF_xs = al256(OFF_modv + (size_t)2 * 3 * NMOD * 4);
constexpr size_t OFF_hbuf = al256(OFF_xs + (size_t)R * D * 4);
constexpr size_t OFF_P = al256(OFF_hbuf + (size_t)R * D * 2);
constexpr size_t OFF_Wt_in = al256(OFF_P + (size_t)R * DIN * 2);
constexpr size_t OFF_Wt_out = al256(OFF_Wt_in + (size_t)2 * DIN * D * 2);
constexpr size_t OFF_Wt_q = al256(OFF_Wt_out + (size_t)2 * D * D * 2);
constexpr size_t OFF_QA = al256(OFF_Wt_q + (size_t)2 * 2048 * D * 2);
constexpr size_t OFF_KA = al256(OFF_QA + (size_t)NB * 8 * NT * 32 * 2);
constexpr size_t OFF_VAt = al256(OFF_KA + (size_t)NB * 8 * NT * 32 * 2);
constexpr size_t OFF_QW = al256(OFF_VAt + (size_t)NB * 4 * 64 * NT * 2);
constexpr size_t OFF_KW = al256(OFF_QW + (size_t)NB * 4 * NT * 64 * 2);
constexpr size_t OFF_VWt = al256(OFF_KW + (size_t)NB * 2 * NT * 64 * 2);
constexpr size_t OFF_QG = al256(OFF_VWt + (size_t)NB * 2 * 64 * NT * 2);
constexpr size_t OFF_KG = al256(OFF_QG + (size_t)NB * 4 * NT * 64 * 2);
constexpr size_t OFF_VGt = al256(OFF_KG + (size_t)NB * 2 * NT * 64 * 2);
constexpr size_t OFF_uT = al256(OFF_VGt + (size_t)NB * 2 * 64 * NT * 2);
constexpr size_t OFF_zT = al256(OFF_uT + (size_t)NB * 768 * NT * 4);
constexpr size_t OFF_yT = al256(OFF_zT + (size_t)NB * 256 * NT * 4);
constexpr size_t OFF_hdn2 = al256(OFF_yT + (size_t)NB * 256 * NT * 4);
constexpr size_t OFF_Hc = al256(OFF_hdn2 + (size_t)2 * NT * 64 * 4);
constexpr size_t OFF_A2 = al256(OFF_Hc + (size_t)256 * 2 * SEQ * 8);
constexpr size_t OFF_u8 = al256(OFF_A2 + (size_t)R * D * 2);
constexpr size_t OFF_v8 = al256(OFF_u8 + (size_t)2 * 16384 * D);
constexpr size_t OFF_us = al256(OFF_v8 + (size_t)2 * 16384 * D);
constexpr size_t OFF_vs = al256(OFF_us + (size_t)2 * 16384 * 4);
constexpr size_t OFF_keysb = al256(OFF_vs + (size_t)2 * 16384 * 4);
constexpr size_t OFF_bar = al256(OFF_keysb + (size_t)2 * 16 * 128 * 128 * 2);
constexpr size_t OFF_hdnB = al256(OFF_bar + (size_t)XCD_BAR_WORDS * 4);
constexpr size_t OFF_W3t = al256(OFF_hdnB + (size_t)2 * SEQ * 64 * 2);
constexpr size_t WS_TOTAL = al256(OFF_W3t + (size_t)2 * 1024 * 64 * 2);
constexpr size_t OFF_topv = OFF_uT;
constexpr size_t OFF_topi = OFF_topv + (size_t)R * 256 * 4;
constexpr size_t OFF_experts = OFF_topi + (size_t)R * 256;
constexpr size_t OFF_gates = OFF_experts + (size_t)R * 128 * 4;
constexpr size_t OFF_xq = OFF_A2;
constexpr size_t OFF_xqs = OFF_xq + (size_t)R * D;
constexpr size_t OFF_wsc = OFF_xqs + (size_t)R * 4;
static_assert(OFF_wsc + (size_t)R * 4 <= OFF_u8, "xq overflows A2");
constexpr size_t OFF_Oslab = OFF_P;
constexpr size_t OFF_Lslab = OFF_Oslab + (size_t)2 * NB * 4 * NT * 64 * 4;
static_assert(OFF_gates + (size_t)R * 128 * 4 <= OFF_zT, "routing buffers overflow uT");
static_assert(OFF_Lslab + (size_t)2 * NB * 4 * NT * 4 <= OFF_Wt_in, "slabs overflow P");

struct MKView;
struct MK {
  const float *x, *c, *ctx, *c_ctx, *w_mod, *b_mod, *g_norm_mix, *w_in, *g_qk_diff, *lambda_diff, *g_qk_win, *sink_win, *g_qk_glob, *hy_conv_w,
      *hy_conv_b, *hy_w1, *hy_b1, *hy_w2, *hy_b2, *hy_w3, *hy_b3, *hy_freq, *hy_bias, *g_mix_out, *w_out, *g_norm_ffn, *peer_wq, *peer_keys,
      *peer_u, *peer_v;
  float* out;
  char* ws;
};
constexpr int SMEM_BYTES = (FN + (FN >> 6) * 4) * 8 + 2048;
typedef const MK __attribute__((address_space(4))) * MKP;
DI MK launder_mk(MKP a) {
  asm volatile("" : "+s"(a));
  MK r;
  r.x = a->x; r.c = a->c; r.ctx = a->ctx; r.c_ctx = a->c_ctx; r.w_mod = a->w_mod; r.b_mod = a->b_mod;
  r.g_norm_mix = a->g_norm_mix; r.w_in = a->w_in; r.g_qk_diff = a->g_qk_diff; r.lambda_diff = a->lambda_diff;
  r.g_qk_win = a->g_qk_win; r.sink_win = a->sink_win; r.g_qk_glob = a->g_qk_glob; r.hy_conv_w = a->hy_conv_w;
  r.hy_conv_b = a->hy_conv_b; r.hy_w1 = a->hy_w1; r.hy_b1 = a->hy_b1; r.hy_w2 = a->hy_w2; r.hy_b2 = a->hy_b2;
  r.hy_w3 = a->hy_w3; r.hy_b3 = a->hy_b3; r.hy_freq = a->hy_freq; r.hy_bias = a->hy_bias; r.g_mix_out = a->g_mix_out;
  r.w_out = a->w_out; r.g_norm_ffn = a->g_norm_ffn; r.peer_wq = a->peer_wq; r.peer_keys = a->peer_keys;
  r.peer_u = a->peer_u; r.peer_v = a->peer_v; r.out = a->out; r.ws = a->ws;
  return r;
}

DI void ph_mod_item(const MK& m, int item, char* smem) {
  float* sc = (float*)smem;
  float* part = sc + 3 * D;
  const int tid = TID, lane = tid & 63, wv = tid >> 6;
  const int l = item / 96, chunk = item % 96;
  __syncthreads();
  for (int i = tid; i < 3 * D; i += NTHR) {
    int row = i / D, k = i % D;
    float v = row < 2 ? m.c[row * D + k] : m.c_ctx[k];
    sc[i] = v / (1.f + __expf(-v));
  }
  __syncthreads();
  const int col = chunk * 64 + lane;
  const float* w = m.w_mod + (size_t)l * D * NMOD + (size_t)(wv * 128) * NMOD + col;
  float a0 = 0, a1 = 0, a2 = 0;
#pragma unroll 8
  for (int k = 0; k < 128; ++k) {
    float wvv = w[(size_t)k * NMOD];
    a0 += sc[wv * 128 + k] * wvv; a1 += sc[D + wv * 128 + k] * wvv; a2 += sc[2 * D + wv * 128 + k] * wvv;
  }
  part[(wv * 3 + 0) * 64 + lane] = a0; part[(wv * 3 + 1) * 64 + lane] = a1; part[(wv * 3 + 2) * 64 + lane] = a2;
  __syncthreads();
  if (tid < 192) {
    const int row = tid >> 6;
    float sacc = 0.f;
    for (int q = 0; q < 8; ++q) sacc += part[(q * 3 + row) * 64 + lane];
    ((float*)(m.ws + OFF_modv))[(l * 3 + row) * NMOD + col] = sacc + m.b_mod[l * NMOD + col];
  }
}
DI void ph_hymlp_group(const MK& m, int g, char* smem) {
  const int tid = TID, wv = tid >> 6, u = tid & 63;
  float* feat = (float*)smem + wv * 128;
  float* h1 = feat + 64;
  const int gi = g * 8 + wv;
  const int l = gi / NT, pos = gi % NT;
  const int which = pos >= SEQ ? 1 : 0;
  const int j = which ? pos - SEQ : pos;
  const int n = which ? CTX : SEQ;
  const float tt = (float)j / (float)(n - 1);
  const float w = (6.283185307179586f / (float)n) * (float)j;
  __syncthreads();
  if (u == 0) feat[0] = tt;
  if (u < 16) {
    float f = 1e-4f + (float)u * ((15.f - 1e-4f) / 15.f);
    feat[1 + u] = cosf(f * w);
    feat[17 + u] = -sinf(f * w);
  }
  __syncthreads();
  const float* w1 = m.hy_w1 + l * 33 * 64; const float* w2 = m.hy_w2 + l * 64 * 64;
  const float fq = m.hy_freq[l * 64 + u];
  float a = m.hy_b1[l * 64 + u];
  for (int i = 0; i < 33; ++i) a += feat[i] * w1[i * 64 + u];
  h1[u] = sinf(fq * a);
  __syncthreads();
  float a2 = m.hy_b2[l * 64 + u];
  for (int i = 0; i < 64; ++i) a2 += h1[i] * w2[i * 64 + u];
  const float hv2 = sinf(fq * a2);
  ((float*)(m.ws + OFF_hdn2))[((size_t)l * 64 + u) * NT + pos] = hv2;
  if (!which) ((bf16_t*)(m.ws + OFF_hdnB))[((size_t)l * SEQ + pos) * 64 + u] = f2bf(hv2);
}
DI void phase0(MKP m_in, char* smem) {
  const MK m = launder_mk(m_in);
  const int bid = BID, nb = NBLK, tid = TID;
  {
    const int lane = tid & 63;
    const int gw = bid * 8 + (tid >> 6), nw = nb * 8;
    for (int row0 = gw; row0 < 4 * 16384; row0 += 8 * nw) {
      float4 v[8][4];
#pragma unroll
      for (int q = 0; q < 8; ++q) {
        const int row = row0 + q * nw;
        if (row < 4 * 16384) {
          const int tbl = row >> 14, rr = row & 16383; const int l = tbl >> 1;
          const float4* sp = (const float4*)(((tbl & 1) ? m.peer_v : m.peer_u) + (size_t)l * 16384 * D + (size_t)rr * D);
          v[q][0] = sp[lane]; v[q][1] = sp[64 + lane]; v[q][2] = sp[128 + lane]; v[q][3] = sp[192 + lane];
        }
      }
#pragma unroll
      for (int q = 0; q < 8; ++q) {
        const int row = row0 + q * nw;
        if (row < 4 * 16384) {
          const int tbl = row >> 14, rr = row & 16383; const int l = tbl >> 1;
          if (tbl & 1) tabconv_fin(v[q][0], v[q][1], v[q][2], v[q][3], ((unsigned char*)(m.ws + OFF_v8)) + (size_t)l * 16384 * D, ((float*)(m.ws + OFF_vs)) + l * 16384, (size_t)rr, lane);
          else tabconv_fin_i8(v[q][0], v[q][1], v[q][2], v[q][3], ((unsigned char*)(m.ws + OFF_u8)) + (size_t)l * 16384 * D, ((float*)(m.ws + OFF_us)) + l * 16384, (size_t)rr, lane);
        }
      }
    }
  }
  for (int it = bid; it < 192; it += nb) ph_mod_item(m, it, smem);
  for (int g = bid; g < 2 * NT / 8; g += nb) ph_hymlp_group(m, g, smem);
  for (int t = bid; t < 2 * 1408; t += nb) {
    int l = t / 1408, tt = t % 1408;
    if (tt < 640) wconv_tile(m.w_in + (size_t)l * D * DIN, ((bf16_t*)(m.ws + OFF_Wt_in)) + (size_t)l * DIN * D, DIN, tt, (float*)smem);
    else if (tt < 896) wconv_tile(m.w_out + (size_t)l * D * D, ((bf16_t*)(m.ws + OFF_Wt_out)) + (size_t)l * D * D, D, tt - 640, (float*)smem);
    else wconv_tile(m.peer_wq + (size_t)l * D * 2048, ((bf16_t*)(m.ws + OFF_Wt_q)) + (size_t)l * 2048 * D, 2048, tt - 896, (float*)smem);
  }
  for (int i = bid * NTHR + tid; i < 2 * 16 * 128 * 128 / 4; i += nb * NTHR) {
    float4 v = ((const float4*)m.peer_keys)[i];
    ((uint2*)((bf16_t*)(m.ws + OFF_keysb)))[i] = make_uint2(pk2bf(v.x, v.y), pk2bf(v.z, v.w));
  }
  for (int i = bid * NTHR + tid; i < 2 * 1024 * 64; i += nb * NTHR) {
    const int l = i >> 16, n = (i >> 6) & 1023, k = i & 63;
    ((bf16_t*)(m.ws + OFF_W3t))[i] = f2bf(m.hy_w3[((size_t)l * 64 + k) * 1024 + n]);
  }
}

DI void phase_norm(MKP m_in, int l, int which  , bool first, bool skip_ctx) {
  const MK m = launder_mk(m_in);
  const int tid = TID, lane = tid & 63;
  const int gw = BID * 8 + (tid >> 6), nw = NBLK * 8;
  const float* g = (which ? m.g_norm_ffn : m.g_norm_mix) + l * D;
  const float* modv_l = ((float*)(m.ws + OFF_modv)) + (size_t)l * 3 * NMOD;
  for (int r = gw; r < R; r += nw) {
    const int b = r / NT, p = r % NT;
    if (skip_ctx && p < CTX) continue;
    const int mrow = p < CTX ? 2 : b;
    const float4* src = (const float4*)(first ? (p < CTX ? m.ctx + ((size_t)b * CTX + p) * D : m.x + ((size_t)b * SEQ + (p - CTX)) * D)
                                              : ((float*)(m.ws + OFF_xs)) + (size_t)r * D);
    float4 v[4];
    float ss = 0.f;
#pragma unroll
    for (int i = 0; i < 4; ++i) { v[i] = src[lane + 64 * i]; ss += v[i].x * v[i].x + v[i].y * v[i].y + v[i].z * v[i].z + v[i].w * v[i].w; }
    for (int o = 32; o > 0; o >>= 1) ss += shxl(ss, lane, o);
    const float rs = rsqrtf(ss * (1.f / D) + EPS);
    const float* sh = modv_l + mrow * NMOD + (which ? 3 : 0) * D;
    const float* sc = sh + D;
#pragma unroll
    for (int i = 0; i < 4; ++i) {
      const int c0 = (lane + 64 * i) * 4;
      float4 gg = *(const float4*)(g + c0), s4 = *(const float4*)(sc + c0), h4 = *(const float4*)(sh + c0);
      float o0 = v[i].x * rs * gg.x * (1.f + s4.x) + h4.x, o1 = v[i].y * rs * gg.y * (1.f + s4.y) + h4.y;
      float o2 = v[i].z * rs * gg.z * (1.f + s4.z) + h4.z, o3 = v[i].w * rs * gg.w * (1.f + s4.w) + h4.w;
      *(uint2*)(((bf16_t*)(m.ws + OFF_hbuf)) + (size_t)r * D + c0) = make_uint2(pk2bf(o0, o1), pk2bf(o2, o3));
      v[i] = make_float4(o0, o1, o2, o3);
    }
    if (which) {
      float mx = 0.f;
#pragma unroll
      for (int i = 0; i < 4; ++i) mx = fmaxf(mx, fmaxf(fmaxf(fabsf(v[i].x), fabsf(v[i].y)), fmaxf(fabsf(v[i].z), fabsf(v[i].w))));
      for (int o = 32; o > 0; o >>= 1) mx = fmaxf(mx, shxl(mx, lane, o));
      mx = fmaxf(mx, 1e-30f);
      const float inv = 127.f / mx;
      *(uint4*)(((unsigned char*)(m.ws + OFF_xq)) + (size_t)r * D + lane * 16) =
          make_uint4(pack_i8x4(v[0].x * inv, v[0].y * inv, v[0].z * inv, v[0].w * inv), pack_i8x4(v[1].x * inv, v[1].y * inv, v[1].z * inv, v[1].w * inv),
                     pack_i8x4(v[2].x * inv, v[2].y * inv, v[2].z * inv, v[2].w * inv), pack_i8x4(v[3].x * inv, v[3].y * inv, v[3].z * inv, v[3].w * inv));
      if (lane == 0) ((float*)(m.ws + OFF_xqs))[r] = mx * (1.f / 127.f);
    }
  }
}

DI int rowtile_of(int i, bool latent_only) { return latent_only ? (i / 64) * 66 + 2 + (i % 64) : i; }
template <int EPI>
DI void phase_gemm(const bf16_t* A, const bf16_t* Wt, int N, bf16_t* Cb, float* xs, const float* gate_base, bool latent_only, char* smem) {
  const int nt_n = N / 128, nrt = latent_only ? 128 : 132, ntiles = nrt * nt_n;
  for (int t = BID; t < ntiles; t += NBLK) {
    int tm = rowtile_of(t / nt_n, latent_only), tn = t % nt_n;
    gemm_tile<EPI>(A, Wt, N, tm * 128, tn * 128, smem, Cb, xs, gate_base);
  }
}

DI void rope_pair8(float (&y)[8], const float (&part)[8], bool upper, const float* cs, const float* sn, int dd0) {
#pragma unroll
  for (int e = 0; e < 8; ++e) {
    float c = cs[dd0 + e], s = sn[dd0 + e];
    float x1 = upper ? part[e] : y[e], x2 = upper ? y[e] : part[e];
    y[e] = upper ? (x1 * s + x2 * c) : (x1 * c - x2 * s);
  }
}
DI void unpack8(uint4 w, float (&v)[8]) {
  v[0] = bflo(w.x); v[1] = bfhi(w.x); v[2] = bflo(w.y); v[3] = bfhi(w.y); v[4] = bflo(w.z); v[5] = bfhi(w.z); v[6] = bflo(w.w); v[7] = bfhi(w.w);
}
DI uint4 pack8(const float (&v)[8], float sc) {
  return make_uint4(pk2bf(v[0] * sc, v[1] * sc), pk2bf(v[2] * sc, v[3] * sc), pk2bf(v[4] * sc, v[5] * sc), pk2bf(v[6] * sc, v[7] * sc));
}
constexpr int VS_STRIDE = 1032;
constexpr int HS_STRIDE = 1552;
DI void prep_tile(MKP m_in, int l, int tile, char* smem) {
  const MK m = launder_mk(m_in);
  const int tid = TID, lane = tid & 63, wid = tid >> 6;
  const int r0 = tile * 32; const int b = r0 / NT, p0 = r0 % NT;
  const bool lat = p0 >= CTX;
  char* Vs = smem;
  char* Hs = smem + 33280;
  float* csh = (float*)(smem + 33280 + 34 * HS_STRIDE);
  const bf16_t* Pb = ((bf16_t*)(m.ws + OFF_P)) + (size_t)(b * NT) * DIN;
  __syncthreads();
  if (lat) {
    for (int i = tid; i < 32 * 48; i += NTHR) {
      int rr = i / 48, a = i % 48;
      int t = p0 + rr - CTX;
      float trow = (float)(t / 64), tcol = (float)(t % 64);
      float* rowp = csh + rr * 96;
      if (a < 16) {
        int j = a & 7; float f = exp2f(-(float)j * (13.287712379549449f / 8.f));
        float ang = (a < 8 ? trow : tcol) * f;
        rowp[a] = cosf(ang); rowp[16 + a] = sinf(ang);
      } else {
        int aa = a - 16; int j = aa & 15; float f = exp2f(-(float)j * (13.287712379549449f / 16.f));
        float ang = (aa < 16 ? trow : tcol) * f;
        rowp[32 + aa] = cosf(ang); rowp[64 + aa] = sinf(ang);
      }
    }
  }
  {
    const int seg_lo = lat ? CTX : 0, seg_hi = lat ? NT : CTX;
    for (int ch = tid; ch < 34 * 96; ch += NTHR) {
      int rr = ch / 96, c8 = ch % 96;
      int p = p0 - 1 + rr;
      uint4 v = make_uint4(0, 0, 0, 0);
      if (p >= seg_lo && p < seg_hi) v = *(const uint4*)(Pb + (size_t)p * DIN + 1792 + c8 * 8);
      *(uint4*)(Hs + rr * HS_STRIDE + c8 * 16) = v;
    }
  }
  __syncthreads();
  const float* gd = m.g_qk_diff + l * 64; const float* gwn = m.g_qk_win + l * 128; const float* gg = m.g_qk_glob + l * 128;
#pragma unroll
  for (int k = 0; k < 4; ++k) {
    const int rr = wid + 8 * k; const int p = p0 + rr;
    const bf16_t* Pr = Pb + (size_t)p * DIN;
    const float* rowp = csh + rr * 96;
    {
      float y[8], part[8];
      unpack8(*(const uint4*)(Pr + 8 * lane), y);
      float ss = 0.f;
#pragma unroll
      for (int e = 0; e < 8; ++e) ss += y[e] * y[e];
      ss += shxl(ss, lane, 1); ss += shxl(ss, lane, 2);
      const float rs = rsqrtf(ss * (1.f / 32) + EPS);
      const int unit = lane >> 2; const bool isk = unit >= 8; const int vh = unit & 7;
      const int d0 = (lane & 3) * 8;
      const float* gn = gd + (isk ? 32 : 0) + d0;
#pragma unroll
      for (int e = 0; e < 8; ++e) y[e] = y[e] * rs * gn[e];
      if (lat) {
#pragma unroll
        for (int e = 0; e < 8; ++e) part[e] = shxl(y[e], lane, 2);
        rope_pair8(y, part, (lane & 2) != 0, rowp, rowp + 16, (lane & 1) * 8);
      }
      bf16_t* dst = (isk ? ((bf16_t*)(m.ws + OFF_KA)) : ((bf16_t*)(m.ws + OFF_QA))) + (((size_t)b * 8 + vh) * NT + p) * 32 + d0;
      *(uint4*)dst = pack8(y, isk ? 1.f : 0.17677669529663687f * LOG2E);
    }
#pragma unroll
    for (int grp = 0; grp < 2; ++grp) {
      float y[8], part[8];
      const int cbase = grp == 0 ? 768 : 1280;
      uint4 w = make_uint4(0, 0, 0, 0);
      if (lane < 48) w = *(const uint4*)(Pr + cbase + 8 * lane);
      unpack8(w, y);
      float ss = 0.f;
#pragma unroll
      for (int e = 0; e < 8; ++e) ss += y[e] * y[e];
      ss += shxl(ss, lane, 1); ss += shxl(ss, lane, 2); ss += shxl(ss, lane, 4);
      const float rs = rsqrtf(ss * (1.f / 64) + EPS);
      const int unit = lane >> 3; const bool isk = unit >= 4; const int hh = isk ? unit - 4 : unit;
      const int d0 = (lane & 7) * 8;
      const float* gn = (grp == 0 ? gwn : gg) + (isk ? 64 : 0) + d0;
      if (lane < 48) {
#pragma unroll
        for (int e = 0; e < 8; ++e) y[e] = y[e] * rs * gn[e];
      }
      if (lat) {
#pragma unroll
        for (int e = 0; e < 8; ++e) part[e] = shxl(y[e], lane, 4);
        rope_pair8(y, part, (lane & 4) != 0, rowp + 32, rowp + 64, (lane & 3) * 8);
      }
      if (lane < 48) {
        bf16_t* base = grp == 0 ? (isk ? ((bf16_t*)(m.ws + OFF_KW)) : ((bf16_t*)(m.ws + OFF_QW))) : (isk ? ((bf16_t*)(m.ws + OFF_KG)) : ((bf16_t*)(m.ws + OFF_QG)));
        bf16_t* dst = base + (((size_t)b * (isk ? 2 : 4) + hh) * NT + p) * 64 + d0;
        *(uint4*)dst = pack8(y, isk ? 1.f : 0.125f * LOG2E);
      }
    }
    {
      const int vsrc = lane < 32 ? 512 + 8 * lane : (lane < 48 ? 1152 + 8 * (lane - 32) : 1664 + 8 * (lane - 48));
      uint4 w = *(const uint4*)(Pr + vsrc);
      *(uint2*)(Vs + rr * VS_STRIDE + lane * 16) = make_uint2(w.x, w.y);
      *(uint2*)(Vs + rr * VS_STRIDE + lane * 16 + 8) = make_uint2(w.z, w.w);
    }
  }
  __syncthreads();
  for (int tk = tid; tk < 2048; tk += NTHR) {
    const int pg = tk & 3; const int vch = (tk >> 2) & 15 | ((tk >> 6) << 4);
    unsigned short e[8];
#pragma unroll
    for (int i = 0; i < 8; ++i) {
      int sidx = 8 * pg + i;
      int pl = (sidx & 16) | perm16(sidx & 15);
      e[i] = *(const unsigned short*)(Vs + pl * VS_STRIDE + vch * 2);
    }
    uint4 w = make_uint4(e[0] | ((unsigned)e[1] << 16), e[2] | ((unsigned)e[3] << 16), e[4] | ((unsigned)e[5] << 16), e[6] | ((unsigned)e[7] << 16));
    bf16_t* dst;
    if (vch < 256) dst = ((bf16_t*)(m.ws + OFF_VAt)) + (((size_t)b * 4 + (vch >> 6)) * 64 + (vch & 63)) * NT;
    else if (vch < 384) dst = ((bf16_t*)(m.ws + OFF_VWt)) + (((size_t)b * 2 + ((vch - 256) >> 6)) * 64 + (vch & 63)) * NT;
    else dst = ((bf16_t*)(m.ws + OFF_VGt)) + (((size_t)b * 2 + ((vch - 384) >> 6)) * 64 + (vch & 63)) * NT;
    *(uint4*)(dst + p0 + 8 * pg) = w;
  }
  {
    const float* cw = ((const float*)m.hy_conv_w) + l * 3 * 768; const float* cb = ((const float*)m.hy_conv_b) + l * 768;
    const int cc = lane >> 3, pg = lane & 7;
#pragma unroll 2
    for (int cg = wid; cg < 96; cg += 8) {
      const int c = cg * 8 + cc;
      const float w0 = cw[c], w1 = cw[768 + c], w2 = cw[1536 + c], bb = cb[c];
      float xin[6];
#pragma unroll
      for (int i = 0; i < 6; ++i) xin[i] = bf2f(*(const bf16_t*)(Hs + (4 * pg + i) * HS_STRIDE + c * 2));
      float o[4];
#pragma unroll
      for (int i = 0; i < 4; ++i) o[i] = xin[i] * w0 + xin[i + 1] * w1 + xin[i + 2] * w2 + bb;
      *(float4*)(((float*)(m.ws + OFF_uT)) + ((size_t)b * 768 + c) * NT + p0 + 4 * pg) = make_float4(o[0], o[1], o[2], o[3]);
    }
  }
}

DI void hyena_ctx_channel(MKP m_in, int l, int c, char* smem) {
  const MK m = launder_mk(m_in);
  float* kf = (float*)smem;
  float* vz = kf + 1024;
  float* red = vz + 512;
  float* wcol = red + 16;
  const int tid = TID;
  const float* hd = ((float*)(m.ws + OFF_hdn2)) + (size_t)l * 64 * NT + SEQ;
  const float* w3 = m.hy_w3 + (size_t)l * 64 * 1024; const float* b3 = m.hy_b3 + l * 1024;
  __syncthreads();
  if (tid < 256) { int od = tid >> 6, i = tid & 63; wcol[i * 4 + od] = w3[i * 1024 + (od >> 1) * 512 + (od & 1) * 256 + c]; }
  __syncthreads();
  const float delta = fabsf(-3.0701134573253944f + (float)c * ((-15.350567286626972f + 3.0701134573253944f) / 255.f));
  float n0 = 0.f, n1 = 0.f;
  if (tid < 256) {
    const int j = tid;
    float f00 = b3[c], f01 = b3[256 + c], f10 = b3[512 + c], f11 = b3[768 + c];
#pragma unroll 4
    for (int i = 0; i < 64; ++i) {
      float hv = hd[(size_t)i * NT + j];
      const float4 w = *(const float4*)(wcol + 4 * i);
      f00 += hv * w.x; f01 += hv * w.y; f10 += hv * w.z; f11 += hv * w.w;
    }
    const float dec = __expf(-((float)j / (float)(CTX - 1)) * delta);
    f00 *= dec; f01 *= dec; f10 *= dec; f11 *= dec;
    kf[256 + j] = f00; kf[512 + 256 + j] = f10; n0 += fabsf(f00); n1 += fabsf(f10);
    if (j > 0) { kf[256 - j] = f01; kf[512 + 256 - j] = f11; n0 += fabsf(f01); n1 += fabsf(f11); }
    else { kf[0] = 0.f; kf[512] = 0.f; }
  }
  n0 = block_sum_512(n0, red);
  n1 = block_sum_512(n1, red);
  const float i0 = 1.f / n0, i1 = 1.f / n1;
  const int bb = tid >> 8, t = tid & 255;
  const float* ub = ((float*)(m.ws + OFF_uT)) + ((size_t)bb * 768 + c) * NT;
  const float vself = ub[t];
  vz[bb * 256 + t] = vself;
  __syncthreads();
  float acc = 0.f;
  for (int s2 = 0; s2 < 256; s2 += 4) { const float4 v4 = *(const float4*)(vz + bb * 256 + s2); const float* kp = kf + 256 + t - s2; acc += v4.x * kp[0] + v4.y * kp[-1] + v4.z * kp[-2] + v4.w * kp[-3]; }
  const float z = ub[(size_t)256 * NT + t] * (acc * i0 + m.hy_bias[l * 512 + c] * vself);
  __syncthreads();
  vz[bb * 256 + t] = z;
  __syncthreads();
  float acc2 = 0.f;
  for (int s2 = 0; s2 < 256; s2 += 4) { const float4 v4 = *(const float4*)(vz + bb * 256 + s2); const float* kp = kf + 512 + 256 + t - s2; acc2 += v4.x * kp[0] + v4.y * kp[-1] + v4.z * kp[-2] + v4.w * kp[-3]; }
  ((float*)(m.ws + OFF_yT))[((size_t)bb * 256 + c) * NT + t] = ub[(size_t)512 * NT + t] * (acc2 * i1 + m.hy_bias[l * 512 + 256 + c] * z);
}

DI void phase_mix(MKP m_in, int l, bool want_ctx, char* smem) {
  const MK m = launder_mk(m_in);
  AttnArgs a;
  a.QA = ((bf16_t*)(m.ws + OFF_QA)); a.KA = ((bf16_t*)(m.ws + OFF_KA)); a.VAt = ((bf16_t*)(m.ws + OFF_VAt)); a.QW = ((bf16_t*)(m.ws + OFF_QW)); a.KW = ((bf16_t*)(m.ws + OFF_KW)); a.VWt = ((bf16_t*)(m.ws + OFF_VWt)); a.QG = ((bf16_t*)(m.ws + OFF_QG)); a.KG = ((bf16_t*)(m.ws + OFF_KG)); a.VGt = ((bf16_t*)(m.ws + OFF_VGt));
  a.g_qk_diff = m.g_qk_diff + l * 64; a.g_qk_win = m.g_qk_win + l * 128; a.g_qk_glob = m.g_qk_glob + l * 128; a.sink = m.sink_win + l * 4;
  a.lambda_diff = m.lambda_diff + l * 128; a.g_mix_out = m.g_mix_out + l * D; a.lambda_init = 0.8f - 0.6f * __expf(-0.3f * (float)l); a.pad0 = 0;
  a.A2 = ((bf16_t*)(m.ws + OFF_A2)); a.Oslab = ((float*)(m.ws + OFF_Oslab)); a.Lslab = ((float*)(m.ws + OFF_Lslab));
  const int nitems = 640 + (want_ctx ? 20 : 0);
  for (int rep = 0; rep < REP_DIFF; ++rep) for (int idx = BID; idx < 256; idx += NBLK) attn_dispatch(a, idx, want_ctx, smem);
  for (int rep = 0; rep < REP_GLOB; ++rep) for (int idx = 256 + BID; idx < 512; idx += NBLK) attn_dispatch(a, idx, want_ctx, smem);
  for (int rep = 0; rep < REP_HY; ++rep) for (int c = BID; c < 256; c += NBLK) {
    hyena_channel(c, m.hy_bias + l * 512, ((float*)(m.ws + OFF_uT)), ((float*)(m.ws + OFF_zT)), ((float*)(m.ws + OFF_yT)), (const uint2*)(m.ws + OFF_Hc), smem);
    if (want_ctx) hyena_ctx_channel(m_in, l, c, smem);
  }
  for (int idx = 512 + BID; idx < nitems; idx += NBLK) attn_dispatch(a, idx, want_ctx, smem);
}

DI void phase_fin(MKP m_in, int l, bool want_ctx, char* smem) {
  const MK m = launder_mk(m_in);
  const float* gmo = m.g_mix_out + l * D;
  const int lane = TID & 63, wid = TID >> 6;
  char* wl = smem + wid * 9216;
  for (int chunk = BID * 8 + wid; chunk < NB * 8 * (NT / 64); chunk += NBLK * 8) {
    const int pc = chunk % (NT / 64), hd = (chunk / (NT / 64)) % 8, b = chunk / ((NT / 64) * 8);
    const int pbase = pc * 64;
    if (pbase < CTX && !want_ctx) continue;
    const float* gm = gmo + 512 + hd * 64;
    bf16_t* dst0 = ((bf16_t*)(m.ws + OFF_A2)) + ((size_t)b * NT + pbase) * D + 512 + hd * 64;
    if (hd < 4) {
      const int c4 = lane & 15, rr = lane >> 4;
      const float4 g4 = *(const float4*)(gm + 4 * c4);
      const size_t i0b = (((size_t)0 * NB + b) * 4 + hd) * NT + pbase, i1b = (((size_t)1 * NB + b) * 4 + hd) * NT + pbase;
      const float* Os = (const float*)(m.ws + OFF_Oslab); const float* Ls = (const float*)(m.ws + OFF_Lslab);
#pragma unroll 4
      for (int ps = 0; ps < 16; ++ps) {
        const int row = ps * 4 + rr;
        const float4 x = *(const float4*)(Os + (i0b + row) * 64 + 4 * c4), y = *(const float4*)(Os + (i1b + row) * 64 + 4 * c4);
        const float inv = 1.f / (Ls[i0b + row] + Ls[i1b + row]);
        const float o0 = (x.x + y.x) * inv, o1 = (x.y + y.y) * inv, o2 = (x.z + y.z) * inv, o3 = (x.w + y.w) * inv;
        float ss = o0 * o0 + o1 * o1 + o2 * o2 + o3 * o3;
        ss += shxl(ss, lane, 8); ss += shxl(ss, lane, 4); ss += shxl(ss, lane, 2); ss += shxl(ss, lane, 1);
        const float rs = rsqrtf(ss * (1.f / 64) + EPS);
        *(uint2*)(dst0 + (size_t)row * D + 4 * c4) = make_uint2(pk2bf(o0 * rs * g4.x, o1 * rs * g4.y), pk2bf(o2 * rs * g4.z, o3 * rs * g4.w));
      }
    } else {
      const int g = hd - 4, p = pbase + lane;
      float o[64]; float ss = 0.f;
#pragma unroll
      for (int i = 0; i < 64; ++i) o[i] = ((const float*)(m.ws + OFF_yT))[((size_t)b * 256 + g * 64 + i) * NT + p];
#pragma unroll
      for (int i = 0; i < 64; ++i) ss += o[i] * o[i];
      const float rs = rsqrtf(ss * (1.f / 64) + EPS);
#pragma unroll
      for (int i = 0; i < 8; ++i)
        *(uint4*)(wl + lane * 144 + i * 16) = make_uint4(pk2bf(o[8 * i] * rs * gm[8 * i], o[8 * i + 1] * rs * gm[8 * i + 1]), pk2bf(o[8 * i + 2] * rs * gm[8 * i + 2], o[8 * i + 3] * rs * gm[8 * i + 3]),
                                                         pk2bf(o[8 * i + 4] * rs * gm[8 * i + 4], o[8 * i + 5] * rs * gm[8 * i + 5]), pk2bf(o[8 * i + 6] * rs * gm[8 * i + 6], o[8 * i + 7] * rs * gm[8 * i + 7]));
      asm volatile("s_waitcnt lgkmcnt(0)" ::: "memory");
#pragma unroll
      for (int k = 0; k < 8; ++k) {
        const int row = k * 8 + (lane >> 3), ch = lane & 7;
        *(uint4*)(dst0 + (size_t)row * D + ch * 8) = *(const uint4*)(wl + row * 144 + ch * 16);
      }
      asm volatile("s_waitcnt lgkmcnt(0)" ::: "memory");
    }
  }
}

#ifndef PEER_SLICED
#define PEER_SLICED 1
#endif
#if !PEER_SLICED
DI void phase_peer(MKP m_in, int l, bool want_ctx, bool last, char* smem) {
  const MK m = launder_mk(m_in);
  const int lane = TID & 63, wid = TID >> 6;
  char* wbase = smem + wid * 10240;
  int* ex_l = (int*)wbase; float* g_l = (float*)(wbase + 4608); float* wd = (float*)(wbase + 9216);
  const float* modv_l = ((float*)(m.ws + OFF_modv)) + (size_t)l * 3 * NMOD;
  const int gw0 = BID * 8 + wid, nw0 = NBLK * 8;
  for (int i0 = 0; gw0 + nw0 * i0 < R && i0 < 9; i0 += 8) {
    const int slot = i0 + (lane >> 3);
    const int r = gw0 + nw0 * slot;
    if (slot < 9 && r < R && !((r % NT) < CTX && !want_ctx))
      merge_one(((unsigned*)(m.ws + OFF_topv)), r, lane & 7, ex_l + slot * 128, g_l + slot * 128);
  }
  int slot = 0;
  for (int r = gw0; r < R; r += nw0, ++slot) {
    if ((r % NT) < CTX && !want_ctx) continue;
    if (slot >= 9) {
      if (lane < 8) merge_one(((unsigned*)(m.ws + OFF_topv)), r, lane, ex_l + 8 * 128, g_l + 8 * 128);
    }
    const int sl = slot < 9 ? slot : 8;
    peer_token<PEER_SLICED>(r, ((bf16_t*)(m.ws + OFF_hbuf)), ex_l + sl * 128, g_l + sl * 128, ((unsigned char*)(m.ws + OFF_u8)) + (size_t)l * 16384 * D, ((float*)(m.ws + OFF_us)) + l * 16384, ((unsigned char*)(m.ws + OFF_v8)) + (size_t)l * 16384 * D, ((float*)(m.ws + OFF_vs)) + l * 16384,
               modv_l, ((float*)(m.ws + OFF_xs)), wd, last ? m.out : nullptr, ((int*)(m.ws + OFF_experts)), ((float*)(m.ws + OFF_gates)));
  }
}
#endif
DI void peer_v_rows(const MK& m, int l, bool want_ctx, bool last, int vslice_, int w0, int wstride) {
  const int lane = TID & 63, g = lane >> 3, j = lane & 7;
  const int vslice = __builtin_amdgcn_readfirstlane(vslice_);
  const unsigned char* v8u = ((const unsigned char*)(m.ws + OFF_v8)) + (size_t)l * 16384 * D + (size_t)vslice * TSLICE;
  const unsigned j16 = (unsigned)j * 16u;
  const unsigned* wts = (const unsigned*)(m.ws + OFF_gates);
  const float* modv_l = ((const float*)(m.ws + OFF_modv)) + (size_t)l * 3 * NMOD;
  float* xs = (float*)(m.ws + OFF_xs);
#pragma unroll 1
  for (int r = w0; r < R; r += wstride) {
    const int b = r / NT, p = r % NT;
    if (p < CTX && !want_ctx) continue;
    unsigned pkv[16];
    {
      const uint4* ep = (const uint4*)(wts + (size_t)r * 128 + 16 * g);
#pragma unroll
      for (int q = 0; q < 4; ++q) { const uint4 e4 = ep[q]; pkv[4 * q] = e4.x; pkv[4 * q + 1] = e4.y; pkv[4 * q + 2] = e4.z; pkv[4 * q + 3] = e4.w; }
    }
    const float invS = ((const float*)(m.ws + OFF_wsc))[r];
    const int col = 256 * (g >> 1) + 32 * vslice + 4 * j + 2 * (g & 1);
    const int mrow = p < CTX ? 2 : b;
    const float2 gg = *(const float2*)(modv_l + mrow * NMOD + 5 * D + col);
    float2 xv = *(const float2*)(xs + (size_t)r * D + col);
    uint4 rw[16];
#pragma unroll
    for (int q = 0; q < 16; ++q) {
      unsigned off;
      asm("v_mad_u32_u16 %0, %1, %2, %3" : "=v"(off) : "v"(pkv[q]), "s"(128u), "v"(j16));
      rw[q] = *(const uint4*)(v8u + off);
    }
    h2_t hacc[8];
#pragma unroll
    for (int i = 0; i < 8; ++i) hacc[i] = (h2_t){(_Float16)0.f, (_Float16)0.f};
#pragma unroll
    for (int q = 0; q < 16; ++q) {
      const h2_t pk2 = __builtin_bit_cast(h2_t, pkv[q]);
      const h2_t w2 = __builtin_shufflevector(pk2, pk2, 1, 1);
      const int r4[4] = {(int)rw[q].x, (int)rw[q].y, (int)rw[q].z, (int)rw[q].w};
#pragma unroll
      for (int c = 0; c < 4; ++c) {
        hacc[2 * c] = __builtin_elementwise_fma(__builtin_bit_cast(h2_t, __builtin_amdgcn_cvt_scalef32_pk_f16_fp8(r4[c], 1.0f, false)), w2, hacc[2 * c]);
        hacc[2 * c + 1] = __builtin_elementwise_fma(__builtin_bit_cast(h2_t, __builtin_amdgcn_cvt_scalef32_pk_f16_fp8(r4[c], 1.0f, true)), w2, hacc[2 * c + 1]);
      }
    }
    h2_t b4[4], c2[2], d1;
    {
      const bool g2 = lane & 32, g1 = lane & 16, g0 = lane & 8;
#pragma unroll
      for (int i = 0; i < 4; ++i) {
        const int send = __builtin_bit_cast(int, g2 ? hacc[i] : hacc[4 + i]); const h2_t keep = g2 ? hacc[4 + i] : hacc[i];
        b4[i] = keep + __builtin_bit_cast(h2_t, shxl(send, lane, 32));
      }
#pragma unroll
      for (int i = 0; i < 2; ++i) {
        const int send = __builtin_bit_cast(int, g1 ? b4[i] : b4[2 + i]); const h2_t keep = g1 ? b4[2 + i] : b4[i];
        c2[i] = keep + __builtin_bit_cast(h2_t, shxl(send, lane, 16));
      }
      {
        const int send = __builtin_bit_cast(int, g0 ? c2[0] : c2[1]); const h2_t keep = g0 ? c2[1] : c2[0];
        d1 = keep + __builtin_bit_cast(h2_t, shxl(send, lane, 8));
      }
    }
    {
      xv.x += gg.x * ((float)d1[0] * invS); xv.y += gg.y * ((float)d1[1] * invS);
      float* op = last ? m.out + ((size_t)b * SEQ + (p - CTX)) * D + col : xs + (size_t)r * D + col;
      *(float2*)op = xv;
    }
  }
}
DI void phase_peer_merge(MKP m_in, bool want_ctx, char* smem) {
  const MK m = launder_mk(m_in);
  const int lane = TID & 63, wid = TID >> 6;
  char* wbase = smem + wid * 8192;
  int* ex_l = (int*)wbase; float* g_l = (float*)(wbase + 4096);
  int* experts = (int*)(m.ws + OFF_experts); float* gates = (float*)(m.ws + OFF_gates);
  for (int grp = BID * 8 + wid; grp < R / 8; grp += NBLK * 8) {
    const int r = grp * 8 + (lane >> 3);
    const bool skip = ((r % NT) < CTX) && !want_ctx;
    if (skip) continue;
    merge_one(((unsigned*)(m.ws + OFF_topv)), r, lane & 7, ex_l + (lane >> 3) * 128, g_l + (lane >> 3) * 128);
    asm volatile("s_waitcnt lgkmcnt(0)" ::: "memory");
#pragma unroll
    for (int q = 0; q < 4; ++q) {
      const int idx = (q * 64 + lane) * 4;
      *(uint4*)(experts + (size_t)grp * 1024 + idx) = *(const uint4*)(ex_l + idx);
      *(float4*)(gates + (size_t)grp * 1024 + idx) = *(const float4*)(g_l + idx);
    }
    asm volatile("s_waitcnt lgkmcnt(0)" ::: "memory");
  }
}
DI void peer_u_rows(const MK& m, int l, bool want_ctx, int vslice_, int w0, int wstride) {
  const int lane = TID & 63, g = lane >> 3, j = lane & 7;
  const int vslice = __builtin_amdgcn_readfirstlane(vslice_);
  const unsigned char* u8 = ((const unsigned char*)(m.ws + OFF_u8)) + (size_t)l * 16384 * D + (size_t)vslice * TSLICE;
  const unsigned char* xq = (const unsigned char*)(m.ws + OFF_xq);
  const unsigned loff = (unsigned)(vslice * 128 + j * 16);
  const unsigned j16 = (unsigned)j * 16u;
  const int* experts = (const int*)(m.ws + OFF_experts);
  int* PD = ((int*)(m.ws + OFF_P)) + (size_t)vslice * R * 128;
#pragma unroll 1
  for (int r = w0; r < R; r += wstride) {
    if (((r % NT) < CTX) && !want_ctx) continue;
    uint4 rw[16];
    {
      const uint4* ep = (const uint4*)((const unsigned short*)experts + (size_t)r * 128 + 16 * g);
      const uint4 ea = ep[0], eb = ep[1];
      const unsigned ew[8] = {ea.x, ea.y, ea.z, ea.w, eb.x, eb.y, eb.z, eb.w};
#pragma unroll
      for (int q = 0; q < 8; ++q) {
        unsigned o0, o1;
        asm("v_mad_u32_u16 %0, %1, %2, %3" : "=v"(o0) : "v"(ew[q]), "s"(128u), "v"(j16));
        asm("v_mad_u32_u16 %0, %1, %2, %3 op_sel:[1,0,0,0]" : "=v"(o1) : "v"(ew[q]), "s"(128u), "v"(j16));
        rw[2 * q] = *(const uint4*)(u8 + o0);
        rw[2 * q + 1] = *(const uint4*)(u8 + o1);
      }
    }
    const uint4 xv = *(const uint4*)(xq + (size_t)r * D + loff);
    int pd[16];
#pragma unroll
    for (int q = 0; q < 16; ++q) {
      int a = __builtin_amdgcn_sdot4((int)rw[q].x, (int)xv.x, 0, false);
      a = __builtin_amdgcn_sdot4((int)rw[q].y, (int)xv.y, a, false);
      a = __builtin_amdgcn_sdot4((int)rw[q].z, (int)xv.z, a, false);
      pd[q] = __builtin_amdgcn_sdot4((int)rw[q].w, (int)xv.w, a, false);
    }
    int b8[8], c4[4], d2[2];
    {
      const bool j2 = lane & 4, j1 = lane & 2, j0 = lane & 1;
#pragma unroll
      for (int i = 0; i < 8; ++i) { const int send = j2 ? pd[i] : pd[8 + i], keep = j2 ? pd[8 + i] : pd[i]; b8[i] = keep + shxl(send, lane, 4); }
#pragma unroll
      for (int i = 0; i < 4; ++i) { const int send = j1 ? b8[i] : b8[4 + i], keep = j1 ? b8[4 + i] : b8[i]; c4[i] = keep + shxl(send, lane, 2); }
#pragma unroll
      for (int i = 0; i < 2; ++i) { const int send = j0 ? c4[i] : c4[2 + i], keep = j0 ? c4[2 + i] : c4[i]; d2[i] = keep + shxl(send, lane, 1); }
    }
    *(int2*)(PD + (size_t)r * 128 + 16 * g + 2 * j) = make_int2(d2[0], d2[1]);
  }
}
DI void phase_peer_u(MKP m_in, int l, bool want_ctx, char* smem) {
  const MK m = launder_mk(m_in);
  unsigned* bar = (unsigned*)(m.ws + OFF_bar);
  volatile LAS unsigned* st = (volatile LAS unsigned*)(smem + SMEM_BYTES);
  if (threadIdx.x == 0) {
    unsigned ok = 1u, mine = 0u; const unsigned x = st[3];
    for (unsigned q = 0; q < 16; ++q) { const unsigned c = xb_ld(&bar[XB_XCNT(q)]); if ((q < 8) != (c > 0u)) ok = 0u; if (q == x) mine = c; }
    st[4] = ok ? mine : 0u;
  }
  __syncthreads();
  const unsigned nloc = st[4];
  const int wid = TID >> 6;
  if (nloc != 0u) peer_u_rows(m, l, want_ctx, (int)(st[3] & 7u), (int)st[2] * 8 + wid, (int)nloc * 8);
  else for (int v = 0; v < 8; ++v) peer_u_rows(m, l, want_ctx, v, BID * 8 + wid, NBLK * 8);
}
DI void phase_peer_reduce(MKP m_in, int l, bool want_ctx) {
  const MK m = launder_mk(m_in);
  const int* experts = (const int*)(m.ws + OFF_experts);
  float* gates = (float*)(m.ws + OFF_gates);
  const int* PD = (const int*)(m.ws + OFF_P);
  const float* us = ((const float*)(m.ws + OFF_us)) + l * 16384;
  const float* vs = ((const float*)(m.ws + OFF_vs)) + l * 16384;
  const float* xqs = (const float*)(m.ws + OFF_xqs);
  for (int i4 = BID * NTHR + TID; i4 < R * 32; i4 += NBLK * NTHR) {
    const int r = i4 >> 5;
    if (((r % NT) < CTX) && !want_ctx) continue;
    int4 acc = make_int4(0, 0, 0, 0);
#pragma unroll
    for (int v = 0; v < 8; ++v) { const int4 p = ((const int4*)(PD + (size_t)v * R * 128))[i4]; acc.x += p.x; acc.y += p.y; acc.z += p.z; acc.w += p.w; }
    const uint2 e2 = ((const uint2*)experts)[i4];
    const int4 e4 = make_int4((int)(e2.x & 0xffffu), (int)(e2.x >> 16), (int)(e2.y & 0xffffu), (int)(e2.y >> 16));
    float4 g4 = ((const float4*)gates)[i4];
    const float xs_ = xqs[r];
    const int ee[4] = {e4.x, e4.y, e4.z, e4.w}; const int aa[4] = {acc.x, acc.y, acc.z, acc.w}; float gg[4] = {g4.x, g4.y, g4.z, g4.w};
#pragma unroll
    for (int q = 0; q < 4; ++q) {
      const float d = (float)aa[q] * (us[ee[q]] * xs_);
      const float t = 0.5f * d * (1.f + tanhf(0.7978845608028654f * (d + 0.044715f * d * d * d)));
      gg[q] = gg[q] * t * vs[ee[q]];
    }
    const int lane = TID & 63;
    float mxw = fmaxf(fmaxf(fabsf(gg[0]), fabsf(gg[1])), fmaxf(fabsf(gg[2]), fabsf(gg[3])));
    mxw = fmaxf(mxw, shxl(mxw, lane, 1)); mxw = fmaxf(mxw, shxl(mxw, lane, 2)); mxw = fmaxf(mxw, shxl(mxw, lane, 4));
    mxw = fmaxf(mxw, shxl(mxw, lane, 8)); mxw = fmaxf(mxw, shxl(mxw, lane, 16));
    const unsigned eb = (__float_as_uint(mxw) >> 23) & 255u;
    const float Sw = __uint_as_float((252u - eb) << 23);
    unsigned pk[4];
#pragma unroll
    for (int q = 0; q < 4; ++q) {
      const _Float16 wh = (_Float16)(gg[q] * Sw);
      pk[q] = (unsigned)ee[q] | ((unsigned)__builtin_bit_cast(unsigned short, wh) << 16);
    }
    ((uint4*)gates)[i4] = make_uint4(pk[0], pk[1], pk[2], pk[3]);
    if ((i4 & 31) == 0) ((float*)(m.ws + OFF_wsc))[r] = __uint_as_float(eb == 0u ? 0u : ((eb + 2u) << 23));
  }
}
DI void phase_peer_v(MKP m_in, int l, bool want_ctx, bool last, char* smem) {
  const MK m = launder_mk(m_in);
  unsigned* bar = (unsigned*)(m.ws + OFF_bar);
  volatile LAS unsigned* st = (volatile LAS unsigned*)(smem + SMEM_BYTES);
  if (threadIdx.x == 0) {
    unsigned ok = 1u, mine = 0u; const unsigned x = st[3];
    for (unsigned q = 0; q < 16; ++q) { const unsigned c = xb_ld(&bar[XB_XCNT(q)]); if ((q < 8) != (c > 0u)) ok = 0u; if (q == x) mine = c; }
    st[1 + 3 + 0] = ok ? mine : 0u;
  }
  __syncthreads();
  const unsigned nloc = st[4];
  const int wid = TID >> 6;
  if (nloc != 0u) {
    peer_v_rows(m, l, want_ctx, last, (int)(st[3] & 7u), (int)st[2] * 8 + wid, (int)nloc * 8);
  } else {
    for (int v = 0; v < 8; ++v) peer_v_rows(m, l, want_ctx, last, v, BID * 8 + wid, NBLK * 8);
  }
}

DI void phase_scores(MKP m_in, int l, bool last, char* smem) {
  const MK m = launder_mk(m_in);
  const int nrt = last ? 128 : 132;
  for (int t = BID; t < nrt * 8; t += NBLK)
    score_head_item(((bf16_t*)(m.ws + OFF_P)), ((bf16_t*)(m.ws + OFF_keysb)) + (size_t)l * 16 * 128 * 128, rowtile_of(t >> 3, last) * 128, t & 7, smem,
                    ((int*)(m.ws + OFF_experts)), ((float*)(m.ws + OFF_gates)));
}
DI void phase_gemm1(MKP m_in, int l, char* smem) {
  const MK m = launder_mk(m_in);
  pg8::Gemm g; g.A = (bf16_t*)(m.ws + OFF_hbuf); g.Bt = (bf16_t*)(m.ws + OFF_Wt_in) + (size_t)l * DIN * D; g.M = R; g.N = DIN; g.K = D;
  MySched S; S.init(DIN, false, NBLK, BID);
  EpiStoreBf16 E; E.Cb = (bf16_t*)(m.ws + OFF_P); E.ldc = DIN;
  __syncthreads();
  pg8::gemm_phase<EpiStoreBf16, MySched, false>((PG8_LAS unsigned char*)smem, g, S, E, nullptr);
  __syncthreads();
}
DI int ctx_rowtile(int i) { return (i >> 1) * 66 + (i & 1); }
DI void phase_gemm2(MKP m_in, int l, bool last, char* smem) {
  const MK m = launder_mk(m_in);
  pg8::Gemm g; g.A = (bf16_t*)(m.ws + OFF_A2); g.Bt = (bf16_t*)(m.ws + OFF_Wt_out) + (size_t)l * D * D; g.M = R; g.N = D; g.K = D;
  MySched S; S.init(D, true, NBLK, BID);
  EpiResidual E; E.xs = (float*)(m.ws + OFF_xs); E.gate_base = (float*)(m.ws + OFF_modv) + (size_t)l * 3 * NMOD + 2 * D;
  E.xin = l == 0 ? m.x : nullptr; E.ctxin = l == 0 ? m.ctx : nullptr;
  __syncthreads();
  pg8::gemm_phase<EpiResidual, MySched, false>((PG8_LAS unsigned char*)smem, g, S, E, nullptr);
  __syncthreads();
  if (!last) {
    const int nb = NBLK;
    for (int t = (BID + nb - 32) % nb; t < 4 * 8; t += nb)
      gemm_tile<1>(g.A, g.Bt, D, ctx_rowtile(t >> 3) * 128, (t & 7) * 128, smem, nullptr, E.xs, E.gate_base, E.xin, E.ctxin);
  }
}
DI void phase_gemm3(MKP m_in, int l, bool last, char* smem) {
  const MK m = launder_mk(m_in);
  pg8::Gemm g; g.A = (bf16_t*)(m.ws + OFF_hbuf); g.Bt = (bf16_t*)(m.ws + OFF_Wt_q) + (size_t)l * 2048 * D; g.M = R; g.N = 2048; g.K = D;
  MySched S; S.init(2048, true, NBLK, BID);
  EpiStoreBf16 E; E.Cb = (bf16_t*)(m.ws + OFF_P); E.ldc = 2048;
  __syncthreads();
  pg8::gemm_phase<EpiStoreBf16, MySched, false>((PG8_LAS unsigned char*)smem, g, S, E, nullptr);
  __syncthreads();
  if (!last) {
    const int nb = NBLK;
    for (int t = (BID + nb - 64) % nb; t < 4 * 16; t += nb)
      gemm_tile<0>(g.A, g.Bt, 2048, ctx_rowtile(t >> 4) * 128, (t & 15) * 128, smem, E.Cb, nullptr, nullptr);
  }
}
#define GSYNC() xcd_barrier((unsigned*)(launder_mk(m).ws + OFF_bar), (volatile LAS unsigned*)(smem + SMEM_BYTES))
DI void phase_filters(MKP m_in, int l, char* smem) {
  const MK m = launder_mk(m_in);
  for (int c = BID; c < 256; c += NBLK)
    hyena_filter_task(c, ((const bf16_t*)(m.ws + OFF_hdnB)) + (size_t)l * SEQ * 64, ((const bf16_t*)(m.ws + OFF_W3t)) + (size_t)l * 1024 * 64, m.hy_b3 + l * 1024, (uint2*)(m.ws + OFF_Hc), smem);
}
template <int L>
DI void layer_body(MKP m, char* smem) {
  constexpr bool want_ctx = L == 0, last = L == 1;
  for (int rep = 0; rep < REP_NORM1; ++rep) { phase_norm(m, L, 0, L == 0, false); GSYNC(); }
  for (int rep = 0; rep < REP_GEMM1; ++rep) { phase_gemm1(m, L, smem); GSYNC(); }
  for (int rep = 0; rep < REP_PREP; ++rep) for (int t = BID; t < R / 32; t += NBLK) prep_tile(m, L, t, smem);
  for (int rep = 0; rep < REP_FILT; ++rep) phase_filters(m, L, smem);
  GSYNC();
  for (int rep = 0; rep < REP_MIX; ++rep) { phase_mix(m, L, want_ctx, smem); GSYNC(); }
  for (int rep = 0; rep < REP_FIN; ++rep) { phase_fin(m, L, want_ctx, smem); GSYNC(); }
  phase_gemm2(m, L, last, smem);
  GSYNC();
  for (int rep = 0; rep < REP_NORM2; ++rep) { phase_norm(m, L, 1, false, last); GSYNC(); }
  for (int rep = 0; rep < REP_GEMM3; ++rep) { phase_gemm3(m, L, last, smem); GSYNC(); }
  for (int rep = 0; rep < REP_SCORES; ++rep) { phase_scores(m, L, last, smem); GSYNC(); }
  for (int rep = 0; rep < (last ? REP_PEER_LAST : 1); ++rep) {
#if PEER_SLICED
    for (int ru = 0; ru < (last ? REP_PEER_U : 1); ++ru) phase_peer_u(m, L, want_ctx, smem);
    GSYNC();
    phase_peer_reduce(m, L, want_ctx);
    GSYNC();
    for (int rv = 0; rv < (last ? REP_PEER_V : 1); ++rv) phase_peer_v(m, L, want_ctx, last, smem);
#else
    phase_peer(m, L, want_ctx, last, smem);
#endif
    if (!last || rep + 1 < REP_PEER_LAST) GSYNC();
  }
}
__global__ __launch_bounds__(NTHR) void k_mega(MK m_unused) {
  extern __shared__ __attribute__((aligned(16))) char smem[];
  (void)m_unused;
  MKP m = (MKP)__builtin_amdgcn_kernarg_segment_ptr();
  {
    volatile LAS unsigned* st = (volatile LAS unsigned*)(smem + SMEM_BYTES);
    if (threadIdx.x == 0) { st[0] = 0u; st[1] = 0u; st[2] = 0u; st[3] = 0u; st[4] = 0u; st[5] = 0u; }
    __syncthreads();
    xcd_barrier_post((unsigned*)(launder_mk(m).ws + OFF_bar), st);
  }
  for (int rep = 0; rep < REP_P0; ++rep) { phase0(m, smem); GSYNC(); }
  layer_body<0>(m, smem);
  layer_body<1>(m, smem);
}

extern "C" void kernel_launch(void* const* d_in, const int* in_sizes, int n_in, void* d_out, int out_size, void* d_ws, size_t ws_size,
                              hipStream_t stream) {
  (void)in_sizes; (void)n_in; (void)out_size;
  MK m;
  memset(&m, 0, sizeof(m));
  const float** ip = (const float**)&m.x;
  for (int i = 0; i < 30; ++i) ip[i] = (const float*)d_in[i];
  m.out = (float*)d_out;
  m.ws = (char*)d_ws;
  if (WS_TOTAL > ws_size) return;

  static int grid_blocks = 0;
  if (!grid_blocks) {
    (void)hipFuncSetAttribute((const void*)k_mega, hipFuncAttributeMaxDynamicSharedMemorySize, SMEM_BYTES + 32);
    int dev = 0, cus = 0, per_cu = 0;
    (void)hipGetDevice(&dev);
    (void)hipDeviceGetAttribute(&cus, hipDeviceAttributeMultiprocessorCount, dev);
    (void)hipOccupancyMaxActiveBlocksPerMultiprocessor(&per_cu, k_mega, NTHR, SMEM_BYTES + 32);
    if (per_cu > 1) per_cu = 1;
    grid_blocks = cus * per_cu;
  }
  (void)hipMemsetAsync(m.ws + OFF_bar, 0, (size_t)XCD_BAR_WORDS * 4, stream);
  void* args[] = {&m};
  (void)hipLaunchCooperativeKernel((void*)k_mega, dim3(grid_blocks), dim3(NTHR), args, SMEM_BYTES + 32, stream);
}
```

```cpp
#include <hip/hip_runtime.h>
#ifndef REP_DIFF
#define REP_DIFF 1
#endif
#ifndef REP_GLOB
#define REP_GLOB 1
#endif
#ifndef REP_HY
#define REP_HY 1
#endif
#ifndef REP_FILT
#define REP_FILT 1
#endif
#ifndef REP_PEER_U
#define REP_PEER_U 1
#endif
#ifndef REP_PEER_V
#define REP_PEER_V 1
#endif
#ifndef REP_NORM1
#define REP_NORM1 1
#endif
#ifndef REP_GEMM1
#define REP_GEMM1 1
#endif
#ifndef REP_PREP
#define REP_PREP 1
#endif
#ifndef REP_MIX
#define REP_MIX 1
#endif
#ifndef REP_FIN
#define REP_FIN 1
#endif
#ifndef REP_NORM2
#define REP_NORM2 1
#endif
#ifndef REP_GEMM3
#define REP_GEMM3 1
#endif
#ifndef REP_SCORES
#define REP_SCORES 1
#endif
#ifndef REP_MERGE
#define REP_MERGE 1
#endif
#ifndef REP_PEER_LAST
#define REP_PEER_LAST 1
#endif
#ifndef REP_P0
#define REP_P0 1
#endif
#include <hip/hip_cooperative_groups.h>
namespace cg = cooperative_groups;
#include <stdint.h>
#include <string.h>

#define DI __device__ __forceinline__
#define LAS __attribute__((address_space(3)))
typedef unsigned short bf16_t;

constexpr int D = 1024;
constexpr int NB = 2;
constexpr int SEQ = 8192;
constexpr int CTX = 256;
constexpr int NT = SEQ + CTX;
constexpr int R = NB * NT;
constexpr int DIN = 2560;
constexpr int NMOD = 6 * D;
constexpr float EPS = 1e-6f;
constexpr float LOG2E = 1.4426950408889634f;

DI int opq_v(int x) { asm volatile("" : "+v"(x)); return x; }
DI int opq_s(int x) { asm volatile("" : "+s"(x)); return x; }
template <class T> DI T* opq_p(T* p) { asm volatile("" : "+s"(p)); return p; }
#define TID opq_v((int)threadIdx.x)
#define BID opq_s((int)blockIdx.x)
#define NBLK opq_s((int)gridDim.x)
DI float shxl(float v, int lane, int mask) { return __builtin_bit_cast(float, __builtin_amdgcn_ds_bpermute((lane ^ mask) << 2, __builtin_bit_cast(int, v))); }
DI int shxl(int v, int lane, int mask) { return __builtin_amdgcn_ds_bpermute((lane ^ mask) << 2, v); }
DI float shx(float v, int mask) { return shxl(v, opq_v((int)threadIdx.x) & 63, mask); }
DI bf16_t f2bf(float x) { unsigned u = __float_as_uint(x); u += 0x7fffu + ((u >> 16) & 1u); return (bf16_t)(u >> 16); }
DI float bf2f(bf16_t h) { return __uint_as_float(((unsigned)h) << 16); }
DI float bflo(unsigned w) { return __uint_as_float(w << 16); }
DI float bfhi(unsigned w) { return __uint_as_float(w & 0xffff0000u); }

DI float block_sum_256(float v, float* red) {
  for (int o = 32; o > 0; o >>= 1) v += shx(v, o);
  int w = TID >> 6;
  __syncthreads();
  if ((TID & 63) == 0) red[w] = v;
  __syncthreads();
  float s = red[0] + red[1] + red[2] + red[3];
  return s;
}

DI int perm16(int o) { return (o & 3) | ((o & 4) << 1) | ((o & 8) >> 1); }

typedef __attribute__((ext_vector_type(8))) short bf16x8;
typedef __attribute__((ext_vector_type(16))) float f32x16;
typedef __attribute__((ext_vector_type(2))) __bf16 bf16x2_t;
typedef __attribute__((ext_vector_type(2))) float f32x2_t;
#define MFMA32(a, b, c) __builtin_amdgcn_mfma_f32_32x32x16_bf16((a), (b), (c), 0, 0, 0)
DI unsigned pk2bf(float a, float b) { f32x2_t v = {a, b}; return __builtin_bit_cast(unsigned, __builtin_convertvector(v, bf16x2_t)); }
constexpr int NTHR = 512;

DI void wconv_tile(const float* __restrict__ W, bf16_t* __restrict__ Wt, int N, int tile, float* sm  ) {
  int tn = tile % (N / 64), tk = tile / (N / 64);
  int tid = TID;
  __syncthreads();
  for (int i = tid; i < 64 * 16; i += NTHR) {
    int kr = i >> 4, c4 = (i & 15) * 4;
    float4 v = *(const float4*)(W + (size_t)(tk * 64 + kr) * N + tn * 64 + c4);
    sm[kr * 65 + c4] = v.x; sm[kr * 65 + c4 + 1] = v.y; sm[kr * 65 + c4 + 2] = v.z; sm[kr * 65 + c4 + 3] = v.w;
  }
  __syncthreads();
  for (int i = tid; i < 64 * 8; i += NTHR) {
    int n = i >> 3, k8 = (i & 7) * 8;
    unsigned w[4];
    for (int j = 0; j < 4; ++j) w[j] = pk2bf(sm[(k8 + 2 * j) * 65 + n], sm[(k8 + 2 * j + 1) * 65 + n]);
    *(uint4*)(Wt + (size_t)(tn * 64 + n) * D + tk * 64 + k8) = make_uint4(w[0], w[1], w[2], w[3]);
  }
}

template <int EPI, int K = D>
DI void gemm_tile(const bf16_t* __restrict__ A, const bf16_t* __restrict__ Wt, int N, int m0, int n0, char* smem, bf16_t* __restrict__ Cb,
                  float* __restrict__ xs, const float* __restrict__ gate_base, const float* __restrict__ xin = nullptr, const float* __restrict__ ctxin = nullptr) {
  const int tid = TID, lane = tid & 63, wid = tid >> 6;
  const int wm = wid & 1, wn = wid >> 1;
  const int r = lane & 31, h = lane >> 5;
  f32x16 acc0, acc1;
  for (int i = 0; i < 16; ++i) { acc0[i] = 0.f; acc1[i] = 0.f; }
  const int lrow = tid >> 3, lch = tid & 7;
  const bf16_t* Ag = A + (size_t)(m0 + lrow) * K + lch * 8;
  const bf16_t* Bg = Wt + (size_t)(n0 + lrow) * K + lch * 8;
  const int woff = lrow * 128 + ((lch ^ ((lrow >> 1) & 7)) << 4);
  uint4 ra0, ra1, rb0, rb1;
  ra0 = *(const uint4*)(Ag); ra1 = *(const uint4*)(Ag + (size_t)64 * K);
  rb0 = *(const uint4*)(Bg); rb1 = *(const uint4*)(Bg + (size_t)64 * K);
  __syncthreads();
  *(uint4*)(smem + woff) = ra0; *(uint4*)(smem + woff + 8192) = ra1;
  *(uint4*)(smem + 16384 + woff) = rb0; *(uint4*)(smem + 16384 + woff + 8192) = rb1;
  __syncthreads();
  const int sw = (r >> 1) & 7;
  const int aoff0 = (wm * 64 + r) * 128, aoff1 = aoff0 + 32 * 128;
  const int boff = 16384 + (wn * 32 + r) * 128;
#pragma unroll 1
  for (int kt = 0; kt < K / 64; ++kt) {
    const char* st = smem + (kt & 1) * 32768;
    if (kt + 1 < K / 64) {
      ra0 = *(const uint4*)(Ag + (kt + 1) * 64); ra1 = *(const uint4*)(Ag + (size_t)64 * K + (kt + 1) * 64);
      rb0 = *(const uint4*)(Bg + (kt + 1) * 64); rb1 = *(const uint4*)(Bg + (size_t)64 * K + (kt + 1) * 64);
    }
#pragma unroll
    for (int s = 0; s < 4; ++s) {
      int co = ((2 * s + h) ^ sw) << 4;
      bf16x8 a0 = *(const bf16x8*)(st + aoff0 + co);
      bf16x8 a1 = *(const bf16x8*)(st + aoff1 + co);
      bf16x8 b = *(const bf16x8*)(st + boff + co);
      acc0 = MFMA32(a0, b, acc0);
      acc1 = MFMA32(a1, b, acc1);
    }
    if (kt + 1 < K / 64) {
      char* sn = smem + ((kt + 1) & 1) * 32768;
      *(uint4*)(sn + woff) = ra0; *(uint4*)(sn + woff + 8192) = ra1;
      *(uint4*)(sn + 16384 + woff) = rb0; *(uint4*)(sn + 16384 + woff + 8192) = rb1;
    }
    __syncthreads();
  }
  float* Cs = (float*)smem;
  constexpr int CS = 132;
#pragma unroll
  for (int i = 0; i < 16; ++i) {
    int row = (i & 3) + 8 * (i >> 2) + 4 * h;
    Cs[(wm * 64 + row) * CS + wn * 32 + r] = acc0[i];
    Cs[(wm * 64 + 32 + row) * CS + wn * 32 + r] = acc1[i];
  }
  __syncthreads();
  if (EPI == 0) {
    for (int i = tid; i < 128 * 16; i += NTHR) {
      int row = i >> 4, c8 = (i & 15) * 8;
      const float* cr = Cs + row * CS + c8;
      float4 v0 = *(const float4*)cr, v1 = *(const float4*)(cr + 4);
      *(uint4*)(Cb + (size_t)(m0 + row) * N + n0 + c8) = make_uint4(pk2bf(v0.x, v0.y), pk2bf(v0.z, v0.w), pk2bf(v1.x, v1.y), pk2bf(v1.z, v1.w));
    }
  } else if (EPI == 2) {
    for (int i = tid; i < 128 * 32; i += NTHR) {
      const int col = i >> 5, r4 = (i & 31) * 4;
      const float4 v = make_float4(Cs[r4 * CS + col], Cs[(r4 + 1) * CS + col], Cs[(r4 + 2) * CS + col], Cs[(r4 + 3) * CS + col]);
      *(float4*)(xs + (size_t)(n0 + col) * N + m0 + r4) = v;
    }
  } else {
    for (int i = tid; i < 128 * 32; i += NTHR) {
      int row = i >> 5, c4 = (i & 31) * 4;
      int rr = m0 + row; int b = rr / NT, p = rr % NT; int mrow = p < CTX ? 2 : b;
      const float* gt = gate_base + mrow * NMOD + n0 + c4;
      float4 v = *(const float4*)(Cs + row * CS + c4);
      const float* rsrc = xin ? (p < CTX ? ctxin + ((size_t)b * CTX + p) * D : xin + ((size_t)b * SEQ + (p - CTX)) * D) : xs + (size_t)rr * D;
      float4 xv = *(const float4*)(rsrc + n0 + c4);
      xv.x += gt[0] * v.x; xv.y += gt[1] * v.y; xv.z += gt[2] * v.z; xv.w += gt[3] * v.w;
      *(float4*)(xs + (size_t)rr * D + n0 + c4) = xv;
    }
  }
}


struct AttnArgs {
  const bf16_t *QA, *KA, *VAt, *QW, *KW, *VWt, *QG, *KG, *VGt;
  const float *g_qk_diff, *g_qk_win, *g_qk_glob, *sink, *lambda_diff, *g_mix_out;
  float lambda_init;
  int pad0;
  bf16_t* A2;
  float* Oslab;
  float* Lslab;
};

DI void store_head_bf16(char* wl, const float (&o)[32], float rs, const float* __restrict__ gm, bf16_t* __restrict__ dst_row0  ,
                        int lane) {
  const int r = lane & 31, h = lane >> 5;
#pragma unroll
  for (int dt = 0; dt < 2; ++dt)
#pragma unroll
    for (int q4 = 0; q4 < 4; ++q4) {
      const int dv = 32 * dt + 8 * q4 + 4 * h;
      const float* ov = o + 16 * dt + 4 * q4;
      *(uint2*)(wl + r * 136 + dv * 2) = make_uint2(pk2bf(ov[0] * rs * gm[dv], ov[1] * rs * gm[dv + 1]), pk2bf(ov[2] * rs * gm[dv + 2], ov[3] * rs * gm[dv + 3]));
    }
  asm volatile("s_waitcnt lgkmcnt(0)" ::: "memory");
#pragma unroll
  for (int ps = 0; ps < 4; ++ps) {
    const int row = ps * 8 + (lane >> 3), ch = lane & 7;
    const uint2 a = *(const uint2*)(wl + row * 136 + ch * 16), c = *(const uint2*)(wl + row * 136 + ch * 16 + 8);
    *(uint4*)(dst_row0 + (size_t)row * D + ch * 8) = make_uint4(a.x, a.y, c.x, c.y);
  }
  asm volatile("s_waitcnt lgkmcnt(0)" ::: "memory");
}
DI void store_head_f32(char* wl, const f32x16& Oa, const f32x16& Ob, float* __restrict__ dst_row0, int lane) {
  const int r = lane & 31, h = lane >> 5;
#pragma unroll
  for (int dt = 0; dt < 2; ++dt)
#pragma unroll
    for (int q4 = 0; q4 < 4; ++q4) {
      const f32x16& O = dt == 0 ? Oa : Ob;
      *(float4*)(wl + r * 272 + (32 * dt + 8 * q4 + 4 * h) * 4) = make_float4(O[4 * q4], O[4 * q4 + 1], O[4 * q4 + 2], O[4 * q4 + 3]);
    }
  asm volatile("s_waitcnt lgkmcnt(0)" ::: "memory");
#pragma unroll
  for (int ps = 0; ps < 8; ++ps) {
    const int row = ps * 4 + (lane >> 4), ch = lane & 15;
    *(float4*)(dst_row0 + (size_t)row * 64 + ch * 4) = *(const float4*)(wl + row * 272 + ch * 16);
  }
  asm volatile("s_waitcnt lgkmcnt(0)" ::: "memory");
}

template <int TYPE>
DI void attn_item(const AttnArgs& a, int b, int g, int p0, int ctx0, int nctx, int lat0, int nkt, int half, char* smem) {
  constexpr int DQK = TYPE == 0 ? 32 : 64;
  constexpr int KS = DQK / 16;
  const int tid = TID, lane = tid & 63, wid = tid >> 6;
  const int r = lane & 31, h = lane >> 5;
  const bf16_t *Q0, *Q1, *K0, *K1, *Vt;
  const float* gqk;
  if (TYPE == 0) {
    Q0 = a.QA + ((size_t)b * 8 + 2 * g) * NT * 32; Q1 = Q0 + (size_t)NT * 32;
    K0 = a.KA + ((size_t)b * 8 + 2 * g) * NT * 32; K1 = K0 + (size_t)NT * 32;
    Vt = a.VAt + ((size_t)b * 4 + g) * 64 * NT; gqk = a.g_qk_diff;
  } else if (TYPE == 1) {
    Q0 = a.QW + ((size_t)b * 4 + 2 * g) * NT * 64; Q1 = Q0 + (size_t)NT * 64;
    K0 = a.KW + ((size_t)b * 2 + g) * NT * 64; K1 = K0;
    Vt = a.VWt + ((size_t)b * 2 + g) * 64 * NT; gqk = a.g_qk_win;
  } else {
    Q0 = a.QG + ((size_t)b * 4 + 2 * g) * NT * 64; Q1 = Q0 + (size_t)NT * 64;
    K0 = a.KG + ((size_t)b * 2 + g) * NT * 64; K1 = K0;
    Vt = a.VGt + ((size_t)b * 2 + g) * 64 * NT; gqk = a.g_qk_glob;
  }
  (void)gqk;
  const int qpos = p0 + wid * 32 + r;
  bf16x8 qf0[KS], qf1[KS];
#pragma unroll
  for (int s = 0; s < KS; ++s) {
    qf0[s] = *(const bf16x8*)(Q0 + (size_t)qpos * DQK + 16 * s + 8 * h);
    qf1[s] = *(const bf16x8*)(Q1 + (size_t)qpos * DQK + 16 * s + 8 * h);
  }
  f32x16 O00, O01, O10, O11, Zero;
#pragma unroll
  for (int i = 0; i < 16; ++i) { O00[i] = 0.f; O01[i] = 0.f; O10[i] = 0.f; O11[i] = 0.f; Zero[i] = 0.f; }
  float l0 = 0.f, l1 = 0.f;

  auto tile_of = [&](int it) { return it < nctx ? ctx0 + it : lat0 + it - nctx; };
  const int wvu = __builtin_amdgcn_readfirstlane(tid >> 6);
#define ATT_GLDS(kt_, sb_)                                                                               \
  {                                                                                                      \
    const int kt__ = (kt_);                                                                              \
    LAS char* sl__ = (LAS char*)(sb_);                                                                   \
    if (TYPE == 0) {                                                                                     \
      const int row = tid >> 2, ch = (tid & 3) ^ ((row >> 2) & 3);                                       \
      __builtin_amdgcn_global_load_lds((const unsigned*)(K0 + (size_t)(kt__ * 128 + row) * 32 + ch * 8), (LAS unsigned*)(sl__ + wvu * 1024), 16, 0, 0);          \
      __builtin_amdgcn_global_load_lds((const unsigned*)(K1 + (size_t)(kt__ * 128 + row) * 32 + ch * 8), (LAS unsigned*)(sl__ + 8192 + wvu * 1024), 16, 0, 0);   \
    } else {                                                                                             \
      _Pragma("unroll") for (int i2 = 0; i2 < 2; ++i2) {                                                 \
        const int lc = tid + 512 * i2; const int row = lc >> 3, ch = (lc & 7) ^ ((row >> 1) & 7);        \
        __builtin_amdgcn_global_load_lds((const unsigned*)(K0 + (size_t)(kt__ * 128 + row) * 64 + ch * 8), (LAS unsigned*)(sl__ + i2 * 8192 + wvu * 1024), 16, 0, 0); \
      }                                                                                                  \
    }                                                                                                    \
    _Pragma("unroll") for (int i2 = 0; i2 < 2; ++i2) {                                                   \
      const int lc = tid + 512 * i2; const int row = lc >> 4, ch = (lc & 15) ^ (row & 15);               \
      __builtin_amdgcn_global_load_lds((const unsigned*)(Vt + (size_t)row * NT + kt__ * 128 + ch * 8), (LAS unsigned*)(sl__ + 16384 + i2 * 8192 + wvu * 1024), 16, 0, 0); \
    }                                                                                                    \
  }
  __syncthreads();
  ATT_GLDS(tile_of(0), smem);
  asm volatile("s_waitcnt vmcnt(0)" ::: "memory");
  __syncthreads();
  const int qwave = p0 + wid * 32;
  const int vbase = r * 256 + ((h ^ (r & 15)) << 4);
#pragma unroll 1
  for (int it = 0; it < nkt; ++it) {
    const int kt = tile_of(it);
    const char* sb = smem + (it & 1) * 32768;
    if (it + 1 < nkt) ATT_GLDS(tile_of(it + 1), smem + ((it + 1) & 1) * 32768);
#pragma unroll 2
    for (int j = 0; j < 4; ++j) {
      const int kbase = kt * 128 + 32 * j;
      bool masked = false;
      if (TYPE == 1) {
        if (kbase >= CTX && p0 >= CTX) {
          if (kbase > qwave + 31 + 128 || kbase + 31 < qwave - 128) continue;
          masked = true;
        }
      }
      f32x16 S0 = Zero, S1 = Zero;
#pragma unroll
      for (int s = 0; s < KS; ++s) {
        if (TYPE == 0) {
          int row = 32 * j + r;
          int off = row * 64 + (((2 * s + h) ^ ((row >> 2) & 3)) << 4);
          bf16x8 k0 = *(const bf16x8*)(sb + off);
          bf16x8 k1 = *(const bf16x8*)(sb + 8192 + off);
          S0 = MFMA32(k0, qf0[s], S0);
          S1 = MFMA32(k1, qf1[s], S1);
        } else {
          int row = 32 * j + r;
          int off = row * 128 + (((2 * s + h) ^ ((row >> 1) & 7)) << 4);
          bf16x8 k0 = *(const bf16x8*)(sb + off);
          S0 = MFMA32(k0, qf0[s], S0);
          S1 = MFMA32(k0, qf1[s], S1);
        }
      }
      float pa[16], pb[16];
#pragma unroll
      for (int i = 0; i < 16; ++i) {
        float e0 = __builtin_amdgcn_exp2f(S0[i]);
        float e1 = __builtin_amdgcn_exp2f(S1[i]);
        if (TYPE == 1) {
          if (masked) {
            int kp = kbase + (i & 3) + 8 * (i >> 2) + 4 * h;
            int dd = kp - qpos;
            bool ok = (dd <= 128) && (dd >= -128);
            e0 = ok ? e0 : 0.f; e1 = ok ? e1 : 0.f;
          }
        }
        pa[i] = e0; pb[i] = e1;
      }
      l0 += ((pa[0] + pa[1]) + (pa[2] + pa[3])) + ((pa[4] + pa[5]) + (pa[6] + pa[7])) + ((pa[8] + pa[9]) + (pa[10] + pa[11])) + ((pa[12] + pa[13]) + (pa[14] + pa[15]));
      l1 += ((pb[0] + pb[1]) + (pb[2] + pb[3])) + ((pb[4] + pb[5]) + (pb[6] + pb[7])) + ((pb[8] + pb[9]) + (pb[10] + pb[11])) + ((pb[12] + pb[13]) + (pb[14] + pb[15]));
      bf16x8 pf0[2], pf1[2];
#pragma unroll
      for (int s2 = 0; s2 < 2; ++s2) {
        unsigned w0[4], w1[4];
#pragma unroll
        for (int e = 0; e < 4; ++e) {
          w0[e] = pk2bf(pa[8 * s2 + 2 * e], pa[8 * s2 + 2 * e + 1]);
          w1[e] = pk2bf(pb[8 * s2 + 2 * e], pb[8 * s2 + 2 * e + 1]);
        }
        pf0[s2] = __builtin_bit_cast(bf16x8, make_uint4(w0[0], w0[1], w0[2], w0[3]));
        pf1[s2] = __builtin_bit_cast(bf16x8, make_uint4(w1[0], w1[1], w1[2], w1[3]));
      }
#pragma unroll
      for (int s2 = 0; s2 < 2; ++s2) {
        const int vo = vbase ^ ((4 * j + 2 * s2) << 4);
        bf16x8 v0 = *(const bf16x8*)(sb + 16384 + vo);
        bf16x8 v1 = *(const bf16x8*)(sb + 16384 + 8192 + vo);
        O00 = MFMA32(v0, pf0[s2], O00);
        O01 = MFMA32(v1, pf0[s2], O01);
        O10 = MFMA32(v0, pf1[s2], O10);
        O11 = MFMA32(v1, pf1[s2], O11);
      }
    }
    asm volatile("s_waitcnt vmcnt(0)" ::: "memory");
    __syncthreads();
  }
  l0 += shxl(l0, lane, 32);
  l1 += shxl(l1, lane, 32);
  if (TYPE == 1) {
    l0 += __builtin_amdgcn_exp2f(a.sink[2 * g] * LOG2E);
    l1 += __builtin_amdgcn_exp2f(a.sink[2 * g + 1] * LOG2E);
  }
  const size_t orow0 = (size_t)b * NT + p0 + wid * 32;
  char* wl = smem + wid * 8704;
  if (TYPE == 2) {
#pragma unroll
    for (int x = 0; x < 2; ++x) {
      int head = 2 * g + x;
      float* dst0 = a.Oslab + ((((size_t)half * NB + b) * 4 + head) * NT + (p0 + wid * 32)) * 64;
      if (x == 0) store_head_f32(wl, O00, O01, dst0, lane); else store_head_f32(wl, O10, O11, dst0, lane);
      if (h == 0) a.Lslab[(((size_t)half * NB + b) * 4 + head) * NT + qpos] = x == 0 ? l0 : l1;
    }
  } else if (TYPE == 0) {
    float s0 = 0.f, s1 = 0.f;
    for (int d = 0; d < 32; ++d) { s0 += a.lambda_diff[d] * a.lambda_diff[32 + d]; s1 += a.lambda_diff[64 + d] * a.lambda_diff[96 + d]; }
    const float lam = __expf(s0) - __expf(s1) + a.lambda_init;
    const float i0 = 1.f / l0, i1 = lam / l1;
    float o[32];
    float ss = 0.f;
#pragma unroll
    for (int i = 0; i < 16; ++i) {
      o[i] = O00[i] * i0 - O10[i] * i1;
      o[16 + i] = O01[i] * i0 - O11[i] * i1;
      ss += o[i] * o[i] + o[16 + i] * o[16 + i];
    }
    ss += shxl(ss, lane, 32);
    const float rs = rsqrtf(ss * (1.f / 64) + EPS) * (1.f - a.lambda_init);
    const float* gm = a.g_mix_out + g * 64;
    store_head_bf16(wl, o, rs, gm, a.A2 + orow0 * D + g * 64, lane);
  } else {
#pragma unroll
    for (int x = 0; x < 2; ++x) {
      const float inv = 1.f / (x == 0 ? l0 : l1);
      float o[32];
      float ss = 0.f;
#pragma unroll
      for (int i = 0; i < 16; ++i) {
        o[i] = (x == 0 ? O00[i] : O10[i]) * inv;
        o[16 + i] = (x == 0 ? O01[i] : O11[i]) * inv;
        ss += o[i] * o[i] + o[16 + i] * o[16 + i];
      }
      ss += shxl(ss, lane, 32);
      const float rs = rsqrtf(ss * (1.f / 64) + EPS);
      const int col0 = 256 + (2 * g + x) * 64;
      const float* gm = a.g_mix_out + col0;
      store_head_bf16(wl, o, rs, gm, a.A2 + orow0 * D + col0, lane);
    }
  }
}

DI void attn_dispatch(const AttnArgs& a, int idx, int want_ctx, char* smem) {
  if (idx < 256) {
    int b = idx >> 7, g = (idx >> 5) & 3, qt = 1 + (idx & 31);
    attn_item<0>(a, b, g, qt * 256, 0, 2, 2, 66, 0, smem);
  } else if (idx < 512) {
    int i = idx - 256; int half = i >> 7, b = (i >> 6) & 1, g = (i >> 5) & 1, qt = 1 + (i & 31);
    if (half == 0) attn_item<2>(a, b, g, qt * 256, 0, 2, 2, 33, 0, smem);
    else attn_item<2>(a, b, g, qt * 256, 0, 0, 33, 33, 1, smem);
  } else if (idx < 640) {
    int i = idx - 512; int b = i >> 6, g = (i >> 5) & 1, qt = 1 + (i & 31);
    int lo = max(2, 2 * qt - 1), hi = min(65, 2 * qt + 2);
    attn_item<1>(a, b, g, qt * 256, 0, 2, lo, 2 + (hi - lo + 1), 0, smem);
  } else if (want_ctx) {
    int i = idx - 640;
    if (i < 8) attn_item<0>(a, i >> 2, i & 3, 0, 0, 2, 0, 2, 0, smem);
    else if (i < 16) { int k = i - 8; int half = k >> 2, b = (k >> 1) & 1, g = k & 1; attn_item<2>(a, b, g, 0, half, 1, 0, 1, half, smem); }
    else if (i < 20) { int k = i - 16; attn_item<1>(a, k >> 1, k & 1, 0, 0, 2, 0, 2, 0, smem); }
  }
}

typedef __attribute__((ext_vector_type(4))) float f32x4v;
typedef __attribute__((ext_vector_type(2))) _Float16 h2_t;
DI unsigned pack_i8x4(float a, float b, float c, float d) {
  const int ia = (int)__builtin_rintf(a), ib = (int)__builtin_rintf(b), ic = (int)__builtin_rintf(c), id = (int)__builtin_rintf(d);
  return (unsigned)(ia & 255) | ((unsigned)(ib & 255) << 8) | ((unsigned)(ic & 255) << 16) | ((unsigned)id << 24);
}
constexpr size_t TSLICE = (size_t)16384 * 128;
DI void tabconv_fin_i8(float4 v0, float4 v1, float4 v2, float4 v3, unsigned char* __restrict__ dst, float* __restrict__ scale, size_t row, int lane) {
  float m = fmaxf(fmaxf(fmaxf(fabsf(v0.x), fabsf(v0.y)), fmaxf(fabsf(v0.z), fabsf(v0.w))), fmaxf(fmaxf(fabsf(v1.x), fabsf(v1.y)), fmaxf(fabsf(v1.z), fabsf(v1.w))));
  m = fmaxf(m, fmaxf(fmaxf(fmaxf(fabsf(v2.x), fabsf(v2.y)), fmaxf(fabsf(v2.z), fabsf(v2.w))), fmaxf(fmaxf(fabsf(v3.x), fabsf(v3.y)), fmaxf(fabsf(v3.z), fabsf(v3.w)))));
  for (int o = 32; o > 0; o >>= 1) m = fmaxf(m, shxl(m, lane, o));
  m = fmaxf(m, 1e-30f);
  const float sc = m * (1.f / 127.f), inv = 127.f / m;
  *(uint4*)(dst + (size_t)(lane >> 3) * TSLICE + row * 128 + (lane & 7) * 16) = make_uint4(pack_i8x4(v0.x * inv, v0.y * inv, v0.z * inv, v0.w * inv), pack_i8x4(v1.x * inv, v1.y * inv, v1.z * inv, v1.w * inv),
                                                    pack_i8x4(v2.x * inv, v2.y * inv, v2.z * inv, v2.w * inv), pack_i8x4(v3.x * inv, v3.y * inv, v3.z * inv, v3.w * inv));
  if (lane == 0) scale[row] = sc;
}
DI void tabconv_fin(float4 v0, float4 v1, float4 v2, float4 v3, unsigned char* __restrict__ dst, float* __restrict__ scale, size_t row, int lane) {
  float m = fmaxf(fmaxf(fmaxf(fabsf(v0.x), fabsf(v0.y)), fmaxf(fabsf(v0.z), fabsf(v0.w))), fmaxf(fmaxf(fabsf(v1.x), fabsf(v1.y)), fmaxf(fabsf(v1.z), fabsf(v1.w))));
  m = fmaxf(m, fmaxf(fmaxf(fmaxf(fabsf(v2.x), fabsf(v2.y)), fmaxf(fabsf(v2.z), fabsf(v2.w))), fmaxf(fmaxf(fabsf(v3.x), fabsf(v3.y)), fmaxf(fabsf(v3.z), fabsf(v3.w)))));
  for (int o = 32; o > 0; o >>= 1) m = fmaxf(m, shxl(m, lane, o));
  m = fmaxf(m, 1e-30f);
  const float sc = m * (1.f / 448.f), inv = 448.f / m;
  int w0 = __builtin_amdgcn_cvt_pk_fp8_f32(v0.x * inv, v0.y * inv, 0, false); w0 = __builtin_amdgcn_cvt_pk_fp8_f32(v0.z * inv, v0.w * inv, w0, true);
  int w1 = __builtin_amdgcn_cvt_pk_fp8_f32(v1.x * inv, v1.y * inv, 0, false); w1 = __builtin_amdgcn_cvt_pk_fp8_f32(v1.z * inv, v1.w * inv, w1, true);
  int w2 = __builtin_amdgcn_cvt_pk_fp8_f32(v2.x * inv, v2.y * inv, 0, false); w2 = __builtin_amdgcn_cvt_pk_fp8_f32(v2.z * inv, v2.w * inv, w2, true);
  int w3 = __builtin_amdgcn_cvt_pk_fp8_f32(v3.x * inv, v3.y * inv, 0, false); w3 = __builtin_amdgcn_cvt_pk_fp8_f32(v3.z * inv, v3.w * inv, w3, true);
  *(uint4*)(dst + (size_t)(lane >> 3) * TSLICE + row * 128 + (lane & 7) * 16) = make_uint4((unsigned)w0, (unsigned)w1, (unsigned)w2, (unsigned)w3);
  if (lane == 0) scale[row] = sc;
}
DI void score_sort(const bf16_t* __restrict__ qbuf, const bf16_t* __restrict__ keysb, int m0, int hp, char* smem, unsigned (&v16)[16]) {
  const int tid = TID, lane = tid & 63, wid = tid >> 6;
  const int wm = wid & 1, wn = wid >> 1;
  const int r = lane & 31, h = lane >> 5;
  f32x16 acc0, acc1;
  for (int i = 0; i < 16; ++i) { acc0[i] = 0.f; acc1[i] = 0.f; }
  const int lrow = tid >> 3, lch = tid & 7;
  const bf16_t* Ag = qbuf + (size_t)(m0 + lrow) * 2048 + hp * 128 + lch * 8;
  const bf16_t* Bg = keysb + ((size_t)hp * 128 + lrow) * 128 + lch * 8;
  const int woff = lrow * 128 + ((lch ^ ((lrow >> 1) & 7)) << 4);
  __syncthreads();
#pragma unroll
  for (int kt = 0; kt < 2; ++kt) {
    char* sn = smem + kt * 32768;
    *(uint4*)(sn + woff) = *(const uint4*)(Ag + kt * 64);
    *(uint4*)(sn + woff + 8192) = *(const uint4*)(Ag + (size_t)64 * 2048 + kt * 64);
    *(uint4*)(sn + 16384 + woff) = *(const uint4*)(Bg + kt * 64);
    *(uint4*)(sn + 16384 + woff + 8192) = *(const uint4*)(Bg + 64 * 128 + kt * 64);
  }
  __syncthreads();
  const int sw = (r >> 1) & 7;
  const int aoff0 = (wm * 64 + r) * 128, aoff1 = aoff0 + 32 * 128;
  const int boff = 16384 + (wn * 32 + r) * 128;
#pragma unroll
  for (int kt = 0; kt < 2; ++kt) {
    const char* st = smem + kt * 32768;
#pragma unroll
    for (int s = 0; s < 4; ++s) {
      int co = ((2 * s + h) ^ sw) << 4;
      bf16x8 a0 = *(const bf16x8*)(st + aoff0 + co);
      bf16x8 a1 = *(const bf16x8*)(st + aoff1 + co);
      bf16x8 b = *(const bf16x8*)(st + boff + co);
      acc0 = MFMA32(a0, b, acc0);
      acc1 = MFMA32(a1, b, acc1);
    }
  }
  __syncthreads();
  float* Cs = (float*)smem;
  constexpr int CS = 132;
#pragma unroll
  for (int i = 0; i < 16; ++i) {
    int row = (i & 3) + 8 * (i >> 2) + 4 * h;
    Cs[(wm * 64 + row) * CS + wn * 32 + r] = acc0[i];
    Cs[(wm * 64 + 32 + row) * CS + wn * 32 + r] = acc1[i];
  }
  __syncthreads();
  const int row = tid >> 2, q = tid & 3;
  unsigned v[32];
#pragma unroll
  for (int i = 0; i < 32; ++i) {
    unsigned u = __float_as_uint(Cs[row * CS + 4 * i + q]);
    u ^= (u & 0x80000000u) ? 0xffffffffu : 0x80000000u;
    v[i] = (u & ~127u) | (unsigned)(127 - (4 * i + q));
  }
#pragma unroll
  for (int k = 2; k <= 32; k <<= 1)
#pragma unroll
    for (int j = k >> 1; j > 0; j >>= 1)
#pragma unroll
      for (int i = 0; i < 32; ++i) {
        const int l = i ^ j;
        if (l > i) {
          const unsigned lo = min(v[i], v[l]), hi = max(v[i], v[l]);
          if ((i & k) == 0) { v[i] = hi; v[l] = lo; } else { v[i] = lo; v[l] = hi; }
        }
      }
#pragma unroll
  for (int step = 0; step < 2; ++step) {
    unsigned c[16];
#pragma unroll
    for (int i = 0; i < 16; ++i) {
      const unsigned o = step == 0 ? (unsigned)__builtin_amdgcn_mov_dpp((int)v[15 - i], 0xB1, 0xf, 0xf, false)
                                   : (unsigned)__builtin_amdgcn_mov_dpp((int)v[15 - i], 0x4E, 0xf, 0xf, false);
      c[i] = max(v[i], o);
    }
#pragma unroll
    for (int j = 8; j > 0; j >>= 1)
#pragma unroll
      for (int i = 0; i < 16; ++i) {
        const int l = i ^ j;
        if (l > i) { const unsigned lo = min(c[i], c[l]), hi = max(c[i], c[l]); c[i] = hi; c[l] = lo; }
      }
#pragma unroll
    for (int i = 0; i < 16; ++i) v[i] = c[i];
  }
#pragma unroll
  for (int i = 0; i < 16; ++i) v16[i] = v[i];
}
constexpr int CAND_I[52] = {0, 0, 0, 0, 0, 0, 0, 0, 0, 0, 0, 0, 0, 0, 0, 0, 1, 1, 1, 1, 1, 1, 1, 1, 2, 2, 2, 2, 2, 3, 3, 3, 3, 4, 4, 4, 5, 5, 6, 6, 7, 7, 8, 9, 10, 11, 12, 13, 14, 15, 0, 0};
constexpr int CAND_J[52] = {0, 1, 2, 3, 4, 5, 6, 7, 8, 9, 10, 11, 12, 13, 14, 15, 0, 1, 2, 3, 4, 5, 6, 7, 0, 1, 2, 3, 4, 0, 1, 2, 3, 0, 1, 2, 0, 1, 0, 1, 0, 1, 0, 0, 0, 0, 0, 0, 0, 0, 0, 0};
DI float sel4(int q, float a, float b, float c, float d) { return q == 0 ? a : q == 1 ? b : q == 2 ? c : d; }
DI unsigned sel4u(int q, unsigned a, unsigned b, unsigned c, unsigned d) { return q == 0 ? a : q == 1 ? b : q == 2 ? c : d; }
DI float key7f(unsigned k) { k &= ~127u; k ^= (k & 0x80000000u) ? 0x80000000u : 0xffffffffu; return __uint_as_float(k); }
DI float key8f(unsigned k) { k &= ~255u; k ^= (k & 0x80000000u) ? 0x80000000u : 0xffffffffu; return __uint_as_float(k); }
DI void score_head_item(const bf16_t* __restrict__ qbuf, const bf16_t* __restrict__ keysb, int m0, int hd, char* smem, int* __restrict__ experts,
                        float* __restrict__ gates) {
  unsigned ka[16], kb[16];
  score_sort(qbuf, keysb, m0, 2 * hd, smem, ka);
  score_sort(qbuf, keysb, m0, 2 * hd + 1, smem, kb);
  const int tid = TID, row = tid >> 2, q = tid & 3;
  unsigned char* ix = (unsigned char*)(smem + 69632) + row * 32;
  *(unsigned*)(ix + 4 * q) = (sel4u(q, ka[0], ka[4], ka[8], ka[12]) & 127u) | ((sel4u(q, ka[1], ka[5], ka[9], ka[13]) & 127u) << 8) |
                             ((sel4u(q, ka[2], ka[6], ka[10], ka[14]) & 127u) << 16) | ((sel4u(q, ka[3], ka[7], ka[11], ka[15]) & 127u) << 24);
  *(unsigned*)(ix + 16 + 4 * q) = (sel4u(q, kb[0], kb[4], kb[8], kb[12]) & 127u) | ((sel4u(q, kb[1], kb[5], kb[9], kb[13]) & 127u) << 8) |
                                  ((sel4u(q, kb[2], kb[6], kb[10], kb[14]) & 127u) << 16) | ((sel4u(q, kb[3], kb[7], kb[11], kb[15]) & 127u) << 24);
  float a[16], b[16];
#pragma unroll
  for (int i = 0; i < 16; ++i) { a[i] = key7f(ka[i]); b[i] = key7f(kb[i]); }
  unsigned c[16];
#pragma unroll
  for (int t = 0; t < 16; ++t) {
    if (4 * t >= 52) { c[t] = 0u; continue; }
    const float sv = sel4(q, a[CAND_I[4 * t]], a[CAND_I[4 * t + 1]], a[CAND_I[4 * t + 2]], a[CAND_I[4 * t + 3]]) +
                     sel4(q, b[CAND_J[4 * t]], b[CAND_J[4 * t + 1]], b[CAND_J[4 * t + 2]], b[CAND_J[4 * t + 3]]);
    const unsigned code = sel4u(q, CAND_I[4 * t] * 16 + CAND_J[4 * t], CAND_I[4 * t + 1] * 16 + CAND_J[4 * t + 1], CAND_I[4 * t + 2] * 16 + CAND_J[4 * t + 2],
                                CAND_I[4 * t + 3] * 16 + CAND_J[4 * t + 3]);
    unsigned u = __float_as_uint(sv);
    u ^= (u & 0x80000000u) ? 0xffffffffu : 0x80000000u;
    const bool valid = (4 * t + q) < 50;
    c[t] = valid ? ((u & ~255u) | code) : 0u;
  }
#pragma unroll
  for (int k = 2; k <= 16; k <<= 1)
#pragma unroll
    for (int j = k >> 1; j > 0; j >>= 1)
#pragma unroll
      for (int i = 0; i < 16; ++i) {
        const int l = i ^ j;
        if (l > i) {
          const unsigned lo = min(c[i], c[l]), hi = max(c[i], c[l]);
          if ((i & k) == 0) { c[i] = hi; c[l] = lo; } else { c[i] = lo; c[l] = hi; }
        }
      }
#pragma unroll
  for (int step = 0; step < 2; ++step) {
    unsigned d[16];
#pragma unroll
    for (int i = 0; i < 16; ++i) {
      const unsigned o = step == 0 ? (unsigned)__builtin_amdgcn_mov_dpp((int)c[15 - i], 0xB1, 0xf, 0xf, false)
                                   : (unsigned)__builtin_amdgcn_mov_dpp((int)c[15 - i], 0x4E, 0xf, 0xf, false);
      d[i] = max(c[i], o);
    }
#pragma unroll
    for (int j = 8; j > 0; j >>= 1)
#pragma unroll
      for (int i = 0; i < 16; ++i) {
        const int l = i ^ j;
        if (l > i) { const unsigned lo = min(d[i], d[l]), hi = max(d[i], d[l]); d[i] = hi; d[l] = lo; }
      }
#pragma unroll
    for (int i = 0; i < 16; ++i) c[i] = d[i];
  }
  const float mx = key8f(c[0]);
  float e[16]; float sum = 0.f;
#pragma unroll
  for (int i = 0; i < 16; ++i) { e[i] = __expf(key8f(c[i]) - mx); sum += e[i]; }
  const float inv = 1.f / sum;
  asm volatile("s_waitcnt lgkmcnt(0)" ::: "memory");
  int eo[4]; float go[4];
#pragma unroll
  for (int k = 0; k < 4; ++k) {
    const unsigned code = sel4u(q, c[k], c[4 + k], c[8 + k], c[12 + k]) & 255u;
    go[k] = sel4(q, e[k], e[4 + k], e[8 + k], e[12 + k]) * inv;
    eo[k] = (127 - (int)ix[code >> 4]) * 128 + (127 - (int)ix[16 + (code & 15)]);
  }
  const size_t o = (size_t)(m0 + row) * 128 + hd * 16 + 4 * q;
  *(uint2*)((unsigned short*)experts + o) = make_uint2((unsigned)eo[0] | ((unsigned)eo[1] << 16), (unsigned)eo[2] | ((unsigned)eo[3] << 16));
  *(float4*)(gates + o) = make_float4(go[0], go[1], go[2], go[3]);
}

DI float key2f(unsigned k) { k &= ~127u; k ^= (k & 0x80000000u) ? 0x80000000u : 0xffffffffu; return __uint_as_float(k); }
DI void merge_one(const unsigned* __restrict__ topk, int r, int hd, int* experts, float* gates) {
  const unsigned* ka = topk + ((size_t)r * 16 + 2 * hd) * 16;
  const unsigned* kb = ka + 16;
  float a[16], bq[16];
#pragma unroll
  for (int i = 0; i < 4; ++i) {
    uint4 x = ((const uint4*)ka)[i], y = ((const uint4*)kb)[i];
    a[4 * i] = key2f(x.x); a[4 * i + 1] = key2f(x.y); a[4 * i + 2] = key2f(x.z); a[4 * i + 3] = key2f(x.w);
    bq[4 * i] = key2f(y.x); bq[4 * i + 1] = key2f(y.y); bq[4 * i + 2] = key2f(y.z); bq[4 * i + 3] = key2f(y.w);
  }
  float cv[50];
  {
    int n = 0;
#pragma unroll
    for (int i = 0; i < 16; ++i)
#pragma unroll
      for (int j = 0; j < 16; ++j)
        if ((i + 1) * (j + 1) <= 16) { cv[n] = a[i] + bq[j]; ++n; }
  }
  int* eo = experts + hd * 16;
  float* go = gates + hd * 16;
  float mx = 0.f, sum = 0.f;
#pragma unroll 1
  for (int k = 0; k < 16; ++k) {
    float mval = cv[0]; int code = 0;
    {
      int n = 0;
#pragma unroll
      for (int i = 0; i < 16; ++i)
#pragma unroll
        for (int j = 0; j < 16; ++j)
          if ((i + 1) * (j + 1) <= 16) {
            if (n > 0) { bool gt = cv[n] > mval; mval = gt ? cv[n] : mval; code = gt ? (i * 16 + j) : code; }
            ++n;
          }
    }
    {
      int n = 0;
#pragma unroll
      for (int i = 0; i < 16; ++i)
#pragma unroll
        for (int j = 0; j < 16; ++j)
          if ((i + 1) * (j + 1) <= 16) { cv[n] = (code == i * 16 + j) ? -3.0e38f : cv[n]; ++n; }
    }
    if (k == 0) mx = mval;
    const float e = __expf(mval - mx);
    sum += e;
    eo[k] = (int)(127u - (ka[code >> 4] & 127u)) * 128 + (int)(127u - (kb[code & 15] & 127u));
    go[k] = e;
  }
  const float inv = 1.f / sum;
#pragma unroll
  for (int i = 0; i < 4; ++i) {
    float4 g4 = ((float4*)go)[i];
    g4.x *= inv; g4.y *= inv; g4.z *= inv; g4.w *= inv;
    ((float4*)go)[i] = g4;
  }
}

template <int MODE>
DI void peer_token(int r, const bf16_t* __restrict__ hbuf, const int* ex_row, const float* g_row,
                   const unsigned char* __restrict__ u8, const float* __restrict__ us, const unsigned char* __restrict__ v8,
                   const float* __restrict__ vs, const float* __restrict__ modv_l, float* __restrict__ xs, float* wdots  ,
                   float* __restrict__ outp, int* __restrict__ ex_out, float* __restrict__ w_out) {
  const int lane = TID & 63;
  float x[16];
  {
    const uint2* hr = (const uint2*)(hbuf + (size_t)r * D + lane * 4);
#pragma unroll
    for (int c = 0; c < 4; ++c) { const uint2 a = hr[64 * c]; x[4 * c] = bflo(a.x); x[4 * c + 1] = bfhi(a.x); x[4 * c + 2] = bflo(a.y); x[4 * c + 3] = bfhi(a.y); }
  }
  const int e0 = ex_row[lane], e1 = ex_row[64 + lane];
  const float g0 = g_row[lane], g1 = g_row[64 + lane];
  const float us0 = us[e0], us1 = us[e1], vs0 = vs[e0], vs1 = vs[e1];
#define PEER_LOAD8(rw_, tab_, k0_)                                                          \
  {                                                                                         \
    _Pragma("unroll") for (int j = 0; j < 8; ++j) {                                         \
      int e = __builtin_amdgcn_readlane((k0_) < 64 ? e0 : e1, ((k0_) + j) & 63);            \
      rw_[j] = *(const uint4*)((tab_) + (size_t)e * D + lane * 16);                         \
    }                                                                                       \
  }
#define PEER_UDOT8(rw_, k0_)                                                                \
  {                                                                                         \
    float p[8];                                                                             \
    _Pragma("unroll") for (int j = 0; j < 8; ++j) {                                         \
      f32x2_t a0 = __builtin_amdgcn_cvt_pk_f32_fp8((int)rw_[j].x, false), a1 = __builtin_amdgcn_cvt_pk_f32_fp8((int)rw_[j].x, true); \
      f32x2_t b0 = __builtin_amdgcn_cvt_pk_f32_fp8((int)rw_[j].y, false), b1 = __builtin_amdgcn_cvt_pk_f32_fp8((int)rw_[j].y, true); \
      f32x2_t c0 = __builtin_amdgcn_cvt_pk_f32_fp8((int)rw_[j].z, false), c1 = __builtin_amdgcn_cvt_pk_f32_fp8((int)rw_[j].z, true); \
      f32x2_t d0 = __builtin_amdgcn_cvt_pk_f32_fp8((int)rw_[j].w, false), d1 = __builtin_amdgcn_cvt_pk_f32_fp8((int)rw_[j].w, true); \
      float s = a0[0] * x[0] + a0[1] * x[1] + a1[0] * x[2] + a1[1] * x[3];                  \
      s += b0[0] * x[4] + b0[1] * x[5] + b1[0] * x[6] + b1[1] * x[7];                       \
      s += c0[0] * x[8] + c0[1] * x[9] + c1[0] * x[10] + c1[1] * x[11];                     \
      s += d0[0] * x[12] + d0[1] * x[13] + d1[0] * x[14] + d1[1] * x[15];                   \
      p[j] = s;                                                                             \
    }                                                                                       \
    float q4[4];                                                                            \
    _Pragma("unroll") for (int i = 0; i < 4; ++i) { float send = hi32 ? p[i] : p[4 + i]; float keep = hi32 ? p[4 + i] : p[i]; q4[i] = keep + shxl(send, lane, 32); } \
    float q2[2];                                                                            \
    _Pragma("unroll") for (int i = 0; i < 2; ++i) { float send = hi16 ? q4[i] : q4[2 + i]; float keep = hi16 ? q4[2 + i] : q4[i]; q2[i] = keep + shxl(send, lane, 16); } \
    float q1;                                                                               \
    { float send = hi8 ? q2[0] : q2[1]; float keep = hi8 ? q2[1] : q2[0]; q1 = keep + shxl(send, lane, 8); } \
    q1 += shxl(q1, lane, 4); q1 += shxl(q1, lane, 2); q1 += shxl(q1, lane, 1);              \
    if ((lane & 7) == 0) wdots[(k0_) + (lane >> 3)] = q1;                                   \
  }
#define PEER_VACC8(rw_, k0_)                                                                \
  {                                                                                         \
    _Pragma("unroll") for (int j = 0; j < 8; ++j) {                                         \
      float w = __builtin_bit_cast(float, __builtin_amdgcn_readlane(__builtin_bit_cast(int, (k0_) < 64 ? w0 : w1), ((k0_) + j) & 63)); \
      f32x2_t a0 = __builtin_amdgcn_cvt_pk_f32_fp8((int)rw_[j].x, false), a1 = __builtin_amdgcn_cvt_pk_f32_fp8((int)rw_[j].x, true); \
      f32x2_t b0 = __builtin_amdgcn_cvt_pk_f32_fp8((int)rw_[j].y, false), b1 = __builtin_amdgcn_cvt_pk_f32_fp8((int)rw_[j].y, true); \
      f32x2_t c0 = __builtin_amdgcn_cvt_pk_f32_fp8((int)rw_[j].z, false), c1 = __builtin_amdgcn_cvt_pk_f32_fp8((int)rw_[j].z, true); \
      f32x2_t d0 = __builtin_amdgcn_cvt_pk_f32_fp8((int)rw_[j].w, false), d1 = __builtin_amdgcn_cvt_pk_f32_fp8((int)rw_[j].w, true); \
      acc[0] += w * a0[0]; acc[1] += w * a0[1]; acc[2] += w * a1[0]; acc[3] += w * a1[1];   \
      acc[4] += w * b0[0]; acc[5] += w * b0[1]; acc[6] += w * b1[0]; acc[7] += w * b1[1];   \
      acc[8] += w * c0[0]; acc[9] += w * c0[1]; acc[10] += w * c1[0]; acc[11] += w * c1[1]; \
      acc[12] += w * d0[0]; acc[13] += w * d0[1]; acc[14] += w * d1[0]; acc[15] += w * d1[1]; \
    }                                                                                       \
  }
  const bool hi32 = lane & 32, hi16 = lane & 16, hi8 = lane & 8;
  uint4 rwA[8], rwB[8];
  PEER_LOAD8(rwA, u8, 0);
#pragma unroll 1
  for (int k0 = 0; k0 < 128; k0 += 16) {
    PEER_LOAD8(rwB, u8, k0 + 8);
    PEER_UDOT8(rwA, k0);
    if (k0 + 16 < 128) { PEER_LOAD8(rwA, u8, k0 + 16); } else if (MODE == 0) { PEER_LOAD8(rwA, v8, 0); }
    PEER_UDOT8(rwB, k0 + 8);
  }
  float w0, w1;
  {
    float d0 = wdots[lane] * us0, d1 = wdots[64 + lane] * us1;
    float t0 = 0.5f * d0 * (1.f + tanhf(0.7978845608028654f * (d0 + 0.044715f * d0 * d0 * d0)));
    float t1 = 0.5f * d1 * (1.f + tanhf(0.7978845608028654f * (d1 + 0.044715f * d1 * d1 * d1)));
    w0 = g0 * t0 * vs0; w1 = g1 * t1 * vs1;
  }
  if (MODE == 1) {
    ex_out[(size_t)r * 128 + lane] = e0; ex_out[(size_t)r * 128 + 64 + lane] = e1;
    w_out[(size_t)r * 128 + lane] = w0; w_out[(size_t)r * 128 + 64 + lane] = w1;
    return;
  }
  float acc[16];
#pragma unroll
  for (int i = 0; i < 16; ++i) acc[i] = 0.f;
#pragma unroll 1
  for (int k0 = 0; k0 < 128; k0 += 16) {
    PEER_LOAD8(rwB, v8, k0 + 8);
    PEER_VACC8(rwA, k0);
    if (k0 + 16 < 128) PEER_LOAD8(rwA, v8, k0 + 16);
    PEER_VACC8(rwB, k0 + 8);
  }
  const int b = r / NT, p = r % NT; const int mrow = p < CTX ? 2 : b;
  const float* g2 = modv_l + mrow * NMOD + 5 * D + lane * 4;
  float4* xp = (float4*)(xs + (size_t)r * D + lane * 4);
  float4* op = outp ? (float4*)(outp + ((size_t)b * SEQ + (p - CTX)) * D + lane * 4) : xp;
#pragma unroll
  for (int i = 0; i < 4; ++i) {
    float4 xv = xp[64 * i]; float4 gg = ((const float4*)g2)[64 * i];
    xv.x += gg.x * acc[4 * i]; xv.y += gg.y * acc[4 * i + 1]; xv.z += gg.z * acc[4 * i + 2]; xv.w += gg.w * acc[4 * i + 3];
    op[64 * i] = xv;
  }
}

constexpr int FN = 2 * SEQ;
DI float2 cmul(float2 a, float2 b) { return make_float2(a.x * b.x - a.y * b.y, a.x * b.y + a.y * b.x); }
DI float2 cmulc(float2 a, float2 b) { return make_float2(a.x * b.x + a.y * b.y, a.y * b.x - a.x * b.y); }
DI int PX(int i) { return i + ((i >> 6) << 2); }
constexpr int FNP = FN + (FN >> 6) * 4;
DI int freq_of_pos(int pos) { return ((pos >> 10) & 15) | (((pos >> 6) & 15) << 4) | (((pos >> 2) & 15) << 8) | ((pos & 3) << 12); }
DI int pos_of_freq(int f) { return ((f & 15) << 10) | (((f >> 4) & 15) << 6) | (((f >> 8) & 15) << 2) | (f >> 12); }
DI float2 cadd(float2 a, float2 b) { return make_float2(a.x + b.x, a.y + b.y); }
DI float2 csub(float2 a, float2 b) { return make_float2(a.x - b.x, a.y - b.y); }
DI float2 cmni(float2 a) { return make_float2(a.y, -a.x); }
DI float2 cconj(float2 a) { return make_float2(a.x, -a.y); }
DI void dft16(float2 (&x)[16]) {
  constexpr float C1 = 0.9238795325112867f, S1 = 0.3826834323650898f, C2 = 0.7071067811865476f;
  float2 u[16];
#pragma unroll
  for (int r = 0; r < 4; ++r) {
    const float2 a = x[r], b = x[r + 4], c = x[r + 8], d = x[r + 12];
    const float2 t0 = cadd(a, c), t1 = csub(a, c), t2 = cadd(b, d), t3 = cmni(csub(b, d));
    const float2 y0 = cadd(t0, t2), y1 = cadd(t1, t3), y2 = csub(t0, t2), y3 = csub(t1, t3);
    u[4 * r] = y0;
    if (r == 0) { u[1] = y1; u[2] = y2; u[3] = y3; }
    else if (r == 1) { u[5] = cmul(y1, make_float2(C1, -S1)); u[6] = cmul(y2, make_float2(C2, -C2)); u[7] = cmul(y3, make_float2(S1, -C1)); }
    else if (r == 2) { u[9] = cmul(y1, make_float2(C2, -C2)); u[10] = cmni(y2); u[11] = cmul(y3, make_float2(-C2, -C2)); }
    else { u[13] = cmul(y1, make_float2(S1, -C1)); u[14] = cmul(y2, make_float2(-C2, -C2)); u[15] = cmul(y3, make_float2(-C1, S1)); }
  }
#pragma unroll
  for (int sdx = 0; sdx < 4; ++sdx) {
    const float2 a = u[sdx], b = u[4 + sdx], c = u[8 + sdx], d = u[12 + sdx];
    const float2 t0 = cadd(a, c), t1 = csub(a, c), t2 = cadd(b, d), t3 = cmni(csub(b, d));
    x[4 * sdx] = cadd(t0, t2); x[4 * sdx + 1] = cadd(t1, t3); x[4 * sdx + 2] = csub(t0, t2); x[4 * sdx + 3] = csub(t1, t3);
  }
}
template <int LQ, bool INV>
DI void fft_pass16(float2* X, int tid) {
  constexpr int q = 1 << LQ;
  constexpr float invL = 1.f / (float)(16 << LQ);
#pragma unroll 1
  for (int bf = 0; bf < 2; ++bf) {
    const int i = tid + 512 * bf;
    const int j = i & (q - 1); const int base = ((i >> LQ) << (LQ + 4)) + j;
    const float fr = (float)j * invL;
    const float2 w1 = make_float2(__builtin_amdgcn_cosf(fr), -__builtin_amdgcn_sinf(fr));
    float2 x[16];
    if (!INV) {
#pragma unroll
      for (int mm = 0; mm < 16; ++mm) x[mm] = X[PX(base + mm * q)];
      dft16(x);
      float2 w = w1;
      X[PX(base)] = x[0];
#pragma unroll
      for (int k = 1; k < 16; ++k) {
        const int p = 4 * (k & 3) + (k >> 2);
        X[PX(base + k * q)] = cmul(x[p], w);
        w = cmul(w, w1);
      }
    } else {
      float2 w = w1;
      x[0] = cconj(X[PX(base)]);
#pragma unroll
      for (int k = 1; k < 16; ++k) {
        x[k] = cmul(cconj(X[PX(base + k * q)]), w);
        w = cmul(w, w1);
      }
      dft16(x);
#pragma unroll
      for (int p = 0; p < 16; ++p) {
        const int mm = (p >> 2) + 4 * (p & 3);
        X[PX(base + mm * q)] = cconj(x[p]);
      }
    }
  }
}
template <bool INV>
DI void fft_pass4(float2* X, int tid) {
#pragma unroll 2
  for (int bf = 0; bf < 8; ++bf) {
    const int base = PX(4 * (tid + 512 * bf));
    float2 a = X[base], b = X[base + 1], c = X[base + 2], d = X[base + 3];
    if (INV) { a = cconj(a); b = cconj(b); c = cconj(c); d = cconj(d); }
    const float2 t0 = cadd(a, c), t1 = csub(a, c), t2 = cadd(b, d), t3 = cmni(csub(b, d));
    float2 y0 = cadd(t0, t2), y1 = cadd(t1, t3), y2 = csub(t0, t2), y3 = csub(t1, t3);
    if (INV) { y0 = cconj(y0); y1 = cconj(y1); y2 = cconj(y2); y3 = cconj(y3); }
    X[base] = y0; X[base + 1] = y1; X[base + 2] = y2; X[base + 3] = y3;
  }
}
DI void fft_fwd(float2* X) {
  const int tid = TID;
  __syncthreads(); fft_pass16<10, false>(X, tid);
  __syncthreads(); fft_pass16<6, false>(X, tid);
  __syncthreads(); fft_pass16<2, false>(X, tid);
  __syncthreads(); fft_pass4<false>(X, tid);
  __syncthreads();
}
DI void fft_inv(float2* X) {
  const int tid = TID;
  __syncthreads(); fft_pass4<true>(X, tid);
  __syncthreads(); fft_pass16<2, true>(X, tid);
  __syncthreads(); fft_pass16<6, true>(X, tid);
  __syncthreads(); fft_pass16<10, true>(X, tid);
  __syncthreads();
}
DI float block_sum_512(float v, float* red) {
  for (int o = 32; o > 0; o >>= 1) v += shx(v, o);
  __syncthreads();
  if ((TID & 63) == 0) red[TID >> 6] = v;
  __syncthreads();
  float s = 0.f;
  for (int i = 0; i < 8; ++i) s += red[i];
  return s;
}
DI unsigned pkc(float2 v) { return pk2bf(v.x, v.y); }
DI float2 upkc(unsigned w) { return make_float2(bflo(w), bfhi(w)); }
DI void hyena_filter_task(int c, const bf16_t* __restrict__ hdnB, const bf16_t* __restrict__ W3t, const float* __restrict__ b3, uint2* __restrict__ H01_all,
                          char* smem) {
  float2* X = (float2*)smem;
  float* red = (float*)(smem + FNP * 8);
  uint2* H01 = H01_all + (size_t)c * FN;
  const int tid = TID;
  __syncthreads();
  const float delta = fabsf(-3.0701134573253944f + (float)c * ((-15.350567286626972f + 3.0701134573253944f) / 255.f));
  const float bb00 = b3[c], bb01 = b3[256 + c], bb10 = b3[512 + c], bb11 = b3[768 + c];
  float n0 = 0.f, n1 = 0.f;
  {
    const int lane = tid & 63, wid = tid >> 6, r = lane & 31, h = lane >> 5;
    bf16x8 wa[4];
#pragma unroll
    for (int s4 = 0; s4 < 4; ++s4) {
      uint4 w = make_uint4(0u, 0u, 0u, 0u);
      if (r < 4) w = *(const uint4*)(W3t + ((size_t)((r >> 1) * 512 + (r & 1) * 256 + c)) * 64 + 16 * s4 + 8 * h);
      wa[s4] = __builtin_bit_cast(bf16x8, w);
    }
#pragma unroll 8
    for (int blk = wid; blk < SEQ / 32; blk += 8) {
      const int j = blk * 32 + r;
      const bf16_t* hp = hdnB + (size_t)blk * 2048 + (h * 32 + r) * 8;
      f32x16 acc;
#pragma unroll
      for (int i = 0; i < 16; ++i) acc[i] = 0.f;
#pragma unroll
      for (int s4 = 0; s4 < 4; ++s4) acc = MFMA32(wa[s4], *(const bf16x8*)(hp + 512 * s4), acc);
      if (h == 0) {
        const float dec = __expf(-((float)j / (float)(SEQ - 1)) * delta);
        const float f00 = (acc[0] + bb00) * dec, f01 = (acc[1] + bb01) * dec, f10 = (acc[2] + bb10) * dec, f11 = (acc[3] + bb11) * dec;
        X[PX(j)] = make_float2(f00, f10);
        n0 += fabsf(f00); n1 += fabsf(f10);
        if (j > 0) { X[PX(FN - j)] = make_float2(f01, f11); n0 += fabsf(f01); n1 += fabsf(f11); }
        else X[PX(SEQ)] = make_float2(0.f, 0.f);
      }
    }
  }
  n0 = block_sum_512(n0, red);
  n1 = block_sum_512(n1, red);
  const float s0 = 0.5f / (n0 * (float)FN), s1 = 0.5f / (n1 * (float)FN);
  fft_fwd(X);
  for (int pos = tid; pos < FN; pos += 512) {
    const int f = freq_of_pos(pos); const int pm = pos_of_freq((FN - f) & (FN - 1));
    const float2 A = X[PX(pos)], Bm = X[PX(pm)];
    const float2 K0 = make_float2((A.x + Bm.x) * s0, (A.y - Bm.y) * s0);
    const float2 K1 = make_float2((A.y + Bm.y) * s1, -(A.x - Bm.x) * s1);
    H01[pos] = make_uint2(pkc(K0), pkc(K1));
  }
}
DI void hyena_channel(int c, const float* __restrict__ hy_bias, const float* __restrict__ uT, float* __restrict__ zT, float* __restrict__ yT,
                      const uint2* __restrict__ H01_all, char* smem) {
  float2* X = (float2*)smem;
  const uint2* H01 = H01_all + (size_t)c * FN;
  const int tid = TID;
  const float* v0p = uT + ((size_t)0 * 768 + c) * NT + CTX;
  const float* v1p = uT + ((size_t)1 * 768 + c) * NT + CTX;
  __syncthreads();
  for (int t = tid; t < SEQ; t += 512) { X[PX(t)] = make_float2(v0p[t], v1p[t]); X[PX(SEQ + t)] = make_float2(0.f, 0.f); }
  fft_fwd(X);
  for (int pos = tid; pos < FN; pos += 512) X[PX(pos)] = cmul(X[PX(pos)], upkc(H01[pos].x));
  fft_inv(X);
  {
    const float bias0 = hy_bias[c];
    const float* x10 = v0p + (size_t)256 * NT; const float* x11 = v1p + (size_t)256 * NT;
    float* z0 = zT + ((size_t)0 * 256 + c) * NT + CTX; float* z1 = zT + ((size_t)1 * 256 + c) * NT + CTX;
    for (int t = tid; t < SEQ; t += 512) {
      float2 y = X[PX(t)];
      float za = x10[t] * (y.x + bias0 * v0p[t]);
      float zb = x11[t] * (y.y + bias0 * v1p[t]);
      z0[t] = za; z1[t] = zb;
      X[PX(t)] = make_float2(za, zb);
    }
    __syncthreads();
    for (int t = tid; t < SEQ; t += 512) X[PX(SEQ + t)] = make_float2(0.f, 0.f);
  }
  fft_fwd(X);
  for (int pos = tid; pos < FN; pos += 512) X[PX(pos)] = cmul(X[PX(pos)], upkc(H01[pos].y));
  fft_inv(X);
  {
    const float bias1 = hy_bias[256 + c];
    const float* x20 = v0p + (size_t)512 * NT; const float* x21 = v1p + (size_t)512 * NT;
    const float* z0 = zT + ((size_t)0 * 256 + c) * NT + CTX; const float* z1 = zT + ((size_t)1 * 256 + c) * NT + CTX;
    float* y0 = yT + ((size_t)0 * 256 + c) * NT + CTX; float* y1 = yT + ((size_t)1 * 256 + c) * NT + CTX;
    for (int t = tid; t < SEQ; t += 512) {
      float2 y = X[PX(t)];
      y0[t] = x20[t] * (y.x + bias1 * z0[t]);
      y1[t] = x21[t] * (y.y + bias1 * z1[t]);
    }
  }
}

namespace pg8 {
#define PG8_LAS __attribute__((address_space(3)))
typedef ::bf16x8 bf16x8;
typedef float f32x4 __attribute__((ext_vector_type(4)));
typedef unsigned u32x4 __attribute__((ext_vector_type(4)));
constexpr int BM = 256, BK = 64, HALF = 128, HTB = HALF * BK * 2  , STAGE_BYTES = 8 * HTB, NXCD = 8, WGM = 8;

__host__ __device__ __forceinline__ int lds_byte(int r, int c) { const int st = (r >> 4) * 2 + (c >> 5), rr = r & 15, cc = c & 31, ob = rr * 64 + cc * 2; return st * 1024 + (ob ^ (((ob >> 9) & 1) << 5)); }
__host__ __device__ __forceinline__ void stage_rc(int b, int& R, int& C) { const int st = b / 1024, sb = b % 1024, swz = sb ^ (((sb >> 9) & 1) << 5); R = (st >> 1) * 16 + swz / 64; C = (st & 1) * 32 + (swz % 64) / 2; }
__host__ __device__ __forceinline__ int perm32(int rho) { const int n = rho >> 4, i = rho & 15; return 8 * (i >> 2) + 4 * n + (i & 3); }
struct Unit { int pm, pn; };
struct Gemm { const bf16_t* A; const bf16_t* Bt; int M, N, K; };
template <class Epi, class Sched, bool STAMP = false>
__device__ __forceinline__ void gemm_phase(PG8_LAS unsigned char* lds, const Gemm g, const Sched& S, const Epi& E, unsigned long long* stamps) {
    const int tid = TID, wid = __builtin_amdgcn_readfirstlane(tid >> 6), lane = tid & 63, wr = wid >> 2, wc = wid & 3, fr = lane & 15, fq = lane >> 4;
    const int K = g.K, nt = K / BK;
    int ts_lo = 0, ts_hi = 0, nts = 0; const unsigned long long rt_entry = STAMP ? (unsigned long long)wall_clock64() : 0ull;
#define PG8_STAMP() do { if (STAMP && wid == 0 && nts < 64) { const unsigned long long _c = (unsigned long long)clock64(); \
        ts_lo = (lane == nts) ? (int)(unsigned)_c : ts_lo; ts_hi = (lane == nts) ? (int)(unsigned)(_c >> 32) : ts_hi; ++nts; } } while (0)
    PG8_STAMP();
    unsigned voffA[2], voffB[2];
#pragma unroll
    for (int i = 0; i < 2; ++i) { int R, C; stage_rc(tid * 16 + i * 8192, R, C); const int Rb = Epi::PERM ? ((R & ~31) + perm32(R & 31)) : R;
        voffA[i] = (unsigned)(R * K + C) * 2u; voffB[i] = (unsigned)(Rb * K + C) * 2u; }
    const size_t kstep = (size_t)(BK * 2);
    const size_t hstep = (size_t)HALF * K * 2;
    const size_t tstep = 2 * hstep;
    const unsigned ldsw = (unsigned)wid * 1024u;
    const int aoff = lds_byte(wr * 64 + fr, fq * 8), boff = lds_byte(wc * 32 + fr, fq * 8);
#define PG8_SA(b, h) (((b) * 2 + (h)) * HTB)
#define PG8_SB(b, h) ((4 + (b) * 2 + (h)) * HTB)
#define PG8_STAGE(bufoff, gbase, voff) do { _Pragma("unroll") for (int _i = 0; _i < 2; ++_i) \
        __builtin_amdgcn_global_load_lds((const unsigned*)((const char*)(gbase) + (voff)[_i]), (PG8_LAS unsigned*)(lds + (bufoff) + ldsw + _i * 8192), 16, 0, 0); } while (0)
#define PG8_LDA(dst, b, h) do { _Pragma("unroll") for (int m = 0; m < 4; ++m) _Pragma("unroll") for (int k = 0; k < 2; ++k) dst[m][k] = *(const PG8_LAS bf16x8*)(lds + PG8_SA(b, h) + aoff + m * 2048 + k * 1024); } while (0)
#define PG8_LDB(dst, b, h) do { _Pragma("unroll") for (int n = 0; n < 2; ++n) _Pragma("unroll") for (int k = 0; k < 2; ++k) dst[n][k] = *(const PG8_LAS bf16x8*)(lds + PG8_SB(b, h) + boff + n * 2048 + k * 1024); } while (0)
#define PG8_MMA(ai, bj, At, Bt) do { __builtin_amdgcn_s_setprio(1); _Pragma("unroll") for (int m = 0; m < 4; ++m) _Pragma("unroll") for (int n = 0; n < 2; ++n) _Pragma("unroll") for (int k = 0; k < 2; ++k) \
        acc[ai][bj][m][n] = __builtin_amdgcn_mfma_f32_16x16x32_bf16(Bt[n][k], At[m][k], acc[ai][bj][m][n], 0, 0, 0); __builtin_amdgcn_s_setprio(0); } while (0)
#define PG8_WAIT_V(n) asm volatile("s_waitcnt vmcnt(" #n ")" ::: "memory")
#define PG8_WAIT_L(n) asm volatile("s_waitcnt lgkmcnt(" #n ")" ::: "memory")
#define PG8_BAR __builtin_amdgcn_s_barrier()
#define PG8_SCHED __builtin_amdgcn_sched_barrier(0)
    Unit cur, nxt; int ui = 0;
    if (!S.next(0, cur)) return;
    f32x4 acc[2][2][4][2];
#pragma unroll
    for (int a = 0; a < 2; ++a)
#pragma unroll
        for (int b = 0; b < 2; ++b)
#pragma unroll
            for (int m = 0; m < 4; ++m)
#pragma unroll
                for (int n = 0; n < 2; ++n) acc[a][b][m][n] = (f32x4){0.f, 0.f, 0.f, 0.f};
    bf16x8 At[4][2], B0[2][2], B1[2][2];
    const char* cA = (const char*)g.A + (size_t)cur.pm * tstep; const char* cB = (const char*)g.Bt + (size_t)cur.pn * tstep;
    S.a_ready(cur);
    PG8_STAGE(PG8_SB(0, 0), cB, voffB); PG8_STAGE(PG8_SA(0, 0), cA, voffA); PG8_STAGE(PG8_SB(0, 1), cB + hstep, voffB); PG8_STAGE(PG8_SA(0, 1), cA + hstep, voffA);
    if (wr == 1) PG8_BAR;
    PG8_WAIT_V(4); PG8_BAR;
    PG8_STAGE(PG8_SB(1, 0), cB + kstep, voffB); PG8_STAGE(PG8_SA(1, 0), cA + kstep, voffA); PG8_STAGE(PG8_SB(1, 1), cB + hstep + kstep, voffB);
    PG8_WAIT_V(6); PG8_BAR;
    PG8_STAMP();
    for (;;) {
        const bool has_next = S.next(ui + 1, nxt);
        const char* nA = has_next ? (const char*)g.A + (size_t)nxt.pm * tstep : cA; const char* nB = has_next ? (const char*)g.Bt + (size_t)nxt.pn * tstep : cB;
        for (int t = 0; t < nt; t += 2) {
            const bool last = (t == nt - 2);
            const char* a1 = cA + (size_t)(t + 1) * kstep;
            const char* a2 = last ? nA : cA + (size_t)(t + 2) * kstep; const char* b2 = last ? nB : cB + (size_t)(t + 2) * kstep;
            const char* a3 = a2 + kstep; const char* b3 = b2 + kstep;
            if (last && has_next) S.a_ready(nxt);
            PG8_LDB(B0, 0, 0); PG8_SCHED; PG8_LDA(At, 0, 0); PG8_STAGE(PG8_SA(1, 1), a1 + hstep, voffA);
            PG8_WAIT_L(8); PG8_BAR; PG8_WAIT_L(0); PG8_MMA(0, 0, At, B0); PG8_BAR; PG8_SCHED;
            PG8_LDB(B1, 0, 1); PG8_STAGE(PG8_SB(0, 0), b2, voffB);
            PG8_BAR; PG8_WAIT_L(0); PG8_MMA(0, 1, At, B1); PG8_BAR;
            PG8_LDA(At, 0, 1); PG8_STAGE(PG8_SA(0, 0), a2, voffA);
            PG8_BAR; PG8_WAIT_L(0); PG8_MMA(1, 0, At, B0); PG8_BAR; PG8_SCHED;
            PG8_STAGE(PG8_SB(0, 1), b2 + hstep, voffB);
            PG8_WAIT_V(6); PG8_BAR; PG8_MMA(1, 1, At, B1); PG8_BAR;
            PG8_LDB(B0, 1, 0); PG8_SCHED; PG8_LDA(At, 1, 0); PG8_STAGE(PG8_SA(0, 1), a2 + hstep, voffA);
            PG8_WAIT_L(8); PG8_BAR; PG8_WAIT_L(0); PG8_MMA(0, 0, At, B0); PG8_BAR; PG8_SCHED;
            PG8_LDB(B1, 1, 1); PG8_STAGE(PG8_SB(1, 0), b3, voffB);
            PG8_BAR; PG8_WAIT_L(0); PG8_MMA(0, 1, At, B1); PG8_BAR;
            PG8_LDA(At, 1, 1); PG8_STAGE(PG8_SA(1, 0), a3, voffA);
            PG8_BAR; PG8_WAIT_L(0); PG8_MMA(1, 0, At, B0); PG8_BAR; PG8_SCHED;
            PG8_STAGE(PG8_SB(1, 1), b3 + hstep, voffB);
            PG8_WAIT_V(6); PG8_BAR; PG8_MMA(1, 1, At, B1); PG8_BAR;
        }
        PG8_STAMP();
        if constexpr (!Epi::AFTER_DRAIN) { E(acc, cur, wr, wc, fr, fq); S.done(cur); }
        PG8_STAMP();
        if (!has_next) break;
#pragma unroll
        for (int a = 0; a < 2; ++a)
#pragma unroll
            for (int b = 0; b < 2; ++b)
#pragma unroll
                for (int m = 0; m < 4; ++m)
#pragma unroll
                    for (int n = 0; n < 2; ++n) acc[a][b][m][n] = (f32x4){0.f, 0.f, 0.f, 0.f};
        cur = nxt; cA = nA; cB = nB; ++ui;
    }
    PG8_WAIT_V(0);
    if (wr == 0) PG8_BAR;
    PG8_BAR;
    if constexpr (Epi::AFTER_DRAIN) { E.fused(acc, cur, wr, wc, fr, fq, lds, wid, lane); S.done(cur); }
    PG8_STAMP();
    if (STAMP && wid == 0) { stamps[lane] = lane < nts ? (((unsigned long long)(unsigned)ts_hi << 32) | (unsigned)ts_lo) : 0ull;
        if (lane == 62) stamps[62] = rt_entry; if (lane == 63) stamps[63] = (unsigned long long)wall_clock64(); }
#undef PG8_STAMP
#undef PG8_SA
#undef PG8_SB
#undef PG8_STAGE
#undef PG8_LDA
#undef PG8_LDB
#undef PG8_MMA
#undef PG8_WAIT_V
#undef PG8_WAIT_L
#undef PG8_BAR
#undef PG8_SCHED
}
}

#ifndef GEMM_WGM
#define GEMM_WGM 4
#endif
struct MySched {
  int nN, nunits, G, c; bool latent_only;
  DI void init(int N, bool lat_only, int G_, int c_) { nN = N / 256; latent_only = lat_only; nunits = (lat_only ? 64 : 66) * nN; G = G_; c = c_; }
  DI bool next(int i, pg8::Unit& u) const {
    const int L = i * G + c; if (L >= nunits) return false;
    const int nM = latent_only ? 64 : 66;
    int wgid = L;
    { const int q = nunits / 8, r = nunits % 8, xcd = wgid % 8, off = wgid / 8; wgid = (xcd < r ? xcd * (q + 1) : r * (q + 1) + (xcd - r) * q) + off; }
    const int nig = GEMM_WGM * nN, gid = wgid / nig, fm = gid * GEMM_WGM, gsz = (nM - fm) < GEMM_WGM ? (nM - fm) : GEMM_WGM;
    const int ri = fm + ((wgid % nig) % gsz);
    u.pn = (wgid % nig) / gsz;
    u.pm = latent_only ? (ri / 32) * 33 + 1 + (ri % 32) : ri;
    return true;
  }
  DI void a_ready(const pg8::Unit&) const {}
  DI void done(const pg8::Unit&) const {}
};
struct EpiStoreBf16 {
  static constexpr bool PERM = true, AFTER_DRAIN = false;
  bf16_t* Cb; int ldc;
  DI void operator()(const pg8::f32x4 (&acc)[2][2][4][2], const pg8::Unit& u, int wr, int wc, int fr, int fq) const {
    const int row0 = u.pm * 256 + wr * 64 + fr, col0 = u.pn * 256 + wc * 32 + 8 * fq;
#pragma unroll
    for (int ai = 0; ai < 2; ++ai)
#pragma unroll
      for (int m = 0; m < 4; ++m) {
        bf16_t* rowp = Cb + (size_t)(row0 + ai * 128 + m * 16) * ldc + col0;
#pragma unroll
        for (int bj = 0; bj < 2; ++bj) {
          const pg8::f32x4 v0 = acc[ai][bj][m][0], v1 = acc[ai][bj][m][1];
          *(uint4*)(rowp + bj * 128) = make_uint4(pk2bf(v0[0], v0[1]), pk2bf(v0[2], v0[3]), pk2bf(v1[0], v1[1]), pk2bf(v1[2], v1[3]));
        }
      }
  }
};
struct EpiResidual {
  static constexpr bool PERM = true, AFTER_DRAIN = false;
  float* xs; const float* gate_base; const float* xin; const float* ctxin;
  DI void operator()(const pg8::f32x4 (&acc)[2][2][4][2], const pg8::Unit& u, int wr, int wc, int fr, int fq) const {
    const int row0 = u.pm * 256 + wr * 64 + fr, col0 = u.pn * 256 + wc * 32 + 8 * fq;
    const int b = u.pm / 33; const int mrow = (u.pm % 33) == 0 ? 2 : b;
    const int pt = (u.pm % 33) * 256 + wr * 64 + fr;
    const float* gt = gate_base + mrow * NMOD + col0;
#pragma unroll
    for (int ai = 0; ai < 2; ++ai)
#pragma unroll
      for (int m = 0; m < 4; ++m) {
        float* rowp = xs + (size_t)(row0 + ai * 128 + m * 16) * D + col0;
        const int pp = pt + ai * 128 + m * 16;
        const float* srcp = xin ? (pp < CTX ? ctxin + ((size_t)b * CTX + pp) * D + col0 : xin + ((size_t)b * SEQ + (pp - CTX)) * D + col0) : rowp;
#pragma unroll
        for (int bj = 0; bj < 2; ++bj)
#pragma unroll
          for (int n = 0; n < 2; ++n) {
            const pg8::f32x4 v = acc[ai][bj][m][n];
            const float4 g4 = *(const float4*)(gt + bj * 128 + n * 4);
            float4 xv = *(const float4*)(srcp + bj * 128 + n * 4);
            xv.x += g4.x * v[0]; xv.y += g4.y * v[1]; xv.z += g4.z * v[2]; xv.w += g4.w * v[3];
            *(float4*)(rowp + bj * 128 + n * 4) = xv;
          }
      }
  }
};

#define XB_TMO      128
#define XB_XCNT(j)  (256  + 64 * (j))
#define XB_XSUB(j)  (1280 + 64 * (j))
#define XB_XGEN(j)  (2304 + 64 * (j))
#define XB_TOP      3328
#define XB_TOPGEN   3392
#define XB_SPIN_CAP (1u << 22)
DI unsigned xb_ld(unsigned* p) { return __hip_atomic_load(p, __ATOMIC_RELAXED, __HIP_MEMORY_SCOPE_AGENT); }
DI unsigned xb_add(unsigned* p, unsigned v) { return __hip_atomic_fetch_add(p, v, __ATOMIC_RELAXED, __HIP_MEMORY_SCOPE_AGENT); }
DI unsigned xb_xcc_id() { return (unsigned)__builtin_amdgcn_s_getreg((3 << 11) | 20) & 0xFu; }
#define XB_SPIN(cond, bar) do { unsigned _sp = 0; while (cond) { __builtin_amdgcn_s_sleep(1); \
    if ((++_sp & 255u) == 0u) { if (xb_ld(&(bar)[XB_TMO])) break; if (_sp > XB_SPIN_CAP) { atomicAdd(&(bar)[XB_TMO], 1u); break; } } } } while (0)
DI void xcd_barrier_post(unsigned* bar, volatile LAS unsigned* st) {
  if (threadIdx.x == 0) { const unsigned x = xb_xcc_id(); st[3] = x; st[2] = xb_add(&bar[XB_XCNT(x)], 1u); }
}
DI void xcd_barrier_complete(unsigned* bar, unsigned x, unsigned& nloc, unsigned& nx) {
  const unsigned G = gridDim.x;
  unsigned sum, cnt, mine, sp = 0u;
  for (;;) {
    sum = 0u; cnt = 0u; mine = 0u;
#pragma unroll
    for (unsigned j = 0; j < 16; ++j) { const unsigned c = xb_ld(&bar[XB_XCNT(j)]); sum += c; cnt += (c > 0u) ? 1u : 0u; mine = (j == x) ? c : mine; }
    if (sum == G) break;
    __builtin_amdgcn_s_sleep(1);
    if ((++sp & 255u) == 0u) { if (xb_ld(&bar[XB_TMO])) break; if (sp > XB_SPIN_CAP) { atomicAdd(&bar[XB_TMO], 1u); break; } }
  }
  nloc = mine > 0u ? mine : 1u; nx = cnt > 0u ? cnt : 1u;
}
DI void xcd_barrier(unsigned* bar, volatile LAS unsigned* st) {
  asm volatile("s_waitcnt vmcnt(0)" ::: "memory");
  __syncthreads();
  if (threadIdx.x == 0) {
    const unsigned x = xb_xcc_id();
    __builtin_amdgcn_s_waitcnt(0);
    unsigned nloc = st[0], nx = st[1];
    if (nloc == 0u) { xcd_barrier_complete(bar, x, nloc, nx); st[0] = nloc; st[1] = nx; }
    const unsigned old = xb_add(&bar[XB_XSUB(x)], 1u);
    const unsigned gen = old / nloc;
    if (old + 1u == (gen + 1u) * nloc) {
      __builtin_amdgcn_fence(__ATOMIC_RELEASE, "agent");
      asm volatile("s_waitcnt vmcnt(0)" ::: "memory");
      const unsigned og = xb_add(&bar[XB_TOP], 1u);
      const unsigned tg = og / nx;
      if (og + 1u == (tg + 1u) * nx) xb_add(&bar[XB_TOPGEN], 1u);
      else XB_SPIN(xb_ld(&bar[XB_TOPGEN]) == tg, bar);
      __builtin_amdgcn_fence(__ATOMIC_ACQUIRE, "agent");
      xb_add(&bar[XB_XGEN(x)], 1u);
      asm volatile("s_waitcnt vmcnt(0)" ::: "memory");
    } else {
      XB_SPIN(xb_ld(&bar[XB_XGEN(x)]) == gen, bar);
      __builtin_amdgcn_fence(__ATOMIC_ACQUIRE, "agent");
      asm volatile("s_waitcnt vmcnt(0)" ::: "memory");
    }
  }
  __syncthreads();
}

#define XCD_BAR_WORDS 3456
constexpr size_t al256(size_t x) { return (x + 255) & ~(size_t)255; }
constexpr size_t OFF_modv = 0;
constexpr size_t OFF_xs = al256(OFF_modv + (size_t)2 * 3 * NMOD * 4);
constexpr size_t OFF_hbuf = al256(OFF_xs + (size_t)R * D * 4);
constexpr size_t OFF_P = al256(OFF_hbuf + (size_t)R * D * 2);
constexpr size_t OFF_Wt_in = al256(OFF_P + (size_t)R * DIN * 2);
constexpr size_t OFF_Wt_out = al256(OFF_Wt_in + (size_t)2 * DIN * D * 2);
constexpr size_t OFF_Wt_q = al256(OFF_Wt_out + (size_t)2 * D * D * 2);
constexpr size_t OFF_QA = al256(OFF_Wt_q + (size_t)2 * 2048 * D * 2);
constexpr size_t OFF_KA = al256(OFF_QA + (size_t)NB * 8 * NT * 32 * 2);
constexpr size_t OFF_VAt = al256(OFF_KA + (size_t)NB * 8 * NT * 32 * 2);
constexpr size_t OFF_QW = al256(OFF_VAt + (size_t)NB * 4 * 64 * NT * 2);
constexpr size_t OFF_KW = al256(OFF_QW + (size_t)NB * 4 * NT * 64 * 2);
constexpr size_t OFF_VWt = al256(OFF_KW + (size_t)NB * 2 * NT * 64 * 2);
constexpr size_t OFF_QG = al256(OFF_VWt + (size_t)NB * 2 * 64 * NT * 2);
constexpr size_t OFF_KG = al256(OFF_QG + (size_t)NB * 4 * NT * 64 * 2);
constexpr size_t OFF_VGt = al256(OFF_KG + (size_t)NB * 2 * NT * 64 * 2);
constexpr size_t OFF_uT = al256(OFF_VGt + (size_t)NB * 2 * 64 * NT * 2);
constexpr size_t OFF_zT = al256(OFF_uT + (size_t)NB * 768 * NT * 4);
constexpr size_t OFF_yT = al256(OFF_zT + (size_t)NB * 256 * NT * 4);
constexpr size_t OFF_hdn2 = al256(OFF_yT + (size_t)NB * 256 * NT * 4);
constexpr size_t OFF_Hc = al256(OFF_hdn2 + (size_t)2 * NT * 64 * 4);
constexpr size_t OFF_A2 = al256(OFF_Hc + (size_t)256 * 2 * SEQ * 8);
constexpr size_t OFF_u8 = al256(OFF_A2 + (size_t)R * D * 2);
constexpr size_t OFF_v8 = al256(OFF_u8 + (size_t)2 * 16384 * D);
constexpr size_t OFF_us = al256(OFF_v8 + (size_t)2 * 16384 * D);
constexpr size_t OFF_vs = al256(OFF_us + (size_t)2 * 16384 * 4);
constexpr size_t OFF_keysb = al256(OFF_vs + (size_t)2 * 16384 * 4);
constexpr size_t OFF_bar = al256(OFF_keysb + (size_t)2 * 16 * 128 * 128 * 2);
constexpr size_t OFF_hdnB = al256(OFF_bar + (size_t)XCD_BAR_WORDS * 4);
constexpr size_t OFF_W3t = al256(OFF_hdnB + (size_t)2 * SEQ * 64 * 2);
constexpr size_t WS_TOTAL = al256(OFF_W3t + (size_t)2 * 1024 * 64 * 2);
constexpr size_t OFF_topv = OFF_uT;
constexpr size_t OFF_topi = OFF_topv + (size_t)R * 256 * 4;
constexpr size_t OFF_experts = OFF_topi + (size_t)R * 256;
constexpr size_t OFF_gates = OFF_experts + (size_t)R * 128 * 4;
constexpr size_t OFF_xq = OFF_A2;
constexpr size_t OFF_xqs = OFF_xq + (size_t)R * D;
constexpr size_t OFF_wsc = OFF_xqs + (size_t)R * 4;
static_assert(OFF_wsc + (size_t)R * 4 <= OFF_u8, "xq overflows A2");
constexpr size_t OFF_Oslab = OFF_P;
constexpr size_t OFF_Lslab = OFF_Oslab + (size_t)2 * NB * 4 * NT * 64 * 4;
static_assert(OFF_gates + (size_t)R * 128 * 4 <= OFF_zT, "routing buffers overflow uT");
static_assert(OFF_Lslab + (size_t)2 * NB * 4 * NT * 4 <= OFF_Wt_in, "slabs overflow P");

struct MKView;
struct MK {
  const float *x, *c, *ctx, *c_ctx, *w_mod, *b_mod, *g_norm_mix, *w_in, *g_qk_diff, *lambda_diff, *g_qk_win, *sink_win, *g_qk_glob, *hy_conv_w,
      *hy_conv_b, *hy_w1, *hy_b1, *hy_w2, *hy_b2, *hy_w3, *hy_b3, *hy_freq, *hy_bias, *g_mix_out, *w_out, *g_norm_ffn, *peer_wq, *peer_keys,
      *peer_u, *peer_v;
  float* out;
  char* ws;
};
constexpr int SMEM_BYTES = (FN + (FN >> 6) * 4) * 8 + 2048;
typedef const MK __attribute__((address_space(4))) * MKP;
DI MK launder_mk(MKP a) {
  asm volatile("" : "+s"(a));
  MK r;
  r.x = a->x; r.c = a->c; r.ctx = a->ctx; r.c_ctx = a->c_ctx; r.w_mod = a->w_mod; r.b_mod = a->b_mod;
  r.g_norm_mix = a->g_norm_mix; r.w_in = a->w_in; r.g_qk_diff = a->g_qk_diff; r.lambda_diff = a->lambda_diff;
  r.g_qk_win = a->g_qk_win; r.sink_win = a->sink_win; r.g_qk_glob = a->g_qk_glob; r.hy_conv_w = a->hy_conv_w;
  r.hy_conv_b = a->hy_conv_b; r.hy_w1 = a->hy_w1; r.hy_b1 = a->hy_b1; r.hy_w2 = a->hy_w2; r.hy_b2 = a->hy_b2;
  r.hy_w3 = a->hy_w3; r.hy_b3 = a->hy_b3; r.hy_freq = a->hy_freq; r.hy_bias = a->hy_bias; r.g_mix_out = a->g_mix_out;
  r.w_out = a->w_out; r.g_norm_ffn = a->g_norm_ffn; r.peer_wq = a->peer_wq; r.peer_keys = a->peer_keys;
  r.peer_u = a->peer_u; r.peer_v = a->peer_v; r.out = a->out; r.ws = a->ws;
  return r;
}

DI void ph_mod_item(const MK& m, int item, char* smem) {
  float* sc = (float*)smem;
  float* part = sc + 3 * D;
  const int tid = TID, lane = tid & 63, wv = tid >> 6;
  const int l = item / 96, chunk = item % 96;
  __syncthreads();
  for (int i = tid; i < 3 * D; i += NTHR) {
    int row = i / D, k = i % D;
    float v = row < 2 ? m.c[row * D + k] : m.c_ctx[k];
    sc[i] = v / (1.f + __expf(-v));
  }
  __syncthreads();
  const int col = chunk * 64 + lane;
  const float* w = m.w_mod + (size_t)l * D * NMOD + (size_t)(wv * 128) * NMOD + col;
  float a0 = 0, a1 = 0, a2 = 0;
#pragma unroll 8
  for (int k = 0; k < 128; ++k) {
    float wvv = w[(size_t)k * NMOD];
    a0 += sc[wv * 128 + k] * wvv; a1 += sc[D + wv * 128 + k] * wvv; a2 += sc[2 * D + wv * 128 + k] * wvv;
  }
  part[(wv * 3 + 0) * 64 + lane] = a0; part[(wv * 3 + 1) * 64 + lane] = a1; part[(wv * 3 + 2) * 64 + lane] = a2;
  __syncthreads();
  if (tid < 192) {
    const int row = tid >> 6;
    float sacc = 0.f;
    for (int q = 0; q < 8; ++q) sacc += part[(q * 3 + row) * 64 + lane];
    ((float*)(m.ws + OFF_modv))[(l * 3 + row) * NMOD + col] = sacc + m.b_mod[l * NMOD + col];
  }
}
DI void ph_hymlp_group(const MK& m, int g, char* smem) {
  const int tid = TID, wv = tid >> 6, u = tid & 63;
  float* feat = (float*)smem + wv * 128;
  float* h1 = feat + 64;
  const int gi = g * 8 + wv;
  const int l = gi / NT, pos = gi % NT;
  const int which = pos >= SEQ ? 1 : 0;
  const int j = which ? pos - SEQ : pos;
  const int n = which ? CTX : SEQ;
  const float tt = (float)j / (float)(n - 1);
  const float w = (6.283185307179586f / (float)n) * (float)j;
  __syncthreads();
  if (u == 0) feat[0] = tt;
  if (u < 16) {
    float f = 1e-4f + (float)u * ((15.f - 1e-4f) / 15.f);
    feat[1 + u] = cosf(f * w);
    feat[17 + u] = -sinf(f * w);
  }
  __syncthreads();
  const float* w1 = m.hy_w1 + l * 33 * 64; const float* w2 = m.hy_w2 + l * 64 * 64;
  const float fq = m.hy_freq[l * 64 + u];
  float a = m.hy_b1[l * 64 + u];
  for (int i = 0; i < 33; ++i) a += feat[i] * w1[i * 64 + u];
  h1[u] = sinf(fq * a);
  __syncthreads();
  float a2 = m.hy_b2[l * 64 + u];
  for (int i = 0; i < 64; ++i) a2 += h1[i] * w2[i * 64 + u];
  const float hv2 = sinf(fq * a2);
  ((float*)(m.ws + OFF_hdn2))[((size_t)l * 64 + u) * NT + pos] = hv2;
  if (!which) ((bf16_t*)(m.ws + OFF_hdnB))[(size_t)l * SEQ * 64 + (size_t)(pos >> 5) * 2048 + (u >> 4) * 512 + (((u >> 3) & 1) * 32 + (pos & 31)) * 8 + (u & 7)] = f2bf(hv2);
}
DI void phase0(MKP m_in, char* smem) {
  const MK m = launder_mk(m_in);
  const int bid = BID, nb = NBLK, tid = TID;
  {
    const int lane = tid & 63;
    const int gw = bid * 8 + (tid >> 6), nw = nb * 8;
    for (int row0 = gw; row0 < 4 * 16384; row0 += 8 * nw) {
      float4 v[8][4];
#pragma unroll
      for (int q = 0; q < 8; ++q) {
        const int row = row0 + q * nw;
        if (row < 4 * 16384) {
          const int tbl = row >> 14, rr = row & 16383; const int l = tbl >> 1;
          const float4* sp = (const float4*)(((tbl & 1) ? m.peer_v : m.peer_u) + (size_t)l * 16384 * D + (size_t)rr * D);
          v[q][0] = sp[lane]; v[q][1] = sp[64 + lane]; v[q][2] = sp[128 + lane]; v[q][3] = sp[192 + lane];
        }
      }
#pragma unroll
      for (int q = 0; q < 8; ++q) {
        const int row = row0 + q * nw;
        if (row < 4 * 16384) {
          const int tbl = row >> 14, rr = row & 16383; const int l = tbl >> 1;
          if (tbl & 1) tabconv_fin(v[q][0], v[q][1], v[q][2], v[q][3], ((unsigned char*)(m.ws + OFF_v8)) + (size_t)l * 16384 * D, ((float*)(m.ws + OFF_vs)) + l * 16384, (size_t)rr, lane);
          else tabconv_fin_i8(v[q][0], v[q][1], v[q][2], v[q][3], ((unsigned char*)(m.ws + OFF_u8)) + (size_t)l * 16384 * D, ((float*)(m.ws + OFF_us)) + l * 16384, (size_t)rr, lane);
        }
      }
    }
  }
  for (int it = bid; it < 192; it += nb) ph_mod_item(m, it, smem);
  for (int g = bid; g < 2 * NT / 8; g += nb) ph_hymlp_group(m, g, smem);
  for (int t = bid; t < 2 * 1408; t += nb) {
    int l = t / 1408, tt = t % 1408;
    if (tt < 640) wconv_tile(m.w_in + (size_t)l * D * DIN, ((bf16_t*)(m.ws + OFF_Wt_in)) + (size_t)l * DIN * D, DIN, tt, (float*)smem);
    else if (tt < 896) wconv_tile(m.w_out + (size_t)l * D * D, ((bf16_t*)(m.ws + OFF_Wt_out)) + (size_t)l * D * D, D, tt - 640, (float*)smem);
    else wconv_tile(m.peer_wq + (size_t)l * D * 2048, ((bf16_t*)(m.ws + OFF_Wt_q)) + (size_t)l * 2048 * D, 2048, tt - 896, (float*)smem);
  }
  for (int i = bid * NTHR + tid; i < 2 * 16 * 128 * 128 / 4; i += nb * NTHR) {
    float4 v = ((const float4*)m.peer_keys)[i];
    ((uint2*)((bf16_t*)(m.ws + OFF_keysb)))[i] = make_uint2(pk2bf(v.x, v.y), pk2bf(v.z, v.w));
  }
  for (int i = bid * NTHR + tid; i < 2 * 1024 * 64; i += nb * NTHR) {
    const int l = i >> 16, n = (i >> 6) & 1023, k = i & 63;
    ((bf16_t*)(m.ws + OFF_W3t))[i] = f2bf(m.hy_w3[((size_t)l * 64 + k) * 1024 + n]);
  }
}

DI void phase_norm(MKP m_in, int l, int which  , bool first, bool skip_ctx) {
  const MK m = launder_mk(m_in);
  const int tid = TID, lane = tid & 63;
  const int gw = BID * 8 + (tid >> 6), nw = NBLK * 8;
  const float* g = (which ? m.g_norm_ffn : m.g_norm_mix) + l * D;
  const float* modv_l = ((float*)(m.ws + OFF_modv)) + (size_t)l * 3 * NMOD;
  for (int r = gw; r < R; r += nw) {
    const int b = r / NT, p = r % NT;
    if (skip_ctx && p < CTX) continue;
    const int mrow = p < CTX ? 2 : b;
    const float4* src = (const float4*)(first ? (p < CTX ? m.ctx + ((size_t)b * CTX + p) * D : m.x + ((size_t)b * SEQ + (p - CTX)) * D)
                                              : ((float*)(m.ws + OFF_xs)) + (size_t)r * D);
    float4 v[4];
    float ss = 0.f;
#pragma unroll
    for (int i = 0; i < 4; ++i) { v[i] = src[lane + 64 * i]; ss += v[i].x * v[i].x + v[i].y * v[i].y + v[i].z * v[i].z + v[i].w * v[i].w; }
    for (int o = 32; o > 0; o >>= 1) ss += shxl(ss, lane, o);
    const float rs = rsqrtf(ss * (1.f / D) + EPS);
    const float* sh = modv_l + mrow * NMOD + (which ? 3 : 0) * D;
    const float* sc = sh + D;
#pragma unroll
    for (int i = 0; i < 4; ++i) {
      const int c0 = (lane + 64 * i) * 4;
      float4 gg = *(const float4*)(g + c0), s4 = *(const float4*)(sc + c0), h4 = *(const float4*)(sh + c0);
      float o0 = v[i].x * rs * gg.x * (1.f + s4.x) + h4.x, o1 = v[i].y * rs * gg.y * (1.f + s4.y) + h4.y;
      float o2 = v[i].z * rs * gg.z * (1.f + s4.z) + h4.z, o3 = v[i].w * rs * gg.w * (1.f + s4.w) + h4.w;
      *(uint2*)(((bf16_t*)(m.ws + OFF_hbuf)) + (size_t)r * D + c0) = make_uint2(pk2bf(o0, o1), pk2bf(o2, o3));
      v[i] = make_float4(o0, o1, o2, o3);
    }
    if (which) {
      float mx = 0.f;
#pragma unroll
      for (int i = 0; i < 4; ++i) mx = fmaxf(mx, fmaxf(fmaxf(fabsf(v[i].x), fabsf(v[i].y)), fmaxf(fabsf(v[i].z), fabsf(v[i].w))));
      for (int o = 32; o > 0; o >>= 1) mx = fmaxf(mx, shxl(mx, lane, o));
      mx = fmaxf(mx, 1e-30f);
      const float inv = 127.f / mx;
      *(uint4*)(((unsigned char*)(m.ws + OFF_xq)) + (size_t)r * D + lane * 16) =
          make_uint4(pack_i8x4(v[0].x * inv, v[0].y * inv, v[0].z * inv, v[0].w * inv), pack_i8x4(v[1].x * inv, v[1].y * inv, v[1].z * inv, v[1].w * inv),
                     pack_i8x4(v[2].x * inv, v[2].y * inv, v[2].z * inv, v[2].w * inv), pack_i8x4(v[3].x * inv, v[3].y * inv, v[3].z * inv, v[3].w * inv));
      if (lane == 0) ((float*)(m.ws + OFF_xqs))[r] = mx * (1.f / 127.f);
    }
  }
}

DI int rowtile_of(int i, bool latent_only) { return latent_only ? (i / 64) * 66 + 2 + (i % 64) : i; }
template <int EPI>
DI void phase_gemm(const bf16_t* A, const bf16_t* Wt, int N, bf16_t* Cb, float* xs, const float* gate_base, bool latent_only, char* smem) {
  const int nt_n = N / 128, nrt = latent_only ? 128 : 132, ntiles = nrt * nt_n;
  for (int t = BID; t < ntiles; t += NBLK) {
    int tm = rowtile_of(t / nt_n, latent_only), tn = t % nt_n;
    gemm_tile<EPI>(A, Wt, N, tm * 128, tn * 128, smem, Cb, xs, gate_base);
  }
}

DI void rope_pair8(float (&y)[8], const float (&part)[8], bool upper, const float* cs, const float* sn, int dd0) {
#pragma unroll
  for (int e = 0; e < 8; ++e) {
    float c = cs[dd0 + e], s = sn[dd0 + e];
    float x1 = upper ? part[e] : y[e], x2 = upper ? y[e] : part[e];
    y[e] = upper ? (x1 * s + x2 * c) : (x1 * c - x2 * s);
  }
}
DI void unpack8(uint4 w, float (&v)[8]) {
  v[0] = bflo(w.x); v[1] = bfhi(w.x); v[2] = bflo(w.y); v[3] = bfhi(w.y); v[4] = bflo(w.z); v[5] = bfhi(w.z); v[6] = bflo(w.w); v[7] = bfhi(w.w);
}
DI uint4 pack8(const float (&v)[8], float sc) {
  return make_uint4(pk2bf(v[0] * sc, v[1] * sc), pk2bf(v[2] * sc, v[3] * sc), pk2bf(v[4] * sc, v[5] * sc), pk2bf(v[6] * sc, v[7] * sc));
}
constexpr int VS_STRIDE = 1032;
constexpr int HS_STRIDE = 1552;
DI void prep_tile(MKP m_in, int l, int tile, char* smem) {
  const MK m = launder_mk(m_in);
  const int tid = TID, lane = tid & 63, wid = tid >> 6;
  const int r0 = tile * 32; const int b = r0 / NT, p0 = r0 % NT;
  const bool lat = p0 >= CTX;
  char* Vs = smem;
  char* Hs = smem + 33280;
  float* csh = (float*)(smem + 33280 + 34 * HS_STRIDE);
  const bf16_t* Pb = ((bf16_t*)(m.ws + OFF_P)) + (size_t)(b * NT) * DIN;
  __syncthreads();
  if (lat) {
    for (int i = tid; i < 32 * 48; i += NTHR) {
      int rr = i / 48, a = i % 48;
      int t = p0 + rr - CTX;
      float trow = (float)(t / 64), tcol = (float)(t % 64);
      float* rowp = csh + rr * 96;
      if (a < 16) {
        int j = a & 7; float f = exp2f(-(float)j * (13.287712379549449f / 8.f));
        float ang = (a < 8 ? trow : tcol) * f;
        rowp[a] = cosf(ang); rowp[16 + a] = sinf(ang);
      } else {
        int aa = a - 16; int j = aa & 15; float f = exp2f(-(float)j * (13.287712379549449f / 16.f));
        float ang = (aa < 16 ? trow : tcol) * f;
        rowp[32 + aa] = cosf(ang); rowp[64 + aa] = sinf(ang);
      }
    }
  }
  {
    const int seg_lo = lat ? CTX : 0, seg_hi = lat ? NT : CTX;
    for (int ch = tid; ch < 34 * 96; ch += NTHR) {
      int rr = ch / 96, c8 = ch % 96;
      int p = p0 - 1 + rr;
      uint4 v = make_uint4(0, 0, 0, 0);
      if (p >= seg_lo && p < seg_hi) v = *(const uint4*)(Pb + (size_t)p * DIN + 1792 + c8 * 8);
      *(uint4*)(Hs + rr * HS_STRIDE + c8 * 16) = v;
    }
  }
  __syncthreads();
  const float* gd = m.g_qk_diff + l * 64; const float* gwn = m.g_qk_win + l * 128; const float* gg = m.g_qk_glob + l * 128;
#pragma unroll
  for (int k = 0; k < 4; ++k) {
    const int rr = wid + 8 * k; const int p = p0 + rr;
    const bf16_t* Pr = Pb + (size_t)p * DIN;
    const float* rowp = csh + rr * 96;
    {
      float y[8], part[8];
      unpack8(*(const uint4*)(Pr + 8 * lane), y);
      float ss = 0.f;
#pragma unroll
      for (int e = 0; e < 8; ++e) ss += y[e] * y[e];
      ss += shxl(ss, lane, 1); ss += shxl(ss, lane, 2);
      const float rs = rsqrtf(ss * (1.f / 32) + EPS);
      const int unit = lane >> 2; const bool isk = unit >= 8; const int vh = unit & 7;
      const int d0 = (lane & 3) * 8;
      const float* gn = gd + (isk ? 32 : 0) + d0;
#pragma unroll
      for (int e = 0; e < 8; ++e) y[e] = y[e] * rs * gn[e];
      if (lat) {
#pragma unroll
        for (int e = 0; e < 8; ++e) part[e] = shxl(y[e], lane, 2);
        rope_pair8(y, part, (lane & 2) != 0, rowp, rowp + 16, (lane & 1) * 8);
      }
      bf16_t* dst = (isk ? ((bf16_t*)(m.ws + OFF_KA)) : ((bf16_t*)(m.ws + OFF_QA))) + (((size_t)b * 8 + vh) * NT + p) * 32 + d0;
      *(uint4*)dst = pack8(y, isk ? 1.f : 0.17677669529663687f * LOG2E);
    }
#pragma unroll
    for (int grp = 0; grp < 2; ++grp) {
      float y[8], part[8];
      const int cbase = grp == 0 ? 768 : 1280;
      uint4 w = make_uint4(0, 0, 0, 0);
      if (lane < 48) w = *(const uint4*)(Pr + cbase + 8 * lane);
      unpack8(w, y);
      float ss = 0.f;
#pragma unroll
      for (int e = 0; e < 8; ++e) ss += y[e] * y[e];
      ss += shxl(ss, lane, 1); ss += shxl(ss, lane, 2); ss += shxl(ss, lane, 4);
      const float rs = rsqrtf(ss * (1.f / 64) + EPS);
      const int unit = lane >> 3; const bool isk = unit >= 4; const int hh = isk ? unit - 4 : unit;
      const int d0 = (lane & 7) * 8;
      const float* gn = (grp == 0 ? gwn : gg) + (isk ? 64 : 0) + d0;
      if (lane < 48) {
#pragma unroll
        for (int e = 0; e < 8; ++e) y[e] = y[e] * rs * gn[e];
      }
      if (lat) {
#pragma unroll
        for (int e = 0; e < 8; ++e) part[e] = shxl(y[e], lane, 4);
        rope_pair8(y, part, (lane & 4) != 0, rowp + 32, rowp + 64, (lane & 3) * 8);
      }
      if (lane < 48) {
        bf16_t* base = grp == 0 ? (isk ? ((bf16_t*)(m.ws + OFF_KW)) : ((bf16_t*)(m.ws + OFF_QW))) : (isk ? ((bf16_t*)(m.ws + OFF_KG)) : ((bf16_t*)(m.ws + OFF_QG)));
        bf16_t* dst = base + (((size_t)b * (isk ? 2 : 4) + hh) * NT + p) * 64 + d0;
        *(uint4*)dst = pack8(y, isk ? 1.f : 0.125f * LOG2E);
      }
    }
    {
      const int vsrc = lane < 32 ? 512 + 8 * lane : (lane < 48 ? 1152 + 8 * (lane - 32) : 1664 + 8 * (lane - 48));
      uint4 w = *(const uint4*)(Pr + vsrc);
      *(uint2*)(Vs + rr * VS_STRIDE + lane * 16) = make_uint2(w.x, w.y);
      *(uint2*)(Vs + rr * VS_STRIDE + lane * 16 + 8) = make_uint2(w.z, w.w);
    }
  }
  __syncthreads();
  for (int tk = tid; tk < 2048; tk += NTHR) {
    const int pg = tk & 3; const int vch = (tk >> 2) & 15 | ((tk >> 6) << 4);
    unsigned short e[8];
#pragma unroll
    for (int i = 0; i < 8; ++i) {
      int sidx = 8 * pg + i;
      int pl = (sidx & 16) | perm16(sidx & 15);
      e[i] = *(const unsigned short*)(Vs + pl * VS_STRIDE + vch * 2);
    }
    uint4 w = make_uint4(e[0] | ((unsigned)e[1] << 16), e[2] | ((unsigned)e[3] << 16), e[4] | ((unsigned)e[5] << 16), e[6] | ((unsigned)e[7] << 16));
    bf16_t* dst;
    if (vch < 256) dst = ((bf16_t*)(m.ws + OFF_VAt)) + (((size_t)b * 4 + (vch >> 6)) * 64 + (vch & 63)) * NT;
    else if (vch < 384) dst = ((bf16_t*)(m.ws + OFF_VWt)) + (((size_t)b * 2 + ((vch - 256) >> 6)) * 64 + (vch & 63)) * NT;
    else dst = ((bf16_t*)(m.ws + OFF_VGt)) + (((size_t)b * 2 + ((vch - 384) >> 6)) * 64 + (vch & 63)) * NT;
    *(uint4*)(dst + p0 + 8 * pg) = w;
  }
  {
    const float* cw = ((const float*)m.hy_conv_w) + l * 3 * 768; const float* cb = ((const float*)m.hy_conv_b) + l * 768;
    const int cc = lane >> 3, pg = lane & 7;
#pragma unroll 2
    for (int cg = wid; cg < 96; cg += 8) {
      const int c = cg * 8 + cc;
      const float w0 = cw[c], w1 = cw[768 + c], w2 = cw[1536 + c], bb = cb[c];
      float xin[6];
#pragma unroll
      for (int i = 0; i < 6; ++i) xin[i] = bf2f(*(const bf16_t*)(Hs + (4 * pg + i) * HS_STRIDE + c * 2));
      float o[4];
#pragma unroll
      for (int i = 0; i < 4; ++i) o[i] = xin[i] * w0 + xin[i + 1] * w1 + xin[i + 2] * w2 + bb;
      *(float4*)(((float*)(m.ws + OFF_uT)) + ((size_t)b * 768 + c) * NT + p0 + 4 * pg) = make_float4(o[0], o[1], o[2], o[3]);
    }
  }
}

DI void hyena_ctx_channel(MKP m_in, int l, int c, char* smem) {
  const MK m = launder_mk(m_in);
  float* kf = (float*)smem;
  float* vz = kf + 1024;
  float* red = vz + 512;
  float* wcol = red + 16;
  const int tid = TID;
  const float* hd = ((float*)(m.ws + OFF_hdn2)) + (size_t)l * 64 * NT + SEQ;
  const float* w3 = m.hy_w3 + (size_t)l * 64 * 1024; const float* b3 = m.hy_b3 + l * 1024;
  __syncthreads();
  if (tid < 256) { int od = tid >> 6, i = tid & 63; wcol[i * 4 + od] = w3[i * 1024 + (od >> 1) * 512 + (od & 1) * 256 + c]; }
  __syncthreads();
  const float delta = fabsf(-3.0701134573253944f + (float)c * ((-15.350567286626972f + 3.0701134573253944f) / 255.f));
  float n0 = 0.f, n1 = 0.f;
  if (tid < 256) {
    const int j = tid;
    float f00 = b3[c], f01 = b3[256 + c], f10 = b3[512 + c], f11 = b3[768 + c];
#pragma unroll 4
    for (int i = 0; i < 64; ++i) {
      float hv = hd[(size_t)i * NT + j];
      const float4 w = *(const float4*)(wcol + 4 * i);
      f00 += hv * w.x; f01 += hv * w.y; f10 += hv * w.z; f11 += hv * w.w;
    }
    const float dec = __expf(-((float)j / (float)(CTX - 1)) * delta);
    f00 *= dec; f01 *= dec; f10 *= dec; f11 *= dec;
    kf[256 + j] = f00; kf[512 + 256 + j] = f10; n0 += fabsf(f00); n1 += fabsf(f10);
    if (j > 0) { kf[256 - j] = f01; kf[512 + 256 - j] = f11; n0 += fabsf(f01); n1 += fabsf(f11); }
    else { kf[0] = 0.f; kf[512] = 0.f; }
  }
  n0 = block_sum_512(n0, red);
  n1 = block_sum_512(n1, red);
  const float i0 = 1.f / n0, i1 = 1.f / n1;
  const int bb = tid >> 8, t = tid & 255;
  const float* ub = ((float*)(m.ws + OFF_uT)) + ((size_t)bb * 768 + c) * NT;
  const float vself = ub[t];
  vz[bb * 256 + t] = vself;
  __syncthreads();
  float acc = 0.f;
  for (int s2 = 0; s2 < 256; s2 += 4) { const float4 v4 = *(const float4*)(vz + bb * 256 + s2); const float* kp = kf + 256 + t - s2; acc += v4.x * kp[0] + v4.y * kp[-1] + v4.z * kp[-2] + v4.w * kp[-3]; }
  const float z = ub[(size_t)256 * NT + t] * (acc * i0 + m.hy_bias[l * 512 + c] * vself);
  __syncthreads();
  vz[bb * 256 + t] = z;
  __syncthreads();
  float acc2 = 0.f;
  for (int s2 = 0; s2 < 256; s2 += 4) { const float4 v4 = *(const float4*)(vz + bb * 256 + s2); const float* kp = kf + 512 + 256 + t - s2; acc2 += v4.x * kp[0] + v4.y * kp[-1] + v4.z * kp[-2] + v4.w * kp[-3]; }
  ((float*)(m.ws + OFF_yT))[((size_t)bb * 256 + c) * NT + t] = ub[(size_t)512 * NT + t] * (acc2 * i1 + m.hy_bias[l * 512 + 256 + c] * z);
}

DI void phase_mix(MKP m_in, int l, bool want_ctx, char* smem) {
  const MK m = launder_mk(m_in);
  AttnArgs a;
  a.QA = ((bf16_t*)(m.ws + OFF_QA)); a.KA = ((bf16_t*)(m.ws + OFF_KA)); a.VAt = ((bf16_t*)(m.ws + OFF_VAt)); a.QW = ((bf16_t*)(m.ws + OFF_QW)); a.KW = ((bf16_t*)(m.ws + OFF_KW)); a.VWt = ((bf16_t*)(m.ws + OFF_VWt)); a.QG = ((bf16_t*)(m.ws + OFF_QG)); a.KG = ((bf16_t*)(m.ws + OFF_KG)); a.VGt = ((bf16_t*)(m.ws + OFF_VGt));
  a.g_qk_diff = m.g_qk_diff + l * 64; a.g_qk_win = m.g_qk_win + l * 128; a.g_qk_glob = m.g_qk_glob + l * 128; a.sink = m.sink_win + l * 4;
  a.lambda_diff = m.lambda_diff + l * 128; a.g_mix_out = m.g_mix_out + l * D; a.lambda_init = 0.8f - 0.6f * __expf(-0.3f * (float)l); a.pad0 = 0;
  a.A2 = ((bf16_t*)(m.ws + OFF_A2)); a.Oslab = ((float*)(m.ws + OFF_Oslab)); a.Lslab = ((float*)(m.ws + OFF_Lslab));
  const int nitems = 640 + (want_ctx ? 20 : 0);
  for (int rep = 0; rep < REP_DIFF; ++rep) for (int idx = BID; idx < 256; idx += NBLK) attn_dispatch(a, idx, want_ctx, smem);
  for (int rep = 0; rep < REP_GLOB; ++rep) for (int idx = 256 + BID; idx < 512; idx += NBLK) attn_dispatch(a, idx, want_ctx, smem);
  for (int rep = 0; rep < REP_HY; ++rep) for (int c = BID; c < 256; c += NBLK) {
    hyena_channel(c, m.hy_bias + l * 512, ((float*)(m.ws + OFF_uT)), ((float*)(m.ws + OFF_zT)), ((float*)(m.ws + OFF_yT)), (const uint2*)(m.ws + OFF_Hc), smem);
    if (want_ctx) hyena_ctx_channel(m_in, l, c, smem);
  }
  for (int idx = 512 + BID; idx < nitems; idx += NBLK) attn_dispatch(a, idx, want_ctx, smem);
}

DI void phase_fin(MKP m_in, int l, bool want_ctx, char* smem) {
  const MK m = launder_mk(m_in);
  const float* gmo = m.g_mix_out + l * D;
  const int lane = TID & 63, wid = TID >> 6;
  char* wl = smem + wid * 9216;
  for (int chunk = BID * 8 + wid; chunk < NB * 8 * (NT / 64); chunk += NBLK * 8) {
    const int pc = chunk % (NT / 64), hd = (chunk / (NT / 64)) % 8, b = chunk / ((NT / 64) * 8);
    const int pbase = pc * 64;
    if (pbase < CTX && !want_ctx) continue;
    const float* gm = gmo + 512 + hd * 64;
    bf16_t* dst0 = ((bf16_t*)(m.ws + OFF_A2)) + ((size_t)b * NT + pbase) * D + 512 + hd * 64;
    if (hd < 4) {
      const int c4 = lane & 15, rr = lane >> 4;
      const float4 g4 = *(const float4*)(gm + 4 * c4);
      const size_t i0b = (((size_t)0 * NB + b) * 4 + hd) * NT + pbase, i1b = (((size_t)1 * NB + b) * 4 + hd) * NT + pbase;
      const float* Os = (const float*)(m.ws + OFF_Oslab); const float* Ls = (const float*)(m.ws + OFF_Lslab);
#pragma unroll 4
      for (int ps = 0; ps < 16; ++ps) {
        const int row = ps * 4 + rr;
        const float4 x = *(const float4*)(Os + (i0b + row) * 64 + 4 * c4), y = *(const float4*)(Os + (i1b + row) * 64 + 4 * c4);
        const float inv = 1.f / (Ls[i0b + row] + Ls[i1b + row]);
        const float o0 = (x.x + y.x) * inv, o1 = (x.y + y.y) * inv, o2 = (x.z + y.z) * inv, o3 = (x.w + y.w) * inv;
        float ss = o0 * o0 + o1 * o1 + o2 * o2 + o3 * o3;
        ss += shxl(ss, lane, 8); ss += shxl(ss, lane, 4); ss += shxl(ss, lane, 2); ss += shxl(ss, lane, 1);
        const float rs = rsqrtf(ss * (1.f / 64) + EPS);
        *(uint2*)(dst0 + (size_t)row * D + 4 * c4) = make_uint2(pk2bf(o0 * rs * g4.x, o1 * rs * g4.y), pk2bf(o2 * rs * g4.z, o3 * rs * g4.w));
      }
    } else {
      const int g = hd - 4, p = pbase + lane;
      float o[64]; float ss = 0.f;
#pragma unroll
      for (int i = 0; i < 64; ++i) o[i] = ((const float*)(m.ws + OFF_yT))[((size_t)b * 256 + g * 64 + i) * NT + p];
#pragma unroll
      for (int i = 0; i < 64; ++i) ss += o[i] * o[i];
      const float rs = rsqrtf(ss * (1.f / 64) + EPS);
#pragma unroll
      for (int i = 0; i < 8; ++i)
        *(uint4*)(wl + lane * 144 + i * 16) = make_uint4(pk2bf(o[8 * i] * rs * gm[8 * i], o[8 * i + 1] * rs * gm[8 * i + 1]), pk2bf(o[8 * i + 2] * rs * gm[8 * i + 2], o[8 * i + 3] * rs * gm[8 * i + 3]),
                                                         pk2bf(o[8 * i + 4] * rs * gm[8 * i + 4], o[8 * i + 5] * rs * gm[8 * i + 5]), pk2bf(o[8 * i + 6] * rs * gm[8 * i + 6], o[8 * i + 7] * rs * gm[8 * i + 7]));
      asm volatile("s_waitcnt lgkmcnt(0)" ::: "memory");
#pragma unroll
      for (int k = 0; k < 8; ++k) {
        const int row = k * 8 + (lane >> 3), ch = lane & 7;
        *(uint4*)(dst0 + (size_t)row * D + ch * 8) = *(const uint4*)(wl + row * 144 + ch * 16);
      }
      asm volatile("s_waitcnt lgkmcnt(0)" ::: "memory");
    }
  }
}

#ifndef PEER_SLICED
#define PEER_SLICED 1
#endif
#if !PEER_SLICED
DI void phase_peer(MKP m_in, int l, bool want_ctx, bool last, char* smem) {
  const MK m = launder_mk(m_in);
  const int lane = TID & 63, wid = TID >> 6;
  char* wbase = smem + wid * 10240;
  int* ex_l = (int*)wbase; float* g_l = (float*)(wbase + 4608); float* wd = (float*)(wbase + 9216);
  const float* modv_l = ((float*)(m.ws + OFF_modv)) + (size_t)l * 3 * NMOD;
  const int gw0 = BID * 8 + wid, nw0 = NBLK * 8;
  for (int i0 = 0; gw0 + nw0 * i0 < R && i0 < 9; i0 += 8) {
    const int slot = i0 + (lane >> 3);
    const int r = gw0 + nw0 * slot;
    if (slot < 9 && r < R && !((r % NT) < CTX && !want_ctx))
      merge_one(((unsigned*)(m.ws + OFF_topv)), r, lane & 7, ex_l + slot * 128, g_l + slot * 128);
  }
  int slot = 0;
  for (int r = gw0; r < R; r += nw0, ++slot) {
    if ((r % NT) < CTX && !want_ctx) continue;
    if (slot >= 9) {
      if (lane < 8) merge_one(((unsigned*)(m.ws + OFF_topv)), r, lane, ex_l + 8 * 128, g_l + 8 * 128);
    }
    const int sl = slot < 9 ? slot : 8;
    peer_token<PEER_SLICED>(r, ((bf16_t*)(m.ws + OFF_hbuf)), ex_l + sl * 128, g_l + sl * 128, ((unsigned char*)(m.ws + OFF_u8)) + (size_t)l * 16384 * D, ((float*)(m.ws + OFF_us)) + l * 16384, ((unsigned char*)(m.ws + OFF_v8)) + (size_t)l * 16384 * D, ((float*)(m.ws + OFF_vs)) + l * 16384,
               modv_l, ((float*)(m.ws + OFF_xs)), wd, last ? m.out : nullptr, ((int*)(m.ws + OFF_experts)), ((float*)(m.ws + OFF_gates)));
  }
}
#endif
DI void peer_v_rows(const MK& m, int l, bool want_ctx, bool last, int vslice_, int w0, int wstride) {
  const int lane = TID & 63, g = lane >> 3, j = lane & 7;
  const int vslice = __builtin_amdgcn_readfirstlane(vslice_);
  const unsigned char* v8u = ((const unsigned char*)(m.ws + OFF_v8)) + (size_t)l * 16384 * D + (size_t)vslice * TSLICE;
  const unsigned j16 = (unsigned)j * 16u;
  const unsigned* wts = (const unsigned*)(m.ws + OFF_gates);
  const float* modv_l = ((const float*)(m.ws + OFF_modv)) + (size_t)l * 3 * NMOD;
  float* xs = (float*)(m.ws + OFF_xs);
#pragma unroll 1
  for (int r = w0; r < R; r += wstride) {
    const int b = r / NT, p = r % NT;
    if (p < CTX && !want_ctx) continue;
    unsigned pkv[16];
    {
      const uint4* ep = (const uint4*)(wts + (size_t)r * 128 + 16 * g);
#pragma unroll
      for (int q = 0; q < 4; ++q) { const uint4 e4 = ep[q]; pkv[4 * q] = e4.x; pkv[4 * q + 1] = e4.y; pkv[4 * q + 2] = e4.z; pkv[4 * q + 3] = e4.w; }
    }
    const float invS = ((const float*)(m.ws + OFF_wsc))[r];
    const int col = 256 * (g >> 1) + 32 * vslice + 4 * j + 2 * (g & 1);
    const int mrow = p < CTX ? 2 : b;
    const float2 gg = *(const float2*)(modv_l + mrow * NMOD + 5 * D + col);
    float2 xv = *(const float2*)(xs + (size_t)r * D + col);
    uint4 rw[16];
#pragma unroll
    for (int q = 0; q < 16; ++q) {
      unsigned off;
      asm("v_mad_u32_u16 %0, %1, %2, %3" : "=v"(off) : "v"(pkv[q]), "s"(128u), "v"(j16));
      rw[q] = *(const uint4*)(v8u + off);
    }
    h2_t hacc[8];
#pragma unroll
    for (int i = 0; i < 8; ++i) hacc[i] = (h2_t){(_Float16)0.f, (_Float16)0.f};
#pragma unroll
    for (int q = 0; q < 16; ++q) {
      const h2_t pk2 = __builtin_bit_cast(h2_t, pkv[q]);
      const h2_t w2 = __builtin_shufflevector(pk2, pk2, 1, 1);
      const int r4[4] = {(int)rw[q].x, (int)rw[q].y, (int)rw[q].z, (int)rw[q].w};
#pragma unroll
      for (int c = 0; c < 4; ++c) {
        hacc[2 * c] = __builtin_elementwise_fma(__builtin_bit_cast(h2_t, __builtin_amdgcn_cvt_scalef32_pk_f16_fp8(r4[c], 1.0f, false)), w2, hacc[2 * c]);
        hacc[2 * c + 1] = __builtin_elementwise_fma(__builtin_bit_cast(h2_t, __builtin_amdgcn_cvt_scalef32_pk_f16_fp8(r4[c], 1.0f, true)), w2, hacc[2 * c + 1]);
      }
    }
    h2_t b4[4], c2[2], d1;
    {
      const bool g2 = lane & 32, g1 = lane & 16, g0 = lane & 8;
#pragma unroll
      for (int i = 0; i < 4; ++i) {
        const int send = __builtin_bit_cast(int, g2 ? hacc[i] : hacc[4 + i]); const h2_t keep = g2 ? hacc[4 + i] : hacc[i];
        b4[i] = keep + __builtin_bit_cast(h2_t, shxl(send, lane, 32));
      }
#pragma unroll
      for (int i = 0; i < 2; ++i) {
        const int send = __builtin_bit_cast(int, g1 ? b4[i] : b4[2 + i]); const h2_t keep = g1 ? b4[2 + i] : b4[i];
        c2[i] = keep + __builtin_bit_cast(h2_t, shxl(send, lane, 16));
      }
      {
        const int send = __builtin_bit_cast(int, g0 ? c2[0] : c2[1]); const h2_t keep = g0 ? c2[1] : c2[0];
        d1 = keep + __builtin_bit_cast(h2_t, shxl(send, lane, 8));
      }
    }
    {
      xv.x += gg.x * ((float)d1[0] * invS); xv.y += gg.y * ((float)d1[1] * invS);
      float* op = last ? m.out + ((size_t)b * SEQ + (p - CTX)) * D + col : xs + (size_t)r * D + col;
      *(float2*)op = xv;
    }
  }
}
DI void phase_peer_merge(MKP m_in, bool want_ctx, char* smem) {
  const MK m = launder_mk(m_in);
  const int lane = TID & 63, wid = TID >> 6;
  char* wbase = smem + wid * 8192;
  int* ex_l = (int*)wbase; float* g_l = (float*)(wbase + 4096);
  int* experts = (int*)(m.ws + OFF_experts); float* gates = (float*)(m.ws + OFF_gates);
  for (int grp = BID * 8 + wid; grp < R / 8; grp += NBLK * 8) {
    const int r = grp * 8 + (lane >> 3);
    const bool skip = ((r % NT) < CTX) && !want_ctx;
    if (skip) continue;
    merge_one(((unsigned*)(m.ws + OFF_topv)), r, lane & 7, ex_l + (lane >> 3) * 128, g_l + (lane >> 3) * 128);
    asm volatile("s_waitcnt lgkmcnt(0)" ::: "memory");
#pragma unroll
    for (int q = 0; q < 4; ++q) {
      const int idx = (q * 64 + lane) * 4;
      *(uint4*)(experts + (size_t)grp * 1024 + idx) = *(const uint4*)(ex_l + idx);
      *(float4*)(gates + (size_t)grp * 1024 + idx) = *(const float4*)(g_l + idx);
    }
    asm volatile("s_waitcnt lgkmcnt(0)" ::: "memory");
  }
}
DI void peer_u_rows(const MK& m, int l, bool want_ctx, int vslice_, int w0, int wstride) {
  const int lane = TID & 63, g = lane >> 3, j = lane & 7;
  const int vslice = __builtin_amdgcn_readfirstlane(vslice_);
  const unsigned char* u8 = ((const unsigned char*)(m.ws + OFF_u8)) + (size_t)l * 16384 * D + (size_t)vslice * TSLICE;
  const unsigned char* xq = (const unsigned char*)(m.ws + OFF_xq);
  const unsigned loff = (unsigned)(vslice * 128 + j * 16);
  const unsigned j16 = (unsigned)j * 16u;
  const int* experts = (const int*)(m.ws + OFF_experts);
  int* PD = ((int*)(m.ws + OFF_P)) + (size_t)vslice * R * 128;
#pragma unroll 1
  for (int r = w0; r < R; r += wstride) {
    if (((r % NT) < CTX) && !want_ctx) continue;
    uint4 rw[16];
    {
      const uint4* ep = (const uint4*)((const unsigned short*)experts + (size_t)r * 128 + 16 * g);
      const uint4 ea = ep[0], eb = ep[1];
      const unsigned ew[8] = {ea.x, ea.y, ea.z, ea.w, eb.x, eb.y, eb.z, eb.w};
#pragma unroll
      for (int q = 0; q < 8; ++q) {
        unsigned o0, o1;
        asm("v_mad_u32_u16 %0, %1, %2, %3" : "=v"(o0) : "v"(ew[q]), "s"(128u), "v"(j16));
        asm("v_mad_u32_u16 %0, %1, %2, %3 op_sel:[1,0,0,0]" : "=v"(o1) : "v"(ew[q]), "s"(128u), "v"(j16));
        rw[2 * q] = *(const uint4*)(u8 + o0);
        rw[2 * q + 1] = *(const uint4*)(u8 + o1);
      }
    }
    const uint4 xv = *(const uint4*)(xq + (size_t)r * D + loff);
    int pd[16];
#pragma unroll
    for (int q = 0; q < 16; ++q) {
      int a = __builtin_amdgcn_sdot4((int)rw[q].x, (int)xv.x, 0, false);
      a = __builtin_amdgcn_sdot4((int)rw[q].y, (int)xv.y, a, false);
      a = __builtin_amdgcn_sdot4((int)rw[q].z, (int)xv.z, a, false);
      pd[q] = __builtin_amdgcn_sdot4((int)rw[q].w, (int)xv.w, a, false);
    }
    int b8[8], c4[4], d2[2];
    {
      const bool j2 = lane & 4, j1 = lane & 2, j0 = lane & 1;
#pragma unroll
      for (int i = 0; i < 8; ++i) { const int send = j2 ? pd[i] : pd[8 + i], keep = j2 ? pd[8 + i] : pd[i]; b8[i] = keep + shxl(send, lane, 4); }
#pragma unroll
      for (int i = 0; i < 4; ++i) { const int send = j1 ? b8[i] : b8[4 + i], keep = j1 ? b8[4 + i] : b8[i]; c4[i] = keep + shxl(send, lane, 2); }
#pragma unroll
      for (int i = 0; i < 2; ++i) { const int send = j0 ? c4[i] : c4[2 + i], keep = j0 ? c4[2 + i] : c4[i]; d2[i] = keep + shxl(send, lane, 1); }
    }
    *(int2*)(PD + (size_t)r * 128 + 16 * g + 2 * j) = make_int2(d2[0], d2[1]);
  }
}
DI void phase_peer_u(MKP m_in, int l, bool want_ctx, char* smem) {
  const MK m = launder_mk(m_in);
  unsigned* bar = (unsigned*)(m.ws + OFF_bar);
  volatile LAS unsigned* st = (volatile LAS unsigned*)(smem + SMEM_BYTES);
  if (threadIdx.x == 0) {
    unsigned ok = 1u, mine = 0u; const unsigned x = st[3];
    for (unsigned q = 0; q < 16; ++q) { const unsigned c = xb_ld(&bar[XB_XCNT(q)]); if ((q < 8) != (c > 0u)) ok = 0u; if (q == x) mine = c; }
    st[4] = ok ? mine : 0u;
  }
  __syncthreads();
  const unsigned nloc = st[4];
  const int wid = TID >> 6;
  if (nloc != 0u) peer_u_rows(m, l, want_ctx, (int)(st[3] & 7u), (int)st[2] * 8 + wid, (int)nloc * 8);
  else for (int v = 0; v < 8; ++v) peer_u_rows(m, l, want_ctx, v, BID * 8 + wid, NBLK * 8);
}
DI void phase_peer_reduce(MKP m_in, int l, bool want_ctx) {
  const MK m = launder_mk(m_in);
  const int* experts = (const int*)(m.ws + OFF_experts);
  float* gates = (float*)(m.ws + OFF_gates);
  const int* PD = (const int*)(m.ws + OFF_P);
  const float* us = ((const float*)(m.ws + OFF_us)) + l * 16384;
  const float* vs = ((const float*)(m.ws + OFF_vs)) + l * 16384;
  const float* xqs = (const float*)(m.ws + OFF_xqs);
  for (int i4 = BID * NTHR + TID; i4 < R * 32; i4 += NBLK * NTHR) {
    const int r = i4 >> 5;
    if (((r % NT) < CTX) && !want_ctx) continue;
    int4 acc = make_int4(0, 0, 0, 0);
#pragma unroll
    for (int v = 0; v < 8; ++v) { const int4 p = ((const int4*)(PD + (size_t)v * R * 128))[i4]; acc.x += p.x; acc.y += p.y; acc.z += p.z; acc.w += p.w; }
    const uint2 e2 = ((const uint2*)experts)[i4];
    const int4 e4 = make_int4((int)(e2.x & 0xffffu), (int)(e2.x >> 16), (int)(e2.y & 0xffffu), (int)(e2.y >> 16));
    float4 g4 = ((const float4*)gates)[i4];
    const float xs_ = xqs[r];
    const int ee[4] = {e4.x, e4.y, e4.z, e4.w}; const int aa[4] = {acc.x, acc.y, acc.z, acc.w}; float gg[4] = {g4.x, g4.y, g4.z, g4.w};
#pragma unroll
    for (int q = 0; q < 4; ++q) {
      const float d = (float)aa[q] * (us[ee[q]] * xs_);
      const float t = 0.5f * d * (1.f + tanhf(0.7978845608028654f * (d + 0.044715f * d * d * d)));
      gg[q] = gg[q] * t * vs[ee[q]];
    }
    const int lane = TID & 63;
    float mxw = fmaxf(fmaxf(fabsf(gg[0]), fabsf(gg[1])), fmaxf(fabsf(gg[2]), fabsf(gg[3])));
    mxw = fmaxf(mxw, shxl(mxw, lane, 1)); mxw = fmaxf(mxw, shxl(mxw, lane, 2)); mxw = fmaxf(mxw, shxl(mxw, lane, 4));
    mxw = fmaxf(mxw, shxl(mxw, lane, 8)); mxw = fmaxf(mxw, shxl(mxw, lane, 16));
    const unsigned eb = (__float_as_uint(mxw) >> 23) & 255u;
    const float Sw = __uint_as_float((252u - eb) << 23);
    unsigned pk[4];
#pragma unroll
    for (int q = 0; q < 4; ++q) {
      const _Float16 wh = (_Float16)(gg[q] * Sw);
      pk[q] = (unsigned)ee[q] | ((unsigned)__builtin_bit_cast(unsigned short, wh) << 16);
    }
    ((uint4*)gates)[i4] = make_uint4(pk[0], pk[1], pk[2], pk[3]);
    if ((i4 & 31) == 0) ((float*)(m.ws + OFF_wsc))[r] = __uint_as_float(eb == 0u ? 0u : ((eb + 2u) << 23));
  }
}
DI void phase_peer_v(MKP m_in, int l, bool want_ctx, bool last, char* smem) {
  const MK m = launder_mk(m_in);
  unsigned* bar = (unsigned*)(m.ws + OFF_bar);
  volatile LAS unsigned* st = (volatile LAS unsigned*)(smem + SMEM_BYTES);
  if (threadIdx.x == 0) {
    unsigned ok = 1u, mine = 0u; const unsigned x = st[3];
    for (unsigned q = 0; q < 16; ++q) { const unsigned c = xb_ld(&bar[XB_XCNT(q)]); if ((q < 8) != (c > 0u)) ok = 0u; if (q == x) mine = c; }
    st[1 + 3 + 0] = ok ? mine : 0u;
  }
  __syncthreads();
  const unsigned nloc = st[4];
  const int wid = TID >> 6;
  if (nloc != 0u) {
    peer_v_rows(m, l, want_ctx, last, (int)(st[3] & 7u), (int)st[2] * 8 + wid, (int)nloc * 8);
  } else {
    for (int v = 0; v < 8; ++v) peer_v_rows(m, l, want_ctx, last, v, BID * 8 + wid, NBLK * 8);
  }
}

DI void phase_scores(MKP m_in, int l, bool last, char* smem) {
  const MK m = launder_mk(m_in);
  const int nrt = last ? 128 : 132;
  for (int t = BID; t < nrt * 8; t += NBLK)
    score_head_item(((bf16_t*)(m.ws + OFF_P)), ((bf16_t*)(m.ws + OFF_keysb)) + (size_t)l * 16 * 128 * 128, rowtile_of(t >> 3, last) * 128, t & 7, smem,
                    ((int*)(m.ws + OFF_experts)), ((float*)(m.ws + OFF_gates)));
}
DI void phase_gemm1(MKP m_in, int l, char* smem) {
  const MK m = launder_mk(m_in);
  pg8::Gemm g; g.A = (bf16_t*)(m.ws + OFF_hbuf); g.Bt = (bf16_t*)(m.ws + OFF_Wt_in) + (size_t)l * DIN * D; g.M = R; g.N = DIN; g.K = D;
  MySched S; S.init(DIN, false, NBLK, BID);
  EpiStoreBf16 E; E.Cb = (bf16_t*)(m.ws + OFF_P); E.ldc = DIN;
  __syncthreads();
  pg8::gemm_phase<EpiStoreBf16, MySched, false>((PG8_LAS unsigned char*)smem, g, S, E, nullptr);
  __syncthreads();
}
DI int ctx_rowtile(int i) { return (i >> 1) * 66 + (i & 1); }
DI void phase_gemm2(MKP m_in, int l, bool last, char* smem) {
  const MK m = launder_mk(m_in);
  pg8::Gemm g; g.A = (bf16_t*)(m.ws + OFF_A2); g.Bt = (bf16_t*)(m.ws + OFF_Wt_out) + (size_t)l * D * D; g.M = R; g.N = D; g.K = D;
  MySched S; S.init(D, true, NBLK, BID);
  EpiResidual E; E.xs = (float*)(m.ws + OFF_xs); E.gate_base = (float*)(m.ws + OFF_modv) + (size_t)l * 3 * NMOD + 2 * D;
  E.xin = l == 0 ? m.x : nullptr; E.ctxin = l == 0 ? m.ctx : nullptr;
  __syncthreads();
  pg8::gemm_phase<EpiResidual, MySched, false>((PG8_LAS unsigned char*)smem, g, S, E, nullptr);
  __syncthreads();
  if (!last) {
    const int nb = NBLK;
    for (int t = (BID + nb - 32) % nb; t < 4 * 8; t += nb)
      gemm_tile<1>(g.A, g.Bt, D, ctx_rowtile(t >> 3) * 128, (t & 7) * 128, smem, nullptr, E.xs, E.gate_base, E.xin, E.ctxin);
  }
}
DI void phase_gemm3(MKP m_in, int l, bool last, char* smem) {
  const MK m = launder_mk(m_in);
  pg8::Gemm g; g.A = (bf16_t*)(m.ws + OFF_hbuf); g.Bt = (bf16_t*)(m.ws + OFF_Wt_q) + (size_t)l * 2048 * D; g.M = R; g.N = 2048; g.K = D;
  MySched S; S.init(2048, true, NBLK, BID);
  EpiStoreBf16 E; E.Cb = (bf16_t*)(m.ws + OFF_P); E.ldc = 2048;
  __syncthreads();
  pg8::gemm_phase<EpiStoreBf16, MySched, false>((PG8_LAS unsigned char*)smem, g, S, E, nullptr);
  __syncthreads();
  if (!last) {
    const int nb = NBLK;
    for (int t = (BID + nb - 64) % nb; t < 4 * 16; t += nb)
      gemm_tile<0>(g.A, g.Bt, 2048, ctx_rowtile(t >> 4) * 128, (t & 15) * 128, smem, E.Cb, nullptr, nullptr);
  }
}
#define GSYNC() xcd_barrier((unsigned*)(launder_mk(m).ws + OFF_bar), (volatile LAS unsigned*)(smem + SMEM_BYTES))
DI void phase_filters(MKP m_in, int l, char* smem) {
  const MK m = launder_mk(m_in);
  for (int c = BID; c < 256; c += NBLK)
    hyena_filter_task(c, ((const bf16_t*)(m.ws + OFF_hdnB)) + (size_t)l * SEQ * 64, ((const bf16_t*)(m.ws + OFF_W3t)) + (size_t)l * 1024 * 64, m.hy_b3 + l * 1024, (uint2*)(m.ws + OFF_Hc), smem);
}
template <int L>
DI void layer_body(MKP m, char* smem) {
  constexpr bool want_ctx = L == 0, last = L == 1;
  for (int rep = 0; rep < REP_NORM1; ++rep) { phase_norm(m, L, 0, L == 0, false); GSYNC(); }
  for (int rep = 0; rep < REP_GEMM1; ++rep) { phase_gemm1(m, L, smem); GSYNC(); }
  for (int rep = 0; rep < REP_PREP; ++rep) for (int t = BID; t < R / 32; t += NBLK) prep_tile(m, L, t, smem);
  for (int rep = 0; rep < REP_FILT; ++rep) phase_filters(m, L, smem);
  GSYNC();
  for (int rep = 0; rep < REP_MIX; ++rep) { phase_mix(m, L, want_ctx, smem); GSYNC(); }
  for (int rep = 0; rep < REP_FIN; ++rep) { phase_fin(m, L, want_ctx, smem); GSYNC(); }
  phase_gemm2(m, L, last, smem);
  GSYNC();
  for (int rep = 0; rep < REP_NORM2; ++rep) { phase_norm(m, L, 1, false, last); GSYNC(); }
  for (int rep = 0; rep < REP_GEMM3; ++rep) { phase_gemm3(m, L, last, smem); GSYNC(); }
  for (int rep = 0; rep < REP_SCORES; ++rep) { phase_scores(m, L, last, smem); GSYNC(); }
  for (int rep = 0; rep < (last ? REP_PEER_LAST : 1); ++rep) {
#if PEER_SLICED
    for (int ru = 0; ru < (last ? REP_PEER_U : 1); ++ru) phase_peer_u(m, L, want_ctx, smem);
    GSYNC();
    phase_peer_reduce(m, L, want_ctx);
    GSYNC();
    for (int rv = 0; rv < (last ? REP_PEER_V : 1); ++rv) phase_peer_v(m, L, want_ctx, last, smem);
#else
    phase_peer(m, L, want_ctx, last, smem);
#endif
    if (!last || rep + 1 < REP_PEER_LAST) GSYNC();
  }
}
__global__ __launch_bounds__(NTHR) void k_mega(MK m_unused) {
  extern __shared__ __attribute__((aligned(16))) char smem[];
  (void)m_unused;
  MKP m = (MKP)__builtin_amdgcn_kernarg_segment_ptr();
  {
    volatile LAS unsigned* st = (volatile LAS unsigned*)(smem + SMEM_BYTES);
    if (threadIdx.x == 0) { st[0] = 0u; st[1] = 0u; st[2] = 0u; st[3] = 0u; st[4] = 0u; st[5] = 0u; }
    __syncthreads();
    xcd_barrier_post((unsigned*)(launder_mk(m).ws + OFF_bar), st);
  }
  for (int rep = 0; rep < REP_P0; ++rep) { phase0(m, smem); GSYNC(); }
  layer_body<0>(m, smem);
  layer_body<1>(m, smem);
}

extern "C" void kernel_launch(void* const* d_in, const int* in_sizes, int n_in, void* d_out, int out_size, void* d_ws, size_t ws_size,
                              hipStream_t stream) {
  (void)in_sizes; (void)n_in; (void)out_size;
  MK m;
  memset(&m, 0, sizeof(m));
  const float** ip = (const float**)&m.x;
  for (int i = 0; i < 30; ++i) ip[i] = (const float*)d_in[i];
  m.out = (float*)d_out;
  m.ws = (char*)d_ws;
  if (WS_TOTAL > ws_size) return;

  static int grid_blocks = 0;
  if (!grid_blocks) {
    (void)hipFuncSetAttribute((const void*)k_mega, hipFuncAttributeMaxDynamicSharedMemorySize, SMEM_BYTES + 32);
    int dev = 0, cus = 0, per_cu = 0;
    (void)hipGetDevice(&dev);
    (void)hipDeviceGetAttribute(&cus, hipDeviceAttributeMultiprocessorCount, dev);
    (void)hipOccupancyMaxActiveBlocksPerMultiprocessor(&per_cu, k_mega, NTHR, SMEM_BYTES + 32);
    if (per_cu > 1) per_cu = 1;
    grid_blocks = cus * per_cu;
  }
  (void)hipMemsetAsync(m.ws + OFF_bar, 0, (size_t)XCD_BAR_WORDS * 4, stream);
  void* args[] = {&m};
  (void)hipLaunchCooperativeKernel((void*)k_mega, dim3(grid_blocks), dim3(NTHR), args, SMEM_BYTES + 32, stream);
}
```

```cpp
#include <hip/hip_runtime.h>
#ifndef REP_DIFF
#define REP_DIFF 1
#endif
#ifndef REP_GLOB
#define REP_GLOB 1
#endif
#ifndef REP_HY
#define REP_HY 1
#endif
#ifndef REP_FILT
#define REP_FILT 1
#endif
#ifndef REP_PEER_U
#define REP_PEER_U 1
#endif
#ifndef REP_PEER_V
#define REP_PEER_V 1
#endif
#ifndef REP_NORM1
#define REP_NORM1 1
#endif
#ifndef REP_GEMM1
#define REP_GEMM1 1
#endif
#ifndef REP_PREP
#define REP_PREP 1
#endif
#ifndef REP_MIX
#define REP_MIX 1
#endif
#ifndef REP_FIN
#define REP_FIN 1
#endif
#ifndef REP_NORM2
#define REP_NORM2 1
#endif
#ifndef REP_GEMM3
#define REP_GEMM3 1
#endif
#ifndef REP_SCORES
#define REP_SCORES 1
#endif
#ifndef REP_MERGE
#define REP_MERGE 1
#endif
#ifndef REP_PEER_LAST
#define REP_PEER_LAST 1
#endif
#ifndef REP_P0
#define REP_P0 1
#endif
#include <hip/hip_cooperative_groups.h>
namespace cg = cooperative_groups;
#include <stdint.h>
#include <string.h>

#define DI __device__ __forceinline__
#define LAS __attribute__((address_space(3)))
typedef unsigned short bf16_t;

constexpr int D = 1024;
constexpr int NB = 2;
constexpr int SEQ = 8192;
constexpr int CTX = 256;
constexpr int NT = SEQ + CTX;
constexpr int R = NB * NT;
constexpr int DIN = 2560;
constexpr int NMOD = 6 * D;
constexpr float EPS = 1e-6f;
constexpr float LOG2E = 1.4426950408889634f;

DI int opq_v(int x) { asm volatile("" : "+v"(x)); return x; }
DI int opq_s(int x) { asm volatile("" : "+s"(x)); return x; }
template <class T> DI T* opq_p(T* p) { asm volatile("" : "+s"(p)); return p; }
#define TID opq_v((int)threadIdx.x)
#define BID opq_s((int)blockIdx.x)
#define NBLK opq_s((int)gridDim.x)
DI float shxl(float v, int lane, int mask) { return __builtin_bit_cast(float, __builtin_amdgcn_ds_bpermute((lane ^ mask) << 2, __builtin_bit_cast(int, v))); }
DI int shxl(int v, int lane, int mask) { return __builtin_amdgcn_ds_bpermute((lane ^ mask) << 2, v); }
DI float shx(float v, int mask) { return shxl(v, opq_v((int)threadIdx.x) & 63, mask); }
DI bf16_t f2bf(float x) { unsigned u = __float_as_uint(x); u += 0x7fffu + ((u >> 16) & 1u); return (bf16_t)(u >> 16); }
DI float bf2f(bf16_t h) { return __uint_as_float(((unsigned)h) << 16); }
DI float bflo(unsigned w) { return __uint_as_float(w << 16); }
DI float bfhi(unsigned w) { return __uint_as_float(w & 0xffff0000u); }

DI float block_sum_256(float v, float* red) {
  for (int o = 32; o > 0; o >>= 1) v += shx(v, o);
  int w = TID >> 6;
  __syncthreads();
  if ((TID & 63) == 0) red[w] = v;
  __syncthreads();
  float s = red[0] + red[1] + red[2] + red[3];
  return s;
}

DI int perm16(int o) { return (o & 3) | ((o & 4) << 1) | ((o & 8) >> 1); }

typedef __attribute__((ext_vector_type(8))) short bf16x8;
typedef __attribute__((ext_vector_type(16))) float f32x16;
typedef __attribute__((ext_vector_type(2))) __bf16 bf16x2_t;
typedef __attribute__((ext_vector_type(2))) float f32x2_t;
#define MFMA32(a, b, c) __builtin_amdgcn_mfma_f32_32x32x16_bf16((a), (b), (c), 0, 0, 0)
DI unsigned pk2bf(float a, float b) { f32x2_t v = {a, b}; return __builtin_bit_cast(unsigned, __builtin_convertvector(v, bf16x2_t)); }
constexpr int NTHR = 512;

DI void wconv_tile(const float* __restrict__ W, bf16_t* __restrict__ Wt, int N, int tile, float* sm  ) {
  int tn = tile % (N / 64), tk = tile / (N / 64);
  int tid = TID;
  __syncthreads();
  for (int i = tid; i < 64 * 16; i += NTHR) {
    int kr = i >> 4, c4 = (i & 15) * 4;
    float4 v = *(const float4*)(W + (size_t)(tk * 64 + kr) * N + tn * 64 + c4);
    sm[kr * 65 + c4] = v.x; sm[kr * 65 + c4 + 1] = v.y; sm[kr * 65 + c4 + 2] = v.z; sm[kr * 65 + c4 + 3] = v.w;
  }
  __syncthreads();
  for (int i = tid; i < 64 * 8; i += NTHR) {
    int n = i >> 3, k8 = (i & 7) * 8;
    unsigned w[4];
    for (int j = 0; j < 4; ++j) w[j] = pk2bf(sm[(k8 + 2 * j) * 65 + n], sm[(k8 + 2 * j + 1) * 65 + n]);
    *(uint4*)(Wt + (size_t)(tn * 64 + n) * D + tk * 64 + k8) = make_uint4(w[0], w[1], w[2], w[3]);
  }
}

template <int EPI, int K = D>
DI void gemm_tile(const bf16_t* __restrict__ A, const bf16_t* __restrict__ Wt, int N, int m0, int n0, char* smem, bf16_t* __restrict__ Cb,
                  float* __restrict__ xs, const float* __restrict__ gate_base, const float* __restrict__ xin = nullptr, const float* __restrict__ ctxin = nullptr) {
  const int tid = TID, lane = tid & 63, wid = tid >> 6;
  const int wm = wid & 1, wn = wid >> 1;
  const int r = lane & 31, h = lane >> 5;
  f32x16 acc0, acc1;
  for (int i = 0; i < 16; ++i) { acc0[i] = 0.f; acc1[i] = 0.f; }
  const int lrow = tid >> 3, lch = tid & 7;
  const bf16_t* Ag = A + (size_t)(m0 + lrow) * K + lch * 8;
  const bf16_t* Bg = Wt + (size_t)(n0 + lrow) * K + lch * 8;
  const int woff = lrow * 128 + ((lch ^ ((lrow >> 1) & 7)) << 4);
  uint4 ra0, ra1, rb0, rb1;
  ra0 = *(const uint4*)(Ag); ra1 = *(const uint4*)(Ag + (size_t)64 * K);
  rb0 = *(const uint4*)(Bg); rb1 = *(const uint4*)(Bg + (size_t)64 * K);
  __syncthreads();
  *(uint4*)(smem + woff) = ra0; *(uint4*)(smem + woff + 8192) = ra1;
  *(uint4*)(smem + 16384 + woff) = rb0; *(uint4*)(smem + 16384 + woff + 8192) = rb1;
  __syncthreads();
  const int sw = (r >> 1) & 7;
  const int aoff0 = (wm * 64 + r) * 128, aoff1 = aoff0 + 32 * 128;
  const int boff = 16384 + (wn * 32 + r) * 128;
#pragma unroll 1
  for (int kt = 0; kt < K / 64; ++kt) {
    const char* st = smem + (kt & 1) * 32768;
    if (kt + 1 < K / 64) {
      ra0 = *(const uint4*)(Ag + (kt + 1) * 64); ra1 = *(const uint4*)(Ag + (size_t)64 * K + (kt + 1) * 64);
      rb0 = *(const uint4*)(Bg + (kt + 1) * 64); rb1 = *(const uint4*)(Bg + (size_t)64 * K + (kt + 1) * 64);
    }
#pragma unroll
    for (int s = 0; s < 4; ++s) {
      int co = ((2 * s + h) ^ sw) << 4;
      bf16x8 a0 = *(const bf16x8*)(st + aoff0 + co);
      bf16x8 a1 = *(const bf16x8*)(st + aoff1 + co);
      bf16x8 b = *(const bf16x8*)(st + boff + co);
      acc0 = MFMA32(a0, b, acc0);
      acc1 = MFMA32(a1, b, acc1);
    }
    if (kt + 1 < K / 64) {
      char* sn = smem + ((kt + 1) & 1) * 32768;
      *(uint4*)(sn + woff) = ra0; *(uint4*)(sn + woff + 8192) = ra1;
      *(uint4*)(sn + 16384 + woff) = rb0; *(uint4*)(sn + 16384 + woff + 8192) = rb1;
    }
    __syncthreads();
  }
  float* Cs = (float*)smem;
  constexpr int CS = 132;
#pragma unroll
  for (int i = 0; i < 16; ++i) {
    int row = (i & 3) + 8 * (i >> 2) + 4 * h;
    Cs[(wm * 64 + row) * CS + wn * 32 + r] = acc0[i];
    Cs[(wm * 64 + 32 + row) * CS + wn * 32 + r] = acc1[i];
  }
  __syncthreads();
  if (EPI == 0) {
    for (int i = tid; i < 128 * 16; i += NTHR) {
      int row = i >> 4, c8 = (i & 15) * 8;
      const float* cr = Cs + row * CS + c8;
      float4 v0 = *(const float4*)cr, v1 = *(const float4*)(cr + 4);
      *(uint4*)(Cb + (size_t)(m0 + row) * N + n0 + c8) = make_uint4(pk2bf(v0.x, v0.y), pk2bf(v0.z, v0.w), pk2bf(v1.x, v1.y), pk2bf(v1.z, v1.w));
    }
  } else if (EPI == 2) {
    for (int i = tid; i < 128 * 32; i += NTHR) {
      const int col = i >> 5, r4 = (i & 31) * 4;
      const float4 v = make_float4(Cs[r4 * CS + col], Cs[(r4 + 1) * CS + col], Cs[(r4 + 2) * CS + col], Cs[(r4 + 3) * CS + col]);
      *(float4*)(xs + (size_t)(n0 + col) * N + m0 + r4) = v;
    }
  } else {
    for (int i = tid; i < 128 * 32; i += NTHR) {
      int row = i >> 5, c4 = (i & 31) * 4;
      int rr = m0 + row; int b = rr / NT, p = rr % NT; int mrow = p < CTX ? 2 : b;
      const float* gt = gate_base + mrow * NMOD + n0 + c4;
      float4 v = *(const float4*)(Cs + row * CS + c4);
      const float* rsrc = xin ? (p < CTX ? ctxin + ((size_t)b * CTX + p) * D : xin + ((size_t)b * SEQ + (p - CTX)) * D) : xs + (size_t)rr * D;
      float4 xv = *(const float4*)(rsrc + n0 + c4);
      xv.x += gt[0] * v.x; xv.y += gt[1] * v.y; xv.z += gt[2] * v.z; xv.w += gt[3] * v.w;
      *(float4*)(xs + (size_t)rr * D + n0 + c4) = xv;
    }
  }
}


struct AttnArgs {
  const bf16_t *QA, *KA, *VAt, *QW, *KW, *VWt, *QG, *KG, *VGt;
  const float *g_qk_diff, *g_qk_win, *g_qk_glob, *sink, *lambda_diff, *g_mix_out;
  float lambda_init;
  int pad0;
  bf16_t* A2;
  float* Oslab;
  float* Lslab;
};

DI void store_head_bf16(char* wl, const float (&o)[32], float rs, const float* __restrict__ gm, bf16_t* __restrict__ dst_row0  ,
                        int lane) {
  const int r = lane & 31, h = lane >> 5;
#pragma unroll
  for (int dt = 0; dt < 2; ++dt)
#pragma unroll
    for (int q4 = 0; q4 < 4; ++q4) {
      const int dv = 32 * dt + 8 * q4 + 4 * h;
      const float* ov = o + 16 * dt + 4 * q4;
      *(uint2*)(wl + r * 136 + dv * 2) = make_uint2(pk2bf(ov[0] * rs * gm[dv], ov[1] * rs * gm[dv + 1]), pk2bf(ov[2] * rs * gm[dv + 2], ov[3] * rs * gm[dv + 3]));
    }
  asm volatile("s_waitcnt lgkmcnt(0)" ::: "memory");
#pragma unroll
  for (int ps = 0; ps < 4; ++ps) {
    const int row = ps * 8 + (lane >> 3), ch = lane & 7;
    const uint2 a = *(const uint2*)(wl + row * 136 + ch * 16), c = *(const uint2*)(wl + row * 136 + ch * 16 + 8);
    *(uint4*)(dst_row0 + (size_t)row * D + ch * 8) = make_uint4(a.x, a.y, c.x, c.y);
  }
  asm volatile("s_waitcnt lgkmcnt(0)" ::: "memory");
}
DI void store_head_f32(char* wl, const f32x16& Oa, const f32x16& Ob, float* __restrict__ dst_row0, int lane) {
  const int r = lane & 31, h = lane >> 5;
#pragma unroll
  for (int dt = 0; dt < 2; ++dt)
#pragma unroll
    for (int q4 = 0; q4 < 4; ++q4) {
      const f32x16& O = dt == 0 ? Oa : Ob;
      *(float4*)(wl + r * 272 + (32 * dt + 8 * q4 + 4 * h) * 4) = make_float4(O[4 * q4], O[4 * q4 + 1], O[4 * q4 + 2], O[4 * q4 + 3]);
    }
  asm volatile("s_waitcnt lgkmcnt(0)" ::: "memory");
#pragma unroll
  for (int ps = 0; ps < 8; ++ps) {
    const int row = ps * 4 + (lane >> 4), ch = lane & 15;
    *(float4*)(dst_row0 + (size_t)row * 64 + ch * 4) = *(const float4*)(wl + row * 272 + ch * 16);
  }
  asm volatile("s_waitcnt lgkmcnt(0)" ::: "memory");
}

template <int TYPE>
DI void attn_item(const AttnArgs& a, int b, int g, int p0, int ctx0, int nctx, int lat0, int nkt, int half, char* smem) {
  constexpr int DQK = TYPE == 0 ? 32 : 64;
  constexpr int KS = DQK / 16;
  const int tid = TID, lane = tid & 63, wid = tid >> 6;
  const int r = lane & 31, h = lane >> 5;
  const bf16_t *Q0, *Q1, *K0, *K1, *Vt;
  const float* gqk;
  if (TYPE == 0) {
    Q0 = a.QA + ((size_t)b * 8 + 2 * g) * NT * 32; Q1 = Q0 + (size_t)NT * 32;
    K0 = a.KA + ((size_t)b * 8 + 2 * g) * NT * 32; K1 = K0 + (size_t)NT * 32;
    Vt = a.VAt + ((size_t)b * 4 + g) * 64 * NT; gqk = a.g_qk_diff;
  } else if (TYPE == 1) {
    Q0 = a.QW + ((size_t)b * 4 + 2 * g) * NT * 64; Q1 = Q0 + (size_t)NT * 64;
    K0 = a.KW + ((size_t)b * 2 + g) * NT * 64; K1 = K0;
    Vt = a.VWt + ((size_t)b * 2 + g) * 64 * NT; gqk = a.g_qk_win;
  } else {
    Q0 = a.QG + ((size_t)b * 4 + 2 * g) * NT * 64; Q1 = Q0 + (size_t)NT * 64;
    K0 = a.KG + ((size_t)b * 2 + g) * NT * 64; K1 = K0;
    Vt = a.VGt + ((size_t)b * 2 + g) * 64 * NT; gqk = a.g_qk_glob;
  }
  (void)gqk;
  const int qpos = p0 + wid * 32 + r;
  bf16x8 qf0[KS], qf1[KS];
#pragma unroll
  for (int s = 0; s < KS; ++s) {
    qf0[s] = *(const bf16x8*)(Q0 + (size_t)qpos * DQK + 16 * s + 8 * h);
    qf1[s] = *(const bf16x8*)(Q1 + (size_t)qpos * DQK + 16 * s + 8 * h);
  }
  f32x16 O00, O01, O10, O11, Zero;
#pragma unroll
  for (int i = 0; i < 16; ++i) { O00[i] = 0.f; O01[i] = 0.f; O10[i] = 0.f; O11[i] = 0.f; Zero[i] = 0.f; }
  float l0 = 0.f, l1 = 0.f;

  auto tile_of = [&](int it) { return it < nctx ? ctx0 + it : lat0 + it - nctx; };
  const int wvu = __builtin_amdgcn_readfirstlane(tid >> 6);
#define ATT_GLDS(kt_, sb_)                                                                               \
  {                                                                                                      \
    const int kt__ = (kt_);                                                                              \
    LAS char* sl__ = (LAS char*)(sb_);                                                                   \
    if (TYPE == 0) {                                                                                     \
      const int row = tid >> 2, ch = (tid & 3) ^ ((row >> 2) & 3);                                       \
      __builtin_amdgcn_global_load_lds((const unsigned*)(K0 + (size_t)(kt__ * 128 + row) * 32 + ch * 8), (LAS unsigned*)(sl__ + wvu * 1024), 16, 0, 0);          \
      __builtin_amdgcn_global_load_lds((const unsigned*)(K1 + (size_t)(kt__ * 128 + row) * 32 + ch * 8), (LAS unsigned*)(sl__ + 8192 + wvu * 1024), 16, 0, 0);   \
    } else {                                                                                             \
      _Pragma("unroll") for (int i2 = 0; i2 < 2; ++i2) {                                                 \
        const int lc = tid + 512 * i2; const int row = lc >> 3, ch = (lc & 7) ^ ((row >> 1) & 7);        \
        __builtin_amdgcn_global_load_lds((const unsigned*)(K0 + (size_t)(kt__ * 128 + row) * 64 + ch * 8), (LAS unsigned*)(sl__ + i2 * 8192 + wvu * 1024), 16, 0, 0); \
      }                                                                                                  \
    }                                                                                                    \
    _Pragma("unroll") for (int i2 = 0; i2 < 2; ++i2) {                                                   \
      const int lc = tid + 512 * i2; const int row = lc >> 4, ch = (lc & 15) ^ (row & 15);               \
      __builtin_amdgcn_global_load_lds((const unsigned*)(Vt + (size_t)row * NT + kt__ * 128 + ch * 8), (LAS unsigned*)(sl__ + 16384 + i2 * 8192 + wvu * 1024), 16, 0, 0); \
    }                                                                                                    \
  }
  __syncthreads();
  ATT_GLDS(tile_of(0), smem);
  asm volatile("s_waitcnt vmcnt(0)" ::: "memory");
  __syncthreads();
  const int qwave = p0 + wid * 32;
  const int vbase = r * 256 + ((h ^ (r & 15)) << 4);
#pragma unroll 1
  for (int it = 0; it < nkt; ++it) {
    const int kt = tile_of(it);
    const char* sb = smem + (it & 1) * 32768;
    if (it + 1 < nkt) ATT_GLDS(tile_of(it + 1), smem + ((it + 1) & 1) * 32768);
#pragma unroll 2
    for (int j = 0; j < 4; ++j) {
      const int kbase = kt * 128 + 32 * j;
      bool masked = false;
      if (TYPE == 1) {
        if (kbase >= CTX && p0 >= CTX) {
          if (kbase > qwave + 31 + 128 || kbase + 31 < qwave - 128) continue;
          masked = true;
        }
      }
      f32x16 S0 = Zero, S1 = Zero;
#pragma unroll
      for (int s = 0; s < KS; ++s) {
        if (TYPE == 0) {
          int row = 32 * j + r;
          int off = row * 64 + (((2 * s + h) ^ ((row >> 2) & 3)) << 4);
          bf16x8 k0 = *(const bf16x8*)(sb + off);
          bf16x8 k1 = *(const bf16x8*)(sb + 8192 + off);
          S0 = MFMA32(k0, qf0[s], S0);
          S1 = MFMA32(k1, qf1[s], S1);
        } else {
          int row = 32 * j + r;
          int off = row * 128 + (((2 * s + h) ^ ((row >> 1) & 7)) << 4);
          bf16x8 k0 = *(const bf16x8*)(sb + off);
          S0 = MFMA32(k0, qf0[s], S0);
          S1 = MFMA32(k0, qf1[s], S1);
        }
      }
      float pa[16], pb[16];
#pragma unroll
      for (int i = 0; i < 16; ++i) {
        float e0 = __builtin_amdgcn_exp2f(S0[i]);
        float e1 = __builtin_amdgcn_exp2f(S1[i]);
        if (TYPE == 1) {
          if (masked) {
            int kp = kbase + (i & 3) + 8 * (i >> 2) + 4 * h;
            int dd = kp - qpos;
            bool ok = (dd <= 128) && (dd >= -128);
            e0 = ok ? e0 : 0.f; e1 = ok ? e1 : 0.f;
          }
        }
        pa[i] = e0; pb[i] = e1;
      }
      l0 += ((pa[0] + pa[1]) + (pa[2] + pa[3])) + ((pa[4] + pa[5]) + (pa[6] + pa[7])) + ((pa[8] + pa[9]) + (pa[10] + pa[11])) + ((pa[12] + pa[13]) + (pa[14] + pa[15]));
      l1 += ((pb[0] + pb[1]) + (pb[2] + pb[3])) + ((pb[4] + pb[5]) + (pb[6] + pb[7])) + ((pb[8] + pb[9]) + (pb[10] + pb[11])) + ((pb[12] + pb[13]) + (pb[14] + pb[15]));
      bf16x8 pf0[2], pf1[2];
#pragma unroll
      for (int s2 = 0; s2 < 2; ++s2) {
        unsigned w0[4], w1[4];
#pragma unroll
        for (int e = 0; e < 4; ++e) {
          w0[e] = pk2bf(pa[8 * s2 + 2 * e], pa[8 * s2 + 2 * e + 1]);
          w1[e] = pk2bf(pb[8 * s2 + 2 * e], pb[8 * s2 + 2 * e + 1]);
        }
        pf0[s2] = __builtin_bit_cast(bf16x8, make_uint4(w0[0], w0[1], w0[2], w0[3]));
        pf1[s2] = __builtin_bit_cast(bf16x8, make_uint4(w1[0], w1[1], w1[2], w1[3]));
      }
#pragma unroll
      for (int s2 = 0; s2 < 2; ++s2) {
        const int vo = vbase ^ ((4 * j + 2 * s2) << 4);
        bf16x8 v0 = *(const bf16x8*)(sb + 16384 + vo);
        bf16x8 v1 = *(const bf16x8*)(sb + 16384 + 8192 + vo);
        O00 = MFMA32(v0, pf0[s2], O00);
        O01 = MFMA32(v1, pf0[s2], O01);
        O10 = MFMA32(v0, pf1[s2], O10);
        O11 = MFMA32(v1, pf1[s2], O11);
      }
    }
    asm volatile("s_waitcnt vmcnt(0)" ::: "memory");
    __syncthreads();
  }
  l0 += shxl(l0, lane, 32);
  l1 += shxl(l1, lane, 32);
  if (TYPE == 1) {
    l0 += __builtin_amdgcn_exp2f(a.sink[2 * g] * LOG2E);
    l1 += __builtin_amdgcn_exp2f(a.sink[2 * g + 1] * LOG2E);
  }
  const size_t orow0 = (size_t)b * NT + p0 + wid * 32;
  char* wl = smem + wid * 8704;
  if (TYPE == 2) {
#pragma unroll
    for (int x = 0; x < 2; ++x) {
      int head = 2 * g + x;
      float* dst0 = a.Oslab + ((((size_t)half * NB + b) * 4 + head) * NT + (p0 + wid * 32)) * 64;
      if (x == 0) store_head_f32(wl, O00, O01, dst0, lane); else store_head_f32(wl, O10, O11, dst0, lane);
      if (h == 0) a.Lslab[(((size_t)half * NB + b) * 4 + head) * NT + qpos] = x == 0 ? l0 : l1;
    }
  } else if (TYPE == 0) {
    float s0 = 0.f, s1 = 0.f;
    for (int d = 0; d < 32; ++d) { s0 += a.lambda_diff[d] * a.lambda_diff[32 + d]; s1 += a.lambda_diff[64 + d] * a.lambda_diff[96 + d]; }
    const float lam = __expf(s0) - __expf(s1) + a.lambda_init;
    const float i0 = 1.f / l0, i1 = lam / l1;
    float o[32];
    float ss = 0.f;
#pragma unroll
    for (int i = 0; i < 16; ++i) {
      o[i] = O00[i] * i0 - O10[i] * i1;
      o[16 + i] = O01[i] * i0 - O11[i] * i1;
      ss += o[i] * o[i] + o[16 + i] * o[16 + i];
    }
    ss += shxl(ss, lane, 32);
    const float rs = rsqrtf(ss * (1.f / 64) + EPS) * (1.f - a.lambda_init);
    const float* gm = a.g_mix_out + g * 64;
    store_head_bf16(wl, o, rs, gm, a.A2 + orow0 * D + g * 64, lane);
  } else {
#pragma unroll
    for (int x = 0; x < 2; ++x) {
      const float inv = 1.f / (x == 0 ? l0 : l1);
      float o[32];
      float ss = 0.f;
#pragma unroll
      for (int i = 0; i < 16; ++i) {
        o[i] = (x == 0 ? O00[i] : O10[i]) * inv;
        o[16 + i] = (x == 0 ? O01[i] : O11[i]) * inv;
        ss += o[i] * o[i] + o[16 + i] * o[16 + i];
      }
      ss += shxl(ss, lane, 32);
      const float rs = rsqrtf(ss * (1.f / 64) + EPS);
      const int col0 = 256 + (2 * g + x) * 64;
      const float* gm = a.g_mix_out + col0;
      store_head_bf16(wl, o, rs, gm, a.A2 + orow0 * D + col0, lane);
    }
  }
}

DI void attn_dispatch(const AttnArgs& a, int idx, int want_ctx, char* smem) {
  if (idx < 256) {
    int b = idx >> 7, g = (idx >> 5) & 3, qt = 1 + (idx & 31);
    attn_item<0>(a, b, g, qt * 256, 0, 2, 2, 66, 0, smem);
  } else if (idx < 512) {
    int i = idx - 256; int half = i >> 7, b = (i >> 6) & 1, g = (i >> 5) & 1, qt = 1 + (i & 31);
    if (half == 0) attn_item<2>(a, b, g, qt * 256, 0, 2, 2, 33, 0, smem);
    else attn_item<2>(a, b, g, qt * 256, 0, 0, 33, 33, 1, smem);
  } else if (idx < 640) {
    int i = idx - 512; int b = i >> 6, g = (i >> 5) & 1, qt = 1 + (i & 31);
    int lo = max(2, 2 * qt - 1), hi = min(65, 2 * qt + 2);
    attn_item<1>(a, b, g, qt * 256, 0, 2, lo, 2 + (hi - lo + 1), 0, smem);
  } else if (want_ctx) {
    int i = idx - 640;
    if (i < 8) attn_item<0>(a, i >> 2, i & 3, 0, 0, 2, 0, 2, 0, smem);
    else if (i < 16) { int k = i - 8; int half = k >> 2, b = (k >> 1) & 1, g = k & 1; attn_item<2>(a, b, g, 0, half, 1, 0, 1, half, smem); }
    else if (i < 20) { int k = i - 16; attn_item<1>(a, k >> 1, k & 1, 0, 0, 2, 0, 2, 0, smem); }
  }
}

typedef __attribute__((ext_vector_type(4))) float f32x4v;
typedef __attribute__((ext_vector_type(2))) _Float16 h2_t;
DI unsigned pack_i8x4(float a, float b, float c, float d) {
  const int ia = (int)__builtin_rintf(a), ib = (int)__builtin_rintf(b), ic = (int)__builtin_rintf(c), id = (int)__builtin_rintf(d);
  return (unsigned)(ia & 255) | ((unsigned)(ib & 255) << 8) | ((unsigned)(ic & 255) << 16) | ((unsigned)id << 24);
}
constexpr size_t TSLICE = (size_t)16384 * 128;
DI void tabconv_fin_i8(float4 v0, float4 v1, float4 v2, float4 v3, unsigned char* __restrict__ dst, float* __restrict__ scale, size_t row, int lane) {
  float m = fmaxf(fmaxf(fmaxf(fabsf(v0.x), fabsf(v0.y)), fmaxf(fabsf(v0.z), fabsf(v0.w))), fmaxf(fmaxf(fabsf(v1.x), fabsf(v1.y)), fmaxf(fabsf(v1.z), fabsf(v1.w))));
  m = fmaxf(m, fmaxf(fmaxf(fmaxf(fabsf(v2.x), fabsf(v2.y)), fmaxf(fabsf(v2.z), fabsf(v2.w))), fmaxf(fmaxf(fabsf(v3.x), fabsf(v3.y)), fmaxf(fabsf(v3.z), fabsf(v3.w)))));
  for (int o = 32; o > 0; o >>= 1) m = fmaxf(m, shxl(m, lane, o));
  m = fmaxf(m, 1e-30f);
  const float sc = m * (1.f / 127.f), inv = 127.f / m;
  *(uint4*)(dst + (size_t)(lane >> 3) * TSLICE + row * 128 + (lane & 7) * 16) = make_uint4(pack_i8x4(v0.x * inv, v0.y * inv, v0.z * inv, v0.w * inv), pack_i8x4(v1.x * inv, v1.y * inv, v1.z * inv, v1.w * inv),
                                                    pack_i8x4(v2.x * inv, v2.y * inv, v2.z * inv, v2.w * inv), pack_i8x4(v3.x * inv, v3.y * inv, v3.z * inv, v3.w * inv));
  if (lane == 0) scale[row] = sc;
}
DI void tabconv_fin(float4 v0, float4 v1, float4 v2, float4 v3, unsigned char* __restrict__ dst, float* __restrict__ scale, size_t row, int lane) {
  float m = fmaxf(fmaxf(fmaxf(fabsf(v0.x), fabsf(v0.y)), fmaxf(fabsf(v0.z), fabsf(v0.w))), fmaxf(fmaxf(fabsf(v1.x), fabsf(v1.y)), fmaxf(fabsf(v1.z), fabsf(v1.w))));
  m = fmaxf(m, fmaxf(fmaxf(fmaxf(fabsf(v2.x), fabsf(v2.y)), fmaxf(fabsf(v2.z), fabsf(v2.w))), fmaxf(fmaxf(fabsf(v3.x), fabsf(v3.y)), fmaxf(fabsf(v3.z), fabsf(v3.w)))));
  for (int o = 32; o > 0; o >>= 1) m = fmaxf(m, shxl(m, lane, o));
  m = fmaxf(m, 1e-30f);
  const float sc = m * (1.f / 448.f), inv = 448.f / m;
  int w0 = __builtin_amdgcn_cvt_pk_fp8_f32(v0.x * inv, v0.y * inv, 0, false); w0 = __builtin_amdgcn_cvt_pk_fp8_f32(v0.z * inv, v0.w * inv, w0, true);
  int w1 = __builtin_amdgcn_cvt_pk_fp8_f32(v1.x * inv, v1.y * inv, 0, false); w1 = __builtin_amdgcn_cvt_pk_fp8_f32(v1.z * inv, v1.w * inv, w1, true);
  int w2 = __builtin_amdgcn_cvt_pk_fp8_f32(v2.x * inv, v2.y * inv, 0, false); w2 = __builtin_amdgcn_cvt_pk_fp8_f32(v2.z * inv, v2.w * inv, w2, true);
  int w3 = __builtin_amdgcn_cvt_pk_fp8_f32(v3.x * inv, v3.y * inv, 0, false); w3 = __builtin_amdgcn_cvt_pk_fp8_f32(v3.z * inv, v3.w * inv, w3, true);
  *(uint4*)(dst + (size_t)(lane >> 3) * TSLICE + row * 128 + (lane & 7) * 16) = make_uint4((unsigned)w0, (unsigned)w1, (unsigned)w2, (unsigned)w3);
  if (lane == 0) scale[row] = sc;
}
DI void score_sort(const bf16_t* __restrict__ qbuf, const bf16_t* __restrict__ keysb, int m0, int hp, char* smem, unsigned (&v16)[16]) {
  const int tid = TID, lane = tid & 63, wid = tid >> 6;
  const int wm = wid & 1, wn = wid >> 1;
  const int r = lane & 31, h = lane >> 5;
  f32x16 acc0, acc1;
  for (int i = 0; i < 16; ++i) { acc0[i] = 0.f; acc1[i] = 0.f; }
  const int lrow = tid >> 3, lch = tid & 7;
  const bf16_t* Ag = qbuf + (size_t)(m0 + lrow) * 2048 + hp * 128 + lch * 8;
  const bf16_t* Bg = keysb + ((size_t)hp * 128 + lrow) * 128 + lch * 8;
  const int woff = lrow * 128 + ((lch ^ ((lrow >> 1) & 7)) << 4);
  __syncthreads();
#pragma unroll
  for (int kt = 0; kt < 2; ++kt) {
    char* sn = smem + kt * 32768;
    *(uint4*)(sn + woff) = *(const uint4*)(Ag + kt * 64);
    *(uint4*)(sn + woff + 8192) = *(const uint4*)(Ag + (size_t)64 * 2048 + kt * 64);
    *(uint4*)(sn + 16384 + woff) = *(const uint4*)(Bg + kt * 64);
    *(uint4*)(sn + 16384 + woff + 8192) = *(const uint4*)(Bg + 64 * 128 + kt * 64);
  }
  __syncthreads();
  const int sw = (r >> 1) & 7;
  const int aoff0 = (wm * 64 + r) * 128, aoff1 = aoff0 + 32 * 128;
  const int boff = 16384 + (wn * 32 + r) * 128;
#pragma unroll
  for (int kt = 0; kt < 2; ++kt) {
    const char* st = smem + kt * 32768;
#pragma unroll
    for (int s = 0; s < 4; ++s) {
      int co = ((2 * s + h) ^ sw) << 4;
      bf16x8 a0 = *(const bf16x8*)(st + aoff0 + co);
      bf16x8 a1 = *(const bf16x8*)(st + aoff1 + co);
      bf16x8 b = *(const bf16x8*)(st + boff + co);
      acc0 = MFMA32(a0, b, acc0);
      acc1 = MFMA32(a1, b, acc1);
    }
  }
  __syncthreads();
  float* Cs = (float*)smem;
  constexpr int CS = 132;
#pragma unroll
  for (int i = 0; i < 16; ++i) {
    int row = (i & 3) + 8 * (i >> 2) + 4 * h;
    Cs[(wm * 64 + row) * CS + wn * 32 + r] = acc0[i];
    Cs[(wm * 64 + 32 + row) * CS + wn * 32 + r] = acc1[i];
  }
  __syncthreads();
  const int row = tid >> 2, q = tid & 3;
  unsigned v[32];
#pragma unroll
  for (int i = 0; i < 32; ++i) {
    unsigned u = __float_as_uint(Cs[row * CS + 4 * i + q]);
    u ^= (u & 0x80000000u) ? 0xffffffffu : 0x80000000u;
    v[i] = (u & ~127u) | (unsigned)(127 - (4 * i + q));
  }
#pragma unroll
  for (int k = 2; k <= 32; k <<= 1)
#pragma unroll
    for (int j = k >> 1; j > 0; j >>= 1)
#pragma unroll
      for (int i = 0; i < 32; ++i) {
        const int l = i ^ j;
        if (l > i) {
          const unsigned lo = min(v[i], v[l]), hi = max(v[i], v[l]);
          if ((i & k) == 0) { v[i] = hi; v[l] = lo; } else { v[i] = lo; v[l] = hi; }
        }
      }
#pragma unroll
  for (int step = 0; step < 2; ++step) {
    unsigned c[16];
#pragma unroll
    for (int i = 0; i < 16; ++i) {
      const unsigned o = step == 0 ? (unsigned)__builtin_amdgcn_mov_dpp((int)v[15 - i], 0xB1, 0xf, 0xf, false)
                                   : (unsigned)__builtin_amdgcn_mov_dpp((int)v[15 - i], 0x4E, 0xf, 0xf, false);
      c[i] = max(v[i], o);
    }
#pragma unroll
    for (int j = 8; j > 0; j >>= 1)
#pragma unroll
      for (int i = 0; i < 16; ++i) {
        const int l = i ^ j;
        if (l > i) { const unsigned lo = min(c[i], c[l]), hi = max(c[i], c[l]); c[i] = hi; c[l] = lo; }
      }
#pragma unroll
    for (int i = 0; i < 16; ++i) v[i] = c[i];
  }
#pragma unroll
  for (int i = 0; i < 16; ++i) v16[i] = v[i];
}
constexpr int CAND_I[52] = {0, 0, 0, 0, 0, 0, 0, 0, 0, 0, 0, 0, 0, 0, 0, 0, 1, 1, 1, 1, 1, 1, 1, 1, 2, 2, 2, 2, 2, 3, 3, 3, 3, 4, 4, 4, 5, 5, 6, 6, 7, 7, 8, 9, 10, 11, 12, 13, 14, 15, 0, 0};
constexpr int CAND_J[52] = {0, 1, 2, 3, 4, 5, 6, 7, 8, 9, 10, 11, 12, 13, 14, 15, 0, 1, 2, 3, 4, 5, 6, 7, 0, 1, 2, 3, 4, 0, 1, 2, 3, 0, 1, 2, 0, 1, 0, 1, 0, 1, 0, 0, 0, 0, 0, 0, 0, 0, 0, 0};
DI float sel4(int q, float a, float b, float c, float d) { return q == 0 ? a : q == 1 ? b : q == 2 ? c : d; }
DI unsigned sel4u(int q, unsigned a, unsigned b, unsigned c, unsigned d) { return q == 0 ? a : q == 1 ? b : q == 2 ? c : d; }
DI float key7f(unsigned k) { k &= ~127u; k ^= (k & 0x80000000u) ? 0x80000000u : 0xffffffffu; return __uint_as_float(k); }
DI float key8f(unsigned k) { k &= ~255u; k ^= (k & 0x80000000u) ? 0x80000000u : 0xffffffffu; return __uint_as_float(k); }
DI void score_head_item(const bf16_t* __restrict__ qbuf, const bf16_t* __restrict__ keysb, int m0, int hd, char* smem, int* __restrict__ experts,
                        float* __restrict__ gates) {
  unsigned ka[16], kb[16];
  score_sort(qbuf, keysb, m0, 2 * hd, smem, ka);
  score_sort(qbuf, keysb, m0, 2 * hd + 1, smem, kb);
  const int tid = TID, row = tid >> 2, q = tid & 3;
  unsigned char* ix = (unsigned char*)(smem + 69632) + row * 32;
  *(unsigned*)(ix + 4 * q) = (sel4u(q, ka[0], ka[4], ka[8], ka[12]) & 127u) | ((sel4u(q, ka[1], ka[5], ka[9], ka[13]) & 127u) << 8) |
                             ((sel4u(q, ka[2], ka[6], ka[10], ka[14]) & 127u) << 16) | ((sel4u(q, ka[3], ka[7], ka[11], ka[15]) & 127u) << 24);
  *(unsigned*)(ix + 16 + 4 * q) = (sel4u(q, kb[0], kb[4], kb[8], kb[12]) & 127u) | ((sel4u(q, kb[1], kb[5], kb[9], kb[13]) & 127u) << 8) |
                                  ((sel4u(q, kb[2], kb[6], kb[10], kb[14]) & 127u) << 16) | ((sel4u(q, kb[3], kb[7], kb[11], kb[15]) & 127u) << 24);
  float a[16], b[16];
#pragma unroll
  for (int i = 0; i < 16; ++i) { a[i] = key7f(ka[i]); b[i] = key7f(kb[i]); }
  unsigned c[16];
#pragma unroll
  for (int t = 0; t < 16; ++t) {
    if (4 * t >= 52) { c[t] = 0u; continue; }
    const float sv = sel4(q, a[CAND_I[4 * t]], a[CAND_I[4 * t + 1]], a[CAND_I[4 * t + 2]], a[CAND_I[4 * t + 3]]) +
                     sel4(q, b[CAND_J[4 * t]], b[CAND_J[4 * t + 1]], b[CAND_J[4 * t + 2]], b[CAND_J[4 * t + 3]]);
    const unsigned code = sel4u(q, CAND_I[4 * t] * 16 + CAND_J[4 * t], CAND_I[4 * t + 1] * 16 + CAND_J[4 * t + 1], CAND_I[4 * t + 2] * 16 + CAND_J[4 * t + 2],
                                CAND_I[4 * t + 3] * 16 + CAND_J[4 * t + 3]);
    unsigned u = __float_as_uint(sv);
    u ^= (u & 0x80000000u) ? 0xffffffffu : 0x80000000u;
    const bool valid = (4 * t + q) < 50;
    c[t] = valid ? ((u & ~255u) | code) : 0u;
  }
#pragma unroll
  for (int k = 2; k <= 16; k <<= 1)
#pragma unroll
    for (int j = k >> 1; j > 0; j >>= 1)
#pragma unroll
      for (int i = 0; i < 16; ++i) {
        const int l = i ^ j;
        if (l > i) {
          const unsigned lo = min(c[i], c[l]), hi = max(c[i], c[l]);
          if ((i & k) == 0) { c[i] = hi; c[l] = lo; } else { c[i] = lo; c[l] = hi; }
        }
      }
#pragma unroll
  for (int step = 0; step < 2; ++step) {
    unsigned d[16];
#pragma unroll
    for (int i = 0; i < 16; ++i) {
      const unsigned o = step == 0 ? (unsigned)__builtin_amdgcn_mov_dpp((int)c[15 - i], 0xB1, 0xf, 0xf, false)
                                   : (unsigned)__builtin_amdgcn_mov_dpp((int)c[15 - i], 0x4E, 0xf, 0xf, false);
      d[i] = max(c[i], o);
    }
#pragma unroll
    for (int j = 8; j > 0; j >>= 1)
#pragma unroll
      for (int i = 0; i < 16; ++i) {
        const int l = i ^ j;
        if (l > i) { const unsigned lo = min(d[i], d[l]), hi = max(d[i], d[l]); d[i] = hi; d[l] = lo; }
      }
#pragma unroll
    for (int i = 0; i < 16; ++i) c[i] = d[i];
  }
  const float mx = key8f(c[0]);
  float e[16]; float sum = 0.f;
#pragma unroll
  for (int i = 0; i < 16; ++i) { e[i] = __expf(key8f(c[i]) - mx); sum += e[i]; }
  const float inv = 1.f / sum;
  asm volatile("s_waitcnt lgkmcnt(0)" ::: "memory");
  int eo[4]; float go[4];
#pragma unroll
  for (int k = 0; k < 4; ++k) {
    const unsigned code = sel4u(q, c[k], c[4 + k], c[8 + k], c[12 + k]) & 255u;
    go[k] = sel4(q, e[k], e[4 + k], e[8 + k], e[12 + k]) * inv;
    eo[k] = (127 - (int)ix[code >> 4]) * 128 + (127 - (int)ix[16 + (code & 15)]);
  }
  const size_t o = (size_t)(m0 + row) * 128 + hd * 16 + 4 * q;
  *(uint2*)((unsigned short*)experts + o) = make_uint2((unsigned)eo[0] | ((unsigned)eo[1] << 16), (unsigned)eo[2] | ((unsigned)eo[3] << 16));
  *(float4*)(gates + o) = make_float4(go[0], go[1], go[2], go[3]);
}

DI float key2f(unsigned k) { k &= ~127u; k ^= (k & 0x80000000u) ? 0x80000000u : 0xffffffffu; return __uint_as_float(k); }
DI void merge_one(const unsigned* __restrict__ topk, int r, int hd, int* experts, float* gates) {
  const unsigned* ka = topk + ((size_t)r * 16 + 2 * hd) * 16;
  const unsigned* kb = ka + 16;
  float a[16], bq[16];
#pragma unroll
  for (int i = 0; i < 4; ++i) {
    uint4 x = ((const uint4*)ka)[i], y = ((const uint4*)kb)[i];
    a[4 * i] = key2f(x.x); a[4 * i + 1] = key2f(x.y); a[4 * i + 2] = key2f(x.z); a[4 * i + 3] = key2f(x.w);
    bq[4 * i] = key2f(y.x); bq[4 * i + 1] = key2f(y.y); bq[4 * i + 2] = key2f(y.z); bq[4 * i + 3] = key2f(y.w);
  }
  float cv[50];
  {
    int n = 0;
#pragma unroll
    for (int i = 0; i < 16; ++i)
#pragma unroll
      for (int j = 0; j < 16; ++j)
        if ((i + 1) * (j + 1) <= 16) { cv[n] = a[i] + bq[j]; ++n; }
  }
  int* eo = experts + hd * 16;
  float* go = gates + hd * 16;
  float mx = 0.f, sum = 0.f;
#pragma unroll 1
  for (int k = 0; k < 16; ++k) {
    float mval = cv[0]; int code = 0;
    {
      int n = 0;
#pragma unroll
      for (int i = 0; i < 16; ++i)
#pragma unroll
        for (int j = 0; j < 16; ++j)
          if ((i + 1) * (j + 1) <= 16) {
            if (n > 0) { bool gt = cv[n] > mval; mval = gt ? cv[n] : mval; code = gt ? (i * 16 + j) : code; }
            ++n;
          }
    }
    {
      int n = 0;
#pragma unroll
      for (int i = 0; i < 16; ++i)
#pragma unroll
        for (int j = 0; j < 16; ++j)
          if ((i + 1) * (j + 1) <= 16) { cv[n] = (code == i * 16 + j) ? -3.0e38f : cv[n]; ++n; }
    }
    if (k == 0) mx = mval;
    const float e = __expf(mval - mx);
    sum += e;
    eo[k] = (int)(127u - (ka[code >> 4] & 127u)) * 128 + (int)(127u - (kb[code & 15] & 127u));
    go[k] = e;
  }
  const float inv = 1.f / sum;
#pragma unroll
  for (int i = 0; i < 4; ++i) {
    float4 g4 = ((float4*)go)[i];
    g4.x *= inv; g4.y *= inv; g4.z *= inv; g4.w *= inv;
    ((float4*)go)[i] = g4;
  }
}

template <int MODE>
DI void peer_token(int r, const bf16_t* __restrict__ hbuf, const int* ex_row, const float* g_row,
                   const unsigned char* __restrict__ u8, const float* __restrict__ us, const unsigned char* __restrict__ v8,
                   const float* __restrict__ vs, const float* __restrict__ modv_l, float* __restrict__ xs, float* wdots  ,
                   float* __restrict__ outp, int* __restrict__ ex_out, float* __restrict__ w_out) {
  const int lane = TID & 63;
  float x[16];
  {
    const uint2* hr = (const uint2*)(hbuf + (size_t)r * D + lane * 4);
#pragma unroll
    for (int c = 0; c < 4; ++c) { const uint2 a = hr[64 * c]; x[4 * c] = bflo(a.x); x[4 * c + 1] = bfhi(a.x); x[4 * c + 2] = bflo(a.y); x[4 * c + 3] = bfhi(a.y); }
  }
  const int e0 = ex_row[lane], e1 = ex_row[64 + lane];
  const float g0 = g_row[lane], g1 = g_row[64 + lane];
  const float us0 = us[e0], us1 = us[e1], vs0 = vs[e0], vs1 = vs[e1];
#define PEER_LOAD8(rw_, tab_, k0_)                                                          \
  {                                                                                         \
    _Pragma("unroll") for (int j = 0; j < 8; ++j) {                                         \
      int e = __builtin_amdgcn_readlane((k0_) < 64 ? e0 : e1, ((k0_) + j) & 63);            \
      rw_[j] = *(const uint4*)((tab_) + (size_t)e * D + lane * 16);                         \
    }                                                                                       \
  }
#define PEER_UDOT8(rw_, k0_)                                                                \
  {                                                                                         \
    float p[8];                                                                             \
    _Pragma("unroll") for (int j = 0; j < 8; ++j) {                                         \
      f32x2_t a0 = __builtin_amdgcn_cvt_pk_f32_fp8((int)rw_[j].x, false), a1 = __builtin_amdgcn_cvt_pk_f32_fp8((int)rw_[j].x, true); \
      f32x2_t b0 = __builtin_amdgcn_cvt_pk_f32_fp8((int)rw_[j].y, false), b1 = __builtin_amdgcn_cvt_pk_f32_fp8((int)rw_[j].y, true); \
      f32x2_t c0 = __builtin_amdgcn_cvt_pk_f32_fp8((int)rw_[j].z, false), c1 = __builtin_amdgcn_cvt_pk_f32_fp8((int)rw_[j].z, true); \
      f32x2_t d0 = __builtin_amdgcn_cvt_pk_f32_fp8((int)rw_[j].w, false), d1 = __builtin_amdgcn_cvt_pk_f32_fp8((int)rw_[j].w, true); \
      float s = a0[0] * x[0] + a0[1] * x[1] + a1[0] * x[2] + a1[1] * x[3];                  \
      s += b0[0] * x[4] + b0[1] * x[5] + b1[0] * x[6] + b1[1] * x[7];                       \
      s += c0[0] * x[8] + c0[1] * x[9] + c1[0] * x[10] + c1[1] * x[11];                     \
      s += d0[0] * x[12] + d0[1] * x[13] + d1[0] * x[14] + d1[1] * x[15];                   \
      p[j] = s;                                                                             \
    }                                                                                       \
    float q4[4];                                                                            \
    _Pragma("unroll") for (int i = 0; i < 4; ++i) { float send = hi32 ? p[i] : p[4 + i]; float keep = hi32 ? p[4 + i] : p[i]; q4[i] = keep + shxl(send, lane, 32); } \
    float q2[2];                                                                            \
    _Pragma("unroll") for (int i = 0; i < 2; ++i) { float send = hi16 ? q4[i] : q4[2 + i]; float keep = hi16 ? q4[2 + i] : q4[i]; q2[i] = keep + shxl(send, lane, 16); } \
    float q1;                                                                               \
    { float send = hi8 ? q2[0] : q2[1]; float keep = hi8 ? q2[1] : q2[0]; q1 = keep + shxl(send, lane, 8); } \
    q1 += shxl(q1, lane, 4); q1 += shxl(q1, lane, 2); q1 += shxl(q1, lane, 1);              \
    if ((lane & 7) == 0) wdots[(k0_) + (lane >> 3)] = q1;                                   \
  }
#define PEER_VACC8(rw_, k0_)                                                                \
  {                                                                                         \
    _Pragma("unroll") for (int j = 0; j < 8; ++j) {                                         \
      float w = __builtin_bit_cast(float, __builtin_amdgcn_readlane(__builtin_bit_cast(int, (k0_) < 64 ? w0 : w1), ((k0_) + j) & 63)); \
      f32x2_t a0 = __builtin_amdgcn_cvt_pk_f32_fp8((int)rw_[j].x, false), a1 = __builtin_amdgcn_cvt_pk_f32_fp8((int)rw_[j].x, true); \
      f32x2_t b0 = __builtin_amdgcn_cvt_pk_f32_fp8((int)rw_[j].y, false), b1 = __builtin_amdgcn_cvt_pk_f32_fp8((int)rw_[j].y, true); \
      f32x2_t c0 = __builtin_amdgcn_cvt_pk_f32_fp8((int)rw_[j].z, false), c1 = __builtin_amdgcn_cvt_pk_f32_fp8((int)rw_[j].z, true); \
      f32x2_t d0 = __builtin_amdgcn_cvt_pk_f32_fp8((int)rw_[j].w, false), d1 = __builtin_amdgcn_cvt_pk_f32_fp8((int)rw_[j].w, true); \
      acc[0] += w * a0[0]; acc[1] += w * a0[1]; acc[2] += w * a1[0]; acc[3] += w * a1[1];   \
      acc[4] += w * b0[0]; acc[5] += w * b0[1]; acc[6] += w * b1[0]; acc[7] += w * b1[1];   \
      acc[8] += w * c0[0]; acc[9] += w * c0[1]; acc[10] += w * c1[0]; acc[11] += w * c1[1]; \
      acc[12] += w * d0[0]; acc[13] += w * d0[1]; acc[14] += w * d1[0]; acc[15] += w * d1[1]; \
    }                                                                                       \
  }
  const bool hi32 = lane & 32, hi16 = lane & 16, hi8 = lane & 8;
  uint4 rwA[8], rwB[8];
  PEER_LOAD8(rwA, u8, 0);
#pragma unroll 1
  for (int k0 = 0; k0 < 128; k0 += 16) {
    PEER_LOAD8(rwB, u8, k0 + 8);
    PEER_UDOT8(rwA, k0);
    if (k0 + 16 < 128) { PEER_LOAD8(rwA, u8, k0 + 16); } else if (MODE == 0) { PEER_LOAD8(rwA, v8, 0); }
    PEER_UDOT8(rwB, k0 + 8);
  }
  float w0, w1;
  {
    float d0 = wdots[lane] * us0, d1 = wdots[64 + lane] * us1;
    float t0 = 0.5f * d0 * (1.f + tanhf(0.7978845608028654f * (d0 + 0.044715f * d0 * d0 * d0)));
    float t1 = 0.5f * d1 * (1.f + tanhf(0.7978845608028654f * (d1 + 0.044715f * d1 * d1 * d1)));
    w0 = g0 * t0 * vs0; w1 = g1 * t1 * vs1;
  }
  if (MODE == 1) {
    ex_out[(size_t)r * 128 + lane] = e0; ex_out[(size_t)r * 128 + 64 + lane] = e1;
    w_out[(size_t)r * 128 + lane] = w0; w_out[(size_t)r * 128 + 64 + lane] = w1;
    return;
  }
  float acc[16];
#pragma unroll
  for (int i = 0; i < 16; ++i) acc[i] = 0.f;
#pragma unroll 1
  for (int k0 = 0; k0 < 128; k0 += 16) {
    PEER_LOAD8(rwB, v8, k0 + 8);
    PEER_VACC8(rwA, k0);
    if (k0 + 16 < 128) PEER_LOAD8(rwA, v8, k0 + 16);
    PEER_VACC8(rwB, k0 + 8);
  }
  const int b = r / NT, p = r % NT; const int mrow = p < CTX ? 2 : b;
  const float* g2 = modv_l + mrow * NMOD + 5 * D + lane * 4;
  float4* xp = (float4*)(xs + (size_t)r * D + lane * 4);
  float4* op = outp ? (float4*)(outp + ((size_t)b * SEQ + (p - CTX)) * D + lane * 4) : xp;
#pragma unroll
  for (int i = 0; i < 4; ++i) {
    float4 xv = xp[64 * i]; float4 gg = ((const float4*)g2)[64 * i];
    xv.x += gg.x * acc[4 * i]; xv.y += gg.y * acc[4 * i + 1]; xv.z += gg.z * acc[4 * i + 2]; xv.w += gg.w * acc[4 * i + 3];
    op[64 * i] = xv;
  }
}

constexpr int FN = 2 * SEQ;
DI float2 cmul(float2 a, float2 b) { return make_float2(a.x * b.x - a.y * b.y, a.x * b.y + a.y * b.x); }
DI float2 cmulc(float2 a, float2 b) { return make_float2(a.x * b.x + a.y * b.y, a.y * b.x - a.x * b.y); }
DI int PX(int i) { return i + ((i >> 6) << 2); }
constexpr int FNP = FN + (FN >> 6) * 4;
DI int freq_of_pos(int pos) { return ((pos >> 10) & 15) | (((pos >> 6) & 15) << 4) | (((pos >> 2) & 15) << 8) | ((pos & 3) << 12); }
DI int pos_of_freq(int f) { return ((f & 15) << 10) | (((f >> 4) & 15) << 6) | (((f >> 8) & 15) << 2) | (f >> 12); }
DI float2 cadd(float2 a, float2 b) { return make_float2(a.x + b.x, a.y + b.y); }
DI float2 csub(float2 a, float2 b) { return make_float2(a.x - b.x, a.y - b.y); }
DI float2 cmni(float2 a) { return make_float2(a.y, -a.x); }
DI float2 cconj(float2 a) { return make_float2(a.x, -a.y); }
struct TabJob {
  const float* pu; const float* pv;
  unsigned char* du; unsigned char* dv;
  float* su; float* sv;
  int slot, wv, nw;
};
DI bool tab_issue(const TabJob& j, float4 (&v)[4], int lane) {
  const int row = j.slot * j.nw + j.wv;
  if (j.pu == nullptr || row >= 32768) return false;
  const float4* sp = (const float4*)(((row >> 14) ? j.pv : j.pu) + (size_t)(row & 16383) * D);
  v[0] = sp[lane]; v[1] = sp[64 + lane]; v[2] = sp[128 + lane]; v[3] = sp[192 + lane];
  return true;
}
DI void tab_finish(TabJob& j, const float4 (&v)[4], bool has, int lane) {
  if (has) {
    const int row = j.slot * j.nw + j.wv;
    if (row >> 14) tabconv_fin(v[0], v[1], v[2], v[3], j.dv, j.sv, (size_t)(row & 16383), lane);
    else tabconv_fin_i8(v[0], v[1], v[2], v[3], j.du, j.su, (size_t)(row & 16383), lane);
  }
  j.slot++;
}
DI void dft16(float2 (&x)[16]) {
  constexpr float C1 = 0.9238795325112867f, S1 = 0.3826834323650898f, C2 = 0.7071067811865476f;
  float2 u[16];
#pragma unroll
  for (int r = 0; r < 4; ++r) {
    const float2 a = x[r], b = x[r + 4], c = x[r + 8], d = x[r + 12];
    const float2 t0 = cadd(a, c), t1 = csub(a, c), t2 = cadd(b, d), t3 = cmni(csub(b, d));
    const float2 y0 = cadd(t0, t2), y1 = cadd(t1, t3), y2 = csub(t0, t2), y3 = csub(t1, t3);
    u[4 * r] = y0;
    if (r == 0) { u[1] = y1; u[2] = y2; u[3] = y3; }
    else if (r == 1) { u[5] = cmul(y1, make_float2(C1, -S1)); u[6] = cmul(y2, make_float2(C2, -C2)); u[7] = cmul(y3, make_float2(S1, -C1)); }
    else if (r == 2) { u[9] = cmul(y1, make_float2(C2, -C2)); u[10] = cmni(y2); u[11] = cmul(y3, make_float2(-C2, -C2)); }
    else { u[13] = cmul(y1, make_float2(S1, -C1)); u[14] = cmul(y2, make_float2(-C2, -C2)); u[15] = cmul(y3, make_float2(-C1, S1)); }
  }
#pragma unroll
  for (int sdx = 0; sdx < 4; ++sdx) {
    const float2 a = u[sdx], b = u[4 + sdx], c = u[8 + sdx], d = u[12 + sdx];
    const float2 t0 = cadd(a, c), t1 = csub(a, c), t2 = cadd(b, d), t3 = cmni(csub(b, d));
    x[4 * sdx] = cadd(t0, t2); x[4 * sdx + 1] = cadd(t1, t3); x[4 * sdx + 2] = csub(t0, t2); x[4 * sdx + 3] = csub(t1, t3);
  }
}
template <int LQ, bool INV>
DI void fft_pass16(float2* X, int tid, TabJob& job) {
  constexpr int q = 1 << LQ;
  constexpr float invL = 1.f / (float)(16 << LQ);
  float4 tv[4]; const bool thas = tab_issue(job, tv, tid & 63);
#pragma unroll 1
  for (int bf = 0; bf < 2; ++bf) {
    const int i = tid + 512 * bf;
    const int j = i & (q - 1); const int base = ((i >> LQ) << (LQ + 4)) + j;
    const float fr = (float)j * invL;
    const float2 w1 = make_float2(__builtin_amdgcn_cosf(fr), -__builtin_amdgcn_sinf(fr));
    float2 x[16];
    if (!INV) {
#pragma unroll
      for (int mm = 0; mm < 16; ++mm) x[mm] = X[PX(base + mm * q)];
      dft16(x);
      float2 w = w1;
      X[PX(base)] = x[0];
#pragma unroll
      for (int k = 1; k < 16; ++k) {
        const int p = 4 * (k & 3) + (k >> 2);
        X[PX(base + k * q)] = cmul(x[p], w);
        w = cmul(w, w1);
      }
    } else {
      float2 w = w1;
      x[0] = cconj(X[PX(base)]);
#pragma unroll
      for (int k = 1; k < 16; ++k) {
        x[k] = cmul(cconj(X[PX(base + k * q)]), w);
        w = cmul(w, w1);
      }
      dft16(x);
#pragma unroll
      for (int p = 0; p < 16; ++p) {
        const int mm = (p >> 2) + 4 * (p & 3);
        X[PX(base + mm * q)] = cconj(x[p]);
      }
    }
  }
  tab_finish(job, tv, thas, tid & 63);
}
template <bool INV>
DI void fft_pass4(float2* X, int tid, TabJob& job) {
  float4 tv[4]; const bool thas = tab_issue(job, tv, tid & 63);
#pragma unroll 2
  for (int bf = 0; bf < 8; ++bf) {
    const int base = PX(4 * (tid + 512 * bf));
    float2 a = X[base], b = X[base + 1], c = X[base + 2], d = X[base + 3];
    if (INV) { a = cconj(a); b = cconj(b); c = cconj(c); d = cconj(d); }
    const float2 t0 = cadd(a, c), t1 = csub(a, c), t2 = cadd(b, d), t3 = cmni(csub(b, d));
    float2 y0 = cadd(t0, t2), y1 = cadd(t1, t3), y2 = csub(t0, t2), y3 = csub(t1, t3);
    if (INV) { y0 = cconj(y0); y1 = cconj(y1); y2 = cconj(y2); y3 = cconj(y3); }
    X[base] = y0; X[base + 1] = y1; X[base + 2] = y2; X[base + 3] = y3;
  }
  tab_finish(job, tv, thas, tid & 63);
}
DI void fft_fwd(float2* X, TabJob& job) {
  const int tid = TID;
  __syncthreads(); fft_pass16<10, false>(X, tid, job);
  __syncthreads(); fft_pass16<6, false>(X, tid, job);
  __syncthreads(); fft_pass16<2, false>(X, tid, job);
  __syncthreads(); fft_pass4<false>(X, tid, job);
  __syncthreads();
}
DI void fft_inv(float2* X, TabJob& job) {
  const int tid = TID;
  __syncthreads(); fft_pass4<true>(X, tid, job);
  __syncthreads(); fft_pass16<2, true>(X, tid, job);
  __syncthreads(); fft_pass16<6, true>(X, tid, job);
  __syncthreads(); fft_pass16<10, true>(X, tid, job);
  __syncthreads();
}
DI float block_sum_512(float v, float* red) {
  for (int o = 32; o > 0; o >>= 1) v += shx(v, o);
  __syncthreads();
  if ((TID & 63) == 0) red[TID >> 6] = v;
  __syncthreads();
  float s = 0.f;
  for (int i = 0; i < 8; ++i) s += red[i];
  return s;
}
DI unsigned pkc(float2 v) { return pk2bf(v.x, v.y); }
DI float2 upkc(unsigned w) { return make_float2(bflo(w), bfhi(w)); }
DI void hyena_filter_task(int c, const bf16_t* __restrict__ hdnB, const bf16_t* __restrict__ W3t, const float* __restrict__ b3, uint2* __restrict__ H01_all,
                          char* smem, TabJob& job) {
  float2* X = (float2*)smem;
  float* red = (float*)(smem + FNP * 8);
  uint2* H01 = H01_all + (size_t)c * FN;
  const int tid = TID;
  __syncthreads();
  const float delta = fabsf(-3.0701134573253944f + (float)c * ((-15.350567286626972f + 3.0701134573253944f) / 255.f));
  const float bb00 = b3[c], bb01 = b3[256 + c], bb10 = b3[512 + c], bb11 = b3[768 + c];
  float n0 = 0.f, n1 = 0.f;
  {
    const int lane = tid & 63, wid = tid >> 6, r = lane & 31, h = lane >> 5;
    bf16x8 wa[4];
#pragma unroll
    for (int s4 = 0; s4 < 4; ++s4) {
      uint4 w = make_uint4(0u, 0u, 0u, 0u);
      if (r < 4) w = *(const uint4*)(W3t + ((size_t)((r >> 1) * 512 + (r & 1) * 256 + c)) * 64 + 16 * s4 + 8 * h);
      wa[s4] = __builtin_bit_cast(bf16x8, w);
    }
#pragma unroll 8
    for (int blk = wid; blk < SEQ / 32; blk += 8) {
      const int j = blk * 32 + r;
      const bf16_t* hp = hdnB + (size_t)blk * 2048 + (h * 32 + r) * 8;
      f32x16 acc;
#pragma unroll
      for (int i = 0; i < 16; ++i) acc[i] = 0.f;
#pragma unroll
      for (int s4 = 0; s4 < 4; ++s4) acc = MFMA32(wa[s4], *(const bf16x8*)(hp + 512 * s4), acc);
      if (h == 0) {
        const float dec = __expf(-((float)j / (float)(SEQ - 1)) * delta);
        const float f00 = (acc[0] + bb00) * dec, f01 = (acc[1] + bb01) * dec, f10 = (acc[2] + bb10) * dec, f11 = (acc[3] + bb11) * dec;
        X[PX(j)] = make_float2(f00, f10);
        n0 += fabsf(f00); n1 += fabsf(f10);
        if (j > 0) { X[PX(FN - j)] = make_float2(f01, f11); n0 += fabsf(f01); n1 += fabsf(f11); }
        else X[PX(SEQ)] = make_float2(0.f, 0.f);
      }
    }
  }
  n0 = block_sum_512(n0, red);
  n1 = block_sum_512(n1, red);
  const float s0 = 0.5f / (n0 * (float)FN), s1 = 0.5f / (n1 * (float)FN);
  fft_fwd(X, job);
  for (int pos = tid; pos < FN; pos += 512) {
    const int f = freq_of_pos(pos); const int pm = pos_of_freq((FN - f) & (FN - 1));
    const float2 A = X[PX(pos)], Bm = X[PX(pm)];
    const float2 K0 = make_float2((A.x + Bm.x) * s0, (A.y - Bm.y) * s0);
    const float2 K1 = make_float2((A.y + Bm.y) * s1, -(A.x - Bm.x) * s1);
    H01[pos] = make_uint2(pkc(K0), pkc(K1));
  }
}
DI void hyena_channel(int c, const float* __restrict__ hy_bias, const float* __restrict__ uT, float* __restrict__ zT, float* __restrict__ yT,
                      const uint2* __restrict__ H01_all, char* smem, TabJob& job) {
  float2* X = (float2*)smem;
  const uint2* H01 = H01_all + (size_t)c * FN;
  const int tid = TID;
  const float* v0p = uT + ((size_t)0 * 768 + c) * NT + CTX;
  const float* v1p = uT + ((size_t)1 * 768 + c) * NT + CTX;
  __syncthreads();
  for (int t = tid; t < SEQ; t += 512) { X[PX(t)] = make_float2(v0p[t], v1p[t]); X[PX(SEQ + t)] = make_float2(0.f, 0.f); }
  fft_fwd(X, job);
  for (int pos = tid; pos < FN; pos += 512) X[PX(pos)] = cmul(X[PX(pos)], upkc(H01[pos].x));
  fft_inv(X, job);
  {
    const float bias0 = hy_bias[c];
    const float* x10 = v0p + (size_t)256 * NT; const float* x11 = v1p + (size_t)256 * NT;
    float* z0 = zT + ((size_t)0 * 256 + c) * NT + CTX; float* z1 = zT + ((size_t)1 * 256 + c) * NT + CTX;
    for (int t = tid; t < SEQ; t += 512) {
      float2 y = X[PX(t)];
      float za = x10[t] * (y.x + bias0 * v0p[t]);
      float zb = x11[t] * (y.y + bias0 * v1p[t]);
      z0[t] = za; z1[t] = zb;
      X[PX(t)] = make_float2(za, zb);
    }
    __syncthreads();
    for (int t = tid; t < SEQ; t += 512) X[PX(SEQ + t)] = make_float2(0.f, 0.f);
  }
  fft_fwd(X, job);
  for (int pos = tid; pos < FN; pos += 512) X[PX(pos)] = cmul(X[PX(pos)], upkc(H01[pos].y));
  fft_inv(X, job);
  {
    const float bias1 = hy_bias[256 + c];
    const float* x20 = v0p + (size_t)512 * NT; const float* x21 = v1p + (size_t)512 * NT;
    const float* z0 = zT + ((size_t)0 * 256 + c) * NT + CTX; const float* z1 = zT + ((size_t)1 * 256 + c) * NT + CTX;
    float* y0 = yT + ((size_t)0 * 256 + c) * NT + CTX; float* y1 = yT + ((size_t)1 * 256 + c) * NT + CTX;
    for (int t = tid; t < SEQ; t += 512) {
      float2 y = X[PX(t)];
      y0[t] = x20[t] * (y.x + bias1 * z0[t]);
      y1[t] = x21[t] * (y.y + bias1 * z1[t]);
    }
  }
}

namespace pg8 {
#define PG8_LAS __attribute__((address_space(3)))
typedef ::bf16x8 bf16x8;
typedef float f32x4 __attribute__((ext_vector_type(4)));
typedef unsigned u32x4 __attribute__((ext_vector_type(4)));
constexpr int BM = 256, BK = 64, HALF = 128, HTB = HALF * BK * 2  , STAGE_BYTES = 8 * HTB, NXCD = 8, WGM = 8;

__host__ __device__ __forceinline__ int lds_byte(int r, int c) { const int st = (r >> 4) * 2 + (c >> 5), rr = r & 15, cc = c & 31, ob = rr * 64 + cc * 2; return st * 1024 + (ob ^ (((ob >> 9) & 1) << 5)); }
__host__ __device__ __forceinline__ void stage_rc(int b, int& R, int& C) { const int st = b / 1024, sb = b % 1024, swz = sb ^ (((sb >> 9) & 1) << 5); R = (st >> 1) * 16 + swz / 64; C = (st & 1) * 32 + (swz % 64) / 2; }
__host__ __device__ __forceinline__ int perm32(int rho) { const int n = rho >> 4, i = rho & 15; return 8 * (i >> 2) + 4 * n + (i & 3); }
struct Unit { int pm, pn; };
struct Gemm { const bf16_t* A; const bf16_t* Bt; int M, N, K; };
template <class Epi, class Sched, bool STAMP = false>
__device__ __forceinline__ void gemm_phase(PG8_LAS unsigned char* lds, const Gemm g, const Sched& S, const Epi& E, unsigned long long* stamps) {
    const int tid = TID, wid = __builtin_amdgcn_readfirstlane(tid >> 6), lane = tid & 63, wr = wid >> 2, wc = wid & 3, fr = lane & 15, fq = lane >> 4;
    const int K = g.K, nt = K / BK;
    int ts_lo = 0, ts_hi = 0, nts = 0; const unsigned long long rt_entry = STAMP ? (unsigned long long)wall_clock64() : 0ull;
#define PG8_STAMP() do { if (STAMP && wid == 0 && nts < 64) { const unsigned long long _c = (unsigned long long)clock64(); \
        ts_lo = (lane == nts) ? (int)(unsigned)_c : ts_lo; ts_hi = (lane == nts) ? (int)(unsigned)(_c >> 32) : ts_hi; ++nts; } } while (0)
    PG8_STAMP();
    unsigned voffA[2], voffB[2];
#pragma unroll
    for (int i = 0; i < 2; ++i) { int R, C; stage_rc(tid * 16 + i * 8192, R, C); const int Rb = Epi::PERM ? ((R & ~31) + perm32(R & 31)) : R;
        voffA[i] = (unsigned)(R * K + C) * 2u; voffB[i] = (unsigned)(Rb * K + C) * 2u; }
    const size_t kstep = (size_t)(BK * 2);
    const size_t hstep = (size_t)HALF * K * 2;
    const size_t tstep = 2 * hstep;
    const unsigned ldsw = (unsigned)wid * 1024u;
    const int aoff = lds_byte(wr * 64 + fr, fq * 8), boff = lds_byte(wc * 32 + fr, fq * 8);
#define PG8_SA(b, h) (((b) * 2 + (h)) * HTB)
#define PG8_SB(b, h) ((4 + (b) * 2 + (h)) * HTB)
#define PG8_STAGE(bufoff, gbase, voff) do { _Pragma("unroll") for (int _i = 0; _i < 2; ++_i) \
        __builtin_amdgcn_global_load_lds((const unsigned*)((const char*)(gbase) + (voff)[_i]), (PG8_LAS unsigned*)(lds + (bufoff) + ldsw + _i * 8192), 16, 0, 0); } while (0)
#define PG8_LDA(dst, b, h) do { _Pragma("unroll") for (int m = 0; m < 4; ++m) _Pragma("unroll") for (int k = 0; k < 2; ++k) dst[m][k] = *(const PG8_LAS bf16x8*)(lds + PG8_SA(b, h) + aoff + m * 2048 + k * 1024); } while (0)
#define PG8_LDB(dst, b, h) do { _Pragma("unroll") for (int n = 0; n < 2; ++n) _Pragma("unroll") for (int k = 0; k < 2; ++k) dst[n][k] = *(const PG8_LAS bf16x8*)(lds + PG8_SB(b, h) + boff + n * 2048 + k * 1024); } while (0)
#define PG8_MMA(ai, bj, At, Bt) do { __builtin_amdgcn_s_setprio(1); _Pragma("unroll") for (int m = 0; m < 4; ++m) _Pragma("unroll") for (int n = 0; n < 2; ++n) _Pragma("unroll") for (int k = 0; k < 2; ++k) \
        acc[ai][bj][m][n] = __builtin_amdgcn_mfma_f32_16x16x32_bf16(Bt[n][k], At[m][k], acc[ai][bj][m][n], 0, 0, 0); __builtin_amdgcn_s_setprio(0); } while (0)
#define PG8_WAIT_V(n) asm volatile("s_waitcnt vmcnt(" #n ")" ::: "memory")
#define PG8_WAIT_L(n) asm volatile("s_waitcnt lgkmcnt(" #n ")" ::: "memory")
#define PG8_BAR __builtin_amdgcn_s_barrier()
#define PG8_SCHED __builtin_amdgcn_sched_barrier(0)
    Unit cur, nxt; int ui = 0;
    if (!S.next(0, cur)) return;
    f32x4 acc[2][2][4][2];
#pragma unroll
    for (int a = 0; a < 2; ++a)
#pragma unroll
        for (int b = 0; b < 2; ++b)
#pragma unroll
            for (int m = 0; m < 4; ++m)
#pragma unroll
                for (int n = 0; n < 2; ++n) acc[a][b][m][n] = (f32x4){0.f, 0.f, 0.f, 0.f};
    bf16x8 At[4][2], B0[2][2], B1[2][2];
    const char* cA = (const char*)g.A + (size_t)cur.pm * tstep; const char* cB = (const char*)g.Bt + (size_t)cur.pn * tstep;
    S.a_ready(cur);
    PG8_STAGE(PG8_SB(0, 0), cB, voffB); PG8_STAGE(PG8_SA(0, 0), cA, voffA); PG8_STAGE(PG8_SB(0, 1), cB + hstep, voffB); PG8_STAGE(PG8_SA(0, 1), cA + hstep, voffA);
    if (wr == 1) PG8_BAR;
    PG8_WAIT_V(4); PG8_BAR;
    PG8_STAGE(PG8_SB(1, 0), cB + kstep, voffB); PG8_STAGE(PG8_SA(1, 0), cA + kstep, voffA); PG8_STAGE(PG8_SB(1, 1), cB + hstep + kstep, voffB);
    PG8_WAIT_V(6); PG8_BAR;
    PG8_STAMP();
    for (;;) {
        const bool has_next = S.next(ui + 1, nxt);
        const char* nA = has_next ? (const char*)g.A + (size_t)nxt.pm * tstep : cA; const char* nB = has_next ? (const char*)g.Bt + (size_t)nxt.pn * tstep : cB;
        for (int t = 0; t < nt; t += 2) {
            const bool last = (t == nt - 2);
            const char* a1 = cA + (size_t)(t + 1) * kstep;
            const char* a2 = last ? nA : cA + (size_t)(t + 2) * kstep; const char* b2 = last ? nB : cB + (size_t)(t + 2) * kstep;
            const char* a3 = a2 + kstep; const char* b3 = b2 + kstep;
            if (last && has_next) S.a_ready(nxt);
            PG8_LDB(B0, 0, 0); PG8_SCHED; PG8_LDA(At, 0, 0); PG8_STAGE(PG8_SA(1, 1), a1 + hstep, voffA);
            PG8_WAIT_L(8); PG8_BAR; PG8_WAIT_L(0); PG8_MMA(0, 0, At, B0); PG8_BAR; PG8_SCHED;
            PG8_LDB(B1, 0, 1); PG8_STAGE(PG8_SB(0, 0), b2, voffB);
            PG8_BAR; PG8_WAIT_L(0); PG8_MMA(0, 1, At, B1); PG8_BAR;
            PG8_LDA(At, 0, 1); PG8_STAGE(PG8_SA(0, 0), a2, voffA);
            PG8_BAR; PG8_WAIT_L(0); PG8_MMA(1, 0, At, B0); PG8_BAR; PG8_SCHED;
            PG8_STAGE(PG8_SB(0, 1), b2 + hstep, voffB);
            PG8_WAIT_V(6); PG8_BAR; PG8_MMA(1, 1, At, B1); PG8_BAR;
            PG8_LDB(B0, 1, 0); PG8_SCHED; PG8_LDA(At, 1, 0); PG8_STAGE(PG8_SA(0, 1), a2 + hstep, voffA);
            PG8_WAIT_L(8); PG8_BAR; PG8_WAIT_L(0); PG8_MMA(0, 0, At, B0); PG8_BAR; PG8_SCHED;
            PG8_LDB(B1, 1, 1); PG8_STAGE(PG8_SB(1, 0), b3, voffB);
            PG8_BAR; PG8_WAIT_L(0); PG8_MMA(0, 1, At, B1); PG8_BAR;
            PG8_LDA(At, 1, 1); PG8_STAGE(PG8_SA(1, 0), a3, voffA);
            PG8_BAR; PG8_WAIT_L(0); PG8_MMA(1, 0, At, B0); PG8_BAR; PG8_SCHED;
            PG8_STAGE(PG8_SB(1, 1), b3 + hstep, voffB);
            PG8_WAIT_V(6); PG8_BAR; PG8_MMA(1, 1, At, B1); PG8_BAR;
        }
        PG8_STAMP();
        if constexpr (!Epi::AFTER_DRAIN) { E(acc, cur, wr, wc, fr, fq); S.done(cur); }
        PG8_STAMP();
        if (!has_next) break;
#pragma unroll
        for (int a = 0; a < 2; ++a)
#pragma unroll
            for (int b = 0; b < 2; ++b)
#pragma unroll
                for (int m = 0; m < 4; ++m)
#pragma unroll
                    for (int n = 0; n < 2; ++n) acc[a][b][m][n] = (f32x4){0.f, 0.f, 0.f, 0.f};
        cur = nxt; cA = nA; cB = nB; ++ui;
    }
    PG8_WAIT_V(0);
    if (wr == 0) PG8_BAR;
    PG8_BAR;
    if constexpr (Epi::AFTER_DRAIN) { E.fused(acc, cur, wr, wc, fr, fq, lds, wid, lane); S.done(cur); }
    PG8_STAMP();
    if (STAMP && wid == 0) { stamps[lane] = lane < nts ? (((unsigned long long)(unsigned)ts_hi << 32) | (unsigned)ts_lo) : 0ull;
        if (lane == 62) stamps[62] = rt_entry; if (lane == 63) stamps[63] = (unsigned long long)wall_clock64(); }
#undef PG8_STAMP
#undef PG8_SA
#undef PG8_SB
#undef PG8_STAGE
#undef PG8_LDA
#undef PG8_LDB
#undef PG8_MMA
#undef PG8_WAIT_V
#undef PG8_WAIT_L
#undef PG8_BAR
#undef PG8_SCHED
}
}

#ifndef GEMM_WGM
#define GEMM_WGM 4
#endif
struct MySched {
  int nN, nunits, G, c; bool latent_only;
  DI void init(int N, bool lat_only, int G_, int c_) { nN = N / 256; latent_only = lat_only; nunits = (lat_only ? 64 : 66) * nN; G = G_; c = c_; }
  DI bool next(int i, pg8::Unit& u) const {
    const int L = i * G + c; if (L >= nunits) return false;
    const int nM = latent_only ? 64 : 66;
    int wgid = L;
    { const int q = nunits / 8, r = nunits % 8, xcd = wgid % 8, off = wgid / 8; wgid = (xcd < r ? xcd * (q + 1) : r * (q + 1) + (xcd - r) * q) + off; }
    const int nig = GEMM_WGM * nN, gid = wgid / nig, fm = gid * GEMM_WGM, gsz = (nM - fm) < GEMM_WGM ? (nM - fm) : GEMM_WGM;
    const int ri = fm + ((wgid % nig) % gsz);
    u.pn = (wgid % nig) / gsz;
    u.pm = latent_only ? (ri / 32) * 33 + 1 + (ri % 32) : ri;
    return true;
  }
  DI void a_ready(const pg8::Unit&) const {}
  DI void done(const pg8::Unit&) const {}
};
struct EpiStoreBf16 {
  static constexpr bool PERM = true, AFTER_DRAIN = false;
  bf16_t* Cb; int ldc;
  DI void operator()(const pg8::f32x4 (&acc)[2][2][4][2], const pg8::Unit& u, int wr, int wc, int fr, int fq) const {
    const int row0 = u.pm * 256 + wr * 64 + fr, col0 = u.pn * 256 + wc * 32 + 8 * fq;
#pragma unroll
    for (int ai = 0; ai < 2; ++ai)
#pragma unroll
      for (int m = 0; m < 4; ++m) {
        bf16_t* rowp = Cb + (size_t)(row0 + ai * 128 + m * 16) * ldc + col0;
#pragma unroll
        for (int bj = 0; bj < 2; ++bj) {
          const pg8::f32x4 v0 = acc[ai][bj][m][0], v1 = acc[ai][bj][m][1];
          *(uint4*)(rowp + bj * 128) = make_uint4(pk2bf(v0[0], v0[1]), pk2bf(v0[2], v0[3]), pk2bf(v1[0], v1[1]), pk2bf(v1[2], v1[3]));
        }
      }
  }
};
struct EpiResidual {
  static constexpr bool PERM = true, AFTER_DRAIN = false;
  float* xs; const float* gate_base; const float* xin; const float* ctxin;
  DI void operator()(const pg8::f32x4 (&acc)[2][2][4][2], const pg8::Unit& u, int wr, int wc, int fr, int fq) const {
    const int row0 = u.pm * 256 + wr * 64 + fr, col0 = u.pn * 256 + wc * 32 + 8 * fq;
    const int b = u.pm / 33; const int mrow = (u.pm % 33) == 0 ? 2 : b;
    const int pt = (u.pm % 33) * 256 + wr * 64 + fr;
    const float* gt = gate_base + mrow * NMOD + col0;
#pragma unroll
    for (int ai = 0; ai < 2; ++ai)
#pragma unroll
      for (int m = 0; m < 4; ++m) {
        float* rowp = xs + (size_t)(row0 + ai * 128 + m * 16) * D + col0;
        const int pp = pt + ai * 128 + m * 16;
        const float* srcp = xin ? (pp < CTX ? ctxin + ((size_t)b * CTX + pp) * D + col0 : xin + ((size_t)b * SEQ + (pp - CTX)) * D + col0) : rowp;
#pragma unroll
        for (int bj = 0; bj < 2; ++bj)
#pragma unroll
          for (int n = 0; n < 2; ++n) {
            const pg8::f32x4 v = acc[ai][bj][m][n];
            const float4 g4 = *(const float4*)(gt + bj * 128 + n * 4);
            float4 xv = *(const float4*)(srcp + bj * 128 + n * 4);
            xv.x += g4.x * v[0]; xv.y += g4.y * v[1]; xv.z += g4.z * v[2]; xv.w += g4.w * v[3];
            *(float4*)(rowp + bj * 128 + n * 4) = xv;
          }
      }
  }
};

#define XB_TMO      128
#define XB_XCNT(j)  (256  + 64 * (j))
#define XB_XSUB(j)  (1280 + 64 * (j))
#define XB_XGEN(j)  (2304 + 64 * (j))
#define XB_TOP      3328
#define XB_TOPGEN   3392
#define XB_SPIN_CAP (1u << 22)
DI unsigned xb_ld(unsigned* p) { return __hip_atomic_load(p, __ATOMIC_RELAXED, __HIP_MEMORY_SCOPE_AGENT); }
DI unsigned xb_add(unsigned* p, unsigned v) { return __hip_atomic_fetch_add(p, v, __ATOMIC_RELAXED, __HIP_MEMORY_SCOPE_AGENT); }
DI unsigned xb_xcc_id() { return (unsigned)__builtin_amdgcn_s_getreg((3 << 11) | 20) & 0xFu; }
#define XB_SPIN(cond, bar) do { unsigned _sp = 0; while (cond) { __builtin_amdgcn_s_sleep(1); \
    if ((++_sp & 255u) == 0u) { if (xb_ld(&(bar)[XB_TMO])) break; if (_sp > XB_SPIN_CAP) { atomicAdd(&(bar)[XB_TMO], 1u); break; } } } } while (0)
DI void xcd_barrier_post(unsigned* bar, volatile LAS unsigned* st) {
  if (threadIdx.x == 0) { const unsigned x = xb_xcc_id(); st[3] = x; st[2] = xb_add(&bar[XB_XCNT(x)], 1u); }
}
DI void xcd_barrier_complete(unsigned* bar, unsigned x, unsigned& nloc, unsigned& nx) {
  const unsigned G = gridDim.x;
  unsigned sum, cnt, mine, sp = 0u;
  for (;;) {
    sum = 0u; cnt = 0u; mine = 0u;
#pragma unroll
    for (unsigned j = 0; j < 16; ++j) { const unsigned c = xb_ld(&bar[XB_XCNT(j)]); sum += c; cnt += (c > 0u) ? 1u : 0u; mine = (j == x) ? c : mine; }
    if (sum == G) break;
    __builtin_amdgcn_s_sleep(1);
    if ((++sp & 255u) == 0u) { if (xb_ld(&bar[XB_TMO])) break; if (sp > XB_SPIN_CAP) { atomicAdd(&bar[XB_TMO], 1u); break; } }
  }
  nloc = mine > 0u ? mine : 1u; nx = cnt > 0u ? cnt : 1u;
}
DI void xcd_barrier(unsigned* bar, volatile LAS unsigned* st) {
  asm volatile("s_waitcnt vmcnt(0)" ::: "memory");
  __syncthreads();
  if (threadIdx.x == 0) {
    const unsigned x = xb_xcc_id();
    __builtin_amdgcn_s_waitcnt(0);
    unsigned nloc = st[0], nx = st[1];
    if (nloc == 0u) { xcd_barrier_complete(bar, x, nloc, nx); st[0] = nloc; st[1] = nx; }
    const unsigned old = xb_add(&bar[XB_XSUB(x)], 1u);
    const unsigned gen = old / nloc;
    if (old + 1u == (gen + 1u) * nloc) {
      __builtin_amdgcn_fence(__ATOMIC_RELEASE, "agent");
      asm volatile("s_waitcnt vmcnt(0)" ::: "memory");
      const unsigned og = xb_add(&bar[XB_TOP], 1u);
      const unsigned tg = og / nx;
      if (og + 1u == (tg + 1u) * nx) xb_add(&bar[XB_TOPGEN], 1u);
      else XB_SPIN(xb_ld(&bar[XB_TOPGEN]) == tg, bar);
      __builtin_amdgcn_fence(__ATOMIC_ACQUIRE, "agent");
      xb_add(&bar[XB_XGEN(x)], 1u);
      asm volatile("s_waitcnt vmcnt(0)" ::: "memory");
    } else {
      XB_SPIN(xb_ld(&bar[XB_XGEN(x)]) == gen, bar);
      __builtin_amdgcn_fence(__ATOMIC_ACQUIRE, "agent");
      asm volatile("s_waitcnt vmcnt(0)" ::: "memory");
    }
  }
  __syncthreads();
}

#define XCD_BAR_WORDS 3456
constexpr size_t al256(size_t x) { return (x + 255) & ~(size_t)255; }
constexpr size_t OFF_modv = 0;
constexpr size_t OFF_xs = al256(OFF_modv + (size_t)2 * 3 * NMOD * 4);
constexpr size_t OFF_hbuf = al256(OFF_xs + (size_t)R * D * 4);
constexpr size_t OFF_P = al256(OFF_hbuf + (size_t)R * D * 2);
constexpr size_t OFF_Wt_in = al256(OFF_P + (size_t)R * DIN * 2);
constexpr size_t OFF_Wt_out = al256(OFF_Wt_in + (size_t)2 * DIN * D * 2);
constexpr size_t OFF_Wt_q = al256(OFF_Wt_out + (size_t)2 * D * D * 2);
constexpr size_t OFF_QA = al256(OFF_Wt_q + (size_t)2 * 2048 * D * 2);
constexpr size_t OFF_KA = al256(OFF_QA + (size_t)NB * 8 * NT * 32 * 2);
constexpr size_t OFF_VAt = al256(OFF_KA + (size_t)NB * 8 * NT * 32 * 2);
constexpr size_t OFF_QW = al256(OFF_VAt + (size_t)NB * 4 * 64 * NT * 2);
constexpr size_t OFF_KW = al256(OFF_QW + (size_t)NB * 4 * NT * 64 * 2);
constexpr size_t OFF_VWt = al256(OFF_KW + (size_t)NB * 2 * NT * 64 * 2);
constexpr size_t OFF_QG = al256(OFF_VWt + (size_t)NB * 2 * 64 * NT * 2);
constexpr size_t OFF_KG = al256(OFF_QG + (size_t)NB * 4 * NT * 64 * 2);
constexpr size_t OFF_VGt = al256(OFF_KG + (size_t)NB * 2 * NT * 64 * 2);
constexpr size_t OFF_uT = al256(OFF_VGt + (size_t)NB * 2 * 64 * NT * 2);
constexpr size_t OFF_zT = al256(OFF_uT + (size_t)NB * 768 * NT * 4);
constexpr size_t OFF_yT = al256(OFF_zT + (size_t)NB * 256 * NT * 4);
constexpr size_t OFF_hdn2 = al256(OFF_yT + (size_t)NB * 256 * NT * 4);
constexpr size_t OFF_Hc = al256(OFF_hdn2 + (size_t)2 * NT * 64 * 4);
constexpr size_t OFF_A2 = al256(OFF_Hc + (size_t)256 * 2 * SEQ * 8);
constexpr size_t OFF_u8 = al256(OFF_A2 + (size_t)R * D * 2);
constexpr size_t OFF_v8 = al256(OFF_u8 + (size_t)2 * 16384 * D);
constexpr size_t OFF_us = al256(OFF_v8 + (size_t)2 * 16384 * D);
constexpr size_t OFF_vs = al256(OFF_us + (size_t)2 * 16384 * 4);
constexpr size_t OFF_keysb = al256(OFF_vs + (size_t)2 * 16384 * 4);
constexpr size_t OFF_bar = al256(OFF_keysb + (size_t)2 * 16 * 128 * 128 * 2);
constexpr size_t OFF_hdnB = al256(OFF_bar + (size_t)XCD_BAR_WORDS * 4);
constexpr size_t OFF_W3t = al256(OFF_hdnB + (size_t)2 * SEQ * 64 * 2);
constexpr size_t WS_TOTAL = al256(OFF_W3t + (size_t)2 * 1024 * 64 * 2);
constexpr size_t OFF_topv = OFF_uT;
constexpr size_t OFF_topi = OFF_topv + (size_t)R * 256 * 4;
constexpr size_t OFF_experts = OFF_topi + (size_t)R * 256;
constexpr size_t OFF_gates = OFF_experts + (size_t)R * 128 * 4;
constexpr size_t OFF_xq = OFF_A2;
constexpr size_t OFF_xqs = OFF_xq + (size_t)R * D;
constexpr size_t OFF_wsc = OFF_xqs + (size_t)R * 4;
static_assert(OFF_wsc + (size_t)R * 4 <= OFF_u8, "xq overflows A2");
constexpr size_t OFF_Oslab = OFF_P;
constexpr size_t OFF_Lslab = OFF_Oslab + (size_t)2 * NB * 4 * NT * 64 * 4;
static_assert(OFF_gates + (size_t)R * 128 * 4 <= OFF_zT, "routing buffers overflow uT");
static_assert(OFF_Lslab + (size_t)2 * NB * 4 * NT * 4 <= OFF_Wt_in, "slabs overflow P");

struct MKView;
struct MK {
  const float *x, *c, *ctx, *c_ctx, *w_mod, *b_mod, *g_norm_mix, *w_in, *g_qk_diff, *lambda_diff, *g_qk_win, *sink_win, *g_qk_glob, *hy_conv_w,
      *hy_conv_b, *hy_w1, *hy_b1, *hy_w2, *hy_b2, *hy_w3, *hy_b3, *hy_freq, *hy_bias, *g_mix_out, *w_out, *g_norm_ffn, *peer_wq, *peer_keys,
      *peer_u, *peer_v;
  float* out;
  char* ws;
};
constexpr int SMEM_BYTES = (FN + (FN >> 6) * 4) * 8 + 2048;
typedef const MK __attribute__((address_space(4))) * MKP;
DI MK launder_mk(MKP a) {
  asm volatile("" : "+s"(a));
  MK r;
  r.x = a->x; r.c = a->c; r.ctx = a->ctx; r.c_ctx = a->c_ctx; r.w_mod = a->w_mod; r.b_mod = a->b_mod;
  r.g_norm_mix = a->g_norm_mix; r.w_in = a->w_in; r.g_qk_diff = a->g_qk_diff; r.lambda_diff = a->lambda_diff;
  r.g_qk_win = a->g_qk_win; r.sink_win = a->sink_win; r.g_qk_glob = a->g_qk_glob; r.hy_conv_w = a->hy_conv_w;
  r.hy_conv_b = a->hy_conv_b; r.hy_w1 = a->hy_w1; r.hy_b1 = a->hy_b1; r.hy_w2 = a->hy_w2; r.hy_b2 = a->hy_b2;
  r.hy_w3 = a->hy_w3; r.hy_b3 = a->hy_b3; r.hy_freq = a->hy_freq; r.hy_bias = a->hy_bias; r.g_mix_out = a->g_mix_out;
  r.w_out = a->w_out; r.g_norm_ffn = a->g_norm_ffn; r.peer_wq = a->peer_wq; r.peer_keys = a->peer_keys;
  r.peer_u = a->peer_u; r.peer_v = a->peer_v; r.out = a->out; r.ws = a->ws;
  return r;
}

DI void ph_mod_item(const MK& m, int item, char* smem) {
  float* sc = (float*)smem;
  float* part = sc + 3 * D;
  const int tid = TID, lane = tid & 63, wv = tid >> 6;
  const int l = item / 96, chunk = item % 96;
  __syncthreads();
  for (int i = tid; i < 3 * D; i += NTHR) {
    int row = i / D, k = i % D;
    float v = row < 2 ? m.c[row * D + k] : m.c_ctx[k];
    sc[i] = v / (1.f + __expf(-v));
  }
  __syncthreads();
  const int col = chunk * 64 + lane;
  const float* w = m.w_mod + (size_t)l * D * NMOD + (size_t)(wv * 128) * NMOD + col;
  float a0 = 0, a1 = 0, a2 = 0;
#pragma unroll 8
  for (int k = 0; k < 128; ++k) {
    float wvv = w[(size_t)k * NMOD];
    a0 += sc[wv * 128 + k] * wvv; a1 += sc[D + wv * 128 + k] * wvv; a2 += sc[2 * D + wv * 128 + k] * wvv;
  }
  part[(wv * 3 + 0) * 64 + lane] = a0; part[(wv * 3 + 1) * 64 + lane] = a1; part[(wv * 3 + 2) * 64 + lane] = a2;
  __syncthreads();
  if (tid < 192) {
    const int row = tid >> 6;
    float sacc = 0.f;
    for (int q = 0; q < 8; ++q) sacc += part[(q * 3 + row) * 64 + lane];
    ((float*)(m.ws + OFF_modv))[(l * 3 + row) * NMOD + col] = sacc + m.b_mod[l * NMOD + col];
  }
}
DI void ph_hymlp_group(const MK& m, int g, char* smem) {
  const int tid = TID, wv = tid >> 6, u = tid & 63;
  float* feat = (float*)smem + wv * 128;
  float* h1 = feat + 64;
  const int gi = g * 8 + wv;
  const int l = gi / NT, pos = gi % NT;
  const int which = pos >= SEQ ? 1 : 0;
  const int j = which ? pos - SEQ : pos;
  const int n = which ? CTX : SEQ;
  const float tt = (float)j / (float)(n - 1);
  const float w = (6.283185307179586f / (float)n) * (float)j;
  __syncthreads();
  if (u == 0) feat[0] = tt;
  if (u < 16) {
    float f = 1e-4f + (float)u * ((15.f - 1e-4f) / 15.f);
    feat[1 + u] = cosf(f * w);
    feat[17 + u] = -sinf(f * w);
  }
  __syncthreads();
  const float* w1 = m.hy_w1 + l * 33 * 64; const float* w2 = m.hy_w2 + l * 64 * 64;
  const float fq = m.hy_freq[l * 64 + u];
  float a = m.hy_b1[l * 64 + u];
  for (int i = 0; i < 33; ++i) a += feat[i] * w1[i * 64 + u];
  h1[u] = sinf(fq * a);
  __syncthreads();
  float a2 = m.hy_b2[l * 64 + u];
  for (int i = 0; i < 64; ++i) a2 += h1[i] * w2[i * 64 + u];
  const float hv2 = sinf(fq * a2);
  ((float*)(m.ws + OFF_hdn2))[((size_t)l * 64 + u) * NT + pos] = hv2;
  if (!which) ((bf16_t*)(m.ws + OFF_hdnB))[(size_t)l * SEQ * 64 + (size_t)(pos >> 5) * 2048 + (u >> 4) * 512 + (((u >> 3) & 1) * 32 + (pos & 31)) * 8 + (u & 7)] = f2bf(hv2);
}
DI void phase0(MKP m_in, char* smem) {
  const MK m = launder_mk(m_in);
  const int bid = BID, nb = NBLK, tid = TID;
  for (int it = bid; it < 192; it += nb) ph_mod_item(m, it, smem);
  for (int g = bid; g < 2 * NT / 8; g += nb) ph_hymlp_group(m, g, smem);
  for (int t = bid; t < 2 * 1408; t += nb) {
    int l = t / 1408, tt = t % 1408;
    if (tt < 640) wconv_tile(m.w_in + (size_t)l * D * DIN, ((bf16_t*)(m.ws + OFF_Wt_in)) + (size_t)l * DIN * D, DIN, tt, (float*)smem);
    else if (tt < 896) wconv_tile(m.w_out + (size_t)l * D * D, ((bf16_t*)(m.ws + OFF_Wt_out)) + (size_t)l * D * D, D, tt - 640, (float*)smem);
    else wconv_tile(m.peer_wq + (size_t)l * D * 2048, ((bf16_t*)(m.ws + OFF_Wt_q)) + (size_t)l * 2048 * D, 2048, tt - 896, (float*)smem);
  }
  for (int i = bid * NTHR + tid; i < 2 * 16 * 128 * 128 / 4; i += nb * NTHR) {
    float4 v = ((const float4*)m.peer_keys)[i];
    ((uint2*)((bf16_t*)(m.ws + OFF_keysb)))[i] = make_uint2(pk2bf(v.x, v.y), pk2bf(v.z, v.w));
  }
  for (int i = bid * NTHR + tid; i < 2 * 1024 * 64; i += nb * NTHR) {
    const int l = i >> 16, n = (i >> 6) & 1023, k = i & 63;
    ((bf16_t*)(m.ws + OFF_W3t))[i] = f2bf(m.hy_w3[((size_t)l * 64 + k) * 1024 + n]);
  }
}

DI void phase_norm(MKP m_in, int l, int which  , bool first, bool skip_ctx) {
  const MK m = launder_mk(m_in);
  const int tid = TID, lane = tid & 63;
  const int gw = BID * 8 + (tid >> 6), nw = NBLK * 8;
  const float* g = (which ? m.g_norm_ffn : m.g_norm_mix) + l * D;
  const float* modv_l = ((float*)(m.ws + OFF_modv)) + (size_t)l * 3 * NMOD;
  for (int r = gw; r < R; r += nw) {
    const int b = r / NT, p = r % NT;
    if (skip_ctx && p < CTX) continue;
    const int mrow = p < CTX ? 2 : b;
    const float4* src = (const float4*)(first ? (p < CTX ? m.ctx + ((size_t)b * CTX + p) * D : m.x + ((size_t)b * SEQ + (p - CTX)) * D)
                                              : ((float*)(m.ws + OFF_xs)) + (size_t)r * D);
    float4 v[4];
    float ss = 0.f;
#pragma unroll
    for (int i = 0; i < 4; ++i) { v[i] = src[lane + 64 * i]; ss += v[i].x * v[i].x + v[i].y * v[i].y + v[i].z * v[i].z + v[i].w * v[i].w; }
    for (int o = 32; o > 0; o >>= 1) ss += shxl(ss, lane, o);
    const float rs = rsqrtf(ss * (1.f / D) + EPS);
    const float* sh = modv_l + mrow * NMOD + (which ? 3 : 0) * D;
    const float* sc = sh + D;
#pragma unroll
    for (int i = 0; i < 4; ++i) {
      const int c0 = (lane + 64 * i) * 4;
      float4 gg = *(const float4*)(g + c0), s4 = *(const float4*)(sc + c0), h4 = *(const float4*)(sh + c0);
      float o0 = v[i].x * rs * gg.x * (1.f + s4.x) + h4.x, o1 = v[i].y * rs * gg.y * (1.f + s4.y) + h4.y;
      float o2 = v[i].z * rs * gg.z * (1.f + s4.z) + h4.z, o3 = v[i].w * rs * gg.w * (1.f + s4.w) + h4.w;
      *(uint2*)(((bf16_t*)(m.ws + OFF_hbuf)) + (size_t)r * D + c0) = make_uint2(pk2bf(o0, o1), pk2bf(o2, o3));
      v[i] = make_float4(o0, o1, o2, o3);
    }
    if (which) {
      float mx = 0.f;
#pragma unroll
      for (int i = 0; i < 4; ++i) mx = fmaxf(mx, fmaxf(fmaxf(fabsf(v[i].x), fabsf(v[i].y)), fmaxf(fabsf(v[i].z), fabsf(v[i].w))));
      for (int o = 32; o > 0; o >>= 1) mx = fmaxf(mx, shxl(mx, lane, o));
      mx = fmaxf(mx, 1e-30f);
      const float inv = 127.f / mx;
      *(uint4*)(((unsigned char*)(m.ws + OFF_xq)) + (size_t)r * D + lane * 16) =
          make_uint4(pack_i8x4(v[0].x * inv, v[0].y * inv, v[0].z * inv, v[0].w * inv), pack_i8x4(v[1].x * inv, v[1].y * inv, v[1].z * inv, v[1].w * inv),
                     pack_i8x4(v[2].x * inv, v[2].y * inv, v[2].z * inv, v[2].w * inv), pack_i8x4(v[3].x * inv, v[3].y * inv, v[3].z * inv, v[3].w * inv));
      if (lane == 0) ((float*)(m.ws + OFF_xqs))[r] = mx * (1.f / 127.f);
    }
  }
}

DI int rowtile_of(int i, bool latent_only) { return latent_only ? (i / 64) * 66 + 2 + (i % 64) : i; }
template <int EPI>
DI void phase_gemm(const bf16_t* A, const bf16_t* Wt, int N, bf16_t* Cb, float* xs, const float* gate_base, bool latent_only, char* smem) {
  const int nt_n = N / 128, nrt = latent_only ? 128 : 132, ntiles = nrt * nt_n;
  for (int t = BID; t < ntiles; t += NBLK) {
    int tm = rowtile_of(t / nt_n, latent_only), tn = t % nt_n;
    gemm_tile<EPI>(A, Wt, N, tm * 128, tn * 128, smem, Cb, xs, gate_base);
  }
}

DI void rope_pair8(float (&y)[8], const float (&part)[8], bool upper, const float* cs, const float* sn, int dd0) {
#pragma unroll
  for (int e = 0; e < 8; ++e) {
    float c = cs[dd0 + e], s = sn[dd0 + e];
    float x1 = upper ? part[e] : y[e], x2 = upper ? y[e] : part[e];
    y[e] = upper ? (x1 * s + x2 * c) : (x1 * c - x2 * s);
  }
}
DI void unpack8(uint4 w, float (&v)[8]) {
  v[0] = bflo(w.x); v[1] = bfhi(w.x); v[2] = bflo(w.y); v[3] = bfhi(w.y); v[4] = bflo(w.z); v[5] = bfhi(w.z); v[6] = bflo(w.w); v[7] = bfhi(w.w);
}
DI uint4 pack8(const float (&v)[8], float sc) {
  return make_uint4(pk2bf(v[0] * sc, v[1] * sc), pk2bf(v[2] * sc, v[3] * sc), pk2bf(v[4] * sc, v[5] * sc), pk2bf(v[6] * sc, v[7] * sc));
}
constexpr int VS_STRIDE = 1032;
constexpr int HS_STRIDE = 1552;
DI void prep_tile(MKP m_in, int l, int tile, char* smem) {
  const MK m = launder_mk(m_in);
  const int tid = TID, lane = tid & 63, wid = tid >> 6;
  const int r0 = tile * 32; const int b = r0 / NT, p0 = r0 % NT;
  const bool lat = p0 >= CTX;
  char* Vs = smem;
  char* Hs = smem + 33280;
  float* csh = (float*)(smem + 33280 + 34 * HS_STRIDE);
  const bf16_t* Pb = ((bf16_t*)(m.ws + OFF_P)) + (size_t)(b * NT) * DIN;
  __syncthreads();
  if (lat) {
    for (int i = tid; i < 32 * 48; i += NTHR) {
      int rr = i / 48, a = i % 48;
      int t = p0 + rr - CTX;
      float trow = (float)(t / 64), tcol = (float)(t % 64);
      float* rowp = csh + rr * 96;
      if (a < 16) {
        int j = a & 7; float f = exp2f(-(float)j * (13.287712379549449f / 8.f));
        float ang = (a < 8 ? trow : tcol) * f;
        rowp[a] = cosf(ang); rowp[16 + a] = sinf(ang);
      } else {
        int aa = a - 16; int j = aa & 15; float f = exp2f(-(float)j * (13.287712379549449f / 16.f));
        float ang = (aa < 16 ? trow : tcol) * f;
        rowp[32 + aa] = cosf(ang); rowp[64 + aa] = sinf(ang);
      }
    }
  }
  {
    const int seg_lo = lat ? CTX : 0, seg_hi = lat ? NT : CTX;
    for (int ch = tid; ch < 34 * 96; ch += NTHR) {
      int rr = ch / 96, c8 = ch % 96;
      int p = p0 - 1 + rr;
      uint4 v = make_uint4(0, 0, 0, 0);
      if (p >= seg_lo && p < seg_hi) v = *(const uint4*)(Pb + (size_t)p * DIN + 1792 + c8 * 8);
      *(uint4*)(Hs + rr * HS_STRIDE + c8 * 16) = v;
    }
  }
  __syncthreads();
  const float* gd = m.g_qk_diff + l * 64; const float* gwn = m.g_qk_win + l * 128; const float* gg = m.g_qk_glob + l * 128;
#pragma unroll
  for (int k = 0; k < 4; ++k) {
    const int rr = wid + 8 * k; const int p = p0 + rr;
    const bf16_t* Pr = Pb + (size_t)p * DIN;
    const float* rowp = csh + rr * 96;
    {
      float y[8], part[8];
      unpack8(*(const uint4*)(Pr + 8 * lane), y);
      float ss = 0.f;
#pragma unroll
      for (int e = 0; e < 8; ++e) ss += y[e] * y[e];
      ss += shxl(ss, lane, 1); ss += shxl(ss, lane, 2);
      const float rs = rsqrtf(ss * (1.f / 32) + EPS);
      const int unit = lane >> 2; const bool isk = unit >= 8; const int vh = unit & 7;
      const int d0 = (lane & 3) * 8;
      const float* gn = gd + (isk ? 32 : 0) + d0;
#pragma unroll
      for (int e = 0; e < 8; ++e) y[e] = y[e] * rs * gn[e];
      if (lat) {
#pragma unroll
        for (int e = 0; e < 8; ++e) part[e] = shxl(y[e], lane, 2);
        rope_pair8(y, part, (lane & 2) != 0, rowp, rowp + 16, (lane & 1) * 8);
      }
      bf16_t* dst = (isk ? ((bf16_t*)(m.ws + OFF_KA)) : ((bf16_t*)(m.ws + OFF_QA))) + (((size_t)b * 8 + vh) * NT + p) * 32 + d0;
      *(uint4*)dst = pack8(y, isk ? 1.f : 0.17677669529663687f * LOG2E);
    }
#pragma unroll
    for (int grp = 0; grp < 2; ++grp) {
      float y[8], part[8];
      const int cbase = grp == 0 ? 768 : 1280;
      uint4 w = make_uint4(0, 0, 0, 0);
      if (lane < 48) w = *(const uint4*)(Pr + cbase + 8 * lane);
      unpack8(w, y);
      float ss = 0.f;
#pragma unroll
      for (int e = 0; e < 8; ++e) ss += y[e] * y[e];
      ss += shxl(ss, lane, 1); ss += shxl(ss, lane, 2); ss += shxl(ss, lane, 4);
      const float rs = rsqrtf(ss * (1.f / 64) + EPS);
      const int unit = lane >> 3; const bool isk = unit >= 4; const int hh = isk ? unit - 4 : unit;
      const int d0 = (lane & 7) * 8;
      const float* gn = (grp == 0 ? gwn : gg) + (isk ? 64 : 0) + d0;
      if (lane < 48) {
#pragma unroll
        for (int e = 0; e < 8; ++e) y[e] = y[e] * rs * gn[e];
      }
      if (lat) {
#pragma unroll
        for (int e = 0; e < 8; ++e) part[e] = shxl(y[e], lane, 4);
        rope_pair8(y, part, (lane & 4) != 0, rowp + 32, rowp + 64, (lane & 3) * 8);
      }
      if (lane < 48) {
        bf16_t* base = grp == 0 ? (isk ? ((bf16_t*)(m.ws + OFF_KW)) : ((bf16_t*)(m.ws + OFF_QW))) : (isk ? ((bf16_t*)(m.ws + OFF_KG)) : ((bf16_t*)(m.ws + OFF_QG)));
        bf16_t* dst = base + (((size_t)b * (isk ? 2 : 4) + hh) * NT + p) * 64 + d0;
        *(uint4*)dst = pack8(y, isk ? 1.f : 0.125f * LOG2E);
      }
    }
    {
      const int vsrc = lane < 32 ? 512 + 8 * lane : (lane < 48 ? 1152 + 8 * (lane - 32) : 1664 + 8 * (lane - 48));
      uint4 w = *(const uint4*)(Pr + vsrc);
      *(uint2*)(Vs + rr * VS_STRIDE + lane * 16) = make_uint2(w.x, w.y);
      *(uint2*)(Vs + rr * VS_STRIDE + lane * 16 + 8) = make_uint2(w.z, w.w);
    }
  }
  __syncthreads();
  for (int tk = tid; tk < 2048; tk += NTHR) {
    const int pg = tk & 3; const int vch = (tk >> 2) & 15 | ((tk >> 6) << 4);
    unsigned short e[8];
#pragma unroll
    for (int i = 0; i < 8; ++i) {
      int sidx = 8 * pg + i;
      int pl = (sidx & 16) | perm16(sidx & 15);
      e[i] = *(const unsigned short*)(Vs + pl * VS_STRIDE + vch * 2);
    }
    uint4 w = make_uint4(e[0] | ((unsigned)e[1] << 16), e[2] | ((unsigned)e[3] << 16), e[4] | ((unsigned)e[5] << 16), e[6] | ((unsigned)e[7] << 16));
    bf16_t* dst;
    if (vch < 256) dst = ((bf16_t*)(m.ws + OFF_VAt)) + (((size_t)b * 4 + (vch >> 6)) * 64 + (vch & 63)) * NT;
    else if (vch < 384) dst = ((bf16_t*)(m.ws + OFF_VWt)) + (((size_t)b * 2 + ((vch - 256) >> 6)) * 64 + (vch & 63)) * NT;
    else dst = ((bf16_t*)(m.ws + OFF_VGt)) + (((size_t)b * 2 + ((vch - 384) >> 6)) * 64 + (vch & 63)) * NT;
    *(uint4*)(dst + p0 + 8 * pg) = w;
  }
  {
    const float* cw = ((const float*)m.hy_conv_w) + l * 3 * 768; const float* cb = ((const float*)m.hy_conv_b) + l * 768;
    const int cc = lane >> 3, pg = lane & 7;
#pragma unroll 2
    for (int cg = wid; cg < 96; cg += 8) {
      const int c = cg * 8 + cc;
      const float w0 = cw[c], w1 = cw[768 + c], w2 = cw[1536 + c], bb = cb[c];
      float xin[6];
#pragma unroll
      for (int i = 0; i < 6; ++i) xin[i] = bf2f(*(const bf16_t*)(Hs + (4 * pg + i) * HS_STRIDE + c * 2));
      float o[4];
#pragma unroll
      for (int i = 0; i < 4; ++i) o[i] = xin[i] * w0 + xin[i + 1] * w1 + xin[i + 2] * w2 + bb;
      *(float4*)(((float*)(m.ws + OFF_uT)) + ((size_t)b * 768 + c) * NT + p0 + 4 * pg) = make_float4(o[0], o[1], o[2], o[3]);
    }
  }
}

DI void hyena_ctx_channel(MKP m_in, int l, int c, char* smem) {
  const MK m = launder_mk(m_in);
  float* kf = (float*)smem;
  float* vz = kf + 1024;
  float* red = vz + 512;
  float* wcol = red + 16;
  const int tid = TID;
  const float* hd = ((float*)(m.ws + OFF_hdn2)) + (size_t)l * 64 * NT + SEQ;
  const float* w3 = m.hy_w3 + (size_t)l * 64 * 1024; const float* b3 = m.hy_b3 + l * 1024;
  __syncthreads();
  if (tid < 256) { int od = tid >> 6, i = tid & 63; wcol[i * 4 + od] = w3[i * 1024 + (od >> 1) * 512 + (od & 1) * 256 + c]; }
  __syncthreads();
  const float delta = fabsf(-3.0701134573253944f + (float)c * ((-15.350567286626972f + 3.0701134573253944f) / 255.f));
  float n0 = 0.f, n1 = 0.f;
  if (tid < 256) {
    const int j = tid;
    float f00 = b3[c], f01 = b3[256 + c], f10 = b3[512 + c], f11 = b3[768 + c];
#pragma unroll 4
    for (int i = 0; i < 64; ++i) {
      float hv = hd[(size_t)i * NT + j];
      const float4 w = *(const float4*)(wcol + 4 * i);
      f00 += hv * w.x; f01 += hv * w.y; f10 += hv * w.z; f11 += hv * w.w;
    }
    const float dec = __expf(-((float)j / (float)(CTX - 1)) * delta);
    f00 *= dec; f01 *= dec; f10 *= dec; f11 *= dec;
    kf[256 + j] = f00; kf[512 + 256 + j] = f10; n0 += fabsf(f00); n1 += fabsf(f10);
    if (j > 0) { kf[256 - j] = f01; kf[512 + 256 - j] = f11; n0 += fabsf(f01); n1 += fabsf(f11); }
    else { kf[0] = 0.f; kf[512] = 0.f; }
  }
  n0 = block_sum_512(n0, red);
  n1 = block_sum_512(n1, red);
  const float i0 = 1.f / n0, i1 = 1.f / n1;
  const int bb = tid >> 8, t = tid & 255;
  const float* ub = ((float*)(m.ws + OFF_uT)) + ((size_t)bb * 768 + c) * NT;
  const float vself = ub[t];
  vz[bb * 256 + t] = vself;
  __syncthreads();
  float acc = 0.f;
  for (int s2 = 0; s2 < 256; s2 += 4) { const float4 v4 = *(const float4*)(vz + bb * 256 + s2); const float* kp = kf + 256 + t - s2; acc += v4.x * kp[0] + v4.y * kp[-1] + v4.z * kp[-2] + v4.w * kp[-3]; }
  const float z = ub[(size_t)256 * NT + t] * (acc * i0 + m.hy_bias[l * 512 + c] * vself);
  __syncthreads();
  vz[bb * 256 + t] = z;
  __syncthreads();
  float acc2 = 0.f;
  for (int s2 = 0; s2 < 256; s2 += 4) { const float4 v4 = *(const float4*)(vz + bb * 256 + s2); const float* kp = kf + 512 + 256 + t - s2; acc2 += v4.x * kp[0] + v4.y * kp[-1] + v4.z * kp[-2] + v4.w * kp[-3]; }
  ((float*)(m.ws + OFF_yT))[((size_t)bb * 256 + c) * NT + t] = ub[(size_t)512 * NT + t] * (acc2 * i1 + m.hy_bias[l * 512 + 256 + c] * z);
}

DI TabJob make_tabjob(const MK& m, int l, int slot0, bool on) {
  TabJob j;
  j.pu = on ? m.peer_u + (size_t)l * 16384 * D : nullptr; j.pv = m.peer_v + (size_t)l * 16384 * D;
  j.du = ((unsigned char*)(m.ws + OFF_u8)) + (size_t)l * 16384 * D; j.dv = ((unsigned char*)(m.ws + OFF_v8)) + (size_t)l * 16384 * D;
  j.su = ((float*)(m.ws + OFF_us)) + l * 16384; j.sv = ((float*)(m.ws + OFF_vs)) + l * 16384;
  j.slot = slot0; j.wv = __builtin_amdgcn_readfirstlane(BID * 8 + (TID >> 6)); j.nw = NBLK * 8;
  return j;
}
constexpr int TAB_SLOTS_FILTER = 4;
constexpr int TAB_SLOTS_ALL = 24;
DI void phase_mix(MKP m_in, int l, bool want_ctx, char* smem) {
  const MK m = launder_mk(m_in);
  AttnArgs a;
  a.QA = ((bf16_t*)(m.ws + OFF_QA)); a.KA = ((bf16_t*)(m.ws + OFF_KA)); a.VAt = ((bf16_t*)(m.ws + OFF_VAt)); a.QW = ((bf16_t*)(m.ws + OFF_QW)); a.KW = ((bf16_t*)(m.ws + OFF_KW)); a.VWt = ((bf16_t*)(m.ws + OFF_VWt)); a.QG = ((bf16_t*)(m.ws + OFF_QG)); a.KG = ((bf16_t*)(m.ws + OFF_KG)); a.VGt = ((bf16_t*)(m.ws + OFF_VGt));
  a.g_qk_diff = m.g_qk_diff + l * 64; a.g_qk_win = m.g_qk_win + l * 128; a.g_qk_glob = m.g_qk_glob + l * 128; a.sink = m.sink_win + l * 4;
  a.lambda_diff = m.lambda_diff + l * 128; a.g_mix_out = m.g_mix_out + l * D; a.lambda_init = 0.8f - 0.6f * __expf(-0.3f * (float)l); a.pad0 = 0;
  a.A2 = ((bf16_t*)(m.ws + OFF_A2)); a.Oslab = ((float*)(m.ws + OFF_Oslab)); a.Lslab = ((float*)(m.ws + OFF_Lslab));
  const int nitems = 640 + (want_ctx ? 20 : 0);
  for (int rep = 0; rep < REP_DIFF; ++rep) for (int idx = BID; idx < 256; idx += NBLK) attn_dispatch(a, idx, want_ctx, smem);
  for (int rep = 0; rep < REP_GLOB; ++rep) for (int idx = 256 + BID; idx < 512; idx += NBLK) attn_dispatch(a, idx, want_ctx, smem);
  for (int rep = 0; rep < REP_HY; ++rep) for (int c = BID; c < 256; c += NBLK) {
    TabJob job = make_tabjob(m, l, TAB_SLOTS_FILTER, rep == 0 && c == BID);
    hyena_channel(c, m.hy_bias + l * 512, ((float*)(m.ws + OFF_uT)), ((float*)(m.ws + OFF_zT)), ((float*)(m.ws + OFF_yT)), (const uint2*)(m.ws + OFF_Hc), smem, job);
    if (want_ctx) hyena_ctx_channel(m_in, l, c, smem);
  }
  {
    TabJob job = make_tabjob(m, l, TAB_SLOTS_ALL, true);
    const int lane = TID & 63;
    while (job.slot * job.nw < 32768) { float4 tv[4]; const bool has = tab_issue(job, tv, lane); tab_finish(job, tv, has, lane); }
  }
  for (int idx = 512 + BID; idx < nitems; idx += NBLK) attn_dispatch(a, idx, want_ctx, smem);
}

DI void phase_fin(MKP m_in, int l, bool want_ctx, char* smem) {
  const MK m = launder_mk(m_in);
  const float* gmo = m.g_mix_out + l * D;
  const int lane = TID & 63, wid = TID >> 6;
  char* wl = smem + wid * 9216;
  for (int chunk = BID * 8 + wid; chunk < NB * 8 * (NT / 64); chunk += NBLK * 8) {
    const int pc = chunk % (NT / 64), hd = (chunk / (NT / 64)) % 8, b = chunk / ((NT / 64) * 8);
    const int pbase = pc * 64;
    if (pbase < CTX && !want_ctx) continue;
    const float* gm = gmo + 512 + hd * 64;
    bf16_t* dst0 = ((bf16_t*)(m.ws + OFF_A2)) + ((size_t)b * NT + pbase) * D + 512 + hd * 64;
    if (hd < 4) {
      const int c4 = lane & 15, rr = lane >> 4;
      const float4 g4 = *(const float4*)(gm + 4 * c4);
      const size_t i0b = (((size_t)0 * NB + b) * 4 + hd) * NT + pbase, i1b = (((size_t)1 * NB + b) * 4 + hd) * NT + pbase;
      const float* Os = (const float*)(m.ws + OFF_Oslab); const float* Ls = (const float*)(m.ws + OFF_Lslab);
#pragma unroll 4
      for (int ps = 0; ps < 16; ++ps) {
        const int row = ps * 4 + rr;
        const float4 x = *(const float4*)(Os + (i0b + row) * 64 + 4 * c4), y = *(const float4*)(Os + (i1b + row) * 64 + 4 * c4);
        const float inv = 1.f / (Ls[i0b + row] + Ls[i1b + row]);
        const float o0 = (x.x + y.x) * inv, o1 = (x.y + y.y) * inv, o2 = (x.z + y.z) * inv, o3 = (x.w + y.w) * inv;
        float ss = o0 * o0 + o1 * o1 + o2 * o2 + o3 * o3;
        ss += shxl(ss, lane, 8); ss += shxl(ss, lane, 4); ss += shxl(ss, lane, 2); ss += shxl(ss, lane, 1);
        const float rs = rsqrtf(ss * (1.f / 64) + EPS);
        *(uint2*)(dst0 + (size_t)row * D + 4 * c4) = make_uint2(pk2bf(o0 * rs * g4.x, o1 * rs * g4.y), pk2bf(o2 * rs * g4.z, o3 * rs * g4.w));
      }
    } else {
      const int g = hd - 4, p = pbase + lane;
      float o[64]; float ss = 0.f;
#pragma unroll
      for (int i = 0; i < 64; ++i) o[i] = ((const float*)(m.ws + OFF_yT))[((size_t)b * 256 + g * 64 + i) * NT + p];
#pragma unroll
      for (int i = 0; i < 64; ++i) ss += o[i] * o[i];
      const float rs = rsqrtf(ss * (1.f / 64) + EPS);
#pragma unroll
      for (int i = 0; i < 8; ++i)
        *(uint4*)(wl + lane * 144 + i * 16) = make_uint4(pk2bf(o[8 * i] * rs * gm[8 * i], o[8 * i + 1] * rs * gm[8 * i + 1]), pk2bf(o[8 * i + 2] * rs * gm[8 * i + 2], o[8 * i + 3] * rs * gm[8 * i + 3]),
                                                         pk2bf(o[8 * i + 4] * rs * gm[8 * i + 4], o[8 * i + 5] * rs * gm[8 * i + 5]), pk2bf(o[8 * i + 6] * rs * gm[8 * i + 6], o[8 * i + 7] * rs * gm[8 * i + 7]));
      asm volatile("s_waitcnt lgkmcnt(0)" ::: "memory");
#pragma unroll
      for (int k = 0; k < 8; ++k) {
        const int row = k * 8 + (lane >> 3), ch = lane & 7;
        *(uint4*)(dst0 + (size_t)row * D + ch * 8) = *(const uint4*)(wl + row * 144 + ch * 16);
      }
      asm volatile("s_waitcnt lgkmcnt(0)" ::: "memory");
    }
  }
}

#ifndef PEER_SLICED
#define PEER_SLICED 1
#endif
#if !PEER_SLICED
DI void phase_peer(MKP m_in, int l, bool want_ctx, bool last, char* smem) {
  const MK m = launder_mk(m_in);
  const int lane = TID & 63, wid = TID >> 6;
  char* wbase = smem + wid * 10240;
  int* ex_l = (int*)wbase; float* g_l = (float*)(wbase + 4608); float* wd = (float*)(wbase + 9216);
  const float* modv_l = ((float*)(m.ws + OFF_modv)) + (size_t)l * 3 * NMOD;
  const int gw0 = BID * 8 + wid, nw0 = NBLK * 8;
  for (int i0 = 0; gw0 + nw0 * i0 < R && i0 < 9; i0 += 8) {
    const int slot = i0 + (lane >> 3);
    const int r = gw0 + nw0 * slot;
    if (slot < 9 && r < R && !((r % NT) < CTX && !want_ctx))
      merge_one(((unsigned*)(m.ws + OFF_topv)), r, lane & 7, ex_l + slot * 128, g_l + slot * 128);
  }
  int slot = 0;
  for (int r = gw0; r < R; r += nw0, ++slot) {
    if ((r % NT) < CTX && !want_ctx) continue;
    if (slot >= 9) {
      if (lane < 8) merge_one(((unsigned*)(m.ws + OFF_topv)), r, lane, ex_l + 8 * 128, g_l + 8 * 128);
    }
    const int sl = slot < 9 ? slot : 8;
    peer_token<PEER_SLICED>(r, ((bf16_t*)(m.ws + OFF_hbuf)), ex_l + sl * 128, g_l + sl * 128, ((unsigned char*)(m.ws + OFF_u8)) + (size_t)l * 16384 * D, ((float*)(m.ws + OFF_us)) + l * 16384, ((unsigned char*)(m.ws + OFF_v8)) + (size_t)l * 16384 * D, ((float*)(m.ws + OFF_vs)) + l * 16384,
               modv_l, ((float*)(m.ws + OFF_xs)), wd, last ? m.out : nullptr, ((int*)(m.ws + OFF_experts)), ((float*)(m.ws + OFF_gates)));
  }
}
#endif
DI void peer_v_rows(const MK& m, int l, bool want_ctx, bool last, int vslice_, int w0, int wstride) {
  const int lane = TID & 63, g = lane >> 3, j = lane & 7;
  const int vslice = __builtin_amdgcn_readfirstlane(vslice_);
  const unsigned char* v8u = ((const unsigned char*)(m.ws + OFF_v8)) + (size_t)l * 16384 * D + (size_t)vslice * TSLICE;
  const unsigned j16 = (unsigned)j * 16u;
  const unsigned* wts = (const unsigned*)(m.ws + OFF_gates);
  const float* modv_l = ((const float*)(m.ws + OFF_modv)) + (size_t)l * 3 * NMOD;
  float* xs = (float*)(m.ws + OFF_xs);
#pragma unroll 1
  for (int r = w0; r < R; r += wstride) {
    const int b = r / NT, p = r % NT;
    if (p < CTX && !want_ctx) continue;
    unsigned pkv[16];
    {
      const uint4* ep = (const uint4*)(wts + (size_t)r * 128 + 16 * g);
#pragma unroll
      for (int q = 0; q < 4; ++q) { const uint4 e4 = ep[q]; pkv[4 * q] = e4.x; pkv[4 * q + 1] = e4.y; pkv[4 * q + 2] = e4.z; pkv[4 * q + 3] = e4.w; }
    }
    const float invS = ((const float*)(m.ws + OFF_wsc))[r];
    const int col = 256 * (g >> 1) + 32 * vslice + 4 * j + 2 * (g & 1);
    const int mrow = p < CTX ? 2 : b;
    const float2 gg = *(const float2*)(modv_l + mrow * NMOD + 5 * D + col);
    float2 xv = *(const float2*)(xs + (size_t)r * D + col);
    uint4 rw[16];
#pragma unroll
    for (int q = 0; q < 16; ++q) {
      unsigned off;
      asm("v_mad_u32_u16 %0, %1, %2, %3" : "=v"(off) : "v"(pkv[q]), "s"(128u), "v"(j16));
      rw[q] = *(const uint4*)(v8u + off);
    }
    h2_t hacc[8];
#pragma unroll
    for (int i = 0; i < 8; ++i) hacc[i] = (h2_t){(_Float16)0.f, (_Float16)0.f};
#pragma unroll
    for (int q = 0; q < 16; ++q) {
      const h2_t pk2 = __builtin_bit_cast(h2_t, pkv[q]);
      const h2_t w2 = __builtin_shufflevector(pk2, pk2, 1, 1);
      const int r4[4] = {(int)rw[q].x, (int)rw[q].y, (int)rw[q].z, (int)rw[q].w};
#pragma unroll
      for (int c = 0; c < 4; ++c) {
        hacc[2 * c] = __builtin_elementwise_fma(__builtin_bit_cast(h2_t, __builtin_amdgcn_cvt_scalef32_pk_f16_fp8(r4[c], 1.0f, false)), w2, hacc[2 * c]);
        hacc[2 * c + 1] = __builtin_elementwise_fma(__builtin_bit_cast(h2_t, __builtin_amdgcn_cvt_scalef32_pk_f16_fp8(r4[c], 1.0f, true)), w2, hacc[2 * c + 1]);
      }
    }
    h2_t b4[4], c2[2], d1;
    {
      const bool g2 = lane & 32, g1 = lane & 16, g0 = lane & 8;
#pragma unroll
      for (int i = 0; i < 4; ++i) {
        const int send = __builtin_bit_cast(int, g2 ? hacc[i] : hacc[4 + i]); const h2_t keep = g2 ? hacc[4 + i] : hacc[i];
        b4[i] = keep + __builtin_bit_cast(h2_t, shxl(send, lane, 32));
      }
#pragma unroll
      for (int i = 0; i < 2; ++i) {
        const int send = __builtin_bit_cast(int, g1 ? b4[i] : b4[2 + i]); const h2_t keep = g1 ? b4[2 + i] : b4[i];
        c2[i] = keep + __builtin_bit_cast(h2_t, shxl(send, lane, 16));
      }
      {
        const int send = __builtin_bit_cast(int, g0 ? c2[0] : c2[1]); const h2_t keep = g0 ? c2[1] : c2[0];
        d1 = keep + __builtin_bit_cast(h2_t, shxl(send, lane, 8));
      }
    }
    {
      xv.x += gg.x * ((float)d1[0] * invS); xv.y += gg.y * ((float)d1[1] * invS);
      float* op = last ? m.out + ((size_t)b * SEQ + (p - CTX)) * D + col : xs + (size_t)r * D + col;
      *(float2*)op = xv;
    }
  }
}
DI void phase_peer_merge(MKP m_in, bool want_ctx, char* smem) {
  const MK m = launder_mk(m_in);
  const int lane = TID & 63, wid = TID >> 6;
  char* wbase = smem + wid * 8192;
  int* ex_l = (int*)wbase; float* g_l = (float*)(wbase + 4096);
  int* experts = (int*)(m.ws + OFF_experts); float* gates = (float*)(m.ws + OFF_gates);
  for (int grp = BID * 8 + wid; grp < R / 8; grp += NBLK * 8) {
    const int r = grp * 8 + (lane >> 3);
    const bool skip = ((r % NT) < CTX) && !want_ctx;
    if (skip) continue;
    merge_one(((unsigned*)(m.ws + OFF_topv)), r, lane & 7, ex_l + (lane >> 3) * 128, g_l + (lane >> 3) * 128);
    asm volatile("s_waitcnt lgkmcnt(0)" ::: "memory");
#pragma unroll
    for (int q = 0; q < 4; ++q) {
      const int idx = (q * 64 + lane) * 4;
      *(uint4*)(experts + (size_t)grp * 1024 + idx) = *(const uint4*)(ex_l + idx);
      *(float4*)(gates + (size_t)grp * 1024 + idx) = *(const float4*)(g_l + idx);
    }
    asm volatile("s_waitcnt lgkmcnt(0)" ::: "memory");
  }
}
DI void peer_u_rows(const MK& m, int l, bool want_ctx, int vslice_, int w0, int wstride) {
  const int lane = TID & 63, g = lane >> 3, j = lane & 7;
  const int vslice = __builtin_amdgcn_readfirstlane(vslice_);
  const unsigned char* u8 = ((const unsigned char*)(m.ws + OFF_u8)) + (size_t)l * 16384 * D + (size_t)vslice * TSLICE;
  const unsigned char* xq = (const unsigned char*)(m.ws + OFF_xq);
  const unsigned loff = (unsigned)(vslice * 128 + j * 16);
  const unsigned j16 = (unsigned)j * 16u;
  const int* experts = (const int*)(m.ws + OFF_experts);
  int* PD = ((int*)(m.ws + OFF_P)) + (size_t)vslice * R * 128;
#pragma unroll 1
  for (int r = w0; r < R; r += wstride) {
    if (((r % NT) < CTX) && !want_ctx) continue;
    uint4 rw[16];
    {
      const uint4* ep = (const uint4*)((const unsigned short*)experts + (size_t)r * 128 + 16 * g);
      const uint4 ea = ep[0], eb = ep[1];
      const unsigned ew[8] = {ea.x, ea.y, ea.z, ea.w, eb.x, eb.y, eb.z, eb.w};
#pragma unroll
      for (int q = 0; q < 8; ++q) {
        unsigned o0, o1;
        asm("v_mad_u32_u16 %0, %1, %2, %3" : "=v"(o0) : "v"(ew[q]), "s"(128u), "v"(j16));
        asm("v_mad_u32_u16 %0, %1, %2, %3 op_sel:[1,0,0,0]" : "=v"(o1) : "v"(ew[q]), "s"(128u), "v"(j16));
        rw[2 * q] = *(const uint4*)(u8 + o0);
        rw[2 * q + 1] = *(const uint4*)(u8 + o1);
      }
    }
    const uint4 xv = *(const uint4*)(xq + (size_t)r * D + loff);
    int pd[16];
#pragma unroll
    for (int q = 0; q < 16; ++q) {
      int a = __builtin_amdgcn_sdot4((int)rw[q].x, (int)xv.x, 0, false);
      a = __builtin_amdgcn_sdot4((int)rw[q].y, (int)xv.y, a, false);
      a = __builtin_amdgcn_sdot4((int)rw[q].z, (int)xv.z, a, false);
      pd[q] = __builtin_amdgcn_sdot4((int)rw[q].w, (int)xv.w, a, false);
    }
    int b8[8], c4[4], d2[2];
    {
      const bool j2 = lane & 4, j1 = lane & 2, j0 = lane & 1;
#pragma unroll
      for (int i = 0; i < 8; ++i) { const int send = j2 ? pd[i] : pd[8 + i], keep = j2 ? pd[8 + i] : pd[i]; b8[i] = keep + shxl(send, lane, 4); }
#pragma unroll
      for (int i = 0; i < 4; ++i) { const int send = j1 ? b8[i] : b8[4 + i], keep = j1 ? b8[4 + i] : b8[i]; c4[i] = keep + shxl(send, lane, 2); }
#pragma unroll
      for (int i = 0; i < 2; ++i) { const int send = j0 ? c4[i] : c4[2 + i], keep = j0 ? c4[2 + i] : c4[i]; d2[i] = keep + shxl(send, lane, 1); }
    }
    *(int2*)(PD + (size_t)r * 128 + 16 * g + 2 * j) = make_int2(d2[0], d2[1]);
  }
}
DI void phase_peer_u(MKP m_in, int l, bool want_ctx, char* smem) {
  const MK m = launder_mk(m_in);
  unsigned* bar = (unsigned*)(m.ws + OFF_bar);
  volatile LAS unsigned* st = (volatile LAS unsigned*)(smem + SMEM_BYTES);
  if (threadIdx.x == 0) {
    unsigned ok = 1u, mine = 0u; const unsigned x = st[3];
    for (unsigned q = 0; q < 16; ++q) { const unsigned c = xb_ld(&bar[XB_XCNT(q)]); if ((q < 8) != (c > 0u)) ok = 0u; if (q == x) mine = c; }
    st[4] = ok ? mine : 0u;
  }
  __syncthreads();
  const unsigned nloc = st[4];
  const int wid = TID >> 6;
  if (nloc != 0u) peer_u_rows(m, l, want_ctx, (int)(st[3] & 7u), (int)st[2] * 8 + wid, (int)nloc * 8);
  else for (int v = 0; v < 8; ++v) peer_u_rows(m, l, want_ctx, v, BID * 8 + wid, NBLK * 8);
}
DI void phase_peer_reduce(MKP m_in, int l, bool want_ctx) {
  const MK m = launder_mk(m_in);
  const int* experts = (const int*)(m.ws + OFF_experts);
  float* gates = (float*)(m.ws + OFF_gates);
  const int* PD = (const int*)(m.ws + OFF_P);
  const float* us = ((const float*)(m.ws + OFF_us)) + l * 16384;
  const float* vs = ((const float*)(m.ws + OFF_vs)) + l * 16384;
  const float* xqs = (const float*)(m.ws + OFF_xqs);
  for (int i4 = BID * NTHR + TID; i4 < R * 32; i4 += NBLK * NTHR) {
    const int r = i4 >> 5;
    if (((r % NT) < CTX) && !want_ctx) continue;
    int4 acc = make_int4(0, 0, 0, 0);
#pragma unroll
    for (int v = 0; v < 8; ++v) { const int4 p = ((const int4*)(PD + (size_t)v * R * 128))[i4]; acc.x += p.x; acc.y += p.y; acc.z += p.z; acc.w += p.w; }
    const uint2 e2 = ((const uint2*)experts)[i4];
    const int4 e4 = make_int4((int)(e2.x & 0xffffu), (int)(e2.x >> 16), (int)(e2.y & 0xffffu), (int)(e2.y >> 16));
    float4 g4 = ((const float4*)gates)[i4];
    const float xs_ = xqs[r];
    const int ee[4] = {e4.x, e4.y, e4.z, e4.w}; const int aa[4] = {acc.x, acc.y, acc.z, acc.w}; float gg[4] = {g4.x, g4.y, g4.z, g4.w};
#pragma unroll
    for (int q = 0; q < 4; ++q) {
      const float d = (float)aa[q] * (us[ee[q]] * xs_);
      const float t = 0.5f * d * (1.f + tanhf(0.7978845608028654f * (d + 0.044715f * d * d * d)));
      gg[q] = gg[q] * t * vs[ee[q]];
    }
    const int lane = TID & 63;
    float mxw = fmaxf(fmaxf(fabsf(gg[0]), fabsf(gg[1])), fmaxf(fabsf(gg[2]), fabsf(gg[3])));
    mxw = fmaxf(mxw, shxl(mxw, lane, 1)); mxw = fmaxf(mxw, shxl(mxw, lane, 2)); mxw = fmaxf(mxw, shxl(mxw, lane, 4));
    mxw = fmaxf(mxw, shxl(mxw, lane, 8)); mxw = fmaxf(mxw, shxl(mxw, lane, 16));
    const unsigned eb = (__float_as_uint(mxw) >> 23) & 255u;
    const float Sw = __uint_as_float((252u - eb) << 23);
    unsigned pk[4];
#pragma unroll
    for (int q = 0; q < 4; ++q) {
      const _Float16 wh = (_Float16)(gg[q] * Sw);
      pk[q] = (unsigned)ee[q] | ((unsigned)__builtin_bit_cast(unsigned short, wh) << 16);
    }
    ((uint4*)gates)[i4] = make_uint4(pk[0], pk[1], pk[2], pk[3]);
    if ((i4 & 31) == 0) ((float*)(m.ws + OFF_wsc))[r] = __uint_as_float(eb == 0u ? 0u : ((eb + 2u) << 23));
  }
}
DI void phase_peer_v(MKP m_in, int l, bool want_ctx, bool last, char* smem) {
  const MK m = launder_mk(m_in);
  unsigned* bar = (unsigned*)(m.ws + OFF_bar);
  volatile LAS unsigned* st = (volatile LAS unsigned*)(smem + SMEM_BYTES);
  if (threadIdx.x == 0) {
    unsigned ok = 1u, mine = 0u; const unsigned x = st[3];
    for (unsigned q = 0; q < 16; ++q) { const unsigned c = xb_ld(&bar[XB_XCNT(q)]); if ((q < 8) != (c > 0u)) ok = 0u; if (q == x) mine = c; }
    st[1 + 3 + 0] = ok ? mine : 0u;
  }
  __syncthreads();
  const unsigned nloc = st[4];
  const int wid = TID >> 6;
  if (nloc != 0u) {
    peer_v_rows(m, l, want_ctx, last, (int)(st[3] & 7u), (int)st[2] * 8 + wid, (int)nloc * 8);
  } else {
    for (int v = 0; v < 8; ++v) peer_v_rows(m, l, want_ctx, last, v, BID * 8 + wid, NBLK * 8);
  }
}

DI void phase_scores(MKP m_in, int l, bool last, char* smem) {
  const MK m = launder_mk(m_in);
  const int nrt = last ? 128 : 132;
  for (int t = BID; t < nrt * 8; t += NBLK)
    score_head_item(((bf16_t*)(m.ws + OFF_P)), ((bf16_t*)(m.ws + OFF_keysb)) + (size_t)l * 16 * 128 * 128, rowtile_of(t >> 3, last) * 128, t & 7, smem,
                    ((int*)(m.ws + OFF_experts)), ((float*)(m.ws + OFF_gates)));
}
DI void phase_gemm1(MKP m_in, int l, char* smem) {
  const MK m = launder_mk(m_in);
  pg8::Gemm g; g.A = (bf16_t*)(m.ws + OFF_hbuf); g.Bt = (bf16_t*)(m.ws + OFF_Wt_in) + (size_t)l * DIN * D; g.M = R; g.N = DIN; g.K = D;
  MySched S; S.init(DIN, false, NBLK, BID);
  EpiStoreBf16 E; E.Cb = (bf16_t*)(m.ws + OFF_P); E.ldc = DIN;
  __syncthreads();
  pg8::gemm_phase<EpiStoreBf16, MySched, false>((PG8_LAS unsigned char*)smem, g, S, E, nullptr);
  __syncthreads();
}
DI int ctx_rowtile(int i) { return (i >> 1) * 66 + (i & 1); }
DI void phase_gemm2(MKP m_in, int l, bool last, char* smem) {
  const MK m = launder_mk(m_in);
  pg8::Gemm g; g.A = (bf16_t*)(m.ws + OFF_A2); g.Bt = (bf16_t*)(m.ws + OFF_Wt_out) + (size_t)l * D * D; g.M = R; g.N = D; g.K = D;
  MySched S; S.init(D, true, NBLK, BID);
  EpiResidual E; E.xs = (float*)(m.ws + OFF_xs); E.gate_base = (float*)(m.ws + OFF_modv) + (size_t)l * 3 * NMOD + 2 * D;
  E.xin = l == 0 ? m.x : nullptr; E.ctxin = l == 0 ? m.ctx : nullptr;
  __syncthreads();
  pg8::gemm_phase<EpiResidual, MySched, false>((PG8_LAS unsigned char*)smem, g, S, E, nullptr);
  __syncthreads();
  if (!last) {
    const int nb = NBLK;
    for (int t = (BID + nb - 32) % nb; t < 4 * 8; t += nb)
      gemm_tile<1>(g.A, g.Bt, D, ctx_rowtile(t >> 3) * 128, (t & 7) * 128, smem, nullptr, E.xs, E.gate_base, E.xin, E.ctxin);
  }
}
DI void phase_gemm3(MKP m_in, int l, bool last, char* smem) {
  const MK m = launder_mk(m_in);
  pg8::Gemm g; g.A = (bf16_t*)(m.ws + OFF_hbuf); g.Bt = (bf16_t*)(m.ws + OFF_Wt_q) + (size_t)l * 2048 * D; g.M = R; g.N = 2048; g.K = D;
  MySched S; S.init(2048, true, NBLK, BID);
  EpiStoreBf16 E; E.Cb = (bf16_t*)(m.ws + OFF_P); E.ldc = 2048;
  __syncthreads();
  pg8::gemm_phase<EpiStoreBf16, MySched, false>((PG8_LAS unsigned char*)smem, g, S, E, nullptr);
  __syncthreads();
  if (!last) {
    const int nb = NBLK;
    for (int t = (BID + nb - 64) % nb; t < 4 * 16; t += nb)
      gemm_tile<0>(g.A, g.Bt, 2048, ctx_rowtile(t >> 4) * 128, (t & 15) * 128, smem, E.Cb, nullptr, nullptr);
  }
}
#define GSYNC() xcd_barrier((unsigned*)(launder_mk(m).ws + OFF_bar), (volatile LAS unsigned*)(smem + SMEM_BYTES))
DI void phase_filters(MKP m_in, int l, char* smem) {
  const MK m = launder_mk(m_in);
  for (int c = BID; c < 256; c += NBLK) {
    TabJob job = make_tabjob(m, l, 0, c == BID);
    hyena_filter_task(c, ((const bf16_t*)(m.ws + OFF_hdnB)) + (size_t)l * SEQ * 64, ((const bf16_t*)(m.ws + OFF_W3t)) + (size_t)l * 1024 * 64, m.hy_b3 + l * 1024, (uint2*)(m.ws + OFF_Hc), smem, job);
  }
}
template <int L>
DI void layer_body(MKP m, char* smem) {
  constexpr bool want_ctx = L == 0, last = L == 1;
  for (int rep = 0; rep < REP_NORM1; ++rep) { phase_norm(m, L, 0, L == 0, false); GSYNC(); }
  for (int rep = 0; rep < REP_GEMM1; ++rep) { phase_gemm1(m, L, smem); GSYNC(); }
  for (int rep = 0; rep < REP_PREP; ++rep) for (int t = BID; t < R / 32; t += NBLK) prep_tile(m, L, t, smem);
  for (int rep = 0; rep < REP_FILT; ++rep) phase_filters(m, L, smem);
  GSYNC();
  for (int rep = 0; rep < REP_MIX; ++rep) { phase_mix(m, L, want_ctx, smem); GSYNC(); }
  for (int rep = 0; rep < REP_FIN; ++rep) { phase_fin(m, L, want_ctx, smem); GSYNC(); }
  phase_gemm2(m, L, last, smem);
  GSYNC();
  for (int rep = 0; rep < REP_NORM2; ++rep) { phase_norm(m, L, 1, false, last); GSYNC(); }
  for (int rep = 0; rep < REP_GEMM3; ++rep) { phase_gemm3(m, L, last, smem); GSYNC(); }
  for (int rep = 0; rep < REP_SCORES; ++rep) { phase_scores(m, L, last, smem); GSYNC(); }
  for (int rep = 0; rep < (last ? REP_PEER_LAST : 1); ++rep) {
#if PEER_SLICED
    for (int ru = 0; ru < (last ? REP_PEER_U : 1); ++ru) phase_peer_u(m, L, want_ctx, smem);
    GSYNC();
    phase_peer_reduce(m, L, want_ctx);
    GSYNC();
    for (int rv = 0; rv < (last ? REP_PEER_V : 1); ++rv) phase_peer_v(m, L, want_ctx, last, smem);
#else
    phase_peer(m, L, want_ctx, last, smem);
#endif
    if (!last || rep + 1 < REP_PEER_LAST) GSYNC();
  }
}
__global__ __launch_bounds__(NTHR) void k_mega(MK m_unused) {
  extern __shared__ __attribute__((aligned(16))) char smem[];
  (void)m_unused;
  MKP m = (MKP)__builtin_amdgcn_kernarg_segment_ptr();
  {
    volatile LAS unsigned* st = (volatile LAS unsigned*)(smem + SMEM_BYTES);
    if (threadIdx.x == 0) { st[0] = 0u; st[1] = 0u; st[2] = 0u; st[3] = 0u; st[4] = 0u; st[5] = 0u; }
    __syncthreads();
    xcd_barrier_post((unsigned*)(launder_mk(m).ws + OFF_bar), st);
  }
  for (int rep = 0; rep < REP_P0; ++rep) { phase0(m, smem); GSYNC(); }
  layer_body<0>(m, smem);
  layer_body<1>(m, smem);
}

extern "C" void kernel_launch(void* const* d_in, const int* in_sizes, int n_in, void* d_out, int out_size, void* d_ws, size_t ws_size,
                              hipStream_t stream) {
  (void)in_sizes; (void)n_in; (void)out_size;
  MK m;
  memset(&m, 0, sizeof(m));
  const float** ip = (const float**)&m.x;
  for (int i = 0; i < 30; ++i) ip[i] = (const float*)d_in[i];
  m.out = (float*)d_out;
  m.ws = (char*)d_ws;
  if (WS_TOTAL > ws_size) return;

  static int grid_blocks = 0;
  if (!grid_blocks) {
    (void)hipFuncSetAttribute((const void*)k_mega, hipFuncAttributeMaxDynamicSharedMemorySize, SMEM_BYTES + 32);
    int dev = 0, cus = 0, per_cu = 0;
    (void)hipGetDevice(&dev);
    (void)hipDeviceGetAttribute(&cus, hipDeviceAttributeMultiprocessorCount, dev);
    (void)hipOccupancyMaxActiveBlocksPerMultiprocessor(&per_cu, k_mega, NTHR, SMEM_BYTES + 32);
    if (per_cu > 1) per_cu = 1;
    grid_blocks = cus * per_cu;
  }
  (void)hipMemsetAsync(m.ws + OFF_bar, 0, (size_t)XCD_BAR_WORDS * 4, stream);
  void* args[] = {&m};
  (void)hipLaunchCooperativeKernel((void*)k_mega, dim3(grid_blocks), dim3(NTHR), args, SMEM_BYTES + 32, stream);
}
```

```cpp
#include <hip/hip_runtime.h>
#ifndef REP_DIFF
#define REP_DIFF 1
#endif
#ifndef REP_GLOB
#define REP_GLOB 1
#endif
#ifndef REP_HY
#define REP_HY 1
#endif
#ifndef REP_FILT
#define REP_FILT 1
#endif
#ifndef REP_PEER_U
#define REP_PEER_U 1
#endif
#ifndef REP_PEER_V
#define REP_PEER_V 1
#endif
#ifndef REP_NORM1
#define REP_NORM1 1
#endif
#ifndef REP_GEMM1
#define REP_GEMM1 1
#endif
#ifndef REP_PREP
#define REP_PREP 1
#endif
#ifndef REP_MIX
#define REP_MIX 1
#endif
#ifndef REP_FIN
#define REP_FIN 1
#endif
#ifndef REP_NORM2
#define REP_NORM2 1
#endif
#ifndef REP_GEMM3
#define REP_GEMM3 1
#endif
#ifndef REP_SCORES
#define REP_SCORES 1
#endif
#ifndef REP_MERGE
#define REP_MERGE 1
#endif
#ifndef REP_PEER_LAST
#define REP_PEER_LAST 1
#endif
#ifndef REP_P0
#define REP_P0 1
#endif
#include <hip/hip_cooperative_groups.h>
namespace cg = cooperative_groups;
#include <stdint.h>
#include <string.h>

#define DI __device__ __forceinline__
#define LAS __attribute__((address_space(3)))
typedef unsigned short bf16_t;

constexpr int D = 1024;
constexpr int NB = 2;
constexpr int SEQ = 8192;
constexpr int CTX = 256;
constexpr int NT = SEQ + CTX;
constexpr int R = NB * NT;
constexpr int DIN = 2560;
constexpr int NMOD = 6 * D;
constexpr float EPS = 1e-6f;
constexpr float LOG2E = 1.4426950408889634f;

DI int opq_v(int x) { asm volatile("" : "+v"(x)); return x; }
DI int opq_s(int x) { asm volatile("" : "+s"(x)); return x; }
template <class T> DI T* opq_p(T* p) { asm volatile("" : "+s"(p)); return p; }
#define TID opq_v((int)threadIdx.x)
#define BID opq_s((int)blockIdx.x)
#define NBLK opq_s((int)gridDim.x)
DI float shxl(float v, int lane, int mask) { return __builtin_bit_cast(float, __builtin_amdgcn_ds_bpermute((lane ^ mask) << 2, __builtin_bit_cast(int, v))); }
DI int shxl(int v, int lane, int mask) { return __builtin_amdgcn_ds_bpermute((lane ^ mask) << 2, v); }
DI float shx(float v, int mask) { return shxl(v, opq_v((int)threadIdx.x) & 63, mask); }
DI bf16_t f2bf(float x) { unsigned u = __float_as_uint(x); u += 0x7fffu + ((u >> 16) & 1u); return (bf16_t)(u >> 16); }
DI float bf2f(bf16_t h) { return __uint_as_float(((unsigned)h) << 16); }
DI float bflo(unsigned w) { return __uint_as_float(w << 16); }
DI float bfhi(unsigned w) { return __uint_as_float(w & 0xffff0000u); }

DI float block_sum_256(float v, float* red) {
  for (int o = 32; o > 0; o >>= 1) v += shx(v, o);
  int w = TID >> 6;
  __syncthreads();
  if ((TID & 63) == 0) red[w] = v;
  __syncthreads();
  float s = red[0] + red[1] + red[2] + red[3];
  return s;
}

DI int perm16(int o) { return (o & 3) | ((o & 4) << 1) | ((o & 8) >> 1); }

typedef __attribute__((ext_vector_type(8))) short bf16x8;
typedef __attribute__((ext_vector_type(16))) float f32x16;
typedef __attribute__((ext_vector_type(2))) __bf16 bf16x2_t;
typedef __attribute__((ext_vector_type(2))) float f32x2_t;
#define MFMA32(a, b, c) __builtin_amdgcn_mfma_f32_32x32x16_bf16((a), (b), (c), 0, 0, 0)
DI unsigned pk2bf(float a, float b) { f32x2_t v = {a, b}; return __builtin_bit_cast(unsigned, __builtin_convertvector(v, bf16x2_t)); }
constexpr int NTHR = 512;

DI void wconv_tile(const float* __restrict__ W, bf16_t* __restrict__ Wt, int N, int tile, float* sm  ) {
  int tn = tile % (N / 64), tk = tile / (N / 64);
  int tid = TID;
  __syncthreads();
  for (int i = tid; i < 64 * 16; i += NTHR) {
    int kr = i >> 4, c4 = (i & 15) * 4;
    float4 v = *(const float4*)(W + (size_t)(tk * 64 + kr) * N + tn * 64 + c4);
    sm[kr * 65 + c4] = v.x; sm[kr * 65 + c4 + 1] = v.y; sm[kr * 65 + c4 + 2] = v.z; sm[kr * 65 + c4 + 3] = v.w;
  }
  __syncthreads();
  for (int i = tid; i < 64 * 8; i += NTHR) {
    int n = i >> 3, k8 = (i & 7) * 8;
    unsigned w[4];
    for (int j = 0; j < 4; ++j) w[j] = pk2bf(sm[(k8 + 2 * j) * 65 + n], sm[(k8 + 2 * j + 1) * 65 + n]);
    *(uint4*)(Wt + (size_t)(tn * 64 + n) * D + tk * 64 + k8) = make_uint4(w[0], w[1], w[2], w[3]);
  }
}

template <int EPI, int K = D>
DI void gemm_tile(const bf16_t* __restrict__ A, const bf16_t* __restrict__ Wt, int N, int m0, int n0, char* smem, bf16_t* __restrict__ Cb,
                  float* __restrict__ xs, const float* __restrict__ gate_base, const float* __restrict__ xin = nullptr, const float* __restrict__ ctxin = nullptr) {
  const int tid = TID, lane = tid & 63, wid = tid >> 6;
  const int wm = wid & 1, wn = wid >> 1;
  const int r = lane & 31, h = lane >> 5;
  f32x16 acc0, acc1;
  for (int i = 0; i < 16; ++i) { acc0[i] = 0.f; acc1[i] = 0.f; }
  const int lrow = tid >> 3, lch = tid & 7;
  const bf16_t* Ag = A + (size_t)(m0 + lrow) * K + lch * 8;
  const bf16_t* Bg = Wt + (size_t)(n0 + lrow) * K + lch * 8;
  const int woff = lrow * 128 + ((lch ^ ((lrow >> 1) & 7)) << 4);
  uint4 ra0, ra1, rb0, rb1;
  ra0 = *(const uint4*)(Ag); ra1 = *(const uint4*)(Ag + (size_t)64 * K);
  rb0 = *(const uint4*)(Bg); rb1 = *(const uint4*)(Bg + (size_t)64 * K);
  __syncthreads();
  *(uint4*)(smem + woff) = ra0; *(uint4*)(smem + woff + 8192) = ra1;
  *(uint4*)(smem + 16384 + woff) = rb0; *(uint4*)(smem + 16384 + woff + 8192) = rb1;
  __syncthreads();
  const int sw = (r >> 1) & 7;
  const int aoff0 = (wm * 64 + r) * 128, aoff1 = aoff0 + 32 * 128;
  const int boff = 16384 + (wn * 32 + r) * 128;
#pragma unroll 1
  for (int kt = 0; kt < K / 64; ++kt) {
    const char* st = smem + (kt & 1) * 32768;
    if (kt + 1 < K / 64) {
      ra0 = *(const uint4*)(Ag + (kt + 1) * 64); ra1 = *(const uint4*)(Ag + (size_t)64 * K + (kt + 1) * 64);
      rb0 = *(const uint4*)(Bg + (kt + 1) * 64); rb1 = *(const uint4*)(Bg + (size_t)64 * K + (kt + 1) * 64);
    }
#pragma unroll
    for (int s = 0; s < 4; ++s) {
      int co = ((2 * s + h) ^ sw) << 4;
      bf16x8 a0 = *(const bf16x8*)(st + aoff0 + co);
      bf16x8 a1 = *(const bf16x8*)(st + aoff1 + co);
      bf16x8 b = *(const bf16x8*)(st + boff + co);
      acc0 = MFMA32(a0, b, acc0);
      acc1 = MFMA32(a1, b, acc1);
    }
    if (kt + 1 < K / 64) {
      char* sn = smem + ((kt + 1) & 1) * 32768;
      *(uint4*)(sn + woff) = ra0; *(uint4*)(sn + woff + 8192) = ra1;
      *(uint4*)(sn + 16384 + woff) = rb0; *(uint4*)(sn + 16384 + woff + 8192) = rb1;
    }
    __syncthreads();
  }
  float* Cs = (float*)smem;
  constexpr int CS = 132;
#pragma unroll
  for (int i = 0; i < 16; ++i) {
    int row = (i & 3) + 8 * (i >> 2) + 4 * h;
    Cs[(wm * 64 + row) * CS + wn * 32 + r] = acc0[i];
    Cs[(wm * 64 + 32 + row) * CS + wn * 32 + r] = acc1[i];
  }
  __syncthreads();
  if (EPI == 0) {
    for (int i = tid; i < 128 * 16; i += NTHR) {
      int row = i >> 4, c8 = (i & 15) * 8;
      const float* cr = Cs + row * CS + c8;
      float4 v0 = *(const float4*)cr, v1 = *(const float4*)(cr + 4);
      *(uint4*)(Cb + (size_t)(m0 + row) * N + n0 + c8) = make_uint4(pk2bf(v0.x, v0.y), pk2bf(v0.z, v0.w), pk2bf(v1.x, v1.y), pk2bf(v1.z, v1.w));
    }
  } else if (EPI == 2) {
    for (int i = tid; i < 128 * 32; i += NTHR) {
      const int col = i >> 5, r4 = (i & 31) * 4;
      const float4 v = make_float4(Cs[r4 * CS + col], Cs[(r4 + 1) * CS + col], Cs[(r4 + 2) * CS + col], Cs[(r4 + 3) * CS + col]);
      *(float4*)(xs + (size_t)(n0 + col) * N + m0 + r4) = v;
    }
  } else {
    for (int i = tid; i < 128 * 32; i += NTHR) {
      int row = i >> 5, c4 = (i & 31) * 4;
      int rr = m0 + row; int b = rr / NT, p = rr % NT; int mrow = p < CTX ? 2 : b;
      const float* gt = gate_base + mrow * NMOD + n0 + c4;
      float4 v = *(const float4*)(Cs + row * CS + c4);
      const float* rsrc = xin ? (p < CTX ? ctxin + ((size_t)b * CTX + p) * D : xin + ((size_t)b * SEQ + (p - CTX)) * D) : xs + (size_t)rr * D;
      float4 xv = *(const float4*)(rsrc + n0 + c4);
      xv.x += gt[0] * v.x; xv.y += gt[1] * v.y; xv.z += gt[2] * v.z; xv.w += gt[3] * v.w;
      *(float4*)(xs + (size_t)rr * D + n0 + c4) = xv;
    }
  }
}


struct AttnArgs {
  const bf16_t *QA, *KA, *VAt, *QW, *KW, *VWt, *QG, *KG, *VGt;
  const float *g_qk_diff, *g_qk_win, *g_qk_glob, *sink, *lambda_diff, *g_mix_out;
  float lambda_init;
  int pad0;
  bf16_t* A2;
  float* Oslab;
  float* Lslab;
};

DI void store_head_bf16(char* wl, const float (&o)[32], float rs, const float* __restrict__ gm, bf16_t* __restrict__ dst_row0  ,
                        int lane) {
  const int r = lane & 31, h = lane >> 5;
#pragma unroll
  for (int dt = 0; dt < 2; ++dt)
#pragma unroll
    for (int q4 = 0; q4 < 4; ++q4) {
      const int dv = 32 * dt + 8 * q4 + 4 * h;
      const float* ov = o + 16 * dt + 4 * q4;
      *(uint2*)(wl + r * 136 + dv * 2) = make_uint2(pk2bf(ov[0] * rs * gm[dv], ov[1] * rs * gm[dv + 1]), pk2bf(ov[2] * rs * gm[dv + 2], ov[3] * rs * gm[dv + 3]));
    }
  asm volatile("s_waitcnt lgkmcnt(0)" ::: "memory");
#pragma unroll
  for (int ps = 0; ps < 4; ++ps) {
    const int row = ps * 8 + (lane >> 3), ch = lane & 7;
    const uint2 a = *(const uint2*)(wl + row * 136 + ch * 16), c = *(const uint2*)(wl + row * 136 + ch * 16 + 8);
    *(uint4*)(dst_row0 + (size_t)row * D + ch * 8) = make_uint4(a.x, a.y, c.x, c.y);
  }
  asm volatile("s_waitcnt lgkmcnt(0)" ::: "memory");
}
DI void store_head_f32(char* wl, const f32x16& Oa, const f32x16& Ob, float* __restrict__ dst_row0, int lane) {
  const int r = lane & 31, h = lane >> 5;
#pragma unroll
  for (int dt = 0; dt < 2; ++dt)
#pragma unroll
    for (int q4 = 0; q4 < 4; ++q4) {
      const f32x16& O = dt == 0 ? Oa : Ob;
      *(float4*)(wl + r * 272 + (32 * dt + 8 * q4 + 4 * h) * 4) = make_float4(O[4 * q4], O[4 * q4 + 1], O[4 * q4 + 2], O[4 * q4 + 3]);
    }
  asm volatile("s_waitcnt lgkmcnt(0)" ::: "memory");
#pragma unroll
  for (int ps = 0; ps < 8; ++ps) {
    const int row = ps * 4 + (lane >> 4), ch = lane & 15;
    *(float4*)(dst_row0 + (size_t)row * 64 + ch * 4) = *(const float4*)(wl + row * 272 + ch * 16);
  }
  asm volatile("s_waitcnt lgkmcnt(0)" ::: "memory");
}

template <int TYPE>
DI void attn_item(const AttnArgs& a, int b, int g, int p0, int ctx0, int nctx, int lat0, int nkt, int half, char* smem) {
  constexpr int DQK = TYPE == 0 ? 32 : 64;
  constexpr int KS = DQK / 16;
  const int tid = TID, lane = tid & 63, wid = tid >> 6;
  const int r = lane & 31, h = lane >> 5;
  const bf16_t *Q0, *Q1, *K0, *K1, *Vt;
  const float* gqk;
  if (TYPE == 0) {
    Q0 = a.QA + ((size_t)b * 8 + 2 * g) * NT * 32; Q1 = Q0 + (size_t)NT * 32;
    K0 = a.KA + ((size_t)b * 8 + 2 * g) * NT * 32; K1 = K0 + (size_t)NT * 32;
    Vt = a.VAt + ((size_t)b * 4 + g) * 64 * NT; gqk = a.g_qk_diff;
  } else if (TYPE == 1) {
    Q0 = a.QW + ((size_t)b * 4 + 2 * g) * NT * 64; Q1 = Q0 + (size_t)NT * 64;
    K0 = a.KW + ((size_t)b * 2 + g) * NT * 64; K1 = K0;
    Vt = a.VWt + ((size_t)b * 2 + g) * 64 * NT; gqk = a.g_qk_win;
  } else {
    Q0 = a.QG + ((size_t)b * 4 + 2 * g) * NT * 64; Q1 = Q0 + (size_t)NT * 64;
    K0 = a.KG + ((size_t)b * 2 + g) * NT * 64; K1 = K0;
    Vt = a.VGt + ((size_t)b * 2 + g) * 64 * NT; gqk = a.g_qk_glob;
  }
  (void)gqk;
  const int qpos = p0 + wid * 32 + r;
  bf16x8 qf0[KS], qf1[KS];
#pragma unroll
  for (int s = 0; s < KS; ++s) {
    qf0[s] = *(const bf16x8*)(Q0 + (size_t)qpos * DQK + 16 * s + 8 * h);
    qf1[s] = *(const bf16x8*)(Q1 + (size_t)qpos * DQK + 16 * s + 8 * h);
  }
  f32x16 O00, O01, O10, O11, Zero;
#pragma unroll
  for (int i = 0; i < 16; ++i) { O00[i] = 0.f; O01[i] = 0.f; O10[i] = 0.f; O11[i] = 0.f; Zero[i] = 0.f; }
  float l0 = 0.f, l1 = 0.f;

  auto tile_of = [&](int it) { return it < nctx ? ctx0 + it : lat0 + it - nctx; };
  const int wvu = __builtin_amdgcn_readfirstlane(tid >> 6);
#define ATT_GLDS(kt_, sb_)                                                                               \
  {                                                                                                      \
    const int kt__ = (kt_);                                                                              \
    LAS char* sl__ = (LAS char*)(sb_);                                                                   \
    if (TYPE == 0) {                                                                                     \
      const int row = tid >> 2, ch = (tid & 3) ^ ((row >> 2) & 3);                                       \
      __builtin_amdgcn_global_load_lds((const unsigned*)(K0 + (size_t)(kt__ * 128 + row) * 32 + ch * 8), (LAS unsigned*)(sl__ + wvu * 1024), 16, 0, 0);          \
      __builtin_amdgcn_global_load_lds((const unsigned*)(K1 + (size_t)(kt__ * 128 + row) * 32 + ch * 8), (LAS unsigned*)(sl__ + 8192 + wvu * 1024), 16, 0, 0);   \
    } else {                                                                                             \
      _Pragma("unroll") for (int i2 = 0; i2 < 2; ++i2) {                                                 \
        const int lc = tid + 512 * i2; const int row = lc >> 3, ch = (lc & 7) ^ ((row >> 1) & 7);        \
        __builtin_amdgcn_global_load_lds((const unsigned*)(K0 + (size_t)(kt__ * 128 + row) * 64 + ch * 8), (LAS unsigned*)(sl__ + i2 * 8192 + wvu * 1024), 16, 0, 0); \
      }                                                                                                  \
    }                                                                                                    \
    _Pragma("unroll") for (int i2 = 0; i2 < 2; ++i2) {                                                   \
      const int lc = tid + 512 * i2; const int row = lc >> 4, ch = (lc & 15) ^ (row & 15);               \
      __builtin_amdgcn_global_load_lds((const unsigned*)(Vt + (size_t)row * NT + kt__ * 128 + ch * 8), (LAS unsigned*)(sl__ + 16384 + i2 * 8192 + wvu * 1024), 16, 0, 0); \
    }                                                                                                    \
  }
  __syncthreads();
  ATT_GLDS(tile_of(0), smem);
  asm volatile("s_waitcnt vmcnt(0)" ::: "memory");
  __syncthreads();
  const int qwave = p0 + wid * 32;
  const int vbase = r * 256 + ((h ^ (r & 15)) << 4);
#pragma unroll 1
  for (int it = 0; it < nkt; ++it) {
    const int kt = tile_of(it);
    const char* sb = smem + (it & 1) * 32768;
    if (it + 1 < nkt) ATT_GLDS(tile_of(it + 1), smem + ((it + 1) & 1) * 32768);
#pragma unroll 2
    for (int j = 0; j < 4; ++j) {
      const int kbase = kt * 128 + 32 * j;
      bool masked = false;
      if (TYPE == 1) {
        if (kbase >= CTX && p0 >= CTX) {
          if (kbase > qwave + 31 + 128 || kbase + 31 < qwave - 128) continue;
          masked = true;
        }
      }
      f32x16 S0 = Zero, S1 = Zero;
#pragma unroll
      for (int s = 0; s < KS; ++s) {
        if (TYPE == 0) {
          int row = 32 * j + r;
          int off = row * 64 + (((2 * s + h) ^ ((row >> 2) & 3)) << 4);
          bf16x8 k0 = *(const bf16x8*)(sb + off);
          bf16x8 k1 = *(const bf16x8*)(sb + 8192 + off);
          S0 = MFMA32(k0, qf0[s], S0);
          S1 = MFMA32(k1, qf1[s], S1);
        } else {
          int row = 32 * j + r;
          int off = row * 128 + (((2 * s + h) ^ ((row >> 1) & 7)) << 4);
          bf16x8 k0 = *(const bf16x8*)(sb + off);
          S0 = MFMA32(k0, qf0[s], S0);
          S1 = MFMA32(k0, qf1[s], S1);
        }
      }
      float pa[16], pb[16];
#pragma unroll
      for (int i = 0; i < 16; ++i) {
        float e0 = __builtin_amdgcn_exp2f(S0[i]);
        float e1 = __builtin_amdgcn_exp2f(S1[i]);
        if (TYPE == 1) {
          if (masked) {
            int kp = kbase + (i & 3) + 8 * (i >> 2) + 4 * h;
            int dd = kp - qpos;
            bool ok = (dd <= 128) && (dd >= -128);
            e0 = ok ? e0 : 0.f; e1 = ok ? e1 : 0.f;
          }
        }
        pa[i] = e0; pb[i] = e1;
      }
      l0 += ((pa[0] + pa[1]) + (pa[2] + pa[3])) + ((pa[4] + pa[5]) + (pa[6] + pa[7])) + ((pa[8] + pa[9]) + (pa[10] + pa[11])) + ((pa[12] + pa[13]) + (pa[14] + pa[15]));
      l1 += ((pb[0] + pb[1]) + (pb[2] + pb[3])) + ((pb[4] + pb[5]) + (pb[6] + pb[7])) + ((pb[8] + pb[9]) + (pb[10] + pb[11])) + ((pb[12] + pb[13]) + (pb[14] + pb[15]));
      bf16x8 pf0[2], pf1[2];
#pragma unroll
      for (int s2 = 0; s2 < 2; ++s2) {
        unsigned w0[4], w1[4];
#pragma unroll
        for (int e = 0; e < 4; ++e) {
          w0[e] = pk2bf(pa[8 * s2 + 2 * e], pa[8 * s2 + 2 * e + 1]);
          w1[e] = pk2bf(pb[8 * s2 + 2 * e], pb[8 * s2 + 2 * e + 1]);
        }
        pf0[s2] = __builtin_bit_cast(bf16x8, make_uint4(w0[0], w0[1], w0[2], w0[3]));
        pf1[s2] = __builtin_bit_cast(bf16x8, make_uint4(w1[0], w1[1], w1[2], w1[3]));
      }
#pragma unroll
      for (int s2 = 0; s2 < 2; ++s2) {
        const int vo = vbase ^ ((4 * j + 2 * s2) << 4);
        bf16x8 v0 = *(const bf16x8*)(sb + 16384 + vo);
        bf16x8 v1 = *(const bf16x8*)(sb + 16384 + 8192 + vo);
        O00 = MFMA32(v0, pf0[s2], O00);
        O01 = MFMA32(v1, pf0[s2], O01);
        O10 = MFMA32(v0, pf1[s2], O10);
        O11 = MFMA32(v1, pf1[s2], O11);
      }
    }
    asm volatile("s_waitcnt vmcnt(0)" ::: "memory");
    __syncthreads();
  }
  l0 += shxl(l0, lane, 32);
  l1 += shxl(l1, lane, 32);
  if (TYPE == 1) {
    l0 += __builtin_amdgcn_exp2f(a.sink[2 * g] * LOG2E);
    l1 += __builtin_amdgcn_exp2f(a.sink[2 * g + 1] * LOG2E);
  }
  const size_t orow0 = (size_t)b * NT + p0 + wid * 32;
  char* wl = smem + wid * 8704;
  if (TYPE == 2) {
#pragma unroll
    for (int x = 0; x < 2; ++x) {
      int head = 2 * g + x;
      float* dst0 = a.Oslab + ((((size_t)half * NB + b) * 4 + head) * NT + (p0 + wid * 32)) * 64;
      if (x == 0) store_head_f32(wl, O00, O01, dst0, lane); else store_head_f32(wl, O10, O11, dst0, lane);
      if (h == 0) a.Lslab[(((size_t)half * NB + b) * 4 + head) * NT + qpos] = x == 0 ? l0 : l1;
    }
  } else if (TYPE == 0) {
    float s0 = 0.f, s1 = 0.f;
    for (int d = 0; d < 32; ++d) { s0 += a.lambda_diff[d] * a.lambda_diff[32 + d]; s1 += a.lambda_diff[64 + d] * a.lambda_diff[96 + d]; }
    const float lam = __expf(s0) - __expf(s1) + a.lambda_init;
    const float i0 = 1.f / l0, i1 = lam / l1;
    float o[32];
    float ss = 0.f;
#pragma unroll
    for (int i = 0; i < 16; ++i) {
      o[i] = O00[i] * i0 - O10[i] * i1;
      o[16 + i] = O01[i] * i0 - O11[i] * i1;
      ss += o[i] * o[i] + o[16 + i] * o[16 + i];
    }
    ss += shxl(ss, lane, 32);
    const float rs = rsqrtf(ss * (1.f / 64) + EPS) * (1.f - a.lambda_init);
    const float* gm = a.g_mix_out + g * 64;
    store_head_bf16(wl, o, rs, gm, a.A2 + orow0 * D + g * 64, lane);
  } else {
#pragma unroll
    for (int x = 0; x < 2; ++x) {
      const float inv = 1.f / (x == 0 ? l0 : l1);
      float o[32];
      float ss = 0.f;
#pragma unroll
      for (int i = 0; i < 16; ++i) {
        o[i] = (x == 0 ? O00[i] : O10[i]) * inv;
        o[16 + i] = (x == 0 ? O01[i] : O11[i]) * inv;
        ss += o[i] * o[i] + o[16 + i] * o[16 + i];
      }
      ss += shxl(ss, lane, 32);
      const float rs = rsqrtf(ss * (1.f / 64) + EPS);
      const int col0 = 256 + (2 * g + x) * 64;
      const float* gm = a.g_mix_out + col0;
      store_head_bf16(wl, o, rs, gm, a.A2 + orow0 * D + col0, lane);
    }
  }
}

DI void attn_dispatch(const AttnArgs& a, int idx, int want_ctx, char* smem) {
  if (idx < 256) {
    int b = idx >> 7, g = (idx >> 5) & 3, qt = 1 + (idx & 31);
    attn_item<0>(a, b, g, qt * 256, 0, 2, 2, 66, 0, smem);
  } else if (idx < 512) {
    int i = idx - 256; int half = i >> 7, b = (i >> 6) & 1, g = (i >> 5) & 1, qt = 1 + (i & 31);
    if (half == 0) attn_item<2>(a, b, g, qt * 256, 0, 2, 2, 33, 0, smem);
    else attn_item<2>(a, b, g, qt * 256, 0, 0, 33, 33, 1, smem);
  } else if (idx < 640) {
    int i = idx - 512; int b = i >> 6, g = (i >> 5) & 1, qt = 1 + (i & 31);
    int lo = max(2, 2 * qt - 1), hi = min(65, 2 * qt + 2);
    attn_item<1>(a, b, g, qt * 256, 0, 2, lo, 2 + (hi - lo + 1), 0, smem);
  } else if (want_ctx) {
    int i = idx - 640;
    if (i < 8) attn_item<0>(a, i >> 2, i & 3, 0, 0, 2, 0, 2, 0, smem);
    else if (i < 16) { int k = i - 8; int half = k >> 2, b = (k >> 1) & 1, g = k & 1; attn_item<2>(a, b, g, 0, half, 1, 0, 1, half, smem); }
    else if (i < 20) { int k = i - 16; attn_item<1>(a, k >> 1, k & 1, 0, 0, 2, 0, 2, 0, smem); }
  }
}

typedef __attribute__((ext_vector_type(4))) float f32x4v;
typedef __attribute__((ext_vector_type(2))) _Float16 h2_t;
DI unsigned pack_i8x4(float a, float b, float c, float d) {
  const int ia = (int)__builtin_rintf(a), ib = (int)__builtin_rintf(b), ic = (int)__builtin_rintf(c), id = (int)__builtin_rintf(d);
  return (unsigned)(ia & 255) | ((unsigned)(ib & 255) << 8) | ((unsigned)(ic & 255) << 16) | ((unsigned)id << 24);
}
constexpr size_t TSLICE = (size_t)16384 * 128;
DI void tabconv_fin_i8(float4 v0, float4 v1, float4 v2, float4 v3, unsigned char* __restrict__ dst, float* __restrict__ scale, size_t row, int lane) {
  float m = fmaxf(fmaxf(fmaxf(fabsf(v0.x), fabsf(v0.y)), fmaxf(fabsf(v0.z), fabsf(v0.w))), fmaxf(fmaxf(fabsf(v1.x), fabsf(v1.y)), fmaxf(fabsf(v1.z), fabsf(v1.w))));
  m = fmaxf(m, fmaxf(fmaxf(fmaxf(fabsf(v2.x), fabsf(v2.y)), fmaxf(fabsf(v2.z), fabsf(v2.w))), fmaxf(fmaxf(fabsf(v3.x), fabsf(v3.y)), fmaxf(fabsf(v3.z), fabsf(v3.w)))));
  for (int o = 32; o > 0; o >>= 1) m = fmaxf(m, shxl(m, lane, o));
  m = fmaxf(m, 1e-30f);
  const float sc = m * (1.f / 127.f), inv = 127.f / m;
  *(uint4*)(dst + (size_t)(lane >> 3) * TSLICE + row * 128 + (lane & 7) * 16) = make_uint4(pack_i8x4(v0.x * inv, v0.y * inv, v0.z * inv, v0.w * inv), pack_i8x4(v1.x * inv, v1.y * inv, v1.z * inv, v1.w * inv),
                                                    pack_i8x4(v2.x * inv, v2.y * inv, v2.z * inv, v2.w * inv), pack_i8x4(v3.x * inv, v3.y * inv, v3.z * inv, v3.w * inv));
  if (lane == 0) scale[row] = sc;
}
DI void tabconv_fin(float4 v0, float4 v1, float4 v2, float4 v3, unsigned char* __restrict__ dst, float* __restrict__ scale, size_t row, int lane) {
  float m = fmaxf(fmaxf(fmaxf(fabsf(v0.x), fabsf(v0.y)), fmaxf(fabsf(v0.z), fabsf(v0.w))), fmaxf(fmaxf(fabsf(v1.x), fabsf(v1.y)), fmaxf(fabsf(v1.z), fabsf(v1.w))));
  m = fmaxf(m, fmaxf(fmaxf(fmaxf(fabsf(v2.x), fabsf(v2.y)), fmaxf(fabsf(v2.z), fabsf(v2.w))), fmaxf(fmaxf(fabsf(v3.x), fabsf(v3.y)), fmaxf(fabsf(v3.z), fabsf(v3.w)))));
  for (int o = 32; o > 0; o >>= 1) m = fmaxf(m, shxl(m, lane, o));
  m = fmaxf(m, 1e-30f);
  const float sc = m * (1.f / 448.f), inv = 448.f / m;
  int w0 = __builtin_amdgcn_cvt_pk_fp8_f32(v0.x * inv, v0.y * inv, 0, false); w0 = __builtin_amdgcn_cvt_pk_fp8_f32(v0.z * inv, v0.w * inv, w0, true);
  int w1 = __builtin_amdgcn_cvt_pk_fp8_f32(v1.x * inv, v1.y * inv, 0, false); w1 = __builtin_amdgcn_cvt_pk_fp8_f32(v1.z * inv, v1.w * inv, w1, true);
  int w2 = __builtin_amdgcn_cvt_pk_fp8_f32(v2.x * inv, v2.y * inv, 0, false); w2 = __builtin_amdgcn_cvt_pk_fp8_f32(v2.z * inv, v2.w * inv, w2, true);
  int w3 = __builtin_amdgcn_cvt_pk_fp8_f32(v3.x * inv, v3.y * inv, 0, false); w3 = __builtin_amdgcn_cvt_pk_fp8_f32(v3.z * inv, v3.w * inv, w3, true);
  *(uint4*)(dst + (size_t)(lane >> 3) * TSLICE + row * 128 + (lane & 7) * 16) = make_uint4((unsigned)w0, (unsigned)w1, (unsigned)w2, (unsigned)w3);
  if (lane == 0) scale[row] = sc;
}
DI void score_sort(const bf16_t* __restrict__ qbuf, const bf16_t* __restrict__ keysb, int m0, int hp, char* smem, unsigned (&v16)[16]) {
  const int tid = TID, lane = tid & 63, wid = tid >> 6;
  const int wm = wid & 1, wn = wid >> 1;
  const int r = lane & 31, h = lane >> 5;
  f32x16 acc0, acc1;
  for (int i = 0; i < 16; ++i) { acc0[i] = 0.f; acc1[i] = 0.f; }
  const int lrow = tid >> 3, lch = tid & 7;
  const bf16_t* Ag = qbuf + (size_t)(m0 + lrow) * 2048 + hp * 128 + lch * 8;
  const bf16_t* Bg = keysb + ((size_t)hp * 128 + lrow) * 128 + lch * 8;
  const int woff = lrow * 128 + ((lch ^ ((lrow >> 1) & 7)) << 4);
  __syncthreads();
#pragma unroll
  for (int kt = 0; kt < 2; ++kt) {
    char* sn = smem + kt * 32768;
    *(uint4*)(sn + woff) = *(const uint4*)(Ag + kt * 64);
    *(uint4*)(sn + woff + 8192) = *(const uint4*)(Ag + (size_t)64 * 2048 + kt * 64);
    *(uint4*)(sn + 16384 + woff) = *(const uint4*)(Bg + kt * 64);
    *(uint4*)(sn + 16384 + woff + 8192) = *(const uint4*)(Bg + 64 * 128 + kt * 64);
  }
  __syncthreads();
  const int sw = (r >> 1) & 7;
  const int aoff0 = (wm * 64 + r) * 128, aoff1 = aoff0 + 32 * 128;
  const int boff = 16384 + (wn * 32 + r) * 128;
#pragma unroll
  for (int kt = 0; kt < 2; ++kt) {
    const char* st = smem + kt * 32768;
#pragma unroll
    for (int s = 0; s < 4; ++s) {
      int co = ((2 * s + h) ^ sw) << 4;
      bf16x8 a0 = *(const bf16x8*)(st + aoff0 + co);
      bf16x8 a1 = *(const bf16x8*)(st + aoff1 + co);
      bf16x8 b = *(const bf16x8*)(st + boff + co);
      acc0 = MFMA32(a0, b, acc0);
      acc1 = MFMA32(a1, b, acc1);
    }
  }
  __syncthreads();
  float* Cs = (float*)smem;
  constexpr int CS = 132;
#pragma unroll
  for (int i = 0; i < 16; ++i) {
    int row = (i & 3) + 8 * (i >> 2) + 4 * h;
    Cs[(wm * 64 + row) * CS + wn * 32 + r] = acc0[i];
    Cs[(wm * 64 + 32 + row) * CS + wn * 32 + r] = acc1[i];
  }
  __syncthreads();
  const int row = tid >> 2, q = tid & 3;
  unsigned v[32];
#pragma unroll
  for (int i = 0; i < 32; ++i) {
    unsigned u = __float_as_uint(Cs[row * CS + 4 * i + q]);
    u ^= (u & 0x80000000u) ? 0xffffffffu : 0x80000000u;
    v[i] = (u & ~127u) | (unsigned)(127 - (4 * i + q));
  }
#pragma unroll
  for (int k = 2; k <= 32; k <<= 1)
#pragma unroll
    for (int j = k >> 1; j > 0; j >>= 1)
#pragma unroll
      for (int i = 0; i < 32; ++i) {
        const int l = i ^ j;
        if (l > i) {
          const unsigned lo = min(v[i], v[l]), hi = max(v[i], v[l]);
          if ((i & k) == 0) { v[i] = hi; v[l] = lo; } else { v[i] = lo; v[l] = hi; }
        }
      }
#pragma unroll
  for (int step = 0; step < 2; ++step) {
    unsigned c[16];
#pragma unroll
    for (int i = 0; i < 16; ++i) {
      const unsigned o = step == 0 ? (unsigned)__builtin_amdgcn_mov_dpp((int)v[15 - i], 0xB1, 0xf, 0xf, false)
                                   : (unsigned)__builtin_amdgcn_mov_dpp((int)v[15 - i], 0x4E, 0xf, 0xf, false);
      c[i] = max(v[i], o);
    }
#pragma unroll
    for (int j = 8; j > 0; j >>= 1)
#pragma unroll
      for (int i = 0; i < 16; ++i) {
        const int l = i ^ j;
        if (l > i) { const unsigned lo = min(c[i], c[l]), hi = max(c[i], c[l]); c[i] = hi; c[l] = lo; }
      }
#pragma unroll
    for (int i = 0; i < 16; ++i) v[i] = c[i];
  }
#pragma unroll
  for (int i = 0; i < 16; ++i) v16[i] = v[i];
}
constexpr int CAND_I[52] = {0, 0, 0, 0, 0, 0, 0, 0, 0, 0, 0, 0, 0, 0, 0, 0, 1, 1, 1, 1, 1, 1, 1, 1, 2, 2, 2, 2, 2, 3, 3, 3, 3, 4, 4, 4, 5, 5, 6, 6, 7, 7, 8, 9, 10, 11, 12, 13, 14, 15, 0, 0};
constexpr int CAND_J[52] = {0, 1, 2, 3, 4, 5, 6, 7, 8, 9, 10, 11, 12, 13, 14, 15, 0, 1, 2, 3, 4, 5, 6, 7, 0, 1, 2, 3, 4, 0, 1, 2, 3, 0, 1, 2, 0, 1, 0, 1, 0, 1, 0, 0, 0, 0, 0, 0, 0, 0, 0, 0};
DI float sel4(int q, float a, float b, float c, float d) { return q == 0 ? a : q == 1 ? b : q == 2 ? c : d; }
DI unsigned sel4u(int q, unsigned a, unsigned b, unsigned c, unsigned d) { return q == 0 ? a : q == 1 ? b : q == 2 ? c : d; }
DI float key7f(unsigned k) { k &= ~127u; k ^= (k & 0x80000000u) ? 0x80000000u : 0xffffffffu; return __uint_as_float(k); }
DI float key8f(unsigned k) { k &= ~255u; k ^= (k & 0x80000000u) ? 0x80000000u : 0xffffffffu; return __uint_as_float(k); }
DI void score_head_item(const bf16_t* __restrict__ qbuf, const bf16_t* __restrict__ keysb, int m0, int hd, char* smem, int* __restrict__ experts,
                        float* __restrict__ gates) {
  unsigned ka[16], kb[16];
  score_sort(qbuf, keysb, m0, 2 * hd, smem, ka);
  score_sort(qbuf, keysb, m0, 2 * hd + 1, smem, kb);
  const int tid = TID, row = tid >> 2, q = tid & 3;
  unsigned char* ix = (unsigned char*)(smem + 69632) + row * 32;
  *(unsigned*)(ix + 4 * q) = (sel4u(q, ka[0], ka[4], ka[8], ka[12]) & 127u) | ((sel4u(q, ka[1], ka[5], ka[9], ka[13]) & 127u) << 8) |
                             ((sel4u(q, ka[2], ka[6], ka[10], ka[14]) & 127u) << 16) | ((sel4u(q, ka[3], ka[7], ka[11], ka[15]) & 127u) << 24);
  *(unsigned*)(ix + 16 + 4 * q) = (sel4u(q, kb[0], kb[4], kb[8], kb[12]) & 127u) | ((sel4u(q, kb[1], kb[5], kb[9], kb[13]) & 127u) << 8) |
                                  ((sel4u(q, kb[2], kb[6], kb[10], kb[14]) & 127u) << 16) | ((sel4u(q, kb[3], kb[7], kb[11], kb[15]) & 127u) << 24);
  float a[16], b[16];
#pragma unroll
  for (int i = 0; i < 16; ++i) { a[i] = key7f(ka[i]); b[i] = key7f(kb[i]); }
  unsigned c[16];
#pragma unroll
  for (int t = 0; t < 16; ++t) {
    if (4 * t >= 52) { c[t] = 0u; continue; }
    const float sv = sel4(q, a[CAND_I[4 * t]], a[CAND_I[4 * t + 1]], a[CAND_I[4 * t + 2]], a[CAND_I[4 * t + 3]]) +
                     sel4(q, b[CAND_J[4 * t]], b[CAND_J[4 * t + 1]], b[CAND_J[4 * t + 2]], b[CAND_J[4 * t + 3]]);
    const unsigned code = sel4u(q, CAND_I[4 * t] * 16 + CAND_J[4 * t], CAND_I[4 * t + 1] * 16 + CAND_J[4 * t + 1], CAND_I[4 * t + 2] * 16 + CAND_J[4 * t + 2],
                                CAND_I[4 * t + 3] * 16 + CAND_J[4 * t + 3]);
    unsigned u = __float_as_uint(sv);
    u ^= (u & 0x80000000u) ? 0xffffffffu : 0x80000000u;
    const bool valid = (4 * t + q) < 50;
    c[t] = valid ? ((u & ~255u) | code) : 0u;
  }
#pragma unroll
  for (int k = 2; k <= 16; k <<= 1)
#pragma unroll
    for (int j = k >> 1; j > 0; j >>= 1)
#pragma unroll
      for (int i = 0; i < 16; ++i) {
        const int l = i ^ j;
        if (l > i) {
          const unsigned lo = min(c[i], c[l]), hi = max(c[i], c[l]);
          if ((i & k) == 0) { c[i] = hi; c[l] = lo; } else { c[i] = lo; c[l] = hi; }
        }
      }
#pragma unroll
  for (int step = 0; step < 2; ++step) {
    unsigned d[16];
#pragma unroll
    for (int i = 0; i < 16; ++i) {
      const unsigned o = step == 0 ? (unsigned)__builtin_amdgcn_mov_dpp((int)c[15 - i], 0xB1, 0xf, 0xf, false)
                                   : (unsigned)__builtin_amdgcn_mov_dpp((int)c[15 - i], 0x4E, 0xf, 0xf, false);
      d[i] = max(c[i], o);
    }
#pragma unroll
    for (int j = 8; j > 0; j >>= 1)
#pragma unroll
      for (int i = 0; i < 16; ++i) {
        const int l = i ^ j;
        if (l > i) { const unsigned lo = min(d[i], d[l]), hi = max(d[i], d[l]); d[i] = hi; d[l] = lo; }
      }
#pragma unroll
    for (int i = 0; i < 16; ++i) c[i] = d[i];
  }
  const float mx = key8f(c[0]);
  float e[16]; float sum = 0.f;
#pragma unroll
  for (int i = 0; i < 16; ++i) { e[i] = __expf(key8f(c[i]) - mx); sum += e[i]; }
  const float inv = 1.f / sum;
  asm volatile("s_waitcnt lgkmcnt(0)" ::: "memory");
  int eo[4]; float go[4];
#pragma unroll
  for (int k = 0; k < 4; ++k) {
    const unsigned code = sel4u(q, c[k], c[4 + k], c[8 + k], c[12 + k]) & 255u;
    go[k] = sel4(q, e[k], e[4 + k], e[8 + k], e[12 + k]) * inv;
    eo[k] = (127 - (int)ix[code >> 4]) * 128 + (127 - (int)ix[16 + (code & 15)]);
  }
  const size_t o = (size_t)(m0 + row) * 128 + hd * 16 + 4 * q;
  *(uint2*)((unsigned short*)experts + o) = make_uint2((unsigned)eo[0] | ((unsigned)eo[1] << 16), (unsigned)eo[2] | ((unsigned)eo[3] << 16));
  *(float4*)(gates + o) = make_float4(go[0], go[1], go[2], go[3]);
}

DI float key2f(unsigned k) { k &= ~127u; k ^= (k & 0x80000000u) ? 0x80000000u : 0xffffffffu; return __uint_as_float(k); }
DI void merge_one(const unsigned* __restrict__ topk, int r, int hd, int* experts, float* gates) {
  const unsigned* ka = topk + ((size_t)r * 16 + 2 * hd) * 16;
  const unsigned* kb = ka + 16;
  float a[16], bq[16];
#pragma unroll
  for (int i = 0; i < 4; ++i) {
    uint4 x = ((const uint4*)ka)[i], y = ((const uint4*)kb)[i];
    a[4 * i] = key2f(x.x); a[4 * i + 1] = key2f(x.y); a[4 * i + 2] = key2f(x.z); a[4 * i + 3] = key2f(x.w);
    bq[4 * i] = key2f(y.x); bq[4 * i + 1] = key2f(y.y); bq[4 * i + 2] = key2f(y.z); bq[4 * i + 3] = key2f(y.w);
  }
  float cv[50];
  {
    int n = 0;
#pragma unroll
    for (int i = 0; i < 16; ++i)
#pragma unroll
      for (int j = 0; j < 16; ++j)
        if ((i + 1) * (j + 1) <= 16) { cv[n] = a[i] + bq[j]; ++n; }
  }
  int* eo = experts + hd * 16;
  float* go = gates + hd * 16;
  float mx = 0.f, sum = 0.f;
#pragma unroll 1
  for (int k = 0; k < 16; ++k) {
    float mval = cv[0]; int code = 0;
    {
      int n = 0;
#pragma unroll
      for (int i = 0; i < 16; ++i)
#pragma unroll
        for (int j = 0; j < 16; ++j)
          if ((i + 1) * (j + 1) <= 16) {
            if (n > 0) { bool gt = cv[n] > mval; mval = gt ? cv[n] : mval; code = gt ? (i * 16 + j) : code; }
            ++n;
          }
    }
    {
      int n = 0;
#pragma unroll
      for (int i = 0; i < 16; ++i)
#pragma unroll
        for (int j = 0; j < 16; ++j)
          if ((i + 1) * (j + 1) <= 16) { cv[n] = (code == i * 16 + j) ? -3.0e38f : cv[n]; ++n; }
    }
    if (k == 0) mx = mval;
    const float e = __expf(mval - mx);
    sum += e;
    eo[k] = (int)(127u - (ka[code >> 4] & 127u)) * 128 + (int)(127u - (kb[code & 15] & 127u));
    go[k] = e;
  }
  const float inv = 1.f / sum;
#pragma unroll
  for (int i = 0; i < 4; ++i) {
    float4 g4 = ((float4*)go)[i];
    g4.x *= inv; g4.y *= inv; g4.z *= inv; g4.w *= inv;
    ((float4*)go)[i] = g4;
  }
}

template <int MODE>
DI void peer_token(int r, const bf16_t* __restrict__ hbuf, const int* ex_row, const float* g_row,
                   const unsigned char* __restrict__ u8, const float* __restrict__ us, const unsigned char* __restrict__ v8,
                   const float* __restrict__ vs, const float* __restrict__ modv_l, float* __restrict__ xs, float* wdots  ,
                   float* __restrict__ outp, int* __restrict__ ex_out, float* __restrict__ w_out) {
  const int lane = TID & 63;
  float x[16];
  {
    const uint2* hr = (const uint2*)(hbuf + (size_t)r * D + lane * 4);
#pragma unroll
    for (int c = 0; c < 4; ++c) { const uint2 a = hr[64 * c]; x[4 * c] = bflo(a.x); x[4 * c + 1] = bfhi(a.x); x[4 * c + 2] = bflo(a.y); x[4 * c + 3] = bfhi(a.y); }
  }
  const int e0 = ex_row[lane], e1 = ex_row[64 + lane];
  const float g0 = g_row[lane], g1 = g_row[64 + lane];
  const float us0 = us[e0], us1 = us[e1], vs0 = vs[e0], vs1 = vs[e1];
#define PEER_LOAD8(rw_, tab_, k0_)                                                          \
  {                                                                                         \
    _Pragma("unroll") for (int j = 0; j < 8; ++j) {                                         \
      int e = __builtin_amdgcn_readlane((k0_) < 64 ? e0 : e1, ((k0_) + j) & 63);            \
      rw_[j] = *(const uint4*)((tab_) + (size_t)e * D + lane * 16);                         \
    }                                                                                       \
  }
#define PEER_UDOT8(rw_, k0_)                                                                \
  {                                                                                         \
    float p[8];                                                                             \
    _Pragma("unroll") for (int j = 0; j < 8; ++j) {                                         \
      f32x2_t a0 = __builtin_amdgcn_cvt_pk_f32_fp8((int)rw_[j].x, false), a1 = __builtin_amdgcn_cvt_pk_f32_fp8((int)rw_[j].x, true); \
      f32x2_t b0 = __builtin_amdgcn_cvt_pk_f32_fp8((int)rw_[j].y, false), b1 = __builtin_amdgcn_cvt_pk_f32_fp8((int)rw_[j].y, true); \
      f32x2_t c0 = __builtin_amdgcn_cvt_pk_f32_fp8((int)rw_[j].z, false), c1 = __builtin_amdgcn_cvt_pk_f32_fp8((int)rw_[j].z, true); \
      f32x2_t d0 = __builtin_amdgcn_cvt_pk_f32_fp8((int)rw_[j].w, false), d1 = __builtin_amdgcn_cvt_pk_f32_fp8((int)rw_[j].w, true); \
      float s = a0[0] * x[0] + a0[1] * x[1] + a1[0] * x[2] + a1[1] * x[3];                  \
      s += b0[0] * x[4] + b0[1] * x[5] + b1[0] * x[6] + b1[1] * x[7];                       \
      s += c0[0] * x[8] + c0[1] * x[9] + c1[0] * x[10] + c1[1] * x[11];                     \
      s += d0[0] * x[12] + d0[1] * x[13] + d1[0] * x[14] + d1[1] * x[15];                   \
      p[j] = s;                                                                             \
    }                                                                                       \
    float q4[4];                                                                            \
    _Pragma("unroll") for (int i = 0; i < 4; ++i) { float send = hi32 ? p[i] : p[4 + i]; float keep = hi32 ? p[4 + i] : p[i]; q4[i] = keep + shxl(send, lane, 32); } \
    float q2[2];                                                                            \
    _Pragma("unroll") for (int i = 0; i < 2; ++i) { float send = hi16 ? q4[i] : q4[2 + i]; float keep = hi16 ? q4[2 + i] : q4[i]; q2[i] = keep + shxl(send, lane, 16); } \
    float q1;                                                                               \
    { float send = hi8 ? q2[0] : q2[1]; float keep = hi8 ? q2[1] : q2[0]; q1 = keep + shxl(send, lane, 8); } \
    q1 += shxl(q1, lane, 4); q1 += shxl(q1, lane, 2); q1 += shxl(q1, lane, 1);              \
    if ((lane & 7) == 0) wdots[(k0_) + (lane >> 3)] = q1;                                   \
  }
#define PEER_VACC8(rw_, k0_)                                                                \
  {                                                                                         \
    _Pragma("unroll") for (int j = 0; j < 8; ++j) {                                         \
      float w = __builtin_bit_cast(float, __builtin_amdgcn_readlane(__builtin_bit_cast(int, (k0_) < 64 ? w0 : w1), ((k0_) + j) & 63)); \
      f32x2_t a0 = __builtin_amdgcn_cvt_pk_f32_fp8((int)rw_[j].x, false), a1 = __builtin_amdgcn_cvt_pk_f32_fp8((int)rw_[j].x, true); \
      f32x2_t b0 = __builtin_amdgcn_cvt_pk_f32_fp8((int)rw_[j].y, false), b1 = __builtin_amdgcn_cvt_pk_f32_fp8((int)rw_[j].y, true); \
      f32x2_t c0 = __builtin_amdgcn_cvt_pk_f32_fp8((int)rw_[j].z, false), c1 = __builtin_amdgcn_cvt_pk_f32_fp8((int)rw_[j].z, true); \
      f32x2_t d0 = __builtin_amdgcn_cvt_pk_f32_fp8((int)rw_[j].w, false), d1 = __builtin_amdgcn_cvt_pk_f32_fp8((int)rw_[j].w, true); \
      acc[0] += w * a0[0]; acc[1] += w * a0[1]; acc[2] += w * a1[0]; acc[3] += w * a1[1];   \
      acc[4] += w * b0[0]; acc[5] += w * b0[1]; acc[6] += w * b1[0]; acc[7] += w * b1[1];   \
      acc[8] += w * c0[0]; acc[9] += w * c0[1]; acc[10] += w * c1[0]; acc[11] += w * c1[1]; \
      acc[12] += w * d0[0]; acc[13] += w * d0[1]; acc[14] += w * d1[0]; acc[15] += w * d1[1]; \
    }                                                                                       \
  }
  const bool hi32 = lane & 32, hi16 = lane & 16, hi8 = lane & 8;
  uint4 rwA[8], rwB[8];
  PEER_LOAD8(rwA, u8, 0);
#pragma unroll 1
  for (int k0 = 0; k0 < 128; k0 += 16) {
    PEER_LOAD8(rwB, u8, k0 + 8);
    PEER_UDOT8(rwA, k0);
    if (k0 + 16 < 128) { PEER_LOAD8(rwA, u8, k0 + 16); } else if (MODE == 0) { PEER_LOAD8(rwA, v8, 0); }
    PEER_UDOT8(rwB, k0 + 8);
  }
  float w0, w1;
  {
    float d0 = wdots[lane] * us0, d1 = wdots[64 + lane] * us1;
    float t0 = 0.5f * d0 * (1.f + tanhf(0.7978845608028654f * (d0 + 0.044715f * d0 * d0 * d0)));
    float t1 = 0.5f * d1 * (1.f + tanhf(0.7978845608028654f * (d1 + 0.044715f * d1 * d1 * d1)));
    w0 = g0 * t0 * vs0; w1 = g1 * t1 * vs1;
  }
  if (MODE == 1) {
    ex_out[(size_t)r * 128 + lane] = e0; ex_out[(size_t)r * 128 + 64 + lane] = e1;
    w_out[(size_t)r * 128 + lane] = w0; w_out[(size_t)r * 128 + 64 + lane] = w1;
    return;
  }
  float acc[16];
#pragma unroll
  for (int i = 0; i < 16; ++i) acc[i] = 0.f;
#pragma unroll 1
  for (int k0 = 0; k0 < 128; k0 += 16) {
    PEER_LOAD8(rwB, v8, k0 + 8);
    PEER_VACC8(rwA, k0);
    if (k0 + 16 < 128) PEER_LOAD8(rwA, v8, k0 + 16);
    PEER_VACC8(rwB, k0 + 8);
  }
  const int b = r / NT, p = r % NT; const int mrow = p < CTX ? 2 : b;
  const float* g2 = modv_l + mrow * NMOD + 5 * D + lane * 4;
  float4* xp = (float4*)(xs + (size_t)r * D + lane * 4);
  float4* op = outp ? (float4*)(outp + ((size_t)b * SEQ + (p - CTX)) * D + lane * 4) : xp;
#pragma unroll
  for (int i = 0; i < 4; ++i) {
    float4 xv = xp[64 * i]; float4 gg = ((const float4*)g2)[64 * i];
    xv.x += gg.x * acc[4 * i]; xv.y += gg.y * acc[4 * i + 1]; xv.z += gg.z * acc[4 * i + 2]; xv.w += gg.w * acc[4 * i + 3];
    op[64 * i] = xv;
  }
}

constexpr int FN = 2 * SEQ;
DI float2 cmul(float2 a, float2 b) { return make_float2(a.x * b.x - a.y * b.y, a.x * b.y + a.y * b.x); }
DI float2 cmulc(float2 a, float2 b) { return make_float2(a.x * b.x + a.y * b.y, a.y * b.x - a.x * b.y); }
DI int PX(int i) { return i + ((i >> 6) << 2); }
constexpr int FNP = FN + (FN >> 6) * 4;
DI int freq_of_pos(int pos) { return ((pos >> 10) & 15) | (((pos >> 6) & 15) << 4) | (((pos >> 2) & 15) << 8) | ((pos & 3) << 12); }
DI int pos_of_freq(int f) { return ((f & 15) << 10) | (((f >> 4) & 15) << 6) | (((f >> 8) & 15) << 2) | (f >> 12); }
DI float2 cadd(float2 a, float2 b) { return make_float2(a.x + b.x, a.y + b.y); }
DI float2 csub(float2 a, float2 b) { return make_float2(a.x - b.x, a.y - b.y); }
DI float2 cmni(float2 a) { return make_float2(a.y, -a.x); }
DI float2 cconj(float2 a) { return make_float2(a.x, -a.y); }
struct TabJob {
  const float* pu; const float* pv;
  unsigned char* du; unsigned char* dv;
  float* su; float* sv;
  int slot, wv, nw;
  int prow;
  float4 v[4];
};
DI void tab_step(TabJob& j, int lane) {
  if (j.prow >= 0) {
    if (j.prow >> 14) tabconv_fin(j.v[0], j.v[1], j.v[2], j.v[3], j.dv, j.sv, (size_t)(j.prow & 16383), lane);
    else tabconv_fin_i8(j.v[0], j.v[1], j.v[2], j.v[3], j.du, j.su, (size_t)(j.prow & 16383), lane);
    j.prow = -1;
  }
  const int row = j.slot * j.nw + j.wv;
  if (j.pu != nullptr && row < 32768) {
    const float4* sp = (const float4*)(((row >> 14) ? j.pv : j.pu) + (size_t)(row & 16383) * D);
    j.v[0] = sp[lane]; j.v[1] = sp[64 + lane]; j.v[2] = sp[128 + lane]; j.v[3] = sp[192 + lane];
    j.prow = row;
  }
  j.slot++;
}
DI void tab_flush(TabJob& j, int lane) {
  if (j.prow >= 0) {
    if (j.prow >> 14) tabconv_fin(j.v[0], j.v[1], j.v[2], j.v[3], j.dv, j.sv, (size_t)(j.prow & 16383), lane);
    else tabconv_fin_i8(j.v[0], j.v[1], j.v[2], j.v[3], j.du, j.su, (size_t)(j.prow & 16383), lane);
    j.prow = -1;
  }
}
DI void dft16(float2 (&x)[16]) {
  constexpr float C1 = 0.9238795325112867f, S1 = 0.3826834323650898f, C2 = 0.7071067811865476f;
  float2 u[16];
#pragma unroll
  for (int r = 0; r < 4; ++r) {
    const float2 a = x[r], b = x[r + 4], c = x[r + 8], d = x[r + 12];
    const float2 t0 = cadd(a, c), t1 = csub(a, c), t2 = cadd(b, d), t3 = cmni(csub(b, d));
    const float2 y0 = cadd(t0, t2), y1 = cadd(t1, t3), y2 = csub(t0, t2), y3 = csub(t1, t3);
    u[4 * r] = y0;
    if (r == 0) { u[1] = y1; u[2] = y2; u[3] = y3; }
    else if (r == 1) { u[5] = cmul(y1, make_float2(C1, -S1)); u[6] = cmul(y2, make_float2(C2, -C2)); u[7] = cmul(y3, make_float2(S1, -C1)); }
    else if (r == 2) { u[9] = cmul(y1, make_float2(C2, -C2)); u[10] = cmni(y2); u[11] = cmul(y3, make_float2(-C2, -C2)); }
    else { u[13] = cmul(y1, make_float2(S1, -C1)); u[14] = cmul(y2, make_float2(-C2, -C2)); u[15] = cmul(y3, make_float2(-C1, S1)); }
  }
#pragma unroll
  for (int sdx = 0; sdx < 4; ++sdx) {
    const float2 a = u[sdx], b = u[4 + sdx], c = u[8 + sdx], d = u[12 + sdx];
    const float2 t0 = cadd(a, c), t1 = csub(a, c), t2 = cadd(b, d), t3 = cmni(csub(b, d));
    x[4 * sdx] = cadd(t0, t2); x[4 * sdx + 1] = cadd(t1, t3); x[4 * sdx + 2] = csub(t0, t2); x[4 * sdx + 3] = csub(t1, t3);
  }
}
template <int LQ, bool INV>
DI void fft_pass16(float2* X, int tid, TabJob& job) {
  constexpr int q = 1 << LQ;
  constexpr float invL = 1.f / (float)(16 << LQ);
  tab_step(job, tid & 63);
#pragma unroll 1
  for (int bf = 0; bf < 2; ++bf) {
    const int i = tid + 512 * bf;
    const int j = i & (q - 1); const int base = ((i >> LQ) << (LQ + 4)) + j;
    const float fr = (float)j * invL;
    const float2 w1 = make_float2(__builtin_amdgcn_cosf(fr), -__builtin_amdgcn_sinf(fr));
    float2 x[16];
    if (!INV) {
#pragma unroll
      for (int mm = 0; mm < 16; ++mm) x[mm] = X[PX(base + mm * q)];
      dft16(x);
      float2 w = w1;
      X[PX(base)] = x[0];
#pragma unroll
      for (int k = 1; k < 16; ++k) {
        const int p = 4 * (k & 3) + (k >> 2);
        X[PX(base + k * q)] = cmul(x[p], w);
        w = cmul(w, w1);
      }
    } else {
      float2 w = w1;
      x[0] = cconj(X[PX(base)]);
#pragma unroll
      for (int k = 1; k < 16; ++k) {
        x[k] = cmul(cconj(X[PX(base + k * q)]), w);
        w = cmul(w, w1);
      }
      dft16(x);
#pragma unroll
      for (int p = 0; p < 16; ++p) {
        const int mm = (p >> 2) + 4 * (p & 3);
        X[PX(base + mm * q)] = cconj(x[p]);
      }
    }
  }
}
template <bool INV>
DI void fft_pass4(float2* X, int tid, TabJob& job) {
  tab_step(job, tid & 63);
#pragma unroll 2
  for (int bf = 0; bf < 8; ++bf) {
    const int base = PX(4 * (tid + 512 * bf));
    float2 a = X[base], b = X[base + 1], c = X[base + 2], d = X[base + 3];
    if (INV) { a = cconj(a); b = cconj(b); c = cconj(c); d = cconj(d); }
    const float2 t0 = cadd(a, c), t1 = csub(a, c), t2 = cadd(b, d), t3 = cmni(csub(b, d));
    float2 y0 = cadd(t0, t2), y1 = cadd(t1, t3), y2 = csub(t0, t2), y3 = csub(t1, t3);
    if (INV) { y0 = cconj(y0); y1 = cconj(y1); y2 = cconj(y2); y3 = cconj(y3); }
    X[base] = y0; X[base + 1] = y1; X[base + 2] = y2; X[base + 3] = y3;
  }
}
DI void fft_fwd(float2* X, TabJob& job) {
  const int tid = TID;
  __syncthreads(); fft_pass16<10, false>(X, tid, job);
  __syncthreads(); fft_pass16<6, false>(X, tid, job);
  __syncthreads(); fft_pass16<2, false>(X, tid, job);
  __syncthreads(); fft_pass4<false>(X, tid, job);
  __syncthreads();
}
DI void fft_inv(float2* X, TabJob& job) {
  const int tid = TID;
  __syncthreads(); fft_pass4<true>(X, tid, job);
  __syncthreads(); fft_pass16<2, true>(X, tid, job);
  __syncthreads(); fft_pass16<6, true>(X, tid, job);
  __syncthreads(); fft_pass16<10, true>(X, tid, job);
  __syncthreads();
}
DI float block_sum_512(float v, float* red) {
  for (int o = 32; o > 0; o >>= 1) v += shx(v, o);
  __syncthreads();
  if ((TID & 63) == 0) red[TID >> 6] = v;
  __syncthreads();
  float s = 0.f;
  for (int i = 0; i < 8; ++i) s += red[i];
  return s;
}
DI unsigned pkc(float2 v) { return pk2bf(v.x, v.y); }
DI float2 upkc(unsigned w) { return make_float2(bflo(w), bfhi(w)); }
DI void hyena_filter_task(int c, const bf16_t* __restrict__ hdnB, const bf16_t* __restrict__ W3t, const float* __restrict__ b3, uint2* __restrict__ H01_all,
                          char* smem, TabJob& job) {
  float2* X = (float2*)smem;
  float* red = (float*)(smem + FNP * 8);
  uint2* H01 = H01_all + (size_t)c * FN;
  const int tid = TID;
  __syncthreads();
  const float delta = fabsf(-3.0701134573253944f + (float)c * ((-15.350567286626972f + 3.0701134573253944f) / 255.f));
  const float bb00 = b3[c], bb01 = b3[256 + c], bb10 = b3[512 + c], bb11 = b3[768 + c];
  float n0 = 0.f, n1 = 0.f;
  {
    const int lane = tid & 63, wid = tid >> 6, r = lane & 31, h = lane >> 5;
    bf16x8 wa[4];
#pragma unroll
    for (int s4 = 0; s4 < 4; ++s4) {
      uint4 w = make_uint4(0u, 0u, 0u, 0u);
      if (r < 4) w = *(const uint4*)(W3t + ((size_t)((r >> 1) * 512 + (r & 1) * 256 + c)) * 64 + 16 * s4 + 8 * h);
      wa[s4] = __builtin_bit_cast(bf16x8, w);
    }
#pragma unroll 8
    for (int blk = wid; blk < SEQ / 32; blk += 8) {
      const int j = blk * 32 + r;
      const bf16_t* hp = hdnB + (size_t)blk * 2048 + (h * 32 + r) * 8;
      f32x16 acc;
#pragma unroll
      for (int i = 0; i < 16; ++i) acc[i] = 0.f;
#pragma unroll
      for (int s4 = 0; s4 < 4; ++s4) acc = MFMA32(wa[s4], *(const bf16x8*)(hp + 512 * s4), acc);
      if (h == 0) {
        const float dec = __expf(-((float)j / (float)(SEQ - 1)) * delta);
        const float f00 = (acc[0] + bb00) * dec, f01 = (acc[1] + bb01) * dec, f10 = (acc[2] + bb10) * dec, f11 = (acc[3] + bb11) * dec;
        X[PX(j)] = make_float2(f00, f10);
        n0 += fabsf(f00); n1 += fabsf(f10);
        if (j > 0) { X[PX(FN - j)] = make_float2(f01, f11); n0 += fabsf(f01); n1 += fabsf(f11); }
        else X[PX(SEQ)] = make_float2(0.f, 0.f);
      }
    }
  }
  n0 = block_sum_512(n0, red);
  n1 = block_sum_512(n1, red);
  const float s0 = 0.5f / (n0 * (float)FN), s1 = 0.5f / (n1 * (float)FN);
  fft_fwd(X, job);
  for (int pos = tid; pos < FN; pos += 512) {
    const int f = freq_of_pos(pos); const int pm = pos_of_freq((FN - f) & (FN - 1));
    const float2 A = X[PX(pos)], Bm = X[PX(pm)];
    const float2 K0 = make_float2((A.x + Bm.x) * s0, (A.y - Bm.y) * s0);
    const float2 K1 = make_float2((A.y + Bm.y) * s1, -(A.x - Bm.x) * s1);
    H01[pos] = make_uint2(pkc(K0), pkc(K1));
  }
}
DI void hyena_channel(int c, const float* __restrict__ hy_bias, const float* __restrict__ uT, float* __restrict__ zT, float* __restrict__ yT,
                      const uint2* __restrict__ H01_all, char* smem, TabJob& job) {
  float2* X = (float2*)smem;
  const uint2* H01 = H01_all + (size_t)c * FN;
  const int tid = TID;
  const float* v0p = uT + ((size_t)0 * 768 + c) * NT + CTX;
  const float* v1p = uT + ((size_t)1 * 768 + c) * NT + CTX;
  __syncthreads();
  for (int t = tid; t < SEQ; t += 512) { X[PX(t)] = make_float2(v0p[t], v1p[t]); X[PX(SEQ + t)] = make_float2(0.f, 0.f); }
  fft_fwd(X, job);
  for (int pos = tid; pos < FN; pos += 512) X[PX(pos)] = cmul(X[PX(pos)], upkc(H01[pos].x));
  fft_inv(X, job);
  {
    const float bias0 = hy_bias[c];
    const float* x10 = v0p + (size_t)256 * NT; const float* x11 = v1p + (size_t)256 * NT;
    float* z0 = zT + ((size_t)0 * 256 + c) * NT + CTX; float* z1 = zT + ((size_t)1 * 256 + c) * NT + CTX;
    for (int t = tid; t < SEQ; t += 512) {
      float2 y = X[PX(t)];
      float za = x10[t] * (y.x + bias0 * v0p[t]);
      float zb = x11[t] * (y.y + bias0 * v1p[t]);
      z0[t] = za; z1[t] = zb;
      X[PX(t)] = make_float2(za, zb);
    }
    __syncthreads();
    for (int t = tid; t < SEQ; t += 512) X[PX(SEQ + t)] = make_float2(0.f, 0.f);
  }
  fft_fwd(X, job);
  for (int pos = tid; pos < FN; pos += 512) X[PX(pos)] = cmul(X[PX(pos)], upkc(H01[pos].y));
  fft_inv(X, job);
  {
    const float bias1 = hy_bias[256 + c];
    const float* x20 = v0p + (size_t)512 * NT; const float* x21 = v1p + (size_t)512 * NT;
    const float* z0 = zT + ((size_t)0 * 256 + c) * NT + CTX; const float* z1 = zT + ((size_t)1 * 256 + c) * NT + CTX;
    float* y0 = yT + ((size_t)0 * 256 + c) * NT + CTX; float* y1 = yT + ((size_t)1 * 256 + c) * NT + CTX;
    for (int t = tid; t < SEQ; t += 512) {
      float2 y = X[PX(t)];
      y0[t] = x20[t] * (y.x + bias1 * z0[t]);
      y1[t] = x21[t] * (y.y + bias1 * z1[t]);
    }
  }
}

namespace pg8 {
#define PG8_LAS __attribute__((address_space(3)))
typedef ::bf16x8 bf16x8;
typedef float f32x4 __attribute__((ext_vector_type(4)));
typedef unsigned u32x4 __attribute__((ext_vector_type(4)));
constexpr int BM = 256, BK = 64, HALF = 128, HTB = HALF * BK * 2  , STAGE_BYTES = 8 * HTB, NXCD = 8, WGM = 8;

__host__ __device__ __forceinline__ int lds_byte(int r, int c) { const int st = (r >> 4) * 2 + (c >> 5), rr = r & 15, cc = c & 31, ob = rr * 64 + cc * 2; return st * 1024 + (ob ^ (((ob >> 9) & 1) << 5)); }
__host__ __device__ __forceinline__ void stage_rc(int b, int& R, int& C) { const int st = b / 1024, sb = b % 1024, swz = sb ^ (((sb >> 9) & 1) << 5); R = (st >> 1) * 16 + swz / 64; C = (st & 1) * 32 + (swz % 64) / 2; }
__host__ __device__ __forceinline__ int perm32(int rho) { const int n = rho >> 4, i = rho & 15; return 8 * (i >> 2) + 4 * n + (i & 3); }
struct Unit { int pm, pn; };
struct Gemm { const bf16_t* A; const bf16_t* Bt; int M, N, K; };
template <class Epi, class Sched, bool STAMP = false>
__device__ __forceinline__ void gemm_phase(PG8_LAS unsigned char* lds, const Gemm g, const Sched& S, const Epi& E, unsigned long long* stamps) {
    const int tid = TID, wid = __builtin_amdgcn_readfirstlane(tid >> 6), lane = tid & 63, wr = wid >> 2, wc = wid & 3, fr = lane & 15, fq = lane >> 4;
    const int K = g.K, nt = K / BK;
    int ts_lo = 0, ts_hi = 0, nts = 0; const unsigned long long rt_entry = STAMP ? (unsigned long long)wall_clock64() : 0ull;
#define PG8_STAMP() do { if (STAMP && wid == 0 && nts < 64) { const unsigned long long _c = (unsigned long long)clock64(); \
        ts_lo = (lane == nts) ? (int)(unsigned)_c : ts_lo; ts_hi = (lane == nts) ? (int)(unsigned)(_c >> 32) : ts_hi; ++nts; } } while (0)
    PG8_STAMP();
    unsigned voffA[2], voffB[2];
#pragma unroll
    for (int i = 0; i < 2; ++i) { int R, C; stage_rc(tid * 16 + i * 8192, R, C); const int Rb = Epi::PERM ? ((R & ~31) + perm32(R & 31)) : R;
        voffA[i] = (unsigned)(R * K + C) * 2u; voffB[i] = (unsigned)(Rb * K + C) * 2u; }
    const size_t kstep = (size_t)(BK * 2);
    const size_t hstep = (size_t)HALF * K * 2;
    const size_t tstep = 2 * hstep;
    const unsigned ldsw = (unsigned)wid * 1024u;
    const int aoff = lds_byte(wr * 64 + fr, fq * 8), boff = lds_byte(wc * 32 + fr, fq * 8);
#define PG8_SA(b, h) (((b) * 2 + (h)) * HTB)
#define PG8_SB(b, h) ((4 + (b) * 2 + (h)) * HTB)
#define PG8_STAGE(bufoff, gbase, voff) do { _Pragma("unroll") for (int _i = 0; _i < 2; ++_i) \
        __builtin_amdgcn_global_load_lds((const unsigned*)((const char*)(gbase) + (voff)[_i]), (PG8_LAS unsigned*)(lds + (bufoff) + ldsw + _i * 8192), 16, 0, 0); } while (0)
#define PG8_LDA(dst, b, h) do { _Pragma("unroll") for (int m = 0; m < 4; ++m) _Pragma("unroll") for (int k = 0; k < 2; ++k) dst[m][k] = *(const PG8_LAS bf16x8*)(lds + PG8_SA(b, h) + aoff + m * 2048 + k * 1024); } while (0)
#define PG8_LDB(dst, b, h) do { _Pragma("unroll") for (int n = 0; n < 2; ++n) _Pragma("unroll") for (int k = 0; k < 2; ++k) dst[n][k] = *(const PG8_LAS bf16x8*)(lds + PG8_SB(b, h) + boff + n * 2048 + k * 1024); } while (0)
#define PG8_MMA(ai, bj, At, Bt) do { __builtin_amdgcn_s_setprio(1); _Pragma("unroll") for (int m = 0; m < 4; ++m) _Pragma("unroll") for (int n = 0; n < 2; ++n) _Pragma("unroll") for (int k = 0; k < 2; ++k) \
        acc[ai][bj][m][n] = __builtin_amdgcn_mfma_f32_16x16x32_bf16(Bt[n][k], At[m][k], acc[ai][bj][m][n], 0, 0, 0); __builtin_amdgcn_s_setprio(0); } while (0)
#define PG8_WAIT_V(n) asm volatile("s_waitcnt vmcnt(" #n ")" ::: "memory")
#define PG8_WAIT_L(n) asm volatile("s_waitcnt lgkmcnt(" #n ")" ::: "memory")
#define PG8_BAR __builtin_amdgcn_s_barrier()
#define PG8_SCHED __builtin_amdgcn_sched_barrier(0)
    Unit cur, nxt; int ui = 0;
    if (!S.next(0, cur)) return;
    f32x4 acc[2][2][4][2];
#pragma unroll
    for (int a = 0; a < 2; ++a)
#pragma unroll
        for (int b = 0; b < 2; ++b)
#pragma unroll
            for (int m = 0; m < 4; ++m)
#pragma unroll
                for (int n = 0; n < 2; ++n) acc[a][b][m][n] = (f32x4){0.f, 0.f, 0.f, 0.f};
    bf16x8 At[4][2], B0[2][2], B1[2][2];
    const char* cA = (const char*)g.A + (size_t)cur.pm * tstep; const char* cB = (const char*)g.Bt + (size_t)cur.pn * tstep;
    S.a_ready(cur);
    PG8_STAGE(PG8_SB(0, 0), cB, voffB); PG8_STAGE(PG8_SA(0, 0), cA, voffA); PG8_STAGE(PG8_SB(0, 1), cB + hstep, voffB); PG8_STAGE(PG8_SA(0, 1), cA + hstep, voffA);
    if (wr == 1) PG8_BAR;
    PG8_WAIT_V(4); PG8_BAR;
    PG8_STAGE(PG8_SB(1, 0), cB + kstep, voffB); PG8_STAGE(PG8_SA(1, 0), cA + kstep, voffA); PG8_STAGE(PG8_SB(1, 1), cB + hstep + kstep, voffB);
    PG8_WAIT_V(6); PG8_BAR;
    PG8_STAMP();
    for (;;) {
        const bool has_next = S.next(ui + 1, nxt);
        const char* nA = has_next ? (const char*)g.A + (size_t)nxt.pm * tstep : cA; const char* nB = has_next ? (const char*)g.Bt + (size_t)nxt.pn * tstep : cB;
        for (int t = 0; t < nt; t += 2) {
            const bool last = (t == nt - 2);
            const char* a1 = cA + (size_t)(t + 1) * kstep;
            const char* a2 = last ? nA : cA + (size_t)(t + 2) * kstep; const char* b2 = last ? nB : cB + (size_t)(t + 2) * kstep;
            const char* a3 = a2 + kstep; const char* b3 = b2 + kstep;
            if (last && has_next) S.a_ready(nxt);
            PG8_LDB(B0, 0, 0); PG8_SCHED; PG8_LDA(At, 0, 0); PG8_STAGE(PG8_SA(1, 1), a1 + hstep, voffA);
            PG8_WAIT_L(8); PG8_BAR; PG8_WAIT_L(0); PG8_MMA(0, 0, At, B0); PG8_BAR; PG8_SCHED;
            PG8_LDB(B1, 0, 1); PG8_STAGE(PG8_SB(0, 0), b2, voffB);
            PG8_BAR; PG8_WAIT_L(0); PG8_MMA(0, 1, At, B1); PG8_BAR;
            PG8_LDA(At, 0, 1); PG8_STAGE(PG8_SA(0, 0), a2, voffA);
            PG8_BAR; PG8_WAIT_L(0); PG8_MMA(1, 0, At, B0); PG8_BAR; PG8_SCHED;
            PG8_STAGE(PG8_SB(0, 1), b2 + hstep, voffB);
            PG8_WAIT_V(6); PG8_BAR; PG8_MMA(1, 1, At, B1); PG8_BAR;
            PG8_LDB(B0, 1, 0); PG8_SCHED; PG8_LDA(At, 1, 0); PG8_STAGE(PG8_SA(0, 1), a2 + hstep, voffA);
            PG8_WAIT_L(8); PG8_BAR; PG8_WAIT_L(0); PG8_MMA(0, 0, At, B0); PG8_BAR; PG8_SCHED;
            PG8_LDB(B1, 1, 1); PG8_STAGE(PG8_SB(1, 0), b3, voffB);
            PG8_BAR; PG8_WAIT_L(0); PG8_MMA(0, 1, At, B1); PG8_BAR;
            PG8_LDA(At, 1, 1); PG8_STAGE(PG8_SA(1, 0), a3, voffA);
            PG8_BAR; PG8_WAIT_L(0); PG8_MMA(1, 0, At, B0); PG8_BAR; PG8_SCHED;
            PG8_STAGE(PG8_SB(1, 1), b3 + hstep, voffB);
            PG8_WAIT_V(6); PG8_BAR; PG8_MMA(1, 1, At, B1); PG8_BAR;
        }
        PG8_STAMP();
        if constexpr (!Epi::AFTER_DRAIN) { E(acc, cur, wr, wc, fr, fq); S.done(cur); }
        PG8_STAMP();
        if (!has_next) break;
#pragma unroll
        for (int a = 0; a < 2; ++a)
#pragma unroll
            for (int b = 0; b < 2; ++b)
#pragma unroll
                for (int m = 0; m < 4; ++m)
#pragma unroll
                    for (int n = 0; n < 2; ++n) acc[a][b][m][n] = (f32x4){0.f, 0.f, 0.f, 0.f};
        cur = nxt; cA = nA; cB = nB; ++ui;
    }
    PG8_WAIT_V(0);
    if (wr == 0) PG8_BAR;
    PG8_BAR;
    if constexpr (Epi::AFTER_DRAIN) { E.fused(acc, cur, wr, wc, fr, fq, lds, wid, lane); S.done(cur); }
    PG8_STAMP();
    if (STAMP && wid == 0) { stamps[lane] = lane < nts ? (((unsigned long long)(unsigned)ts_hi << 32) | (unsigned)ts_lo) : 0ull;
        if (lane == 62) stamps[62] = rt_entry; if (lane == 63) stamps[63] = (unsigned long long)wall_clock64(); }
#undef PG8_STAMP
#undef PG8_SA
#undef PG8_SB
#undef PG8_STAGE
#undef PG8_LDA
#undef PG8_LDB
#undef PG8_MMA
#undef PG8_WAIT_V
#undef PG8_WAIT_L
#undef PG8_BAR
#undef PG8_SCHED
}
}

#ifndef GEMM_WGM
#define GEMM_WGM 4
#endif
struct MySched {
  int nN, nunits, G, c; bool latent_only;
  DI void init(int N, bool lat_only, int G_, int c_) { nN = N / 256; latent_only = lat_only; nunits = (lat_only ? 64 : 66) * nN; G = G_; c = c_; }
  DI bool next(int i, pg8::Unit& u) const {
    const int L = i * G + c; if (L >= nunits) return false;
    const int nM = latent_only ? 64 : 66;
    int wgid = L;
    { const int q = nunits / 8, r = nunits % 8, xcd = wgid % 8, off = wgid / 8; wgid = (xcd < r ? xcd * (q + 1) : r * (q + 1) + (xcd - r) * q) + off; }
    const int nig = GEMM_WGM * nN, gid = wgid / nig, fm = gid * GEMM_WGM, gsz = (nM - fm) < GEMM_WGM ? (nM - fm) : GEMM_WGM;
    const int ri = fm + ((wgid % nig) % gsz);
    u.pn = (wgid % nig) / gsz;
    u.pm = latent_only ? (ri / 32) * 33 + 1 + (ri % 32) : ri;
    return true;
  }
  DI void a_ready(const pg8::Unit&) const {}
  DI void done(const pg8::Unit&) const {}
};
struct EpiStoreBf16 {
  static constexpr bool PERM = true, AFTER_DRAIN = false;
  bf16_t* Cb; int ldc;
  DI void operator()(const pg8::f32x4 (&acc)[2][2][4][2], const pg8::Unit& u, int wr, int wc, int fr, int fq) const {
    const int row0 = u.pm * 256 + wr * 64 + fr, col0 = u.pn * 256 + wc * 32 + 8 * fq;
#pragma unroll
    for (int ai = 0; ai < 2; ++ai)
#pragma unroll
      for (int m = 0; m < 4; ++m) {
        bf16_t* rowp = Cb + (size_t)(row0 + ai * 128 + m * 16) * ldc + col0;
#pragma unroll
        for (int bj = 0; bj < 2; ++bj) {
          const pg8::f32x4 v0 = acc[ai][bj][m][0], v1 = acc[ai][bj][m][1];
          *(uint4*)(rowp + bj * 128) = make_uint4(pk2bf(v0[0], v0[1]), pk2bf(v0[2], v0[3]), pk2bf(v1[0], v1[1]), pk2bf(v1[2], v1[3]));
        }
      }
  }
};
struct EpiResidual {
  static constexpr bool PERM = true, AFTER_DRAIN = false;
  float* xs; const float* gate_base; const float* xin; const float* ctxin;
  DI void operator()(const pg8::f32x4 (&acc)[2][2][4][2], const pg8::Unit& u, int wr, int wc, int fr, int fq) const {
    const int row0 = u.pm * 256 + wr * 64 + fr, col0 = u.pn * 256 + wc * 32 + 8 * fq;
    const int b = u.pm / 33; const int mrow = (u.pm % 33) == 0 ? 2 : b;
    const int pt = (u.pm % 33) * 256 + wr * 64 + fr;
    const float* gt = gate_base + mrow * NMOD + col0;
#pragma unroll
    for (int ai = 0; ai < 2; ++ai)
#pragma unroll
      for (int m = 0; m < 4; ++m) {
        float* rowp = xs + (size_t)(row0 + ai * 128 + m * 16) * D + col0;
        const int pp = pt + ai * 128 + m * 16;
        const float* srcp = xin ? (pp < CTX ? ctxin + ((size_t)b * CTX + pp) * D + col0 : xin + ((size_t)b * SEQ + (pp - CTX)) * D + col0) : rowp;
#pragma unroll
        for (int bj = 0; bj < 2; ++bj)
#pragma unroll
          for (int n = 0; n < 2; ++n) {
            const pg8::f32x4 v = acc[ai][bj][m][n];
            const float4 g4 = *(const float4*)(gt + bj * 128 + n * 4);
            float4 xv = *(const float4*)(srcp + bj * 128 + n * 4);
            xv.x += g4.x * v[0]; xv.y += g4.y * v[1]; xv.z += g4.z * v[2]; xv.w += g4.w * v[3];
            *(float4*)(rowp + bj * 128 + n * 4) = xv;
          }
      }
  }
};

#define XB_TMO      128
#define XB_XCNT(j)  (256  + 64 * (j))
#define XB_XSUB(j)  (1280 + 64 * (j))
#define XB_XGEN(j)  (2304 + 64 * (j))
#define XB_TOP      3328
#define XB_TOPGEN   3392
#define XB_SPIN_CAP (1u << 22)
DI unsigned xb_ld(unsigned* p) { return __hip_atomic_load(p, __ATOMIC_RELAXED, __HIP_MEMORY_SCOPE_AGENT); }
DI unsigned xb_add(unsigned* p, unsigned v) { return __hip_atomic_fetch_add(p, v, __ATOMIC_RELAXED, __HIP_MEMORY_SCOPE_AGENT); }
DI unsigned xb_xcc_id() { return (unsigned)__builtin_amdgcn_s_getreg((3 << 11) | 20) & 0xFu; }
#define XB_SPIN(cond, bar) do { unsigned _sp = 0; while (cond) { __builtin_amdgcn_s_sleep(1); \
    if ((++_sp & 255u) == 0u) { if (xb_ld(&(bar)[XB_TMO])) break; if (_sp > XB_SPIN_CAP) { atomicAdd(&(bar)[XB_TMO], 1u); break; } } } } while (0)
DI void xcd_barrier_post(unsigned* bar, volatile LAS unsigned* st) {
  if (threadIdx.x == 0) { const unsigned x = xb_xcc_id(); st[3] = x; st[2] = xb_add(&bar[XB_XCNT(x)], 1u); }
}
DI void xcd_barrier_complete(unsigned* bar, unsigned x, unsigned& nloc, unsigned& nx) {
  const unsigned G = gridDim.x;
  unsigned sum, cnt, mine, sp = 0u;
  for (;;) {
    sum = 0u; cnt = 0u; mine = 0u;
#pragma unroll
    for (unsigned j = 0; j < 16; ++j) { const unsigned c = xb_ld(&bar[XB_XCNT(j)]); sum += c; cnt += (c > 0u) ? 1u : 0u; mine = (j == x) ? c : mine; }
    if (sum == G) break;
    __builtin_amdgcn_s_sleep(1);
    if ((++sp & 255u) == 0u) { if (xb_ld(&bar[XB_TMO])) break; if (sp > XB_SPIN_CAP) { atomicAdd(&bar[XB_TMO], 1u); break; } }
  }
  nloc = mine > 0u ? mine : 1u; nx = cnt > 0u ? cnt : 1u;
}
DI void xcd_barrier(unsigned* bar, volatile LAS unsigned* st) {
  asm volatile("s_waitcnt vmcnt(0)" ::: "memory");
  __syncthreads();
  if (threadIdx.x == 0) {
    const unsigned x = xb_xcc_id();
    __builtin_amdgcn_s_waitcnt(0);
    unsigned nloc = st[0], nx = st[1];
    if (nloc == 0u) { xcd_barrier_complete(bar, x, nloc, nx); st[0] = nloc; st[1] = nx; }
    const unsigned old = xb_add(&bar[XB_XSUB(x)], 1u);
    const unsigned gen = old / nloc;
    if (old + 1u == (gen + 1u) * nloc) {
      __builtin_amdgcn_fence(__ATOMIC_RELEASE, "agent");
      asm volatile("s_waitcnt vmcnt(0)" ::: "memory");
      const unsigned og = xb_add(&bar[XB_TOP], 1u);
      const unsigned tg = og / nx;
      if (og + 1u == (tg + 1u) * nx) xb_add(&bar[XB_TOPGEN], 1u);
      else XB_SPIN(xb_ld(&bar[XB_TOPGEN]) == tg, bar);
      __builtin_amdgcn_fence(__ATOMIC_ACQUIRE, "agent");
      xb_add(&bar[XB_XGEN(x)], 1u);
      asm volatile("s_waitcnt vmcnt(0)" ::: "memory");
    } else {
      XB_SPIN(xb_ld(&bar[XB_XGEN(x)]) == gen, bar);
      __builtin_amdgcn_fence(__ATOMIC_ACQUIRE, "agent");
      asm volatile("s_waitcnt vmcnt(0)" ::: "memory");
    }
  }
  __syncthreads();
}

#define XCD_BAR_WORDS 3456
constexpr size_t al256(size_t x) { return (x + 255) & ~(size_t)255; }
constexpr size_t OFF_modv = 0;
constexpr size_t OFF_xs = al256(OFF_modv + (size_t)2 * 3 * NMOD * 4);
constexpr size_t OFF_hbuf = al256(OFF_xs + (size_t)R * D * 4);
constexpr size_t OFF_P = al256(OFF_hbuf + (size_t)R * D * 2);
constexpr size_t OFF_Wt_in = al256(OFF_P + (size_t)R * DIN * 2);
constexpr size_t OFF_Wt_out = al256(OFF_Wt_in + (size_t)2 * DIN * D * 2);
constexpr size_t OFF_Wt_q = al256(OFF_Wt_out + (size_t)2 * D * D * 2);
constexpr size_t OFF_QA = al256(OFF_Wt_q + (size_t)2 * 2048 * D * 2);
constexpr size_t OFF_KA = al256(OFF_QA + (size_t)NB * 8 * NT * 32 * 2);
constexpr size_t OFF_VAt = al256(OFF_KA + (size_t)NB * 8 * NT * 32 * 2);
constexpr size_t OFF_QW = al256(OFF_VAt + (size_t)NB * 4 * 64 * NT * 2);
constexpr size_t OFF_KW = al256(OFF_QW + (size_t)NB * 4 * NT * 64 * 2);
constexpr size_t OFF_VWt = al256(OFF_KW + (size_t)NB * 2 * NT * 64 * 2);
constexpr size_t OFF_QG = al256(OFF_VWt + (size_t)NB * 2 * 64 * NT * 2);
constexpr size_t OFF_KG = al256(OFF_QG + (size_t)NB * 4 * NT * 64 * 2);
constexpr size_t OFF_VGt = al256(OFF_KG + (size_t)NB * 2 * NT * 64 * 2);
constexpr size_t OFF_uT = al256(OFF_VGt + (size_t)NB * 2 * 64 * NT * 2);
constexpr size_t OFF_zT = al256(OFF_uT + (size_t)NB * 768 * NT * 4);
constexpr size_t OFF_yT = al256(OFF_zT + (size_t)NB * 256 * NT * 4);
constexpr size_t OFF_hdn2 = al256(OFF_yT + (size_t)NB * 256 * NT * 4);
constexpr size_t OFF_Hc = al256(OFF_hdn2 + (size_t)2 * NT * 64 * 4);
constexpr size_t OFF_A2 = al256(OFF_Hc + (size_t)256 * 2 * SEQ * 8);
constexpr size_t OFF_u8 = al256(OFF_A2 + (size_t)R * D * 2);
constexpr size_t OFF_v8 = al256(OFF_u8 + (size_t)2 * 16384 * D);
constexpr size_t OFF_us = al256(OFF_v8 + (size_t)2 * 16384 * D);
constexpr size_t OFF_vs = al256(OFF_us + (size_t)2 * 16384 * 4);
constexpr size_t OFF_keysb = al256(OFF_vs + (size_t)2 * 16384 * 4);
constexpr size_t OFF_bar = al256(OFF_keysb + (size_t)2 * 16 * 128 * 128 * 2);
constexpr size_t OFF_hdnB = al256(OFF_bar + (size_t)XCD_BAR_WORDS * 4);
constexpr size_t OFF_W3t = al256(OFF_hdnB + (size_t)2 * SEQ * 64 * 2);
constexpr size_t WS_TOTAL = al256(OFF_W3t + (size_t)2 * 1024 * 64 * 2);
constexpr size_t OFF_topv = OFF_uT;
constexpr size_t OFF_topi = OFF_topv + (size_t)R * 256 * 4;
constexpr size_t OFF_experts = OFF_topi + (size_t)R * 256;
constexpr size_t OFF_gates = OFF_experts + (size_t)R * 128 * 4;
constexpr size_t OFF_xq = OFF_A2;
constexpr size_t OFF_xqs = OFF_xq + (size_t)R * D;
constexpr size_t OFF_wsc = OFF_xqs + (size_t)R * 4;
static_assert(OFF_wsc + (size_t)R * 4 <= OFF_u8, "xq overflows A2");
constexpr size_t OFF_Oslab = OFF_P;
constexpr size_t OFF_Lslab = OFF_Oslab + (size_t)2 * NB * 4 * NT * 64 * 4;
static_assert(OFF_gates + (size_t)R * 128 * 4 <= OFF_zT, "routing buffers overflow uT");
static_assert(OFF_Lslab + (size_t)2 * NB * 4 * NT * 4 <= OFF_Wt_in, "slabs overflow P");

struct MKView;
struct MK {
  const float *x, *c, *ctx, *c_ctx, *w_mod, *b_mod, *g_norm_mix, *w_in, *g_qk_diff, *lambda_diff, *g_qk_win, *sink_win, *g_qk_glob, *hy_conv_w,
      *hy_conv_b, *hy_w1, *hy_b1, *hy_w2, *hy_b2, *hy_w3, *hy_b3, *hy_freq, *hy_bias, *g_mix_out, *w_out, *g_norm_ffn, *peer_wq, *peer_keys,
      *peer_u, *peer_v;
  float* out;
  char* ws;
};
constexpr int SMEM_BYTES = (FN + (FN >> 6) * 4) * 8 + 2048;
typedef const MK __attribute__((address_space(4))) * MKP;
DI MK launder_mk(MKP a) {
  asm volatile("" : "+s"(a));
  MK r;
  r.x = a->x; r.c = a->c; r.ctx = a->ctx; r.c_ctx = a->c_ctx; r.w_mod = a->w_mod; r.b_mod = a->b_mod;
  r.g_norm_mix = a->g_norm_mix; r.w_in = a->w_in; r.g_qk_diff = a->g_qk_diff; r.lambda_diff = a->lambda_diff;
  r.g_qk_win = a->g_qk_win; r.sink_win = a->sink_win; r.g_qk_glob = a->g_qk_glob; r.hy_conv_w = a->hy_conv_w;
  r.hy_conv_b = a->hy_conv_b; r.hy_w1 = a->hy_w1; r.hy_b1 = a->hy_b1; r.hy_w2 = a->hy_w2; r.hy_b2 = a->hy_b2;
  r.hy_w3 = a->hy_w3; r.hy_b3 = a->hy_b3; r.hy_freq = a->hy_freq; r.hy_bias = a->hy_bias; r.g_mix_out = a->g_mix_out;
  r.w_out = a->w_out; r.g_norm_ffn = a->g_norm_ffn; r.peer_wq = a->peer_wq; r.peer_keys = a->peer_keys;
  r.peer_u = a->peer_u; r.peer_v = a->peer_v; r.out = a->out; r.ws = a->ws;
  return r;
}

DI void ph_mod_item(const MK& m, int item, char* smem) {
  float* sc = (float*)smem;
  float* part = sc + 3 * D;
  const int tid = TID, lane = tid & 63, wv = tid >> 6;
  const int l = item / 96, chunk = item % 96;
  __syncthreads();
  for (int i = tid; i < 3 * D; i += NTHR) {
    int row = i / D, k = i % D;
    float v = row < 2 ? m.c[row * D + k] : m.c_ctx[k];
    sc[i] = v / (1.f + __expf(-v));
  }
  __syncthreads();
  const int col = chunk * 64 + lane;
  const float* w = m.w_mod + (size_t)l * D * NMOD + (size_t)(wv * 128) * NMOD + col;
  float a0 = 0, a1 = 0, a2 = 0;
#pragma unroll 8
  for (int k = 0; k < 128; ++k) {
    float wvv = w[(size_t)k * NMOD];
    a0 += sc[wv * 128 + k] * wvv; a1 += sc[D + wv * 128 + k] * wvv; a2 += sc[2 * D + wv * 128 + k] * wvv;
  }
  part[(wv * 3 + 0) * 64 + lane] = a0; part[(wv * 3 + 1) * 64 + lane] = a1; part[(wv * 3 + 2) * 64 + lane] = a2;
  __syncthreads();
  if (tid < 192) {
    const int row = tid >> 6;
    float sacc = 0.f;
    for (int q = 0; q < 8; ++q) sacc += part[(q * 3 + row) * 64 + lane];
    ((float*)(m.ws + OFF_modv))[(l * 3 + row) * NMOD + col] = sacc + m.b_mod[l * NMOD + col];
  }
}
DI void ph_hymlp_group(const MK& m, int g, char* smem) {
  const int tid = TID, wv = tid >> 6, u = tid & 63;
  float* feat = (float*)smem + wv * 128;
  float* h1 = feat + 64;
  const int gi = g * 8 + wv;
  const int l = gi / NT, pos = gi % NT;
  const int which = pos >= SEQ ? 1 : 0;
  const int j = which ? pos - SEQ : pos;
  const int n = which ? CTX : SEQ;
  const float tt = (float)j / (float)(n - 1);
  const float w = (6.283185307179586f / (float)n) * (float)j;
  __syncthreads();
  if (u == 0) feat[0] = tt;
  if (u < 16) {
    float f = 1e-4f + (float)u * ((15.f - 1e-4f) / 15.f);
    feat[1 + u] = cosf(f * w);
    feat[17 + u] = -sinf(f * w);
  }
  __syncthreads();
  const float* w1 = m.hy_w1 + l * 33 * 64; const float* w2 = m.hy_w2 + l * 64 * 64;
  const float fq = m.hy_freq[l * 64 + u];
  float a = m.hy_b1[l * 64 + u];
  for (int i = 0; i < 33; ++i) a += feat[i] * w1[i * 64 + u];
  h1[u] = sinf(fq * a);
  __syncthreads();
  float a2 = m.hy_b2[l * 64 + u];
  for (int i = 0; i < 64; ++i) a2 += h1[i] * w2[i * 64 + u];
  const float hv2 = sinf(fq * a2);
  ((float*)(m.ws + OFF_hdn2))[((size_t)l * 64 + u) * NT + pos] = hv2;
  if (!which) ((bf16_t*)(m.ws + OFF_hdnB))[(size_t)l * SEQ * 64 + (size_t)(pos >> 5) * 2048 + (u >> 4) * 512 + (((u >> 3) & 1) * 32 + (pos & 31)) * 8 + (u & 7)] = f2bf(hv2);
}
DI void phase0(MKP m_in, char* smem) {
  const MK m = launder_mk(m_in);
  const int bid = BID, nb = NBLK, tid = TID;
  for (int it = bid; it < 192; it += nb) ph_mod_item(m, it, smem);
  for (int g = bid; g < 2 * NT / 8; g += nb) ph_hymlp_group(m, g, smem);
  for (int t = bid; t < 2 * 1408; t += nb) {
    int l = t / 1408, tt = t % 1408;
    if (tt < 640) wconv_tile(m.w_in + (size_t)l * D * DIN, ((bf16_t*)(m.ws + OFF_Wt_in)) + (size_t)l * DIN * D, DIN, tt, (float*)smem);
    else if (tt < 896) wconv_tile(m.w_out + (size_t)l * D * D, ((bf16_t*)(m.ws + OFF_Wt_out)) + (size_t)l * D * D, D, tt - 640, (float*)smem);
    else wconv_tile(m.peer_wq + (size_t)l * D * 2048, ((bf16_t*)(m.ws + OFF_Wt_q)) + (size_t)l * 2048 * D, 2048, tt - 896, (float*)smem);
  }
  for (int i = bid * NTHR + tid; i < 2 * 16 * 128 * 128 / 4; i += nb * NTHR) {
    float4 v = ((const float4*)m.peer_keys)[i];
    ((uint2*)((bf16_t*)(m.ws + OFF_keysb)))[i] = make_uint2(pk2bf(v.x, v.y), pk2bf(v.z, v.w));
  }
  for (int i = bid * NTHR + tid; i < 2 * 1024 * 64; i += nb * NTHR) {
    const int l = i >> 16, n = (i >> 6) & 1023, k = i & 63;
    ((bf16_t*)(m.ws + OFF_W3t))[i] = f2bf(m.hy_w3[((size_t)l * 64 + k) * 1024 + n]);
  }
}

DI void phase_norm(MKP m_in, int l, int which  , bool first, bool skip_ctx) {
  const MK m = launder_mk(m_in);
  const int tid = TID, lane = tid & 63;
  const int gw = BID * 8 + (tid >> 6), nw = NBLK * 8;
  const float* g = (which ? m.g_norm_ffn : m.g_norm_mix) + l * D;
  const float* modv_l = ((float*)(m.ws + OFF_modv)) + (size_t)l * 3 * NMOD;
  for (int r = gw; r < R; r += nw) {
    const int b = r / NT, p = r % NT;
    if (skip_ctx && p < CTX) continue;
    const int mrow = p < CTX ? 2 : b;
    const float4* src = (const float4*)(first ? (p < CTX ? m.ctx + ((size_t)b * CTX + p) * D : m.x + ((size_t)b * SEQ + (p - CTX)) * D)
                                              : ((float*)(m.ws + OFF_xs)) + (size_t)r * D);
    float4 v[4];
    float ss = 0.f;
#pragma unroll
    for (int i = 0; i < 4; ++i) { v[i] = src[lane + 64 * i]; ss += v[i].x * v[i].x + v[i].y * v[i].y + v[i].z * v[i].z + v[i].w * v[i].w; }
    for (int o = 32; o > 0; o >>= 1) ss += shxl(ss, lane, o);
    const float rs = rsqrtf(ss * (1.f / D) + EPS);
    const float* sh = modv_l + mrow * NMOD + (which ? 3 : 0) * D;
    const float* sc = sh + D;
#pragma unroll
    for (int i = 0; i < 4; ++i) {
      const int c0 = (lane + 64 * i) * 4;
      float4 gg = *(const float4*)(g + c0), s4 = *(const float4*)(sc + c0), h4 = *(const float4*)(sh + c0);
      float o0 = v[i].x * rs * gg.x * (1.f + s4.x) + h4.x, o1 = v[i].y * rs * gg.y * (1.f + s4.y) + h4.y;
      float o2 = v[i].z * rs * gg.z * (1.f + s4.z) + h4.z, o3 = v[i].w * rs * gg.w * (1.f + s4.w) + h4.w;
      *(uint2*)(((bf16_t*)(m.ws + OFF_hbuf)) + (size_t)r * D + c0) = make_uint2(pk2bf(o0, o1), pk2bf(o2, o3));
      v[i] = make_float4(o0, o1, o2, o3);
    }
    if (which) {
      float mx = 0.f;
#pragma unroll
      for (int i = 0; i < 4; ++i) mx = fmaxf(mx, fmaxf(fmaxf(fabsf(v[i].x), fabsf(v[i].y)), fmaxf(fabsf(v[i].z), fabsf(v[i].w))));
      for (int o = 32; o > 0; o >>= 1) mx = fmaxf(mx, shxl(mx, lane, o));
      mx = fmaxf(mx, 1e-30f);
      const float inv = 127.f / mx;
      *(uint4*)(((unsigned char*)(m.ws + OFF_xq)) + (size_t)r * D + lane * 16) =
          make_uint4(pack_i8x4(v[0].x * inv, v[0].y * inv, v[0].z * inv, v[0].w * inv), pack_i8x4(v[1].x * inv, v[1].y * inv, v[1].z * inv, v[1].w * inv),
                     pack_i8x4(v[2].x * inv, v[2].y * inv, v[2].z * inv, v[2].w * inv), pack_i8x4(v[3].x * inv, v[3].y * inv, v[3].z * inv, v[3].w * inv));
      if (lane == 0) ((float*)(m.ws + OFF_xqs))[r] = mx * (1.f / 127.f);
    }
  }
}

DI int rowtile_of(int i, bool latent_only) { return latent_only ? (i / 64) * 66 + 2 + (i % 64) : i; }
template <int EPI>
DI void phase_gemm(const bf16_t* A, const bf16_t* Wt, int N, bf16_t* Cb, float* xs, const float* gate_base, bool latent_only, char* smem) {
  const int nt_n = N / 128, nrt = latent_only ? 128 : 132, ntiles = nrt * nt_n;
  for (int t = BID; t < ntiles; t += NBLK) {
    int tm = rowtile_of(t / nt_n, latent_only), tn = t % nt_n;
    gemm_tile<EPI>(A, Wt, N, tm * 128, tn * 128, smem, Cb, xs, gate_base);
  }
}

DI void rope_pair8(float (&y)[8], const float (&part)[8], bool upper, const float* cs, const float* sn, int dd0) {
#pragma unroll
  for (int e = 0; e < 8; ++e) {
    float c = cs[dd0 + e], s = sn[dd0 + e];
    float x1 = upper ? part[e] : y[e], x2 = upper ? y[e] : part[e];
    y[e] = upper ? (x1 * s + x2 * c) : (x1 * c - x2 * s);
  }
}
DI void unpack8(uint4 w, float (&v)[8]) {
  v[0] = bflo(w.x); v[1] = bfhi(w.x); v[2] = bflo(w.y); v[3] = bfhi(w.y); v[4] = bflo(w.z); v[5] = bfhi(w.z); v[6] = bflo(w.w); v[7] = bfhi(w.w);
}
DI uint4 pack8(const float (&v)[8], float sc) {
  return make_uint4(pk2bf(v[0] * sc, v[1] * sc), pk2bf(v[2] * sc, v[3] * sc), pk2bf(v[4] * sc, v[5] * sc), pk2bf(v[6] * sc, v[7] * sc));
}
constexpr int VS_STRIDE = 1032;
constexpr int HS_STRIDE = 1552;
DI void prep_tile(MKP m_in, int l, int tile, char* smem) {
  const MK m = launder_mk(m_in);
  const int tid = TID, lane = tid & 63, wid = tid >> 6;
  const int r0 = tile * 32; const int b = r0 / NT, p0 = r0 % NT;
  const bool lat = p0 >= CTX;
  char* Vs = smem;
  char* Hs = smem + 33280;
  float* csh = (float*)(smem + 33280 + 34 * HS_STRIDE);
  const bf16_t* Pb = ((bf16_t*)(m.ws + OFF_P)) + (size_t)(b * NT) * DIN;
  __syncthreads();
  if (lat) {
    for (int i = tid; i < 32 * 48; i += NTHR) {
      int rr = i / 48, a = i % 48;
      int t = p0 + rr - CTX;
      float trow = (float)(t / 64), tcol = (float)(t % 64);
      float* rowp = csh + rr * 96;
      if (a < 16) {
        int j = a & 7; float f = exp2f(-(float)j * (13.287712379549449f / 8.f));
        float ang = (a < 8 ? trow : tcol) * f;
        rowp[a] = cosf(ang); rowp[16 + a] = sinf(ang);
      } else {
        int aa = a - 16; int j = aa & 15; float f = exp2f(-(float)j * (13.287712379549449f / 16.f));
        float ang = (aa < 16 ? trow : tcol) * f;
        rowp[32 + aa] = cosf(ang); rowp[64 + aa] = sinf(ang);
      }
    }
  }
  {
    const int seg_lo = lat ? CTX : 0, seg_hi = lat ? NT : CTX;
    for (int ch = tid; ch < 34 * 96; ch += NTHR) {
      int rr = ch / 96, c8 = ch % 96;
      int p = p0 - 1 + rr;
      uint4 v = make_uint4(0, 0, 0, 0);
      if (p >= seg_lo && p < seg_hi) v = *(const uint4*)(Pb + (size_t)p * DIN + 1792 + c8 * 8);
      *(uint4*)(Hs + rr * HS_STRIDE + c8 * 16) = v;
    }
  }
  __syncthreads();
  const float* gd = m.g_qk_diff + l * 64; const float* gwn = m.g_qk_win + l * 128; const float* gg = m.g_qk_glob + l * 128;
#pragma unroll
  for (int k = 0; k < 4; ++k) {
    const int rr = wid + 8 * k; const int p = p0 + rr;
    const bf16_t* Pr = Pb + (size_t)p * DIN;
    const float* rowp = csh + rr * 96;
    {
      float y[8], part[8];
      unpack8(*(const uint4*)(Pr + 8 * lane), y);
      float ss = 0.f;
#pragma unroll
      for (int e = 0; e < 8; ++e) ss += y[e] * y[e];
      ss += shxl(ss, lane, 1); ss += shxl(ss, lane, 2);
      const float rs = rsqrtf(ss * (1.f / 32) + EPS);
      const int unit = lane >> 2; const bool isk = unit >= 8; const int vh = unit & 7;
      const int d0 = (lane & 3) * 8;
      const float* gn = gd + (isk ? 32 : 0) + d0;
#pragma unroll
      for (int e = 0; e < 8; ++e) y[e] = y[e] * rs * gn[e];
      if (lat) {
#pragma unroll
        for (int e = 0; e < 8; ++e) part[e] = shxl(y[e], lane, 2);
        rope_pair8(y, part, (lane & 2) != 0, rowp, rowp + 16, (lane & 1) * 8);
      }
      bf16_t* dst = (isk ? ((bf16_t*)(m.ws + OFF_KA)) : ((bf16_t*)(m.ws + OFF_QA))) + (((size_t)b * 8 + vh) * NT + p) * 32 + d0;
      *(uint4*)dst = pack8(y, isk ? 1.f : 0.17677669529663687f * LOG2E);
    }
#pragma unroll
    for (int grp = 0; grp < 2; ++grp) {
      float y[8], part[8];
      const int cbase = grp == 0 ? 768 : 1280;
      uint4 w = make_uint4(0, 0, 0, 0);
      if (lane < 48) w = *(const uint4*)(Pr + cbase + 8 * lane);
      unpack8(w, y);
      float ss = 0.f;
#pragma unroll
      for (int e = 0; e < 8; ++e) ss += y[e] * y[e];
      ss += shxl(ss, lane, 1); ss += shxl(ss, lane, 2); ss += shxl(ss, lane, 4);
      const float rs = rsqrtf(ss * (1.f / 64) + EPS);
      const int unit = lane >> 3; const bool isk = unit >= 4; const int hh = isk ? unit - 4 : unit;
      const int d0 = (lane & 7) * 8;
      const float* gn = (grp == 0 ? gwn : gg) + (isk ? 64 : 0) + d0;
      if (lane < 48) {
#pragma unroll
        for (int e = 0; e < 8; ++e) y[e] = y[e] * rs * gn[e];
      }
      if (lat) {
#pragma unroll
        for (int e = 0; e < 8; ++e) part[e] = shxl(y[e], lane, 4);
        rope_pair8(y, part, (lane & 4) != 0, rowp + 32, rowp + 64, (lane & 3) * 8);
      }
      if (lane < 48) {
        bf16_t* base = grp == 0 ? (isk ? ((bf16_t*)(m.ws + OFF_KW)) : ((bf16_t*)(m.ws + OFF_QW))) : (isk ? ((bf16_t*)(m.ws + OFF_KG)) : ((bf16_t*)(m.ws + OFF_QG)));
        bf16_t* dst = base + (((size_t)b * (isk ? 2 : 4) + hh) * NT + p) * 64 + d0;
        *(uint4*)dst = pack8(y, isk ? 1.f : 0.125f * LOG2E);
      }
    }
    {
      const int vsrc = lane < 32 ? 512 + 8 * lane : (lane < 48 ? 1152 + 8 * (lane - 32) : 1664 + 8 * (lane - 48));
      uint4 w = *(const uint4*)(Pr + vsrc);
      *(uint2*)(Vs + rr * VS_STRIDE + lane * 16) = make_uint2(w.x, w.y);
      *(uint2*)(Vs + rr * VS_STRIDE + lane * 16 + 8) = make_uint2(w.z, w.w);
    }
  }
  __syncthreads();
  for (int tk = tid; tk < 2048; tk += NTHR) {
    const int pg = tk & 3; const int vch = (tk >> 2) & 15 | ((tk >> 6) << 4);
    unsigned short e[8];
#pragma unroll
    for (int i = 0; i < 8; ++i) {
      int sidx = 8 * pg + i;
      int pl = (sidx & 16) | perm16(sidx & 15);
      e[i] = *(const unsigned short*)(Vs + pl * VS_STRIDE + vch * 2);
    }
    uint4 w = make_uint4(e[0] | ((unsigned)e[1] << 16), e[2] | ((unsigned)e[3] << 16), e[4] | ((unsigned)e[5] << 16), e[6] | ((unsigned)e[7] << 16));
    bf16_t* dst;
    if (vch < 256) dst = ((bf16_t*)(m.ws + OFF_VAt)) + (((size_t)b * 4 + (vch >> 6)) * 64 + (vch & 63)) * NT;
    else if (vch < 384) dst = ((bf16_t*)(m.ws + OFF_VWt)) + (((size_t)b * 2 + ((vch - 256) >> 6)) * 64 + (vch & 63)) * NT;
    else dst = ((bf16_t*)(m.ws + OFF_VGt)) + (((size_t)b * 2 + ((vch - 384) >> 6)) * 64 + (vch & 63)) * NT;
    *(uint4*)(dst + p0 + 8 * pg) = w;
  }
  {
    const float* cw = ((const float*)m.hy_conv_w) + l * 3 * 768; const float* cb = ((const float*)m.hy_conv_b) + l * 768;
    const int cc = lane >> 3, pg = lane & 7;
#pragma unroll 2
    for (int cg = wid; cg < 96; cg += 8) {
      const int c = cg * 8 + cc;
      const float w0 = cw[c], w1 = cw[768 + c], w2 = cw[1536 + c], bb = cb[c];
      float xin[6];
#pragma unroll
      for (int i = 0; i < 6; ++i) xin[i] = bf2f(*(const bf16_t*)(Hs + (4 * pg + i) * HS_STRIDE + c * 2));
      float o[4];
#pragma unroll
      for (int i = 0; i < 4; ++i) o[i] = xin[i] * w0 + xin[i + 1] * w1 + xin[i + 2] * w2 + bb;
      *(float4*)(((float*)(m.ws + OFF_uT)) + ((size_t)b * 768 + c) * NT + p0 + 4 * pg) = make_float4(o[0], o[1], o[2], o[3]);
    }
  }
}

DI void hyena_ctx_channel(MKP m_in, int l, int c, char* smem) {
  const MK m = launder_mk(m_in);
  float* kf = (float*)smem;
  float* vz = kf + 1024;
  float* red = vz + 512;
  float* wcol = red + 16;
  const int tid = TID;
  const float* hd = ((float*)(m.ws + OFF_hdn2)) + (size_t)l * 64 * NT + SEQ;
  const float* w3 = m.hy_w3 + (size_t)l * 64 * 1024; const float* b3 = m.hy_b3 + l * 1024;
  __syncthreads();
  if (tid < 256) { int od = tid >> 6, i = tid & 63; wcol[i * 4 + od] = w3[i * 1024 + (od >> 1) * 512 + (od & 1) * 256 + c]; }
  __syncthreads();
  const float delta = fabsf(-3.0701134573253944f + (float)c * ((-15.350567286626972f + 3.0701134573253944f) / 255.f));
  float n0 = 0.f, n1 = 0.f;
  if (tid < 256) {
    const int j = tid;
    float f00 = b3[c], f01 = b3[256 + c], f10 = b3[512 + c], f11 = b3[768 + c];
#pragma unroll 4
    for (int i = 0; i < 64; ++i) {
      float hv = hd[(size_t)i * NT + j];
      const float4 w = *(const float4*)(wcol + 4 * i);
      f00 += hv * w.x; f01 += hv * w.y; f10 += hv * w.z; f11 += hv * w.w;
    }
    const float dec = __expf(-((float)j / (float)(CTX - 1)) * delta);
    f00 *= dec; f01 *= dec; f10 *= dec; f11 *= dec;
    kf[256 + j] = f00; kf[512 + 256 + j] = f10; n0 += fabsf(f00); n1 += fabsf(f10);
    if (j > 0) { kf[256 - j] = f01; kf[512 + 256 - j] = f11; n0 += fabsf(f01); n1 += fabsf(f11); }
    else { kf[0] = 0.f; kf[512] = 0.f; }
  }
  n0 = block_sum_512(n0, red);
  n1 = block_sum_512(n1, red);
  const float i0 = 1.f / n0, i1 = 1.f / n1;
  const int bb = tid >> 8, t = tid & 255;
  const float* ub = ((float*)(m.ws + OFF_uT)) + ((size_t)bb * 768 + c) * NT;
  const float vself = ub[t];
  vz[bb * 256 + t] = vself;
  __syncthreads();
  float acc = 0.f;
  for (int s2 = 0; s2 < 256; s2 += 4) { const float4 v4 = *(const float4*)(vz + bb * 256 + s2); const float* kp = kf + 256 + t - s2; acc += v4.x * kp[0] + v4.y * kp[-1] + v4.z * kp[-2] + v4.w * kp[-3]; }
  const float z = ub[(size_t)256 * NT + t] * (acc * i0 + m.hy_bias[l * 512 + c] * vself);
  __syncthreads();
  vz[bb * 256 + t] = z;
  __syncthreads();
  float acc2 = 0.f;
  for (int s2 = 0; s2 < 256; s2 += 4) { const float4 v4 = *(const float4*)(vz + bb * 256 + s2); const float* kp = kf + 512 + 256 + t - s2; acc2 += v4.x * kp[0] + v4.y * kp[-1] + v4.z * kp[-2] + v4.w * kp[-3]; }
  ((float*)(m.ws + OFF_yT))[((size_t)bb * 256 + c) * NT + t] = ub[(size_t)512 * NT + t] * (acc2 * i1 + m.hy_bias[l * 512 + 256 + c] * z);
}

DI TabJob make_tabjob(const MK& m, int l, int slot0, bool on) {
  TabJob j;
  j.pu = on ? m.peer_u + (size_t)l * 16384 * D : nullptr; j.pv = m.peer_v + (size_t)l * 16384 * D;
  j.du = ((unsigned char*)(m.ws + OFF_u8)) + (size_t)l * 16384 * D; j.dv = ((unsigned char*)(m.ws + OFF_v8)) + (size_t)l * 16384 * D;
  j.su = ((float*)(m.ws + OFF_us)) + l * 16384; j.sv = ((float*)(m.ws + OFF_vs)) + l * 16384;
  j.slot = slot0; j.wv = __builtin_amdgcn_readfirstlane(BID * 8 + (TID >> 6)); j.nw = NBLK * 8; j.prow = -1;
  return j;
}
constexpr int TAB_SLOTS_FILTER = 4;
constexpr int TAB_SLOTS_ALL = 24;
DI void phase_mix(MKP m_in, int l, bool want_ctx, char* smem) {
  const MK m = launder_mk(m_in);
  AttnArgs a;
  a.QA = ((bf16_t*)(m.ws + OFF_QA)); a.KA = ((bf16_t*)(m.ws + OFF_KA)); a.VAt = ((bf16_t*)(m.ws + OFF_VAt)); a.QW = ((bf16_t*)(m.ws + OFF_QW)); a.KW = ((bf16_t*)(m.ws + OFF_KW)); a.VWt = ((bf16_t*)(m.ws + OFF_VWt)); a.QG = ((bf16_t*)(m.ws + OFF_QG)); a.KG = ((bf16_t*)(m.ws + OFF_KG)); a.VGt = ((bf16_t*)(m.ws + OFF_VGt));
  a.g_qk_diff = m.g_qk_diff + l * 64; a.g_qk_win = m.g_qk_win + l * 128; a.g_qk_glob = m.g_qk_glob + l * 128; a.sink = m.sink_win + l * 4;
  a.lambda_diff = m.lambda_diff + l * 128; a.g_mix_out = m.g_mix_out + l * D; a.lambda_init = 0.8f - 0.6f * __expf(-0.3f * (float)l); a.pad0 = 0;
  a.A2 = ((bf16_t*)(m.ws + OFF_A2)); a.Oslab = ((float*)(m.ws + OFF_Oslab)); a.Lslab = ((float*)(m.ws + OFF_Lslab));
  const int nitems = 640 + (want_ctx ? 20 : 0);
  for (int rep = 0; rep < REP_DIFF; ++rep) for (int idx = BID; idx < 256; idx += NBLK) attn_dispatch(a, idx, want_ctx, smem);
  for (int rep = 0; rep < REP_GLOB; ++rep) for (int idx = 256 + BID; idx < 512; idx += NBLK) attn_dispatch(a, idx, want_ctx, smem);
  for (int rep = 0; rep < REP_HY; ++rep) for (int c = BID; c < 256; c += NBLK) {
    TabJob job = make_tabjob(m, l, TAB_SLOTS_FILTER, rep == 0 && c == BID);
    hyena_channel(c, m.hy_bias + l * 512, ((float*)(m.ws + OFF_uT)), ((float*)(m.ws + OFF_zT)), ((float*)(m.ws + OFF_yT)), (const uint2*)(m.ws + OFF_Hc), smem, job);
    tab_flush(job, TID & 63);
    if (want_ctx) hyena_ctx_channel(m_in, l, c, smem);
  }
  {
    TabJob job = make_tabjob(m, l, TAB_SLOTS_ALL, true);
    const int lane = TID & 63;
    while (job.slot * job.nw < 32768) tab_step(job, lane);
    tab_flush(job, lane);
  }
  for (int idx = 512 + BID; idx < nitems; idx += NBLK) attn_dispatch(a, idx, want_ctx, smem);
}

DI void phase_fin(MKP m_in, int l, bool want_ctx, char* smem) {
  const MK m = launder_mk(m_in);
  const float* gmo = m.g_mix_out + l * D;
  const int lane = TID & 63, wid = TID >> 6;
  char* wl = smem + wid * 9216;
  for (int chunk = BID * 8 + wid; chunk < NB * 8 * (NT / 64); chunk += NBLK * 8) {
    const int pc = chunk % (NT / 64), hd = (chunk / (NT / 64)) % 8, b = chunk / ((NT / 64) * 8);
    const int pbase = pc * 64;
    if (pbase < CTX && !want_ctx) continue;
    const float* gm = gmo + 512 + hd * 64;
    bf16_t* dst0 = ((bf16_t*)(m.ws + OFF_A2)) + ((size_t)b * NT + pbase) * D + 512 + hd * 64;
    if (hd < 4) {
      const int c4 = lane & 15, rr = lane >> 4;
      const float4 g4 = *(const float4*)(gm + 4 * c4);
      const size_t i0b = (((size_t)0 * NB + b) * 4 + hd) * NT + pbase, i1b = (((size_t)1 * NB + b) * 4 + hd) * NT + pbase;
      const float* Os = (const float*)(m.ws + OFF_Oslab); const float* Ls = (const float*)(m.ws + OFF_Lslab);
#pragma unroll 4
      for (int ps = 0; ps < 16; ++ps) {
        const int row = ps * 4 + rr;
        const float4 x = *(const float4*)(Os + (i0b + row) * 64 + 4 * c4), y = *(const float4*)(Os + (i1b + row) * 64 + 4 * c4);
        const float inv = 1.f / (Ls[i0b + row] + Ls[i1b + row]);
        const float o0 = (x.x + y.x) * inv, o1 = (x.y + y.y) * inv, o2 = (x.z + y.z) * inv, o3 = (x.w + y.w) * inv;
        float ss = o0 * o0 + o1 * o1 + o2 * o2 + o3 * o3;
        ss += shxl(ss, lane, 8); ss += shxl(ss, lane, 4); ss += shxl(ss, lane, 2); ss += shxl(ss, lane, 1);
        const float rs = rsqrtf(ss * (1.f / 64) + EPS);
        *(uint2*)(dst0 + (size_t)row * D + 4 * c4) = make_uint2(pk2bf(o0 * rs * g4.x, o1 * rs * g4.y), pk2bf(o2 * rs * g4.z, o3 * rs * g4.w));
      }
    } else {
      const int g = hd - 4, p = pbase + lane;
      float o[64]; float ss = 0.f;
#pragma unroll
      for (int i = 0; i < 64; ++i) o[i] = ((const float*)(m.ws + OFF_yT))[((size_t)b * 256 + g * 64 + i) * NT + p];
#pragma unroll
      for (int i = 0; i < 64; ++i) ss += o[i] * o[i];
      const float rs = rsqrtf(ss * (1.f / 64) + EPS);
#pragma unroll
      for (int i = 0; i < 8; ++i)
        *(uint4*)(wl + lane * 144 + i * 16) = make_uint4(pk2bf(o[8 * i] * rs * gm[8 * i], o[8 * i + 1] * rs * gm[8 * i + 1]), pk2bf(o[8 * i + 2] * rs * gm[8 * i + 2], o[8 * i + 3] * rs * gm[8 * i + 3]),
                                                         pk2bf(o[8 * i + 4] * rs * gm[8 * i + 4], o[8 * i + 5] * rs * gm[8 * i + 5]), pk2bf(o[8 * i + 6] * rs * gm[8 * i + 6], o[8 * i + 7] * rs * gm[8 * i + 7]));
      asm volatile("s_waitcnt lgkmcnt(0)" ::: "memory");
#pragma unroll
      for (int k = 0; k < 8; ++k) {
        const int row = k * 8 + (lane >> 3), ch = lane & 7;
        *(uint4*)(dst0 + (size_t)row * D + ch * 8) = *(const uint4*)(wl + row * 144 + ch * 16);
      }
      asm volatile("s_waitcnt lgkmcnt(0)" ::: "memory");
    }
  }
}

#ifndef PEER_SLICED
#define PEER_SLICED 1
#endif
#if !PEER_SLICED
DI void phase_peer(MKP m_in, int l, bool want_ctx, bool last, char* smem) {
  const MK m = launder_mk(m_in);
  const int lane = TID & 63, wid = TID >> 6;
  char* wbase = smem + wid * 10240;
  int* ex_l = (int*)wbase; float* g_l = (float*)(wbase + 4608); float* wd = (float*)(wbase + 9216);
  const float* modv_l = ((float*)(m.ws + OFF_modv)) + (size_t)l * 3 * NMOD;
  const int gw0 = BID * 8 + wid, nw0 = NBLK * 8;
  for (int i0 = 0; gw0 + nw0 * i0 < R && i0 < 9; i0 += 8) {
    const int slot = i0 + (lane >> 3);
    const int r = gw0 + nw0 * slot;
    if (slot < 9 && r < R && !((r % NT) < CTX && !want_ctx))
      merge_one(((unsigned*)(m.ws + OFF_topv)), r, lane & 7, ex_l + slot * 128, g_l + slot * 128);
  }
  int slot = 0;
  for (int r = gw0; r < R; r += nw0, ++slot) {
    if ((r % NT) < CTX && !want_ctx) continue;
    if (slot >= 9) {
      if (lane < 8) merge_one(((unsigned*)(m.ws + OFF_topv)), r, lane, ex_l + 8 * 128, g_l + 8 * 128);
    }
    const int sl = slot < 9 ? slot : 8;
    peer_token<PEER_SLICED>(r, ((bf16_t*)(m.ws + OFF_hbuf)), ex_l + sl * 128, g_l + sl * 128, ((unsigned char*)(m.ws + OFF_u8)) + (size_t)l * 16384 * D, ((float*)(m.ws + OFF_us)) + l * 16384, ((unsigned char*)(m.ws + OFF_v8)) + (size_t)l * 16384 * D, ((float*)(m.ws + OFF_vs)) + l * 16384,
               modv_l, ((float*)(m.ws + OFF_xs)), wd, last ? m.out : nullptr, ((int*)(m.ws + OFF_experts)), ((float*)(m.ws + OFF_gates)));
  }
}
#endif
DI void peer_v_rows(const MK& m, int l, bool want_ctx, bool last, int vslice_, int w0, int wstride) {
  const int lane = TID & 63, g = lane >> 3, j = lane & 7;
  const int vslice = __builtin_amdgcn_readfirstlane(vslice_);
  const unsigned char* v8u = ((const unsigned char*)(m.ws + OFF_v8)) + (size_t)l * 16384 * D + (size_t)vslice * TSLICE;
  const unsigned j16 = (unsigned)j * 16u;
  const unsigned* wts = (const unsigned*)(m.ws + OFF_gates);
  const float* modv_l = ((const float*)(m.ws + OFF_modv)) + (size_t)l * 3 * NMOD;
  float* xs = (float*)(m.ws + OFF_xs);
#pragma unroll 1
  for (int r = w0; r < R; r += wstride) {
    const int b = r / NT, p = r % NT;
    if (p < CTX && !want_ctx) continue;
    unsigned pkv[16];
    {
      const uint4* ep = (const uint4*)(wts + (size_t)r * 128 + 16 * g);
#pragma unroll
      for (int q = 0; q < 4; ++q) { const uint4 e4 = ep[q]; pkv[4 * q] = e4.x; pkv[4 * q + 1] = e4.y; pkv[4 * q + 2] = e4.z; pkv[4 * q + 3] = e4.w; }
    }
    const float invS = ((const float*)(m.ws + OFF_wsc))[r];
    const int col = 256 * (g >> 1) + 32 * vslice + 4 * j + 2 * (g & 1);
    const int mrow = p < CTX ? 2 : b;
    const float2 gg = *(const float2*)(modv_l + mrow * NMOD + 5 * D + col);
    float2 xv = *(const float2*)(xs + (size_t)r * D + col);
    uint4 rw[16];
#pragma unroll
    for (int q = 0; q < 16; ++q) {
      unsigned off;
      asm("v_mad_u32_u16 %0, %1, %2, %3" : "=v"(off) : "v"(pkv[q]), "s"(128u), "v"(j16));
      rw[q] = *(const uint4*)(v8u + off);
    }
    h2_t hacc[8];
#pragma unroll
    for (int i = 0; i < 8; ++i) hacc[i] = (h2_t){(_Float16)0.f, (_Float16)0.f};
#pragma unroll
    for (int q = 0; q < 16; ++q) {
      const h2_t pk2 = __builtin_bit_cast(h2_t, pkv[q]);
      const h2_t w2 = __builtin_shufflevector(pk2, pk2, 1, 1);
      const int r4[4] = {(int)rw[q].x, (int)rw[q].y, (int)rw[q].z, (int)rw[q].w};
#pragma unroll
      for (int c = 0; c < 4; ++c) {
        hacc[2 * c] = __builtin_elementwise_fma(__builtin_bit_cast(h2_t, __builtin_amdgcn_cvt_scalef32_pk_f16_fp8(r4[c], 1.0f, false)), w2, hacc[2 * c]);
        hacc[2 * c + 1] = __builtin_elementwise_fma(__builtin_bit_cast(h2_t, __builtin_amdgcn_cvt_scalef32_pk_f16_fp8(r4[c], 1.0f, true)), w2, hacc[2 * c + 1]);
      }
    }
    h2_t b4[4], c2[2], d1;
    {
      const bool g2 = lane & 32, g1 = lane & 16, g0 = lane & 8;
#pragma unroll
      for (int i = 0; i < 4; ++i) {
        const int send = __builtin_bit_cast(int, g2 ? hacc[i] : hacc[4 + i]); const h2_t keep = g2 ? hacc[4 + i] : hacc[i];
        b4[i] = keep + __builtin_bit_cast(h2_t, shxl(send, lane, 32));
      }
#pragma unroll
      for (int i = 0; i < 2; ++i) {
        const int send = __builtin_bit_cast(int, g1 ? b4[i] : b4[2 + i]); const h2_t keep = g1 ? b4[2 + i] : b4[i];
        c2[i] = keep + __builtin_bit_cast(h2_t, shxl(send, lane, 16));
      }
      {
        const int send = __builtin_bit_cast(int, g0 ? c2[0] : c2[1]); const h2_t keep = g0 ? c2[1] : c2[0];
        d1 = keep + __builtin_bit_cast(h2_t, shxl(send, lane, 8));
      }
    }
    {
      xv.x += gg.x * ((float)d1[0] * invS); xv.y += gg.y * ((float)d1[1] * invS);
      float* op = last ? m.out + ((size_t)b * SEQ + (p - CTX)) * D + col : xs + (size_t)r * D + col;
      *(float2*)op = xv;
    }
  }
}
DI void phase_peer_merge(MKP m_in, bool want_ctx, char* smem) {
  const MK m = launder_mk(m_in);
  const int lane = TID & 63, wid = TID >> 6;
  char* wbase = smem + wid * 8192;
  int* ex_l = (int*)wbase; float* g_l = (float*)(wbase + 4096);
  int* experts = (int*)(m.ws + OFF_experts); float* gates = (float*)(m.ws + OFF_gates);
  for (int grp = BID * 8 + wid; grp < R / 8; grp += NBLK * 8) {
    const int r = grp * 8 + (lane >> 3);
    const bool skip = ((r % NT) < CTX) && !want_ctx;
    if (skip) continue;
    merge_one(((unsigned*)(m.ws + OFF_topv)), r, lane & 7, ex_l + (lane >> 3) * 128, g_l + (lane >> 3) * 128);
    asm volatile("s_waitcnt lgkmcnt(0)" ::: "memory");
#pragma unroll
    for (int q = 0; q < 4; ++q) {
      const int idx = (q * 64 + lane) * 4;
      *(uint4*)(experts + (size_t)grp * 1024 + idx) = *(const uint4*)(ex_l + idx);
      *(float4*)(gates + (size_t)grp * 1024 + idx) = *(const float4*)(g_l + idx);
    }
    asm volatile("s_waitcnt lgkmcnt(0)" ::: "memory");
  }
}
DI void peer_u_rows(const MK& m, int l, bool want_ctx, int vslice_, int w0, int wstride) {
  const int lane = TID & 63, g = lane >> 3, j = lane & 7;
  const int vslice = __builtin_amdgcn_readfirstlane(vslice_);
  const unsigned char* u8 = ((const unsigned char*)(m.ws + OFF_u8)) + (size_t)l * 16384 * D + (size_t)vslice * TSLICE;
  const unsigned char* xq = (const unsigned char*)(m.ws + OFF_xq);
  const unsigned loff = (unsigned)(vslice * 128 + j * 16);
  const unsigned j16 = (unsigned)j * 16u;
  const int* experts = (const int*)(m.ws + OFF_experts);
  int* PD = ((int*)(m.ws + OFF_P)) + (size_t)vslice * R * 128;
#pragma unroll 1
  for (int r = w0; r < R; r += wstride) {
    if (((r % NT) < CTX) && !want_ctx) continue;
    uint4 rw[16];
    {
      const uint4* ep = (const uint4*)((const unsigned short*)experts + (size_t)r * 128 + 16 * g);
      const uint4 ea = ep[0], eb = ep[1];
      const unsigned ew[8] = {ea.x, ea.y, ea.z, ea.w, eb.x, eb.y, eb.z, eb.w};
#pragma unroll
      for (int q = 0; q < 8; ++q) {
        unsigned o0, o1;
        asm("v_mad_u32_u16 %0, %1, %2, %3" : "=v"(o0) : "v"(ew[q]), "s"(128u), "v"(j16));
        asm("v_mad_u32_u16 %0, %1, %2, %3 op_sel:[1,0,0,0]" : "=v"(o1) : "v"(ew[q]), "s"(128u), "v"(j16));
        rw[2 * q] = *(const uint4*)(u8 + o0);
        rw[2 * q + 1] = *(const uint4*)(u8 + o1);
      }
    }
    const uint4 xv = *(const uint4*)(xq + (size_t)r * D + loff);
    int pd[16];
#pragma unroll
    for (int q = 0; q < 16; ++q) {
      int a = __builtin_amdgcn_sdot4((int)rw[q].x, (int)xv.x, 0, false);
      a = __builtin_amdgcn_sdot4((int)rw[q].y, (int)xv.y, a, false);
      a = __builtin_amdgcn_sdot4((int)rw[q].z, (int)xv.z, a, false);
      pd[q] = __builtin_amdgcn_sdot4((int)rw[q].w, (int)xv.w, a, false);
    }
    int b8[8], c4[4], d2[2];
    {
      const bool j2 = lane & 4, j1 = lane & 2, j0 = lane & 1;
#pragma unroll
      for (int i = 0; i < 8; ++i) { const int send = j2 ? pd[i] : pd[8 + i], keep = j2 ? pd[8 + i] : pd[i]; b8[i] = keep + shxl(send, lane, 4); }
#pragma unroll
      for (int i = 0; i < 4; ++i) { const int send = j1 ? b8[i] : b8[4 + i], keep = j1 ? b8[4 + i] : b8[i]; c4[i] = keep + shxl(send, lane, 2); }
#pragma unroll
      for (int i = 0; i < 2; ++i) { const int send = j0 ? c4[i] : c4[2 + i], keep = j0 ? c4[2 + i] : c4[i]; d2[i] = keep + shxl(send, lane, 1); }
    }
    *(int2*)(PD + (size_t)r * 128 + 16 * g + 2 * j) = make_int2(d2[0], d2[1]);
  }
}
DI void phase_peer_u(MKP m_in, int l, bool want_ctx, char* smem) {
  const MK m = launder_mk(m_in);
  unsigned* bar = (unsigned*)(m.ws + OFF_bar);
  volatile LAS unsigned* st = (volatile LAS unsigned*)(smem + SMEM_BYTES);
  if (threadIdx.x == 0) {
    unsigned ok = 1u, mine = 0u; const unsigned x = st[3];
    for (unsigned q = 0; q < 16; ++q) { const unsigned c = xb_ld(&bar[XB_XCNT(q)]); if ((q < 8) != (c > 0u)) ok = 0u; if (q == x) mine = c; }
    st[4] = ok ? mine : 0u;
  }
  __syncthreads();
  const unsigned nloc = st[4];
  const int wid = TID >> 6;
  if (nloc != 0u) peer_u_rows(m, l, want_ctx, (int)(st[3] & 7u), (int)st[2] * 8 + wid, (int)nloc * 8);
  else for (int v = 0; v < 8; ++v) peer_u_rows(m, l, want_ctx, v, BID * 8 + wid, NBLK * 8);
}
DI void phase_peer_reduce(MKP m_in, int l, bool want_ctx) {
  const MK m = launder_mk(m_in);
  const int* experts = (const int*)(m.ws + OFF_experts);
  float* gates = (float*)(m.ws + OFF_gates);
  const int* PD = (const int*)(m.ws + OFF_P);
  const float* us = ((const float*)(m.ws + OFF_us)) + l * 16384;
  const float* vs = ((const float*)(m.ws + OFF_vs)) + l * 16384;
  const float* xqs = (const float*)(m.ws + OFF_xqs);
  for (int i4 = BID * NTHR + TID; i4 < R * 32; i4 += NBLK * NTHR) {
    const int r = i4 >> 5;
    if (((r % NT) < CTX) && !want_ctx) continue;
    int4 acc = make_int4(0, 0, 0, 0);
#pragma unroll
    for (int v = 0; v < 8; ++v) { const int4 p = ((const int4*)(PD + (size_t)v * R * 128))[i4]; acc.x += p.x; acc.y += p.y; acc.z += p.z; acc.w += p.w; }
    const uint2 e2 = ((const uint2*)experts)[i4];
    const int4 e4 = make_int4((int)(e2.x & 0xffffu), (int)(e2.x >> 16), (int)(e2.y & 0xffffu), (int)(e2.y >> 16));
    float4 g4 = ((const float4*)gates)[i4];
    const float xs_ = xqs[r];
    const int ee[4] = {e4.x, e4.y, e4.z, e4.w}; const int aa[4] = {acc.x, acc.y, acc.z, acc.w}; float gg[4] = {g4.x, g4.y, g4.z, g4.w};
#pragma unroll
    for (int q = 0; q < 4; ++q) {
      const float d = (float)aa[q] * (us[ee[q]] * xs_);
      const float t = 0.5f * d * (1.f + tanhf(0.7978845608028654f * (d + 0.044715f * d * d * d)));
      gg[q] = gg[q] * t * vs[ee[q]];
    }
    const int lane = TID & 63;
    float mxw = fmaxf(fmaxf(fabsf(gg[0]), fabsf(gg[1])), fmaxf(fabsf(gg[2]), fabsf(gg[3])));
    mxw = fmaxf(mxw, shxl(mxw, lane, 1)); mxw = fmaxf(mxw, shxl(mxw, lane, 2)); mxw = fmaxf(mxw, shxl(mxw, lane, 4));
    mxw = fmaxf(mxw, shxl(mxw, lane, 8)); mxw = fmaxf(mxw, shxl(mxw, lane, 16));
    const unsigned eb = (__float_as_uint(mxw) >> 23) & 255u;
    const float Sw = __uint_as_float((252u - eb) << 23);
    unsigned pk[4];
#pragma unroll
    for (int q = 0; q < 4; ++q) {
      const _Float16 wh = (_Float16)(gg[q] * Sw);
      pk[q] = (unsigned)ee[q] | ((unsigned)__builtin_bit_cast(unsigned short, wh) << 16);
    }
    ((uint4*)gates)[i4] = make_uint4(pk[0], pk[1], pk[2], pk[3]);
    if ((i4 & 31) == 0) ((float*)(m.ws + OFF_wsc))[r] = __uint_as_float(eb == 0u ? 0u : ((eb + 2u) << 23));
  }
}
DI void phase_peer_v(MKP m_in, int l, bool want_ctx, bool last, char* smem) {
  const MK m = launder_mk(m_in);
  unsigned* bar = (unsigned*)(m.ws + OFF_bar);
  volatile LAS unsigned* st = (volatile LAS unsigned*)(smem + SMEM_BYTES);
  if (threadIdx.x == 0) {
    unsigned ok = 1u, mine = 0u; const unsigned x = st[3];
    for (unsigned q = 0; q < 16; ++q) { const unsigned c = xb_ld(&bar[XB_XCNT(q)]); if ((q < 8) != (c > 0u)) ok = 0u; if (q == x) mine = c; }
    st[1 + 3 + 0] = ok ? mine : 0u;
  }
  __syncthreads();
  const unsigned nloc = st[4];
  const int wid = TID >> 6;
  if (nloc != 0u) {
    peer_v_rows(m, l, want_ctx, last, (int)(st[3] & 7u), (int)st[2] * 8 + wid, (int)nloc * 8);
  } else {
    for (int v = 0; v < 8; ++v) peer_v_rows(m, l, want_ctx, last, v, BID * 8 + wid, NBLK * 8);
  }
}

DI void phase_scores(MKP m_in, int l, bool last, char* smem) {
  const MK m = launder_mk(m_in);
  const int nrt = last ? 128 : 132;
  for (int t = BID; t < nrt * 8; t += NBLK)
    score_head_item(((bf16_t*)(m.ws + OFF_P)), ((bf16_t*)(m.ws + OFF_keysb)) + (size_t)l * 16 * 128 * 128, rowtile_of(t >> 3, last) * 128, t & 7, smem,
                    ((int*)(m.ws + OFF_experts)), ((float*)(m.ws + OFF_gates)));
}
DI void phase_gemm1(MKP m_in, int l, char* smem) {
  const MK m = launder_mk(m_in);
  pg8::Gemm g; g.A = (bf16_t*)(m.ws + OFF_hbuf); g.Bt = (bf16_t*)(m.ws + OFF_Wt_in) + (size_t)l * DIN * D; g.M = R; g.N = DIN; g.K = D;
  MySched S; S.init(DIN, false, NBLK, BID);
  EpiStoreBf16 E; E.Cb = (bf16_t*)(m.ws + OFF_P); E.ldc = DIN;
  __syncthreads();
  pg8::gemm_phase<EpiStoreBf16, MySched, false>((PG8_LAS unsigned char*)smem, g, S, E, nullptr);
  __syncthreads();
}
DI int ctx_rowtile(int i) { return (i >> 1) * 66 + (i & 1); }
DI void phase_gemm2(MKP m_in, int l, bool last, char* smem) {
  const MK m = launder_mk(m_in);
  pg8::Gemm g; g.A = (bf16_t*)(m.ws + OFF_A2); g.Bt = (bf16_t*)(m.ws + OFF_Wt_out) + (size_t)l * D * D; g.M = R; g.N = D; g.K = D;
  MySched S; S.init(D, true, NBLK, BID);
  EpiResidual E; E.xs = (float*)(m.ws + OFF_xs); E.gate_base = (float*)(m.ws + OFF_modv) + (size_t)l * 3 * NMOD + 2 * D;
  E.xin = l == 0 ? m.x : nullptr; E.ctxin = l == 0 ? m.ctx : nullptr;
  __syncthreads();
  pg8::gemm_phase<EpiResidual, MySched, false>((PG8_LAS unsigned char*)smem, g, S, E, nullptr);
  __syncthreads();
  if (!last) {
    const int nb = NBLK;
    for (int t = (BID + nb - 32) % nb; t < 4 * 8; t += nb)
      gemm_tile<1>(g.A, g.Bt, D, ctx_rowtile(t >> 3) * 128, (t & 7) * 128, smem, nullptr, E.xs, E.gate_base, E.xin, E.ctxin);
  }
}
DI void phase_gemm3(MKP m_in, int l, bool last, char* smem) {
  const MK m = launder_mk(m_in);
  pg8::Gemm g; g.A = (bf16_t*)(m.ws + OFF_hbuf); g.Bt = (bf16_t*)(m.ws + OFF_Wt_q) + (size_t)l * 2048 * D; g.M = R; g.N = 2048; g.K = D;
  MySched S; S.init(2048, true, NBLK, BID);
  EpiStoreBf16 E; E.Cb = (bf16_t*)(m.ws + OFF_P); E.ldc = 2048;
  __syncthreads();
  pg8::gemm_phase<EpiStoreBf16, MySched, false>((PG8_LAS unsigned char*)smem, g, S, E, nullptr);
  __syncthreads();
  if (!last) {
    const int nb = NBLK;
    for (int t = (BID + nb - 64) % nb; t < 4 * 16; t += nb)
      gemm_tile<0>(g.A, g.Bt, 2048, ctx_rowtile(t >> 4) * 128, (t & 15) * 128, smem, E.Cb, nullptr, nullptr);
  }
}
#define GSYNC() xcd_barrier((unsigned*)(launder_mk(m).ws + OFF_bar), (volatile LAS unsigned*)(smem + SMEM_BYTES))
DI void phase_filters(MKP m_in, int l, char* smem) {
  const MK m = launder_mk(m_in);
  for (int c = BID; c < 256; c += NBLK) {
    TabJob job = make_tabjob(m, l, 0, c == BID);
    hyena_filter_task(c, ((const bf16_t*)(m.ws + OFF_hdnB)) + (size_t)l * SEQ * 64, ((const bf16_t*)(m.ws + OFF_W3t)) + (size_t)l * 1024 * 64, m.hy_b3 + l * 1024, (uint2*)(m.ws + OFF_Hc), smem, job);
    tab_flush(job, TID & 63);
  }
}
template <int L>
DI void layer_body(MKP m, char* smem) {
  constexpr bool want_ctx = L == 0, last = L == 1;
  for (int rep = 0; rep < REP_NORM1; ++rep) { phase_norm(m, L, 0, L == 0, false); GSYNC(); }
  for (int rep = 0; rep < REP_GEMM1; ++rep) { phase_gemm1(m, L, smem); GSYNC(); }
  for (int rep = 0; rep < REP_PREP; ++rep) for (int t = BID; t < R / 32; t += NBLK) prep_tile(m, L, t, smem);
  for (int rep = 0; rep < REP_FILT; ++rep) phase_filters(m, L, smem);
  GSYNC();
  for (int rep = 0; rep < REP_MIX; ++rep) { phase_mix(m, L, want_ctx, smem); GSYNC(); }
  for (int rep = 0; rep < REP_FIN; ++rep) { phase_fin(m, L, want_ctx, smem); GSYNC(); }
  phase_gemm2(m, L, last, smem);
  GSYNC();
  for (int rep = 0; rep < REP_NORM2; ++rep) { phase_norm(m, L, 1, false, last); GSYNC(); }
  for (int rep = 0; rep < REP_GEMM3; ++rep) { phase_gemm3(m, L, last, smem); GSYNC(); }
  for (int rep = 0; rep < REP_SCORES; ++rep) { phase_scores(m, L, last, smem); GSYNC(); }
  for (int rep = 0; rep < (last ? REP_PEER_LAST : 1); ++rep) {
#if PEER_SLICED
    for (int ru = 0; ru < (last ? REP_PEER_U : 1); ++ru) phase_peer_u(m, L, want_ctx, smem);
    GSYNC();
    phase_peer_reduce(m, L, want_ctx);
    GSYNC();
    for (int rv = 0; rv < (last ? REP_PEER_V : 1); ++rv) phase_peer_v(m, L, want_ctx, last, smem);
#else
    phase_peer(m, L, want_ctx, last, smem);
#endif
    if (!last || rep + 1 < REP_PEER_LAST) GSYNC();
  }
}
__global__ __launch_bounds__(NTHR) void k_mega(MK m_unused) {
  extern __shared__ __attribute__((aligned(16))) char smem[];
  (void)m_unused;
  MKP m = (MKP)__builtin_amdgcn_kernarg_segment_ptr();
  {
    volatile LAS unsigned* st = (volatile LAS unsigned*)(smem + SMEM_BYTES);
    if (threadIdx.x == 0) { st[0] = 0u; st[1] = 0u; st[2] = 0u; st[3] = 0u; st[4] = 0u; st[5] = 0u; }
    __syncthreads();
    xcd_barrier_post((unsigned*)(launder_mk(m).ws + OFF_bar), st);
  }
  for (int rep = 0; rep < REP_P0; ++rep) { phase0(m, smem); GSYNC(); }
  layer_body<0>(m, smem);
  layer_body<1>(m, smem);
}

extern "C" void kernel_launch(void* const* d_in, const int* in_sizes, int n_in, void* d_out, int out_size, void* d_ws, size_t ws_size,
                              hipStream_t stream) {
  (void)in_sizes; (void)n_in; (void)out_size;
  MK m;
  memset(&m, 0, sizeof(m));
  const float** ip = (const float**)&m.x;
  for (int i = 0; i < 30; ++i) ip[i] = (const float*)d_in[i];
  m.out = (float*)d_out;
  m.ws = (char*)d_ws;
  if (WS_TOTAL > ws_size) return;

  static int grid_blocks = 0;
  if (!grid_blocks) {
    (void)hipFuncSetAttribute((const void*)k_mega, hipFuncAttributeMaxDynamicSharedMemorySize, SMEM_BYTES + 32);
    int dev = 0, cus = 0, per_cu = 0;
    (void)hipGetDevice(&dev);
    (void)hipDeviceGetAttribute(&cus, hipDeviceAttributeMultiprocessorCount, dev);
    (void)hipOccupancyMaxActiveBlocksPerMultiprocessor(&per_cu, k_mega, NTHR, SMEM_BYTES + 32);
    if (per_cu > 1) per_cu = 1;
    grid_blocks = cus * per_cu;
  }
  (void)hipMemsetAsync(m.ws + OFF_bar, 0, (size_t)XCD_BAR_WORDS * 4, stream);
  void* args[] = {&m};
  (void)hipLaunchCooperativeKernel((void*)k_mega, dim3(grid_blocks), dim3(NTHR), args, SMEM_BYTES + 32, stream);
}
```

```cpp
#include <hip/hip_runtime.h>
#ifndef REP_DIFF
#define REP_DIFF 1
#endif
#ifndef REP_GLOB
#define REP_GLOB 1
#endif
#ifndef REP_HY
#define REP_HY 1
#endif
#ifndef REP_FILT
#define REP_FILT 1
#endif
#ifndef REP_PEER_U
#define REP_PEER_U 1
#endif
#ifndef REP_PEER_V
#define REP_PEER_V 1
#endif
#ifndef REP_NORM1
#define REP_NORM1 1
#endif
#ifndef REP_GEMM1
#define REP_GEMM1 1
#endif
#ifndef REP_PREP
#define REP_PREP 1
#endif
#ifndef REP_MIX
#define REP_MIX 1
#endif
#ifndef REP_FIN
#define REP_FIN 1
#endif
#ifndef REP_NORM2
#define REP_NORM2 1
#endif
#ifndef REP_GEMM3
#define REP_GEMM3 1
#endif
#ifndef REP_SCORES
#define REP_SCORES 1
#endif
#ifndef REP_MERGE
#define REP_MERGE 1
#endif
#ifndef REP_PEER_LAST
#define REP_PEER_LAST 1
#endif
#ifndef REP_P0
#define REP_P0 1
#endif
#include <hip/hip_cooperative_groups.h>
namespace cg = cooperative_groups;
#include <stdint.h>
#include <string.h>

#define DI __device__ __forceinline__
#define LAS __attribute__((address_space(3)))
typedef unsigned short bf16_t;

constexpr int D = 1024;
constexpr int NB = 2;
constexpr int SEQ = 8192;
constexpr int CTX = 256;
constexpr int NT = SEQ + CTX;
constexpr int R = NB * NT;
constexpr int DIN = 2560;
constexpr int NMOD = 6 * D;
constexpr float EPS = 1e-6f;
constexpr float LOG2E = 1.4426950408889634f;

DI int opq_v(int x) { asm volatile("" : "+v"(x)); return x; }
DI int opq_s(int x) { asm volatile("" : "+s"(x)); return x; }
template <class T> DI T* opq_p(T* p) { asm volatile("" : "+s"(p)); return p; }
#define TID opq_v((int)threadIdx.x)
#define BID opq_s((int)blockIdx.x)
#define NBLK opq_s((int)gridDim.x)
DI float shxl(float v, int lane, int mask) { return __builtin_bit_cast(float, __builtin_amdgcn_ds_bpermute((lane ^ mask) << 2, __builtin_bit_cast(int, v))); }
DI int shxl(int v, int lane, int mask) { return __builtin_amdgcn_ds_bpermute((lane ^ mask) << 2, v); }
DI float shx(float v, int mask) { return shxl(v, opq_v((int)threadIdx.x) & 63, mask); }
DI bf16_t f2bf(float x) { unsigned u = __float_as_uint(x); u += 0x7fffu + ((u >> 16) & 1u); return (bf16_t)(u >> 16); }
DI float bf2f(bf16_t h) { return __uint_as_float(((unsigned)h) << 16); }
DI float bflo(unsigned w) { return __uint_as_float(w << 16); }
DI float bfhi(unsigned w) { return __uint_as_float(w & 0xffff0000u); }

DI float block_sum_256(float v, float* red) {
  for (int o = 32; o > 0; o >>= 1) v += shx(v, o);
  int w = TID >> 6;
  __syncthreads();
  if ((TID & 63) == 0) red[w] = v;
  __syncthreads();
  float s = red[0] + red[1] + red[2] + red[3];
  return s;
}

DI int perm16(int o) { return (o & 3) | ((o & 4) << 1) | ((o & 8) >> 1); }

typedef __attribute__((ext_vector_type(8))) short bf16x8;
typedef __attribute__((ext_vector_type(16))) float f32x16;
typedef __attribute__((ext_vector_type(2))) __bf16 bf16x2_t;
typedef __attribute__((ext_vector_type(2))) float f32x2_t;
#define MFMA32(a, b, c) __builtin_amdgcn_mfma_f32_32x32x16_bf16((a), (b), (c), 0, 0, 0)
DI unsigned pk2bf(float a, float b) { f32x2_t v = {a, b}; return __builtin_bit_cast(unsigned, __builtin_convertvector(v, bf16x2_t)); }
constexpr int NTHR = 512;

DI void wconv_strip(const float* __restrict__ W, bf16_t* __restrict__ Wt, int N, int strip, float* sm) {
  const int tn4 = strip % (N / 256), tk = strip / (N / 256);
  const int tid = TID;
  __syncthreads();
#pragma unroll
  for (int q = 0; q < 8; ++q) {
    const int i = tid + q * NTHR;
    const int kr = i >> 6, c4 = (i & 63) * 4;
    const float4 v = *(const float4*)(W + (size_t)(tk * 64 + kr) * N + tn4 * 256 + c4);
    float* d = sm + kr * 257 + c4; d[0] = v.x; d[1] = v.y; d[2] = v.z; d[3] = v.w;
  }
  __syncthreads();
#pragma unroll
  for (int q = 0; q < 4; ++q) {
    const int i = tid + q * NTHR;
    const int n = i >> 3, k8 = (i & 7) * 8;
    unsigned w[4];
#pragma unroll
    for (int j = 0; j < 4; ++j) w[j] = pk2bf(sm[(k8 + 2 * j) * 257 + n], sm[(k8 + 2 * j + 1) * 257 + n]);
    *(uint4*)(Wt + (size_t)(tn4 * 256 + n) * D + tk * 64 + k8) = make_uint4(w[0], w[1], w[2], w[3]);
  }
}
DI void wconv_tile(const float* __restrict__ W, bf16_t* __restrict__ Wt, int N, int tile, float* sm  ) {
  int tn = tile % (N / 64), tk = tile / (N / 64);
  int tid = TID;
  __syncthreads();
  for (int i = tid; i < 64 * 16; i += NTHR) {
    int kr = i >> 4, c4 = (i & 15) * 4;
    float4 v = *(const float4*)(W + (size_t)(tk * 64 + kr) * N + tn * 64 + c4);
    sm[kr * 65 + c4] = v.x; sm[kr * 65 + c4 + 1] = v.y; sm[kr * 65 + c4 + 2] = v.z; sm[kr * 65 + c4 + 3] = v.w;
  }
  __syncthreads();
  for (int i = tid; i < 64 * 8; i += NTHR) {
    int n = i >> 3, k8 = (i & 7) * 8;
    unsigned w[4];
    for (int j = 0; j < 4; ++j) w[j] = pk2bf(sm[(k8 + 2 * j) * 65 + n], sm[(k8 + 2 * j + 1) * 65 + n]);
    *(uint4*)(Wt + (size_t)(tn * 64 + n) * D + tk * 64 + k8) = make_uint4(w[0], w[1], w[2], w[3]);
  }
}

template <int EPI, int K = D>
DI void gemm_tile(const bf16_t* __restrict__ A, const bf16_t* __restrict__ Wt, int N, int m0, int n0, char* smem, bf16_t* __restrict__ Cb,
                  float* __restrict__ xs, const float* __restrict__ gate_base, const float* __restrict__ xin = nullptr, const float* __restrict__ ctxin = nullptr) {
  const int tid = TID, lane = tid & 63, wid = tid >> 6;
  const int wm = wid & 1, wn = wid >> 1;
  const int r = lane & 31, h = lane >> 5;
  f32x16 acc0, acc1;
  for (int i = 0; i < 16; ++i) { acc0[i] = 0.f; acc1[i] = 0.f; }
  const int lrow = tid >> 3, lch = tid & 7;
  const bf16_t* Ag = A + (size_t)(m0 + lrow) * K + lch * 8;
  const bf16_t* Bg = Wt + (size_t)(n0 + lrow) * K + lch * 8;
  const int woff = lrow * 128 + ((lch ^ ((lrow >> 1) & 7)) << 4);
  uint4 ra0, ra1, rb0, rb1;
  ra0 = *(const uint4*)(Ag); ra1 = *(const uint4*)(Ag + (size_t)64 * K);
  rb0 = *(const uint4*)(Bg); rb1 = *(const uint4*)(Bg + (size_t)64 * K);
  __syncthreads();
  *(uint4*)(smem + woff) = ra0; *(uint4*)(smem + woff + 8192) = ra1;
  *(uint4*)(smem + 16384 + woff) = rb0; *(uint4*)(smem + 16384 + woff + 8192) = rb1;
  __syncthreads();
  const int sw = (r >> 1) & 7;
  const int aoff0 = (wm * 64 + r) * 128, aoff1 = aoff0 + 32 * 128;
  const int boff = 16384 + (wn * 32 + r) * 128;
#pragma unroll 1
  for (int kt = 0; kt < K / 64; ++kt) {
    const char* st = smem + (kt & 1) * 32768;
    if (kt + 1 < K / 64) {
      ra0 = *(const uint4*)(Ag + (kt + 1) * 64); ra1 = *(const uint4*)(Ag + (size_t)64 * K + (kt + 1) * 64);
      rb0 = *(const uint4*)(Bg + (kt + 1) * 64); rb1 = *(const uint4*)(Bg + (size_t)64 * K + (kt + 1) * 64);
    }
#pragma unroll
    for (int s = 0; s < 4; ++s) {
      int co = ((2 * s + h) ^ sw) << 4;
      bf16x8 a0 = *(const bf16x8*)(st + aoff0 + co);
      bf16x8 a1 = *(const bf16x8*)(st + aoff1 + co);
      bf16x8 b = *(const bf16x8*)(st + boff + co);
      acc0 = MFMA32(a0, b, acc0);
      acc1 = MFMA32(a1, b, acc1);
    }
    if (kt + 1 < K / 64) {
      char* sn = smem + ((kt + 1) & 1) * 32768;
      *(uint4*)(sn + woff) = ra0; *(uint4*)(sn + woff + 8192) = ra1;
      *(uint4*)(sn + 16384 + woff) = rb0; *(uint4*)(sn + 16384 + woff + 8192) = rb1;
    }
    __syncthreads();
  }
  float* Cs = (float*)smem;
  constexpr int CS = 132;
#pragma unroll
  for (int i = 0; i < 16; ++i) {
    int row = (i & 3) + 8 * (i >> 2) + 4 * h;
    Cs[(wm * 64 + row) * CS + wn * 32 + r] = acc0[i];
    Cs[(wm * 64 + 32 + row) * CS + wn * 32 + r] = acc1[i];
  }
  __syncthreads();
  if (EPI == 0) {
    for (int i = tid; i < 128 * 16; i += NTHR) {
      int row = i >> 4, c8 = (i & 15) * 8;
      const float* cr = Cs + row * CS + c8;
      float4 v0 = *(const float4*)cr, v1 = *(const float4*)(cr + 4);
      *(uint4*)(Cb + (size_t)(m0 + row) * N + n0 + c8) = make_uint4(pk2bf(v0.x, v0.y), pk2bf(v0.z, v0.w), pk2bf(v1.x, v1.y), pk2bf(v1.z, v1.w));
    }
  } else if (EPI == 2) {
    for (int i = tid; i < 128 * 32; i += NTHR) {
      const int col = i >> 5, r4 = (i & 31) * 4;
      const float4 v = make_float4(Cs[r4 * CS + col], Cs[(r4 + 1) * CS + col], Cs[(r4 + 2) * CS + col], Cs[(r4 + 3) * CS + col]);
      *(float4*)(xs + (size_t)(n0 + col) * N + m0 + r4) = v;
    }
  } else {
    for (int i = tid; i < 128 * 32; i += NTHR) {
      int row = i >> 5, c4 = (i & 31) * 4;
      int rr = m0 + row; int b = rr / NT, p = rr % NT; int mrow = p < CTX ? 2 : b;
      const float* gt = gate_base + mrow * NMOD + n0 + c4;
      float4 v = *(const float4*)(Cs + row * CS + c4);
      const float* rsrc = xin ? (p < CTX ? ctxin + ((size_t)b * CTX + p) * D : xin + ((size_t)b * SEQ + (p - CTX)) * D) : xs + (size_t)rr * D;
      float4 xv = *(const float4*)(rsrc + n0 + c4);
      xv.x += gt[0] * v.x; xv.y += gt[1] * v.y; xv.z += gt[2] * v.z; xv.w += gt[3] * v.w;
      *(float4*)(xs + (size_t)rr * D + n0 + c4) = xv;
    }
  }
}


struct AttnArgs {
  const bf16_t *QA, *KA, *VAt, *QW, *KW, *VWt, *QG, *KG, *VGt;
  const float *g_qk_diff, *g_qk_win, *g_qk_glob, *sink, *lambda_diff, *g_mix_out;
  float lambda_init;
  int pad0;
  bf16_t* A2;
  float* Oslab;
  float* Lslab;
};

DI void store_head_bf16(char* wl, const float (&o)[32], float rs, const float* __restrict__ gm, bf16_t* __restrict__ dst_row0  ,
                        int lane) {
  const int r = lane & 31, h = lane >> 5;
#pragma unroll
  for (int dt = 0; dt < 2; ++dt)
#pragma unroll
    for (int q4 = 0; q4 < 4; ++q4) {
      const int dv = 32 * dt + 8 * q4 + 4 * h;
      const float* ov = o + 16 * dt + 4 * q4;
      *(uint2*)(wl + r * 136 + dv * 2) = make_uint2(pk2bf(ov[0] * rs * gm[dv], ov[1] * rs * gm[dv + 1]), pk2bf(ov[2] * rs * gm[dv + 2], ov[3] * rs * gm[dv + 3]));
    }
  asm volatile("s_waitcnt lgkmcnt(0)" ::: "memory");
#pragma unroll
  for (int ps = 0; ps < 4; ++ps) {
    const int row = ps * 8 + (lane >> 3), ch = lane & 7;
    const uint2 a = *(const uint2*)(wl + row * 136 + ch * 16), c = *(const uint2*)(wl + row * 136 + ch * 16 + 8);
    *(uint4*)(dst_row0 + (size_t)row * D + ch * 8) = make_uint4(a.x, a.y, c.x, c.y);
  }
  asm volatile("s_waitcnt lgkmcnt(0)" ::: "memory");
}
DI void store_head_f32(char* wl, const f32x16& Oa, const f32x16& Ob, float* __restrict__ dst_row0, int lane) {
  const int r = lane & 31, h = lane >> 5;
#pragma unroll
  for (int dt = 0; dt < 2; ++dt)
#pragma unroll
    for (int q4 = 0; q4 < 4; ++q4) {
      const f32x16& O = dt == 0 ? Oa : Ob;
      *(float4*)(wl + r * 272 + (32 * dt + 8 * q4 + 4 * h) * 4) = make_float4(O[4 * q4], O[4 * q4 + 1], O[4 * q4 + 2], O[4 * q4 + 3]);
    }
  asm volatile("s_waitcnt lgkmcnt(0)" ::: "memory");
#pragma unroll
  for (int ps = 0; ps < 8; ++ps) {
    const int row = ps * 4 + (lane >> 4), ch = lane & 15;
    *(float4*)(dst_row0 + (size_t)row * 64 + ch * 4) = *(const float4*)(wl + row * 272 + ch * 16);
  }
  asm volatile("s_waitcnt lgkmcnt(0)" ::: "memory");
}

template <int TYPE>
DI void attn_item(const AttnArgs& a, int b, int g, int p0, int ctx0, int nctx, int lat0, int nkt, int half, char* smem) {
  constexpr int DQK = TYPE == 0 ? 32 : 64;
  constexpr int KS = DQK / 16;
  const int tid = TID, lane = tid & 63, wid = tid >> 6;
  const int r = lane & 31, h = lane >> 5;
  const bf16_t *Q0, *Q1, *K0, *K1, *Vt;
  const float* gqk;
  if (TYPE == 0) {
    Q0 = a.QA + ((size_t)b * 8 + 2 * g) * NT * 32; Q1 = Q0 + (size_t)NT * 32;
    K0 = a.KA + ((size_t)b * 8 + 2 * g) * NT * 32; K1 = K0 + (size_t)NT * 32;
    Vt = a.VAt + ((size_t)b * 4 + g) * 64 * NT; gqk = a.g_qk_diff;
  } else if (TYPE == 1) {
    Q0 = a.QW + ((size_t)b * 4 + 2 * g) * NT * 64; Q1 = Q0 + (size_t)NT * 64;
    K0 = a.KW + ((size_t)b * 2 + g) * NT * 64; K1 = K0;
    Vt = a.VWt + ((size_t)b * 2 + g) * 64 * NT; gqk = a.g_qk_win;
  } else {
    Q0 = a.QG + ((size_t)b * 4 + 2 * g) * NT * 64; Q1 = Q0 + (size_t)NT * 64;
    K0 = a.KG + ((size_t)b * 2 + g) * NT * 64; K1 = K0;
    Vt = a.VGt + ((size_t)b * 2 + g) * 64 * NT; gqk = a.g_qk_glob;
  }
  (void)gqk;
  const int qpos = p0 + wid * 32 + r;
  bf16x8 qf0[KS], qf1[KS];
#pragma unroll
  for (int s = 0; s < KS; ++s) {
    qf0[s] = *(const bf16x8*)(Q0 + (size_t)qpos * DQK + 16 * s + 8 * h);
    qf1[s] = *(const bf16x8*)(Q1 + (size_t)qpos * DQK + 16 * s + 8 * h);
  }
  f32x16 O00, O01, O10, O11, Zero;
#pragma unroll
  for (int i = 0; i < 16; ++i) { O00[i] = 0.f; O01[i] = 0.f; O10[i] = 0.f; O11[i] = 0.f; Zero[i] = 0.f; }
  float l0 = 0.f, l1 = 0.f;

  auto tile_of = [&](int it) { return it < nctx ? ctx0 + it : lat0 + it - nctx; };
  const int wvu = __builtin_amdgcn_readfirstlane(tid >> 6);
#define ATT_GLDS(kt_, sb_)                                                                               \
  {                                                                                                      \
    const int kt__ = (kt_);                                                                              \
    LAS char* sl__ = (LAS char*)(sb_);                                                                   \
    if (TYPE == 0) {                                                                                     \
      const int row = tid >> 2, ch = (tid & 3) ^ ((row >> 2) & 3);                                       \
      __builtin_amdgcn_global_load_lds((const unsigned*)(K0 + (size_t)(kt__ * 128 + row) * 32 + ch * 8), (LAS unsigned*)(sl__ + wvu * 1024), 16, 0, 0);          \
      __builtin_amdgcn_global_load_lds((const unsigned*)(K1 + (size_t)(kt__ * 128 + row) * 32 + ch * 8), (LAS unsigned*)(sl__ + 8192 + wvu * 1024), 16, 0, 0);   \
    } else {                                                                                             \
      _Pragma("unroll") for (int i2 = 0; i2 < 2; ++i2) {                                                 \
        const int lc = tid + 512 * i2; const int row = lc >> 3, ch = (lc & 7) ^ ((row >> 1) & 7);        \
        __builtin_amdgcn_global_load_lds((const unsigned*)(K0 + (size_t)(kt__ * 128 + row) * 64 + ch * 8), (LAS unsigned*)(sl__ + i2 * 8192 + wvu * 1024), 16, 0, 0); \
      }                                                                                                  \
    }                                                                                                    \
    _Pragma("unroll") for (int i2 = 0; i2 < 2; ++i2) {                                                   \
      const int lc = tid + 512 * i2; const int row = lc >> 4, ch = (lc & 15) ^ (row & 15);               \
      __builtin_amdgcn_global_load_lds((const unsigned*)(Vt + (size_t)row * NT + kt__ * 128 + ch * 8), (LAS unsigned*)(sl__ + 16384 + i2 * 8192 + wvu * 1024), 16, 0, 0); \
    }                                                                                                    \
  }
  __syncthreads();
  ATT_GLDS(tile_of(0), smem);
  asm volatile("s_waitcnt vmcnt(0)" ::: "memory");
  __syncthreads();
  const int qwave = p0 + wid * 32;
  const int vbase = r * 256 + ((h ^ (r & 15)) << 4);
#pragma unroll 1
  for (int it = 0; it < nkt; ++it) {
    const int kt = tile_of(it);
    const char* sb = smem + (it & 1) * 32768;
    if (it + 1 < nkt) ATT_GLDS(tile_of(it + 1), smem + ((it + 1) & 1) * 32768);
#pragma unroll 2
    for (int j = 0; j < 4; ++j) {
      const int kbase = kt * 128 + 32 * j;
      bool masked = false;
      if (TYPE == 1) {
        if (kbase >= CTX && p0 >= CTX) {
          if (kbase > qwave + 31 + 128 || kbase + 31 < qwave - 128) continue;
          masked = true;
        }
      }
      f32x16 S0 = Zero, S1 = Zero;
#pragma unroll
      for (int s = 0; s < KS; ++s) {
        if (TYPE == 0) {
          int row = 32 * j + r;
          int off = row * 64 + (((2 * s + h) ^ ((row >> 2) & 3)) << 4);
          bf16x8 k0 = *(const bf16x8*)(sb + off);
          bf16x8 k1 = *(const bf16x8*)(sb + 8192 + off);
          S0 = MFMA32(k0, qf0[s], S0);
          S1 = MFMA32(k1, qf1[s], S1);
        } else {
          int row = 32 * j + r;
          int off = row * 128 + (((2 * s + h) ^ ((row >> 1) & 7)) << 4);
          bf16x8 k0 = *(const bf16x8*)(sb + off);
          S0 = MFMA32(k0, qf0[s], S0);
          S1 = MFMA32(k0, qf1[s], S1);
        }
      }
      float pa[16], pb[16];
#pragma unroll
      for (int i = 0; i < 16; ++i) {
        float e0 = __builtin_amdgcn_exp2f(S0[i]);
        float e1 = __builtin_amdgcn_exp2f(S1[i]);
        if (TYPE == 1) {
          if (masked) {
            int kp = kbase + (i & 3) + 8 * (i >> 2) + 4 * h;
            int dd = kp - qpos;
            bool ok = (dd <= 128) && (dd >= -128);
            e0 = ok ? e0 : 0.f; e1 = ok ? e1 : 0.f;
          }
        }
        pa[i] = e0; pb[i] = e1;
      }
      l0 += ((pa[0] + pa[1]) + (pa[2] + pa[3])) + ((pa[4] + pa[5]) + (pa[6] + pa[7])) + ((pa[8] + pa[9]) + (pa[10] + pa[11])) + ((pa[12] + pa[13]) + (pa[14] + pa[15]));
      l1 += ((pb[0] + pb[1]) + (pb[2] + pb[3])) + ((pb[4] + pb[5]) + (pb[6] + pb[7])) + ((pb[8] + pb[9]) + (pb[10] + pb[11])) + ((pb[12] + pb[13]) + (pb[14] + pb[15]));
      bf16x8 pf0[2], pf1[2];
#pragma unroll
      for (int s2 = 0; s2 < 2; ++s2) {
        unsigned w0[4], w1[4];
#pragma unroll
        for (int e = 0; e < 4; ++e) {
          w0[e] = pk2bf(pa[8 * s2 + 2 * e], pa[8 * s2 + 2 * e + 1]);
          w1[e] = pk2bf(pb[8 * s2 + 2 * e], pb[8 * s2 + 2 * e + 1]);
        }
        pf0[s2] = __builtin_bit_cast(bf16x8, make_uint4(w0[0], w0[1], w0[2], w0[3]));
        pf1[s2] = __builtin_bit_cast(bf16x8, make_uint4(w1[0], w1[1], w1[2], w1[3]));
      }
#pragma unroll
      for (int s2 = 0; s2 < 2; ++s2) {
        const int vo = vbase ^ ((4 * j + 2 * s2) << 4);
        bf16x8 v0 = *(const bf16x8*)(sb + 16384 + vo);
        bf16x8 v1 = *(const bf16x8*)(sb + 16384 + 8192 + vo);
        O00 = MFMA32(v0, pf0[s2], O00);
        O01 = MFMA32(v1, pf0[s2], O01);
        O10 = MFMA32(v0, pf1[s2], O10);
        O11 = MFMA32(v1, pf1[s2], O11);
      }
    }
    asm volatile("s_waitcnt vmcnt(0)" ::: "memory");
    __syncthreads();
  }
  l0 += shxl(l0, lane, 32);
  l1 += shxl(l1, lane, 32);
  if (TYPE == 1) {
    l0 += __builtin_amdgcn_exp2f(a.sink[2 * g] * LOG2E);
    l1 += __builtin_amdgcn_exp2f(a.sink[2 * g + 1] * LOG2E);
  }
  const size_t orow0 = (size_t)b * NT + p0 + wid * 32;
  char* wl = smem + wid * 8704;
  if (TYPE == 2) {
#pragma unroll
    for (int x = 0; x < 2; ++x) {
      int head = 2 * g + x;
      float* dst0 = a.Oslab + ((((size_t)half * NB + b) * 4 + head) * NT + (p0 + wid * 32)) * 64;
      if (x == 0) store_head_f32(wl, O00, O01, dst0, lane); else store_head_f32(wl, O10, O11, dst0, lane);
      if (h == 0) a.Lslab[(((size_t)half * NB + b) * 4 + head) * NT + qpos] = x == 0 ? l0 : l1;
    }
  } else if (TYPE == 0) {
    float s0 = 0.f, s1 = 0.f;
    for (int d = 0; d < 32; ++d) { s0 += a.lambda_diff[d] * a.lambda_diff[32 + d]; s1 += a.lambda_diff[64 + d] * a.lambda_diff[96 + d]; }
    const float lam = __expf(s0) - __expf(s1) + a.lambda_init;
    const float i0 = 1.f / l0, i1 = lam / l1;
    float o[32];
    float ss = 0.f;
#pragma unroll
    for (int i = 0; i < 16; ++i) {
      o[i] = O00[i] * i0 - O10[i] * i1;
      o[16 + i] = O01[i] * i0 - O11[i] * i1;
      ss += o[i] * o[i] + o[16 + i] * o[16 + i];
    }
    ss += shxl(ss, lane, 32);
    const float rs = rsqrtf(ss * (1.f / 64) + EPS) * (1.f - a.lambda_init);
    const float* gm = a.g_mix_out + g * 64;
    store_head_bf16(wl, o, rs, gm, a.A2 + orow0 * D + g * 64, lane);
  } else {
#pragma unroll
    for (int x = 0; x < 2; ++x) {
      const float inv = 1.f / (x == 0 ? l0 : l1);
      float o[32];
      float ss = 0.f;
#pragma unroll
      for (int i = 0; i < 16; ++i) {
        o[i] = (x == 0 ? O00[i] : O10[i]) * inv;
        o[16 + i] = (x == 0 ? O01[i] : O11[i]) * inv;
        ss += o[i] * o[i] + o[16 + i] * o[16 + i];
      }
      ss += shxl(ss, lane, 32);
      const float rs = rsqrtf(ss * (1.f / 64) + EPS);
      const int col0 = 256 + (2 * g + x) * 64;
      const float* gm = a.g_mix_out + col0;
      store_head_bf16(wl, o, rs, gm, a.A2 + orow0 * D + col0, lane);
    }
  }
}

DI void attn_dispatch(const AttnArgs& a, int idx, int want_ctx, char* smem) {
  if (idx < 256) {
    int b = idx >> 7, g = (idx >> 5) & 3, qt = 1 + (idx & 31);
    attn_item<0>(a, b, g, qt * 256, 0, 2, 2, 66, 0, smem);
  } else if (idx < 512) {
    int i = idx - 256; int half = i >> 7, b = (i >> 6) & 1, g = (i >> 5) & 1, qt = 1 + (i & 31);
    if (half == 0) attn_item<2>(a, b, g, qt * 256, 0, 2, 2, 33, 0, smem);
    else attn_item<2>(a, b, g, qt * 256, 0, 0, 33, 33, 1, smem);
  } else if (idx < 640) {
    int i = idx - 512; int b = i >> 6, g = (i >> 5) & 1, qt = 1 + (i & 31);
    int lo = max(2, 2 * qt - 1), hi = min(65, 2 * qt + 2);
    attn_item<1>(a, b, g, qt * 256, 0, 2, lo, 2 + (hi - lo + 1), 0, smem);
  } else if (want_ctx) {
    int i = idx - 640;
    if (i < 8) attn_item<0>(a, i >> 2, i & 3, 0, 0, 2, 0, 2, 0, smem);
    else if (i < 16) { int k = i - 8; int half = k >> 2, b = (k >> 1) & 1, g = k & 1; attn_item<2>(a, b, g, 0, half, 1, 0, 1, half, smem); }
    else if (i < 20) { int k = i - 16; attn_item<1>(a, k >> 1, k & 1, 0, 0, 2, 0, 2, 0, smem); }
  }
}

typedef __attribute__((ext_vector_type(4))) float f32x4v;
typedef __attribute__((ext_vector_type(2))) _Float16 h2_t;
DI unsigned pack_i8x4(float a, float b, float c, float d) {
  const int ia = (int)__builtin_rintf(a), ib = (int)__builtin_rintf(b), ic = (int)__builtin_rintf(c), id = (int)__builtin_rintf(d);
  return (unsigned)(ia & 255) | ((unsigned)(ib & 255) << 8) | ((unsigned)(ic & 255) << 16) | ((unsigned)id << 24);
}
constexpr size_t TSLICE = (size_t)16384 * 128;
DI void tabconv_fin_i8(float4 v0, float4 v1, float4 v2, float4 v3, unsigned char* __restrict__ dst, float* __restrict__ scale, size_t row, int lane) {
  float m = fmaxf(fmaxf(fmaxf(fabsf(v0.x), fabsf(v0.y)), fmaxf(fabsf(v0.z), fabsf(v0.w))), fmaxf(fmaxf(fabsf(v1.x), fabsf(v1.y)), fmaxf(fabsf(v1.z), fabsf(v1.w))));
  m = fmaxf(m, fmaxf(fmaxf(fmaxf(fabsf(v2.x), fabsf(v2.y)), fmaxf(fabsf(v2.z), fabsf(v2.w))), fmaxf(fmaxf(fabsf(v3.x), fabsf(v3.y)), fmaxf(fabsf(v3.z), fabsf(v3.w)))));
  for (int o = 32; o > 0; o >>= 1) m = fmaxf(m, shxl(m, lane, o));
  m = fmaxf(m, 1e-30f);
  const float sc = m * (1.f / 127.f), inv = 127.f / m;
  *(uint4*)(dst + (size_t)(lane >> 3) * TSLICE + row * 128 + (lane & 7) * 16) = make_uint4(pack_i8x4(v0.x * inv, v0.y * inv, v0.z * inv, v0.w * inv), pack_i8x4(v1.x * inv, v1.y * inv, v1.z * inv, v1.w * inv),
                                                    pack_i8x4(v2.x * inv, v2.y * inv, v2.z * inv, v2.w * inv), pack_i8x4(v3.x * inv, v3.y * inv, v3.z * inv, v3.w * inv));
  if (lane == 0) scale[row] = sc;
}
DI void tabconv_fin(float4 v0, float4 v1, float4 v2, float4 v3, unsigned char* __restrict__ dst, float* __restrict__ scale, size_t row, int lane) {
  float m = fmaxf(fmaxf(fmaxf(fabsf(v0.x), fabsf(v0.y)), fmaxf(fabsf(v0.z), fabsf(v0.w))), fmaxf(fmaxf(fabsf(v1.x), fabsf(v1.y)), fmaxf(fabsf(v1.z), fabsf(v1.w))));
  m = fmaxf(m, fmaxf(fmaxf(fmaxf(fabsf(v2.x), fabsf(v2.y)), fmaxf(fabsf(v2.z), fabsf(v2.w))), fmaxf(fmaxf(fabsf(v3.x), fabsf(v3.y)), fmaxf(fabsf(v3.z), fabsf(v3.w)))));
  for (int o = 32; o > 0; o >>= 1) m = fmaxf(m, shxl(m, lane, o));
  m = fmaxf(m, 1e-30f);
  const float sc = m * (1.f / 448.f), inv = 448.f / m;
  int w0 = __builtin_amdgcn_cvt_pk_fp8_f32(v0.x * inv, v0.y * inv, 0, false); w0 = __builtin_amdgcn_cvt_pk_fp8_f32(v0.z * inv, v0.w * inv, w0, true);
  int w1 = __builtin_amdgcn_cvt_pk_fp8_f32(v1.x * inv, v1.y * inv, 0, false); w1 = __builtin_amdgcn_cvt_pk_fp8_f32(v1.z * inv, v1.w * inv, w1, true);
  int w2 = __builtin_amdgcn_cvt_pk_fp8_f32(v2.x * inv, v2.y * inv, 0, false); w2 = __builtin_amdgcn_cvt_pk_fp8_f32(v2.z * inv, v2.w * inv, w2, true);
  int w3 = __builtin_amdgcn_cvt_pk_fp8_f32(v3.x * inv, v3.y * inv, 0, false); w3 = __builtin_amdgcn_cvt_pk_fp8_f32(v3.z * inv, v3.w * inv, w3, true);
  *(uint4*)(dst + (size_t)(lane >> 3) * TSLICE + row * 128 + (lane & 7) * 16) = make_uint4((unsigned)w0, (unsigned)w1, (unsigned)w2, (unsigned)w3);
  if (lane == 0) scale[row] = sc;
}
DI void score_sort(const bf16_t* __restrict__ qbuf, const bf16_t* __restrict__ keysb, int m0, int hp, char* smem, unsigned (&v16)[16]) {
  const int tid = TID, lane = tid & 63, wid = tid >> 6;
  const int wm = wid & 1, wn = wid >> 1;
  const int r = lane & 31, h = lane >> 5;
  f32x16 acc0, acc1;
  for (int i = 0; i < 16; ++i) { acc0[i] = 0.f; acc1[i] = 0.f; }
  const int lrow = tid >> 3, lch = tid & 7;
  const bf16_t* Ag = qbuf + (size_t)(m0 + lrow) * 2048 + hp * 128 + lch * 8;
  const bf16_t* Bg = keysb + ((size_t)hp * 128 + lrow) * 128 + lch * 8;
  const int woff = lrow * 128 + ((lch ^ ((lrow >> 1) & 7)) << 4);
  __syncthreads();
#pragma unroll
  for (int kt = 0; kt < 2; ++kt) {
    char* sn = smem + kt * 32768;
    *(uint4*)(sn + woff) = *(const uint4*)(Ag + kt * 64);
    *(uint4*)(sn + woff + 8192) = *(const uint4*)(Ag + (size_t)64 * 2048 + kt * 64);
    *(uint4*)(sn + 16384 + woff) = *(const uint4*)(Bg + kt * 64);
    *(uint4*)(sn + 16384 + woff + 8192) = *(const uint4*)(Bg + 64 * 128 + kt * 64);
  }
  __syncthreads();
  const int sw = (r >> 1) & 7;
  const int aoff0 = (wm * 64 + r) * 128, aoff1 = aoff0 + 32 * 128;
  const int boff = 16384 + (wn * 32 + r) * 128;
#pragma unroll
  for (int kt = 0; kt < 2; ++kt) {
    const char* st = smem + kt * 32768;
#pragma unroll
    for (int s = 0; s < 4; ++s) {
      int co = ((2 * s + h) ^ sw) << 4;
      bf16x8 a0 = *(const bf16x8*)(st + aoff0 + co);
      bf16x8 a1 = *(const bf16x8*)(st + aoff1 + co);
      bf16x8 b = *(const bf16x8*)(st + boff + co);
      acc0 = MFMA32(a0, b, acc0);
      acc1 = MFMA32(a1, b, acc1);
    }
  }
  __syncthreads();
  float* Cs = (float*)smem;
  constexpr int CS = 132;
#pragma unroll
  for (int i = 0; i < 16; ++i) {
    int row = (i & 3) + 8 * (i >> 2) + 4 * h;
    Cs[(wm * 64 + row) * CS + wn * 32 + r] = acc0[i];
    Cs[(wm * 64 + 32 + row) * CS + wn * 32 + r] = acc1[i];
  }
  __syncthreads();
  const int row = tid >> 2, q = tid & 3;
  unsigned v[32];
#pragma unroll
  for (int i = 0; i < 32; ++i) {
    unsigned u = __float_as_uint(Cs[row * CS + 4 * i + q]);
    u ^= (u & 0x80000000u) ? 0xffffffffu : 0x80000000u;
    v[i] = (u & ~127u) | (unsigned)(127 - (4 * i + q));
  }
#pragma unroll
  for (int k = 2; k <= 32; k <<= 1)
#pragma unroll
    for (int j = k >> 1; j > 0; j >>= 1)
#pragma unroll
      for (int i = 0; i < 32; ++i) {
        const int l = i ^ j;
        if (l > i) {
          const unsigned lo = min(v[i], v[l]), hi = max(v[i], v[l]);
          if ((i & k) == 0) { v[i] = hi; v[l] = lo; } else { v[i] = lo; v[l] = hi; }
        }
      }
#pragma unroll
  for (int step = 0; step < 2; ++step) {
    unsigned c[16];
#pragma unroll
    for (int i = 0; i < 16; ++i) {
      const unsigned o = step == 0 ? (unsigned)__builtin_amdgcn_mov_dpp((int)v[15 - i], 0xB1, 0xf, 0xf, false)
                                   : (unsigned)__builtin_amdgcn_mov_dpp((int)v[15 - i], 0x4E, 0xf, 0xf, false);
      c[i] = max(v[i], o);
    }
#pragma unroll
    for (int j = 8; j > 0; j >>= 1)
#pragma unroll
      for (int i = 0; i < 16; ++i) {
        const int l = i ^ j;
        if (l > i) { const unsigned lo = min(c[i], c[l]), hi = max(c[i], c[l]); c[i] = hi; c[l] = lo; }
      }
#pragma unroll
    for (int i = 0; i < 16; ++i) v[i] = c[i];
  }
#pragma unroll
  for (int i = 0; i < 16; ++i) v16[i] = v[i];
}
constexpr int CAND_I[52] = {0, 0, 0, 0, 0, 0, 0, 0, 0, 0, 0, 0, 0, 0, 0, 0, 1, 1, 1, 1, 1, 1, 1, 1, 2, 2, 2, 2, 2, 3, 3, 3, 3, 4, 4, 4, 5, 5, 6, 6, 7, 7, 8, 9, 10, 11, 12, 13, 14, 15, 0, 0};
constexpr int CAND_J[52] = {0, 1, 2, 3, 4, 5, 6, 7, 8, 9, 10, 11, 12, 13, 14, 15, 0, 1, 2, 3, 4, 5, 6, 7, 0, 1, 2, 3, 4, 0, 1, 2, 3, 0, 1, 2, 0, 1, 0, 1, 0, 1, 0, 0, 0, 0, 0, 0, 0, 0, 0, 0};
DI float sel4(int q, float a, float b, float c, float d) { return q == 0 ? a : q == 1 ? b : q == 2 ? c : d; }
DI unsigned sel4u(int q, unsigned a, unsigned b, unsigned c, unsigned d) { return q == 0 ? a : q == 1 ? b : q == 2 ? c : d; }
DI float key7f(unsigned k) { k &= ~127u; k ^= (k & 0x80000000u) ? 0x80000000u : 0xffffffffu; return __uint_as_float(k); }
DI float key8f(unsigned k) { k &= ~255u; k ^= (k & 0x80000000u) ? 0x80000000u : 0xffffffffu; return __uint_as_float(k); }
DI void score_head_item(const bf16_t* __restrict__ qbuf, const bf16_t* __restrict__ keysb, int m0, int hd, char* smem, int* __restrict__ experts,
                        float* __restrict__ gates) {
  unsigned ka[16], kb[16];
  score_sort(qbuf, keysb, m0, 2 * hd, smem, ka);
  score_sort(qbuf, keysb, m0, 2 * hd + 1, smem, kb);
  const int tid = TID, row = tid >> 2, q = tid & 3;
  unsigned char* ix = (unsigned char*)(smem + 69632) + row * 32;
  *(unsigned*)(ix + 4 * q) = (sel4u(q, ka[0], ka[4], ka[8], ka[12]) & 127u) | ((sel4u(q, ka[1], ka[5], ka[9], ka[13]) & 127u) << 8) |
                             ((sel4u(q, ka[2], ka[6], ka[10], ka[14]) & 127u) << 16) | ((sel4u(q, ka[3], ka[7], ka[11], ka[15]) & 127u) << 24);
  *(unsigned*)(ix + 16 + 4 * q) = (sel4u(q, kb[0], kb[4], kb[8], kb[12]) & 127u) | ((sel4u(q, kb[1], kb[5], kb[9], kb[13]) & 127u) << 8) |
                                  ((sel4u(q, kb[2], kb[6], kb[10], kb[14]) & 127u) << 16) | ((sel4u(q, kb[3], kb[7], kb[11], kb[15]) & 127u) << 24);
  float a[16], b[16];
#pragma unroll
  for (int i = 0; i < 16; ++i) { a[i] = key7f(ka[i]); b[i] = key7f(kb[i]); }
  unsigned c[16];
#pragma unroll
  for (int t = 0; t < 16; ++t) {
    if (4 * t >= 52) { c[t] = 0u; continue; }
    const float sv = sel4(q, a[CAND_I[4 * t]], a[CAND_I[4 * t + 1]], a[CAND_I[4 * t + 2]], a[CAND_I[4 * t + 3]]) +
                     sel4(q, b[CAND_J[4 * t]], b[CAND_J[4 * t + 1]], b[CAND_J[4 * t + 2]], b[CAND_J[4 * t + 3]]);
    const unsigned code = sel4u(q, CAND_I[4 * t] * 16 + CAND_J[4 * t], CAND_I[4 * t + 1] * 16 + CAND_J[4 * t + 1], CAND_I[4 * t + 2] * 16 + CAND_J[4 * t + 2],
                                CAND_I[4 * t + 3] * 16 + CAND_J[4 * t + 3]);
    unsigned u = __float_as_uint(sv);
    u ^= (u & 0x80000000u) ? 0xffffffffu : 0x80000000u;
    const bool valid = (4 * t + q) < 50;
    c[t] = valid ? ((u & ~255u) | code) : 0u;
  }
#pragma unroll
  for (int k = 2; k <= 16; k <<= 1)
#pragma unroll
    for (int j = k >> 1; j > 0; j >>= 1)
#pragma unroll
      for (int i = 0; i < 16; ++i) {
        const int l = i ^ j;
        if (l > i) {
          const unsigned lo = min(c[i], c[l]), hi = max(c[i], c[l]);
          if ((i & k) == 0) { c[i] = hi; c[l] = lo; } else { c[i] = lo; c[l] = hi; }
        }
      }
#pragma unroll
  for (int step = 0; step < 2; ++step) {
    unsigned d[16];
#pragma unroll
    for (int i = 0; i < 16; ++i) {
      const unsigned o = step == 0 ? (unsigned)__builtin_amdgcn_mov_dpp((int)c[15 - i], 0xB1, 0xf, 0xf, false)
                                   : (unsigned)__builtin_amdgcn_mov_dpp((int)c[15 - i], 0x4E, 0xf, 0xf, false);
      d[i] = max(c[i], o);
    }
#pragma unroll
    for (int j = 8; j > 0; j >>= 1)
#pragma unroll
      for (int i = 0; i < 16; ++i) {
        const int l = i ^ j;
        if (l > i) { const unsigned lo = min(d[i], d[l]), hi = max(d[i], d[l]); d[i] = hi; d[l] = lo; }
      }
#pragma unroll
    for (int i = 0; i < 16; ++i) c[i] = d[i];
  }
  const float mx = key8f(c[0]);
  float e[16]; float sum = 0.f;
#pragma unroll
  for (int i = 0; i < 16; ++i) { e[i] = __expf(key8f(c[i]) - mx); sum += e[i]; }
  const float inv = 1.f / sum;
  asm volatile("s_waitcnt lgkmcnt(0)" ::: "memory");
  int eo[4]; float go[4];
#pragma unroll
  for (int k = 0; k < 4; ++k) {
    const unsigned code = sel4u(q, c[k], c[4 + k], c[8 + k], c[12 + k]) & 255u;
    go[k] = sel4(q, e[k], e[4 + k], e[8 + k], e[12 + k]) * inv;
    eo[k] = (127 - (int)ix[code >> 4]) * 128 + (127 - (int)ix[16 + (code & 15)]);
  }
  const size_t o = (size_t)(m0 + row) * 128 + hd * 16 + 4 * q;
  *(uint2*)((unsigned short*)experts + o) = make_uint2((unsigned)eo[0] | ((unsigned)eo[1] << 16), (unsigned)eo[2] | ((unsigned)eo[3] << 16));
  *(float4*)(gates + o) = make_float4(go[0], go[1], go[2], go[3]);
}

DI float key2f(unsigned k) { k &= ~127u; k ^= (k & 0x80000000u) ? 0x80000000u : 0xffffffffu; return __uint_as_float(k); }
DI void merge_one(const unsigned* __restrict__ topk, int r, int hd, int* experts, float* gates) {
  const unsigned* ka = topk + ((size_t)r * 16 + 2 * hd) * 16;
  const unsigned* kb = ka + 16;
  float a[16], bq[16];
#pragma unroll
  for (int i = 0; i < 4; ++i) {
    uint4 x = ((const uint4*)ka)[i], y = ((const uint4*)kb)[i];
    a[4 * i] = key2f(x.x); a[4 * i + 1] = key2f(x.y); a[4 * i + 2] = key2f(x.z); a[4 * i + 3] = key2f(x.w);
    bq[4 * i] = key2f(y.x); bq[4 * i + 1] = key2f(y.y); bq[4 * i + 2] = key2f(y.z); bq[4 * i + 3] = key2f(y.w);
  }
  float cv[50];
  {
    int n = 0;
#pragma unroll
    for (int i = 0; i < 16; ++i)
#pragma unroll
      for (int j = 0; j < 16; ++j)
        if ((i + 1) * (j + 1) <= 16) { cv[n] = a[i] + bq[j]; ++n; }
  }
  int* eo = experts + hd * 16;
  float* go = gates + hd * 16;
  float mx = 0.f, sum = 0.f;
#pragma unroll 1
  for (int k = 0; k < 16; ++k) {
    float mval = cv[0]; int code = 0;
    {
      int n = 0;
#pragma unroll
      for (int i = 0; i < 16; ++i)
#pragma unroll
        for (int j = 0; j < 16; ++j)
          if ((i + 1) * (j + 1) <= 16) {
            if (n > 0) { bool gt = cv[n] > mval; mval = gt ? cv[n] : mval; code = gt ? (i * 16 + j) : code; }
            ++n;
          }
    }
    {
      int n = 0;
#pragma unroll
      for (int i = 0; i < 16; ++i)
#pragma unroll
        for (int j = 0; j < 16; ++j)
          if ((i + 1) * (j + 1) <= 16) { cv[n] = (code == i * 16 + j) ? -3.0e38f : cv[n]; ++n; }
    }
    if (k == 0) mx = mval;
    const float e = __expf(mval - mx);
    sum += e;
    eo[k] = (int)(127u - (ka[code >> 4] & 127u)) * 128 + (int)(127u - (kb[code & 15] & 127u));
    go[k] = e;
  }
  const float inv = 1.f / sum;
#pragma unroll
  for (int i = 0; i < 4; ++i) {
    float4 g4 = ((float4*)go)[i];
    g4.x *= inv; g4.y *= inv; g4.z *= inv; g4.w *= inv;
    ((float4*)go)[i] = g4;
  }
}

template <int MODE>
DI void peer_token(int r, const bf16_t* __restrict__ hbuf, const int* ex_row, const float* g_row,
                   const unsigned char* __restrict__ u8, const float* __restrict__ us, const unsigned char* __restrict__ v8,
                   const float* __restrict__ vs, const float* __restrict__ modv_l, float* __restrict__ xs, float* wdots  ,
                   float* __restrict__ outp, int* __restrict__ ex_out, float* __restrict__ w_out) {
  const int lane = TID & 63;
  float x[16];
  {
    const uint2* hr = (const uint2*)(hbuf + (size_t)r * D + lane * 4);
#pragma unroll
    for (int c = 0; c < 4; ++c) { const uint2 a = hr[64 * c]; x[4 * c] = bflo(a.x); x[4 * c + 1] = bfhi(a.x); x[4 * c + 2] = bflo(a.y); x[4 * c + 3] = bfhi(a.y); }
  }
  const int e0 = ex_row[lane], e1 = ex_row[64 + lane];
  const float g0 = g_row[lane], g1 = g_row[64 + lane];
  const float us0 = us[e0], us1 = us[e1], vs0 = vs[e0], vs1 = vs[e1];
#define PEER_LOAD8(rw_, tab_, k0_)                                                          \
  {                                                                                         \
    _Pragma("unroll") for (int j = 0; j < 8; ++j) {                                         \
      int e = __builtin_amdgcn_readlane((k0_) < 64 ? e0 : e1, ((k0_) + j) & 63);            \
      rw_[j] = *(const uint4*)((tab_) + (size_t)e * D + lane * 16);                         \
    }                                                                                       \
  }
#define PEER_UDOT8(rw_, k0_)                                                                \
  {                                                                                         \
    float p[8];                                                                             \
    _Pragma("unroll") for (int j = 0; j < 8; ++j) {                                         \
      f32x2_t a0 = __builtin_amdgcn_cvt_pk_f32_fp8((int)rw_[j].x, false), a1 = __builtin_amdgcn_cvt_pk_f32_fp8((int)rw_[j].x, true); \
      f32x2_t b0 = __builtin_amdgcn_cvt_pk_f32_fp8((int)rw_[j].y, false), b1 = __builtin_amdgcn_cvt_pk_f32_fp8((int)rw_[j].y, true); \
      f32x2_t c0 = __builtin_amdgcn_cvt_pk_f32_fp8((int)rw_[j].z, false), c1 = __builtin_amdgcn_cvt_pk_f32_fp8((int)rw_[j].z, true); \
      f32x2_t d0 = __builtin_amdgcn_cvt_pk_f32_fp8((int)rw_[j].w, false), d1 = __builtin_amdgcn_cvt_pk_f32_fp8((int)rw_[j].w, true); \
      float s = a0[0] * x[0] + a0[1] * x[1] + a1[0] * x[2] + a1[1] * x[3];                  \
      s += b0[0] * x[4] + b0[1] * x[5] + b1[0] * x[6] + b1[1] * x[7];                       \
      s += c0[0] * x[8] + c0[1] * x[9] + c1[0] * x[10] + c1[1] * x[11];                     \
      s += d0[0] * x[12] + d0[1] * x[13] + d1[0] * x[14] + d1[1] * x[15];                   \
      p[j] = s;                                                                             \
    }                                                                                       \
    float q4[4];                                                                            \
    _Pragma("unroll") for (int i = 0; i < 4; ++i) { float send = hi32 ? p[i] : p[4 + i]; float keep = hi32 ? p[4 + i] : p[i]; q4[i] = keep + shxl(send, lane, 32); } \
    float q2[2];                                                                            \
    _Pragma("unroll") for (int i = 0; i < 2; ++i) { float send = hi16 ? q4[i] : q4[2 + i]; float keep = hi16 ? q4[2 + i] : q4[i]; q2[i] = keep + shxl(send, lane, 16); } \
    float q1;                                                                               \
    { float send = hi8 ? q2[0] : q2[1]; float keep = hi8 ? q2[1] : q2[0]; q1 = keep + shxl(send, lane, 8); } \
    q1 += shxl(q1, lane, 4); q1 += shxl(q1, lane, 2); q1 += shxl(q1, lane, 1);              \
    if ((lane & 7) == 0) wdots[(k0_) + (lane >> 3)] = q1;                                   \
  }
#define PEER_VACC8(rw_, k0_)                                                                \
  {                                                                                         \
    _Pragma("unroll") for (int j = 0; j < 8; ++j) {                                         \
      float w = __builtin_bit_cast(float, __builtin_amdgcn_readlane(__builtin_bit_cast(int, (k0_) < 64 ? w0 : w1), ((k0_) + j) & 63)); \
      f32x2_t a0 = __builtin_amdgcn_cvt_pk_f32_fp8((int)rw_[j].x, false), a1 = __builtin_amdgcn_cvt_pk_f32_fp8((int)rw_[j].x, true); \
      f32x2_t b0 = __builtin_amdgcn_cvt_pk_f32_fp8((int)rw_[j].y, false), b1 = __builtin_amdgcn_cvt_pk_f32_fp8((int)rw_[j].y, true); \
      f32x2_t c0 = __builtin_amdgcn_cvt_pk_f32_fp8((int)rw_[j].z, false), c1 = __builtin_amdgcn_cvt_pk_f32_fp8((int)rw_[j].z, true); \
      f32x2_t d0 = __builtin_amdgcn_cvt_pk_f32_fp8((int)rw_[j].w, false), d1 = __builtin_amdgcn_cvt_pk_f32_fp8((int)rw_[j].w, true); \
      acc[0] += w * a0[0]; acc[1] += w * a0[1]; acc[2] += w * a1[0]; acc[3] += w * a1[1];   \
      acc[4] += w * b0[0]; acc[5] += w * b0[1]; acc[6] += w * b1[0]; acc[7] += w * b1[1];   \
      acc[8] += w * c0[0]; acc[9] += w * c0[1]; acc[10] += w * c1[0]; acc[11] += w * c1[1]; \
      acc[12] += w * d0[0]; acc[13] += w * d0[1]; acc[14] += w * d1[0]; acc[15] += w * d1[1]; \
    }                                                                                       \
  }
  const bool hi32 = lane & 32, hi16 = lane & 16, hi8 = lane & 8;
  uint4 rwA[8], rwB[8];
  PEER_LOAD8(rwA, u8, 0);
#pragma unroll 1
  for (int k0 = 0; k0 < 128; k0 += 16) {
    PEER_LOAD8(rwB, u8, k0 + 8);
    PEER_UDOT8(rwA, k0);
    if (k0 + 16 < 128) { PEER_LOAD8(rwA, u8, k0 + 16); } else if (MODE == 0) { PEER_LOAD8(rwA, v8, 0); }
    PEER_UDOT8(rwB, k0 + 8);
  }
  float w0, w1;
  {
    float d0 = wdots[lane] * us0, d1 = wdots[64 + lane] * us1;
    float t0 = 0.5f * d0 * (1.f + tanhf(0.7978845608028654f * (d0 + 0.044715f * d0 * d0 * d0)));
    float t1 = 0.5f * d1 * (1.f + tanhf(0.7978845608028654f * (d1 + 0.044715f * d1 * d1 * d1)));
    w0 = g0 * t0 * vs0; w1 = g1 * t1 * vs1;
  }
  if (MODE == 1) {
    ex_out[(size_t)r * 128 + lane] = e0; ex_out[(size_t)r * 128 + 64 + lane] = e1;
    w_out[(size_t)r * 128 + lane] = w0; w_out[(size_t)r * 128 + 64 + lane] = w1;
    return;
  }
  float acc[16];
#pragma unroll
  for (int i = 0; i < 16; ++i) acc[i] = 0.f;
#pragma unroll 1
  for (int k0 = 0; k0 < 128; k0 += 16) {
    PEER_LOAD8(rwB, v8, k0 + 8);
    PEER_VACC8(rwA, k0);
    if (k0 + 16 < 128) PEER_LOAD8(rwA, v8, k0 + 16);
    PEER_VACC8(rwB, k0 + 8);
  }
  const int b = r / NT, p = r % NT; const int mrow = p < CTX ? 2 : b;
  const float* g2 = modv_l + mrow * NMOD + 5 * D + lane * 4;
  float4* xp = (float4*)(xs + (size_t)r * D + lane * 4);
  float4* op = outp ? (float4*)(outp + ((size_t)b * SEQ + (p - CTX)) * D + lane * 4) : xp;
#pragma unroll
  for (int i = 0; i < 4; ++i) {
    float4 xv = xp[64 * i]; float4 gg = ((const float4*)g2)[64 * i];
    xv.x += gg.x * acc[4 * i]; xv.y += gg.y * acc[4 * i + 1]; xv.z += gg.z * acc[4 * i + 2]; xv.w += gg.w * acc[4 * i + 3];
    op[64 * i] = xv;
  }
}

constexpr int FN = 2 * SEQ;
DI float2 cmul(float2 a, float2 b) { return make_float2(a.x * b.x - a.y * b.y, a.x * b.y + a.y * b.x); }
DI float2 cmulc(float2 a, float2 b) { return make_float2(a.x * b.x + a.y * b.y, a.y * b.x - a.x * b.y); }
DI int PX(int i) { return i + ((i >> 6) << 2); }
constexpr int FNP = FN + (FN >> 6) * 4;
DI int freq_of_pos(int pos) { return ((pos >> 10) & 15) | (((pos >> 6) & 15) << 4) | (((pos >> 2) & 15) << 8) | ((pos & 3) << 12); }
DI int pos_of_freq(int f) { return ((f & 15) << 10) | (((f >> 4) & 15) << 6) | (((f >> 8) & 15) << 2) | (f >> 12); }
DI float2 cadd(float2 a, float2 b) { return make_float2(a.x + b.x, a.y + b.y); }
DI float2 csub(float2 a, float2 b) { return make_float2(a.x - b.x, a.y - b.y); }
DI float2 cmni(float2 a) { return make_float2(a.y, -a.x); }
DI float2 cconj(float2 a) { return make_float2(a.x, -a.y); }
struct TabJob {
  const float* pu; const float* pv;
  unsigned char* du; unsigned char* dv;
  float* su; float* sv;
  int slot, wv, nw;
  int prow;
  float4 v[4];
};
DI void tab_step(TabJob& j, int lane) {
  if (j.prow >= 0) {
    if (j.prow >> 14) tabconv_fin(j.v[0], j.v[1], j.v[2], j.v[3], j.dv, j.sv, (size_t)(j.prow & 16383), lane);
    else tabconv_fin_i8(j.v[0], j.v[1], j.v[2], j.v[3], j.du, j.su, (size_t)(j.prow & 16383), lane);
    j.prow = -1;
  }
  const int row = j.slot * j.nw + j.wv;
  if (j.pu != nullptr && row < 32768) {
    const float4* sp = (const float4*)(((row >> 14) ? j.pv : j.pu) + (size_t)(row & 16383) * D);
    j.v[0] = sp[lane]; j.v[1] = sp[64 + lane]; j.v[2] = sp[128 + lane]; j.v[3] = sp[192 + lane];
    j.prow = row;
  }
  j.slot++;
}
DI void tab_flush(TabJob& j, int lane) {
  if (j.prow >= 0) {
    if (j.prow >> 14) tabconv_fin(j.v[0], j.v[1], j.v[2], j.v[3], j.dv, j.sv, (size_t)(j.prow & 16383), lane);
    else tabconv_fin_i8(j.v[0], j.v[1], j.v[2], j.v[3], j.du, j.su, (size_t)(j.prow & 16383), lane);
    j.prow = -1;
  }
}
DI void dft16(float2 (&x)[16]) {
  constexpr float C1 = 0.9238795325112867f, S1 = 0.3826834323650898f, C2 = 0.7071067811865476f;
  float2 u[16];
#pragma unroll
  for (int r = 0; r < 4; ++r) {
    const float2 a = x[r], b = x[r + 4], c = x[r + 8], d = x[r + 12];
    const float2 t0 = cadd(a, c), t1 = csub(a, c), t2 = cadd(b, d), t3 = cmni(csub(b, d));
    const float2 y0 = cadd(t0, t2), y1 = cadd(t1, t3), y2 = csub(t0, t2), y3 = csub(t1, t3);
    u[4 * r] = y0;
    if (r == 0) { u[1] = y1; u[2] = y2; u[3] = y3; }
    else if (r == 1) { u[5] = cmul(y1, make_float2(C1, -S1)); u[6] = cmul(y2, make_float2(C2, -C2)); u[7] = cmul(y3, make_float2(S1, -C1)); }
    else if (r == 2) { u[9] = cmul(y1, make_float2(C2, -C2)); u[10] = cmni(y2); u[11] = cmul(y3, make_float2(-C2, -C2)); }
    else { u[13] = cmul(y1, make_float2(S1, -C1)); u[14] = cmul(y2, make_float2(-C2, -C2)); u[15] = cmul(y3, make_float2(-C1, S1)); }
  }
#pragma unroll
  for (int sdx = 0; sdx < 4; ++sdx) {
    const float2 a = u[sdx], b = u[4 + sdx], c = u[8 + sdx], d = u[12 + sdx];
    const float2 t0 = cadd(a, c), t1 = csub(a, c), t2 = cadd(b, d), t3 = cmni(csub(b, d));
    x[4 * sdx] = cadd(t0, t2); x[4 * sdx + 1] = cadd(t1, t3); x[4 * sdx + 2] = csub(t0, t2); x[4 * sdx + 3] = csub(t1, t3);
  }
}
template <int LQ, bool INV>
DI void fft_pass16(float2* X, int tid, TabJob& job) {
  constexpr int q = 1 << LQ;
  constexpr float invL = 1.f / (float)(16 << LQ);
  tab_step(job, tid & 63);
#pragma unroll 1
  for (int bf = 0; bf < 2; ++bf) {
    const int i = tid + 512 * bf;
    const int j = i & (q - 1); const int base = ((i >> LQ) << (LQ + 4)) + j;
    const float fr = (float)j * invL;
    const float2 w1 = make_float2(__builtin_amdgcn_cosf(fr), -__builtin_amdgcn_sinf(fr));
    float2 x[16];
    if (!INV) {
#pragma unroll
      for (int mm = 0; mm < 16; ++mm) x[mm] = X[PX(base + mm * q)];
      dft16(x);
      float2 w = w1;
      X[PX(base)] = x[0];
#pragma unroll
      for (int k = 1; k < 16; ++k) {
        const int p = 4 * (k & 3) + (k >> 2);
        X[PX(base + k * q)] = cmul(x[p], w);
        w = cmul(w, w1);
      }
    } else {
      float2 w = w1;
      x[0] = cconj(X[PX(base)]);
#pragma unroll
      for (int k = 1; k < 16; ++k) {
        x[k] = cmul(cconj(X[PX(base + k * q)]), w);
        w = cmul(w, w1);
      }
      dft16(x);
#pragma unroll
      for (int p = 0; p < 16; ++p) {
        const int mm = (p >> 2) + 4 * (p & 3);
        X[PX(base + mm * q)] = cconj(x[p]);
      }
    }
  }
}
template <bool INV>
DI void fft_pass4(float2* X, int tid, TabJob& job) {
  tab_step(job, tid & 63);
#pragma unroll 2
  for (int bf = 0; bf < 8; ++bf) {
    const int base = PX(4 * (tid + 512 * bf));
    float2 a = X[base], b = X[base + 1], c = X[base + 2], d = X[base + 3];
    if (INV) { a = cconj(a); b = cconj(b); c = cconj(c); d = cconj(d); }
    const float2 t0 = cadd(a, c), t1 = csub(a, c), t2 = cadd(b, d), t3 = cmni(csub(b, d));
    float2 y0 = cadd(t0, t2), y1 = cadd(t1, t3), y2 = csub(t0, t2), y3 = csub(t1, t3);
    if (INV) { y0 = cconj(y0); y1 = cconj(y1); y2 = cconj(y2); y3 = cconj(y3); }
    X[base] = y0; X[base + 1] = y1; X[base + 2] = y2; X[base + 3] = y3;
  }
}
DI void fft_fwd(float2* X, TabJob& job) {
  const int tid = TID;
  __syncthreads(); fft_pass16<10, false>(X, tid, job);
  __syncthreads(); fft_pass16<6, false>(X, tid, job);
  __syncthreads(); fft_pass16<2, false>(X, tid, job);
  __syncthreads(); fft_pass4<false>(X, tid, job);
  __syncthreads();
}
DI void fft_inv(float2* X, TabJob& job) {
  const int tid = TID;
  __syncthreads(); fft_pass4<true>(X, tid, job);
  __syncthreads(); fft_pass16<2, true>(X, tid, job);
  __syncthreads(); fft_pass16<6, true>(X, tid, job);
  __syncthreads(); fft_pass16<10, true>(X, tid, job);
  __syncthreads();
}
DI float block_sum_512(float v, float* red) {
  for (int o = 32; o > 0; o >>= 1) v += shx(v, o);
  __syncthreads();
  if ((TID & 63) == 0) red[TID >> 6] = v;
  __syncthreads();
  float s = 0.f;
  for (int i = 0; i < 8; ++i) s += red[i];
  return s;
}
DI unsigned pkc(float2 v) { return pk2bf(v.x, v.y); }
DI float2 upkc(unsigned w) { return make_float2(bflo(w), bfhi(w)); }
DI void hyena_filter_task(int c, const bf16_t* __restrict__ hdnB, const bf16_t* __restrict__ W3t, const float* __restrict__ b3, uint2* __restrict__ H01_all,
                          char* smem, TabJob& job) {
  float2* X = (float2*)smem;
  float* red = (float*)(smem + FNP * 8);
  uint2* H01 = H01_all + (size_t)c * FN;
  const int tid = TID;
  __syncthreads();
  const float delta = fabsf(-3.0701134573253944f + (float)c * ((-15.350567286626972f + 3.0701134573253944f) / 255.f));
  const float bb00 = b3[c], bb01 = b3[256 + c], bb10 = b3[512 + c], bb11 = b3[768 + c];
  float n0 = 0.f, n1 = 0.f;
  {
    const int lane = tid & 63, wid = tid >> 6, r = lane & 31, h = lane >> 5;
    bf16x8 wa[4];
#pragma unroll
    for (int s4 = 0; s4 < 4; ++s4) {
      uint4 w = make_uint4(0u, 0u, 0u, 0u);
      if (r < 4) w = *(const uint4*)(W3t + ((size_t)((r >> 1) * 512 + (r & 1) * 256 + c)) * 64 + 16 * s4 + 8 * h);
      wa[s4] = __builtin_bit_cast(bf16x8, w);
    }
#pragma unroll 8
    for (int blk = wid; blk < SEQ / 32; blk += 8) {
      const int j = blk * 32 + r;
      const bf16_t* hp = hdnB + (size_t)blk * 2048 + (h * 32 + r) * 8;
      f32x16 acc;
#pragma unroll
      for (int i = 0; i < 16; ++i) acc[i] = 0.f;
#pragma unroll
      for (int s4 = 0; s4 < 4; ++s4) acc = MFMA32(wa[s4], *(const bf16x8*)(hp + 512 * s4), acc);
      if (h == 0) {
        const float dec = __expf(-((float)j / (float)(SEQ - 1)) * delta);
        const float f00 = (acc[0] + bb00) * dec, f01 = (acc[1] + bb01) * dec, f10 = (acc[2] + bb10) * dec, f11 = (acc[3] + bb11) * dec;
        X[PX(j)] = make_float2(f00, f10);
        n0 += fabsf(f00); n1 += fabsf(f10);
        if (j > 0) { X[PX(FN - j)] = make_float2(f01, f11); n0 += fabsf(f01); n1 += fabsf(f11); }
        else X[PX(SEQ)] = make_float2(0.f, 0.f);
      }
    }
  }
  n0 = block_sum_512(n0, red);
  n1 = block_sum_512(n1, red);
  const float s0 = 0.5f / (n0 * (float)FN), s1 = 0.5f / (n1 * (float)FN);
  fft_fwd(X, job);
  for (int pos = tid; pos < FN; pos += 512) {
    const int f = freq_of_pos(pos); const int pm = pos_of_freq((FN - f) & (FN - 1));
    const float2 A = X[PX(pos)], Bm = X[PX(pm)];
    const float2 K0 = make_float2((A.x + Bm.x) * s0, (A.y - Bm.y) * s0);
    const float2 K1 = make_float2((A.y + Bm.y) * s1, -(A.x - Bm.x) * s1);
    H01[pos] = make_uint2(pkc(K0), pkc(K1));
  }
}
DI void hyena_channel(int c, const float* __restrict__ hy_bias, const float* __restrict__ uT, float* __restrict__ zT, float* __restrict__ yT,
                      const uint2* __restrict__ H01_all, char* smem, TabJob& job) {
  float2* X = (float2*)smem;
  const uint2* H01 = H01_all + (size_t)c * FN;
  const int tid = TID;
  const float* v0p = uT + ((size_t)0 * 768 + c) * NT + CTX;
  const float* v1p = uT + ((size_t)1 * 768 + c) * NT + CTX;
  __syncthreads();
  for (int t = tid; t < SEQ; t += 512) { X[PX(t)] = make_float2(v0p[t], v1p[t]); X[PX(SEQ + t)] = make_float2(0.f, 0.f); }
  fft_fwd(X, job);
  for (int pos = tid; pos < FN; pos += 512) X[PX(pos)] = cmul(X[PX(pos)], upkc(H01[pos].x));
  fft_inv(X, job);
  {
    const float bias0 = hy_bias[c];
    const float* x10 = v0p + (size_t)256 * NT; const float* x11 = v1p + (size_t)256 * NT;
    float* z0 = zT + ((size_t)0 * 256 + c) * NT + CTX; float* z1 = zT + ((size_t)1 * 256 + c) * NT + CTX;
    for (int t = tid; t < SEQ; t += 512) {
      float2 y = X[PX(t)];
      float za = x10[t] * (y.x + bias0 * v0p[t]);
      float zb = x11[t] * (y.y + bias0 * v1p[t]);
      z0[t] = za; z1[t] = zb;
      X[PX(t)] = make_float2(za, zb);
    }
    __syncthreads();
    for (int t = tid; t < SEQ; t += 512) X[PX(SEQ + t)] = make_float2(0.f, 0.f);
  }
  fft_fwd(X, job);
  for (int pos = tid; pos < FN; pos += 512) X[PX(pos)] = cmul(X[PX(pos)], upkc(H01[pos].y));
  fft_inv(X, job);
  {
    const float bias1 = hy_bias[256 + c];
    const float* x20 = v0p + (size_t)512 * NT; const float* x21 = v1p + (size_t)512 * NT;
    const float* z0 = zT + ((size_t)0 * 256 + c) * NT + CTX; const float* z1 = zT + ((size_t)1 * 256 + c) * NT + CTX;
    float* y0 = yT + ((size_t)0 * 256 + c) * NT + CTX; float* y1 = yT + ((size_t)1 * 256 + c) * NT + CTX;
    for (int t = tid; t < SEQ; t += 512) {
      float2 y = X[PX(t)];
      y0[t] = x20[t] * (y.x + bias1 * z0[t]);
      y1[t] = x21[t] * (y.y + bias1 * z1[t]);
    }
  }
}

namespace pg8 {
#define PG8_LAS __attribute__((address_space(3)))
typedef ::bf16x8 bf16x8;
typedef float f32x4 __attribute__((ext_vector_type(4)));
typedef unsigned u32x4 __attribute__((ext_vector_type(4)));
constexpr int BM = 256, BK = 64, HALF = 128, HTB = HALF * BK * 2  , STAGE_BYTES = 8 * HTB, NXCD = 8, WGM = 8;

__host__ __device__ __forceinline__ int lds_byte(int r, int c) { const int st = (r >> 4) * 2 + (c >> 5), rr = r & 15, cc = c & 31, ob = rr * 64 + cc * 2; return st * 1024 + (ob ^ (((ob >> 9) & 1) << 5)); }
__host__ __device__ __forceinline__ void stage_rc(int b, int& R, int& C) { const int st = b / 1024, sb = b % 1024, swz = sb ^ (((sb >> 9) & 1) << 5); R = (st >> 1) * 16 + swz / 64; C = (st & 1) * 32 + (swz % 64) / 2; }
__host__ __device__ __forceinline__ int perm32(int rho) { const int n = rho >> 4, i = rho & 15; return 8 * (i >> 2) + 4 * n + (i & 3); }
struct Unit { int pm, pn; };
struct Gemm { const bf16_t* A; const bf16_t* Bt; int M, N, K; };
template <class Epi, class Sched, bool STAMP = false>
__device__ __forceinline__ void gemm_phase(PG8_LAS unsigned char* lds, const Gemm g, const Sched& S, const Epi& E, unsigned long long* stamps) {
    const int tid = TID, wid = __builtin_amdgcn_readfirstlane(tid >> 6), lane = tid & 63, wr = wid >> 2, wc = wid & 3, fr = lane & 15, fq = lane >> 4;
    const int K = g.K, nt = K / BK;
    int ts_lo = 0, ts_hi = 0, nts = 0; const unsigned long long rt_entry = STAMP ? (unsigned long long)wall_clock64() : 0ull;
#define PG8_STAMP() do { if (STAMP && wid == 0 && nts < 64) { const unsigned long long _c = (unsigned long long)clock64(); \
        ts_lo = (lane == nts) ? (int)(unsigned)_c : ts_lo; ts_hi = (lane == nts) ? (int)(unsigned)(_c >> 32) : ts_hi; ++nts; } } while (0)
    PG8_STAMP();
    unsigned voffA[2], voffB[2];
#pragma unroll
    for (int i = 0; i < 2; ++i) { int R, C; stage_rc(tid * 16 + i * 8192, R, C); const int Rb = Epi::PERM ? ((R & ~31) + perm32(R & 31)) : R;
        voffA[i] = (unsigned)(R * K + C) * 2u; voffB[i] = (unsigned)(Rb * K + C) * 2u; }
    const size_t kstep = (size_t)(BK * 2);
    const size_t hstep = (size_t)HALF * K * 2;
    const size_t tstep = 2 * hstep;
    const unsigned ldsw = (unsigned)wid * 1024u;
    const int aoff = lds_byte(wr * 64 + fr, fq * 8), boff = lds_byte(wc * 32 + fr, fq * 8);
#define PG8_SA(b, h) (((b) * 2 + (h)) * HTB)
#define PG8_SB(b, h) ((4 + (b) * 2 + (h)) * HTB)
#define PG8_STAGE(bufoff, gbase, voff) do { _Pragma("unroll") for (int _i = 0; _i < 2; ++_i) \
        __builtin_amdgcn_global_load_lds((const unsigned*)((const char*)(gbase) + (voff)[_i]), (PG8_LAS unsigned*)(lds + (bufoff) + ldsw + _i * 8192), 16, 0, 0); } while (0)
#define PG8_LDA(dst, b, h) do { _Pragma("unroll") for (int m = 0; m < 4; ++m) _Pragma("unroll") for (int k = 0; k < 2; ++k) dst[m][k] = *(const PG8_LAS bf16x8*)(lds + PG8_SA(b, h) + aoff + m * 2048 + k * 1024); } while (0)
#define PG8_LDB(dst, b, h) do { _Pragma("unroll") for (int n = 0; n < 2; ++n) _Pragma("unroll") for (int k = 0; k < 2; ++k) dst[n][k] = *(const PG8_LAS bf16x8*)(lds + PG8_SB(b, h) + boff + n * 2048 + k * 1024); } while (0)
#define PG8_MMA(ai, bj, At, Bt) do { __builtin_amdgcn_s_setprio(1); _Pragma("unroll") for (int m = 0; m < 4; ++m) _Pragma("unroll") for (int n = 0; n < 2; ++n) _Pragma("unroll") for (int k = 0; k < 2; ++k) \
        acc[ai][bj][m][n] = __builtin_amdgcn_mfma_f32_16x16x32_bf16(Bt[n][k], At[m][k], acc[ai][bj][m][n], 0, 0, 0); __builtin_amdgcn_s_setprio(0); } while (0)
#define PG8_WAIT_V(n) asm volatile("s_waitcnt vmcnt(" #n ")" ::: "memory")
#define PG8_WAIT_L(n) asm volatile("s_waitcnt lgkmcnt(" #n ")" ::: "memory")
#define PG8_BAR __builtin_amdgcn_s_barrier()
#define PG8_SCHED __builtin_amdgcn_sched_barrier(0)
    Unit cur, nxt; int ui = 0;
    if (!S.next(0, cur)) return;
    f32x4 acc[2][2][4][2];
#pragma unroll
    for (int a = 0; a < 2; ++a)
#pragma unroll
        for (int b = 0; b < 2; ++b)
#pragma unroll
            for (int m = 0; m < 4; ++m)
#pragma unroll
                for (int n = 0; n < 2; ++n) acc[a][b][m][n] = (f32x4){0.f, 0.f, 0.f, 0.f};
    bf16x8 At[4][2], B0[2][2], B1[2][2];
    const char* cA = (const char*)g.A + (size_t)cur.pm * tstep; const char* cB = (const char*)g.Bt + (size_t)cur.pn * tstep;
    S.a_ready(cur);
    PG8_STAGE(PG8_SB(0, 0), cB, voffB); PG8_STAGE(PG8_SA(0, 0), cA, voffA); PG8_STAGE(PG8_SB(0, 1), cB + hstep, voffB); PG8_STAGE(PG8_SA(0, 1), cA + hstep, voffA);
    if (wr == 1) PG8_BAR;
    PG8_WAIT_V(4); PG8_BAR;
    PG8_STAGE(PG8_SB(1, 0), cB + kstep, voffB); PG8_STAGE(PG8_SA(1, 0), cA + kstep, voffA); PG8_STAGE(PG8_SB(1, 1), cB + hstep + kstep, voffB);
    PG8_WAIT_V(6); PG8_BAR;
    PG8_STAMP();
    for (;;) {
        const bool has_next = S.next(ui + 1, nxt);
        const char* nA = has_next ? (const char*)g.A + (size_t)nxt.pm * tstep : cA; const char* nB = has_next ? (const char*)g.Bt + (size_t)nxt.pn * tstep : cB;
        for (int t = 0; t < nt; t += 2) {
            const bool last = (t == nt - 2);
            const char* a1 = cA + (size_t)(t + 1) * kstep;
            const char* a2 = last ? nA : cA + (size_t)(t + 2) * kstep; const char* b2 = last ? nB : cB + (size_t)(t + 2) * kstep;
            const char* a3 = a2 + kstep; const char* b3 = b2 + kstep;
            if (last && has_next) S.a_ready(nxt);
            PG8_LDB(B0, 0, 0); PG8_SCHED; PG8_LDA(At, 0, 0); PG8_STAGE(PG8_SA(1, 1), a1 + hstep, voffA);
            PG8_WAIT_L(8); PG8_BAR; PG8_WAIT_L(0); PG8_MMA(0, 0, At, B0); PG8_BAR; PG8_SCHED;
            PG8_LDB(B1, 0, 1); PG8_STAGE(PG8_SB(0, 0), b2, voffB);
            PG8_BAR; PG8_WAIT_L(0); PG8_MMA(0, 1, At, B1); PG8_BAR;
            PG8_LDA(At, 0, 1); PG8_STAGE(PG8_SA(0, 0), a2, voffA);
            PG8_BAR; PG8_WAIT_L(0); PG8_MMA(1, 0, At, B0); PG8_BAR; PG8_SCHED;
            PG8_STAGE(PG8_SB(0, 1), b2 + hstep, voffB);
            PG8_WAIT_V(6); PG8_BAR; PG8_MMA(1, 1, At, B1); PG8_BAR;
            PG8_LDB(B0, 1, 0); PG8_SCHED; PG8_LDA(At, 1, 0); PG8_STAGE(PG8_SA(0, 1), a2 + hstep, voffA);
            PG8_WAIT_L(8); PG8_BAR; PG8_WAIT_L(0); PG8_MMA(0, 0, At, B0); PG8_BAR; PG8_SCHED;
            PG8_LDB(B1, 1, 1); PG8_STAGE(PG8_SB(1, 0), b3, voffB);
            PG8_BAR; PG8_WAIT_L(0); PG8_MMA(0, 1, At, B1); PG8_BAR;
            PG8_LDA(At, 1, 1); PG8_STAGE(PG8_SA(1, 0), a3, voffA);
            PG8_BAR; PG8_WAIT_L(0); PG8_MMA(1, 0, At, B0); PG8_BAR; PG8_SCHED;
            PG8_STAGE(PG8_SB(1, 1), b3 + hstep, voffB);
            PG8_WAIT_V(6); PG8_BAR; PG8_MMA(1, 1, At, B1); PG8_BAR;
        }
        PG8_STAMP();
        if constexpr (!Epi::AFTER_DRAIN) { E(acc, cur, wr, wc, fr, fq); S.done(cur); }
        PG8_STAMP();
        if (!has_next) break;
#pragma unroll
        for (int a = 0; a < 2; ++a)
#pragma unroll
            for (int b = 0; b < 2; ++b)
#pragma unroll
                for (int m = 0; m < 4; ++m)
#pragma unroll
                    for (int n = 0; n < 2; ++n) acc[a][b][m][n] = (f32x4){0.f, 0.f, 0.f, 0.f};
        cur = nxt; cA = nA; cB = nB; ++ui;
    }
    PG8_WAIT_V(0);
    if (wr == 0) PG8_BAR;
    PG8_BAR;
    if constexpr (Epi::AFTER_DRAIN) { E.fused(acc, cur, wr, wc, fr, fq, lds, wid, lane); S.done(cur); }
    PG8_STAMP();
    if (STAMP && wid == 0) { stamps[lane] = lane < nts ? (((unsigned long long)(unsigned)ts_hi << 32) | (unsigned)ts_lo) : 0ull;
        if (lane == 62) stamps[62] = rt_entry; if (lane == 63) stamps[63] = (unsigned long long)wall_clock64(); }
#undef PG8_STAMP
#undef PG8_SA
#undef PG8_SB
#undef PG8_STAGE
#undef PG8_LDA
#undef PG8_LDB
#undef PG8_MMA
#undef PG8_WAIT_V
#undef PG8_WAIT_L
#undef PG8_BAR
#undef PG8_SCHED
}
}

#ifndef GEMM_WGM
#define GEMM_WGM 4
#endif
struct MySched {
  int nN, nunits, G, c; bool latent_only;
  DI void init(int N, bool lat_only, int G_, int c_) { nN = N / 256; latent_only = lat_only; nunits = (lat_only ? 64 : 66) * nN; G = G_; c = c_; }
  DI bool next(int i, pg8::Unit& u) const {
    const int L = i * G + c; if (L >= nunits) return false;
    const int nM = latent_only ? 64 : 66;
    int wgid = L;
    { const int q = nunits / 8, r = nunits % 8, xcd = wgid % 8, off = wgid / 8; wgid = (xcd < r ? xcd * (q + 1) : r * (q + 1) + (xcd - r) * q) + off; }
    const int nig = GEMM_WGM * nN, gid = wgid / nig, fm = gid * GEMM_WGM, gsz = (nM - fm) < GEMM_WGM ? (nM - fm) : GEMM_WGM;
    const int ri = fm + ((wgid % nig) % gsz);
    u.pn = (wgid % nig) / gsz;
    u.pm = latent_only ? (ri / 32) * 33 + 1 + (ri % 32) : ri;
    return true;
  }
  DI void a_ready(const pg8::Unit&) const {}
  DI void done(const pg8::Unit&) const {}
};
struct EpiStoreBf16 {
  static constexpr bool PERM = true, AFTER_DRAIN = false;
  bf16_t* Cb; int ldc;
  DI void operator()(const pg8::f32x4 (&acc)[2][2][4][2], const pg8::Unit& u, int wr, int wc, int fr, int fq) const {
    const int row0 = u.pm * 256 + wr * 64 + fr, col0 = u.pn * 256 + wc * 32 + 8 * fq;
#pragma unroll
    for (int ai = 0; ai < 2; ++ai)
#pragma unroll
      for (int m = 0; m < 4; ++m) {
        bf16_t* rowp = Cb + (size_t)(row0 + ai * 128 + m * 16) * ldc + col0;
#pragma unroll
        for (int bj = 0; bj < 2; ++bj) {
          const pg8::f32x4 v0 = acc[ai][bj][m][0], v1 = acc[ai][bj][m][1];
          *(uint4*)(rowp + bj * 128) = make_uint4(pk2bf(v0[0], v0[1]), pk2bf(v0[2], v0[3]), pk2bf(v1[0], v1[1]), pk2bf(v1[2], v1[3]));
        }
      }
  }
};
struct EpiResidual {
  static constexpr bool PERM = true, AFTER_DRAIN = false;
  float* xs; const float* gate_base; const float* xin; const float* ctxin;
  DI void operator()(const pg8::f32x4 (&acc)[2][2][4][2], const pg8::Unit& u, int wr, int wc, int fr, int fq) const {
    const int row0 = u.pm * 256 + wr * 64 + fr, col0 = u.pn * 256 + wc * 32 + 8 * fq;
    const int b = u.pm / 33; const int mrow = (u.pm % 33) == 0 ? 2 : b;
    const int pt = (u.pm % 33) * 256 + wr * 64 + fr;
    const float* gt = gate_base + mrow * NMOD + col0;
#pragma unroll
    for (int ai = 0; ai < 2; ++ai)
#pragma unroll
      for (int m = 0; m < 4; ++m) {
        float* rowp = xs + (size_t)(row0 + ai * 128 + m * 16) * D + col0;
        const int pp = pt + ai * 128 + m * 16;
        const float* srcp = xin ? (pp < CTX ? ctxin + ((size_t)b * CTX + pp) * D + col0 : xin + ((size_t)b * SEQ + (pp - CTX)) * D + col0) : rowp;
#pragma unroll
        for (int bj = 0; bj < 2; ++bj)
#pragma unroll
          for (int n = 0; n < 2; ++n) {
            const pg8::f32x4 v = acc[ai][bj][m][n];
            const float4 g4 = *(const float4*)(gt + bj * 128 + n * 4);
            float4 xv = *(const float4*)(srcp + bj * 128 + n * 4);
            xv.x += g4.x * v[0]; xv.y += g4.y * v[1]; xv.z += g4.z * v[2]; xv.w += g4.w * v[3];
            *(float4*)(rowp + bj * 128 + n * 4) = xv;
          }
      }
  }
};

#define XB_TMO      128
#define XB_XCNT(j)  (256  + 64 * (j))
#define XB_XSUB(j)  (1280 + 64 * (j))
#define XB_XGEN(j)  (2304 + 64 * (j))
#define XB_TOP      3328
#define XB_TOPGEN   3392
#define XB_SPIN_CAP (1u << 22)
DI unsigned xb_ld(unsigned* p) { return __hip_atomic_load(p, __ATOMIC_RELAXED, __HIP_MEMORY_SCOPE_AGENT); }
DI unsigned xb_add(unsigned* p, unsigned v) { return __hip_atomic_fetch_add(p, v, __ATOMIC_RELAXED, __HIP_MEMORY_SCOPE_AGENT); }
DI unsigned xb_xcc_id() { return (unsigned)__builtin_amdgcn_s_getreg((3 << 11) | 20) & 0xFu; }
#define XB_SPIN(cond, bar) do { unsigned _sp = 0; while (cond) { __builtin_amdgcn_s_sleep(1); \
    if ((++_sp & 255u) == 0u) { if (xb_ld(&(bar)[XB_TMO])) break; if (_sp > XB_SPIN_CAP) { atomicAdd(&(bar)[XB_TMO], 1u); break; } } } } while (0)
DI void xcd_barrier_post(unsigned* bar, volatile LAS unsigned* st) {
  if (threadIdx.x == 0) { const unsigned x = xb_xcc_id(); st[3] = x; st[2] = xb_add(&bar[XB_XCNT(x)], 1u); }
}
DI void xcd_barrier_complete(unsigned* bar, unsigned x, unsigned& nloc, unsigned& nx) {
  const unsigned G = gridDim.x;
  unsigned sum, cnt, mine, sp = 0u;
  for (;;) {
    sum = 0u; cnt = 0u; mine = 0u;
#pragma unroll
    for (unsigned j = 0; j < 16; ++j) { const unsigned c = xb_ld(&bar[XB_XCNT(j)]); sum += c; cnt += (c > 0u) ? 1u : 0u; mine = (j == x) ? c : mine; }
    if (sum == G) break;
    __builtin_amdgcn_s_sleep(1);
    if ((++sp & 255u) == 0u) { if (xb_ld(&bar[XB_TMO])) break; if (sp > XB_SPIN_CAP) { atomicAdd(&bar[XB_TMO], 1u); break; } }
  }
  nloc = mine > 0u ? mine : 1u; nx = cnt > 0u ? cnt : 1u;
}
DI void xcd_barrier(unsigned* bar, volatile LAS unsigned* st) {
  asm volatile("s_waitcnt vmcnt(0)" ::: "memory");
  __syncthreads();
  if (threadIdx.x == 0) {
    const unsigned x = xb_xcc_id();
    __builtin_amdgcn_s_waitcnt(0);
    unsigned nloc = st[0], nx = st[1];
    if (nloc == 0u) { xcd_barrier_complete(bar, x, nloc, nx); st[0] = nloc; st[1] = nx; }
    const unsigned old = xb_add(&bar[XB_XSUB(x)], 1u);
    const unsigned gen = old / nloc;
    if (old + 1u == (gen + 1u) * nloc) {
      __builtin_amdgcn_fence(__ATOMIC_RELEASE, "agent");
      asm volatile("s_waitcnt vmcnt(0)" ::: "memory");
      const unsigned og = xb_add(&bar[XB_TOP], 1u);
      const unsigned tg = og / nx;
      if (og + 1u == (tg + 1u) * nx) xb_add(&bar[XB_TOPGEN], 1u);
      else XB_SPIN(xb_ld(&bar[XB_TOPGEN]) == tg, bar);
      __builtin_amdgcn_fence(__ATOMIC_ACQUIRE, "agent");
      xb_add(&bar[XB_XGEN(x)], 1u);
      asm volatile("s_waitcnt vmcnt(0)" ::: "memory");
    } else {
      XB_SPIN(xb_ld(&bar[XB_XGEN(x)]) == gen, bar);
      __builtin_amdgcn_fence(__ATOMIC_ACQUIRE, "agent");
      asm volatile("s_waitcnt vmcnt(0)" ::: "memory");
    }
  }
  __syncthreads();
}

#define XCD_BAR_WORDS 3456
constexpr size_t al256(size_t x) { return (x + 255) & ~(size_t)255; }
constexpr size_t OFF_modv = 0;
constexpr size_t OFF_xs = al256(OFF_modv + (size_t)2 * 3 * NMOD * 4);
constexpr size_t OFF_hbuf = al256(OFF_xs + (size_t)R * D * 4);
constexpr size_t OFF_P = al256(OFF_hbuf + (size_t)R * D * 2);
constexpr size_t OFF_Wt_in = al256(OFF_P + (size_t)R * DIN * 2);
constexpr size_t OFF_Wt_out = al256(OFF_Wt_in + (size_t)2 * DIN * D * 2);
constexpr size_t OFF_Wt_q = al256(OFF_Wt_out + (size_t)2 * D * D * 2);
constexpr size_t OFF_QA = al256(OFF_Wt_q + (size_t)2 * 2048 * D * 2);
constexpr size_t OFF_KA = al256(OFF_QA + (size_t)NB * 8 * NT * 32 * 2);
constexpr size_t OFF_VAt = al256(OFF_KA + (size_t)NB * 8 * NT * 32 * 2);
constexpr size_t OFF_QW = al256(OFF_VAt + (size_t)NB * 4 * 64 * NT * 2);
constexpr size_t OFF_KW = al256(OFF_QW + (size_t)NB * 4 * NT * 64 * 2);
constexpr size_t OFF_VWt = al256(OFF_KW + (size_t)NB * 2 * NT * 64 * 2);
constexpr size_t OFF_QG = al256(OFF_VWt + (size_t)NB * 2 * 64 * NT * 2);
constexpr size_t OFF_KG = al256(OFF_QG + (size_t)NB * 4 * NT * 64 * 2);
constexpr size_t OFF_VGt = al256(OFF_KG + (size_t)NB * 2 * NT * 64 * 2);
constexpr size_t OFF_uT = al256(OFF_VGt + (size_t)NB * 2 * 64 * NT * 2);
constexpr size_t OFF_zT = al256(OFF_uT + (size_t)NB * 768 * NT * 4);
constexpr size_t OFF_yT = al256(OFF_zT + (size_t)NB * 256 * NT * 4);
constexpr size_t OFF_hdn2 = al256(OFF_yT + (size_t)NB * 256 * NT * 4);
constexpr size_t OFF_Hc = al256(OFF_hdn2 + (size_t)2 * NT * 64 * 4);
constexpr size_t OFF_A2 = al256(OFF_Hc + (size_t)256 * 2 * SEQ * 8);
constexpr size_t OFF_u8 = al256(OFF_A2 + (size_t)R * D * 2);
constexpr size_t OFF_v8 = al256(OFF_u8 + (size_t)2 * 16384 * D);
constexpr size_t OFF_us = al256(OFF_v8 + (size_t)2 * 16384 * D);
constexpr size_t OFF_vs = al256(OFF_us + (size_t)2 * 16384 * 4);
constexpr size_t OFF_keysb = al256(OFF_vs + (size_t)2 * 16384 * 4);
constexpr size_t OFF_bar = al256(OFF_keysb + (size_t)2 * 16 * 128 * 128 * 2);
constexpr size_t OFF_hdnB = al256(OFF_bar + (size_t)XCD_BAR_WORDS * 4);
constexpr size_t OFF_W3t = al256(OFF_hdnB + (size_t)2 * SEQ * 64 * 2);
constexpr size_t WS_TOTAL = al256(OFF_W3t + (size_t)2 * 1024 * 64 * 2);
constexpr size_t OFF_topv = OFF_uT;
constexpr size_t OFF_topi = OFF_topv + (size_t)R * 256 * 4;
constexpr size_t OFF_experts = OFF_topi + (size_t)R * 256;
constexpr size_t OFF_gates = OFF_experts + (size_t)R * 128 * 4;
constexpr size_t OFF_xq = OFF_A2;
constexpr size_t OFF_xqs = OFF_xq + (size_t)R * D;
constexpr size_t OFF_wsc = OFF_xqs + (size_t)R * 4;
static_assert(OFF_wsc + (size_t)R * 4 <= OFF_u8, "xq overflows A2");
constexpr size_t OFF_Oslab = OFF_P;
constexpr size_t OFF_Lslab = OFF_Oslab + (size_t)2 * NB * 4 * NT * 64 * 4;
static_assert(OFF_gates + (size_t)R * 128 * 4 <= OFF_zT, "routing buffers overflow uT");
static_assert(OFF_Lslab + (size_t)2 * NB * 4 * NT * 4 <= OFF_Wt_in, "slabs overflow P");

struct MKView;
struct MK {
  const float *x, *c, *ctx, *c_ctx, *w_mod, *b_mod, *g_norm_mix, *w_in, *g_qk_diff, *lambda_diff, *g_qk_win, *sink_win, *g_qk_glob, *hy_conv_w,
      *hy_conv_b, *hy_w1, *hy_b1, *hy_w2, *hy_b2, *hy_w3, *hy_b3, *hy_freq, *hy_bias, *g_mix_out, *w_out, *g_norm_ffn, *peer_wq, *peer_keys,
      *peer_u, *peer_v;
  float* out;
  char* ws;
};
constexpr int SMEM_BYTES = (FN + (FN >> 6) * 4) * 8 + 2048;
typedef const MK __attribute__((address_space(4))) * MKP;
DI MK launder_mk(MKP a) {
  asm volatile("" : "+s"(a));
  MK r;
  r.x = a->x; r.c = a->c; r.ctx = a->ctx; r.c_ctx = a->c_ctx; r.w_mod = a->w_mod; r.b_mod = a->b_mod;
  r.g_norm_mix = a->g_norm_mix; r.w_in = a->w_in; r.g_qk_diff = a->g_qk_diff; r.lambda_diff = a->lambda_diff;
  r.g_qk_win = a->g_qk_win; r.sink_win = a->sink_win; r.g_qk_glob = a->g_qk_glob; r.hy_conv_w = a->hy_conv_w;
  r.hy_conv_b = a->hy_conv_b; r.hy_w1 = a->hy_w1; r.hy_b1 = a->hy_b1; r.hy_w2 = a->hy_w2; r.hy_b2 = a->hy_b2;
  r.hy_w3 = a->hy_w3; r.hy_b3 = a->hy_b3; r.hy_freq = a->hy_freq; r.hy_bias = a->hy_bias; r.g_mix_out = a->g_mix_out;
  r.w_out = a->w_out; r.g_norm_ffn = a->g_norm_ffn; r.peer_wq = a->peer_wq; r.peer_keys = a->peer_keys;
  r.peer_u = a->peer_u; r.peer_v = a->peer_v; r.out = a->out; r.ws = a->ws;
  return r;
}

DI void ph_mod_item(const MK& m, int item, char* smem) {
  float* sc = (float*)smem;
  float* part = sc + 3 * D;
  const int tid = TID, lane = tid & 63, wv = tid >> 6;
  const int l = item / 96, chunk = item % 96;
  __syncthreads();
  for (int i = tid; i < 3 * D; i += NTHR) {
    int row = i / D, k = i % D;
    float v = row < 2 ? m.c[row * D + k] : m.c_ctx[k];
    sc[i] = v / (1.f + __expf(-v));
  }
  __syncthreads();
  const int col = chunk * 64 + lane;
  const float* w = m.w_mod + (size_t)l * D * NMOD + (size_t)(wv * 128) * NMOD + col;
  float a0 = 0, a1 = 0, a2 = 0;
#pragma unroll 32
  for (int k = 0; k < 128; ++k) {
    float wvv = w[(size_t)k * NMOD];
    a0 += sc[wv * 128 + k] * wvv; a1 += sc[D + wv * 128 + k] * wvv; a2 += sc[2 * D + wv * 128 + k] * wvv;
  }
  part[(wv * 3 + 0) * 64 + lane] = a0; part[(wv * 3 + 1) * 64 + lane] = a1; part[(wv * 3 + 2) * 64 + lane] = a2;
  __syncthreads();
  if (tid < 192) {
    const int row = tid >> 6;
    float sacc = 0.f;
    for (int q = 0; q < 8; ++q) sacc += part[(q * 3 + row) * 64 + lane];
    ((float*)(m.ws + OFF_modv))[(l * 3 + row) * NMOD + col] = sacc + m.b_mod[l * NMOD + col];
  }
}
DI void ph_hymlp_all(const MK& m, char* smem) {
  const int tid = TID, wv = tid >> 6, u = tid & 63;
  float* feat = (float*)smem + wv * 128;
  float* h1 = feat + 64;
  float w1r[33], w2r[64];
  float b1 = 0.f, b2 = 0.f, fq = 0.f;
  int curl = -1;
  __syncthreads();
  for (int g = BID; g < 2 * NT / 8; g += NBLK) {
    const int gi = g * 8 + wv;
    const int l = gi / NT, pos = gi % NT;
    if (l != curl) {
      curl = l;
      const float* w1 = m.hy_w1 + l * 33 * 64 + u; const float* w2 = m.hy_w2 + l * 64 * 64 + u;
#pragma unroll
      for (int i = 0; i < 33; ++i) w1r[i] = w1[i * 64];
#pragma unroll
      for (int i = 0; i < 64; ++i) w2r[i] = w2[i * 64];
      b1 = m.hy_b1[l * 64 + u]; b2 = m.hy_b2[l * 64 + u]; fq = m.hy_freq[l * 64 + u];
    }
    const int which = pos >= SEQ ? 1 : 0;
    const int j = which ? pos - SEQ : pos;
    const int n = which ? CTX : SEQ;
    const float tt = (float)j / (float)(n - 1);
    const float w = (6.283185307179586f / (float)n) * (float)j;
    if (u == 0) feat[0] = tt;
    if (u < 16) {
      float f = 1e-4f + (float)u * ((15.f - 1e-4f) / 15.f);
      feat[1 + u] = cosf(f * w);
      feat[17 + u] = -sinf(f * w);
    }
    asm volatile("s_waitcnt lgkmcnt(0)" ::: "memory");
    float a = b1;
#pragma unroll
    for (int i = 0; i < 33; ++i) a += feat[i] * w1r[i];
    h1[u] = sinf(fq * a);
    asm volatile("s_waitcnt lgkmcnt(0)" ::: "memory");
    float a2 = b2;
#pragma unroll
    for (int i = 0; i < 64; ++i) a2 += h1[i] * w2r[i];
    const float hv2 = sinf(fq * a2);
    asm volatile("s_waitcnt lgkmcnt(0)" ::: "memory");
    if (which) ((float*)(m.ws + OFF_hdn2))[((size_t)l * 64 + u) * NT + pos] = hv2;
    else ((bf16_t*)(m.ws + OFF_hdnB))[(size_t)l * SEQ * 64 + (size_t)(pos >> 5) * 2048 + (u >> 4) * 512 + (((u >> 3) & 1) * 32 + (pos & 31)) * 8 + (u & 7)] = f2bf(hv2);
  }
}
DI void phase0(MKP m_in, char* smem) {
  const MK m = launder_mk(m_in);
  const int bid = BID, nb = NBLK, tid = TID;
  for (int it = bid; it < 192; it += nb) ph_mod_item(m, it, smem);
  ph_hymlp_all(m, smem);
  for (int t = bid; t < 2 * 352; t += nb) {
    int l = t / 352, tt = t % 352;
    if (tt < 160) wconv_strip(m.w_in + (size_t)l * D * DIN, ((bf16_t*)(m.ws + OFF_Wt_in)) + (size_t)l * DIN * D, DIN, tt, (float*)smem);
    else if (tt < 224) wconv_strip(m.w_out + (size_t)l * D * D, ((bf16_t*)(m.ws + OFF_Wt_out)) + (size_t)l * D * D, D, tt - 160, (float*)smem);
    else wconv_strip(m.peer_wq + (size_t)l * D * 2048, ((bf16_t*)(m.ws + OFF_Wt_q)) + (size_t)l * 2048 * D, 2048, tt - 224, (float*)smem);
  }
  for (int i = bid * NTHR + tid; i < 2 * 16 * 128 * 128 / 4; i += nb * NTHR) {
    float4 v = ((const float4*)m.peer_keys)[i];
    ((uint2*)((bf16_t*)(m.ws + OFF_keysb)))[i] = make_uint2(pk2bf(v.x, v.y), pk2bf(v.z, v.w));
  }
  for (int i = bid * NTHR + tid; i < 2 * 1024 * 64; i += nb * NTHR) {
    const int l = i >> 16, n = (i >> 6) & 1023, k = i & 63;
    ((bf16_t*)(m.ws + OFF_W3t))[i] = f2bf(m.hy_w3[((size_t)l * 64 + k) * 1024 + n]);
  }
}

DI void phase_norm(MKP m_in, int l, int which  , bool first, bool skip_ctx) {
  const MK m = launder_mk(m_in);
  const int tid = TID, lane = tid & 63;
  const int gw = BID * 8 + (tid >> 6), nw = NBLK * 8;
  const float* g = (which ? m.g_norm_ffn : m.g_norm_mix) + l * D;
  const float* modv_l = ((float*)(m.ws + OFF_modv)) + (size_t)l * 3 * NMOD;
  for (int r = gw; r < R; r += nw) {
    const int b = r / NT, p = r % NT;
    if (skip_ctx && p < CTX) continue;
    const int mrow = p < CTX ? 2 : b;
    const float4* src = (const float4*)(first ? (p < CTX ? m.ctx + ((size_t)b * CTX + p) * D : m.x + ((size_t)b * SEQ + (p - CTX)) * D)
                                              : ((float*)(m.ws + OFF_xs)) + (size_t)r * D);
    float4 v[4];
    float ss = 0.f;
#pragma unroll
    for (int i = 0; i < 4; ++i) { v[i] = src[lane + 64 * i]; ss += v[i].x * v[i].x + v[i].y * v[i].y + v[i].z * v[i].z + v[i].w * v[i].w; }
    for (int o = 32; o > 0; o >>= 1) ss += shxl(ss, lane, o);
    const float rs = rsqrtf(ss * (1.f / D) + EPS);
    const float* sh = modv_l + mrow * NMOD + (which ? 3 : 0) * D;
    const float* sc = sh + D;
#pragma unroll
    for (int i = 0; i < 4; ++i) {
      const int c0 = (lane + 64 * i) * 4;
      float4 gg = *(const float4*)(g + c0), s4 = *(const float4*)(sc + c0), h4 = *(const float4*)(sh + c0);
      float o0 = v[i].x * rs * gg.x * (1.f + s4.x) + h4.x, o1 = v[i].y * rs * gg.y * (1.f + s4.y) + h4.y;
      float o2 = v[i].z * rs * gg.z * (1.f + s4.z) + h4.z, o3 = v[i].w * rs * gg.w * (1.f + s4.w) + h4.w;
      *(uint2*)(((bf16_t*)(m.ws + OFF_hbuf)) + (size_t)r * D + c0) = make_uint2(pk2bf(o0, o1), pk2bf(o2, o3));
      v[i] = make_float4(o0, o1, o2, o3);
    }
    if (which) {
      float mx = 0.f;
#pragma unroll
      for (int i = 0; i < 4; ++i) mx = fmaxf(mx, fmaxf(fmaxf(fabsf(v[i].x), fabsf(v[i].y)), fmaxf(fabsf(v[i].z), fabsf(v[i].w))));
      for (int o = 32; o > 0; o >>= 1) mx = fmaxf(mx, shxl(mx, lane, o));
      mx = fmaxf(mx, 1e-30f);
      const float inv = 127.f / mx;
      *(uint4*)(((unsigned char*)(m.ws + OFF_xq)) + (size_t)r * D + lane * 16) =
          make_uint4(pack_i8x4(v[0].x * inv, v[0].y * inv, v[0].z * inv, v[0].w * inv), pack_i8x4(v[1].x * inv, v[1].y * inv, v[1].z * inv, v[1].w * inv),
                     pack_i8x4(v[2].x * inv, v[2].y * inv, v[2].z * inv, v[2].w * inv), pack_i8x4(v[3].x * inv, v[3].y * inv, v[3].z * inv, v[3].w * inv));
      if (lane == 0) ((float*)(m.ws + OFF_xqs))[r] = mx * (1.f / 127.f);
    }
  }
}

DI int rowtile_of(int i, bool latent_only) { return latent_only ? (i / 64) * 66 + 2 + (i % 64) : i; }
template <int EPI>
DI void phase_gemm(const bf16_t* A, const bf16_t* Wt, int N, bf16_t* Cb, float* xs, const float* gate_base, bool latent_only, char* smem) {
  const int nt_n = N / 128, nrt = latent_only ? 128 : 132, ntiles = nrt * nt_n;
  for (int t = BID; t < ntiles; t += NBLK) {
    int tm = rowtile_of(t / nt_n, latent_only), tn = t % nt_n;
    gemm_tile<EPI>(A, Wt, N, tm * 128, tn * 128, smem, Cb, xs, gate_base);
  }
}

DI void rope_pair8(float (&y)[8], const float (&part)[8], bool upper, const float* cs, const float* sn, int dd0) {
#pragma unroll
  for (int e = 0; e < 8; ++e) {
    float c = cs[dd0 + e], s = sn[dd0 + e];
    float x1 = upper ? part[e] : y[e], x2 = upper ? y[e] : part[e];
    y[e] = upper ? (x1 * s + x2 * c) : (x1 * c - x2 * s);
  }
}
DI void unpack8(uint4 w, float (&v)[8]) {
  v[0] = bflo(w.x); v[1] = bfhi(w.x); v[2] = bflo(w.y); v[3] = bfhi(w.y); v[4] = bflo(w.z); v[5] = bfhi(w.z); v[6] = bflo(w.w); v[7] = bfhi(w.w);
}
DI uint4 pack8(const float (&v)[8], float sc) {
  return make_uint4(pk2bf(v[0] * sc, v[1] * sc), pk2bf(v[2] * sc, v[3] * sc), pk2bf(v[4] * sc, v[5] * sc), pk2bf(v[6] * sc, v[7] * sc));
}
constexpr int VS_STRIDE = 1032;
constexpr int HS_STRIDE = 1552;
DI void prep_tile(MKP m_in, int l, int tile, char* smem) {
  const MK m = launder_mk(m_in);
  const int tid = TID, lane = tid & 63, wid = tid >> 6;
  const int r0 = tile * 32; const int b = r0 / NT, p0 = r0 % NT;
  const bool lat = p0 >= CTX;
  char* Vs = smem;
  char* Hs = smem + 33280;
  float* csh = (float*)(smem + 33280 + 34 * HS_STRIDE);
  const bf16_t* Pb = ((bf16_t*)(m.ws + OFF_P)) + (size_t)(b * NT) * DIN;
  __syncthreads();
  if (lat) {
    for (int i = tid; i < 32 * 48; i += NTHR) {
      int rr = i / 48, a = i % 48;
      int t = p0 + rr - CTX;
      float trow = (float)(t / 64), tcol = (float)(t % 64);
      float* rowp = csh + rr * 96;
      if (a < 16) {
        int j = a & 7; float f = exp2f(-(float)j * (13.287712379549449f / 8.f));
        float ang = (a < 8 ? trow : tcol) * f;
        rowp[a] = cosf(ang); rowp[16 + a] = sinf(ang);
      } else {
        int aa = a - 16; int j = aa & 15; float f = exp2f(-(float)j * (13.287712379549449f / 16.f));
        float ang = (aa < 16 ? trow : tcol) * f;
        rowp[32 + aa] = cosf(ang); rowp[64 + aa] = sinf(ang);
      }
    }
  }
  {
    const int seg_lo = lat ? CTX : 0, seg_hi = lat ? NT : CTX;
    for (int ch = tid; ch < 34 * 96; ch += NTHR) {
      int rr = ch / 96, c8 = ch % 96;
      int p = p0 - 1 + rr;
      uint4 v = make_uint4(0, 0, 0, 0);
      if (p >= seg_lo && p < seg_hi) v = *(const uint4*)(Pb + (size_t)p * DIN + 1792 + c8 * 8);
      *(uint4*)(Hs + rr * HS_STRIDE + c8 * 16) = v;
    }
  }
  __syncthreads();
  const float* gd = m.g_qk_diff + l * 64; const float* gwn = m.g_qk_win + l * 128; const float* gg = m.g_qk_glob + l * 128;
#pragma unroll
  for (int k = 0; k < 4; ++k) {
    const int rr = wid + 8 * k; const int p = p0 + rr;
    const bf16_t* Pr = Pb + (size_t)p * DIN;
    const float* rowp = csh + rr * 96;
    {
      float y[8], part[8];
      unpack8(*(const uint4*)(Pr + 8 * lane), y);
      float ss = 0.f;
#pragma unroll
      for (int e = 0; e < 8; ++e) ss += y[e] * y[e];
      ss += shxl(ss, lane, 1); ss += shxl(ss, lane, 2);
      const float rs = rsqrtf(ss * (1.f / 32) + EPS);
      const int unit = lane >> 2; const bool isk = unit >= 8; const int vh = unit & 7;
      const int d0 = (lane & 3) * 8;
      const float* gn = gd + (isk ? 32 : 0) + d0;
#pragma unroll
      for (int e = 0; e < 8; ++e) y[e] = y[e] * rs * gn[e];
      if (lat) {
#pragma unroll
        for (int e = 0; e < 8; ++e) part[e] = shxl(y[e], lane, 2);
        rope_pair8(y, part, (lane & 2) != 0, rowp, rowp + 16, (lane & 1) * 8);
      }
      bf16_t* dst = (isk ? ((bf16_t*)(m.ws + OFF_KA)) : ((bf16_t*)(m.ws + OFF_QA))) + (((size_t)b * 8 + vh) * NT + p) * 32 + d0;
      *(uint4*)dst = pack8(y, isk ? 1.f : 0.17677669529663687f * LOG2E);
    }
#pragma unroll
    for (int grp = 0; grp < 2; ++grp) {
      float y[8], part[8];
      const int cbase = grp == 0 ? 768 : 1280;
      uint4 w = make_uint4(0, 0, 0, 0);
      if (lane < 48) w = *(const uint4*)(Pr + cbase + 8 * lane);
      unpack8(w, y);
      float ss = 0.f;
#pragma unroll
      for (int e = 0; e < 8; ++e) ss += y[e] * y[e];
      ss += shxl(ss, lane, 1); ss += shxl(ss, lane, 2); ss += shxl(ss, lane, 4);
      const float rs = rsqrtf(ss * (1.f / 64) + EPS);
      const int unit = lane >> 3; const bool isk = unit >= 4; const int hh = isk ? unit - 4 : unit;
      const int d0 = (lane & 7) * 8;
      const float* gn = (grp == 0 ? gwn : gg) + (isk ? 64 : 0) + d0;
      if (lane < 48) {
#pragma unroll
        for (int e = 0; e < 8; ++e) y[e] = y[e] * rs * gn[e];
      }
      if (lat) {
#pragma unroll
        for (int e = 0; e < 8; ++e) part[e] = shxl(y[e], lane, 4);
        rope_pair8(y, part, (lane & 4) != 0, rowp + 32, rowp + 64, (lane & 3) * 8);
      }
      if (lane < 48) {
        bf16_t* base = grp == 0 ? (isk ? ((bf16_t*)(m.ws + OFF_KW)) : ((bf16_t*)(m.ws + OFF_QW))) : (isk ? ((bf16_t*)(m.ws + OFF_KG)) : ((bf16_t*)(m.ws + OFF_QG)));
        bf16_t* dst = base + (((size_t)b * (isk ? 2 : 4) + hh) * NT + p) * 64 + d0;
        *(uint4*)dst = pack8(y, isk ? 1.f : 0.125f * LOG2E);
      }
    }
    {
      const int vsrc = lane < 32 ? 512 + 8 * lane : (lane < 48 ? 1152 + 8 * (lane - 32) : 1664 + 8 * (lane - 48));
      uint4 w = *(const uint4*)(Pr + vsrc);
      *(uint2*)(Vs + rr * VS_STRIDE + lane * 16) = make_uint2(w.x, w.y);
      *(uint2*)(Vs + rr * VS_STRIDE + lane * 16 + 8) = make_uint2(w.z, w.w);
    }
  }
  __syncthreads();
  for (int tk = tid; tk < 2048; tk += NTHR) {
    const int pg = tk & 3; const int vch = (tk >> 2) & 15 | ((tk >> 6) << 4);
    unsigned short e[8];
#pragma unroll
    for (int i = 0; i < 8; ++i) {
      int sidx = 8 * pg + i;
      int pl = (sidx & 16) | perm16(sidx & 15);
      e[i] = *(const unsigned short*)(Vs + pl * VS_STRIDE + vch * 2);
    }
    uint4 w = make_uint4(e[0] | ((unsigned)e[1] << 16), e[2] | ((unsigned)e[3] << 16), e[4] | ((unsigned)e[5] << 16), e[6] | ((unsigned)e[7] << 16));
    bf16_t* dst;
    if (vch < 256) dst = ((bf16_t*)(m.ws + OFF_VAt)) + (((size_t)b * 4 + (vch >> 6)) * 64 + (vch & 63)) * NT;
    else if (vch < 384) dst = ((bf16_t*)(m.ws + OFF_VWt)) + (((size_t)b * 2 + ((vch - 256) >> 6)) * 64 + (vch & 63)) * NT;
    else dst = ((bf16_t*)(m.ws + OFF_VGt)) + (((size_t)b * 2 + ((vch - 384) >> 6)) * 64 + (vch & 63)) * NT;
    *(uint4*)(dst + p0 + 8 * pg) = w;
  }
  {
    const float* cw = ((const float*)m.hy_conv_w) + l * 3 * 768; const float* cb = ((const float*)m.hy_conv_b) + l * 768;
    const int cc = lane >> 3, pg = lane & 7;
#pragma unroll 2
    for (int cg = wid; cg < 96; cg += 8) {
      const int c = cg * 8 + cc;
      const float w0 = cw[c], w1 = cw[768 + c], w2 = cw[1536 + c], bb = cb[c];
      float xin[6];
#pragma unroll
      for (int i = 0; i < 6; ++i) xin[i] = bf2f(*(const bf16_t*)(Hs + (4 * pg + i) * HS_STRIDE + c * 2));
      float o[4];
#pragma unroll
      for (int i = 0; i < 4; ++i) o[i] = xin[i] * w0 + xin[i + 1] * w1 + xin[i + 2] * w2 + bb;
      *(float4*)(((float*)(m.ws + OFF_uT)) + ((size_t)b * 768 + c) * NT + p0 + 4 * pg) = make_float4(o[0], o[1], o[2], o[3]);
    }
  }
}

DI void hyena_ctx_channel(MKP m_in, int l, int c, char* smem) {
  const MK m = launder_mk(m_in);
  float* kf = (float*)smem;
  float* vz = kf + 1024;
  float* red = vz + 512;
  float* wcol = red + 16;
  const int tid = TID;
  const float* hd = ((float*)(m.ws + OFF_hdn2)) + (size_t)l * 64 * NT + SEQ;
  const float* w3 = m.hy_w3 + (size_t)l * 64 * 1024; const float* b3 = m.hy_b3 + l * 1024;
  __syncthreads();
  if (tid < 256) { int od = tid >> 6, i = tid & 63; wcol[i * 4 + od] = w3[i * 1024 + (od >> 1) * 512 + (od & 1) * 256 + c]; }
  __syncthreads();
  const float delta = fabsf(-3.0701134573253944f + (float)c * ((-15.350567286626972f + 3.0701134573253944f) / 255.f));
  float n0 = 0.f, n1 = 0.f;
  if (tid < 256) {
    const int j = tid;
    float f00 = b3[c], f01 = b3[256 + c], f10 = b3[512 + c], f11 = b3[768 + c];
#pragma unroll 4
    for (int i = 0; i < 64; ++i) {
      float hv = hd[(size_t)i * NT + j];
      const float4 w = *(const float4*)(wcol + 4 * i);
      f00 += hv * w.x; f01 += hv * w.y; f10 += hv * w.z; f11 += hv * w.w;
    }
    const float dec = __expf(-((float)j / (float)(CTX - 1)) * delta);
    f00 *= dec; f01 *= dec; f10 *= dec; f11 *= dec;
    kf[256 + j] = f00; kf[512 + 256 + j] = f10; n0 += fabsf(f00); n1 += fabsf(f10);
    if (j > 0) { kf[256 - j] = f01; kf[512 + 256 - j] = f11; n0 += fabsf(f01); n1 += fabsf(f11); }
    else { kf[0] = 0.f; kf[512] = 0.f; }
  }
  n0 = block_sum_512(n0, red);
  n1 = block_sum_512(n1, red);
  const float i0 = 1.f / n0, i1 = 1.f / n1;
  const int bb = tid >> 8, t = tid & 255;
  const float* ub = ((float*)(m.ws + OFF_uT)) + ((size_t)bb * 768 + c) * NT;
  const float vself = ub[t];
  vz[bb * 256 + t] = vself;
  __syncthreads();
  float acc = 0.f;
  for (int s2 = 0; s2 < 256; s2 += 4) { const float4 v4 = *(const float4*)(vz + bb * 256 + s2); const float* kp = kf + 256 + t - s2; acc += v4.x * kp[0] + v4.y * kp[-1] + v4.z * kp[-2] + v4.w * kp[-3]; }
  const float z = ub[(size_t)256 * NT + t] * (acc * i0 + m.hy_bias[l * 512 + c] * vself);
  __syncthreads();
  vz[bb * 256 + t] = z;
  __syncthreads();
  float acc2 = 0.f;
  for (int s2 = 0; s2 < 256; s2 += 4) { const float4 v4 = *(const float4*)(vz + bb * 256 + s2); const float* kp = kf + 512 + 256 + t - s2; acc2 += v4.x * kp[0] + v4.y * kp[-1] + v4.z * kp[-2] + v4.w * kp[-3]; }
  ((float*)(m.ws + OFF_yT))[((size_t)bb * 256 + c) * NT + t] = ub[(size_t)512 * NT + t] * (acc2 * i1 + m.hy_bias[l * 512 + 256 + c] * z);
}

DI TabJob make_tabjob(const MK& m, int l, int slot0, bool on) {
  TabJob j;
  j.pu = on ? m.peer_u + (size_t)l * 16384 * D : nullptr; j.pv = m.peer_v + (size_t)l * 16384 * D;
  j.du = ((unsigned char*)(m.ws + OFF_u8)) + (size_t)l * 16384 * D; j.dv = ((unsigned char*)(m.ws + OFF_v8)) + (size_t)l * 16384 * D;
  j.su = ((float*)(m.ws + OFF_us)) + l * 16384; j.sv = ((float*)(m.ws + OFF_vs)) + l * 16384;
  j.slot = slot0; j.wv = __builtin_amdgcn_readfirstlane(BID * 8 + (TID >> 6)); j.nw = NBLK * 8; j.prow = -1;
  return j;
}
constexpr int TAB_SLOTS_FILTER = 4;
constexpr int TAB_SLOTS_ALL = 24;
DI void phase_mix(MKP m_in, int l, bool want_ctx, char* smem) {
  const MK m = launder_mk(m_in);
  AttnArgs a;
  a.QA = ((bf16_t*)(m.ws + OFF_QA)); a.KA = ((bf16_t*)(m.ws + OFF_KA)); a.VAt = ((bf16_t*)(m.ws + OFF_VAt)); a.QW = ((bf16_t*)(m.ws + OFF_QW)); a.KW = ((bf16_t*)(m.ws + OFF_KW)); a.VWt = ((bf16_t*)(m.ws + OFF_VWt)); a.QG = ((bf16_t*)(m.ws + OFF_QG)); a.KG = ((bf16_t*)(m.ws + OFF_KG)); a.VGt = ((bf16_t*)(m.ws + OFF_VGt));
  a.g_qk_diff = m.g_qk_diff + l * 64; a.g_qk_win = m.g_qk_win + l * 128; a.g_qk_glob = m.g_qk_glob + l * 128; a.sink = m.sink_win + l * 4;
  a.lambda_diff = m.lambda_diff + l * 128; a.g_mix_out = m.g_mix_out + l * D; a.lambda_init = 0.8f - 0.6f * __expf(-0.3f * (float)l); a.pad0 = 0;
  a.A2 = ((bf16_t*)(m.ws + OFF_A2)); a.Oslab = ((float*)(m.ws + OFF_Oslab)); a.Lslab = ((float*)(m.ws + OFF_Lslab));
  const int nitems = 640 + (want_ctx ? 20 : 0);
  for (int rep = 0; rep < REP_DIFF; ++rep) for (int idx = BID; idx < 256; idx += NBLK) attn_dispatch(a, idx, want_ctx, smem);
  for (int rep = 0; rep < REP_GLOB; ++rep) for (int idx = 256 + BID; idx < 512; idx += NBLK) attn_dispatch(a, idx, want_ctx, smem);
  for (int rep = 0; rep < REP_HY; ++rep) for (int c = BID; c < 256; c += NBLK) {
    TabJob job = make_tabjob(m, l, TAB_SLOTS_FILTER, rep == 0 && c == BID);
    hyena_channel(c, m.hy_bias + l * 512, ((float*)(m.ws + OFF_uT)), ((float*)(m.ws + OFF_zT)), ((float*)(m.ws + OFF_yT)), (const uint2*)(m.ws + OFF_Hc), smem, job);
    tab_flush(job, TID & 63);
    if (want_ctx) hyena_ctx_channel(m_in, l, c, smem);
  }
  {
    TabJob job = make_tabjob(m, l, TAB_SLOTS_ALL, true);
    const int lane = TID & 63;
    while (job.slot * job.nw < 32768) tab_step(job, lane);
    tab_flush(job, lane);
  }
  for (int idx = 512 + BID; idx < nitems; idx += NBLK) attn_dispatch(a, idx, want_ctx, smem);
}

DI void phase_fin(MKP m_in, int l, bool want_ctx, char* smem) {
  const MK m = launder_mk(m_in);
  const float* gmo = m.g_mix_out + l * D;
  const int lane = TID & 63, wid = TID >> 6;
  char* wl = smem + wid * 9216;
  for (int chunk = BID * 8 + wid; chunk < NB * 8 * (NT / 64); chunk += NBLK * 8) {
    const int pc = chunk % (NT / 64), hd = (chunk / (NT / 64)) % 8, b = chunk / ((NT / 64) * 8);
    const int pbase = pc * 64;
    if (pbase < CTX && !want_ctx) continue;
    const float* gm = gmo + 512 + hd * 64;
    bf16_t* dst0 = ((bf16_t*)(m.ws + OFF_A2)) + ((size_t)b * NT + pbase) * D + 512 + hd * 64;
    if (hd < 4) {
      const int c4 = lane & 15, rr = lane >> 4;
      const float4 g4 = *(const float4*)(gm + 4 * c4);
      const size_t i0b = (((size_t)0 * NB + b) * 4 + hd) * NT + pbase, i1b = (((size_t)1 * NB + b) * 4 + hd) * NT + pbase;
      const float* Os = (const float*)(m.ws + OFF_Oslab); const float* Ls = (const float*)(m.ws + OFF_Lslab);
#pragma unroll 4
      for (int ps = 0; ps < 16; ++ps) {
        const int row = ps * 4 + rr;
        const float4 x = *(const float4*)(Os + (i0b + row) * 64 + 4 * c4), y = *(const float4*)(Os + (i1b + row) * 64 + 4 * c4);
        const float inv = 1.f / (Ls[i0b + row] + Ls[i1b + row]);
        const float o0 = (x.x + y.x) * inv, o1 = (x.y + y.y) * inv, o2 = (x.z + y.z) * inv, o3 = (x.w + y.w) * inv;
        float ss = o0 * o0 + o1 * o1 + o2 * o2 + o3 * o3;
        ss += shxl(ss, lane, 8); ss += shxl(ss, lane, 4); ss += shxl(ss, lane, 2); ss += shxl(ss, lane, 1);
        const float rs = rsqrtf(ss * (1.f / 64) + EPS);
        *(uint2*)(dst0 + (size_t)row * D + 4 * c4) = make_uint2(pk2bf(o0 * rs * g4.x, o1 * rs * g4.y), pk2bf(o2 * rs * g4.z, o3 * rs * g4.w));
      }
    } else {
      const int g = hd - 4, p = pbase + lane;
      float o[64]; float ss = 0.f;
#pragma unroll
      for (int i = 0; i < 64; ++i) o[i] = ((const float*)(m.ws + OFF_yT))[((size_t)b * 256 + g * 64 + i) * NT + p];
#pragma unroll
      for (int i = 0; i < 64; ++i) ss += o[i] * o[i];
      const float rs = rsqrtf(ss * (1.f / 64) + EPS);
#pragma unroll
      for (int i = 0; i < 8; ++i)
        *(uint4*)(wl + lane * 144 + i * 16) = make_uint4(pk2bf(o[8 * i] * rs * gm[8 * i], o[8 * i + 1] * rs * gm[8 * i + 1]), pk2bf(o[8 * i + 2] * rs * gm[8 * i + 2], o[8 * i + 3] * rs * gm[8 * i + 3]),
                                                         pk2bf(o[8 * i + 4] * rs * gm[8 * i + 4], o[8 * i + 5] * rs * gm[8 * i + 5]), pk2bf(o[8 * i + 6] * rs * gm[8 * i + 6], o[8 * i + 7] * rs * gm[8 * i + 7]));
      asm volatile("s_waitcnt lgkmcnt(0)" ::: "memory");
#pragma unroll
      for (int k = 0; k < 8; ++k) {
        const int row = k * 8 + (lane >> 3), ch = lane & 7;
        *(uint4*)(dst0 + (size_t)row * D + ch * 8) = *(const uint4*)(wl + row * 144 + ch * 16);
      }
      asm volatile("s_waitcnt lgkmcnt(0)" ::: "memory");
    }
  }
}

#ifndef PEER_SLICED
#define PEER_SLICED 1
#endif
#if !PEER_SLICED
DI void phase_peer(MKP m_in, int l, bool want_ctx, bool last, char* smem) {
  const MK m = launder_mk(m_in);
  const int lane = TID & 63, wid = TID >> 6;
  char* wbase = smem + wid * 10240;
  int* ex_l = (int*)wbase; float* g_l = (float*)(wbase + 4608); float* wd = (float*)(wbase + 9216);
  const float* modv_l = ((float*)(m.ws + OFF_modv)) + (size_t)l * 3 * NMOD;
  const int gw0 = BID * 8 + wid, nw0 = NBLK * 8;
  for (int i0 = 0; gw0 + nw0 * i0 < R && i0 < 9; i0 += 8) {
    const int slot = i0 + (lane >> 3);
    const int r = gw0 + nw0 * slot;
    if (slot < 9 && r < R && !((r % NT) < CTX && !want_ctx))
      merge_one(((unsigned*)(m.ws + OFF_topv)), r, lane & 7, ex_l + slot * 128, g_l + slot * 128);
  }
  int slot = 0;
  for (int r = gw0; r < R; r += nw0, ++slot) {
    if ((r % NT) < CTX && !want_ctx) continue;
    if (slot >= 9) {
      if (lane < 8) merge_one(((unsigned*)(m.ws + OFF_topv)), r, lane, ex_l + 8 * 128, g_l + 8 * 128);
    }
    const int sl = slot < 9 ? slot : 8;
    peer_token<PEER_SLICED>(r, ((bf16_t*)(m.ws + OFF_hbuf)), ex_l + sl * 128, g_l + sl * 128, ((unsigned char*)(m.ws + OFF_u8)) + (size_t)l * 16384 * D, ((float*)(m.ws + OFF_us)) + l * 16384, ((unsigned char*)(m.ws + OFF_v8)) + (size_t)l * 16384 * D, ((float*)(m.ws + OFF_vs)) + l * 16384,
               modv_l, ((float*)(m.ws + OFF_xs)), wd, last ? m.out : nullptr, ((int*)(m.ws + OFF_experts)), ((float*)(m.ws + OFF_gates)));
  }
}
#endif
DI void peer_v_rows(const MK& m, int l, bool want_ctx, bool last, int vslice_, int w0, int wstride) {
  const int lane = TID & 63, g = lane >> 3, j = lane & 7;
  const int vslice = __builtin_amdgcn_readfirstlane(vslice_);
  const unsigned char* v8u = ((const unsigned char*)(m.ws + OFF_v8)) + (size_t)l * 16384 * D + (size_t)vslice * TSLICE;
  const unsigned j16 = (unsigned)j * 16u;
  const unsigned* wts = (const unsigned*)(m.ws + OFF_gates);
  const float* modv_l = ((const float*)(m.ws + OFF_modv)) + (size_t)l * 3 * NMOD;
  float* xs = (float*)(m.ws + OFF_xs);
#pragma unroll 1
  for (int r = w0; r < R; r += wstride) {
    const int b = r / NT, p = r % NT;
    if (p < CTX && !want_ctx) continue;
    unsigned pkv[16];
    {
      const uint4* ep = (const uint4*)(wts + (size_t)r * 128 + 16 * g);
#pragma unroll
      for (int q = 0; q < 4; ++q) { const uint4 e4 = ep[q]; pkv[4 * q] = e4.x; pkv[4 * q + 1] = e4.y; pkv[4 * q + 2] = e4.z; pkv[4 * q + 3] = e4.w; }
    }
    const float invS = ((const float*)(m.ws + OFF_wsc))[r];
    const int col = 256 * (g >> 1) + 32 * vslice + 4 * j + 2 * (g & 1);
    const int mrow = p < CTX ? 2 : b;
    const float2 gg = *(const float2*)(modv_l + mrow * NMOD + 5 * D + col);
    float2 xv = *(const float2*)(xs + (size_t)r * D + col);
    uint4 rw[16];
#pragma unroll
    for (int q = 0; q < 16; ++q) {
      unsigned off;
      asm("v_mad_u32_u16 %0, %1, %2, %3" : "=v"(off) : "v"(pkv[q]), "s"(128u), "v"(j16));
      rw[q] = *(const uint4*)(v8u + off);
    }
    h2_t hacc[8];
#pragma unroll
    for (int i = 0; i < 8; ++i) hacc[i] = (h2_t){(_Float16)0.f, (_Float16)0.f};
#pragma unroll
    for (int q = 0; q < 16; ++q) {
      const h2_t pk2 = __builtin_bit_cast(h2_t, pkv[q]);
      const h2_t w2 = __builtin_shufflevector(pk2, pk2, 1, 1);
      const int r4[4] = {(int)rw[q].x, (int)rw[q].y, (int)rw[q].z, (int)rw[q].w};
#pragma unroll
      for (int c = 0; c < 4; ++c) {
        hacc[2 * c] = __builtin_elementwise_fma(__builtin_bit_cast(h2_t, __builtin_amdgcn_cvt_scalef32_pk_f16_fp8(r4[c], 1.0f, false)), w2, hacc[2 * c]);
        hacc[2 * c + 1] = __builtin_elementwise_fma(__builtin_bit_cast(h2_t, __builtin_amdgcn_cvt_scalef32_pk_f16_fp8(r4[c], 1.0f, true)), w2, hacc[2 * c + 1]);
      }
    }
    h2_t b4[4], c2[2], d1;
    {
      const bool g2 = lane & 32, g1 = lane & 16, g0 = lane & 8;
#pragma unroll
      for (int i = 0; i < 4; ++i) {
        const int send = __builtin_bit_cast(int, g2 ? hacc[i] : hacc[4 + i]); const h2_t keep = g2 ? hacc[4 + i] : hacc[i];
        b4[i] = keep + __builtin_bit_cast(h2_t, shxl(send, lane, 32));
      }
#pragma unroll
      for (int i = 0; i < 2; ++i) {
        const int send = __builtin_bit_cast(int, g1 ? b4[i] : b4[2 + i]); const h2_t keep = g1 ? b4[2 + i] : b4[i];
        c2[i] = keep + __builtin_bit_cast(h2_t, shxl(send, lane, 16));
      }
      {
        const int send = __builtin_bit_cast(int, g0 ? c2[0] : c2[1]); const h2_t keep = g0 ? c2[1] : c2[0];
        d1 = keep + __builtin_bit_cast(h2_t, shxl(send, lane, 8));
      }
    }
    {
      xv.x += gg.x * ((float)d1[0] * invS); xv.y += gg.y * ((float)d1[1] * invS);
      float* op = last ? m.out + ((size_t)b * SEQ + (p - CTX)) * D + col : xs + (size_t)r * D + col;
      *(float2*)op = xv;
    }
  }
}
DI void phase_peer_merge(MKP m_in, bool want_ctx, char* smem) {
  const MK m = launder_mk(m_in);
  const int lane = TID & 63, wid = TID >> 6;
  char* wbase = smem + wid * 8192;
  int* ex_l = (int*)wbase; float* g_l = (float*)(wbase + 4096);
  int* experts = (int*)(m.ws + OFF_experts); float* gates = (float*)(m.ws + OFF_gates);
  for (int grp = BID * 8 + wid; grp < R / 8; grp += NBLK * 8) {
    const int r = grp * 8 + (lane >> 3);
    const bool skip = ((r % NT) < CTX) && !want_ctx;
    if (skip) continue;
    merge_one(((unsigned*)(m.ws + OFF_topv)), r, lane & 7, ex_l + (lane >> 3) * 128, g_l + (lane >> 3) * 128);
    asm volatile("s_waitcnt lgkmcnt(0)" ::: "memory");
#pragma unroll
    for (int q = 0; q < 4; ++q) {
      const int idx = (q * 64 + lane) * 4;
      *(uint4*)(experts + (size_t)grp * 1024 + idx) = *(const uint4*)(ex_l + idx);
      *(float4*)(gates + (size_t)grp * 1024 + idx) = *(const float4*)(g_l + idx);
    }
    asm volatile("s_waitcnt lgkmcnt(0)" ::: "memory");
  }
}
DI void peer_u_rows(const MK& m, int l, bool want_ctx, int vslice_, int w0, int wstride) {
  const int lane = TID & 63, g = lane >> 3, j = lane & 7;
  const int vslice = __builtin_amdgcn_readfirstlane(vslice_);
  const unsigned char* u8 = ((const unsigned char*)(m.ws + OFF_u8)) + (size_t)l * 16384 * D + (size_t)vslice * TSLICE;
  const unsigned char* xq = (const unsigned char*)(m.ws + OFF_xq);
  const unsigned loff = (unsigned)(vslice * 128 + j * 16);
  const unsigned j16 = (unsigned)j * 16u;
  const int* experts = (const int*)(m.ws + OFF_experts);
  int* PD = ((int*)(m.ws + OFF_P)) + (size_t)vslice * R * 128;
#pragma unroll 1
  for (int r = w0; r < R; r += wstride) {
    if (((r % NT) < CTX) && !want_ctx) continue;
    uint4 rw[16];
    {
      const uint4* ep = (const uint4*)((const unsigned short*)experts + (size_t)r * 128 + 16 * g);
      const uint4 ea = ep[0], eb = ep[1];
      const unsigned ew[8] = {ea.x, ea.y, ea.z, ea.w, eb.x, eb.y, eb.z, eb.w};
#pragma unroll
      for (int q = 0; q < 8; ++q) {
        unsigned o0, o1;
        asm("v_mad_u32_u16 %0, %1, %2, %3" : "=v"(o0) : "v"(ew[q]), "s"(128u), "v"(j16));
        asm("v_mad_u32_u16 %0, %1, %2, %3 op_sel:[1,0,0,0]" : "=v"(o1) : "v"(ew[q]), "s"(128u), "v"(j16));
        rw[2 * q] = *(const uint4*)(u8 + o0);
        rw[2 * q + 1] = *(const uint4*)(u8 + o1);
      }
    }
    const uint4 xv = *(const uint4*)(xq + (size_t)r * D + loff);
    int pd[16];
#pragma unroll
    for (int q = 0; q < 16; ++q) {
      int a = __builtin_amdgcn_sdot4((int)rw[q].x, (int)xv.x, 0, false);
      a = __builtin_amdgcn_sdot4((int)rw[q].y, (int)xv.y, a, false);
      a = __builtin_amdgcn_sdot4((int)rw[q].z, (int)xv.z, a, false);
      pd[q] = __builtin_amdgcn_sdot4((int)rw[q].w, (int)xv.w, a, false);
    }
    int b8[8], c4[4], d2[2];
    {
      const bool j2 = lane & 4, j1 = lane & 2, j0 = lane & 1;
#pragma unroll
      for (int i = 0; i < 8; ++i) { const int send = j2 ? pd[i] : pd[8 + i], keep = j2 ? pd[8 + i] : pd[i]; b8[i] = keep + shxl(send, lane, 4); }
#pragma unroll
      for (int i = 0; i < 4; ++i) { const int send = j1 ? b8[i] : b8[4 + i], keep = j1 ? b8[4 + i] : b8[i]; c4[i] = keep + shxl(send, lane, 2); }
#pragma unroll
      for (int i = 0; i < 2; ++i) { const int send = j0 ? c4[i] : c4[2 + i], keep = j0 ? c4[2 + i] : c4[i]; d2[i] = keep + shxl(send, lane, 1); }
    }
    *(int2*)(PD + (size_t)r * 128 + 16 * g + 2 * j) = make_int2(d2[0], d2[1]);
  }
}
DI void phase_peer_u(MKP m_in, int l, bool want_ctx, char* smem) {
  const MK m = launder_mk(m_in);
  unsigned* bar = (unsigned*)(m.ws + OFF_bar);
  volatile LAS unsigned* st = (volatile LAS unsigned*)(smem + SMEM_BYTES);
  if (threadIdx.x == 0) {
    unsigned ok = 1u, mine = 0u; const unsigned x = st[3];
    for (unsigned q = 0; q < 16; ++q) { const unsigned c = xb_ld(&bar[XB_XCNT(q)]); if ((q < 8) != (c > 0u)) ok = 0u; if (q == x) mine = c; }
    st[4] = ok ? mine : 0u;
  }
  __syncthreads();
  const unsigned nloc = st[4];
  const int wid = TID >> 6;
  if (nloc != 0u) peer_u_rows(m, l, want_ctx, (int)(st[3] & 7u), (int)st[2] * 8 + wid, (int)nloc * 8);
  else for (int v = 0; v < 8; ++v) peer_u_rows(m, l, want_ctx, v, BID * 8 + wid, NBLK * 8);
}
DI void phase_peer_reduce(MKP m_in, int l, bool want_ctx) {
  const MK m = launder_mk(m_in);
  const int* experts = (const int*)(m.ws + OFF_experts);
  float* gates = (float*)(m.ws + OFF_gates);
  const int* PD = (const int*)(m.ws + OFF_P);
  const float* us = ((const float*)(m.ws + OFF_us)) + l * 16384;
  const float* vs = ((const float*)(m.ws + OFF_vs)) + l * 16384;
  const float* xqs = (const float*)(m.ws + OFF_xqs);
  for (int i4 = BID * NTHR + TID; i4 < R * 32; i4 += NBLK * NTHR) {
    const int r = i4 >> 5;
    if (((r % NT) < CTX) && !want_ctx) continue;
    int4 acc = make_int4(0, 0, 0, 0);
#pragma unroll
    for (int v = 0; v < 8; ++v) { const int4 p = ((const int4*)(PD + (size_t)v * R * 128))[i4]; acc.x += p.x; acc.y += p.y; acc.z += p.z; acc.w += p.w; }
    const uint2 e2 = ((const uint2*)experts)[i4];
    const int4 e4 = make_int4((int)(e2.x & 0xffffu), (int)(e2.x >> 16), (int)(e2.y & 0xffffu), (int)(e2.y >> 16));
    float4 g4 = ((const float4*)gates)[i4];
    const float xs_ = xqs[r];
    const int ee[4] = {e4.x, e4.y, e4.z, e4.w}; const int aa[4] = {acc.x, acc.y, acc.z, acc.w}; float gg[4] = {g4.x, g4.y, g4.z, g4.w};
#pragma unroll
    for (int q = 0; q < 4; ++q) {
      const float d = (float)aa[q] * (us[ee[q]] * xs_);
      const float t = 0.5f * d * (1.f + tanhf(0.7978845608028654f * (d + 0.044715f * d * d * d)));
      gg[q] = gg[q] * t * vs[ee[q]];
    }
    const int lane = TID & 63;
    float mxw = fmaxf(fmaxf(fabsf(gg[0]), fabsf(gg[1])), fmaxf(fabsf(gg[2]), fabsf(gg[3])));
    mxw = fmaxf(mxw, shxl(mxw, lane, 1)); mxw = fmaxf(mxw, shxl(mxw, lane, 2)); mxw = fmaxf(mxw, shxl(mxw, lane, 4));
    mxw = fmaxf(mxw, shxl(mxw, lane, 8)); mxw = fmaxf(mxw, shxl(mxw, lane, 16));
    const unsigned eb = (__float_as_uint(mxw) >> 23) & 255u;
    const float Sw = __uint_as_float((252u - eb) << 23);
    unsigned pk[4];
#pragma unroll
    for (int q = 0; q < 4; ++q) {
      const _Float16 wh = (_Float16)(gg[q] * Sw);
      pk[q] = (unsigned)ee[q] | ((unsigned)__builtin_bit_cast(unsigned short, wh) << 16);
    }
    ((uint4*)gates)[i4] = make_uint4(pk[0], pk[1], pk[2], pk[3]);
    if ((i4 & 31) == 0) ((float*)(m.ws + OFF_wsc))[r] = __uint_as_float(eb == 0u ? 0u : ((eb + 2u) << 23));
  }
}
DI void phase_peer_v(MKP m_in, int l, bool want_ctx, bool last, char* smem) {
  const MK m = launder_mk(m_in);
  unsigned* bar = (unsigned*)(m.ws + OFF_bar);
  volatile LAS unsigned* st = (volatile LAS unsigned*)(smem + SMEM_BYTES);
  if (threadIdx.x == 0) {
    unsigned ok = 1u, mine = 0u; const unsigned x = st[3];
    for (unsigned q = 0; q < 16; ++q) { const unsigned c = xb_ld(&bar[XB_XCNT(q)]); if ((q < 8) != (c > 0u)) ok = 0u; if (q == x) mine = c; }
    st[1 + 3 + 0] = ok ? mine : 0u;
  }
  __syncthreads();
  const unsigned nloc = st[4];
  const int wid = TID >> 6;
  if (nloc != 0u) {
    peer_v_rows(m, l, want_ctx, last, (int)(st[3] & 7u), (int)st[2] * 8 + wid, (int)nloc * 8);
  } else {
    for (int v = 0; v < 8; ++v) peer_v_rows(m, l, want_ctx, last, v, BID * 8 + wid, NBLK * 8);
  }
}

DI void phase_scores(MKP m_in, int l, bool last, char* smem) {
  const MK m = launder_mk(m_in);
  const int nrt = last ? 128 : 132;
  for (int t = BID; t < nrt * 8; t += NBLK)
    score_head_item(((bf16_t*)(m.ws + OFF_P)), ((bf16_t*)(m.ws + OFF_keysb)) + (size_t)l * 16 * 128 * 128, rowtile_of(t >> 3, last) * 128, t & 7, smem,
                    ((int*)(m.ws + OFF_experts)), ((float*)(m.ws + OFF_gates)));
}
DI void phase_gemm1(MKP m_in, int l, char* smem) {
  const MK m = launder_mk(m_in);
  pg8::Gemm g; g.A = (bf16_t*)(m.ws + OFF_hbuf); g.Bt = (bf16_t*)(m.ws + OFF_Wt_in) + (size_t)l * DIN * D; g.M = R; g.N = DIN; g.K = D;
  MySched S; S.init(DIN, false, NBLK, BID);
  EpiStoreBf16 E; E.Cb = (bf16_t*)(m.ws + OFF_P); E.ldc = DIN;
  __syncthreads();
  pg8::gemm_phase<EpiStoreBf16, MySched, false>((PG8_LAS unsigned char*)smem, g, S, E, nullptr);
  __syncthreads();
}
DI int ctx_rowtile(int i) { return (i >> 1) * 66 + (i & 1); }
DI void phase_gemm2(MKP m_in, int l, bool last, char* smem) {
  const MK m = launder_mk(m_in);
  pg8::Gemm g; g.A = (bf16_t*)(m.ws + OFF_A2); g.Bt = (bf16_t*)(m.ws + OFF_Wt_out) + (size_t)l * D * D; g.M = R; g.N = D; g.K = D;
  MySched S; S.init(D, true, NBLK, BID);
  EpiResidual E; E.xs = (float*)(m.ws + OFF_xs); E.gate_base = (float*)(m.ws + OFF_modv) + (size_t)l * 3 * NMOD + 2 * D;
  E.xin = l == 0 ? m.x : nullptr; E.ctxin = l == 0 ? m.ctx : nullptr;
  __syncthreads();
  pg8::gemm_phase<EpiResidual, MySched, false>((PG8_LAS unsigned char*)smem, g, S, E, nullptr);
  __syncthreads();
  if (!last) {
    const int nb = NBLK;
    for (int t = (BID + nb - 32) % nb; t < 4 * 8; t += nb)
      gemm_tile<1>(g.A, g.Bt, D, ctx_rowtile(t >> 3) * 128, (t & 7) * 128, smem, nullptr, E.xs, E.gate_base, E.xin, E.ctxin);
  }
}
DI void phase_gemm3(MKP m_in, int l, bool last, char* smem) {
  const MK m = launder_mk(m_in);
  pg8::Gemm g; g.A = (bf16_t*)(m.ws + OFF_hbuf); g.Bt = (bf16_t*)(m.ws + OFF_Wt_q) + (size_t)l * 2048 * D; g.M = R; g.N = 2048; g.K = D;
  MySched S; S.init(2048, true, NBLK, BID);
  EpiStoreBf16 E; E.Cb = (bf16_t*)(m.ws + OFF_P); E.ldc = 2048;
  __syncthreads();
  pg8::gemm_phase<EpiStoreBf16, MySched, false>((PG8_LAS unsigned char*)smem, g, S, E, nullptr);
  __syncthreads();
  if (!last) {
    const int nb = NBLK;
    for (int t = (BID + nb - 64) % nb; t < 4 * 16; t += nb)
      gemm_tile<0>(g.A, g.Bt, 2048, ctx_rowtile(t >> 4) * 128, (t & 15) * 128, smem, E.Cb, nullptr, nullptr);
  }
}
#define GSYNC() xcd_barrier((unsigned*)(launder_mk(m).ws + OFF_bar), (volatile LAS unsigned*)(smem + SMEM_BYTES))
DI void phase_filters(MKP m_in, int l, char* smem) {
  const MK m = launder_mk(m_in);
  for (int c = BID; c < 256; c += NBLK) {
    TabJob job = make_tabjob(m, l, 0, c == BID);
    hyena_filter_task(c, ((const bf16_t*)(m.ws + OFF_hdnB)) + (size_t)l * SEQ * 64, ((const bf16_t*)(m.ws + OFF_W3t)) + (size_t)l * 1024 * 64, m.hy_b3 + l * 1024, (uint2*)(m.ws + OFF_Hc), smem, job);
    tab_flush(job, TID & 63);
  }
}
template <int L>
DI void layer_body(MKP m, char* smem) {
  constexpr bool want_ctx = L == 0, last = L == 1;
  for (int rep = 0; rep < REP_NORM1; ++rep) { phase_norm(m, L, 0, L == 0, false); GSYNC(); }
  for (int rep = 0; rep < REP_GEMM1; ++rep) { phase_gemm1(m, L, smem); GSYNC(); }
  for (int rep = 0; rep < REP_PREP; ++rep) for (int t = BID; t < R / 32; t += NBLK) prep_tile(m, L, t, smem);
  for (int rep = 0; rep < REP_FILT; ++rep) phase_filters(m, L, smem);
  GSYNC();
  for (int rep = 0; rep < REP_MIX; ++rep) { phase_mix(m, L, want_ctx, smem); GSYNC(); }
  for (int rep = 0; rep < REP_FIN; ++rep) { phase_fin(m, L, want_ctx, smem); GSYNC(); }
  phase_gemm2(m, L, last, smem);
  GSYNC();
  for (int rep = 0; rep < REP_NORM2; ++rep) { phase_norm(m, L, 1, false, last); GSYNC(); }
  for (int rep = 0; rep < REP_GEMM3; ++rep) { phase_gemm3(m, L, last, smem); GSYNC(); }
  for (int rep = 0; rep < REP_SCORES; ++rep) { phase_scores(m, L, last, smem); GSYNC(); }
  for (int rep = 0; rep < (last ? REP_PEER_LAST : 1); ++rep) {
#if PEER_SLICED
    for (int ru = 0; ru < (last ? REP_PEER_U : 1); ++ru) phase_peer_u(m, L, want_ctx, smem);
    GSYNC();
    phase_peer_reduce(m, L, want_ctx);
    GSYNC();
    for (int rv = 0; rv < (last ? REP_PEER_V : 1); ++rv) phase_peer_v(m, L, want_ctx, last, smem);
#else
    phase_peer(m, L, want_ctx, last, smem);
#endif
    if (!last || rep + 1 < REP_PEER_LAST) GSYNC();
  }
}
__global__ __launch_bounds__(NTHR) void k_mega(MK m_unused) {
  extern __shared__ __attribute__((aligned(16))) char smem[];
  (void)m_unused;
  MKP m = (MKP)__builtin_amdgcn_kernarg_segment_ptr();
  {
    volatile LAS unsigned* st = (volatile LAS unsigned*)(smem + SMEM_BYTES);
    if (threadIdx.x == 0) { st[0] = 0u; st[1] = 0u; st[2] = 0u; st[3] = 0u; st[4] = 0u; st[5] = 0u; }
    __syncthreads();
    xcd_barrier_post((unsigned*)(launder_mk(m).ws + OFF_bar), st);
  }
  for (int rep = 0; rep < REP_P0; ++rep) { phase0(m, smem); GSYNC(); }
  layer_body<0>(m, smem);
  layer_body<1>(m, smem);
}

extern "C" void kernel_launch(void* const* d_in, const int* in_sizes, int n_in, void* d_out, int out_size, void* d_ws, size_t ws_size,
                              hipStream_t stream) {
  (void)in_sizes; (void)n_in; (void)out_size;
  MK m;
  memset(&m, 0, sizeof(m));
  const float** ip = (const float**)&m.x;
  for (int i = 0; i < 30; ++i) ip[i] = (const float*)d_in[i];
  m.out = (float*)d_out;
  m.ws = (char*)d_ws;
  if (WS_TOTAL > ws_size) return;

  static int grid_blocks = 0;
  if (!grid_blocks) {
    (void)hipFuncSetAttribute((const void*)k_mega, hipFuncAttributeMaxDynamicSharedMemorySize, SMEM_BYTES + 32);
    int dev = 0, cus = 0, per_cu = 0;
    (void)hipGetDevice(&dev);
    (void)hipDeviceGetAttribute(&cus, hipDeviceAttributeMultiprocessorCount, dev);
    (void)hipOccupancyMaxActiveBlocksPerMultiprocessor(&per_cu, k_mega, NTHR, SMEM_BYTES + 32);
    if (per_cu > 1) per_cu = 1;
    grid_blocks = cus * per_cu;
  }
  (void)hipMemsetAsync(m.ws + OFF_bar, 0, (size_t)XCD_BAR_WORDS * 4, stream);
  void* args[] = {&m};
  (void)hipLaunchCooperativeKernel((void*)k_mega, dim3(grid_blocks), dim3(NTHR), args, SMEM_BYTES + 32, stream);
}
```

```cpp
#include <hip/hip_runtime.h>
#ifndef REP_DIFF
#define REP_DIFF 1
#endif
#ifndef REP_GLOB
#define REP_GLOB 1
#endif
#ifndef REP_HY
#define REP_HY 1
#endif
#ifndef REP_FILT
#define REP_FILT 1
#endif
#ifndef REP_PEER_U
#define REP_PEER_U 1
#endif
#ifndef REP_PEER_V
#define REP_PEER_V 1
#endif
#ifndef REP_NORM1
#define REP_NORM1 1
#endif
#ifndef REP_GEMM1
#define REP_GEMM1 1
#endif
#ifndef REP_PREP
#define REP_PREP 1
#endif
#ifndef REP_MIX
#define REP_MIX 1
#endif
#ifndef REP_FIN
#define REP_FIN 1
#endif
#ifndef REP_NORM2
#define REP_NORM2 1
#endif
#ifndef REP_GEMM3
#define REP_GEMM3 1
#endif
#ifndef REP_SCORES
#define REP_SCORES 1
#endif
#ifndef REP_MERGE
#define REP_MERGE 1
#endif
#ifndef REP_PEER_LAST
#define REP_PEER_LAST 1
#endif
#ifndef REP_P0_MOD
#define REP_P0_MOD 1
#endif
#ifndef REP_P0_HY
#define REP_P0_HY 1
#endif
#ifndef REP_P0_W
#define REP_P0_W 1
#endif
#ifndef REP_P0
#define REP_P0 1
#endif
#include <hip/hip_cooperative_groups.h>
namespace cg = cooperative_groups;
#include <stdint.h>
#include <string.h>

#define DI __device__ __forceinline__
#define LAS __attribute__((address_space(3)))
typedef unsigned short bf16_t;

constexpr int D = 1024;
constexpr int NB = 2;
constexpr int SEQ = 8192;
constexpr int CTX = 256;
constexpr int NT = SEQ + CTX;
constexpr int R = NB * NT;
constexpr int DIN = 2560;
constexpr int NMOD = 6 * D;
constexpr float EPS = 1e-6f;
constexpr float LOG2E = 1.4426950408889634f;

DI int opq_v(int x) { asm volatile("" : "+v"(x)); return x; }
DI int opq_s(int x) { asm volatile("" : "+s"(x)); return x; }
template <class T> DI T* opq_p(T* p) { asm volatile("" : "+s"(p)); return p; }
#define TID opq_v((int)threadIdx.x)
#define BID opq_s((int)blockIdx.x)
#define NBLK opq_s((int)gridDim.x)
DI float shxl(float v, int lane, int mask) { return __builtin_bit_cast(float, __builtin_amdgcn_ds_bpermute((lane ^ mask) << 2, __builtin_bit_cast(int, v))); }
DI int shxl(int v, int lane, int mask) { return __builtin_amdgcn_ds_bpermute((lane ^ mask) << 2, v); }
DI float shx(float v, int mask) { return shxl(v, opq_v((int)threadIdx.x) & 63, mask); }
DI bf16_t f2bf(float x) { unsigned u = __float_as_uint(x); u += 0x7fffu + ((u >> 16) & 1u); return (bf16_t)(u >> 16); }
DI float bf2f(bf16_t h) { return __uint_as_float(((unsigned)h) << 16); }
DI float bflo(unsigned w) { return __uint_as_float(w << 16); }
DI float bfhi(unsigned w) { return __uint_as_float(w & 0xffff0000u); }

DI float block_sum_256(float v, float* red) {
  for (int o = 32; o > 0; o >>= 1) v += shx(v, o);
  int w = TID >> 6;
  __syncthreads();
  if ((TID & 63) == 0) red[w] = v;
  __syncthreads();
  float s = red[0] + red[1] + red[2] + red[3];
  return s;
}

DI int perm16(int o) { return (o & 3) | ((o & 4) << 1) | ((o & 8) >> 1); }

typedef __attribute__((ext_vector_type(8))) short bf16x8;
typedef __attribute__((ext_vector_type(16))) float f32x16;
typedef __attribute__((ext_vector_type(2))) __bf16 bf16x2_t;
typedef __attribute__((ext_vector_type(2))) float f32x2_t;
#define MFMA32(a, b, c) __builtin_amdgcn_mfma_f32_32x32x16_bf16((a), (b), (c), 0, 0, 0)
DI unsigned pk2bf(float a, float b) { f32x2_t v = {a, b}; return __builtin_bit_cast(unsigned, __builtin_convertvector(v, bf16x2_t)); }
constexpr int NTHR = 512;

DI void wconv_strip(const float* __restrict__ W, bf16_t* __restrict__ Wt, int N, int strip, float* sm) {
  const int tn4 = strip % (N / 256), tk = strip / (N / 256);
  const int tid = TID;
  __syncthreads();
#pragma unroll
  for (int q = 0; q < 8; ++q) {
    const int i = tid + q * NTHR;
    const int kr = i >> 6, c4 = (i & 63) * 4;
    const float4 v = *(const float4*)(W + (size_t)(tk * 64 + kr) * N + tn4 * 256 + c4);
    float* d = sm + kr * 257 + c4; d[0] = v.x; d[1] = v.y; d[2] = v.z; d[3] = v.w;
  }
  __syncthreads();
#pragma unroll
  for (int q = 0; q < 4; ++q) {
    const int i = tid + q * NTHR;
    const int n = i >> 3, k8 = (i & 7) * 8;
    unsigned w[4];
#pragma unroll
    for (int j = 0; j < 4; ++j) w[j] = pk2bf(sm[(k8 + 2 * j) * 257 + n], sm[(k8 + 2 * j + 1) * 257 + n]);
    *(uint4*)(Wt + (size_t)(tn4 * 256 + n) * D + tk * 64 + k8) = make_uint4(w[0], w[1], w[2], w[3]);
  }
}
struct WS8 { float4 v0, v1, v2, v3, v4, v5, v6, v7; };
DI WS8 wstrip_fetch(const float* __restrict__ W, int N, int strip) {
  const int tn4 = strip % (N / 256), tk = strip / (N / 256);
  const int tid = TID;
  const float* p = W + (size_t)(tk * 64 + (tid >> 6)) * N + tn4 * 256 + (tid & 63) * 4;
  WS8 r;
  r.v0 = *(const float4*)(p); r.v1 = *(const float4*)(p + (size_t)8 * N); r.v2 = *(const float4*)(p + (size_t)16 * N); r.v3 = *(const float4*)(p + (size_t)24 * N);
  r.v4 = *(const float4*)(p + (size_t)32 * N); r.v5 = *(const float4*)(p + (size_t)40 * N); r.v6 = *(const float4*)(p + (size_t)48 * N); r.v7 = *(const float4*)(p + (size_t)56 * N);
  return r;
}
DI void wstrip_process(const WS8& r, bf16_t* __restrict__ Wt, int N, int strip, float* sm) {
  const int tn4 = strip % (N / 256), tk = strip / (N / 256);
  const int tid = TID;
  __syncthreads();
  {
    float* d = sm + (tid >> 6) * 257 + (tid & 63) * 4;
#define WS_PUT(q_, v_) { float* e = d + (q_) * 8 * 257; e[0] = v_.x; e[1] = v_.y; e[2] = v_.z; e[3] = v_.w; }
    WS_PUT(0, r.v0) WS_PUT(1, r.v1) WS_PUT(2, r.v2) WS_PUT(3, r.v3) WS_PUT(4, r.v4) WS_PUT(5, r.v5) WS_PUT(6, r.v6) WS_PUT(7, r.v7)
#undef WS_PUT
  }
  __syncthreads();
#pragma unroll
  for (int q = 0; q < 4; ++q) {
    const int i = tid + q * NTHR;
    const int n = i >> 3, k8 = (i & 7) * 8;
    unsigned w[4];
#pragma unroll
    for (int j = 0; j < 4; ++j) w[j] = pk2bf(sm[(k8 + 2 * j) * 257 + n], sm[(k8 + 2 * j + 1) * 257 + n]);
    *(uint4*)(Wt + (size_t)(tn4 * 256 + n) * D + tk * 64 + k8) = make_uint4(w[0], w[1], w[2], w[3]);
  }
}
DI void wconv_tile(const float* __restrict__ W, bf16_t* __restrict__ Wt, int N, int tile, float* sm  ) {
  int tn = tile % (N / 64), tk = tile / (N / 64);
  int tid = TID;
  __syncthreads();
  for (int i = tid; i < 64 * 16; i += NTHR) {
    int kr = i >> 4, c4 = (i & 15) * 4;
    float4 v = *(const float4*)(W + (size_t)(tk * 64 + kr) * N + tn * 64 + c4);
    sm[kr * 65 + c4] = v.x; sm[kr * 65 + c4 + 1] = v.y; sm[kr * 65 + c4 + 2] = v.z; sm[kr * 65 + c4 + 3] = v.w;
  }
  __syncthreads();
  for (int i = tid; i < 64 * 8; i += NTHR) {
    int n = i >> 3, k8 = (i & 7) * 8;
    unsigned w[4];
    for (int j = 0; j < 4; ++j) w[j] = pk2bf(sm[(k8 + 2 * j) * 65 + n], sm[(k8 + 2 * j + 1) * 65 + n]);
    *(uint4*)(Wt + (size_t)(tn * 64 + n) * D + tk * 64 + k8) = make_uint4(w[0], w[1], w[2], w[3]);
  }
}

template <int EPI, int K = D>
DI void gemm_tile(const bf16_t* __restrict__ A, const bf16_t* __restrict__ Wt, int N, int m0, int n0, char* smem, bf16_t* __restrict__ Cb,
                  float* __restrict__ xs, const float* __restrict__ gate_base, const float* __restrict__ xin = nullptr, const float* __restrict__ ctxin = nullptr) {
  const int tid = TID, lane = tid & 63, wid = tid >> 6;
  const int wm = wid & 1, wn = wid >> 1;
  const int r = lane & 31, h = lane >> 5;
  f32x16 acc0, acc1;
  for (int i = 0; i < 16; ++i) { acc0[i] = 0.f; acc1[i] = 0.f; }
  const int lrow = tid >> 3, lch = tid & 7;
  const bf16_t* Ag = A + (size_t)(m0 + lrow) * K + lch * 8;
  const bf16_t* Bg = Wt + (size_t)(n0 + lrow) * K + lch * 8;
  const int woff = lrow * 128 + ((lch ^ ((lrow >> 1) & 7)) << 4);
  uint4 ra0, ra1, rb0, rb1;
  ra0 = *(const uint4*)(Ag); ra1 = *(const uint4*)(Ag + (size_t)64 * K);
  rb0 = *(const uint4*)(Bg); rb1 = *(const uint4*)(Bg + (size_t)64 * K);
  __syncthreads();
  *(uint4*)(smem + woff) = ra0; *(uint4*)(smem + woff + 8192) = ra1;
  *(uint4*)(smem + 16384 + woff) = rb0; *(uint4*)(smem + 16384 + woff + 8192) = rb1;
  __syncthreads();
  const int sw = (r >> 1) & 7;
  const int aoff0 = (wm * 64 + r) * 128, aoff1 = aoff0 + 32 * 128;
  const int boff = 16384 + (wn * 32 + r) * 128;
#pragma unroll 1
  for (int kt = 0; kt < K / 64; ++kt) {
    const char* st = smem + (kt & 1) * 32768;
    if (kt + 1 < K / 64) {
      ra0 = *(const uint4*)(Ag + (kt + 1) * 64); ra1 = *(const uint4*)(Ag + (size_t)64 * K + (kt + 1) * 64);
      rb0 = *(const uint4*)(Bg + (kt + 1) * 64); rb1 = *(const uint4*)(Bg + (size_t)64 * K + (kt + 1) * 64);
    }
#pragma unroll
    for (int s = 0; s < 4; ++s) {
      int co = ((2 * s + h) ^ sw) << 4;
      bf16x8 a0 = *(const bf16x8*)(st + aoff0 + co);
      bf16x8 a1 = *(const bf16x8*)(st + aoff1 + co);
      bf16x8 b = *(const bf16x8*)(st + boff + co);
      acc0 = MFMA32(a0, b, acc0);
      acc1 = MFMA32(a1, b, acc1);
    }
    if (kt + 1 < K / 64) {
      char* sn = smem + ((kt + 1) & 1) * 32768;
      *(uint4*)(sn + woff) = ra0; *(uint4*)(sn + woff + 8192) = ra1;
      *(uint4*)(sn + 16384 + woff) = rb0; *(uint4*)(sn + 16384 + woff + 8192) = rb1;
    }
    __syncthreads();
  }
  float* Cs = (float*)smem;
  constexpr int CS = 132;
#pragma unroll
  for (int i = 0; i < 16; ++i) {
    int row = (i & 3) + 8 * (i >> 2) + 4 * h;
    Cs[(wm * 64 + row) * CS + wn * 32 + r] = acc0[i];
    Cs[(wm * 64 + 32 + row) * CS + wn * 32 + r] = acc1[i];
  }
  __syncthreads();
  if (EPI == 0) {
    for (int i = tid; i < 128 * 16; i += NTHR) {
      int row = i >> 4, c8 = (i & 15) * 8;
      const float* cr = Cs + row * CS + c8;
      float4 v0 = *(const float4*)cr, v1 = *(const float4*)(cr + 4);
      *(uint4*)(Cb + (size_t)(m0 + row) * N + n0 + c8) = make_uint4(pk2bf(v0.x, v0.y), pk2bf(v0.z, v0.w), pk2bf(v1.x, v1.y), pk2bf(v1.z, v1.w));
    }
  } else if (EPI == 2) {
    for (int i = tid; i < 128 * 32; i += NTHR) {
      const int col = i >> 5, r4 = (i & 31) * 4;
      const float4 v = make_float4(Cs[r4 * CS + col], Cs[(r4 + 1) * CS + col], Cs[(r4 + 2) * CS + col], Cs[(r4 + 3) * CS + col]);
      *(float4*)(xs + (size_t)(n0 + col) * N + m0 + r4) = v;
    }
  } else {
    for (int i = tid; i < 128 * 32; i += NTHR) {
      int row = i >> 5, c4 = (i & 31) * 4;
      int rr = m0 + row; int b = rr / NT, p = rr % NT; int mrow = p < CTX ? 2 : b;
      const float* gt = gate_base + mrow * NMOD + n0 + c4;
      float4 v = *(const float4*)(Cs + row * CS + c4);
      const float* rsrc = xin ? (p < CTX ? ctxin + ((size_t)b * CTX + p) * D : xin + ((size_t)b * SEQ + (p - CTX)) * D) : xs + (size_t)rr * D;
      float4 xv = *(const float4*)(rsrc + n0 + c4);
      xv.x += gt[0] * v.x; xv.y += gt[1] * v.y; xv.z += gt[2] * v.z; xv.w += gt[3] * v.w;
      *(float4*)(xs + (size_t)rr * D + n0 + c4) = xv;
    }
  }
}


struct AttnArgs {
  const bf16_t *QA, *KA, *VAt, *QW, *KW, *VWt, *QG, *KG, *VGt;
  const float *g_qk_diff, *g_qk_win, *g_qk_glob, *sink, *lambda_diff, *g_mix_out;
  float lambda_init;
  int pad0;
  bf16_t* A2;
  float* Oslab;
  float* Lslab;
};

DI void store_head_bf16(char* wl, const float (&o)[32], float rs, const float* __restrict__ gm, bf16_t* __restrict__ dst_row0  ,
                        int lane) {
  const int r = lane & 31, h = lane >> 5;
#pragma unroll
  for (int dt = 0; dt < 2; ++dt)
#pragma unroll
    for (int q4 = 0; q4 < 4; ++q4) {
      const int dv = 32 * dt + 8 * q4 + 4 * h;
      const float* ov = o + 16 * dt + 4 * q4;
      *(uint2*)(wl + r * 136 + dv * 2) = make_uint2(pk2bf(ov[0] * rs * gm[dv], ov[1] * rs * gm[dv + 1]), pk2bf(ov[2] * rs * gm[dv + 2], ov[3] * rs * gm[dv + 3]));
    }
  asm volatile("s_waitcnt lgkmcnt(0)" ::: "memory");
#pragma unroll
  for (int ps = 0; ps < 4; ++ps) {
    const int row = ps * 8 + (lane >> 3), ch = lane & 7;
    const uint2 a = *(const uint2*)(wl + row * 136 + ch * 16), c = *(const uint2*)(wl + row * 136 + ch * 16 + 8);
    *(uint4*)(dst_row0 + (size_t)row * D + ch * 8) = make_uint4(a.x, a.y, c.x, c.y);
  }
  asm volatile("s_waitcnt lgkmcnt(0)" ::: "memory");
}
DI void store_head_f32(char* wl, const f32x16& Oa, const f32x16& Ob, float* __restrict__ dst_row0, int lane) {
  const int r = lane & 31, h = lane >> 5;
#pragma unroll
  for (int dt = 0; dt < 2; ++dt)
#pragma unroll
    for (int q4 = 0; q4 < 4; ++q4) {
      const f32x16& O = dt == 0 ? Oa : Ob;
      *(float4*)(wl + r * 272 + (32 * dt + 8 * q4 + 4 * h) * 4) = make_float4(O[4 * q4], O[4 * q4 + 1], O[4 * q4 + 2], O[4 * q4 + 3]);
    }
  asm volatile("s_waitcnt lgkmcnt(0)" ::: "memory");
#pragma unroll
  for (int ps = 0; ps < 8; ++ps) {
    const int row = ps * 4 + (lane >> 4), ch = lane & 15;
    *(float4*)(dst_row0 + (size_t)row * 64 + ch * 4) = *(const float4*)(wl + row * 272 + ch * 16);
  }
  asm volatile("s_waitcnt lgkmcnt(0)" ::: "memory");
}

template <int TYPE>
DI void attn_item(const AttnArgs& a, int b, int g, int p0, int ctx0, int nctx, int lat0, int nkt, int half, char* smem) {
  constexpr int DQK = TYPE == 0 ? 32 : 64;
  constexpr int KS = DQK / 16;
  const int tid = TID, lane = tid & 63, wid = tid >> 6;
  const int r = lane & 31, h = lane >> 5;
  const bf16_t *Q0, *Q1, *K0, *K1, *Vt;
  const float* gqk;
  if (TYPE == 0) {
    Q0 = a.QA + ((size_t)b * 8 + 2 * g) * NT * 32; Q1 = Q0 + (size_t)NT * 32;
    K0 = a.KA + ((size_t)b * 8 + 2 * g) * NT * 32; K1 = K0 + (size_t)NT * 32;
    Vt = a.VAt + ((size_t)b * 4 + g) * 64 * NT; gqk = a.g_qk_diff;
  } else if (TYPE == 1) {
    Q0 = a.QW + ((size_t)b * 4 + 2 * g) * NT * 64; Q1 = Q0 + (size_t)NT * 64;
    K0 = a.KW + ((size_t)b * 2 + g) * NT * 64; K1 = K0;
    Vt = a.VWt + ((size_t)b * 2 + g) * 64 * NT; gqk = a.g_qk_win;
  } else {
    Q0 = a.QG + ((size_t)b * 4 + 2 * g) * NT * 64; Q1 = Q0 + (size_t)NT * 64;
    K0 = a.KG + ((size_t)b * 2 + g) * NT * 64; K1 = K0;
    Vt = a.VGt + ((size_t)b * 2 + g) * 64 * NT; gqk = a.g_qk_glob;
  }
  (void)gqk;
  const int qpos = p0 + wid * 32 + r;
  bf16x8 qf0[KS], qf1[KS];
#pragma unroll
  for (int s = 0; s < KS; ++s) {
    qf0[s] = *(const bf16x8*)(Q0 + (size_t)qpos * DQK + 16 * s + 8 * h);
    qf1[s] = *(const bf16x8*)(Q1 + (size_t)qpos * DQK + 16 * s + 8 * h);
  }
  f32x16 O00, O01, O10, O11, Zero;
#pragma unroll
  for (int i = 0; i < 16; ++i) { O00[i] = 0.f; O01[i] = 0.f; O10[i] = 0.f; O11[i] = 0.f; Zero[i] = 0.f; }
  float l0 = 0.f, l1 = 0.f;

  auto tile_of = [&](int it) { return it < nctx ? ctx0 + it : lat0 + it - nctx; };
  const int wvu = __builtin_amdgcn_readfirstlane(tid >> 6);
#define ATT_GLDS(kt_, sb_)                                                                               \
  {                                                                                                      \
    const int kt__ = (kt_);                                                                              \
    LAS char* sl__ = (LAS char*)(sb_);                                                                   \
    if (TYPE == 0) {                                                                                     \
      const int row = tid >> 2, ch = (tid & 3) ^ ((row >> 2) & 3);                                       \
      __builtin_amdgcn_global_load_lds((const unsigned*)(K0 + (size_t)(kt__ * 128 + row) * 32 + ch * 8), (LAS unsigned*)(sl__ + wvu * 1024), 16, 0, 0);          \
      __builtin_amdgcn_global_load_lds((const unsigned*)(K1 + (size_t)(kt__ * 128 + row) * 32 + ch * 8), (LAS unsigned*)(sl__ + 8192 + wvu * 1024), 16, 0, 0);   \
    } else {                                                                                             \
      _Pragma("unroll") for (int i2 = 0; i2 < 2; ++i2) {                                                 \
        const int lc = tid + 512 * i2; const int row = lc >> 3, ch = (lc & 7) ^ ((row >> 1) & 7);        \
        __builtin_amdgcn_global_load_lds((const unsigned*)(K0 + (size_t)(kt__ * 128 + row) * 64 + ch * 8), (LAS unsigned*)(sl__ + i2 * 8192 + wvu * 1024), 16, 0, 0); \
      }                                                                                                  \
    }                                                                                                    \
    _Pragma("unroll") for (int i2 = 0; i2 < 2; ++i2) {                                                   \
      const int lc = tid + 512 * i2; const int row = lc >> 4, ch = (lc & 15) ^ (row & 15);               \
      __builtin_amdgcn_global_load_lds((const unsigned*)(Vt + (size_t)row * NT + kt__ * 128 + ch * 8), (LAS unsigned*)(sl__ + 16384 + i2 * 8192 + wvu * 1024), 16, 0, 0); \
    }                                                                                                    \
  }
  __syncthreads();
  ATT_GLDS(tile_of(0), smem);
  asm volatile("s_waitcnt vmcnt(0)" ::: "memory");
  __syncthreads();
  const int qwave = p0 + wid * 32;
  const int vbase = r * 256 + ((h ^ (r & 15)) << 4);
#pragma unroll 1
  for (int it = 0; it < nkt; ++it) {
    const int kt = tile_of(it);
    const char* sb = smem + (it & 1) * 32768;
    if (it + 1 < nkt) ATT_GLDS(tile_of(it + 1), smem + ((it + 1) & 1) * 32768);
#pragma unroll 2
    for (int j = 0; j < 4; ++j) {
      const int kbase = kt * 128 + 32 * j;
      bool masked = false;
      if (TYPE == 1) {
        if (kbase >= CTX && p0 >= CTX) {
          if (kbase > qwave + 31 + 128 || kbase + 31 < qwave - 128) continue;
          masked = true;
        }
      }
      f32x16 S0 = Zero, S1 = Zero;
#pragma unroll
      for (int s = 0; s < KS; ++s) {
        if (TYPE == 0) {
          int row = 32 * j + r;
          int off = row * 64 + (((2 * s + h) ^ ((row >> 2) & 3)) << 4);
          bf16x8 k0 = *(const bf16x8*)(sb + off);
          bf16x8 k1 = *(const bf16x8*)(sb + 8192 + off);
          S0 = MFMA32(k0, qf0[s], S0);
          S1 = MFMA32(k1, qf1[s], S1);
        } else {
          int row = 32 * j + r;
          int off = row * 128 + (((2 * s + h) ^ ((row >> 1) & 7)) << 4);
          bf16x8 k0 = *(const bf16x8*)(sb + off);
          S0 = MFMA32(k0, qf0[s], S0);
          S1 = MFMA32(k0, qf1[s], S1);
        }
      }
      float pa[16], pb[16];
#pragma unroll
      for (int i = 0; i < 16; ++i) {
        float e0 = __builtin_amdgcn_exp2f(S0[i]);
        float e1 = __builtin_amdgcn_exp2f(S1[i]);
        if (TYPE == 1) {
          if (masked) {
            int kp = kbase + (i & 3) + 8 * (i >> 2) + 4 * h;
            int dd = kp - qpos;
            bool ok = (dd <= 128) && (dd >= -128);
            e0 = ok ? e0 : 0.f; e1 = ok ? e1 : 0.f;
          }
        }
        pa[i] = e0; pb[i] = e1;
      }
      l0 += ((pa[0] + pa[1]) + (pa[2] + pa[3])) + ((pa[4] + pa[5]) + (pa[6] + pa[7])) + ((pa[8] + pa[9]) + (pa[10] + pa[11])) + ((pa[12] + pa[13]) + (pa[14] + pa[15]));
      l1 += ((pb[0] + pb[1]) + (pb[2] + pb[3])) + ((pb[4] + pb[5]) + (pb[6] + pb[7])) + ((pb[8] + pb[9]) + (pb[10] + pb[11])) + ((pb[12] + pb[13]) + (pb[14] + pb[15]));
      bf16x8 pf0[2], pf1[2];
#pragma unroll
      for (int s2 = 0; s2 < 2; ++s2) {
        unsigned w0[4], w1[4];
#pragma unroll
        for (int e = 0; e < 4; ++e) {
          w0[e] = pk2bf(pa[8 * s2 + 2 * e], pa[8 * s2 + 2 * e + 1]);
          w1[e] = pk2bf(pb[8 * s2 + 2 * e], pb[8 * s2 + 2 * e + 1]);
        }
        pf0[s2] = __builtin_bit_cast(bf16x8, make_uint4(w0[0], w0[1], w0[2], w0[3]));
        pf1[s2] = __builtin_bit_cast(bf16x8, make_uint4(w1[0], w1[1], w1[2], w1[3]));
      }
#pragma unroll
      for (int s2 = 0; s2 < 2; ++s2) {
        const int vo = vbase ^ ((4 * j + 2 * s2) << 4);
        bf16x8 v0 = *(const bf16x8*)(sb + 16384 + vo);
        bf16x8 v1 = *(const bf16x8*)(sb + 16384 + 8192 + vo);
        O00 = MFMA32(v0, pf0[s2], O00);
        O01 = MFMA32(v1, pf0[s2], O01);
        O10 = MFMA32(v0, pf1[s2], O10);
        O11 = MFMA32(v1, pf1[s2], O11);
      }
    }
    asm volatile("s_waitcnt vmcnt(0)" ::: "memory");
    __syncthreads();
  }
  l0 += shxl(l0, lane, 32);
  l1 += shxl(l1, lane, 32);
  if (TYPE == 1) {
    l0 += __builtin_amdgcn_exp2f(a.sink[2 * g] * LOG2E);
    l1 += __builtin_amdgcn_exp2f(a.sink[2 * g + 1] * LOG2E);
  }
  const size_t orow0 = (size_t)b * NT + p0 + wid * 32;
  char* wl = smem + wid * 8704;
  if (TYPE == 2) {
#pragma unroll
    for (int x = 0; x < 2; ++x) {
      int head = 2 * g + x;
      float* dst0 = a.Oslab + ((((size_t)half * NB + b) * 4 + head) * NT + (p0 + wid * 32)) * 64;
      if (x == 0) store_head_f32(wl, O00, O01, dst0, lane); else store_head_f32(wl, O10, O11, dst0, lane);
      if (h == 0) a.Lslab[(((size_t)half * NB + b) * 4 + head) * NT + qpos] = x == 0 ? l0 : l1;
    }
  } else if (TYPE == 0) {
    float s0 = 0.f, s1 = 0.f;
    for (int d = 0; d < 32; ++d) { s0 += a.lambda_diff[d] * a.lambda_diff[32 + d]; s1 += a.lambda_diff[64 + d] * a.lambda_diff[96 + d]; }
    const float lam = __expf(s0) - __expf(s1) + a.lambda_init;
    const float i0 = 1.f / l0, i1 = lam / l1;
    float o[32];
    float ss = 0.f;
#pragma unroll
    for (int i = 0; i < 16; ++i) {
      o[i] = O00[i] * i0 - O10[i] * i1;
      o[16 + i] = O01[i] * i0 - O11[i] * i1;
      ss += o[i] * o[i] + o[16 + i] * o[16 + i];
    }
    ss += shxl(ss, lane, 32);
    const float rs = rsqrtf(ss * (1.f / 64) + EPS) * (1.f - a.lambda_init);
    const float* gm = a.g_mix_out + g * 64;
    store_head_bf16(wl, o, rs, gm, a.A2 + orow0 * D + g * 64, lane);
  } else {
#pragma unroll
    for (int x = 0; x < 2; ++x) {
      const float inv = 1.f / (x == 0 ? l0 : l1);
      float o[32];
      float ss = 0.f;
#pragma unroll
      for (int i = 0; i < 16; ++i) {
        o[i] = (x == 0 ? O00[i] : O10[i]) * inv;
        o[16 + i] = (x == 0 ? O01[i] : O11[i]) * inv;
        ss += o[i] * o[i] + o[16 + i] * o[16 + i];
      }
      ss += shxl(ss, lane, 32);
      const float rs = rsqrtf(ss * (1.f / 64) + EPS);
      const int col0 = 256 + (2 * g + x) * 64;
      const float* gm = a.g_mix_out + col0;
      store_head_bf16(wl, o, rs, gm, a.A2 + orow0 * D + col0, lane);
    }
  }
}

DI void attn_dispatch(const AttnArgs& a, int idx, int want_ctx, char* smem) {
  if (idx < 256) {
    int b = idx >> 7, g = (idx >> 5) & 3, qt = 1 + (idx & 31);
    attn_item<0>(a, b, g, qt * 256, 0, 2, 2, 66, 0, smem);
  } else if (idx < 512) {
    int i = idx - 256; int half = i >> 7, b = (i >> 6) & 1, g = (i >> 5) & 1, qt = 1 + (i & 31);
    if (half == 0) attn_item<2>(a, b, g, qt * 256, 0, 2, 2, 33, 0, smem);
    else attn_item<2>(a, b, g, qt * 256, 0, 0, 33, 33, 1, smem);
  } else if (idx < 640) {
    int i = idx - 512; int b = i >> 6, g = (i >> 5) & 1, qt = 1 + (i & 31);
    int lo = max(2, 2 * qt - 1), hi = min(65, 2 * qt + 2);
    attn_item<1>(a, b, g, qt * 256, 0, 2, lo, 2 + (hi - lo + 1), 0, smem);
  } else if (want_ctx) {
    int i = idx - 640;
    if (i < 8) attn_item<0>(a, i >> 2, i & 3, 0, 0, 2, 0, 2, 0, smem);
    else if (i < 16) { int k = i - 8; int half = k >> 2, b = (k >> 1) & 1, g = k & 1; attn_item<2>(a, b, g, 0, half, 1, 0, 1, half, smem); }
    else if (i < 20) { int k = i - 16; attn_item<1>(a, k >> 1, k & 1, 0, 0, 2, 0, 2, 0, smem); }
  }
}

typedef __attribute__((ext_vector_type(4))) float f32x4v;
typedef __attribute__((ext_vector_type(2))) _Float16 h2_t;
DI unsigned pack_i8x4(float a, float b, float c, float d) {
  const int ia = (int)__builtin_rintf(a), ib = (int)__builtin_rintf(b), ic = (int)__builtin_rintf(c), id = (int)__builtin_rintf(d);
  return (unsigned)(ia & 255) | ((unsigned)(ib & 255) << 8) | ((unsigned)(ic & 255) << 16) | ((unsigned)id << 24);
}
constexpr size_t TSLICE = (size_t)16384 * 128;
DI void tabconv_fin_i8(float4 v0, float4 v1, float4 v2, float4 v3, unsigned char* __restrict__ dst, float* __restrict__ scale, size_t row, int lane) {
  float m = fmaxf(fmaxf(fmaxf(fabsf(v0.x), fabsf(v0.y)), fmaxf(fabsf(v0.z), fabsf(v0.w))), fmaxf(fmaxf(fabsf(v1.x), fabsf(v1.y)), fmaxf(fabsf(v1.z), fabsf(v1.w))));
  m = fmaxf(m, fmaxf(fmaxf(fmaxf(fabsf(v2.x), fabsf(v2.y)), fmaxf(fabsf(v2.z), fabsf(v2.w))), fmaxf(fmaxf(fabsf(v3.x), fabsf(v3.y)), fmaxf(fabsf(v3.z), fabsf(v3.w)))));
  for (int o = 32; o > 0; o >>= 1) m = fmaxf(m, shxl(m, lane, o));
  m = fmaxf(m, 1e-30f);
  const float sc = m * (1.f / 127.f), inv = 127.f / m;
  *(uint4*)(dst + (size_t)(lane >> 3) * TSLICE + row * 128 + (lane & 7) * 16) = make_uint4(pack_i8x4(v0.x * inv, v0.y * inv, v0.z * inv, v0.w * inv), pack_i8x4(v1.x * inv, v1.y * inv, v1.z * inv, v1.w * inv),
                                                    pack_i8x4(v2.x * inv, v2.y * inv, v2.z * inv, v2.w * inv), pack_i8x4(v3.x * inv, v3.y * inv, v3.z * inv, v3.w * inv));
  if (lane == 0) scale[row] = sc;
}
DI void tabconv_fin(float4 v0, float4 v1, float4 v2, float4 v3, unsigned char* __restrict__ dst, float* __restrict__ scale, size_t row, int lane) {
  float m = fmaxf(fmaxf(fmaxf(fabsf(v0.x), fabsf(v0.y)), fmaxf(fabsf(v0.z), fabsf(v0.w))), fmaxf(fmaxf(fabsf(v1.x), fabsf(v1.y)), fmaxf(fabsf(v1.z), fabsf(v1.w))));
  m = fmaxf(m, fmaxf(fmaxf(fmaxf(fabsf(v2.x), fabsf(v2.y)), fmaxf(fabsf(v2.z), fabsf(v2.w))), fmaxf(fmaxf(fabsf(v3.x), fabsf(v3.y)), fmaxf(fabsf(v3.z), fabsf(v3.w)))));
  for (int o = 32; o > 0; o >>= 1) m = fmaxf(m, shxl(m, lane, o));
  m = fmaxf(m, 1e-30f);
  const float sc = m * (1.f / 448.f), inv = 448.f / m;
  int w0 = __builtin_amdgcn_cvt_pk_fp8_f32(v0.x * inv, v0.y * inv, 0, false); w0 = __builtin_amdgcn_cvt_pk_fp8_f32(v0.z * inv, v0.w * inv, w0, true);
  int w1 = __builtin_amdgcn_cvt_pk_fp8_f32(v1.x * inv, v1.y * inv, 0, false); w1 = __builtin_amdgcn_cvt_pk_fp8_f32(v1.z * inv, v1.w * inv, w1, true);
  int w2 = __builtin_amdgcn_cvt_pk_fp8_f32(v2.x * inv, v2.y * inv, 0, false); w2 = __builtin_amdgcn_cvt_pk_fp8_f32(v2.z * inv, v2.w * inv, w2, true);
  int w3 = __builtin_amdgcn_cvt_pk_fp8_f32(v3.x * inv, v3.y * inv, 0, false); w3 = __builtin_amdgcn_cvt_pk_fp8_f32(v3.z * inv, v3.w * inv, w3, true);
  *(uint4*)(dst + (size_t)(lane >> 3) * TSLICE + row * 128 + (lane & 7) * 16) = make_uint4((unsigned)w0, (unsigned)w1, (unsigned)w2, (unsigned)w3);
  if (lane == 0) scale[row] = sc;
}
struct SSLd { uint4 a0, a1, b0, b1, a2, a3, b2, b3; };
DI SSLd score_sort_fetch(const bf16_t* __restrict__ qbuf, const bf16_t* __restrict__ keysb, int m0, int hp) {
  const int tid = TID;
  const int lrow = tid >> 3, lch = tid & 7;
  const bf16_t* Ag = qbuf + (size_t)(m0 + lrow) * 2048 + hp * 128 + lch * 8;
  const bf16_t* Bg = keysb + ((size_t)hp * 128 + lrow) * 128 + lch * 8;
  SSLd d;
  d.a0 = *(const uint4*)(Ag); d.a1 = *(const uint4*)(Ag + (size_t)64 * 2048); d.b0 = *(const uint4*)(Bg); d.b1 = *(const uint4*)(Bg + 64 * 128);
  d.a2 = *(const uint4*)(Ag + 64); d.a3 = *(const uint4*)(Ag + (size_t)64 * 2048 + 64); d.b2 = *(const uint4*)(Bg + 64); d.b3 = *(const uint4*)(Bg + 64 * 128 + 64);
  return d;
}
DI void score_sort(const SSLd& ld, char* smem, unsigned (&v16)[16]) {
  const int tid = TID, lane = tid & 63, wid = tid >> 6;
  const int wm = wid & 1, wn = wid >> 1;
  const int r = lane & 31, h = lane >> 5;
  f32x16 acc0, acc1;
  for (int i = 0; i < 16; ++i) { acc0[i] = 0.f; acc1[i] = 0.f; }
  const int lrow = tid >> 3, lch = tid & 7;
  const int woff = lrow * 128 + ((lch ^ ((lrow >> 1) & 7)) << 4);
  __syncthreads();
  *(uint4*)(smem + woff) = ld.a0; *(uint4*)(smem + woff + 8192) = ld.a1; *(uint4*)(smem + 16384 + woff) = ld.b0; *(uint4*)(smem + 16384 + woff + 8192) = ld.b1;
  *(uint4*)(smem + 32768 + woff) = ld.a2; *(uint4*)(smem + 32768 + woff + 8192) = ld.a3; *(uint4*)(smem + 32768 + 16384 + woff) = ld.b2; *(uint4*)(smem + 32768 + 16384 + woff + 8192) = ld.b3;
  __syncthreads();
  const int sw = (r >> 1) & 7;
  const int aoff0 = (wm * 64 + r) * 128, aoff1 = aoff0 + 32 * 128;
  const int boff = 16384 + (wn * 32 + r) * 128;
#pragma unroll
  for (int kt = 0; kt < 2; ++kt) {
    const char* st = smem + kt * 32768;
#pragma unroll
    for (int s = 0; s < 4; ++s) {
      int co = ((2 * s + h) ^ sw) << 4;
      bf16x8 a0 = *(const bf16x8*)(st + aoff0 + co);
      bf16x8 a1 = *(const bf16x8*)(st + aoff1 + co);
      bf16x8 b = *(const bf16x8*)(st + boff + co);
      acc0 = MFMA32(a0, b, acc0);
      acc1 = MFMA32(a1, b, acc1);
    }
  }
  __syncthreads();
  float* Cs = (float*)smem;
  constexpr int CS = 132;
#pragma unroll
  for (int i = 0; i < 16; ++i) {
    int row = (i & 3) + 8 * (i >> 2) + 4 * h;
    Cs[(wm * 64 + row) * CS + wn * 32 + r] = acc0[i];
    Cs[(wm * 64 + 32 + row) * CS + wn * 32 + r] = acc1[i];
  }
  __syncthreads();
  const int row = tid >> 2, q = tid & 3;
  unsigned v[32];
#pragma unroll
  for (int i = 0; i < 32; ++i) {
    unsigned u = __float_as_uint(Cs[row * CS + 4 * i + q]);
    u ^= (u & 0x80000000u) ? 0xffffffffu : 0x80000000u;
    v[i] = (u & ~127u) | (unsigned)(127 - (4 * i + q));
  }
#pragma unroll
  for (int k = 2; k <= 32; k <<= 1)
#pragma unroll
    for (int j = k >> 1; j > 0; j >>= 1)
#pragma unroll
      for (int i = 0; i < 32; ++i) {
        const int l = i ^ j;
        if (l > i) {
          const unsigned lo = min(v[i], v[l]), hi = max(v[i], v[l]);
          if ((i & k) == 0) { v[i] = hi; v[l] = lo; } else { v[i] = lo; v[l] = hi; }
        }
      }
#pragma unroll
  for (int step = 0; step < 2; ++step) {
    unsigned c[16];
#pragma unroll
    for (int i = 0; i < 16; ++i) {
      const unsigned o = step == 0 ? (unsigned)__builtin_amdgcn_mov_dpp((int)v[15 - i], 0xB1, 0xf, 0xf, false)
                                   : (unsigned)__builtin_amdgcn_mov_dpp((int)v[15 - i], 0x4E, 0xf, 0xf, false);
      c[i] = max(v[i], o);
    }
#pragma unroll
    for (int j = 8; j > 0; j >>= 1)
#pragma unroll
      for (int i = 0; i < 16; ++i) {
        const int l = i ^ j;
        if (l > i) { const unsigned lo = min(c[i], c[l]), hi = max(c[i], c[l]); c[i] = hi; c[l] = lo; }
      }
#pragma unroll
    for (int i = 0; i < 16; ++i) v[i] = c[i];
  }
#pragma unroll
  for (int i = 0; i < 16; ++i) v16[i] = v[i];
}
constexpr int CAND_I[52] = {0, 0, 0, 0, 0, 0, 0, 0, 0, 0, 0, 0, 0, 0, 0, 0, 1, 1, 1, 1, 1, 1, 1, 1, 2, 2, 2, 2, 2, 3, 3, 3, 3, 4, 4, 4, 5, 5, 6, 6, 7, 7, 8, 9, 10, 11, 12, 13, 14, 15, 0, 0};
constexpr int CAND_J[52] = {0, 1, 2, 3, 4, 5, 6, 7, 8, 9, 10, 11, 12, 13, 14, 15, 0, 1, 2, 3, 4, 5, 6, 7, 0, 1, 2, 3, 4, 0, 1, 2, 3, 0, 1, 2, 0, 1, 0, 1, 0, 1, 0, 0, 0, 0, 0, 0, 0, 0, 0, 0};
DI float sel4(int q, float a, float b, float c, float d) { return q == 0 ? a : q == 1 ? b : q == 2 ? c : d; }
DI unsigned sel4u(int q, unsigned a, unsigned b, unsigned c, unsigned d) { return q == 0 ? a : q == 1 ? b : q == 2 ? c : d; }
DI float key7f(unsigned k) { k &= ~127u; k ^= (k & 0x80000000u) ? 0x80000000u : 0xffffffffu; return __uint_as_float(k); }
DI float key8f(unsigned k) { k &= ~255u; k ^= (k & 0x80000000u) ? 0x80000000u : 0xffffffffu; return __uint_as_float(k); }
DI void score_head_item(const bf16_t* __restrict__ qbuf, const bf16_t* __restrict__ keysb, int m0, int hd, char* smem, int* __restrict__ experts,
                        float* __restrict__ gates, SSLd& carry, bool has_next, int m0n, int hdn) {
  unsigned ka[16], kb[16];
  {
    const SSLd ldb = score_sort_fetch(qbuf, keysb, m0, 2 * hd + 1);
    score_sort(carry, smem, ka);
    if (has_next) carry = score_sort_fetch(qbuf, keysb, m0n, 2 * hdn);
    score_sort(ldb, smem, kb);
  }
  const int tid = TID, row = tid >> 2, q = tid & 3;
  unsigned char* ix = (unsigned char*)(smem + 69632) + row * 32;
  *(unsigned*)(ix + 4 * q) = (sel4u(q, ka[0], ka[4], ka[8], ka[12]) & 127u) | ((sel4u(q, ka[1], ka[5], ka[9], ka[13]) & 127u) << 8) |
                             ((sel4u(q, ka[2], ka[6], ka[10], ka[14]) & 127u) << 16) | ((sel4u(q, ka[3], ka[7], ka[11], ka[15]) & 127u) << 24);
  *(unsigned*)(ix + 16 + 4 * q) = (sel4u(q, kb[0], kb[4], kb[8], kb[12]) & 127u) | ((sel4u(q, kb[1], kb[5], kb[9], kb[13]) & 127u) << 8) |
                                  ((sel4u(q, kb[2], kb[6], kb[10], kb[14]) & 127u) << 16) | ((sel4u(q, kb[3], kb[7], kb[11], kb[15]) & 127u) << 24);
  float a[16], b[16];
#pragma unroll
  for (int i = 0; i < 16; ++i) { a[i] = key7f(ka[i]); b[i] = key7f(kb[i]); }
  unsigned c[16];
#pragma unroll
  for (int t = 0; t < 16; ++t) {
    if (4 * t >= 52) { c[t] = 0u; continue; }
    const float sv = sel4(q, a[CAND_I[4 * t]], a[CAND_I[4 * t + 1]], a[CAND_I[4 * t + 2]], a[CAND_I[4 * t + 3]]) +
                     sel4(q, b[CAND_J[4 * t]], b[CAND_J[4 * t + 1]], b[CAND_J[4 * t + 2]], b[CAND_J[4 * t + 3]]);
    const unsigned code = sel4u(q, CAND_I[4 * t] * 16 + CAND_J[4 * t], CAND_I[4 * t + 1] * 16 + CAND_J[4 * t + 1], CAND_I[4 * t + 2] * 16 + CAND_J[4 * t + 2],
                                CAND_I[4 * t + 3] * 16 + CAND_J[4 * t + 3]);
    unsigned u = __float_as_uint(sv);
    u ^= (u & 0x80000000u) ? 0xffffffffu : 0x80000000u;
    const bool valid = (4 * t + q) < 50;
    c[t] = valid ? ((u & ~255u) | code) : 0u;
  }
#pragma unroll
  for (int k = 2; k <= 16; k <<= 1)
#pragma unroll
    for (int j = k >> 1; j > 0; j >>= 1)
#pragma unroll
      for (int i = 0; i < 16; ++i) {
        const int l = i ^ j;
        if (l > i) {
          const unsigned lo = min(c[i], c[l]), hi = max(c[i], c[l]);
          if ((i & k) == 0) { c[i] = hi; c[l] = lo; } else { c[i] = lo; c[l] = hi; }
        }
      }
#pragma unroll
  for (int step = 0; step < 2; ++step) {
    unsigned d[16];
#pragma unroll
    for (int i = 0; i < 16; ++i) {
      const unsigned o = step == 0 ? (unsigned)__builtin_amdgcn_mov_dpp((int)c[15 - i], 0xB1, 0xf, 0xf, false)
                                   : (unsigned)__builtin_amdgcn_mov_dpp((int)c[15 - i], 0x4E, 0xf, 0xf, false);
      d[i] = max(c[i], o);
    }
#pragma unroll
    for (int j = 8; j > 0; j >>= 1)
#pragma unroll
      for (int i = 0; i < 16; ++i) {
        const int l = i ^ j;
        if (l > i) { const unsigned lo = min(d[i], d[l]), hi = max(d[i], d[l]); d[i] = hi; d[l] = lo; }
      }
#pragma unroll
    for (int i = 0; i < 16; ++i) c[i] = d[i];
  }
  const float mx = key8f(c[0]);
  float e[16]; float sum = 0.f;
#pragma unroll
  for (int i = 0; i < 16; ++i) { e[i] = __expf(key8f(c[i]) - mx); sum += e[i]; }
  const float inv = 1.f / sum;
  asm volatile("s_waitcnt lgkmcnt(0)" ::: "memory");
  int eo[4]; float go[4];
#pragma unroll
  for (int k = 0; k < 4; ++k) {
    const unsigned code = sel4u(q, c[k], c[4 + k], c[8 + k], c[12 + k]) & 255u;
    go[k] = sel4(q, e[k], e[4 + k], e[8 + k], e[12 + k]) * inv;
    eo[k] = (127 - (int)ix[code >> 4]) * 128 + (127 - (int)ix[16 + (code & 15)]);
  }
  const size_t o = (size_t)(m0 + row) * 128 + hd * 16 + 4 * q;
  *(uint2*)((unsigned short*)experts + o) = make_uint2((unsigned)eo[0] | ((unsigned)eo[1] << 16), (unsigned)eo[2] | ((unsigned)eo[3] << 16));
  *(float4*)(gates + o) = make_float4(go[0], go[1], go[2], go[3]);
}

DI float key2f(unsigned k) { k &= ~127u; k ^= (k & 0x80000000u) ? 0x80000000u : 0xffffffffu; return __uint_as_float(k); }
DI void merge_one(const unsigned* __restrict__ topk, int r, int hd, int* experts, float* gates) {
  const unsigned* ka = topk + ((size_t)r * 16 + 2 * hd) * 16;
  const unsigned* kb = ka + 16;
  float a[16], bq[16];
#pragma unroll
  for (int i = 0; i < 4; ++i) {
    uint4 x = ((const uint4*)ka)[i], y = ((const uint4*)kb)[i];
    a[4 * i] = key2f(x.x); a[4 * i + 1] = key2f(x.y); a[4 * i + 2] = key2f(x.z); a[4 * i + 3] = key2f(x.w);
    bq[4 * i] = key2f(y.x); bq[4 * i + 1] = key2f(y.y); bq[4 * i + 2] = key2f(y.z); bq[4 * i + 3] = key2f(y.w);
  }
  float cv[50];
  {
    int n = 0;
#pragma unroll
    for (int i = 0; i < 16; ++i)
#pragma unroll
      for (int j = 0; j < 16; ++j)
        if ((i + 1) * (j + 1) <= 16) { cv[n] = a[i] + bq[j]; ++n; }
  }
  int* eo = experts + hd * 16;
  float* go = gates + hd * 16;
  float mx = 0.f, sum = 0.f;
#pragma unroll 1
  for (int k = 0; k < 16; ++k) {
    float mval = cv[0]; int code = 0;
    {
      int n = 0;
#pragma unroll
      for (int i = 0; i < 16; ++i)
#pragma unroll
        for (int j = 0; j < 16; ++j)
          if ((i + 1) * (j + 1) <= 16) {
            if (n > 0) { bool gt = cv[n] > mval; mval = gt ? cv[n] : mval; code = gt ? (i * 16 + j) : code; }
            ++n;
          }
    }
    {
      int n = 0;
#pragma unroll
      for (int i = 0; i < 16; ++i)
#pragma unroll
        for (int j = 0; j < 16; ++j)
          if ((i + 1) * (j + 1) <= 16) { cv[n] = (code == i * 16 + j) ? -3.0e38f : cv[n]; ++n; }
    }
    if (k == 0) mx = mval;
    const float e = __expf(mval - mx);
    sum += e;
    eo[k] = (int)(127u - (ka[code >> 4] & 127u)) * 128 + (int)(127u - (kb[code & 15] & 127u));
    go[k] = e;
  }
  const float inv = 1.f / sum;
#pragma unroll
  for (int i = 0; i < 4; ++i) {
    float4 g4 = ((float4*)go)[i];
    g4.x *= inv; g4.y *= inv; g4.z *= inv; g4.w *= inv;
    ((float4*)go)[i] = g4;
  }
}

template <int MODE>
DI void peer_token(int r, const bf16_t* __restrict__ hbuf, const int* ex_row, const float* g_row,
                   const unsigned char* __restrict__ u8, const float* __restrict__ us, const unsigned char* __restrict__ v8,
                   const float* __restrict__ vs, const float* __restrict__ modv_l, float* __restrict__ xs, float* wdots  ,
                   float* __restrict__ outp, int* __restrict__ ex_out, float* __restrict__ w_out) {
  const int lane = TID & 63;
  float x[16];
  {
    const uint2* hr = (const uint2*)(hbuf + (size_t)r * D + lane * 4);
#pragma unroll
    for (int c = 0; c < 4; ++c) { const uint2 a = hr[64 * c]; x[4 * c] = bflo(a.x); x[4 * c + 1] = bfhi(a.x); x[4 * c + 2] = bflo(a.y); x[4 * c + 3] = bfhi(a.y); }
  }
  const int e0 = ex_row[lane], e1 = ex_row[64 + lane];
  const float g0 = g_row[lane], g1 = g_row[64 + lane];
  const float us0 = us[e0], us1 = us[e1], vs0 = vs[e0], vs1 = vs[e1];
#define PEER_LOAD8(rw_, tab_, k0_)                                                          \
  {                                                                                         \
    _Pragma("unroll") for (int j = 0; j < 8; ++j) {                                         \
      int e = __builtin_amdgcn_readlane((k0_) < 64 ? e0 : e1, ((k0_) + j) & 63);            \
      rw_[j] = *(const uint4*)((tab_) + (size_t)e * D + lane * 16);                         \
    }                                                                                       \
  }
#define PEER_UDOT8(rw_, k0_)                                                                \
  {                                                                                         \
    float p[8];                                                                             \
    _Pragma("unroll") for (int j = 0; j < 8; ++j) {                                         \
      f32x2_t a0 = __builtin_amdgcn_cvt_pk_f32_fp8((int)rw_[j].x, false), a1 = __builtin_amdgcn_cvt_pk_f32_fp8((int)rw_[j].x, true); \
      f32x2_t b0 = __builtin_amdgcn_cvt_pk_f32_fp8((int)rw_[j].y, false), b1 = __builtin_amdgcn_cvt_pk_f32_fp8((int)rw_[j].y, true); \
      f32x2_t c0 = __builtin_amdgcn_cvt_pk_f32_fp8((int)rw_[j].z, false), c1 = __builtin_amdgcn_cvt_pk_f32_fp8((int)rw_[j].z, true); \
      f32x2_t d0 = __builtin_amdgcn_cvt_pk_f32_fp8((int)rw_[j].w, false), d1 = __builtin_amdgcn_cvt_pk_f32_fp8((int)rw_[j].w, true); \
      float s = a0[0] * x[0] + a0[1] * x[1] + a1[0] * x[2] + a1[1] * x[3];                  \
      s += b0[0] * x[4] + b0[1] * x[5] + b1[0] * x[6] + b1[1] * x[7];                       \
      s += c0[0] * x[8] + c0[1] * x[9] + c1[0] * x[10] + c1[1] * x[11];                     \
      s += d0[0] * x[12] + d0[1] * x[13] + d1[0] * x[14] + d1[1] * x[15];                   \
      p[j] = s;                                                                             \
    }                                                                                       \
    float q4[4];                                                                            \
    _Pragma("unroll") for (int i = 0; i < 4; ++i) { float send = hi32 ? p[i] : p[4 + i]; float keep = hi32 ? p[4 + i] : p[i]; q4[i] = keep + shxl(send, lane, 32); } \
    float q2[2];                                                                            \
    _Pragma("unroll") for (int i = 0; i < 2; ++i) { float send = hi16 ? q4[i] : q4[2 + i]; float keep = hi16 ? q4[2 + i] : q4[i]; q2[i] = keep + shxl(send, lane, 16); } \
    float q1;                                                                               \
    { float send = hi8 ? q2[0] : q2[1]; float keep = hi8 ? q2[1] : q2[0]; q1 = keep + shxl(send, lane, 8); } \
    q1 += shxl(q1, lane, 4); q1 += shxl(q1, lane, 2); q1 += shxl(q1, lane, 1);              \
    if ((lane & 7) == 0) wdots[(k0_) + (lane >> 3)] = q1;                                   \
  }
#define PEER_VACC8(rw_, k0_)                                                                \
  {                                                                                         \
    _Pragma("unroll") for (int j = 0; j < 8; ++j) {                                         \
      float w = __builtin_bit_cast(float, __builtin_amdgcn_readlane(__builtin_bit_cast(int, (k0_) < 64 ? w0 : w1), ((k0_) + j) & 63)); \
      f32x2_t a0 = __builtin_amdgcn_cvt_pk_f32_fp8((int)rw_[j].x, false), a1 = __builtin_amdgcn_cvt_pk_f32_fp8((int)rw_[j].x, true); \
      f32x2_t b0 = __builtin_amdgcn_cvt_pk_f32_fp8((int)rw_[j].y, false), b1 = __builtin_amdgcn_cvt_pk_f32_fp8((int)rw_[j].y, true); \
      f32x2_t c0 = __builtin_amdgcn_cvt_pk_f32_fp8((int)rw_[j].z, false), c1 = __builtin_amdgcn_cvt_pk_f32_fp8((int)rw_[j].z, true); \
      f32x2_t d0 = __builtin_amdgcn_cvt_pk_f32_fp8((int)rw_[j].w, false), d1 = __builtin_amdgcn_cvt_pk_f32_fp8((int)rw_[j].w, true); \
      acc[0] += w * a0[0]; acc[1] += w * a0[1]; acc[2] += w * a1[0]; acc[3] += w * a1[1];   \
      acc[4] += w * b0[0]; acc[5] += w * b0[1]; acc[6] += w * b1[0]; acc[7] += w * b1[1];   \
      acc[8] += w * c0[0]; acc[9] += w * c0[1]; acc[10] += w * c1[0]; acc[11] += w * c1[1]; \
      acc[12] += w * d0[0]; acc[13] += w * d0[1]; acc[14] += w * d1[0]; acc[15] += w * d1[1]; \
    }                                                                                       \
  }
  const bool hi32 = lane & 32, hi16 = lane & 16, hi8 = lane & 8;
  uint4 rwA[8], rwB[8];
  PEER_LOAD8(rwA, u8, 0);
#pragma unroll 1
  for (int k0 = 0; k0 < 128; k0 += 16) {
    PEER_LOAD8(rwB, u8, k0 + 8);
    PEER_UDOT8(rwA, k0);
    if (k0 + 16 < 128) { PEER_LOAD8(rwA, u8, k0 + 16); } else if (MODE == 0) { PEER_LOAD8(rwA, v8, 0); }
    PEER_UDOT8(rwB, k0 + 8);
  }
  float w0, w1;
  {
    float d0 = wdots[lane] * us0, d1 = wdots[64 + lane] * us1;
    float t0 = 0.5f * d0 * (1.f + tanhf(0.7978845608028654f * (d0 + 0.044715f * d0 * d0 * d0)));
    float t1 = 0.5f * d1 * (1.f + tanhf(0.7978845608028654f * (d1 + 0.044715f * d1 * d1 * d1)));
    w0 = g0 * t0 * vs0; w1 = g1 * t1 * vs1;
  }
  if (MODE == 1) {
    ex_out[(size_t)r * 128 + lane] = e0; ex_out[(size_t)r * 128 + 64 + lane] = e1;
    w_out[(size_t)r * 128 + lane] = w0; w_out[(size_t)r * 128 + 64 + lane] = w1;
    return;
  }
  float acc[16];
#pragma unroll
  for (int i = 0; i < 16; ++i) acc[i] = 0.f;
#pragma unroll 1
  for (int k0 = 0; k0 < 128; k0 += 16) {
    PEER_LOAD8(rwB, v8, k0 + 8);
    PEER_VACC8(rwA, k0);
    if (k0 + 16 < 128) PEER_LOAD8(rwA, v8, k0 + 16);
    PEER_VACC8(rwB, k0 + 8);
  }
  const int b = r / NT, p = r % NT; const int mrow = p < CTX ? 2 : b;
  const float* g2 = modv_l + mrow * NMOD + 5 * D + lane * 4;
  float4* xp = (float4*)(xs + (size_t)r * D + lane * 4);
  float4* op = outp ? (float4*)(outp + ((size_t)b * SEQ + (p - CTX)) * D + lane * 4) : xp;
#pragma unroll
  for (int i = 0; i < 4; ++i) {
    float4 xv = xp[64 * i]; float4 gg = ((const float4*)g2)[64 * i];
    xv.x += gg.x * acc[4 * i]; xv.y += gg.y * acc[4 * i + 1]; xv.z += gg.z * acc[4 * i + 2]; xv.w += gg.w * acc[4 * i + 3];
    op[64 * i] = xv;
  }
}

constexpr int FN = 2 * SEQ;
DI float2 cmul(float2 a, float2 b) { return make_float2(a.x * b.x - a.y * b.y, a.x * b.y + a.y * b.x); }
DI float2 cmulc(float2 a, float2 b) { return make_float2(a.x * b.x + a.y * b.y, a.y * b.x - a.x * b.y); }
DI int PX(int i) { return i + ((i >> 6) << 2); }
constexpr int FNP = FN + (FN >> 6) * 4;
DI int freq_of_pos(int pos) { return ((pos >> 10) & 15) | (((pos >> 6) & 15) << 4) | (((pos >> 2) & 15) << 8) | ((pos & 3) << 12); }
DI int pos_of_freq(int f) { return ((f & 15) << 10) | (((f >> 4) & 15) << 6) | (((f >> 8) & 15) << 2) | (f >> 12); }
DI float2 cadd(float2 a, float2 b) { return make_float2(a.x + b.x, a.y + b.y); }
DI float2 csub(float2 a, float2 b) { return make_float2(a.x - b.x, a.y - b.y); }
DI float2 cmni(float2 a) { return make_float2(a.y, -a.x); }
DI float2 cconj(float2 a) { return make_float2(a.x, -a.y); }
struct TabJob {
  const float* pu; const float* pv;
  unsigned char* du; unsigned char* dv;
  float* su; float* sv;
  int slot, wv, nw;
  int prow;
  float4 v[4];
};
DI void tab_step(TabJob& j, int lane) {
  if (j.prow >= 0) {
    if (j.prow >> 14) tabconv_fin(j.v[0], j.v[1], j.v[2], j.v[3], j.dv, j.sv, (size_t)(j.prow & 16383), lane);
    else tabconv_fin_i8(j.v[0], j.v[1], j.v[2], j.v[3], j.du, j.su, (size_t)(j.prow & 16383), lane);
    j.prow = -1;
  }
  const int row = j.slot * j.nw + j.wv;
  if (j.pu != nullptr && row < 32768) {
    const float4* sp = (const float4*)(((row >> 14) ? j.pv : j.pu) + (size_t)(row & 16383) * D);
    j.v[0] = sp[lane]; j.v[1] = sp[64 + lane]; j.v[2] = sp[128 + lane]; j.v[3] = sp[192 + lane];
    j.prow = row;
  }
  j.slot++;
}
DI void tab_flush(TabJob& j, int lane) {
  if (j.prow >= 0) {
    if (j.prow >> 14) tabconv_fin(j.v[0], j.v[1], j.v[2], j.v[3], j.dv, j.sv, (size_t)(j.prow & 16383), lane);
    else tabconv_fin_i8(j.v[0], j.v[1], j.v[2], j.v[3], j.du, j.su, (size_t)(j.prow & 16383), lane);
    j.prow = -1;
  }
}
DI void dft16(float2 (&x)[16]) {
  constexpr float C1 = 0.9238795325112867f, S1 = 0.3826834323650898f, C2 = 0.7071067811865476f;
  float2 u[16];
#pragma unroll
  for (int r = 0; r < 4; ++r) {
    const float2 a = x[r], b = x[r + 4], c = x[r + 8], d = x[r + 12];
    const float2 t0 = cadd(a, c), t1 = csub(a, c), t2 = cadd(b, d), t3 = cmni(csub(b, d));
    const float2 y0 = cadd(t0, t2), y1 = cadd(t1, t3), y2 = csub(t0, t2), y3 = csub(t1, t3);
    u[4 * r] = y0;
    if (r == 0) { u[1] = y1; u[2] = y2; u[3] = y3; }
    else if (r == 1) { u[5] = cmul(y1, make_float2(C1, -S1)); u[6] = cmul(y2, make_float2(C2, -C2)); u[7] = cmul(y3, make_float2(S1, -C1)); }
    else if (r == 2) { u[9] = cmul(y1, make_float2(C2, -C2)); u[10] = cmni(y2); u[11] = cmul(y3, make_float2(-C2, -C2)); }
    else { u[13] = cmul(y1, make_float2(S1, -C1)); u[14] = cmul(y2, make_float2(-C2, -C2)); u[15] = cmul(y3, make_float2(-C1, S1)); }
  }
#pragma unroll
  for (int sdx = 0; sdx < 4; ++sdx) {
    const float2 a = u[sdx], b = u[4 + sdx], c = u[8 + sdx], d = u[12 + sdx];
    const float2 t0 = cadd(a, c), t1 = csub(a, c), t2 = cadd(b, d), t3 = cmni(csub(b, d));
    x[4 * sdx] = cadd(t0, t2); x[4 * sdx + 1] = cadd(t1, t3); x[4 * sdx + 2] = csub(t0, t2); x[4 * sdx + 3] = csub(t1, t3);
  }
}
template <int LQ, bool INV>
DI void fft_pass16(float2* X, int tid, TabJob& job) {
  constexpr int q = 1 << LQ;
  constexpr float invL = 1.f / (float)(16 << LQ);
  tab_step(job, tid & 63);
#pragma unroll 1
  for (int bf = 0; bf < 2; ++bf) {
    const int i = tid + 512 * bf;
    const int j = i & (q - 1); const int base = ((i >> LQ) << (LQ + 4)) + j;
    const float fr = (float)j * invL;
    const float2 w1 = make_float2(__builtin_amdgcn_cosf(fr), -__builtin_amdgcn_sinf(fr));
    float2 x[16];
    if (!INV) {
#pragma unroll
      for (int mm = 0; mm < 16; ++mm) x[mm] = X[PX(base + mm * q)];
      dft16(x);
      float2 w = w1;
      X[PX(base)] = x[0];
#pragma unroll
      for (int k = 1; k < 16; ++k) {
        const int p = 4 * (k & 3) + (k >> 2);
        X[PX(base + k * q)] = cmul(x[p], w);
        w = cmul(w, w1);
      }
    } else {
      float2 w = w1;
      x[0] = cconj(X[PX(base)]);
#pragma unroll
      for (int k = 1; k < 16; ++k) {
        x[k] = cmul(cconj(X[PX(base + k * q)]), w);
        w = cmul(w, w1);
      }
      dft16(x);
#pragma unroll
      for (int p = 0; p < 16; ++p) {
        const int mm = (p >> 2) + 4 * (p & 3);
        X[PX(base + mm * q)] = cconj(x[p]);
      }
    }
  }
}
template <bool INV>
DI void fft_pass4(float2* X, int tid, TabJob& job) {
  tab_step(job, tid & 63);
#pragma unroll 2
  for (int bf = 0; bf < 8; ++bf) {
    const int base = PX(4 * (tid + 512 * bf));
    float2 a = X[base], b = X[base + 1], c = X[base + 2], d = X[base + 3];
    if (INV) { a = cconj(a); b = cconj(b); c = cconj(c); d = cconj(d); }
    const float2 t0 = cadd(a, c), t1 = csub(a, c), t2 = cadd(b, d), t3 = cmni(csub(b, d));
    float2 y0 = cadd(t0, t2), y1 = cadd(t1, t3), y2 = csub(t0, t2), y3 = csub(t1, t3);
    if (INV) { y0 = cconj(y0); y1 = cconj(y1); y2 = cconj(y2); y3 = cconj(y3); }
    X[base] = y0; X[base + 1] = y1; X[base + 2] = y2; X[base + 3] = y3;
  }
}
DI unsigned pkc(float2 v) { return pk2bf(v.x, v.y); }
DI float2 upkc(unsigned w) { return make_float2(bflo(w), bfhi(w)); }
template <int SEL>
DI void fft_pass4_mul(float2* X, int tid, const uint2* __restrict__ H01, TabJob& job) {
  tab_step(job, tid & 63);
#pragma unroll 2
  for (int bf = 0; bf < 8; ++bf) {
    const int q4 = tid + 512 * bf;
    const int base = PX(4 * q4);
    const uint4 h01 = *(const uint4*)(H01 + 4 * q4), h23 = *(const uint4*)(H01 + 4 * q4 + 2);
    float2 a = X[base], b = X[base + 1], c = X[base + 2], d = X[base + 3];
    float2 t0 = cadd(a, c), t1 = csub(a, c), t2 = cadd(b, d), t3 = cmni(csub(b, d));
    a = cmul(cadd(t0, t2), upkc(SEL ? h01.y : h01.x)); b = cmul(cadd(t1, t3), upkc(SEL ? h01.w : h01.z));
    c = cmul(csub(t0, t2), upkc(SEL ? h23.y : h23.x)); d = cmul(csub(t1, t3), upkc(SEL ? h23.w : h23.z));
    a = cconj(a); b = cconj(b); c = cconj(c); d = cconj(d);
    t0 = cadd(a, c); t1 = csub(a, c); t2 = cadd(b, d); t3 = cmni(csub(b, d));
    X[base] = cconj(cadd(t0, t2)); X[base + 1] = cconj(cadd(t1, t3)); X[base + 2] = cconj(csub(t0, t2)); X[base + 3] = cconj(csub(t1, t3));
  }
}
DI void fft_fwd(float2* X, TabJob& job) {
  const int tid = TID;
  __syncthreads(); fft_pass16<10, false>(X, tid, job);
  __syncthreads(); fft_pass16<6, false>(X, tid, job);
  __syncthreads(); fft_pass16<2, false>(X, tid, job);
  __syncthreads(); fft_pass4<false>(X, tid, job);
  __syncthreads();
}
DI void fft_inv(float2* X, TabJob& job) {
  const int tid = TID;
  __syncthreads(); fft_pass4<true>(X, tid, job);
  __syncthreads(); fft_pass16<2, true>(X, tid, job);
  __syncthreads(); fft_pass16<6, true>(X, tid, job);
  __syncthreads(); fft_pass16<10, true>(X, tid, job);
  __syncthreads();
}
template <int SEL>
DI void fft_conv(float2* X, const uint2* __restrict__ H01, TabJob& job) {
  const int tid = TID;
  __syncthreads(); fft_pass16<10, false>(X, tid, job);
  __syncthreads(); fft_pass16<6, false>(X, tid, job);
  __syncthreads(); fft_pass16<2, false>(X, tid, job);
  __syncthreads(); fft_pass4_mul<SEL>(X, tid, H01, job);
  __syncthreads(); fft_pass16<2, true>(X, tid, job);
  __syncthreads(); fft_pass16<6, true>(X, tid, job);
  __syncthreads(); fft_pass16<10, true>(X, tid, job);
  __syncthreads();
}
DI float block_sum_512(float v, float* red) {
  for (int o = 32; o > 0; o >>= 1) v += shx(v, o);
  __syncthreads();
  if ((TID & 63) == 0) red[TID >> 6] = v;
  __syncthreads();
  float s = 0.f;
  for (int i = 0; i < 8; ++i) s += red[i];
  return s;
}
DI void hyena_filter_task(int c, const bf16_t* __restrict__ hdnB, const bf16_t* __restrict__ W3t, const float* __restrict__ b3, uint2* __restrict__ H01_all,
                          char* smem, TabJob& job) {
  float2* X = (float2*)smem;
  float* red = (float*)(smem + FNP * 8);
  uint2* H01 = H01_all + (size_t)c * FN;
  const int tid = TID;
  __syncthreads();
  const float delta = fabsf(-3.0701134573253944f + (float)c * ((-15.350567286626972f + 3.0701134573253944f) / 255.f));
  const float bb00 = b3[c], bb01 = b3[256 + c], bb10 = b3[512 + c], bb11 = b3[768 + c];
  float n0 = 0.f, n1 = 0.f;
  {
    const int lane = tid & 63, wid = tid >> 6, r = lane & 31, h = lane >> 5;
    bf16x8 wa[4];
#pragma unroll
    for (int s4 = 0; s4 < 4; ++s4) {
      uint4 w = make_uint4(0u, 0u, 0u, 0u);
      if (r < 4) w = *(const uint4*)(W3t + ((size_t)((r >> 1) * 512 + (r & 1) * 256 + c)) * 64 + 16 * s4 + 8 * h);
      wa[s4] = __builtin_bit_cast(bf16x8, w);
    }
#pragma unroll 8
    for (int blk = wid; blk < SEQ / 32; blk += 8) {
      const int j = blk * 32 + r;
      const bf16_t* hp = hdnB + (size_t)blk * 2048 + (h * 32 + r) * 8;
      f32x16 acc;
#pragma unroll
      for (int i = 0; i < 16; ++i) acc[i] = 0.f;
#pragma unroll
      for (int s4 = 0; s4 < 4; ++s4) acc = MFMA32(wa[s4], *(const bf16x8*)(hp + 512 * s4), acc);
      if (h == 0) {
        const float dec = __expf(-((float)j / (float)(SEQ - 1)) * delta);
        const float f00 = (acc[0] + bb00) * dec, f01 = (acc[1] + bb01) * dec, f10 = (acc[2] + bb10) * dec, f11 = (acc[3] + bb11) * dec;
        X[PX(j)] = make_float2(f00, f10);
        n0 += fabsf(f00); n1 += fabsf(f10);
        if (j > 0) { X[PX(FN - j)] = make_float2(f01, f11); n0 += fabsf(f01); n1 += fabsf(f11); }
        else X[PX(SEQ)] = make_float2(0.f, 0.f);
      }
    }
  }
  n0 = block_sum_512(n0, red);
  n1 = block_sum_512(n1, red);
  const float s0 = 0.5f / (n0 * (float)FN), s1 = 0.5f / (n1 * (float)FN);
  fft_fwd(X, job);
  for (int pos = 2 * tid; pos < FN; pos += 1024) {
    unsigned w[4];
#pragma unroll
    for (int e = 0; e < 2; ++e) {
      const int f = freq_of_pos(pos + e); const int pm = pos_of_freq((FN - f) & (FN - 1));
      const float2 A = X[PX(pos + e)], Bm = X[PX(pm)];
      const float2 K0 = make_float2((A.x + Bm.x) * s0, (A.y - Bm.y) * s0);
      const float2 K1 = make_float2((A.y + Bm.y) * s1, -(A.x - Bm.x) * s1);
      w[2 * e] = pkc(K0); w[2 * e + 1] = pkc(K1);
    }
    *(uint4*)(H01 + pos) = make_uint4(w[0], w[1], w[2], w[3]);
  }
}
DI void hyena_channel(int c, const float* __restrict__ hy_bias, const float* __restrict__ uT, float* __restrict__ zT, float* __restrict__ yT,
                      const uint2* __restrict__ H01_all, char* smem, TabJob& job) {
  float2* X = (float2*)smem;
  const uint2* H01 = H01_all + (size_t)c * FN;
  const int tid = TID;
  const float* v0p = uT + ((size_t)0 * 768 + c) * NT + CTX;
  const float* v1p = uT + ((size_t)1 * 768 + c) * NT + CTX;
  __syncthreads();
  for (int t4 = tid * 4; t4 < SEQ; t4 += 2048) {
    const float4 a = *(const float4*)(v0p + t4), b = *(const float4*)(v1p + t4);
    const int px = PX(t4), pz = PX(SEQ + t4);
    X[px] = make_float2(a.x, b.x); X[px + 1] = make_float2(a.y, b.y); X[px + 2] = make_float2(a.z, b.z); X[px + 3] = make_float2(a.w, b.w);
    X[pz] = make_float2(0.f, 0.f); X[pz + 1] = make_float2(0.f, 0.f); X[pz + 2] = make_float2(0.f, 0.f); X[pz + 3] = make_float2(0.f, 0.f);
  }
  fft_conv<0>(X, H01, job);
  {
    const float bias0 = hy_bias[c];
    const float* x10 = v0p + (size_t)256 * NT; const float* x11 = v1p + (size_t)256 * NT;
    float* z0 = zT + ((size_t)0 * 256 + c) * NT + CTX; float* z1 = zT + ((size_t)1 * 256 + c) * NT + CTX;
    for (int t4 = tid * 4; t4 < SEQ; t4 += 2048) {
      const int px = PX(t4);
      const float4 xa = *(const float4*)(x10 + t4), xb = *(const float4*)(x11 + t4), va = *(const float4*)(v0p + t4), vb = *(const float4*)(v1p + t4);
      const float2 q0 = X[px], q1 = X[px + 1], q2 = X[px + 2], q3 = X[px + 3];
      const float4 za = make_float4(xa.x * (q0.x + bias0 * va.x), xa.y * (q1.x + bias0 * va.y), xa.z * (q2.x + bias0 * va.z), xa.w * (q3.x + bias0 * va.w));
      const float4 zb = make_float4(xb.x * (q0.y + bias0 * vb.x), xb.y * (q1.y + bias0 * vb.y), xb.z * (q2.y + bias0 * vb.z), xb.w * (q3.y + bias0 * vb.w));
      *(float4*)(z0 + t4) = za; *(float4*)(z1 + t4) = zb;
      X[px] = make_float2(za.x, zb.x); X[px + 1] = make_float2(za.y, zb.y); X[px + 2] = make_float2(za.z, zb.z); X[px + 3] = make_float2(za.w, zb.w);
    }
    __syncthreads();
    for (int t4 = tid * 4; t4 < SEQ; t4 += 2048) {
      const int pz = PX(SEQ + t4);
      X[pz] = make_float2(0.f, 0.f); X[pz + 1] = make_float2(0.f, 0.f); X[pz + 2] = make_float2(0.f, 0.f); X[pz + 3] = make_float2(0.f, 0.f);
    }
  }
  fft_conv<1>(X, H01, job);
  {
    const float bias1 = hy_bias[256 + c];
    const float* x20 = v0p + (size_t)512 * NT; const float* x21 = v1p + (size_t)512 * NT;
    const float* z0 = zT + ((size_t)0 * 256 + c) * NT + CTX; const float* z1 = zT + ((size_t)1 * 256 + c) * NT + CTX;
    float* y0 = yT + ((size_t)0 * 256 + c) * NT + CTX; float* y1 = yT + ((size_t)1 * 256 + c) * NT + CTX;
    for (int t4 = tid * 4; t4 < SEQ; t4 += 2048) {
      const int px = PX(t4);
      const float4 xa = *(const float4*)(x20 + t4), xb = *(const float4*)(x21 + t4), za = *(const float4*)(z0 + t4), zb = *(const float4*)(z1 + t4);
      const float2 q0 = X[px], q1 = X[px + 1], q2 = X[px + 2], q3 = X[px + 3];
      *(float4*)(y0 + t4) = make_float4(xa.x * (q0.x + bias1 * za.x), xa.y * (q1.x + bias1 * za.y), xa.z * (q2.x + bias1 * za.z), xa.w * (q3.x + bias1 * za.w));
      *(float4*)(y1 + t4) = make_float4(xb.x * (q0.y + bias1 * zb.x), xb.y * (q1.y + bias1 * zb.y), xb.z * (q2.y + bias1 * zb.z), xb.w * (q3.y + bias1 * zb.w));
    }
  }
}

namespace pg8 {
#define PG8_LAS __attribute__((address_space(3)))
typedef ::bf16x8 bf16x8;
typedef float f32x4 __attribute__((ext_vector_type(4)));
typedef unsigned u32x4 __attribute__((ext_vector_type(4)));
constexpr int BM = 256, BK = 64, HALF = 128, HTB = HALF * BK * 2  , STAGE_BYTES = 8 * HTB, NXCD = 8, WGM = 8;

__host__ __device__ __forceinline__ int lds_byte(int r, int c) { const int st = (r >> 4) * 2 + (c >> 5), rr = r & 15, cc = c & 31, ob = rr * 64 + cc * 2; return st * 1024 + (ob ^ (((ob >> 9) & 1) << 5)); }
__host__ __device__ __forceinline__ void stage_rc(int b, int& R, int& C) { const int st = b / 1024, sb = b % 1024, swz = sb ^ (((sb >> 9) & 1) << 5); R = (st >> 1) * 16 + swz / 64; C = (st & 1) * 32 + (swz % 64) / 2; }
__host__ __device__ __forceinline__ int perm32(int rho) { const int n = rho >> 4, i = rho & 15; return 8 * (i >> 2) + 4 * n + (i & 3); }
struct Unit { int pm, pn; };
struct Gemm { const bf16_t* A; const bf16_t* Bt; int M, N, K; };
template <class Epi, class Sched, bool STAMP = false>
__device__ __forceinline__ void gemm_phase(PG8_LAS unsigned char* lds, const Gemm g, const Sched& S, const Epi& E, unsigned long long* stamps) {
    const int tid = TID, wid = __builtin_amdgcn_readfirstlane(tid >> 6), lane = tid & 63, wr = wid >> 2, wc = wid & 3, fr = lane & 15, fq = lane >> 4;
    const int K = g.K, nt = K / BK;
    int ts_lo = 0, ts_hi = 0, nts = 0; const unsigned long long rt_entry = STAMP ? (unsigned long long)wall_clock64() : 0ull;
#define PG8_STAMP() do { if (STAMP && wid == 0 && nts < 64) { const unsigned long long _c = (unsigned long long)clock64(); \
        ts_lo = (lane == nts) ? (int)(unsigned)_c : ts_lo; ts_hi = (lane == nts) ? (int)(unsigned)(_c >> 32) : ts_hi; ++nts; } } while (0)
    PG8_STAMP();
    unsigned voffA[2], voffB[2];
#pragma unroll
    for (int i = 0; i < 2; ++i) { int R, C; stage_rc(tid * 16 + i * 8192, R, C); const int Rb = Epi::PERM ? ((R & ~31) + perm32(R & 31)) : R;
        voffA[i] = (unsigned)(R * K + C) * 2u; voffB[i] = (unsigned)(Rb * K + C) * 2u; }
    const size_t kstep = (size_t)(BK * 2);
    const size_t hstep = (size_t)HALF * K * 2;
    const size_t tstep = 2 * hstep;
    const unsigned ldsw = (unsigned)wid * 1024u;
    const int aoff = lds_byte(wr * 64 + fr, fq * 8), boff = lds_byte(wc * 32 + fr, fq * 8);
#define PG8_SA(b, h) (((b) * 2 + (h)) * HTB)
#define PG8_SB(b, h) ((4 + (b) * 2 + (h)) * HTB)
#define PG8_STAGE(bufoff, gbase, voff) do { _Pragma("unroll") for (int _i = 0; _i < 2; ++_i) \
        __builtin_amdgcn_global_load_lds((const unsigned*)((const char*)(gbase) + (voff)[_i]), (PG8_LAS unsigned*)(lds + (bufoff) + ldsw + _i * 8192), 16, 0, 0); } while (0)
#define PG8_LDA(dst, b, h) do { _Pragma("unroll") for (int m = 0; m < 4; ++m) _Pragma("unroll") for (int k = 0; k < 2; ++k) dst[m][k] = *(const PG8_LAS bf16x8*)(lds + PG8_SA(b, h) + aoff + m * 2048 + k * 1024); } while (0)
#define PG8_LDB(dst, b, h) do { _Pragma("unroll") for (int n = 0; n < 2; ++n) _Pragma("unroll") for (int k = 0; k < 2; ++k) dst[n][k] = *(const PG8_LAS bf16x8*)(lds + PG8_SB(b, h) + boff + n * 2048 + k * 1024); } while (0)
#define PG8_MMA(ai, bj, At, Bt) do { __builtin_amdgcn_s_setprio(1); _Pragma("unroll") for (int m = 0; m < 4; ++m) _Pragma("unroll") for (int n = 0; n < 2; ++n) _Pragma("unroll") for (int k = 0; k < 2; ++k) \
        acc[ai][bj][m][n] = __builtin_amdgcn_mfma_f32_16x16x32_bf16(Bt[n][k], At[m][k], acc[ai][bj][m][n], 0, 0, 0); __builtin_amdgcn_s_setprio(0); } while (0)
#define PG8_WAIT_V(n) asm volatile("s_waitcnt vmcnt(" #n ")" ::: "memory")
#define PG8_WAIT_L(n) asm volatile("s_waitcnt lgkmcnt(" #n ")" ::: "memory")
#define PG8_BAR __builtin_amdgcn_s_barrier()
#define PG8_SCHED __builtin_amdgcn_sched_barrier(0)
    Unit cur, nxt; int ui = 0;
    if (!S.next(0, cur)) return;
    f32x4 acc[2][2][4][2];
#pragma unroll
    for (int a = 0; a < 2; ++a)
#pragma unroll
        for (int b = 0; b < 2; ++b)
#pragma unroll
            for (int m = 0; m < 4; ++m)
#pragma unroll
                for (int n = 0; n < 2; ++n) acc[a][b][m][n] = (f32x4){0.f, 0.f, 0.f, 0.f};
    bf16x8 At[4][2], B0[2][2], B1[2][2];
    const char* cA = (const char*)g.A + (size_t)cur.pm * tstep; const char* cB = (const char*)g.Bt + (size_t)cur.pn * tstep;
    S.a_ready(cur);
    PG8_STAGE(PG8_SB(0, 0), cB, voffB); PG8_STAGE(PG8_SA(0, 0), cA, voffA); PG8_STAGE(PG8_SB(0, 1), cB + hstep, voffB); PG8_STAGE(PG8_SA(0, 1), cA + hstep, voffA);
    if (wr == 1) PG8_BAR;
    PG8_WAIT_V(4); PG8_BAR;
    PG8_STAGE(PG8_SB(1, 0), cB + kstep, voffB); PG8_STAGE(PG8_SA(1, 0), cA + kstep, voffA); PG8_STAGE(PG8_SB(1, 1), cB + hstep + kstep, voffB);
    PG8_WAIT_V(6); PG8_BAR;
    PG8_STAMP();
    for (;;) {
        const bool has_next = S.next(ui + 1, nxt);
        const char* nA = has_next ? (const char*)g.A + (size_t)nxt.pm * tstep : cA; const char* nB = has_next ? (const char*)g.Bt + (size_t)nxt.pn * tstep : cB;
        for (int t = 0; t < nt; t += 2) {
            const bool last = (t == nt - 2);
            const char* a1 = cA + (size_t)(t + 1) * kstep;
            const char* a2 = last ? nA : cA + (size_t)(t + 2) * kstep; const char* b2 = last ? nB : cB + (size_t)(t + 2) * kstep;
            const char* a3 = a2 + kstep; const char* b3 = b2 + kstep;
            if (last && has_next) S.a_ready(nxt);
            PG8_LDB(B0, 0, 0); PG8_SCHED; PG8_LDA(At, 0, 0); PG8_STAGE(PG8_SA(1, 1), a1 + hstep, voffA);
            PG8_WAIT_L(8); PG8_BAR; PG8_WAIT_L(0); PG8_MMA(0, 0, At, B0); PG8_BAR; PG8_SCHED;
            PG8_LDB(B1, 0, 1); PG8_STAGE(PG8_SB(0, 0), b2, voffB);
            PG8_BAR; PG8_WAIT_L(0); PG8_MMA(0, 1, At, B1); PG8_BAR;
            PG8_LDA(At, 0, 1); PG8_STAGE(PG8_SA(0, 0), a2, voffA);
            PG8_BAR; PG8_WAIT_L(0); PG8_MMA(1, 0, At, B0); PG8_BAR; PG8_SCHED;
            PG8_STAGE(PG8_SB(0, 1), b2 + hstep, voffB);
            PG8_WAIT_V(6); PG8_BAR; PG8_MMA(1, 1, At, B1); PG8_BAR;
            PG8_LDB(B0, 1, 0); PG8_SCHED; PG8_LDA(At, 1, 0); PG8_STAGE(PG8_SA(0, 1), a2 + hstep, voffA);
            PG8_WAIT_L(8); PG8_BAR; PG8_WAIT_L(0); PG8_MMA(0, 0, At, B0); PG8_BAR; PG8_SCHED;
            PG8_LDB(B1, 1, 1); PG8_STAGE(PG8_SB(1, 0), b3, voffB);
            PG8_BAR; PG8_WAIT_L(0); PG8_MMA(0, 1, At, B1); PG8_BAR;
            PG8_LDA(At, 1, 1); PG8_STAGE(PG8_SA(1, 0), a3, voffA);
            PG8_BAR; PG8_WAIT_L(0); PG8_MMA(1, 0, At, B0); PG8_BAR; PG8_SCHED;
            PG8_STAGE(PG8_SB(1, 1), b3 + hstep, voffB);
            PG8_WAIT_V(6); PG8_BAR; PG8_MMA(1, 1, At, B1); PG8_BAR;
        }
        PG8_STAMP();
        if constexpr (!Epi::AFTER_DRAIN) { E(acc, cur, wr, wc, fr, fq); S.done(cur); }
        PG8_STAMP();
        if (!has_next) break;
#pragma unroll
        for (int a = 0; a < 2; ++a)
#pragma unroll
            for (int b = 0; b < 2; ++b)
#pragma unroll
                for (int m = 0; m < 4; ++m)
#pragma unroll
                    for (int n = 0; n < 2; ++n) acc[a][b][m][n] = (f32x4){0.f, 0.f, 0.f, 0.f};
        cur = nxt; cA = nA; cB = nB; ++ui;
    }
    PG8_WAIT_V(0);
    if (wr == 0) PG8_BAR;
    PG8_BAR;
    if constexpr (Epi::AFTER_DRAIN) { E.fused(acc, cur, wr, wc, fr, fq, lds, wid, lane); S.done(cur); }
    PG8_STAMP();
    if (STAMP && wid == 0) { stamps[lane] = lane < nts ? (((unsigned long long)(unsigned)ts_hi << 32) | (unsigned)ts_lo) : 0ull;
        if (lane == 62) stamps[62] = rt_entry; if (lane == 63) stamps[63] = (unsigned long long)wall_clock64(); }
#undef PG8_STAMP
#undef PG8_SA
#undef PG8_SB
#undef PG8_STAGE
#undef PG8_LDA
#undef PG8_LDB
#undef PG8_MMA
#undef PG8_WAIT_V
#undef PG8_WAIT_L
#undef PG8_BAR
#undef PG8_SCHED
}
}

#ifndef GEMM_WGM
#define GEMM_WGM 4
#endif
struct MySched {
  int nN, nunits, G, c; bool latent_only;
  DI void init(int N, bool lat_only, int G_, int c_) { nN = N / 256; latent_only = lat_only; nunits = (lat_only ? 64 : 66) * nN; G = G_; c = c_; }
  DI bool next(int i, pg8::Unit& u) const {
    const int L = i * G + c; if (L >= nunits) return false;
    const int nM = latent_only ? 64 : 66;
    int wgid = L;
    { const int q = nunits / 8, r = nunits % 8, xcd = wgid % 8, off = wgid / 8; wgid = (xcd < r ? xcd * (q + 1) : r * (q + 1) + (xcd - r) * q) + off; }
    const int nig = GEMM_WGM * nN, gid = wgid / nig, fm = gid * GEMM_WGM, gsz = (nM - fm) < GEMM_WGM ? (nM - fm) : GEMM_WGM;
    const int ri = fm + ((wgid % nig) % gsz);
    u.pn = (wgid % nig) / gsz;
    u.pm = latent_only ? (ri / 32) * 33 + 1 + (ri % 32) : ri;
    return true;
  }
  DI void a_ready(const pg8::Unit&) const {}
  DI void done(const pg8::Unit&) const {}
};
struct EpiStoreBf16 {
  static constexpr bool PERM = true, AFTER_DRAIN = false;
  bf16_t* Cb; int ldc;
  DI void operator()(const pg8::f32x4 (&acc)[2][2][4][2], const pg8::Unit& u, int wr, int wc, int fr, int fq) const {
    const int row0 = u.pm * 256 + wr * 64 + fr, col0 = u.pn * 256 + wc * 32 + 8 * fq;
#pragma unroll
    for (int ai = 0; ai < 2; ++ai)
#pragma unroll
      for (int m = 0; m < 4; ++m) {
        bf16_t* rowp = Cb + (size_t)(row0 + ai * 128 + m * 16) * ldc + col0;
#pragma unroll
        for (int bj = 0; bj < 2; ++bj) {
          const pg8::f32x4 v0 = acc[ai][bj][m][0], v1 = acc[ai][bj][m][1];
          *(uint4*)(rowp + bj * 128) = make_uint4(pk2bf(v0[0], v0[1]), pk2bf(v0[2], v0[3]), pk2bf(v1[0], v1[1]), pk2bf(v1[2], v1[3]));
        }
      }
  }
};
struct EpiResidual {
  static constexpr bool PERM = true, AFTER_DRAIN = false;
  float* xs; const float* gate_base; const float* xin; const float* ctxin;
  DI void operator()(const pg8::f32x4 (&acc)[2][2][4][2], const pg8::Unit& u, int wr, int wc, int fr, int fq) const {
    const int row0 = u.pm * 256 + wr * 64 + fr, col0 = u.pn * 256 + wc * 32 + 8 * fq;
    const int b = u.pm / 33; const int mrow = (u.pm % 33) == 0 ? 2 : b;
    const int pt = (u.pm % 33) * 256 + wr * 64 + fr;
    const float* gt = gate_base + mrow * NMOD + col0;
#pragma unroll
    for (int ai = 0; ai < 2; ++ai)
#pragma unroll
      for (int m = 0; m < 4; ++m) {
        float* rowp = xs + (size_t)(row0 + ai * 128 + m * 16) * D + col0;
        const int pp = pt + ai * 128 + m * 16;
        const float* srcp = xin ? (pp < CTX ? ctxin + ((size_t)b * CTX + pp) * D + col0 : xin + ((size_t)b * SEQ + (pp - CTX)) * D + col0) : rowp;
#pragma unroll
        for (int bj = 0; bj < 2; ++bj)
#pragma unroll
          for (int n = 0; n < 2; ++n) {
            const pg8::f32x4 v = acc[ai][bj][m][n];
            const float4 g4 = *(const float4*)(gt + bj * 128 + n * 4);
            float4 xv = *(const float4*)(srcp + bj * 128 + n * 4);
            xv.x += g4.x * v[0]; xv.y += g4.y * v[1]; xv.z += g4.z * v[2]; xv.w += g4.w * v[3];
            *(float4*)(rowp + bj * 128 + n * 4) = xv;
          }
      }
  }
};

#define XB_TMO      128
#define XB_XCNT(j)  (256  + 64 * (j))
#define XB_XSUB(j)  (1280 + 64 * (j))
#define XB_XGEN(j)  (2304 + 64 * (j))
#define XB_TOP      3328
#define XB_TOPGEN   3392
#define XB_SPIN_CAP (1u << 22)
DI unsigned xb_ld(unsigned* p) { return __hip_atomic_load(p, __ATOMIC_RELAXED, __HIP_MEMORY_SCOPE_AGENT); }
DI unsigned xb_add(unsigned* p, unsigned v) { return __hip_atomic_fetch_add(p, v, __ATOMIC_RELAXED, __HIP_MEMORY_SCOPE_AGENT); }
DI unsigned xb_xcc_id() { return (unsigned)__builtin_amdgcn_s_getreg((3 << 11) | 20) & 0xFu; }
#define XB_SPIN(cond, bar) do { unsigned _sp = 0; while (cond) { __builtin_amdgcn_s_sleep(1); \
    if ((++_sp & 255u) == 0u) { if (xb_ld(&(bar)[XB_TMO])) break; if (_sp > XB_SPIN_CAP) { atomicAdd(&(bar)[XB_TMO], 1u); break; } } } } while (0)
DI void xcd_barrier_post(unsigned* bar, volatile LAS unsigned* st) {
  if (threadIdx.x == 0) { const unsigned x = xb_xcc_id(); st[3] = x; st[2] = xb_add(&bar[XB_XCNT(x)], 1u); }
}
DI void xcd_barrier_complete(unsigned* bar, unsigned x, unsigned& nloc, unsigned& nx) {
  const unsigned G = gridDim.x;
  unsigned sum, cnt, mine, sp = 0u;
  for (;;) {
    sum = 0u; cnt = 0u; mine = 0u;
#pragma unroll
    for (unsigned j = 0; j < 16; ++j) { const unsigned c = xb_ld(&bar[XB_XCNT(j)]); sum += c; cnt += (c > 0u) ? 1u : 0u; mine = (j == x) ? c : mine; }
    if (sum == G) break;
    __builtin_amdgcn_s_sleep(1);
    if ((++sp & 255u) == 0u) { if (xb_ld(&bar[XB_TMO])) break; if (sp > XB_SPIN_CAP) { atomicAdd(&bar[XB_TMO], 1u); break; } }
  }
  nloc = mine > 0u ? mine : 1u; nx = cnt > 0u ? cnt : 1u;
}
DI void xcd_barrier(unsigned* bar, volatile LAS unsigned* st) {
  asm volatile("s_waitcnt vmcnt(0)" ::: "memory");
  __syncthreads();
  if (threadIdx.x == 0) {
    const unsigned x = xb_xcc_id();
    __builtin_amdgcn_s_waitcnt(0);
    unsigned nloc = st[0], nx = st[1];
    if (nloc == 0u) { xcd_barrier_complete(bar, x, nloc, nx); st[0] = nloc; st[1] = nx; }
    const unsigned old = xb_add(&bar[XB_XSUB(x)], 1u);
    const unsigned gen = old / nloc;
    if (old + 1u == (gen + 1u) * nloc) {
      __builtin_amdgcn_fence(__ATOMIC_RELEASE, "agent");
      asm volatile("s_waitcnt vmcnt(0)" ::: "memory");
      const unsigned og = xb_add(&bar[XB_TOP], 1u);
      const unsigned tg = og / nx;
      if (og + 1u == (tg + 1u) * nx) xb_add(&bar[XB_TOPGEN], 1u);
      else XB_SPIN(xb_ld(&bar[XB_TOPGEN]) == tg, bar);
      __builtin_amdgcn_fence(__ATOMIC_ACQUIRE, "agent");
      xb_add(&bar[XB_XGEN(x)], 1u);
      asm volatile("s_waitcnt vmcnt(0)" ::: "memory");
    } else {
      XB_SPIN(xb_ld(&bar[XB_XGEN(x)]) == gen, bar);
      __builtin_amdgcn_fence(__ATOMIC_ACQUIRE, "agent");
      asm volatile("s_waitcnt vmcnt(0)" ::: "memory");
    }
  }
  __syncthreads();
}

#define XCD_BAR_WORDS 3456
constexpr size_t al256(size_t x) { return (x + 255) & ~(size_t)255; }
constexpr size_t OFF_modv = 0;
constexpr size_t OFF_xs = al256(OFF_modv + (size_t)2 * 3 * NMOD * 4);
constexpr size_t OFF_hbuf = al256(OFF_xs + (size_t)R * D * 4);
constexpr size_t OFF_P = al256(OFF_hbuf + (size_t)R * D * 2);
constexpr size_t OFF_Wt_in = al256(OFF_P + (size_t)R * DIN * 2);
constexpr size_t OFF_Wt_out = al256(OFF_Wt_in + (size_t)2 * DIN * D * 2);
constexpr size_t OFF_Wt_q = al256(OFF_Wt_out + (size_t)2 * D * D * 2);
constexpr size_t OFF_QA = al256(OFF_Wt_q + (size_t)2 * 2048 * D * 2);
constexpr size_t OFF_KA = al256(OFF_QA + (size_t)NB * 8 * NT * 32 * 2);
constexpr size_t OFF_VAt = al256(OFF_KA + (size_t)NB * 8 * NT * 32 * 2);
constexpr size_t OFF_QW = al256(OFF_VAt + (size_t)NB * 4 * 64 * NT * 2);
constexpr size_t OFF_KW = al256(OFF_QW + (size_t)NB * 4 * NT * 64 * 2);
constexpr size_t OFF_VWt = al256(OFF_KW + (size_t)NB * 2 * NT * 64 * 2);
constexpr size_t OFF_QG = al256(OFF_VWt + (size_t)NB * 2 * 64 * NT * 2);
constexpr size_t OFF_KG = al256(OFF_QG + (size_t)NB * 4 * NT * 64 * 2);
constexpr size_t OFF_VGt = al256(OFF_KG + (size_t)NB * 2 * NT * 64 * 2);
constexpr size_t OFF_uT = al256(OFF_VGt + (size_t)NB * 2 * 64 * NT * 2);
constexpr size_t OFF_zT = al256(OFF_uT + (size_t)NB * 768 * NT * 4);
constexpr size_t OFF_yT = al256(OFF_zT + (size_t)NB * 256 * NT * 4);
constexpr size_t OFF_hdn2 = al256(OFF_yT + (size_t)NB * 256 * NT * 4);
constexpr size_t OFF_Hc = al256(OFF_hdn2 + (size_t)2 * NT * 64 * 4);
constexpr size_t OFF_A2 = al256(OFF_Hc + (size_t)256 * 2 * SEQ * 8);
constexpr size_t OFF_u8 = al256(OFF_A2 + (size_t)R * D * 2);
constexpr size_t OFF_v8 = al256(OFF_u8 + (size_t)2 * 16384 * D);
constexpr size_t OFF_us = al256(OFF_v8 + (size_t)2 * 16384 * D);
constexpr size_t OFF_vs = al256(OFF_us + (size_t)2 * 16384 * 4);
constexpr size_t OFF_keysb = al256(OFF_vs + (size_t)2 * 16384 * 4);
constexpr size_t OFF_bar = al256(OFF_keysb + (size_t)2 * 16 * 128 * 128 * 2);
constexpr size_t OFF_hdnB = al256(OFF_bar + (size_t)XCD_BAR_WORDS * 4);
constexpr size_t OFF_W3t = al256(OFF_hdnB + (size_t)2 * SEQ * 64 * 2);
constexpr size_t WS_TOTAL = al256(OFF_W3t + (size_t)2 * 1024 * 64 * 2);
constexpr size_t OFF_topv = OFF_uT;
constexpr size_t OFF_topi = OFF_topv + (size_t)R * 256 * 4;
constexpr size_t OFF_experts = OFF_topi + (size_t)R * 256;
constexpr size_t OFF_gates = OFF_experts + (size_t)R * 128 * 4;
constexpr size_t OFF_xq = OFF_A2;
constexpr size_t OFF_xqs = OFF_xq + (size_t)R * D;
constexpr size_t OFF_wsc = OFF_xqs + (size_t)R * 4;
static_assert(OFF_wsc + (size_t)R * 4 <= OFF_u8, "xq overflows A2");
constexpr size_t OFF_Oslab = OFF_P;
constexpr size_t OFF_Lslab = OFF_Oslab + (size_t)2 * NB * 4 * NT * 64 * 4;
static_assert(OFF_gates + (size_t)R * 128 * 4 <= OFF_zT, "routing buffers overflow uT");
static_assert(OFF_Lslab + (size_t)2 * NB * 4 * NT * 4 <= OFF_Wt_in, "slabs overflow P");

struct MKView;
struct MK {
  const float *x, *c, *ctx, *c_ctx, *w_mod, *b_mod, *g_norm_mix, *w_in, *g_qk_diff, *lambda_diff, *g_qk_win, *sink_win, *g_qk_glob, *hy_conv_w,
      *hy_conv_b, *hy_w1, *hy_b1, *hy_w2, *hy_b2, *hy_w3, *hy_b3, *hy_freq, *hy_bias, *g_mix_out, *w_out, *g_norm_ffn, *peer_wq, *peer_keys,
      *peer_u, *peer_v;
  float* out;
  char* ws;
};
constexpr int SMEM_BYTES = (FN + (FN >> 6) * 4) * 8 + 2048;
typedef const MK __attribute__((address_space(4))) * MKP;
DI MK launder_mk(MKP a) {
  asm volatile("" : "+s"(a));
  MK r;
  r.x = a->x; r.c = a->c; r.ctx = a->ctx; r.c_ctx = a->c_ctx; r.w_mod = a->w_mod; r.b_mod = a->b_mod;
  r.g_norm_mix = a->g_norm_mix; r.w_in = a->w_in; r.g_qk_diff = a->g_qk_diff; r.lambda_diff = a->lambda_diff;
  r.g_qk_win = a->g_qk_win; r.sink_win = a->sink_win; r.g_qk_glob = a->g_qk_glob; r.hy_conv_w = a->hy_conv_w;
  r.hy_conv_b = a->hy_conv_b; r.hy_w1 = a->hy_w1; r.hy_b1 = a->hy_b1; r.hy_w2 = a->hy_w2; r.hy_b2 = a->hy_b2;
  r.hy_w3 = a->hy_w3; r.hy_b3 = a->hy_b3; r.hy_freq = a->hy_freq; r.hy_bias = a->hy_bias; r.g_mix_out = a->g_mix_out;
  r.w_out = a->w_out; r.g_norm_ffn = a->g_norm_ffn; r.peer_wq = a->peer_wq; r.peer_keys = a->peer_keys;
  r.peer_u = a->peer_u; r.peer_v = a->peer_v; r.out = a->out; r.ws = a->ws;
  return r;
}

DI void ph_mod_item(const MK& m, int item, char* smem) {
  float* sc = (float*)smem;
  float* part = sc + 3 * D;
  const int tid = TID, lane = tid & 63, wv = tid >> 6;
  const int l = item / 96, chunk = item % 96;
  __syncthreads();
  for (int i = tid; i < 3 * D; i += NTHR) {
    int row = i / D, k = i % D;
    float v = row < 2 ? m.c[row * D + k] : m.c_ctx[k];
    sc[i] = v / (1.f + __expf(-v));
  }
  __syncthreads();
  const int col = chunk * 64 + lane;
  const float* w = m.w_mod + (size_t)l * D * NMOD + (size_t)(wv * 128) * NMOD + col;
  float a0 = 0, a1 = 0, a2 = 0;
#pragma unroll 32
  for (int k = 0; k < 128; ++k) {
    float wvv = w[(size_t)k * NMOD];
    a0 += sc[wv * 128 + k] * wvv; a1 += sc[D + wv * 128 + k] * wvv; a2 += sc[2 * D + wv * 128 + k] * wvv;
  }
  part[(wv * 3 + 0) * 64 + lane] = a0; part[(wv * 3 + 1) * 64 + lane] = a1; part[(wv * 3 + 2) * 64 + lane] = a2;
  __syncthreads();
  if (tid < 192) {
    const int row = tid >> 6;
    float sacc = 0.f;
    for (int q = 0; q < 8; ++q) sacc += part[(q * 3 + row) * 64 + lane];
    ((float*)(m.ws + OFF_modv))[(l * 3 + row) * NMOD + col] = sacc + m.b_mod[l * NMOD + col];
  }
}
DI void ph_hymlp_all(const MK& m, char* smem) {
  const int tid = TID, wv = tid >> 6, u = tid & 63;
  float* feat = (float*)smem + wv * 128;
  float* h1 = feat + 64;
  float w1r[33], w2r[64];
  float b1 = 0.f, b2 = 0.f, fq = 0.f;
  int curl = -1;
  __syncthreads();
  for (int g = BID; g < 2 * NT / 8; g += NBLK) {
    const int gi = g * 8 + wv;
    const int l = gi / NT, pos = gi % NT;
    if (l != curl) {
      curl = l;
      const float* w1 = m.hy_w1 + l * 33 * 64 + u; const float* w2 = m.hy_w2 + l * 64 * 64 + u;
#pragma unroll
      for (int i = 0; i < 33; ++i) w1r[i] = w1[i * 64];
#pragma unroll
      for (int i = 0; i < 64; ++i) w2r[i] = w2[i * 64];
      b1 = m.hy_b1[l * 64 + u]; b2 = m.hy_b2[l * 64 + u]; fq = m.hy_freq[l * 64 + u];
    }
    const int which = pos >= SEQ ? 1 : 0;
    const int j = which ? pos - SEQ : pos;
    const int n = which ? CTX : SEQ;
    const float tt = (float)j / (float)(n - 1);
    const float w = (6.283185307179586f / (float)n) * (float)j;
    if (u == 0) feat[0] = tt;
    if (u < 16) {
      float f = 1e-4f + (float)u * ((15.f - 1e-4f) / 15.f);
      const float tr = f * w * 0.15915494309189535f;
      feat[1 + u] = __builtin_amdgcn_cosf(tr - floorf(tr));
      feat[17 + u] = -__builtin_amdgcn_sinf(tr - floorf(tr));
    }
    asm volatile("s_waitcnt lgkmcnt(0)" ::: "memory");
    float a = b1;
#pragma unroll
    for (int i = 0; i < 33; ++i) a += feat[i] * w1r[i];
    { const float tr = fq * a * 0.15915494309189535f; h1[u] = __builtin_amdgcn_sinf(tr - floorf(tr)); }
    asm volatile("s_waitcnt lgkmcnt(0)" ::: "memory");
    float a2 = b2;
#pragma unroll
    for (int i = 0; i < 64; ++i) a2 += h1[i] * w2r[i];
    const float tr2 = fq * a2 * 0.15915494309189535f; const float hv2 = __builtin_amdgcn_sinf(tr2 - floorf(tr2));
    asm volatile("s_waitcnt lgkmcnt(0)" ::: "memory");
    if (which) ((float*)(m.ws + OFF_hdn2))[((size_t)l * 64 + u) * NT + pos] = hv2;
    else ((bf16_t*)(m.ws + OFF_hdnB))[(size_t)l * SEQ * 64 + (size_t)(pos >> 5) * 2048 + (u >> 4) * 512 + (((u >> 3) & 1) * 32 + (pos & 31)) * 8 + (u & 7)] = f2bf(hv2);
  }
}
DI void phase0(MKP m_in, char* smem) {
  const MK m = launder_mk(m_in);
  const int bid = BID, nb = NBLK, tid = TID;
  for (int rp = 0; rp < REP_P0_MOD; ++rp) for (int it = bid; it < 192; it += nb) ph_mod_item(m, it, smem);
  for (int rp = 0; rp < REP_P0_HY; ++rp) ph_hymlp_all(m, smem);
  {
#define WS_DECODE(t_, W_, Wt_, N_, ls_)                                                                                      \
    { const int l_ = (t_) / 352, tt_ = (t_) % 352;                                                                           \
      if (tt_ < 160) { W_ = m.w_in + (size_t)l_ * D * DIN; Wt_ = ((bf16_t*)(m.ws + OFF_Wt_in)) + (size_t)l_ * DIN * D; N_ = DIN; ls_ = tt_; }          \
      else if (tt_ < 224) { W_ = m.w_out + (size_t)l_ * D * D; Wt_ = ((bf16_t*)(m.ws + OFF_Wt_out)) + (size_t)l_ * D * D; N_ = D; ls_ = tt_ - 160; }   \
      else { W_ = m.peer_wq + (size_t)l_ * D * 2048; Wt_ = ((bf16_t*)(m.ws + OFF_Wt_q)) + (size_t)l_ * 2048 * D; N_ = 2048; ls_ = tt_ - 224; } }
    int t = bid;
    if (t < 2 * 352) {
      const float* Wc; bf16_t* Wtc; int Nc, lsc;
      WS_DECODE(t, Wc, Wtc, Nc, lsc)
      WS8 cur = wstrip_fetch(Wc, Nc, lsc);
      for (; t < 2 * 352; t += nb) {
        const int tn = (t + nb < 2 * 352) ? t + nb : t;
        const float* Wn; bf16_t* Wtn; int Nn, lsn;
        WS_DECODE(tn, Wn, Wtn, Nn, lsn)
        const WS8 nxt = wstrip_fetch(Wn, Nn, lsn);
        wstrip_process(cur, Wtc, Nc, lsc, (float*)smem);
        cur = nxt; Wtc = Wtn; Nc = Nn; lsc = lsn;
      }
    }
#undef WS_DECODE
  }
  for (int i = bid * NTHR + tid; i < 2 * 16 * 128 * 128 / 4; i += nb * NTHR) {
    float4 v = ((const float4*)m.peer_keys)[i];
    ((uint2*)((bf16_t*)(m.ws + OFF_keysb)))[i] = make_uint2(pk2bf(v.x, v.y), pk2bf(v.z, v.w));
  }
  for (int i = bid * NTHR + tid; i < 2 * 1024 * 64; i += nb * NTHR) {
    const int l = i >> 16, n = (i >> 6) & 1023, k = i & 63;
    ((bf16_t*)(m.ws + OFF_W3t))[i] = f2bf(m.hy_w3[((size_t)l * 64 + k) * 1024 + n]);
  }
}

DI void phase_norm(MKP m_in, int l, int which  , bool first, bool skip_ctx) {
  const MK m = launder_mk(m_in);
  const int tid = TID, lane = tid & 63;
  const int gw = BID * 8 + (tid >> 6), nw = NBLK * 8;
  const float* g = (which ? m.g_norm_ffn : m.g_norm_mix) + l * D;
  const float* modv_l = ((float*)(m.ws + OFF_modv)) + (size_t)l * 3 * NMOD;
  for (int r = gw; r < R; r += nw) {
    const int b = r / NT, p = r % NT;
    if (skip_ctx && p < CTX) continue;
    const int mrow = p < CTX ? 2 : b;
    const float4* src = (const float4*)(first ? (p < CTX ? m.ctx + ((size_t)b * CTX + p) * D : m.x + ((size_t)b * SEQ + (p - CTX)) * D)
                                              : ((float*)(m.ws + OFF_xs)) + (size_t)r * D);
    float4 v[4];
    float ss = 0.f;
#pragma unroll
    for (int i = 0; i < 4; ++i) { v[i] = src[lane + 64 * i]; ss += v[i].x * v[i].x + v[i].y * v[i].y + v[i].z * v[i].z + v[i].w * v[i].w; }
    for (int o = 32; o > 0; o >>= 1) ss += shxl(ss, lane, o);
    const float rs = rsqrtf(ss * (1.f / D) + EPS);
    const float* sh = modv_l + mrow * NMOD + (which ? 3 : 0) * D;
    const float* sc = sh + D;
#pragma unroll
    for (int i = 0; i < 4; ++i) {
      const int c0 = (lane + 64 * i) * 4;
      float4 gg = *(const float4*)(g + c0), s4 = *(const float4*)(sc + c0), h4 = *(const float4*)(sh + c0);
      float o0 = v[i].x * rs * gg.x * (1.f + s4.x) + h4.x, o1 = v[i].y * rs * gg.y * (1.f + s4.y) + h4.y;
      float o2 = v[i].z * rs * gg.z * (1.f + s4.z) + h4.z, o3 = v[i].w * rs * gg.w * (1.f + s4.w) + h4.w;
      *(uint2*)(((bf16_t*)(m.ws + OFF_hbuf)) + (size_t)r * D + c0) = make_uint2(pk2bf(o0, o1), pk2bf(o2, o3));
      v[i] = make_float4(o0, o1, o2, o3);
    }
    if (which) {
      float mx = 0.f;
#pragma unroll
      for (int i = 0; i < 4; ++i) mx = fmaxf(mx, fmaxf(fmaxf(fabsf(v[i].x), fabsf(v[i].y)), fmaxf(fabsf(v[i].z), fabsf(v[i].w))));
      for (int o = 32; o > 0; o >>= 1) mx = fmaxf(mx, shxl(mx, lane, o));
      mx = fmaxf(mx, 1e-30f);
      const float inv = 127.f / mx;
      *(uint4*)(((unsigned char*)(m.ws + OFF_xq)) + (size_t)r * D + lane * 16) =
          make_uint4(pack_i8x4(v[0].x * inv, v[0].y * inv, v[0].z * inv, v[0].w * inv), pack_i8x4(v[1].x * inv, v[1].y * inv, v[1].z * inv, v[1].w * inv),
                     pack_i8x4(v[2].x * inv, v[2].y * inv, v[2].z * inv, v[2].w * inv), pack_i8x4(v[3].x * inv, v[3].y * inv, v[3].z * inv, v[3].w * inv));
      if (lane == 0) ((float*)(m.ws + OFF_xqs))[r] = mx * (1.f / 127.f);
    }
  }
}

DI int rowtile_of(int i, bool latent_only) { return latent_only ? (i / 64) * 66 + 2 + (i % 64) : i; }
template <int EPI>
DI void phase_gemm(const bf16_t* A, const bf16_t* Wt, int N, bf16_t* Cb, float* xs, const float* gate_base, bool latent_only, char* smem) {
  const int nt_n = N / 128, nrt = latent_only ? 128 : 132, ntiles = nrt * nt_n;
  for (int t = BID; t < ntiles; t += NBLK) {
    int tm = rowtile_of(t / nt_n, latent_only), tn = t % nt_n;
    gemm_tile<EPI>(A, Wt, N, tm * 128, tn * 128, smem, Cb, xs, gate_base);
  }
}

DI void rope_pair8(float (&y)[8], const float (&part)[8], bool upper, const float* cs, const float* sn, int dd0) {
#pragma unroll
  for (int e = 0; e < 8; ++e) {
    float c = cs[dd0 + e], s = sn[dd0 + e];
    float x1 = upper ? part[e] : y[e], x2 = upper ? y[e] : part[e];
    y[e] = upper ? (x1 * s + x2 * c) : (x1 * c - x2 * s);
  }
}
DI void unpack8(uint4 w, float (&v)[8]) {
  v[0] = bflo(w.x); v[1] = bfhi(w.x); v[2] = bflo(w.y); v[3] = bfhi(w.y); v[4] = bflo(w.z); v[5] = bfhi(w.z); v[6] = bflo(w.w); v[7] = bfhi(w.w);
}
DI uint4 pack8(const float (&v)[8], float sc) {
  return make_uint4(pk2bf(v[0] * sc, v[1] * sc), pk2bf(v[2] * sc, v[3] * sc), pk2bf(v[4] * sc, v[5] * sc), pk2bf(v[6] * sc, v[7] * sc));
}
constexpr int VS_STRIDE = 1032;
constexpr int HS_STRIDE = 1552;
DI void prep_tile(MKP m_in, int l, int tile, char* smem) {
  const MK m = launder_mk(m_in);
  const int tid = TID, lane = tid & 63, wid = tid >> 6;
  const int r0 = tile * 32; const int b = r0 / NT, p0 = r0 % NT;
  const bool lat = p0 >= CTX;
  char* Vs = smem;
  char* Hs = smem + 33280;
  float* csh = (float*)(smem + 33280 + 34 * HS_STRIDE);
  const bf16_t* Pb = ((bf16_t*)(m.ws + OFF_P)) + (size_t)(b * NT) * DIN;
  __syncthreads();
  if (lat) {
    for (int i = tid; i < 32 * 48; i += NTHR) {
      int rr = i / 48, a = i % 48;
      int t = p0 + rr - CTX;
      float trow = (float)(t / 64), tcol = (float)(t % 64);
      float* rowp = csh + rr * 96;
      if (a < 16) {
        int j = a & 7; float f = exp2f(-(float)j * (13.287712379549449f / 8.f));
        float ang = (a < 8 ? trow : tcol) * f * 0.15915494309189535f; ang -= floorf(ang);
        rowp[a] = __builtin_amdgcn_cosf(ang); rowp[16 + a] = __builtin_amdgcn_sinf(ang);
      } else {
        int aa = a - 16; int j = aa & 15; float f = exp2f(-(float)j * (13.287712379549449f / 16.f));
        float ang = (aa < 16 ? trow : tcol) * f * 0.15915494309189535f; ang -= floorf(ang);
        rowp[32 + aa] = __builtin_amdgcn_cosf(ang); rowp[64 + aa] = __builtin_amdgcn_sinf(ang);
      }
    }
  }
  {
    const int seg_lo = lat ? CTX : 0, seg_hi = lat ? NT : CTX;
    for (int ch = tid; ch < 34 * 96; ch += NTHR) {
      int rr = ch / 96, c8 = ch % 96;
      int p = p0 - 1 + rr;
      uint4 v = make_uint4(0, 0, 0, 0);
      if (p >= seg_lo && p < seg_hi) v = *(const uint4*)(Pb + (size_t)p * DIN + 1792 + c8 * 8);
      *(uint4*)(Hs + rr * HS_STRIDE + c8 * 16) = v;
    }
  }
  __syncthreads();
  const float* gd = m.g_qk_diff + l * 64; const float* gwn = m.g_qk_win + l * 128; const float* gg = m.g_qk_glob + l * 128;
#pragma unroll
  for (int k = 0; k < 4; ++k) {
    const int rr = wid + 8 * k; const int p = p0 + rr;
    const bf16_t* Pr = Pb + (size_t)p * DIN;
    const float* rowp = csh + rr * 96;
    {
      float y[8], part[8];
      unpack8(*(const uint4*)(Pr + 8 * lane), y);
      float ss = 0.f;
#pragma unroll
      for (int e = 0; e < 8; ++e) ss += y[e] * y[e];
      ss += shxl(ss, lane, 1); ss += shxl(ss, lane, 2);
      const float rs = rsqrtf(ss * (1.f / 32) + EPS);
      const int unit = lane >> 2; const bool isk = unit >= 8; const int vh = unit & 7;
      const int d0 = (lane & 3) * 8;
      const float* gn = gd + (isk ? 32 : 0) + d0;
#pragma unroll
      for (int e = 0; e < 8; ++e) y[e] = y[e] * rs * gn[e];
      if (lat) {
#pragma unroll
        for (int e = 0; e < 8; ++e) part[e] = shxl(y[e], lane, 2);
        rope_pair8(y, part, (lane & 2) != 0, rowp, rowp + 16, (lane & 1) * 8);
      }
      bf16_t* dst = (isk ? ((bf16_t*)(m.ws + OFF_KA)) : ((bf16_t*)(m.ws + OFF_QA))) + (((size_t)b * 8 + vh) * NT + p) * 32 + d0;
      *(uint4*)dst = pack8(y, isk ? 1.f : 0.17677669529663687f * LOG2E);
    }
#pragma unroll
    for (int grp = 0; grp < 2; ++grp) {
      float y[8], part[8];
      const int cbase = grp == 0 ? 768 : 1280;
      uint4 w = make_uint4(0, 0, 0, 0);
      if (lane < 48) w = *(const uint4*)(Pr + cbase + 8 * lane);
      unpack8(w, y);
      float ss = 0.f;
#pragma unroll
      for (int e = 0; e < 8; ++e) ss += y[e] * y[e];
      ss += shxl(ss, lane, 1); ss += shxl(ss, lane, 2); ss += shxl(ss, lane, 4);
      const float rs = rsqrtf(ss * (1.f / 64) + EPS);
      const int unit = lane >> 3; const bool isk = unit >= 4; const int hh = isk ? unit - 4 : unit;
      const int d0 = (lane & 7) * 8;
      const float* gn = (grp == 0 ? gwn : gg) + (isk ? 64 : 0) + d0;
      if (lane < 48) {
#pragma unroll
        for (int e = 0; e < 8; ++e) y[e] = y[e] * rs * gn[e];
      }
      if (lat) {
#pragma unroll
        for (int e = 0; e < 8; ++e) part[e] = shxl(y[e], lane, 4);
        rope_pair8(y, part, (lane & 4) != 0, rowp + 32, rowp + 64, (lane & 3) * 8);
      }
      if (lane < 48) {
        bf16_t* base = grp == 0 ? (isk ? ((bf16_t*)(m.ws + OFF_KW)) : ((bf16_t*)(m.ws + OFF_QW))) : (isk ? ((bf16_t*)(m.ws + OFF_KG)) : ((bf16_t*)(m.ws + OFF_QG)));
        bf16_t* dst = base + (((size_t)b * (isk ? 2 : 4) + hh) * NT + p) * 64 + d0;
        *(uint4*)dst = pack8(y, isk ? 1.f : 0.125f * LOG2E);
      }
    }
    {
      const int vsrc = lane < 32 ? 512 + 8 * lane : (lane < 48 ? 1152 + 8 * (lane - 32) : 1664 + 8 * (lane - 48));
      uint4 w = *(const uint4*)(Pr + vsrc);
      *(uint2*)(Vs + rr * VS_STRIDE + lane * 16) = make_uint2(w.x, w.y);
      *(uint2*)(Vs + rr * VS_STRIDE + lane * 16 + 8) = make_uint2(w.z, w.w);
    }
  }
  __syncthreads();
  for (int tk = tid; tk < 2048; tk += NTHR) {
    const int pg = tk & 3; const int vch = (tk >> 2) & 15 | ((tk >> 6) << 4);
    unsigned short e[8];
#pragma unroll
    for (int i = 0; i < 8; ++i) {
      int sidx = 8 * pg + i;
      int pl = (sidx & 16) | perm16(sidx & 15);
      e[i] = *(const unsigned short*)(Vs + pl * VS_STRIDE + vch * 2);
    }
    uint4 w = make_uint4(e[0] | ((unsigned)e[1] << 16), e[2] | ((unsigned)e[3] << 16), e[4] | ((unsigned)e[5] << 16), e[6] | ((unsigned)e[7] << 16));
    bf16_t* dst;
    if (vch < 256) dst = ((bf16_t*)(m.ws + OFF_VAt)) + (((size_t)b * 4 + (vch >> 6)) * 64 + (vch & 63)) * NT;
    else if (vch < 384) dst = ((bf16_t*)(m.ws + OFF_VWt)) + (((size_t)b * 2 + ((vch - 256) >> 6)) * 64 + (vch & 63)) * NT;
    else dst = ((bf16_t*)(m.ws + OFF_VGt)) + (((size_t)b * 2 + ((vch - 384) >> 6)) * 64 + (vch & 63)) * NT;
    *(uint4*)(dst + p0 + 8 * pg) = w;
  }
  {
    const float* cw = ((const float*)m.hy_conv_w) + l * 3 * 768; const float* cb = ((const float*)m.hy_conv_b) + l * 768;
    const int cc = lane >> 3, pg = lane & 7;
#pragma unroll 2
    for (int cg = wid; cg < 96; cg += 8) {
      const int c = cg * 8 + cc;
      const float w0 = cw[c], w1 = cw[768 + c], w2 = cw[1536 + c], bb = cb[c];
      float xin[6];
#pragma unroll
      for (int i = 0; i < 6; ++i) xin[i] = bf2f(*(const bf16_t*)(Hs + (4 * pg + i) * HS_STRIDE + c * 2));
      float o[4];
#pragma unroll
      for (int i = 0; i < 4; ++i) o[i] = xin[i] * w0 + xin[i + 1] * w1 + xin[i + 2] * w2 + bb;
      *(float4*)(((float*)(m.ws + OFF_uT)) + ((size_t)b * 768 + c) * NT + p0 + 4 * pg) = make_float4(o[0], o[1], o[2], o[3]);
    }
  }
}

DI void hyena_ctx_channel(MKP m_in, int l, int c, char* smem) {
  const MK m = launder_mk(m_in);
  float* kf = (float*)smem;
  float* vz = kf + 1024;
  float* red = vz + 512;
  float* wcol = red + 16;
  const int tid = TID;
  const float* hd = ((float*)(m.ws + OFF_hdn2)) + (size_t)l * 64 * NT + SEQ;
  const float* w3 = m.hy_w3 + (size_t)l * 64 * 1024; const float* b3 = m.hy_b3 + l * 1024;
  __syncthreads();
  if (tid < 256) { int od = tid >> 6, i = tid & 63; wcol[i * 4 + od] = w3[i * 1024 + (od >> 1) * 512 + (od & 1) * 256 + c]; }
  __syncthreads();
  const float delta = fabsf(-3.0701134573253944f + (float)c * ((-15.350567286626972f + 3.0701134573253944f) / 255.f));
  float n0 = 0.f, n1 = 0.f;
  if (tid < 256) {
    const int j = tid;
    float f00 = b3[c], f01 = b3[256 + c], f10 = b3[512 + c], f11 = b3[768 + c];
#pragma unroll 16
    for (int i = 0; i < 64; ++i) {
      float hv = hd[(size_t)i * NT + j];
      const float4 w = *(const float4*)(wcol + 4 * i);
      f00 += hv * w.x; f01 += hv * w.y; f10 += hv * w.z; f11 += hv * w.w;
    }
    const float dec = __expf(-((float)j / (float)(CTX - 1)) * delta);
    f00 *= dec; f01 *= dec; f10 *= dec; f11 *= dec;
    kf[256 + j] = f00; kf[512 + 256 + j] = f10; n0 += fabsf(f00); n1 += fabsf(f10);
    if (j > 0) { kf[256 - j] = f01; kf[512 + 256 - j] = f11; n0 += fabsf(f01); n1 += fabsf(f11); }
    else { kf[0] = 0.f; kf[512] = 0.f; }
  }
  n0 = block_sum_512(n0, red);
  n1 = block_sum_512(n1, red);
  const float i0 = 1.f / n0, i1 = 1.f / n1;
  const int bb = tid >> 8, t = tid & 255;
  const float* ub = ((float*)(m.ws + OFF_uT)) + ((size_t)bb * 768 + c) * NT;
  const float vself = ub[t];
  vz[bb * 256 + t] = vself;
  __syncthreads();
  float acc = 0.f;
  for (int s2 = 0; s2 < 256; s2 += 4) { const float4 v4 = *(const float4*)(vz + bb * 256 + s2); const float* kp = kf + 256 + t - s2; acc += v4.x * kp[0] + v4.y * kp[-1] + v4.z * kp[-2] + v4.w * kp[-3]; }
  const float z = ub[(size_t)256 * NT + t] * (acc * i0 + m.hy_bias[l * 512 + c] * vself);
  __syncthreads();
  vz[bb * 256 + t] = z;
  __syncthreads();
  float acc2 = 0.f;
  for (int s2 = 0; s2 < 256; s2 += 4) { const float4 v4 = *(const float4*)(vz + bb * 256 + s2); const float* kp = kf + 512 + 256 + t - s2; acc2 += v4.x * kp[0] + v4.y * kp[-1] + v4.z * kp[-2] + v4.w * kp[-3]; }
  ((float*)(m.ws + OFF_yT))[((size_t)bb * 256 + c) * NT + t] = ub[(size_t)512 * NT + t] * (acc2 * i1 + m.hy_bias[l * 512 + 256 + c] * z);
}

DI TabJob make_tabjob(const MK& m, int l, int slot0, bool on) {
  TabJob j;
  j.pu = on ? m.peer_u + (size_t)l * 16384 * D : nullptr; j.pv = m.peer_v + (size_t)l * 16384 * D;
  j.du = ((unsigned char*)(m.ws + OFF_u8)) + (size_t)l * 16384 * D; j.dv = ((unsigned char*)(m.ws + OFF_v8)) + (size_t)l * 16384 * D;
  j.su = ((float*)(m.ws + OFF_us)) + l * 16384; j.sv = ((float*)(m.ws + OFF_vs)) + l * 16384;
  j.slot = slot0; j.wv = __builtin_amdgcn_readfirstlane(BID * 8 + (TID >> 6)); j.nw = NBLK * 8; j.prow = -1;
  return j;
}
constexpr int TAB_SLOTS_FILTER = 4;
constexpr int TAB_SLOTS_ALL = 18;
DI void phase_mix(MKP m_in, int l, bool want_ctx, char* smem) {
  const MK m = launder_mk(m_in);
  AttnArgs a;
  a.QA = ((bf16_t*)(m.ws + OFF_QA)); a.KA = ((bf16_t*)(m.ws + OFF_KA)); a.VAt = ((bf16_t*)(m.ws + OFF_VAt)); a.QW = ((bf16_t*)(m.ws + OFF_QW)); a.KW = ((bf16_t*)(m.ws + OFF_KW)); a.VWt = ((bf16_t*)(m.ws + OFF_VWt)); a.QG = ((bf16_t*)(m.ws + OFF_QG)); a.KG = ((bf16_t*)(m.ws + OFF_KG)); a.VGt = ((bf16_t*)(m.ws + OFF_VGt));
  a.g_qk_diff = m.g_qk_diff + l * 64; a.g_qk_win = m.g_qk_win + l * 128; a.g_qk_glob = m.g_qk_glob + l * 128; a.sink = m.sink_win + l * 4;
  a.lambda_diff = m.lambda_diff + l * 128; a.g_mix_out = m.g_mix_out + l * D; a.lambda_init = 0.8f - 0.6f * __expf(-0.3f * (float)l); a.pad0 = 0;
  a.A2 = ((bf16_t*)(m.ws + OFF_A2)); a.Oslab = ((float*)(m.ws + OFF_Oslab)); a.Lslab = ((float*)(m.ws + OFF_Lslab));
  const int nitems = 640 + (want_ctx ? 20 : 0);
  for (int rep = 0; rep < REP_DIFF; ++rep) for (int idx = BID; idx < 256; idx += NBLK) attn_dispatch(a, idx, want_ctx, smem);
  for (int rep = 0; rep < REP_GLOB; ++rep) for (int idx = 256 + BID; idx < 512; idx += NBLK) attn_dispatch(a, idx, want_ctx, smem);
  for (int rep = 0; rep < REP_HY; ++rep) for (int c = BID; c < 256; c += NBLK) {
    TabJob job = make_tabjob(m, l, TAB_SLOTS_FILTER, rep == 0 && c == BID);
    hyena_channel(c, m.hy_bias + l * 512, ((float*)(m.ws + OFF_uT)), ((float*)(m.ws + OFF_zT)), ((float*)(m.ws + OFF_yT)), (const uint2*)(m.ws + OFF_Hc), smem, job);
    tab_flush(job, TID & 63);
    if (want_ctx) hyena_ctx_channel(m_in, l, c, smem);
  }
  {
    TabJob job = make_tabjob(m, l, TAB_SLOTS_ALL, true);
    const int lane = TID & 63;
    while (job.slot * job.nw < 32768) tab_step(job, lane);
    tab_flush(job, lane);
  }
  for (int idx = 512 + BID; idx < nitems; idx += NBLK) attn_dispatch(a, idx, want_ctx, smem);
}

DI void phase_fin(MKP m_in, int l, bool want_ctx, char* smem) {
  const MK m = launder_mk(m_in);
  const float* gmo = m.g_mix_out + l * D;
  const int lane = TID & 63, wid = TID >> 6;
  char* wl = smem + wid * 9216;
  for (int chunk = BID * 8 + wid; chunk < NB * 8 * (NT / 64); chunk += NBLK * 8) {
    const int pc = chunk % (NT / 64), hd = (chunk / (NT / 64)) % 8, b = chunk / ((NT / 64) * 8);
    const int pbase = pc * 64;
    if (pbase < CTX && !want_ctx) continue;
    const float* gm = gmo + 512 + hd * 64;
    bf16_t* dst0 = ((bf16_t*)(m.ws + OFF_A2)) + ((size_t)b * NT + pbase) * D + 512 + hd * 64;
    if (hd < 4) {
      const int c4 = lane & 15, rr = lane >> 4;
      const float4 g4 = *(const float4*)(gm + 4 * c4);
      const size_t i0b = (((size_t)0 * NB + b) * 4 + hd) * NT + pbase, i1b = (((size_t)1 * NB + b) * 4 + hd) * NT + pbase;
      const float* Os = (const float*)(m.ws + OFF_Oslab); const float* Ls = (const float*)(m.ws + OFF_Lslab);
#pragma unroll 4
      for (int ps = 0; ps < 16; ++ps) {
        const int row = ps * 4 + rr;
        const float4 x = *(const float4*)(Os + (i0b + row) * 64 + 4 * c4), y = *(const float4*)(Os + (i1b + row) * 64 + 4 * c4);
        const float inv = 1.f / (Ls[i0b + row] + Ls[i1b + row]);
        const float o0 = (x.x + y.x) * inv, o1 = (x.y + y.y) * inv, o2 = (x.z + y.z) * inv, o3 = (x.w + y.w) * inv;
        float ss = o0 * o0 + o1 * o1 + o2 * o2 + o3 * o3;
        ss += shxl(ss, lane, 8); ss += shxl(ss, lane, 4); ss += shxl(ss, lane, 2); ss += shxl(ss, lane, 1);
        const float rs = rsqrtf(ss * (1.f / 64) + EPS);
        *(uint2*)(dst0 + (size_t)row * D + 4 * c4) = make_uint2(pk2bf(o0 * rs * g4.x, o1 * rs * g4.y), pk2bf(o2 * rs * g4.z, o3 * rs * g4.w));
      }
    } else {
      const int g = hd - 4, p = pbase + lane;
      float o[64]; float ss = 0.f;
#pragma unroll
      for (int i = 0; i < 64; ++i) o[i] = ((const float*)(m.ws + OFF_yT))[((size_t)b * 256 + g * 64 + i) * NT + p];
#pragma unroll
      for (int i = 0; i < 64; ++i) ss += o[i] * o[i];
      const float rs = rsqrtf(ss * (1.f / 64) + EPS);
#pragma unroll
      for (int i = 0; i < 8; ++i)
        *(uint4*)(wl + lane * 144 + i * 16) = make_uint4(pk2bf(o[8 * i] * rs * gm[8 * i], o[8 * i + 1] * rs * gm[8 * i + 1]), pk2bf(o[8 * i + 2] * rs * gm[8 * i + 2], o[8 * i + 3] * rs * gm[8 * i + 3]),
                                                         pk2bf(o[8 * i + 4] * rs * gm[8 * i + 4], o[8 * i + 5] * rs * gm[8 * i + 5]), pk2bf(o[8 * i + 6] * rs * gm[8 * i + 6], o[8 * i + 7] * rs * gm[8 * i + 7]));
      asm volatile("s_waitcnt lgkmcnt(0)" ::: "memory");
#pragma unroll
      for (int k = 0; k < 8; ++k) {
        const int row = k * 8 + (lane >> 3), ch = lane & 7;
        *(uint4*)(dst0 + (size_t)row * D + ch * 8) = *(const uint4*)(wl + row * 144 + ch * 16);
      }
      asm volatile("s_waitcnt lgkmcnt(0)" ::: "memory");
    }
  }
}

#ifndef PEER_SLICED
#define PEER_SLICED 1
#endif
#if !PEER_SLICED
DI void phase_peer(MKP m_in, int l, bool want_ctx, bool last, char* smem) {
  const MK m = launder_mk(m_in);
  const int lane = TID & 63, wid = TID >> 6;
  char* wbase = smem + wid * 10240;
  int* ex_l = (int*)wbase; float* g_l = (float*)(wbase + 4608); float* wd = (float*)(wbase + 9216);
  const float* modv_l = ((float*)(m.ws + OFF_modv)) + (size_t)l * 3 * NMOD;
  const int gw0 = BID * 8 + wid, nw0 = NBLK * 8;
  for (int i0 = 0; gw0 + nw0 * i0 < R && i0 < 9; i0 += 8) {
    const int slot = i0 + (lane >> 3);
    const int r = gw0 + nw0 * slot;
    if (slot < 9 && r < R && !((r % NT) < CTX && !want_ctx))
      merge_one(((unsigned*)(m.ws + OFF_topv)), r, lane & 7, ex_l + slot * 128, g_l + slot * 128);
  }
  int slot = 0;
  for (int r = gw0; r < R; r += nw0, ++slot) {
    if ((r % NT) < CTX && !want_ctx) continue;
    if (slot >= 9) {
      if (lane < 8) merge_one(((unsigned*)(m.ws + OFF_topv)), r, lane, ex_l + 8 * 128, g_l + 8 * 128);
    }
    const int sl = slot < 9 ? slot : 8;
    peer_token<PEER_SLICED>(r, ((bf16_t*)(m.ws + OFF_hbuf)), ex_l + sl * 128, g_l + sl * 128, ((unsigned char*)(m.ws + OFF_u8)) + (size_t)l * 16384 * D, ((float*)(m.ws + OFF_us)) + l * 16384, ((unsigned char*)(m.ws + OFF_v8)) + (size_t)l * 16384 * D, ((float*)(m.ws + OFF_vs)) + l * 16384,
               modv_l, ((float*)(m.ws + OFF_xs)), wd, last ? m.out : nullptr, ((int*)(m.ws + OFF_experts)), ((float*)(m.ws + OFF_gates)));
  }
}
#endif
DI void peer_v_rows(const MK& m, int l, bool want_ctx, bool last, int vslice_, int w0, int wstride) {
  const int lane = TID & 63, g = lane >> 3, j = lane & 7;
  const int vslice = __builtin_amdgcn_readfirstlane(vslice_);
  const unsigned char* v8u = ((const unsigned char*)(m.ws + OFF_v8)) + (size_t)l * 16384 * D + (size_t)vslice * TSLICE;
  const unsigned j16 = (unsigned)j * 16u;
  const unsigned* wts = (const unsigned*)(m.ws + OFF_gates);
  const float* modv_l = ((const float*)(m.ws + OFF_modv)) + (size_t)l * 3 * NMOD;
  float* xs = (float*)(m.ws + OFF_xs);
#pragma unroll 1
  for (int r = w0; r < R; r += wstride) {
    const int b = r / NT, p = r % NT;
    if (p < CTX && !want_ctx) continue;
    unsigned pkv[16];
    {
      const uint4* ep = (const uint4*)(wts + (size_t)r * 128 + 16 * g);
#pragma unroll
      for (int q = 0; q < 4; ++q) { const uint4 e4 = ep[q]; pkv[4 * q] = e4.x; pkv[4 * q + 1] = e4.y; pkv[4 * q + 2] = e4.z; pkv[4 * q + 3] = e4.w; }
    }
    const float invS = ((const float*)(m.ws + OFF_wsc))[r];
    const int col = 256 * (g >> 1) + 32 * vslice + 4 * j + 2 * (g & 1);
    const int mrow = p < CTX ? 2 : b;
    const float2 gg = *(const float2*)(modv_l + mrow * NMOD + 5 * D + col);
    float2 xv = *(const float2*)(xs + (size_t)r * D + col);
    uint4 rw[16];
#pragma unroll
    for (int q = 0; q < 16; ++q) {
      unsigned off;
      asm("v_mad_u32_u16 %0, %1, %2, %3" : "=v"(off) : "v"(pkv[q]), "s"(128u), "v"(j16));
      rw[q] = *(const uint4*)(v8u + off);
    }
    h2_t hacc[8];
#pragma unroll
    for (int i = 0; i < 8; ++i) hacc[i] = (h2_t){(_Float16)0.f, (_Float16)0.f};
#pragma unroll
    for (int q = 0; q < 16; ++q) {
      const h2_t pk2 = __builtin_bit_cast(h2_t, pkv[q]);
      const h2_t w2 = __builtin_shufflevector(pk2, pk2, 1, 1);
      const int r4[4] = {(int)rw[q].x, (int)rw[q].y, (int)rw[q].z, (int)rw[q].w};
#pragma unroll
      for (int c = 0; c < 4; ++c) {
        hacc[2 * c] = __builtin_elementwise_fma(__builtin_bit_cast(h2_t, __builtin_amdgcn_cvt_scalef32_pk_f16_fp8(r4[c], 1.0f, false)), w2, hacc[2 * c]);
        hacc[2 * c + 1] = __builtin_elementwise_fma(__builtin_bit_cast(h2_t, __builtin_amdgcn_cvt_scalef32_pk_f16_fp8(r4[c], 1.0f, true)), w2, hacc[2 * c + 1]);
      }
    }
    h2_t b4[4], c2[2], d1;
    {
      const bool g2 = lane & 32, g1 = lane & 16, g0 = lane & 8;
#pragma unroll
      for (int i = 0; i < 4; ++i) {
        const int send = __builtin_bit_cast(int, g2 ? hacc[i] : hacc[4 + i]); const h2_t keep = g2 ? hacc[4 + i] : hacc[i];
        b4[i] = keep + __builtin_bit_cast(h2_t, shxl(send, lane, 32));
      }
#pragma unroll
      for (int i = 0; i < 2; ++i) {
        const int send = __builtin_bit_cast(int, g1 ? b4[i] : b4[2 + i]); const h2_t keep = g1 ? b4[2 + i] : b4[i];
        c2[i] = keep + __builtin_bit_cast(h2_t, shxl(send, lane, 16));
      }
      {
        const int send = __builtin_bit_cast(int, g0 ? c2[0] : c2[1]); const h2_t keep = g0 ? c2[1] : c2[0];
        d1 = keep + __builtin_bit_cast(h2_t, shxl(send, lane, 8));
      }
    }
    {
      xv.x += gg.x * ((float)d1[0] * invS); xv.y += gg.y * ((float)d1[1] * invS);
      float* op = last ? m.out + ((size_t)b * SEQ + (p - CTX)) * D + col : xs + (size_t)r * D + col;
      *(float2*)op = xv;
    }
  }
}
DI void phase_peer_merge(MKP m_in, bool want_ctx, char* smem) {
  const MK m = launder_mk(m_in);
  const int lane = TID & 63, wid = TID >> 6;
  char* wbase = smem + wid * 8192;
  int* ex_l = (int*)wbase; float* g_l = (float*)(wbase + 4096);
  int* experts = (int*)(m.ws + OFF_experts); float* gates = (float*)(m.ws + OFF_gates);
  for (int grp = BID * 8 + wid; grp < R / 8; grp += NBLK * 8) {
    const int r = grp * 8 + (lane >> 3);
    const bool skip = ((r % NT) < CTX) && !want_ctx;
    if (skip) continue;
    merge_one(((unsigned*)(m.ws + OFF_topv)), r, lane & 7, ex_l + (lane >> 3) * 128, g_l + (lane >> 3) * 128);
    asm volatile("s_waitcnt lgkmcnt(0)" ::: "memory");
#pragma unroll
    for (int q = 0; q < 4; ++q) {
      const int idx = (q * 64 + lane) * 4;
      *(uint4*)(experts + (size_t)grp * 1024 + idx) = *(const uint4*)(ex_l + idx);
      *(float4*)(gates + (size_t)grp * 1024 + idx) = *(const float4*)(g_l + idx);
    }
    asm volatile("s_waitcnt lgkmcnt(0)" ::: "memory");
  }
}
DI void peer_u_rows(const MK& m, int l, bool want_ctx, int vslice_, int w0, int wstride) {
  const int lane = TID & 63, g = lane >> 3, j = lane & 7;
  const int vslice = __builtin_amdgcn_readfirstlane(vslice_);
  const unsigned char* u8 = ((const unsigned char*)(m.ws + OFF_u8)) + (size_t)l * 16384 * D + (size_t)vslice * TSLICE;
  const unsigned char* xq = (const unsigned char*)(m.ws + OFF_xq);
  const unsigned loff = (unsigned)(vslice * 128 + j * 16);
  const unsigned j16 = (unsigned)j * 16u;
  const int* experts = (const int*)(m.ws + OFF_experts);
  int* PD = ((int*)(m.ws + OFF_P)) + (size_t)vslice * R * 128;
#pragma unroll 1
  for (int r = w0; r < R; r += wstride) {
    if (((r % NT) < CTX) && !want_ctx) continue;
    uint4 rw[16];
    {
      const uint4* ep = (const uint4*)((const unsigned short*)experts + (size_t)r * 128 + 16 * g);
      const uint4 ea = ep[0], eb = ep[1];
      const unsigned ew[8] = {ea.x, ea.y, ea.z, ea.w, eb.x, eb.y, eb.z, eb.w};
#pragma unroll
      for (int q = 0; q < 8; ++q) {
        unsigned o0, o1;
        asm("v_mad_u32_u16 %0, %1, %2, %3" : "=v"(o0) : "v"(ew[q]), "s"(128u), "v"(j16));
        asm("v_mad_u32_u16 %0, %1, %2, %3 op_sel:[1,0,0,0]" : "=v"(o1) : "v"(ew[q]), "s"(128u), "v"(j16));
        rw[2 * q] = *(const uint4*)(u8 + o0);
        rw[2 * q + 1] = *(const uint4*)(u8 + o1);
      }
    }
    const uint4 xv = *(const uint4*)(xq + (size_t)r * D + loff);
    int pd[16];
#pragma unroll
    for (int q = 0; q < 16; ++q) {
      int a = __builtin_amdgcn_sdot4((int)rw[q].x, (int)xv.x, 0, false);
      a = __builtin_amdgcn_sdot4((int)rw[q].y, (int)xv.y, a, false);
      a = __builtin_amdgcn_sdot4((int)rw[q].z, (int)xv.z, a, false);
      pd[q] = __builtin_amdgcn_sdot4((int)rw[q].w, (int)xv.w, a, false);
    }
    int b8[8], c4[4], d2[2];
    {
      const bool j2 = lane & 4, j1 = lane & 2, j0 = lane & 1;
#pragma unroll
      for (int i = 0; i < 8; ++i) { const int send = j2 ? pd[i] : pd[8 + i], keep = j2 ? pd[8 + i] : pd[i]; b8[i] = keep + shxl(send, lane, 4); }
#pragma unroll
      for (int i = 0; i < 4; ++i) { const int send = j1 ? b8[i] : b8[4 + i], keep = j1 ? b8[4 + i] : b8[i]; c4[i] = keep + shxl(send, lane, 2); }
#pragma unroll
      for (int i = 0; i < 2; ++i) { const int send = j0 ? c4[i] : c4[2 + i], keep = j0 ? c4[2 + i] : c4[i]; d2[i] = keep + shxl(send, lane, 1); }
    }
    *(int2*)(PD + (size_t)r * 128 + 16 * g + 2 * j) = make_int2(d2[0], d2[1]);
  }
}
DI void phase_peer_u(MKP m_in, int l, bool want_ctx, char* smem) {
  const MK m = launder_mk(m_in);
  unsigned* bar = (unsigned*)(m.ws + OFF_bar);
  volatile LAS unsigned* st = (volatile LAS unsigned*)(smem + SMEM_BYTES);
  if (threadIdx.x == 0) {
    unsigned ok = 1u, mine = 0u; const unsigned x = st[3];
    for (unsigned q = 0; q < 16; ++q) { const unsigned c = xb_ld(&bar[XB_XCNT(q)]); if ((q < 8) != (c > 0u)) ok = 0u; if (q == x) mine = c; }
    st[4] = ok ? mine : 0u;
  }
  __syncthreads();
  const unsigned nloc = st[4];
  const int wid = TID >> 6;
  if (nloc != 0u) peer_u_rows(m, l, want_ctx, (int)(st[3] & 7u), (int)st[2] * 8 + wid, (int)nloc * 8);
  else for (int v = 0; v < 8; ++v) peer_u_rows(m, l, want_ctx, v, BID * 8 + wid, NBLK * 8);
}
DI void phase_peer_reduce(MKP m_in, int l, bool want_ctx) {
  const MK m = launder_mk(m_in);
  const int* experts = (const int*)(m.ws + OFF_experts);
  float* gates = (float*)(m.ws + OFF_gates);
  const int* PD = (const int*)(m.ws + OFF_P);
  const float* us = ((const float*)(m.ws + OFF_us)) + l * 16384;
  const float* vs = ((const float*)(m.ws + OFF_vs)) + l * 16384;
  const float* xqs = (const float*)(m.ws + OFF_xqs);
  for (int i4 = BID * NTHR + TID; i4 < R * 32; i4 += NBLK * NTHR) {
    const int r = i4 >> 5;
    if (((r % NT) < CTX) && !want_ctx) continue;
    int4 acc = make_int4(0, 0, 0, 0);
#pragma unroll
    for (int v = 0; v < 8; ++v) { const int4 p = ((const int4*)(PD + (size_t)v * R * 128))[i4]; acc.x += p.x; acc.y += p.y; acc.z += p.z; acc.w += p.w; }
    const uint2 e2 = ((const uint2*)experts)[i4];
    const int4 e4 = make_int4((int)(e2.x & 0xffffu), (int)(e2.x >> 16), (int)(e2.y & 0xffffu), (int)(e2.y >> 16));
    float4 g4 = ((const float4*)gates)[i4];
    const float xs_ = xqs[r];
    const int ee[4] = {e4.x, e4.y, e4.z, e4.w}; const int aa[4] = {acc.x, acc.y, acc.z, acc.w}; float gg[4] = {g4.x, g4.y, g4.z, g4.w};
#pragma unroll
    for (int q = 0; q < 4; ++q) {
      const float d = (float)aa[q] * (us[ee[q]] * xs_);
      const float t = d / (1.f + __expf(-2.f * 0.7978845608028654f * (d + 0.044715f * d * d * d)));
      gg[q] = gg[q] * t * vs[ee[q]];
    }
    const int lane = TID & 63;
    float mxw = fmaxf(fmaxf(fabsf(gg[0]), fabsf(gg[1])), fmaxf(fabsf(gg[2]), fabsf(gg[3])));
    mxw = fmaxf(mxw, shxl(mxw, lane, 1)); mxw = fmaxf(mxw, shxl(mxw, lane, 2)); mxw = fmaxf(mxw, shxl(mxw, lane, 4));
    mxw = fmaxf(mxw, shxl(mxw, lane, 8)); mxw = fmaxf(mxw, shxl(mxw, lane, 16));
    const unsigned eb = (__float_as_uint(mxw) >> 23) & 255u;
    const float Sw = __uint_as_float((252u - eb) << 23);
    unsigned pk[4];
#pragma unroll
    for (int q = 0; q < 4; ++q) {
      const _Float16 wh = (_Float16)(gg[q] * Sw);
      pk[q] = (unsigned)ee[q] | ((unsigned)__builtin_bit_cast(unsigned short, wh) << 16);
    }
    ((uint4*)gates)[i4] = make_uint4(pk[0], pk[1], pk[2], pk[3]);
    if ((i4 & 31) == 0) ((float*)(m.ws + OFF_wsc))[r] = __uint_as_float(eb == 0u ? 0u : ((eb + 2u) << 23));
  }
}
DI void phase_peer_v(MKP m_in, int l, bool want_ctx, bool last, char* smem) {
  const MK m = launder_mk(m_in);
  unsigned* bar = (unsigned*)(m.ws + OFF_bar);
  volatile LAS unsigned* st = (volatile LAS unsigned*)(smem + SMEM_BYTES);
  if (threadIdx.x == 0) {
    unsigned ok = 1u, mine = 0u; const unsigned x = st[3];
    for (unsigned q = 0; q < 16; ++q) { const unsigned c = xb_ld(&bar[XB_XCNT(q)]); if ((q < 8) != (c > 0u)) ok = 0u; if (q == x) mine = c; }
    st[1 + 3 + 0] = ok ? mine : 0u;
  }
  __syncthreads();
  const unsigned nloc = st[4];
  const int wid = TID >> 6;
  if (nloc != 0u) {
    peer_v_rows(m, l, want_ctx, last, (int)(st[3] & 7u), (int)st[2] * 8 + wid, (int)nloc * 8);
  } else {
    for (int v = 0; v < 8; ++v) peer_v_rows(m, l, want_ctx, last, v, BID * 8 + wid, NBLK * 8);
  }
}

DI void phase_scores(MKP m_in, int l, bool last, char* smem) {
  const MK m = launder_mk(m_in);
  const int nrt = last ? 128 : 132;
  const bf16_t* qb = (const bf16_t*)(m.ws + OFF_P); const bf16_t* kb = ((const bf16_t*)(m.ws + OFF_keysb)) + (size_t)l * 16 * 128 * 128;
  const int nb = NBLK;
  int t = BID;
  if (t >= nrt * 8) return;
  SSLd carry = score_sort_fetch(qb, kb, rowtile_of(t >> 3, last) * 128, 2 * (t & 7));
  for (; t < nrt * 8; t += nb) {
    const int tn = t + nb; const bool hn = tn < nrt * 8; const int tq = hn ? tn : t;
    score_head_item(qb, kb, rowtile_of(t >> 3, last) * 128, t & 7, smem, ((int*)(m.ws + OFF_experts)), ((float*)(m.ws + OFF_gates)), carry, hn,
                    rowtile_of(tq >> 3, last) * 128, tq & 7);
  }
}
DI void phase_gemm1(MKP m_in, int l, char* smem) {
  const MK m = launder_mk(m_in);
  pg8::Gemm g; g.A = (bf16_t*)(m.ws + OFF_hbuf); g.Bt = (bf16_t*)(m.ws + OFF_Wt_in) + (size_t)l * DIN * D; g.M = R; g.N = DIN; g.K = D;
  MySched S; S.init(DIN, false, NBLK, BID);
  EpiStoreBf16 E; E.Cb = (bf16_t*)(m.ws + OFF_P); E.ldc = DIN;
  __syncthreads();
  pg8::gemm_phase<EpiStoreBf16, MySched, false>((PG8_LAS unsigned char*)smem, g, S, E, nullptr);
  __syncthreads();
}
DI int ctx_rowtile(int i) { return (i >> 1) * 66 + (i & 1); }
DI void phase_gemm2(MKP m_in, int l, bool last, char* smem) {
  const MK m = launder_mk(m_in);
  pg8::Gemm g; g.A = (bf16_t*)(m.ws + OFF_A2); g.Bt = (bf16_t*)(m.ws + OFF_Wt_out) + (size_t)l * D * D; g.M = R; g.N = D; g.K = D;
  MySched S; S.init(D, true, NBLK, BID);
  EpiResidual E; E.xs = (float*)(m.ws + OFF_xs); E.gate_base = (float*)(m.ws + OFF_modv) + (size_t)l * 3 * NMOD + 2 * D;
  E.xin = l == 0 ? m.x : nullptr; E.ctxin = l == 0 ? m.ctx : nullptr;
  __syncthreads();
  pg8::gemm_phase<EpiResidual, MySched, false>((PG8_LAS unsigned char*)smem, g, S, E, nullptr);
  __syncthreads();
  if (!last) {
    const int nb = NBLK;
    for (int t = (BID + nb - 32) % nb; t < 4 * 8; t += nb)
      gemm_tile<1>(g.A, g.Bt, D, ctx_rowtile(t >> 3) * 128, (t & 7) * 128, smem, nullptr, E.xs, E.gate_base, E.xin, E.ctxin);
  }
}
DI void phase_gemm3(MKP m_in, int l, bool last, char* smem) {
  const MK m = launder_mk(m_in);
  pg8::Gemm g; g.A = (bf16_t*)(m.ws + OFF_hbuf); g.Bt = (bf16_t*)(m.ws + OFF_Wt_q) + (size_t)l * 2048 * D; g.M = R; g.N = 2048; g.K = D;
  MySched S; S.init(2048, true, NBLK, BID);
  EpiStoreBf16 E; E.Cb = (bf16_t*)(m.ws + OFF_P); E.ldc = 2048;
  __syncthreads();
  pg8::gemm_phase<EpiStoreBf16, MySched, false>((PG8_LAS unsigned char*)smem, g, S, E, nullptr);
  __syncthreads();
  if (!last) {
    const int nb = NBLK;
    for (int t = (BID + nb - 64) % nb; t < 4 * 16; t += nb)
      gemm_tile<0>(g.A, g.Bt, 2048, ctx_rowtile(t >> 4) * 128, (t & 15) * 128, smem, E.Cb, nullptr, nullptr);
  }
}
#define GSYNC() xcd_barrier((unsigned*)(launder_mk(m).ws + OFF_bar), (volatile LAS unsigned*)(smem + SMEM_BYTES))
DI void phase_filters(MKP m_in, int l, char* smem) {
  const MK m = launder_mk(m_in);
  for (int c = BID; c < 256; c += NBLK) {
    TabJob job = make_tabjob(m, l, 0, c == BID);
    hyena_filter_task(c, ((const bf16_t*)(m.ws + OFF_hdnB)) + (size_t)l * SEQ * 64, ((const bf16_t*)(m.ws + OFF_W3t)) + (size_t)l * 1024 * 64, m.hy_b3 + l * 1024, (uint2*)(m.ws + OFF_Hc), smem, job);
    tab_flush(job, TID & 63);
  }
}
template <int L>
DI void layer_body(MKP m, char* smem) {
  constexpr bool want_ctx = L == 0, last = L == 1;
  for (int rep = 0; rep < REP_NORM1; ++rep) { phase_norm(m, L, 0, L == 0, false); GSYNC(); }
  for (int rep = 0; rep < REP_GEMM1; ++rep) { phase_gemm1(m, L, smem); GSYNC(); }
  for (int rep = 0; rep < REP_PREP; ++rep) for (int t = BID; t < R / 32; t += NBLK) prep_tile(m, L, t, smem);
  for (int rep = 0; rep < REP_FILT; ++rep) phase_filters(m, L, smem);
  GSYNC();
  for (int rep = 0; rep < REP_MIX; ++rep) { phase_mix(m, L, want_ctx, smem); GSYNC(); }
  for (int rep = 0; rep < REP_FIN; ++rep) { phase_fin(m, L, want_ctx, smem); GSYNC(); }
  phase_gemm2(m, L, last, smem);
  GSYNC();
  for (int rep = 0; rep < REP_NORM2; ++rep) { phase_norm(m, L, 1, false, last); GSYNC(); }
  for (int rep = 0; rep < REP_GEMM3; ++rep) { phase_gemm3(m, L, last, smem); GSYNC(); }
  for (int rep = 0; rep < REP_SCORES; ++rep) { phase_scores(m, L, last, smem); GSYNC(); }
  for (int rep = 0; rep < (last ? REP_PEER_LAST : 1); ++rep) {
#if PEER_SLICED
    for (int ru = 0; ru < (last ? REP_PEER_U : 1); ++ru) phase_peer_u(m, L, want_ctx, smem);
    GSYNC();
    phase_peer_reduce(m, L, want_ctx);
    GSYNC();
    for (int rv = 0; rv < (last ? REP_PEER_V : 1); ++rv) phase_peer_v(m, L, want_ctx, last, smem);
#else
    phase_peer(m, L, want_ctx, last, smem);
#endif
    if (!last || rep + 1 < REP_PEER_LAST) GSYNC();
  }
}
__global__ __launch_bounds__(NTHR) void k_mega(MK m_unused) {
  extern __shared__ __attribute__((aligned(16))) char smem[];
  (void)m_unused;
  MKP m = (MKP)__builtin_amdgcn_kernarg_segment_ptr();
  {
    volatile LAS unsigned* st = (volatile LAS unsigned*)(smem + SMEM_BYTES);
    if (threadIdx.x == 0) { st[0] = 0u; st[1] = 0u; st[2] = 0u; st[3] = 0u; st[4] = 0u; st[5] = 0u; }
    __syncthreads();
    xcd_barrier_post((unsigned*)(launder_mk(m).ws + OFF_bar), st);
  }
  for (int rep = 0; rep < REP_P0; ++rep) { phase0(m, smem); GSYNC(); }
  layer_body<0>(m, smem);
  layer_body<1>(m, smem);
}

extern "C" void kernel_launch(void* const* d_in, const int* in_sizes, int n_in, void* d_out, int out_size, void* d_ws, size_t ws_size,
                              hipStream_t stream) {
  (void)in_sizes; (void)n_in; (void)out_size;
  MK m;
  memset(&m, 0, sizeof(m));
  const float** ip = (const float**)&m.x;
  for (int i = 0; i < 30; ++i) ip[i] = (const float*)d_in[i];
  m.out = (float*)d_out;
  m.ws = (char*)d_ws;
  if (WS_TOTAL > ws_size) return;

  static int grid_blocks = 0;
  if (!grid_blocks) {
    (void)hipFuncSetAttribute((const void*)k_mega, hipFuncAttributeMaxDynamicSharedMemorySize, SMEM_BYTES + 32);
    int dev = 0, cus = 0, per_cu = 0;
    (void)hipGetDevice(&dev);
    (void)hipDeviceGetAttribute(&cus, hipDeviceAttributeMultiprocessorCount, dev);
    (void)hipOccupancyMaxActiveBlocksPerMultiprocessor(&per_cu, k_mega, NTHR, SMEM_BYTES + 32);
    if (per_cu > 1) per_cu = 1;
    grid_blocks = cus * per_cu;
  }
  (void)hipMemsetAsync(m.ws + OFF_bar, 0, (size_t)XCD_BAR_WORDS * 4, stream);
  void* args[] = {&m};
  (void)hipLaunchCooperativeKernel((void*)k_mega, dim3(grid_blocks), dim3(NTHR), args, SMEM_BYTES + 32, stream);
}
```
